# Optimizing an MI355X kernel written in HIP

```python
import jax, jax.numpy as jnp
from jax import lax
import numpy as np


D_MODEL = 1024
BATCH = 4
SEQ = 4096
DEPTH = 1
DEC_BATCH = 128
DEC_SEQ = 8
PAST_LEN = 2048
PAGE_SIZE = 128

D_POOL = D_MODEL // 2
POOL_WINDOWS = (2, 4, 8, 16)
POOL_GROUPS = len(POOL_WINDOWS)
POOL_GC = D_POOL // POOL_GROUPS
POOL_HIST = max(POOL_WINDOWS) - 1
D_ATTN = D_MODEL // 2
HEAD_DIM = 64
N_HEADS = D_ATTN // HEAD_DIM
Q_BLOCK = 128
ATTN_SCALE = HEAD_DIM ** -0.5
N_KEYS = 128
N_EXPERTS = N_KEYS * N_KEYS
PEER_HEADS = 8
PEER_TOPK = 16
D_KEY = 256
D_KEY_HALF = D_KEY // 2
PEER_CHUNK = 128
RMS_EPS = 1e-6
D_IN = D_POOL + 3 * D_ATTN + N_HEADS + 2 * D_MODEL
SPLITS = (D_POOL, D_POOL + D_ATTN, D_POOL + 2 * D_ATTN, D_POOL + 3 * D_ATTN,
          D_POOL + 3 * D_ATTN + N_HEADS, D_POOL + 3 * D_ATTN + N_HEADS + D_MODEL)

kernel_name = 'hybrid_pool_fox_peer_decode_step'


def rmsnorm(x, g):
    xf = x.astype(jnp.float32)
    ms = jnp.mean(xf * xf, axis=-1, keepdims=True)
    return (xf * lax.rsqrt(ms + RMS_EPS) * g.astype(jnp.float32)).astype(x.dtype)


def project_in(x, norm_mix_g, w_in, b_forget, q_norm_g, k_norm_g):
    B, L, _ = x.shape
    xn = rmsnorm(x, norm_mix_g)
    p = xn @ w_in
    u_pool, q, k, v, f_logit, gate_a, gate_b = jnp.split(p, SPLITS, axis=-1)
    q = rmsnorm(q.reshape(B, L, N_HEADS, HEAD_DIM), q_norm_g)
    k = rmsnorm(k.reshape(B, L, N_HEADS, HEAD_DIM), k_norm_g)
    v = v.reshape(B, L, N_HEADS, HEAD_DIM)
    logf = jax.nn.log_sigmoid((f_logit + b_forget).astype(jnp.float32))
    return u_pool, q, k, v, logf, gate_a, gate_b


def pool_mixer(u, hist, pos0, pool_mix_w, pool_scale):
    B, L, _ = u.shape
    u_ext = jnp.concatenate([hist.astype(u.dtype), u], axis=1)
    c = jnp.cumsum(u_ext.astype(jnp.float32), axis=1)
    c = jnp.concatenate([jnp.zeros((B, 1, D_POOL), jnp.float32), c], axis=1)
    pos = pos0 + jnp.arange(L)
    start = POOL_HIST + 1
    outs = []
    for gi, w in enumerate(POOL_WINDOWS):
        sl = slice(gi * POOL_GC, (gi + 1) * POOL_GC)
        wsum = c[:, start:start + L, sl] - c[:, start - w:start - w + L, sl]
        cnt = jnp.minimum(pos + 1, w).astype(jnp.float32)
        outs.append(wsum / cnt[None, :, None] - u[..., sl].astype(jnp.float32))
    m = jnp.stack(outs, axis=2)
    m = jnp.einsum('blgc,gcd->blgd', m, pool_mix_w.astype(jnp.float32)).reshape(B, L, D_POOL)
    out = (m * pool_scale).astype(u.dtype)
    return out, u_ext[:, -POOL_HIST:]


def attend(q, k, v, cq, ck, qpos, kpos):
    logits = jnp.einsum('bqhd,bkhd->bhqk', q.astype(jnp.float32), k.astype(jnp.float32)) * ATTN_SCALE
    bias = jnp.transpose(cq, (0, 2, 1))[..., :, None] - jnp.transpose(ck, (0, 2, 1))[..., None, :]
    mask = kpos[None, :] <= qpos[:, None]
    logits = jnp.where(mask, logits + bias, -jnp.inf)
    p = jax.nn.softmax(logits, axis=-1)
    o = jnp.einsum('bhqk,bkhd->bqhd', p, v.astype(jnp.float32))
    return o.astype(v.dtype)


def prompt_attention(q, k, v, logf):
    B, S = q.shape[:2]
    c = jnp.cumsum(logf.astype(jnp.float32), axis=1)
    kpos = jnp.arange(S)

    def block(i):
        s0 = i * Q_BLOCK
        qb = lax.dynamic_slice_in_dim(q, s0, Q_BLOCK, axis=1)
        cqb = lax.dynamic_slice_in_dim(c, s0, Q_BLOCK, axis=1)
        return attend(qb, k, v, cqb, c, s0 + jnp.arange(Q_BLOCK), kpos)

    o = lax.map(block, jnp.arange(S // Q_BLOCK))
    return jnp.transpose(o, (1, 0, 2, 3, 4)).reshape(B, S, D_ATTN)


def sample_attention(q, k, v, logf, cache_k, cache_v, cache_logf, page_table):
    DB, T = q.shape[:2]
    n_pages = page_table.shape[1]
    P = n_pages * PAGE_SIZE
    k_past = cache_k[page_table].reshape(DB, P, N_HEADS, HEAD_DIM)
    v_past = cache_v[page_table].reshape(DB, P, N_HEADS, HEAD_DIM)
    lf_past = cache_logf[page_table].reshape(DB, P, N_HEADS)
    k_all = jnp.concatenate([k_past, k.astype(k_past.dtype)], axis=1)
    v_all = jnp.concatenate([v_past, v.astype(v_past.dtype)], axis=1)
    c_all = jnp.cumsum(jnp.concatenate([lf_past.astype(jnp.float32), logf], axis=1), axis=1)
    o = attend(q, k_all, v_all, c_all[:, P:], c_all, P + jnp.arange(T), jnp.arange(P + T))
    return o.reshape(DB, T, D_ATTN)


def peer_chunk(xc, w_query, sub_keys, peer_u, peer_v):
    C = xc.shape[0]
    q = (xc @ w_query).reshape(C, PEER_HEADS, 2, D_KEY_HALF)
    s = jnp.einsum('chpd,hpnd->chpn', q.astype(jnp.float32), sub_keys.astype(jnp.float32))
    s1, i1 = lax.top_k(s[:, :, 0], PEER_TOPK)
    s2, i2 = lax.top_k(s[:, :, 1], PEER_TOPK)
    cand_s = (s1[..., :, None] + s2[..., None, :]).reshape(C, PEER_HEADS, PEER_TOPK * PEER_TOPK)
    cand_i = (i1[..., :, None] * N_KEYS + i2[..., None, :]).reshape(C, PEER_HEADS, PEER_TOPK * PEER_TOPK)
    top_s, top_pos = lax.top_k(cand_s, PEER_TOPK)
    idx = jnp.take_along_axis(cand_i, top_pos, axis=-1)
    g = jax.nn.softmax(top_s, axis=-1)
    u = peer_u[idx]
    a = jax.nn.gelu(jnp.einsum('cd,chkd->chk', xc, u).astype(jnp.float32), approximate=False)
    v = peer_v[idx]
    return jnp.einsum('chk,chkd->cd', (g * a).astype(v.dtype), v).astype(xc.dtype)


def peer_ffn(xn, w_query, sub_keys, peer_u, peer_v):
    n = xn.shape[0]
    pad = (-n) % PEER_CHUNK
    xp = jnp.pad(xn, ((0, pad), (0, 0))).reshape(-1, PEER_CHUNK, D_MODEL)
    out = lax.map(lambda xc: peer_chunk(xc, w_query, sub_keys, peer_u, peer_v), xp)
    return out.reshape(-1, D_MODEL)[:n]


def merge_and_ffn(x, pool_out, attn_out, gate_a, gate_b, w_branch_pool, w_branch_attn, w_out,
                  norm_ffn_g, w_query, sub_keys, peer_u, peer_v):
    mixed = jax.nn.sigmoid(gate_a) * (pool_out @ w_branch_pool) + jax.nn.sigmoid(gate_b) * (attn_out @ w_branch_attn)
    h = x + mixed @ w_out
    hn = rmsnorm(h, norm_ffn_g)
    return h + peer_ffn(hn.reshape(-1, D_MODEL), w_query, sub_keys, peer_u, peer_v).reshape(h.shape)


def layer_step(x_p, x_s, cache_k, cache_v, cache_logf, state_pool, page_table, norm_mix_g, w_in, b_forget,
               q_norm_g, k_norm_g, pool_mix_w, pool_scale, w_branch_pool, w_branch_attn, w_out, norm_ffn_g,
               w_query, sub_keys, peer_u, peer_v):
    u_p, q_p, k_p, v_p, lf_p, ga_p, gb_p = project_in(x_p, norm_mix_g, w_in, b_forget, q_norm_g, k_norm_g)
    hist0 = jnp.zeros((x_p.shape[0], POOL_HIST, D_POOL), u_p.dtype)
    pool_p, hist_p = pool_mixer(u_p, hist0, 0, pool_mix_w, pool_scale)
    attn_p = prompt_attention(q_p, k_p, v_p, lf_p)
    y_p = merge_and_ffn(x_p, pool_p, attn_p, ga_p, gb_p, w_branch_pool, w_branch_attn, w_out,
                        norm_ffn_g, w_query, sub_keys, peer_u, peer_v)
    u_s, q_s, k_s, v_s, lf_s, ga_s, gb_s = project_in(x_s, norm_mix_g, w_in, b_forget, q_norm_g, k_norm_g)
    pool_s, hist_s = pool_mixer(u_s, state_pool, PAST_LEN, pool_mix_w, pool_scale)
    attn_s = sample_attention(q_s, k_s, v_s, lf_s, cache_k, cache_v, cache_logf, page_table)
    y_s = merge_and_ffn(x_s, pool_s, attn_s, ga_s, gb_s, w_branch_pool, w_branch_attn, w_out,
                        norm_ffn_g, w_query, sub_keys, peer_u, peer_v)
    return y_p, y_s, k_p, v_p, lf_p, hist_p, k_s, v_s, lf_s, hist_s


def setup_inputs(seed: int = 0) -> dict:
    key = jax.random.key(seed)
    ks = jax.random.split(key, 24)
    nrm = jax.random.normal
    n_pages = PAST_LEN // PAGE_SIZE
    n_used = DEC_BATCH * n_pages
    n_phys = n_used + (n_used + 3) // 4
    page_table = jax.random.permutation(ks[0], n_phys)[:n_used].reshape(DEC_BATCH, n_pages).astype(jnp.int32)
    L = DEPTH
    return {
        'x_prompt': nrm(ks[1], (BATCH, SEQ, D_MODEL), jnp.float32),
        'x_sample': nrm(ks[2], (DEC_BATCH, DEC_SEQ, D_MODEL), jnp.float32),
        'cache_k': nrm(ks[3], (L, n_phys, PAGE_SIZE, N_HEADS, HEAD_DIM), jnp.float32),
        'cache_v': nrm(ks[4], (L, n_phys, PAGE_SIZE, N_HEADS, HEAD_DIM), jnp.float32),
        'cache_logf': jax.nn.log_sigmoid(3.0 + nrm(ks[5], (L, n_phys, PAGE_SIZE, N_HEADS), jnp.float32)),
        'state_pool': nrm(ks[6], (L, DEC_BATCH, POOL_HIST, D_POOL), jnp.float32),
        'page_table': page_table,
        'norm_mix_g': 1.0 + 0.02 * nrm(ks[7], (L, D_MODEL), jnp.float32),
        'w_in': nrm(ks[8], (L, D_MODEL, D_IN), jnp.float32) * D_MODEL ** -0.5,
        'b_forget': 3.0 + 0.5 * nrm(ks[9], (L, N_HEADS), jnp.float32),
        'q_norm_g': 1.0 + 0.02 * nrm(ks[10], (L, HEAD_DIM), jnp.float32),
        'k_norm_g': 1.0 + 0.02 * nrm(ks[11], (L, HEAD_DIM), jnp.float32),
        'pool_mix_w': nrm(ks[12], (L, POOL_GROUPS, POOL_GC, POOL_GC), jnp.float32) * POOL_GC ** -0.5,
        'pool_scale': 1.0 + 0.05 * nrm(ks[13], (L, D_POOL), jnp.float32),
        'w_branch_pool': nrm(ks[14], (L, D_POOL, D_MODEL), jnp.float32) * D_POOL ** -0.5,
        'w_branch_attn': nrm(ks[15], (L, D_ATTN, D_MODEL), jnp.float32) * D_ATTN ** -0.5,
        'w_out': nrm(ks[16], (L, D_MODEL, D_MODEL), jnp.float32) * D_MODEL ** -0.5,
        'norm_ffn_g': 1.0 + 0.02 * nrm(ks[17], (L, D_MODEL), jnp.float32),
        'w_query': nrm(ks[18], (L, D_MODEL, PEER_HEADS * D_KEY), jnp.float32) * D_MODEL ** -0.5,
        'sub_keys': nrm(ks[19], (L, PEER_HEADS, 2, N_KEYS, D_KEY_HALF), jnp.float32) * D_KEY_HALF ** -0.5,
        'peer_u': nrm(ks[20], (L, N_EXPERTS, D_MODEL), jnp.float32) * D_MODEL ** -0.5,
        'peer_v': nrm(ks[21], (L, N_EXPERTS, D_MODEL), jnp.float32) * (0.5 * PEER_HEADS ** -0.5),
    }


def reference(x_prompt, x_sample, cache_k, cache_v, cache_logf, state_pool, page_table, norm_mix_g, w_in,
              b_forget, q_norm_g, k_norm_g, pool_mix_w, pool_scale, w_branch_pool, w_branch_attn, w_out,
              norm_ffn_g, w_query, sub_keys, peer_u, peer_v):
    x_p, x_s = x_prompt, x_sample
    kp_l, vp_l, lfp_l, pp_l, ks_l, vs_l, lfs_l, ps_l = [], [], [], [], [], [], [], []
    for l in range(DEPTH):
        x_p, x_s, k_p, v_p, lf_p, h_p, k_s, v_s, lf_s, h_s = layer_step(
            x_p, x_s, cache_k[l], cache_v[l], cache_logf[l], state_pool[l], page_table,
            norm_mix_g[l], w_in[l], b_forget[l], q_norm_g[l], k_norm_g[l], pool_mix_w[l], pool_scale[l],
            w_branch_pool[l], w_branch_attn[l], w_out[l], norm_ffn_g[l], w_query[l], sub_keys[l],
            peer_u[l], peer_v[l])
        kp_l.append(k_p); vp_l.append(v_p); lfp_l.append(lf_p); pp_l.append(h_p)
        ks_l.append(k_s); vs_l.append(v_s); lfs_l.append(lf_s); ps_l.append(h_s)
    k_prompt = jnp.stack(kp_l); v_prompt = jnp.stack(vp_l)
    logf_prompt = jnp.stack(lfp_l); pool_prompt = jnp.stack(pp_l)
    k_sample = jnp.stack(ks_l); v_sample = jnp.stack(vs_l)
    logf_sample = jnp.stack(lfs_l); pool_sample = jnp.stack(ps_l)
    return (x_p, x_s, k_prompt, v_prompt, logf_prompt, pool_prompt, k_sample, v_sample, logf_sample, pool_sample)
```

```cpp
#include <hip/hip_runtime.h>
#include <cstdio>
#include <cstdint>
#include <cmath>
namespace pg8 {
#define PG8_LAS __attribute__((address_space(3)))
typedef unsigned short bf16_t;
typedef short bf16x8 __attribute__((ext_vector_type(8)));
typedef float f32x4 __attribute__((ext_vector_type(4)));
typedef unsigned u32x4 __attribute__((ext_vector_type(4)));
constexpr int BM = 256, BK = 64, HALF = 128, HTB = HALF * BK * 2  , STAGE_BYTES = 8 * HTB, NXCD = 8, WGM = 8;

__host__ __device__ __forceinline__ int lds_byte(int r, int c) { const int st = (r >> 4) * 2 + (c >> 5), rr = r & 15, cc = c & 31, ob = rr * 64 + cc * 2; return st * 1024 + (ob ^ (((ob >> 9) & 1) << 5)); }
__host__ __device__ __forceinline__ void stage_rc(int b, int& R, int& C) { const int st = b / 1024, sb = b % 1024, swz = sb ^ (((sb >> 9) & 1) << 5); R = (st >> 1) * 16 + swz / 64; C = (st & 1) * 32 + (swz % 64) / 2; }
__host__ __device__ __forceinline__ int perm32(int rho) { const int n = rho >> 4, i = rho & 15; return 8 * (i >> 2) + 4 * n + (i & 3); }

struct Unit { int pm, pn; };
struct Gemm { const bf16_t* A; const bf16_t* Bt; int M, N, K; };

struct StaticOrder {
    int nM, nN, nwg, G, c;
    __host__ __device__ void init(int M, int N, int G_, int c_) { nM = M / BM; nN = N / BM; nwg = nM * nN; G = G_; c = c_; }
    __host__ __device__ bool next(int i, Unit& u) const {
        const long L = (long)i * G + c; if (L >= nwg) return false;
        int wgid = (int)L; { const int q = nwg / NXCD, r = nwg % NXCD, xcd = wgid % NXCD, off = wgid / NXCD; wgid = (xcd < r ? xcd * (q + 1) : r * (q + 1) + (xcd - r) * q) + off; }
        const int nig = WGM * nN, gid = wgid / nig, fm = gid * WGM, gsz = (nM - fm) < WGM ? (nM - fm) : WGM;
        u.pm = fm + ((wgid % nig) % gsz); u.pn = (wgid % nig) / gsz; return true;
    }
    __device__ __forceinline__ void a_ready(const Unit&) const {}
    __device__ __forceinline__ void done(const Unit&) const {}
};

typedef float f32x2c __attribute__((ext_vector_type(2))); typedef __bf16 bf16x2c __attribute__((ext_vector_type(2)));
__device__ __forceinline__ unsigned cvt_pk_bf16(float lo, float hi) { f32x2c v = {lo, hi}; bf16x2c b = __builtin_convertvector(v, bf16x2c); return __builtin_bit_cast(unsigned, b); }
typedef float f32x2 __attribute__((ext_vector_type(2)));
__device__ __forceinline__ f32x2 gelu_pk(f32x2 v) {
    const f32x2 av = __builtin_elementwise_abs(v), d = av * 0.2316418882f + 1.0f;
    f32x2 t; t.x = __builtin_amdgcn_rcpf(d.x); t.y = __builtin_amdgcn_rcpf(d.y);
    f32x2 q = t * 0.5307027145f + (-0.7265760135f); q = q * t + 0.7107068705f; q = q * t + (-0.142248368f); q = q * t + 0.127414796f; q = q * t;
    const f32x2 s = (v * v) * (-0.72134752044f);
    f32x2 e; e.x = __builtin_amdgcn_exp2f(s.x); e.y = __builtin_amdgcn_exp2f(s.y);
    const f32x2 m = v * (q * e), r = v - m;
    f32x2 o; o.x = v.x < 0.f ? m.x : r.x; o.y = v.y < 0.f ? m.y : r.y; return o;
}

template <int ACT  > struct EpiBf16 {
    static constexpr bool PERM = true, AFTER_DRAIN = false; static_assert(ACT == 0 || ACT == 1, "EpiBf16: ACT is 0 (none) or 1 (gelu_pk)");
    bf16_t* O; int ldc; const float* bias; int split_cols; size_t split_stride; float scale0;
    __device__ __forceinline__ void operator()(const f32x4 (&acc)[2][2][4][2], const Unit& u, int wr, int wc, int fr, int fq) const {
        const int row0 = u.pm * BM + wr * 64 + fr; int colt = u.pn * BM; bf16_t* base = O;
        float sc = 1.f; if (split_cols) { const int t = colt / split_cols; base += (size_t)t * split_stride; colt -= t * split_cols; if (t == 0) sc = scale0; }
        const int col0 = colt + wc * 32 + 8 * fq, bcol0 = u.pn * BM + wc * 32 + 8 * fq;
        f32x4 bv[2][2];
#pragma unroll
        for (int bj = 0; bj < 2; ++bj)
#pragma unroll
            for (int n = 0; n < 2; ++n) bv[bj][n] = bias ? *(const f32x4*)(bias + bcol0 + bj * HALF + 4 * n) : (f32x4){0.f, 0.f, 0.f, 0.f};
#pragma unroll
        for (int ai = 0; ai < 2; ++ai)
#pragma unroll
            for (int m = 0; m < 4; ++m) { bf16_t* rowp = base + (size_t)(row0 + ai * HALF + m * 16) * ldc + col0;
#pragma unroll
                for (int bj = 0; bj < 2; ++bj) { f32x4 v0 = acc[ai][bj][m][0] + bv[bj][0], v1 = acc[ai][bj][m][1] + bv[bj][1];
                    if (ACT == 1) { f32x2 a = gelu_pk((f32x2){v0[0], v0[1]}), b = gelu_pk((f32x2){v0[2], v0[3]}), c = gelu_pk((f32x2){v1[0], v1[1]}), d = gelu_pk((f32x2){v1[2], v1[3]});
                        v0 = (f32x4){a.x, a.y, b.x, b.y}; v1 = (f32x4){c.x, c.y, d.x, d.y}; }
                    v0 = v0 * sc; v1 = v1 * sc; u32x4 w; w.x = cvt_pk_bf16(v0[0], v0[1]); w.y = cvt_pk_bf16(v0[2], v0[3]); w.z = cvt_pk_bf16(v1[0], v1[1]); w.w = cvt_pk_bf16(v1[2], v1[3]);
                    *(u32x4*)(rowp + bj * HALF) = w; } }
    }
};
template <class Epi, class Sched, bool ALIGN_EPI = false, bool SP2 = false>
__device__ __forceinline__ void gemm_phase(PG8_LAS unsigned char* lds, const Gemm g, const Sched& S, const Epi& E) {
    const int tid = threadIdx.x, wid = __builtin_amdgcn_readfirstlane(tid >> 6), lane = tid & 63, wr = wid >> 2, wc = wid & 3, fr = lane & 15, fq = lane >> 4;
    const int K = g.K, nt = K / BK;
    unsigned voffA[2], voffB[2];
#pragma unroll
    for (int i = 0; i < 2; ++i) { int R, C; stage_rc(tid * 16 + i * 8192, R, C); const int Rb = Epi::PERM ? ((R & ~31) + perm32(R & 31)) : R;
        voffA[i] = (unsigned)(R * K + C) * 2u; voffB[i] = (unsigned)(Rb * K + C) * 2u; }
    const size_t kstep = (size_t)(BK * 2);
    const size_t hstep = (size_t)HALF * K * 2;
    const size_t tstep = 2 * hstep;
    const unsigned ldsw = (unsigned)wid * 1024u;
    const int aoff = lds_byte(wr * 64 + fr, fq * 8), boff = lds_byte(wc * 32 + fr, fq * 8);
#define PG8_SA(b, h) (((b) * 2 + (h)) * HTB)
#define PG8_SB(b, h) ((4 + (b) * 2 + (h)) * HTB)
#define PG8_STAGE(bufoff, gbase, voff) do { _Pragma("unroll") for (int _i = 0; _i < 2; ++_i) \
        __builtin_amdgcn_global_load_lds((const unsigned*)((const char*)(gbase) + (voff)[_i]), (PG8_LAS unsigned*)(lds + (bufoff) + ldsw + _i * 8192), 16, 0, 0); } while (0)
#define PG8_LDA(dst, b, h) do { _Pragma("unroll") for (int m = 0; m < 4; ++m) _Pragma("unroll") for (int k = 0; k < 2; ++k) dst[m][k] = *(const PG8_LAS bf16x8*)(lds + PG8_SA(b, h) + aoff + m * 2048 + k * 1024); } while (0)
#define PG8_LDB(dst, b, h) do { _Pragma("unroll") for (int n = 0; n < 2; ++n) _Pragma("unroll") for (int k = 0; k < 2; ++k) dst[n][k] = *(const PG8_LAS bf16x8*)(lds + PG8_SB(b, h) + boff + n * 2048 + k * 1024); } while (0)
#define PG8_MMA(ai, bj, At, Bt) do { __builtin_amdgcn_s_setprio(1); _Pragma("unroll") for (int m = 0; m < 4; ++m) _Pragma("unroll") for (int n = 0; n < 2; ++n) _Pragma("unroll") for (int k = 0; k < 2; ++k) \
        acc[ai][bj][m][n] = __builtin_amdgcn_mfma_f32_16x16x32_bf16(Bt[n][k], At[m][k], acc[ai][bj][m][n], 0, 0, 0); __builtin_amdgcn_s_setprio(0); } while (0)
#define PG8_WAIT_V(n) asm volatile("s_waitcnt vmcnt(" #n ")" ::: "memory")
#define PG8_WAIT_L(n) asm volatile("s_waitcnt lgkmcnt(" #n ")" ::: "memory")
#define PG8_BAR __builtin_amdgcn_s_barrier()
#define PG8_SCHED __builtin_amdgcn_sched_barrier(0)
    Unit cur, nxt; int ui = 0;
    if (!S.next(0, cur)) return;
    f32x4 acc[2][2][4][2];
#pragma unroll
    for (int a = 0; a < 2; ++a)
#pragma unroll
        for (int b = 0; b < 2; ++b)
#pragma unroll
            for (int m = 0; m < 4; ++m)
#pragma unroll
                for (int n = 0; n < 2; ++n) acc[a][b][m][n] = (f32x4){0.f, 0.f, 0.f, 0.f};
    bf16x8 At[4][2], B0[2][2], B1[2][2];
    const char* cA = (const char*)g.A + (size_t)cur.pm * tstep; const char* cB = (const char*)g.Bt + (size_t)cur.pn * tstep;
    S.a_ready(cur);
    if constexpr (SP2) {
        PG8_STAGE(PG8_SB(0, 0), cB, voffB); PG8_STAGE(PG8_SB(0, 1), cB + hstep, voffB); PG8_STAGE(PG8_SA(0, 0), cA, voffA); PG8_STAGE(PG8_SA(0, 1), cA + hstep, voffA);
        if (wr == 1) PG8_BAR;
        PG8_WAIT_V(2); PG8_BAR;
        PG8_STAGE(PG8_SB(1, 0), cB + kstep, voffB); PG8_STAGE(PG8_SA(1, 0), cA + kstep, voffA); PG8_STAGE(PG8_SB(1, 1), cB + hstep + kstep, voffB);
        PG8_WAIT_V(6); PG8_BAR;
    } else {
        PG8_STAGE(PG8_SB(0, 0), cB, voffB); PG8_STAGE(PG8_SA(0, 0), cA, voffA); PG8_STAGE(PG8_SB(0, 1), cB + hstep, voffB); PG8_STAGE(PG8_SA(0, 1), cA + hstep, voffA);
        if (wr == 1) PG8_BAR;
        PG8_WAIT_V(4); PG8_BAR;
        PG8_STAGE(PG8_SB(1, 0), cB + kstep, voffB); PG8_STAGE(PG8_SA(1, 0), cA + kstep, voffA); PG8_STAGE(PG8_SB(1, 1), cB + hstep + kstep, voffB);
        PG8_WAIT_V(6); PG8_BAR;
    }
    for (;;) {
        const bool has_next = S.next(ui + 1, nxt);
        const char* nA = has_next ? (const char*)g.A + (size_t)nxt.pm * tstep : cA; const char* nB = has_next ? (const char*)g.Bt + (size_t)nxt.pn * tstep : cB;
        for (int t = 0; t < nt; t += 2) {
            const bool last = (t == nt - 2);
            const char* a1 = cA + (size_t)(t + 1) * kstep;
            const char* a2 = last ? nA : cA + (size_t)(t + 2) * kstep; const char* b2 = last ? nB : cB + (size_t)(t + 2) * kstep;
            const char* a3 = a2 + kstep; const char* b3 = b2 + kstep;
            if (last && has_next) S.a_ready(nxt);
            if constexpr (SP2) {
            PG8_LDB(B0, 0, 0); PG8_LDB(B1, 0, 1); PG8_SCHED; PG8_LDA(At, 0, 0); PG8_STAGE(PG8_SA(1, 1), a1 + hstep, voffA);
            PG8_WAIT_V(8); PG8_WAIT_L(0); PG8_BAR; PG8_MMA(0, 0, At, B0); PG8_MMA(0, 1, At, B1); PG8_BAR; PG8_SCHED;
            PG8_LDA(At, 0, 1); PG8_STAGE(PG8_SB(0, 0), b2, voffB); PG8_STAGE(PG8_SB(0, 1), b2 + hstep, voffB); PG8_STAGE(PG8_SA(0, 0), a2, voffA);
            PG8_WAIT_V(8); PG8_WAIT_L(0); PG8_BAR; PG8_MMA(1, 0, At, B0); PG8_MMA(1, 1, At, B1); PG8_BAR; PG8_SCHED;
            PG8_LDB(B0, 1, 0); PG8_LDB(B1, 1, 1); PG8_SCHED; PG8_LDA(At, 1, 0); PG8_STAGE(PG8_SA(0, 1), a2 + hstep, voffA);
            PG8_WAIT_V(8); PG8_WAIT_L(0); PG8_BAR; PG8_MMA(0, 0, At, B0); PG8_MMA(0, 1, At, B1); PG8_BAR; PG8_SCHED;
            PG8_LDA(At, 1, 1); PG8_STAGE(PG8_SB(1, 0), b3, voffB); PG8_STAGE(PG8_SB(1, 1), b3 + hstep, voffB); PG8_STAGE(PG8_SA(1, 0), a3, voffA);
            PG8_WAIT_V(8); PG8_WAIT_L(0); PG8_BAR; PG8_MMA(1, 0, At, B0); PG8_MMA(1, 1, At, B1); PG8_BAR; PG8_SCHED;
            } else {
            PG8_LDB(B0, 0, 0); PG8_SCHED; PG8_LDA(At, 0, 0); PG8_STAGE(PG8_SA(1, 1), a1 + hstep, voffA);
            PG8_WAIT_L(8); PG8_BAR; PG8_WAIT_L(0); PG8_MMA(0, 0, At, B0); PG8_BAR; PG8_SCHED;
            PG8_LDB(B1, 0, 1); PG8_STAGE(PG8_SB(0, 0), b2, voffB);
            PG8_BAR; PG8_WAIT_L(0); PG8_MMA(0, 1, At, B1); PG8_BAR;
            PG8_LDA(At, 0, 1); PG8_STAGE(PG8_SA(0, 0), a2, voffA);
            PG8_BAR; PG8_WAIT_L(0); PG8_MMA(1, 0, At, B0); PG8_BAR; PG8_SCHED;
            PG8_STAGE(PG8_SB(0, 1), b2 + hstep, voffB);
            PG8_WAIT_V(6); PG8_BAR; PG8_MMA(1, 1, At, B1); PG8_BAR;
            PG8_LDB(B0, 1, 0); PG8_SCHED; PG8_LDA(At, 1, 0); PG8_STAGE(PG8_SA(0, 1), a2 + hstep, voffA);
            PG8_WAIT_L(8); PG8_BAR; PG8_WAIT_L(0); PG8_MMA(0, 0, At, B0); PG8_BAR; PG8_SCHED;
            PG8_LDB(B1, 1, 1); PG8_STAGE(PG8_SB(1, 0), b3, voffB);
            PG8_BAR; PG8_WAIT_L(0); PG8_MMA(0, 1, At, B1); PG8_BAR;
            PG8_LDA(At, 1, 1); PG8_STAGE(PG8_SA(1, 0), a3, voffA);
            PG8_BAR; PG8_WAIT_L(0); PG8_MMA(1, 0, At, B0); PG8_BAR; PG8_SCHED;
            PG8_STAGE(PG8_SB(1, 1), b3 + hstep, voffB);
            PG8_WAIT_V(6); PG8_BAR; PG8_MMA(1, 1, At, B1); PG8_BAR;
            }
        }
        if constexpr (ALIGN_EPI) { if (wr == 0) PG8_BAR; }
        if constexpr (!Epi::AFTER_DRAIN) { E(acc, cur, wr, wc, fr, fq); S.done(cur); }
        if (!has_next) break;
#pragma unroll
        for (int a = 0; a < 2; ++a)
#pragma unroll
            for (int b = 0; b < 2; ++b)
#pragma unroll
                for (int m = 0; m < 4; ++m)
#pragma unroll
                    for (int n = 0; n < 2; ++n) acc[a][b][m][n] = (f32x4){0.f, 0.f, 0.f, 0.f};
        cur = nxt; cA = nA; cB = nB; ++ui;
        if constexpr (ALIGN_EPI) { if (wr == 1) PG8_BAR; }
    }
    PG8_WAIT_V(0);
    if constexpr (!ALIGN_EPI) { if (wr == 0) PG8_BAR; }
    PG8_BAR;
    if constexpr (Epi::AFTER_DRAIN) { E.fused(acc, cur, wr, wc, fr, fq, lds, wid, lane); S.done(cur); }
#undef PG8_SA
#undef PG8_SB
#undef PG8_STAGE
#undef PG8_LDA
#undef PG8_LDB
#undef PG8_MMA
#undef PG8_WAIT_V
#undef PG8_WAIT_L
#undef PG8_BAR
#undef PG8_SCHED
}
}
#define GAS __attribute__((address_space(1)))
#define LAS __attribute__((address_space(3)))
typedef unsigned short bf16;
typedef unsigned v4u __attribute__((ext_vector_type(4)));
typedef float f32x4 __attribute__((ext_vector_type(4)));
typedef short bf16x8 __attribute__((ext_vector_type(8)));
typedef GAS unsigned gu32;
typedef GAS unsigned long long gu64;
#define RLX_AGENT __ATOMIC_RELAXED, __HIP_MEMORY_SCOPE_AGENT
#define LDS_WAIT() asm volatile("s_waitcnt lgkmcnt(0)" ::: "memory")
#define VM_WAIT() asm volatile("s_waitcnt vmcnt(0)" ::: "memory")
__device__ __forceinline__ unsigned long long rt() { return __builtin_amdgcn_s_memrealtime(); }
__device__ __forceinline__ unsigned f2bf(float f) { unsigned u = __builtin_bit_cast(unsigned, f); return (u + 0x7fffu + ((u >> 16) & 1u)) >> 16; }
__device__ __forceinline__ unsigned pk2(float lo, float hi) { return f2bf(lo) | (f2bf(hi) << 16); }

#define XB_TMO      128
#define XB_XCNT(j)  (256  + 64 * (j))
#define XB_XSUB(j)  (1280 + 64 * (j))
#define XB_XGEN(j)  (2304 + 64 * (j))
#define XB_TOP      3328
#define XB_TOPGEN   3392
#define XCD_BAR_WORDS 3456
#define XB_SPIN_CAP (1u << 18)

__device__ __forceinline__ unsigned xb_ld(unsigned* p)              { return __hip_atomic_load(p, __ATOMIC_RELAXED, __HIP_MEMORY_SCOPE_AGENT); }
__device__ __forceinline__ unsigned xb_add(unsigned* p, unsigned v) { return __hip_atomic_fetch_add(p, v, __ATOMIC_RELAXED, __HIP_MEMORY_SCOPE_AGENT); }
__device__ __forceinline__ unsigned xb_xcc_id() { return (unsigned)__builtin_amdgcn_s_getreg((3 << 11) | 20) & 0xFu; }
#define XB_SPIN(cond, bar) do { unsigned _sp = 0; while (cond) { __builtin_amdgcn_s_sleep(1); \
    if ((++_sp & 255u) == 0u) { if (xb_ld(&(bar)[XB_TMO])) break; if (_sp > XB_SPIN_CAP) { atomicAdd(&(bar)[XB_TMO], 1u); break; } } } } while (0)

struct XcdBarrier {
    unsigned* bar; unsigned x;
    volatile LAS unsigned* st;
};

__device__ __forceinline__ XcdBarrier xcd_barrier_post(unsigned* bar, volatile LAS unsigned* st) {
    XcdBarrier b; b.bar = bar; b.x = xb_xcc_id(); b.st = st;
    if (threadIdx.x == 0) (void)xb_add(&bar[XB_XCNT(b.x)], 1u);
    return b;
}
__device__ __forceinline__ void xcd_barrier_complete(unsigned* bar, unsigned x, unsigned& nloc, unsigned& nx) {
    const unsigned G = gridDim.x * gridDim.y * gridDim.z;
    unsigned sum, cnt, mine, sp = 0u;
    for (;;) {
        sum = 0u; cnt = 0u; mine = 0u;
#pragma unroll
        for (unsigned j = 0; j < 16; ++j) { const unsigned c = xb_ld(&bar[XB_XCNT(j)]); sum += c; cnt += (c > 0u) ? 1u : 0u; mine = (j == x) ? c : mine; }
        if (sum == G) break;
        __builtin_amdgcn_s_sleep(1);
        if ((++sp & 255u) == 0u) { if (xb_ld(&bar[XB_TMO])) break; if (sp > XB_SPIN_CAP) { atomicAdd(&bar[XB_TMO], 1u); break; } }
    }
    nloc = mine > 0u ? mine : 1u; nx = cnt > 0u ? cnt : 1u;
}

__device__ __forceinline__ void xcd_barrier(const XcdBarrier& b) {
    asm volatile("s_waitcnt vmcnt(0)" ::: "memory");
    __syncthreads();
    if (threadIdx.x == 0) {
        unsigned* bar = b.bar;
        __builtin_amdgcn_s_waitcnt(0);
        unsigned nloc = b.st[0], nx = b.st[1];
        if (nloc == 0u) { xcd_barrier_complete(bar, b.x, nloc, nx); b.st[0] = nloc; b.st[1] = nx; }
        const unsigned old = xb_add(&bar[XB_XSUB(b.x)], 1u);
        const unsigned gen = old / nloc;
        if (old + 1u == (gen + 1u) * nloc) {
            __builtin_amdgcn_fence(__ATOMIC_RELEASE, "agent");
            asm volatile("s_waitcnt vmcnt(0)" ::: "memory");
            const unsigned og = xb_add(&bar[XB_TOP], 1u);
            const unsigned tg = og / nx;
            if (og + 1u == (tg + 1u) * nx) xb_add(&bar[XB_TOPGEN], 1u);
            else XB_SPIN(xb_ld(&bar[XB_TOPGEN]) == tg, bar);
            __builtin_amdgcn_fence(__ATOMIC_ACQUIRE, "agent");
            xb_add(&bar[XB_XGEN(b.x)], 1u);
            asm volatile("s_waitcnt vmcnt(0)" ::: "memory");
        } else {
            XB_SPIN(xb_ld(&bar[XB_XGEN(b.x)]) == gen, bar);
            __builtin_amdgcn_fence(__ATOMIC_ACQUIRE, "agent");
            asm volatile("s_waitcnt vmcnt(0)" ::: "memory");
        }
    }
    __syncthreads();
}

constexpr int NWAVES = 8, NTHR = 512;
constexpr int DM = 1024, NB = 4, SEQ = 4096, DB = 128, DSEQ = 8, PAST = 2048, PAGE = 128, NPAGES = 16;
constexpr int MP = NB * SEQ, MS = DB * DSEQ, M = MP + MS;
constexpr int DP = 512, DA = 512, NH = 8, HD = 64, DIN = 4104, NPROJ = 4096;
constexpr int NKEYS = 128, NEXP = 16384, PH = 8, TOPK = 16, DKH = 128, DQ = 2048;
constexpr float EPS = 1e-6f;
constexpr float LOG2E = 1.4426950408889634f;
constexpr float C2 = 0.125f * LOG2E;
constexpr size_t O_YP = 0, O_YS = O_YP + (size_t)MP * DM, O_KP = O_YS + (size_t)MS * DM, O_VP = O_KP + (size_t)MP * DA, O_LFP = O_VP + (size_t)MP * DA,
                 O_PP = O_LFP + (size_t)MP * NH, O_KS = O_PP + (size_t)NB * 15 * DP, O_VS = O_KS + (size_t)MS * DA, O_LFS = O_VS + (size_t)MS * DA,
                 O_PS = O_LFS + (size_t)MS * NH, O_END = O_PS + (size_t)DB * 15 * DP;
constexpr size_t MiB = 1u << 20;
constexpr size_t WS_CTL = 0, CTL_ZERO_BYTES = 1 * MiB;
constexpr size_t WS_WIN = 2 * MiB, WS_WBP = 10 * MiB, WS_WBA = 11 * MiB, WS_WOUT = 12 * MiB, WS_WQ = 14 * MiB, WS_SUBK = 18 * MiB, WS_CP2 = 19 * MiB, WS_RSS = 20 * MiB;
constexpr size_t WS_PU = 32 * MiB, WS_PV = 64 * MiB, WS_XN = 96 * MiB  , WS_U = 132 * MiB, WS_Q = 150 * MiB, WS_K = 168 * MiB, WS_V = 186 * MiB,
                 WS_GA = 204 * MiB, WS_GB = 240 * MiB, WS_PO = 276 * MiB, WS_AO = 294 * MiB, WS_T = 312 * MiB, WS_MIX = 348 * MiB, WS_PQ = 384 * MiB,
                 WS_SI = 456 * MiB, WS_SG = 466 * MiB, WS_END = 476 * MiB;
constexpr int CW_BAR = 4096;
constexpr int LDS_BYTES = 163840;
constexpr int SCR_BYTES = 159 * 1024;
constexpr int MISC_OFF = SCR_BYTES;

typedef unsigned short bf16;
typedef unsigned v4u __attribute__((ext_vector_type(4)));
typedef unsigned v2u __attribute__((ext_vector_type(2)));
typedef float f32x4 __attribute__((ext_vector_type(4)));
typedef float f32x2 __attribute__((ext_vector_type(2)));

__device__ __forceinline__ float bf2f(unsigned short b) { return __uint_as_float((unsigned)b << 16); }
__device__ __forceinline__ float bflo(unsigned w) { return __uint_as_float(w << 16); }
__device__ __forceinline__ float bfhi(unsigned w) { return __uint_as_float(w & 0xffff0000u); }
typedef __bf16 bf16x2_t __attribute__((ext_vector_type(2)));
__device__ __forceinline__ unsigned pkbf(float lo, float hi) { f32x2 v = {lo, hi}; bf16x2_t b = __builtin_convertvector(v, bf16x2_t); return __builtin_bit_cast(unsigned, b); }
__device__ __forceinline__ float wave_sum(float v) {
#pragma unroll
    for (int o = 1; o < 64; o <<= 1) v += __shfl_xor(v, o);
    return v;
}
__device__ __forceinline__ float wave_max(float v) {
#pragma unroll
    for (int o = 1; o < 64; o <<= 1) v = fmaxf(v, __shfl_xor(v, o));
    return v;
}

struct Args {
    const float* x_p; const float* x_s; const float* cache_k; const float* cache_v; const float* cache_lf; const float* state_pool; const int* page_table;
    const float* norm_mix_g; const float* w_in; const float* b_forget; const float* q_norm_g; const float* k_norm_g; const float* pool_mix_w; const float* pool_scale;
    const float* w_bp; const float* w_ba; const float* w_out; const float* norm_ffn_g; const float* w_query; const float* sub_keys; const float* peer_u; const float* peer_v;
    float* out; unsigned char* ws; int ph_lo, ph_hi, li, pad;
};

using pg8::Unit;
struct EpiInProj {
    static constexpr bool PERM = true, AFTER_DRAIN = false;
    bf16 *U, *Q, *K, *V, *GA, *GB; float* out; const float *gq, *gk;
    __device__ __forceinline__ void operator()(const f32x4 (&acc)[2][2][4][2], const Unit& u, int wr, int wc, int fr, int fq) const {
        const int pn = u.pn; const int row0 = u.pm * 256 + wr * 64 + fr; const bool prompt = u.pm < (MP / 256);
        if (pn < 2) {
#pragma unroll
            for (int ai = 0; ai < 2; ++ai)
#pragma unroll
                for (int m = 0; m < 4; ++m) { const int row = row0 + ai * 128 + m * 16;
                    float* tail = nullptr;
                    if (prompt) { const int s = row & (SEQ - 1), b = row >> 12; if (s >= SEQ - 15) tail = out + O_PP + (size_t)(b * 15 + (s - (SEQ - 15))) * DP; }
                    else { const int rs = row - MP; tail = out + O_PS + (size_t)((rs >> 3) * 15 + 7 + (rs & 7)) * DP; }
#pragma unroll
                    for (int bj = 0; bj < 2; ++bj) { const int col = pn * 256 + bj * 128 + wc * 32 + 8 * fq; const f32x4 v0 = acc[ai][bj][m][0], v1 = acc[ai][bj][m][1];
                        v4u w; w.x = pkbf(v0[0], v0[1]); w.y = pkbf(v0[2], v0[3]); w.z = pkbf(v1[0], v1[1]); w.w = pkbf(v1[2], v1[3]);
                        *(v4u*)(U + (size_t)row * DP + col) = w;
                        if (tail) { *(f32x4*)(tail + col) = v0; *(f32x4*)(tail + col + 4) = v1; } } }
        } else if (pn < 6) {
            const bool isq = pn < 4; const int head = 4 * (pn & 1) + wc; const float* g = isq ? gq : gk;
            f32x4 gv[2][2];
#pragma unroll
            for (int bj = 0; bj < 2; ++bj)
#pragma unroll
                for (int n = 0; n < 2; ++n) gv[bj][n] = *(const f32x4*)(g + 32 * bj + 8 * fq + 4 * n);
            bf16* dst = isq ? Q : K;
#pragma unroll
            for (int ai = 0; ai < 2; ++ai)
#pragma unroll
                for (int m = 0; m < 4; ++m) { const int row = row0 + ai * 128 + m * 16; float ss = 0.f;
#pragma unroll
                    for (int bj = 0; bj < 2; ++bj)
#pragma unroll
                        for (int n = 0; n < 2; ++n) { const f32x4 x = acc[ai][bj][m][n]; ss += (x[0] * x[0] + x[1] * x[1]) + (x[2] * x[2] + x[3] * x[3]); }
                    ss += __shfl_xor(ss, 16); ss += __shfl_xor(ss, 32);
                    float r = 1.0f / sqrtf(ss * (1.0f / 64.0f) + EPS);
                    float* kout = isq ? nullptr : (prompt ? out + O_KP + (size_t)row * DA : out + O_KS + (size_t)(row - MP) * DA);
                    const float rq = isq ? r * C2 : r;
#pragma unroll
                    for (int bj = 0; bj < 2; ++bj) { const int col = head * 64 + 32 * bj + 8 * fq; const f32x4 v0 = acc[ai][bj][m][0] * gv[bj][0] * rq, v1 = acc[ai][bj][m][1] * gv[bj][1] * rq;
                        v4u w; w.x = pkbf(v0[0], v0[1]); w.y = pkbf(v0[2], v0[3]); w.z = pkbf(v1[0], v1[1]); w.w = pkbf(v1[2], v1[3]);
                        *(v4u*)(dst + (size_t)row * DA + col) = w;
                        if (!isq) { *(f32x4*)(kout + col) = v0; *(f32x4*)(kout + col + 4) = v1; } } }
        } else if (pn < 8) {
#pragma unroll
            for (int ai = 0; ai < 2; ++ai)
#pragma unroll
                for (int m = 0; m < 4; ++m) { const int row = row0 + ai * 128 + m * 16;
                    float* vout = prompt ? out + O_VP + (size_t)row * DA : out + O_VS + (size_t)(row - MP) * DA;
#pragma unroll
                    for (int bj = 0; bj < 2; ++bj) { const int col = (pn - 6) * 256 + bj * 128 + wc * 32 + 8 * fq; const f32x4 v0 = acc[ai][bj][m][0], v1 = acc[ai][bj][m][1];
                        v4u w; w.x = pkbf(v0[0], v0[1]); w.y = pkbf(v0[2], v0[3]); w.z = pkbf(v1[0], v1[1]); w.w = pkbf(v1[2], v1[3]);
                        *(v4u*)(V + (size_t)row * DA + col) = w; *(f32x4*)(vout + col) = v0; *(f32x4*)(vout + col + 4) = v1; } }
        } else {
            bf16* dst = pn < 12 ? GA : GB; const int ct = (pn < 12 ? pn - 8 : pn - 12) * 256;
#pragma unroll
            for (int ai = 0; ai < 2; ++ai)
#pragma unroll
                for (int m = 0; m < 4; ++m) { const int row = row0 + ai * 128 + m * 16;
#pragma unroll
                    for (int bj = 0; bj < 2; ++bj) { const int col = ct + bj * 128 + wc * 32 + 8 * fq; float s[8];
#pragma unroll
                        for (int n = 0; n < 2; ++n)
#pragma unroll
                            for (int i = 0; i < 4; ++i) s[4 * n + i] = __builtin_amdgcn_rcpf(1.0f + __builtin_amdgcn_exp2f(-LOG2E * acc[ai][bj][m][n][i]));
                        v4u w; w.x = pkbf(s[0], s[1]); w.y = pkbf(s[2], s[3]); w.z = pkbf(s[4], s[5]); w.w = pkbf(s[6], s[7]);
                        *(v4u*)(dst + (size_t)row * DM + col) = w; } }
        }
    }
};
template <int MODE> struct EpiGate {
    static constexpr bool PERM = true, AFTER_DRAIN = false;
    const bf16* G; const bf16* Tin; bf16* O;
    __device__ __forceinline__ void operator()(const f32x4 (&acc)[2][2][4][2], const Unit& u, int wr, int wc, int fr, int fq) const {
        const int row0 = u.pm * 256 + wr * 64 + fr;
#pragma unroll
        for (int ai = 0; ai < 2; ++ai)
#pragma unroll
            for (int m = 0; m < 4; ++m) { const int row = row0 + ai * 128 + m * 16;
#pragma unroll
                for (int bj = 0; bj < 2; ++bj) { const size_t off = (size_t)row * DM + u.pn * 256 + bj * 128 + wc * 32 + 8 * fq;
                    const v4u g = *(const v4u*)(G + off); const f32x4 v0 = acc[ai][bj][m][0], v1 = acc[ai][bj][m][1];
                    float r[8] = {v0[0] * bflo(g.x), v0[1] * bfhi(g.x), v0[2] * bflo(g.y), v0[3] * bfhi(g.y), v1[0] * bflo(g.z), v1[1] * bfhi(g.z), v1[2] * bflo(g.w), v1[3] * bfhi(g.w)};
                    if (MODE == 1) { const v4u t = *(const v4u*)(Tin + off);
                        r[0] += bflo(t.x); r[1] += bfhi(t.x); r[2] += bflo(t.y); r[3] += bfhi(t.y); r[4] += bflo(t.z); r[5] += bfhi(t.z); r[6] += bflo(t.w); r[7] += bfhi(t.w); }
                    v4u w; w.x = pkbf(r[0], r[1]); w.y = pkbf(r[2], r[3]); w.z = pkbf(r[4], r[5]); w.w = pkbf(r[6], r[7]);
                    *(v4u*)(O + off) = w; } }
    }
};
struct EpiOut {
    static constexpr bool PERM = true, AFTER_DRAIN = false;
    const float* xp; const float* xs; float* H; bf16* HG; const float* gf; float* RSS;
    __device__ __forceinline__ void operator()(const f32x4 (&acc)[2][2][4][2], const Unit& u, int wr, int wc, int fr, int fq) const {
        const int row0 = u.pm * 256 + wr * 64 + fr; const bool prompt = u.pm < (MP / 256);
        f32x4 gv[2][2];
#pragma unroll
        for (int bj = 0; bj < 2; ++bj)
#pragma unroll
            for (int n = 0; n < 2; ++n) gv[bj][n] = *(const f32x4*)(gf + u.pn * 256 + bj * 128 + wc * 32 + 8 * fq + 4 * n);
#pragma unroll
        for (int ai = 0; ai < 2; ++ai)
#pragma unroll
            for (int m = 0; m < 4; ++m) { const int row = row0 + ai * 128 + m * 16; float ss = 0.f;
                const float* xr = prompt ? xp + (size_t)row * DM : xs + (size_t)(row - MP) * DM;
#pragma unroll
                for (int bj = 0; bj < 2; ++bj) { const int col = u.pn * 256 + bj * 128 + wc * 32 + 8 * fq;
                    const f32x4 h0 = acc[ai][bj][m][0] + *(const f32x4*)(xr + col), h1 = acc[ai][bj][m][1] + *(const f32x4*)(xr + col + 4);
                    ss += (h0[0] * h0[0] + h0[1] * h0[1]) + (h0[2] * h0[2] + h0[3] * h0[3]) + (h1[0] * h1[0] + h1[1] * h1[1]) + (h1[2] * h1[2] + h1[3] * h1[3]);
                    *(f32x4*)(H + (size_t)row * DM + col) = h0; *(f32x4*)(H + (size_t)row * DM + col + 4) = h1;
                    const f32x4 a0 = h0 * gv[bj][0], a1 = h1 * gv[bj][1];
                    v4u w; w.x = pkbf(a0[0], a0[1]); w.y = pkbf(a0[2], a0[3]); w.z = pkbf(a1[0], a1[1]); w.w = pkbf(a1[2], a1[3]);
                    *(v4u*)(HG + (size_t)row * DM + col) = w; }
                ss += __shfl_xor(ss, 16); ss += __shfl_xor(ss, 32);
                if (fq == 0) RSS[(size_t)row * 16 + u.pn * 4 + wc] = ss; }
    }
};

struct Frame {
    LAS unsigned char* lds; volatile LAS unsigned* MISC; gu32* ctl;
    int tid, lane, wave, vcu, G;
};

__device__ __forceinline__ void transpose_item(const float* W, int ldw, int K, bf16* WT, int src_col0, int dst_row0, int k0, LAS float* scr, int lane) {
#pragma unroll 8
    for (int i = 0; i < 32; ++i) { const int kk = 2 * i + (lane >> 5); scr[kk * 33 + (lane & 31)] = W[(size_t)(k0 + kk) * ldw + src_col0 + (lane & 31)]; }
    LDS_WAIT(); asm volatile("" ::: "memory");
    const int c = lane & 7;
#pragma unroll
    for (int j = 0; j < 4; ++j) { const int n = (lane >> 3) + 8 * j; const LAS float* s = scr + (8 * c) * 33 + n;
        v4u o; o.x = pkbf(s[0 * 33], s[1 * 33]); o.y = pkbf(s[2 * 33], s[3 * 33]); o.z = pkbf(s[4 * 33], s[5 * 33]); o.w = pkbf(s[6 * 33], s[7 * 33]);
        *(v4u*)(WT + (size_t)(dst_row0 + n) * K + k0 + 8 * c) = o; }
    LDS_WAIT(); asm volatile("" ::: "memory");
}
__device__ __forceinline__ int win_src_col(int db) {
    if (db < 16) return 32 * db;
    if (db < 48) { const int base = db < 32 ? 512 : 1024; const int local = (db - 16) & 15, tile = local >> 3, blk = local & 7, bj = blk >> 2, w = blk & 3; return base + tile * 256 + 64 * w + 32 * bj; }
    if (db < 64) return 1536 + 32 * (db - 48);
    if (db < 96) return 2056 + 32 * (db - 64);
    return 3080 + 32 * (db - 96);
}
__device__ __forceinline__ void cvt_rows_bf16(const float* src, bf16* dst, size_t n8, size_t gtid, size_t gn) {
    for (size_t i = gtid; i < n8; i += gn) { const f32x4 a = *(const f32x4*)(src + 8 * i), b = *(const f32x4*)(src + 8 * i + 4);
        v4u w; w.x = pkbf(a[0], a[1]); w.y = pkbf(a[2], a[3]); w.z = pkbf(b[0], b[1]); w.w = pkbf(b[2], b[3]); *(v4u*)(dst + 8 * i) = w; }
}
__device__ __forceinline__ void p0_prologue(Frame& F, const Args& a) {
    unsigned char* ws = a.ws;
    LAS float* scr = (LAS float*)(F.lds + F.wave * 16384);
    const int gw = F.vcu * NWAVES + F.wave, NGW = F.G * NWAVES;
    for (int it = gw; it < 4096; it += NGW) {
        int r = it;
        if (r < 2048) { const int kb = r >> 7, db = r & 127; transpose_item(a.w_in, DIN, DM, (bf16*)(ws + WS_WIN), win_src_col(db), 32 * db, 64 * kb, scr, F.lane); continue; } r -= 2048;
        if (r < 256) { const int kb = r >> 5, nb = r & 31; transpose_item(a.w_bp, DM, DP, (bf16*)(ws + WS_WBP), 32 * nb, 32 * nb, 64 * kb, scr, F.lane); continue; } r -= 256;
        if (r < 256) { const int kb = r >> 5, nb = r & 31; transpose_item(a.w_ba, DM, DA, (bf16*)(ws + WS_WBA), 32 * nb, 32 * nb, 64 * kb, scr, F.lane); continue; } r -= 256;
        if (r < 512) { const int kb = r >> 5, nb = r & 31; transpose_item(a.w_out, DM, DM, (bf16*)(ws + WS_WOUT), 32 * nb, 32 * nb, 64 * kb, scr, F.lane); continue; } r -= 512;
        { const int kb = r >> 6, nb = r & 63; transpose_item(a.w_query, DQ, DM, (bf16*)(ws + WS_WQ), 32 * nb, 32 * nb, 64 * kb, scr, F.lane); }
    }
    { const size_t gtid = (size_t)F.vcu * NTHR + F.tid, gn = (size_t)F.G * NTHR;
      cvt_rows_bf16(a.peer_u, (bf16*)(ws + WS_PU), (size_t)NEXP * DM / 8, gtid, gn);
      cvt_rows_bf16(a.peer_v, (bf16*)(ws + WS_PV), (size_t)NEXP * DM / 8, gtid, gn);
      cvt_rows_bf16(a.sub_keys, (bf16*)(ws + WS_SUBK), (size_t)PH * 2 * NKEYS * DKH / 8, gtid, gn);
      for (size_t i = gtid; i < (size_t)DB * 7 * DP; i += gn) { const int b = (int)(i / (7 * DP)), j = (int)((i / DP) % 7), c = (int)(i % DP);
          a.out[O_PS + (size_t)(b * 15 + j) * DP + c] = a.state_pool[(size_t)(b * 15 + 8 + j) * DP + c]; } }
    __syncthreads();
    LAS float* wfT = (LAS float*)F.lds;
    for (int i = F.tid; i < 8 * DM; i += NTHR) { const int col = i >> 3, h = i & 7; wfT[h * DM + col] = a.w_in[(size_t)col * DIN + 2048 + h]; }
    __syncthreads();
    bf16* XN = (bf16*)(ws + WS_XN);
    for (int row = gw; row < M; row += NGW) {
        const float* xr = row < MP ? a.x_p + (size_t)row * DM : a.x_s + (size_t)(row - MP) * DM;
        f32x4 v[4]; float ss = 0.f;
#pragma unroll
        for (int j = 0; j < 4; ++j) { v[j] = *(const f32x4*)(xr + 256 * j + 4 * F.lane); ss += (v[j][0] * v[j][0] + v[j][1] * v[j][1]) + (v[j][2] * v[j][2] + v[j][3] * v[j][3]); }
        const float r = 1.0f / sqrtf(wave_sum(ss) * (1.0f / DM) + EPS);
        float f[8];
#pragma unroll
        for (int h = 0; h < 8; ++h) f[h] = 0.f;
#pragma unroll
        for (int j = 0; j < 4; ++j) { const f32x4 g = *(const f32x4*)(a.norm_mix_g + 256 * j + 4 * F.lane); v[j] = v[j] * r * g;
            v2u w; w.x = pkbf(v[j][0], v[j][1]); w.y = pkbf(v[j][2], v[j][3]); *(v2u*)(XN + (size_t)row * DM + 256 * j + 4 * F.lane) = w;
#pragma unroll
            for (int h = 0; h < 8; ++h) { const f32x4 wv = *(const LAS f32x4*)(wfT + h * DM + 256 * j + 4 * F.lane); f[h] += (v[j][0] * wv[0] + v[j][1] * wv[1]) + (v[j][2] * wv[2] + v[j][3] * wv[3]); } }
        float mine = 0.f;
#pragma unroll
        for (int h = 0; h < 8; ++h) { const float s = wave_sum(f[h]); if (F.lane == h) mine = s; }
        if (F.lane < 8) { const float z = mine + a.b_forget[F.lane]; const float lf = fminf(z, 0.f) - log1pf(expf(-fabsf(z)));
            if (row < MP) a.out[O_LFP + (size_t)row * NH + F.lane] = lf; else a.out[O_LFS + (size_t)(row - MP) * NH + F.lane] = lf; }
    }
}

__device__ __forceinline__ void p2_cumsum_pool(Frame& F, const Args& a) {
    unsigned char* ws = a.ws;
    { const int gw = F.vcu * NWAVES + F.wave; float* CP2 = (float*)(ws + WS_CP2);
      if (gw < NB * NH) { const int b = gw >> 3, h = gw & 7; float carry = 0.f;
          for (int c = 0; c < SEQ / 64; ++c) { float v = a.out[O_LFP + (size_t)(b * SEQ + c * 64 + F.lane) * NH + h];
#pragma unroll
              for (int o = 1; o < 64; o <<= 1) { const float t = __shfl_up(v, o); if (F.lane >= o) v += t; }
              v += carry; CP2[(size_t)gw * SEQ + c * 64 + F.lane] = v * LOG2E; carry = __shfl(v, 63); } } }
    const bf16* U = (const bf16*)(ws + WS_U); bf16* PO = (bf16*)(ws + WS_PO);
    LAS float* pw = (LAS float*)F.lds;
    LAS float* mt = (LAS float*)(F.lds + 65536);
    int cur_g = -1;
    for (int unit = blockIdx.x; unit < 4 * (M / 32); unit += F.G) {
        const int g = unit / (M / 32), tile = unit % (M / 32);
        __syncthreads();
        if (g != cur_g) { for (int i = F.tid; i < 128 * 128 / 4; i += NTHR) *(LAS f32x4*)(pw + 4 * i) = *(const f32x4*)(a.pool_mix_w + (size_t)g * 16384 + 4 * i); cur_g = g; }
        { const int r = F.tid >> 4, c8 = (F.tid & 15) * 8, ch = g * 128 + c8, row = tile * 32 + r, w = 2 << g;
          float sum[8], self[8];
#pragma unroll
          for (int i = 0; i < 8; ++i) sum[i] = 0.f;
          float cnt;
          if (row < MP) { const int s = row & (SEQ - 1); cnt = (float)(s + 1 < w ? s + 1 : w);
              for (int i = 0; i < w; ++i) if (s - i >= 0) { const v4u q = *(const v4u*)(U + (size_t)(row - i) * DP + ch);
                  const float e[8] = {bflo(q.x), bfhi(q.x), bflo(q.y), bfhi(q.y), bflo(q.z), bfhi(q.z), bflo(q.w), bfhi(q.w)};
#pragma unroll
                  for (int k = 0; k < 8; ++k) { sum[k] += e[k]; if (i == 0) self[k] = e[k]; } }
          } else { const int rs = row - MP, b = rs >> 3, t = rs & 7; cnt = (float)w;
              for (int i = 0; i < w; ++i) { const int tt = t - i; float e[8];
                  if (tt >= 0) { const v4u q = *(const v4u*)(U + (size_t)(MP + b * 8 + tt) * DP + ch);
                      e[0] = bflo(q.x); e[1] = bfhi(q.x); e[2] = bflo(q.y); e[3] = bfhi(q.y); e[4] = bflo(q.z); e[5] = bfhi(q.z); e[6] = bflo(q.w); e[7] = bfhi(q.w); }
                  else { const f32x4 p0 = *(const f32x4*)(a.state_pool + (size_t)(b * 15 + 15 + tt) * DP + ch), p1 = *(const f32x4*)(a.state_pool + (size_t)(b * 15 + 15 + tt) * DP + ch + 4);
                      e[0] = p0[0]; e[1] = p0[1]; e[2] = p0[2]; e[3] = p0[3]; e[4] = p1[0]; e[5] = p1[1]; e[6] = p1[2]; e[7] = p1[3]; }
#pragma unroll
                  for (int k = 0; k < 8; ++k) { sum[k] += e[k]; if (i == 0) self[k] = e[k]; } } }
          const float inv = 1.0f / cnt;
#pragma unroll
          for (int k = 0; k < 8; ++k) mt[r * 132 + c8 + k] = sum[k] * inv - self[k]; }
        __syncthreads();
        { const int r = F.tid >> 4, d8 = (F.tid & 15) * 8, row = tile * 32 + r; float acc[8];
#pragma unroll
          for (int k = 0; k < 8; ++k) acc[k] = 0.f;
#pragma unroll 4
          for (int c = 0; c < 128; ++c) { const float mv = mt[r * 132 + c]; const f32x4 w0 = *(const LAS f32x4*)(pw + c * 128 + d8), w1 = *(const LAS f32x4*)(pw + c * 128 + d8 + 4);
              acc[0] += mv * w0[0]; acc[1] += mv * w0[1]; acc[2] += mv * w0[2]; acc[3] += mv * w0[3]; acc[4] += mv * w1[0]; acc[5] += mv * w1[1]; acc[6] += mv * w1[2]; acc[7] += mv * w1[3]; }
          const f32x4 s0 = *(const f32x4*)(a.pool_scale + g * 128 + d8), s1 = *(const f32x4*)(a.pool_scale + g * 128 + d8 + 4);
          v4u o; o.x = pkbf(acc[0] * s0[0], acc[1] * s0[1]); o.y = pkbf(acc[2] * s0[2], acc[3] * s0[3]); o.z = pkbf(acc[4] * s1[0], acc[5] * s1[1]); o.w = pkbf(acc[6] * s1[2], acc[7] * s1[3]);
          *(v4u*)(PO + (size_t)row * DP + g * 128 + d8) = o; }
    }
}

__device__ __forceinline__ float attn_bound2(const Args& a, int lane) {
    const float gq = wave_max(fabsf(a.q_norm_g[lane])), gk = wave_max(fabsf(a.k_norm_g[lane]));
    return 64.0f * C2 * gq * gk * 1.03f;
}

__device__ __forceinline__ void p3_prompt_attn_naive(Frame& F, const Args& a) {
    unsigned char* ws = a.ws;
    const bf16* Q = (const bf16*)(ws + WS_Q); const bf16* K = (const bf16*)(ws + WS_K); const bf16* V = (const bf16*)(ws + WS_V); bf16* AO = (bf16*)(ws + WS_AO);
    const float* CP2 = (const float*)(ws + WS_CP2);
    LAS float* Ks = (LAS float*)F.lds;
    LAS float* Vs = (LAS float*)(F.lds + 16384);
    LAS float* cks = (LAS float*)(F.lds + 32768);
    const float M2 = attn_bound2(a, F.lane);
    for (int unit = blockIdx.x; unit < NB * NH * (SEQ / 512); unit += F.G) {
        const int bh = unit & 31, qblk = 7 - (unit >> 5), b = bh >> 3, h = bh & 7;
        const int i = qblk * 512 + F.tid; const size_t qrow = (size_t)(b * SEQ + i);
        float q[64], o[64];
#pragma unroll
        for (int d8 = 0; d8 < 8; ++d8) { const v4u w = *(const v4u*)(Q + qrow * DA + h * 64 + d8 * 8);
            q[d8 * 8 + 0] = bflo(w.x); q[d8 * 8 + 1] = bfhi(w.x); q[d8 * 8 + 2] = bflo(w.y); q[d8 * 8 + 3] = bfhi(w.y); q[d8 * 8 + 4] = bflo(w.z); q[d8 * 8 + 5] = bfhi(w.z); q[d8 * 8 + 6] = bflo(w.w); q[d8 * 8 + 7] = bfhi(w.w); }
#pragma unroll
        for (int d = 0; d < 64; ++d) o[d] = 0.f;
        const float cq = CP2[(size_t)bh * SEQ + i] - M2; float l = 0.f;
        const int ntile = (qblk + 1) * 8;
        for (int jt = 0; jt < ntile; ++jt) {
            __syncthreads();
            { const int kr = F.tid >> 3, d8 = (F.tid & 7) * 8; const size_t krow = (size_t)(b * SEQ + jt * 64 + kr);
              const v4u kw = *(const v4u*)(K + krow * DA + h * 64 + d8), vw = *(const v4u*)(V + krow * DA + h * 64 + d8);
              LAS float* kd = Ks + kr * 64 + d8; LAS float* vd = Vs + kr * 64 + d8;
              *(LAS f32x4*)kd = (f32x4){bflo(kw.x), bfhi(kw.x), bflo(kw.y), bfhi(kw.y)}; *(LAS f32x4*)(kd + 4) = (f32x4){bflo(kw.z), bfhi(kw.z), bflo(kw.w), bfhi(kw.w)};
              *(LAS f32x4*)vd = (f32x4){bflo(vw.x), bfhi(vw.x), bflo(vw.y), bfhi(vw.y)}; *(LAS f32x4*)(vd + 4) = (f32x4){bflo(vw.z), bfhi(vw.z), bflo(vw.w), bfhi(vw.w)};
              if (F.tid < 64) cks[F.tid] = CP2[(size_t)bh * SEQ + jt * 64 + F.tid]; }
            __syncthreads();
            for (int j = 0; j < 64; ++j) {
                float s = 0.f;
#pragma unroll
                for (int d4 = 0; d4 < 16; ++d4) { const f32x4 kv = *(const LAS f32x4*)(Ks + j * 64 + d4 * 4); s += (q[d4 * 4] * kv[0] + q[d4 * 4 + 1] * kv[1]) + (q[d4 * 4 + 2] * kv[2] + q[d4 * 4 + 3] * kv[3]); }
                float p = __builtin_amdgcn_exp2f(s + cq - cks[j]); if (jt * 64 + j > i) p = 0.f;
                l += p;
#pragma unroll
                for (int d4 = 0; d4 < 16; ++d4) { const f32x4 vv = *(const LAS f32x4*)(Vs + j * 64 + d4 * 4); o[d4 * 4] += p * vv[0]; o[d4 * 4 + 1] += p * vv[1]; o[d4 * 4 + 2] += p * vv[2]; o[d4 * 4 + 3] += p * vv[3]; }
            }
        }
        const float il = 1.0f / l;
#pragma unroll
        for (int d8 = 0; d8 < 8; ++d8) { v4u w; w.x = pkbf(o[d8 * 8] * il, o[d8 * 8 + 1] * il); w.y = pkbf(o[d8 * 8 + 2] * il, o[d8 * 8 + 3] * il); w.z = pkbf(o[d8 * 8 + 4] * il, o[d8 * 8 + 5] * il); w.w = pkbf(o[d8 * 8 + 6] * il, o[d8 * 8 + 7] * il);
            *(v4u*)(AO + qrow * DA + h * 64 + d8 * 8) = w; }
    }
}

__device__ __forceinline__ void p3_sample_attn(Frame& F, const Args& a) {
    unsigned char* ws = a.ws;
    const bf16* Q = (const bf16*)(ws + WS_Q); bf16* AO = (bf16*)(ws + WS_AO);
    LAS float* qs = (LAS float*)F.lds;
    LAS float* lfp = (LAS float*)(F.lds + 2048);
    LAS float* E2 = (LAS float*)(F.lds + 2048 + 8192);
    LAS float* sc = (LAS float*)(F.lds + 12288);
    LAS float* Op = (LAS float*)(F.lds + 12288 + 16384);
    LAS float* lp = (LAS float*)(F.lds + 12288 + 32768);
    const float M2 = attn_bound2(a, F.lane);
    const int lane = F.lane, w = F.wave;
    for (int unit = blockIdx.x; unit < DB * NH; unit += F.G) {
        const int b = unit >> 3, h = unit & 7;
        __syncthreads();
        { const int t = F.tid >> 6, d = F.tid & 63; qs[t * 64 + d] = bf2f(Q[(size_t)(MP + b * 8 + t) * DA + h * 64 + d]); }
        for (int j = F.tid; j < PAST; j += NTHR) { const int pg = a.page_table[b * NPAGES + (j >> 7)]; lfp[j] = a.cache_lf[((size_t)pg * PAGE + (j & 127)) * NH + h]; }
        __syncthreads();
        if (w == 0) {
            float loc[32]; float tot = 0.f;
#pragma unroll
            for (int k = 31; k >= 0; --k) { loc[k] = tot; tot += lfp[lane * 32 + k]; }
            float inc = tot;
#pragma unroll
            for (int o = 1; o < 64; o <<= 1) { const float t = __shfl_down(inc, o); if (lane + o < 64) inc += t; }
            const float excl = inc - tot;
#pragma unroll
            for (int k = 0; k < 32; ++k) lfp[lane * 32 + k] = (loc[k] + excl) * LOG2E;
            if (lane < 8) { float e = 0.f; for (int t = 0; t <= lane; ++t) e += a.out[O_LFS + (size_t)(b * 8 + t) * NH + h]; E2[lane] = e * LOG2E; }
        }
        __syncthreads();
        f32x4 qp[8];
#pragma unroll
        for (int t = 0; t < 8; ++t) qp[t] = *(const LAS f32x4*)(qs + t * 64 + 4 * (lane & 15));
        float e2[8];
#pragma unroll
        for (int t = 0; t < 8; ++t) e2[t] = E2[t] - M2;
        float o[8], lsum[8];
#pragma unroll
        for (int t = 0; t < 8; ++t) { o[t] = 0.f; lsum[t] = 0.f; }
        LAS float* scw = sc + w * 512;
        const int nblk = (w == 0) ? 5 : 4;
        for (int blk = 0; blk < nblk; ++blk) {
            const bool isnew = blk == 4;
            for (int gi = 0; gi < (isnew ? 2 : 16); ++gi) {
                const int kk = 4 * gi + (lane >> 4);
                const float* kp;
                if (!isnew) { const int j = w * 256 + blk * 64 + kk; const int pg = a.page_table[b * NPAGES + (j >> 7)]; kp = a.cache_k + (((size_t)pg * PAGE + (j & 127)) * NH + h) * HD; }
                else kp = a.out + O_KS + (size_t)(b * 8 + kk) * DA + h * HD;
                const f32x4 k4 = *(const f32x4*)(kp + 4 * (lane & 15));
                float part[8];
#pragma unroll
                for (int t = 0; t < 8; ++t) part[t] = (qp[t][0] * k4[0] + qp[t][1] * k4[1]) + (qp[t][2] * k4[2] + qp[t][3] * k4[3]);
#pragma unroll
                for (int t = 0; t < 8; ++t) { part[t] += __shfl_xor(part[t], 1); part[t] += __shfl_xor(part[t], 2); part[t] += __shfl_xor(part[t], 4); part[t] += __shfl_xor(part[t], 8); }
                float mine = 0.f;
#pragma unroll
                for (int t = 0; t < 8; ++t) if ((lane & 15) == t) mine = part[t];
                if ((lane & 15) < 8) scw[kk * 8 + (lane & 15)] = mine;
            }
            LDS_WAIT(); asm volatile("" ::: "memory");
            { f32x4 s0 = *(const LAS f32x4*)(scw + lane * 8), s1 = *(const LAS f32x4*)(scw + lane * 8 + 4); float p[8];
              const float sv[8] = {s0[0], s0[1], s0[2], s0[3], s1[0], s1[1], s1[2], s1[3]};
              if (!isnew) { const float dj = lfp[w * 256 + blk * 64 + lane];
#pragma unroll
                  for (int t = 0; t < 8; ++t) p[t] = __builtin_amdgcn_exp2f(sv[t] + e2[t] + dj);
              } else {
#pragma unroll
                  for (int t = 0; t < 8; ++t) { const float ek = E2[lane & 7]; p[t] = (lane <= t) ? __builtin_amdgcn_exp2f(sv[t] + e2[t] - ek) : 0.f; }
              }
#pragma unroll
              for (int t = 0; t < 8; ++t) lsum[t] += p[t];
              *(LAS f32x4*)(scw + lane * 8) = (f32x4){p[0], p[1], p[2], p[3]}; *(LAS f32x4*)(scw + lane * 8 + 4) = (f32x4){p[4], p[5], p[6], p[7]}; }
            LDS_WAIT(); asm volatile("" ::: "memory");
            for (int kk = 0; kk < (isnew ? 8 : 64); ++kk) {
                const float* vp;
                if (!isnew) { const int j = w * 256 + blk * 64 + kk; const int pg = a.page_table[b * NPAGES + (j >> 7)]; vp = a.cache_v + (((size_t)pg * PAGE + (j & 127)) * NH + h) * HD; }
                else vp = a.out + O_VS + (size_t)(b * 8 + kk) * DA + h * HD;
                const float vv = vp[lane];
                const f32x4 p0 = *(const LAS f32x4*)(scw + kk * 8), p1 = *(const LAS f32x4*)(scw + kk * 8 + 4);
                o[0] += p0[0] * vv; o[1] += p0[1] * vv; o[2] += p0[2] * vv; o[3] += p0[3] * vv; o[4] += p1[0] * vv; o[5] += p1[1] * vv; o[6] += p1[2] * vv; o[7] += p1[3] * vv;
            }
            LDS_WAIT(); asm volatile("" ::: "memory");
        }
#pragma unroll
        for (int t = 0; t < 8; ++t) { Op[(w * 8 + t) * 64 + lane] = o[t]; const float ls = wave_sum(lsum[t]); if (lane == 0) lp[w * 8 + t] = ls; }
        __syncthreads();
        { const int t = F.tid >> 6, d = F.tid & 63; float O = 0.f, L = 0.f;
#pragma unroll
          for (int ww = 0; ww < 8; ++ww) { O += Op[(ww * 8 + t) * 64 + d]; L += lp[ww * 8 + t]; }
          AO[(size_t)(MP + b * 8 + t) * DA + h * 64 + d] = (bf16)(pkbf(O / L, 0.f) & 0xffffu); }
    }
}

__device__ __forceinline__ void p7_topk_naive(Frame& F, const Args& a) {
    unsigned char* ws = a.ws;
    const bf16* PQ = (const bf16*)(ws + WS_PQ); const bf16* SK = (const bf16*)(ws + WS_SUBK); const float* RSS = (const float*)(ws + WS_RSS);
    int* SI = (int*)(ws + WS_SI); float* SG = (float*)(ws + WS_SG);
    LAS float* kT = (LAS float*)F.lds;
    LAS float* qt = (LAS float*)(F.lds + 67584);
    LAS float* sc = (LAS float*)(F.lds + 83968);
    LAS float* tps = (LAS float*)(F.lds + 100352);
    LAS int* tpi = (LAS int*)(F.lds + 100352 + 4096);
    LAS float* fs = (LAS float*)(F.lds + 100352 + 8192);
    LAS float* rs = (LAS float*)(F.lds + 100352 + 8192 + 2048);
    LAS int* cab = (LAS int*)(F.lds + 100352 + 8192 + 2048 + 128);
    if (F.tid == 0) { int n = 0; for (int ca = 0; ca < 16; ++ca) for (int cb = 0; cb < 16; ++cb) if ((ca + 1) * (cb + 1) <= 16) cab[n++] = (ca << 4) | cb; }
    for (int unit = blockIdx.x; unit < (M / 32) * PH; unit += F.G) {
        const int h = unit & 7, tile = unit >> 3, row0 = tile * 32;
        for (int p = 0; p < 2; ++p) {
            __syncthreads();
            for (int i = F.tid; i < 128 * 128 / 8; i += NTHR) { const int n = i >> 4, d8 = (i & 15) * 8; const v4u wv = *(const v4u*)(SK + ((size_t)(h * 2 + p) * NKEYS + n) * DKH + d8);
                kT[(d8 + 0) * 132 + n] = bflo(wv.x); kT[(d8 + 1) * 132 + n] = bfhi(wv.x); kT[(d8 + 2) * 132 + n] = bflo(wv.y); kT[(d8 + 3) * 132 + n] = bfhi(wv.y);
                kT[(d8 + 4) * 132 + n] = bflo(wv.z); kT[(d8 + 5) * 132 + n] = bfhi(wv.z); kT[(d8 + 6) * 132 + n] = bflo(wv.w); kT[(d8 + 7) * 132 + n] = bfhi(wv.w); }
            { const int t = F.tid >> 4, d8 = (F.tid & 15) * 8; const v4u wv = *(const v4u*)(PQ + (size_t)(row0 + t) * DQ + h * 256 + p * 128 + d8);
              *(LAS f32x4*)(qt + t * 128 + d8) = (f32x4){bflo(wv.x), bfhi(wv.x), bflo(wv.y), bfhi(wv.y)}; *(LAS f32x4*)(qt + t * 128 + d8 + 4) = (f32x4){bflo(wv.z), bfhi(wv.z), bflo(wv.w), bfhi(wv.w)}; }
            if (p == 0 && F.tid < 32) { float s = 0.f; for (int k = 0; k < 16; ++k) s += RSS[(size_t)(row0 + F.tid) * 16 + k]; rs[F.tid] = 1.0f / sqrtf(s * (1.0f / DM) + EPS); }
            __syncthreads();
            const int t = F.tid >> 4, kq = (F.tid & 15) * 8;
            float acc[8];
#pragma unroll
            for (int k = 0; k < 8; ++k) acc[k] = 0.f;
#pragma unroll 4
            for (int d = 0; d < 128; ++d) { const float qv = qt[t * 128 + d]; const f32x4 k0 = *(const LAS f32x4*)(kT + d * 132 + kq), k1 = *(const LAS f32x4*)(kT + d * 132 + kq + 4);
                acc[0] += qv * k0[0]; acc[1] += qv * k0[1]; acc[2] += qv * k0[2]; acc[3] += qv * k0[3]; acc[4] += qv * k1[0]; acc[5] += qv * k1[1]; acc[6] += qv * k1[2]; acc[7] += qv * k1[3]; }
            *(LAS f32x4*)(sc + t * 128 + kq) = (f32x4){acc[0], acc[1], acc[2], acc[3]}; *(LAS f32x4*)(sc + t * 128 + kq + 4) = (f32x4){acc[4], acc[5], acc[6], acc[7]};
            __syncthreads();
            int rank[8];
#pragma unroll
            for (int k = 0; k < 8; ++k) rank[k] = 0;
            for (int j = 0; j < 128; ++j) { const float sj = sc[t * 128 + j];
#pragma unroll
                for (int k = 0; k < 8; ++k) rank[k] += (sj > acc[k] || (sj == acc[k] && j < kq + k)) ? 1 : 0; }
#pragma unroll
            for (int k = 0; k < 8; ++k) if (rank[k] < 16) { tps[(p * 32 + t) * 16 + rank[k]] = acc[k]; tpi[(p * 32 + t) * 16 + rank[k]] = kq + k; }
        }
        __syncthreads();
        { const int t = F.tid >> 4, l16 = F.tid & 15;
          float cs[4]; int cf[4], ci[4], rk[4];
#pragma unroll
          for (int k = 0; k < 4; ++k) { const int c = l16 + 16 * k; if (c < 50) { const int ab = cab[c], ca = ab >> 4, cb = ab & 15; cs[k] = tps[t * 16 + ca] + tps[(32 + t) * 16 + cb]; cf[k] = ab; ci[k] = tpi[t * 16 + ca] * NKEYS + tpi[(32 + t) * 16 + cb]; }
              else { cs[k] = -INFINITY; cf[k] = 1 << 20; ci[k] = 0; } rk[k] = 0; }
          for (int c = 0; c < 50; ++c) { const int ab = cab[c]; const float s = tps[t * 16 + (ab >> 4)] + tps[(32 + t) * 16 + (ab & 15)];
#pragma unroll
              for (int k = 0; k < 4; ++k) rk[k] += (s > cs[k] || (s == cs[k] && ab < cf[k])) ? 1 : 0; }
#pragma unroll
          for (int k = 0; k < 4; ++k) if (l16 + 16 * k < 50 && rk[k] < 16) { fs[t * 16 + rk[k]] = cs[k]; SI[(size_t)(row0 + t) * 128 + h * 16 + rk[k]] = ci[k]; }
        }
        __syncthreads();
        { const int t = F.tid >> 4, l16 = F.tid & 15; const float z = fs[t * 16 + l16] * rs[t];
          float mx = z; mx = fmaxf(mx, __shfl_xor(mx, 1)); mx = fmaxf(mx, __shfl_xor(mx, 2)); mx = fmaxf(mx, __shfl_xor(mx, 4)); mx = fmaxf(mx, __shfl_xor(mx, 8));
          const float e = expf(z - mx); float sm = e; sm += __shfl_xor(sm, 1); sm += __shfl_xor(sm, 2); sm += __shfl_xor(sm, 4); sm += __shfl_xor(sm, 8);
          SG[(size_t)(row0 + t) * 128 + h * 16 + l16] = e / sm; }
    }
}

__device__ __forceinline__ void p8_gather_naive(Frame& F, const Args& a) {
    unsigned char* ws = a.ws;
    const bf16* HG = (const bf16*)(ws + WS_XN); const bf16* PU = (const bf16*)(ws + WS_PU); const bf16* PV = (const bf16*)(ws + WS_PV);
    const float* RSS = (const float*)(ws + WS_RSS); const int* SI = (const int*)(ws + WS_SI); const float* SG = (const float*)(ws + WS_SG);
    float* Y = a.out + O_YP;
    LAS float* wl = (LAS float*)(F.lds + F.wave * 512);
    const int gw = F.vcu * NWAVES + F.wave, NGW = F.G * NWAVES, lane = F.lane;
    for (int row = gw; row < M; row += NGW) {
        float hx[16];
        { const v4u a0 = *(const v4u*)(HG + (size_t)row * DM + 8 * lane), a1 = *(const v4u*)(HG + (size_t)row * DM + 512 + 8 * lane);
          hx[0] = bflo(a0.x); hx[1] = bfhi(a0.x); hx[2] = bflo(a0.y); hx[3] = bfhi(a0.y); hx[4] = bflo(a0.z); hx[5] = bfhi(a0.z); hx[6] = bflo(a0.w); hx[7] = bfhi(a0.w);
          hx[8] = bflo(a1.x); hx[9] = bfhi(a1.x); hx[10] = bflo(a1.y); hx[11] = bfhi(a1.y); hx[12] = bflo(a1.z); hx[13] = bfhi(a1.z); hx[14] = bflo(a1.w); hx[15] = bfhi(a1.w); }
        float ssum = (lane < 16) ? RSS[(size_t)row * 16 + lane] : 0.f; ssum = wave_sum(ssum);
        const float rstd = 1.0f / sqrtf(ssum * (1.0f / DM) + EPS);
        const int e0 = SI[(size_t)row * 128 + lane], e1 = SI[(size_t)row * 128 + 64 + lane];
        const float g0 = SG[(size_t)row * 128 + lane], g1 = SG[(size_t)row * 128 + 64 + lane];
#pragma unroll 4
        for (int k = 0; k < 128; ++k) {
            const int e = __shfl(k < 64 ? e0 : e1, k & 63);
            const v4u u0 = *(const v4u*)(PU + (size_t)e * DM + 8 * lane), u1 = *(const v4u*)(PU + (size_t)e * DM + 512 + 8 * lane);
            float d = (hx[0] * bflo(u0.x) + hx[1] * bfhi(u0.x)) + (hx[2] * bflo(u0.y) + hx[3] * bfhi(u0.y)) + (hx[4] * bflo(u0.z) + hx[5] * bfhi(u0.z)) + (hx[6] * bflo(u0.w) + hx[7] * bfhi(u0.w))
                    + (hx[8] * bflo(u1.x) + hx[9] * bfhi(u1.x)) + (hx[10] * bflo(u1.y) + hx[11] * bfhi(u1.y)) + (hx[12] * bflo(u1.z) + hx[13] * bfhi(u1.z)) + (hx[14] * bflo(u1.w) + hx[15] * bfhi(u1.w));
            d = wave_sum(d);
            if (lane == (k & 63)) { const float z = d * rstd; const float ge = 0.5f * z * (1.0f + erff(z * 0.70710678118654752f)); wl[k] = ge * (k < 64 ? g0 : g1); }
        }
        LDS_WAIT(); asm volatile("" ::: "memory");
        float o[16];
#pragma unroll
        for (int i = 0; i < 16; ++i) o[i] = 0.f;
#pragma unroll 4
        for (int k = 0; k < 128; ++k) {
            const int e = __shfl(k < 64 ? e0 : e1, k & 63); const float wv = wl[k];
            const v4u u0 = *(const v4u*)(PV + (size_t)e * DM + 8 * lane), u1 = *(const v4u*)(PV + (size_t)e * DM + 512 + 8 * lane);
            o[0] += wv * bflo(u0.x); o[1] += wv * bfhi(u0.x); o[2] += wv * bflo(u0.y); o[3] += wv * bfhi(u0.y); o[4] += wv * bflo(u0.z); o[5] += wv * bfhi(u0.z); o[6] += wv * bflo(u0.w); o[7] += wv * bfhi(u0.w);
            o[8] += wv * bflo(u1.x); o[9] += wv * bfhi(u1.x); o[10] += wv * bflo(u1.y); o[11] += wv * bfhi(u1.y); o[12] += wv * bflo(u1.z); o[13] += wv * bfhi(u1.z); o[14] += wv * bflo(u1.w); o[15] += wv * bfhi(u1.w);
        }
        LDS_WAIT(); asm volatile("" ::: "memory");
        float* yr = Y + (size_t)row * DM;
        { f32x4 y0 = *(f32x4*)(yr + 8 * lane), y1 = *(f32x4*)(yr + 8 * lane + 4), y2 = *(f32x4*)(yr + 512 + 8 * lane), y3 = *(f32x4*)(yr + 512 + 8 * lane + 4);
          y0 += (f32x4){o[0], o[1], o[2], o[3]}; y1 += (f32x4){o[4], o[5], o[6], o[7]}; y2 += (f32x4){o[8], o[9], o[10], o[11]}; y3 += (f32x4){o[12], o[13], o[14], o[15]};
          *(f32x4*)(yr + 8 * lane) = y0; *(f32x4*)(yr + 8 * lane + 4) = y1; *(f32x4*)(yr + 512 + 8 * lane) = y2; *(f32x4*)(yr + 512 + 8 * lane + 4) = y3; }
    }
}

constexpr int N_PHASES = 9;
#ifndef MK_PER_PHASE
#define MK_PER_PHASE 1
#endif
__global__ void __launch_bounds__(NTHR, 2) fwd_kernel(Args args) {
    extern __shared__ __attribute__((aligned(16))) unsigned char lds[];
    Frame F;
    F.lds = (LAS unsigned char*)lds; F.MISC = (volatile LAS unsigned*)(F.lds + MISC_OFF);
    F.tid = threadIdx.x; F.lane = F.tid & 63; F.wave = __builtin_amdgcn_readfirstlane(F.tid >> 6);
    F.G = gridDim.x; { const int bx = blockIdx.x; F.vcu = (F.G % 8 == 0) ? (bx % 8) * (F.G / 8) + bx / 8 : bx; }
    F.ctl = (gu32*)(args.ws + WS_CTL);
    for (int u = F.tid; u < (LDS_BYTES - MISC_OFF) / 4; u += NTHR) ((LAS unsigned*)(F.lds + MISC_OFF))[u] = 0u;
    __syncthreads();
#if MK_PER_PHASE
#define GRID_BAR() do { } while (0)
#else
    XcdBarrier bar = xcd_barrier_post((unsigned*)(F.ctl + CW_BAR), F.MISC + 8);
#define GRID_BAR() xcd_barrier(bar)
#endif
    unsigned char* ws = args.ws;
    const int lo = args.ph_lo, hi = args.ph_hi;
#define IN(k) (lo <= (k) && (k) < hi)
#define BOTH(k) (IN(k) && IN((k) + 1))
    if (IN(0)) { p0_prologue(F, args); if (BOTH(0)) GRID_BAR(); }
    if (IN(1)) {
        pg8::Gemm g{(const bf16*)(ws + WS_XN), (const bf16*)(ws + WS_WIN), M, NPROJ, DM}; pg8::StaticOrder S; S.init(M, NPROJ, F.G, (int)blockIdx.x);
        EpiInProj E{(bf16*)(ws + WS_U), (bf16*)(ws + WS_Q), (bf16*)(ws + WS_K), (bf16*)(ws + WS_V), (bf16*)(ws + WS_GA), (bf16*)(ws + WS_GB), args.out, args.q_norm_g, args.k_norm_g};
        pg8::gemm_phase<EpiInProj, pg8::StaticOrder, true, true>(F.lds, g, S, E);
        if (BOTH(1)) GRID_BAR();
    }
    if (IN(2)) { p2_cumsum_pool(F, args); if (BOTH(2)) GRID_BAR(); }
    if (IN(3)) { p3_prompt_attn_naive(F, args); p3_sample_attn(F, args); if (BOTH(3)) GRID_BAR(); }
    if (IN(4)) {
        { pg8::Gemm g{(const bf16*)(ws + WS_PO), (const bf16*)(ws + WS_WBP), M, DM, DP}; pg8::StaticOrder S; S.init(M, DM, F.G, (int)blockIdx.x);
          EpiGate<0> E{(const bf16*)(ws + WS_GA), nullptr, (bf16*)(ws + WS_T)};
          pg8::gemm_phase<EpiGate<0>, pg8::StaticOrder, true, true>(F.lds, g, S, E); }
        __syncthreads();
        { pg8::Gemm g{(const bf16*)(ws + WS_AO), (const bf16*)(ws + WS_WBA), M, DM, DA}; pg8::StaticOrder S; S.init(M, DM, F.G, (int)blockIdx.x);
          EpiGate<1> E{(const bf16*)(ws + WS_GB), (const bf16*)(ws + WS_T), (bf16*)(ws + WS_MIX)};
          pg8::gemm_phase<EpiGate<1>, pg8::StaticOrder, true, true>(F.lds, g, S, E); }
        if (BOTH(4)) GRID_BAR();
    }
    if (IN(5)) {
        pg8::Gemm g{(const bf16*)(ws + WS_MIX), (const bf16*)(ws + WS_WOUT), M, DM, DM}; pg8::StaticOrder S; S.init(M, DM, F.G, (int)blockIdx.x);
        EpiOut E{args.x_p, args.x_s, args.out + O_YP, (bf16*)(ws + WS_XN), args.norm_ffn_g, (float*)(ws + WS_RSS)};
        pg8::gemm_phase<EpiOut, pg8::StaticOrder, true, true>(F.lds, g, S, E);
        if (BOTH(5)) GRID_BAR();
    }
    if (IN(6)) {
        pg8::Gemm g{(const bf16*)(ws + WS_XN), (const bf16*)(ws + WS_WQ), M, DQ, DM}; pg8::StaticOrder S; S.init(M, DQ, F.G, (int)blockIdx.x);
        pg8::EpiBf16<0> E{(bf16*)(ws + WS_PQ), DQ, nullptr, 0, 0, 1.f};
        pg8::gemm_phase<pg8::EpiBf16<0>, pg8::StaticOrder, true, true>(F.lds, g, S, E);
        if (BOTH(6)) GRID_BAR();
    }
    if (IN(7)) { p7_topk_naive(F, args); if (BOTH(7)) GRID_BAR(); }
    if (IN(8)) { p8_gather_naive(F, args); }
#ifdef DBG_DUMP
    if (IN(9)) { const bf16* AO = (const bf16*)(ws + WS_AO); const bf16* PO = (const bf16*)(ws + WS_PO); const bf16* MX = (const bf16*)(ws + (DBG_DUMP == 3 ? WS_T : DBG_DUMP == 4 ? WS_GA : WS_MIX));
        for (size_t i = (size_t)blockIdx.x * NTHR + F.tid; i < (size_t)M * DM; i += (size_t)F.G * NTHR) { const int row = (int)(i >> 10), c = (int)(i & 1023);
            float v; if (DBG_DUMP == 1) v = c < 512 ? bf2f(AO[(size_t)row * DA + c]) : bf2f(PO[(size_t)row * DP + c - 512]); else v = bf2f(MX[i]);
            args.out[O_YP + i] = v; } }
#endif
#undef IN
#undef BOTH
}

extern "C" void kernel_launch(void* const* d_in, const int* in_sizes, int n_in, void* d_out, int out_size, void* d_ws, size_t ws_size, hipStream_t stream) {
    static int grid = 0;
    if (grid == 0) {
        if (n_in != 22 || (size_t)out_size != O_END || ws_size < WS_END) { fprintf(stderr, "kernel_launch: unexpected shapes (n_in %d out %d ws %zu)\n", n_in, out_size, ws_size); grid = -1; return; }
        int dev = 0, cus = 0, per_cu = 0;
        if (hipGetDevice(&dev) != hipSuccess || hipDeviceGetAttribute(&cus, hipDeviceAttributeMultiprocessorCount, dev) != hipSuccess) { grid = -1; return; }
        if (hipFuncSetAttribute((const void*)fwd_kernel, hipFuncAttributeMaxDynamicSharedMemorySize, LDS_BYTES) != hipSuccess) { fprintf(stderr, "kernel_launch: hipFuncSetAttribute failed\n"); grid = -1; return; }
        if (hipOccupancyMaxActiveBlocksPerMultiprocessor(&per_cu, (const void*)fwd_kernel, NTHR, LDS_BYTES) != hipSuccess || per_cu < 1) fprintf(stderr, "kernel_launch: occupancy query reports %d\n", per_cu);
        (void)hipGetLastError();
        grid = cus;
    }
    if (grid < 0) return;
    if (hipMemsetAsync((char*)d_ws + WS_CTL, 0, CTL_ZERO_BYTES, stream) != hipSuccess) return;
    Args a{};
    a.x_p = (const float*)d_in[0]; a.x_s = (const float*)d_in[1]; a.cache_k = (const float*)d_in[2]; a.cache_v = (const float*)d_in[3]; a.cache_lf = (const float*)d_in[4];
    a.state_pool = (const float*)d_in[5]; a.page_table = (const int*)d_in[6]; a.norm_mix_g = (const float*)d_in[7]; a.w_in = (const float*)d_in[8]; a.b_forget = (const float*)d_in[9];
    a.q_norm_g = (const float*)d_in[10]; a.k_norm_g = (const float*)d_in[11]; a.pool_mix_w = (const float*)d_in[12]; a.pool_scale = (const float*)d_in[13]; a.w_bp = (const float*)d_in[14];
    a.w_ba = (const float*)d_in[15]; a.w_out = (const float*)d_in[16]; a.norm_ffn_g = (const float*)d_in[17]; a.w_query = (const float*)d_in[18]; a.sub_keys = (const float*)d_in[19];
    a.peer_u = (const float*)d_in[20]; a.peer_v = (const float*)d_in[21];
    a.out = (float*)d_out; a.ws = (unsigned char*)d_ws; a.pad = 0;
#if MK_PER_PHASE
#ifndef DBG_NPH
#define DBG_NPH N_PHASES
#endif
    for (int ph = 0; ph < DBG_NPH; ++ph) { a.ph_lo = ph; a.ph_hi = ph + 1; a.li = ph; hipLaunchKernelGGL(fwd_kernel, dim3(grid), dim3(NTHR), LDS_BYTES, stream, a); }
#ifdef DBG_DUMP
    a.ph_lo = 9; a.ph_hi = 10; a.li = 9; hipLaunchKernelGGL(fwd_kernel, dim3(grid), dim3(NTHR), LDS_BYTES, stream, a);
#endif
#else
    a.ph_lo = 0; a.ph_hi = N_PHASES; a.li = 0; hipLaunchKernelGGL(fwd_kernel, dim3(grid), dim3(NTHR), LDS_BYTES, stream, a);
#endif
}
```

```cpp
#include <hip/hip_runtime.h>
#include <cstdio>
#include <cstdint>
#include <cmath>
namespace pg8 {
#define PG8_LAS __attribute__((address_space(3)))
typedef unsigned short bf16_t;
typedef short bf16x8 __attribute__((ext_vector_type(8)));
typedef float f32x4 __attribute__((ext_vector_type(4)));
typedef unsigned u32x4 __attribute__((ext_vector_type(4)));
constexpr int BM = 256, BK = 64, HALF = 128, HTB = HALF * BK * 2  , STAGE_BYTES = 8 * HTB, NXCD = 8, WGM = 8;

__host__ __device__ __forceinline__ int lds_byte(int r, int c) { const int st = (r >> 4) * 2 + (c >> 5), rr = r & 15, cc = c & 31, ob = rr * 64 + cc * 2; return st * 1024 + (ob ^ (((ob >> 9) & 1) << 5)); }
__host__ __device__ __forceinline__ void stage_rc(int b, int& R, int& C) { const int st = b / 1024, sb = b % 1024, swz = sb ^ (((sb >> 9) & 1) << 5); R = (st >> 1) * 16 + swz / 64; C = (st & 1) * 32 + (swz % 64) / 2; }
__host__ __device__ __forceinline__ int perm32(int rho) { const int n = rho >> 4, i = rho & 15; return 8 * (i >> 2) + 4 * n + (i & 3); }

struct Unit { int pm, pn; };
struct Gemm { const bf16_t* A; const bf16_t* Bt; int M, N, K; };

struct StaticOrder {
    int nM, nN, nwg, G, c;
    __host__ __device__ void init(int M, int N, int G_, int c_) { nM = M / BM; nN = N / BM; nwg = nM * nN; G = G_; c = c_; }
    __host__ __device__ bool next(int i, Unit& u) const {
        const long L = (long)i * G + c; if (L >= nwg) return false;
        int wgid = (int)L; { const int q = nwg / NXCD, r = nwg % NXCD, xcd = wgid % NXCD, off = wgid / NXCD; wgid = (xcd < r ? xcd * (q + 1) : r * (q + 1) + (xcd - r) * q) + off; }
        const int nig = WGM * nN, gid = wgid / nig, fm = gid * WGM, gsz = (nM - fm) < WGM ? (nM - fm) : WGM;
        u.pm = fm + ((wgid % nig) % gsz); u.pn = (wgid % nig) / gsz; return true;
    }
    __device__ __forceinline__ void a_ready(const Unit&) const {}
    __device__ __forceinline__ void done(const Unit&) const {}
};

typedef float f32x2c __attribute__((ext_vector_type(2))); typedef __bf16 bf16x2c __attribute__((ext_vector_type(2)));
__device__ __forceinline__ unsigned cvt_pk_bf16(float lo, float hi) { f32x2c v = {lo, hi}; bf16x2c b = __builtin_convertvector(v, bf16x2c); return __builtin_bit_cast(unsigned, b); }
typedef float f32x2 __attribute__((ext_vector_type(2)));
__device__ __forceinline__ f32x2 gelu_pk(f32x2 v) {
    const f32x2 av = __builtin_elementwise_abs(v), d = av * 0.2316418882f + 1.0f;
    f32x2 t; t.x = __builtin_amdgcn_rcpf(d.x); t.y = __builtin_amdgcn_rcpf(d.y);
    f32x2 q = t * 0.5307027145f + (-0.7265760135f); q = q * t + 0.7107068705f; q = q * t + (-0.142248368f); q = q * t + 0.127414796f; q = q * t;
    const f32x2 s = (v * v) * (-0.72134752044f);
    f32x2 e; e.x = __builtin_amdgcn_exp2f(s.x); e.y = __builtin_amdgcn_exp2f(s.y);
    const f32x2 m = v * (q * e), r = v - m;
    f32x2 o; o.x = v.x < 0.f ? m.x : r.x; o.y = v.y < 0.f ? m.y : r.y; return o;
}

template <int ACT  > struct EpiBf16 {
    static constexpr bool PERM = true, AFTER_DRAIN = false; static_assert(ACT == 0 || ACT == 1, "EpiBf16: ACT is 0 (none) or 1 (gelu_pk)");
    bf16_t* O; int ldc; const float* bias; int split_cols; size_t split_stride; float scale0;
    __device__ __forceinline__ void operator()(const f32x4 (&acc)[2][2][4][2], const Unit& u, int wr, int wc, int fr, int fq) const {
        const int row0 = u.pm * BM + wr * 64 + fr; int colt = u.pn * BM; bf16_t* base = O;
        float sc = 1.f; if (split_cols) { const int t = colt / split_cols; base += (size_t)t * split_stride; colt -= t * split_cols; if (t == 0) sc = scale0; }
        const int col0 = colt + wc * 32 + 8 * fq, bcol0 = u.pn * BM + wc * 32 + 8 * fq;
        f32x4 bv[2][2];
#pragma unroll
        for (int bj = 0; bj < 2; ++bj)
#pragma unroll
            for (int n = 0; n < 2; ++n) bv[bj][n] = bias ? *(const f32x4*)(bias + bcol0 + bj * HALF + 4 * n) : (f32x4){0.f, 0.f, 0.f, 0.f};
#pragma unroll
        for (int ai = 0; ai < 2; ++ai)
#pragma unroll
            for (int m = 0; m < 4; ++m) { bf16_t* rowp = base + (size_t)(row0 + ai * HALF + m * 16) * ldc + col0;
#pragma unroll
                for (int bj = 0; bj < 2; ++bj) { f32x4 v0 = acc[ai][bj][m][0] + bv[bj][0], v1 = acc[ai][bj][m][1] + bv[bj][1];
                    if (ACT == 1) { f32x2 a = gelu_pk((f32x2){v0[0], v0[1]}), b = gelu_pk((f32x2){v0[2], v0[3]}), c = gelu_pk((f32x2){v1[0], v1[1]}), d = gelu_pk((f32x2){v1[2], v1[3]});
                        v0 = (f32x4){a.x, a.y, b.x, b.y}; v1 = (f32x4){c.x, c.y, d.x, d.y}; }
                    v0 = v0 * sc; v1 = v1 * sc; u32x4 w; w.x = cvt_pk_bf16(v0[0], v0[1]); w.y = cvt_pk_bf16(v0[2], v0[3]); w.z = cvt_pk_bf16(v1[0], v1[1]); w.w = cvt_pk_bf16(v1[2], v1[3]);
                    *(u32x4*)(rowp + bj * HALF) = w; } }
    }
};
template <class Epi, class Sched, bool ALIGN_EPI = false, bool SP2 = false>
__device__ __forceinline__ void gemm_phase(PG8_LAS unsigned char* lds, const Gemm g, const Sched& S, const Epi& E) {
    const int tid = threadIdx.x, wid = __builtin_amdgcn_readfirstlane(tid >> 6), lane = tid & 63, wr = wid >> 2, wc = wid & 3, fr = lane & 15, fq = lane >> 4;
    const int K = g.K, nt = K / BK;
    unsigned voffA[2], voffB[2];
#pragma unroll
    for (int i = 0; i < 2; ++i) { int R, C; stage_rc(tid * 16 + i * 8192, R, C); const int Rb = Epi::PERM ? ((R & ~31) + perm32(R & 31)) : R;
        voffA[i] = (unsigned)(R * K + C) * 2u; voffB[i] = (unsigned)(Rb * K + C) * 2u; }
    const size_t kstep = (size_t)(BK * 2);
    const size_t hstep = (size_t)HALF * K * 2;
    const size_t tstep = 2 * hstep;
    const unsigned ldsw = (unsigned)wid * 1024u;
    const int aoff = lds_byte(wr * 64 + fr, fq * 8), boff = lds_byte(wc * 32 + fr, fq * 8);
#define PG8_SA(b, h) (((b) * 2 + (h)) * HTB)
#define PG8_SB(b, h) ((4 + (b) * 2 + (h)) * HTB)
#define PG8_STAGE(bufoff, gbase, voff) do { _Pragma("unroll") for (int _i = 0; _i < 2; ++_i) \
        __builtin_amdgcn_global_load_lds((const unsigned*)((const char*)(gbase) + (voff)[_i]), (PG8_LAS unsigned*)(lds + (bufoff) + ldsw + _i * 8192), 16, 0, 0); } while (0)
#define PG8_LDA(dst, b, h) do { _Pragma("unroll") for (int m = 0; m < 4; ++m) _Pragma("unroll") for (int k = 0; k < 2; ++k) dst[m][k] = *(const PG8_LAS bf16x8*)(lds + PG8_SA(b, h) + aoff + m * 2048 + k * 1024); } while (0)
#define PG8_LDB(dst, b, h) do { _Pragma("unroll") for (int n = 0; n < 2; ++n) _Pragma("unroll") for (int k = 0; k < 2; ++k) dst[n][k] = *(const PG8_LAS bf16x8*)(lds + PG8_SB(b, h) + boff + n * 2048 + k * 1024); } while (0)
#define PG8_MMA(ai, bj, At, Bt) do { __builtin_amdgcn_s_setprio(1); _Pragma("unroll") for (int m = 0; m < 4; ++m) _Pragma("unroll") for (int n = 0; n < 2; ++n) _Pragma("unroll") for (int k = 0; k < 2; ++k) \
        acc[ai][bj][m][n] = __builtin_amdgcn_mfma_f32_16x16x32_bf16(Bt[n][k], At[m][k], acc[ai][bj][m][n], 0, 0, 0); __builtin_amdgcn_s_setprio(0); } while (0)
#define PG8_WAIT_V(n) asm volatile("s_waitcnt vmcnt(" #n ")" ::: "memory")
#define PG8_WAIT_L(n) asm volatile("s_waitcnt lgkmcnt(" #n ")" ::: "memory")
#define PG8_BAR __builtin_amdgcn_s_barrier()
#define PG8_SCHED __builtin_amdgcn_sched_barrier(0)
    Unit cur, nxt; int ui = 0;
    if (!S.next(0, cur)) return;
    f32x4 acc[2][2][4][2];
#pragma unroll
    for (int a = 0; a < 2; ++a)
#pragma unroll
        for (int b = 0; b < 2; ++b)
#pragma unroll
            for (int m = 0; m < 4; ++m)
#pragma unroll
                for (int n = 0; n < 2; ++n) acc[a][b][m][n] = (f32x4){0.f, 0.f, 0.f, 0.f};
    bf16x8 At[4][2], B0[2][2], B1[2][2];
    const char* cA = (const char*)g.A + (size_t)cur.pm * tstep; const char* cB = (const char*)g.Bt + (size_t)cur.pn * tstep;
    S.a_ready(cur);
    if constexpr (SP2) {
        PG8_STAGE(PG8_SB(0, 0), cB, voffB); PG8_STAGE(PG8_SB(0, 1), cB + hstep, voffB); PG8_STAGE(PG8_SA(0, 0), cA, voffA); PG8_STAGE(PG8_SA(0, 1), cA + hstep, voffA);
        if (wr == 1) PG8_BAR;
        PG8_WAIT_V(2); PG8_BAR;
        PG8_STAGE(PG8_SB(1, 0), cB + kstep, voffB); PG8_STAGE(PG8_SA(1, 0), cA + kstep, voffA); PG8_STAGE(PG8_SB(1, 1), cB + hstep + kstep, voffB);
        PG8_WAIT_V(6); PG8_BAR;
    } else {
        PG8_STAGE(PG8_SB(0, 0), cB, voffB); PG8_STAGE(PG8_SA(0, 0), cA, voffA); PG8_STAGE(PG8_SB(0, 1), cB + hstep, voffB); PG8_STAGE(PG8_SA(0, 1), cA + hstep, voffA);
        if (wr == 1) PG8_BAR;
        PG8_WAIT_V(4); PG8_BAR;
        PG8_STAGE(PG8_SB(1, 0), cB + kstep, voffB); PG8_STAGE(PG8_SA(1, 0), cA + kstep, voffA); PG8_STAGE(PG8_SB(1, 1), cB + hstep + kstep, voffB);
        PG8_WAIT_V(6); PG8_BAR;
    }
    for (;;) {
        const bool has_next = S.next(ui + 1, nxt);
        const char* nA = has_next ? (const char*)g.A + (size_t)nxt.pm * tstep : cA; const char* nB = has_next ? (const char*)g.Bt + (size_t)nxt.pn * tstep : cB;
        for (int t = 0; t < nt; t += 2) {
            const bool last = (t == nt - 2);
            const char* a1 = cA + (size_t)(t + 1) * kstep;
            const char* a2 = last ? nA : cA + (size_t)(t + 2) * kstep; const char* b2 = last ? nB : cB + (size_t)(t + 2) * kstep;
            const char* a3 = a2 + kstep; const char* b3 = b2 + kstep;
            if (last && has_next) S.a_ready(nxt);
            if constexpr (SP2) {
            PG8_LDB(B0, 0, 0); PG8_LDB(B1, 0, 1); PG8_SCHED; PG8_LDA(At, 0, 0); PG8_STAGE(PG8_SA(1, 1), a1 + hstep, voffA);
            PG8_WAIT_V(8); PG8_WAIT_L(0); PG8_BAR; PG8_MMA(0, 0, At, B0); PG8_MMA(0, 1, At, B1); PG8_BAR; PG8_SCHED;
            PG8_LDA(At, 0, 1); PG8_STAGE(PG8_SB(0, 0), b2, voffB); PG8_STAGE(PG8_SB(0, 1), b2 + hstep, voffB); PG8_STAGE(PG8_SA(0, 0), a2, voffA);
            PG8_WAIT_V(8); PG8_WAIT_L(0); PG8_BAR; PG8_MMA(1, 0, At, B0); PG8_MMA(1, 1, At, B1); PG8_BAR; PG8_SCHED;
            PG8_LDB(B0, 1, 0); PG8_LDB(B1, 1, 1); PG8_SCHED; PG8_LDA(At, 1, 0); PG8_STAGE(PG8_SA(0, 1), a2 + hstep, voffA);
            PG8_WAIT_V(8); PG8_WAIT_L(0); PG8_BAR; PG8_MMA(0, 0, At, B0); PG8_MMA(0, 1, At, B1); PG8_BAR; PG8_SCHED;
            PG8_LDA(At, 1, 1); PG8_STAGE(PG8_SB(1, 0), b3, voffB); PG8_STAGE(PG8_SB(1, 1), b3 + hstep, voffB); PG8_STAGE(PG8_SA(1, 0), a3, voffA);
            PG8_WAIT_V(8); PG8_WAIT_L(0); PG8_BAR; PG8_MMA(1, 0, At, B0); PG8_MMA(1, 1, At, B1); PG8_BAR; PG8_SCHED;
            } else {
            PG8_LDB(B0, 0, 0); PG8_SCHED; PG8_LDA(At, 0, 0); PG8_STAGE(PG8_SA(1, 1), a1 + hstep, voffA);
            PG8_WAIT_L(8); PG8_BAR; PG8_WAIT_L(0); PG8_MMA(0, 0, At, B0); PG8_BAR; PG8_SCHED;
            PG8_LDB(B1, 0, 1); PG8_STAGE(PG8_SB(0, 0), b2, voffB);
            PG8_BAR; PG8_WAIT_L(0); PG8_MMA(0, 1, At, B1); PG8_BAR;
            PG8_LDA(At, 0, 1); PG8_STAGE(PG8_SA(0, 0), a2, voffA);
            PG8_BAR; PG8_WAIT_L(0); PG8_MMA(1, 0, At, B0); PG8_BAR; PG8_SCHED;
            PG8_STAGE(PG8_SB(0, 1), b2 + hstep, voffB);
            PG8_WAIT_V(6); PG8_BAR; PG8_MMA(1, 1, At, B1); PG8_BAR;
            PG8_LDB(B0, 1, 0); PG8_SCHED; PG8_LDA(At, 1, 0); PG8_STAGE(PG8_SA(0, 1), a2 + hstep, voffA);
            PG8_WAIT_L(8); PG8_BAR; PG8_WAIT_L(0); PG8_MMA(0, 0, At, B0); PG8_BAR; PG8_SCHED;
            PG8_LDB(B1, 1, 1); PG8_STAGE(PG8_SB(1, 0), b3, voffB);
            PG8_BAR; PG8_WAIT_L(0); PG8_MMA(0, 1, At, B1); PG8_BAR;
            PG8_LDA(At, 1, 1); PG8_STAGE(PG8_SA(1, 0), a3, voffA);
            PG8_BAR; PG8_WAIT_L(0); PG8_MMA(1, 0, At, B0); PG8_BAR; PG8_SCHED;
            PG8_STAGE(PG8_SB(1, 1), b3 + hstep, voffB);
            PG8_WAIT_V(6); PG8_BAR; PG8_MMA(1, 1, At, B1); PG8_BAR;
            }
        }
        if constexpr (ALIGN_EPI) { if (wr == 0) PG8_BAR; }
        if constexpr (!Epi::AFTER_DRAIN) { E(acc, cur, wr, wc, fr, fq); S.done(cur); }
        if (!has_next) break;
#pragma unroll
        for (int a = 0; a < 2; ++a)
#pragma unroll
            for (int b = 0; b < 2; ++b)
#pragma unroll
                for (int m = 0; m < 4; ++m)
#pragma unroll
                    for (int n = 0; n < 2; ++n) acc[a][b][m][n] = (f32x4){0.f, 0.f, 0.f, 0.f};
        cur = nxt; cA = nA; cB = nB; ++ui;
        if constexpr (ALIGN_EPI) { if (wr == 1) PG8_BAR; }
    }
    PG8_WAIT_V(0);
    if constexpr (!ALIGN_EPI) { if (wr == 0) PG8_BAR; }
    PG8_BAR;
    if constexpr (Epi::AFTER_DRAIN) { E.fused(acc, cur, wr, wc, fr, fq, lds, wid, lane); S.done(cur); }
#undef PG8_SA
#undef PG8_SB
#undef PG8_STAGE
#undef PG8_LDA
#undef PG8_LDB
#undef PG8_MMA
#undef PG8_WAIT_V
#undef PG8_WAIT_L
#undef PG8_BAR
#undef PG8_SCHED
}
}
#define GAS __attribute__((address_space(1)))
#define LAS __attribute__((address_space(3)))
typedef unsigned short bf16;
typedef unsigned v4u __attribute__((ext_vector_type(4)));
typedef float f32x4 __attribute__((ext_vector_type(4)));
typedef short bf16x8 __attribute__((ext_vector_type(8)));
typedef GAS unsigned gu32;
typedef GAS unsigned long long gu64;
#define RLX_AGENT __ATOMIC_RELAXED, __HIP_MEMORY_SCOPE_AGENT
#define LDS_WAIT() asm volatile("s_waitcnt lgkmcnt(0)" ::: "memory")
#define VM_WAIT() asm volatile("s_waitcnt vmcnt(0)" ::: "memory")
__device__ __forceinline__ unsigned long long rt() { return __builtin_amdgcn_s_memrealtime(); }
__device__ __forceinline__ unsigned f2bf(float f) { unsigned u = __builtin_bit_cast(unsigned, f); return (u + 0x7fffu + ((u >> 16) & 1u)) >> 16; }
__device__ __forceinline__ unsigned pk2(float lo, float hi) { return f2bf(lo) | (f2bf(hi) << 16); }

#define XB_TMO      128
#define XB_XCNT(j)  (256  + 64 * (j))
#define XB_XSUB(j)  (1280 + 64 * (j))
#define XB_XGEN(j)  (2304 + 64 * (j))
#define XB_TOP      3328
#define XB_TOPGEN   3392
#define XCD_BAR_WORDS 3456
#define XB_SPIN_CAP (1u << 18)

__device__ __forceinline__ unsigned xb_ld(unsigned* p)              { return __hip_atomic_load(p, __ATOMIC_RELAXED, __HIP_MEMORY_SCOPE_AGENT); }
__device__ __forceinline__ unsigned xb_add(unsigned* p, unsigned v) { return __hip_atomic_fetch_add(p, v, __ATOMIC_RELAXED, __HIP_MEMORY_SCOPE_AGENT); }
__device__ __forceinline__ unsigned xb_xcc_id() { return (unsigned)__builtin_amdgcn_s_getreg((3 << 11) | 20) & 0xFu; }
#define XB_SPIN(cond, bar) do { unsigned _sp = 0; while (cond) { __builtin_amdgcn_s_sleep(1); \
    if ((++_sp & 255u) == 0u) { if (xb_ld(&(bar)[XB_TMO])) break; if (_sp > XB_SPIN_CAP) { atomicAdd(&(bar)[XB_TMO], 1u); break; } } } } while (0)

struct XcdBarrier {
    unsigned* bar; unsigned x;
    volatile LAS unsigned* st;
};

__device__ __forceinline__ XcdBarrier xcd_barrier_post(unsigned* bar, volatile LAS unsigned* st) {
    XcdBarrier b; b.bar = bar; b.x = xb_xcc_id(); b.st = st;
    if (threadIdx.x == 0) (void)xb_add(&bar[XB_XCNT(b.x)], 1u);
    return b;
}
__device__ __forceinline__ void xcd_barrier_complete(unsigned* bar, unsigned x, unsigned& nloc, unsigned& nx) {
    const unsigned G = gridDim.x * gridDim.y * gridDim.z;
    unsigned sum, cnt, mine, sp = 0u;
    for (;;) {
        sum = 0u; cnt = 0u; mine = 0u;
#pragma unroll
        for (unsigned j = 0; j < 16; ++j) { const unsigned c = xb_ld(&bar[XB_XCNT(j)]); sum += c; cnt += (c > 0u) ? 1u : 0u; mine = (j == x) ? c : mine; }
        if (sum == G) break;
        __builtin_amdgcn_s_sleep(1);
        if ((++sp & 255u) == 0u) { if (xb_ld(&bar[XB_TMO])) break; if (sp > XB_SPIN_CAP) { atomicAdd(&bar[XB_TMO], 1u); break; } }
    }
    nloc = mine > 0u ? mine : 1u; nx = cnt > 0u ? cnt : 1u;
}

__device__ __forceinline__ void xcd_barrier(const XcdBarrier& b) {
    asm volatile("s_waitcnt vmcnt(0)" ::: "memory");
    __syncthreads();
    if (threadIdx.x == 0) {
        unsigned* bar = b.bar;
        __builtin_amdgcn_s_waitcnt(0);
        unsigned nloc = b.st[0], nx = b.st[1];
        if (nloc == 0u) { xcd_barrier_complete(bar, b.x, nloc, nx); b.st[0] = nloc; b.st[1] = nx; }
        const unsigned old = xb_add(&bar[XB_XSUB(b.x)], 1u);
        const unsigned gen = old / nloc;
        if (old + 1u == (gen + 1u) * nloc) {
            __builtin_amdgcn_fence(__ATOMIC_RELEASE, "agent");
            asm volatile("s_waitcnt vmcnt(0)" ::: "memory");
            const unsigned og = xb_add(&bar[XB_TOP], 1u);
            const unsigned tg = og / nx;
            if (og + 1u == (tg + 1u) * nx) xb_add(&bar[XB_TOPGEN], 1u);
            else XB_SPIN(xb_ld(&bar[XB_TOPGEN]) == tg, bar);
            __builtin_amdgcn_fence(__ATOMIC_ACQUIRE, "agent");
            xb_add(&bar[XB_XGEN(b.x)], 1u);
            asm volatile("s_waitcnt vmcnt(0)" ::: "memory");
        } else {
            XB_SPIN(xb_ld(&bar[XB_XGEN(b.x)]) == gen, bar);
            __builtin_amdgcn_fence(__ATOMIC_ACQUIRE, "agent");
            asm volatile("s_waitcnt vmcnt(0)" ::: "memory");
        }
    }
    __syncthreads();
}

constexpr int NWAVES = 8, NTHR = 512;
constexpr int DM = 1024, NB = 4, SEQ = 4096, DB = 128, DSEQ = 8, PAST = 2048, PAGE = 128, NPAGES = 16;
constexpr int MP = NB * SEQ, MS = DB * DSEQ, M = MP + MS;
constexpr int DP = 512, DA = 512, NH = 8, HD = 64, DIN = 4104, NPROJ = 4096;
constexpr int NKEYS = 128, NEXP = 16384, PH = 8, TOPK = 16, DKH = 128, DQ = 2048;
constexpr float EPS = 1e-6f;
constexpr float LOG2E = 1.4426950408889634f;
constexpr float C2 = 0.125f * LOG2E;
constexpr size_t O_YP = 0, O_YS = O_YP + (size_t)MP * DM, O_KP = O_YS + (size_t)MS * DM, O_VP = O_KP + (size_t)MP * DA, O_LFP = O_VP + (size_t)MP * DA,
                 O_PP = O_LFP + (size_t)MP * NH, O_KS = O_PP + (size_t)NB * 15 * DP, O_VS = O_KS + (size_t)MS * DA, O_LFS = O_VS + (size_t)MS * DA,
                 O_PS = O_LFS + (size_t)MS * NH, O_END = O_PS + (size_t)DB * 15 * DP;
constexpr size_t MiB = 1u << 20;
constexpr size_t WS_CTL = 0, CTL_ZERO_BYTES = 1 * MiB;
constexpr size_t WS_WIN = 2 * MiB, WS_WBP = 10 * MiB, WS_WBA = 11 * MiB, WS_WOUT = 12 * MiB, WS_WQ = 14 * MiB, WS_SUBK = 18 * MiB, WS_CP2 = 19 * MiB, WS_RSS = 20 * MiB;
constexpr size_t WS_PU = 32 * MiB, WS_PV = 64 * MiB, WS_XN = 96 * MiB  , WS_U = 132 * MiB, WS_Q = 150 * MiB, WS_K = 168 * MiB, WS_V = 186 * MiB,
                 WS_GA = 204 * MiB, WS_GB = 240 * MiB, WS_PO = 276 * MiB, WS_AO = 294 * MiB, WS_T = 312 * MiB, WS_MIX = 348 * MiB, WS_PQ = 384 * MiB,
                 WS_SI = 456 * MiB, WS_SG = 466 * MiB, WS_END = 476 * MiB;
constexpr int CW_BAR = 4096;
constexpr int LDS_BYTES = 163840;
constexpr int SCR_BYTES = 159 * 1024;
constexpr int MISC_OFF = SCR_BYTES;

typedef unsigned short bf16;
typedef unsigned v4u __attribute__((ext_vector_type(4)));
typedef unsigned v2u __attribute__((ext_vector_type(2)));
typedef float f32x4 __attribute__((ext_vector_type(4)));
typedef float f32x2 __attribute__((ext_vector_type(2)));

__device__ __forceinline__ float bf2f(unsigned short b) { return __uint_as_float((unsigned)b << 16); }
__device__ __forceinline__ float bflo(unsigned w) { return __uint_as_float(w << 16); }
__device__ __forceinline__ float bfhi(unsigned w) { return __uint_as_float(w & 0xffff0000u); }
typedef __bf16 bf16x2_t __attribute__((ext_vector_type(2)));
__device__ __forceinline__ unsigned pkbf(float lo, float hi) { f32x2 v = {lo, hi}; bf16x2_t b = __builtin_convertvector(v, bf16x2_t); return __builtin_bit_cast(unsigned, b); }
__device__ __forceinline__ float wave_sum(float v) {
#pragma unroll
    for (int o = 1; o < 64; o <<= 1) v += __shfl_xor(v, o);
    return v;
}
__device__ __forceinline__ float wave_max(float v) {
#pragma unroll
    for (int o = 1; o < 64; o <<= 1) v = fmaxf(v, __shfl_xor(v, o));
    return v;
}

struct Args {
    const float* x_p; const float* x_s; const float* cache_k; const float* cache_v; const float* cache_lf; const float* state_pool; const int* page_table;
    const float* norm_mix_g; const float* w_in; const float* b_forget; const float* q_norm_g; const float* k_norm_g; const float* pool_mix_w; const float* pool_scale;
    const float* w_bp; const float* w_ba; const float* w_out; const float* norm_ffn_g; const float* w_query; const float* sub_keys; const float* peer_u; const float* peer_v;
    float* out; unsigned char* ws; int ph_lo, ph_hi, li, pad;
};

using pg8::Unit;
struct EpiInProj {
    static constexpr bool PERM = true, AFTER_DRAIN = false;
    bf16 *U, *Q, *K, *V, *GA, *GB; float* out; const float *gq, *gk;
    __device__ __forceinline__ void operator()(const f32x4 (&acc)[2][2][4][2], const Unit& u, int wr, int wc, int fr, int fq) const {
        const int pn = u.pn; const int row0 = u.pm * 256 + wr * 64 + fr; const bool prompt = u.pm < (MP / 256);
        if (pn < 2) {
#pragma unroll
            for (int ai = 0; ai < 2; ++ai)
#pragma unroll
                for (int m = 0; m < 4; ++m) { const int row = row0 + ai * 128 + m * 16;
                    float* tail = nullptr;
                    if (prompt) { const int s = row & (SEQ - 1), b = row >> 12; if (s >= SEQ - 15) tail = out + O_PP + (size_t)(b * 15 + (s - (SEQ - 15))) * DP; }
                    else { const int rs = row - MP; tail = out + O_PS + (size_t)((rs >> 3) * 15 + 7 + (rs & 7)) * DP; }
#pragma unroll
                    for (int bj = 0; bj < 2; ++bj) { const int col = pn * 256 + bj * 128 + wc * 32 + 8 * fq; const f32x4 v0 = acc[ai][bj][m][0], v1 = acc[ai][bj][m][1];
                        v4u w; w.x = pkbf(v0[0], v0[1]); w.y = pkbf(v0[2], v0[3]); w.z = pkbf(v1[0], v1[1]); w.w = pkbf(v1[2], v1[3]);
                        *(v4u*)(U + (size_t)row * DP + col) = w;
                        if (tail) { *(f32x4*)(tail + col) = v0; *(f32x4*)(tail + col + 4) = v1; } } }
        } else if (pn < 6) {
            const bool isq = pn < 4; const int head = 4 * (pn & 1) + wc; const float* g = isq ? gq : gk;
            f32x4 gv[2][2];
#pragma unroll
            for (int bj = 0; bj < 2; ++bj)
#pragma unroll
                for (int n = 0; n < 2; ++n) gv[bj][n] = *(const f32x4*)(g + 32 * bj + 8 * fq + 4 * n);
            bf16* dst = isq ? Q : K;
#pragma unroll
            for (int ai = 0; ai < 2; ++ai)
#pragma unroll
                for (int m = 0; m < 4; ++m) { const int row = row0 + ai * 128 + m * 16; float ss = 0.f;
#pragma unroll
                    for (int bj = 0; bj < 2; ++bj)
#pragma unroll
                        for (int n = 0; n < 2; ++n) { const f32x4 x = acc[ai][bj][m][n]; ss += (x[0] * x[0] + x[1] * x[1]) + (x[2] * x[2] + x[3] * x[3]); }
                    ss += __shfl_xor(ss, 16); ss += __shfl_xor(ss, 32);
                    float r = 1.0f / sqrtf(ss * (1.0f / 64.0f) + EPS);
                    float* kout = isq ? nullptr : (prompt ? out + O_KP + (size_t)row * DA : out + O_KS + (size_t)(row - MP) * DA);
                    const float rq = isq ? r * C2 : r;
#pragma unroll
                    for (int bj = 0; bj < 2; ++bj) { const int col = head * 64 + 32 * bj + 8 * fq; const f32x4 v0 = acc[ai][bj][m][0] * gv[bj][0] * rq, v1 = acc[ai][bj][m][1] * gv[bj][1] * rq;
                        v4u w; w.x = pkbf(v0[0], v0[1]); w.y = pkbf(v0[2], v0[3]); w.z = pkbf(v1[0], v1[1]); w.w = pkbf(v1[2], v1[3]);
                        *(v4u*)(dst + (size_t)row * DA + col) = w;
                        if (!isq) { *(f32x4*)(kout + col) = v0; *(f32x4*)(kout + col + 4) = v1; } } }
        } else if (pn < 8) {
#pragma unroll
            for (int ai = 0; ai < 2; ++ai)
#pragma unroll
                for (int m = 0; m < 4; ++m) { const int row = row0 + ai * 128 + m * 16;
                    float* vout = prompt ? out + O_VP + (size_t)row * DA : out + O_VS + (size_t)(row - MP) * DA;
#pragma unroll
                    for (int bj = 0; bj < 2; ++bj) { const int col = (pn - 6) * 256 + bj * 128 + wc * 32 + 8 * fq; const f32x4 v0 = acc[ai][bj][m][0], v1 = acc[ai][bj][m][1];
                        v4u w; w.x = pkbf(v0[0], v0[1]); w.y = pkbf(v0[2], v0[3]); w.z = pkbf(v1[0], v1[1]); w.w = pkbf(v1[2], v1[3]);
                        *(v4u*)(V + (size_t)row * DA + col) = w; *(f32x4*)(vout + col) = v0; *(f32x4*)(vout + col + 4) = v1; } }
        } else {
            bf16* dst = pn < 12 ? GA : GB; const int ct = (pn < 12 ? pn - 8 : pn - 12) * 256;
#pragma unroll
            for (int ai = 0; ai < 2; ++ai)
#pragma unroll
                for (int m = 0; m < 4; ++m) { const int row = row0 + ai * 128 + m * 16;
#pragma unroll
                    for (int bj = 0; bj < 2; ++bj) { const int col = ct + bj * 128 + wc * 32 + 8 * fq; float s[8];
#pragma unroll
                        for (int n = 0; n < 2; ++n)
#pragma unroll
                            for (int i = 0; i < 4; ++i) s[4 * n + i] = __builtin_amdgcn_rcpf(1.0f + __builtin_amdgcn_exp2f(-LOG2E * acc[ai][bj][m][n][i]));
                        v4u w; w.x = pkbf(s[0], s[1]); w.y = pkbf(s[2], s[3]); w.z = pkbf(s[4], s[5]); w.w = pkbf(s[6], s[7]);
                        *(v4u*)(dst + (size_t)row * DM + col) = w; } }
        }
    }
};
template <int MODE> struct EpiGate {
    static constexpr bool PERM = true, AFTER_DRAIN = false;
    const bf16* G; const bf16* Tin; bf16* O;
    __device__ __forceinline__ void operator()(const f32x4 (&acc)[2][2][4][2], const Unit& u, int wr, int wc, int fr, int fq) const {
        const int row0 = u.pm * 256 + wr * 64 + fr;
#pragma unroll
        for (int ai = 0; ai < 2; ++ai)
#pragma unroll
            for (int m = 0; m < 4; ++m) { const int row = row0 + ai * 128 + m * 16;
#pragma unroll
                for (int bj = 0; bj < 2; ++bj) { const size_t off = (size_t)row * DM + u.pn * 256 + bj * 128 + wc * 32 + 8 * fq;
                    const v4u g = *(const v4u*)(G + off); const f32x4 v0 = acc[ai][bj][m][0], v1 = acc[ai][bj][m][1];
                    float r[8] = {v0[0] * bflo(g.x), v0[1] * bfhi(g.x), v0[2] * bflo(g.y), v0[3] * bfhi(g.y), v1[0] * bflo(g.z), v1[1] * bfhi(g.z), v1[2] * bflo(g.w), v1[3] * bfhi(g.w)};
                    if (MODE == 1) { const v4u t = *(const v4u*)(Tin + off);
                        r[0] += bflo(t.x); r[1] += bfhi(t.x); r[2] += bflo(t.y); r[3] += bfhi(t.y); r[4] += bflo(t.z); r[5] += bfhi(t.z); r[6] += bflo(t.w); r[7] += bfhi(t.w); }
                    v4u w; w.x = pkbf(r[0], r[1]); w.y = pkbf(r[2], r[3]); w.z = pkbf(r[4], r[5]); w.w = pkbf(r[6], r[7]);
                    *(v4u*)(O + off) = w; } }
    }
};
struct EpiOut {
    static constexpr bool PERM = true, AFTER_DRAIN = false;
    const float* xp; const float* xs; float* H; bf16* HG; const float* gf; float* RSS;
    __device__ __forceinline__ void operator()(const f32x4 (&acc)[2][2][4][2], const Unit& u, int wr, int wc, int fr, int fq) const {
        const int row0 = u.pm * 256 + wr * 64 + fr; const bool prompt = u.pm < (MP / 256);
        f32x4 gv[2][2];
#pragma unroll
        for (int bj = 0; bj < 2; ++bj)
#pragma unroll
            for (int n = 0; n < 2; ++n) gv[bj][n] = *(const f32x4*)(gf + u.pn * 256 + bj * 128 + wc * 32 + 8 * fq + 4 * n);
#pragma unroll
        for (int ai = 0; ai < 2; ++ai)
#pragma unroll
            for (int m = 0; m < 4; ++m) { const int row = row0 + ai * 128 + m * 16; float ss = 0.f;
                const float* xr = prompt ? xp + (size_t)row * DM : xs + (size_t)(row - MP) * DM;
#pragma unroll
                for (int bj = 0; bj < 2; ++bj) { const int col = u.pn * 256 + bj * 128 + wc * 32 + 8 * fq;
                    const f32x4 h0 = acc[ai][bj][m][0] + *(const f32x4*)(xr + col), h1 = acc[ai][bj][m][1] + *(const f32x4*)(xr + col + 4);
                    ss += (h0[0] * h0[0] + h0[1] * h0[1]) + (h0[2] * h0[2] + h0[3] * h0[3]) + (h1[0] * h1[0] + h1[1] * h1[1]) + (h1[2] * h1[2] + h1[3] * h1[3]);
                    *(f32x4*)(H + (size_t)row * DM + col) = h0; *(f32x4*)(H + (size_t)row * DM + col + 4) = h1;
                    const f32x4 a0 = h0 * gv[bj][0], a1 = h1 * gv[bj][1];
                    v4u w; w.x = pkbf(a0[0], a0[1]); w.y = pkbf(a0[2], a0[3]); w.z = pkbf(a1[0], a1[1]); w.w = pkbf(a1[2], a1[3]);
                    *(v4u*)(HG + (size_t)row * DM + col) = w; }
                ss += __shfl_xor(ss, 16); ss += __shfl_xor(ss, 32);
                if (fq == 0) RSS[(size_t)row * 16 + u.pn * 4 + wc] = ss; }
    }
};

struct Frame {
    LAS unsigned char* lds; volatile LAS unsigned* MISC; gu32* ctl;
    int tid, lane, wave, vcu, G;
};

__device__ __forceinline__ void transpose_item(const float* W, int ldw, int K, bf16* WT, int src_col0, int dst_row0, int k0, LAS float* scr, int lane) {
#pragma unroll 8
    for (int i = 0; i < 32; ++i) { const int kk = 2 * i + (lane >> 5); scr[kk * 33 + (lane & 31)] = W[(size_t)(k0 + kk) * ldw + src_col0 + (lane & 31)]; }
    LDS_WAIT(); asm volatile("" ::: "memory");
    const int c = lane & 7;
#pragma unroll
    for (int j = 0; j < 4; ++j) { const int n = (lane >> 3) + 8 * j; const LAS float* s = scr + (8 * c) * 33 + n;
        v4u o; o.x = pkbf(s[0 * 33], s[1 * 33]); o.y = pkbf(s[2 * 33], s[3 * 33]); o.z = pkbf(s[4 * 33], s[5 * 33]); o.w = pkbf(s[6 * 33], s[7 * 33]);
        *(v4u*)(WT + (size_t)(dst_row0 + n) * K + k0 + 8 * c) = o; }
    LDS_WAIT(); asm volatile("" ::: "memory");
}
__device__ __forceinline__ int win_src_col(int db) {
    if (db < 16) return 32 * db;
    if (db < 48) { const int base = db < 32 ? 512 : 1024; const int local = (db - 16) & 15, tile = local >> 3, blk = local & 7, bj = blk >> 2, w = blk & 3; return base + tile * 256 + 64 * w + 32 * bj; }
    if (db < 64) return 1536 + 32 * (db - 48);
    if (db < 96) return 2056 + 32 * (db - 64);
    return 3080 + 32 * (db - 96);
}
__device__ __forceinline__ void cvt_rows_bf16(const float* src, bf16* dst, size_t n8, size_t gtid, size_t gn) {
    for (size_t i = gtid; i < n8; i += gn) { const f32x4 a = *(const f32x4*)(src + 8 * i), b = *(const f32x4*)(src + 8 * i + 4);
        v4u w; w.x = pkbf(a[0], a[1]); w.y = pkbf(a[2], a[3]); w.z = pkbf(b[0], b[1]); w.w = pkbf(b[2], b[3]); *(v4u*)(dst + 8 * i) = w; }
}
__device__ __forceinline__ void p0_prologue(Frame& F, const Args& a) {
    unsigned char* ws = a.ws;
    LAS float* scr = (LAS float*)(F.lds + F.wave * 16384);
    const int gw = F.vcu * NWAVES + F.wave, NGW = F.G * NWAVES;
    for (int it = gw; it < 4096; it += NGW) {
        int r = it;
        if (r < 2048) { const int kb = r >> 7, db = r & 127; transpose_item(a.w_in, DIN, DM, (bf16*)(ws + WS_WIN), win_src_col(db), 32 * db, 64 * kb, scr, F.lane); continue; } r -= 2048;
        if (r < 256) { const int kb = r >> 5, nb = r & 31; transpose_item(a.w_bp, DM, DP, (bf16*)(ws + WS_WBP), 32 * nb, 32 * nb, 64 * kb, scr, F.lane); continue; } r -= 256;
        if (r < 256) { const int kb = r >> 5, nb = r & 31; transpose_item(a.w_ba, DM, DA, (bf16*)(ws + WS_WBA), 32 * nb, 32 * nb, 64 * kb, scr, F.lane); continue; } r -= 256;
        if (r < 512) { const int kb = r >> 5, nb = r & 31; transpose_item(a.w_out, DM, DM, (bf16*)(ws + WS_WOUT), 32 * nb, 32 * nb, 64 * kb, scr, F.lane); continue; } r -= 512;
        { const int kb = r >> 6, nb = r & 63; transpose_item(a.w_query, DQ, DM, (bf16*)(ws + WS_WQ), 32 * nb, 32 * nb, 64 * kb, scr, F.lane); }
    }
    { const size_t gtid = (size_t)F.vcu * NTHR + F.tid, gn = (size_t)F.G * NTHR;
      cvt_rows_bf16(a.peer_u, (bf16*)(ws + WS_PU), (size_t)NEXP * DM / 8, gtid, gn);
      cvt_rows_bf16(a.peer_v, (bf16*)(ws + WS_PV), (size_t)NEXP * DM / 8, gtid, gn);
      cvt_rows_bf16(a.sub_keys, (bf16*)(ws + WS_SUBK), (size_t)PH * 2 * NKEYS * DKH / 8, gtid, gn);
      for (size_t i = gtid; i < (size_t)DB * 7 * DP; i += gn) { const int b = (int)(i / (7 * DP)), j = (int)((i / DP) % 7), c = (int)(i % DP);
          a.out[O_PS + (size_t)(b * 15 + j) * DP + c] = a.state_pool[(size_t)(b * 15 + 8 + j) * DP + c]; } }
    __syncthreads();
    LAS float* wfT = (LAS float*)F.lds;
    for (int i = F.tid; i < 8 * DM; i += NTHR) { const int col = i >> 3, h = i & 7; wfT[h * DM + col] = a.w_in[(size_t)col * DIN + 2048 + h]; }
    __syncthreads();
    bf16* XN = (bf16*)(ws + WS_XN);
    for (int row = gw; row < M; row += NGW) {
        const float* xr = row < MP ? a.x_p + (size_t)row * DM : a.x_s + (size_t)(row - MP) * DM;
        f32x4 v[4]; float ss = 0.f;
#pragma unroll
        for (int j = 0; j < 4; ++j) { v[j] = *(const f32x4*)(xr + 256 * j + 4 * F.lane); ss += (v[j][0] * v[j][0] + v[j][1] * v[j][1]) + (v[j][2] * v[j][2] + v[j][3] * v[j][3]); }
        const float r = 1.0f / sqrtf(wave_sum(ss) * (1.0f / DM) + EPS);
        float f[8];
#pragma unroll
        for (int h = 0; h < 8; ++h) f[h] = 0.f;
#pragma unroll
        for (int j = 0; j < 4; ++j) { const f32x4 g = *(const f32x4*)(a.norm_mix_g + 256 * j + 4 * F.lane); v[j] = v[j] * r * g;
            v2u w; w.x = pkbf(v[j][0], v[j][1]); w.y = pkbf(v[j][2], v[j][3]); *(v2u*)(XN + (size_t)row * DM + 256 * j + 4 * F.lane) = w;
#pragma unroll
            for (int h = 0; h < 8; ++h) { const f32x4 wv = *(const LAS f32x4*)(wfT + h * DM + 256 * j + 4 * F.lane); f[h] += (v[j][0] * wv[0] + v[j][1] * wv[1]) + (v[j][2] * wv[2] + v[j][3] * wv[3]); } }
        float mine = 0.f;
#pragma unroll
        for (int h = 0; h < 8; ++h) { const float s = wave_sum(f[h]); if (F.lane == h) mine = s; }
        if (F.lane < 8) { const float z = mine + a.b_forget[F.lane]; const float lf = fminf(z, 0.f) - log1pf(expf(-fabsf(z)));
            if (row < MP) a.out[O_LFP + (size_t)row * NH + F.lane] = lf; else a.out[O_LFS + (size_t)(row - MP) * NH + F.lane] = lf; }
    }
}

__device__ __forceinline__ void p2_cumsum_pool(Frame& F, const Args& a) {
    unsigned char* ws = a.ws;
    { const int gw = F.vcu * NWAVES + F.wave; float* CP2 = (float*)(ws + WS_CP2);
      if (gw < NB * NH) { const int b = gw >> 3, h = gw & 7; float carry = 0.f;
          for (int c = 0; c < SEQ / 64; ++c) { float v = a.out[O_LFP + (size_t)(b * SEQ + c * 64 + F.lane) * NH + h];
#pragma unroll
              for (int o = 1; o < 64; o <<= 1) { const float t = __shfl_up(v, o); if (F.lane >= o) v += t; }
              v += carry; CP2[(size_t)gw * SEQ + c * 64 + F.lane] = v * LOG2E; carry = __shfl(v, 63); } } }
    const bf16* U = (const bf16*)(ws + WS_U); bf16* PO = (bf16*)(ws + WS_PO);
    LAS float* pw = (LAS float*)F.lds;
    LAS float* mt = (LAS float*)(F.lds + 65536);
    int cur_g = -1;
    for (int unit = blockIdx.x; unit < 4 * (M / 32); unit += F.G) {
        const int g = unit / (M / 32), tile = unit % (M / 32);
        __syncthreads();
        if (g != cur_g) { for (int i = F.tid; i < 128 * 128 / 4; i += NTHR) *(LAS f32x4*)(pw + 4 * i) = *(const f32x4*)(a.pool_mix_w + (size_t)g * 16384 + 4 * i); cur_g = g; }
        { const int r = F.tid >> 4, c8 = (F.tid & 15) * 8, ch = g * 128 + c8, row = tile * 32 + r, w = 2 << g;
          float sum[8], self[8];
#pragma unroll
          for (int i = 0; i < 8; ++i) sum[i] = 0.f;
          float cnt;
          if (row < MP) { const int s = row & (SEQ - 1); cnt = (float)(s + 1 < w ? s + 1 : w);
              for (int i = 0; i < w; ++i) if (s - i >= 0) { const v4u q = *(const v4u*)(U + (size_t)(row - i) * DP + ch);
                  const float e[8] = {bflo(q.x), bfhi(q.x), bflo(q.y), bfhi(q.y), bflo(q.z), bfhi(q.z), bflo(q.w), bfhi(q.w)};
#pragma unroll
                  for (int k = 0; k < 8; ++k) { sum[k] += e[k]; if (i == 0) self[k] = e[k]; } }
          } else { const int rs = row - MP, b = rs >> 3, t = rs & 7; cnt = (float)w;
              for (int i = 0; i < w; ++i) { const int tt = t - i; float e[8];
                  if (tt >= 0) { const v4u q = *(const v4u*)(U + (size_t)(MP + b * 8 + tt) * DP + ch);
                      e[0] = bflo(q.x); e[1] = bfhi(q.x); e[2] = bflo(q.y); e[3] = bfhi(q.y); e[4] = bflo(q.z); e[5] = bfhi(q.z); e[6] = bflo(q.w); e[7] = bfhi(q.w); }
                  else { const f32x4 p0 = *(const f32x4*)(a.state_pool + (size_t)(b * 15 + 15 + tt) * DP + ch), p1 = *(const f32x4*)(a.state_pool + (size_t)(b * 15 + 15 + tt) * DP + ch + 4);
                      e[0] = p0[0]; e[1] = p0[1]; e[2] = p0[2]; e[3] = p0[3]; e[4] = p1[0]; e[5] = p1[1]; e[6] = p1[2]; e[7] = p1[3]; }
#pragma unroll
                  for (int k = 0; k < 8; ++k) { sum[k] += e[k]; if (i == 0) self[k] = e[k]; } } }
          const float inv = 1.0f / cnt;
#pragma unroll
          for (int k = 0; k < 8; ++k) mt[r * 132 + c8 + k] = sum[k] * inv - self[k]; }
        __syncthreads();
        { const int r = F.tid >> 4, d8 = (F.tid & 15) * 8, row = tile * 32 + r; float acc[8];
#pragma unroll
          for (int k = 0; k < 8; ++k) acc[k] = 0.f;
#pragma unroll 4
          for (int c = 0; c < 128; ++c) { const float mv = mt[r * 132 + c]; const f32x4 w0 = *(const LAS f32x4*)(pw + c * 128 + d8), w1 = *(const LAS f32x4*)(pw + c * 128 + d8 + 4);
              acc[0] += mv * w0[0]; acc[1] += mv * w0[1]; acc[2] += mv * w0[2]; acc[3] += mv * w0[3]; acc[4] += mv * w1[0]; acc[5] += mv * w1[1]; acc[6] += mv * w1[2]; acc[7] += mv * w1[3]; }
          const f32x4 s0 = *(const f32x4*)(a.pool_scale + g * 128 + d8), s1 = *(const f32x4*)(a.pool_scale + g * 128 + d8 + 4);
          v4u o; o.x = pkbf(acc[0] * s0[0], acc[1] * s0[1]); o.y = pkbf(acc[2] * s0[2], acc[3] * s0[3]); o.z = pkbf(acc[4] * s1[0], acc[5] * s1[1]); o.w = pkbf(acc[6] * s1[2], acc[7] * s1[3]);
          *(v4u*)(PO + (size_t)row * DP + g * 128 + d8) = o; }
    }
}

__device__ __forceinline__ float attn_bound2(const Args& a, int lane) {
    const float gq = wave_max(fabsf(a.q_norm_g[lane])), gk = wave_max(fabsf(a.k_norm_g[lane]));
    return 64.0f * C2 * gq * gk * 1.03f;
}

__device__ __forceinline__ void p3_prompt_attn_naive(Frame& F, const Args& a) {
    unsigned char* ws = a.ws;
    const bf16* Q = (const bf16*)(ws + WS_Q); const bf16* K = (const bf16*)(ws + WS_K); const bf16* V = (const bf16*)(ws + WS_V); bf16* AO = (bf16*)(ws + WS_AO);
    const float* CP2 = (const float*)(ws + WS_CP2);
    LAS float* Ks = (LAS float*)F.lds;
    LAS float* Vs = (LAS float*)(F.lds + 16384);
    LAS float* cks = (LAS float*)(F.lds + 32768);
    const float M2 = attn_bound2(a, F.lane);
    for (int unit = blockIdx.x; unit < NB * NH * (SEQ / 512); unit += F.G) {
        const int bh = unit & 31, qblk = 7 - (unit >> 5), b = bh >> 3, h = bh & 7;
        const int i = qblk * 512 + F.tid; const size_t qrow = (size_t)(b * SEQ + i);
        float q[64], o[64];
#pragma unroll
        for (int d8 = 0; d8 < 8; ++d8) { const v4u w = *(const v4u*)(Q + qrow * DA + h * 64 + d8 * 8);
            q[d8 * 8 + 0] = bflo(w.x); q[d8 * 8 + 1] = bfhi(w.x); q[d8 * 8 + 2] = bflo(w.y); q[d8 * 8 + 3] = bfhi(w.y); q[d8 * 8 + 4] = bflo(w.z); q[d8 * 8 + 5] = bfhi(w.z); q[d8 * 8 + 6] = bflo(w.w); q[d8 * 8 + 7] = bfhi(w.w); }
#pragma unroll
        for (int d = 0; d < 64; ++d) o[d] = 0.f;
        const float cq = CP2[(size_t)bh * SEQ + i] - M2; float l = 0.f;
        const int ntile = (qblk + 1) * 8;
        for (int jt = 0; jt < ntile; ++jt) {
            __syncthreads();
            { const int kr = F.tid >> 3, d8 = (F.tid & 7) * 8; const size_t krow = (size_t)(b * SEQ + jt * 64 + kr);
              const v4u kw = *(const v4u*)(K + krow * DA + h * 64 + d8), vw = *(const v4u*)(V + krow * DA + h * 64 + d8);
              LAS float* kd = Ks + kr * 64 + d8; LAS float* vd = Vs + kr * 64 + d8;
              *(LAS f32x4*)kd = (f32x4){bflo(kw.x), bfhi(kw.x), bflo(kw.y), bfhi(kw.y)}; *(LAS f32x4*)(kd + 4) = (f32x4){bflo(kw.z), bfhi(kw.z), bflo(kw.w), bfhi(kw.w)};
              *(LAS f32x4*)vd = (f32x4){bflo(vw.x), bfhi(vw.x), bflo(vw.y), bfhi(vw.y)}; *(LAS f32x4*)(vd + 4) = (f32x4){bflo(vw.z), bfhi(vw.z), bflo(vw.w), bfhi(vw.w)};
              if (F.tid < 64) cks[F.tid] = CP2[(size_t)bh * SEQ + jt * 64 + F.tid]; }
            __syncthreads();
            for (int j = 0; j < 64; ++j) {
                float s = 0.f;
#pragma unroll
                for (int d4 = 0; d4 < 16; ++d4) { const f32x4 kv = *(const LAS f32x4*)(Ks + j * 64 + d4 * 4); s += (q[d4 * 4] * kv[0] + q[d4 * 4 + 1] * kv[1]) + (q[d4 * 4 + 2] * kv[2] + q[d4 * 4 + 3] * kv[3]); }
                float p = __builtin_amdgcn_exp2f(s + cq - cks[j]); if (jt * 64 + j > i) p = 0.f;
                l += p;
#pragma unroll
                for (int d4 = 0; d4 < 16; ++d4) { const f32x4 vv = *(const LAS f32x4*)(Vs + j * 64 + d4 * 4); o[d4 * 4] += p * vv[0]; o[d4 * 4 + 1] += p * vv[1]; o[d4 * 4 + 2] += p * vv[2]; o[d4 * 4 + 3] += p * vv[3]; }
            }
        }
        const float il = 1.0f / l;
#pragma unroll
        for (int d8 = 0; d8 < 8; ++d8) { v4u w; w.x = pkbf(o[d8 * 8] * il, o[d8 * 8 + 1] * il); w.y = pkbf(o[d8 * 8 + 2] * il, o[d8 * 8 + 3] * il); w.z = pkbf(o[d8 * 8 + 4] * il, o[d8 * 8 + 5] * il); w.w = pkbf(o[d8 * 8 + 6] * il, o[d8 * 8 + 7] * il);
            *(v4u*)(AO + qrow * DA + h * 64 + d8 * 8) = w; }
    }
}

__device__ __forceinline__ void p3_sample_attn(Frame& F, const Args& a) {
    unsigned char* ws = a.ws;
    const bf16* Q = (const bf16*)(ws + WS_Q); bf16* AO = (bf16*)(ws + WS_AO);
    LAS float* qs = (LAS float*)F.lds;
    LAS float* lfp = (LAS float*)(F.lds + 2048);
    LAS float* E2 = (LAS float*)(F.lds + 2048 + 8192);
    LAS float* sc = (LAS float*)(F.lds + 12288);
    LAS float* Op = (LAS float*)(F.lds + 12288 + 16384);
    LAS float* lp = (LAS float*)(F.lds + 12288 + 32768);
    const float M2 = attn_bound2(a, F.lane);
    const int lane = F.lane, w = F.wave;
    for (int unit = blockIdx.x; unit < DB * NH; unit += F.G) {
        const int b = unit >> 3, h = unit & 7;
        __syncthreads();
        { const int t = F.tid >> 6, d = F.tid & 63; qs[t * 64 + d] = bf2f(Q[(size_t)(MP + b * 8 + t) * DA + h * 64 + d]); }
        for (int j = F.tid; j < PAST; j += NTHR) { const int pg = a.page_table[b * NPAGES + (j >> 7)]; lfp[j] = a.cache_lf[((size_t)pg * PAGE + (j & 127)) * NH + h]; }
        __syncthreads();
        if (w == 0) {
            float loc[32]; float tot = 0.f;
#pragma unroll
            for (int k = 31; k >= 0; --k) { loc[k] = tot; tot += lfp[lane * 32 + k]; }
            float inc = tot;
#pragma unroll
            for (int o = 1; o < 64; o <<= 1) { const float t = __shfl_down(inc, o); if (lane + o < 64) inc += t; }
            const float excl = inc - tot;
#pragma unroll
            for (int k = 0; k < 32; ++k) lfp[lane * 32 + k] = (loc[k] + excl) * LOG2E;
            if (lane < 8) { float e = 0.f; for (int t = 0; t <= lane; ++t) e += a.out[O_LFS + (size_t)(b * 8 + t) * NH + h]; E2[lane] = e * LOG2E; }
        }
        __syncthreads();
        f32x4 qp[8];
#pragma unroll
        for (int t = 0; t < 8; ++t) qp[t] = *(const LAS f32x4*)(qs + t * 64 + 4 * (lane & 15));
        float e2[8];
#pragma unroll
        for (int t = 0; t < 8; ++t) e2[t] = E2[t] - M2;
        float o[8], lsum[8];
#pragma unroll
        for (int t = 0; t < 8; ++t) { o[t] = 0.f; lsum[t] = 0.f; }
        LAS float* scw = sc + w * 512;
        const int nblk = (w == 0) ? 5 : 4;
        for (int blk = 0; blk < nblk; ++blk) {
            const bool isnew = blk == 4;
            for (int gi = 0; gi < (isnew ? 2 : 16); ++gi) {
                const int kk = 4 * gi + (lane >> 4);
                const float* kp;
                if (!isnew) { const int j = w * 256 + blk * 64 + kk; const int pg = a.page_table[b * NPAGES + (j >> 7)]; kp = a.cache_k + (((size_t)pg * PAGE + (j & 127)) * NH + h) * HD; }
                else kp = a.out + O_KS + (size_t)(b * 8 + kk) * DA + h * HD;
                const f32x4 k4 = *(const f32x4*)(kp + 4 * (lane & 15));
                float part[8];
#pragma unroll
                for (int t = 0; t < 8; ++t) part[t] = (qp[t][0] * k4[0] + qp[t][1] * k4[1]) + (qp[t][2] * k4[2] + qp[t][3] * k4[3]);
#pragma unroll
                for (int t = 0; t < 8; ++t) { part[t] += __shfl_xor(part[t], 1); part[t] += __shfl_xor(part[t], 2); part[t] += __shfl_xor(part[t], 4); part[t] += __shfl_xor(part[t], 8); }
                float mine = 0.f;
#pragma unroll
                for (int t = 0; t < 8; ++t) if ((lane & 15) == t) mine = part[t];
                if ((lane & 15) < 8) scw[kk * 8 + (lane & 15)] = mine;
            }
            LDS_WAIT(); asm volatile("" ::: "memory");
            { f32x4 s0 = *(const LAS f32x4*)(scw + lane * 8), s1 = *(const LAS f32x4*)(scw + lane * 8 + 4); float p[8];
              const float sv[8] = {s0[0], s0[1], s0[2], s0[3], s1[0], s1[1], s1[2], s1[3]};
              if (!isnew) { const float dj = lfp[w * 256 + blk * 64 + lane];
#pragma unroll
                  for (int t = 0; t < 8; ++t) p[t] = __builtin_amdgcn_exp2f(sv[t] + e2[t] + dj);
              } else {
#pragma unroll
                  for (int t = 0; t < 8; ++t) { const float ek = E2[lane & 7]; p[t] = (lane <= t) ? __builtin_amdgcn_exp2f(sv[t] + e2[t] - ek) : 0.f; }
              }
#pragma unroll
              for (int t = 0; t < 8; ++t) lsum[t] += p[t];
              *(LAS f32x4*)(scw + lane * 8) = (f32x4){p[0], p[1], p[2], p[3]}; *(LAS f32x4*)(scw + lane * 8 + 4) = (f32x4){p[4], p[5], p[6], p[7]}; }
            LDS_WAIT(); asm volatile("" ::: "memory");
            for (int kk = 0; kk < (isnew ? 8 : 64); ++kk) {
                const float* vp;
                if (!isnew) { const int j = w * 256 + blk * 64 + kk; const int pg = a.page_table[b * NPAGES + (j >> 7)]; vp = a.cache_v + (((size_t)pg * PAGE + (j & 127)) * NH + h) * HD; }
                else vp = a.out + O_VS + (size_t)(b * 8 + kk) * DA + h * HD;
                const float vv = vp[lane];
                const f32x4 p0 = *(const LAS f32x4*)(scw + kk * 8), p1 = *(const LAS f32x4*)(scw + kk * 8 + 4);
                o[0] += p0[0] * vv; o[1] += p0[1] * vv; o[2] += p0[2] * vv; o[3] += p0[3] * vv; o[4] += p1[0] * vv; o[5] += p1[1] * vv; o[6] += p1[2] * vv; o[7] += p1[3] * vv;
            }
            LDS_WAIT(); asm volatile("" ::: "memory");
        }
#pragma unroll
        for (int t = 0; t < 8; ++t) { Op[(w * 8 + t) * 64 + lane] = o[t]; const float ls = wave_sum(lsum[t]); if (lane == 0) lp[w * 8 + t] = ls; }
        __syncthreads();
        { const int t = F.tid >> 6, d = F.tid & 63; float O = 0.f, L = 0.f;
#pragma unroll
          for (int ww = 0; ww < 8; ++ww) { O += Op[(ww * 8 + t) * 64 + d]; L += lp[ww * 8 + t]; }
          AO[(size_t)(MP + b * 8 + t) * DA + h * 64 + d] = (bf16)(pkbf(O / L, 0.f) & 0xffffu); }
    }
}

__device__ __forceinline__ void p7_topk_naive(Frame& F, const Args& a) {
    unsigned char* ws = a.ws;
    const bf16* PQ = (const bf16*)(ws + WS_PQ); const bf16* SK = (const bf16*)(ws + WS_SUBK); const float* RSS = (const float*)(ws + WS_RSS);
    int* SI = (int*)(ws + WS_SI); float* SG = (float*)(ws + WS_SG);
    LAS float* kT = (LAS float*)F.lds;
    LAS float* qt = (LAS float*)(F.lds + 67584);
    LAS float* sc = (LAS float*)(F.lds + 83968);
    LAS float* tps = (LAS float*)(F.lds + 100352);
    LAS int* tpi = (LAS int*)(F.lds + 100352 + 4096);
    LAS float* fs = (LAS float*)(F.lds + 100352 + 8192);
    LAS float* rs = (LAS float*)(F.lds + 100352 + 8192 + 2048);
    LAS int* cab = (LAS int*)(F.lds + 100352 + 8192 + 2048 + 128);
    if (F.tid == 0) { int n = 0; for (int ca = 0; ca < 16; ++ca) for (int cb = 0; cb < 16; ++cb) if ((ca + 1) * (cb + 1) <= 16) cab[n++] = (ca << 4) | cb; }
    for (int unit = blockIdx.x; unit < (M / 32) * PH; unit += F.G) {
        const int h = unit & 7, tile = unit >> 3, row0 = tile * 32;
        for (int p = 0; p < 2; ++p) {
            __syncthreads();
            for (int i = F.tid; i < 128 * 128 / 8; i += NTHR) { const int n = i >> 4, d8 = (i & 15) * 8; const v4u wv = *(const v4u*)(SK + ((size_t)(h * 2 + p) * NKEYS + n) * DKH + d8);
                kT[(d8 + 0) * 132 + n] = bflo(wv.x); kT[(d8 + 1) * 132 + n] = bfhi(wv.x); kT[(d8 + 2) * 132 + n] = bflo(wv.y); kT[(d8 + 3) * 132 + n] = bfhi(wv.y);
                kT[(d8 + 4) * 132 + n] = bflo(wv.z); kT[(d8 + 5) * 132 + n] = bfhi(wv.z); kT[(d8 + 6) * 132 + n] = bflo(wv.w); kT[(d8 + 7) * 132 + n] = bfhi(wv.w); }
            { const int t = F.tid >> 4, d8 = (F.tid & 15) * 8; const v4u wv = *(const v4u*)(PQ + (size_t)(row0 + t) * DQ + h * 256 + p * 128 + d8);
              *(LAS f32x4*)(qt + t * 128 + d8) = (f32x4){bflo(wv.x), bfhi(wv.x), bflo(wv.y), bfhi(wv.y)}; *(LAS f32x4*)(qt + t * 128 + d8 + 4) = (f32x4){bflo(wv.z), bfhi(wv.z), bflo(wv.w), bfhi(wv.w)}; }
            if (p == 0 && F.tid < 32) { float s = 0.f; for (int k = 0; k < 16; ++k) s += RSS[(size_t)(row0 + F.tid) * 16 + k]; rs[F.tid] = 1.0f / sqrtf(s * (1.0f / DM) + EPS); }
            __syncthreads();
            const int t = F.tid >> 4, kq = (F.tid & 15) * 8;
            float acc[8];
#pragma unroll
            for (int k = 0; k < 8; ++k) acc[k] = 0.f;
#pragma unroll 4
            for (int d = 0; d < 128; ++d) { const float qv = qt[t * 128 + d]; const f32x4 k0 = *(const LAS f32x4*)(kT + d * 132 + kq), k1 = *(const LAS f32x4*)(kT + d * 132 + kq + 4);
                acc[0] += qv * k0[0]; acc[1] += qv * k0[1]; acc[2] += qv * k0[2]; acc[3] += qv * k0[3]; acc[4] += qv * k1[0]; acc[5] += qv * k1[1]; acc[6] += qv * k1[2]; acc[7] += qv * k1[3]; }
            *(LAS f32x4*)(sc + t * 128 + kq) = (f32x4){acc[0], acc[1], acc[2], acc[3]}; *(LAS f32x4*)(sc + t * 128 + kq + 4) = (f32x4){acc[4], acc[5], acc[6], acc[7]};
            __syncthreads();
            int rank[8];
#pragma unroll
            for (int k = 0; k < 8; ++k) rank[k] = 0;
            for (int j = 0; j < 128; ++j) { const float sj = sc[t * 128 + j];
#pragma unroll
                for (int k = 0; k < 8; ++k) rank[k] += (sj > acc[k] || (sj == acc[k] && j < kq + k)) ? 1 : 0; }
#pragma unroll
            for (int k = 0; k < 8; ++k) if (rank[k] < 16) { tps[(p * 32 + t) * 16 + rank[k]] = acc[k]; tpi[(p * 32 + t) * 16 + rank[k]] = kq + k; }
        }
        __syncthreads();
        { const int t = F.tid >> 4, l16 = F.tid & 15;
          float cs[4]; int cf[4], ci[4], rk[4];
#pragma unroll
          for (int k = 0; k < 4; ++k) { const int c = l16 + 16 * k; if (c < 50) { const int ab = cab[c], ca = ab >> 4, cb = ab & 15; cs[k] = tps[t * 16 + ca] + tps[(32 + t) * 16 + cb]; cf[k] = ab; ci[k] = tpi[t * 16 + ca] * NKEYS + tpi[(32 + t) * 16 + cb]; }
              else { cs[k] = -INFINITY; cf[k] = 1 << 20; ci[k] = 0; } rk[k] = 0; }
          for (int c = 0; c < 50; ++c) { const int ab = cab[c]; const float s = tps[t * 16 + (ab >> 4)] + tps[(32 + t) * 16 + (ab & 15)];
#pragma unroll
              for (int k = 0; k < 4; ++k) rk[k] += (s > cs[k] || (s == cs[k] && ab < cf[k])) ? 1 : 0; }
#pragma unroll
          for (int k = 0; k < 4; ++k) if (l16 + 16 * k < 50 && rk[k] < 16) { fs[t * 16 + rk[k]] = cs[k]; SI[(size_t)(row0 + t) * 128 + h * 16 + rk[k]] = ci[k]; }
        }
        __syncthreads();
        { const int t = F.tid >> 4, l16 = F.tid & 15; const float z = fs[t * 16 + l16] * rs[t];
          float mx = z; mx = fmaxf(mx, __shfl_xor(mx, 1)); mx = fmaxf(mx, __shfl_xor(mx, 2)); mx = fmaxf(mx, __shfl_xor(mx, 4)); mx = fmaxf(mx, __shfl_xor(mx, 8));
          const float e = expf(z - mx); float sm = e; sm += __shfl_xor(sm, 1); sm += __shfl_xor(sm, 2); sm += __shfl_xor(sm, 4); sm += __shfl_xor(sm, 8);
          SG[(size_t)(row0 + t) * 128 + h * 16 + l16] = e / sm; }
    }
}

__device__ __forceinline__ void p8_gather_naive(Frame& F, const Args& a) {
    unsigned char* ws = a.ws;
    const bf16* HG = (const bf16*)(ws + WS_XN); const bf16* PU = (const bf16*)(ws + WS_PU); const bf16* PV = (const bf16*)(ws + WS_PV);
    const float* RSS = (const float*)(ws + WS_RSS); const int* SI = (const int*)(ws + WS_SI); const float* SG = (const float*)(ws + WS_SG);
    float* Y = a.out + O_YP;
    LAS float* wl = (LAS float*)(F.lds + F.wave * 512);
    const int gw = F.vcu * NWAVES + F.wave, NGW = F.G * NWAVES, lane = F.lane;
    for (int row = gw; row < M; row += NGW) {
        float hx[16];
        { const v4u a0 = *(const v4u*)(HG + (size_t)row * DM + 8 * lane), a1 = *(const v4u*)(HG + (size_t)row * DM + 512 + 8 * lane);
          hx[0] = bflo(a0.x); hx[1] = bfhi(a0.x); hx[2] = bflo(a0.y); hx[3] = bfhi(a0.y); hx[4] = bflo(a0.z); hx[5] = bfhi(a0.z); hx[6] = bflo(a0.w); hx[7] = bfhi(a0.w);
          hx[8] = bflo(a1.x); hx[9] = bfhi(a1.x); hx[10] = bflo(a1.y); hx[11] = bfhi(a1.y); hx[12] = bflo(a1.z); hx[13] = bfhi(a1.z); hx[14] = bflo(a1.w); hx[15] = bfhi(a1.w); }
        float ssum = (lane < 16) ? RSS[(size_t)row * 16 + lane] : 0.f; ssum = wave_sum(ssum);
        const float rstd = 1.0f / sqrtf(ssum * (1.0f / DM) + EPS);
        const int e0 = SI[(size_t)row * 128 + lane], e1 = SI[(size_t)row * 128 + 64 + lane];
        const float g0 = SG[(size_t)row * 128 + lane], g1 = SG[(size_t)row * 128 + 64 + lane];
#pragma unroll 4
        for (int k = 0; k < 128; ++k) {
            const int e = __shfl(k < 64 ? e0 : e1, k & 63);
            const v4u u0 = *(const v4u*)(PU + (size_t)e * DM + 8 * lane), u1 = *(const v4u*)(PU + (size_t)e * DM + 512 + 8 * lane);
            float d = (hx[0] * bflo(u0.x) + hx[1] * bfhi(u0.x)) + (hx[2] * bflo(u0.y) + hx[3] * bfhi(u0.y)) + (hx[4] * bflo(u0.z) + hx[5] * bfhi(u0.z)) + (hx[6] * bflo(u0.w) + hx[7] * bfhi(u0.w))
                    + (hx[8] * bflo(u1.x) + hx[9] * bfhi(u1.x)) + (hx[10] * bflo(u1.y) + hx[11] * bfhi(u1.y)) + (hx[12] * bflo(u1.z) + hx[13] * bfhi(u1.z)) + (hx[14] * bflo(u1.w) + hx[15] * bfhi(u1.w));
            d = wave_sum(d);
            if (lane == (k & 63)) { const float z = d * rstd; const float ge = 0.5f * z * (1.0f + erff(z * 0.70710678118654752f)); wl[k] = ge * (k < 64 ? g0 : g1); }
        }
        LDS_WAIT(); asm volatile("" ::: "memory");
        float o[16];
#pragma unroll
        for (int i = 0; i < 16; ++i) o[i] = 0.f;
#pragma unroll 4
        for (int k = 0; k < 128; ++k) {
            const int e = __shfl(k < 64 ? e0 : e1, k & 63); const float wv = wl[k];
            const v4u u0 = *(const v4u*)(PV + (size_t)e * DM + 8 * lane), u1 = *(const v4u*)(PV + (size_t)e * DM + 512 + 8 * lane);
            o[0] += wv * bflo(u0.x); o[1] += wv * bfhi(u0.x); o[2] += wv * bflo(u0.y); o[3] += wv * bfhi(u0.y); o[4] += wv * bflo(u0.z); o[5] += wv * bfhi(u0.z); o[6] += wv * bflo(u0.w); o[7] += wv * bfhi(u0.w);
            o[8] += wv * bflo(u1.x); o[9] += wv * bfhi(u1.x); o[10] += wv * bflo(u1.y); o[11] += wv * bfhi(u1.y); o[12] += wv * bflo(u1.z); o[13] += wv * bfhi(u1.z); o[14] += wv * bflo(u1.w); o[15] += wv * bfhi(u1.w);
        }
        LDS_WAIT(); asm volatile("" ::: "memory");
        float* yr = Y + (size_t)row * DM;
        { f32x4 y0 = *(f32x4*)(yr + 8 * lane), y1 = *(f32x4*)(yr + 8 * lane + 4), y2 = *(f32x4*)(yr + 512 + 8 * lane), y3 = *(f32x4*)(yr + 512 + 8 * lane + 4);
          y0 += (f32x4){o[0], o[1], o[2], o[3]}; y1 += (f32x4){o[4], o[5], o[6], o[7]}; y2 += (f32x4){o[8], o[9], o[10], o[11]}; y3 += (f32x4){o[12], o[13], o[14], o[15]};
          *(f32x4*)(yr + 8 * lane) = y0; *(f32x4*)(yr + 8 * lane + 4) = y1; *(f32x4*)(yr + 512 + 8 * lane) = y2; *(f32x4*)(yr + 512 + 8 * lane + 4) = y3; }
    }
}

constexpr int N_PHASES = 9;
#ifndef MK_PER_PHASE
#define MK_PER_PHASE 0
#endif
__global__ void __launch_bounds__(NTHR, 2) fwd_kernel(Args args) {
    extern __shared__ __attribute__((aligned(16))) unsigned char lds[];
    Frame F;
    F.lds = (LAS unsigned char*)lds; F.MISC = (volatile LAS unsigned*)(F.lds + MISC_OFF);
    F.tid = threadIdx.x; F.lane = F.tid & 63; F.wave = __builtin_amdgcn_readfirstlane(F.tid >> 6);
    F.G = gridDim.x; { const int bx = blockIdx.x; F.vcu = (F.G % 8 == 0) ? (bx % 8) * (F.G / 8) + bx / 8 : bx; }
    F.ctl = (gu32*)(args.ws + WS_CTL);
    for (int u = F.tid; u < (LDS_BYTES - MISC_OFF) / 4; u += NTHR) ((LAS unsigned*)(F.lds + MISC_OFF))[u] = 0u;
    __syncthreads();
#if MK_PER_PHASE
#define GRID_BAR() do { } while (0)
#else
    XcdBarrier bar = xcd_barrier_post((unsigned*)(F.ctl + CW_BAR), F.MISC + 8);
#define GRID_BAR() xcd_barrier(bar)
#endif
    unsigned char* ws = args.ws;
    const int lo = args.ph_lo, hi = args.ph_hi;
#define IN(k) (lo <= (k) && (k) < hi)
#define BOTH(k) (IN(k) && IN((k) + 1))
    if (IN(0)) { p0_prologue(F, args); if (BOTH(0)) GRID_BAR(); }
    if (IN(1)) {
        pg8::Gemm g{(const bf16*)(ws + WS_XN), (const bf16*)(ws + WS_WIN), M, NPROJ, DM}; pg8::StaticOrder S; S.init(M, NPROJ, F.G, (int)blockIdx.x);
        EpiInProj E{(bf16*)(ws + WS_U), (bf16*)(ws + WS_Q), (bf16*)(ws + WS_K), (bf16*)(ws + WS_V), (bf16*)(ws + WS_GA), (bf16*)(ws + WS_GB), args.out, args.q_norm_g, args.k_norm_g};
        pg8::gemm_phase<EpiInProj, pg8::StaticOrder, true, true>(F.lds, g, S, E);
        if (BOTH(1)) GRID_BAR();
    }
    if (IN(2)) { p2_cumsum_pool(F, args); if (BOTH(2)) GRID_BAR(); }
    if (IN(3)) { p3_prompt_attn_naive(F, args); p3_sample_attn(F, args); if (BOTH(3)) GRID_BAR(); }
    if (IN(4)) {
        { pg8::Gemm g{(const bf16*)(ws + WS_PO), (const bf16*)(ws + WS_WBP), M, DM, DP}; pg8::StaticOrder S; S.init(M, DM, F.G, (int)blockIdx.x);
          EpiGate<0> E{(const bf16*)(ws + WS_GA), nullptr, (bf16*)(ws + WS_T)};
          pg8::gemm_phase<EpiGate<0>, pg8::StaticOrder, true, true>(F.lds, g, S, E); }
        __syncthreads();
        { pg8::Gemm g{(const bf16*)(ws + WS_AO), (const bf16*)(ws + WS_WBA), M, DM, DA}; pg8::StaticOrder S; S.init(M, DM, F.G, (int)blockIdx.x);
          EpiGate<1> E{(const bf16*)(ws + WS_GB), (const bf16*)(ws + WS_T), (bf16*)(ws + WS_MIX)};
          pg8::gemm_phase<EpiGate<1>, pg8::StaticOrder, true, true>(F.lds, g, S, E); }
        if (BOTH(4)) GRID_BAR();
    }
    if (IN(5)) {
        pg8::Gemm g{(const bf16*)(ws + WS_MIX), (const bf16*)(ws + WS_WOUT), M, DM, DM}; pg8::StaticOrder S; S.init(M, DM, F.G, (int)blockIdx.x);
        EpiOut E{args.x_p, args.x_s, args.out + O_YP, (bf16*)(ws + WS_XN), args.norm_ffn_g, (float*)(ws + WS_RSS)};
        pg8::gemm_phase<EpiOut, pg8::StaticOrder, true, true>(F.lds, g, S, E);
        if (BOTH(5)) GRID_BAR();
    }
    if (IN(6)) {
        pg8::Gemm g{(const bf16*)(ws + WS_XN), (const bf16*)(ws + WS_WQ), M, DQ, DM}; pg8::StaticOrder S; S.init(M, DQ, F.G, (int)blockIdx.x);
        pg8::EpiBf16<0> E{(bf16*)(ws + WS_PQ), DQ, nullptr, 0, 0, 1.f};
        pg8::gemm_phase<pg8::EpiBf16<0>, pg8::StaticOrder, true, true>(F.lds, g, S, E);
        if (BOTH(6)) GRID_BAR();
    }
    if (IN(7)) { p7_topk_naive(F, args); if (BOTH(7)) GRID_BAR(); }
    if (IN(8)) { p8_gather_naive(F, args); }
#ifdef DBG_DUMP
    if (IN(9)) { const bf16* AO = (const bf16*)(ws + WS_AO); const bf16* PO = (const bf16*)(ws + WS_PO); const bf16* MX = (const bf16*)(ws + (DBG_DUMP == 3 ? WS_T : DBG_DUMP == 4 ? WS_GA : WS_MIX));
        for (size_t i = (size_t)blockIdx.x * NTHR + F.tid; i < (size_t)M * DM; i += (size_t)F.G * NTHR) { const int row = (int)(i >> 10), c = (int)(i & 1023);
            float v; if (DBG_DUMP == 1) v = c < 512 ? bf2f(AO[(size_t)row * DA + c]) : bf2f(PO[(size_t)row * DP + c - 512]); else v = bf2f(MX[i]);
            args.out[O_YP + i] = v; } }
#endif
#undef IN
#undef BOTH
}

extern "C" void kernel_launch(void* const* d_in, const int* in_sizes, int n_in, void* d_out, int out_size, void* d_ws, size_t ws_size, hipStream_t stream) {
    static int grid = 0;
    if (grid == 0) {
        if (n_in != 22 || (size_t)out_size != O_END || ws_size < WS_END) { fprintf(stderr, "kernel_launch: unexpected shapes (n_in %d out %d ws %zu)\n", n_in, out_size, ws_size); grid = -1; return; }
        int dev = 0, cus = 0, per_cu = 0;
        if (hipGetDevice(&dev) != hipSuccess || hipDeviceGetAttribute(&cus, hipDeviceAttributeMultiprocessorCount, dev) != hipSuccess) { grid = -1; return; }
        if (hipFuncSetAttribute((const void*)fwd_kernel, hipFuncAttributeMaxDynamicSharedMemorySize, LDS_BYTES) != hipSuccess) { fprintf(stderr, "kernel_launch: hipFuncSetAttribute failed\n"); grid = -1; return; }
        if (hipOccupancyMaxActiveBlocksPerMultiprocessor(&per_cu, (const void*)fwd_kernel, NTHR, LDS_BYTES) != hipSuccess || per_cu < 1) fprintf(stderr, "kernel_launch: occupancy query reports %d\n", per_cu);
        (void)hipGetLastError();
        grid = cus;
    }
    if (grid < 0) return;
    if (hipMemsetAsync((char*)d_ws + WS_CTL, 0, CTL_ZERO_BYTES, stream) != hipSuccess) return;
    Args a{};
    a.x_p = (const float*)d_in[0]; a.x_s = (const float*)d_in[1]; a.cache_k = (const float*)d_in[2]; a.cache_v = (const float*)d_in[3]; a.cache_lf = (const float*)d_in[4];
    a.state_pool = (const float*)d_in[5]; a.page_table = (const int*)d_in[6]; a.norm_mix_g = (const float*)d_in[7]; a.w_in = (const float*)d_in[8]; a.b_forget = (const float*)d_in[9];
    a.q_norm_g = (const float*)d_in[10]; a.k_norm_g = (const float*)d_in[11]; a.pool_mix_w = (const float*)d_in[12]; a.pool_scale = (const float*)d_in[13]; a.w_bp = (const float*)d_in[14];
    a.w_ba = (const float*)d_in[15]; a.w_out = (const float*)d_in[16]; a.norm_ffn_g = (const float*)d_in[17]; a.w_query = (const float*)d_in[18]; a.sub_keys = (const float*)d_in[19];
    a.peer_u = (const float*)d_in[20]; a.peer_v = (const float*)d_in[21];
    a.out = (float*)d_out; a.ws = (unsigned char*)d_ws; a.pad = 0;
#if MK_PER_PHASE
#ifndef DBG_NPH
#define DBG_NPH N_PHASES
#endif
    for (int ph = 0; ph < DBG_NPH; ++ph) { a.ph_lo = ph; a.ph_hi = ph + 1; a.li = ph; hipLaunchKernelGGL(fwd_kernel, dim3(grid), dim3(NTHR), LDS_BYTES, stream, a); }
#ifdef DBG_DUMP
    a.ph_lo = 9; a.ph_hi = 10; a.li = 9; hipLaunchKernelGGL(fwd_kernel, dim3(grid), dim3(NTHR), LDS_BYTES, stream, a);
#endif
#else
    a.ph_lo = 0; a.ph_hi = N_PHASES; a.li = 0; hipLaunchKernelGGL(fwd_kernel, dim3(grid), dim3(NTHR), LDS_BYTES, stream, a);
#endif
}
```

```cpp
#include <hip/hip_runtime.h>
#include <cstdio>
#include <cstdint>
#include <cmath>
namespace pg8 {
#define PG8_LAS __attribute__((address_space(3)))
typedef unsigned short bf16_t;
typedef short bf16x8 __attribute__((ext_vector_type(8)));
typedef float f32x4 __attribute__((ext_vector_type(4)));
typedef unsigned u32x4 __attribute__((ext_vector_type(4)));
constexpr int BM = 256, BK = 64, HALF = 128, HTB = HALF * BK * 2  , STAGE_BYTES = 8 * HTB, NXCD = 8, WGM = 8;

__host__ __device__ __forceinline__ int lds_byte(int r, int c) { const int st = (r >> 4) * 2 + (c >> 5), rr = r & 15, cc = c & 31, ob = rr * 64 + cc * 2; return st * 1024 + (ob ^ (((ob >> 9) & 1) << 5)); }
__host__ __device__ __forceinline__ void stage_rc(int b, int& R, int& C) { const int st = b / 1024, sb = b % 1024, swz = sb ^ (((sb >> 9) & 1) << 5); R = (st >> 1) * 16 + swz / 64; C = (st & 1) * 32 + (swz % 64) / 2; }
__host__ __device__ __forceinline__ int perm32(int rho) { const int n = rho >> 4, i = rho & 15; return 8 * (i >> 2) + 4 * n + (i & 3); }

struct Unit { int pm, pn; };
struct Gemm { const bf16_t* A; const bf16_t* Bt; int M, N, K; };

struct StaticOrder {
    int nM, nN, nwg, G, c;
    __host__ __device__ void init(int M, int N, int G_, int c_) { nM = M / BM; nN = N / BM; nwg = nM * nN; G = G_; c = c_; }
    __host__ __device__ bool next(int i, Unit& u) const {
        const long L = (long)i * G + c; if (L >= nwg) return false;
        int wgid = (int)L; { const int q = nwg / NXCD, r = nwg % NXCD, xcd = wgid % NXCD, off = wgid / NXCD; wgid = (xcd < r ? xcd * (q + 1) : r * (q + 1) + (xcd - r) * q) + off; }
        const int nig = WGM * nN, gid = wgid / nig, fm = gid * WGM, gsz = (nM - fm) < WGM ? (nM - fm) : WGM;
        u.pm = fm + ((wgid % nig) % gsz); u.pn = (wgid % nig) / gsz; return true;
    }
    __device__ __forceinline__ void a_ready(const Unit&) const {}
    __device__ __forceinline__ void done(const Unit&) const {}
};

typedef float f32x2c __attribute__((ext_vector_type(2))); typedef __bf16 bf16x2c __attribute__((ext_vector_type(2)));
__device__ __forceinline__ unsigned cvt_pk_bf16(float lo, float hi) { f32x2c v = {lo, hi}; bf16x2c b = __builtin_convertvector(v, bf16x2c); return __builtin_bit_cast(unsigned, b); }
typedef float f32x2 __attribute__((ext_vector_type(2)));
__device__ __forceinline__ f32x2 gelu_pk(f32x2 v) {
    const f32x2 av = __builtin_elementwise_abs(v), d = av * 0.2316418882f + 1.0f;
    f32x2 t; t.x = __builtin_amdgcn_rcpf(d.x); t.y = __builtin_amdgcn_rcpf(d.y);
    f32x2 q = t * 0.5307027145f + (-0.7265760135f); q = q * t + 0.7107068705f; q = q * t + (-0.142248368f); q = q * t + 0.127414796f; q = q * t;
    const f32x2 s = (v * v) * (-0.72134752044f);
    f32x2 e; e.x = __builtin_amdgcn_exp2f(s.x); e.y = __builtin_amdgcn_exp2f(s.y);
    const f32x2 m = v * (q * e), r = v - m;
    f32x2 o; o.x = v.x < 0.f ? m.x : r.x; o.y = v.y < 0.f ? m.y : r.y; return o;
}

template <int ACT  > struct EpiBf16 {
    static constexpr bool PERM = true, AFTER_DRAIN = false; static_assert(ACT == 0 || ACT == 1, "EpiBf16: ACT is 0 (none) or 1 (gelu_pk)");
    bf16_t* O; int ldc; const float* bias; int split_cols; size_t split_stride; float scale0;
    __device__ __forceinline__ void operator()(const f32x4 (&acc)[2][2][4][2], const Unit& u, int wr, int wc, int fr, int fq) const {
        const int row0 = u.pm * BM + wr * 64 + fr; int colt = u.pn * BM; bf16_t* base = O;
        float sc = 1.f; if (split_cols) { const int t = colt / split_cols; base += (size_t)t * split_stride; colt -= t * split_cols; if (t == 0) sc = scale0; }
        const int col0 = colt + wc * 32 + 8 * fq, bcol0 = u.pn * BM + wc * 32 + 8 * fq;
        f32x4 bv[2][2];
#pragma unroll
        for (int bj = 0; bj < 2; ++bj)
#pragma unroll
            for (int n = 0; n < 2; ++n) bv[bj][n] = bias ? *(const f32x4*)(bias + bcol0 + bj * HALF + 4 * n) : (f32x4){0.f, 0.f, 0.f, 0.f};
#pragma unroll
        for (int ai = 0; ai < 2; ++ai)
#pragma unroll
            for (int m = 0; m < 4; ++m) { bf16_t* rowp = base + (size_t)(row0 + ai * HALF + m * 16) * ldc + col0;
#pragma unroll
                for (int bj = 0; bj < 2; ++bj) { f32x4 v0 = acc[ai][bj][m][0] + bv[bj][0], v1 = acc[ai][bj][m][1] + bv[bj][1];
                    if (ACT == 1) { f32x2 a = gelu_pk((f32x2){v0[0], v0[1]}), b = gelu_pk((f32x2){v0[2], v0[3]}), c = gelu_pk((f32x2){v1[0], v1[1]}), d = gelu_pk((f32x2){v1[2], v1[3]});
                        v0 = (f32x4){a.x, a.y, b.x, b.y}; v1 = (f32x4){c.x, c.y, d.x, d.y}; }
                    v0 = v0 * sc; v1 = v1 * sc; u32x4 w; w.x = cvt_pk_bf16(v0[0], v0[1]); w.y = cvt_pk_bf16(v0[2], v0[3]); w.z = cvt_pk_bf16(v1[0], v1[1]); w.w = cvt_pk_bf16(v1[2], v1[3]);
                    *(u32x4*)(rowp + bj * HALF) = w; } }
    }
};
template <class Epi, class Sched, bool ALIGN_EPI = false, bool SP2 = false>
__device__ __forceinline__ void gemm_phase(PG8_LAS unsigned char* lds, const Gemm g, const Sched& S, const Epi& E) {
    const int tid = threadIdx.x, wid = __builtin_amdgcn_readfirstlane(tid >> 6), lane = tid & 63, wr = wid >> 2, wc = wid & 3, fr = lane & 15, fq = lane >> 4;
    const int K = g.K, nt = K / BK;
    unsigned voffA[2], voffB[2];
#pragma unroll
    for (int i = 0; i < 2; ++i) { int R, C; stage_rc(tid * 16 + i * 8192, R, C); const int Rb = Epi::PERM ? ((R & ~31) + perm32(R & 31)) : R;
        voffA[i] = (unsigned)(R * K + C) * 2u; voffB[i] = (unsigned)(Rb * K + C) * 2u; }
    const size_t kstep = (size_t)(BK * 2);
    const size_t hstep = (size_t)HALF * K * 2;
    const size_t tstep = 2 * hstep;
    const unsigned ldsw = (unsigned)wid * 1024u;
    const int aoff = lds_byte(wr * 64 + fr, fq * 8), boff = lds_byte(wc * 32 + fr, fq * 8);
#define PG8_SA(b, h) (((b) * 2 + (h)) * HTB)
#define PG8_SB(b, h) ((4 + (b) * 2 + (h)) * HTB)
#define PG8_STAGE(bufoff, gbase, voff) do { _Pragma("unroll") for (int _i = 0; _i < 2; ++_i) \
        __builtin_amdgcn_global_load_lds((const unsigned*)((const char*)(gbase) + (voff)[_i]), (PG8_LAS unsigned*)(lds + (bufoff) + ldsw + _i * 8192), 16, 0, 0); } while (0)
#define PG8_LDA(dst, b, h) do { _Pragma("unroll") for (int m = 0; m < 4; ++m) _Pragma("unroll") for (int k = 0; k < 2; ++k) dst[m][k] = *(const PG8_LAS bf16x8*)(lds + PG8_SA(b, h) + aoff + m * 2048 + k * 1024); } while (0)
#define PG8_LDB(dst, b, h) do { _Pragma("unroll") for (int n = 0; n < 2; ++n) _Pragma("unroll") for (int k = 0; k < 2; ++k) dst[n][k] = *(const PG8_LAS bf16x8*)(lds + PG8_SB(b, h) + boff + n * 2048 + k * 1024); } while (0)
#define PG8_MMA(ai, bj, At, Bt) do { __builtin_amdgcn_s_setprio(1); _Pragma("unroll") for (int m = 0; m < 4; ++m) _Pragma("unroll") for (int n = 0; n < 2; ++n) _Pragma("unroll") for (int k = 0; k < 2; ++k) \
        acc[ai][bj][m][n] = __builtin_amdgcn_mfma_f32_16x16x32_bf16(Bt[n][k], At[m][k], acc[ai][bj][m][n], 0, 0, 0); __builtin_amdgcn_s_setprio(0); } while (0)
#define PG8_WAIT_V(n) asm volatile("s_waitcnt vmcnt(" #n ")" ::: "memory")
#define PG8_WAIT_L(n) asm volatile("s_waitcnt lgkmcnt(" #n ")" ::: "memory")
#define PG8_BAR __builtin_amdgcn_s_barrier()
#define PG8_SCHED __builtin_amdgcn_sched_barrier(0)
    Unit cur, nxt; int ui = 0;
    if (!S.next(0, cur)) return;
    f32x4 acc[2][2][4][2];
#pragma unroll
    for (int a = 0; a < 2; ++a)
#pragma unroll
        for (int b = 0; b < 2; ++b)
#pragma unroll
            for (int m = 0; m < 4; ++m)
#pragma unroll
                for (int n = 0; n < 2; ++n) acc[a][b][m][n] = (f32x4){0.f, 0.f, 0.f, 0.f};
    bf16x8 At[4][2], B0[2][2], B1[2][2];
    const char* cA = (const char*)g.A + (size_t)cur.pm * tstep; const char* cB = (const char*)g.Bt + (size_t)cur.pn * tstep;
    S.a_ready(cur);
    if constexpr (SP2) {
        PG8_STAGE(PG8_SB(0, 0), cB, voffB); PG8_STAGE(PG8_SB(0, 1), cB + hstep, voffB); PG8_STAGE(PG8_SA(0, 0), cA, voffA); PG8_STAGE(PG8_SA(0, 1), cA + hstep, voffA);
        if (wr == 1) PG8_BAR;
        PG8_WAIT_V(2); PG8_BAR;
        PG8_STAGE(PG8_SB(1, 0), cB + kstep, voffB); PG8_STAGE(PG8_SA(1, 0), cA + kstep, voffA); PG8_STAGE(PG8_SB(1, 1), cB + hstep + kstep, voffB);
        PG8_WAIT_V(6); PG8_BAR;
    } else {
        PG8_STAGE(PG8_SB(0, 0), cB, voffB); PG8_STAGE(PG8_SA(0, 0), cA, voffA); PG8_STAGE(PG8_SB(0, 1), cB + hstep, voffB); PG8_STAGE(PG8_SA(0, 1), cA + hstep, voffA);
        if (wr == 1) PG8_BAR;
        PG8_WAIT_V(4); PG8_BAR;
        PG8_STAGE(PG8_SB(1, 0), cB + kstep, voffB); PG8_STAGE(PG8_SA(1, 0), cA + kstep, voffA); PG8_STAGE(PG8_SB(1, 1), cB + hstep + kstep, voffB);
        PG8_WAIT_V(6); PG8_BAR;
    }
    for (;;) {
        const bool has_next = S.next(ui + 1, nxt);
        const char* nA = has_next ? (const char*)g.A + (size_t)nxt.pm * tstep : cA; const char* nB = has_next ? (const char*)g.Bt + (size_t)nxt.pn * tstep : cB;
        for (int t = 0; t < nt; t += 2) {
            const bool last = (t == nt - 2);
            const char* a1 = cA + (size_t)(t + 1) * kstep;
            const char* a2 = last ? nA : cA + (size_t)(t + 2) * kstep; const char* b2 = last ? nB : cB + (size_t)(t + 2) * kstep;
            const char* a3 = a2 + kstep; const char* b3 = b2 + kstep;
            if (last && has_next) S.a_ready(nxt);
            if constexpr (SP2) {
            PG8_LDB(B0, 0, 0); PG8_LDB(B1, 0, 1); PG8_SCHED; PG8_LDA(At, 0, 0); PG8_STAGE(PG8_SA(1, 1), a1 + hstep, voffA);
            PG8_WAIT_V(8); PG8_WAIT_L(0); PG8_BAR; PG8_MMA(0, 0, At, B0); PG8_MMA(0, 1, At, B1); PG8_BAR; PG8_SCHED;
            PG8_LDA(At, 0, 1); PG8_STAGE(PG8_SB(0, 0), b2, voffB); PG8_STAGE(PG8_SB(0, 1), b2 + hstep, voffB); PG8_STAGE(PG8_SA(0, 0), a2, voffA);
            PG8_WAIT_V(8); PG8_WAIT_L(0); PG8_BAR; PG8_MMA(1, 0, At, B0); PG8_MMA(1, 1, At, B1); PG8_BAR; PG8_SCHED;
            PG8_LDB(B0, 1, 0); PG8_LDB(B1, 1, 1); PG8_SCHED; PG8_LDA(At, 1, 0); PG8_STAGE(PG8_SA(0, 1), a2 + hstep, voffA);
            PG8_WAIT_V(8); PG8_WAIT_L(0); PG8_BAR; PG8_MMA(0, 0, At, B0); PG8_MMA(0, 1, At, B1); PG8_BAR; PG8_SCHED;
            PG8_LDA(At, 1, 1); PG8_STAGE(PG8_SB(1, 0), b3, voffB); PG8_STAGE(PG8_SB(1, 1), b3 + hstep, voffB); PG8_STAGE(PG8_SA(1, 0), a3, voffA);
            PG8_WAIT_V(8); PG8_WAIT_L(0); PG8_BAR; PG8_MMA(1, 0, At, B0); PG8_MMA(1, 1, At, B1); PG8_BAR; PG8_SCHED;
            } else {
            PG8_LDB(B0, 0, 0); PG8_SCHED; PG8_LDA(At, 0, 0); PG8_STAGE(PG8_SA(1, 1), a1 + hstep, voffA);
            PG8_WAIT_L(8); PG8_BAR; PG8_WAIT_L(0); PG8_MMA(0, 0, At, B0); PG8_BAR; PG8_SCHED;
            PG8_LDB(B1, 0, 1); PG8_STAGE(PG8_SB(0, 0), b2, voffB);
            PG8_BAR; PG8_WAIT_L(0); PG8_MMA(0, 1, At, B1); PG8_BAR;
            PG8_LDA(At, 0, 1); PG8_STAGE(PG8_SA(0, 0), a2, voffA);
            PG8_BAR; PG8_WAIT_L(0); PG8_MMA(1, 0, At, B0); PG8_BAR; PG8_SCHED;
            PG8_STAGE(PG8_SB(0, 1), b2 + hstep, voffB);
            PG8_WAIT_V(6); PG8_BAR; PG8_MMA(1, 1, At, B1); PG8_BAR;
            PG8_LDB(B0, 1, 0); PG8_SCHED; PG8_LDA(At, 1, 0); PG8_STAGE(PG8_SA(0, 1), a2 + hstep, voffA);
            PG8_WAIT_L(8); PG8_BAR; PG8_WAIT_L(0); PG8_MMA(0, 0, At, B0); PG8_BAR; PG8_SCHED;
            PG8_LDB(B1, 1, 1); PG8_STAGE(PG8_SB(1, 0), b3, voffB);
            PG8_BAR; PG8_WAIT_L(0); PG8_MMA(0, 1, At, B1); PG8_BAR;
            PG8_LDA(At, 1, 1); PG8_STAGE(PG8_SA(1, 0), a3, voffA);
            PG8_BAR; PG8_WAIT_L(0); PG8_MMA(1, 0, At, B0); PG8_BAR; PG8_SCHED;
            PG8_STAGE(PG8_SB(1, 1), b3 + hstep, voffB);
            PG8_WAIT_V(6); PG8_BAR; PG8_MMA(1, 1, At, B1); PG8_BAR;
            }
        }
        if constexpr (ALIGN_EPI) { if (wr == 0) PG8_BAR; }
        if constexpr (!Epi::AFTER_DRAIN) { E(acc, cur, wr, wc, fr, fq); S.done(cur); }
        if (!has_next) break;
#pragma unroll
        for (int a = 0; a < 2; ++a)
#pragma unroll
            for (int b = 0; b < 2; ++b)
#pragma unroll
                for (int m = 0; m < 4; ++m)
#pragma unroll
                    for (int n = 0; n < 2; ++n) acc[a][b][m][n] = (f32x4){0.f, 0.f, 0.f, 0.f};
        cur = nxt; cA = nA; cB = nB; ++ui;
        if constexpr (ALIGN_EPI) { if (wr == 1) PG8_BAR; }
    }
    PG8_WAIT_V(0);
    if constexpr (!ALIGN_EPI) { if (wr == 0) PG8_BAR; }
    PG8_BAR;
    if constexpr (Epi::AFTER_DRAIN) { E.fused(acc, cur, wr, wc, fr, fq, lds, wid, lane); S.done(cur); }
#undef PG8_SA
#undef PG8_SB
#undef PG8_STAGE
#undef PG8_LDA
#undef PG8_LDB
#undef PG8_MMA
#undef PG8_WAIT_V
#undef PG8_WAIT_L
#undef PG8_BAR
#undef PG8_SCHED
}
}
#define GAS __attribute__((address_space(1)))
#define LAS __attribute__((address_space(3)))
typedef unsigned short bf16;
typedef unsigned v4u __attribute__((ext_vector_type(4)));
typedef float f32x4 __attribute__((ext_vector_type(4)));
typedef short bf16x8 __attribute__((ext_vector_type(8)));
typedef GAS unsigned gu32;
typedef GAS unsigned long long gu64;
#define RLX_AGENT __ATOMIC_RELAXED, __HIP_MEMORY_SCOPE_AGENT
#define LDS_WAIT() asm volatile("s_waitcnt lgkmcnt(0)" ::: "memory")
#define VM_WAIT() asm volatile("s_waitcnt vmcnt(0)" ::: "memory")
__device__ __forceinline__ unsigned long long rt() { return __builtin_amdgcn_s_memrealtime(); }
__device__ __forceinline__ unsigned f2bf(float f) { unsigned u = __builtin_bit_cast(unsigned, f); return (u + 0x7fffu + ((u >> 16) & 1u)) >> 16; }
__device__ __forceinline__ unsigned pk2(float lo, float hi) { return f2bf(lo) | (f2bf(hi) << 16); }

#define XB_TMO      128
#define XB_XCNT(j)  (256  + 64 * (j))
#define XB_XSUB(j)  (1280 + 64 * (j))
#define XB_XGEN(j)  (2304 + 64 * (j))
#define XB_TOP      3328
#define XB_TOPGEN   3392
#define XCD_BAR_WORDS 3456
#define XB_SPIN_CAP (1u << 18)

__device__ __forceinline__ unsigned xb_ld(unsigned* p)              { return __hip_atomic_load(p, __ATOMIC_RELAXED, __HIP_MEMORY_SCOPE_AGENT); }
__device__ __forceinline__ unsigned xb_add(unsigned* p, unsigned v) { return __hip_atomic_fetch_add(p, v, __ATOMIC_RELAXED, __HIP_MEMORY_SCOPE_AGENT); }
__device__ __forceinline__ unsigned xb_xcc_id() { return (unsigned)__builtin_amdgcn_s_getreg((3 << 11) | 20) & 0xFu; }
#define XB_SPIN(cond, bar) do { unsigned _sp = 0; while (cond) { __builtin_amdgcn_s_sleep(1); \
    if ((++_sp & 255u) == 0u) { if (xb_ld(&(bar)[XB_TMO])) break; if (_sp > XB_SPIN_CAP) { atomicAdd(&(bar)[XB_TMO], 1u); break; } } } } while (0)

struct XcdBarrier {
    unsigned* bar; unsigned x;
    volatile LAS unsigned* st;
};

__device__ __forceinline__ XcdBarrier xcd_barrier_post(unsigned* bar, volatile LAS unsigned* st) {
    XcdBarrier b; b.bar = bar; b.x = xb_xcc_id(); b.st = st;
    if (threadIdx.x == 0) (void)xb_add(&bar[XB_XCNT(b.x)], 1u);
    return b;
}
__device__ __forceinline__ void xcd_barrier_complete(unsigned* bar, unsigned x, unsigned& nloc, unsigned& nx) {
    const unsigned G = gridDim.x * gridDim.y * gridDim.z;
    unsigned sum, cnt, mine, sp = 0u;
    for (;;) {
        sum = 0u; cnt = 0u; mine = 0u;
#pragma unroll
        for (unsigned j = 0; j < 16; ++j) { const unsigned c = xb_ld(&bar[XB_XCNT(j)]); sum += c; cnt += (c > 0u) ? 1u : 0u; mine = (j == x) ? c : mine; }
        if (sum == G) break;
        __builtin_amdgcn_s_sleep(1);
        if ((++sp & 255u) == 0u) { if (xb_ld(&bar[XB_TMO])) break; if (sp > XB_SPIN_CAP) { atomicAdd(&bar[XB_TMO], 1u); break; } }
    }
    nloc = mine > 0u ? mine : 1u; nx = cnt > 0u ? cnt : 1u;
}

__device__ __forceinline__ void xcd_barrier(const XcdBarrier& b) {
    asm volatile("s_waitcnt vmcnt(0)" ::: "memory");
    __syncthreads();
    if (threadIdx.x == 0) {
        unsigned* bar = b.bar;
        __builtin_amdgcn_s_waitcnt(0);
        unsigned nloc = b.st[0], nx = b.st[1];
        if (nloc == 0u) { xcd_barrier_complete(bar, b.x, nloc, nx); b.st[0] = nloc; b.st[1] = nx; }
        const unsigned old = xb_add(&bar[XB_XSUB(b.x)], 1u);
        const unsigned gen = old / nloc;
        if (old + 1u == (gen + 1u) * nloc) {
            __builtin_amdgcn_fence(__ATOMIC_RELEASE, "agent");
            asm volatile("s_waitcnt vmcnt(0)" ::: "memory");
            const unsigned og = xb_add(&bar[XB_TOP], 1u);
            const unsigned tg = og / nx;
            if (og + 1u == (tg + 1u) * nx) xb_add(&bar[XB_TOPGEN], 1u);
            else XB_SPIN(xb_ld(&bar[XB_TOPGEN]) == tg, bar);
            __builtin_amdgcn_fence(__ATOMIC_ACQUIRE, "agent");
            xb_add(&bar[XB_XGEN(b.x)], 1u);
            asm volatile("s_waitcnt vmcnt(0)" ::: "memory");
        } else {
            XB_SPIN(xb_ld(&bar[XB_XGEN(b.x)]) == gen, bar);
            __builtin_amdgcn_fence(__ATOMIC_ACQUIRE, "agent");
            asm volatile("s_waitcnt vmcnt(0)" ::: "memory");
        }
    }
    __syncthreads();
}
#include <hip/hip_bf16.h>
#include <cmath>
namespace attn_body {
using bf16=__hip_bfloat16;
using bf16x8=__attribute__((ext_vector_type(8)))short;
using s16x4=__attribute__((ext_vector_type(4)))short;
using f32x16=__attribute__((ext_vector_type(16)))float;
using u32x4=__attribute__((ext_vector_type(4)))unsigned;
constexpr int BATCH=4,NHEAD=8,SEQ=4096,D=64,DM=NHEAD*D;
constexpr int NW=8,QBLK=32,QB=QBLK*NW,KVBLK=64,NQB=SEQ/QB;
constexpr int ATTN_PITCH=DM, ATTN_UNIT_ROWS=QB;
__device__ __forceinline__ int crow(int r,int hi){return (r&3)+8*(r>>2)+4*hi;}
#define SBAR() __builtin_amdgcn_sched_barrier(0)
__device__ __forceinline__ void cmask(f32x16&p0,f32x16&p1,int jb,int qrel,int hi){
  const float NEG=-INFINITY; int kb=64*jb+4*hi;
  #pragma unroll
  for(int r=0;r<16;++r){int kv=kb+(r&3)+8*(r>>2); if(kv>qrel)p0[r]=NEG; if(kv+32>qrel)p1[r]=NEG;}
}

constexpr int NSLOT=3, SLOTB=8192;
constexpr int LDS_K=0, LDS_V=NSLOT*SLOTB, LDS_WS=2*NSLOT*SLOTB, LDS_OST=LDS_WS+NW*64*4, LDS_CK=LDS_OST+NW*4096, LDS_BYTES=LDS_CK+SEQ*4;
constexpr float C2=0.125f*1.4426950408889634f;
__device__ __forceinline__ void glds16(const void*gsrc,unsigned lds_dst){unsigned keep;
  asm volatile("s_mov_b32 %0, m0\n\ts_mov_b32 m0, %2\n\ts_nop 0\n\tglobal_load_lds_dwordx4 %1, off\n\ts_mov_b32 m0, %0":"=&s"(keep):"v"(gsrc),"s"(lds_dst):"memory");}
__device__ __forceinline__ float max3f(float a,float b,float c){float r;asm("v_max3_f32 %0, %1, %2, %3":"=v"(r):"v"(a),"v"(b),"v"(c));return r;}
__device__ __forceinline__ float max2f(float a,float b){float r;asm("v_max_f32_e32 %0, %1, %2":"=v"(r):"v"(a),"v"(b));return r;}
__device__ __forceinline__ float fadd_s(float a,float b){float r;asm("v_add_f32_e32 %0, %1, %2":"=v"(r):"v"(a),"v"(b));return r;}
__device__ __forceinline__ float fsub_s(float a,float b){float r;asm("v_sub_f32_e32 %0, %1, %2":"=v"(r):"v"(a),"v"(b));return r;}
typedef float f32x2_t __attribute__((ext_vector_type(2))); typedef __bf16 bf16x2_t __attribute__((ext_vector_type(2)));
__device__ __forceinline__ unsigned cvtpk_s(float lo,float hi){f32x2_t v={lo,hi};bf16x2_t b=__builtin_convertvector(v,bf16x2_t);return __builtin_bit_cast(unsigned,b);}
#define WAIT_BAR(N) asm volatile("s_waitcnt vmcnt(" #N ") lgkmcnt(0)\n\ts_barrier":::"memory")

__device__ __forceinline__ void qkt(f32x16&p0,f32x16&p1,const char*Kslot,const bf16x8*qr,int r32,int hi){
  const char*kb=Kslot+hi*1024+r32*16;
  #pragma unroll
  for(int d0=0;d0<4;++d0){
    const bf16x8 b0=*reinterpret_cast<const bf16x8*>(kb+d0*2048);
    const bf16x8 b1=*reinterpret_cast<const bf16x8*>(kb+d0*2048+512);
    p0=__builtin_amdgcn_mfma_f32_32x32x16_bf16(b0,qr[d0],p0,0,0,0);p1=__builtin_amdgcn_mfma_f32_32x32x16_bf16(b1,qr[d0],p1,0,0,0);}
}
typedef __attribute__((address_space(3))) const char* lds_cptr;
typedef short v4i16_t __attribute__((ext_vector_type(4)));
__device__ __forceinline__ void kload8(bf16x8*kf,lds_cptr kp){
  kf[0]=*(const __attribute__((address_space(3))) bf16x8*)(kp);      kf[1]=*(const __attribute__((address_space(3))) bf16x8*)(kp+512);
  kf[2]=*(const __attribute__((address_space(3))) bf16x8*)(kp+2048); kf[3]=*(const __attribute__((address_space(3))) bf16x8*)(kp+2560);
  kf[4]=*(const __attribute__((address_space(3))) bf16x8*)(kp+4096); kf[5]=*(const __attribute__((address_space(3))) bf16x8*)(kp+4608);
  kf[6]=*(const __attribute__((address_space(3))) bf16x8*)(kp+6144); kf[7]=*(const __attribute__((address_space(3))) bf16x8*)(kp+6656);
}
__device__ __forceinline__ void kload2(bf16x8*kf,lds_cptr kp,int j){ kf[2*j]=*(const __attribute__((address_space(3))) bf16x8*)(kp+j*2048); kf[2*j+1]=*(const __attribute__((address_space(3))) bf16x8*)(kp+j*2048+512); }
__device__ __forceinline__ s16x4 vtr(lds_cptr p){ return __builtin_bit_cast(s16x4,__builtin_amdgcn_ds_read_tr16_b64_v4i16((__attribute__((address_space(3))) v4i16_t*)p)); }
__device__ __forceinline__ float rowmax(const f32x16&p0,const f32x16&p1){
  float a=max3f(p0[0],p0[1],p1[0]),b=max3f(p0[2],p0[3],p1[1]);a=max3f(a,p1[2],p1[3]);
  #pragma unroll
  for(int r=4;r<16;r+=4){a=max3f(a,p0[r],p0[r+1]);b=max3f(b,p0[r+2],p0[r+3]);a=max3f(a,p1[r],p1[r+1]);b=max3f(b,p1[r+2],p1[r+3]);}
  const float m=max2f(a,b);
  auto rr=__builtin_amdgcn_permlane32_swap(__float_as_uint(m),__float_as_uint(m),false,false);
  return max2f(__uint_as_float(rr[0]),__uint_as_float(rr[1]));
}
__device__ __forceinline__ void pv(f32x16*o,int vb,bf16x8 pa0,bf16x8 pa1,bf16x8 pa2,bf16x8 pa3){
  #pragma unroll
  for(int d0=0;d0<2;++d0){s16x4 lo[4],hi[4];
    #pragma unroll
    for(int ks=0;ks<4;++ks){
      asm volatile("ds_read_b64_tr_b16 %0,%1 offset:%c2":"=&v"(lo[ks]):"v"(vb),"i"(d0*4096+ks*1024):"memory");
      asm volatile("ds_read_b64_tr_b16 %0,%1 offset:%c2":"=&v"(hi[ks]):"v"(vb),"i"(d0*4096+ks*1024+512):"memory");}
    asm volatile("s_waitcnt lgkmcnt(0)":::"memory");SBAR();
    #define PK(k) (bf16x8){lo[k][0],lo[k][1],lo[k][2],lo[k][3],hi[k][0],hi[k][1],hi[k][2],hi[k][3]}
    o[d0]=__builtin_amdgcn_mfma_f32_32x32x16_bf16(pa0,PK(0),o[d0],0,0,0);
    o[d0]=__builtin_amdgcn_mfma_f32_32x32x16_bf16(pa1,PK(1),o[d0],0,0,0);
    o[d0]=__builtin_amdgcn_mfma_f32_32x32x16_bf16(pa2,PK(2),o[d0],0,0,0);
    o[d0]=__builtin_amdgcn_mfma_f32_32x32x16_bf16(pa3,PK(3),o[d0],0,0,0);
    #undef PK
  }
}

#ifndef ATTN_STORE16
#define ATTN_STORE16(p,v) (*(u32x4*)(p)=(v))
#endif
template<int THRL> __device__ __forceinline__ void attn_unit(int b,int h,int qb,const bf16*Q,const bf16*__restrict__ K,const bf16*__restrict__ V,bf16*O,const float*__restrict__ c2,float M2,char*shm){
  const int tid=threadIdx.x,lane=tid&63,r32=lane&31,hi=lane>>5; const int wid=__builtin_amdgcn_readfirstlane(tid>>6);
  const long rowbase=(long)b*SEQ; const int q0=qb*QB;
  const bf16*Qw=Q+(rowbase+q0+wid*QBLK)*DM+h*D;
  const bf16*Kh=K+rowbase*DM+h*D,*Vh=V+rowbase*DM+h*D;
  const unsigned lds0=(unsigned)(uintptr_t)shm;
  float*wsf=(float*)(shm+LDS_WS)+wid*64;
  const bf16*ksrc=Kh+(long)lane*DM+wid*8;
  const bf16*vsrc=Vh+(long)(16*(wid&3)+(lane>>2))*DM+(wid>>2)*32+(lane&3)*8;
  const unsigned kdst=lds0+LDS_K+wid*1024, vdst=lds0+LDS_V+wid*1024;
  #define DMA_K(t,slot) glds16(ksrc+(long)(t)*KVBLK*DM,(unsigned)__builtin_amdgcn_readfirstlane(kdst+(slot)))
  #define DMA_V(t,slot) glds16(vsrc+(long)(t)*KVBLK*DM,(unsigned)__builtin_amdgcn_readfirstlane(vdst+(slot)))
  const int vb0=(int)(lds0+LDS_V)+((lane>>4)&1)*32+(lane&3)*8+(4*hi+((lane&15)>>2))*64;
  const char*Kbase=shm+LDS_K; bf16x8 kf[8];
  const lds_cptr shm3=(lds_cptr)shm; const lds_cptr kp0=shm3+LDS_K+hi*1024+r32*16; const lds_cptr vp0=shm3+LDS_V+((lane>>4)&1)*32+(lane&3)*8+(4*hi+((lane&15)>>2))*64;
  const int NT=(q0+QB)/KVBLK;
  typedef float f32x4_t __attribute__((ext_vector_type(4)));
  const int nck4=(q0+QB)/4; f32x4_t ckv0=f32x4_t{},ckv1=f32x4_t{}; if(tid<nck4)ckv0=((const f32x4_t*)c2)[tid]; if(tid+512<nck4)ckv1=((const f32x4_t*)c2)[tid+512];
  const float cq=c2[q0+wid*QBLK+r32]-M2;
  DMA_K(0,0);DMA_V(0,0);DMA_K(1,SLOTB);
  bf16x8 qr[4];
  #pragma unroll
  for(int d0=0;d0<4;++d0)qr[d0]=*reinterpret_cast<const bf16x8*>(&Qw[(long)r32*DM+d0*16+hi*8]);
  float l_reg=0.f;f32x16 o[2];o[0]=f32x16{};o[1]=f32x16{};
  { __attribute__((address_space(3))) f32x4_t*ckl=(__attribute__((address_space(3))) f32x4_t*)((lds_cptr)shm+LDS_CK); if(tid<nck4)ckl[tid]=ckv0; if(tid+512<nck4)ckl[tid+512]=ckv1; }
  const __attribute__((address_space(3))) f32x4_t*ckp=(const __attribute__((address_space(3))) f32x4_t*)((lds_cptr)shm+LDS_CK)+hi;
  #define CKLD(P0,P1,t) do{ _Pragma("unroll") for(int g_=0;g_<4;++g_){ const f32x4_t a_=ckp[(t)*16+2*g_], b_=ckp[(t)*16+8+2*g_]; P0[4*g_]=a_[0];P0[4*g_+1]=a_[1];P0[4*g_+2]=a_[2];P0[4*g_+3]=a_[3]; P1[4*g_]=b_[0];P1[4*g_+1]=b_[1];P1[4*g_+2]=b_[2];P1[4*g_+3]=b_[3]; } }while(0)
  #define CKSUB(P0,P1) do{ _Pragma("unroll") for(int r=0;r<16;++r){P0[r]=cq-P0[r];P1[r]=cq-P1[r];} }while(0)
  const int qrel=wid*QBLK+r32;
  #define CMASK(P0,P1,t) do{int jb_=(t)-(NT-4); if(jb_>=0)cmask(P0,P1,jb_,qrel,hi);}while(0)
  #define START(P0,P1) do{ _Pragma("unroll") for(int r=0;r<16;++r)P0[r]=__builtin_amdgcn_exp2f(P0[r]); }while(0)
  #define RESC() do{}while(0)
  f32x16 pA0,pA1,pB0,pB1;
  int sl_prev=0,sl_cur=0,sl_next=SLOTB;
  #define ROT() do{sl_prev=sl_cur;sl_cur=sl_next;sl_next=(sl_next==(NSLOT-1)*SLOTB)?0:sl_next+SLOTB;}while(0)
  DMA_K(2,2*SLOTB);
  WAIT_BAR(3);
  CKLD(pA0,pA1,0);CKSUB(pA0,pA1);
  qkt(pA0,pA1,Kbase,qr,r32,hi);asm volatile("s_nop 15\n\ts_nop 7":"+v"(pA0),"+v"(pA1));CMASK(pA0,pA1,0);
  CKLD(pB0,pB1,1);CKSUB(pB0,pB1);
  START(pA0,pA1);
  _Pragma("unroll") for(int r=0;r<16;++r)pA1[r]=__builtin_amdgcn_exp2f(pA1[r]);
  WAIT_BAR(0);
  DMA_K(3,0);DMA_V(1,SLOTB);
  ROT();
  kload8(kf,kp0+sl_cur);
  WAIT_BAR(2);
  s16x4 vlo[8],vhi[8]; u32x4 pw0,pw1,pw2,pw3;
  #define PKW(P,B) cvtpk_s(P[B],P[B+1])
  #define PAF(k) __builtin_bit_cast(bf16x8,pw##k)
  #define VFR(i) (bf16x8){vlo[i][0],vlo[i][1],vlo[i][2],vlo[i][3],vhi[i][0],vhi[i][1],vhi[i][2],vhi[i][3]}
  #define PIN(x) asm volatile("":"+v"(x))
  #define MX3(a,b,c) __builtin_fmaxf(__builtin_fmaxf((a),(b)),(c))
  #define GAPA(MF,A0,A1,A2,A3,W0,W1,PW) do{ MF; sacc+=A0; sacc+=A1; sacc+=A2; sacc+=A3; PIN(sacc); W0; W1; PIN(PW); SBAR(); }while(0)
  #define EX(v) __builtin_amdgcn_exp2f(v)
  #define GAPB(MF,X,B) do{ MF; X[B]=EX(X[B]); X[B+1]=EX(X[B+1]); X[B+2]=EX(X[B+2]); X[B+3]=EX(X[B+3]); PIN(X); SBAR(); }while(0)
  #define VRD(i) do{ vlo[i]=vtr(vp_+(((i)>>2)*4096+((i)&3)*1024)); vhi[i]=vtr(vp_+(((i)>>2)*4096+((i)&3)*1024+512)); }while(0)
  #define KRD(G,j) do{ if(G){ kload2(kf,kp0+sl_next,j); SBAR(); } }while(0)
  #define STEP(C0,C1,P0,P1,t,GK,GV,GL) do{ SBAR(); \
    const lds_cptr vp_=vp0+sl_prev; \
    VRD(0); SBAR(); float sacc=(P0[0]+P0[1]); \
    GAPA(C0=__builtin_amdgcn_mfma_f32_32x32x16_bf16(kf[0],qr[0],C0,0,0,0), P0[2],P0[3],P0[4],P0[5],     pw0[0]=PKW(P0,0), pw0[1]=PKW(P0,2), pw0); \
    VRD(4); SBAR(); GAPA(C1=__builtin_amdgcn_mfma_f32_32x32x16_bf16(kf[1],qr[0],C1,0,0,0), P0[6],P0[7],P0[8],P0[9],     pw0[2]=PKW(P0,4), pw0[3]=PKW(P0,6), pw0); \
    VRD(1); SBAR(); GAPA(C0=__builtin_amdgcn_mfma_f32_32x32x16_bf16(kf[2],qr[1],C0,0,0,0),   P0[10],P0[11],P0[12],P0[13], pw1[0]=PKW(P0,8), pw1[1]=PKW(P0,10), pw1); \
    VRD(5); SBAR(); GAPA(C1=__builtin_amdgcn_mfma_f32_32x32x16_bf16(kf[3],qr[1],C1,0,0,0),   P0[14],P0[15],P1[0],P1[1],   pw1[2]=PKW(P0,12),pw1[3]=PKW(P0,14), pw1); \
    VRD(2); SBAR(); GAPA(C0=__builtin_amdgcn_mfma_f32_32x32x16_bf16(kf[4],qr[2],C0,0,0,0),   P1[2],P1[3],P1[4],P1[5],     pw2[0]=PKW(P1,0), pw2[1]=PKW(P1,2), pw2); \
    VRD(6); SBAR(); GAPA(C1=__builtin_amdgcn_mfma_f32_32x32x16_bf16(kf[5],qr[2],C1,0,0,0),   P1[6],P1[7],P1[8],P1[9],     pw2[2]=PKW(P1,4), pw2[3]=PKW(P1,6), pw2); \
    VRD(3); SBAR(); GAPA(C0=__builtin_amdgcn_mfma_f32_32x32x16_bf16(kf[6],qr[3],C0,0,0,0),   P1[10],P1[11],P1[12],P1[13], pw3[0]=PKW(P1,8), pw3[1]=PKW(P1,10), pw3); \
    VRD(7); SBAR(); GAPA(C1=__builtin_amdgcn_mfma_f32_32x32x16_bf16(kf[7],qr[3],C1,0,0,0),   P1[14],P1[15],0.f,0.f,       pw3[2]=PKW(P1,12),pw3[3]=PKW(P1,14), pw3); \
    l_reg+=sacc; \
    if(GK){DMA_K((t)+3,sl_cur);} if(GV){DMA_V((t)+1,sl_next);} \
    CMASK(C0,C1,t); \
    SBAR(); \
    GAPB(o[0]=__builtin_amdgcn_mfma_f32_32x32x16_bf16(PAF(0),VFR(0),o[0],0,0,0), C0,0); \
    GAPB(o[1]=__builtin_amdgcn_mfma_f32_32x32x16_bf16(PAF(0),VFR(4),o[1],0,0,0), C0,4); \
    KRD(GL,0); GAPB(o[0]=__builtin_amdgcn_mfma_f32_32x32x16_bf16(PAF(1),VFR(1),o[0],0,0,0), C0,8); \
    KRD(GL,1); GAPB(o[1]=__builtin_amdgcn_mfma_f32_32x32x16_bf16(PAF(1),VFR(5),o[1],0,0,0), C0,12); \
    KRD(GL,2); GAPB(o[0]=__builtin_amdgcn_mfma_f32_32x32x16_bf16(PAF(2),VFR(2),o[0],0,0,0), C1,0); \
    KRD(GL,3); GAPB(o[1]=__builtin_amdgcn_mfma_f32_32x32x16_bf16(PAF(2),VFR(6),o[1],0,0,0), C1,4); \
    GAPB(o[0]=__builtin_amdgcn_mfma_f32_32x32x16_bf16(PAF(3),VFR(3),o[0],0,0,0), C1,8); \
    GAPB(o[1]=__builtin_amdgcn_mfma_f32_32x32x16_bf16(PAF(3),VFR(7),o[1],0,0,0), C1,12); \
    if(GL){ CKLD(P0,P1,(t)+1); CKSUB(P0,P1); } \
    }while(0)
  int t=1;
  #undef CMASK
  #define CMASK(P0,P1,t) do{}while(0)
  for(;t+5<NT;t+=2){
    STEP(pB0,pB1,pA0,pA1,t,true,true,true);     WAIT_BAR(2); RESC(); ROT();
    STEP(pA0,pA1,pB0,pB1,t+1,true,true,true);   WAIT_BAR(2); RESC(); ROT();
  }
  #undef CMASK
  #define CMASK(P0,P1,t) do{int jb_=(t)-(NT-4); if(jb_>=0)cmask(P0,P1,jb_,qrel,hi);}while(0)
  #define ENDW(tt) do{ if((tt)+3<NT){WAIT_BAR(2);} else if((tt)+2<NT){WAIT_BAR(1);} else {WAIT_BAR(0);} }while(0)
  for(;t+1<NT;t+=2){
    STEP(pB0,pB1,pA0,pA1,t,(t+3<NT),(t+1<NT),(t+1<NT));       ENDW(t);   RESC(); ROT();
    STEP(pA0,pA1,pB0,pB1,t+1,(t+4<NT),(t+2<NT),(t+2<NT));     ENDW(t+1); RESC(); ROT();
  }
  STEP(pB0,pB1,pA0,pA1,NT-1,false,false,false); RESC();
  { float sacc=pB0[0]+pB0[1]; _Pragma("unroll") for(int r=2;r<16;++r)sacc+=pB0[r]; _Pragma("unroll") for(int r=0;r<16;++r)sacc+=pB1[r]; l_reg+=sacc;
    pw0=(u32x4){PKW(pB0,0),PKW(pB0,2),PKW(pB0,4),PKW(pB0,6)};pw1=(u32x4){PKW(pB0,8),PKW(pB0,10),PKW(pB0,12),PKW(pB0,14)};pw2=(u32x4){PKW(pB1,0),PKW(pB1,2),PKW(pB1,4),PKW(pB1,6)};pw3=(u32x4){PKW(pB1,8),PKW(pB1,10),PKW(pB1,12),PKW(pB1,14)};
    SBAR(); pv(o,vb0+sl_cur,PAF(0),PAF(1),PAF(2),PAF(3)); }
  #undef PKW
  #undef PAF
  #undef VFR
  #undef PIN
  #undef MX3
  #undef GAPA
  #undef GAPB
  #undef EX
  #undef VRD
  #undef KRD
  #undef STEP
  #undef ENDW
  {auto rr=__builtin_amdgcn_permlane32_swap(__float_as_uint(l_reg),__float_as_uint(l_reg),false,false);l_reg=__uint_as_float(rr[0])+__uint_as_float(rr[1]);}
  if(hi==0)wsf[32+r32]=l_reg;asm volatile("s_waitcnt lgkmcnt(0)":::"memory");
  float rli[16];
  #pragma unroll
  for(int r=0;r<16;++r)rli[r]=__builtin_amdgcn_rcpf(wsf[32+crow(r,hi)]);
  bf16*Ow=O+(rowbase+q0+wid*QBLK)*DM+h*D;
  { bf16*stg=(bf16*)(shm+LDS_OST)+wid*2048;
    #pragma unroll
    for(int r=0;r<16;++r){const int orow=crow(r,hi);
      #pragma unroll
      for(int d0=0;d0<2;++d0)stg[orow*64+d0*32+r32]=__float2bfloat16(o[d0][r]*rli[r]);}
    asm volatile("s_waitcnt lgkmcnt(0)":::"memory");
    #pragma unroll
    for(int i=0;i<4;++i){const int row=i*8+(lane>>3),ch=lane&7; const u32x4 v=*(const u32x4*)(stg+row*64+ch*8); ATTN_STORE16(Ow+(long)row*DM+ch*8,v);} }
  asm volatile("s_waitcnt lgkmcnt(0)\n\ts_barrier":::"memory");
  #undef DMA_K
  #undef DMA_V
  #undef CMASK
  #undef START
  #undef RESC
  #undef ROT
  #undef CKLD
  #undef CKSUB
}
constexpr int ATTN_LDS_BYTES=LDS_BYTES;
struct AttnTensors { const bf16* Q; const bf16* K; const bf16* V; bf16* O; const float* C2T; float M2; };
struct AttnUnit { int bh; int qb; };
struct StaticOrder {
  int vcu, G;
  __device__ __forceinline__ explicit StaticOrder(int grid,int v):vcu(v),G(grid){}
  __device__ __forceinline__ bool next(int i,AttnUnit&u)const{ const int L=i*G+vcu; if(L>=BATCH*NHEAD*NQB)return false; const int r=L>>8, idx=L&255, k=idx&7; u.bh=idx>>3; u.qb=(r==0)?(NQB-1-k):k; return true; }
  __device__ __forceinline__ void a_ready(const AttnUnit&)const{}
  __device__ __forceinline__ void done(const AttnUnit&)const{}
};
template<class Sched,int THRL=8> __device__ __forceinline__ void attn_phase(char*lds,const AttnTensors&T,const Sched&S){
  AttnUnit u;
  for(int i=0;S.next(i,u);++i){ S.a_ready(u); attn_unit<THRL>(u.bh/NHEAD,u.bh%NHEAD,u.qb,T.Q,T.K,T.V,T.O,T.C2T+(size_t)u.bh*SEQ,T.M2,lds); S.done(u); }
}
#undef SBAR
#undef WAIT_BAR
}

constexpr int NWAVES = 8, NTHR = 512;
constexpr int DM = 1024, NB = 4, SEQ = 4096, DB = 128, DSEQ = 8, PAST = 2048, PAGE = 128, NPAGES = 16;
constexpr int MP = NB * SEQ, MS = DB * DSEQ, M = MP + MS;
constexpr int DP = 512, DA = 512, NH = 8, HD = 64, DIN = 4104, NPROJ = 4096;
constexpr int NKEYS = 128, NEXP = 16384, PH = 8, TOPK = 16, DKH = 128, DQ = 2048;
constexpr float EPS = 1e-6f;
constexpr float LOG2E = 1.4426950408889634f;
constexpr float C2 = 0.125f * LOG2E;
constexpr size_t O_YP = 0, O_YS = O_YP + (size_t)MP * DM, O_KP = O_YS + (size_t)MS * DM, O_VP = O_KP + (size_t)MP * DA, O_LFP = O_VP + (size_t)MP * DA,
                 O_PP = O_LFP + (size_t)MP * NH, O_KS = O_PP + (size_t)NB * 15 * DP, O_VS = O_KS + (size_t)MS * DA, O_LFS = O_VS + (size_t)MS * DA,
                 O_PS = O_LFS + (size_t)MS * NH, O_END = O_PS + (size_t)DB * 15 * DP;
constexpr size_t MiB = 1u << 20;
constexpr size_t WS_CTL = 0, CTL_ZERO_BYTES = 1 * MiB;
constexpr size_t WS_WIN = 2 * MiB, WS_WBP = 10 * MiB, WS_WBA = 11 * MiB, WS_WOUT = 12 * MiB, WS_WQ = 14 * MiB, WS_SUBK = 18 * MiB, WS_CP2 = 19 * MiB, WS_RSS = 20 * MiB;
constexpr size_t WS_PU = 32 * MiB, WS_PV = 64 * MiB, WS_XN = 96 * MiB  , WS_U = 132 * MiB, WS_Q = 150 * MiB, WS_K = 168 * MiB, WS_V = 186 * MiB,
                 WS_GA = 204 * MiB, WS_GB = 240 * MiB, WS_PO = 276 * MiB, WS_AO = 294 * MiB, WS_T = 312 * MiB, WS_MIX = 348 * MiB, WS_PQ = 384 * MiB,
                 WS_SI = 456 * MiB, WS_SG = 466 * MiB, WS_H = 476 * MiB, WS_END = 548 * MiB;
constexpr int CW_BAR = 4096;
constexpr int LDS_BYTES = 163840;
constexpr int SCR_BYTES = 159 * 1024;
constexpr int MISC_OFF = SCR_BYTES;

typedef unsigned short bf16;
typedef unsigned v4u __attribute__((ext_vector_type(4)));
typedef unsigned v2u __attribute__((ext_vector_type(2)));
typedef float f32x4 __attribute__((ext_vector_type(4)));
typedef float f32x2 __attribute__((ext_vector_type(2)));

__device__ __forceinline__ float bf2f(unsigned short b) { return __uint_as_float((unsigned)b << 16); }
__device__ __forceinline__ float bflo(unsigned w) { return __uint_as_float(w << 16); }
__device__ __forceinline__ float bfhi(unsigned w) { return __uint_as_float(w & 0xffff0000u); }
typedef __bf16 bf16x2_t __attribute__((ext_vector_type(2)));
__device__ __forceinline__ unsigned pkbf(float lo, float hi) { f32x2 v = {lo, hi}; bf16x2_t b = __builtin_convertvector(v, bf16x2_t); return __builtin_bit_cast(unsigned, b); }
__device__ __forceinline__ float wave_sum(float v) {
#pragma unroll
    for (int o = 1; o < 64; o <<= 1) v += __shfl_xor(v, o);
    return v;
}
__device__ __forceinline__ float wave_max(float v) {
#pragma unroll
    for (int o = 1; o < 64; o <<= 1) v = fmaxf(v, __shfl_xor(v, o));
    return v;
}

struct Args {
    const float* x_p; const float* x_s; const float* cache_k; const float* cache_v; const float* cache_lf; const float* state_pool; const int* page_table;
    const float* norm_mix_g; const float* w_in; const float* b_forget; const float* q_norm_g; const float* k_norm_g; const float* pool_mix_w; const float* pool_scale;
    const float* w_bp; const float* w_ba; const float* w_out; const float* norm_ffn_g; const float* w_query; const float* sub_keys; const float* peer_u; const float* peer_v;
    float* out; unsigned char* ws; int ph_lo, ph_hi, li, pad;
};

using pg8::Unit;
struct EpiInProj {
    static constexpr bool PERM = true, AFTER_DRAIN = false;
    bf16 *U, *Q, *K, *V, *GA, *GB; float* out; const float *gq, *gk;
    __device__ __forceinline__ void operator()(const f32x4 (&acc)[2][2][4][2], const Unit& u, int wr, int wc, int fr, int fq) const {
        const int pn = u.pn; const int row0 = u.pm * 256 + wr * 64 + fr; const bool prompt = u.pm < (MP / 256);
        if (pn < 2) {
#pragma unroll
            for (int ai = 0; ai < 2; ++ai)
#pragma unroll
                for (int m = 0; m < 4; ++m) { const int row = row0 + ai * 128 + m * 16;
                    float* tail = nullptr;
                    if (prompt) { const int s = row & (SEQ - 1), b = row >> 12; if (s >= SEQ - 15) tail = out + O_PP + (size_t)(b * 15 + (s - (SEQ - 15))) * DP; }
                    else { const int rs = row - MP; tail = out + O_PS + (size_t)((rs >> 3) * 15 + 7 + (rs & 7)) * DP; }
#pragma unroll
                    for (int bj = 0; bj < 2; ++bj) { const int col = pn * 256 + bj * 128 + wc * 32 + 8 * fq; const f32x4 v0 = acc[ai][bj][m][0], v1 = acc[ai][bj][m][1];
                        v4u w; w.x = pkbf(v0[0], v0[1]); w.y = pkbf(v0[2], v0[3]); w.z = pkbf(v1[0], v1[1]); w.w = pkbf(v1[2], v1[3]);
                        *(v4u*)(U + (size_t)row * DP + col) = w;
                        if (tail) { *(f32x4*)(tail + col) = v0; *(f32x4*)(tail + col + 4) = v1; } } }
        } else if (pn < 6) {
            const bool isq = pn < 4; const int head = 4 * (pn & 1) + wc; const float* g = isq ? gq : gk;
            f32x4 gv[2][2];
#pragma unroll
            for (int bj = 0; bj < 2; ++bj)
#pragma unroll
                for (int n = 0; n < 2; ++n) gv[bj][n] = *(const f32x4*)(g + 32 * bj + 8 * fq + 4 * n);
            bf16* dst = isq ? Q : K;
#pragma unroll
            for (int ai = 0; ai < 2; ++ai)
#pragma unroll
                for (int m = 0; m < 4; ++m) { const int row = row0 + ai * 128 + m * 16; float ss = 0.f;
#pragma unroll
                    for (int bj = 0; bj < 2; ++bj)
#pragma unroll
                        for (int n = 0; n < 2; ++n) { const f32x4 x = acc[ai][bj][m][n]; ss += (x[0] * x[0] + x[1] * x[1]) + (x[2] * x[2] + x[3] * x[3]); }
                    ss += __shfl_xor(ss, 16); ss += __shfl_xor(ss, 32);
                    float r = 1.0f / sqrtf(ss * (1.0f / 64.0f) + EPS);
                    float* kout = isq ? nullptr : (prompt ? out + O_KP + (size_t)row * DA : out + O_KS + (size_t)(row - MP) * DA);
                    const float rq = isq ? r * C2 : r;
#pragma unroll
                    for (int bj = 0; bj < 2; ++bj) { const int col = head * 64 + 32 * bj + 8 * fq; const f32x4 v0 = acc[ai][bj][m][0] * gv[bj][0] * rq, v1 = acc[ai][bj][m][1] * gv[bj][1] * rq;
                        v4u w; w.x = pkbf(v0[0], v0[1]); w.y = pkbf(v0[2], v0[3]); w.z = pkbf(v1[0], v1[1]); w.w = pkbf(v1[2], v1[3]);
                        *(v4u*)(dst + (size_t)row * DA + col) = w;
                        if (!isq) { *(f32x4*)(kout + col) = v0; *(f32x4*)(kout + col + 4) = v1; } } }
        } else if (pn < 8) {
#pragma unroll
            for (int ai = 0; ai < 2; ++ai)
#pragma unroll
                for (int m = 0; m < 4; ++m) { const int row = row0 + ai * 128 + m * 16;
                    float* vout = prompt ? out + O_VP + (size_t)row * DA : out + O_VS + (size_t)(row - MP) * DA;
#pragma unroll
                    for (int bj = 0; bj < 2; ++bj) { const int col = (pn - 6) * 256 + bj * 128 + wc * 32 + 8 * fq; const f32x4 v0 = acc[ai][bj][m][0], v1 = acc[ai][bj][m][1];
                        v4u w; w.x = pkbf(v0[0], v0[1]); w.y = pkbf(v0[2], v0[3]); w.z = pkbf(v1[0], v1[1]); w.w = pkbf(v1[2], v1[3]);
                        *(v4u*)(V + (size_t)row * DA + col) = w; *(f32x4*)(vout + col) = v0; *(f32x4*)(vout + col + 4) = v1; } }
        } else {
            bf16* dst = pn < 12 ? GA : GB; const int ct = (pn < 12 ? pn - 8 : pn - 12) * 256;
#pragma unroll
            for (int ai = 0; ai < 2; ++ai)
#pragma unroll
                for (int m = 0; m < 4; ++m) { const int row = row0 + ai * 128 + m * 16;
#pragma unroll
                    for (int bj = 0; bj < 2; ++bj) { const int col = ct + bj * 128 + wc * 32 + 8 * fq; float s[8];
#pragma unroll
                        for (int n = 0; n < 2; ++n)
#pragma unroll
                            for (int i = 0; i < 4; ++i) s[4 * n + i] = __builtin_amdgcn_rcpf(1.0f + __builtin_amdgcn_exp2f(-LOG2E * acc[ai][bj][m][n][i]));
                        v4u w; w.x = pkbf(s[0], s[1]); w.y = pkbf(s[2], s[3]); w.z = pkbf(s[4], s[5]); w.w = pkbf(s[6], s[7]);
                        *(v4u*)(dst + (size_t)row * DM + col) = w; } }
        }
    }
};
template <int MODE> struct EpiGate {
    static constexpr bool PERM = true, AFTER_DRAIN = false;
    const bf16* G; const bf16* Tin; bf16* O;
    __device__ __forceinline__ void operator()(const f32x4 (&acc)[2][2][4][2], const Unit& u, int wr, int wc, int fr, int fq) const {
        const int row0 = u.pm * 256 + wr * 64 + fr;
#pragma unroll
        for (int ai = 0; ai < 2; ++ai)
#pragma unroll
            for (int m = 0; m < 4; ++m) { const int row = row0 + ai * 128 + m * 16;
#pragma unroll
                for (int bj = 0; bj < 2; ++bj) { const size_t off = (size_t)row * DM + u.pn * 256 + bj * 128 + wc * 32 + 8 * fq;
                    const v4u g = *(const v4u*)(G + off); const f32x4 v0 = acc[ai][bj][m][0], v1 = acc[ai][bj][m][1];
                    float r[8] = {v0[0] * bflo(g.x), v0[1] * bfhi(g.x), v0[2] * bflo(g.y), v0[3] * bfhi(g.y), v1[0] * bflo(g.z), v1[1] * bfhi(g.z), v1[2] * bflo(g.w), v1[3] * bfhi(g.w)};
                    if (MODE == 1) { const v4u t = *(const v4u*)(Tin + off);
                        r[0] += bflo(t.x); r[1] += bfhi(t.x); r[2] += bflo(t.y); r[3] += bfhi(t.y); r[4] += bflo(t.z); r[5] += bfhi(t.z); r[6] += bflo(t.w); r[7] += bfhi(t.w); }
                    v4u w; w.x = pkbf(r[0], r[1]); w.y = pkbf(r[2], r[3]); w.z = pkbf(r[4], r[5]); w.w = pkbf(r[6], r[7]);
                    *(v4u*)(O + off) = w; } }
    }
};
struct EpiOut {
    static constexpr bool PERM = true, AFTER_DRAIN = false;
    const float* xp; const float* xs; float* H; bf16* HG; const float* gf; float* RSS;
    __device__ __forceinline__ void operator()(const f32x4 (&acc)[2][2][4][2], const Unit& u, int wr, int wc, int fr, int fq) const {
        const int row0 = u.pm * 256 + wr * 64 + fr; const bool prompt = u.pm < (MP / 256);
        f32x4 gv[2][2];
#pragma unroll
        for (int bj = 0; bj < 2; ++bj)
#pragma unroll
            for (int n = 0; n < 2; ++n) gv[bj][n] = *(const f32x4*)(gf + u.pn * 256 + bj * 128 + wc * 32 + 8 * fq + 4 * n);
#pragma unroll
        for (int ai = 0; ai < 2; ++ai)
#pragma unroll
            for (int m = 0; m < 4; ++m) { const int row = row0 + ai * 128 + m * 16; float ss = 0.f;
                const float* xr = prompt ? xp + (size_t)row * DM : xs + (size_t)(row - MP) * DM;
#pragma unroll
                for (int bj = 0; bj < 2; ++bj) { const int col = u.pn * 256 + bj * 128 + wc * 32 + 8 * fq;
                    const f32x4 h0 = acc[ai][bj][m][0] + *(const f32x4*)(xr + col), h1 = acc[ai][bj][m][1] + *(const f32x4*)(xr + col + 4);
                    ss += (h0[0] * h0[0] + h0[1] * h0[1]) + (h0[2] * h0[2] + h0[3] * h0[3]) + (h1[0] * h1[0] + h1[1] * h1[1]) + (h1[2] * h1[2] + h1[3] * h1[3]);
                    *(f32x4*)(H + (size_t)row * DM + col) = h0; *(f32x4*)(H + (size_t)row * DM + col + 4) = h1;
                    const f32x4 a0 = h0 * gv[bj][0], a1 = h1 * gv[bj][1];
                    v4u w; w.x = pkbf(a0[0], a0[1]); w.y = pkbf(a0[2], a0[3]); w.z = pkbf(a1[0], a1[1]); w.w = pkbf(a1[2], a1[3]);
                    *(v4u*)(HG + (size_t)row * DM + col) = w; }
                ss += __shfl_xor(ss, 16); ss += __shfl_xor(ss, 32);
                if (fq == 0) RSS[(size_t)row * 16 + u.pn * 4 + wc] = ss; }
    }
};

struct Frame {
    LAS unsigned char* lds; volatile LAS unsigned* MISC; gu32* ctl;
    int tid, lane, wave, vcu, G;
};

__device__ __forceinline__ void transpose_item(const float* W, int ldw, int K, bf16* WT, int src_col0, int dst_row0, int k0, LAS float* scr, int lane) {
#pragma unroll 8
    for (int i = 0; i < 32; ++i) { const int kk = 2 * i + (lane >> 5); scr[kk * 33 + (lane & 31)] = W[(size_t)(k0 + kk) * ldw + src_col0 + (lane & 31)]; }
    LDS_WAIT(); asm volatile("" ::: "memory");
    const int c = lane & 7;
#pragma unroll
    for (int j = 0; j < 4; ++j) { const int n = (lane >> 3) + 8 * j; const LAS float* s = scr + (8 * c) * 33 + n;
        v4u o; o.x = pkbf(s[0 * 33], s[1 * 33]); o.y = pkbf(s[2 * 33], s[3 * 33]); o.z = pkbf(s[4 * 33], s[5 * 33]); o.w = pkbf(s[6 * 33], s[7 * 33]);
        *(v4u*)(WT + (size_t)(dst_row0 + n) * K + k0 + 8 * c) = o; }
    LDS_WAIT(); asm volatile("" ::: "memory");
}
__device__ __forceinline__ int win_src_col(int db) {
    if (db < 16) return 32 * db;
    if (db < 48) { const int base = db < 32 ? 512 : 1024; const int local = (db - 16) & 15, tile = local >> 3, blk = local & 7, bj = blk >> 2, w = blk & 3; return base + tile * 256 + 64 * w + 32 * bj; }
    if (db < 64) return 1536 + 32 * (db - 48);
    if (db < 96) return 2056 + 32 * (db - 64);
    return 3080 + 32 * (db - 96);
}
__device__ __forceinline__ void cvt_rows_bf16(const float* src, bf16* dst, size_t n8, size_t gtid, size_t gn) {
    for (size_t i = gtid; i < n8; i += gn) { const f32x4 a = *(const f32x4*)(src + 8 * i), b = *(const f32x4*)(src + 8 * i + 4);
        v4u w; w.x = pkbf(a[0], a[1]); w.y = pkbf(a[2], a[3]); w.z = pkbf(b[0], b[1]); w.w = pkbf(b[2], b[3]); *(v4u*)(dst + 8 * i) = w; }
}
__device__ __forceinline__ void p0_prologue(Frame& F, const Args& a) {
    unsigned char* ws = a.ws;
    LAS float* scr = (LAS float*)(F.lds + F.wave * 16384);
    const int gw = F.vcu * NWAVES + F.wave, NGW = F.G * NWAVES;
    for (int it = gw; it < 4096; it += NGW) {
        int r = it;
        if (r < 2048) { const int kb = r >> 7, db = r & 127; transpose_item(a.w_in, DIN, DM, (bf16*)(ws + WS_WIN), win_src_col(db), 32 * db, 64 * kb, scr, F.lane); continue; } r -= 2048;
        if (r < 256) { const int kb = r >> 5, nb = r & 31; transpose_item(a.w_bp, DM, DP, (bf16*)(ws + WS_WBP), 32 * nb, 32 * nb, 64 * kb, scr, F.lane); continue; } r -= 256;
        if (r < 256) { const int kb = r >> 5, nb = r & 31; transpose_item(a.w_ba, DM, DA, (bf16*)(ws + WS_WBA), 32 * nb, 32 * nb, 64 * kb, scr, F.lane); continue; } r -= 256;
        if (r < 512) { const int kb = r >> 5, nb = r & 31; transpose_item(a.w_out, DM, DM, (bf16*)(ws + WS_WOUT), 32 * nb, 32 * nb, 64 * kb, scr, F.lane); continue; } r -= 512;
        { const int kb = r >> 6, nb = r & 63; transpose_item(a.w_query, DQ, DM, (bf16*)(ws + WS_WQ), 32 * nb, 32 * nb, 64 * kb, scr, F.lane); }
    }
    { const size_t gtid = (size_t)F.vcu * NTHR + F.tid, gn = (size_t)F.G * NTHR;
      cvt_rows_bf16(a.peer_u, (bf16*)(ws + WS_PU), (size_t)NEXP * DM / 8, gtid, gn);
      cvt_rows_bf16(a.peer_v, (bf16*)(ws + WS_PV), (size_t)NEXP * DM / 8, gtid, gn);
      cvt_rows_bf16(a.sub_keys, (bf16*)(ws + WS_SUBK), (size_t)PH * 2 * NKEYS * DKH / 8, gtid, gn);
      for (size_t i = gtid; i < (size_t)DB * 7 * DP; i += gn) { const int b = (int)(i / (7 * DP)), j = (int)((i / DP) % 7), c = (int)(i % DP);
          a.out[O_PS + (size_t)(b * 15 + j) * DP + c] = a.state_pool[(size_t)(b * 15 + 8 + j) * DP + c]; } }
    __syncthreads();
    LAS float* wfT = (LAS float*)F.lds;
    for (int i = F.tid; i < 8 * DM; i += NTHR) { const int col = i >> 3, h = i & 7; wfT[h * DM + col] = a.w_in[(size_t)col * DIN + 2048 + h]; }
    __syncthreads();
    bf16* XN = (bf16*)(ws + WS_XN);
    for (int row = gw; row < M; row += NGW) {
        const float* xr = row < MP ? a.x_p + (size_t)row * DM : a.x_s + (size_t)(row - MP) * DM;
        f32x4 v[4]; float ss = 0.f;
#pragma unroll
        for (int j = 0; j < 4; ++j) { v[j] = *(const f32x4*)(xr + 256 * j + 4 * F.lane); ss += (v[j][0] * v[j][0] + v[j][1] * v[j][1]) + (v[j][2] * v[j][2] + v[j][3] * v[j][3]); }
        const float r = 1.0f / sqrtf(wave_sum(ss) * (1.0f / DM) + EPS);
        float f[8];
#pragma unroll
        for (int h = 0; h < 8; ++h) f[h] = 0.f;
#pragma unroll
        for (int j = 0; j < 4; ++j) { const f32x4 g = *(const f32x4*)(a.norm_mix_g + 256 * j + 4 * F.lane); v[j] = v[j] * r * g;
            v2u w; w.x = pkbf(v[j][0], v[j][1]); w.y = pkbf(v[j][2], v[j][3]); *(v2u*)(XN + (size_t)row * DM + 256 * j + 4 * F.lane) = w;
#pragma unroll
            for (int h = 0; h < 8; ++h) { const f32x4 wv = *(const LAS f32x4*)(wfT + h * DM + 256 * j + 4 * F.lane); f[h] += (v[j][0] * wv[0] + v[j][1] * wv[1]) + (v[j][2] * wv[2] + v[j][3] * wv[3]); } }
        float mine = 0.f;
#pragma unroll
        for (int h = 0; h < 8; ++h) { const float s = wave_sum(f[h]); if (F.lane == h) mine = s; }
        if (F.lane < 8) { const float z = mine + a.b_forget[F.lane]; const float lf = fminf(z, 0.f) - log1pf(expf(-fabsf(z)));
            if (row < MP) a.out[O_LFP + (size_t)row * NH + F.lane] = lf; else a.out[O_LFS + (size_t)(row - MP) * NH + F.lane] = lf; }
    }
}

__device__ __forceinline__ void p2_cumsum_pool(Frame& F, const Args& a) {
    unsigned char* ws = a.ws;
    { const int gw = F.vcu * NWAVES + F.wave; float* CP2 = (float*)(ws + WS_CP2);
      if (gw < NB * NH) { const int b = gw >> 3, h = gw & 7; float carry = 0.f;
          for (int c = 0; c < SEQ / 64; ++c) { float v = a.out[O_LFP + (size_t)(b * SEQ + c * 64 + F.lane) * NH + h];
#pragma unroll
              for (int o = 1; o < 64; o <<= 1) { const float t = __shfl_up(v, o); if (F.lane >= o) v += t; }
              v += carry; CP2[(size_t)gw * SEQ + c * 64 + F.lane] = v * LOG2E; carry = __shfl(v, 63); } } }
    const bf16* U = (const bf16*)(ws + WS_U); bf16* PO = (bf16*)(ws + WS_PO);
    LAS float* pw = (LAS float*)F.lds;
    LAS float* mt = (LAS float*)(F.lds + 65536);
    int cur_g = -1;
    for (int unit = blockIdx.x; unit < 4 * (M / 32); unit += F.G) {
        const int g = unit / (M / 32), tile = unit % (M / 32);
        __syncthreads();
        if (g != cur_g) { for (int i = F.tid; i < 128 * 128 / 4; i += NTHR) *(LAS f32x4*)(pw + 4 * i) = *(const f32x4*)(a.pool_mix_w + (size_t)g * 16384 + 4 * i); cur_g = g; }
        { const int r = F.tid >> 4, c8 = (F.tid & 15) * 8, ch = g * 128 + c8, row = tile * 32 + r, w = 2 << g;
          float sum[8], self[8];
#pragma unroll
          for (int i = 0; i < 8; ++i) sum[i] = 0.f;
          float cnt;
          if (row < MP) { const int s = row & (SEQ - 1); cnt = (float)(s + 1 < w ? s + 1 : w);
              for (int i = 0; i < w; ++i) if (s - i >= 0) { const v4u q = *(const v4u*)(U + (size_t)(row - i) * DP + ch);
                  const float e[8] = {bflo(q.x), bfhi(q.x), bflo(q.y), bfhi(q.y), bflo(q.z), bfhi(q.z), bflo(q.w), bfhi(q.w)};
#pragma unroll
                  for (int k = 0; k < 8; ++k) { sum[k] += e[k]; if (i == 0) self[k] = e[k]; } }
          } else { const int rs = row - MP, b = rs >> 3, t = rs & 7; cnt = (float)w;
              for (int i = 0; i < w; ++i) { const int tt = t - i; float e[8];
                  if (tt >= 0) { const v4u q = *(const v4u*)(U + (size_t)(MP + b * 8 + tt) * DP + ch);
                      e[0] = bflo(q.x); e[1] = bfhi(q.x); e[2] = bflo(q.y); e[3] = bfhi(q.y); e[4] = bflo(q.z); e[5] = bfhi(q.z); e[6] = bflo(q.w); e[7] = bfhi(q.w); }
                  else { const f32x4 p0 = *(const f32x4*)(a.state_pool + (size_t)(b * 15 + 15 + tt) * DP + ch), p1 = *(const f32x4*)(a.state_pool + (size_t)(b * 15 + 15 + tt) * DP + ch + 4);
                      e[0] = p0[0]; e[1] = p0[1]; e[2] = p0[2]; e[3] = p0[3]; e[4] = p1[0]; e[5] = p1[1]; e[6] = p1[2]; e[7] = p1[3]; }
#pragma unroll
                  for (int k = 0; k < 8; ++k) { sum[k] += e[k]; if (i == 0) self[k] = e[k]; } } }
          const float inv = 1.0f / cnt;
#pragma unroll
          for (int k = 0; k < 8; ++k) mt[r * 132 + c8 + k] = sum[k] * inv - self[k]; }
        __syncthreads();
        { const int r = F.tid >> 4, d8 = (F.tid & 15) * 8, row = tile * 32 + r; float acc[8];
#pragma unroll
          for (int k = 0; k < 8; ++k) acc[k] = 0.f;
#pragma unroll 4
          for (int c = 0; c < 128; ++c) { const float mv = mt[r * 132 + c]; const f32x4 w0 = *(const LAS f32x4*)(pw + c * 128 + d8), w1 = *(const LAS f32x4*)(pw + c * 128 + d8 + 4);
              acc[0] += mv * w0[0]; acc[1] += mv * w0[1]; acc[2] += mv * w0[2]; acc[3] += mv * w0[3]; acc[4] += mv * w1[0]; acc[5] += mv * w1[1]; acc[6] += mv * w1[2]; acc[7] += mv * w1[3]; }
          const f32x4 s0 = *(const f32x4*)(a.pool_scale + g * 128 + d8), s1 = *(const f32x4*)(a.pool_scale + g * 128 + d8 + 4);
          v4u o; o.x = pkbf(acc[0] * s0[0], acc[1] * s0[1]); o.y = pkbf(acc[2] * s0[2], acc[3] * s0[3]); o.z = pkbf(acc[4] * s1[0], acc[5] * s1[1]); o.w = pkbf(acc[6] * s1[2], acc[7] * s1[3]);
          *(v4u*)(PO + (size_t)row * DP + g * 128 + d8) = o; }
    }
}

__device__ __forceinline__ float attn_bound2(const Args& a, int lane) {
    const float gq = wave_max(fabsf(a.q_norm_g[lane])), gk = wave_max(fabsf(a.k_norm_g[lane]));
    return 64.0f * C2 * gq * gk * 1.03f;
}

__device__ __forceinline__ void p3_prompt_attn_naive(Frame& F, const Args& a) {
    unsigned char* ws = a.ws;
    const bf16* Q = (const bf16*)(ws + WS_Q); const bf16* K = (const bf16*)(ws + WS_K); const bf16* V = (const bf16*)(ws + WS_V); bf16* AO = (bf16*)(ws + WS_AO);
    const float* CP2 = (const float*)(ws + WS_CP2);
    LAS float* Ks = (LAS float*)F.lds;
    LAS float* Vs = (LAS float*)(F.lds + 16384);
    LAS float* cks = (LAS float*)(F.lds + 32768);
    const float M2 = attn_bound2(a, F.lane);
    for (int unit = blockIdx.x; unit < NB * NH * (SEQ / 512); unit += F.G) {
        const int bh = unit & 31, qblk = 7 - (unit >> 5), b = bh >> 3, h = bh & 7;
        const int i = qblk * 512 + F.tid; const size_t qrow = (size_t)(b * SEQ + i);
        float q[64], o[64];
#pragma unroll
        for (int d8 = 0; d8 < 8; ++d8) { const v4u w = *(const v4u*)(Q + qrow * DA + h * 64 + d8 * 8);
            q[d8 * 8 + 0] = bflo(w.x); q[d8 * 8 + 1] = bfhi(w.x); q[d8 * 8 + 2] = bflo(w.y); q[d8 * 8 + 3] = bfhi(w.y); q[d8 * 8 + 4] = bflo(w.z); q[d8 * 8 + 5] = bfhi(w.z); q[d8 * 8 + 6] = bflo(w.w); q[d8 * 8 + 7] = bfhi(w.w); }
#pragma unroll
        for (int d = 0; d < 64; ++d) o[d] = 0.f;
        const float cq = CP2[(size_t)bh * SEQ + i] - M2; float l = 0.f;
        const int ntile = (qblk + 1) * 8;
        for (int jt = 0; jt < ntile; ++jt) {
            __syncthreads();
            { const int kr = F.tid >> 3, d8 = (F.tid & 7) * 8; const size_t krow = (size_t)(b * SEQ + jt * 64 + kr);
              const v4u kw = *(const v4u*)(K + krow * DA + h * 64 + d8), vw = *(const v4u*)(V + krow * DA + h * 64 + d8);
              LAS float* kd = Ks + kr * 64 + d8; LAS float* vd = Vs + kr * 64 + d8;
              *(LAS f32x4*)kd = (f32x4){bflo(kw.x), bfhi(kw.x), bflo(kw.y), bfhi(kw.y)}; *(LAS f32x4*)(kd + 4) = (f32x4){bflo(kw.z), bfhi(kw.z), bflo(kw.w), bfhi(kw.w)};
              *(LAS f32x4*)vd = (f32x4){bflo(vw.x), bfhi(vw.x), bflo(vw.y), bfhi(vw.y)}; *(LAS f32x4*)(vd + 4) = (f32x4){bflo(vw.z), bfhi(vw.z), bflo(vw.w), bfhi(vw.w)};
              if (F.tid < 64) cks[F.tid] = CP2[(size_t)bh * SEQ + jt * 64 + F.tid]; }
            __syncthreads();
            for (int j = 0; j < 64; ++j) {
                float s = 0.f;
#pragma unroll
                for (int d4 = 0; d4 < 16; ++d4) { const f32x4 kv = *(const LAS f32x4*)(Ks + j * 64 + d4 * 4); s += (q[d4 * 4] * kv[0] + q[d4 * 4 + 1] * kv[1]) + (q[d4 * 4 + 2] * kv[2] + q[d4 * 4 + 3] * kv[3]); }
                float p = __builtin_amdgcn_exp2f(s + cq - cks[j]); if (jt * 64 + j > i) p = 0.f;
                l += p;
#pragma unroll
                for (int d4 = 0; d4 < 16; ++d4) { const f32x4 vv = *(const LAS f32x4*)(Vs + j * 64 + d4 * 4); o[d4 * 4] += p * vv[0]; o[d4 * 4 + 1] += p * vv[1]; o[d4 * 4 + 2] += p * vv[2]; o[d4 * 4 + 3] += p * vv[3]; }
            }
        }
        const float il = 1.0f / l;
#pragma unroll
        for (int d8 = 0; d8 < 8; ++d8) { v4u w; w.x = pkbf(o[d8 * 8] * il, o[d8 * 8 + 1] * il); w.y = pkbf(o[d8 * 8 + 2] * il, o[d8 * 8 + 3] * il); w.z = pkbf(o[d8 * 8 + 4] * il, o[d8 * 8 + 5] * il); w.w = pkbf(o[d8 * 8 + 6] * il, o[d8 * 8 + 7] * il);
            *(v4u*)(AO + qrow * DA + h * 64 + d8 * 8) = w; }
    }
}

__device__ __forceinline__ void p3_sample_attn(Frame& F, const Args& a, const float M2) {
    unsigned char* ws = a.ws;
    const bf16* Q = (const bf16*)(ws + WS_Q); bf16* AO = (bf16*)(ws + WS_AO);
    LAS float* qs = (LAS float*)F.lds;
    LAS float* lfp = (LAS float*)(F.lds + 2048);
    LAS float* E2 = (LAS float*)(F.lds + 2048 + 8192);
    LAS float* sc = (LAS float*)(F.lds + 12288);
    LAS float* Op = (LAS float*)(F.lds + 12288 + 16384);
    LAS float* lp = (LAS float*)(F.lds + 12288 + 32768);
    const int lane = F.lane, w = F.wave;
    for (int unit = blockIdx.x; unit < DB * NH; unit += F.G) {
        const int b = unit >> 3, h = unit & 7;
        __syncthreads();
        { const int t = F.tid >> 6, d = F.tid & 63; qs[t * 64 + d] = bf2f(Q[(size_t)(MP + b * 8 + t) * DA + h * 64 + d]); }
        for (int j = F.tid; j < PAST; j += NTHR) { const int pg = a.page_table[b * NPAGES + (j >> 7)]; lfp[j] = a.cache_lf[((size_t)pg * PAGE + (j & 127)) * NH + h]; }
        __syncthreads();
        if (w == 0) {
            float loc[32]; float tot = 0.f;
#pragma unroll
            for (int k = 31; k >= 0; --k) { loc[k] = tot; tot += lfp[lane * 32 + k]; }
            float inc = tot;
#pragma unroll
            for (int o = 1; o < 64; o <<= 1) { const float t = __shfl_down(inc, o); if (lane + o < 64) inc += t; }
            const float excl = inc - tot;
#pragma unroll
            for (int k = 0; k < 32; ++k) lfp[lane * 32 + k] = (loc[k] + excl) * LOG2E;
            if (lane < 8) { float e = 0.f; for (int t = 0; t <= lane; ++t) e += a.out[O_LFS + (size_t)(b * 8 + t) * NH + h]; E2[lane] = e * LOG2E; }
        }
        __syncthreads();
        f32x4 qp[8];
#pragma unroll
        for (int t = 0; t < 8; ++t) qp[t] = *(const LAS f32x4*)(qs + t * 64 + 4 * (lane & 15));
        float e2[8];
#pragma unroll
        for (int t = 0; t < 8; ++t) e2[t] = E2[t] - M2;
        float o[8], lsum[8];
#pragma unroll
        for (int t = 0; t < 8; ++t) { o[t] = 0.f; lsum[t] = 0.f; }
        LAS float* scw = sc + w * 512;
        const int nblk = (w == 0) ? 5 : 4;
        for (int blk = 0; blk < nblk; ++blk) {
            const bool isnew = blk == 4;
            for (int gi = 0; gi < (isnew ? 2 : 16); ++gi) {
                const int kk = 4 * gi + (lane >> 4);
                const float* kp;
                if (!isnew) { const int j = w * 256 + blk * 64 + kk; const int pg = a.page_table[b * NPAGES + (j >> 7)]; kp = a.cache_k + (((size_t)pg * PAGE + (j & 127)) * NH + h) * HD; }
                else kp = a.out + O_KS + (size_t)(b * 8 + kk) * DA + h * HD;
                const f32x4 k4 = *(const f32x4*)(kp + 4 * (lane & 15));
                float part[8];
#pragma unroll
                for (int t = 0; t < 8; ++t) part[t] = (qp[t][0] * k4[0] + qp[t][1] * k4[1]) + (qp[t][2] * k4[2] + qp[t][3] * k4[3]);
#pragma unroll
                for (int t = 0; t < 8; ++t) { part[t] += __shfl_xor(part[t], 1); part[t] += __shfl_xor(part[t], 2); part[t] += __shfl_xor(part[t], 4); part[t] += __shfl_xor(part[t], 8); }
                float mine = 0.f;
#pragma unroll
                for (int t = 0; t < 8; ++t) if ((lane & 15) == t) mine = part[t];
                if ((lane & 15) < 8) scw[kk * 8 + (lane & 15)] = mine;
            }
            LDS_WAIT(); asm volatile("" ::: "memory");
            { f32x4 s0 = *(const LAS f32x4*)(scw + lane * 8), s1 = *(const LAS f32x4*)(scw + lane * 8 + 4); float p[8];
              const float sv[8] = {s0[0], s0[1], s0[2], s0[3], s1[0], s1[1], s1[2], s1[3]};
              if (!isnew) { const float dj = lfp[w * 256 + blk * 64 + lane];
#pragma unroll
                  for (int t = 0; t < 8; ++t) p[t] = __builtin_amdgcn_exp2f(sv[t] + e2[t] + dj);
              } else {
#pragma unroll
                  for (int t = 0; t < 8; ++t) { const float ek = E2[lane & 7]; p[t] = (lane <= t) ? __builtin_amdgcn_exp2f(sv[t] + e2[t] - ek) : 0.f; }
              }
#pragma unroll
              for (int t = 0; t < 8; ++t) lsum[t] += p[t];
              *(LAS f32x4*)(scw + lane * 8) = (f32x4){p[0], p[1], p[2], p[3]}; *(LAS f32x4*)(scw + lane * 8 + 4) = (f32x4){p[4], p[5], p[6], p[7]}; }
            LDS_WAIT(); asm volatile("" ::: "memory");
            for (int kk = 0; kk < (isnew ? 8 : 64); ++kk) {
                const float* vp;
                if (!isnew) { const int j = w * 256 + blk * 64 + kk; const int pg = a.page_table[b * NPAGES + (j >> 7)]; vp = a.cache_v + (((size_t)pg * PAGE + (j & 127)) * NH + h) * HD; }
                else vp = a.out + O_VS + (size_t)(b * 8 + kk) * DA + h * HD;
                const float vv = vp[lane];
                const f32x4 p0 = *(const LAS f32x4*)(scw + kk * 8), p1 = *(const LAS f32x4*)(scw + kk * 8 + 4);
                o[0] += p0[0] * vv; o[1] += p0[1] * vv; o[2] += p0[2] * vv; o[3] += p0[3] * vv; o[4] += p1[0] * vv; o[5] += p1[1] * vv; o[6] += p1[2] * vv; o[7] += p1[3] * vv;
            }
            LDS_WAIT(); asm volatile("" ::: "memory");
        }
#pragma unroll
        for (int t = 0; t < 8; ++t) { Op[(w * 8 + t) * 64 + lane] = o[t]; const float ls = wave_sum(lsum[t]); if (lane == 0) lp[w * 8 + t] = ls; }
        __syncthreads();
        { const int t = F.tid >> 6, d = F.tid & 63; float O = 0.f, L = 0.f;
#pragma unroll
          for (int ww = 0; ww < 8; ++ww) { O += Op[(ww * 8 + t) * 64 + d]; L += lp[ww * 8 + t]; }
          AO[(size_t)(MP + b * 8 + t) * DA + h * 64 + d] = (bf16)(pkbf(O / L, 0.f) & 0xffffu); }
    }
}

__device__ __forceinline__ void p7_topk_naive(Frame& F, const Args& a) {
    unsigned char* ws = a.ws;
    const bf16* PQ = (const bf16*)(ws + WS_PQ); const bf16* SK = (const bf16*)(ws + WS_SUBK); const float* RSS = (const float*)(ws + WS_RSS);
    int* SI = (int*)(ws + WS_SI); float* SG = (float*)(ws + WS_SG);
    LAS float* kT = (LAS float*)F.lds;
    LAS float* qt = (LAS float*)(F.lds + 67584);
    LAS float* sc = (LAS float*)(F.lds + 83968);
    LAS float* tps = (LAS float*)(F.lds + 100352);
    LAS int* tpi = (LAS int*)(F.lds + 100352 + 4096);
    LAS float* fs = (LAS float*)(F.lds + 100352 + 8192);
    LAS float* rs = (LAS float*)(F.lds + 100352 + 8192 + 2048);
    LAS int* cab = (LAS int*)(F.lds + 100352 + 8192 + 2048 + 128);
    if (F.tid == 0) { int n = 0; for (int ca = 0; ca < 16; ++ca) for (int cb = 0; cb < 16; ++cb) if ((ca + 1) * (cb + 1) <= 16) cab[n++] = (ca << 4) | cb; }
    for (int unit = blockIdx.x; unit < (M / 32) * PH; unit += F.G) {
        const int h = unit & 7, tile = unit >> 3, row0 = tile * 32;
        for (int p = 0; p < 2; ++p) {
            __syncthreads();
            for (int i = F.tid; i < 128 * 128 / 8; i += NTHR) { const int n = i >> 4, d8 = (i & 15) * 8; const v4u wv = *(const v4u*)(SK + ((size_t)(h * 2 + p) * NKEYS + n) * DKH + d8);
                kT[(d8 + 0) * 132 + n] = bflo(wv.x); kT[(d8 + 1) * 132 + n] = bfhi(wv.x); kT[(d8 + 2) * 132 + n] = bflo(wv.y); kT[(d8 + 3) * 132 + n] = bfhi(wv.y);
                kT[(d8 + 4) * 132 + n] = bflo(wv.z); kT[(d8 + 5) * 132 + n] = bfhi(wv.z); kT[(d8 + 6) * 132 + n] = bflo(wv.w); kT[(d8 + 7) * 132 + n] = bfhi(wv.w); }
            { const int t = F.tid >> 4, d8 = (F.tid & 15) * 8; const v4u wv = *(const v4u*)(PQ + (size_t)(row0 + t) * DQ + h * 256 + p * 128 + d8);
              *(LAS f32x4*)(qt + t * 128 + d8) = (f32x4){bflo(wv.x), bfhi(wv.x), bflo(wv.y), bfhi(wv.y)}; *(LAS f32x4*)(qt + t * 128 + d8 + 4) = (f32x4){bflo(wv.z), bfhi(wv.z), bflo(wv.w), bfhi(wv.w)}; }
            if (p == 0 && F.tid < 32) { float s = 0.f; for (int k = 0; k < 16; ++k) s += RSS[(size_t)(row0 + F.tid) * 16 + k]; rs[F.tid] = 1.0f / sqrtf(s * (1.0f / DM) + EPS); }
            __syncthreads();
            const int t = F.tid >> 4, kq = (F.tid & 15) * 8;
            float acc[8];
#pragma unroll
            for (int k = 0; k < 8; ++k) acc[k] = 0.f;
#pragma unroll 4
            for (int d = 0; d < 128; ++d) { const float qv = qt[t * 128 + d]; const f32x4 k0 = *(const LAS f32x4*)(kT + d * 132 + kq), k1 = *(const LAS f32x4*)(kT + d * 132 + kq + 4);
                acc[0] += qv * k0[0]; acc[1] += qv * k0[1]; acc[2] += qv * k0[2]; acc[3] += qv * k0[3]; acc[4] += qv * k1[0]; acc[5] += qv * k1[1]; acc[6] += qv * k1[2]; acc[7] += qv * k1[3]; }
            *(LAS f32x4*)(sc + t * 128 + kq) = (f32x4){acc[0], acc[1], acc[2], acc[3]}; *(LAS f32x4*)(sc + t * 128 + kq + 4) = (f32x4){acc[4], acc[5], acc[6], acc[7]};
            __syncthreads();
            int rank[8];
#pragma unroll
            for (int k = 0; k < 8; ++k) rank[k] = 0;
            for (int j = 0; j < 128; ++j) { const float sj = sc[t * 128 + j];
#pragma unroll
                for (int k = 0; k < 8; ++k) rank[k] += (sj > acc[k] || (sj == acc[k] && j < kq + k)) ? 1 : 0; }
#pragma unroll
            for (int k = 0; k < 8; ++k) if (rank[k] < 16) { tps[(p * 32 + t) * 16 + rank[k]] = acc[k]; tpi[(p * 32 + t) * 16 + rank[k]] = kq + k; }
        }
        __syncthreads();
        { const int t = F.tid >> 4, l16 = F.tid & 15;
          float cs[4]; int cf[4], ci[4], rk[4];
#pragma unroll
          for (int k = 0; k < 4; ++k) { const int c = l16 + 16 * k; if (c < 50) { const int ab = cab[c], ca = ab >> 4, cb = ab & 15; cs[k] = tps[t * 16 + ca] + tps[(32 + t) * 16 + cb]; cf[k] = ab; ci[k] = tpi[t * 16 + ca] * NKEYS + tpi[(32 + t) * 16 + cb]; }
              else { cs[k] = -INFINITY; cf[k] = 1 << 20; ci[k] = 0; } rk[k] = 0; }
          for (int c = 0; c < 50; ++c) { const int ab = cab[c]; const float s = tps[t * 16 + (ab >> 4)] + tps[(32 + t) * 16 + (ab & 15)];
#pragma unroll
              for (int k = 0; k < 4; ++k) rk[k] += (s > cs[k] || (s == cs[k] && ab < cf[k])) ? 1 : 0; }
#pragma unroll
          for (int k = 0; k < 4; ++k) if (l16 + 16 * k < 50 && rk[k] < 16) { fs[t * 16 + rk[k]] = cs[k]; SI[(size_t)(row0 + t) * 128 + h * 16 + rk[k]] = ci[k]; }
        }
        __syncthreads();
        { const int t = F.tid >> 4, l16 = F.tid & 15; const float z = fs[t * 16 + l16] * rs[t];
          float mx = z; mx = fmaxf(mx, __shfl_xor(mx, 1)); mx = fmaxf(mx, __shfl_xor(mx, 2)); mx = fmaxf(mx, __shfl_xor(mx, 4)); mx = fmaxf(mx, __shfl_xor(mx, 8));
          const float e = expf(z - mx); float sm = e; sm += __shfl_xor(sm, 1); sm += __shfl_xor(sm, 2); sm += __shfl_xor(sm, 4); sm += __shfl_xor(sm, 8);
          SG[(size_t)(row0 + t) * 128 + h * 16 + l16] = e / sm; }
    }
}

__device__ __forceinline__ void p8_gather_naive(Frame& F, const Args& a) {
    unsigned char* ws = a.ws;
    const bf16* HG = (const bf16*)(ws + WS_XN); const bf16* PU = (const bf16*)(ws + WS_PU); const bf16* PV = (const bf16*)(ws + WS_PV);
    const float* RSS = (const float*)(ws + WS_RSS); const int* SI = (const int*)(ws + WS_SI); const float* SG = (const float*)(ws + WS_SG);
    float* Y = a.out + O_YP;
    LAS float* wl = (LAS float*)(F.lds + F.wave * 512);
    const int gw = F.vcu * NWAVES + F.wave, NGW = F.G * NWAVES, lane = F.lane;
    for (int row = gw; row < M; row += NGW) {
        float hx[16];
        { const v4u a0 = *(const v4u*)(HG + (size_t)row * DM + 8 * lane), a1 = *(const v4u*)(HG + (size_t)row * DM + 512 + 8 * lane);
          hx[0] = bflo(a0.x); hx[1] = bfhi(a0.x); hx[2] = bflo(a0.y); hx[3] = bfhi(a0.y); hx[4] = bflo(a0.z); hx[5] = bfhi(a0.z); hx[6] = bflo(a0.w); hx[7] = bfhi(a0.w);
          hx[8] = bflo(a1.x); hx[9] = bfhi(a1.x); hx[10] = bflo(a1.y); hx[11] = bfhi(a1.y); hx[12] = bflo(a1.z); hx[13] = bfhi(a1.z); hx[14] = bflo(a1.w); hx[15] = bfhi(a1.w); }
        float ssum = (lane < 16) ? RSS[(size_t)row * 16 + lane] : 0.f; ssum = wave_sum(ssum);
        const float rstd = 1.0f / sqrtf(ssum * (1.0f / DM) + EPS);
        const int e0 = SI[(size_t)row * 128 + lane], e1 = SI[(size_t)row * 128 + 64 + lane];
        const float g0 = SG[(size_t)row * 128 + lane], g1 = SG[(size_t)row * 128 + 64 + lane];
#pragma unroll 4
        for (int k = 0; k < 128; ++k) {
            const int e = __shfl(k < 64 ? e0 : e1, k & 63);
            const v4u u0 = *(const v4u*)(PU + (size_t)e * DM + 8 * lane), u1 = *(const v4u*)(PU + (size_t)e * DM + 512 + 8 * lane);
            float d = (hx[0] * bflo(u0.x) + hx[1] * bfhi(u0.x)) + (hx[2] * bflo(u0.y) + hx[3] * bfhi(u0.y)) + (hx[4] * bflo(u0.z) + hx[5] * bfhi(u0.z)) + (hx[6] * bflo(u0.w) + hx[7] * bfhi(u0.w))
                    + (hx[8] * bflo(u1.x) + hx[9] * bfhi(u1.x)) + (hx[10] * bflo(u1.y) + hx[11] * bfhi(u1.y)) + (hx[12] * bflo(u1.z) + hx[13] * bfhi(u1.z)) + (hx[14] * bflo(u1.w) + hx[15] * bfhi(u1.w));
            d = wave_sum(d);
            if (lane == (k & 63)) { const float z = d * rstd; const float ge = 0.5f * z * (1.0f + erff(z * 0.70710678118654752f)); wl[k] = ge * (k < 64 ? g0 : g1); }
        }
        LDS_WAIT(); asm volatile("" ::: "memory");
        float o[16];
#pragma unroll
        for (int i = 0; i < 16; ++i) o[i] = 0.f;
#pragma unroll 4
        for (int k = 0; k < 128; ++k) {
            const int e = __shfl(k < 64 ? e0 : e1, k & 63); const float wv = wl[k];
            const v4u u0 = *(const v4u*)(PV + (size_t)e * DM + 8 * lane), u1 = *(const v4u*)(PV + (size_t)e * DM + 512 + 8 * lane);
            o[0] += wv * bflo(u0.x); o[1] += wv * bfhi(u0.x); o[2] += wv * bflo(u0.y); o[3] += wv * bfhi(u0.y); o[4] += wv * bflo(u0.z); o[5] += wv * bfhi(u0.z); o[6] += wv * bflo(u0.w); o[7] += wv * bfhi(u0.w);
            o[8] += wv * bflo(u1.x); o[9] += wv * bfhi(u1.x); o[10] += wv * bflo(u1.y); o[11] += wv * bfhi(u1.y); o[12] += wv * bflo(u1.z); o[13] += wv * bfhi(u1.z); o[14] += wv * bflo(u1.w); o[15] += wv * bfhi(u1.w);
        }
        LDS_WAIT(); asm volatile("" ::: "memory");
        float* yr = Y + (size_t)row * DM; const float* hr = (const float*)(ws + WS_H) + (size_t)row * DM;
        { f32x4 y0 = *(const f32x4*)(hr + 8 * lane), y1 = *(const f32x4*)(hr + 8 * lane + 4), y2 = *(const f32x4*)(hr + 512 + 8 * lane), y3 = *(const f32x4*)(hr + 512 + 8 * lane + 4);
          y0 += (f32x4){o[0], o[1], o[2], o[3]}; y1 += (f32x4){o[4], o[5], o[6], o[7]}; y2 += (f32x4){o[8], o[9], o[10], o[11]}; y3 += (f32x4){o[12], o[13], o[14], o[15]};
          *(f32x4*)(yr + 8 * lane) = y0; *(f32x4*)(yr + 8 * lane + 4) = y1; *(f32x4*)(yr + 512 + 8 * lane) = y2; *(f32x4*)(yr + 512 + 8 * lane + 4) = y3; }
    }
}


typedef float f32x16 __attribute__((ext_vector_type(16)));
typedef short bf16x8v __attribute__((ext_vector_type(8)));
__device__ __forceinline__ int f2key(float s) { int b = __builtin_bit_cast(int, s); return b ^ ((b >> 31) & 0x7fffffff); }
__device__ __forceinline__ float key2f(int k) { return __builtin_bit_cast(float, k ^ ((k >> 31) & 0x7fffffff)); }
#define CE_DESC(x, y) do { const int mx_ = (x) > (y) ? (x) : (y), mn_ = (x) > (y) ? (y) : (x); (x) = mx_; (y) = mn_; } while (0)
template <int OFF, int N, typename T> __device__ __forceinline__ void bsort_desc(T& v) {
#pragma unroll
    for (int k = 2; k <= N; k <<= 1)
#pragma unroll
        for (int j = k >> 1; j > 0; j >>= 1)
#pragma unroll
            for (int i = 0; i < N; ++i) { const int l = i ^ j; if (l > i) { if ((i & k) == 0) CE_DESC(v[OFF + i], v[OFF + l]); else CE_DESC(v[OFF + l], v[OFF + i]); } }
}
template <int OFF, typename T> __device__ __forceinline__ void bmerge16_desc(T& v) {
#pragma unroll
    for (int j = 8; j > 0; j >>= 1)
#pragma unroll
        for (int i = 0; i < 16; ++i) { const int l = i ^ j; if (l > i) CE_DESC(v[OFF + i], v[OFF + l]); }
}
template <int OA, int OB, typename T> __device__ __forceinline__ void top16_merge(T& v) {
#pragma unroll
    for (int i = 0; i < 16; ++i) v[OA + i] = v[OA + i] > v[OB + 15 - i] ? v[OA + i] : v[OB + 15 - i];
    bmerge16_desc<OA>(v);
}
template <typename T> __device__ __forceinline__ void top16_of_64(T& v) {
    bsort_desc<0, 16>(v); bsort_desc<16, 16>(v); bsort_desc<32, 16>(v); bsort_desc<48, 16>(v);
    top16_merge<0, 16>(v); top16_merge<32, 48>(v); top16_merge<0, 32>(v);
}
__device__ __forceinline__ void p7_topk(Frame& F, const Args& a) {
    unsigned char* ws = a.ws;
    const bf16* PQ = (const bf16*)(ws + WS_PQ); const bf16* SK = (const bf16*)(ws + WS_SUBK); const float* RSS = (const float*)(ws + WS_RSS);
    int* SI = (int*)(ws + WS_SI); float* SG = (float*)(ws + WS_SG);
    const int lane = F.lane, j = lane & 31, hi = lane >> 5;
    LAS unsigned* ib = (LAS unsigned*)(F.lds + F.wave * 1024);
    const int gw = F.vcu * NWAVES + F.wave, NGW = F.G * NWAVES;
    for (int item = gw; item < (M / 32) * PH; item += NGW) {
        const int h = item & 7, row0 = (item >> 3) * 32;
        int jl = j, hl = hi; asm volatile("" : "+v"(jl), "+v"(hl));
        int top[2][16];
#pragma unroll
        for (int p = 0; p < 2; ++p) {
            bf16x8v qf[8];
#pragma unroll
            for (int ks = 0; ks < 8; ++ks) qf[ks] = *(const bf16x8v*)(PQ + (size_t)(row0 + jl) * DQ + h * 256 + p * 128 + 16 * ks + 8 * hl);
            f32x16 acc[4];
#pragma unroll
            for (int mt = 0; mt < 4; ++mt) acc[mt] = f32x16{};
            const bf16* kb = SK + ((size_t)(h * 2 + p) * NKEYS + jl) * DKH + 8 * hl;
#pragma unroll
            for (int ks = 0; ks < 8; ++ks)
#pragma unroll
                for (int mt = 0; mt < 4; ++mt) { const bf16x8v af = *(const bf16x8v*)(kb + mt * 32 * DKH + ks * 16); acc[mt] = __builtin_amdgcn_mfma_f32_32x32x16_bf16(af, qf[ks], acc[mt], 0, 0, 0); }
            int v[64];
#pragma unroll
            for (int mt = 0; mt < 4; ++mt)
#pragma unroll
                for (int r = 0; r < 16; ++r) { const int n = 32 * mt + (r & 3) + 8 * (r >> 2) + 4 * hi; v[16 * mt + r] = (f2key(acc[mt][r]) & ~127) | (127 - n); }
            top16_of_64(v);
#pragma unroll
            for (int i = 0; i < 16; ++i) top[p][i] = v[i];
        }
        int S[32];
#pragma unroll
        for (int i = 0; i < 16; ++i) { auto rr = __builtin_amdgcn_permlane32_swap((unsigned)top[0][i], (unsigned)top[1][i], false, false); S[i] = (int)rr[0]; S[16 + i] = (int)rr[1]; }
        top16_merge<0, 16>(S);
        { unsigned w0 = 0, w1 = 0, w2 = 0, w3 = 0;
#pragma unroll
          for (int i = 0; i < 4; ++i) { w0 |= (unsigned)(127 - (S[i] & 127)) << (8 * i); w1 |= (unsigned)(127 - (S[4 + i] & 127)) << (8 * i); w2 |= (unsigned)(127 - (S[8 + i] & 127)) << (8 * i); w3 |= (unsigned)(127 - (S[12 + i] & 127)) << (8 * i); }
          *(LAS v4u*)(ib + (hi * 32 + j) * 4) = (v4u){w0, w1, w2, w3}; }
        float s1[16], s2[16];
#pragma unroll
        for (int i = 0; i < 16; ++i) { auto rr = __builtin_amdgcn_permlane32_swap((unsigned)S[i], (unsigned)S[i], false, false); s1[i] = key2f((int)rr[0] & ~127); s2[i] = key2f((int)rr[1] & ~127); }
        int c[64]; { int n = 0;
#pragma unroll
          for (int ca = 0; ca < 16; ++ca)
#pragma unroll
              for (int cb = 0; cb < 16; ++cb) if ((ca + 1) * (cb + 1) <= 16) { c[n] = (f2key(s1[ca] + s2[cb]) & ~255) | (255 - (ca * 16 + cb)); ++n; }
#pragma unroll
          for (int q = 50; q < 64; ++q) c[q] = (int)0x80000000; }
        top16_of_64(c);
        float ssq = 0.f;
#pragma unroll
        for (int q = 0; q < 4; ++q) { const f32x4 t4 = *(const f32x4*)(RSS + (size_t)(row0 + j) * 16 + 4 * q); ssq += (t4[0] + t4[1]) + (t4[2] + t4[3]); }
        const float rstd = 1.0f / sqrtf(ssq * (1.0f / DM) + EPS);
        const float z0 = key2f(c[0] & ~255) * rstd; float e[16], esum = 0.f;
#pragma unroll
        for (int k = 0; k < 16; ++k) { e[k] = __expf(key2f(c[k] & ~255) * rstd - z0); esum += e[k]; }
        const float inv = 1.0f / esum;
        LDS_WAIT(); asm volatile("" ::: "memory");
        const LAS unsigned char* ib8 = (const LAS unsigned char*)ib;
        int oi[8]; float og[8];
#pragma unroll
        for (int k = 0; k < 8; ++k) { const int ck = hi ? c[8 + k] : c[k]; const float ek = hi ? e[8 + k] : e[k]; const int fl = 255 - (ck & 255);
            const int i1 = ib8[(0 * 32 + j) * 16 + (fl >> 4)], i2 = ib8[(1 * 32 + j) * 16 + (fl & 15)]; oi[k] = i1 * NKEYS + i2; og[k] = ek * inv; }
        { int* sp = SI + (size_t)(row0 + j) * 128 + h * 16 + hi * 8; float* gp = SG + (size_t)(row0 + j) * 128 + h * 16 + hi * 8;
          *(v4u*)sp = (v4u){(unsigned)oi[0], (unsigned)oi[1], (unsigned)oi[2], (unsigned)oi[3]}; *(v4u*)(sp + 4) = (v4u){(unsigned)oi[4], (unsigned)oi[5], (unsigned)oi[6], (unsigned)oi[7]};
          *(f32x4*)gp = (f32x4){og[0], og[1], og[2], og[3]}; *(f32x4*)(gp + 4) = (f32x4){og[4], og[5], og[6], og[7]}; }
        LDS_WAIT(); asm volatile("" ::: "memory");
    }
}

constexpr int N_PHASES = 9;
#ifndef MK_PER_PHASE
#define MK_PER_PHASE 0
#endif
__global__ void __launch_bounds__(NTHR, 2) fwd_kernel(Args args) {
    extern __shared__ __attribute__((aligned(16))) unsigned char lds[];
    Frame F;
    F.lds = (LAS unsigned char*)lds; F.MISC = (volatile LAS unsigned*)(F.lds + MISC_OFF);
    F.tid = threadIdx.x; F.lane = F.tid & 63; F.wave = __builtin_amdgcn_readfirstlane(F.tid >> 6);
    F.G = gridDim.x; { const int bx = blockIdx.x; F.vcu = (F.G % 8 == 0) ? (bx % 8) * (F.G / 8) + bx / 8 : bx; }
    F.ctl = (gu32*)(args.ws + WS_CTL);
    for (int u = F.tid; u < (LDS_BYTES - MISC_OFF) / 4; u += NTHR) ((LAS unsigned*)(F.lds + MISC_OFF))[u] = 0u;
    __syncthreads();
#if MK_PER_PHASE
#define GRID_BAR() do { } while (0)
#else
    XcdBarrier bar = xcd_barrier_post((unsigned*)(F.ctl + CW_BAR), F.MISC + 8);
#define GRID_BAR() xcd_barrier(bar)
#endif
    unsigned char* ws = args.ws;
    const int lo = args.ph_lo, hi = args.ph_hi;
#ifndef DBG_REP_PHASE
#define DBG_REP_PHASE -1
#endif
#ifndef DBG_REP_N
#define DBG_REP_N 1
#endif
#define REPS(k) for (int rep_ = 0; rep_ < ((k) == DBG_REP_PHASE ? 1 + DBG_REP_N : 1); ++rep_)
#define IN(k) (lo <= (k) && (k) < hi)
#define BOTH(k) (IN(k) && IN((k) + 1))
#define ENDPH(k) do { if (BOTH(k) || (k) == DBG_REP_PHASE) GRID_BAR(); } while (0)
    if (IN(0)) REPS(0) { p0_prologue(F, args); ENDPH(0); }
    if (IN(1)) REPS(1) {
        pg8::Gemm g{(const bf16*)(ws + WS_XN), (const bf16*)(ws + WS_WIN), M, NPROJ, DM}; pg8::StaticOrder S; S.init(M, NPROJ, F.G, (int)blockIdx.x);
        EpiInProj E{(bf16*)(ws + WS_U), (bf16*)(ws + WS_Q), (bf16*)(ws + WS_K), (bf16*)(ws + WS_V), (bf16*)(ws + WS_GA), (bf16*)(ws + WS_GB), args.out, args.q_norm_g, args.k_norm_g};
        pg8::gemm_phase<EpiInProj, pg8::StaticOrder, true, true>(F.lds, g, S, E);
        ENDPH(1);
    }
    if (IN(2)) REPS(2) { p2_cumsum_pool(F, args); ENDPH(2); }
    if (IN(3)) {
        const float M2 = __builtin_bit_cast(float, __builtin_amdgcn_readfirstlane(__builtin_bit_cast(int, attn_bound2(args, F.lane))));
#if !defined(DBG_SKIP_PATTN)
        { const attn_body::AttnTensors AT{(const attn_body::bf16*)(ws + WS_Q), (const attn_body::bf16*)(ws + WS_K), (const attn_body::bf16*)(ws + WS_V), (attn_body::bf16*)(ws + WS_AO), (const float*)(ws + WS_CP2), M2};
          const attn_body::StaticOrder S((int)F.G, F.vcu);
          attn_body::attn_phase<attn_body::StaticOrder>((char*)lds, AT, S); }
#endif
        REPS(3) { p3_sample_attn(F, args, M2); }
        ENDPH(3); }
    if (IN(4)) REPS(4) {
        { pg8::Gemm g{(const bf16*)(ws + WS_PO), (const bf16*)(ws + WS_WBP), M, DM, DP}; pg8::StaticOrder S; S.init(M, DM, F.G, (int)blockIdx.x);
          EpiGate<0> E{(const bf16*)(ws + WS_GA), nullptr, (bf16*)(ws + WS_T)};
          pg8::gemm_phase<EpiGate<0>, pg8::StaticOrder, true, true>(F.lds, g, S, E); }
        __syncthreads();
        { pg8::Gemm g{(const bf16*)(ws + WS_AO), (const bf16*)(ws + WS_WBA), M, DM, DA}; pg8::StaticOrder S; S.init(M, DM, F.G, (int)blockIdx.x);
          EpiGate<1> E{(const bf16*)(ws + WS_GB), (const bf16*)(ws + WS_T), (bf16*)(ws + WS_MIX)};
          pg8::gemm_phase<EpiGate<1>, pg8::StaticOrder, true, true>(F.lds, g, S, E); }
        ENDPH(4);
    }
    if (IN(5)) REPS(5) {
        pg8::Gemm g{(const bf16*)(ws + WS_MIX), (const bf16*)(ws + WS_WOUT), M, DM, DM}; pg8::StaticOrder S; S.init(M, DM, F.G, (int)blockIdx.x);
        EpiOut E{args.x_p, args.x_s, (float*)(ws + WS_H), (bf16*)(ws + WS_XN), args.norm_ffn_g, (float*)(ws + WS_RSS)};
        pg8::gemm_phase<EpiOut, pg8::StaticOrder, true, true>(F.lds, g, S, E);
        ENDPH(5);
    }
    if (IN(6)) REPS(6) {
        pg8::Gemm g{(const bf16*)(ws + WS_XN), (const bf16*)(ws + WS_WQ), M, DQ, DM}; pg8::StaticOrder S; S.init(M, DQ, F.G, (int)blockIdx.x);
        pg8::EpiBf16<0> E{(bf16*)(ws + WS_PQ), DQ, nullptr, 0, 0, 1.f};
        pg8::gemm_phase<pg8::EpiBf16<0>, pg8::StaticOrder, true, true>(F.lds, g, S, E);
        ENDPH(6);
    }
#ifdef P7_NAIVE
    if (IN(7)) REPS(7) { p7_topk_naive(F, args); ENDPH(7); }
#else
    if (IN(7)) REPS(7) { p7_topk(F, args); ENDPH(7); }
#endif
    if (IN(8)) REPS(8) { p8_gather_naive(F, args); ENDPH(8); }
#ifdef DBG_DUMP
    if (IN(9)) { const bf16* AO = (const bf16*)(ws + WS_AO); const bf16* PO = (const bf16*)(ws + WS_PO); const bf16* MX = (const bf16*)(ws + (DBG_DUMP == 3 ? WS_T : DBG_DUMP == 4 ? WS_GA : WS_MIX));
        for (size_t i = (size_t)blockIdx.x * NTHR + F.tid; i < (size_t)M * DM; i += (size_t)F.G * NTHR) { const int row = (int)(i >> 10), c = (int)(i & 1023);
            float v; if (DBG_DUMP == 1) v = c < 512 ? bf2f(AO[(size_t)row * DA + c]) : bf2f(PO[(size_t)row * DP + c - 512]); else v = bf2f(MX[i]);
            args.out[O_YP + i] = v; } }
#endif
#undef IN
#undef BOTH
}

extern "C" void kernel_launch(void* const* d_in, const int* in_sizes, int n_in, void* d_out, int out_size, void* d_ws, size_t ws_size, hipStream_t stream) {
    static int grid = 0;
    if (grid == 0) {
        if (n_in != 22 || (size_t)out_size != O_END || ws_size < WS_END) { fprintf(stderr, "kernel_launch: unexpected shapes (n_in %d out %d ws %zu)\n", n_in, out_size, ws_size); grid = -1; return; }
        int dev = 0, cus = 0, per_cu = 0;
        if (hipGetDevice(&dev) != hipSuccess || hipDeviceGetAttribute(&cus, hipDeviceAttributeMultiprocessorCount, dev) != hipSuccess) { grid = -1; return; }
        if (hipFuncSetAttribute((const void*)fwd_kernel, hipFuncAttributeMaxDynamicSharedMemorySize, LDS_BYTES) != hipSuccess) { fprintf(stderr, "kernel_launch: hipFuncSetAttribute failed\n"); grid = -1; return; }
        if (hipOccupancyMaxActiveBlocksPerMultiprocessor(&per_cu, (const void*)fwd_kernel, NTHR, LDS_BYTES) != hipSuccess || per_cu < 1) fprintf(stderr, "kernel_launch: occupancy query reports %d\n", per_cu);
        (void)hipGetLastError();
        grid = cus;
    }
    if (grid < 0) return;
    if (hipMemsetAsync((char*)d_ws + WS_CTL, 0, CTL_ZERO_BYTES, stream) != hipSuccess) return;
    Args a{};
    a.x_p = (const float*)d_in[0]; a.x_s = (const float*)d_in[1]; a.cache_k = (const float*)d_in[2]; a.cache_v = (const float*)d_in[3]; a.cache_lf = (const float*)d_in[4];
    a.state_pool = (const float*)d_in[5]; a.page_table = (const int*)d_in[6]; a.norm_mix_g = (const float*)d_in[7]; a.w_in = (const float*)d_in[8]; a.b_forget = (const float*)d_in[9];
    a.q_norm_g = (const float*)d_in[10]; a.k_norm_g = (const float*)d_in[11]; a.pool_mix_w = (const float*)d_in[12]; a.pool_scale = (const float*)d_in[13]; a.w_bp = (const float*)d_in[14];
    a.w_ba = (const float*)d_in[15]; a.w_out = (const float*)d_in[16]; a.norm_ffn_g = (const float*)d_in[17]; a.w_query = (const float*)d_in[18]; a.sub_keys = (const float*)d_in[19];
    a.peer_u = (const float*)d_in[20]; a.peer_v = (const float*)d_in[21];
    a.out = (float*)d_out; a.ws = (unsigned char*)d_ws; a.pad = 0;
#if MK_PER_PHASE
#ifndef DBG_NPH
#define DBG_NPH N_PHASES
#endif
    for (int ph = 0; ph < DBG_NPH; ++ph) { a.ph_lo = ph; a.ph_hi = ph + 1; a.li = ph; hipLaunchKernelGGL(fwd_kernel, dim3(grid), dim3(NTHR), LDS_BYTES, stream, a); }
#ifdef DBG_DUMP
    a.ph_lo = 9; a.ph_hi = 10; a.li = 9; hipLaunchKernelGGL(fwd_kernel, dim3(grid), dim3(NTHR), LDS_BYTES, stream, a);
#endif
#else
    a.ph_lo = 0; a.ph_hi = N_PHASES; a.li = 0; hipLaunchKernelGGL(fwd_kernel, dim3(grid), dim3(NTHR), LDS_BYTES, stream, a);
#endif
}
```

```cpp
#include <hip/hip_runtime.h>
#include <cstdio>
#include <cstdint>
#include <cmath>
namespace pg8 {
#define PG8_LAS __attribute__((address_space(3)))
typedef unsigned short bf16_t;
typedef short bf16x8 __attribute__((ext_vector_type(8)));
typedef float f32x4 __attribute__((ext_vector_type(4)));
typedef unsigned u32x4 __attribute__((ext_vector_type(4)));
constexpr int BM = 256, BK = 64, HALF = 128, HTB = HALF * BK * 2  , STAGE_BYTES = 8 * HTB, NXCD = 8, WGM = 8;

__host__ __device__ __forceinline__ int lds_byte(int r, int c) { const int st = (r >> 4) * 2 + (c >> 5), rr = r & 15, cc = c & 31, ob = rr * 64 + cc * 2; return st * 1024 + (ob ^ (((ob >> 9) & 1) << 5)); }
__host__ __device__ __forceinline__ void stage_rc(int b, int& R, int& C) { const int st = b / 1024, sb = b % 1024, swz = sb ^ (((sb >> 9) & 1) << 5); R = (st >> 1) * 16 + swz / 64; C = (st & 1) * 32 + (swz % 64) / 2; }
__host__ __device__ __forceinline__ int perm32(int rho) { const int n = rho >> 4, i = rho & 15; return 8 * (i >> 2) + 4 * n + (i & 3); }

struct Unit { int pm, pn; };
struct Gemm { const bf16_t* A; const bf16_t* Bt; int M, N, K; };

struct StaticOrder {
    int nM, nN, nwg, G, c;
    __host__ __device__ void init(int M, int N, int G_, int c_) { nM = M / BM; nN = N / BM; nwg = nM * nN; G = G_; c = c_; }
    __host__ __device__ bool next(int i, Unit& u) const {
        const long L = (long)i * G + c; if (L >= nwg) return false;
        int wgid = (int)L; { const int q = nwg / NXCD, r = nwg % NXCD, xcd = wgid % NXCD, off = wgid / NXCD; wgid = (xcd < r ? xcd * (q + 1) : r * (q + 1) + (xcd - r) * q) + off; }
        const int nig = WGM * nN, gid = wgid / nig, fm = gid * WGM, gsz = (nM - fm) < WGM ? (nM - fm) : WGM;
        u.pm = fm + ((wgid % nig) % gsz); u.pn = (wgid % nig) / gsz; return true;
    }
    __device__ __forceinline__ void a_ready(const Unit&) const {}
    __device__ __forceinline__ void done(const Unit&) const {}
};

typedef float f32x2c __attribute__((ext_vector_type(2))); typedef __bf16 bf16x2c __attribute__((ext_vector_type(2)));
__device__ __forceinline__ unsigned cvt_pk_bf16(float lo, float hi) { f32x2c v = {lo, hi}; bf16x2c b = __builtin_convertvector(v, bf16x2c); return __builtin_bit_cast(unsigned, b); }
typedef float f32x2 __attribute__((ext_vector_type(2)));
__device__ __forceinline__ f32x2 gelu_pk(f32x2 v) {
    const f32x2 av = __builtin_elementwise_abs(v), d = av * 0.2316418882f + 1.0f;
    f32x2 t; t.x = __builtin_amdgcn_rcpf(d.x); t.y = __builtin_amdgcn_rcpf(d.y);
    f32x2 q = t * 0.5307027145f + (-0.7265760135f); q = q * t + 0.7107068705f; q = q * t + (-0.142248368f); q = q * t + 0.127414796f; q = q * t;
    const f32x2 s = (v * v) * (-0.72134752044f);
    f32x2 e; e.x = __builtin_amdgcn_exp2f(s.x); e.y = __builtin_amdgcn_exp2f(s.y);
    const f32x2 m = v * (q * e), r = v - m;
    f32x2 o; o.x = v.x < 0.f ? m.x : r.x; o.y = v.y < 0.f ? m.y : r.y; return o;
}

template <int ACT  > struct EpiBf16 {
    static constexpr bool PERM = true, AFTER_DRAIN = false; static_assert(ACT == 0 || ACT == 1, "EpiBf16: ACT is 0 (none) or 1 (gelu_pk)");
    bf16_t* O; int ldc; const float* bias; int split_cols; size_t split_stride; float scale0;
    __device__ __forceinline__ void operator()(const f32x4 (&acc)[2][2][4][2], const Unit& u, int wr, int wc, int fr, int fq) const {
        const int row0 = u.pm * BM + wr * 64 + fr; int colt = u.pn * BM; bf16_t* base = O;
        float sc = 1.f; if (split_cols) { const int t = colt / split_cols; base += (size_t)t * split_stride; colt -= t * split_cols; if (t == 0) sc = scale0; }
        const int col0 = colt + wc * 32 + 8 * fq, bcol0 = u.pn * BM + wc * 32 + 8 * fq;
        f32x4 bv[2][2];
#pragma unroll
        for (int bj = 0; bj < 2; ++bj)
#pragma unroll
            for (int n = 0; n < 2; ++n) bv[bj][n] = bias ? *(const f32x4*)(bias + bcol0 + bj * HALF + 4 * n) : (f32x4){0.f, 0.f, 0.f, 0.f};
#pragma unroll
        for (int ai = 0; ai < 2; ++ai)
#pragma unroll
            for (int m = 0; m < 4; ++m) { bf16_t* rowp = base + (size_t)(row0 + ai * HALF + m * 16) * ldc + col0;
#pragma unroll
                for (int bj = 0; bj < 2; ++bj) { f32x4 v0 = acc[ai][bj][m][0] + bv[bj][0], v1 = acc[ai][bj][m][1] + bv[bj][1];
                    if (ACT == 1) { f32x2 a = gelu_pk((f32x2){v0[0], v0[1]}), b = gelu_pk((f32x2){v0[2], v0[3]}), c = gelu_pk((f32x2){v1[0], v1[1]}), d = gelu_pk((f32x2){v1[2], v1[3]});
                        v0 = (f32x4){a.x, a.y, b.x, b.y}; v1 = (f32x4){c.x, c.y, d.x, d.y}; }
                    v0 = v0 * sc; v1 = v1 * sc; u32x4 w; w.x = cvt_pk_bf16(v0[0], v0[1]); w.y = cvt_pk_bf16(v0[2], v0[3]); w.z = cvt_pk_bf16(v1[0], v1[1]); w.w = cvt_pk_bf16(v1[2], v1[3]);
                    *(u32x4*)(rowp + bj * HALF) = w; } }
    }
};
template <class Epi, class Sched, bool ALIGN_EPI = false, bool SP2 = false>
__device__ __forceinline__ void gemm_phase(PG8_LAS unsigned char* lds, const Gemm g, const Sched& S, const Epi& E) {
    const int tid = threadIdx.x, wid = __builtin_amdgcn_readfirstlane(tid >> 6), lane = tid & 63, wr = wid >> 2, wc = wid & 3, fr = lane & 15, fq = lane >> 4;
    const int K = g.K, nt = K / BK;
    unsigned voffA[2], voffB[2];
#pragma unroll
    for (int i = 0; i < 2; ++i) { int R, C; stage_rc(tid * 16 + i * 8192, R, C); const int Rb = Epi::PERM ? ((R & ~31) + perm32(R & 31)) : R;
        voffA[i] = (unsigned)(R * K + C) * 2u; voffB[i] = (unsigned)(Rb * K + C) * 2u; }
    const size_t kstep = (size_t)(BK * 2);
    const size_t hstep = (size_t)HALF * K * 2;
    const size_t tstep = 2 * hstep;
    const unsigned ldsw = (unsigned)wid * 1024u;
    const int aoff = lds_byte(wr * 64 + fr, fq * 8), boff = lds_byte(wc * 32 + fr, fq * 8);
#define PG8_SA(b, h) (((b) * 2 + (h)) * HTB)
#define PG8_SB(b, h) ((4 + (b) * 2 + (h)) * HTB)
#define PG8_STAGE(bufoff, gbase, voff) do { _Pragma("unroll") for (int _i = 0; _i < 2; ++_i) \
        __builtin_amdgcn_global_load_lds((const unsigned*)((const char*)(gbase) + (voff)[_i]), (PG8_LAS unsigned*)(lds + (bufoff) + ldsw + _i * 8192), 16, 0, 0); } while (0)
#define PG8_LDA(dst, b, h) do { _Pragma("unroll") for (int m = 0; m < 4; ++m) _Pragma("unroll") for (int k = 0; k < 2; ++k) dst[m][k] = *(const PG8_LAS bf16x8*)(lds + PG8_SA(b, h) + aoff + m * 2048 + k * 1024); } while (0)
#define PG8_LDB(dst, b, h) do { _Pragma("unroll") for (int n = 0; n < 2; ++n) _Pragma("unroll") for (int k = 0; k < 2; ++k) dst[n][k] = *(const PG8_LAS bf16x8*)(lds + PG8_SB(b, h) + boff + n * 2048 + k * 1024); } while (0)
#define PG8_MMA(ai, bj, At, Bt) do { __builtin_amdgcn_s_setprio(1); _Pragma("unroll") for (int m = 0; m < 4; ++m) _Pragma("unroll") for (int n = 0; n < 2; ++n) _Pragma("unroll") for (int k = 0; k < 2; ++k) \
        acc[ai][bj][m][n] = __builtin_amdgcn_mfma_f32_16x16x32_bf16(Bt[n][k], At[m][k], acc[ai][bj][m][n], 0, 0, 0); __builtin_amdgcn_s_setprio(0); } while (0)
#define PG8_WAIT_V(n) asm volatile("s_waitcnt vmcnt(" #n ")" ::: "memory")
#define PG8_WAIT_L(n) asm volatile("s_waitcnt lgkmcnt(" #n ")" ::: "memory")
#define PG8_BAR __builtin_amdgcn_s_barrier()
#define PG8_SCHED __builtin_amdgcn_sched_barrier(0)
    Unit cur, nxt; int ui = 0;
    if (!S.next(0, cur)) return;
    f32x4 acc[2][2][4][2];
#pragma unroll
    for (int a = 0; a < 2; ++a)
#pragma unroll
        for (int b = 0; b < 2; ++b)
#pragma unroll
            for (int m = 0; m < 4; ++m)
#pragma unroll
                for (int n = 0; n < 2; ++n) acc[a][b][m][n] = (f32x4){0.f, 0.f, 0.f, 0.f};
    bf16x8 At[4][2], B0[2][2], B1[2][2];
    const char* cA = (const char*)g.A + (size_t)cur.pm * tstep; const char* cB = (const char*)g.Bt + (size_t)cur.pn * tstep;
    S.a_ready(cur);
    if constexpr (SP2) {
        PG8_STAGE(PG8_SB(0, 0), cB, voffB); PG8_STAGE(PG8_SB(0, 1), cB + hstep, voffB); PG8_STAGE(PG8_SA(0, 0), cA, voffA); PG8_STAGE(PG8_SA(0, 1), cA + hstep, voffA);
        if (wr == 1) PG8_BAR;
        PG8_WAIT_V(2); PG8_BAR;
        PG8_STAGE(PG8_SB(1, 0), cB + kstep, voffB); PG8_STAGE(PG8_SA(1, 0), cA + kstep, voffA); PG8_STAGE(PG8_SB(1, 1), cB + hstep + kstep, voffB);
        PG8_WAIT_V(6); PG8_BAR;
    } else {
        PG8_STAGE(PG8_SB(0, 0), cB, voffB); PG8_STAGE(PG8_SA(0, 0), cA, voffA); PG8_STAGE(PG8_SB(0, 1), cB + hstep, voffB); PG8_STAGE(PG8_SA(0, 1), cA + hstep, voffA);
        if (wr == 1) PG8_BAR;
        PG8_WAIT_V(4); PG8_BAR;
        PG8_STAGE(PG8_SB(1, 0), cB + kstep, voffB); PG8_STAGE(PG8_SA(1, 0), cA + kstep, voffA); PG8_STAGE(PG8_SB(1, 1), cB + hstep + kstep, voffB);
        PG8_WAIT_V(6); PG8_BAR;
    }
    for (;;) {
        const bool has_next = S.next(ui + 1, nxt);
        const char* nA = has_next ? (const char*)g.A + (size_t)nxt.pm * tstep : cA; const char* nB = has_next ? (const char*)g.Bt + (size_t)nxt.pn * tstep : cB;
        for (int t = 0; t < nt; t += 2) {
            const bool last = (t == nt - 2);
            const char* a1 = cA + (size_t)(t + 1) * kstep;
            const char* a2 = last ? nA : cA + (size_t)(t + 2) * kstep; const char* b2 = last ? nB : cB + (size_t)(t + 2) * kstep;
            const char* a3 = a2 + kstep; const char* b3 = b2 + kstep;
            if (last && has_next) S.a_ready(nxt);
            if constexpr (SP2) {
            PG8_LDB(B0, 0, 0); PG8_LDB(B1, 0, 1); PG8_SCHED; PG8_LDA(At, 0, 0); PG8_STAGE(PG8_SA(1, 1), a1 + hstep, voffA);
            PG8_WAIT_V(8); PG8_WAIT_L(0); PG8_BAR; PG8_MMA(0, 0, At, B0); PG8_MMA(0, 1, At, B1); PG8_BAR; PG8_SCHED;
            PG8_LDA(At, 0, 1); PG8_STAGE(PG8_SB(0, 0), b2, voffB); PG8_STAGE(PG8_SB(0, 1), b2 + hstep, voffB); PG8_STAGE(PG8_SA(0, 0), a2, voffA);
            PG8_WAIT_V(8); PG8_WAIT_L(0); PG8_BAR; PG8_MMA(1, 0, At, B0); PG8_MMA(1, 1, At, B1); PG8_BAR; PG8_SCHED;
            PG8_LDB(B0, 1, 0); PG8_LDB(B1, 1, 1); PG8_SCHED; PG8_LDA(At, 1, 0); PG8_STAGE(PG8_SA(0, 1), a2 + hstep, voffA);
            PG8_WAIT_V(8); PG8_WAIT_L(0); PG8_BAR; PG8_MMA(0, 0, At, B0); PG8_MMA(0, 1, At, B1); PG8_BAR; PG8_SCHED;
            PG8_LDA(At, 1, 1); PG8_STAGE(PG8_SB(1, 0), b3, voffB); PG8_STAGE(PG8_SB(1, 1), b3 + hstep, voffB); PG8_STAGE(PG8_SA(1, 0), a3, voffA);
            PG8_WAIT_V(8); PG8_WAIT_L(0); PG8_BAR; PG8_MMA(1, 0, At, B0); PG8_MMA(1, 1, At, B1); PG8_BAR; PG8_SCHED;
            } else {
            PG8_LDB(B0, 0, 0); PG8_SCHED; PG8_LDA(At, 0, 0); PG8_STAGE(PG8_SA(1, 1), a1 + hstep, voffA);
            PG8_WAIT_L(8); PG8_BAR; PG8_WAIT_L(0); PG8_MMA(0, 0, At, B0); PG8_BAR; PG8_SCHED;
            PG8_LDB(B1, 0, 1); PG8_STAGE(PG8_SB(0, 0), b2, voffB);
            PG8_BAR; PG8_WAIT_L(0); PG8_MMA(0, 1, At, B1); PG8_BAR;
            PG8_LDA(At, 0, 1); PG8_STAGE(PG8_SA(0, 0), a2, voffA);
            PG8_BAR; PG8_WAIT_L(0); PG8_MMA(1, 0, At, B0); PG8_BAR; PG8_SCHED;
            PG8_STAGE(PG8_SB(0, 1), b2 + hstep, voffB);
            PG8_WAIT_V(6); PG8_BAR; PG8_MMA(1, 1, At, B1); PG8_BAR;
            PG8_LDB(B0, 1, 0); PG8_SCHED; PG8_LDA(At, 1, 0); PG8_STAGE(PG8_SA(0, 1), a2 + hstep, voffA);
            PG8_WAIT_L(8); PG8_BAR; PG8_WAIT_L(0); PG8_MMA(0, 0, At, B0); PG8_BAR; PG8_SCHED;
            PG8_LDB(B1, 1, 1); PG8_STAGE(PG8_SB(1, 0), b3, voffB);
            PG8_BAR; PG8_WAIT_L(0); PG8_MMA(0, 1, At, B1); PG8_BAR;
            PG8_LDA(At, 1, 1); PG8_STAGE(PG8_SA(1, 0), a3, voffA);
            PG8_BAR; PG8_WAIT_L(0); PG8_MMA(1, 0, At, B0); PG8_BAR; PG8_SCHED;
            PG8_STAGE(PG8_SB(1, 1), b3 + hstep, voffB);
            PG8_WAIT_V(6); PG8_BAR; PG8_MMA(1, 1, At, B1); PG8_BAR;
            }
        }
        if constexpr (ALIGN_EPI) { if (wr == 0) PG8_BAR; }
        if constexpr (!Epi::AFTER_DRAIN) { E(acc, cur, wr, wc, fr, fq); S.done(cur); }
        if (!has_next) break;
#pragma unroll
        for (int a = 0; a < 2; ++a)
#pragma unroll
            for (int b = 0; b < 2; ++b)
#pragma unroll
                for (int m = 0; m < 4; ++m)
#pragma unroll
                    for (int n = 0; n < 2; ++n) acc[a][b][m][n] = (f32x4){0.f, 0.f, 0.f, 0.f};
        cur = nxt; cA = nA; cB = nB; ++ui;
        if constexpr (ALIGN_EPI) { if (wr == 1) PG8_BAR; }
    }
    PG8_WAIT_V(0);
    if constexpr (!ALIGN_EPI) { if (wr == 0) PG8_BAR; }
    PG8_BAR;
    if constexpr (Epi::AFTER_DRAIN) { E.fused(acc, cur, wr, wc, fr, fq, lds, wid, lane); S.done(cur); }
#undef PG8_SA
#undef PG8_SB
#undef PG8_STAGE
#undef PG8_LDA
#undef PG8_LDB
#undef PG8_MMA
#undef PG8_WAIT_V
#undef PG8_WAIT_L
#undef PG8_BAR
#undef PG8_SCHED
}
}
#define GAS __attribute__((address_space(1)))
#define LAS __attribute__((address_space(3)))
typedef unsigned short bf16;
typedef unsigned v4u __attribute__((ext_vector_type(4)));
typedef float f32x4 __attribute__((ext_vector_type(4)));
typedef short bf16x8 __attribute__((ext_vector_type(8)));
typedef GAS unsigned gu32;
typedef GAS unsigned long long gu64;
#define RLX_AGENT __ATOMIC_RELAXED, __HIP_MEMORY_SCOPE_AGENT
#define LDS_WAIT() asm volatile("s_waitcnt lgkmcnt(0)" ::: "memory")
#define VM_WAIT() asm volatile("s_waitcnt vmcnt(0)" ::: "memory")
__device__ __forceinline__ unsigned long long rt() { return __builtin_amdgcn_s_memrealtime(); }
__device__ __forceinline__ unsigned f2bf(float f) { unsigned u = __builtin_bit_cast(unsigned, f); return (u + 0x7fffu + ((u >> 16) & 1u)) >> 16; }
__device__ __forceinline__ unsigned pk2(float lo, float hi) { return f2bf(lo) | (f2bf(hi) << 16); }

#define XB_TMO      128
#define XB_XCNT(j)  (256  + 64 * (j))
#define XB_XSUB(j)  (1280 + 64 * (j))
#define XB_XGEN(j)  (2304 + 64 * (j))
#define XB_TOP      3328
#define XB_TOPGEN   3392
#define XCD_BAR_WORDS 3456
#define XB_SPIN_CAP (1u << 18)

__device__ __forceinline__ unsigned xb_ld(unsigned* p)              { return __hip_atomic_load(p, __ATOMIC_RELAXED, __HIP_MEMORY_SCOPE_AGENT); }
__device__ __forceinline__ unsigned xb_add(unsigned* p, unsigned v) { return __hip_atomic_fetch_add(p, v, __ATOMIC_RELAXED, __HIP_MEMORY_SCOPE_AGENT); }
__device__ __forceinline__ unsigned xb_xcc_id() { return (unsigned)__builtin_amdgcn_s_getreg((3 << 11) | 20) & 0xFu; }
#define XB_SPIN(cond, bar) do { unsigned _sp = 0; while (cond) { __builtin_amdgcn_s_sleep(1); \
    if ((++_sp & 255u) == 0u) { if (xb_ld(&(bar)[XB_TMO])) break; if (_sp > XB_SPIN_CAP) { atomicAdd(&(bar)[XB_TMO], 1u); break; } } } } while (0)

struct XcdBarrier {
    unsigned* bar; unsigned x;
    volatile LAS unsigned* st;
};

__device__ __forceinline__ XcdBarrier xcd_barrier_post(unsigned* bar, volatile LAS unsigned* st) {
    XcdBarrier b; b.bar = bar; b.x = xb_xcc_id(); b.st = st;
    if (threadIdx.x == 0) (void)xb_add(&bar[XB_XCNT(b.x)], 1u);
    return b;
}
__device__ __forceinline__ void xcd_barrier_complete(unsigned* bar, unsigned x, unsigned& nloc, unsigned& nx) {
    const unsigned G = gridDim.x * gridDim.y * gridDim.z;
    unsigned sum, cnt, mine, sp = 0u;
    for (;;) {
        sum = 0u; cnt = 0u; mine = 0u;
#pragma unroll
        for (unsigned j = 0; j < 16; ++j) { const unsigned c = xb_ld(&bar[XB_XCNT(j)]); sum += c; cnt += (c > 0u) ? 1u : 0u; mine = (j == x) ? c : mine; }
        if (sum == G) break;
        __builtin_amdgcn_s_sleep(1);
        if ((++sp & 255u) == 0u) { if (xb_ld(&bar[XB_TMO])) break; if (sp > XB_SPIN_CAP) { atomicAdd(&bar[XB_TMO], 1u); break; } }
    }
    nloc = mine > 0u ? mine : 1u; nx = cnt > 0u ? cnt : 1u;
}

__device__ __forceinline__ void xcd_barrier(const XcdBarrier& b) {
    asm volatile("s_waitcnt vmcnt(0)" ::: "memory");
    __syncthreads();
    if (threadIdx.x == 0) {
        unsigned* bar = b.bar;
        __builtin_amdgcn_s_waitcnt(0);
        unsigned nloc = b.st[0], nx = b.st[1];
        if (nloc == 0u) { xcd_barrier_complete(bar, b.x, nloc, nx); b.st[0] = nloc; b.st[1] = nx; }
        const unsigned old = xb_add(&bar[XB_XSUB(b.x)], 1u);
        const unsigned gen = old / nloc;
        if (old + 1u == (gen + 1u) * nloc) {
            __builtin_amdgcn_fence(__ATOMIC_RELEASE, "agent");
            asm volatile("s_waitcnt vmcnt(0)" ::: "memory");
            const unsigned og = xb_add(&bar[XB_TOP], 1u);
            const unsigned tg = og / nx;
            if (og + 1u == (tg + 1u) * nx) xb_add(&bar[XB_TOPGEN], 1u);
            else XB_SPIN(xb_ld(&bar[XB_TOPGEN]) == tg, bar);
            __builtin_amdgcn_fence(__ATOMIC_ACQUIRE, "agent");
            xb_add(&bar[XB_XGEN(b.x)], 1u);
            asm volatile("s_waitcnt vmcnt(0)" ::: "memory");
        } else {
            XB_SPIN(xb_ld(&bar[XB_XGEN(b.x)]) == gen, bar);
            __builtin_amdgcn_fence(__ATOMIC_ACQUIRE, "agent");
            asm volatile("s_waitcnt vmcnt(0)" ::: "memory");
        }
    }
    __syncthreads();
}
#include <hip/hip_bf16.h>
#include <cmath>
namespace attn_body {
using bf16=__hip_bfloat16;
using bf16x8=__attribute__((ext_vector_type(8)))short;
using s16x4=__attribute__((ext_vector_type(4)))short;
using f32x16=__attribute__((ext_vector_type(16)))float;
using u32x4=__attribute__((ext_vector_type(4)))unsigned;
constexpr int BATCH=4,NHEAD=8,SEQ=4096,D=64,DM=NHEAD*D;
constexpr int NW=8,QBLK=32,QB=QBLK*NW,KVBLK=64,NQB=SEQ/QB;
constexpr int ATTN_PITCH=DM, ATTN_UNIT_ROWS=QB;
__device__ __forceinline__ int crow(int r,int hi){return (r&3)+8*(r>>2)+4*hi;}
#define SBAR() __builtin_amdgcn_sched_barrier(0)
__device__ __forceinline__ void cmask(f32x16&p0,f32x16&p1,int jb,int qrel,int hi){
  const float NEG=-INFINITY; int kb=64*jb+4*hi;
  #pragma unroll
  for(int r=0;r<16;++r){int kv=kb+(r&3)+8*(r>>2); if(kv>qrel)p0[r]=NEG; if(kv+32>qrel)p1[r]=NEG;}
}

constexpr int NSLOT=3, SLOTB=8192;
constexpr int LDS_K=0, LDS_V=NSLOT*SLOTB, LDS_WS=2*NSLOT*SLOTB, LDS_OST=LDS_WS+NW*64*4, LDS_CK=LDS_OST+NW*4096, LDS_BYTES=LDS_CK+SEQ*4;
constexpr float C2=0.125f*1.4426950408889634f;
__device__ __forceinline__ void glds16(const void*gsrc,unsigned lds_dst){unsigned keep;
  asm volatile("s_mov_b32 %0, m0\n\ts_mov_b32 m0, %2\n\ts_nop 0\n\tglobal_load_lds_dwordx4 %1, off\n\ts_mov_b32 m0, %0":"=&s"(keep):"v"(gsrc),"s"(lds_dst):"memory");}
__device__ __forceinline__ float max3f(float a,float b,float c){float r;asm("v_max3_f32 %0, %1, %2, %3":"=v"(r):"v"(a),"v"(b),"v"(c));return r;}
__device__ __forceinline__ float max2f(float a,float b){float r;asm("v_max_f32_e32 %0, %1, %2":"=v"(r):"v"(a),"v"(b));return r;}
__device__ __forceinline__ float fadd_s(float a,float b){float r;asm("v_add_f32_e32 %0, %1, %2":"=v"(r):"v"(a),"v"(b));return r;}
__device__ __forceinline__ float fsub_s(float a,float b){float r;asm("v_sub_f32_e32 %0, %1, %2":"=v"(r):"v"(a),"v"(b));return r;}
typedef float f32x2_t __attribute__((ext_vector_type(2))); typedef __bf16 bf16x2_t __attribute__((ext_vector_type(2)));
__device__ __forceinline__ unsigned cvtpk_s(float lo,float hi){f32x2_t v={lo,hi};bf16x2_t b=__builtin_convertvector(v,bf16x2_t);return __builtin_bit_cast(unsigned,b);}
#define WAIT_BAR(N) asm volatile("s_waitcnt vmcnt(" #N ") lgkmcnt(0)\n\ts_barrier":::"memory")

__device__ __forceinline__ void qkt(f32x16&p0,f32x16&p1,const char*Kslot,const bf16x8*qr,int r32,int hi){
  const char*kb=Kslot+hi*1024+r32*16;
  #pragma unroll
  for(int d0=0;d0<4;++d0){
    const bf16x8 b0=*reinterpret_cast<const bf16x8*>(kb+d0*2048);
    const bf16x8 b1=*reinterpret_cast<const bf16x8*>(kb+d0*2048+512);
    p0=__builtin_amdgcn_mfma_f32_32x32x16_bf16(b0,qr[d0],p0,0,0,0);p1=__builtin_amdgcn_mfma_f32_32x32x16_bf16(b1,qr[d0],p1,0,0,0);}
}
typedef __attribute__((address_space(3))) const char* lds_cptr;
typedef short v4i16_t __attribute__((ext_vector_type(4)));
__device__ __forceinline__ void kload8(bf16x8*kf,lds_cptr kp){
  kf[0]=*(const __attribute__((address_space(3))) bf16x8*)(kp);      kf[1]=*(const __attribute__((address_space(3))) bf16x8*)(kp+512);
  kf[2]=*(const __attribute__((address_space(3))) bf16x8*)(kp+2048); kf[3]=*(const __attribute__((address_space(3))) bf16x8*)(kp+2560);
  kf[4]=*(const __attribute__((address_space(3))) bf16x8*)(kp+4096); kf[5]=*(const __attribute__((address_space(3))) bf16x8*)(kp+4608);
  kf[6]=*(const __attribute__((address_space(3))) bf16x8*)(kp+6144); kf[7]=*(const __attribute__((address_space(3))) bf16x8*)(kp+6656);
}
__device__ __forceinline__ void kload2(bf16x8*kf,lds_cptr kp,int j){ kf[2*j]=*(const __attribute__((address_space(3))) bf16x8*)(kp+j*2048); kf[2*j+1]=*(const __attribute__((address_space(3))) bf16x8*)(kp+j*2048+512); }
__device__ __forceinline__ s16x4 vtr(lds_cptr p){ return __builtin_bit_cast(s16x4,__builtin_amdgcn_ds_read_tr16_b64_v4i16((__attribute__((address_space(3))) v4i16_t*)p)); }
__device__ __forceinline__ float rowmax(const f32x16&p0,const f32x16&p1){
  float a=max3f(p0[0],p0[1],p1[0]),b=max3f(p0[2],p0[3],p1[1]);a=max3f(a,p1[2],p1[3]);
  #pragma unroll
  for(int r=4;r<16;r+=4){a=max3f(a,p0[r],p0[r+1]);b=max3f(b,p0[r+2],p0[r+3]);a=max3f(a,p1[r],p1[r+1]);b=max3f(b,p1[r+2],p1[r+3]);}
  const float m=max2f(a,b);
  auto rr=__builtin_amdgcn_permlane32_swap(__float_as_uint(m),__float_as_uint(m),false,false);
  return max2f(__uint_as_float(rr[0]),__uint_as_float(rr[1]));
}
__device__ __forceinline__ void pv(f32x16*o,int vb,bf16x8 pa0,bf16x8 pa1,bf16x8 pa2,bf16x8 pa3){
  #pragma unroll
  for(int d0=0;d0<2;++d0){s16x4 lo[4],hi[4];
    #pragma unroll
    for(int ks=0;ks<4;++ks){
      asm volatile("ds_read_b64_tr_b16 %0,%1 offset:%c2":"=&v"(lo[ks]):"v"(vb),"i"(d0*4096+ks*1024):"memory");
      asm volatile("ds_read_b64_tr_b16 %0,%1 offset:%c2":"=&v"(hi[ks]):"v"(vb),"i"(d0*4096+ks*1024+512):"memory");}
    asm volatile("s_waitcnt lgkmcnt(0)":::"memory");SBAR();
    #define PK(k) (bf16x8){lo[k][0],lo[k][1],lo[k][2],lo[k][3],hi[k][0],hi[k][1],hi[k][2],hi[k][3]}
    o[d0]=__builtin_amdgcn_mfma_f32_32x32x16_bf16(pa0,PK(0),o[d0],0,0,0);
    o[d0]=__builtin_amdgcn_mfma_f32_32x32x16_bf16(pa1,PK(1),o[d0],0,0,0);
    o[d0]=__builtin_amdgcn_mfma_f32_32x32x16_bf16(pa2,PK(2),o[d0],0,0,0);
    o[d0]=__builtin_amdgcn_mfma_f32_32x32x16_bf16(pa3,PK(3),o[d0],0,0,0);
    #undef PK
  }
}

#ifndef ATTN_STORE16
#define ATTN_STORE16(p,v) (*(u32x4*)(p)=(v))
#endif
template<int THRL> __device__ __forceinline__ void attn_unit(int b,int h,int qb,const bf16*Q,const bf16*__restrict__ K,const bf16*__restrict__ V,bf16*O,const float*__restrict__ c2,float M2,char*shm){
  const int tid=threadIdx.x,lane=tid&63,r32=lane&31,hi=lane>>5; const int wid=__builtin_amdgcn_readfirstlane(tid>>6);
  const long rowbase=(long)b*SEQ; const int q0=qb*QB;
  const bf16*Qw=Q+(rowbase+q0+wid*QBLK)*DM+h*D;
  const bf16*Kh=K+rowbase*DM+h*D,*Vh=V+rowbase*DM+h*D;
  const unsigned lds0=(unsigned)(uintptr_t)shm;
  float*wsf=(float*)(shm+LDS_WS)+wid*64;
  const bf16*ksrc=Kh+(long)lane*DM+wid*8;
  const bf16*vsrc=Vh+(long)(16*(wid&3)+(lane>>2))*DM+(wid>>2)*32+(lane&3)*8;
  const unsigned kdst=lds0+LDS_K+wid*1024, vdst=lds0+LDS_V+wid*1024;
  #define DMA_K(t,slot) glds16(ksrc+(long)(t)*KVBLK*DM,(unsigned)__builtin_amdgcn_readfirstlane(kdst+(slot)))
  #define DMA_V(t,slot) glds16(vsrc+(long)(t)*KVBLK*DM,(unsigned)__builtin_amdgcn_readfirstlane(vdst+(slot)))
  const int vb0=(int)(lds0+LDS_V)+((lane>>4)&1)*32+(lane&3)*8+(4*hi+((lane&15)>>2))*64;
  const char*Kbase=shm+LDS_K; bf16x8 kf[8];
  const lds_cptr shm3=(lds_cptr)shm; const lds_cptr kp0=shm3+LDS_K+hi*1024+r32*16; const lds_cptr vp0=shm3+LDS_V+((lane>>4)&1)*32+(lane&3)*8+(4*hi+((lane&15)>>2))*64;
  const int NT=(q0+QB)/KVBLK;
  typedef float f32x4_t __attribute__((ext_vector_type(4)));
  const int nck4=(q0+QB)/4; f32x4_t ckv0=f32x4_t{},ckv1=f32x4_t{}; if(tid<nck4)ckv0=((const f32x4_t*)c2)[tid]; if(tid+512<nck4)ckv1=((const f32x4_t*)c2)[tid+512];
  const float cq=c2[q0+wid*QBLK+r32]-M2;
  DMA_K(0,0);DMA_V(0,0);DMA_K(1,SLOTB);
  bf16x8 qr[4];
  #pragma unroll
  for(int d0=0;d0<4;++d0)qr[d0]=*reinterpret_cast<const bf16x8*>(&Qw[(long)r32*DM+d0*16+hi*8]);
  float l_reg=0.f;f32x16 o[2];o[0]=f32x16{};o[1]=f32x16{};
  { __attribute__((address_space(3))) f32x4_t*ckl=(__attribute__((address_space(3))) f32x4_t*)((lds_cptr)shm+LDS_CK); if(tid<nck4)ckl[tid]=ckv0; if(tid+512<nck4)ckl[tid+512]=ckv1; }
  const __attribute__((address_space(3))) f32x4_t*ckp=(const __attribute__((address_space(3))) f32x4_t*)((lds_cptr)shm+LDS_CK)+hi;
  #define CKLD(P0,P1,t) do{ _Pragma("unroll") for(int g_=0;g_<4;++g_){ const f32x4_t a_=ckp[(t)*16+2*g_], b_=ckp[(t)*16+8+2*g_]; P0[4*g_]=a_[0];P0[4*g_+1]=a_[1];P0[4*g_+2]=a_[2];P0[4*g_+3]=a_[3]; P1[4*g_]=b_[0];P1[4*g_+1]=b_[1];P1[4*g_+2]=b_[2];P1[4*g_+3]=b_[3]; } }while(0)
  #define CKSUB(P0,P1) do{ _Pragma("unroll") for(int r=0;r<16;++r){P0[r]=cq-P0[r];P1[r]=cq-P1[r];} }while(0)
  const int qrel=wid*QBLK+r32;
  #define CMASK(P0,P1,t) do{int jb_=(t)-(NT-4); if(jb_>=0)cmask(P0,P1,jb_,qrel,hi);}while(0)
  #define START(P0,P1) do{ _Pragma("unroll") for(int r=0;r<16;++r)P0[r]=__builtin_amdgcn_exp2f(P0[r]); }while(0)
  #define RESC() do{}while(0)
  f32x16 pA0,pA1,pB0,pB1;
  int sl_prev=0,sl_cur=0,sl_next=SLOTB;
  #define ROT() do{sl_prev=sl_cur;sl_cur=sl_next;sl_next=(sl_next==(NSLOT-1)*SLOTB)?0:sl_next+SLOTB;}while(0)
  DMA_K(2,2*SLOTB);
  WAIT_BAR(3);
  CKLD(pA0,pA1,0);CKSUB(pA0,pA1);
  qkt(pA0,pA1,Kbase,qr,r32,hi);asm volatile("s_nop 15\n\ts_nop 7":"+v"(pA0),"+v"(pA1));CMASK(pA0,pA1,0);
  CKLD(pB0,pB1,1);CKSUB(pB0,pB1);
  START(pA0,pA1);
  _Pragma("unroll") for(int r=0;r<16;++r)pA1[r]=__builtin_amdgcn_exp2f(pA1[r]);
  WAIT_BAR(0);
  DMA_K(3,0);DMA_V(1,SLOTB);
  ROT();
  kload8(kf,kp0+sl_cur);
  WAIT_BAR(2);
  s16x4 vlo[8],vhi[8]; u32x4 pw0,pw1,pw2,pw3;
  #define PKW(P,B) cvtpk_s(P[B],P[B+1])
  #define PAF(k) __builtin_bit_cast(bf16x8,pw##k)
  #define VFR(i) (bf16x8){vlo[i][0],vlo[i][1],vlo[i][2],vlo[i][3],vhi[i][0],vhi[i][1],vhi[i][2],vhi[i][3]}
  #define PIN(x) asm volatile("":"+v"(x))
  #define MX3(a,b,c) __builtin_fmaxf(__builtin_fmaxf((a),(b)),(c))
  #define GAPA(MF,A0,A1,A2,A3,W0,W1,PW) do{ MF; sacc+=A0; sacc+=A1; sacc+=A2; sacc+=A3; PIN(sacc); W0; W1; PIN(PW); SBAR(); }while(0)
  #define EX(v) __builtin_amdgcn_exp2f(v)
  #define GAPB(MF,X,B) do{ MF; X[B]=EX(X[B]); X[B+1]=EX(X[B+1]); X[B+2]=EX(X[B+2]); X[B+3]=EX(X[B+3]); PIN(X); SBAR(); }while(0)
  #define VRD(i) do{ vlo[i]=vtr(vp_+(((i)>>2)*4096+((i)&3)*1024)); vhi[i]=vtr(vp_+(((i)>>2)*4096+((i)&3)*1024+512)); }while(0)
  #define KRD(G,j) do{ if(G){ kload2(kf,kp0+sl_next,j); SBAR(); } }while(0)
  #define STEP(C0,C1,P0,P1,t,GK,GV,GL) do{ SBAR(); \
    const lds_cptr vp_=vp0+sl_prev; \
    VRD(0); SBAR(); float sacc=(P0[0]+P0[1]); \
    GAPA(C0=__builtin_amdgcn_mfma_f32_32x32x16_bf16(kf[0],qr[0],C0,0,0,0), P0[2],P0[3],P0[4],P0[5],     pw0[0]=PKW(P0,0), pw0[1]=PKW(P0,2), pw0); \
    VRD(4); SBAR(); GAPA(C1=__builtin_amdgcn_mfma_f32_32x32x16_bf16(kf[1],qr[0],C1,0,0,0), P0[6],P0[7],P0[8],P0[9],     pw0[2]=PKW(P0,4), pw0[3]=PKW(P0,6), pw0); \
    VRD(1); SBAR(); GAPA(C0=__builtin_amdgcn_mfma_f32_32x32x16_bf16(kf[2],qr[1],C0,0,0,0),   P0[10],P0[11],P0[12],P0[13], pw1[0]=PKW(P0,8), pw1[1]=PKW(P0,10), pw1); \
    VRD(5); SBAR(); GAPA(C1=__builtin_amdgcn_mfma_f32_32x32x16_bf16(kf[3],qr[1],C1,0,0,0),   P0[14],P0[15],P1[0],P1[1],   pw1[2]=PKW(P0,12),pw1[3]=PKW(P0,14), pw1); \
    VRD(2); SBAR(); GAPA(C0=__builtin_amdgcn_mfma_f32_32x32x16_bf16(kf[4],qr[2],C0,0,0,0),   P1[2],P1[3],P1[4],P1[5],     pw2[0]=PKW(P1,0), pw2[1]=PKW(P1,2), pw2); \
    VRD(6); SBAR(); GAPA(C1=__builtin_amdgcn_mfma_f32_32x32x16_bf16(kf[5],qr[2],C1,0,0,0),   P1[6],P1[7],P1[8],P1[9],     pw2[2]=PKW(P1,4), pw2[3]=PKW(P1,6), pw2); \
    VRD(3); SBAR(); GAPA(C0=__builtin_amdgcn_mfma_f32_32x32x16_bf16(kf[6],qr[3],C0,0,0,0),   P1[10],P1[11],P1[12],P1[13], pw3[0]=PKW(P1,8), pw3[1]=PKW(P1,10), pw3); \
    VRD(7); SBAR(); GAPA(C1=__builtin_amdgcn_mfma_f32_32x32x16_bf16(kf[7],qr[3],C1,0,0,0),   P1[14],P1[15],0.f,0.f,       pw3[2]=PKW(P1,12),pw3[3]=PKW(P1,14), pw3); \
    l_reg+=sacc; \
    if(GK){DMA_K((t)+3,sl_cur);} if(GV){DMA_V((t)+1,sl_next);} \
    CMASK(C0,C1,t); \
    SBAR(); \
    GAPB(o[0]=__builtin_amdgcn_mfma_f32_32x32x16_bf16(PAF(0),VFR(0),o[0],0,0,0), C0,0); \
    GAPB(o[1]=__builtin_amdgcn_mfma_f32_32x32x16_bf16(PAF(0),VFR(4),o[1],0,0,0), C0,4); \
    KRD(GL,0); GAPB(o[0]=__builtin_amdgcn_mfma_f32_32x32x16_bf16(PAF(1),VFR(1),o[0],0,0,0), C0,8); \
    KRD(GL,1); GAPB(o[1]=__builtin_amdgcn_mfma_f32_32x32x16_bf16(PAF(1),VFR(5),o[1],0,0,0), C0,12); \
    KRD(GL,2); GAPB(o[0]=__builtin_amdgcn_mfma_f32_32x32x16_bf16(PAF(2),VFR(2),o[0],0,0,0), C1,0); \
    KRD(GL,3); GAPB(o[1]=__builtin_amdgcn_mfma_f32_32x32x16_bf16(PAF(2),VFR(6),o[1],0,0,0), C1,4); \
    GAPB(o[0]=__builtin_amdgcn_mfma_f32_32x32x16_bf16(PAF(3),VFR(3),o[0],0,0,0), C1,8); \
    GAPB(o[1]=__builtin_amdgcn_mfma_f32_32x32x16_bf16(PAF(3),VFR(7),o[1],0,0,0), C1,12); \
    if(GL){ CKLD(P0,P1,(t)+1); CKSUB(P0,P1); } \
    }while(0)
  int t=1;
  #undef CMASK
  #define CMASK(P0,P1,t) do{}while(0)
  for(;t+5<NT;t+=2){
    STEP(pB0,pB1,pA0,pA1,t,true,true,true);     WAIT_BAR(2); RESC(); ROT();
    STEP(pA0,pA1,pB0,pB1,t+1,true,true,true);   WAIT_BAR(2); RESC(); ROT();
  }
  #undef CMASK
  #define CMASK(P0,P1,t) do{int jb_=(t)-(NT-4); if(jb_>=0)cmask(P0,P1,jb_,qrel,hi);}while(0)
  #define ENDW(tt) do{ if((tt)+3<NT){WAIT_BAR(2);} else if((tt)+2<NT){WAIT_BAR(1);} else {WAIT_BAR(0);} }while(0)
  for(;t+1<NT;t+=2){
    STEP(pB0,pB1,pA0,pA1,t,(t+3<NT),(t+1<NT),(t+1<NT));       ENDW(t);   RESC(); ROT();
    STEP(pA0,pA1,pB0,pB1,t+1,(t+4<NT),(t+2<NT),(t+2<NT));     ENDW(t+1); RESC(); ROT();
  }
  STEP(pB0,pB1,pA0,pA1,NT-1,false,false,false); RESC();
  { float sacc=pB0[0]+pB0[1]; _Pragma("unroll") for(int r=2;r<16;++r)sacc+=pB0[r]; _Pragma("unroll") for(int r=0;r<16;++r)sacc+=pB1[r]; l_reg+=sacc;
    pw0=(u32x4){PKW(pB0,0),PKW(pB0,2),PKW(pB0,4),PKW(pB0,6)};pw1=(u32x4){PKW(pB0,8),PKW(pB0,10),PKW(pB0,12),PKW(pB0,14)};pw2=(u32x4){PKW(pB1,0),PKW(pB1,2),PKW(pB1,4),PKW(pB1,6)};pw3=(u32x4){PKW(pB1,8),PKW(pB1,10),PKW(pB1,12),PKW(pB1,14)};
    SBAR(); pv(o,vb0+sl_cur,PAF(0),PAF(1),PAF(2),PAF(3)); }
  #undef PKW
  #undef PAF
  #undef VFR
  #undef PIN
  #undef MX3
  #undef GAPA
  #undef GAPB
  #undef EX
  #undef VRD
  #undef KRD
  #undef STEP
  #undef ENDW
  {auto rr=__builtin_amdgcn_permlane32_swap(__float_as_uint(l_reg),__float_as_uint(l_reg),false,false);l_reg=__uint_as_float(rr[0])+__uint_as_float(rr[1]);}
  if(hi==0)wsf[32+r32]=l_reg;asm volatile("s_waitcnt lgkmcnt(0)":::"memory");
  float rli[16];
  #pragma unroll
  for(int r=0;r<16;++r)rli[r]=__builtin_amdgcn_rcpf(wsf[32+crow(r,hi)]);
  bf16*Ow=O+(rowbase+q0+wid*QBLK)*DM+h*D;
  { bf16*stg=(bf16*)(shm+LDS_OST)+wid*2048;
    #pragma unroll
    for(int r=0;r<16;++r){const int orow=crow(r,hi);
      #pragma unroll
      for(int d0=0;d0<2;++d0)stg[orow*64+d0*32+r32]=__float2bfloat16(o[d0][r]*rli[r]);}
    asm volatile("s_waitcnt lgkmcnt(0)":::"memory");
    #pragma unroll
    for(int i=0;i<4;++i){const int row=i*8+(lane>>3),ch=lane&7; const u32x4 v=*(const u32x4*)(stg+row*64+ch*8); ATTN_STORE16(Ow+(long)row*DM+ch*8,v);} }
  asm volatile("s_waitcnt lgkmcnt(0)\n\ts_barrier":::"memory");
  #undef DMA_K
  #undef DMA_V
  #undef CMASK
  #undef START
  #undef RESC
  #undef ROT
  #undef CKLD
  #undef CKSUB
}
constexpr int ATTN_LDS_BYTES=LDS_BYTES;
struct AttnTensors { const bf16* Q; const bf16* K; const bf16* V; bf16* O; const float* C2T; float M2; };
struct AttnUnit { int bh; int qb; };
struct StaticOrder {
  int vcu, G;
  __device__ __forceinline__ explicit StaticOrder(int grid,int v):vcu(v),G(grid){}
  __device__ __forceinline__ bool next(int i,AttnUnit&u)const{ const int L=i*G+vcu; if(L>=BATCH*NHEAD*NQB)return false; const int r=L>>8, idx=L&255, k=idx&7; u.bh=idx>>3; u.qb=(r==0)?(NQB-1-k):k; return true; }
  __device__ __forceinline__ void a_ready(const AttnUnit&)const{}
  __device__ __forceinline__ void done(const AttnUnit&)const{}
};
template<class Sched,int THRL=8> __device__ __forceinline__ void attn_phase(char*lds,const AttnTensors&T,const Sched&S){
  AttnUnit u;
  for(int i=0;S.next(i,u);++i){ S.a_ready(u); attn_unit<THRL>(u.bh/NHEAD,u.bh%NHEAD,u.qb,T.Q,T.K,T.V,T.O,T.C2T+(size_t)u.bh*SEQ,T.M2,lds); S.done(u); }
}
#undef SBAR
#undef WAIT_BAR
}

constexpr int NWAVES = 8, NTHR = 512;
constexpr int DM = 1024, NB = 4, SEQ = 4096, DB = 128, DSEQ = 8, PAST = 2048, PAGE = 128, NPAGES = 16;
constexpr int MP = NB * SEQ, MS = DB * DSEQ, M = MP + MS;
constexpr int DP = 512, DA = 512, NH = 8, HD = 64, DIN = 4104, NPROJ = 4096;
constexpr int NKEYS = 128, NEXP = 16384, PH = 8, TOPK = 16, DKH = 128, DQ = 2048;
constexpr float EPS = 1e-6f;
constexpr float LOG2E = 1.4426950408889634f;
constexpr float C2 = 0.125f * LOG2E;
constexpr size_t O_YP = 0, O_YS = O_YP + (size_t)MP * DM, O_KP = O_YS + (size_t)MS * DM, O_VP = O_KP + (size_t)MP * DA, O_LFP = O_VP + (size_t)MP * DA,
                 O_PP = O_LFP + (size_t)MP * NH, O_KS = O_PP + (size_t)NB * 15 * DP, O_VS = O_KS + (size_t)MS * DA, O_LFS = O_VS + (size_t)MS * DA,
                 O_PS = O_LFS + (size_t)MS * NH, O_END = O_PS + (size_t)DB * 15 * DP;
constexpr size_t MiB = 1u << 20;
constexpr size_t WS_CTL = 0, CTL_ZERO_BYTES = 1 * MiB;
constexpr size_t WS_WIN = 2 * MiB, WS_WBP = 10 * MiB, WS_WBA = 11 * MiB, WS_WOUT = 12 * MiB, WS_WQ = 14 * MiB, WS_SUBK = 18 * MiB, WS_CP2 = 19 * MiB, WS_RSS = 20 * MiB;
constexpr size_t WS_PU = 32 * MiB, WS_PV = 64 * MiB, WS_XN = 96 * MiB  , WS_U = 132 * MiB, WS_Q = 150 * MiB, WS_K = 168 * MiB, WS_V = 186 * MiB,
                 WS_GA = 204 * MiB, WS_GB = 240 * MiB, WS_PO = 276 * MiB, WS_AO = 294 * MiB, WS_T = 312 * MiB, WS_MIX = 348 * MiB, WS_PQ = 384 * MiB,
                 WS_SI = 456 * MiB, WS_SG = 466 * MiB, WS_H = 476 * MiB, WS_END = 548 * MiB;
constexpr int CW_BAR = 4096;
constexpr int LDS_BYTES = 163840;
constexpr int SCR_BYTES = 159 * 1024;
constexpr int MISC_OFF = SCR_BYTES;

typedef unsigned short bf16;
typedef unsigned v4u __attribute__((ext_vector_type(4)));
typedef unsigned v2u __attribute__((ext_vector_type(2)));
typedef float f32x4 __attribute__((ext_vector_type(4)));
typedef float f32x2 __attribute__((ext_vector_type(2)));

__device__ __forceinline__ float bf2f(unsigned short b) { return __uint_as_float((unsigned)b << 16); }
__device__ __forceinline__ float bflo(unsigned w) { return __uint_as_float(w << 16); }
__device__ __forceinline__ float bfhi(unsigned w) { return __uint_as_float(w & 0xffff0000u); }
typedef __bf16 bf16x2_t __attribute__((ext_vector_type(2)));
__device__ __forceinline__ unsigned pkbf(float lo, float hi) { f32x2 v = {lo, hi}; bf16x2_t b = __builtin_convertvector(v, bf16x2_t); return __builtin_bit_cast(unsigned, b); }
__device__ __forceinline__ float wave_sum(float v) {
#pragma unroll
    for (int o = 1; o < 64; o <<= 1) v += __shfl_xor(v, o);
    return v;
}
__device__ __forceinline__ float wave_max(float v) {
#pragma unroll
    for (int o = 1; o < 64; o <<= 1) v = fmaxf(v, __shfl_xor(v, o));
    return v;
}

struct Args {
    const float* x_p; const float* x_s; const float* cache_k; const float* cache_v; const float* cache_lf; const float* state_pool; const int* page_table;
    const float* norm_mix_g; const float* w_in; const float* b_forget; const float* q_norm_g; const float* k_norm_g; const float* pool_mix_w; const float* pool_scale;
    const float* w_bp; const float* w_ba; const float* w_out; const float* norm_ffn_g; const float* w_query; const float* sub_keys; const float* peer_u; const float* peer_v;
    float* out; unsigned char* ws; int ph_lo, ph_hi, li, pad;
};

using pg8::Unit;
struct EpiInProj {
    static constexpr bool PERM = true, AFTER_DRAIN = false;
    bf16 *U, *Q, *K, *V, *GA, *GB; float* out; const float *gq, *gk;
    __device__ __forceinline__ void operator()(const f32x4 (&acc)[2][2][4][2], const Unit& u, int wr, int wc, int fr, int fq) const {
        const int pn = u.pn; const int row0 = u.pm * 256 + wr * 64 + fr; const bool prompt = u.pm < (MP / 256);
        if (pn < 2) {
#pragma unroll
            for (int ai = 0; ai < 2; ++ai)
#pragma unroll
                for (int m = 0; m < 4; ++m) { const int row = row0 + ai * 128 + m * 16;
                    float* tail = nullptr;
                    if (prompt) { const int s = row & (SEQ - 1), b = row >> 12; if (s >= SEQ - 15) tail = out + O_PP + (size_t)(b * 15 + (s - (SEQ - 15))) * DP; }
                    else { const int rs = row - MP; tail = out + O_PS + (size_t)((rs >> 3) * 15 + 7 + (rs & 7)) * DP; }
#pragma unroll
                    for (int bj = 0; bj < 2; ++bj) { const int col = pn * 256 + bj * 128 + wc * 32 + 8 * fq; const f32x4 v0 = acc[ai][bj][m][0], v1 = acc[ai][bj][m][1];
                        v4u w; w.x = pkbf(v0[0], v0[1]); w.y = pkbf(v0[2], v0[3]); w.z = pkbf(v1[0], v1[1]); w.w = pkbf(v1[2], v1[3]);
                        *(v4u*)(U + (size_t)row * DP + col) = w;
                        if (tail) { *(f32x4*)(tail + col) = v0; *(f32x4*)(tail + col + 4) = v1; } } }
        } else if (pn < 6) {
            const bool isq = pn < 4; const int head = 4 * (pn & 1) + wc; const float* g = isq ? gq : gk;
            f32x4 gv[2][2];
#pragma unroll
            for (int bj = 0; bj < 2; ++bj)
#pragma unroll
                for (int n = 0; n < 2; ++n) gv[bj][n] = *(const f32x4*)(g + 32 * bj + 8 * fq + 4 * n);
            bf16* dst = isq ? Q : K;
#pragma unroll
            for (int ai = 0; ai < 2; ++ai)
#pragma unroll
                for (int m = 0; m < 4; ++m) { const int row = row0 + ai * 128 + m * 16; float ss = 0.f;
#pragma unroll
                    for (int bj = 0; bj < 2; ++bj)
#pragma unroll
                        for (int n = 0; n < 2; ++n) { const f32x4 x = acc[ai][bj][m][n]; ss += (x[0] * x[0] + x[1] * x[1]) + (x[2] * x[2] + x[3] * x[3]); }
                    ss += __shfl_xor(ss, 16); ss += __shfl_xor(ss, 32);
                    float r = 1.0f / sqrtf(ss * (1.0f / 64.0f) + EPS);
                    float* kout = isq ? nullptr : (prompt ? out + O_KP + (size_t)row * DA : out + O_KS + (size_t)(row - MP) * DA);
                    const float rq = isq ? r * C2 : r;
#pragma unroll
                    for (int bj = 0; bj < 2; ++bj) { const int col = head * 64 + 32 * bj + 8 * fq; const f32x4 v0 = acc[ai][bj][m][0] * gv[bj][0] * rq, v1 = acc[ai][bj][m][1] * gv[bj][1] * rq;
                        v4u w; w.x = pkbf(v0[0], v0[1]); w.y = pkbf(v0[2], v0[3]); w.z = pkbf(v1[0], v1[1]); w.w = pkbf(v1[2], v1[3]);
                        *(v4u*)(dst + (size_t)row * DA + col) = w;
                        if (!isq) { *(f32x4*)(kout + col) = v0; *(f32x4*)(kout + col + 4) = v1; } } }
        } else if (pn < 8) {
#pragma unroll
            for (int ai = 0; ai < 2; ++ai)
#pragma unroll
                for (int m = 0; m < 4; ++m) { const int row = row0 + ai * 128 + m * 16;
                    float* vout = prompt ? out + O_VP + (size_t)row * DA : out + O_VS + (size_t)(row - MP) * DA;
#pragma unroll
                    for (int bj = 0; bj < 2; ++bj) { const int col = (pn - 6) * 256 + bj * 128 + wc * 32 + 8 * fq; const f32x4 v0 = acc[ai][bj][m][0], v1 = acc[ai][bj][m][1];
                        v4u w; w.x = pkbf(v0[0], v0[1]); w.y = pkbf(v0[2], v0[3]); w.z = pkbf(v1[0], v1[1]); w.w = pkbf(v1[2], v1[3]);
                        *(v4u*)(V + (size_t)row * DA + col) = w; *(f32x4*)(vout + col) = v0; *(f32x4*)(vout + col + 4) = v1; } }
        } else {
            bf16* dst = pn < 12 ? GA : GB; const int ct = (pn < 12 ? pn - 8 : pn - 12) * 256;
#pragma unroll
            for (int ai = 0; ai < 2; ++ai)
#pragma unroll
                for (int m = 0; m < 4; ++m) { const int row = row0 + ai * 128 + m * 16;
#pragma unroll
                    for (int bj = 0; bj < 2; ++bj) { const int col = ct + bj * 128 + wc * 32 + 8 * fq; float s[8];
#pragma unroll
                        for (int n = 0; n < 2; ++n)
#pragma unroll
                            for (int i = 0; i < 4; ++i) s[4 * n + i] = __builtin_amdgcn_rcpf(1.0f + __builtin_amdgcn_exp2f(-LOG2E * acc[ai][bj][m][n][i]));
                        v4u w; w.x = pkbf(s[0], s[1]); w.y = pkbf(s[2], s[3]); w.z = pkbf(s[4], s[5]); w.w = pkbf(s[6], s[7]);
                        *(v4u*)(dst + (size_t)row * DM + col) = w; } }
        }
    }
};
template <int MODE> struct EpiGate {
    static constexpr bool PERM = true, AFTER_DRAIN = false;
    const bf16* G; const bf16* Tin; bf16* O;
    __device__ __forceinline__ void operator()(const f32x4 (&acc)[2][2][4][2], const Unit& u, int wr, int wc, int fr, int fq) const {
        const int row0 = u.pm * 256 + wr * 64 + fr;
#pragma unroll
        for (int ai = 0; ai < 2; ++ai)
#pragma unroll
            for (int m = 0; m < 4; ++m) { const int row = row0 + ai * 128 + m * 16;
#pragma unroll
                for (int bj = 0; bj < 2; ++bj) { const size_t off = (size_t)row * DM + u.pn * 256 + bj * 128 + wc * 32 + 8 * fq;
                    const v4u g = *(const v4u*)(G + off); const f32x4 v0 = acc[ai][bj][m][0], v1 = acc[ai][bj][m][1];
                    float r[8] = {v0[0] * bflo(g.x), v0[1] * bfhi(g.x), v0[2] * bflo(g.y), v0[3] * bfhi(g.y), v1[0] * bflo(g.z), v1[1] * bfhi(g.z), v1[2] * bflo(g.w), v1[3] * bfhi(g.w)};
                    if (MODE == 1) { const v4u t = *(const v4u*)(Tin + off);
                        r[0] += bflo(t.x); r[1] += bfhi(t.x); r[2] += bflo(t.y); r[3] += bfhi(t.y); r[4] += bflo(t.z); r[5] += bfhi(t.z); r[6] += bflo(t.w); r[7] += bfhi(t.w); }
                    v4u w; w.x = pkbf(r[0], r[1]); w.y = pkbf(r[2], r[3]); w.z = pkbf(r[4], r[5]); w.w = pkbf(r[6], r[7]);
                    *(v4u*)(O + off) = w; } }
    }
};
struct EpiOut {
    static constexpr bool PERM = true, AFTER_DRAIN = false;
    const float* xp; const float* xs; float* H; bf16* HG; const float* gf; float* RSS;
    __device__ __forceinline__ void operator()(const f32x4 (&acc)[2][2][4][2], const Unit& u, int wr, int wc, int fr, int fq) const {
        const int row0 = u.pm * 256 + wr * 64 + fr; const bool prompt = u.pm < (MP / 256);
        f32x4 gv[2][2];
#pragma unroll
        for (int bj = 0; bj < 2; ++bj)
#pragma unroll
            for (int n = 0; n < 2; ++n) gv[bj][n] = *(const f32x4*)(gf + u.pn * 256 + bj * 128 + wc * 32 + 8 * fq + 4 * n);
#pragma unroll
        for (int ai = 0; ai < 2; ++ai)
#pragma unroll
            for (int m = 0; m < 4; ++m) { const int row = row0 + ai * 128 + m * 16; float ss = 0.f;
                const float* xr = prompt ? xp + (size_t)row * DM : xs + (size_t)(row - MP) * DM;
#pragma unroll
                for (int bj = 0; bj < 2; ++bj) { const int col = u.pn * 256 + bj * 128 + wc * 32 + 8 * fq;
                    const f32x4 h0 = acc[ai][bj][m][0] + *(const f32x4*)(xr + col), h1 = acc[ai][bj][m][1] + *(const f32x4*)(xr + col + 4);
                    ss += (h0[0] * h0[0] + h0[1] * h0[1]) + (h0[2] * h0[2] + h0[3] * h0[3]) + (h1[0] * h1[0] + h1[1] * h1[1]) + (h1[2] * h1[2] + h1[3] * h1[3]);
                    *(f32x4*)(H + (size_t)row * DM + col) = h0; *(f32x4*)(H + (size_t)row * DM + col + 4) = h1;
                    const f32x4 a0 = h0 * gv[bj][0], a1 = h1 * gv[bj][1];
                    v4u w; w.x = pkbf(a0[0], a0[1]); w.y = pkbf(a0[2], a0[3]); w.z = pkbf(a1[0], a1[1]); w.w = pkbf(a1[2], a1[3]);
                    *(v4u*)(HG + (size_t)row * DM + col) = w; }
                ss += __shfl_xor(ss, 16); ss += __shfl_xor(ss, 32);
                if (fq == 0) RSS[(size_t)row * 16 + u.pn * 4 + wc] = ss; }
    }
};

struct Frame {
    LAS unsigned char* lds; volatile LAS unsigned* MISC; gu32* ctl;
    int tid, lane, wave, vcu, G;
};

__device__ __forceinline__ void transpose_item(const float* W, int ldw, int K, bf16* WT, int src_col0, int dst_row0, int k0, LAS float* scr, int lane) {
#pragma unroll 8
    for (int i = 0; i < 32; ++i) { const int kk = 2 * i + (lane >> 5); scr[kk * 33 + (lane & 31)] = W[(size_t)(k0 + kk) * ldw + src_col0 + (lane & 31)]; }
    LDS_WAIT(); asm volatile("" ::: "memory");
    const int c = lane & 7;
#pragma unroll
    for (int j = 0; j < 4; ++j) { const int n = (lane >> 3) + 8 * j; const LAS float* s = scr + (8 * c) * 33 + n;
        v4u o; o.x = pkbf(s[0 * 33], s[1 * 33]); o.y = pkbf(s[2 * 33], s[3 * 33]); o.z = pkbf(s[4 * 33], s[5 * 33]); o.w = pkbf(s[6 * 33], s[7 * 33]);
        *(v4u*)(WT + (size_t)(dst_row0 + n) * K + k0 + 8 * c) = o; }
    LDS_WAIT(); asm volatile("" ::: "memory");
}
__device__ __forceinline__ int win_src_col(int db) {
    if (db < 16) return 32 * db;
    if (db < 48) { const int base = db < 32 ? 512 : 1024; const int local = (db - 16) & 15, tile = local >> 3, blk = local & 7, bj = blk >> 2, w = blk & 3; return base + tile * 256 + 64 * w + 32 * bj; }
    if (db < 64) return 1536 + 32 * (db - 48);
    if (db < 96) return 2056 + 32 * (db - 64);
    return 3080 + 32 * (db - 96);
}
__device__ __forceinline__ void cvt_rows_bf16(const float* src, bf16* dst, size_t n8, size_t gtid, size_t gn) {
    for (size_t i = gtid; i < n8; i += gn) { const f32x4 a = *(const f32x4*)(src + 8 * i), b = *(const f32x4*)(src + 8 * i + 4);
        v4u w; w.x = pkbf(a[0], a[1]); w.y = pkbf(a[2], a[3]); w.z = pkbf(b[0], b[1]); w.w = pkbf(b[2], b[3]); *(v4u*)(dst + 8 * i) = w; }
}
__device__ __forceinline__ void p0_prologue(Frame& F, const Args& a) {
    unsigned char* ws = a.ws;
    LAS float* scr = (LAS float*)(F.lds + F.wave * 16384);
    const int gw = F.vcu * NWAVES + F.wave, NGW = F.G * NWAVES;
    for (int it = gw; it < 4096; it += NGW) {
        int r = it;
        if (r < 2048) { const int kb = r >> 7, db = r & 127; transpose_item(a.w_in, DIN, DM, (bf16*)(ws + WS_WIN), win_src_col(db), 32 * db, 64 * kb, scr, F.lane); continue; } r -= 2048;
        if (r < 256) { const int kb = r >> 5, nb = r & 31; transpose_item(a.w_bp, DM, DP, (bf16*)(ws + WS_WBP), 32 * nb, 32 * nb, 64 * kb, scr, F.lane); continue; } r -= 256;
        if (r < 256) { const int kb = r >> 5, nb = r & 31; transpose_item(a.w_ba, DM, DA, (bf16*)(ws + WS_WBA), 32 * nb, 32 * nb, 64 * kb, scr, F.lane); continue; } r -= 256;
        if (r < 512) { const int kb = r >> 5, nb = r & 31; transpose_item(a.w_out, DM, DM, (bf16*)(ws + WS_WOUT), 32 * nb, 32 * nb, 64 * kb, scr, F.lane); continue; } r -= 512;
        { const int kb = r >> 6, nb = r & 63; transpose_item(a.w_query, DQ, DM, (bf16*)(ws + WS_WQ), 32 * nb, 32 * nb, 64 * kb, scr, F.lane); }
    }
    { const size_t gtid = (size_t)F.vcu * NTHR + F.tid, gn = (size_t)F.G * NTHR;
      cvt_rows_bf16(a.peer_u, (bf16*)(ws + WS_PU), (size_t)NEXP * DM / 8, gtid, gn);
      cvt_rows_bf16(a.peer_v, (bf16*)(ws + WS_PV), (size_t)NEXP * DM / 8, gtid, gn);
      cvt_rows_bf16(a.sub_keys, (bf16*)(ws + WS_SUBK), (size_t)PH * 2 * NKEYS * DKH / 8, gtid, gn);
      for (size_t i = gtid; i < (size_t)DB * 7 * DP; i += gn) { const int b = (int)(i / (7 * DP)), j = (int)((i / DP) % 7), c = (int)(i % DP);
          a.out[O_PS + (size_t)(b * 15 + j) * DP + c] = a.state_pool[(size_t)(b * 15 + 8 + j) * DP + c]; } }
    __syncthreads();
    LAS float* wfT = (LAS float*)F.lds;
    for (int i = F.tid; i < 8 * DM; i += NTHR) { const int col = i >> 3, h = i & 7; wfT[h * DM + col] = a.w_in[(size_t)col * DIN + 2048 + h]; }
    __syncthreads();
    bf16* XN = (bf16*)(ws + WS_XN);
    for (int row = gw; row < M; row += NGW) {
        const float* xr = row < MP ? a.x_p + (size_t)row * DM : a.x_s + (size_t)(row - MP) * DM;
        f32x4 v[4]; float ss = 0.f;
#pragma unroll
        for (int j = 0; j < 4; ++j) { v[j] = *(const f32x4*)(xr + 256 * j + 4 * F.lane); ss += (v[j][0] * v[j][0] + v[j][1] * v[j][1]) + (v[j][2] * v[j][2] + v[j][3] * v[j][3]); }
        const float r = 1.0f / sqrtf(wave_sum(ss) * (1.0f / DM) + EPS);
        float f[8];
#pragma unroll
        for (int h = 0; h < 8; ++h) f[h] = 0.f;
#pragma unroll
        for (int j = 0; j < 4; ++j) { const f32x4 g = *(const f32x4*)(a.norm_mix_g + 256 * j + 4 * F.lane); v[j] = v[j] * r * g;
            v2u w; w.x = pkbf(v[j][0], v[j][1]); w.y = pkbf(v[j][2], v[j][3]); *(v2u*)(XN + (size_t)row * DM + 256 * j + 4 * F.lane) = w;
#pragma unroll
            for (int h = 0; h < 8; ++h) { const f32x4 wv = *(const LAS f32x4*)(wfT + h * DM + 256 * j + 4 * F.lane); f[h] += (v[j][0] * wv[0] + v[j][1] * wv[1]) + (v[j][2] * wv[2] + v[j][3] * wv[3]); } }
        float mine = 0.f;
#pragma unroll
        for (int h = 0; h < 8; ++h) { const float s = wave_sum(f[h]); if (F.lane == h) mine = s; }
        if (F.lane < 8) { const float z = mine + a.b_forget[F.lane]; const float lf = fminf(z, 0.f) - log1pf(expf(-fabsf(z)));
            if (row < MP) a.out[O_LFP + (size_t)row * NH + F.lane] = lf; else a.out[O_LFS + (size_t)(row - MP) * NH + F.lane] = lf; }
    }
}

__device__ __forceinline__ void p2_cumsum_pool(Frame& F, const Args& a) {
    unsigned char* ws = a.ws;
    { const int gw = F.vcu * NWAVES + F.wave; float* CP2 = (float*)(ws + WS_CP2);
      if (gw < NB * NH) { const int b = gw >> 3, h = gw & 7; float carry = 0.f;
          for (int c = 0; c < SEQ / 64; ++c) { float v = a.out[O_LFP + (size_t)(b * SEQ + c * 64 + F.lane) * NH + h];
#pragma unroll
              for (int o = 1; o < 64; o <<= 1) { const float t = __shfl_up(v, o); if (F.lane >= o) v += t; }
              v += carry; CP2[(size_t)gw * SEQ + c * 64 + F.lane] = v * LOG2E; carry = __shfl(v, 63); } } }
    const bf16* U = (const bf16*)(ws + WS_U); bf16* PO = (bf16*)(ws + WS_PO);
    LAS float* pw = (LAS float*)F.lds;
    LAS float* mt = (LAS float*)(F.lds + 65536);
    int cur_g = -1;
    for (int unit = blockIdx.x; unit < 4 * (M / 32); unit += F.G) {
        const int g = unit / (M / 32), tile = unit % (M / 32);
        __syncthreads();
        if (g != cur_g) { for (int i = F.tid; i < 128 * 128 / 4; i += NTHR) *(LAS f32x4*)(pw + 4 * i) = *(const f32x4*)(a.pool_mix_w + (size_t)g * 16384 + 4 * i); cur_g = g; }
        { const int r = F.tid >> 4, c8 = (F.tid & 15) * 8, ch = g * 128 + c8, row = tile * 32 + r, w = 2 << g;
          float sum[8], self[8];
#pragma unroll
          for (int i = 0; i < 8; ++i) sum[i] = 0.f;
          float cnt;
          if (row < MP) { const int s = row & (SEQ - 1); cnt = (float)(s + 1 < w ? s + 1 : w);
              for (int i = 0; i < w; ++i) if (s - i >= 0) { const v4u q = *(const v4u*)(U + (size_t)(row - i) * DP + ch);
                  const float e[8] = {bflo(q.x), bfhi(q.x), bflo(q.y), bfhi(q.y), bflo(q.z), bfhi(q.z), bflo(q.w), bfhi(q.w)};
#pragma unroll
                  for (int k = 0; k < 8; ++k) { sum[k] += e[k]; if (i == 0) self[k] = e[k]; } }
          } else { const int rs = row - MP, b = rs >> 3, t = rs & 7; cnt = (float)w;
              for (int i = 0; i < w; ++i) { const int tt = t - i; float e[8];
                  if (tt >= 0) { const v4u q = *(const v4u*)(U + (size_t)(MP + b * 8 + tt) * DP + ch);
                      e[0] = bflo(q.x); e[1] = bfhi(q.x); e[2] = bflo(q.y); e[3] = bfhi(q.y); e[4] = bflo(q.z); e[5] = bfhi(q.z); e[6] = bflo(q.w); e[7] = bfhi(q.w); }
                  else { const f32x4 p0 = *(const f32x4*)(a.state_pool + (size_t)(b * 15 + 15 + tt) * DP + ch), p1 = *(const f32x4*)(a.state_pool + (size_t)(b * 15 + 15 + tt) * DP + ch + 4);
                      e[0] = p0[0]; e[1] = p0[1]; e[2] = p0[2]; e[3] = p0[3]; e[4] = p1[0]; e[5] = p1[1]; e[6] = p1[2]; e[7] = p1[3]; }
#pragma unroll
                  for (int k = 0; k < 8; ++k) { sum[k] += e[k]; if (i == 0) self[k] = e[k]; } } }
          const float inv = 1.0f / cnt;
#pragma unroll
          for (int k = 0; k < 8; ++k) mt[r * 132 + c8 + k] = sum[k] * inv - self[k]; }
        __syncthreads();
        { const int r = F.tid >> 4, d8 = (F.tid & 15) * 8, row = tile * 32 + r; float acc[8];
#pragma unroll
          for (int k = 0; k < 8; ++k) acc[k] = 0.f;
#pragma unroll 4
          for (int c = 0; c < 128; ++c) { const float mv = mt[r * 132 + c]; const f32x4 w0 = *(const LAS f32x4*)(pw + c * 128 + d8), w1 = *(const LAS f32x4*)(pw + c * 128 + d8 + 4);
              acc[0] += mv * w0[0]; acc[1] += mv * w0[1]; acc[2] += mv * w0[2]; acc[3] += mv * w0[3]; acc[4] += mv * w1[0]; acc[5] += mv * w1[1]; acc[6] += mv * w1[2]; acc[7] += mv * w1[3]; }
          const f32x4 s0 = *(const f32x4*)(a.pool_scale + g * 128 + d8), s1 = *(const f32x4*)(a.pool_scale + g * 128 + d8 + 4);
          v4u o; o.x = pkbf(acc[0] * s0[0], acc[1] * s0[1]); o.y = pkbf(acc[2] * s0[2], acc[3] * s0[3]); o.z = pkbf(acc[4] * s1[0], acc[5] * s1[1]); o.w = pkbf(acc[6] * s1[2], acc[7] * s1[3]);
          *(v4u*)(PO + (size_t)row * DP + g * 128 + d8) = o; }
    }
}

__device__ __forceinline__ float attn_bound2(const Args& a, int lane) {
    asm volatile("" : "+v"(lane));
    const float gq = wave_max(fabsf(a.q_norm_g[lane])), gk = wave_max(fabsf(a.k_norm_g[lane]));
    return 64.0f * C2 * gq * gk * 1.03f;
}

__device__ __forceinline__ void p3_prompt_attn_naive(Frame& F, const Args& a) {
    unsigned char* ws = a.ws;
    const bf16* Q = (const bf16*)(ws + WS_Q); const bf16* K = (const bf16*)(ws + WS_K); const bf16* V = (const bf16*)(ws + WS_V); bf16* AO = (bf16*)(ws + WS_AO);
    const float* CP2 = (const float*)(ws + WS_CP2);
    LAS float* Ks = (LAS float*)F.lds;
    LAS float* Vs = (LAS float*)(F.lds + 16384);
    LAS float* cks = (LAS float*)(F.lds + 32768);
    const float M2 = attn_bound2(a, F.lane);
    for (int unit = blockIdx.x; unit < NB * NH * (SEQ / 512); unit += F.G) {
        const int bh = unit & 31, qblk = 7 - (unit >> 5), b = bh >> 3, h = bh & 7;
        const int i = qblk * 512 + F.tid; const size_t qrow = (size_t)(b * SEQ + i);
        float q[64], o[64];
#pragma unroll
        for (int d8 = 0; d8 < 8; ++d8) { const v4u w = *(const v4u*)(Q + qrow * DA + h * 64 + d8 * 8);
            q[d8 * 8 + 0] = bflo(w.x); q[d8 * 8 + 1] = bfhi(w.x); q[d8 * 8 + 2] = bflo(w.y); q[d8 * 8 + 3] = bfhi(w.y); q[d8 * 8 + 4] = bflo(w.z); q[d8 * 8 + 5] = bfhi(w.z); q[d8 * 8 + 6] = bflo(w.w); q[d8 * 8 + 7] = bfhi(w.w); }
#pragma unroll
        for (int d = 0; d < 64; ++d) o[d] = 0.f;
        const float cq = CP2[(size_t)bh * SEQ + i] - M2; float l = 0.f;
        const int ntile = (qblk + 1) * 8;
        for (int jt = 0; jt < ntile; ++jt) {
            __syncthreads();
            { const int kr = F.tid >> 3, d8 = (F.tid & 7) * 8; const size_t krow = (size_t)(b * SEQ + jt * 64 + kr);
              const v4u kw = *(const v4u*)(K + krow * DA + h * 64 + d8), vw = *(const v4u*)(V + krow * DA + h * 64 + d8);
              LAS float* kd = Ks + kr * 64 + d8; LAS float* vd = Vs + kr * 64 + d8;
              *(LAS f32x4*)kd = (f32x4){bflo(kw.x), bfhi(kw.x), bflo(kw.y), bfhi(kw.y)}; *(LAS f32x4*)(kd + 4) = (f32x4){bflo(kw.z), bfhi(kw.z), bflo(kw.w), bfhi(kw.w)};
              *(LAS f32x4*)vd = (f32x4){bflo(vw.x), bfhi(vw.x), bflo(vw.y), bfhi(vw.y)}; *(LAS f32x4*)(vd + 4) = (f32x4){bflo(vw.z), bfhi(vw.z), bflo(vw.w), bfhi(vw.w)};
              if (F.tid < 64) cks[F.tid] = CP2[(size_t)bh * SEQ + jt * 64 + F.tid]; }
            __syncthreads();
            for (int j = 0; j < 64; ++j) {
                float s = 0.f;
#pragma unroll
                for (int d4 = 0; d4 < 16; ++d4) { const f32x4 kv = *(const LAS f32x4*)(Ks + j * 64 + d4 * 4); s += (q[d4 * 4] * kv[0] + q[d4 * 4 + 1] * kv[1]) + (q[d4 * 4 + 2] * kv[2] + q[d4 * 4 + 3] * kv[3]); }
                float p = __builtin_amdgcn_exp2f(s + cq - cks[j]); if (jt * 64 + j > i) p = 0.f;
                l += p;
#pragma unroll
                for (int d4 = 0; d4 < 16; ++d4) { const f32x4 vv = *(const LAS f32x4*)(Vs + j * 64 + d4 * 4); o[d4 * 4] += p * vv[0]; o[d4 * 4 + 1] += p * vv[1]; o[d4 * 4 + 2] += p * vv[2]; o[d4 * 4 + 3] += p * vv[3]; }
            }
        }
        const float il = 1.0f / l;
#pragma unroll
        for (int d8 = 0; d8 < 8; ++d8) { v4u w; w.x = pkbf(o[d8 * 8] * il, o[d8 * 8 + 1] * il); w.y = pkbf(o[d8 * 8 + 2] * il, o[d8 * 8 + 3] * il); w.z = pkbf(o[d8 * 8 + 4] * il, o[d8 * 8 + 5] * il); w.w = pkbf(o[d8 * 8 + 6] * il, o[d8 * 8 + 7] * il);
            *(v4u*)(AO + qrow * DA + h * 64 + d8 * 8) = w; }
    }
}

__device__ __forceinline__ void p3_sample_attn(Frame& F, const Args& a, const float M2) {
    unsigned char* ws = a.ws;
    const bf16* Q = (const bf16*)(ws + WS_Q); bf16* AO = (bf16*)(ws + WS_AO);
    LAS float* qs = (LAS float*)F.lds;
    LAS float* lfp = (LAS float*)(F.lds + 2048);
    LAS float* E2 = (LAS float*)(F.lds + 2048 + 8192);
    LAS float* sc = (LAS float*)(F.lds + 12288);
    LAS float* Op = (LAS float*)(F.lds + 12288 + 16384);
    LAS float* lp = (LAS float*)(F.lds + 12288 + 32768);
    const int lane = F.lane, w = F.wave;
    for (int unit = blockIdx.x; unit < DB * NH; unit += F.G) {
        const int b = unit >> 3, h = unit & 7;
        __syncthreads();
        { const int t = F.tid >> 6, d = F.tid & 63; qs[t * 64 + d] = bf2f(Q[(size_t)(MP + b * 8 + t) * DA + h * 64 + d]); }
        for (int j = F.tid; j < PAST; j += NTHR) { const int pg = a.page_table[b * NPAGES + (j >> 7)]; lfp[j] = a.cache_lf[((size_t)pg * PAGE + (j & 127)) * NH + h]; }
        __syncthreads();
        if (w == 0) {
            float loc[32]; float tot = 0.f;
#pragma unroll
            for (int k = 31; k >= 0; --k) { loc[k] = tot; tot += lfp[lane * 32 + k]; }
            float inc = tot;
#pragma unroll
            for (int o = 1; o < 64; o <<= 1) { const float t = __shfl_down(inc, o); if (lane + o < 64) inc += t; }
            const float excl = inc - tot;
#pragma unroll
            for (int k = 0; k < 32; ++k) lfp[lane * 32 + k] = (loc[k] + excl) * LOG2E;
            if (lane < 8) { float e = 0.f; for (int t = 0; t <= lane; ++t) e += a.out[O_LFS + (size_t)(b * 8 + t) * NH + h]; E2[lane] = e * LOG2E; }
        }
        __syncthreads();
        f32x4 qp[8];
#pragma unroll
        for (int t = 0; t < 8; ++t) qp[t] = *(const LAS f32x4*)(qs + t * 64 + 4 * (lane & 15));
        float e2[8];
#pragma unroll
        for (int t = 0; t < 8; ++t) e2[t] = E2[t] - M2;
        float o[8], lsum[8];
#pragma unroll
        for (int t = 0; t < 8; ++t) { o[t] = 0.f; lsum[t] = 0.f; }
        LAS float* scw = sc + w * 512;
        const int nblk = (w == 0) ? 5 : 4;
        for (int blk = 0; blk < nblk; ++blk) {
            const bool isnew = blk == 4;
            for (int gi = 0; gi < (isnew ? 2 : 16); ++gi) {
                const int kk = 4 * gi + (lane >> 4);
                const float* kp;
                if (!isnew) { const int j = w * 256 + blk * 64 + kk; const int pg = a.page_table[b * NPAGES + (j >> 7)]; kp = a.cache_k + (((size_t)pg * PAGE + (j & 127)) * NH + h) * HD; }
                else kp = a.out + O_KS + (size_t)(b * 8 + kk) * DA + h * HD;
                const f32x4 k4 = *(const f32x4*)(kp + 4 * (lane & 15));
                float part[8];
#pragma unroll
                for (int t = 0; t < 8; ++t) part[t] = (qp[t][0] * k4[0] + qp[t][1] * k4[1]) + (qp[t][2] * k4[2] + qp[t][3] * k4[3]);
#pragma unroll
                for (int t = 0; t < 8; ++t) { part[t] += __shfl_xor(part[t], 1); part[t] += __shfl_xor(part[t], 2); part[t] += __shfl_xor(part[t], 4); part[t] += __shfl_xor(part[t], 8); }
                float mine = 0.f;
#pragma unroll
                for (int t = 0; t < 8; ++t) if ((lane & 15) == t) mine = part[t];
                if ((lane & 15) < 8) scw[kk * 8 + (lane & 15)] = mine;
            }
            LDS_WAIT(); asm volatile("" ::: "memory");
            { f32x4 s0 = *(const LAS f32x4*)(scw + lane * 8), s1 = *(const LAS f32x4*)(scw + lane * 8 + 4); float p[8];
              const float sv[8] = {s0[0], s0[1], s0[2], s0[3], s1[0], s1[1], s1[2], s1[3]};
              if (!isnew) { const float dj = lfp[w * 256 + blk * 64 + lane];
#pragma unroll
                  for (int t = 0; t < 8; ++t) p[t] = __builtin_amdgcn_exp2f(sv[t] + e2[t] + dj);
              } else {
#pragma unroll
                  for (int t = 0; t < 8; ++t) { const float ek = E2[lane & 7]; p[t] = (lane <= t) ? __builtin_amdgcn_exp2f(sv[t] + e2[t] - ek) : 0.f; }
              }
#pragma unroll
              for (int t = 0; t < 8; ++t) lsum[t] += p[t];
              *(LAS f32x4*)(scw + lane * 8) = (f32x4){p[0], p[1], p[2], p[3]}; *(LAS f32x4*)(scw + lane * 8 + 4) = (f32x4){p[4], p[5], p[6], p[7]}; }
            LDS_WAIT(); asm volatile("" ::: "memory");
            for (int kk = 0; kk < (isnew ? 8 : 64); ++kk) {
                const float* vp;
                if (!isnew) { const int j = w * 256 + blk * 64 + kk; const int pg = a.page_table[b * NPAGES + (j >> 7)]; vp = a.cache_v + (((size_t)pg * PAGE + (j & 127)) * NH + h) * HD; }
                else vp = a.out + O_VS + (size_t)(b * 8 + kk) * DA + h * HD;
                const float vv = vp[lane];
                const f32x4 p0 = *(const LAS f32x4*)(scw + kk * 8), p1 = *(const LAS f32x4*)(scw + kk * 8 + 4);
                o[0] += p0[0] * vv; o[1] += p0[1] * vv; o[2] += p0[2] * vv; o[3] += p0[3] * vv; o[4] += p1[0] * vv; o[5] += p1[1] * vv; o[6] += p1[2] * vv; o[7] += p1[3] * vv;
            }
            LDS_WAIT(); asm volatile("" ::: "memory");
        }
#pragma unroll
        for (int t = 0; t < 8; ++t) { Op[(w * 8 + t) * 64 + lane] = o[t]; const float ls = wave_sum(lsum[t]); if (lane == 0) lp[w * 8 + t] = ls; }
        __syncthreads();
        { const int t = F.tid >> 6, d = F.tid & 63; float O = 0.f, L = 0.f;
#pragma unroll
          for (int ww = 0; ww < 8; ++ww) { O += Op[(ww * 8 + t) * 64 + d]; L += lp[ww * 8 + t]; }
          AO[(size_t)(MP + b * 8 + t) * DA + h * 64 + d] = (bf16)(pkbf(O / L, 0.f) & 0xffffu); }
    }
}

__device__ __forceinline__ void p7_topk_naive(Frame& F, const Args& a) {
    unsigned char* ws = a.ws;
    const bf16* PQ = (const bf16*)(ws + WS_PQ); const bf16* SK = (const bf16*)(ws + WS_SUBK); const float* RSS = (const float*)(ws + WS_RSS);
    int* SI = (int*)(ws + WS_SI); float* SG = (float*)(ws + WS_SG);
    LAS float* kT = (LAS float*)F.lds;
    LAS float* qt = (LAS float*)(F.lds + 67584);
    LAS float* sc = (LAS float*)(F.lds + 83968);
    LAS float* tps = (LAS float*)(F.lds + 100352);
    LAS int* tpi = (LAS int*)(F.lds + 100352 + 4096);
    LAS float* fs = (LAS float*)(F.lds + 100352 + 8192);
    LAS float* rs = (LAS float*)(F.lds + 100352 + 8192 + 2048);
    LAS int* cab = (LAS int*)(F.lds + 100352 + 8192 + 2048 + 128);
    if (F.tid == 0) { int n = 0; for (int ca = 0; ca < 16; ++ca) for (int cb = 0; cb < 16; ++cb) if ((ca + 1) * (cb + 1) <= 16) cab[n++] = (ca << 4) | cb; }
    for (int unit = blockIdx.x; unit < (M / 32) * PH; unit += F.G) {
        const int h = unit & 7, tile = unit >> 3, row0 = tile * 32;
        for (int p = 0; p < 2; ++p) {
            __syncthreads();
            for (int i = F.tid; i < 128 * 128 / 8; i += NTHR) { const int n = i >> 4, d8 = (i & 15) * 8; const v4u wv = *(const v4u*)(SK + ((size_t)(h * 2 + p) * NKEYS + n) * DKH + d8);
                kT[(d8 + 0) * 132 + n] = bflo(wv.x); kT[(d8 + 1) * 132 + n] = bfhi(wv.x); kT[(d8 + 2) * 132 + n] = bflo(wv.y); kT[(d8 + 3) * 132 + n] = bfhi(wv.y);
                kT[(d8 + 4) * 132 + n] = bflo(wv.z); kT[(d8 + 5) * 132 + n] = bfhi(wv.z); kT[(d8 + 6) * 132 + n] = bflo(wv.w); kT[(d8 + 7) * 132 + n] = bfhi(wv.w); }
            { const int t = F.tid >> 4, d8 = (F.tid & 15) * 8; const v4u wv = *(const v4u*)(PQ + (size_t)(row0 + t) * DQ + h * 256 + p * 128 + d8);
              *(LAS f32x4*)(qt + t * 128 + d8) = (f32x4){bflo(wv.x), bfhi(wv.x), bflo(wv.y), bfhi(wv.y)}; *(LAS f32x4*)(qt + t * 128 + d8 + 4) = (f32x4){bflo(wv.z), bfhi(wv.z), bflo(wv.w), bfhi(wv.w)}; }
            if (p == 0 && F.tid < 32) { float s = 0.f; for (int k = 0; k < 16; ++k) s += RSS[(size_t)(row0 + F.tid) * 16 + k]; rs[F.tid] = 1.0f / sqrtf(s * (1.0f / DM) + EPS); }
            __syncthreads();
            const int t = F.tid >> 4, kq = (F.tid & 15) * 8;
            float acc[8];
#pragma unroll
            for (int k = 0; k < 8; ++k) acc[k] = 0.f;
#pragma unroll 4
            for (int d = 0; d < 128; ++d) { const float qv = qt[t * 128 + d]; const f32x4 k0 = *(const LAS f32x4*)(kT + d * 132 + kq), k1 = *(const LAS f32x4*)(kT + d * 132 + kq + 4);
                acc[0] += qv * k0[0]; acc[1] += qv * k0[1]; acc[2] += qv * k0[2]; acc[3] += qv * k0[3]; acc[4] += qv * k1[0]; acc[5] += qv * k1[1]; acc[6] += qv * k1[2]; acc[7] += qv * k1[3]; }
            *(LAS f32x4*)(sc + t * 128 + kq) = (f32x4){acc[0], acc[1], acc[2], acc[3]}; *(LAS f32x4*)(sc + t * 128 + kq + 4) = (f32x4){acc[4], acc[5], acc[6], acc[7]};
            __syncthreads();
            int rank[8];
#pragma unroll
            for (int k = 0; k < 8; ++k) rank[k] = 0;
            for (int j = 0; j < 128; ++j) { const float sj = sc[t * 128 + j];
#pragma unroll
                for (int k = 0; k < 8; ++k) rank[k] += (sj > acc[k] || (sj == acc[k] && j < kq + k)) ? 1 : 0; }
#pragma unroll
            for (int k = 0; k < 8; ++k) if (rank[k] < 16) { tps[(p * 32 + t) * 16 + rank[k]] = acc[k]; tpi[(p * 32 + t) * 16 + rank[k]] = kq + k; }
        }
        __syncthreads();
        { const int t = F.tid >> 4, l16 = F.tid & 15;
          float cs[4]; int cf[4], ci[4], rk[4];
#pragma unroll
          for (int k = 0; k < 4; ++k) { const int c = l16 + 16 * k; if (c < 50) { const int ab = cab[c], ca = ab >> 4, cb = ab & 15; cs[k] = tps[t * 16 + ca] + tps[(32 + t) * 16 + cb]; cf[k] = ab; ci[k] = tpi[t * 16 + ca] * NKEYS + tpi[(32 + t) * 16 + cb]; }
              else { cs[k] = -INFINITY; cf[k] = 1 << 20; ci[k] = 0; } rk[k] = 0; }
          for (int c = 0; c < 50; ++c) { const int ab = cab[c]; const float s = tps[t * 16 + (ab >> 4)] + tps[(32 + t) * 16 + (ab & 15)];
#pragma unroll
              for (int k = 0; k < 4; ++k) rk[k] += (s > cs[k] || (s == cs[k] && ab < cf[k])) ? 1 : 0; }
#pragma unroll
          for (int k = 0; k < 4; ++k) if (l16 + 16 * k < 50 && rk[k] < 16) { fs[t * 16 + rk[k]] = cs[k]; SI[(size_t)(row0 + t) * 128 + h * 16 + rk[k]] = ci[k]; }
        }
        __syncthreads();
        { const int t = F.tid >> 4, l16 = F.tid & 15; const float z = fs[t * 16 + l16] * rs[t];
          float mx = z; mx = fmaxf(mx, __shfl_xor(mx, 1)); mx = fmaxf(mx, __shfl_xor(mx, 2)); mx = fmaxf(mx, __shfl_xor(mx, 4)); mx = fmaxf(mx, __shfl_xor(mx, 8));
          const float e = expf(z - mx); float sm = e; sm += __shfl_xor(sm, 1); sm += __shfl_xor(sm, 2); sm += __shfl_xor(sm, 4); sm += __shfl_xor(sm, 8);
          SG[(size_t)(row0 + t) * 128 + h * 16 + l16] = e / sm; }
    }
}

__device__ __forceinline__ void p8_gather_naive(Frame& F, const Args& a) {
    unsigned char* ws = a.ws;
    const bf16* HG = (const bf16*)(ws + WS_XN); const bf16* PU = (const bf16*)(ws + WS_PU); const bf16* PV = (const bf16*)(ws + WS_PV);
    const float* RSS = (const float*)(ws + WS_RSS); const int* SI = (const int*)(ws + WS_SI); const float* SG = (const float*)(ws + WS_SG);
    float* Y = a.out + O_YP;
    LAS float* wl = (LAS float*)(F.lds + F.wave * 512);
    const int gw = F.vcu * NWAVES + F.wave, NGW = F.G * NWAVES, lane = F.lane;
    for (int row = gw; row < M; row += NGW) {
        float hx[16];
        { const v4u a0 = *(const v4u*)(HG + (size_t)row * DM + 8 * lane), a1 = *(const v4u*)(HG + (size_t)row * DM + 512 + 8 * lane);
          hx[0] = bflo(a0.x); hx[1] = bfhi(a0.x); hx[2] = bflo(a0.y); hx[3] = bfhi(a0.y); hx[4] = bflo(a0.z); hx[5] = bfhi(a0.z); hx[6] = bflo(a0.w); hx[7] = bfhi(a0.w);
          hx[8] = bflo(a1.x); hx[9] = bfhi(a1.x); hx[10] = bflo(a1.y); hx[11] = bfhi(a1.y); hx[12] = bflo(a1.z); hx[13] = bfhi(a1.z); hx[14] = bflo(a1.w); hx[15] = bfhi(a1.w); }
        float ssum = (lane < 16) ? RSS[(size_t)row * 16 + lane] : 0.f; ssum = wave_sum(ssum);
        const float rstd = 1.0f / sqrtf(ssum * (1.0f / DM) + EPS);
        const int e0 = SI[(size_t)row * 128 + lane], e1 = SI[(size_t)row * 128 + 64 + lane];
        const float g0 = SG[(size_t)row * 128 + lane], g1 = SG[(size_t)row * 128 + 64 + lane];
#pragma unroll 4
        for (int k = 0; k < 128; ++k) {
            const int e = __shfl(k < 64 ? e0 : e1, k & 63);
            const v4u u0 = *(const v4u*)(PU + (size_t)e * DM + 8 * lane), u1 = *(const v4u*)(PU + (size_t)e * DM + 512 + 8 * lane);
            float d = (hx[0] * bflo(u0.x) + hx[1] * bfhi(u0.x)) + (hx[2] * bflo(u0.y) + hx[3] * bfhi(u0.y)) + (hx[4] * bflo(u0.z) + hx[5] * bfhi(u0.z)) + (hx[6] * bflo(u0.w) + hx[7] * bfhi(u0.w))
                    + (hx[8] * bflo(u1.x) + hx[9] * bfhi(u1.x)) + (hx[10] * bflo(u1.y) + hx[11] * bfhi(u1.y)) + (hx[12] * bflo(u1.z) + hx[13] * bfhi(u1.z)) + (hx[14] * bflo(u1.w) + hx[15] * bfhi(u1.w));
            d = wave_sum(d);
            if (lane == (k & 63)) { const float z = d * rstd; const float ge = 0.5f * z * (1.0f + erff(z * 0.70710678118654752f)); wl[k] = ge * (k < 64 ? g0 : g1); }
        }
        LDS_WAIT(); asm volatile("" ::: "memory");
        float o[16];
#pragma unroll
        for (int i = 0; i < 16; ++i) o[i] = 0.f;
#pragma unroll 4
        for (int k = 0; k < 128; ++k) {
            const int e = __shfl(k < 64 ? e0 : e1, k & 63); const float wv = wl[k];
            const v4u u0 = *(const v4u*)(PV + (size_t)e * DM + 8 * lane), u1 = *(const v4u*)(PV + (size_t)e * DM + 512 + 8 * lane);
            o[0] += wv * bflo(u0.x); o[1] += wv * bfhi(u0.x); o[2] += wv * bflo(u0.y); o[3] += wv * bfhi(u0.y); o[4] += wv * bflo(u0.z); o[5] += wv * bfhi(u0.z); o[6] += wv * bflo(u0.w); o[7] += wv * bfhi(u0.w);
            o[8] += wv * bflo(u1.x); o[9] += wv * bfhi(u1.x); o[10] += wv * bflo(u1.y); o[11] += wv * bfhi(u1.y); o[12] += wv * bflo(u1.z); o[13] += wv * bfhi(u1.z); o[14] += wv * bflo(u1.w); o[15] += wv * bfhi(u1.w);
        }
        LDS_WAIT(); asm volatile("" ::: "memory");
        float* yr = Y + (size_t)row * DM; const float* hr = (const float*)(ws + WS_H) + (size_t)row * DM;
        { f32x4 y0 = *(const f32x4*)(hr + 8 * lane), y1 = *(const f32x4*)(hr + 8 * lane + 4), y2 = *(const f32x4*)(hr + 512 + 8 * lane), y3 = *(const f32x4*)(hr + 512 + 8 * lane + 4);
          y0 += (f32x4){o[0], o[1], o[2], o[3]}; y1 += (f32x4){o[4], o[5], o[6], o[7]}; y2 += (f32x4){o[8], o[9], o[10], o[11]}; y3 += (f32x4){o[12], o[13], o[14], o[15]};
          *(f32x4*)(yr + 8 * lane) = y0; *(f32x4*)(yr + 8 * lane + 4) = y1; *(f32x4*)(yr + 512 + 8 * lane) = y2; *(f32x4*)(yr + 512 + 8 * lane + 4) = y3; }
    }
}


typedef float f32x16 __attribute__((ext_vector_type(16)));
typedef short bf16x8v __attribute__((ext_vector_type(8)));
__device__ __forceinline__ int f2key(float s) { int b = __builtin_bit_cast(int, s); return b ^ ((b >> 31) & 0x7fffffff); }
__device__ __forceinline__ float key2f(int k) { return __builtin_bit_cast(float, k ^ ((k >> 31) & 0x7fffffff)); }
#define CE_DESC(x, y) do { const int mx_ = (x) > (y) ? (x) : (y), mn_ = (x) > (y) ? (y) : (x); (x) = mx_; (y) = mn_; } while (0)
template <int OFF, int N, typename T> __device__ __forceinline__ void bsort_desc(T& v) {
#pragma unroll
    for (int k = 2; k <= N; k <<= 1)
#pragma unroll
        for (int j = k >> 1; j > 0; j >>= 1)
#pragma unroll
            for (int i = 0; i < N; ++i) { const int l = i ^ j; if (l > i) { if ((i & k) == 0) CE_DESC(v[OFF + i], v[OFF + l]); else CE_DESC(v[OFF + l], v[OFF + i]); } }
}
template <int OFF, typename T> __device__ __forceinline__ void bmerge16_desc(T& v) {
#pragma unroll
    for (int j = 8; j > 0; j >>= 1)
#pragma unroll
        for (int i = 0; i < 16; ++i) { const int l = i ^ j; if (l > i) CE_DESC(v[OFF + i], v[OFF + l]); }
}
template <int OA, int OB, typename T> __device__ __forceinline__ void top16_merge(T& v) {
#pragma unroll
    for (int i = 0; i < 16; ++i) v[OA + i] = v[OA + i] > v[OB + 15 - i] ? v[OA + i] : v[OB + 15 - i];
    bmerge16_desc<OA>(v);
}
template <typename T> __device__ __forceinline__ void top16_of_64(T& v) {
    bsort_desc<0, 16>(v); bsort_desc<16, 16>(v); bsort_desc<32, 16>(v); bsort_desc<48, 16>(v);
    top16_merge<0, 16>(v); top16_merge<32, 48>(v); top16_merge<0, 32>(v);
}
__device__ __forceinline__ void p7_topk(Frame& F, const Args& a) {
    unsigned char* ws = a.ws;
    const bf16* PQ = (const bf16*)(ws + WS_PQ); const bf16* SK = (const bf16*)(ws + WS_SUBK); const float* RSS = (const float*)(ws + WS_RSS);
    int* SI = (int*)(ws + WS_SI); float* SG = (float*)(ws + WS_SG);
    const int lane = F.lane, j = lane & 31, hi = lane >> 5;
    LAS unsigned* ib = (LAS unsigned*)(F.lds + F.wave * 1024);
    const int gw = F.vcu * NWAVES + F.wave, NGW = F.G * NWAVES;
    for (int item = gw; item < (M / 32) * PH; item += NGW) {
        const int h = item & 7, row0 = (item >> 3) * 32;
        int jl = j, hl = hi; asm volatile("" : "+v"(jl), "+v"(hl));
        int top[2][16];
#pragma unroll
        for (int p = 0; p < 2; ++p) {
            bf16x8v qf[8];
#pragma unroll
            for (int ks = 0; ks < 8; ++ks) qf[ks] = *(const bf16x8v*)(PQ + (size_t)(row0 + jl) * DQ + h * 256 + p * 128 + 16 * ks + 8 * hl);
            f32x16 acc[4];
#pragma unroll
            for (int mt = 0; mt < 4; ++mt) acc[mt] = f32x16{};
            const bf16* kb = SK + ((size_t)(h * 2 + p) * NKEYS + jl) * DKH + 8 * hl;
#pragma unroll
            for (int ks = 0; ks < 8; ++ks)
#pragma unroll
                for (int mt = 0; mt < 4; ++mt) { const bf16x8v af = *(const bf16x8v*)(kb + mt * 32 * DKH + ks * 16); acc[mt] = __builtin_amdgcn_mfma_f32_32x32x16_bf16(af, qf[ks], acc[mt], 0, 0, 0); }
            int v[64];
#pragma unroll
            for (int mt = 0; mt < 4; ++mt)
#pragma unroll
                for (int r = 0; r < 16; ++r) { const int n = 32 * mt + (r & 3) + 8 * (r >> 2) + 4 * hi; v[16 * mt + r] = (f2key(acc[mt][r]) & ~127) | (127 - n); }
            top16_of_64(v);
#pragma unroll
            for (int i = 0; i < 16; ++i) top[p][i] = v[i];
        }
        int S[32];
#pragma unroll
        for (int i = 0; i < 16; ++i) { auto rr = __builtin_amdgcn_permlane32_swap((unsigned)top[0][i], (unsigned)top[1][i], false, false); S[i] = (int)rr[0]; S[16 + i] = (int)rr[1]; }
        top16_merge<0, 16>(S);
        { unsigned w0 = 0, w1 = 0, w2 = 0, w3 = 0;
#pragma unroll
          for (int i = 0; i < 4; ++i) { w0 |= (unsigned)(127 - (S[i] & 127)) << (8 * i); w1 |= (unsigned)(127 - (S[4 + i] & 127)) << (8 * i); w2 |= (unsigned)(127 - (S[8 + i] & 127)) << (8 * i); w3 |= (unsigned)(127 - (S[12 + i] & 127)) << (8 * i); }
          *(LAS v4u*)(ib + (hi * 32 + j) * 4) = (v4u){w0, w1, w2, w3}; }
        float s1[16], s2[16];
#pragma unroll
        for (int i = 0; i < 16; ++i) { auto rr = __builtin_amdgcn_permlane32_swap((unsigned)S[i], (unsigned)S[i], false, false); s1[i] = key2f((int)rr[0] & ~127); s2[i] = key2f((int)rr[1] & ~127); }
        int c[64]; { int n = 0;
#pragma unroll
          for (int ca = 0; ca < 16; ++ca)
#pragma unroll
              for (int cb = 0; cb < 16; ++cb) if ((ca + 1) * (cb + 1) <= 16) { c[n] = (f2key(s1[ca] + s2[cb]) & ~255) | (255 - (ca * 16 + cb)); ++n; }
#pragma unroll
          for (int q = 50; q < 64; ++q) c[q] = (int)0x80000000; }
        top16_of_64(c);
        float ssq = 0.f;
#pragma unroll
        for (int q = 0; q < 4; ++q) { const f32x4 t4 = *(const f32x4*)(RSS + (size_t)(row0 + j) * 16 + 4 * q); ssq += (t4[0] + t4[1]) + (t4[2] + t4[3]); }
        const float rstd = 1.0f / sqrtf(ssq * (1.0f / DM) + EPS);
        const float z0 = key2f(c[0] & ~255) * rstd; float e[16], esum = 0.f;
#pragma unroll
        for (int k = 0; k < 16; ++k) { e[k] = __expf(key2f(c[k] & ~255) * rstd - z0); esum += e[k]; }
        const float inv = 1.0f / esum;
        LDS_WAIT(); asm volatile("" ::: "memory");
        const LAS unsigned char* ib8 = (const LAS unsigned char*)ib;
        int oi[8]; float og[8];
#pragma unroll
        for (int k = 0; k < 8; ++k) { const int ck = hi ? c[8 + k] : c[k]; const float ek = hi ? e[8 + k] : e[k]; const int fl = 255 - (ck & 255);
            const int i1 = ib8[(0 * 32 + j) * 16 + (fl >> 4)], i2 = ib8[(1 * 32 + j) * 16 + (fl & 15)]; oi[k] = i1 * NKEYS + i2; og[k] = ek * inv; }
        { int* sp = SI + (size_t)(row0 + j) * 128 + h * 16 + hi * 8; float* gp = SG + (size_t)(row0 + j) * 128 + h * 16 + hi * 8;
          *(v4u*)sp = (v4u){(unsigned)oi[0], (unsigned)oi[1], (unsigned)oi[2], (unsigned)oi[3]}; *(v4u*)(sp + 4) = (v4u){(unsigned)oi[4], (unsigned)oi[5], (unsigned)oi[6], (unsigned)oi[7]};
          *(f32x4*)gp = (f32x4){og[0], og[1], og[2], og[3]}; *(f32x4*)(gp + 4) = (f32x4){og[4], og[5], og[6], og[7]}; }
        LDS_WAIT(); asm volatile("" ::: "memory");
    }
}


constexpr int P8_TOK = 68, P8_Q = 9;
static_assert(M % P8_TOK == 0 && P8_TOK <= 8 * P8_Q, "P8 chunking");
typedef __bf16 bf16x2v __attribute__((ext_vector_type(2)));
__device__ __forceinline__ float dot2bf(unsigned w, unsigned x, float acc) { return __builtin_amdgcn_fdot2_f32_bf16(__builtin_bit_cast(bf16x2v, w), __builtin_bit_cast(bf16x2v, x), acc, false); }
__device__ __forceinline__ void p8_gather(Frame& F, const Args& a) {
    unsigned char* ws = a.ws;
    const bf16* HG = (const bf16*)(ws + WS_XN); const bf16* PU = (const bf16*)(ws + WS_PU); const bf16* PV = (const bf16*)(ws + WS_PV);
    const float* RSS = (const float*)(ws + WS_RSS); const int* SI = (const int*)(ws + WS_SI); const float* SG = (const float*)(ws + WS_SG); const float* Hh = (const float*)(ws + WS_H);
    float* Y = a.out + O_YP;
    LAS unsigned short* ix = (LAS unsigned short*)F.lds;
    LAS float* wt = (LAS float*)(F.lds + P8_TOK * 128 * 2);
    LAS float* rs = (LAS float*)(F.lds + P8_TOK * 128 * 2 + P8_TOK * 128 * 4);
    const int lane = F.lane, g = lane >> 2, c4 = lane & 3;
    for (int chunk = F.vcu; chunk < M / P8_TOK; chunk += F.G) {
        const int tb = chunk * P8_TOK;
        __syncthreads();
        for (int i = F.tid; i < P8_TOK * 128; i += NTHR) { ix[i] = (unsigned short)SI[(size_t)tb * 128 + i]; wt[i] = SG[(size_t)tb * 128 + i]; }
        if (F.tid < P8_TOK) { float s = 0.f; for (int k = 0; k < 16; ++k) s += RSS[(size_t)(tb + F.tid) * 16 + k]; rs[F.tid] = 1.0f / sqrtf(s * (1.0f / DM) + EPS); }
        __syncthreads();
        float acc[P8_Q][8];
#pragma unroll
        for (int q = 0; q < P8_Q; ++q)
#pragma unroll
            for (int i = 0; i < 8; ++i) acc[q][i] = 0.f;
        for (int s = 0; s < 16; ++s) {
            int cl = c4; asm volatile("" : "+v"(cl));
#pragma unroll
            for (int q = 0; q < P8_Q; ++q) { const int lt = F.wave + 8 * q; if (lt < P8_TOK) {
                const v4u ea = *(const LAS v4u*)(ix + lt * 128 + g * 8);
                const v4u h0 = *(const v4u*)(HG + (size_t)(tb + lt) * DM + 64 * s + 16 * cl), h1 = *(const v4u*)(HG + (size_t)(tb + lt) * DM + 64 * s + 16 * cl + 8);
                const unsigned ew[4] = {ea.x, ea.y, ea.z, ea.w};
                v4u r0[8], r1[8];
#pragma unroll
                for (int i = 0; i < 8; ++i) { const unsigned e = (i & 1) ? (ew[i >> 1] >> 16) : (ew[i >> 1] & 0xffffu); const bf16* up = PU + (size_t)e * DM + 64 * s + 16 * cl;
                    r0[i] = *(const v4u*)up; r1[i] = *(const v4u*)(up + 8); }
#pragma unroll
                for (int i = 0; i < 8; ++i) { float d = acc[q][i];
                    d = dot2bf(r0[i].x, h0.x, d); d = dot2bf(r0[i].y, h0.y, d); d = dot2bf(r0[i].z, h0.z, d); d = dot2bf(r0[i].w, h0.w, d);
                    d = dot2bf(r1[i].x, h1.x, d); d = dot2bf(r1[i].y, h1.y, d); d = dot2bf(r1[i].z, h1.z, d); d = dot2bf(r1[i].w, h1.w, d); acc[q][i] = d; } } }
        }
#pragma unroll
        for (int q = 0; q < P8_Q; ++q) { const int lt = F.wave + 8 * q; if (lt < P8_TOK) {
            float v4[4], v2[2]; const bool b2 = (c4 & 2) != 0, b1 = (c4 & 1) != 0;
#pragma unroll
            for (int j2 = 0; j2 < 4; ++j2) { const float keep = b2 ? acc[q][4 + j2] : acc[q][j2], send = b2 ? acc[q][j2] : acc[q][4 + j2]; v4[j2] = keep + __shfl_xor(send, 2); }
#pragma unroll
            for (int j2 = 0; j2 < 2; ++j2) { const float keep = b1 ? v4[2 + j2] : v4[j2], send = b1 ? v4[j2] : v4[2 + j2]; v2[j2] = keep + __shfl_xor(send, 1); }
            const float r = rs[lt]; LAS float* wp = wt + lt * 128 + g * 8 + 2 * c4; const f32x2 gt = *(const LAS f32x2*)wp;
            const float z0 = v2[0] * r, z1 = v2[1] * r;
            const float a0 = 0.5f * z0 * (1.0f + erff(z0 * 0.70710678118654752f)), a1 = 0.5f * z1 * (1.0f + erff(z1 * 0.70710678118654752f));
            *(LAS f32x2*)wp = (f32x2){gt[0] * a0, gt[1] * a1}; } }
        LDS_WAIT(); asm volatile("" ::: "memory");
        for (int s = 0; s < 16; ++s) {
            int cl = c4; asm volatile("" : "+v"(cl));
#pragma unroll 1
            for (int q = 0; q < P8_Q; ++q) { const int lt = F.wave + 8 * q; if (lt < P8_TOK) {
                const v4u ea = *(const LAS v4u*)(ix + lt * 128 + g * 8);
                const unsigned ew[4] = {ea.x, ea.y, ea.z, ea.w};
                const f32x4 wa = *(const LAS f32x4*)(wt + lt * 128 + g * 8), wb = *(const LAS f32x4*)(wt + lt * 128 + g * 8 + 4);
                const float wv[8] = {wa[0], wa[1], wa[2], wa[3], wb[0], wb[1], wb[2], wb[3]};
                v4u r0[8], r1[8];
#pragma unroll
                for (int i = 0; i < 8; ++i) { const unsigned e = (i & 1) ? (ew[i >> 1] >> 16) : (ew[i >> 1] & 0xffffu); const bf16* vp = PV + (size_t)e * DM + 64 * s + 16 * cl;
                    r0[i] = *(const v4u*)vp; r1[i] = *(const v4u*)(vp + 8); }
                float o[16];
#pragma unroll
                for (int k = 0; k < 16; ++k) o[k] = 0.f;
#pragma unroll
                for (int i = 0; i < 8; ++i) { const float w = wv[i];
                    o[0] += w * bflo(r0[i].x); o[1] += w * bfhi(r0[i].x); o[2] += w * bflo(r0[i].y); o[3] += w * bfhi(r0[i].y); o[4] += w * bflo(r0[i].z); o[5] += w * bfhi(r0[i].z); o[6] += w * bflo(r0[i].w); o[7] += w * bfhi(r0[i].w);
                    o[8] += w * bflo(r1[i].x); o[9] += w * bfhi(r1[i].x); o[10] += w * bflo(r1[i].y); o[11] += w * bfhi(r1[i].y); o[12] += w * bflo(r1[i].z); o[13] += w * bfhi(r1[i].z); o[14] += w * bflo(r1[i].w); o[15] += w * bfhi(r1[i].w); }
                const bool b5 = (lane & 32) != 0, b4 = (lane & 16) != 0, b3 = (lane & 8) != 0, b2 = (lane & 4) != 0; float p8[8], p4[4], p2[2];
#pragma unroll
                for (int j2 = 0; j2 < 8; ++j2) { const float keep = b5 ? o[8 + j2] : o[j2], send = b5 ? o[j2] : o[8 + j2]; p8[j2] = keep + __shfl_xor(send, 32); }
#pragma unroll
                for (int j2 = 0; j2 < 4; ++j2) { const float keep = b4 ? p8[4 + j2] : p8[j2], send = b4 ? p8[j2] : p8[4 + j2]; p4[j2] = keep + __shfl_xor(send, 16); }
#pragma unroll
                for (int j2 = 0; j2 < 2; ++j2) { const float keep = b3 ? p4[2 + j2] : p4[j2], send = b3 ? p4[j2] : p4[2 + j2]; p2[j2] = keep + __shfl_xor(send, 8); }
                const float keep = b2 ? p2[1] : p2[0], send = b2 ? p2[0] : p2[1]; const float tot = keep + __shfl_xor(send, 4);
                const size_t off = (size_t)(tb + lt) * DM + 64 * s + 16 * cl + (b5 ? 8 : 0) + (b4 ? 4 : 0) + (b3 ? 2 : 0) + (b2 ? 1 : 0);
                Y[off] = Hh[off] + tot; } }
        }
    }
}


__device__ __forceinline__ void p3_sample_attn2(Frame& F, const Args& a, const float M2) {
    unsigned char* ws = a.ws;
    const bf16* Q = (const bf16*)(ws + WS_Q); bf16* AO = (bf16*)(ws + WS_AO);
    LAS float* D2 = (LAS float*)F.lds;
    LAS float* E2 = (LAS float*)(F.lds + 32768);
    LAS float* Pt = (LAS float*)(F.lds + 32768 + 128);
    LAS float* Op = (LAS float*)(F.lds + 32768 + 128 + 8192);
    LAS float* lp = (LAS float*)(F.lds + 32768 + 128 + 8192 + 16384);
    int lane = F.lane; asm volatile("" : "+v"(lane));
    const int w = F.wave, hh = w >> 1, kh = w & 1, n = lane & 31, hi = lane >> 5;
    LAS float* Pw = Pt + w * 256;
    for (int unit = F.vcu; unit < DB * 2; unit += F.G) {
        const int b = unit >> 1, h = 4 * (unit & 1) + hh;
        __syncthreads();
        for (int i = F.tid; i < 4 * PAST; i += NTHR) { const int hq = i >> 11, jk = i & (PAST - 1); const int pg = a.page_table[b * NPAGES + (jk >> 7)];
            D2[i] = a.cache_lf[((size_t)pg * PAGE + (jk & 127)) * NH + 4 * (unit & 1) + hq]; }
        __syncthreads();
        if (kh == 0) {
            LAS float* d = D2 + hh * PAST; float loc[32]; float tot = 0.f;
#pragma unroll
            for (int k = 31; k >= 0; --k) { loc[k] = tot; tot += d[lane * 32 + k]; }
            float inc = tot;
#pragma unroll
            for (int o = 1; o < 64; o <<= 1) { const float t = __shfl_down(inc, o); if (lane + o < 64) inc += t; }
            const float excl = inc - tot;
#pragma unroll
            for (int k = 0; k < 32; ++k) d[lane * 32 + k] = (loc[k] + excl) * LOG2E;
            if (lane < 8) { float e = 0.f; for (int t = 0; t <= lane; ++t) e += a.out[O_LFS + (size_t)(b * 8 + t) * NH + h]; E2[hh * 8 + lane] = e * LOG2E; }
        }
        __syncthreads();
        bf16x8v qa[4];
#pragma unroll
        for (int ks = 0; ks < 4; ++ks) { qa[ks] = bf16x8v{}; if (n < 8) qa[ks] = *(const bf16x8v*)(Q + (size_t)(MP + b * 8 + n) * DA + h * 64 + 16 * ks + 8 * hi); }
        float e2[4];
#pragma unroll
        for (int t = 0; t < 4; ++t) e2[t] = E2[hh * 8 + 4 * hi + t] - M2;
        float o[8], lsum[4];
#pragma unroll
        for (int t = 0; t < 8; ++t) o[t] = 0.f;
#pragma unroll
        for (int t = 0; t < 4; ++t) lsum[t] = 0.f;
        const LAS float* dh = D2 + hh * PAST;
        const int nit = PAST / 2 / 32;
        f32x4 kq[8]; float vv[32];
#define S3_COMPUTE(it_, NEWK) do { f32x16 sacc = f32x16{}; \
            _Pragma("unroll") for (int ks = 0; ks < 4; ++ks) { const f32x4 x0_ = kq[2 * ks], x1_ = kq[2 * ks + 1]; v4u kb_; kb_.x = pkbf(x0_[0], x0_[1]); kb_.y = pkbf(x0_[2], x0_[3]); kb_.z = pkbf(x1_[0], x1_[1]); kb_.w = pkbf(x1_[2], x1_[3]); \
                sacc = __builtin_amdgcn_mfma_f32_32x32x16_bf16(qa[ks], __builtin_bit_cast(bf16x8v, kb_), sacc, 0, 0, 0); } \
            float p_[4]; \
            if (!(NEWK)) { const float dj_ = dh[kh * (PAST / 2) + (it_) * 32 + n]; _Pragma("unroll") for (int t = 0; t < 4; ++t) p_[t] = __builtin_amdgcn_exp2f(sacc[t] + e2[t] + dj_); } \
            else { const float ek_ = E2[hh * 8 + (n & 7)]; _Pragma("unroll") for (int t = 0; t < 4; ++t) p_[t] = (n <= 4 * hi + t) ? __builtin_amdgcn_exp2f(sacc[t] + e2[t] - ek_) : 0.f; } \
            _Pragma("unroll") for (int t = 0; t < 4; ++t) lsum[t] += p_[t]; \
            *(LAS f32x4*)(Pw + n * 8 + 4 * hi) = (f32x4){p_[0], p_[1], p_[2], p_[3]}; \
            LDS_WAIT(); asm volatile("" ::: "memory"); \
            _Pragma("unroll") for (int k_ = 0; k_ < ((NEWK) ? 8 : 32); ++k_) { const f32x4 pa_ = *(const LAS f32x4*)(Pw + k_ * 8), pb_ = *(const LAS f32x4*)(Pw + k_ * 8 + 4); const float v_ = vv[k_]; \
                o[0] += pa_[0] * v_; o[1] += pa_[1] * v_; o[2] += pa_[2] * v_; o[3] += pa_[3] * v_; o[4] += pb_[0] * v_; o[5] += pb_[1] * v_; o[6] += pb_[2] * v_; o[7] += pb_[3] * v_; } \
            LDS_WAIT(); asm volatile("" ::: "memory"); } while (0)
        for (int it = 0; it < nit; ++it) {
            const int j0 = kh * (PAST / 2) + it * 32; const int pg = a.page_table[b * NPAGES + (j0 >> 7)];
            const size_t rowoff = (((size_t)pg * PAGE + (j0 & 127)) * NH + h) * HD;
            const float* kr = a.cache_k + rowoff + (size_t)n * (NH * HD) + 8 * hi; const float* vb = a.cache_v + rowoff;
#pragma unroll
            for (int ks = 0; ks < 4; ++ks) { kq[2 * ks] = __builtin_nontemporal_load((const f32x4*)(kr + 16 * ks)); kq[2 * ks + 1] = __builtin_nontemporal_load((const f32x4*)(kr + 16 * ks + 4)); }
#pragma unroll
            for (int k = 0; k < 32; ++k) vv[k] = __builtin_nontemporal_load(vb + (size_t)k * (NH * HD) + lane);
            S3_COMPUTE(it, false);
        }
        if (kh == 1) {
            const float* kr = a.out + O_KS + (size_t)(b * 8 + (n & 7)) * DA + h * HD + 8 * hi; const float* vr = a.out + O_VS + (size_t)(b * 8) * DA + h * HD + lane;
#pragma unroll
            for (int ks = 0; ks < 4; ++ks) { kq[2 * ks] = *(const f32x4*)(kr + 16 * ks); kq[2 * ks + 1] = *(const f32x4*)(kr + 16 * ks + 4); }
#pragma unroll
            for (int k = 0; k < 8; ++k) vv[k] = vr[(size_t)k * DA];
            S3_COMPUTE(0, true);
        }
#undef S3_COMPUTE
#pragma unroll
        for (int t = 0; t < 4; ++t) { float s = lsum[t]; s += __shfl_xor(s, 1); s += __shfl_xor(s, 2); s += __shfl_xor(s, 4); s += __shfl_xor(s, 8); s += __shfl_xor(s, 16); if (n == 0) lp[w * 8 + 4 * hi + t] = s; }
#pragma unroll
        for (int t = 0; t < 8; ++t) Op[(w * 8 + t) * 64 + lane] = o[t];
        __syncthreads();
        for (int i = F.tid; i < 4 * 8 * 64; i += NTHR) { const int hq = i >> 9, t = (i >> 6) & 7, d = i & 63;
            const float O = Op[((2 * hq) * 8 + t) * 64 + d] + Op[((2 * hq + 1) * 8 + t) * 64 + d], L = lp[(2 * hq) * 8 + t] + lp[(2 * hq + 1) * 8 + t];
            AO[(size_t)(MP + b * 8 + t) * DA + (4 * (unit & 1) + hq) * 64 + d] = (bf16)(pkbf(O / L, 0.f) & 0xffffu); }
    }
}

constexpr int N_PHASES = 9;
#ifndef MK_PER_PHASE
#define MK_PER_PHASE 0
#endif
__global__ void __launch_bounds__(NTHR, 2) fwd_kernel(Args args) {
    extern __shared__ __attribute__((aligned(16))) unsigned char lds[];
    Frame F;
    F.lds = (LAS unsigned char*)lds; F.MISC = (volatile LAS unsigned*)(F.lds + MISC_OFF);
    F.tid = threadIdx.x; F.lane = F.tid & 63; F.wave = __builtin_amdgcn_readfirstlane(F.tid >> 6);
    F.G = gridDim.x; { const int bx = blockIdx.x; F.vcu = (F.G % 8 == 0) ? (bx % 8) * (F.G / 8) + bx / 8 : bx; }
    F.ctl = (gu32*)(args.ws + WS_CTL);
    for (int u = F.tid; u < (LDS_BYTES - MISC_OFF) / 4; u += NTHR) ((LAS unsigned*)(F.lds + MISC_OFF))[u] = 0u;
    __syncthreads();
#if MK_PER_PHASE
#define GRID_BAR() do { } while (0)
#else
    XcdBarrier bar = xcd_barrier_post((unsigned*)(F.ctl + CW_BAR), F.MISC + 8);
#define GRID_BAR() xcd_barrier(bar)
#endif
    unsigned char* ws = args.ws;
    const int lo = args.ph_lo, hi = args.ph_hi;
#ifndef DBG_REP_PHASE
#define DBG_REP_PHASE -1
#endif
#ifndef DBG_REP_N
#define DBG_REP_N 1
#endif
#define REPS(k) for (int rep_ = 0; rep_ < ((k) == DBG_REP_PHASE ? 1 + DBG_REP_N : 1); ++rep_)
#define IN(k) (lo <= (k) && (k) < hi)
#define BOTH(k) (IN(k) && IN((k) + 1))
#define ENDPH(k) do { if (BOTH(k) || (k) == DBG_REP_PHASE) GRID_BAR(); } while (0)
    if (IN(0)) REPS(0) { p0_prologue(F, args); ENDPH(0); }
    if (IN(1)) REPS(1) {
        pg8::Gemm g{(const bf16*)(ws + WS_XN), (const bf16*)(ws + WS_WIN), M, NPROJ, DM}; pg8::StaticOrder S; S.init(M, NPROJ, F.G, (int)blockIdx.x);
        EpiInProj E{(bf16*)(ws + WS_U), (bf16*)(ws + WS_Q), (bf16*)(ws + WS_K), (bf16*)(ws + WS_V), (bf16*)(ws + WS_GA), (bf16*)(ws + WS_GB), args.out, args.q_norm_g, args.k_norm_g};
        pg8::gemm_phase<EpiInProj, pg8::StaticOrder, true, true>(F.lds, g, S, E);
        ENDPH(1);
    }
    if (IN(2)) REPS(2) { p2_cumsum_pool(F, args); ENDPH(2); }
    if (IN(3)) {
        const float M2 = __builtin_bit_cast(float, __builtin_amdgcn_readfirstlane(__builtin_bit_cast(int, attn_bound2(args, F.lane))));
#if !defined(DBG_SKIP_PATTN)
        { const attn_body::AttnTensors AT{(const attn_body::bf16*)(ws + WS_Q), (const attn_body::bf16*)(ws + WS_K), (const attn_body::bf16*)(ws + WS_V), (attn_body::bf16*)(ws + WS_AO), (const float*)(ws + WS_CP2), M2};
          const attn_body::StaticOrder S((int)F.G, F.vcu);
          attn_body::attn_phase<attn_body::StaticOrder>((char*)lds, AT, S); }
#endif
#ifdef P3S_OLD
        REPS(3) { p3_sample_attn(F, args, M2); }
#else
        REPS(3) { p3_sample_attn2(F, args, M2); }
#endif
        ENDPH(3); }
    if (IN(4)) REPS(4) {
        { pg8::Gemm g{(const bf16*)(ws + WS_PO), (const bf16*)(ws + WS_WBP), M, DM, DP}; pg8::StaticOrder S; S.init(M, DM, F.G, (int)blockIdx.x);
          EpiGate<0> E{(const bf16*)(ws + WS_GA), nullptr, (bf16*)(ws + WS_T)};
          pg8::gemm_phase<EpiGate<0>, pg8::StaticOrder, true, true>(F.lds, g, S, E); }
        __syncthreads();
        { pg8::Gemm g{(const bf16*)(ws + WS_AO), (const bf16*)(ws + WS_WBA), M, DM, DA}; pg8::StaticOrder S; S.init(M, DM, F.G, (int)blockIdx.x);
          EpiGate<1> E{(const bf16*)(ws + WS_GB), (const bf16*)(ws + WS_T), (bf16*)(ws + WS_MIX)};
          pg8::gemm_phase<EpiGate<1>, pg8::StaticOrder, true, true>(F.lds, g, S, E); }
        ENDPH(4);
    }
    if (IN(5)) REPS(5) {
        pg8::Gemm g{(const bf16*)(ws + WS_MIX), (const bf16*)(ws + WS_WOUT), M, DM, DM}; pg8::StaticOrder S; S.init(M, DM, F.G, (int)blockIdx.x);
        EpiOut E{args.x_p, args.x_s, (float*)(ws + WS_H), (bf16*)(ws + WS_XN), args.norm_ffn_g, (float*)(ws + WS_RSS)};
        pg8::gemm_phase<EpiOut, pg8::StaticOrder, true, true>(F.lds, g, S, E);
        ENDPH(5);
    }
    if (IN(6)) REPS(6) {
        pg8::Gemm g{(const bf16*)(ws + WS_XN), (const bf16*)(ws + WS_WQ), M, DQ, DM}; pg8::StaticOrder S; S.init(M, DQ, F.G, (int)blockIdx.x);
        pg8::EpiBf16<0> E{(bf16*)(ws + WS_PQ), DQ, nullptr, 0, 0, 1.f};
        pg8::gemm_phase<pg8::EpiBf16<0>, pg8::StaticOrder, true, true>(F.lds, g, S, E);
        ENDPH(6);
    }
#ifdef P7_NAIVE
    if (IN(7)) REPS(7) { p7_topk_naive(F, args); ENDPH(7); }
#else
    if (IN(7)) REPS(7) { p7_topk(F, args); ENDPH(7); }
#endif
#ifdef P8_NAIVE
    if (IN(8)) REPS(8) { p8_gather_naive(F, args); ENDPH(8); }
#else
    if (IN(8)) REPS(8) { p8_gather(F, args); ENDPH(8); }
#endif
#ifdef DBG_DUMP
    if (IN(9)) { const bf16* AO = (const bf16*)(ws + WS_AO); const bf16* PO = (const bf16*)(ws + WS_PO); const bf16* MX = (const bf16*)(ws + (DBG_DUMP == 3 ? WS_T : DBG_DUMP == 4 ? WS_GA : WS_MIX));
        for (size_t i = (size_t)blockIdx.x * NTHR + F.tid; i < (size_t)M * DM; i += (size_t)F.G * NTHR) { const int row = (int)(i >> 10), c = (int)(i & 1023);
            float v; if (DBG_DUMP == 1) v = c < 512 ? bf2f(AO[(size_t)row * DA + c]) : bf2f(PO[(size_t)row * DP + c - 512]); else v = bf2f(MX[i]);
            args.out[O_YP + i] = v; } }
#endif
#undef IN
#undef BOTH
}

extern "C" void kernel_launch(void* const* d_in, const int* in_sizes, int n_in, void* d_out, int out_size, void* d_ws, size_t ws_size, hipStream_t stream) {
    static int grid = 0;
    if (grid == 0) {
        if (n_in != 22 || (size_t)out_size != O_END || ws_size < WS_END) { fprintf(stderr, "kernel_launch: unexpected shapes (n_in %d out %d ws %zu)\n", n_in, out_size, ws_size); grid = -1; return; }
        int dev = 0, cus = 0, per_cu = 0;
        if (hipGetDevice(&dev) != hipSuccess || hipDeviceGetAttribute(&cus, hipDeviceAttributeMultiprocessorCount, dev) != hipSuccess) { grid = -1; return; }
        if (hipFuncSetAttribute((const void*)fwd_kernel, hipFuncAttributeMaxDynamicSharedMemorySize, LDS_BYTES) != hipSuccess) { fprintf(stderr, "kernel_launch: hipFuncSetAttribute failed\n"); grid = -1; return; }
        if (hipOccupancyMaxActiveBlocksPerMultiprocessor(&per_cu, (const void*)fwd_kernel, NTHR, LDS_BYTES) != hipSuccess || per_cu < 1) fprintf(stderr, "kernel_launch: occupancy query reports %d\n", per_cu);
        (void)hipGetLastError();
        grid = cus;
    }
    if (grid < 0) return;
    if (hipMemsetAsync((char*)d_ws + WS_CTL, 0, CTL_ZERO_BYTES, stream) != hipSuccess) return;
    Args a{};
    a.x_p = (const float*)d_in[0]; a.x_s = (const float*)d_in[1]; a.cache_k = (const float*)d_in[2]; a.cache_v = (const float*)d_in[3]; a.cache_lf = (const float*)d_in[4];
    a.state_pool = (const float*)d_in[5]; a.page_table = (const int*)d_in[6]; a.norm_mix_g = (const float*)d_in[7]; a.w_in = (const float*)d_in[8]; a.b_forget = (const float*)d_in[9];
    a.q_norm_g = (const float*)d_in[10]; a.k_norm_g = (const float*)d_in[11]; a.pool_mix_w = (const float*)d_in[12]; a.pool_scale = (const float*)d_in[13]; a.w_bp = (const float*)d_in[14];
    a.w_ba = (const float*)d_in[15]; a.w_out = (const float*)d_in[16]; a.norm_ffn_g = (const float*)d_in[17]; a.w_query = (const float*)d_in[18]; a.sub_keys = (const float*)d_in[19];
    a.peer_u = (const float*)d_in[20]; a.peer_v = (const float*)d_in[21];
    a.out = (float*)d_out; a.ws = (unsigned char*)d_ws; a.pad = 0;
#if MK_PER_PHASE
#ifndef DBG_NPH
#define DBG_NPH N_PHASES
#endif
    for (int ph = 0; ph < DBG_NPH; ++ph) { a.ph_lo = ph; a.ph_hi = ph + 1; a.li = ph; hipLaunchKernelGGL(fwd_kernel, dim3(grid), dim3(NTHR), LDS_BYTES, stream, a); }
#ifdef DBG_DUMP
    a.ph_lo = 9; a.ph_hi = 10; a.li = 9; hipLaunchKernelGGL(fwd_kernel, dim3(grid), dim3(NTHR), LDS_BYTES, stream, a);
#endif
#else
    a.ph_lo = 0; a.ph_hi = N_PHASES; a.li = 0; hipLaunchKernelGGL(fwd_kernel, dim3(grid), dim3(NTHR), LDS_BYTES, stream, a);
#endif
}
```

```cpp
#include <hip/hip_runtime.h>
#include <cstdio>
#include <cstdint>
#include <cmath>
namespace pg8 {
#define PG8_LAS __attribute__((address_space(3)))
typedef unsigned short bf16_t;
typedef short bf16x8 __attribute__((ext_vector_type(8)));
typedef float f32x4 __attribute__((ext_vector_type(4)));
typedef unsigned u32x4 __attribute__((ext_vector_type(4)));
constexpr int BM = 256, BK = 64, HALF = 128, HTB = HALF * BK * 2  , STAGE_BYTES = 8 * HTB, NXCD = 8, WGM = 8;

__host__ __device__ __forceinline__ int lds_byte(int r, int c) { const int st = (r >> 4) * 2 + (c >> 5), rr = r & 15, cc = c & 31, ob = rr * 64 + cc * 2; return st * 1024 + (ob ^ (((ob >> 9) & 1) << 5)); }
__host__ __device__ __forceinline__ void stage_rc(int b, int& R, int& C) { const int st = b / 1024, sb = b % 1024, swz = sb ^ (((sb >> 9) & 1) << 5); R = (st >> 1) * 16 + swz / 64; C = (st & 1) * 32 + (swz % 64) / 2; }
__host__ __device__ __forceinline__ int perm32(int rho) { const int n = rho >> 4, i = rho & 15; return 8 * (i >> 2) + 4 * n + (i & 3); }

struct Unit { int pm, pn; };
struct Gemm { const bf16_t* A; const bf16_t* Bt; int M, N, K; };

struct StaticOrder {
    int nM, nN, nwg, G, c;
    __host__ __device__ void init(int M, int N, int G_, int c_) { nM = M / BM; nN = N / BM; nwg = nM * nN; G = G_; c = c_; }
    __host__ __device__ bool next(int i, Unit& u) const {
        const long L = (long)i * G + c; if (L >= nwg) return false;
        int wgid = (int)L; { const int q = nwg / NXCD, r = nwg % NXCD, xcd = wgid % NXCD, off = wgid / NXCD; wgid = (xcd < r ? xcd * (q + 1) : r * (q + 1) + (xcd - r) * q) + off; }
        const int nig = WGM * nN, gid = wgid / nig, fm = gid * WGM, gsz = (nM - fm) < WGM ? (nM - fm) : WGM;
        u.pm = fm + ((wgid % nig) % gsz); u.pn = (wgid % nig) / gsz; return true;
    }
    __device__ __forceinline__ void a_ready(const Unit&) const {}
    __device__ __forceinline__ void done(const Unit&) const {}
};

typedef float f32x2c __attribute__((ext_vector_type(2))); typedef __bf16 bf16x2c __attribute__((ext_vector_type(2)));
__device__ __forceinline__ unsigned cvt_pk_bf16(float lo, float hi) { f32x2c v = {lo, hi}; bf16x2c b = __builtin_convertvector(v, bf16x2c); return __builtin_bit_cast(unsigned, b); }
typedef float f32x2 __attribute__((ext_vector_type(2)));
__device__ __forceinline__ f32x2 gelu_pk(f32x2 v) {
    const f32x2 av = __builtin_elementwise_abs(v), d = av * 0.2316418882f + 1.0f;
    f32x2 t; t.x = __builtin_amdgcn_rcpf(d.x); t.y = __builtin_amdgcn_rcpf(d.y);
    f32x2 q = t * 0.5307027145f + (-0.7265760135f); q = q * t + 0.7107068705f; q = q * t + (-0.142248368f); q = q * t + 0.127414796f; q = q * t;
    const f32x2 s = (v * v) * (-0.72134752044f);
    f32x2 e; e.x = __builtin_amdgcn_exp2f(s.x); e.y = __builtin_amdgcn_exp2f(s.y);
    const f32x2 m = v * (q * e), r = v - m;
    f32x2 o; o.x = v.x < 0.f ? m.x : r.x; o.y = v.y < 0.f ? m.y : r.y; return o;
}

template <int ACT  > struct EpiBf16 {
    static constexpr bool PERM = true, AFTER_DRAIN = false; static_assert(ACT == 0 || ACT == 1, "EpiBf16: ACT is 0 (none) or 1 (gelu_pk)");
    bf16_t* O; int ldc; const float* bias; int split_cols; size_t split_stride; float scale0;
    __device__ __forceinline__ void operator()(const f32x4 (&acc)[2][2][4][2], const Unit& u, int wr, int wc, int fr, int fq) const {
        const int row0 = u.pm * BM + wr * 64 + fr; int colt = u.pn * BM; bf16_t* base = O;
        float sc = 1.f; if (split_cols) { const int t = colt / split_cols; base += (size_t)t * split_stride; colt -= t * split_cols; if (t == 0) sc = scale0; }
        const int col0 = colt + wc * 32 + 8 * fq, bcol0 = u.pn * BM + wc * 32 + 8 * fq;
        f32x4 bv[2][2];
#pragma unroll
        for (int bj = 0; bj < 2; ++bj)
#pragma unroll
            for (int n = 0; n < 2; ++n) bv[bj][n] = bias ? *(const f32x4*)(bias + bcol0 + bj * HALF + 4 * n) : (f32x4){0.f, 0.f, 0.f, 0.f};
#pragma unroll
        for (int ai = 0; ai < 2; ++ai)
#pragma unroll
            for (int m = 0; m < 4; ++m) { bf16_t* rowp = base + (size_t)(row0 + ai * HALF + m * 16) * ldc + col0;
#pragma unroll
                for (int bj = 0; bj < 2; ++bj) { f32x4 v0 = acc[ai][bj][m][0] + bv[bj][0], v1 = acc[ai][bj][m][1] + bv[bj][1];
                    if (ACT == 1) { f32x2 a = gelu_pk((f32x2){v0[0], v0[1]}), b = gelu_pk((f32x2){v0[2], v0[3]}), c = gelu_pk((f32x2){v1[0], v1[1]}), d = gelu_pk((f32x2){v1[2], v1[3]});
                        v0 = (f32x4){a.x, a.y, b.x, b.y}; v1 = (f32x4){c.x, c.y, d.x, d.y}; }
                    v0 = v0 * sc; v1 = v1 * sc; u32x4 w; w.x = cvt_pk_bf16(v0[0], v0[1]); w.y = cvt_pk_bf16(v0[2], v0[3]); w.z = cvt_pk_bf16(v1[0], v1[1]); w.w = cvt_pk_bf16(v1[2], v1[3]);
                    *(u32x4*)(rowp + bj * HALF) = w; } }
    }
};
template <class Epi, class Sched, bool ALIGN_EPI = false, bool SP2 = false>
__device__ __forceinline__ void gemm_phase(PG8_LAS unsigned char* lds, const Gemm g, const Sched& S, const Epi& E) {
    const int tid = threadIdx.x, wid = __builtin_amdgcn_readfirstlane(tid >> 6), lane = tid & 63, wr = wid >> 2, wc = wid & 3, fr = lane & 15, fq = lane >> 4;
    const int K = g.K, nt = K / BK;
    unsigned voffA[2], voffB[2];
#pragma unroll
    for (int i = 0; i < 2; ++i) { int R, C; stage_rc(tid * 16 + i * 8192, R, C); const int Rb = Epi::PERM ? ((R & ~31) + perm32(R & 31)) : R;
        voffA[i] = (unsigned)(R * K + C) * 2u; voffB[i] = (unsigned)(Rb * K + C) * 2u; }
    const size_t kstep = (size_t)(BK * 2);
    const size_t hstep = (size_t)HALF * K * 2;
    const size_t tstep = 2 * hstep;
    const unsigned ldsw = (unsigned)wid * 1024u;
    const int aoff = lds_byte(wr * 64 + fr, fq * 8), boff = lds_byte(wc * 32 + fr, fq * 8);
#define PG8_SA(b, h) (((b) * 2 + (h)) * HTB)
#define PG8_SB(b, h) ((4 + (b) * 2 + (h)) * HTB)
#define PG8_STAGE(bufoff, gbase, voff) do { _Pragma("unroll") for (int _i = 0; _i < 2; ++_i) \
        __builtin_amdgcn_global_load_lds((const unsigned*)((const char*)(gbase) + (voff)[_i]), (PG8_LAS unsigned*)(lds + (bufoff) + ldsw + _i * 8192), 16, 0, 0); } while (0)
#define PG8_LDA(dst, b, h) do { _Pragma("unroll") for (int m = 0; m < 4; ++m) _Pragma("unroll") for (int k = 0; k < 2; ++k) dst[m][k] = *(const PG8_LAS bf16x8*)(lds + PG8_SA(b, h) + aoff + m * 2048 + k * 1024); } while (0)
#define PG8_LDB(dst, b, h) do { _Pragma("unroll") for (int n = 0; n < 2; ++n) _Pragma("unroll") for (int k = 0; k < 2; ++k) dst[n][k] = *(const PG8_LAS bf16x8*)(lds + PG8_SB(b, h) + boff + n * 2048 + k * 1024); } while (0)
#define PG8_MMA(ai, bj, At, Bt) do { __builtin_amdgcn_s_setprio(1); _Pragma("unroll") for (int m = 0; m < 4; ++m) _Pragma("unroll") for (int n = 0; n < 2; ++n) _Pragma("unroll") for (int k = 0; k < 2; ++k) \
        acc[ai][bj][m][n] = __builtin_amdgcn_mfma_f32_16x16x32_bf16(Bt[n][k], At[m][k], acc[ai][bj][m][n], 0, 0, 0); __builtin_amdgcn_s_setprio(0); } while (0)
#define PG8_WAIT_V(n) asm volatile("s_waitcnt vmcnt(" #n ")" ::: "memory")
#define PG8_WAIT_L(n) asm volatile("s_waitcnt lgkmcnt(" #n ")" ::: "memory")
#define PG8_BAR __builtin_amdgcn_s_barrier()
#define PG8_SCHED __builtin_amdgcn_sched_barrier(0)
    Unit cur, nxt; int ui = 0;
    if (!S.next(0, cur)) return;
    f32x4 acc[2][2][4][2];
#pragma unroll
    for (int a = 0; a < 2; ++a)
#pragma unroll
        for (int b = 0; b < 2; ++b)
#pragma unroll
            for (int m = 0; m < 4; ++m)
#pragma unroll
                for (int n = 0; n < 2; ++n) acc[a][b][m][n] = (f32x4){0.f, 0.f, 0.f, 0.f};
    bf16x8 At[4][2], B0[2][2], B1[2][2];
    const char* cA = (const char*)g.A + (size_t)cur.pm * tstep; const char* cB = (const char*)g.Bt + (size_t)cur.pn * tstep;
    S.a_ready(cur);
    if constexpr (SP2) {
        PG8_STAGE(PG8_SB(0, 0), cB, voffB); PG8_STAGE(PG8_SB(0, 1), cB + hstep, voffB); PG8_STAGE(PG8_SA(0, 0), cA, voffA); PG8_STAGE(PG8_SA(0, 1), cA + hstep, voffA);
        if (wr == 1) PG8_BAR;
        PG8_WAIT_V(2); PG8_BAR;
        PG8_STAGE(PG8_SB(1, 0), cB + kstep, voffB); PG8_STAGE(PG8_SA(1, 0), cA + kstep, voffA); PG8_STAGE(PG8_SB(1, 1), cB + hstep + kstep, voffB);
        PG8_WAIT_V(6); PG8_BAR;
    } else {
        PG8_STAGE(PG8_SB(0, 0), cB, voffB); PG8_STAGE(PG8_SA(0, 0), cA, voffA); PG8_STAGE(PG8_SB(0, 1), cB + hstep, voffB); PG8_STAGE(PG8_SA(0, 1), cA + hstep, voffA);
        if (wr == 1) PG8_BAR;
        PG8_WAIT_V(4); PG8_BAR;
        PG8_STAGE(PG8_SB(1, 0), cB + kstep, voffB); PG8_STAGE(PG8_SA(1, 0), cA + kstep, voffA); PG8_STAGE(PG8_SB(1, 1), cB + hstep + kstep, voffB);
        PG8_WAIT_V(6); PG8_BAR;
    }
    for (;;) {
        const bool has_next = S.next(ui + 1, nxt);
        const char* nA = has_next ? (const char*)g.A + (size_t)nxt.pm * tstep : cA; const char* nB = has_next ? (const char*)g.Bt + (size_t)nxt.pn * tstep : cB;
        for (int t = 0; t < nt; t += 2) {
            const bool last = (t == nt - 2);
            const char* a1 = cA + (size_t)(t + 1) * kstep;
            const char* a2 = last ? nA : cA + (size_t)(t + 2) * kstep; const char* b2 = last ? nB : cB + (size_t)(t + 2) * kstep;
            const char* a3 = a2 + kstep; const char* b3 = b2 + kstep;
            if (last && has_next) S.a_ready(nxt);
            if constexpr (SP2) {
            PG8_LDB(B0, 0, 0); PG8_LDB(B1, 0, 1); PG8_SCHED; PG8_LDA(At, 0, 0); PG8_STAGE(PG8_SA(1, 1), a1 + hstep, voffA);
            PG8_WAIT_V(8); PG8_WAIT_L(0); PG8_BAR; PG8_MMA(0, 0, At, B0); PG8_MMA(0, 1, At, B1); PG8_BAR; PG8_SCHED;
            PG8_LDA(At, 0, 1); PG8_STAGE(PG8_SB(0, 0), b2, voffB); PG8_STAGE(PG8_SB(0, 1), b2 + hstep, voffB); PG8_STAGE(PG8_SA(0, 0), a2, voffA);
            PG8_WAIT_V(8); PG8_WAIT_L(0); PG8_BAR; PG8_MMA(1, 0, At, B0); PG8_MMA(1, 1, At, B1); PG8_BAR; PG8_SCHED;
            PG8_LDB(B0, 1, 0); PG8_LDB(B1, 1, 1); PG8_SCHED; PG8_LDA(At, 1, 0); PG8_STAGE(PG8_SA(0, 1), a2 + hstep, voffA);
            PG8_WAIT_V(8); PG8_WAIT_L(0); PG8_BAR; PG8_MMA(0, 0, At, B0); PG8_MMA(0, 1, At, B1); PG8_BAR; PG8_SCHED;
            PG8_LDA(At, 1, 1); PG8_STAGE(PG8_SB(1, 0), b3, voffB); PG8_STAGE(PG8_SB(1, 1), b3 + hstep, voffB); PG8_STAGE(PG8_SA(1, 0), a3, voffA);
            PG8_WAIT_V(8); PG8_WAIT_L(0); PG8_BAR; PG8_MMA(1, 0, At, B0); PG8_MMA(1, 1, At, B1); PG8_BAR; PG8_SCHED;
            } else {
            PG8_LDB(B0, 0, 0); PG8_SCHED; PG8_LDA(At, 0, 0); PG8_STAGE(PG8_SA(1, 1), a1 + hstep, voffA);
            PG8_WAIT_L(8); PG8_BAR; PG8_WAIT_L(0); PG8_MMA(0, 0, At, B0); PG8_BAR; PG8_SCHED;
            PG8_LDB(B1, 0, 1); PG8_STAGE(PG8_SB(0, 0), b2, voffB);
            PG8_BAR; PG8_WAIT_L(0); PG8_MMA(0, 1, At, B1); PG8_BAR;
            PG8_LDA(At, 0, 1); PG8_STAGE(PG8_SA(0, 0), a2, voffA);
            PG8_BAR; PG8_WAIT_L(0); PG8_MMA(1, 0, At, B0); PG8_BAR; PG8_SCHED;
            PG8_STAGE(PG8_SB(0, 1), b2 + hstep, voffB);
            PG8_WAIT_V(6); PG8_BAR; PG8_MMA(1, 1, At, B1); PG8_BAR;
            PG8_LDB(B0, 1, 0); PG8_SCHED; PG8_LDA(At, 1, 0); PG8_STAGE(PG8_SA(0, 1), a2 + hstep, voffA);
            PG8_WAIT_L(8); PG8_BAR; PG8_WAIT_L(0); PG8_MMA(0, 0, At, B0); PG8_BAR; PG8_SCHED;
            PG8_LDB(B1, 1, 1); PG8_STAGE(PG8_SB(1, 0), b3, voffB);
            PG8_BAR; PG8_WAIT_L(0); PG8_MMA(0, 1, At, B1); PG8_BAR;
            PG8_LDA(At, 1, 1); PG8_STAGE(PG8_SA(1, 0), a3, voffA);
            PG8_BAR; PG8_WAIT_L(0); PG8_MMA(1, 0, At, B0); PG8_BAR; PG8_SCHED;
            PG8_STAGE(PG8_SB(1, 1), b3 + hstep, voffB);
            PG8_WAIT_V(6); PG8_BAR; PG8_MMA(1, 1, At, B1); PG8_BAR;
            }
        }
        if constexpr (ALIGN_EPI) { if (wr == 0) PG8_BAR; }
        if constexpr (!Epi::AFTER_DRAIN) { E(acc, cur, wr, wc, fr, fq); S.done(cur); }
        if (!has_next) break;
#pragma unroll
        for (int a = 0; a < 2; ++a)
#pragma unroll
            for (int b = 0; b < 2; ++b)
#pragma unroll
                for (int m = 0; m < 4; ++m)
#pragma unroll
                    for (int n = 0; n < 2; ++n) acc[a][b][m][n] = (f32x4){0.f, 0.f, 0.f, 0.f};
        cur = nxt; cA = nA; cB = nB; ++ui;
        if constexpr (ALIGN_EPI) { if (wr == 1) PG8_BAR; }
    }
    PG8_WAIT_V(0);
    if constexpr (!ALIGN_EPI) { if (wr == 0) PG8_BAR; }
    PG8_BAR;
    if constexpr (Epi::AFTER_DRAIN) { E.fused(acc, cur, wr, wc, fr, fq, lds, wid, lane); S.done(cur); }
#undef PG8_SA
#undef PG8_SB
#undef PG8_STAGE
#undef PG8_LDA
#undef PG8_LDB
#undef PG8_MMA
#undef PG8_WAIT_V
#undef PG8_WAIT_L
#undef PG8_BAR
#undef PG8_SCHED
}
}
#define GAS __attribute__((address_space(1)))
#define LAS __attribute__((address_space(3)))
typedef unsigned short bf16;
typedef unsigned v4u __attribute__((ext_vector_type(4)));
typedef float f32x4 __attribute__((ext_vector_type(4)));
typedef short bf16x8 __attribute__((ext_vector_type(8)));
typedef GAS unsigned gu32;
typedef GAS unsigned long long gu64;
#define RLX_AGENT __ATOMIC_RELAXED, __HIP_MEMORY_SCOPE_AGENT
#define LDS_WAIT() asm volatile("s_waitcnt lgkmcnt(0)" ::: "memory")
#define VM_WAIT() asm volatile("s_waitcnt vmcnt(0)" ::: "memory")
__device__ __forceinline__ unsigned long long rt() { return __builtin_amdgcn_s_memrealtime(); }
__device__ __forceinline__ unsigned f2bf(float f) { unsigned u = __builtin_bit_cast(unsigned, f); return (u + 0x7fffu + ((u >> 16) & 1u)) >> 16; }
__device__ __forceinline__ unsigned pk2(float lo, float hi) { return f2bf(lo) | (f2bf(hi) << 16); }

#define XB_TMO      128
#define XB_XCNT(j)  (256  + 64 * (j))
#define XB_XSUB(j)  (1280 + 64 * (j))
#define XB_XGEN(j)  (2304 + 64 * (j))
#define XB_TOP      3328
#define XB_TOPGEN   3392
#define XCD_BAR_WORDS 3456
#define XB_SPIN_CAP (1u << 18)

__device__ __forceinline__ unsigned xb_ld(unsigned* p)              { return __hip_atomic_load(p, __ATOMIC_RELAXED, __HIP_MEMORY_SCOPE_AGENT); }
__device__ __forceinline__ unsigned xb_add(unsigned* p, unsigned v) { return __hip_atomic_fetch_add(p, v, __ATOMIC_RELAXED, __HIP_MEMORY_SCOPE_AGENT); }
__device__ __forceinline__ unsigned xb_xcc_id() { return (unsigned)__builtin_amdgcn_s_getreg((3 << 11) | 20) & 0xFu; }
#define XB_SPIN(cond, bar) do { unsigned _sp = 0; while (cond) { __builtin_amdgcn_s_sleep(1); \
    if ((++_sp & 255u) == 0u) { if (xb_ld(&(bar)[XB_TMO])) break; if (_sp > XB_SPIN_CAP) { atomicAdd(&(bar)[XB_TMO], 1u); break; } } } } while (0)

struct XcdBarrier {
    unsigned* bar; unsigned x;
    volatile LAS unsigned* st;
};

__device__ __forceinline__ XcdBarrier xcd_barrier_post(unsigned* bar, volatile LAS unsigned* st) {
    XcdBarrier b; b.bar = bar; b.x = xb_xcc_id(); b.st = st;
    if (threadIdx.x == 0) (void)xb_add(&bar[XB_XCNT(b.x)], 1u);
    return b;
}
__device__ __forceinline__ void xcd_barrier_complete(unsigned* bar, unsigned x, unsigned& nloc, unsigned& nx) {
    const unsigned G = gridDim.x * gridDim.y * gridDim.z;
    unsigned sum, cnt, mine, sp = 0u;
    for (;;) {
        sum = 0u; cnt = 0u; mine = 0u;
#pragma unroll
        for (unsigned j = 0; j < 16; ++j) { const unsigned c = xb_ld(&bar[XB_XCNT(j)]); sum += c; cnt += (c > 0u) ? 1u : 0u; mine = (j == x) ? c : mine; }
        if (sum == G) break;
        __builtin_amdgcn_s_sleep(1);
        if ((++sp & 255u) == 0u) { if (xb_ld(&bar[XB_TMO])) break; if (sp > XB_SPIN_CAP) { atomicAdd(&bar[XB_TMO], 1u); break; } }
    }
    nloc = mine > 0u ? mine : 1u; nx = cnt > 0u ? cnt : 1u;
}

__device__ __forceinline__ void xcd_barrier(const XcdBarrier& b) {
    asm volatile("s_waitcnt vmcnt(0)" ::: "memory");
    __syncthreads();
    if (threadIdx.x == 0) {
        unsigned* bar = b.bar;
        __builtin_amdgcn_s_waitcnt(0);
        unsigned nloc = b.st[0], nx = b.st[1];
        if (nloc == 0u) { xcd_barrier_complete(bar, b.x, nloc, nx); b.st[0] = nloc; b.st[1] = nx; }
        const unsigned old = xb_add(&bar[XB_XSUB(b.x)], 1u);
        const unsigned gen = old / nloc;
        if (old + 1u == (gen + 1u) * nloc) {
            __builtin_amdgcn_fence(__ATOMIC_RELEASE, "agent");
            asm volatile("s_waitcnt vmcnt(0)" ::: "memory");
            const unsigned og = xb_add(&bar[XB_TOP], 1u);
            const unsigned tg = og / nx;
            if (og + 1u == (tg + 1u) * nx) xb_add(&bar[XB_TOPGEN], 1u);
            else XB_SPIN(xb_ld(&bar[XB_TOPGEN]) == tg, bar);
            __builtin_amdgcn_fence(__ATOMIC_ACQUIRE, "agent");
            xb_add(&bar[XB_XGEN(b.x)], 1u);
            asm volatile("s_waitcnt vmcnt(0)" ::: "memory");
        } else {
            XB_SPIN(xb_ld(&bar[XB_XGEN(b.x)]) == gen, bar);
            __builtin_amdgcn_fence(__ATOMIC_ACQUIRE, "agent");
            asm volatile("s_waitcnt vmcnt(0)" ::: "memory");
        }
    }
    __syncthreads();
}
#include <hip/hip_bf16.h>
#include <cmath>
namespace attn_body {
using bf16=__hip_bfloat16;
using bf16x8=__attribute__((ext_vector_type(8)))short;
using s16x4=__attribute__((ext_vector_type(4)))short;
using f32x16=__attribute__((ext_vector_type(16)))float;
using u32x4=__attribute__((ext_vector_type(4)))unsigned;
constexpr int BATCH=4,NHEAD=8,SEQ=4096,D=64,DM=NHEAD*D;
constexpr int NW=8,QBLK=32,QB=QBLK*NW,KVBLK=64,NQB=SEQ/QB;
constexpr int ATTN_PITCH=DM, ATTN_UNIT_ROWS=QB;
__device__ __forceinline__ int crow(int r,int hi){return (r&3)+8*(r>>2)+4*hi;}
#define SBAR() __builtin_amdgcn_sched_barrier(0)
__device__ __forceinline__ void cmask(f32x16&p0,f32x16&p1,int jb,int qrel,int hi){
  const float NEG=-INFINITY; int kb=64*jb+4*hi;
  #pragma unroll
  for(int r=0;r<16;++r){int kv=kb+(r&3)+8*(r>>2); if(kv>qrel)p0[r]=NEG; if(kv+32>qrel)p1[r]=NEG;}
}

constexpr int NSLOT=3, SLOTB=8192;
constexpr int LDS_K=0, LDS_V=NSLOT*SLOTB, LDS_WS=2*NSLOT*SLOTB, LDS_OST=LDS_WS+NW*64*4, LDS_CK=LDS_OST+NW*4096, LDS_BYTES=LDS_CK+SEQ*4;
constexpr float C2=0.125f*1.4426950408889634f;
__device__ __forceinline__ void glds16(const void*gsrc,unsigned lds_dst){unsigned keep;
  asm volatile("s_mov_b32 %0, m0\n\ts_mov_b32 m0, %2\n\ts_nop 0\n\tglobal_load_lds_dwordx4 %1, off\n\ts_mov_b32 m0, %0":"=&s"(keep):"v"(gsrc),"s"(lds_dst):"memory");}
__device__ __forceinline__ float max3f(float a,float b,float c){float r;asm("v_max3_f32 %0, %1, %2, %3":"=v"(r):"v"(a),"v"(b),"v"(c));return r;}
__device__ __forceinline__ float max2f(float a,float b){float r;asm("v_max_f32_e32 %0, %1, %2":"=v"(r):"v"(a),"v"(b));return r;}
__device__ __forceinline__ float fadd_s(float a,float b){float r;asm("v_add_f32_e32 %0, %1, %2":"=v"(r):"v"(a),"v"(b));return r;}
__device__ __forceinline__ float fsub_s(float a,float b){float r;asm("v_sub_f32_e32 %0, %1, %2":"=v"(r):"v"(a),"v"(b));return r;}
typedef float f32x2_t __attribute__((ext_vector_type(2))); typedef __bf16 bf16x2_t __attribute__((ext_vector_type(2)));
__device__ __forceinline__ unsigned cvtpk_s(float lo,float hi){f32x2_t v={lo,hi};bf16x2_t b=__builtin_convertvector(v,bf16x2_t);return __builtin_bit_cast(unsigned,b);}
#define WAIT_BAR(N) asm volatile("s_waitcnt vmcnt(" #N ") lgkmcnt(0)\n\ts_barrier":::"memory")

__device__ __forceinline__ void qkt(f32x16&p0,f32x16&p1,const char*Kslot,const bf16x8*qr,int r32,int hi){
  const char*kb=Kslot+hi*1024+r32*16;
  #pragma unroll
  for(int d0=0;d0<4;++d0){
    const bf16x8 b0=*reinterpret_cast<const bf16x8*>(kb+d0*2048);
    const bf16x8 b1=*reinterpret_cast<const bf16x8*>(kb+d0*2048+512);
    p0=__builtin_amdgcn_mfma_f32_32x32x16_bf16(b0,qr[d0],p0,0,0,0);p1=__builtin_amdgcn_mfma_f32_32x32x16_bf16(b1,qr[d0],p1,0,0,0);}
}
typedef __attribute__((address_space(3))) const char* lds_cptr;
typedef short v4i16_t __attribute__((ext_vector_type(4)));
__device__ __forceinline__ void kload8(bf16x8*kf,lds_cptr kp){
  kf[0]=*(const __attribute__((address_space(3))) bf16x8*)(kp);      kf[1]=*(const __attribute__((address_space(3))) bf16x8*)(kp+512);
  kf[2]=*(const __attribute__((address_space(3))) bf16x8*)(kp+2048); kf[3]=*(const __attribute__((address_space(3))) bf16x8*)(kp+2560);
  kf[4]=*(const __attribute__((address_space(3))) bf16x8*)(kp+4096); kf[5]=*(const __attribute__((address_space(3))) bf16x8*)(kp+4608);
  kf[6]=*(const __attribute__((address_space(3))) bf16x8*)(kp+6144); kf[7]=*(const __attribute__((address_space(3))) bf16x8*)(kp+6656);
}
__device__ __forceinline__ void kload2(bf16x8*kf,lds_cptr kp,int j){ kf[2*j]=*(const __attribute__((address_space(3))) bf16x8*)(kp+j*2048); kf[2*j+1]=*(const __attribute__((address_space(3))) bf16x8*)(kp+j*2048+512); }
__device__ __forceinline__ s16x4 vtr(lds_cptr p){ return __builtin_bit_cast(s16x4,__builtin_amdgcn_ds_read_tr16_b64_v4i16((__attribute__((address_space(3))) v4i16_t*)p)); }
__device__ __forceinline__ float rowmax(const f32x16&p0,const f32x16&p1){
  float a=max3f(p0[0],p0[1],p1[0]),b=max3f(p0[2],p0[3],p1[1]);a=max3f(a,p1[2],p1[3]);
  #pragma unroll
  for(int r=4;r<16;r+=4){a=max3f(a,p0[r],p0[r+1]);b=max3f(b,p0[r+2],p0[r+3]);a=max3f(a,p1[r],p1[r+1]);b=max3f(b,p1[r+2],p1[r+3]);}
  const float m=max2f(a,b);
  auto rr=__builtin_amdgcn_permlane32_swap(__float_as_uint(m),__float_as_uint(m),false,false);
  return max2f(__uint_as_float(rr[0]),__uint_as_float(rr[1]));
}
__device__ __forceinline__ void pv(f32x16*o,int vb,bf16x8 pa0,bf16x8 pa1,bf16x8 pa2,bf16x8 pa3){
  #pragma unroll
  for(int d0=0;d0<2;++d0){s16x4 lo[4],hi[4];
    #pragma unroll
    for(int ks=0;ks<4;++ks){
      asm volatile("ds_read_b64_tr_b16 %0,%1 offset:%c2":"=&v"(lo[ks]):"v"(vb),"i"(d0*4096+ks*1024):"memory");
      asm volatile("ds_read_b64_tr_b16 %0,%1 offset:%c2":"=&v"(hi[ks]):"v"(vb),"i"(d0*4096+ks*1024+512):"memory");}
    asm volatile("s_waitcnt lgkmcnt(0)":::"memory");SBAR();
    #define PK(k) (bf16x8){lo[k][0],lo[k][1],lo[k][2],lo[k][3],hi[k][0],hi[k][1],hi[k][2],hi[k][3]}
    o[d0]=__builtin_amdgcn_mfma_f32_32x32x16_bf16(pa0,PK(0),o[d0],0,0,0);
    o[d0]=__builtin_amdgcn_mfma_f32_32x32x16_bf16(pa1,PK(1),o[d0],0,0,0);
    o[d0]=__builtin_amdgcn_mfma_f32_32x32x16_bf16(pa2,PK(2),o[d0],0,0,0);
    o[d0]=__builtin_amdgcn_mfma_f32_32x32x16_bf16(pa3,PK(3),o[d0],0,0,0);
    #undef PK
  }
}

#ifndef ATTN_STORE16
#define ATTN_STORE16(p,v) (*(u32x4*)(p)=(v))
#endif
template<int THRL> __device__ __forceinline__ void attn_unit(int b,int h,int qb,const bf16*Q,const bf16*__restrict__ K,const bf16*__restrict__ V,bf16*O,const float*__restrict__ c2,float M2,char*shm){
  const int tid=threadIdx.x,lane=tid&63,r32=lane&31,hi=lane>>5; const int wid=__builtin_amdgcn_readfirstlane(tid>>6);
  const long rowbase=(long)b*SEQ; const int q0=qb*QB;
  const bf16*Qw=Q+(rowbase+q0+wid*QBLK)*DM+h*D;
  const bf16*Kh0=K+rowbase*DM+h*D,*Vh0=V+rowbase*DM+h*D;
  const unsigned lds0=(unsigned)(uintptr_t)shm;
  float*wsf=(float*)(shm+LDS_WS)+wid*64;
  const unsigned kdst=lds0+LDS_K+wid*1024, vdst=lds0+LDS_V+wid*1024;
  #define DMA_K(t,slot) glds16(ksrc+(long)(t)*KVBLK*DM,(unsigned)__builtin_amdgcn_readfirstlane(kdst+(slot)))
  #define DMA_V(t,slot) glds16(vsrc+(long)(t)*KVBLK*DM,(unsigned)__builtin_amdgcn_readfirstlane(vdst+(slot)))
  const int vb0=(int)(lds0+LDS_V)+((lane>>4)&1)*32+(lane&3)*8+(4*hi+((lane&15)>>2))*64;
  const char*Kbase=shm+LDS_K; bf16x8 kf[8];
  const lds_cptr shm3=(lds_cptr)shm; const lds_cptr kp0=shm3+LDS_K+hi*1024+r32*16; const lds_cptr vp0=shm3+LDS_V+((lane>>4)&1)*32+(lane&3)*8+(4*hi+((lane&15)>>2))*64;
  const int NT0=(q0+QB)/KVBLK;
  int ts; { const int tl=lane; const float cqa=c2[q0]; const float ckb=(tl<NT0-4)?c2[64*tl+63]:cqa; const unsigned long long bm=__ballot((tl<NT0-4)&&(cqa-ckb< -(40.f+2.f*M2))); ts=__builtin_popcountll(bm)&~1; }
  ts=__builtin_amdgcn_readfirstlane(ts);
  const int NT=NT0-ts;
  const bf16*Kh=Kh0+(long)ts*KVBLK*DM,*Vh=Vh0+(long)ts*KVBLK*DM;
  const bf16*ksrc=Kh+(long)lane*DM+wid*8;
  const bf16*vsrc=Vh+(long)(16*(wid&3)+(lane>>2))*DM+(wid>>2)*32+(lane&3)*8;
  typedef float f32x4_t __attribute__((ext_vector_type(4)));
  const int nck4=(q0+QB)/4; f32x4_t ckv0=f32x4_t{},ckv1=f32x4_t{}; if(tid<nck4)ckv0=((const f32x4_t*)c2)[tid]; if(tid+512<nck4)ckv1=((const f32x4_t*)c2)[tid+512];
  const float cq=c2[q0+wid*QBLK+r32]-M2;
  DMA_K(0,0);DMA_V(0,0);DMA_K(1,SLOTB);
  bf16x8 qr[4];
  #pragma unroll
  for(int d0=0;d0<4;++d0)qr[d0]=*reinterpret_cast<const bf16x8*>(&Qw[(long)r32*DM+d0*16+hi*8]);
  float l_reg=0.f;f32x16 o[2];o[0]=f32x16{};o[1]=f32x16{};
  { __attribute__((address_space(3))) f32x4_t*ckl=(__attribute__((address_space(3))) f32x4_t*)((lds_cptr)shm+LDS_CK); if(tid<nck4)ckl[tid]=ckv0; if(tid+512<nck4)ckl[tid+512]=ckv1; }
  const __attribute__((address_space(3))) f32x4_t*ckp=(const __attribute__((address_space(3))) f32x4_t*)((lds_cptr)shm+LDS_CK)+hi+ts*16;
  #define CKLD(P0,P1,t) do{ _Pragma("unroll") for(int g_=0;g_<4;++g_){ const f32x4_t a_=ckp[(t)*16+2*g_], b_=ckp[(t)*16+8+2*g_]; P0[4*g_]=a_[0];P0[4*g_+1]=a_[1];P0[4*g_+2]=a_[2];P0[4*g_+3]=a_[3]; P1[4*g_]=b_[0];P1[4*g_+1]=b_[1];P1[4*g_+2]=b_[2];P1[4*g_+3]=b_[3]; } }while(0)
  #define CKSUB(P0,P1) do{ _Pragma("unroll") for(int r=0;r<16;++r){P0[r]=cq-P0[r];P1[r]=cq-P1[r];} }while(0)
  const int qrel=wid*QBLK+r32;
  #define CMASK(P0,P1,t) do{int jb_=(t)-(NT-4); if(jb_>=0)cmask(P0,P1,jb_,qrel,hi);}while(0)
  #define START(P0,P1) do{ _Pragma("unroll") for(int r=0;r<16;++r)P0[r]=__builtin_amdgcn_exp2f(P0[r]); }while(0)
  #define RESC() do{}while(0)
  f32x16 pA0,pA1,pB0,pB1;
  int sl_prev=0,sl_cur=0,sl_next=SLOTB;
  #define ROT() do{sl_prev=sl_cur;sl_cur=sl_next;sl_next=(sl_next==(NSLOT-1)*SLOTB)?0:sl_next+SLOTB;}while(0)
  DMA_K(2,2*SLOTB);
  WAIT_BAR(3);
  CKLD(pA0,pA1,0);CKSUB(pA0,pA1);
  qkt(pA0,pA1,Kbase,qr,r32,hi);asm volatile("s_nop 15\n\ts_nop 7":"+v"(pA0),"+v"(pA1));CMASK(pA0,pA1,0);
  CKLD(pB0,pB1,1);CKSUB(pB0,pB1);
  START(pA0,pA1);
  _Pragma("unroll") for(int r=0;r<16;++r)pA1[r]=__builtin_amdgcn_exp2f(pA1[r]);
  WAIT_BAR(0);
  DMA_K(3,0);DMA_V(1,SLOTB);
  ROT();
  kload8(kf,kp0+sl_cur);
  WAIT_BAR(2);
  s16x4 vlo[8],vhi[8]; u32x4 pw0,pw1,pw2,pw3;
  #define PKW(P,B) cvtpk_s(P[B],P[B+1])
  #define PAF(k) __builtin_bit_cast(bf16x8,pw##k)
  #define VFR(i) (bf16x8){vlo[i][0],vlo[i][1],vlo[i][2],vlo[i][3],vhi[i][0],vhi[i][1],vhi[i][2],vhi[i][3]}
  #define PIN(x) asm volatile("":"+v"(x))
  #define MX3(a,b,c) __builtin_fmaxf(__builtin_fmaxf((a),(b)),(c))
  #define GAPA(MF,A0,A1,A2,A3,W0,W1,PW) do{ MF; sacc+=A0; sacc+=A1; sacc+=A2; sacc+=A3; PIN(sacc); W0; W1; PIN(PW); SBAR(); }while(0)
  #define EX(v) __builtin_amdgcn_exp2f(v)
  #define GAPB(MF,X,B) do{ MF; X[B]=EX(X[B]); X[B+1]=EX(X[B+1]); X[B+2]=EX(X[B+2]); X[B+3]=EX(X[B+3]); PIN(X); SBAR(); }while(0)
  #define VRD(i) do{ vlo[i]=vtr(vp_+(((i)>>2)*4096+((i)&3)*1024)); vhi[i]=vtr(vp_+(((i)>>2)*4096+((i)&3)*1024+512)); }while(0)
  #define KRD(G,j) do{ if(G){ kload2(kf,kp0+sl_next,j); SBAR(); } }while(0)
  #define STEP(C0,C1,P0,P1,t,GK,GV,GL) do{ SBAR(); \
    const lds_cptr vp_=vp0+sl_prev; \
    VRD(0); SBAR(); float sacc=(P0[0]+P0[1]); \
    GAPA(C0=__builtin_amdgcn_mfma_f32_32x32x16_bf16(kf[0],qr[0],C0,0,0,0), P0[2],P0[3],P0[4],P0[5],     pw0[0]=PKW(P0,0), pw0[1]=PKW(P0,2), pw0); \
    VRD(4); SBAR(); GAPA(C1=__builtin_amdgcn_mfma_f32_32x32x16_bf16(kf[1],qr[0],C1,0,0,0), P0[6],P0[7],P0[8],P0[9],     pw0[2]=PKW(P0,4), pw0[3]=PKW(P0,6), pw0); \
    VRD(1); SBAR(); GAPA(C0=__builtin_amdgcn_mfma_f32_32x32x16_bf16(kf[2],qr[1],C0,0,0,0),   P0[10],P0[11],P0[12],P0[13], pw1[0]=PKW(P0,8), pw1[1]=PKW(P0,10), pw1); \
    VRD(5); SBAR(); GAPA(C1=__builtin_amdgcn_mfma_f32_32x32x16_bf16(kf[3],qr[1],C1,0,0,0),   P0[14],P0[15],P1[0],P1[1],   pw1[2]=PKW(P0,12),pw1[3]=PKW(P0,14), pw1); \
    VRD(2); SBAR(); GAPA(C0=__builtin_amdgcn_mfma_f32_32x32x16_bf16(kf[4],qr[2],C0,0,0,0),   P1[2],P1[3],P1[4],P1[5],     pw2[0]=PKW(P1,0), pw2[1]=PKW(P1,2), pw2); \
    VRD(6); SBAR(); GAPA(C1=__builtin_amdgcn_mfma_f32_32x32x16_bf16(kf[5],qr[2],C1,0,0,0),   P1[6],P1[7],P1[8],P1[9],     pw2[2]=PKW(P1,4), pw2[3]=PKW(P1,6), pw2); \
    VRD(3); SBAR(); GAPA(C0=__builtin_amdgcn_mfma_f32_32x32x16_bf16(kf[6],qr[3],C0,0,0,0),   P1[10],P1[11],P1[12],P1[13], pw3[0]=PKW(P1,8), pw3[1]=PKW(P1,10), pw3); \
    VRD(7); SBAR(); GAPA(C1=__builtin_amdgcn_mfma_f32_32x32x16_bf16(kf[7],qr[3],C1,0,0,0),   P1[14],P1[15],0.f,0.f,       pw3[2]=PKW(P1,12),pw3[3]=PKW(P1,14), pw3); \
    l_reg+=sacc; \
    if(GK){DMA_K((t)+3,sl_cur);} if(GV){DMA_V((t)+1,sl_next);} \
    CMASK(C0,C1,t); \
    SBAR(); \
    GAPB(o[0]=__builtin_amdgcn_mfma_f32_32x32x16_bf16(PAF(0),VFR(0),o[0],0,0,0), C0,0); \
    GAPB(o[1]=__builtin_amdgcn_mfma_f32_32x32x16_bf16(PAF(0),VFR(4),o[1],0,0,0), C0,4); \
    KRD(GL,0); GAPB(o[0]=__builtin_amdgcn_mfma_f32_32x32x16_bf16(PAF(1),VFR(1),o[0],0,0,0), C0,8); \
    KRD(GL,1); GAPB(o[1]=__builtin_amdgcn_mfma_f32_32x32x16_bf16(PAF(1),VFR(5),o[1],0,0,0), C0,12); \
    KRD(GL,2); GAPB(o[0]=__builtin_amdgcn_mfma_f32_32x32x16_bf16(PAF(2),VFR(2),o[0],0,0,0), C1,0); \
    KRD(GL,3); GAPB(o[1]=__builtin_amdgcn_mfma_f32_32x32x16_bf16(PAF(2),VFR(6),o[1],0,0,0), C1,4); \
    GAPB(o[0]=__builtin_amdgcn_mfma_f32_32x32x16_bf16(PAF(3),VFR(3),o[0],0,0,0), C1,8); \
    GAPB(o[1]=__builtin_amdgcn_mfma_f32_32x32x16_bf16(PAF(3),VFR(7),o[1],0,0,0), C1,12); \
    if(GL){ CKLD(P0,P1,(t)+1); CKSUB(P0,P1); } \
    }while(0)
  int t=1;
  #undef CMASK
  #define CMASK(P0,P1,t) do{}while(0)
  for(;t+5<NT;t+=2){
    STEP(pB0,pB1,pA0,pA1,t,true,true,true);     WAIT_BAR(2); RESC(); ROT();
    STEP(pA0,pA1,pB0,pB1,t+1,true,true,true);   WAIT_BAR(2); RESC(); ROT();
  }
  #undef CMASK
  #define CMASK(P0,P1,t) do{int jb_=(t)-(NT-4); if(jb_>=0)cmask(P0,P1,jb_,qrel,hi);}while(0)
  #define ENDW(tt) do{ if((tt)+3<NT){WAIT_BAR(2);} else if((tt)+2<NT){WAIT_BAR(1);} else {WAIT_BAR(0);} }while(0)
  for(;t+1<NT;t+=2){
    STEP(pB0,pB1,pA0,pA1,t,(t+3<NT),(t+1<NT),(t+1<NT));       ENDW(t);   RESC(); ROT();
    STEP(pA0,pA1,pB0,pB1,t+1,(t+4<NT),(t+2<NT),(t+2<NT));     ENDW(t+1); RESC(); ROT();
  }
  STEP(pB0,pB1,pA0,pA1,NT-1,false,false,false); RESC();
  { float sacc=pB0[0]+pB0[1]; _Pragma("unroll") for(int r=2;r<16;++r)sacc+=pB0[r]; _Pragma("unroll") for(int r=0;r<16;++r)sacc+=pB1[r]; l_reg+=sacc;
    pw0=(u32x4){PKW(pB0,0),PKW(pB0,2),PKW(pB0,4),PKW(pB0,6)};pw1=(u32x4){PKW(pB0,8),PKW(pB0,10),PKW(pB0,12),PKW(pB0,14)};pw2=(u32x4){PKW(pB1,0),PKW(pB1,2),PKW(pB1,4),PKW(pB1,6)};pw3=(u32x4){PKW(pB1,8),PKW(pB1,10),PKW(pB1,12),PKW(pB1,14)};
    SBAR(); pv(o,vb0+sl_cur,PAF(0),PAF(1),PAF(2),PAF(3)); }
  #undef PKW
  #undef PAF
  #undef VFR
  #undef PIN
  #undef MX3
  #undef GAPA
  #undef GAPB
  #undef EX
  #undef VRD
  #undef KRD
  #undef STEP
  #undef ENDW
  {auto rr=__builtin_amdgcn_permlane32_swap(__float_as_uint(l_reg),__float_as_uint(l_reg),false,false);l_reg=__uint_as_float(rr[0])+__uint_as_float(rr[1]);}
  if(hi==0)wsf[32+r32]=l_reg;asm volatile("s_waitcnt lgkmcnt(0)":::"memory");
  float rli[16];
  #pragma unroll
  for(int r=0;r<16;++r)rli[r]=__builtin_amdgcn_rcpf(wsf[32+crow(r,hi)]);
  bf16*Ow=O+(rowbase+q0+wid*QBLK)*DM+h*D;
  { bf16*stg=(bf16*)(shm+LDS_OST)+wid*2048;
    #pragma unroll
    for(int r=0;r<16;++r){const int orow=crow(r,hi);
      #pragma unroll
      for(int d0=0;d0<2;++d0)stg[orow*64+d0*32+r32]=__float2bfloat16(o[d0][r]*rli[r]);}
    asm volatile("s_waitcnt lgkmcnt(0)":::"memory");
    #pragma unroll
    for(int i=0;i<4;++i){const int row=i*8+(lane>>3),ch=lane&7; const u32x4 v=*(const u32x4*)(stg+row*64+ch*8); ATTN_STORE16(Ow+(long)row*DM+ch*8,v);} }
  asm volatile("s_waitcnt lgkmcnt(0)\n\ts_barrier":::"memory");
  #undef DMA_K
  #undef DMA_V
  #undef CMASK
  #undef START
  #undef RESC
  #undef ROT
  #undef CKLD
  #undef CKSUB
}
constexpr int ATTN_LDS_BYTES=LDS_BYTES;
struct AttnTensors { const bf16* Q; const bf16* K; const bf16* V; bf16* O; const float* C2T; float M2; };
struct AttnUnit { int bh; int qb; };
struct StaticOrder {
  int vcu, G;
  __device__ __forceinline__ explicit StaticOrder(int grid,int v):vcu(v),G(grid){}
  __device__ __forceinline__ bool next(int i,AttnUnit&u)const{ const int L=i*G+vcu; if(L>=BATCH*NHEAD*NQB)return false; const int r=L>>8, idx=L&255, k=idx&7; u.bh=idx>>3; u.qb=(r==0)?(NQB-1-k):k; return true; }
  __device__ __forceinline__ void a_ready(const AttnUnit&)const{}
  __device__ __forceinline__ void done(const AttnUnit&)const{}
};
template<class Sched,int THRL=8> __device__ __forceinline__ void attn_phase(char*lds,const AttnTensors&T,const Sched&S){
  AttnUnit u;
  for(int i=0;S.next(i,u);++i){ S.a_ready(u); attn_unit<THRL>(u.bh/NHEAD,u.bh%NHEAD,u.qb,T.Q,T.K,T.V,T.O,T.C2T+(size_t)u.bh*SEQ,T.M2,lds); S.done(u); }
}
#undef SBAR
#undef WAIT_BAR
}

constexpr int NWAVES = 8, NTHR = 512;
constexpr int DM = 1024, NB = 4, SEQ = 4096, DB = 128, DSEQ = 8, PAST = 2048, PAGE = 128, NPAGES = 16;
constexpr int MP = NB * SEQ, MS = DB * DSEQ, M = MP + MS;
constexpr int DP = 512, DA = 512, NH = 8, HD = 64, DIN = 4104, NPROJ = 4096;
constexpr int NKEYS = 128, NEXP = 16384, PH = 8, TOPK = 16, DKH = 128, DQ = 2048;
constexpr float EPS = 1e-6f;
constexpr float LOG2E = 1.4426950408889634f;
constexpr float C2 = 0.125f * LOG2E;
constexpr size_t O_YP = 0, O_YS = O_YP + (size_t)MP * DM, O_KP = O_YS + (size_t)MS * DM, O_VP = O_KP + (size_t)MP * DA, O_LFP = O_VP + (size_t)MP * DA,
                 O_PP = O_LFP + (size_t)MP * NH, O_KS = O_PP + (size_t)NB * 15 * DP, O_VS = O_KS + (size_t)MS * DA, O_LFS = O_VS + (size_t)MS * DA,
                 O_PS = O_LFS + (size_t)MS * NH, O_END = O_PS + (size_t)DB * 15 * DP;
constexpr size_t MiB = 1u << 20;
constexpr size_t WS_CTL = 0, CTL_ZERO_BYTES = 1 * MiB;
constexpr size_t WS_WIN = 2 * MiB, WS_WBP = 10 * MiB, WS_WBA = 11 * MiB, WS_WOUT = 12 * MiB, WS_WQ = 14 * MiB, WS_SUBK = 18 * MiB, WS_CP2 = 19 * MiB, WS_RSS = 20 * MiB;
constexpr size_t WS_PU = 32 * MiB, WS_PV = 64 * MiB, WS_XN = 96 * MiB  , WS_U = 132 * MiB, WS_Q = 150 * MiB, WS_K = 168 * MiB, WS_V = 186 * MiB,
                 WS_GA = 204 * MiB, WS_GB = 240 * MiB, WS_PO = 276 * MiB, WS_AO = 294 * MiB, WS_T = 312 * MiB, WS_MIX = 348 * MiB, WS_PQ = 384 * MiB,
                 WS_SI = 456 * MiB, WS_SG = 466 * MiB, WS_H = 476 * MiB, WS_END = 548 * MiB;
constexpr int CW_BAR = 4096;
constexpr int LDS_BYTES = 163840;
constexpr int SCR_BYTES = 159 * 1024;
constexpr int MISC_OFF = SCR_BYTES;

typedef unsigned short bf16;
typedef unsigned v4u __attribute__((ext_vector_type(4)));
typedef unsigned v2u __attribute__((ext_vector_type(2)));
typedef float f32x4 __attribute__((ext_vector_type(4)));
typedef float f32x2 __attribute__((ext_vector_type(2)));

__device__ __forceinline__ float bf2f(unsigned short b) { return __uint_as_float((unsigned)b << 16); }
__device__ __forceinline__ float bflo(unsigned w) { return __uint_as_float(w << 16); }
__device__ __forceinline__ float bfhi(unsigned w) { return __uint_as_float(w & 0xffff0000u); }
typedef __bf16 bf16x2_t __attribute__((ext_vector_type(2)));
__device__ __forceinline__ unsigned pkbf(float lo, float hi) { f32x2 v = {lo, hi}; bf16x2_t b = __builtin_convertvector(v, bf16x2_t); return __builtin_bit_cast(unsigned, b); }
__device__ __forceinline__ float wave_sum(float v) {
#pragma unroll
    for (int o = 1; o < 64; o <<= 1) v += __shfl_xor(v, o);
    return v;
}
__device__ __forceinline__ float wave_max(float v) {
#pragma unroll
    for (int o = 1; o < 64; o <<= 1) v = fmaxf(v, __shfl_xor(v, o));
    return v;
}

struct Args {
    const float* x_p; const float* x_s; const float* cache_k; const float* cache_v; const float* cache_lf; const float* state_pool; const int* page_table;
    const float* norm_mix_g; const float* w_in; const float* b_forget; const float* q_norm_g; const float* k_norm_g; const float* pool_mix_w; const float* pool_scale;
    const float* w_bp; const float* w_ba; const float* w_out; const float* norm_ffn_g; const float* w_query; const float* sub_keys; const float* peer_u; const float* peer_v;
    float* out; unsigned char* ws; int ph_lo, ph_hi, li, pad;
};

using pg8::Unit;
struct EpiInProj {
    static constexpr bool PERM = true, AFTER_DRAIN = false;
    bf16 *U, *Q, *K, *V, *GA, *GB; float* out; const float *gq, *gk;
    __device__ __forceinline__ void operator()(const f32x4 (&acc)[2][2][4][2], const Unit& u, int wr, int wc, int fr, int fq) const {
        const int pn = u.pn; const int row0 = u.pm * 256 + wr * 64 + fr; const bool prompt = u.pm < (MP / 256);
        if (pn < 2) {
#pragma unroll
            for (int ai = 0; ai < 2; ++ai)
#pragma unroll
                for (int m = 0; m < 4; ++m) { const int row = row0 + ai * 128 + m * 16;
                    float* tail = nullptr;
                    if (prompt) { const int s = row & (SEQ - 1), b = row >> 12; if (s >= SEQ - 15) tail = out + O_PP + (size_t)(b * 15 + (s - (SEQ - 15))) * DP; }
                    else { const int rs = row - MP; tail = out + O_PS + (size_t)((rs >> 3) * 15 + 7 + (rs & 7)) * DP; }
#pragma unroll
                    for (int bj = 0; bj < 2; ++bj) { const int col = pn * 256 + bj * 128 + wc * 32 + 8 * fq; const f32x4 v0 = acc[ai][bj][m][0], v1 = acc[ai][bj][m][1];
                        v4u w; w.x = pkbf(v0[0], v0[1]); w.y = pkbf(v0[2], v0[3]); w.z = pkbf(v1[0], v1[1]); w.w = pkbf(v1[2], v1[3]);
                        *(v4u*)(U + (size_t)row * DP + col) = w;
                        if (tail) { *(f32x4*)(tail + col) = v0; *(f32x4*)(tail + col + 4) = v1; } } }
        } else if (pn < 6) {
            const bool isq = pn < 4; const int head = 4 * (pn & 1) + wc; const float* g = isq ? gq : gk;
            f32x4 gv[2][2];
#pragma unroll
            for (int bj = 0; bj < 2; ++bj)
#pragma unroll
                for (int n = 0; n < 2; ++n) gv[bj][n] = *(const f32x4*)(g + 32 * bj + 8 * fq + 4 * n);
            bf16* dst = isq ? Q : K;
#pragma unroll
            for (int ai = 0; ai < 2; ++ai)
#pragma unroll
                for (int m = 0; m < 4; ++m) { const int row = row0 + ai * 128 + m * 16; float ss = 0.f;
#pragma unroll
                    for (int bj = 0; bj < 2; ++bj)
#pragma unroll
                        for (int n = 0; n < 2; ++n) { const f32x4 x = acc[ai][bj][m][n]; ss += (x[0] * x[0] + x[1] * x[1]) + (x[2] * x[2] + x[3] * x[3]); }
                    ss += __shfl_xor(ss, 16); ss += __shfl_xor(ss, 32);
                    float r = 1.0f / sqrtf(ss * (1.0f / 64.0f) + EPS);
                    float* kout = isq ? nullptr : (prompt ? out + O_KP + (size_t)row * DA : out + O_KS + (size_t)(row - MP) * DA);
                    const float rq = isq ? r * C2 : r;
#pragma unroll
                    for (int bj = 0; bj < 2; ++bj) { const int col = head * 64 + 32 * bj + 8 * fq; const f32x4 v0 = acc[ai][bj][m][0] * gv[bj][0] * rq, v1 = acc[ai][bj][m][1] * gv[bj][1] * rq;
                        v4u w; w.x = pkbf(v0[0], v0[1]); w.y = pkbf(v0[2], v0[3]); w.z = pkbf(v1[0], v1[1]); w.w = pkbf(v1[2], v1[3]);
                        *(v4u*)(dst + (size_t)row * DA + col) = w;
                        if (!isq) { *(f32x4*)(kout + col) = v0; *(f32x4*)(kout + col + 4) = v1; } } }
        } else if (pn < 8) {
#pragma unroll
            for (int ai = 0; ai < 2; ++ai)
#pragma unroll
                for (int m = 0; m < 4; ++m) { const int row = row0 + ai * 128 + m * 16;
                    float* vout = prompt ? out + O_VP + (size_t)row * DA : out + O_VS + (size_t)(row - MP) * DA;
#pragma unroll
                    for (int bj = 0; bj < 2; ++bj) { const int col = (pn - 6) * 256 + bj * 128 + wc * 32 + 8 * fq; const f32x4 v0 = acc[ai][bj][m][0], v1 = acc[ai][bj][m][1];
                        v4u w; w.x = pkbf(v0[0], v0[1]); w.y = pkbf(v0[2], v0[3]); w.z = pkbf(v1[0], v1[1]); w.w = pkbf(v1[2], v1[3]);
                        *(v4u*)(V + (size_t)row * DA + col) = w; *(f32x4*)(vout + col) = v0; *(f32x4*)(vout + col + 4) = v1; } }
        } else {
            bf16* dst = pn < 12 ? GA : GB; const int ct = (pn < 12 ? pn - 8 : pn - 12) * 256;
#pragma unroll
            for (int ai = 0; ai < 2; ++ai)
#pragma unroll
                for (int m = 0; m < 4; ++m) { const int row = row0 + ai * 128 + m * 16;
#pragma unroll
                    for (int bj = 0; bj < 2; ++bj) { const int col = ct + bj * 128 + wc * 32 + 8 * fq; float s[8];
#pragma unroll
                        for (int n = 0; n < 2; ++n)
#pragma unroll
                            for (int i = 0; i < 4; ++i) s[4 * n + i] = __builtin_amdgcn_rcpf(1.0f + __builtin_amdgcn_exp2f(-LOG2E * acc[ai][bj][m][n][i]));
                        v4u w; w.x = pkbf(s[0], s[1]); w.y = pkbf(s[2], s[3]); w.z = pkbf(s[4], s[5]); w.w = pkbf(s[6], s[7]);
                        *(v4u*)(dst + (size_t)row * DM + col) = w; } }
        }
    }
};
template <int MODE> struct EpiGate {
    static constexpr bool PERM = true, AFTER_DRAIN = false;
    const bf16* G; const bf16* Tin; bf16* O;
    __device__ __forceinline__ void operator()(const f32x4 (&acc)[2][2][4][2], const Unit& u, int wr, int wc, int fr, int fq) const {
        const int row0 = u.pm * 256 + wr * 64 + fr;
#pragma unroll
        for (int ai = 0; ai < 2; ++ai)
#pragma unroll
            for (int m = 0; m < 4; ++m) { const int row = row0 + ai * 128 + m * 16;
#pragma unroll
                for (int bj = 0; bj < 2; ++bj) { const size_t off = (size_t)row * DM + u.pn * 256 + bj * 128 + wc * 32 + 8 * fq;
                    const v4u g = *(const v4u*)(G + off); const f32x4 v0 = acc[ai][bj][m][0], v1 = acc[ai][bj][m][1];
                    float r[8] = {v0[0] * bflo(g.x), v0[1] * bfhi(g.x), v0[2] * bflo(g.y), v0[3] * bfhi(g.y), v1[0] * bflo(g.z), v1[1] * bfhi(g.z), v1[2] * bflo(g.w), v1[3] * bfhi(g.w)};
                    if (MODE == 1) { const v4u t = *(const v4u*)(Tin + off);
                        r[0] += bflo(t.x); r[1] += bfhi(t.x); r[2] += bflo(t.y); r[3] += bfhi(t.y); r[4] += bflo(t.z); r[5] += bfhi(t.z); r[6] += bflo(t.w); r[7] += bfhi(t.w); }
                    v4u w; w.x = pkbf(r[0], r[1]); w.y = pkbf(r[2], r[3]); w.z = pkbf(r[4], r[5]); w.w = pkbf(r[6], r[7]);
                    *(v4u*)(O + off) = w; } }
    }
};
struct EpiOut {
    static constexpr bool PERM = true, AFTER_DRAIN = false;
    const float* xp; const float* xs; float* H; bf16* HG; const float* gf; float* RSS;
    __device__ __forceinline__ void operator()(const f32x4 (&acc)[2][2][4][2], const Unit& u, int wr, int wc, int fr, int fq) const {
        const int row0 = u.pm * 256 + wr * 64 + fr; const bool prompt = u.pm < (MP / 256);
        f32x4 gv[2][2];
#pragma unroll
        for (int bj = 0; bj < 2; ++bj)
#pragma unroll
            for (int n = 0; n < 2; ++n) gv[bj][n] = *(const f32x4*)(gf + u.pn * 256 + bj * 128 + wc * 32 + 8 * fq + 4 * n);
#pragma unroll
        for (int ai = 0; ai < 2; ++ai)
#pragma unroll
            for (int m = 0; m < 4; ++m) { const int row = row0 + ai * 128 + m * 16; float ss = 0.f;
                const float* xr = prompt ? xp + (size_t)row * DM : xs + (size_t)(row - MP) * DM;
#pragma unroll
                for (int bj = 0; bj < 2; ++bj) { const int col = u.pn * 256 + bj * 128 + wc * 32 + 8 * fq;
                    const f32x4 h0 = acc[ai][bj][m][0] + *(const f32x4*)(xr + col), h1 = acc[ai][bj][m][1] + *(const f32x4*)(xr + col + 4);
                    ss += (h0[0] * h0[0] + h0[1] * h0[1]) + (h0[2] * h0[2] + h0[3] * h0[3]) + (h1[0] * h1[0] + h1[1] * h1[1]) + (h1[2] * h1[2] + h1[3] * h1[3]);
                    *(f32x4*)(H + (size_t)row * DM + col) = h0; *(f32x4*)(H + (size_t)row * DM + col + 4) = h1;
                    const f32x4 a0 = h0 * gv[bj][0], a1 = h1 * gv[bj][1];
                    v4u w; w.x = pkbf(a0[0], a0[1]); w.y = pkbf(a0[2], a0[3]); w.z = pkbf(a1[0], a1[1]); w.w = pkbf(a1[2], a1[3]);
                    *(v4u*)(HG + (size_t)row * DM + col) = w; }
                ss += __shfl_xor(ss, 16); ss += __shfl_xor(ss, 32);
                if (fq == 0) RSS[(size_t)row * 16 + u.pn * 4 + wc] = ss; }
    }
};

struct Frame {
    LAS unsigned char* lds; volatile LAS unsigned* MISC; gu32* ctl;
    int tid, lane, wave, vcu, G;
};

__device__ __forceinline__ void transpose_item(const float* W, int ldw, int K, bf16* WT, int src_col0, int dst_row0, int k0, LAS float* scr, int lane) {
#pragma unroll 8
    for (int i = 0; i < 32; ++i) { const int kk = 2 * i + (lane >> 5); scr[kk * 33 + (lane & 31)] = W[(size_t)(k0 + kk) * ldw + src_col0 + (lane & 31)]; }
    LDS_WAIT(); asm volatile("" ::: "memory");
    const int c = lane & 7;
#pragma unroll
    for (int j = 0; j < 4; ++j) { const int n = (lane >> 3) + 8 * j; const LAS float* s = scr + (8 * c) * 33 + n;
        v4u o; o.x = pkbf(s[0 * 33], s[1 * 33]); o.y = pkbf(s[2 * 33], s[3 * 33]); o.z = pkbf(s[4 * 33], s[5 * 33]); o.w = pkbf(s[6 * 33], s[7 * 33]);
        *(v4u*)(WT + (size_t)(dst_row0 + n) * K + k0 + 8 * c) = o; }
    LDS_WAIT(); asm volatile("" ::: "memory");
}
__device__ __forceinline__ int win_src_col(int db) {
    if (db < 16) return 32 * db;
    if (db < 48) { const int base = db < 32 ? 512 : 1024; const int local = (db - 16) & 15, tile = local >> 3, blk = local & 7, bj = blk >> 2, w = blk & 3; return base + tile * 256 + 64 * w + 32 * bj; }
    if (db < 64) return 1536 + 32 * (db - 48);
    if (db < 96) return 2056 + 32 * (db - 64);
    return 3080 + 32 * (db - 96);
}
__device__ __forceinline__ void cvt_rows_bf16(const float* src, bf16* dst, size_t n8, size_t gtid, size_t gn) {
    for (size_t i = gtid; i < n8; i += gn) { const f32x4 a = *(const f32x4*)(src + 8 * i), b = *(const f32x4*)(src + 8 * i + 4);
        v4u w; w.x = pkbf(a[0], a[1]); w.y = pkbf(a[2], a[3]); w.z = pkbf(b[0], b[1]); w.w = pkbf(b[2], b[3]); *(v4u*)(dst + 8 * i) = w; }
}
__device__ __forceinline__ void p0_prologue(Frame& F, const Args& a) {
    unsigned char* ws = a.ws;
    LAS float* scr = (LAS float*)(F.lds + F.wave * 16384);
    const int gw = F.vcu * NWAVES + F.wave, NGW = F.G * NWAVES;
    for (int it = gw; it < 4096; it += NGW) {
        int r = it;
        if (r < 2048) { const int kb = r >> 7, db = r & 127; transpose_item(a.w_in, DIN, DM, (bf16*)(ws + WS_WIN), win_src_col(db), 32 * db, 64 * kb, scr, F.lane); continue; } r -= 2048;
        if (r < 256) { const int kb = r >> 5, nb = r & 31; transpose_item(a.w_bp, DM, DP, (bf16*)(ws + WS_WBP), 32 * nb, 32 * nb, 64 * kb, scr, F.lane); continue; } r -= 256;
        if (r < 256) { const int kb = r >> 5, nb = r & 31; transpose_item(a.w_ba, DM, DA, (bf16*)(ws + WS_WBA), 32 * nb, 32 * nb, 64 * kb, scr, F.lane); continue; } r -= 256;
        if (r < 512) { const int kb = r >> 5, nb = r & 31; transpose_item(a.w_out, DM, DM, (bf16*)(ws + WS_WOUT), 32 * nb, 32 * nb, 64 * kb, scr, F.lane); continue; } r -= 512;
        { const int kb = r >> 6, nb = r & 63; transpose_item(a.w_query, DQ, DM, (bf16*)(ws + WS_WQ), 32 * nb, 32 * nb, 64 * kb, scr, F.lane); }
    }
    { const size_t gtid = (size_t)F.vcu * NTHR + F.tid, gn = (size_t)F.G * NTHR;
      cvt_rows_bf16(a.peer_u, (bf16*)(ws + WS_PU), (size_t)NEXP * DM / 8, gtid, gn);
      cvt_rows_bf16(a.peer_v, (bf16*)(ws + WS_PV), (size_t)NEXP * DM / 8, gtid, gn);
      cvt_rows_bf16(a.sub_keys, (bf16*)(ws + WS_SUBK), (size_t)PH * 2 * NKEYS * DKH / 8, gtid, gn);
      for (size_t i = gtid; i < (size_t)DB * 7 * DP; i += gn) { const int b = (int)(i / (7 * DP)), j = (int)((i / DP) % 7), c = (int)(i % DP);
          a.out[O_PS + (size_t)(b * 15 + j) * DP + c] = a.state_pool[(size_t)(b * 15 + 8 + j) * DP + c]; } }
    __syncthreads();
    LAS float* wfT = (LAS float*)F.lds;
    for (int i = F.tid; i < 8 * DM; i += NTHR) { const int col = i >> 3, h = i & 7; wfT[h * DM + col] = a.w_in[(size_t)col * DIN + 2048 + h]; }
    __syncthreads();
    bf16* XN = (bf16*)(ws + WS_XN);
    for (int row = gw; row < M; row += NGW) {
        const float* xr = row < MP ? a.x_p + (size_t)row * DM : a.x_s + (size_t)(row - MP) * DM;
        f32x4 v[4]; float ss = 0.f;
#pragma unroll
        for (int j = 0; j < 4; ++j) { v[j] = *(const f32x4*)(xr + 256 * j + 4 * F.lane); ss += (v[j][0] * v[j][0] + v[j][1] * v[j][1]) + (v[j][2] * v[j][2] + v[j][3] * v[j][3]); }
        const float r = 1.0f / sqrtf(wave_sum(ss) * (1.0f / DM) + EPS);
        float f[8];
#pragma unroll
        for (int h = 0; h < 8; ++h) f[h] = 0.f;
#pragma unroll
        for (int j = 0; j < 4; ++j) { const f32x4 g = *(const f32x4*)(a.norm_mix_g + 256 * j + 4 * F.lane); v[j] = v[j] * r * g;
            v2u w; w.x = pkbf(v[j][0], v[j][1]); w.y = pkbf(v[j][2], v[j][3]); *(v2u*)(XN + (size_t)row * DM + 256 * j + 4 * F.lane) = w;
#pragma unroll
            for (int h = 0; h < 8; ++h) { const f32x4 wv = *(const LAS f32x4*)(wfT + h * DM + 256 * j + 4 * F.lane); f[h] += (v[j][0] * wv[0] + v[j][1] * wv[1]) + (v[j][2] * wv[2] + v[j][3] * wv[3]); } }
        float mine = 0.f;
#pragma unroll
        for (int h = 0; h < 8; ++h) { const float s = wave_sum(f[h]); if (F.lane == h) mine = s; }
        if (F.lane < 8) { const float z = mine + a.b_forget[F.lane]; const float lf = fminf(z, 0.f) - log1pf(expf(-fabsf(z)));
            if (row < MP) a.out[O_LFP + (size_t)row * NH + F.lane] = lf; else a.out[O_LFS + (size_t)(row - MP) * NH + F.lane] = lf; }
    }
}

__device__ __forceinline__ void p2_cumsum_pool(Frame& F, const Args& a) {
    unsigned char* ws = a.ws;
    { const int gw = F.vcu * NWAVES + F.wave; float* CP2 = (float*)(ws + WS_CP2);
      if (gw < NB * NH) { const int b = gw >> 3, h = gw & 7; float carry = 0.f;
          for (int c = 0; c < SEQ / 64; ++c) { float v = a.out[O_LFP + (size_t)(b * SEQ + c * 64 + F.lane) * NH + h];
#pragma unroll
              for (int o = 1; o < 64; o <<= 1) { const float t = __shfl_up(v, o); if (F.lane >= o) v += t; }
              v += carry; CP2[(size_t)gw * SEQ + c * 64 + F.lane] = v * LOG2E; carry = __shfl(v, 63); } } }
    const bf16* U = (const bf16*)(ws + WS_U); bf16* PO = (bf16*)(ws + WS_PO);
    LAS float* pw = (LAS float*)F.lds;
    LAS float* mt = (LAS float*)(F.lds + 65536);
    int cur_g = -1;
    for (int unit = blockIdx.x; unit < 4 * (M / 32); unit += F.G) {
        const int g = unit / (M / 32), tile = unit % (M / 32);
        __syncthreads();
        if (g != cur_g) { for (int i = F.tid; i < 128 * 128 / 4; i += NTHR) *(LAS f32x4*)(pw + 4 * i) = *(const f32x4*)(a.pool_mix_w + (size_t)g * 16384 + 4 * i); cur_g = g; }
        { const int r = F.tid >> 4, c8 = (F.tid & 15) * 8, ch = g * 128 + c8, row = tile * 32 + r, w = 2 << g;
          float sum[8], self[8];
#pragma unroll
          for (int i = 0; i < 8; ++i) sum[i] = 0.f;
          float cnt;
          if (row < MP) { const int s = row & (SEQ - 1); cnt = (float)(s + 1 < w ? s + 1 : w);
              for (int i = 0; i < w; ++i) if (s - i >= 0) { const v4u q = *(const v4u*)(U + (size_t)(row - i) * DP + ch);
                  const float e[8] = {bflo(q.x), bfhi(q.x), bflo(q.y), bfhi(q.y), bflo(q.z), bfhi(q.z), bflo(q.w), bfhi(q.w)};
#pragma unroll
                  for (int k = 0; k < 8; ++k) { sum[k] += e[k]; if (i == 0) self[k] = e[k]; } }
          } else { const int rs = row - MP, b = rs >> 3, t = rs & 7; cnt = (float)w;
              for (int i = 0; i < w; ++i) { const int tt = t - i; float e[8];
                  if (tt >= 0) { const v4u q = *(const v4u*)(U + (size_t)(MP + b * 8 + tt) * DP + ch);
                      e[0] = bflo(q.x); e[1] = bfhi(q.x); e[2] = bflo(q.y); e[3] = bfhi(q.y); e[4] = bflo(q.z); e[5] = bfhi(q.z); e[6] = bflo(q.w); e[7] = bfhi(q.w); }
                  else { const f32x4 p0 = *(const f32x4*)(a.state_pool + (size_t)(b * 15 + 15 + tt) * DP + ch), p1 = *(const f32x4*)(a.state_pool + (size_t)(b * 15 + 15 + tt) * DP + ch + 4);
                      e[0] = p0[0]; e[1] = p0[1]; e[2] = p0[2]; e[3] = p0[3]; e[4] = p1[0]; e[5] = p1[1]; e[6] = p1[2]; e[7] = p1[3]; }
#pragma unroll
                  for (int k = 0; k < 8; ++k) { sum[k] += e[k]; if (i == 0) self[k] = e[k]; } } }
          const float inv = 1.0f / cnt;
#pragma unroll
          for (int k = 0; k < 8; ++k) mt[r * 132 + c8 + k] = sum[k] * inv - self[k]; }
        __syncthreads();
        { const int r = F.tid >> 4, d8 = (F.tid & 15) * 8, row = tile * 32 + r; float acc[8];
#pragma unroll
          for (int k = 0; k < 8; ++k) acc[k] = 0.f;
#pragma unroll 4
          for (int c = 0; c < 128; ++c) { const float mv = mt[r * 132 + c]; const f32x4 w0 = *(const LAS f32x4*)(pw + c * 128 + d8), w1 = *(const LAS f32x4*)(pw + c * 128 + d8 + 4);
              acc[0] += mv * w0[0]; acc[1] += mv * w0[1]; acc[2] += mv * w0[2]; acc[3] += mv * w0[3]; acc[4] += mv * w1[0]; acc[5] += mv * w1[1]; acc[6] += mv * w1[2]; acc[7] += mv * w1[3]; }
          const f32x4 s0 = *(const f32x4*)(a.pool_scale + g * 128 + d8), s1 = *(const f32x4*)(a.pool_scale + g * 128 + d8 + 4);
          v4u o; o.x = pkbf(acc[0] * s0[0], acc[1] * s0[1]); o.y = pkbf(acc[2] * s0[2], acc[3] * s0[3]); o.z = pkbf(acc[4] * s1[0], acc[5] * s1[1]); o.w = pkbf(acc[6] * s1[2], acc[7] * s1[3]);
          *(v4u*)(PO + (size_t)row * DP + g * 128 + d8) = o; }
    }
}

__device__ __forceinline__ float attn_bound2(const Args& a, int lane) {
    asm volatile("" : "+v"(lane));
    const float gq = wave_max(fabsf(a.q_norm_g[lane])), gk = wave_max(fabsf(a.k_norm_g[lane]));
    return 64.0f * C2 * gq * gk * 1.03f;
}

__device__ __forceinline__ void p3_prompt_attn_naive(Frame& F, const Args& a) {
    unsigned char* ws = a.ws;
    const bf16* Q = (const bf16*)(ws + WS_Q); const bf16* K = (const bf16*)(ws + WS_K); const bf16* V = (const bf16*)(ws + WS_V); bf16* AO = (bf16*)(ws + WS_AO);
    const float* CP2 = (const float*)(ws + WS_CP2);
    LAS float* Ks = (LAS float*)F.lds;
    LAS float* Vs = (LAS float*)(F.lds + 16384);
    LAS float* cks = (LAS float*)(F.lds + 32768);
    const float M2 = attn_bound2(a, F.lane);
    for (int unit = blockIdx.x; unit < NB * NH * (SEQ / 512); unit += F.G) {
        const int bh = unit & 31, qblk = 7 - (unit >> 5), b = bh >> 3, h = bh & 7;
        const int i = qblk * 512 + F.tid; const size_t qrow = (size_t)(b * SEQ + i);
        float q[64], o[64];
#pragma unroll
        for (int d8 = 0; d8 < 8; ++d8) { const v4u w = *(const v4u*)(Q + qrow * DA + h * 64 + d8 * 8);
            q[d8 * 8 + 0] = bflo(w.x); q[d8 * 8 + 1] = bfhi(w.x); q[d8 * 8 + 2] = bflo(w.y); q[d8 * 8 + 3] = bfhi(w.y); q[d8 * 8 + 4] = bflo(w.z); q[d8 * 8 + 5] = bfhi(w.z); q[d8 * 8 + 6] = bflo(w.w); q[d8 * 8 + 7] = bfhi(w.w); }
#pragma unroll
        for (int d = 0; d < 64; ++d) o[d] = 0.f;
        const float cq = CP2[(size_t)bh * SEQ + i] - M2; float l = 0.f;
        const int ntile = (qblk + 1) * 8;
        for (int jt = 0; jt < ntile; ++jt) {
            __syncthreads();
            { const int kr = F.tid >> 3, d8 = (F.tid & 7) * 8; const size_t krow = (size_t)(b * SEQ + jt * 64 + kr);
              const v4u kw = *(const v4u*)(K + krow * DA + h * 64 + d8), vw = *(const v4u*)(V + krow * DA + h * 64 + d8);
              LAS float* kd = Ks + kr * 64 + d8; LAS float* vd = Vs + kr * 64 + d8;
              *(LAS f32x4*)kd = (f32x4){bflo(kw.x), bfhi(kw.x), bflo(kw.y), bfhi(kw.y)}; *(LAS f32x4*)(kd + 4) = (f32x4){bflo(kw.z), bfhi(kw.z), bflo(kw.w), bfhi(kw.w)};
              *(LAS f32x4*)vd = (f32x4){bflo(vw.x), bfhi(vw.x), bflo(vw.y), bfhi(vw.y)}; *(LAS f32x4*)(vd + 4) = (f32x4){bflo(vw.z), bfhi(vw.z), bflo(vw.w), bfhi(vw.w)};
              if (F.tid < 64) cks[F.tid] = CP2[(size_t)bh * SEQ + jt * 64 + F.tid]; }
            __syncthreads();
            for (int j = 0; j < 64; ++j) {
                float s = 0.f;
#pragma unroll
                for (int d4 = 0; d4 < 16; ++d4) { const f32x4 kv = *(const LAS f32x4*)(Ks + j * 64 + d4 * 4); s += (q[d4 * 4] * kv[0] + q[d4 * 4 + 1] * kv[1]) + (q[d4 * 4 + 2] * kv[2] + q[d4 * 4 + 3] * kv[3]); }
                float p = __builtin_amdgcn_exp2f(s + cq - cks[j]); if (jt * 64 + j > i) p = 0.f;
                l += p;
#pragma unroll
                for (int d4 = 0; d4 < 16; ++d4) { const f32x4 vv = *(const LAS f32x4*)(Vs + j * 64 + d4 * 4); o[d4 * 4] += p * vv[0]; o[d4 * 4 + 1] += p * vv[1]; o[d4 * 4 + 2] += p * vv[2]; o[d4 * 4 + 3] += p * vv[3]; }
            }
        }
        const float il = 1.0f / l;
#pragma unroll
        for (int d8 = 0; d8 < 8; ++d8) { v4u w; w.x = pkbf(o[d8 * 8] * il, o[d8 * 8 + 1] * il); w.y = pkbf(o[d8 * 8 + 2] * il, o[d8 * 8 + 3] * il); w.z = pkbf(o[d8 * 8 + 4] * il, o[d8 * 8 + 5] * il); w.w = pkbf(o[d8 * 8 + 6] * il, o[d8 * 8 + 7] * il);
            *(v4u*)(AO + qrow * DA + h * 64 + d8 * 8) = w; }
    }
}

__device__ __forceinline__ void p3_sample_attn(Frame& F, const Args& a, const float M2) {
    unsigned char* ws = a.ws;
    const bf16* Q = (const bf16*)(ws + WS_Q); bf16* AO = (bf16*)(ws + WS_AO);
    LAS float* qs = (LAS float*)F.lds;
    LAS float* lfp = (LAS float*)(F.lds + 2048);
    LAS float* E2 = (LAS float*)(F.lds + 2048 + 8192);
    LAS float* sc = (LAS float*)(F.lds + 12288);
    LAS float* Op = (LAS float*)(F.lds + 12288 + 16384);
    LAS float* lp = (LAS float*)(F.lds + 12288 + 32768);
    const int lane = F.lane, w = F.wave;
    for (int unit = blockIdx.x; unit < DB * NH; unit += F.G) {
        const int b = unit >> 3, h = unit & 7;
        __syncthreads();
        { const int t = F.tid >> 6, d = F.tid & 63; qs[t * 64 + d] = bf2f(Q[(size_t)(MP + b * 8 + t) * DA + h * 64 + d]); }
        for (int j = F.tid; j < PAST; j += NTHR) { const int pg = a.page_table[b * NPAGES + (j >> 7)]; lfp[j] = a.cache_lf[((size_t)pg * PAGE + (j & 127)) * NH + h]; }
        __syncthreads();
        if (w == 0) {
            float loc[32]; float tot = 0.f;
#pragma unroll
            for (int k = 31; k >= 0; --k) { loc[k] = tot; tot += lfp[lane * 32 + k]; }
            float inc = tot;
#pragma unroll
            for (int o = 1; o < 64; o <<= 1) { const float t = __shfl_down(inc, o); if (lane + o < 64) inc += t; }
            const float excl = inc - tot;
#pragma unroll
            for (int k = 0; k < 32; ++k) lfp[lane * 32 + k] = (loc[k] + excl) * LOG2E;
            if (lane < 8) { float e = 0.f; for (int t = 0; t <= lane; ++t) e += a.out[O_LFS + (size_t)(b * 8 + t) * NH + h]; E2[lane] = e * LOG2E; }
        }
        __syncthreads();
        f32x4 qp[8];
#pragma unroll
        for (int t = 0; t < 8; ++t) qp[t] = *(const LAS f32x4*)(qs + t * 64 + 4 * (lane & 15));
        float e2[8];
#pragma unroll
        for (int t = 0; t < 8; ++t) e2[t] = E2[t] - M2;
        float o[8], lsum[8];
#pragma unroll
        for (int t = 0; t < 8; ++t) { o[t] = 0.f; lsum[t] = 0.f; }
        LAS float* scw = sc + w * 512;
        const int nblk = (w == 0) ? 5 : 4;
        for (int blk = 0; blk < nblk; ++blk) {
            const bool isnew = blk == 4;
            for (int gi = 0; gi < (isnew ? 2 : 16); ++gi) {
                const int kk = 4 * gi + (lane >> 4);
                const float* kp;
                if (!isnew) { const int j = w * 256 + blk * 64 + kk; const int pg = a.page_table[b * NPAGES + (j >> 7)]; kp = a.cache_k + (((size_t)pg * PAGE + (j & 127)) * NH + h) * HD; }
                else kp = a.out + O_KS + (size_t)(b * 8 + kk) * DA + h * HD;
                const f32x4 k4 = *(const f32x4*)(kp + 4 * (lane & 15));
                float part[8];
#pragma unroll
                for (int t = 0; t < 8; ++t) part[t] = (qp[t][0] * k4[0] + qp[t][1] * k4[1]) + (qp[t][2] * k4[2] + qp[t][3] * k4[3]);
#pragma unroll
                for (int t = 0; t < 8; ++t) { part[t] += __shfl_xor(part[t], 1); part[t] += __shfl_xor(part[t], 2); part[t] += __shfl_xor(part[t], 4); part[t] += __shfl_xor(part[t], 8); }
                float mine = 0.f;
#pragma unroll
                for (int t = 0; t < 8; ++t) if ((lane & 15) == t) mine = part[t];
                if ((lane & 15) < 8) scw[kk * 8 + (lane & 15)] = mine;
            }
            LDS_WAIT(); asm volatile("" ::: "memory");
            { f32x4 s0 = *(const LAS f32x4*)(scw + lane * 8), s1 = *(const LAS f32x4*)(scw + lane * 8 + 4); float p[8];
              const float sv[8] = {s0[0], s0[1], s0[2], s0[3], s1[0], s1[1], s1[2], s1[3]};
              if (!isnew) { const float dj = lfp[w * 256 + blk * 64 + lane];
#pragma unroll
                  for (int t = 0; t < 8; ++t) p[t] = __builtin_amdgcn_exp2f(sv[t] + e2[t] + dj);
              } else {
#pragma unroll
                  for (int t = 0; t < 8; ++t) { const float ek = E2[lane & 7]; p[t] = (lane <= t) ? __builtin_amdgcn_exp2f(sv[t] + e2[t] - ek) : 0.f; }
              }
#pragma unroll
              for (int t = 0; t < 8; ++t) lsum[t] += p[t];
              *(LAS f32x4*)(scw + lane * 8) = (f32x4){p[0], p[1], p[2], p[3]}; *(LAS f32x4*)(scw + lane * 8 + 4) = (f32x4){p[4], p[5], p[6], p[7]}; }
            LDS_WAIT(); asm volatile("" ::: "memory");
            for (int kk = 0; kk < (isnew ? 8 : 64); ++kk) {
                const float* vp;
                if (!isnew) { const int j = w * 256 + blk * 64 + kk; const int pg = a.page_table[b * NPAGES + (j >> 7)]; vp = a.cache_v + (((size_t)pg * PAGE + (j & 127)) * NH + h) * HD; }
                else vp = a.out + O_VS + (size_t)(b * 8 + kk) * DA + h * HD;
                const float vv = vp[lane];
                const f32x4 p0 = *(const LAS f32x4*)(scw + kk * 8), p1 = *(const LAS f32x4*)(scw + kk * 8 + 4);
                o[0] += p0[0] * vv; o[1] += p0[1] * vv; o[2] += p0[2] * vv; o[3] += p0[3] * vv; o[4] += p1[0] * vv; o[5] += p1[1] * vv; o[6] += p1[2] * vv; o[7] += p1[3] * vv;
            }
            LDS_WAIT(); asm volatile("" ::: "memory");
        }
#pragma unroll
        for (int t = 0; t < 8; ++t) { Op[(w * 8 + t) * 64 + lane] = o[t]; const float ls = wave_sum(lsum[t]); if (lane == 0) lp[w * 8 + t] = ls; }
        __syncthreads();
        { const int t = F.tid >> 6, d = F.tid & 63; float O = 0.f, L = 0.f;
#pragma unroll
          for (int ww = 0; ww < 8; ++ww) { O += Op[(ww * 8 + t) * 64 + d]; L += lp[ww * 8 + t]; }
          AO[(size_t)(MP + b * 8 + t) * DA + h * 64 + d] = (bf16)(pkbf(O / L, 0.f) & 0xffffu); }
    }
}

__device__ __forceinline__ void p7_topk_naive(Frame& F, const Args& a) {
    unsigned char* ws = a.ws;
    const bf16* PQ = (const bf16*)(ws + WS_PQ); const bf16* SK = (const bf16*)(ws + WS_SUBK); const float* RSS = (const float*)(ws + WS_RSS);
    int* SI = (int*)(ws + WS_SI); float* SG = (float*)(ws + WS_SG);
    LAS float* kT = (LAS float*)F.lds;
    LAS float* qt = (LAS float*)(F.lds + 67584);
    LAS float* sc = (LAS float*)(F.lds + 83968);
    LAS float* tps = (LAS float*)(F.lds + 100352);
    LAS int* tpi = (LAS int*)(F.lds + 100352 + 4096);
    LAS float* fs = (LAS float*)(F.lds + 100352 + 8192);
    LAS float* rs = (LAS float*)(F.lds + 100352 + 8192 + 2048);
    LAS int* cab = (LAS int*)(F.lds + 100352 + 8192 + 2048 + 128);
    if (F.tid == 0) { int n = 0; for (int ca = 0; ca < 16; ++ca) for (int cb = 0; cb < 16; ++cb) if ((ca + 1) * (cb + 1) <= 16) cab[n++] = (ca << 4) | cb; }
    for (int unit = blockIdx.x; unit < (M / 32) * PH; unit += F.G) {
        const int h = unit & 7, tile = unit >> 3, row0 = tile * 32;
        for (int p = 0; p < 2; ++p) {
            __syncthreads();
            for (int i = F.tid; i < 128 * 128 / 8; i += NTHR) { const int n = i >> 4, d8 = (i & 15) * 8; const v4u wv = *(const v4u*)(SK + ((size_t)(h * 2 + p) * NKEYS + n) * DKH + d8);
                kT[(d8 + 0) * 132 + n] = bflo(wv.x); kT[(d8 + 1) * 132 + n] = bfhi(wv.x); kT[(d8 + 2) * 132 + n] = bflo(wv.y); kT[(d8 + 3) * 132 + n] = bfhi(wv.y);
                kT[(d8 + 4) * 132 + n] = bflo(wv.z); kT[(d8 + 5) * 132 + n] = bfhi(wv.z); kT[(d8 + 6) * 132 + n] = bflo(wv.w); kT[(d8 + 7) * 132 + n] = bfhi(wv.w); }
            { const int t = F.tid >> 4, d8 = (F.tid & 15) * 8; const v4u wv = *(const v4u*)(PQ + (size_t)(row0 + t) * DQ + h * 256 + p * 128 + d8);
              *(LAS f32x4*)(qt + t * 128 + d8) = (f32x4){bflo(wv.x), bfhi(wv.x), bflo(wv.y), bfhi(wv.y)}; *(LAS f32x4*)(qt + t * 128 + d8 + 4) = (f32x4){bflo(wv.z), bfhi(wv.z), bflo(wv.w), bfhi(wv.w)}; }
            if (p == 0 && F.tid < 32) { float s = 0.f; for (int k = 0; k < 16; ++k) s += RSS[(size_t)(row0 + F.tid) * 16 + k]; rs[F.tid] = 1.0f / sqrtf(s * (1.0f / DM) + EPS); }
            __syncthreads();
            const int t = F.tid >> 4, kq = (F.tid & 15) * 8;
            float acc[8];
#pragma unroll
            for (int k = 0; k < 8; ++k) acc[k] = 0.f;
#pragma unroll 4
            for (int d = 0; d < 128; ++d) { const float qv = qt[t * 128 + d]; const f32x4 k0 = *(const LAS f32x4*)(kT + d * 132 + kq), k1 = *(const LAS f32x4*)(kT + d * 132 + kq + 4);
                acc[0] += qv * k0[0]; acc[1] += qv * k0[1]; acc[2] += qv * k0[2]; acc[3] += qv * k0[3]; acc[4] += qv * k1[0]; acc[5] += qv * k1[1]; acc[6] += qv * k1[2]; acc[7] += qv * k1[3]; }
            *(LAS f32x4*)(sc + t * 128 + kq) = (f32x4){acc[0], acc[1], acc[2], acc[3]}; *(LAS f32x4*)(sc + t * 128 + kq + 4) = (f32x4){acc[4], acc[5], acc[6], acc[7]};
            __syncthreads();
            int rank[8];
#pragma unroll
            for (int k = 0; k < 8; ++k) rank[k] = 0;
            for (int j = 0; j < 128; ++j) { const float sj = sc[t * 128 + j];
#pragma unroll
                for (int k = 0; k < 8; ++k) rank[k] += (sj > acc[k] || (sj == acc[k] && j < kq + k)) ? 1 : 0; }
#pragma unroll
            for (int k = 0; k < 8; ++k) if (rank[k] < 16) { tps[(p * 32 + t) * 16 + rank[k]] = acc[k]; tpi[(p * 32 + t) * 16 + rank[k]] = kq + k; }
        }
        __syncthreads();
        { const int t = F.tid >> 4, l16 = F.tid & 15;
          float cs[4]; int cf[4], ci[4], rk[4];
#pragma unroll
          for (int k = 0; k < 4; ++k) { const int c = l16 + 16 * k; if (c < 50) { const int ab = cab[c], ca = ab >> 4, cb = ab & 15; cs[k] = tps[t * 16 + ca] + tps[(32 + t) * 16 + cb]; cf[k] = ab; ci[k] = tpi[t * 16 + ca] * NKEYS + tpi[(32 + t) * 16 + cb]; }
              else { cs[k] = -INFINITY; cf[k] = 1 << 20; ci[k] = 0; } rk[k] = 0; }
          for (int c = 0; c < 50; ++c) { const int ab = cab[c]; const float s = tps[t * 16 + (ab >> 4)] + tps[(32 + t) * 16 + (ab & 15)];
#pragma unroll
              for (int k = 0; k < 4; ++k) rk[k] += (s > cs[k] || (s == cs[k] && ab < cf[k])) ? 1 : 0; }
#pragma unroll
          for (int k = 0; k < 4; ++k) if (l16 + 16 * k < 50 && rk[k] < 16) { fs[t * 16 + rk[k]] = cs[k]; SI[(size_t)(row0 + t) * 128 + h * 16 + rk[k]] = ci[k]; }
        }
        __syncthreads();
        { const int t = F.tid >> 4, l16 = F.tid & 15; const float z = fs[t * 16 + l16] * rs[t];
          float mx = z; mx = fmaxf(mx, __shfl_xor(mx, 1)); mx = fmaxf(mx, __shfl_xor(mx, 2)); mx = fmaxf(mx, __shfl_xor(mx, 4)); mx = fmaxf(mx, __shfl_xor(mx, 8));
          const float e = expf(z - mx); float sm = e; sm += __shfl_xor(sm, 1); sm += __shfl_xor(sm, 2); sm += __shfl_xor(sm, 4); sm += __shfl_xor(sm, 8);
          SG[(size_t)(row0 + t) * 128 + h * 16 + l16] = e / sm; }
    }
}

__device__ __forceinline__ void p8_gather_naive(Frame& F, const Args& a) {
    unsigned char* ws = a.ws;
    const bf16* HG = (const bf16*)(ws + WS_XN); const bf16* PU = (const bf16*)(ws + WS_PU); const bf16* PV = (const bf16*)(ws + WS_PV);
    const float* RSS = (const float*)(ws + WS_RSS); const int* SI = (const int*)(ws + WS_SI); const float* SG = (const float*)(ws + WS_SG);
    float* Y = a.out + O_YP;
    LAS float* wl = (LAS float*)(F.lds + F.wave * 512);
    const int gw = F.vcu * NWAVES + F.wave, NGW = F.G * NWAVES, lane = F.lane;
    for (int row = gw; row < M; row += NGW) {
        float hx[16];
        { const v4u a0 = *(const v4u*)(HG + (size_t)row * DM + 8 * lane), a1 = *(const v4u*)(HG + (size_t)row * DM + 512 + 8 * lane);
          hx[0] = bflo(a0.x); hx[1] = bfhi(a0.x); hx[2] = bflo(a0.y); hx[3] = bfhi(a0.y); hx[4] = bflo(a0.z); hx[5] = bfhi(a0.z); hx[6] = bflo(a0.w); hx[7] = bfhi(a0.w);
          hx[8] = bflo(a1.x); hx[9] = bfhi(a1.x); hx[10] = bflo(a1.y); hx[11] = bfhi(a1.y); hx[12] = bflo(a1.z); hx[13] = bfhi(a1.z); hx[14] = bflo(a1.w); hx[15] = bfhi(a1.w); }
        float ssum = (lane < 16) ? RSS[(size_t)row * 16 + lane] : 0.f; ssum = wave_sum(ssum);
        const float rstd = 1.0f / sqrtf(ssum * (1.0f / DM) + EPS);
        const int e0 = SI[(size_t)row * 128 + lane], e1 = SI[(size_t)row * 128 + 64 + lane];
        const float g0 = SG[(size_t)row * 128 + lane], g1 = SG[(size_t)row * 128 + 64 + lane];
#pragma unroll 4
        for (int k = 0; k < 128; ++k) {
            const int e = __shfl(k < 64 ? e0 : e1, k & 63);
            const v4u u0 = *(const v4u*)(PU + (size_t)e * DM + 8 * lane), u1 = *(const v4u*)(PU + (size_t)e * DM + 512 + 8 * lane);
            float d = (hx[0] * bflo(u0.x) + hx[1] * bfhi(u0.x)) + (hx[2] * bflo(u0.y) + hx[3] * bfhi(u0.y)) + (hx[4] * bflo(u0.z) + hx[5] * bfhi(u0.z)) + (hx[6] * bflo(u0.w) + hx[7] * bfhi(u0.w))
                    + (hx[8] * bflo(u1.x) + hx[9] * bfhi(u1.x)) + (hx[10] * bflo(u1.y) + hx[11] * bfhi(u1.y)) + (hx[12] * bflo(u1.z) + hx[13] * bfhi(u1.z)) + (hx[14] * bflo(u1.w) + hx[15] * bfhi(u1.w));
            d = wave_sum(d);
            if (lane == (k & 63)) { const float z = d * rstd; const float ge = 0.5f * z * (1.0f + erff(z * 0.70710678118654752f)); wl[k] = ge * (k < 64 ? g0 : g1); }
        }
        LDS_WAIT(); asm volatile("" ::: "memory");
        float o[16];
#pragma unroll
        for (int i = 0; i < 16; ++i) o[i] = 0.f;
#pragma unroll 4
        for (int k = 0; k < 128; ++k) {
            const int e = __shfl(k < 64 ? e0 : e1, k & 63); const float wv = wl[k];
            const v4u u0 = *(const v4u*)(PV + (size_t)e * DM + 8 * lane), u1 = *(const v4u*)(PV + (size_t)e * DM + 512 + 8 * lane);
            o[0] += wv * bflo(u0.x); o[1] += wv * bfhi(u0.x); o[2] += wv * bflo(u0.y); o[3] += wv * bfhi(u0.y); o[4] += wv * bflo(u0.z); o[5] += wv * bfhi(u0.z); o[6] += wv * bflo(u0.w); o[7] += wv * bfhi(u0.w);
            o[8] += wv * bflo(u1.x); o[9] += wv * bfhi(u1.x); o[10] += wv * bflo(u1.y); o[11] += wv * bfhi(u1.y); o[12] += wv * bflo(u1.z); o[13] += wv * bfhi(u1.z); o[14] += wv * bflo(u1.w); o[15] += wv * bfhi(u1.w);
        }
        LDS_WAIT(); asm volatile("" ::: "memory");
        float* yr = Y + (size_t)row * DM; const float* hr = (const float*)(ws + WS_H) + (size_t)row * DM;
        { f32x4 y0 = *(const f32x4*)(hr + 8 * lane), y1 = *(const f32x4*)(hr + 8 * lane + 4), y2 = *(const f32x4*)(hr + 512 + 8 * lane), y3 = *(const f32x4*)(hr + 512 + 8 * lane + 4);
          y0 += (f32x4){o[0], o[1], o[2], o[3]}; y1 += (f32x4){o[4], o[5], o[6], o[7]}; y2 += (f32x4){o[8], o[9], o[10], o[11]}; y3 += (f32x4){o[12], o[13], o[14], o[15]};
          *(f32x4*)(yr + 8 * lane) = y0; *(f32x4*)(yr + 8 * lane + 4) = y1; *(f32x4*)(yr + 512 + 8 * lane) = y2; *(f32x4*)(yr + 512 + 8 * lane + 4) = y3; }
    }
}


typedef float f32x16 __attribute__((ext_vector_type(16)));
typedef short bf16x8v __attribute__((ext_vector_type(8)));
__device__ __forceinline__ int f2key(float s) { int b = __builtin_bit_cast(int, s); return b ^ ((b >> 31) & 0x7fffffff); }
__device__ __forceinline__ float key2f(int k) { return __builtin_bit_cast(float, k ^ ((k >> 31) & 0x7fffffff)); }
#define CE_DESC(x, y) do { const int mx_ = (x) > (y) ? (x) : (y), mn_ = (x) > (y) ? (y) : (x); (x) = mx_; (y) = mn_; } while (0)
template <int OFF, int N, typename T> __device__ __forceinline__ void bsort_desc(T& v) {
#pragma unroll
    for (int k = 2; k <= N; k <<= 1)
#pragma unroll
        for (int j = k >> 1; j > 0; j >>= 1)
#pragma unroll
            for (int i = 0; i < N; ++i) { const int l = i ^ j; if (l > i) { if ((i & k) == 0) CE_DESC(v[OFF + i], v[OFF + l]); else CE_DESC(v[OFF + l], v[OFF + i]); } }
}
template <int OFF, typename T> __device__ __forceinline__ void bmerge16_desc(T& v) {
#pragma unroll
    for (int j = 8; j > 0; j >>= 1)
#pragma unroll
        for (int i = 0; i < 16; ++i) { const int l = i ^ j; if (l > i) CE_DESC(v[OFF + i], v[OFF + l]); }
}
template <int OA, int OB, typename T> __device__ __forceinline__ void top16_merge(T& v) {
#pragma unroll
    for (int i = 0; i < 16; ++i) v[OA + i] = v[OA + i] > v[OB + 15 - i] ? v[OA + i] : v[OB + 15 - i];
    bmerge16_desc<OA>(v);
}
template <typename T> __device__ __forceinline__ void top16_of_64(T& v) {
    bsort_desc<0, 16>(v); bsort_desc<16, 16>(v); bsort_desc<32, 16>(v); bsort_desc<48, 16>(v);
    top16_merge<0, 16>(v); top16_merge<32, 48>(v); top16_merge<0, 32>(v);
}
__device__ __forceinline__ void p7_topk(Frame& F, const Args& a) {
    unsigned char* ws = a.ws;
    const bf16* PQ = (const bf16*)(ws + WS_PQ); const bf16* SK = (const bf16*)(ws + WS_SUBK); const float* RSS = (const float*)(ws + WS_RSS);
    int* SI = (int*)(ws + WS_SI); float* SG = (float*)(ws + WS_SG);
    const int lane = F.lane, j = lane & 31, hi = lane >> 5;
    LAS unsigned* ib = (LAS unsigned*)(F.lds + F.wave * 1024);
    const int gw = F.vcu * NWAVES + F.wave, NGW = F.G * NWAVES;
    for (int item = gw; item < (M / 32) * PH; item += NGW) {
        const int h = item & 7, row0 = (item >> 3) * 32;
        int jl = j, hl = hi; asm volatile("" : "+v"(jl), "+v"(hl));
        int top[2][16];
#pragma unroll
        for (int p = 0; p < 2; ++p) {
            bf16x8v qf[8];
#pragma unroll
            for (int ks = 0; ks < 8; ++ks) qf[ks] = *(const bf16x8v*)(PQ + (size_t)(row0 + jl) * DQ + h * 256 + p * 128 + 16 * ks + 8 * hl);
            f32x16 acc[4];
#pragma unroll
            for (int mt = 0; mt < 4; ++mt) acc[mt] = f32x16{};
            const bf16* kb = SK + ((size_t)(h * 2 + p) * NKEYS + jl) * DKH + 8 * hl;
#pragma unroll
            for (int ks = 0; ks < 8; ++ks)
#pragma unroll
                for (int mt = 0; mt < 4; ++mt) { const bf16x8v af = *(const bf16x8v*)(kb + mt * 32 * DKH + ks * 16); acc[mt] = __builtin_amdgcn_mfma_f32_32x32x16_bf16(af, qf[ks], acc[mt], 0, 0, 0); }
            int v[64];
#pragma unroll
            for (int mt = 0; mt < 4; ++mt)
#pragma unroll
                for (int r = 0; r < 16; ++r) { const int n = 32 * mt + (r & 3) + 8 * (r >> 2) + 4 * hi; v[16 * mt + r] = (f2key(acc[mt][r]) & ~127) | (127 - n); }
            top16_of_64(v);
#pragma unroll
            for (int i = 0; i < 16; ++i) top[p][i] = v[i];
        }
        int S[32];
#pragma unroll
        for (int i = 0; i < 16; ++i) { auto rr = __builtin_amdgcn_permlane32_swap((unsigned)top[0][i], (unsigned)top[1][i], false, false); S[i] = (int)rr[0]; S[16 + i] = (int)rr[1]; }
        top16_merge<0, 16>(S);
        { unsigned w0 = 0, w1 = 0, w2 = 0, w3 = 0;
#pragma unroll
          for (int i = 0; i < 4; ++i) { w0 |= (unsigned)(127 - (S[i] & 127)) << (8 * i); w1 |= (unsigned)(127 - (S[4 + i] & 127)) << (8 * i); w2 |= (unsigned)(127 - (S[8 + i] & 127)) << (8 * i); w3 |= (unsigned)(127 - (S[12 + i] & 127)) << (8 * i); }
          *(LAS v4u*)(ib + (hi * 32 + j) * 4) = (v4u){w0, w1, w2, w3}; }
        float s1[16], s2[16];
#pragma unroll
        for (int i = 0; i < 16; ++i) { auto rr = __builtin_amdgcn_permlane32_swap((unsigned)S[i], (unsigned)S[i], false, false); s1[i] = key2f((int)rr[0] & ~127); s2[i] = key2f((int)rr[1] & ~127); }
        int c[64]; { int n = 0;
#pragma unroll
          for (int ca = 0; ca < 16; ++ca)
#pragma unroll
              for (int cb = 0; cb < 16; ++cb) if ((ca + 1) * (cb + 1) <= 16) { c[n] = (f2key(s1[ca] + s2[cb]) & ~255) | (255 - (ca * 16 + cb)); ++n; }
#pragma unroll
          for (int q = 50; q < 64; ++q) c[q] = (int)0x80000000; }
        top16_of_64(c);
        float ssq = 0.f;
#pragma unroll
        for (int q = 0; q < 4; ++q) { const f32x4 t4 = *(const f32x4*)(RSS + (size_t)(row0 + j) * 16 + 4 * q); ssq += (t4[0] + t4[1]) + (t4[2] + t4[3]); }
        const float rstd = 1.0f / sqrtf(ssq * (1.0f / DM) + EPS);
        const float z0 = key2f(c[0] & ~255) * rstd; float e[16], esum = 0.f;
#pragma unroll
        for (int k = 0; k < 16; ++k) { e[k] = __expf(key2f(c[k] & ~255) * rstd - z0); esum += e[k]; }
        const float inv = 1.0f / esum;
        LDS_WAIT(); asm volatile("" ::: "memory");
        const LAS unsigned char* ib8 = (const LAS unsigned char*)ib;
        int oi[8]; float og[8];
#pragma unroll
        for (int k = 0; k < 8; ++k) { const int ck = hi ? c[8 + k] : c[k]; const float ek = hi ? e[8 + k] : e[k]; const int fl = 255 - (ck & 255);
            const int i1 = ib8[(0 * 32 + j) * 16 + (fl >> 4)], i2 = ib8[(1 * 32 + j) * 16 + (fl & 15)]; oi[k] = i1 * NKEYS + i2; og[k] = ek * inv; }
        { int* sp = SI + (size_t)(row0 + j) * 128 + h * 16 + hi * 8; float* gp = SG + (size_t)(row0 + j) * 128 + h * 16 + hi * 8;
          *(v4u*)sp = (v4u){(unsigned)oi[0], (unsigned)oi[1], (unsigned)oi[2], (unsigned)oi[3]}; *(v4u*)(sp + 4) = (v4u){(unsigned)oi[4], (unsigned)oi[5], (unsigned)oi[6], (unsigned)oi[7]};
          *(f32x4*)gp = (f32x4){og[0], og[1], og[2], og[3]}; *(f32x4*)(gp + 4) = (f32x4){og[4], og[5], og[6], og[7]}; }
        LDS_WAIT(); asm volatile("" ::: "memory");
    }
}


constexpr int P8_TOK = 68, P8_Q = 9;
static_assert(M % P8_TOK == 0 && P8_TOK <= 8 * P8_Q, "P8 chunking");
typedef __bf16 bf16x2v __attribute__((ext_vector_type(2)));
__device__ __forceinline__ float dot2bf(unsigned w, unsigned x, float acc) { return __builtin_amdgcn_fdot2_f32_bf16(__builtin_bit_cast(bf16x2v, w), __builtin_bit_cast(bf16x2v, x), acc, false); }
__device__ __forceinline__ void p8_gather(Frame& F, const Args& a) {
    unsigned char* ws = a.ws;
    const bf16* HG = (const bf16*)(ws + WS_XN); const bf16* PU = (const bf16*)(ws + WS_PU); const bf16* PV = (const bf16*)(ws + WS_PV);
    const float* RSS = (const float*)(ws + WS_RSS); const int* SI = (const int*)(ws + WS_SI); const float* SG = (const float*)(ws + WS_SG); const float* Hh = (const float*)(ws + WS_H);
    float* Y = a.out + O_YP;
    LAS unsigned short* ix = (LAS unsigned short*)F.lds;
    LAS float* wt = (LAS float*)(F.lds + P8_TOK * 128 * 2);
    LAS float* rs = (LAS float*)(F.lds + P8_TOK * 128 * 2 + P8_TOK * 128 * 4);
    const int lane = F.lane, g = lane >> 2, c4 = lane & 3;
    for (int chunk = F.vcu; chunk < M / P8_TOK; chunk += F.G) {
        const int tb = chunk * P8_TOK;
        __syncthreads();
        for (int i = F.tid; i < P8_TOK * 128; i += NTHR) { ix[i] = (unsigned short)SI[(size_t)tb * 128 + i]; wt[i] = SG[(size_t)tb * 128 + i]; }
        if (F.tid < P8_TOK) { float s = 0.f; for (int k = 0; k < 16; ++k) s += RSS[(size_t)(tb + F.tid) * 16 + k]; rs[F.tid] = 1.0f / sqrtf(s * (1.0f / DM) + EPS); }
        __syncthreads();
        float acc[P8_Q][8];
#pragma unroll
        for (int q = 0; q < P8_Q; ++q)
#pragma unroll
            for (int i = 0; i < 8; ++i) acc[q][i] = 0.f;
        for (int s = 0; s < 16; ++s) {
            int cl = c4; asm volatile("" : "+v"(cl));
#pragma unroll
            for (int q = 0; q < P8_Q; ++q) { const int lt = F.wave + 8 * q; if (lt < P8_TOK) {
                const v4u ea = *(const LAS v4u*)(ix + lt * 128 + g * 8);
                const v4u h0 = *(const v4u*)(HG + (size_t)(tb + lt) * DM + 64 * s + 8 * cl), h1 = *(const v4u*)(HG + (size_t)(tb + lt) * DM + 64 * s + 32 + 8 * cl);
                const unsigned ew[4] = {ea.x, ea.y, ea.z, ea.w};
                v4u r0[8], r1[8];
#pragma unroll
                for (int i = 0; i < 8; ++i) { const unsigned e = (i & 1) ? (ew[i >> 1] >> 16) : (ew[i >> 1] & 0xffffu); const bf16* up = PU + (size_t)e * DM + 64 * s + 8 * cl;
                    r0[i] = *(const v4u*)up; r1[i] = *(const v4u*)(up + 32); }
#pragma unroll
                for (int i = 0; i < 8; ++i) { float d = acc[q][i];
                    d = dot2bf(r0[i].x, h0.x, d); d = dot2bf(r0[i].y, h0.y, d); d = dot2bf(r0[i].z, h0.z, d); d = dot2bf(r0[i].w, h0.w, d);
                    d = dot2bf(r1[i].x, h1.x, d); d = dot2bf(r1[i].y, h1.y, d); d = dot2bf(r1[i].z, h1.z, d); d = dot2bf(r1[i].w, h1.w, d); acc[q][i] = d; } } }
        }
#pragma unroll
        for (int q = 0; q < P8_Q; ++q) { const int lt = F.wave + 8 * q; if (lt < P8_TOK) {
            float v4[4], v2[2]; const bool b2 = (c4 & 2) != 0, b1 = (c4 & 1) != 0;
#pragma unroll
            for (int j2 = 0; j2 < 4; ++j2) { const float keep = b2 ? acc[q][4 + j2] : acc[q][j2], send = b2 ? acc[q][j2] : acc[q][4 + j2]; v4[j2] = keep + __shfl_xor(send, 2); }
#pragma unroll
            for (int j2 = 0; j2 < 2; ++j2) { const float keep = b1 ? v4[2 + j2] : v4[j2], send = b1 ? v4[j2] : v4[2 + j2]; v2[j2] = keep + __shfl_xor(send, 1); }
            const float r = rs[lt]; LAS float* wp = wt + lt * 128 + g * 8 + 2 * c4; const f32x2 gt = *(const LAS f32x2*)wp;
            const float z0 = v2[0] * r, z1 = v2[1] * r;
            const float a0 = 0.5f * z0 * (1.0f + erff(z0 * 0.70710678118654752f)), a1 = 0.5f * z1 * (1.0f + erff(z1 * 0.70710678118654752f));
            *(LAS f32x2*)wp = (f32x2){gt[0] * a0, gt[1] * a1}; } }
        LDS_WAIT(); asm volatile("" ::: "memory");
        for (int s = 0; s < 16; ++s) {
            int cl = c4; asm volatile("" : "+v"(cl));
#pragma unroll 1
            for (int q = 0; q < P8_Q; ++q) { const int lt = F.wave + 8 * q; if (lt < P8_TOK) {
                const v4u ea = *(const LAS v4u*)(ix + lt * 128 + g * 8);
                const unsigned ew[4] = {ea.x, ea.y, ea.z, ea.w};
                const f32x4 wa = *(const LAS f32x4*)(wt + lt * 128 + g * 8), wb = *(const LAS f32x4*)(wt + lt * 128 + g * 8 + 4);
                const float wv[8] = {wa[0], wa[1], wa[2], wa[3], wb[0], wb[1], wb[2], wb[3]};
                v4u r0[8], r1[8];
#pragma unroll
                for (int i = 0; i < 8; ++i) { const unsigned e = (i & 1) ? (ew[i >> 1] >> 16) : (ew[i >> 1] & 0xffffu); const bf16* vp = PV + (size_t)e * DM + 64 * s + 8 * cl;
                    r0[i] = *(const v4u*)vp; r1[i] = *(const v4u*)(vp + 32); }
                float o[16];
#pragma unroll
                for (int k = 0; k < 16; ++k) o[k] = 0.f;
#pragma unroll
                for (int i = 0; i < 8; ++i) { const float w = wv[i];
                    o[0] += w * bflo(r0[i].x); o[1] += w * bfhi(r0[i].x); o[2] += w * bflo(r0[i].y); o[3] += w * bfhi(r0[i].y); o[4] += w * bflo(r0[i].z); o[5] += w * bfhi(r0[i].z); o[6] += w * bflo(r0[i].w); o[7] += w * bfhi(r0[i].w);
                    o[8] += w * bflo(r1[i].x); o[9] += w * bfhi(r1[i].x); o[10] += w * bflo(r1[i].y); o[11] += w * bfhi(r1[i].y); o[12] += w * bflo(r1[i].z); o[13] += w * bfhi(r1[i].z); o[14] += w * bflo(r1[i].w); o[15] += w * bfhi(r1[i].w); }
                const bool b5 = (lane & 32) != 0, b4 = (lane & 16) != 0, b3 = (lane & 8) != 0, b2 = (lane & 4) != 0; float p8[8], p4[4], p2[2];
#pragma unroll
                for (int j2 = 0; j2 < 8; ++j2) { const float keep = b5 ? o[8 + j2] : o[j2], send = b5 ? o[j2] : o[8 + j2]; p8[j2] = keep + __shfl_xor(send, 32); }
#pragma unroll
                for (int j2 = 0; j2 < 4; ++j2) { const float keep = b4 ? p8[4 + j2] : p8[j2], send = b4 ? p8[j2] : p8[4 + j2]; p4[j2] = keep + __shfl_xor(send, 16); }
#pragma unroll
                for (int j2 = 0; j2 < 2; ++j2) { const float keep = b3 ? p4[2 + j2] : p4[j2], send = b3 ? p4[j2] : p4[2 + j2]; p2[j2] = keep + __shfl_xor(send, 8); }
                const float keep = b2 ? p2[1] : p2[0], send = b2 ? p2[0] : p2[1]; const float tot = keep + __shfl_xor(send, 4);
                const size_t off = (size_t)(tb + lt) * DM + 64 * s + 8 * cl + (b5 ? 32 : 0) + (b4 ? 4 : 0) + (b3 ? 2 : 0) + (b2 ? 1 : 0);
                Y[off] = Hh[off] + tot; } }
        }
    }
}


__device__ __forceinline__ void p3_sample_attn2(Frame& F, const Args& a, const float M2) {
    unsigned char* ws = a.ws;
    const bf16* Q = (const bf16*)(ws + WS_Q); bf16* AO = (bf16*)(ws + WS_AO);
    LAS float* D2 = (LAS float*)F.lds;
    LAS float* E2 = (LAS float*)(F.lds + 32768);
    LAS float* Pt = (LAS float*)(F.lds + 32768 + 128);
    LAS float* Op = (LAS float*)(F.lds + 32768 + 128 + 8192);
    LAS float* lp = (LAS float*)(F.lds + 32768 + 128 + 8192 + 16384);
    int lane = F.lane; asm volatile("" : "+v"(lane));
    const int w = F.wave, hh = w >> 1, kh = w & 1, n = lane & 31, hi = lane >> 5;
    LAS float* Pw = Pt + w * 256;
    for (int unit = F.vcu; unit < DB * 2; unit += F.G) {
        const int b = unit >> 1, h = 4 * (unit & 1) + hh;
        __syncthreads();
        for (int i = F.tid; i < 4 * PAST; i += NTHR) { const int hq = i >> 11, jk = i & (PAST - 1); const int pg = a.page_table[b * NPAGES + (jk >> 7)];
            D2[i] = a.cache_lf[((size_t)pg * PAGE + (jk & 127)) * NH + 4 * (unit & 1) + hq]; }
        __syncthreads();
        if (kh == 0) {
            LAS float* d = D2 + hh * PAST; float loc[32]; float tot = 0.f;
#pragma unroll
            for (int k = 31; k >= 0; --k) { loc[k] = tot; tot += d[lane * 32 + k]; }
            float inc = tot;
#pragma unroll
            for (int o = 1; o < 64; o <<= 1) { const float t = __shfl_down(inc, o); if (lane + o < 64) inc += t; }
            const float excl = inc - tot;
#pragma unroll
            for (int k = 0; k < 32; ++k) d[lane * 32 + k] = (loc[k] + excl) * LOG2E;
            if (lane < 8) { float e = 0.f; for (int t = 0; t <= lane; ++t) e += a.out[O_LFS + (size_t)(b * 8 + t) * NH + h]; E2[hh * 8 + lane] = e * LOG2E; }
        }
        __syncthreads();
        bf16x8v qa[4];
#pragma unroll
        for (int ks = 0; ks < 4; ++ks) { qa[ks] = bf16x8v{}; if (n < 8) qa[ks] = *(const bf16x8v*)(Q + (size_t)(MP + b * 8 + n) * DA + h * 64 + 16 * ks + 8 * hi); }
        float e2[4];
#pragma unroll
        for (int t = 0; t < 4; ++t) e2[t] = E2[hh * 8 + 4 * hi + t] - M2;
        float o[8], lsum[4];
#pragma unroll
        for (int t = 0; t < 8; ++t) o[t] = 0.f;
#pragma unroll
        for (int t = 0; t < 4; ++t) lsum[t] = 0.f;
        const LAS float* dh = D2 + hh * PAST;
        int nskip; { const float dl = dh[32 * lane + 31]; nskip = __builtin_popcountll(__ballot(dl < -(40.f + 2.f * M2))); }
        nskip = __builtin_amdgcn_readfirstlane(nskip);
        const int nblk = PAST / 32 - nskip, nb0 = nblk >> 1;
        const int blk_lo = nskip + (kh ? nb0 : 0), nit = kh ? (nblk - nb0) : nb0;
        f32x4 kq[8]; float vv[32];
#define S3_COMPUTE(it_, NEWK) do { f32x16 sacc = f32x16{}; \
            _Pragma("unroll") for (int ks = 0; ks < 4; ++ks) { const f32x4 x0_ = kq[2 * ks], x1_ = kq[2 * ks + 1]; v4u kb_; kb_.x = pkbf(x0_[0], x0_[1]); kb_.y = pkbf(x0_[2], x0_[3]); kb_.z = pkbf(x1_[0], x1_[1]); kb_.w = pkbf(x1_[2], x1_[3]); \
                sacc = __builtin_amdgcn_mfma_f32_32x32x16_bf16(qa[ks], __builtin_bit_cast(bf16x8v, kb_), sacc, 0, 0, 0); } \
            float p_[4]; \
            if (!(NEWK)) { const float dj_ = dh[(blk_lo + (it_)) * 32 + n]; _Pragma("unroll") for (int t = 0; t < 4; ++t) p_[t] = __builtin_amdgcn_exp2f(sacc[t] + e2[t] + dj_); } \
            else { const float ek_ = E2[hh * 8 + (n & 7)]; _Pragma("unroll") for (int t = 0; t < 4; ++t) p_[t] = (n <= 4 * hi + t) ? __builtin_amdgcn_exp2f(sacc[t] + e2[t] - ek_) : 0.f; } \
            _Pragma("unroll") for (int t = 0; t < 4; ++t) lsum[t] += p_[t]; \
            *(LAS f32x4*)(Pw + n * 8 + 4 * hi) = (f32x4){p_[0], p_[1], p_[2], p_[3]}; \
            LDS_WAIT(); asm volatile("" ::: "memory"); \
            _Pragma("unroll") for (int k_ = 0; k_ < ((NEWK) ? 8 : 32); ++k_) { const f32x4 pa_ = *(const LAS f32x4*)(Pw + k_ * 8), pb_ = *(const LAS f32x4*)(Pw + k_ * 8 + 4); const float v_ = vv[k_]; \
                o[0] += pa_[0] * v_; o[1] += pa_[1] * v_; o[2] += pa_[2] * v_; o[3] += pa_[3] * v_; o[4] += pb_[0] * v_; o[5] += pb_[1] * v_; o[6] += pb_[2] * v_; o[7] += pb_[3] * v_; } \
            LDS_WAIT(); asm volatile("" ::: "memory"); } while (0)
        for (int it = 0; it < nit; ++it) {
            const int j0 = (blk_lo + it) * 32; const int pg = a.page_table[b * NPAGES + (j0 >> 7)];
            const size_t rowoff = (((size_t)pg * PAGE + (j0 & 127)) * NH + h) * HD;
            const float* kr = a.cache_k + rowoff + (size_t)n * (NH * HD) + 8 * hi; const float* vb = a.cache_v + rowoff;
#pragma unroll
            for (int ks = 0; ks < 4; ++ks) { kq[2 * ks] = __builtin_nontemporal_load((const f32x4*)(kr + 16 * ks)); kq[2 * ks + 1] = __builtin_nontemporal_load((const f32x4*)(kr + 16 * ks + 4)); }
#pragma unroll
            for (int k = 0; k < 32; ++k) vv[k] = __builtin_nontemporal_load(vb + (size_t)k * (NH * HD) + lane);
            S3_COMPUTE(it, false);
        }
        if (kh == 1) {
            const float* kr = a.out + O_KS + (size_t)(b * 8 + (n & 7)) * DA + h * HD + 8 * hi; const float* vr = a.out + O_VS + (size_t)(b * 8) * DA + h * HD + lane;
#pragma unroll
            for (int ks = 0; ks < 4; ++ks) { kq[2 * ks] = *(const f32x4*)(kr + 16 * ks); kq[2 * ks + 1] = *(const f32x4*)(kr + 16 * ks + 4); }
#pragma unroll
            for (int k = 0; k < 8; ++k) vv[k] = vr[(size_t)k * DA];
            S3_COMPUTE(0, true);
        }
#undef S3_COMPUTE
#pragma unroll
        for (int t = 0; t < 4; ++t) { float s = lsum[t]; s += __shfl_xor(s, 1); s += __shfl_xor(s, 2); s += __shfl_xor(s, 4); s += __shfl_xor(s, 8); s += __shfl_xor(s, 16); if (n == 0) lp[w * 8 + 4 * hi + t] = s; }
#pragma unroll
        for (int t = 0; t < 8; ++t) Op[(w * 8 + t) * 64 + lane] = o[t];
        __syncthreads();
        for (int i = F.tid; i < 4 * 8 * 64; i += NTHR) { const int hq = i >> 9, t = (i >> 6) & 7, d = i & 63;
            const float O = Op[((2 * hq) * 8 + t) * 64 + d] + Op[((2 * hq + 1) * 8 + t) * 64 + d], L = lp[(2 * hq) * 8 + t] + lp[(2 * hq + 1) * 8 + t];
            AO[(size_t)(MP + b * 8 + t) * DA + (4 * (unit & 1) + hq) * 64 + d] = (bf16)(pkbf(O / L, 0.f) & 0xffffu); }
    }
}

constexpr int N_PHASES = 9;
#ifndef MK_PER_PHASE
#define MK_PER_PHASE 0
#endif
__global__ void __launch_bounds__(NTHR, 2) fwd_kernel(Args args) {
    extern __shared__ __attribute__((aligned(16))) unsigned char lds[];
    Frame F;
    F.lds = (LAS unsigned char*)lds; F.MISC = (volatile LAS unsigned*)(F.lds + MISC_OFF);
    F.tid = threadIdx.x; F.lane = F.tid & 63; F.wave = __builtin_amdgcn_readfirstlane(F.tid >> 6);
    F.G = gridDim.x; { const int bx = blockIdx.x; F.vcu = (F.G % 8 == 0) ? (bx % 8) * (F.G / 8) + bx / 8 : bx; }
    F.ctl = (gu32*)(args.ws + WS_CTL);
    for (int u = F.tid; u < (LDS_BYTES - MISC_OFF) / 4; u += NTHR) ((LAS unsigned*)(F.lds + MISC_OFF))[u] = 0u;
    __syncthreads();
#if MK_PER_PHASE
#define GRID_BAR() do { } while (0)
#else
    XcdBarrier bar = xcd_barrier_post((unsigned*)(F.ctl + CW_BAR), F.MISC + 8);
#define GRID_BAR() xcd_barrier(bar)
#endif
    unsigned char* ws = args.ws;
    const int lo = args.ph_lo, hi = args.ph_hi;
#ifndef DBG_REP_PHASE
#define DBG_REP_PHASE -1
#endif
#ifndef DBG_REP_N
#define DBG_REP_N 1
#endif
#define REPS(k) for (int rep_ = 0; rep_ < ((k) == DBG_REP_PHASE ? 1 + DBG_REP_N : 1); ++rep_)
#define IN(k) (lo <= (k) && (k) < hi)
#define BOTH(k) (IN(k) && IN((k) + 1))
#define ENDPH(k) do { if (BOTH(k) || (k) == DBG_REP_PHASE) GRID_BAR(); } while (0)
    if (IN(0)) REPS(0) { p0_prologue(F, args); ENDPH(0); }
    if (IN(1)) REPS(1) {
        pg8::Gemm g{(const bf16*)(ws + WS_XN), (const bf16*)(ws + WS_WIN), M, NPROJ, DM}; pg8::StaticOrder S; S.init(M, NPROJ, F.G, (int)blockIdx.x);
        EpiInProj E{(bf16*)(ws + WS_U), (bf16*)(ws + WS_Q), (bf16*)(ws + WS_K), (bf16*)(ws + WS_V), (bf16*)(ws + WS_GA), (bf16*)(ws + WS_GB), args.out, args.q_norm_g, args.k_norm_g};
        pg8::gemm_phase<EpiInProj, pg8::StaticOrder, true, true>(F.lds, g, S, E);
        ENDPH(1);
    }
    if (IN(2)) REPS(2) { p2_cumsum_pool(F, args); ENDPH(2); }
    if (IN(3)) {
        const float M2 = __builtin_bit_cast(float, __builtin_amdgcn_readfirstlane(__builtin_bit_cast(int, attn_bound2(args, F.lane))));
#if !defined(DBG_SKIP_PATTN)
        { const attn_body::AttnTensors AT{(const attn_body::bf16*)(ws + WS_Q), (const attn_body::bf16*)(ws + WS_K), (const attn_body::bf16*)(ws + WS_V), (attn_body::bf16*)(ws + WS_AO), (const float*)(ws + WS_CP2), M2};
          const attn_body::StaticOrder S((int)F.G, F.vcu);
          attn_body::attn_phase<attn_body::StaticOrder>((char*)lds, AT, S); }
#endif
#ifdef P3S_OLD
        REPS(3) { p3_sample_attn(F, args, M2); }
#else
        REPS(3) { p3_sample_attn2(F, args, M2); }
#endif
        ENDPH(3); }
    if (IN(4)) REPS(4) {
        { pg8::Gemm g{(const bf16*)(ws + WS_PO), (const bf16*)(ws + WS_WBP), M, DM, DP}; pg8::StaticOrder S; S.init(M, DM, F.G, (int)blockIdx.x);
          EpiGate<0> E{(const bf16*)(ws + WS_GA), nullptr, (bf16*)(ws + WS_T)};
          pg8::gemm_phase<EpiGate<0>, pg8::StaticOrder, true, true>(F.lds, g, S, E); }
        __syncthreads();
        { pg8::Gemm g{(const bf16*)(ws + WS_AO), (const bf16*)(ws + WS_WBA), M, DM, DA}; pg8::StaticOrder S; S.init(M, DM, F.G, (int)blockIdx.x);
          EpiGate<1> E{(const bf16*)(ws + WS_GB), (const bf16*)(ws + WS_T), (bf16*)(ws + WS_MIX)};
          pg8::gemm_phase<EpiGate<1>, pg8::StaticOrder, true, true>(F.lds, g, S, E); }
        ENDPH(4);
    }
    if (IN(5)) REPS(5) {
        pg8::Gemm g{(const bf16*)(ws + WS_MIX), (const bf16*)(ws + WS_WOUT), M, DM, DM}; pg8::StaticOrder S; S.init(M, DM, F.G, (int)blockIdx.x);
        EpiOut E{args.x_p, args.x_s, (float*)(ws + WS_H), (bf16*)(ws + WS_XN), args.norm_ffn_g, (float*)(ws + WS_RSS)};
        pg8::gemm_phase<EpiOut, pg8::StaticOrder, true, true>(F.lds, g, S, E);
        ENDPH(5);
    }
    if (IN(6)) REPS(6) {
        pg8::Gemm g{(const bf16*)(ws + WS_XN), (const bf16*)(ws + WS_WQ), M, DQ, DM}; pg8::StaticOrder S; S.init(M, DQ, F.G, (int)blockIdx.x);
        pg8::EpiBf16<0> E{(bf16*)(ws + WS_PQ), DQ, nullptr, 0, 0, 1.f};
        pg8::gemm_phase<pg8::EpiBf16<0>, pg8::StaticOrder, true, true>(F.lds, g, S, E);
        ENDPH(6);
    }
#ifdef P7_NAIVE
    if (IN(7)) REPS(7) { p7_topk_naive(F, args); ENDPH(7); }
#else
    if (IN(7)) REPS(7) { p7_topk(F, args); ENDPH(7); }
#endif
#ifdef P8_NAIVE
    if (IN(8)) REPS(8) { p8_gather_naive(F, args); ENDPH(8); }
#else
    if (IN(8)) REPS(8) { p8_gather(F, args); ENDPH(8); }
#endif
#ifdef DBG_DUMP
    if (IN(9)) { const bf16* AO = (const bf16*)(ws + WS_AO); const bf16* PO = (const bf16*)(ws + WS_PO); const bf16* MX = (const bf16*)(ws + (DBG_DUMP == 3 ? WS_T : DBG_DUMP == 4 ? WS_GA : WS_MIX));
        for (size_t i = (size_t)blockIdx.x * NTHR + F.tid; i < (size_t)M * DM; i += (size_t)F.G * NTHR) { const int row = (int)(i >> 10), c = (int)(i & 1023);
            float v; if (DBG_DUMP == 1) v = c < 512 ? bf2f(AO[(size_t)row * DA + c]) : bf2f(PO[(size_t)row * DP + c - 512]); else v = bf2f(MX[i]);
            args.out[O_YP + i] = v; } }
#endif
#undef IN
#undef BOTH
}

extern "C" void kernel_launch(void* const* d_in, const int* in_sizes, int n_in, void* d_out, int out_size, void* d_ws, size_t ws_size, hipStream_t stream) {
    static int grid = 0;
    if (grid == 0) {
        if (n_in != 22 || (size_t)out_size != O_END || ws_size < WS_END) { fprintf(stderr, "kernel_launch: unexpected shapes (n_in %d out %d ws %zu)\n", n_in, out_size, ws_size); grid = -1; return; }
        int dev = 0, cus = 0, per_cu = 0;
        if (hipGetDevice(&dev) != hipSuccess || hipDeviceGetAttribute(&cus, hipDeviceAttributeMultiprocessorCount, dev) != hipSuccess) { grid = -1; return; }
        if (hipFuncSetAttribute((const void*)fwd_kernel, hipFuncAttributeMaxDynamicSharedMemorySize, LDS_BYTES) != hipSuccess) { fprintf(stderr, "kernel_launch: hipFuncSetAttribute failed\n"); grid = -1; return; }
        if (hipOccupancyMaxActiveBlocksPerMultiprocessor(&per_cu, (const void*)fwd_kernel, NTHR, LDS_BYTES) != hipSuccess || per_cu < 1) fprintf(stderr, "kernel_launch: occupancy query reports %d\n", per_cu);
        (void)hipGetLastError();
        grid = cus;
    }
    if (grid < 0) return;
    if (hipMemsetAsync((char*)d_ws + WS_CTL, 0, CTL_ZERO_BYTES, stream) != hipSuccess) return;
    Args a{};
    a.x_p = (const float*)d_in[0]; a.x_s = (const float*)d_in[1]; a.cache_k = (const float*)d_in[2]; a.cache_v = (const float*)d_in[3]; a.cache_lf = (const float*)d_in[4];
    a.state_pool = (const float*)d_in[5]; a.page_table = (const int*)d_in[6]; a.norm_mix_g = (const float*)d_in[7]; a.w_in = (const float*)d_in[8]; a.b_forget = (const float*)d_in[9];
    a.q_norm_g = (const float*)d_in[10]; a.k_norm_g = (const float*)d_in[11]; a.pool_mix_w = (const float*)d_in[12]; a.pool_scale = (const float*)d_in[13]; a.w_bp = (const float*)d_in[14];
    a.w_ba = (const float*)d_in[15]; a.w_out = (const float*)d_in[16]; a.norm_ffn_g = (const float*)d_in[17]; a.w_query = (const float*)d_in[18]; a.sub_keys = (const float*)d_in[19];
    a.peer_u = (const float*)d_in[20]; a.peer_v = (const float*)d_in[21];
    a.out = (float*)d_out; a.ws = (unsigned char*)d_ws; a.pad = 0;
#if MK_PER_PHASE
#ifndef DBG_NPH
#define DBG_NPH N_PHASES
#endif
    for (int ph = 0; ph < DBG_NPH; ++ph) { a.ph_lo = ph; a.ph_hi = ph + 1; a.li = ph; hipLaunchKernelGGL(fwd_kernel, dim3(grid), dim3(NTHR), LDS_BYTES, stream, a); }
#ifdef DBG_DUMP
    a.ph_lo = 9; a.ph_hi = 10; a.li = 9; hipLaunchKernelGGL(fwd_kernel, dim3(grid), dim3(NTHR), LDS_BYTES, stream, a);
#endif
#else
    a.ph_lo = 0; a.ph_hi = N_PHASES; a.li = 0; hipLaunchKernelGGL(fwd_kernel, dim3(grid), dim3(NTHR), LDS_BYTES, stream, a);
#endif
}
```

```cpp
#include <hip/hip_runtime.h>
#include <cstdio>
#include <cstdint>
#include <cmath>
namespace pg8 {
#define PG8_LAS __attribute__((address_space(3)))
typedef unsigned short bf16_t;
typedef short bf16x8 __attribute__((ext_vector_type(8)));
typedef float f32x4 __attribute__((ext_vector_type(4)));
typedef unsigned u32x4 __attribute__((ext_vector_type(4)));
constexpr int BM = 256, BK = 64, HALF = 128, HTB = HALF * BK * 2  , STAGE_BYTES = 8 * HTB, NXCD = 8, WGM = 8;

__host__ __device__ __forceinline__ int lds_byte(int r, int c) { const int st = (r >> 4) * 2 + (c >> 5), rr = r & 15, cc = c & 31, ob = rr * 64 + cc * 2; return st * 1024 + (ob ^ (((ob >> 9) & 1) << 5)); }
__host__ __device__ __forceinline__ void stage_rc(int b, int& R, int& C) { const int st = b / 1024, sb = b % 1024, swz = sb ^ (((sb >> 9) & 1) << 5); R = (st >> 1) * 16 + swz / 64; C = (st & 1) * 32 + (swz % 64) / 2; }
__host__ __device__ __forceinline__ int perm32(int rho) { const int n = rho >> 4, i = rho & 15; return 8 * (i >> 2) + 4 * n + (i & 3); }

struct Unit { int pm, pn; };
struct Gemm { const bf16_t* A; const bf16_t* Bt; int M, N, K; };

struct StaticOrder {
    int nM, nN, nwg, G, c;
    __host__ __device__ void init(int M, int N, int G_, int c_) { nM = M / BM; nN = N / BM; nwg = nM * nN; G = G_; c = c_; }
    __host__ __device__ bool next(int i, Unit& u) const {
        const long L = (long)i * G + c; if (L >= nwg) return false;
        int wgid = (int)L; { const int q = nwg / NXCD, r = nwg % NXCD, xcd = wgid % NXCD, off = wgid / NXCD; wgid = (xcd < r ? xcd * (q + 1) : r * (q + 1) + (xcd - r) * q) + off; }
        const int nig = WGM * nN, gid = wgid / nig, fm = gid * WGM, gsz = (nM - fm) < WGM ? (nM - fm) : WGM;
        u.pm = fm + ((wgid % nig) % gsz); u.pn = (wgid % nig) / gsz; return true;
    }
    __device__ __forceinline__ void a_ready(const Unit&) const {}
    __device__ __forceinline__ void done(const Unit&) const {}
};

typedef float f32x2c __attribute__((ext_vector_type(2))); typedef __bf16 bf16x2c __attribute__((ext_vector_type(2)));
__device__ __forceinline__ unsigned cvt_pk_bf16(float lo, float hi) { f32x2c v = {lo, hi}; bf16x2c b = __builtin_convertvector(v, bf16x2c); return __builtin_bit_cast(unsigned, b); }
typedef float f32x2 __attribute__((ext_vector_type(2)));
__device__ __forceinline__ f32x2 gelu_pk(f32x2 v) {
    const f32x2 av = __builtin_elementwise_abs(v), d = av * 0.2316418882f + 1.0f;
    f32x2 t; t.x = __builtin_amdgcn_rcpf(d.x); t.y = __builtin_amdgcn_rcpf(d.y);
    f32x2 q = t * 0.5307027145f + (-0.7265760135f); q = q * t + 0.7107068705f; q = q * t + (-0.142248368f); q = q * t + 0.127414796f; q = q * t;
    const f32x2 s = (v * v) * (-0.72134752044f);
    f32x2 e; e.x = __builtin_amdgcn_exp2f(s.x); e.y = __builtin_amdgcn_exp2f(s.y);
    const f32x2 m = v * (q * e), r = v - m;
    f32x2 o; o.x = v.x < 0.f ? m.x : r.x; o.y = v.y < 0.f ? m.y : r.y; return o;
}

template <int ACT  > struct EpiBf16 {
    static constexpr bool PERM = true, AFTER_DRAIN = false; static_assert(ACT == 0 || ACT == 1, "EpiBf16: ACT is 0 (none) or 1 (gelu_pk)");
    bf16_t* O; int ldc; const float* bias; int split_cols; size_t split_stride; float scale0;
    __device__ __forceinline__ void operator()(const f32x4 (&acc)[2][2][4][2], const Unit& u, int wr, int wc, int fr, int fq) const {
        const int row0 = u.pm * BM + wr * 64 + fr; int colt = u.pn * BM; bf16_t* base = O;
        float sc = 1.f; if (split_cols) { const int t = colt / split_cols; base += (size_t)t * split_stride; colt -= t * split_cols; if (t == 0) sc = scale0; }
        const int col0 = colt + wc * 32 + 8 * fq, bcol0 = u.pn * BM + wc * 32 + 8 * fq;
        f32x4 bv[2][2];
#pragma unroll
        for (int bj = 0; bj < 2; ++bj)
#pragma unroll
            for (int n = 0; n < 2; ++n) bv[bj][n] = bias ? *(const f32x4*)(bias + bcol0 + bj * HALF + 4 * n) : (f32x4){0.f, 0.f, 0.f, 0.f};
#pragma unroll
        for (int ai = 0; ai < 2; ++ai)
#pragma unroll
            for (int m = 0; m < 4; ++m) { bf16_t* rowp = base + (size_t)(row0 + ai * HALF + m * 16) * ldc + col0;
#pragma unroll
                for (int bj = 0; bj < 2; ++bj) { f32x4 v0 = acc[ai][bj][m][0] + bv[bj][0], v1 = acc[ai][bj][m][1] + bv[bj][1];
                    if (ACT == 1) { f32x2 a = gelu_pk((f32x2){v0[0], v0[1]}), b = gelu_pk((f32x2){v0[2], v0[3]}), c = gelu_pk((f32x2){v1[0], v1[1]}), d = gelu_pk((f32x2){v1[2], v1[3]});
                        v0 = (f32x4){a.x, a.y, b.x, b.y}; v1 = (f32x4){c.x, c.y, d.x, d.y}; }
                    v0 = v0 * sc; v1 = v1 * sc; u32x4 w; w.x = cvt_pk_bf16(v0[0], v0[1]); w.y = cvt_pk_bf16(v0[2], v0[3]); w.z = cvt_pk_bf16(v1[0], v1[1]); w.w = cvt_pk_bf16(v1[2], v1[3]);
                    *(u32x4*)(rowp + bj * HALF) = w; } }
    }
};
template <class Epi, class Sched, bool ALIGN_EPI = false, bool SP2 = false>
__device__ __forceinline__ void gemm_phase(PG8_LAS unsigned char* lds, const Gemm g, const Sched& S, const Epi& E) {
    int tid = threadIdx.x; asm volatile("" : "+v"(tid));
    const int wid = __builtin_amdgcn_readfirstlane(tid >> 6), lane = tid & 63, wr = wid >> 2, wc = wid & 3, fr = lane & 15, fq = lane >> 4;
    const int K = g.K, nt = K / BK;
    unsigned voffA[2], voffB[2];
#pragma unroll
    for (int i = 0; i < 2; ++i) { int R, C; stage_rc(tid * 16 + i * 8192, R, C); const int Rb = Epi::PERM ? ((R & ~31) + perm32(R & 31)) : R;
        voffA[i] = (unsigned)(R * K + C) * 2u; voffB[i] = (unsigned)(Rb * K + C) * 2u; }
    const size_t kstep = (size_t)(BK * 2);
    const size_t hstep = (size_t)HALF * K * 2;
    const size_t tstep = 2 * hstep;
    const unsigned ldsw = (unsigned)wid * 1024u;
    const int aoff = lds_byte(wr * 64 + fr, fq * 8), boff = lds_byte(wc * 32 + fr, fq * 8);
#define PG8_SA(b, h) (((b) * 2 + (h)) * HTB)
#define PG8_SB(b, h) ((4 + (b) * 2 + (h)) * HTB)
#define PG8_STAGE(bufoff, gbase, voff) do { _Pragma("unroll") for (int _i = 0; _i < 2; ++_i) \
        __builtin_amdgcn_global_load_lds((const unsigned*)((const char*)(gbase) + (voff)[_i]), (PG8_LAS unsigned*)(lds + (bufoff) + ldsw + _i * 8192), 16, 0, 0); } while (0)
#define PG8_LDA(dst, b, h) do { _Pragma("unroll") for (int m = 0; m < 4; ++m) _Pragma("unroll") for (int k = 0; k < 2; ++k) dst[m][k] = *(const PG8_LAS bf16x8*)(lds + PG8_SA(b, h) + aoff + m * 2048 + k * 1024); } while (0)
#define PG8_LDB(dst, b, h) do { _Pragma("unroll") for (int n = 0; n < 2; ++n) _Pragma("unroll") for (int k = 0; k < 2; ++k) dst[n][k] = *(const PG8_LAS bf16x8*)(lds + PG8_SB(b, h) + boff + n * 2048 + k * 1024); } while (0)
#define PG8_MMA(ai, bj, At, Bt) do { __builtin_amdgcn_s_setprio(1); _Pragma("unroll") for (int m = 0; m < 4; ++m) _Pragma("unroll") for (int n = 0; n < 2; ++n) _Pragma("unroll") for (int k = 0; k < 2; ++k) \
        acc[ai][bj][m][n] = __builtin_amdgcn_mfma_f32_16x16x32_bf16(Bt[n][k], At[m][k], acc[ai][bj][m][n], 0, 0, 0); __builtin_amdgcn_s_setprio(0); } while (0)
#define PG8_WAIT_V(n) asm volatile("s_waitcnt vmcnt(" #n ")" ::: "memory")
#define PG8_WAIT_L(n) asm volatile("s_waitcnt lgkmcnt(" #n ")" ::: "memory")
#define PG8_BAR __builtin_amdgcn_s_barrier()
#define PG8_SCHED __builtin_amdgcn_sched_barrier(0)
    Unit cur, nxt; int ui = 0;
    if (!S.next(0, cur)) return;
    f32x4 acc[2][2][4][2];
#pragma unroll
    for (int a = 0; a < 2; ++a)
#pragma unroll
        for (int b = 0; b < 2; ++b)
#pragma unroll
            for (int m = 0; m < 4; ++m)
#pragma unroll
                for (int n = 0; n < 2; ++n) acc[a][b][m][n] = (f32x4){0.f, 0.f, 0.f, 0.f};
    bf16x8 At[4][2], B0[2][2], B1[2][2];
    const char* cA = (const char*)g.A + (size_t)cur.pm * tstep; const char* cB = (const char*)g.Bt + (size_t)cur.pn * tstep;
    S.a_ready(cur);
    if constexpr (SP2) {
        PG8_STAGE(PG8_SB(0, 0), cB, voffB); PG8_STAGE(PG8_SB(0, 1), cB + hstep, voffB); PG8_STAGE(PG8_SA(0, 0), cA, voffA); PG8_STAGE(PG8_SA(0, 1), cA + hstep, voffA);
        if (wr == 1) PG8_BAR;
        PG8_WAIT_V(2); PG8_BAR;
        PG8_STAGE(PG8_SB(1, 0), cB + kstep, voffB); PG8_STAGE(PG8_SA(1, 0), cA + kstep, voffA); PG8_STAGE(PG8_SB(1, 1), cB + hstep + kstep, voffB);
        PG8_WAIT_V(6); PG8_BAR;
    } else {
        PG8_STAGE(PG8_SB(0, 0), cB, voffB); PG8_STAGE(PG8_SA(0, 0), cA, voffA); PG8_STAGE(PG8_SB(0, 1), cB + hstep, voffB); PG8_STAGE(PG8_SA(0, 1), cA + hstep, voffA);
        if (wr == 1) PG8_BAR;
        PG8_WAIT_V(4); PG8_BAR;
        PG8_STAGE(PG8_SB(1, 0), cB + kstep, voffB); PG8_STAGE(PG8_SA(1, 0), cA + kstep, voffA); PG8_STAGE(PG8_SB(1, 1), cB + hstep + kstep, voffB);
        PG8_WAIT_V(6); PG8_BAR;
    }
    for (;;) {
        const bool has_next = S.next(ui + 1, nxt);
        const char* nA = has_next ? (const char*)g.A + (size_t)nxt.pm * tstep : cA; const char* nB = has_next ? (const char*)g.Bt + (size_t)nxt.pn * tstep : cB;
        for (int t = 0; t < nt; t += 2) {
            const bool last = (t == nt - 2);
            const char* a1 = cA + (size_t)(t + 1) * kstep;
            const char* a2 = last ? nA : cA + (size_t)(t + 2) * kstep; const char* b2 = last ? nB : cB + (size_t)(t + 2) * kstep;
            const char* a3 = a2 + kstep; const char* b3 = b2 + kstep;
            if (last && has_next) S.a_ready(nxt);
            if constexpr (SP2) {
            PG8_LDB(B0, 0, 0); PG8_LDB(B1, 0, 1); PG8_SCHED; PG8_LDA(At, 0, 0); PG8_STAGE(PG8_SA(1, 1), a1 + hstep, voffA);
            PG8_WAIT_V(8); PG8_WAIT_L(0); PG8_BAR; PG8_MMA(0, 0, At, B0); PG8_MMA(0, 1, At, B1); PG8_BAR; PG8_SCHED;
            PG8_LDA(At, 0, 1); PG8_STAGE(PG8_SB(0, 0), b2, voffB); PG8_STAGE(PG8_SB(0, 1), b2 + hstep, voffB); PG8_STAGE(PG8_SA(0, 0), a2, voffA);
            PG8_WAIT_V(8); PG8_WAIT_L(0); PG8_BAR; PG8_MMA(1, 0, At, B0); PG8_MMA(1, 1, At, B1); PG8_BAR; PG8_SCHED;
            PG8_LDB(B0, 1, 0); PG8_LDB(B1, 1, 1); PG8_SCHED; PG8_LDA(At, 1, 0); PG8_STAGE(PG8_SA(0, 1), a2 + hstep, voffA);
            PG8_WAIT_V(8); PG8_WAIT_L(0); PG8_BAR; PG8_MMA(0, 0, At, B0); PG8_MMA(0, 1, At, B1); PG8_BAR; PG8_SCHED;
            PG8_LDA(At, 1, 1); PG8_STAGE(PG8_SB(1, 0), b3, voffB); PG8_STAGE(PG8_SB(1, 1), b3 + hstep, voffB); PG8_STAGE(PG8_SA(1, 0), a3, voffA);
            PG8_WAIT_V(8); PG8_WAIT_L(0); PG8_BAR; PG8_MMA(1, 0, At, B0); PG8_MMA(1, 1, At, B1); PG8_BAR; PG8_SCHED;
            } else {
            PG8_LDB(B0, 0, 0); PG8_SCHED; PG8_LDA(At, 0, 0); PG8_STAGE(PG8_SA(1, 1), a1 + hstep, voffA);
            PG8_WAIT_L(8); PG8_BAR; PG8_WAIT_L(0); PG8_MMA(0, 0, At, B0); PG8_BAR; PG8_SCHED;
            PG8_LDB(B1, 0, 1); PG8_STAGE(PG8_SB(0, 0), b2, voffB);
            PG8_BAR; PG8_WAIT_L(0); PG8_MMA(0, 1, At, B1); PG8_BAR;
            PG8_LDA(At, 0, 1); PG8_STAGE(PG8_SA(0, 0), a2, voffA);
            PG8_BAR; PG8_WAIT_L(0); PG8_MMA(1, 0, At, B0); PG8_BAR; PG8_SCHED;
            PG8_STAGE(PG8_SB(0, 1), b2 + hstep, voffB);
            PG8_WAIT_V(6); PG8_BAR; PG8_MMA(1, 1, At, B1); PG8_BAR;
            PG8_LDB(B0, 1, 0); PG8_SCHED; PG8_LDA(At, 1, 0); PG8_STAGE(PG8_SA(0, 1), a2 + hstep, voffA);
            PG8_WAIT_L(8); PG8_BAR; PG8_WAIT_L(0); PG8_MMA(0, 0, At, B0); PG8_BAR; PG8_SCHED;
            PG8_LDB(B1, 1, 1); PG8_STAGE(PG8_SB(1, 0), b3, voffB);
            PG8_BAR; PG8_WAIT_L(0); PG8_MMA(0, 1, At, B1); PG8_BAR;
            PG8_LDA(At, 1, 1); PG8_STAGE(PG8_SA(1, 0), a3, voffA);
            PG8_BAR; PG8_WAIT_L(0); PG8_MMA(1, 0, At, B0); PG8_BAR; PG8_SCHED;
            PG8_STAGE(PG8_SB(1, 1), b3 + hstep, voffB);
            PG8_WAIT_V(6); PG8_BAR; PG8_MMA(1, 1, At, B1); PG8_BAR;
            }
        }
        if constexpr (ALIGN_EPI) { if (wr == 0) PG8_BAR; }
        if constexpr (!Epi::AFTER_DRAIN) { E(acc, cur, wr, wc, fr, fq); S.done(cur); }
        if (!has_next) break;
#pragma unroll
        for (int a = 0; a < 2; ++a)
#pragma unroll
            for (int b = 0; b < 2; ++b)
#pragma unroll
                for (int m = 0; m < 4; ++m)
#pragma unroll
                    for (int n = 0; n < 2; ++n) acc[a][b][m][n] = (f32x4){0.f, 0.f, 0.f, 0.f};
        cur = nxt; cA = nA; cB = nB; ++ui;
        if constexpr (ALIGN_EPI) { if (wr == 1) PG8_BAR; }
    }
    PG8_WAIT_V(0);
    if constexpr (!ALIGN_EPI) { if (wr == 0) PG8_BAR; }
    PG8_BAR;
    if constexpr (Epi::AFTER_DRAIN) { E.fused(acc, cur, wr, wc, fr, fq, lds, wid, lane); S.done(cur); }
#undef PG8_SA
#undef PG8_SB
#undef PG8_STAGE
#undef PG8_LDA
#undef PG8_LDB
#undef PG8_MMA
#undef PG8_WAIT_V
#undef PG8_WAIT_L
#undef PG8_BAR
#undef PG8_SCHED
}
}
#define GAS __attribute__((address_space(1)))
#define LAS __attribute__((address_space(3)))
typedef unsigned short bf16;
typedef unsigned v4u __attribute__((ext_vector_type(4)));
typedef float f32x4 __attribute__((ext_vector_type(4)));
typedef short bf16x8 __attribute__((ext_vector_type(8)));
typedef GAS unsigned gu32;
typedef GAS unsigned long long gu64;
#define RLX_AGENT __ATOMIC_RELAXED, __HIP_MEMORY_SCOPE_AGENT
#define LDS_WAIT() asm volatile("s_waitcnt lgkmcnt(0)" ::: "memory")
#define VM_WAIT() asm volatile("s_waitcnt vmcnt(0)" ::: "memory")
__device__ __forceinline__ unsigned long long rt() { return __builtin_amdgcn_s_memrealtime(); }
__device__ __forceinline__ unsigned f2bf(float f) { unsigned u = __builtin_bit_cast(unsigned, f); return (u + 0x7fffu + ((u >> 16) & 1u)) >> 16; }
__device__ __forceinline__ unsigned pk2(float lo, float hi) { return f2bf(lo) | (f2bf(hi) << 16); }

#define XB_TMO      128
#define XB_XCNT(j)  (256  + 64 * (j))
#define XB_XSUB(j)  (1280 + 64 * (j))
#define XB_XGEN(j)  (2304 + 64 * (j))
#define XB_TOP      3328
#define XB_TOPGEN   3392
#define XCD_BAR_WORDS 3456
#define XB_SPIN_CAP (1u << 18)

__device__ __forceinline__ unsigned xb_ld(unsigned* p)              { return __hip_atomic_load(p, __ATOMIC_RELAXED, __HIP_MEMORY_SCOPE_AGENT); }
__device__ __forceinline__ unsigned xb_add(unsigned* p, unsigned v) { return __hip_atomic_fetch_add(p, v, __ATOMIC_RELAXED, __HIP_MEMORY_SCOPE_AGENT); }
__device__ __forceinline__ unsigned xb_xcc_id() { return (unsigned)__builtin_amdgcn_s_getreg((3 << 11) | 20) & 0xFu; }
#define XB_SPIN(cond, bar) do { unsigned _sp = 0; while (cond) { __builtin_amdgcn_s_sleep(1); \
    if ((++_sp & 255u) == 0u) { if (xb_ld(&(bar)[XB_TMO])) break; if (_sp > XB_SPIN_CAP) { atomicAdd(&(bar)[XB_TMO], 1u); break; } } } } while (0)

struct XcdBarrier {
    unsigned* bar; unsigned x;
    volatile LAS unsigned* st;
};

__device__ __forceinline__ XcdBarrier xcd_barrier_post(unsigned* bar, volatile LAS unsigned* st) {
    XcdBarrier b; b.bar = bar; b.x = xb_xcc_id(); b.st = st;
    if (threadIdx.x == 0) (void)xb_add(&bar[XB_XCNT(b.x)], 1u);
    return b;
}
__device__ __forceinline__ void xcd_barrier_complete(unsigned* bar, unsigned x, unsigned& nloc, unsigned& nx) {
    const unsigned G = gridDim.x * gridDim.y * gridDim.z;
    unsigned sum, cnt, mine, sp = 0u;
    for (;;) {
        sum = 0u; cnt = 0u; mine = 0u;
#pragma unroll
        for (unsigned j = 0; j < 16; ++j) { const unsigned c = xb_ld(&bar[XB_XCNT(j)]); sum += c; cnt += (c > 0u) ? 1u : 0u; mine = (j == x) ? c : mine; }
        if (sum == G) break;
        __builtin_amdgcn_s_sleep(1);
        if ((++sp & 255u) == 0u) { if (xb_ld(&bar[XB_TMO])) break; if (sp > XB_SPIN_CAP) { atomicAdd(&bar[XB_TMO], 1u); break; } }
    }
    nloc = mine > 0u ? mine : 1u; nx = cnt > 0u ? cnt : 1u;
}

__device__ __forceinline__ void xcd_barrier(const XcdBarrier& b) {
    asm volatile("s_waitcnt vmcnt(0)" ::: "memory");
    __syncthreads();
    if (threadIdx.x == 0) {
        unsigned* bar = b.bar;
        __builtin_amdgcn_s_waitcnt(0);
        unsigned nloc = b.st[0], nx = b.st[1];
        if (nloc == 0u) { xcd_barrier_complete(bar, b.x, nloc, nx); b.st[0] = nloc; b.st[1] = nx; }
        const unsigned old = xb_add(&bar[XB_XSUB(b.x)], 1u);
        const unsigned gen = old / nloc;
        if (old + 1u == (gen + 1u) * nloc) {
            __builtin_amdgcn_fence(__ATOMIC_RELEASE, "agent");
            asm volatile("s_waitcnt vmcnt(0)" ::: "memory");
            const unsigned og = xb_add(&bar[XB_TOP], 1u);
            const unsigned tg = og / nx;
            if (og + 1u == (tg + 1u) * nx) xb_add(&bar[XB_TOPGEN], 1u);
            else XB_SPIN(xb_ld(&bar[XB_TOPGEN]) == tg, bar);
            __builtin_amdgcn_fence(__ATOMIC_ACQUIRE, "agent");
            xb_add(&bar[XB_XGEN(b.x)], 1u);
            asm volatile("s_waitcnt vmcnt(0)" ::: "memory");
        } else {
            XB_SPIN(xb_ld(&bar[XB_XGEN(b.x)]) == gen, bar);
            __builtin_amdgcn_fence(__ATOMIC_ACQUIRE, "agent");
            asm volatile("s_waitcnt vmcnt(0)" ::: "memory");
        }
    }
    __syncthreads();
}
#include <hip/hip_bf16.h>
#include <cmath>
namespace attn_body {
using bf16=__hip_bfloat16;
using bf16x8=__attribute__((ext_vector_type(8)))short;
using s16x4=__attribute__((ext_vector_type(4)))short;
using f32x16=__attribute__((ext_vector_type(16)))float;
using u32x4=__attribute__((ext_vector_type(4)))unsigned;
constexpr int BATCH=4,NHEAD=8,SEQ=4096,D=64,DM=NHEAD*D;
constexpr int NW=8,QBLK=32,QB=QBLK*NW,KVBLK=64,NQB=SEQ/QB;
constexpr int ATTN_PITCH=DM, ATTN_UNIT_ROWS=QB;
__device__ __forceinline__ int crow(int r,int hi){return (r&3)+8*(r>>2)+4*hi;}
#define SBAR() __builtin_amdgcn_sched_barrier(0)
__device__ __forceinline__ void cmask(f32x16&p0,f32x16&p1,int jb,int qrel,int hi){
  const float NEG=-INFINITY; int kb=64*jb+4*hi;
  #pragma unroll
  for(int r=0;r<16;++r){int kv=kb+(r&3)+8*(r>>2); if(kv>qrel)p0[r]=NEG; if(kv+32>qrel)p1[r]=NEG;}
}

constexpr int NSLOT=3, SLOTB=8192;
constexpr int LDS_K=0, LDS_V=NSLOT*SLOTB, LDS_WS=2*NSLOT*SLOTB, LDS_OST=LDS_WS+NW*64*4, LDS_CK=LDS_OST+NW*4096, LDS_BYTES=LDS_CK+SEQ*4;
constexpr float C2=0.125f*1.4426950408889634f;
__device__ __forceinline__ void glds16(const void*gsrc,unsigned lds_dst){unsigned keep;
  asm volatile("s_mov_b32 %0, m0\n\ts_mov_b32 m0, %2\n\ts_nop 0\n\tglobal_load_lds_dwordx4 %1, off\n\ts_mov_b32 m0, %0":"=&s"(keep):"v"(gsrc),"s"(lds_dst):"memory");}
__device__ __forceinline__ float max3f(float a,float b,float c){float r;asm("v_max3_f32 %0, %1, %2, %3":"=v"(r):"v"(a),"v"(b),"v"(c));return r;}
__device__ __forceinline__ float max2f(float a,float b){float r;asm("v_max_f32_e32 %0, %1, %2":"=v"(r):"v"(a),"v"(b));return r;}
__device__ __forceinline__ float fadd_s(float a,float b){float r;asm("v_add_f32_e32 %0, %1, %2":"=v"(r):"v"(a),"v"(b));return r;}
__device__ __forceinline__ float fsub_s(float a,float b){float r;asm("v_sub_f32_e32 %0, %1, %2":"=v"(r):"v"(a),"v"(b));return r;}
typedef float f32x2_t __attribute__((ext_vector_type(2))); typedef __bf16 bf16x2_t __attribute__((ext_vector_type(2)));
__device__ __forceinline__ unsigned cvtpk_s(float lo,float hi){f32x2_t v={lo,hi};bf16x2_t b=__builtin_convertvector(v,bf16x2_t);return __builtin_bit_cast(unsigned,b);}
#define WAIT_BAR(N) asm volatile("s_waitcnt vmcnt(" #N ") lgkmcnt(0)\n\ts_barrier":::"memory")

__device__ __forceinline__ void qkt(f32x16&p0,f32x16&p1,const char*Kslot,const bf16x8*qr,int r32,int hi){
  const char*kb=Kslot+hi*1024+r32*16;
  #pragma unroll
  for(int d0=0;d0<4;++d0){
    const bf16x8 b0=*reinterpret_cast<const bf16x8*>(kb+d0*2048);
    const bf16x8 b1=*reinterpret_cast<const bf16x8*>(kb+d0*2048+512);
    p0=__builtin_amdgcn_mfma_f32_32x32x16_bf16(b0,qr[d0],p0,0,0,0);p1=__builtin_amdgcn_mfma_f32_32x32x16_bf16(b1,qr[d0],p1,0,0,0);}
}
typedef __attribute__((address_space(3))) const char* lds_cptr;
typedef short v4i16_t __attribute__((ext_vector_type(4)));
__device__ __forceinline__ void kload8(bf16x8*kf,lds_cptr kp){
  kf[0]=*(const __attribute__((address_space(3))) bf16x8*)(kp);      kf[1]=*(const __attribute__((address_space(3))) bf16x8*)(kp+512);
  kf[2]=*(const __attribute__((address_space(3))) bf16x8*)(kp+2048); kf[3]=*(const __attribute__((address_space(3))) bf16x8*)(kp+2560);
  kf[4]=*(const __attribute__((address_space(3))) bf16x8*)(kp+4096); kf[5]=*(const __attribute__((address_space(3))) bf16x8*)(kp+4608);
  kf[6]=*(const __attribute__((address_space(3))) bf16x8*)(kp+6144); kf[7]=*(const __attribute__((address_space(3))) bf16x8*)(kp+6656);
}
__device__ __forceinline__ void kload2(bf16x8*kf,lds_cptr kp,int j){ kf[2*j]=*(const __attribute__((address_space(3))) bf16x8*)(kp+j*2048); kf[2*j+1]=*(const __attribute__((address_space(3))) bf16x8*)(kp+j*2048+512); }
__device__ __forceinline__ s16x4 vtr(lds_cptr p){ return __builtin_bit_cast(s16x4,__builtin_amdgcn_ds_read_tr16_b64_v4i16((__attribute__((address_space(3))) v4i16_t*)p)); }
__device__ __forceinline__ float rowmax(const f32x16&p0,const f32x16&p1){
  float a=max3f(p0[0],p0[1],p1[0]),b=max3f(p0[2],p0[3],p1[1]);a=max3f(a,p1[2],p1[3]);
  #pragma unroll
  for(int r=4;r<16;r+=4){a=max3f(a,p0[r],p0[r+1]);b=max3f(b,p0[r+2],p0[r+3]);a=max3f(a,p1[r],p1[r+1]);b=max3f(b,p1[r+2],p1[r+3]);}
  const float m=max2f(a,b);
  auto rr=__builtin_amdgcn_permlane32_swap(__float_as_uint(m),__float_as_uint(m),false,false);
  return max2f(__uint_as_float(rr[0]),__uint_as_float(rr[1]));
}
__device__ __forceinline__ void pv(f32x16*o,int vb,bf16x8 pa0,bf16x8 pa1,bf16x8 pa2,bf16x8 pa3){
  #pragma unroll
  for(int d0=0;d0<2;++d0){s16x4 lo[4],hi[4];
    #pragma unroll
    for(int ks=0;ks<4;++ks){
      asm volatile("ds_read_b64_tr_b16 %0,%1 offset:%c2":"=&v"(lo[ks]):"v"(vb),"i"(d0*4096+ks*1024):"memory");
      asm volatile("ds_read_b64_tr_b16 %0,%1 offset:%c2":"=&v"(hi[ks]):"v"(vb),"i"(d0*4096+ks*1024+512):"memory");}
    asm volatile("s_waitcnt lgkmcnt(0)":::"memory");SBAR();
    #define PK(k) (bf16x8){lo[k][0],lo[k][1],lo[k][2],lo[k][3],hi[k][0],hi[k][1],hi[k][2],hi[k][3]}
    o[d0]=__builtin_amdgcn_mfma_f32_32x32x16_bf16(pa0,PK(0),o[d0],0,0,0);
    o[d0]=__builtin_amdgcn_mfma_f32_32x32x16_bf16(pa1,PK(1),o[d0],0,0,0);
    o[d0]=__builtin_amdgcn_mfma_f32_32x32x16_bf16(pa2,PK(2),o[d0],0,0,0);
    o[d0]=__builtin_amdgcn_mfma_f32_32x32x16_bf16(pa3,PK(3),o[d0],0,0,0);
    #undef PK
  }
}

#ifndef ATTN_STORE16
#define ATTN_STORE16(p,v) (*(u32x4*)(p)=(v))
#endif
template<int THRL> __device__ __forceinline__ void attn_unit(int b,int h,int qb,const bf16*Q,const bf16*__restrict__ K,const bf16*__restrict__ V,bf16*O,const float*__restrict__ c2,float M2,char*shm){
  int tid=threadIdx.x; asm volatile("":"+v"(tid)); const int lane=tid&63,r32=lane&31,hi=lane>>5; const int wid=__builtin_amdgcn_readfirstlane(tid>>6);
  const long rowbase=(long)b*SEQ; const int q0=qb*QB;
  const bf16*Qw=Q+(rowbase+q0+wid*QBLK)*DM+h*D;
  const bf16*Kh0=K+rowbase*DM+h*D,*Vh0=V+rowbase*DM+h*D;
  const unsigned lds0=(unsigned)(uintptr_t)shm;
  float*wsf=(float*)(shm+LDS_WS)+wid*64;
  const unsigned kdst=lds0+LDS_K+wid*1024, vdst=lds0+LDS_V+wid*1024;
  #define DMA_K(t,slot) glds16(ksrc+(long)(t)*KVBLK*DM,(unsigned)__builtin_amdgcn_readfirstlane(kdst+(slot)))
  #define DMA_V(t,slot) glds16(vsrc+(long)(t)*KVBLK*DM,(unsigned)__builtin_amdgcn_readfirstlane(vdst+(slot)))
  const int vb0=(int)(lds0+LDS_V)+((lane>>4)&1)*32+(lane&3)*8+(4*hi+((lane&15)>>2))*64;
  const char*Kbase=shm+LDS_K; bf16x8 kf[8];
  const lds_cptr shm3=(lds_cptr)shm; const lds_cptr kp0=shm3+LDS_K+hi*1024+r32*16; const lds_cptr vp0=shm3+LDS_V+((lane>>4)&1)*32+(lane&3)*8+(4*hi+((lane&15)>>2))*64;
  const int NT0=(q0+QB)/KVBLK;
  int ts; { const int tl=lane; const float cqa=c2[q0]; const float ckb=(tl<NT0-4)?c2[64*tl+63]:cqa; const unsigned long long bm=__ballot((tl<NT0-4)&&(cqa-ckb< -(40.f+2.f*M2))); ts=__builtin_popcountll(bm)&~1; }
  ts=__builtin_amdgcn_readfirstlane(ts);
  const int NT=NT0-ts;
  const bf16*Kh=Kh0+(long)ts*KVBLK*DM,*Vh=Vh0+(long)ts*KVBLK*DM;
  const bf16*ksrc=Kh+(long)lane*DM+wid*8;
  const bf16*vsrc=Vh+(long)(16*(wid&3)+(lane>>2))*DM+(wid>>2)*32+(lane&3)*8;
  typedef float f32x4_t __attribute__((ext_vector_type(4)));
  int tidl=tid; asm volatile("":"+v"(tidl));
  const int nck4=(q0+QB)/4; f32x4_t ckv0=f32x4_t{},ckv1=f32x4_t{}; if(tidl<nck4)ckv0=((const f32x4_t*)c2)[tidl]; if(tidl+512<nck4)ckv1=((const f32x4_t*)c2)[tidl+512];
  const float cq=c2[q0+wid*QBLK+r32]-M2;
  DMA_K(0,0);DMA_V(0,0);DMA_K(1,SLOTB);
  bf16x8 qr[4];
  #pragma unroll
  for(int d0=0;d0<4;++d0)qr[d0]=*reinterpret_cast<const bf16x8*>(&Qw[(long)r32*DM+d0*16+hi*8]);
  float l_reg=0.f;f32x16 o[2];o[0]=f32x16{};o[1]=f32x16{};
  { __attribute__((address_space(3))) f32x4_t*ckl=(__attribute__((address_space(3))) f32x4_t*)((lds_cptr)shm+LDS_CK); if(tidl<nck4)ckl[tidl]=ckv0; if(tidl+512<nck4)ckl[tidl+512]=ckv1; }
  const __attribute__((address_space(3))) f32x4_t*ckp=(const __attribute__((address_space(3))) f32x4_t*)((lds_cptr)shm+LDS_CK)+hi+ts*16;
  #define CKLD(P0,P1,t) do{ _Pragma("unroll") for(int g_=0;g_<4;++g_){ const f32x4_t a_=ckp[(t)*16+2*g_], b_=ckp[(t)*16+8+2*g_]; P0[4*g_]=a_[0];P0[4*g_+1]=a_[1];P0[4*g_+2]=a_[2];P0[4*g_+3]=a_[3]; P1[4*g_]=b_[0];P1[4*g_+1]=b_[1];P1[4*g_+2]=b_[2];P1[4*g_+3]=b_[3]; } }while(0)
  #define CKSUB(P0,P1) do{ _Pragma("unroll") for(int r=0;r<16;++r){P0[r]=cq-P0[r];P1[r]=cq-P1[r];} }while(0)
  const int qrel=wid*QBLK+r32;
  #define CMASK(P0,P1,t) do{int jb_=(t)-(NT-4); if(jb_>=0)cmask(P0,P1,jb_,qrel,hi);}while(0)
  #define START(P0,P1) do{ _Pragma("unroll") for(int r=0;r<16;++r)P0[r]=__builtin_amdgcn_exp2f(P0[r]); }while(0)
  #define RESC() do{}while(0)
  f32x16 pA0,pA1,pB0,pB1;
  int sl_prev=0,sl_cur=0,sl_next=SLOTB;
  #define ROT() do{sl_prev=sl_cur;sl_cur=sl_next;sl_next=(sl_next==(NSLOT-1)*SLOTB)?0:sl_next+SLOTB;}while(0)
  DMA_K(2,2*SLOTB);
  WAIT_BAR(3);
  CKLD(pA0,pA1,0);CKSUB(pA0,pA1);
  qkt(pA0,pA1,Kbase,qr,r32,hi);asm volatile("s_nop 15\n\ts_nop 7":"+v"(pA0),"+v"(pA1));CMASK(pA0,pA1,0);
  CKLD(pB0,pB1,1);CKSUB(pB0,pB1);
  START(pA0,pA1);
  _Pragma("unroll") for(int r=0;r<16;++r)pA1[r]=__builtin_amdgcn_exp2f(pA1[r]);
  WAIT_BAR(0);
  DMA_K(3,0);DMA_V(1,SLOTB);
  ROT();
  kload8(kf,kp0+sl_cur);
  WAIT_BAR(2);
  s16x4 vlo[8],vhi[8]; u32x4 pw0,pw1,pw2,pw3;
  #define PKW(P,B) cvtpk_s(P[B],P[B+1])
  #define PAF(k) __builtin_bit_cast(bf16x8,pw##k)
  #define VFR(i) (bf16x8){vlo[i][0],vlo[i][1],vlo[i][2],vlo[i][3],vhi[i][0],vhi[i][1],vhi[i][2],vhi[i][3]}
  #define PIN(x) asm volatile("":"+v"(x))
  #define MX3(a,b,c) __builtin_fmaxf(__builtin_fmaxf((a),(b)),(c))
  #define GAPA(MF,A0,A1,A2,A3,W0,W1,PW) do{ MF; sacc+=A0; sacc+=A1; sacc+=A2; sacc+=A3; PIN(sacc); W0; W1; PIN(PW); SBAR(); }while(0)
  #define EX(v) __builtin_amdgcn_exp2f(v)
  #define GAPB(MF,X,B) do{ MF; X[B]=EX(X[B]); X[B+1]=EX(X[B+1]); X[B+2]=EX(X[B+2]); X[B+3]=EX(X[B+3]); PIN(X); SBAR(); }while(0)
  #define VRD(i) do{ vlo[i]=vtr(vp_+(((i)>>2)*4096+((i)&3)*1024)); vhi[i]=vtr(vp_+(((i)>>2)*4096+((i)&3)*1024+512)); }while(0)
  #define KRD(G,j) do{ if(G){ kload2(kf,kp0+sl_next,j); SBAR(); } }while(0)
  #define STEP(C0,C1,P0,P1,t,GK,GV,GL) do{ SBAR(); \
    const lds_cptr vp_=vp0+sl_prev; \
    VRD(0); SBAR(); float sacc=(P0[0]+P0[1]); \
    GAPA(C0=__builtin_amdgcn_mfma_f32_32x32x16_bf16(kf[0],qr[0],C0,0,0,0), P0[2],P0[3],P0[4],P0[5],     pw0[0]=PKW(P0,0), pw0[1]=PKW(P0,2), pw0); \
    VRD(4); SBAR(); GAPA(C1=__builtin_amdgcn_mfma_f32_32x32x16_bf16(kf[1],qr[0],C1,0,0,0), P0[6],P0[7],P0[8],P0[9],     pw0[2]=PKW(P0,4), pw0[3]=PKW(P0,6), pw0); \
    VRD(1); SBAR(); GAPA(C0=__builtin_amdgcn_mfma_f32_32x32x16_bf16(kf[2],qr[1],C0,0,0,0),   P0[10],P0[11],P0[12],P0[13], pw1[0]=PKW(P0,8), pw1[1]=PKW(P0,10), pw1); \
    VRD(5); SBAR(); GAPA(C1=__builtin_amdgcn_mfma_f32_32x32x16_bf16(kf[3],qr[1],C1,0,0,0),   P0[14],P0[15],P1[0],P1[1],   pw1[2]=PKW(P0,12),pw1[3]=PKW(P0,14), pw1); \
    VRD(2); SBAR(); GAPA(C0=__builtin_amdgcn_mfma_f32_32x32x16_bf16(kf[4],qr[2],C0,0,0,0),   P1[2],P1[3],P1[4],P1[5],     pw2[0]=PKW(P1,0), pw2[1]=PKW(P1,2), pw2); \
    VRD(6); SBAR(); GAPA(C1=__builtin_amdgcn_mfma_f32_32x32x16_bf16(kf[5],qr[2],C1,0,0,0),   P1[6],P1[7],P1[8],P1[9],     pw2[2]=PKW(P1,4), pw2[3]=PKW(P1,6), pw2); \
    VRD(3); SBAR(); GAPA(C0=__builtin_amdgcn_mfma_f32_32x32x16_bf16(kf[6],qr[3],C0,0,0,0),   P1[10],P1[11],P1[12],P1[13], pw3[0]=PKW(P1,8), pw3[1]=PKW(P1,10), pw3); \
    VRD(7); SBAR(); GAPA(C1=__builtin_amdgcn_mfma_f32_32x32x16_bf16(kf[7],qr[3],C1,0,0,0),   P1[14],P1[15],0.f,0.f,       pw3[2]=PKW(P1,12),pw3[3]=PKW(P1,14), pw3); \
    l_reg+=sacc; \
    if(GK){DMA_K((t)+3,sl_cur);} if(GV){DMA_V((t)+1,sl_next);} \
    CMASK(C0,C1,t); \
    SBAR(); \
    GAPB(o[0]=__builtin_amdgcn_mfma_f32_32x32x16_bf16(PAF(0),VFR(0),o[0],0,0,0), C0,0); \
    GAPB(o[1]=__builtin_amdgcn_mfma_f32_32x32x16_bf16(PAF(0),VFR(4),o[1],0,0,0), C0,4); \
    KRD(GL,0); GAPB(o[0]=__builtin_amdgcn_mfma_f32_32x32x16_bf16(PAF(1),VFR(1),o[0],0,0,0), C0,8); \
    KRD(GL,1); GAPB(o[1]=__builtin_amdgcn_mfma_f32_32x32x16_bf16(PAF(1),VFR(5),o[1],0,0,0), C0,12); \
    KRD(GL,2); GAPB(o[0]=__builtin_amdgcn_mfma_f32_32x32x16_bf16(PAF(2),VFR(2),o[0],0,0,0), C1,0); \
    KRD(GL,3); GAPB(o[1]=__builtin_amdgcn_mfma_f32_32x32x16_bf16(PAF(2),VFR(6),o[1],0,0,0), C1,4); \
    GAPB(o[0]=__builtin_amdgcn_mfma_f32_32x32x16_bf16(PAF(3),VFR(3),o[0],0,0,0), C1,8); \
    GAPB(o[1]=__builtin_amdgcn_mfma_f32_32x32x16_bf16(PAF(3),VFR(7),o[1],0,0,0), C1,12); \
    if(GL){ CKLD(P0,P1,(t)+1); CKSUB(P0,P1); } \
    }while(0)
  int t=1;
  #undef CMASK
  #define CMASK(P0,P1,t) do{}while(0)
  for(;t+5<NT;t+=2){
    STEP(pB0,pB1,pA0,pA1,t,true,true,true);     WAIT_BAR(2); RESC(); ROT();
    STEP(pA0,pA1,pB0,pB1,t+1,true,true,true);   WAIT_BAR(2); RESC(); ROT();
  }
  #undef CMASK
  #define CMASK(P0,P1,t) do{int jb_=(t)-(NT-4); if(jb_>=0)cmask(P0,P1,jb_,qrel,hi);}while(0)
  #define ENDW(tt) do{ if((tt)+3<NT){WAIT_BAR(2);} else if((tt)+2<NT){WAIT_BAR(1);} else {WAIT_BAR(0);} }while(0)
  for(;t+1<NT;t+=2){
    STEP(pB0,pB1,pA0,pA1,t,(t+3<NT),(t+1<NT),(t+1<NT));       ENDW(t);   RESC(); ROT();
    STEP(pA0,pA1,pB0,pB1,t+1,(t+4<NT),(t+2<NT),(t+2<NT));     ENDW(t+1); RESC(); ROT();
  }
  STEP(pB0,pB1,pA0,pA1,NT-1,false,false,false); RESC();
  { float sacc=pB0[0]+pB0[1]; _Pragma("unroll") for(int r=2;r<16;++r)sacc+=pB0[r]; _Pragma("unroll") for(int r=0;r<16;++r)sacc+=pB1[r]; l_reg+=sacc;
    pw0=(u32x4){PKW(pB0,0),PKW(pB0,2),PKW(pB0,4),PKW(pB0,6)};pw1=(u32x4){PKW(pB0,8),PKW(pB0,10),PKW(pB0,12),PKW(pB0,14)};pw2=(u32x4){PKW(pB1,0),PKW(pB1,2),PKW(pB1,4),PKW(pB1,6)};pw3=(u32x4){PKW(pB1,8),PKW(pB1,10),PKW(pB1,12),PKW(pB1,14)};
    SBAR(); pv(o,vb0+sl_cur,PAF(0),PAF(1),PAF(2),PAF(3)); }
  #undef PKW
  #undef PAF
  #undef VFR
  #undef PIN
  #undef MX3
  #undef GAPA
  #undef GAPB
  #undef EX
  #undef VRD
  #undef KRD
  #undef STEP
  #undef ENDW
  {auto rr=__builtin_amdgcn_permlane32_swap(__float_as_uint(l_reg),__float_as_uint(l_reg),false,false);l_reg=__uint_as_float(rr[0])+__uint_as_float(rr[1]);}
  if(hi==0)wsf[32+r32]=l_reg;asm volatile("s_waitcnt lgkmcnt(0)":::"memory");
  float rli[16];
  #pragma unroll
  for(int r=0;r<16;++r)rli[r]=__builtin_amdgcn_rcpf(wsf[32+crow(r,hi)]);
  bf16*Ow=O+(rowbase+q0+wid*QBLK)*DM+h*D;
  { bf16*stg=(bf16*)(shm+LDS_OST)+wid*2048;
    #pragma unroll
    for(int r=0;r<16;++r){const int orow=crow(r,hi);
      #pragma unroll
      for(int d0=0;d0<2;++d0)stg[orow*64+d0*32+r32]=__float2bfloat16(o[d0][r]*rli[r]);}
    asm volatile("s_waitcnt lgkmcnt(0)":::"memory");
    #pragma unroll
    for(int i=0;i<4;++i){const int row=i*8+(lane>>3),ch=lane&7; const u32x4 v=*(const u32x4*)(stg+row*64+ch*8); ATTN_STORE16(Ow+(long)row*DM+ch*8,v);} }
  asm volatile("s_waitcnt lgkmcnt(0)\n\ts_barrier":::"memory");
  #undef DMA_K
  #undef DMA_V
  #undef CMASK
  #undef START
  #undef RESC
  #undef ROT
  #undef CKLD
  #undef CKSUB
}
constexpr int ATTN_LDS_BYTES=LDS_BYTES;
struct AttnTensors { const bf16* Q; const bf16* K; const bf16* V; bf16* O; const float* C2T; float M2; };
struct AttnUnit { int bh; int qb; };
struct StaticOrder {
  int vcu, G;
  __device__ __forceinline__ explicit StaticOrder(int grid,int v):vcu(v),G(grid){}
  __device__ __forceinline__ bool next(int i,AttnUnit&u)const{ const int L=i*G+vcu; if(L>=BATCH*NHEAD*NQB)return false; const int r=L>>8, idx=L&255, k=idx&7; u.bh=idx>>3; u.qb=(r==0)?(NQB-1-k):k; return true; }
  __device__ __forceinline__ void a_ready(const AttnUnit&)const{}
  __device__ __forceinline__ void done(const AttnUnit&)const{}
};
template<class Sched,int THRL=8> __device__ __forceinline__ void attn_phase(char*lds,const AttnTensors&T,const Sched&S){
  AttnUnit u;
  for(int i=0;S.next(i,u);++i){ S.a_ready(u); attn_unit<THRL>(u.bh/NHEAD,u.bh%NHEAD,u.qb,T.Q,T.K,T.V,T.O,T.C2T+(size_t)u.bh*SEQ,T.M2,lds); S.done(u); }
}
#undef SBAR
#undef WAIT_BAR
}

constexpr int NWAVES = 8, NTHR = 512;
constexpr int DM = 1024, NB = 4, SEQ = 4096, DB = 128, DSEQ = 8, PAST = 2048, PAGE = 128, NPAGES = 16;
constexpr int MP = NB * SEQ, MS = DB * DSEQ, M = MP + MS;
constexpr int DP = 512, DA = 512, NH = 8, HD = 64, DIN = 4104, NPROJ = 4096;
constexpr int NKEYS = 128, NEXP = 16384, PH = 8, TOPK = 16, DKH = 128, DQ = 2048;
constexpr float EPS = 1e-6f;
constexpr float LOG2E = 1.4426950408889634f;
constexpr float C2 = 0.125f * LOG2E;
constexpr size_t O_YP = 0, O_YS = O_YP + (size_t)MP * DM, O_KP = O_YS + (size_t)MS * DM, O_VP = O_KP + (size_t)MP * DA, O_LFP = O_VP + (size_t)MP * DA,
                 O_PP = O_LFP + (size_t)MP * NH, O_KS = O_PP + (size_t)NB * 15 * DP, O_VS = O_KS + (size_t)MS * DA, O_LFS = O_VS + (size_t)MS * DA,
                 O_PS = O_LFS + (size_t)MS * NH, O_END = O_PS + (size_t)DB * 15 * DP;
constexpr size_t MiB = 1u << 20;
constexpr size_t WS_CTL = 0, CTL_ZERO_BYTES = 1 * MiB;
constexpr size_t WS_WIN = 2 * MiB, WS_WBP = 10 * MiB, WS_WBA = 11 * MiB, WS_WOUT = 12 * MiB, WS_WQ = 14 * MiB, WS_SUBK = 18 * MiB, WS_CP2 = 19 * MiB, WS_RSS = 20 * MiB, WS_US = 22 * MiB, WS_VS = 23 * MiB;
constexpr size_t WS_PU = 32 * MiB, WS_PV = 64 * MiB, WS_XN = 96 * MiB  , WS_U = 132 * MiB, WS_Q = 150 * MiB, WS_K = 168 * MiB, WS_V = 186 * MiB,
                 WS_GA = 204 * MiB, WS_GB = 240 * MiB, WS_PO = 276 * MiB, WS_AO = 294 * MiB, WS_T = 312 * MiB, WS_MIX = 348 * MiB, WS_PQ = 384 * MiB,
                 WS_SI = 456 * MiB, WS_SG = 466 * MiB, WS_H = 476 * MiB, WS_END = 548 * MiB;
constexpr int CW_BAR = 4096;
constexpr int LDS_BYTES = 163840;
constexpr int SCR_BYTES = 159 * 1024;
constexpr int MISC_OFF = SCR_BYTES;

typedef unsigned short bf16;
typedef unsigned v4u __attribute__((ext_vector_type(4)));
typedef unsigned v2u __attribute__((ext_vector_type(2)));
typedef float f32x4 __attribute__((ext_vector_type(4)));
typedef float f32x2 __attribute__((ext_vector_type(2)));

__device__ __forceinline__ float bf2f(unsigned short b) { return __uint_as_float((unsigned)b << 16); }
__device__ __forceinline__ float bflo(unsigned w) { return __uint_as_float(w << 16); }
__device__ __forceinline__ float bfhi(unsigned w) { return __uint_as_float(w & 0xffff0000u); }
typedef __bf16 bf16x2_t __attribute__((ext_vector_type(2)));
__device__ __forceinline__ unsigned pkbf(float lo, float hi) { f32x2 v = {lo, hi}; bf16x2_t b = __builtin_convertvector(v, bf16x2_t); return __builtin_bit_cast(unsigned, b); }
__device__ __forceinline__ float wave_sum(float v) {
#pragma unroll
    for (int o = 1; o < 64; o <<= 1) v += __shfl_xor(v, o);
    return v;
}
__device__ __forceinline__ float wave_max(float v) {
#pragma unroll
    for (int o = 1; o < 64; o <<= 1) v = fmaxf(v, __shfl_xor(v, o));
    return v;
}

struct Args {
    const float* x_p; const float* x_s; const float* cache_k; const float* cache_v; const float* cache_lf; const float* state_pool; const int* page_table;
    const float* norm_mix_g; const float* w_in; const float* b_forget; const float* q_norm_g; const float* k_norm_g; const float* pool_mix_w; const float* pool_scale;
    const float* w_bp; const float* w_ba; const float* w_out; const float* norm_ffn_g; const float* w_query; const float* sub_keys; const float* peer_u; const float* peer_v;
    float* out; unsigned char* ws; int ph_lo, ph_hi, li, pad;
};

using pg8::Unit;
struct EpiInProj {
    static constexpr bool PERM = true, AFTER_DRAIN = false;
    bf16 *U, *Q, *K, *V, *GA, *GB; float* out; const float *gq, *gk;
    __device__ __forceinline__ void operator()(const f32x4 (&acc)[2][2][4][2], const Unit& u, int wr, int wc, int fr, int fq) const {
        const int pn = u.pn; const int row0 = u.pm * 256 + wr * 64 + fr; const bool prompt = u.pm < (MP / 256);
        if (pn < 2) {
#pragma unroll
            for (int ai = 0; ai < 2; ++ai)
#pragma unroll
                for (int m = 0; m < 4; ++m) { const int row = row0 + ai * 128 + m * 16;
                    float* tail = nullptr;
                    if (prompt) { const int s = row & (SEQ - 1), b = row >> 12; if (s >= SEQ - 15) tail = out + O_PP + (size_t)(b * 15 + (s - (SEQ - 15))) * DP; }
                    else { const int rs = row - MP; tail = out + O_PS + (size_t)((rs >> 3) * 15 + 7 + (rs & 7)) * DP; }
#pragma unroll
                    for (int bj = 0; bj < 2; ++bj) { const int col = pn * 256 + bj * 128 + wc * 32 + 8 * fq; const f32x4 v0 = acc[ai][bj][m][0], v1 = acc[ai][bj][m][1];
                        v4u w; w.x = pkbf(v0[0], v0[1]); w.y = pkbf(v0[2], v0[3]); w.z = pkbf(v1[0], v1[1]); w.w = pkbf(v1[2], v1[3]);
                        *(v4u*)(U + (size_t)row * DP + col) = w;
                        if (tail) { *(f32x4*)(tail + col) = v0; *(f32x4*)(tail + col + 4) = v1; } } }
        } else if (pn < 6) {
            const bool isq = pn < 4; const int head = 4 * (pn & 1) + wc; const float* g = isq ? gq : gk;
            f32x4 gv[2][2];
#pragma unroll
            for (int bj = 0; bj < 2; ++bj)
#pragma unroll
                for (int n = 0; n < 2; ++n) gv[bj][n] = *(const f32x4*)(g + 32 * bj + 8 * fq + 4 * n);
            bf16* dst = isq ? Q : K;
#pragma unroll
            for (int ai = 0; ai < 2; ++ai)
#pragma unroll
                for (int m = 0; m < 4; ++m) { const int row = row0 + ai * 128 + m * 16; float ss = 0.f;
#pragma unroll
                    for (int bj = 0; bj < 2; ++bj)
#pragma unroll
                        for (int n = 0; n < 2; ++n) { const f32x4 x = acc[ai][bj][m][n]; ss += (x[0] * x[0] + x[1] * x[1]) + (x[2] * x[2] + x[3] * x[3]); }
                    ss += __shfl_xor(ss, 16); ss += __shfl_xor(ss, 32);
                    float r = 1.0f / sqrtf(ss * (1.0f / 64.0f) + EPS);
                    float* kout = isq ? nullptr : (prompt ? out + O_KP + (size_t)row * DA : out + O_KS + (size_t)(row - MP) * DA);
                    const float rq = isq ? r * C2 : r;
#pragma unroll
                    for (int bj = 0; bj < 2; ++bj) { const int col = head * 64 + 32 * bj + 8 * fq; const f32x4 v0 = acc[ai][bj][m][0] * gv[bj][0] * rq, v1 = acc[ai][bj][m][1] * gv[bj][1] * rq;
                        v4u w; w.x = pkbf(v0[0], v0[1]); w.y = pkbf(v0[2], v0[3]); w.z = pkbf(v1[0], v1[1]); w.w = pkbf(v1[2], v1[3]);
                        *(v4u*)(dst + (size_t)row * DA + col) = w;
                        if (!isq) { *(f32x4*)(kout + col) = v0; *(f32x4*)(kout + col + 4) = v1; } } }
        } else if (pn < 8) {
#pragma unroll
            for (int ai = 0; ai < 2; ++ai)
#pragma unroll
                for (int m = 0; m < 4; ++m) { const int row = row0 + ai * 128 + m * 16;
                    float* vout = prompt ? out + O_VP + (size_t)row * DA : out + O_VS + (size_t)(row - MP) * DA;
#pragma unroll
                    for (int bj = 0; bj < 2; ++bj) { const int col = (pn - 6) * 256 + bj * 128 + wc * 32 + 8 * fq; const f32x4 v0 = acc[ai][bj][m][0], v1 = acc[ai][bj][m][1];
                        v4u w; w.x = pkbf(v0[0], v0[1]); w.y = pkbf(v0[2], v0[3]); w.z = pkbf(v1[0], v1[1]); w.w = pkbf(v1[2], v1[3]);
                        *(v4u*)(V + (size_t)row * DA + col) = w; *(f32x4*)(vout + col) = v0; *(f32x4*)(vout + col + 4) = v1; } }
        } else {
            bf16* dst = pn < 12 ? GA : GB; const int ct = (pn < 12 ? pn - 8 : pn - 12) * 256;
#pragma unroll
            for (int ai = 0; ai < 2; ++ai)
#pragma unroll
                for (int m = 0; m < 4; ++m) { const int row = row0 + ai * 128 + m * 16;
#pragma unroll
                    for (int bj = 0; bj < 2; ++bj) { const int col = ct + bj * 128 + wc * 32 + 8 * fq; float s[8];
#pragma unroll
                        for (int n = 0; n < 2; ++n)
#pragma unroll
                            for (int i = 0; i < 4; ++i) s[4 * n + i] = __builtin_amdgcn_rcpf(1.0f + __builtin_amdgcn_exp2f(-LOG2E * acc[ai][bj][m][n][i]));
                        v4u w; w.x = pkbf(s[0], s[1]); w.y = pkbf(s[2], s[3]); w.z = pkbf(s[4], s[5]); w.w = pkbf(s[6], s[7]);
                        *(v4u*)(dst + (size_t)row * DM + col) = w; } }
        }
    }
};
template <int MODE> struct EpiGate {
    static constexpr bool PERM = true, AFTER_DRAIN = false;
    const bf16* G; const bf16* Tin; bf16* O;
    __device__ __forceinline__ void operator()(const f32x4 (&acc)[2][2][4][2], const Unit& u, int wr, int wc, int fr, int fq) const {
        const int row0 = u.pm * 256 + wr * 64 + fr;
#pragma unroll
        for (int ai = 0; ai < 2; ++ai)
#pragma unroll
            for (int m = 0; m < 4; ++m) { const int row = row0 + ai * 128 + m * 16;
#pragma unroll
                for (int bj = 0; bj < 2; ++bj) { const size_t off = (size_t)row * DM + u.pn * 256 + bj * 128 + wc * 32 + 8 * fq;
                    const v4u g = *(const v4u*)(G + off); const f32x4 v0 = acc[ai][bj][m][0], v1 = acc[ai][bj][m][1];
                    float r[8] = {v0[0] * bflo(g.x), v0[1] * bfhi(g.x), v0[2] * bflo(g.y), v0[3] * bfhi(g.y), v1[0] * bflo(g.z), v1[1] * bfhi(g.z), v1[2] * bflo(g.w), v1[3] * bfhi(g.w)};
                    if (MODE == 1) { const v4u t = *(const v4u*)(Tin + off);
                        r[0] += bflo(t.x); r[1] += bfhi(t.x); r[2] += bflo(t.y); r[3] += bfhi(t.y); r[4] += bflo(t.z); r[5] += bfhi(t.z); r[6] += bflo(t.w); r[7] += bfhi(t.w); }
                    v4u w; w.x = pkbf(r[0], r[1]); w.y = pkbf(r[2], r[3]); w.z = pkbf(r[4], r[5]); w.w = pkbf(r[6], r[7]);
                    *(v4u*)(O + off) = w; } }
    }
};
struct EpiOut {
    static constexpr bool PERM = true, AFTER_DRAIN = false;
    const float* xp; const float* xs; float* H; bf16* HG; const float* gf; float* RSS;
    __device__ __forceinline__ void operator()(const f32x4 (&acc)[2][2][4][2], const Unit& u, int wr, int wc, int fr, int fq) const {
        const int row0 = u.pm * 256 + wr * 64 + fr; const bool prompt = u.pm < (MP / 256);
        f32x4 gv[2][2];
#pragma unroll
        for (int bj = 0; bj < 2; ++bj)
#pragma unroll
            for (int n = 0; n < 2; ++n) gv[bj][n] = *(const f32x4*)(gf + u.pn * 256 + bj * 128 + wc * 32 + 8 * fq + 4 * n);
#pragma unroll
        for (int ai = 0; ai < 2; ++ai)
#pragma unroll
            for (int m = 0; m < 4; ++m) { const int row = row0 + ai * 128 + m * 16; float ss = 0.f;
                const float* xr = prompt ? xp + (size_t)row * DM : xs + (size_t)(row - MP) * DM;
#pragma unroll
                for (int bj = 0; bj < 2; ++bj) { const int col = u.pn * 256 + bj * 128 + wc * 32 + 8 * fq;
                    const f32x4 h0 = acc[ai][bj][m][0] + *(const f32x4*)(xr + col), h1 = acc[ai][bj][m][1] + *(const f32x4*)(xr + col + 4);
                    ss += (h0[0] * h0[0] + h0[1] * h0[1]) + (h0[2] * h0[2] + h0[3] * h0[3]) + (h1[0] * h1[0] + h1[1] * h1[1]) + (h1[2] * h1[2] + h1[3] * h1[3]);
                    *(f32x4*)(H + (size_t)row * DM + col) = h0; *(f32x4*)(H + (size_t)row * DM + col + 4) = h1;
                    const f32x4 a0 = h0 * gv[bj][0], a1 = h1 * gv[bj][1];
                    v4u w; w.x = pkbf(a0[0], a0[1]); w.y = pkbf(a0[2], a0[3]); w.z = pkbf(a1[0], a1[1]); w.w = pkbf(a1[2], a1[3]);
                    *(v4u*)(HG + (size_t)row * DM + col) = w; }
                ss += __shfl_xor(ss, 16); ss += __shfl_xor(ss, 32);
                if (fq == 0) RSS[(size_t)row * 16 + u.pn * 4 + wc] = ss; }
    }
};

struct Frame {
    LAS unsigned char* lds; volatile LAS unsigned* MISC; gu32* ctl;
    int tid, lane, wave, vcu, G;
};

__device__ __forceinline__ void transpose_item(const float* W, int ldw, int K, bf16* WT, int src_col0, int dst_row0, int k0, LAS float* scr, int lane) {
#pragma unroll 8
    for (int i = 0; i < 32; ++i) { const int kk = 2 * i + (lane >> 5); scr[kk * 33 + (lane & 31)] = W[(size_t)(k0 + kk) * ldw + src_col0 + (lane & 31)]; }
    LDS_WAIT(); asm volatile("" ::: "memory");
    const int c = lane & 7;
#pragma unroll
    for (int j = 0; j < 4; ++j) { const int n = (lane >> 3) + 8 * j; const LAS float* s = scr + (8 * c) * 33 + n;
        v4u o; o.x = pkbf(s[0 * 33], s[1 * 33]); o.y = pkbf(s[2 * 33], s[3 * 33]); o.z = pkbf(s[4 * 33], s[5 * 33]); o.w = pkbf(s[6 * 33], s[7 * 33]);
        *(v4u*)(WT + (size_t)(dst_row0 + n) * K + k0 + 8 * c) = o; }
    LDS_WAIT(); asm volatile("" ::: "memory");
}
__device__ __forceinline__ int win_src_col(int db) {
    if (db < 16) return 32 * db;
    if (db < 48) { const int base = db < 32 ? 512 : 1024; const int local = (db - 16) & 15, tile = local >> 3, blk = local & 7, bj = blk >> 2, w = blk & 3; return base + tile * 256 + 64 * w + 32 * bj; }
    if (db < 64) return 1536 + 32 * (db - 48);
    if (db < 96) return 2056 + 32 * (db - 64);
    return 3080 + 32 * (db - 96);
}
__device__ __forceinline__ void cvt_rows_bf16(const float* src, bf16* dst, size_t n8, size_t gtid, size_t gn) {
    for (size_t i = gtid; i < n8; i += gn) { const f32x4 a = *(const f32x4*)(src + 8 * i), b = *(const f32x4*)(src + 8 * i + 4);
        v4u w; w.x = pkbf(a[0], a[1]); w.y = pkbf(a[2], a[3]); w.z = pkbf(b[0], b[1]); w.w = pkbf(b[2], b[3]); *(v4u*)(dst + 8 * i) = w; }
}
__device__ __forceinline__ void cvt_rows_fp8(const float* src, unsigned char* dst, float* scl, int gw, int NGW, int lane) {
    for (int e = gw; e < NEXP; e += NGW) { const float* r = src + (size_t)e * DM + 16 * lane;
        const f32x4 a0 = *(const f32x4*)r, a1 = *(const f32x4*)(r + 4), a2 = *(const f32x4*)(r + 8), a3 = *(const f32x4*)(r + 12);
        float mx = fmaxf(fmaxf(fmaxf(fabsf(a0[0]), fabsf(a0[1])), fmaxf(fabsf(a0[2]), fabsf(a0[3]))), fmaxf(fmaxf(fabsf(a1[0]), fabsf(a1[1])), fmaxf(fabsf(a1[2]), fabsf(a1[3]))));
        mx = fmaxf(mx, fmaxf(fmaxf(fmaxf(fabsf(a2[0]), fabsf(a2[1])), fmaxf(fabsf(a2[2]), fabsf(a2[3]))), fmaxf(fmaxf(fabsf(a3[0]), fabsf(a3[1])), fmaxf(fabsf(a3[2]), fabsf(a3[3])))));
        mx = wave_max(mx);
        int k = 0; if (mx > 1e-30f) k = 7 - ((int)((__builtin_bit_cast(unsigned, mx) >> 23) & 0xffu) - 127);
        k = k < -100 ? -100 : (k > 100 ? 100 : k);
        const float sc = __builtin_bit_cast(float, (unsigned)(k + 127) << 23), isc = __builtin_bit_cast(float, (unsigned)(127 - k) << 23);
        int w0 = 0, w1 = 0, w2 = 0, w3 = 0;
        w0 = __builtin_amdgcn_cvt_pk_fp8_f32(a0[0] * sc, a0[1] * sc, w0, false); w0 = __builtin_amdgcn_cvt_pk_fp8_f32(a0[2] * sc, a0[3] * sc, w0, true);
        w1 = __builtin_amdgcn_cvt_pk_fp8_f32(a1[0] * sc, a1[1] * sc, w1, false); w1 = __builtin_amdgcn_cvt_pk_fp8_f32(a1[2] * sc, a1[3] * sc, w1, true);
        w2 = __builtin_amdgcn_cvt_pk_fp8_f32(a2[0] * sc, a2[1] * sc, w2, false); w2 = __builtin_amdgcn_cvt_pk_fp8_f32(a2[2] * sc, a2[3] * sc, w2, true);
        w3 = __builtin_amdgcn_cvt_pk_fp8_f32(a3[0] * sc, a3[1] * sc, w3, false); w3 = __builtin_amdgcn_cvt_pk_fp8_f32(a3[2] * sc, a3[3] * sc, w3, true);
        *(v4u*)(dst + (size_t)(lane >> 3) * ((size_t)NEXP * 128) + (size_t)e * 128 + 16 * (lane & 7)) = (v4u){(unsigned)w0, (unsigned)w1, (unsigned)w2, (unsigned)w3};
        if (lane == 0) scl[e] = isc; }
}
__device__ __forceinline__ void p0_prologue(Frame& F, const Args& a) {
    unsigned char* ws = a.ws;
    LAS float* scr = (LAS float*)(F.lds + F.wave * 16384);
    const int gw = F.vcu * NWAVES + F.wave, NGW = F.G * NWAVES;
    for (int it = gw; it < 4096; it += NGW) {
        int r = it;
        if (r < 2048) { const int kb = r >> 7, db = r & 127; transpose_item(a.w_in, DIN, DM, (bf16*)(ws + WS_WIN), win_src_col(db), 32 * db, 64 * kb, scr, F.lane); continue; } r -= 2048;
        if (r < 256) { continue; } r -= 256;
        if (r < 256) { const int kb = r >> 5, nb = r & 31; transpose_item(a.w_ba, DM, DA, (bf16*)(ws + WS_WBA), 32 * nb, 32 * nb, 64 * kb, scr, F.lane); continue; } r -= 256;
        if (r < 512) { const int kb = r >> 5, nb = r & 31; transpose_item(a.w_out, DM, DM, (bf16*)(ws + WS_WOUT), 32 * nb, 32 * nb, 64 * kb, scr, F.lane); continue; } r -= 512;
        { const int kb = r >> 6, nb = r & 63; transpose_item(a.w_query, DQ, DM, (bf16*)(ws + WS_WQ), 32 * nb, 32 * nb, 64 * kb, scr, F.lane); }
    }
    for (int it = gw; it < 16 * 4 * 16; it += NGW) { const int nb = it & 15, g = (it >> 4) & 3, cb = it >> 6; const int nn = 64 * nb + F.lane; float acc8[8];
#pragma unroll
        for (int i = 0; i < 8; ++i) acc8[i] = 0.f;
        const float* pm = a.pool_mix_w + (size_t)g * 16384 + (size_t)(8 * cb) * 128;
        for (int d = 0; d < 128; ++d) { const float wv = a.w_bp[(size_t)(g * 128 + d) * DM + nn] * a.pool_scale[g * 128 + d];
#pragma unroll
            for (int i = 0; i < 8; ++i) acc8[i] += pm[i * 128 + d] * wv; }
        v4u o; o.x = pkbf(acc8[0], acc8[1]); o.y = pkbf(acc8[2], acc8[3]); o.z = pkbf(acc8[4], acc8[5]); o.w = pkbf(acc8[6], acc8[7]);
        *(v4u*)((bf16*)(ws + WS_WBP) + (size_t)nn * DP + g * 128 + 8 * cb) = o; }
    { const size_t gtid = (size_t)F.vcu * NTHR + F.tid, gn = (size_t)F.G * NTHR;
      cvt_rows_fp8(a.peer_u, ws + WS_PU, (float*)(ws + WS_US), gw, NGW, F.lane);
      cvt_rows_fp8(a.peer_v, ws + WS_PV, (float*)(ws + WS_VS), gw, NGW, F.lane);
      cvt_rows_bf16(a.sub_keys, (bf16*)(ws + WS_SUBK), (size_t)PH * 2 * NKEYS * DKH / 8, gtid, gn);
      for (size_t i = gtid; i < (size_t)DB * 7 * DP; i += gn) { const int b = (int)(i / (7 * DP)), j = (int)((i / DP) % 7), c = (int)(i % DP);
          a.out[O_PS + (size_t)(b * 15 + j) * DP + c] = a.state_pool[(size_t)(b * 15 + 8 + j) * DP + c]; } }
    __syncthreads();
    LAS float* wfT = (LAS float*)F.lds;
    for (int i = F.tid; i < 8 * DM; i += NTHR) { const int col = i >> 3, h = i & 7; wfT[h * DM + col] = a.w_in[(size_t)col * DIN + 2048 + h]; }
    __syncthreads();
    bf16* XN = (bf16*)(ws + WS_XN);
    for (int row = gw; row < M; row += NGW) {
        const float* xr = row < MP ? a.x_p + (size_t)row * DM : a.x_s + (size_t)(row - MP) * DM;
        f32x4 v[4]; float ss = 0.f;
#pragma unroll
        for (int j = 0; j < 4; ++j) { v[j] = *(const f32x4*)(xr + 256 * j + 4 * F.lane); ss += (v[j][0] * v[j][0] + v[j][1] * v[j][1]) + (v[j][2] * v[j][2] + v[j][3] * v[j][3]); }
        const float r = 1.0f / sqrtf(wave_sum(ss) * (1.0f / DM) + EPS);
        float f[8];
#pragma unroll
        for (int h = 0; h < 8; ++h) f[h] = 0.f;
#pragma unroll
        for (int j = 0; j < 4; ++j) { const f32x4 g = *(const f32x4*)(a.norm_mix_g + 256 * j + 4 * F.lane); v[j] = v[j] * r * g;
            v2u w; w.x = pkbf(v[j][0], v[j][1]); w.y = pkbf(v[j][2], v[j][3]); *(v2u*)(XN + (size_t)row * DM + 256 * j + 4 * F.lane) = w;
#pragma unroll
            for (int h = 0; h < 8; ++h) { const f32x4 wv = *(const LAS f32x4*)(wfT + h * DM + 256 * j + 4 * F.lane); f[h] += (v[j][0] * wv[0] + v[j][1] * wv[1]) + (v[j][2] * wv[2] + v[j][3] * wv[3]); } }
        float mine = 0.f;
#pragma unroll
        for (int h = 0; h < 8; ++h) { const float s = wave_sum(f[h]); if (F.lane == h) mine = s; }
        if (F.lane < 8) { const float z = mine + a.b_forget[F.lane]; const float lf = fminf(z, 0.f) - log1pf(expf(-fabsf(z)));
            if (row < MP) a.out[O_LFP + (size_t)row * NH + F.lane] = lf; else a.out[O_LFS + (size_t)(row - MP) * NH + F.lane] = lf; }
    }
}

__device__ __forceinline__ void p2_cumsum_pool(Frame& F, const Args& a) {
    unsigned char* ws = a.ws;
    { const int gw = F.vcu * NWAVES + F.wave; float* CP2 = (float*)(ws + WS_CP2);
      if (gw < NB * NH) { const int b = gw >> 3, h = gw & 7; float carry = 0.f;
          for (int c = 0; c < SEQ / 64; ++c) { float v = a.out[O_LFP + (size_t)(b * SEQ + c * 64 + F.lane) * NH + h];
#pragma unroll
              for (int o = 1; o < 64; o <<= 1) { const float t = __shfl_up(v, o); if (F.lane >= o) v += t; }
              v += carry; CP2[(size_t)gw * SEQ + c * 64 + F.lane] = v * LOG2E; carry = __shfl(v, 63); } } }
    const bf16* U = (const bf16*)(ws + WS_U); bf16* PO = (bf16*)(ws + WS_PO);
    for (int item = F.vcu * NTHR + F.tid; item < M * 64; item += F.G * NTHR) {
        const int row = item >> 6, ch = (item & 63) * 8, g = ch >> 7, w = 2 << g;
        float sum[8], self[8];
#pragma unroll
        for (int i = 0; i < 8; ++i) sum[i] = 0.f;
        float cnt;
        if (row < MP) { const int s = row & (SEQ - 1); cnt = (float)(s + 1 < w ? s + 1 : w); const int nw = s + 1 < w ? s + 1 : w;
            for (int i = 0; i < nw; ++i) { const v4u q = *(const v4u*)(U + (size_t)(row - i) * DP + ch);
                const float e[8] = {bflo(q.x), bfhi(q.x), bflo(q.y), bfhi(q.y), bflo(q.z), bfhi(q.z), bflo(q.w), bfhi(q.w)};
#pragma unroll
                for (int k = 0; k < 8; ++k) { sum[k] += e[k]; if (i == 0) self[k] = e[k]; } }
        } else { const int rs = row - MP, b = rs >> 3, t = rs & 7; cnt = (float)w;
            for (int i = 0; i < w; ++i) { const int tt = t - i; float e[8];
                if (tt >= 0) { const v4u q = *(const v4u*)(U + (size_t)(MP + b * 8 + tt) * DP + ch);
                    e[0] = bflo(q.x); e[1] = bfhi(q.x); e[2] = bflo(q.y); e[3] = bfhi(q.y); e[4] = bflo(q.z); e[5] = bfhi(q.z); e[6] = bflo(q.w); e[7] = bfhi(q.w); }
                else { const f32x4 p0 = *(const f32x4*)(a.state_pool + (size_t)(b * 15 + 15 + tt) * DP + ch), p1 = *(const f32x4*)(a.state_pool + (size_t)(b * 15 + 15 + tt) * DP + ch + 4);
                    e[0] = p0[0]; e[1] = p0[1]; e[2] = p0[2]; e[3] = p0[3]; e[4] = p1[0]; e[5] = p1[1]; e[6] = p1[2]; e[7] = p1[3]; }
#pragma unroll
                for (int k = 0; k < 8; ++k) { sum[k] += e[k]; if (i == 0) self[k] = e[k]; } } }
        const float inv = 1.0f / cnt; float mm[8];
#pragma unroll
        for (int k = 0; k < 8; ++k) mm[k] = sum[k] * inv - self[k];
        v4u o; o.x = pkbf(mm[0], mm[1]); o.y = pkbf(mm[2], mm[3]); o.z = pkbf(mm[4], mm[5]); o.w = pkbf(mm[6], mm[7]);
        *(v4u*)(PO + (size_t)row * DP + ch) = o;
    }
}

__device__ __forceinline__ float attn_bound2(const Args& a, int lane) {
    asm volatile("" : "+v"(lane));
    const float gq = wave_max(fabsf(a.q_norm_g[lane])), gk = wave_max(fabsf(a.k_norm_g[lane]));
    return 64.0f * C2 * gq * gk * 1.03f;
}

typedef float f32x16 __attribute__((ext_vector_type(16)));
typedef short bf16x8v __attribute__((ext_vector_type(8)));
__device__ __forceinline__ int f2key(float s) { int b = __builtin_bit_cast(int, s); return b ^ ((b >> 31) & 0x7fffffff); }
__device__ __forceinline__ float key2f(int k) { return __builtin_bit_cast(float, k ^ ((k >> 31) & 0x7fffffff)); }
#define CE_DESC(x, y) do { const int mx_ = (x) > (y) ? (x) : (y), mn_ = (x) > (y) ? (y) : (x); (x) = mx_; (y) = mn_; } while (0)
template <int OFF, int N, typename T> __device__ __forceinline__ void bsort_desc(T& v) {
#pragma unroll
    for (int k = 2; k <= N; k <<= 1)
#pragma unroll
        for (int j = k >> 1; j > 0; j >>= 1)
#pragma unroll
            for (int i = 0; i < N; ++i) { const int l = i ^ j; if (l > i) { if ((i & k) == 0) CE_DESC(v[OFF + i], v[OFF + l]); else CE_DESC(v[OFF + l], v[OFF + i]); } }
}
template <int OFF, typename T> __device__ __forceinline__ void bmerge16_desc(T& v) {
#pragma unroll
    for (int j = 8; j > 0; j >>= 1)
#pragma unroll
        for (int i = 0; i < 16; ++i) { const int l = i ^ j; if (l > i) CE_DESC(v[OFF + i], v[OFF + l]); }
}
template <int OA, int OB, typename T> __device__ __forceinline__ void top16_merge(T& v) {
#pragma unroll
    for (int i = 0; i < 16; ++i) v[OA + i] = v[OA + i] > v[OB + 15 - i] ? v[OA + i] : v[OB + 15 - i];
    bmerge16_desc<OA>(v);
}
template <typename T> __device__ __forceinline__ void top16_of_64(T& v) {
    bsort_desc<0, 16>(v); bsort_desc<16, 16>(v); bsort_desc<32, 16>(v); bsort_desc<48, 16>(v);
    top16_merge<0, 16>(v); top16_merge<32, 48>(v); top16_merge<0, 32>(v);
}
__device__ __forceinline__ void p7_topk(Frame& F, const Args& a) {
    unsigned char* ws = a.ws;
    const bf16* PQ = (const bf16*)(ws + WS_PQ); const bf16* SK = (const bf16*)(ws + WS_SUBK); const float* RSS = (const float*)(ws + WS_RSS);
    int* SI = (int*)(ws + WS_SI); float* SG = (float*)(ws + WS_SG);
    const int lane = F.lane, j = lane & 31, hi = lane >> 5;
    LAS unsigned* ib = (LAS unsigned*)(F.lds + F.wave * 1024);
    const int gw = F.vcu * NWAVES + F.wave, NGW = F.G * NWAVES;
    for (int item = gw; item < (M / 32) * PH; item += NGW) {
        const int h = item & 7, row0 = (item >> 3) * 32;
        int jl = j, hl = hi; asm volatile("" : "+v"(jl), "+v"(hl));
        int top[2][16];
#pragma unroll
        for (int p = 0; p < 2; ++p) {
            bf16x8v qf[8];
#pragma unroll
            for (int ks = 0; ks < 8; ++ks) qf[ks] = *(const bf16x8v*)(PQ + (size_t)(row0 + jl) * DQ + h * 256 + p * 128 + 16 * ks + 8 * hl);
            f32x16 acc[4];
#pragma unroll
            for (int mt = 0; mt < 4; ++mt) acc[mt] = f32x16{};
            const bf16* kb = SK + ((size_t)(h * 2 + p) * NKEYS + jl) * DKH + 8 * hl;
#pragma unroll
            for (int ks = 0; ks < 8; ++ks)
#pragma unroll
                for (int mt = 0; mt < 4; ++mt) { const bf16x8v af = *(const bf16x8v*)(kb + mt * 32 * DKH + ks * 16); acc[mt] = __builtin_amdgcn_mfma_f32_32x32x16_bf16(af, qf[ks], acc[mt], 0, 0, 0); }
            int v[64];
#pragma unroll
            for (int mt = 0; mt < 4; ++mt)
#pragma unroll
                for (int r = 0; r < 16; ++r) { const int n = 32 * mt + (r & 3) + 8 * (r >> 2) + 4 * hi; v[16 * mt + r] = (f2key(acc[mt][r]) & ~127) | (127 - n); }
            top16_of_64(v);
#pragma unroll
            for (int i = 0; i < 16; ++i) top[p][i] = v[i];
        }
        int S[32];
#pragma unroll
        for (int i = 0; i < 16; ++i) { auto rr = __builtin_amdgcn_permlane32_swap((unsigned)top[0][i], (unsigned)top[1][i], false, false); S[i] = (int)rr[0]; S[16 + i] = (int)rr[1]; }
        top16_merge<0, 16>(S);
        { unsigned w0 = 0, w1 = 0, w2 = 0, w3 = 0;
#pragma unroll
          for (int i = 0; i < 4; ++i) { w0 |= (unsigned)(127 - (S[i] & 127)) << (8 * i); w1 |= (unsigned)(127 - (S[4 + i] & 127)) << (8 * i); w2 |= (unsigned)(127 - (S[8 + i] & 127)) << (8 * i); w3 |= (unsigned)(127 - (S[12 + i] & 127)) << (8 * i); }
          *(LAS v4u*)(ib + (hi * 32 + j) * 4) = (v4u){w0, w1, w2, w3}; }
        float s1[16], s2[16];
#pragma unroll
        for (int i = 0; i < 16; ++i) { auto rr = __builtin_amdgcn_permlane32_swap((unsigned)S[i], (unsigned)S[i], false, false); s1[i] = key2f((int)rr[0] & ~127); s2[i] = key2f((int)rr[1] & ~127); }
        int c[64]; { int n = 0;
#pragma unroll
          for (int ca = 0; ca < 16; ++ca)
#pragma unroll
              for (int cb = 0; cb < 16; ++cb) if ((ca + 1) * (cb + 1) <= 16) { c[n] = (f2key(s1[ca] + s2[cb]) & ~255) | (255 - (ca * 16 + cb)); ++n; }
#pragma unroll
          for (int q = 50; q < 64; ++q) c[q] = (int)0x80000000; }
        top16_of_64(c);
        float ssq = 0.f;
#pragma unroll
        for (int q = 0; q < 4; ++q) { const f32x4 t4 = *(const f32x4*)(RSS + (size_t)(row0 + j) * 16 + 4 * q); ssq += (t4[0] + t4[1]) + (t4[2] + t4[3]); }
        const float rstd = 1.0f / sqrtf(ssq * (1.0f / DM) + EPS);
        const float z0 = key2f(c[0] & ~255) * rstd; float e[16], esum = 0.f;
#pragma unroll
        for (int k = 0; k < 16; ++k) { e[k] = __expf(key2f(c[k] & ~255) * rstd - z0); esum += e[k]; }
        const float inv = 1.0f / esum;
        LDS_WAIT(); asm volatile("" ::: "memory");
        const LAS unsigned char* ib8 = (const LAS unsigned char*)ib;
        int oi[8]; float og[8];
#pragma unroll
        for (int k = 0; k < 8; ++k) { const int ck = hi ? c[8 + k] : c[k]; const float ek = hi ? e[8 + k] : e[k]; const int fl = 255 - (ck & 255);
            const int i1 = ib8[(0 * 32 + j) * 16 + (fl >> 4)], i2 = ib8[(1 * 32 + j) * 16 + (fl & 15)]; oi[k] = i1 * NKEYS + i2; og[k] = ek * inv; }
        { int* sp = SI + (size_t)(row0 + j) * 128 + h * 16 + hi * 8; float* gp = SG + (size_t)(row0 + j) * 128 + h * 16 + hi * 8;
          *(v4u*)sp = (v4u){(unsigned)oi[0], (unsigned)oi[1], (unsigned)oi[2], (unsigned)oi[3]}; *(v4u*)(sp + 4) = (v4u){(unsigned)oi[4], (unsigned)oi[5], (unsigned)oi[6], (unsigned)oi[7]};
          *(f32x4*)gp = (f32x4){og[0], og[1], og[2], og[3]}; *(f32x4*)(gp + 4) = (f32x4){og[4], og[5], og[6], og[7]}; }
        LDS_WAIT(); asm volatile("" ::: "memory");
    }
}


constexpr int P8_TOK = 34, P8_Q = 5, P8_NS = 8, P8_SW = 128;
static_assert(M % P8_TOK == 0 && P8_TOK <= 8 * P8_Q, "P8 chunking");
#define FP8X2(wd, hi_) __builtin_amdgcn_cvt_pk_f32_fp8((int)(wd), (hi_))
typedef __bf16 bf16x2v __attribute__((ext_vector_type(2)));
template <bool HI> __device__ __forceinline__ float p8_dot(unsigned wd, unsigned hpair, float accv) { const f32x2 f = FP8X2(wd, HI); return __builtin_amdgcn_fdot2_f32_bf16(__builtin_bit_cast(bf16x2v, pkbf(f[0], f[1])), __builtin_bit_cast(bf16x2v, hpair), accv, false); }
__device__ __forceinline__ void p8_gather(Frame& F, const Args& a) {
    unsigned char* ws = a.ws;
    const bf16* HG = (const bf16*)(ws + WS_XN); const unsigned char* PU = ws + WS_PU; const unsigned char* PV = ws + WS_PV; const float* US = (const float*)(ws + WS_US); const float* VS = (const float*)(ws + WS_VS);
    const float* RSS = (const float*)(ws + WS_RSS); const int* SI = (const int*)(ws + WS_SI); const float* SG = (const float*)(ws + WS_SG); const float* Hh = (const float*)(ws + WS_H);
    float* Y = a.out + O_YP;
    LAS unsigned short* ix = (LAS unsigned short*)F.lds;
    LAS float* wt = (LAS float*)(F.lds + P8_TOK * 128 * 2);
    LAS float* rs = (LAS float*)(F.lds + P8_TOK * 128 * 2 + P8_TOK * 128 * 4);
    int lane = F.lane; asm volatile("" : "+v"(lane));
    const int g = lane >> 3, c8 = lane & 7;
    for (int chunk = F.vcu; chunk < M / P8_TOK; chunk += F.G) {
        const int tb = chunk * P8_TOK;
        __syncthreads();
        for (int i = F.tid; i < P8_TOK * 128; i += NTHR) { ix[i] = (unsigned short)SI[(size_t)tb * 128 + i]; wt[i] = SG[(size_t)tb * 128 + i]; }
        if (F.tid < P8_TOK) { float s = 0.f; for (int k = 0; k < 16; ++k) s += RSS[(size_t)(tb + F.tid) * 16 + k]; rs[F.tid] = 1.0f / sqrtf(s * (1.0f / DM) + EPS); }
        __syncthreads();
        float acc[P8_Q][16];
#pragma unroll
        for (int q = 0; q < P8_Q; ++q)
#pragma unroll
            for (int i = 0; i < 16; ++i) acc[q][i] = 0.f;
        for (int s = 0; s < P8_NS; ++s) {
            int cl = c8; asm volatile("" : "+v"(cl));
            const unsigned char* pus = PU + (size_t)s * ((size_t)NEXP * P8_SW) + 16 * cl;
#pragma unroll
            for (int q = 0; q < P8_Q; ++q) { const int lt = F.wave + 8 * q; if (lt < P8_TOK) {
                const v4u h0 = *(const v4u*)(HG + (size_t)(tb + lt) * DM + P8_SW * s + 16 * cl), h1 = *(const v4u*)(HG + (size_t)(tb + lt) * DM + P8_SW * s + 16 * cl + 8);
                const unsigned hp8[8] = {h0.x, h0.y, h0.z, h0.w, h1.x, h1.y, h1.z, h1.w};
#pragma unroll
                for (int hb = 0; hb < 2; ++hb) {
                    const v4u ea = *(const LAS v4u*)(ix + lt * 128 + g * 16 + 8 * hb);
                    const unsigned ew[4] = {ea.x, ea.y, ea.z, ea.w};
                    v4u r[8];
#pragma unroll
                    for (int i = 0; i < 8; ++i) { const unsigned e = (i & 1) ? (ew[i >> 1] >> 16) : (ew[i >> 1] & 0xffffu); r[i] = *(const v4u*)(pus + (size_t)e * P8_SW); }
#pragma unroll
                    for (int i = 0; i < 8; ++i) { float d = acc[q][8 * hb + i]; const unsigned wd[4] = {r[i].x, r[i].y, r[i].z, r[i].w};
#pragma unroll
                        for (int jj = 0; jj < 4; ++jj) { d = p8_dot<false>(wd[jj], hp8[2 * jj], d); d = p8_dot<true>(wd[jj], hp8[2 * jj + 1], d); }
                        acc[q][8 * hb + i] = d; } } } }
        }
#pragma unroll
        for (int q = 0; q < P8_Q; ++q) { const int lt = F.wave + 8 * q; if (lt < P8_TOK) {
            float v8[8], v4[4], v2[2]; const bool b4 = (c8 & 4) != 0, b2 = (c8 & 2) != 0, b1 = (c8 & 1) != 0;
#pragma unroll
            for (int j2 = 0; j2 < 8; ++j2) { const float keep = b4 ? acc[q][8 + j2] : acc[q][j2], send = b4 ? acc[q][j2] : acc[q][8 + j2]; v8[j2] = keep + __shfl_xor(send, 4); }
#pragma unroll
            for (int j2 = 0; j2 < 4; ++j2) { const float keep = b2 ? v8[4 + j2] : v8[j2], send = b2 ? v8[j2] : v8[4 + j2]; v4[j2] = keep + __shfl_xor(send, 2); }
#pragma unroll
            for (int j2 = 0; j2 < 2; ++j2) { const float keep = b1 ? v4[2 + j2] : v4[j2], send = b1 ? v4[j2] : v4[2 + j2]; v2[j2] = keep + __shfl_xor(send, 1); }
            const float r = rs[lt]; const int kk = lt * 128 + g * 16 + 2 * c8; LAS float* wp = wt + kk; const f32x2 gt = *(const LAS f32x2*)wp;
            const int e0 = ix[kk], e1 = ix[kk + 1];
            const float z0 = v2[0] * r * US[e0], z1 = v2[1] * r * US[e1];
            const float a0 = 0.5f * z0 * (1.0f + erff(z0 * 0.70710678118654752f)), a1 = 0.5f * z1 * (1.0f + erff(z1 * 0.70710678118654752f));
            *(LAS f32x2*)wp = (f32x2){gt[0] * a0 * VS[e0], gt[1] * a1 * VS[e1]}; } }
        LDS_WAIT(); asm volatile("" ::: "memory");
        for (int s = 0; s < P8_NS; ++s) {
            int cl = c8; asm volatile("" : "+v"(cl));
            const unsigned char* pvs = PV + (size_t)s * ((size_t)NEXP * P8_SW) + 16 * cl;
#pragma unroll 1
            for (int q = 0; q < P8_Q; ++q) { const int lt = F.wave + 8 * q; if (lt < P8_TOK) {
                float o[16];
#pragma unroll
                for (int k = 0; k < 16; ++k) o[k] = 0.f;
#pragma unroll
                for (int hb = 0; hb < 2; ++hb) {
                    const v4u ea = *(const LAS v4u*)(ix + lt * 128 + g * 16 + 8 * hb);
                    const unsigned ew[4] = {ea.x, ea.y, ea.z, ea.w};
                    const f32x4 wa = *(const LAS f32x4*)(wt + lt * 128 + g * 16 + 8 * hb), wb = *(const LAS f32x4*)(wt + lt * 128 + g * 16 + 8 * hb + 4);
                    const float wv[8] = {wa[0], wa[1], wa[2], wa[3], wb[0], wb[1], wb[2], wb[3]};
                    v4u r[8];
#pragma unroll
                    for (int i = 0; i < 8; ++i) { const unsigned e = (i & 1) ? (ew[i >> 1] >> 16) : (ew[i >> 1] & 0xffffu); r[i] = *(const v4u*)(pvs + (size_t)e * P8_SW); }
#pragma unroll
                    for (int i = 0; i < 8; ++i) { const float wgt = wv[i]; const unsigned wd[4] = {r[i].x, r[i].y, r[i].z, r[i].w};
#pragma unroll
                        for (int jj = 0; jj < 4; ++jj) { const f32x2 lo = FP8X2(wd[jj], false), hi2 = FP8X2(wd[jj], true);
                            o[4 * jj] += wgt * lo[0]; o[4 * jj + 1] += wgt * lo[1]; o[4 * jj + 2] += wgt * hi2[0]; o[4 * jj + 3] += wgt * hi2[1]; } } }
                const bool b5 = (lane & 32) != 0, b4 = (lane & 16) != 0, b3 = (lane & 8) != 0; float p8[8], p4[4], p2[2];
#pragma unroll
                for (int j2 = 0; j2 < 8; ++j2) { const float keep = b5 ? o[8 + j2] : o[j2], send = b5 ? o[j2] : o[8 + j2]; p8[j2] = keep + __shfl_xor(send, 32); }
#pragma unroll
                for (int j2 = 0; j2 < 4; ++j2) { const float keep = b4 ? p8[4 + j2] : p8[j2], send = b4 ? p8[j2] : p8[4 + j2]; p4[j2] = keep + __shfl_xor(send, 16); }
#pragma unroll
                for (int j2 = 0; j2 < 2; ++j2) { const float keep = b3 ? p4[2 + j2] : p4[j2], send = b3 ? p4[j2] : p4[2 + j2]; p2[j2] = keep + __shfl_xor(send, 8); }
                const size_t off = (size_t)(tb + lt) * DM + P8_SW * s + 16 * cl + (b5 ? 8 : 0) + (b4 ? 4 : 0) + (b3 ? 2 : 0);
                const f32x2 hv = *(const f32x2*)(Hh + off);
                *(f32x2*)(Y + off) = (f32x2){hv[0] + p2[0], hv[1] + p2[1]}; } }
        }
    }
}

__device__ __forceinline__ void p3_sample_attn2(Frame& F, const Args& a, const float M2) {
    unsigned char* ws = a.ws;
    const bf16* Q = (const bf16*)(ws + WS_Q); bf16* AO = (bf16*)(ws + WS_AO);
    LAS float* D2 = (LAS float*)F.lds;
    LAS float* E2 = (LAS float*)(F.lds + 32768);
    LAS float* Pt = (LAS float*)(F.lds + 32768 + 128);
    LAS float* Op = (LAS float*)(F.lds + 32768 + 128 + 8192);
    LAS float* lp = (LAS float*)(F.lds + 32768 + 128 + 8192 + 16384);
    int lane = F.lane; asm volatile("" : "+v"(lane));
    const int w = F.wave, hh = w >> 1, kh = w & 1, n = lane & 31, hi = lane >> 5;
    LAS float* Pw = Pt + w * 256;
    for (int unit = F.vcu; unit < DB * 2; unit += F.G) {
        const int b = unit >> 1, h = 4 * (unit & 1) + hh;
        __syncthreads();
        for (int i = F.tid; i < 4 * PAST; i += NTHR) { const int hq = i >> 11, jk = i & (PAST - 1); const int pg = a.page_table[b * NPAGES + (jk >> 7)];
            D2[i] = a.cache_lf[((size_t)pg * PAGE + (jk & 127)) * NH + 4 * (unit & 1) + hq]; }
        __syncthreads();
        if (kh == 0) {
            LAS float* d = D2 + hh * PAST; float loc[32]; float tot = 0.f;
#pragma unroll
            for (int k = 31; k >= 0; --k) { loc[k] = tot; tot += d[lane * 32 + k]; }
            float inc = tot;
#pragma unroll
            for (int o = 1; o < 64; o <<= 1) { const float t = __shfl_down(inc, o); if (lane + o < 64) inc += t; }
            const float excl = inc - tot;
#pragma unroll
            for (int k = 0; k < 32; ++k) d[lane * 32 + k] = (loc[k] + excl) * LOG2E;
            if (lane < 8) { float e = 0.f; for (int t = 0; t <= lane; ++t) e += a.out[O_LFS + (size_t)(b * 8 + t) * NH + h]; E2[hh * 8 + lane] = e * LOG2E; }
        }
        __syncthreads();
        bf16x8v qa[4];
#pragma unroll
        for (int ks = 0; ks < 4; ++ks) { qa[ks] = bf16x8v{}; if (n < 8) qa[ks] = *(const bf16x8v*)(Q + (size_t)(MP + b * 8 + n) * DA + h * 64 + 16 * ks + 8 * hi); }
        float e2[4];
#pragma unroll
        for (int t = 0; t < 4; ++t) e2[t] = E2[hh * 8 + 4 * hi + t] - M2;
        float o[8], lsum[4];
#pragma unroll
        for (int t = 0; t < 8; ++t) o[t] = 0.f;
#pragma unroll
        for (int t = 0; t < 4; ++t) lsum[t] = 0.f;
        const LAS float* dh = D2 + hh * PAST;
        int nskip; { const float dl = dh[32 * lane + 31]; nskip = __builtin_popcountll(__ballot(dl < -(40.f + 2.f * M2))); }
        nskip = __builtin_amdgcn_readfirstlane(nskip);
        const int nblk = PAST / 32 - nskip, nb0 = nblk >> 1;
        const int blk_lo = nskip + (kh ? nb0 : 0), nit = kh ? (nblk - nb0) : nb0;
        f32x4 kq[8]; float vv[32];
#define S3_COMPUTE(it_, NEWK) do { f32x16 sacc = f32x16{}; \
            _Pragma("unroll") for (int ks = 0; ks < 4; ++ks) { const f32x4 x0_ = kq[2 * ks], x1_ = kq[2 * ks + 1]; v4u kb_; kb_.x = pkbf(x0_[0], x0_[1]); kb_.y = pkbf(x0_[2], x0_[3]); kb_.z = pkbf(x1_[0], x1_[1]); kb_.w = pkbf(x1_[2], x1_[3]); \
                sacc = __builtin_amdgcn_mfma_f32_32x32x16_bf16(qa[ks], __builtin_bit_cast(bf16x8v, kb_), sacc, 0, 0, 0); } \
            float p_[4]; \
            if (!(NEWK)) { const float dj_ = dh[(blk_lo + (it_)) * 32 + n]; _Pragma("unroll") for (int t = 0; t < 4; ++t) p_[t] = __builtin_amdgcn_exp2f(sacc[t] + e2[t] + dj_); } \
            else { const float ek_ = E2[hh * 8 + (n & 7)]; _Pragma("unroll") for (int t = 0; t < 4; ++t) p_[t] = (n <= 4 * hi + t) ? __builtin_amdgcn_exp2f(sacc[t] + e2[t] - ek_) : 0.f; } \
            _Pragma("unroll") for (int t = 0; t < 4; ++t) lsum[t] += p_[t]; \
            *(LAS f32x4*)(Pw + n * 8 + 4 * hi) = (f32x4){p_[0], p_[1], p_[2], p_[3]}; \
            LDS_WAIT(); asm volatile("" ::: "memory"); \
            _Pragma("unroll") for (int k_ = 0; k_ < ((NEWK) ? 8 : 32); ++k_) { const f32x4 pa_ = *(const LAS f32x4*)(Pw + k_ * 8), pb_ = *(const LAS f32x4*)(Pw + k_ * 8 + 4); const float v_ = vv[k_]; \
                o[0] += pa_[0] * v_; o[1] += pa_[1] * v_; o[2] += pa_[2] * v_; o[3] += pa_[3] * v_; o[4] += pb_[0] * v_; o[5] += pb_[1] * v_; o[6] += pb_[2] * v_; o[7] += pb_[3] * v_; } \
            LDS_WAIT(); asm volatile("" ::: "memory"); } while (0)
        for (int it = 0; it < nit; ++it) {
            const int j0 = (blk_lo + it) * 32; const int pg = a.page_table[b * NPAGES + (j0 >> 7)];
            const size_t rowoff = (((size_t)pg * PAGE + (j0 & 127)) * NH + h) * HD;
            const float* kr = a.cache_k + rowoff + (size_t)n * (NH * HD) + 8 * hi; const float* vb = a.cache_v + rowoff;
#pragma unroll
            for (int ks = 0; ks < 4; ++ks) { kq[2 * ks] = __builtin_nontemporal_load((const f32x4*)(kr + 16 * ks)); kq[2 * ks + 1] = __builtin_nontemporal_load((const f32x4*)(kr + 16 * ks + 4)); }
#pragma unroll
            for (int k = 0; k < 32; ++k) vv[k] = __builtin_nontemporal_load(vb + (size_t)k * (NH * HD) + lane);
            S3_COMPUTE(it, false);
        }
        if (kh == 1) {
            const float* kr = a.out + O_KS + (size_t)(b * 8 + (n & 7)) * DA + h * HD + 8 * hi; const float* vr = a.out + O_VS + (size_t)(b * 8) * DA + h * HD + lane;
#pragma unroll
            for (int ks = 0; ks < 4; ++ks) { kq[2 * ks] = *(const f32x4*)(kr + 16 * ks); kq[2 * ks + 1] = *(const f32x4*)(kr + 16 * ks + 4); }
#pragma unroll
            for (int k = 0; k < 8; ++k) vv[k] = vr[(size_t)k * DA];
            S3_COMPUTE(0, true);
        }
#undef S3_COMPUTE
#pragma unroll
        for (int t = 0; t < 4; ++t) { float s = lsum[t]; s += __shfl_xor(s, 1); s += __shfl_xor(s, 2); s += __shfl_xor(s, 4); s += __shfl_xor(s, 8); s += __shfl_xor(s, 16); if (n == 0) lp[w * 8 + 4 * hi + t] = s; }
#pragma unroll
        for (int t = 0; t < 8; ++t) Op[(w * 8 + t) * 64 + lane] = o[t];
        __syncthreads();
        for (int i = F.tid; i < 4 * 8 * 64; i += NTHR) { const int hq = i >> 9, t = (i >> 6) & 7, d = i & 63;
            const float O = Op[((2 * hq) * 8 + t) * 64 + d] + Op[((2 * hq + 1) * 8 + t) * 64 + d], L = lp[(2 * hq) * 8 + t] + lp[(2 * hq + 1) * 8 + t];
            AO[(size_t)(MP + b * 8 + t) * DA + (4 * (unit & 1) + hq) * 64 + d] = (bf16)(pkbf(O / L, 0.f) & 0xffffu); }
    }
}

constexpr int N_PHASES = 9;
#ifndef MK_PER_PHASE
#define MK_PER_PHASE 0
#endif
__global__ void __launch_bounds__(NTHR, 2) fwd_kernel(Args args) {
    extern __shared__ __attribute__((aligned(16))) unsigned char lds[];
    Frame F;
    F.lds = (LAS unsigned char*)lds; F.MISC = (volatile LAS unsigned*)(F.lds + MISC_OFF);
    F.tid = threadIdx.x; F.lane = F.tid & 63; F.wave = __builtin_amdgcn_readfirstlane(F.tid >> 6);
    F.G = gridDim.x; { const int bx = blockIdx.x; F.vcu = (F.G % 8 == 0) ? (bx % 8) * (F.G / 8) + bx / 8 : bx; }
    F.ctl = (gu32*)(args.ws + WS_CTL);
    for (int u = F.tid; u < (LDS_BYTES - MISC_OFF) / 4; u += NTHR) ((LAS unsigned*)(F.lds + MISC_OFF))[u] = 0u;
    __syncthreads();
#if MK_PER_PHASE
#define GRID_BAR() do { } while (0)
#else
    XcdBarrier bar = xcd_barrier_post((unsigned*)(F.ctl + CW_BAR), F.MISC + 8);
#define GRID_BAR() xcd_barrier(bar)
#endif
    unsigned char* ws = args.ws;
    const int lo = args.ph_lo, hi = args.ph_hi;
#ifndef DBG_REP_PHASE
#define DBG_REP_PHASE -1
#endif
#ifndef DBG_REP_N
#define DBG_REP_N 1
#endif
#define REPS(k) for (int rep_ = 0; rep_ < ((k) == DBG_REP_PHASE ? 1 + DBG_REP_N : 1); ++rep_)
#define IN(k) (lo <= (k) && (k) < hi)
#define BOTH(k) (IN(k) && IN((k) + 1))
#define ENDPH(k) do { if (BOTH(k) || (k) == DBG_REP_PHASE) GRID_BAR(); } while (0)
    if (IN(0)) REPS(0) { p0_prologue(F, args); ENDPH(0); }
    if (IN(1)) REPS(1) {
        pg8::Gemm g{(const bf16*)(ws + WS_XN), (const bf16*)(ws + WS_WIN), M, NPROJ, DM}; pg8::StaticOrder S; S.init(M, NPROJ, F.G, (int)blockIdx.x);
        EpiInProj E{(bf16*)(ws + WS_U), (bf16*)(ws + WS_Q), (bf16*)(ws + WS_K), (bf16*)(ws + WS_V), (bf16*)(ws + WS_GA), (bf16*)(ws + WS_GB), args.out, args.q_norm_g, args.k_norm_g};
        pg8::gemm_phase<EpiInProj, pg8::StaticOrder, true, true>(F.lds, g, S, E);
        ENDPH(1);
    }
    if (IN(2)) REPS(2) { p2_cumsum_pool(F, args); ENDPH(2); }
    if (IN(3)) {
        const float M2 = __builtin_bit_cast(float, __builtin_amdgcn_readfirstlane(__builtin_bit_cast(int, attn_bound2(args, F.lane))));
#if !defined(DBG_SKIP_PATTN)
        { const attn_body::AttnTensors AT{(const attn_body::bf16*)(ws + WS_Q), (const attn_body::bf16*)(ws + WS_K), (const attn_body::bf16*)(ws + WS_V), (attn_body::bf16*)(ws + WS_AO), (const float*)(ws + WS_CP2), M2};
          const attn_body::StaticOrder S((int)F.G, F.vcu);
          attn_body::attn_phase<attn_body::StaticOrder>((char*)lds, AT, S); }
#endif
        REPS(3) { p3_sample_attn2(F, args, M2); }
        ENDPH(3); }
    if (IN(4)) REPS(4) {
        { pg8::Gemm g{(const bf16*)(ws + WS_PO), (const bf16*)(ws + WS_WBP), M, DM, DP}; pg8::StaticOrder S; S.init(M, DM, F.G, (int)blockIdx.x);
          EpiGate<0> E{(const bf16*)(ws + WS_GA), nullptr, (bf16*)(ws + WS_T)};
          pg8::gemm_phase<EpiGate<0>, pg8::StaticOrder, true, true>(F.lds, g, S, E); }
        __syncthreads();
        { pg8::Gemm g{(const bf16*)(ws + WS_AO), (const bf16*)(ws + WS_WBA), M, DM, DA}; pg8::StaticOrder S; S.init(M, DM, F.G, (int)blockIdx.x);
          EpiGate<1> E{(const bf16*)(ws + WS_GB), (const bf16*)(ws + WS_T), (bf16*)(ws + WS_MIX)};
          pg8::gemm_phase<EpiGate<1>, pg8::StaticOrder, true, true>(F.lds, g, S, E); }
        ENDPH(4);
    }
    if (IN(5)) REPS(5) {
        pg8::Gemm g{(const bf16*)(ws + WS_MIX), (const bf16*)(ws + WS_WOUT), M, DM, DM}; pg8::StaticOrder S; S.init(M, DM, F.G, (int)blockIdx.x);
        EpiOut E{args.x_p, args.x_s, (float*)(ws + WS_H), (bf16*)(ws + WS_XN), args.norm_ffn_g, (float*)(ws + WS_RSS)};
        pg8::gemm_phase<EpiOut, pg8::StaticOrder, true, true>(F.lds, g, S, E);
        ENDPH(5);
    }
    if (IN(6)) REPS(6) {
        pg8::Gemm g{(const bf16*)(ws + WS_XN), (const bf16*)(ws + WS_WQ), M, DQ, DM}; pg8::StaticOrder S; S.init(M, DQ, F.G, (int)blockIdx.x);
        pg8::EpiBf16<0> E{(bf16*)(ws + WS_PQ), DQ, nullptr, 0, 0, 1.f};
        pg8::gemm_phase<pg8::EpiBf16<0>, pg8::StaticOrder, true, true>(F.lds, g, S, E);
        ENDPH(6);
    }
    if (IN(7)) REPS(7) { p7_topk(F, args); ENDPH(7); }
    if (IN(8)) REPS(8) { p8_gather(F, args); ENDPH(8); }
#ifdef DBG_DUMP
    if (IN(9)) { const bf16* AO = (const bf16*)(ws + WS_AO); const bf16* PO = (const bf16*)(ws + WS_PO); const bf16* MX = (const bf16*)(ws + (DBG_DUMP == 3 ? WS_T : DBG_DUMP == 4 ? WS_GA : WS_MIX));
        for (size_t i = (size_t)blockIdx.x * NTHR + F.tid; i < (size_t)M * DM; i += (size_t)F.G * NTHR) { const int row = (int)(i >> 10), c = (int)(i & 1023);
            float v; if (DBG_DUMP == 1) v = c < 512 ? bf2f(AO[(size_t)row * DA + c]) : bf2f(PO[(size_t)row * DP + c - 512]); else v = bf2f(MX[i]);
            args.out[O_YP + i] = v; } }
#endif
#undef IN
#undef BOTH
}

extern "C" void kernel_launch(void* const* d_in, const int* in_sizes, int n_in, void* d_out, int out_size, void* d_ws, size_t ws_size, hipStream_t stream) {
    static int grid = 0;
    if (grid == 0) {
        if (n_in != 22 || (size_t)out_size != O_END || ws_size < WS_END) { fprintf(stderr, "kernel_launch: unexpected shapes (n_in %d out %d ws %zu)\n", n_in, out_size, ws_size); grid = -1; return; }
        int dev = 0, cus = 0, per_cu = 0;
        if (hipGetDevice(&dev) != hipSuccess || hipDeviceGetAttribute(&cus, hipDeviceAttributeMultiprocessorCount, dev) != hipSuccess) { grid = -1; return; }
        if (hipFuncSetAttribute((const void*)fwd_kernel, hipFuncAttributeMaxDynamicSharedMemorySize, LDS_BYTES) != hipSuccess) { fprintf(stderr, "kernel_launch: hipFuncSetAttribute failed\n"); grid = -1; return; }
        if (hipOccupancyMaxActiveBlocksPerMultiprocessor(&per_cu, (const void*)fwd_kernel, NTHR, LDS_BYTES) != hipSuccess || per_cu < 1) fprintf(stderr, "kernel_launch: occupancy query reports %d\n", per_cu);
        (void)hipGetLastError();
        grid = cus;
    }
    if (grid < 0) return;
    if (hipMemsetAsync((char*)d_ws + WS_CTL, 0, CTL_ZERO_BYTES, stream) != hipSuccess) return;
    Args a{};
    a.x_p = (const float*)d_in[0]; a.x_s = (const float*)d_in[1]; a.cache_k = (const float*)d_in[2]; a.cache_v = (const float*)d_in[3]; a.cache_lf = (const float*)d_in[4];
    a.state_pool = (const float*)d_in[5]; a.page_table = (const int*)d_in[6]; a.norm_mix_g = (const float*)d_in[7]; a.w_in = (const float*)d_in[8]; a.b_forget = (const float*)d_in[9];
    a.q_norm_g = (const float*)d_in[10]; a.k_norm_g = (const float*)d_in[11]; a.pool_mix_w = (const float*)d_in[12]; a.pool_scale = (const float*)d_in[13]; a.w_bp = (const float*)d_in[14];
    a.w_ba = (const float*)d_in[15]; a.w_out = (const float*)d_in[16]; a.norm_ffn_g = (const float*)d_in[17]; a.w_query = (const float*)d_in[18]; a.sub_keys = (const float*)d_in[19];
    a.peer_u = (const float*)d_in[20]; a.peer_v = (const float*)d_in[21];
    a.out = (float*)d_out; a.ws = (unsigned char*)d_ws; a.pad = 0;
#if MK_PER_PHASE
#ifndef DBG_NPH
#define DBG_NPH N_PHASES
#endif
    for (int ph = 0; ph < DBG_NPH; ++ph) { a.ph_lo = ph; a.ph_hi = ph + 1; a.li = ph; hipLaunchKernelGGL(fwd_kernel, dim3(grid), dim3(NTHR), LDS_BYTES, stream, a); }
#ifdef DBG_DUMP
    a.ph_lo = 9; a.ph_hi = 10; a.li = 9; hipLaunchKernelGGL(fwd_kernel, dim3(grid), dim3(NTHR), LDS_BYTES, stream, a);
#endif
#else
    a.ph_lo = 0; a.ph_hi = N_PHASES; a.li = 0; hipLaunchKernelGGL(fwd_kernel, dim3(grid), dim3(NTHR), LDS_BYTES, stream, a);
#endif
}
```

```cpp
#include <hip/hip_runtime.h>
#include <cstdio>
#include <cstdint>
#include <cmath>
namespace pg8 {
#define PG8_LAS __attribute__((address_space(3)))
typedef unsigned short bf16_t;
typedef short bf16x8 __attribute__((ext_vector_type(8)));
typedef float f32x4 __attribute__((ext_vector_type(4)));
typedef unsigned u32x4 __attribute__((ext_vector_type(4)));
constexpr int BM = 256, BK = 64, HALF = 128, HTB = HALF * BK * 2  , STAGE_BYTES = 8 * HTB, NXCD = 8, WGM = 8;

__host__ __device__ __forceinline__ int lds_byte(int r, int c) { const int st = (r >> 4) * 2 + (c >> 5), rr = r & 15, cc = c & 31, ob = rr * 64 + cc * 2; return st * 1024 + (ob ^ (((ob >> 9) & 1) << 5)); }
__host__ __device__ __forceinline__ void stage_rc(int b, int& R, int& C) { const int st = b / 1024, sb = b % 1024, swz = sb ^ (((sb >> 9) & 1) << 5); R = (st >> 1) * 16 + swz / 64; C = (st & 1) * 32 + (swz % 64) / 2; }
__host__ __device__ __forceinline__ int perm32(int rho) { const int n = rho >> 4, i = rho & 15; return 8 * (i >> 2) + 4 * n + (i & 3); }

struct Unit { int pm, pn; };
struct Gemm { const bf16_t* A; const bf16_t* Bt; int M, N, K; };

struct StaticOrder {
    int nM, nN, nwg, G, c;
    __host__ __device__ void init(int M, int N, int G_, int c_) { nM = M / BM; nN = N / BM; nwg = nM * nN; G = G_; c = c_; }
    __host__ __device__ bool next(int i, Unit& u) const {
        const long L = (long)i * G + c; if (L >= nwg) return false;
        int wgid = (int)L; { const int q = nwg / NXCD, r = nwg % NXCD, xcd = wgid % NXCD, off = wgid / NXCD; wgid = (xcd < r ? xcd * (q + 1) : r * (q + 1) + (xcd - r) * q) + off; }
        const int nig = WGM * nN, gid = wgid / nig, fm = gid * WGM, gsz = (nM - fm) < WGM ? (nM - fm) : WGM;
        u.pm = fm + ((wgid % nig) % gsz); u.pn = (wgid % nig) / gsz; return true;
    }
    __device__ __forceinline__ void a_ready(const Unit&) const {}
    __device__ __forceinline__ void done(const Unit&) const {}
};

typedef float f32x2c __attribute__((ext_vector_type(2))); typedef __bf16 bf16x2c __attribute__((ext_vector_type(2)));
__device__ __forceinline__ unsigned cvt_pk_bf16(float lo, float hi) { f32x2c v = {lo, hi}; bf16x2c b = __builtin_convertvector(v, bf16x2c); return __builtin_bit_cast(unsigned, b); }
typedef float f32x2 __attribute__((ext_vector_type(2)));
__device__ __forceinline__ f32x2 gelu_pk(f32x2 v) {
    const f32x2 av = __builtin_elementwise_abs(v), d = av * 0.2316418882f + 1.0f;
    f32x2 t; t.x = __builtin_amdgcn_rcpf(d.x); t.y = __builtin_amdgcn_rcpf(d.y);
    f32x2 q = t * 0.5307027145f + (-0.7265760135f); q = q * t + 0.7107068705f; q = q * t + (-0.142248368f); q = q * t + 0.127414796f; q = q * t;
    const f32x2 s = (v * v) * (-0.72134752044f);
    f32x2 e; e.x = __builtin_amdgcn_exp2f(s.x); e.y = __builtin_amdgcn_exp2f(s.y);
    const f32x2 m = v * (q * e), r = v - m;
    f32x2 o; o.x = v.x < 0.f ? m.x : r.x; o.y = v.y < 0.f ? m.y : r.y; return o;
}

template <int ACT  > struct EpiBf16 {
    static constexpr bool PERM = true, AFTER_DRAIN = false; static_assert(ACT == 0 || ACT == 1, "EpiBf16: ACT is 0 (none) or 1 (gelu_pk)");
    bf16_t* O; int ldc; const float* bias; int split_cols; size_t split_stride; float scale0;
    __device__ __forceinline__ void operator()(const f32x4 (&acc)[2][2][4][2], const Unit& u, int wr, int wc, int fr, int fq) const {
        const int row0 = u.pm * BM + wr * 64 + fr; int colt = u.pn * BM; bf16_t* base = O;
        float sc = 1.f; if (split_cols) { const int t = colt / split_cols; base += (size_t)t * split_stride; colt -= t * split_cols; if (t == 0) sc = scale0; }
        const int col0 = colt + wc * 32 + 8 * fq, bcol0 = u.pn * BM + wc * 32 + 8 * fq;
        f32x4 bv[2][2];
#pragma unroll
        for (int bj = 0; bj < 2; ++bj)
#pragma unroll
            for (int n = 0; n < 2; ++n) bv[bj][n] = bias ? *(const f32x4*)(bias + bcol0 + bj * HALF + 4 * n) : (f32x4){0.f, 0.f, 0.f, 0.f};
#pragma unroll
        for (int ai = 0; ai < 2; ++ai)
#pragma unroll
            for (int m = 0; m < 4; ++m) { bf16_t* rowp = base + (size_t)(row0 + ai * HALF + m * 16) * ldc + col0;
#pragma unroll
                for (int bj = 0; bj < 2; ++bj) { f32x4 v0 = acc[ai][bj][m][0] + bv[bj][0], v1 = acc[ai][bj][m][1] + bv[bj][1];
                    if (ACT == 1) { f32x2 a = gelu_pk((f32x2){v0[0], v0[1]}), b = gelu_pk((f32x2){v0[2], v0[3]}), c = gelu_pk((f32x2){v1[0], v1[1]}), d = gelu_pk((f32x2){v1[2], v1[3]});
                        v0 = (f32x4){a.x, a.y, b.x, b.y}; v1 = (f32x4){c.x, c.y, d.x, d.y}; }
                    v0 = v0 * sc; v1 = v1 * sc; u32x4 w; w.x = cvt_pk_bf16(v0[0], v0[1]); w.y = cvt_pk_bf16(v0[2], v0[3]); w.z = cvt_pk_bf16(v1[0], v1[1]); w.w = cvt_pk_bf16(v1[2], v1[3]);
                    *(u32x4*)(rowp + bj * HALF) = w; } }
    }
};
template <class Epi, class Sched, bool ALIGN_EPI = false, bool SP2 = false>
__device__ __forceinline__ void gemm_phase(PG8_LAS unsigned char* lds, const Gemm g, const Sched& S, const Epi& E) {
    int tid = threadIdx.x; asm volatile("" : "+v"(tid));
    const int wid = __builtin_amdgcn_readfirstlane(tid >> 6), lane = tid & 63, wr = wid >> 2, wc = wid & 3, fr = lane & 15, fq = lane >> 4;
    const int K = g.K, nt = K / BK;
    unsigned voffA[2], voffB[2];
#pragma unroll
    for (int i = 0; i < 2; ++i) { int R, C; stage_rc(tid * 16 + i * 8192, R, C); const int Rb = Epi::PERM ? ((R & ~31) + perm32(R & 31)) : R;
        voffA[i] = (unsigned)(R * K + C) * 2u; voffB[i] = (unsigned)(Rb * K + C) * 2u; }
    const size_t kstep = (size_t)(BK * 2);
    const size_t hstep = (size_t)HALF * K * 2;
    const size_t tstep = 2 * hstep;
    const unsigned ldsw = (unsigned)wid * 1024u;
    const int aoff = lds_byte(wr * 64 + fr, fq * 8), boff = lds_byte(wc * 32 + fr, fq * 8);
#define PG8_SA(b, h) (((b) * 2 + (h)) * HTB)
#define PG8_SB(b, h) ((4 + (b) * 2 + (h)) * HTB)
#define PG8_STAGE(bufoff, gbase, voff) do { _Pragma("unroll") for (int _i = 0; _i < 2; ++_i) \
        __builtin_amdgcn_global_load_lds((const unsigned*)((const char*)(gbase) + (voff)[_i]), (PG8_LAS unsigned*)(lds + (bufoff) + ldsw + _i * 8192), 16, 0, 0); } while (0)
#define PG8_LDA(dst, b, h) do { _Pragma("unroll") for (int m = 0; m < 4; ++m) _Pragma("unroll") for (int k = 0; k < 2; ++k) dst[m][k] = *(const PG8_LAS bf16x8*)(lds + PG8_SA(b, h) + aoff + m * 2048 + k * 1024); } while (0)
#define PG8_LDB(dst, b, h) do { _Pragma("unroll") for (int n = 0; n < 2; ++n) _Pragma("unroll") for (int k = 0; k < 2; ++k) dst[n][k] = *(const PG8_LAS bf16x8*)(lds + PG8_SB(b, h) + boff + n * 2048 + k * 1024); } while (0)
#define PG8_MMA(ai, bj, At, Bt) do { __builtin_amdgcn_s_setprio(1); _Pragma("unroll") for (int m = 0; m < 4; ++m) _Pragma("unroll") for (int n = 0; n < 2; ++n) _Pragma("unroll") for (int k = 0; k < 2; ++k) \
        acc[ai][bj][m][n] = __builtin_amdgcn_mfma_f32_16x16x32_bf16(Bt[n][k], At[m][k], acc[ai][bj][m][n], 0, 0, 0); __builtin_amdgcn_s_setprio(0); } while (0)
#define PG8_WAIT_V(n) asm volatile("s_waitcnt vmcnt(" #n ")" ::: "memory")
#define PG8_WAIT_L(n) asm volatile("s_waitcnt lgkmcnt(" #n ")" ::: "memory")
#define PG8_BAR __builtin_amdgcn_s_barrier()
#define PG8_SCHED __builtin_amdgcn_sched_barrier(0)
    Unit cur, nxt; int ui = 0;
    if (!S.next(0, cur)) return;
    f32x4 acc[2][2][4][2];
#pragma unroll
    for (int a = 0; a < 2; ++a)
#pragma unroll
        for (int b = 0; b < 2; ++b)
#pragma unroll
            for (int m = 0; m < 4; ++m)
#pragma unroll
                for (int n = 0; n < 2; ++n) acc[a][b][m][n] = (f32x4){0.f, 0.f, 0.f, 0.f};
    bf16x8 At[4][2], B0[2][2], B1[2][2];
    const char* cA = (const char*)g.A + (size_t)cur.pm * tstep; const char* cB = (const char*)g.Bt + (size_t)cur.pn * tstep;
    S.a_ready(cur);
    if constexpr (SP2) {
        PG8_STAGE(PG8_SB(0, 0), cB, voffB); PG8_STAGE(PG8_SB(0, 1), cB + hstep, voffB); PG8_STAGE(PG8_SA(0, 0), cA, voffA); PG8_STAGE(PG8_SA(0, 1), cA + hstep, voffA);
        if (wr == 1) PG8_BAR;
        PG8_WAIT_V(2); PG8_BAR;
        PG8_STAGE(PG8_SB(1, 0), cB + kstep, voffB); PG8_STAGE(PG8_SA(1, 0), cA + kstep, voffA); PG8_STAGE(PG8_SB(1, 1), cB + hstep + kstep, voffB);
        PG8_WAIT_V(6); PG8_BAR;
    } else {
        PG8_STAGE(PG8_SB(0, 0), cB, voffB); PG8_STAGE(PG8_SA(0, 0), cA, voffA); PG8_STAGE(PG8_SB(0, 1), cB + hstep, voffB); PG8_STAGE(PG8_SA(0, 1), cA + hstep, voffA);
        if (wr == 1) PG8_BAR;
        PG8_WAIT_V(4); PG8_BAR;
        PG8_STAGE(PG8_SB(1, 0), cB + kstep, voffB); PG8_STAGE(PG8_SA(1, 0), cA + kstep, voffA); PG8_STAGE(PG8_SB(1, 1), cB + hstep + kstep, voffB);
        PG8_WAIT_V(6); PG8_BAR;
    }
    for (;;) {
        const bool has_next = S.next(ui + 1, nxt);
        const char* nA = has_next ? (const char*)g.A + (size_t)nxt.pm * tstep : cA; const char* nB = has_next ? (const char*)g.Bt + (size_t)nxt.pn * tstep : cB;
        for (int t = 0; t < nt; t += 2) {
            const bool last = (t == nt - 2);
            const char* a1 = cA + (size_t)(t + 1) * kstep;
            const char* a2 = last ? nA : cA + (size_t)(t + 2) * kstep; const char* b2 = last ? nB : cB + (size_t)(t + 2) * kstep;
            const char* a3 = a2 + kstep; const char* b3 = b2 + kstep;
            if (last && has_next) S.a_ready(nxt);
            if constexpr (SP2) {
            PG8_LDB(B0, 0, 0); PG8_LDB(B1, 0, 1); PG8_SCHED; PG8_LDA(At, 0, 0); PG8_STAGE(PG8_SA(1, 1), a1 + hstep, voffA);
            PG8_WAIT_V(8); PG8_WAIT_L(0); PG8_BAR; PG8_MMA(0, 0, At, B0); PG8_MMA(0, 1, At, B1); PG8_BAR; PG8_SCHED;
            PG8_LDA(At, 0, 1); PG8_STAGE(PG8_SB(0, 0), b2, voffB); PG8_STAGE(PG8_SB(0, 1), b2 + hstep, voffB); PG8_STAGE(PG8_SA(0, 0), a2, voffA);
            PG8_WAIT_V(8); PG8_WAIT_L(0); PG8_BAR; PG8_MMA(1, 0, At, B0); PG8_MMA(1, 1, At, B1); PG8_BAR; PG8_SCHED;
            PG8_LDB(B0, 1, 0); PG8_LDB(B1, 1, 1); PG8_SCHED; PG8_LDA(At, 1, 0); PG8_STAGE(PG8_SA(0, 1), a2 + hstep, voffA);
            PG8_WAIT_V(8); PG8_WAIT_L(0); PG8_BAR; PG8_MMA(0, 0, At, B0); PG8_MMA(0, 1, At, B1); PG8_BAR; PG8_SCHED;
            PG8_LDA(At, 1, 1); PG8_STAGE(PG8_SB(1, 0), b3, voffB); PG8_STAGE(PG8_SB(1, 1), b3 + hstep, voffB); PG8_STAGE(PG8_SA(1, 0), a3, voffA);
            PG8_WAIT_V(8); PG8_WAIT_L(0); PG8_BAR; PG8_MMA(1, 0, At, B0); PG8_MMA(1, 1, At, B1); PG8_BAR; PG8_SCHED;
            } else {
            PG8_LDB(B0, 0, 0); PG8_SCHED; PG8_LDA(At, 0, 0); PG8_STAGE(PG8_SA(1, 1), a1 + hstep, voffA);
            PG8_WAIT_L(8); PG8_BAR; PG8_WAIT_L(0); PG8_MMA(0, 0, At, B0); PG8_BAR; PG8_SCHED;
            PG8_LDB(B1, 0, 1); PG8_STAGE(PG8_SB(0, 0), b2, voffB);
            PG8_BAR; PG8_WAIT_L(0); PG8_MMA(0, 1, At, B1); PG8_BAR;
            PG8_LDA(At, 0, 1); PG8_STAGE(PG8_SA(0, 0), a2, voffA);
            PG8_BAR; PG8_WAIT_L(0); PG8_MMA(1, 0, At, B0); PG8_BAR; PG8_SCHED;
            PG8_STAGE(PG8_SB(0, 1), b2 + hstep, voffB);
            PG8_WAIT_V(6); PG8_BAR; PG8_MMA(1, 1, At, B1); PG8_BAR;
            PG8_LDB(B0, 1, 0); PG8_SCHED; PG8_LDA(At, 1, 0); PG8_STAGE(PG8_SA(0, 1), a2 + hstep, voffA);
            PG8_WAIT_L(8); PG8_BAR; PG8_WAIT_L(0); PG8_MMA(0, 0, At, B0); PG8_BAR; PG8_SCHED;
            PG8_LDB(B1, 1, 1); PG8_STAGE(PG8_SB(1, 0), b3, voffB);
            PG8_BAR; PG8_WAIT_L(0); PG8_MMA(0, 1, At, B1); PG8_BAR;
            PG8_LDA(At, 1, 1); PG8_STAGE(PG8_SA(1, 0), a3, voffA);
            PG8_BAR; PG8_WAIT_L(0); PG8_MMA(1, 0, At, B0); PG8_BAR; PG8_SCHED;
            PG8_STAGE(PG8_SB(1, 1), b3 + hstep, voffB);
            PG8_WAIT_V(6); PG8_BAR; PG8_MMA(1, 1, At, B1); PG8_BAR;
            }
        }
        if constexpr (ALIGN_EPI) { if (wr == 0) PG8_BAR; }
        if constexpr (!Epi::AFTER_DRAIN) { E(acc, cur, wr, wc, fr, fq); S.done(cur); }
        if (!has_next) break;
#pragma unroll
        for (int a = 0; a < 2; ++a)
#pragma unroll
            for (int b = 0; b < 2; ++b)
#pragma unroll
                for (int m = 0; m < 4; ++m)
#pragma unroll
                    for (int n = 0; n < 2; ++n) acc[a][b][m][n] = (f32x4){0.f, 0.f, 0.f, 0.f};
        cur = nxt; cA = nA; cB = nB; ++ui;
        if constexpr (ALIGN_EPI) { if (wr == 1) PG8_BAR; }
    }
    PG8_WAIT_V(0);
    if constexpr (!ALIGN_EPI) { if (wr == 0) PG8_BAR; }
    PG8_BAR;
    if constexpr (Epi::AFTER_DRAIN) { E.fused(acc, cur, wr, wc, fr, fq, lds, wid, lane); S.done(cur); }
#undef PG8_SA
#undef PG8_SB
#undef PG8_STAGE
#undef PG8_LDA
#undef PG8_LDB
#undef PG8_MMA
#undef PG8_WAIT_V
#undef PG8_WAIT_L
#undef PG8_BAR
#undef PG8_SCHED
}
}
#define GAS __attribute__((address_space(1)))
#define LAS __attribute__((address_space(3)))
typedef unsigned short bf16;
typedef unsigned v4u __attribute__((ext_vector_type(4)));
typedef float f32x4 __attribute__((ext_vector_type(4)));
typedef short bf16x8 __attribute__((ext_vector_type(8)));
typedef GAS unsigned gu32;
typedef GAS unsigned long long gu64;
#define RLX_AGENT __ATOMIC_RELAXED, __HIP_MEMORY_SCOPE_AGENT
#define LDS_WAIT() asm volatile("s_waitcnt lgkmcnt(0)" ::: "memory")
#define VM_WAIT() asm volatile("s_waitcnt vmcnt(0)" ::: "memory")
__device__ __forceinline__ unsigned long long rt() { return __builtin_amdgcn_s_memrealtime(); }
__device__ __forceinline__ unsigned f2bf(float f) { unsigned u = __builtin_bit_cast(unsigned, f); return (u + 0x7fffu + ((u >> 16) & 1u)) >> 16; }
__device__ __forceinline__ unsigned pk2(float lo, float hi) { return f2bf(lo) | (f2bf(hi) << 16); }

#define XB_TMO      128
#define XB_XCNT(j)  (256  + 64 * (j))
#define XB_XSUB(j)  (1280 + 64 * (j))
#define XB_XGEN(j)  (2304 + 64 * (j))
#define XB_TOP      3328
#define XB_TOPGEN   3392
#define XCD_BAR_WORDS 3456
#define XB_SPIN_CAP (1u << 18)

__device__ __forceinline__ unsigned xb_ld(unsigned* p)              { return __hip_atomic_load(p, __ATOMIC_RELAXED, __HIP_MEMORY_SCOPE_AGENT); }
__device__ __forceinline__ unsigned xb_add(unsigned* p, unsigned v) { return __hip_atomic_fetch_add(p, v, __ATOMIC_RELAXED, __HIP_MEMORY_SCOPE_AGENT); }
__device__ __forceinline__ unsigned xb_xcc_id() { return (unsigned)__builtin_amdgcn_s_getreg((3 << 11) | 20) & 0xFu; }
#define XB_SPIN(cond, bar) do { unsigned _sp = 0; while (cond) { __builtin_amdgcn_s_sleep(1); \
    if ((++_sp & 255u) == 0u) { if (xb_ld(&(bar)[XB_TMO])) break; if (_sp > XB_SPIN_CAP) { atomicAdd(&(bar)[XB_TMO], 1u); break; } } } } while (0)

struct XcdBarrier {
    unsigned* bar; unsigned x;
    volatile LAS unsigned* st;
};

__device__ __forceinline__ XcdBarrier xcd_barrier_post(unsigned* bar, volatile LAS unsigned* st) {
    XcdBarrier b; b.bar = bar; b.x = xb_xcc_id(); b.st = st;
    if (threadIdx.x == 0) (void)xb_add(&bar[XB_XCNT(b.x)], 1u);
    return b;
}
__device__ __forceinline__ void xcd_barrier_complete(unsigned* bar, unsigned x, unsigned& nloc, unsigned& nx) {
    const unsigned G = gridDim.x * gridDim.y * gridDim.z;
    unsigned sum, cnt, mine, sp = 0u;
    for (;;) {
        sum = 0u; cnt = 0u; mine = 0u;
#pragma unroll
        for (unsigned j = 0; j < 16; ++j) { const unsigned c = xb_ld(&bar[XB_XCNT(j)]); sum += c; cnt += (c > 0u) ? 1u : 0u; mine = (j == x) ? c : mine; }
        if (sum == G) break;
        __builtin_amdgcn_s_sleep(1);
        if ((++sp & 255u) == 0u) { if (xb_ld(&bar[XB_TMO])) break; if (sp > XB_SPIN_CAP) { atomicAdd(&bar[XB_TMO], 1u); break; } }
    }
    nloc = mine > 0u ? mine : 1u; nx = cnt > 0u ? cnt : 1u;
}

__device__ __forceinline__ void xcd_barrier(const XcdBarrier& b) {
    asm volatile("s_waitcnt vmcnt(0)" ::: "memory");
    __syncthreads();
    if (threadIdx.x == 0) {
        unsigned* bar = b.bar;
        __builtin_amdgcn_s_waitcnt(0);
        unsigned nloc = b.st[0], nx = b.st[1];
        if (nloc == 0u) { xcd_barrier_complete(bar, b.x, nloc, nx); b.st[0] = nloc; b.st[1] = nx; }
        const unsigned old = xb_add(&bar[XB_XSUB(b.x)], 1u);
        const unsigned gen = old / nloc;
        if (old + 1u == (gen + 1u) * nloc) {
            __builtin_amdgcn_fence(__ATOMIC_RELEASE, "agent");
            asm volatile("s_waitcnt vmcnt(0)" ::: "memory");
            const unsigned og = xb_add(&bar[XB_TOP], 1u);
            const unsigned tg = og / nx;
            if (og + 1u == (tg + 1u) * nx) xb_add(&bar[XB_TOPGEN], 1u);
            else XB_SPIN(xb_ld(&bar[XB_TOPGEN]) == tg, bar);
            __builtin_amdgcn_fence(__ATOMIC_ACQUIRE, "agent");
            xb_add(&bar[XB_XGEN(b.x)], 1u);
            asm volatile("s_waitcnt vmcnt(0)" ::: "memory");
        } else {
            XB_SPIN(xb_ld(&bar[XB_XGEN(b.x)]) == gen, bar);
            __builtin_amdgcn_fence(__ATOMIC_ACQUIRE, "agent");
            asm volatile("s_waitcnt vmcnt(0)" ::: "memory");
        }
    }
    __syncthreads();
}
#include <hip/hip_bf16.h>
#include <cmath>
namespace attn_body {
using bf16=__hip_bfloat16;
using bf16x8=__attribute__((ext_vector_type(8)))short;
using s16x4=__attribute__((ext_vector_type(4)))short;
using f32x16=__attribute__((ext_vector_type(16)))float;
using u32x4=__attribute__((ext_vector_type(4)))unsigned;
constexpr int BATCH=4,NHEAD=8,SEQ=4096,D=64,DM=NHEAD*D;
constexpr int NW=8,QBLK=32,QB=QBLK*NW,KVBLK=64,NQB=SEQ/QB;
constexpr int ATTN_PITCH=DM, ATTN_UNIT_ROWS=QB;
__device__ __forceinline__ int crow(int r,int hi){return (r&3)+8*(r>>2)+4*hi;}
#define SBAR() __builtin_amdgcn_sched_barrier(0)
__device__ __forceinline__ void cmask(f32x16&p0,f32x16&p1,int jb,int qrel,int hi){
  const float NEG=-INFINITY; int kb=64*jb+4*hi;
  #pragma unroll
  for(int r=0;r<16;++r){int kv=kb+(r&3)+8*(r>>2); if(kv>qrel)p0[r]=NEG; if(kv+32>qrel)p1[r]=NEG;}
}

constexpr int NSLOT=3, SLOTB=8192;
constexpr int LDS_K=0, LDS_V=NSLOT*SLOTB, LDS_WS=2*NSLOT*SLOTB, LDS_OST=LDS_WS+NW*64*4, LDS_CK=LDS_OST+NW*4096, LDS_BYTES=LDS_CK+SEQ*4;
constexpr float C2=0.125f*1.4426950408889634f;
__device__ __forceinline__ void glds16(const void*gsrc,unsigned lds_dst){unsigned keep;
  asm volatile("s_mov_b32 %0, m0\n\ts_mov_b32 m0, %2\n\ts_nop 0\n\tglobal_load_lds_dwordx4 %1, off\n\ts_mov_b32 m0, %0":"=&s"(keep):"v"(gsrc),"s"(lds_dst):"memory");}
__device__ __forceinline__ float max3f(float a,float b,float c){float r;asm("v_max3_f32 %0, %1, %2, %3":"=v"(r):"v"(a),"v"(b),"v"(c));return r;}
__device__ __forceinline__ float max2f(float a,float b){float r;asm("v_max_f32_e32 %0, %1, %2":"=v"(r):"v"(a),"v"(b));return r;}
__device__ __forceinline__ float fadd_s(float a,float b){float r;asm("v_add_f32_e32 %0, %1, %2":"=v"(r):"v"(a),"v"(b));return r;}
__device__ __forceinline__ float fsub_s(float a,float b){float r;asm("v_sub_f32_e32 %0, %1, %2":"=v"(r):"v"(a),"v"(b));return r;}
typedef float f32x2_t __attribute__((ext_vector_type(2))); typedef __bf16 bf16x2_t __attribute__((ext_vector_type(2)));
__device__ __forceinline__ unsigned cvtpk_s(float lo,float hi){f32x2_t v={lo,hi};bf16x2_t b=__builtin_convertvector(v,bf16x2_t);return __builtin_bit_cast(unsigned,b);}
#define WAIT_BAR(N) asm volatile("s_waitcnt vmcnt(" #N ") lgkmcnt(0)\n\ts_barrier":::"memory")

__device__ __forceinline__ void qkt(f32x16&p0,f32x16&p1,const char*Kslot,const bf16x8*qr,int r32,int hi){
  const char*kb=Kslot+hi*1024+r32*16;
  #pragma unroll
  for(int d0=0;d0<4;++d0){
    const bf16x8 b0=*reinterpret_cast<const bf16x8*>(kb+d0*2048);
    const bf16x8 b1=*reinterpret_cast<const bf16x8*>(kb+d0*2048+512);
    p0=__builtin_amdgcn_mfma_f32_32x32x16_bf16(b0,qr[d0],p0,0,0,0);p1=__builtin_amdgcn_mfma_f32_32x32x16_bf16(b1,qr[d0],p1,0,0,0);}
}
typedef __attribute__((address_space(3))) const char* lds_cptr;
typedef short v4i16_t __attribute__((ext_vector_type(4)));
__device__ __forceinline__ void kload8(bf16x8*kf,lds_cptr kp){
  kf[0]=*(const __attribute__((address_space(3))) bf16x8*)(kp);      kf[1]=*(const __attribute__((address_space(3))) bf16x8*)(kp+512);
  kf[2]=*(const __attribute__((address_space(3))) bf16x8*)(kp+2048); kf[3]=*(const __attribute__((address_space(3))) bf16x8*)(kp+2560);
  kf[4]=*(const __attribute__((address_space(3))) bf16x8*)(kp+4096); kf[5]=*(const __attribute__((address_space(3))) bf16x8*)(kp+4608);
  kf[6]=*(const __attribute__((address_space(3))) bf16x8*)(kp+6144); kf[7]=*(const __attribute__((address_space(3))) bf16x8*)(kp+6656);
}
__device__ __forceinline__ void kload2(bf16x8*kf,lds_cptr kp,int j){ kf[2*j]=*(const __attribute__((address_space(3))) bf16x8*)(kp+j*2048); kf[2*j+1]=*(const __attribute__((address_space(3))) bf16x8*)(kp+j*2048+512); }
__device__ __forceinline__ s16x4 vtr(lds_cptr p){ return __builtin_bit_cast(s16x4,__builtin_amdgcn_ds_read_tr16_b64_v4i16((__attribute__((address_space(3))) v4i16_t*)p)); }
__device__ __forceinline__ float rowmax(const f32x16&p0,const f32x16&p1){
  float a=max3f(p0[0],p0[1],p1[0]),b=max3f(p0[2],p0[3],p1[1]);a=max3f(a,p1[2],p1[3]);
  #pragma unroll
  for(int r=4;r<16;r+=4){a=max3f(a,p0[r],p0[r+1]);b=max3f(b,p0[r+2],p0[r+3]);a=max3f(a,p1[r],p1[r+1]);b=max3f(b,p1[r+2],p1[r+3]);}
  const float m=max2f(a,b);
  auto rr=__builtin_amdgcn_permlane32_swap(__float_as_uint(m),__float_as_uint(m),false,false);
  return max2f(__uint_as_float(rr[0]),__uint_as_float(rr[1]));
}
__device__ __forceinline__ void pv(f32x16*o,int vb,bf16x8 pa0,bf16x8 pa1,bf16x8 pa2,bf16x8 pa3){
  #pragma unroll
  for(int d0=0;d0<2;++d0){s16x4 lo[4],hi[4];
    #pragma unroll
    for(int ks=0;ks<4;++ks){
      asm volatile("ds_read_b64_tr_b16 %0,%1 offset:%c2":"=&v"(lo[ks]):"v"(vb),"i"(d0*4096+ks*1024):"memory");
      asm volatile("ds_read_b64_tr_b16 %0,%1 offset:%c2":"=&v"(hi[ks]):"v"(vb),"i"(d0*4096+ks*1024+512):"memory");}
    asm volatile("s_waitcnt lgkmcnt(0)":::"memory");SBAR();
    #define PK(k) (bf16x8){lo[k][0],lo[k][1],lo[k][2],lo[k][3],hi[k][0],hi[k][1],hi[k][2],hi[k][3]}
    o[d0]=__builtin_amdgcn_mfma_f32_32x32x16_bf16(pa0,PK(0),o[d0],0,0,0);
    o[d0]=__builtin_amdgcn_mfma_f32_32x32x16_bf16(pa1,PK(1),o[d0],0,0,0);
    o[d0]=__builtin_amdgcn_mfma_f32_32x32x16_bf16(pa2,PK(2),o[d0],0,0,0);
    o[d0]=__builtin_amdgcn_mfma_f32_32x32x16_bf16(pa3,PK(3),o[d0],0,0,0);
    #undef PK
  }
}

#ifndef ATTN_STORE16
#define ATTN_STORE16(p,v) (*(u32x4*)(p)=(v))
#endif
template<int THRL> __device__ __forceinline__ void attn_unit(int b,int h,int qb,const bf16*Q,const bf16*__restrict__ K,const bf16*__restrict__ V,bf16*O,const float*__restrict__ c2,float M2,char*shm){
  int tid=threadIdx.x; asm volatile("":"+v"(tid)); const int lane=tid&63,r32=lane&31,hi=lane>>5; const int wid=__builtin_amdgcn_readfirstlane(tid>>6);
  const long rowbase=(long)b*SEQ; const int q0=qb*QB;
  const bf16*Qw=Q+(rowbase+q0+wid*QBLK)*DM+h*D;
  const bf16*Kh0=K+rowbase*DM+h*D,*Vh0=V+rowbase*DM+h*D;
  const unsigned lds0=(unsigned)(uintptr_t)shm;
  float*wsf=(float*)(shm+LDS_WS)+wid*64;
  const unsigned kdst=lds0+LDS_K+wid*1024, vdst=lds0+LDS_V+wid*1024;
  #define DMA_K(t,slot) glds16(ksrc+(long)(t)*KVBLK*DM,(unsigned)__builtin_amdgcn_readfirstlane(kdst+(slot)))
  #define DMA_V(t,slot) glds16(vsrc+(long)(t)*KVBLK*DM,(unsigned)__builtin_amdgcn_readfirstlane(vdst+(slot)))
  const int vb0=(int)(lds0+LDS_V)+((lane>>4)&1)*32+(lane&3)*8+(4*hi+((lane&15)>>2))*64;
  const char*Kbase=shm+LDS_K; bf16x8 kf[8];
  const lds_cptr shm3=(lds_cptr)shm; const lds_cptr kp0=shm3+LDS_K+hi*1024+r32*16; const lds_cptr vp0=shm3+LDS_V+((lane>>4)&1)*32+(lane&3)*8+(4*hi+((lane&15)>>2))*64;
  const int NT0=(q0+QB)/KVBLK;
  int ts; { const int tl=lane; const float cqa=c2[q0]; const float ckb=(tl<NT0-4)?c2[64*tl+63]:cqa; const unsigned long long bm=__ballot((tl<NT0-4)&&(cqa-ckb< -(40.f+2.f*M2))); ts=__builtin_popcountll(bm)&~1; }
  ts=__builtin_amdgcn_readfirstlane(ts);
  const int NT=NT0-ts;
  const bf16*Kh=Kh0+(long)ts*KVBLK*DM,*Vh=Vh0+(long)ts*KVBLK*DM;
  const bf16*ksrc=Kh+(long)lane*DM+wid*8;
  const bf16*vsrc=Vh+(long)(16*(wid&3)+(lane>>2))*DM+(wid>>2)*32+(lane&3)*8;
  typedef float f32x4_t __attribute__((ext_vector_type(4)));
  int tidl=tid; asm volatile("":"+v"(tidl));
  const int nck4=(q0+QB)/4; f32x4_t ckv0=f32x4_t{},ckv1=f32x4_t{}; if(tidl<nck4)ckv0=((const f32x4_t*)c2)[tidl]; if(tidl+512<nck4)ckv1=((const f32x4_t*)c2)[tidl+512];
  const float cq=c2[q0+wid*QBLK+r32]-M2;
  DMA_K(0,0);DMA_V(0,0);DMA_K(1,SLOTB);
  bf16x8 qr[4];
  #pragma unroll
  for(int d0=0;d0<4;++d0)qr[d0]=*reinterpret_cast<const bf16x8*>(&Qw[(long)r32*DM+d0*16+hi*8]);
  float l_reg=0.f;f32x16 o[2];o[0]=f32x16{};o[1]=f32x16{};
  { __attribute__((address_space(3))) f32x4_t*ckl=(__attribute__((address_space(3))) f32x4_t*)((lds_cptr)shm+LDS_CK); if(tidl<nck4)ckl[tidl]=ckv0; if(tidl+512<nck4)ckl[tidl+512]=ckv1; }
  const __attribute__((address_space(3))) f32x4_t*ckp=(const __attribute__((address_space(3))) f32x4_t*)((lds_cptr)shm+LDS_CK)+hi+ts*16;
  #define CKLD(P0,P1,t) do{ _Pragma("unroll") for(int g_=0;g_<4;++g_){ const f32x4_t a_=ckp[(t)*16+2*g_], b_=ckp[(t)*16+8+2*g_]; P0[4*g_]=a_[0];P0[4*g_+1]=a_[1];P0[4*g_+2]=a_[2];P0[4*g_+3]=a_[3]; P1[4*g_]=b_[0];P1[4*g_+1]=b_[1];P1[4*g_+2]=b_[2];P1[4*g_+3]=b_[3]; } }while(0)
  #define CKSUB(P0,P1) do{ _Pragma("unroll") for(int r=0;r<16;++r){P0[r]=cq-P0[r];P1[r]=cq-P1[r];} }while(0)
  const int qrel=wid*QBLK+r32;
  #define CMASK(P0,P1,t) do{int jb_=(t)-(NT-4); if(jb_>=0)cmask(P0,P1,jb_,qrel,hi);}while(0)
  #define START(P0,P1) do{ _Pragma("unroll") for(int r=0;r<16;++r)P0[r]=__builtin_amdgcn_exp2f(P0[r]); }while(0)
  #define RESC() do{}while(0)
  f32x16 pA0,pA1,pB0,pB1;
  int sl_prev=0,sl_cur=0,sl_next=SLOTB;
  #define ROT() do{sl_prev=sl_cur;sl_cur=sl_next;sl_next=(sl_next==(NSLOT-1)*SLOTB)?0:sl_next+SLOTB;}while(0)
  DMA_K(2,2*SLOTB);
  WAIT_BAR(3);
  CKLD(pA0,pA1,0);CKSUB(pA0,pA1);
  qkt(pA0,pA1,Kbase,qr,r32,hi);asm volatile("s_nop 15\n\ts_nop 7":"+v"(pA0),"+v"(pA1));CMASK(pA0,pA1,0);
  CKLD(pB0,pB1,1);CKSUB(pB0,pB1);
  START(pA0,pA1);
  _Pragma("unroll") for(int r=0;r<16;++r)pA1[r]=__builtin_amdgcn_exp2f(pA1[r]);
  WAIT_BAR(0);
  DMA_K(3,0);DMA_V(1,SLOTB);
  ROT();
  kload8(kf,kp0+sl_cur);
  WAIT_BAR(2);
  s16x4 vlo[8],vhi[8]; u32x4 pw0,pw1,pw2,pw3;
  #define PKW(P,B) cvtpk_s(P[B],P[B+1])
  #define PAF(k) __builtin_bit_cast(bf16x8,pw##k)
  #define VFR(i) (bf16x8){vlo[i][0],vlo[i][1],vlo[i][2],vlo[i][3],vhi[i][0],vhi[i][1],vhi[i][2],vhi[i][3]}
  #define PIN(x) asm volatile("":"+v"(x))
  #define MX3(a,b,c) __builtin_fmaxf(__builtin_fmaxf((a),(b)),(c))
  #define GAPA(MF,A0,A1,A2,A3,W0,W1,PW) do{ MF; sacc+=A0; sacc+=A1; sacc+=A2; sacc+=A3; PIN(sacc); W0; W1; PIN(PW); SBAR(); }while(0)
  #define EX(v) __builtin_amdgcn_exp2f(v)
  #define GAPB(MF,X,B) do{ MF; X[B]=EX(X[B]); X[B+1]=EX(X[B+1]); X[B+2]=EX(X[B+2]); X[B+3]=EX(X[B+3]); PIN(X); SBAR(); }while(0)
  #define VRD(i) do{ vlo[i]=vtr(vp_+(((i)>>2)*4096+((i)&3)*1024)); vhi[i]=vtr(vp_+(((i)>>2)*4096+((i)&3)*1024+512)); }while(0)
  #define KRD(G,j) do{ if(G){ kload2(kf,kp0+sl_next,j); SBAR(); } }while(0)
  #define STEP(C0,C1,P0,P1,t,GK,GV,GL) do{ SBAR(); \
    const lds_cptr vp_=vp0+sl_prev; \
    VRD(0); SBAR(); float sacc=(P0[0]+P0[1]); \
    GAPA(C0=__builtin_amdgcn_mfma_f32_32x32x16_bf16(kf[0],qr[0],C0,0,0,0), P0[2],P0[3],P0[4],P0[5],     pw0[0]=PKW(P0,0), pw0[1]=PKW(P0,2), pw0); \
    VRD(4); SBAR(); GAPA(C1=__builtin_amdgcn_mfma_f32_32x32x16_bf16(kf[1],qr[0],C1,0,0,0), P0[6],P0[7],P0[8],P0[9],     pw0[2]=PKW(P0,4), pw0[3]=PKW(P0,6), pw0); \
    VRD(1); SBAR(); GAPA(C0=__builtin_amdgcn_mfma_f32_32x32x16_bf16(kf[2],qr[1],C0,0,0,0),   P0[10],P0[11],P0[12],P0[13], pw1[0]=PKW(P0,8), pw1[1]=PKW(P0,10), pw1); \
    VRD(5); SBAR(); GAPA(C1=__builtin_amdgcn_mfma_f32_32x32x16_bf16(kf[3],qr[1],C1,0,0,0),   P0[14],P0[15],P1[0],P1[1],   pw1[2]=PKW(P0,12),pw1[3]=PKW(P0,14), pw1); \
    VRD(2); SBAR(); GAPA(C0=__builtin_amdgcn_mfma_f32_32x32x16_bf16(kf[4],qr[2],C0,0,0,0),   P1[2],P1[3],P1[4],P1[5],     pw2[0]=PKW(P1,0), pw2[1]=PKW(P1,2), pw2); \
    VRD(6); SBAR(); GAPA(C1=__builtin_amdgcn_mfma_f32_32x32x16_bf16(kf[5],qr[2],C1,0,0,0),   P1[6],P1[7],P1[8],P1[9],     pw2[2]=PKW(P1,4), pw2[3]=PKW(P1,6), pw2); \
    VRD(3); SBAR(); GAPA(C0=__builtin_amdgcn_mfma_f32_32x32x16_bf16(kf[6],qr[3],C0,0,0,0),   P1[10],P1[11],P1[12],P1[13], pw3[0]=PKW(P1,8), pw3[1]=PKW(P1,10), pw3); \
    VRD(7); SBAR(); GAPA(C1=__builtin_amdgcn_mfma_f32_32x32x16_bf16(kf[7],qr[3],C1,0,0,0),   P1[14],P1[15],0.f,0.f,       pw3[2]=PKW(P1,12),pw3[3]=PKW(P1,14), pw3); \
    l_reg+=sacc; \
    if(GK){DMA_K((t)+3,sl_cur);} if(GV){DMA_V((t)+1,sl_next);} \
    CMASK(C0,C1,t); \
    SBAR(); \
    GAPB(o[0]=__builtin_amdgcn_mfma_f32_32x32x16_bf16(PAF(0),VFR(0),o[0],0,0,0), C0,0); \
    GAPB(o[1]=__builtin_amdgcn_mfma_f32_32x32x16_bf16(PAF(0),VFR(4),o[1],0,0,0), C0,4); \
    KRD(GL,0); GAPB(o[0]=__builtin_amdgcn_mfma_f32_32x32x16_bf16(PAF(1),VFR(1),o[0],0,0,0), C0,8); \
    KRD(GL,1); GAPB(o[1]=__builtin_amdgcn_mfma_f32_32x32x16_bf16(PAF(1),VFR(5),o[1],0,0,0), C0,12); \
    KRD(GL,2); GAPB(o[0]=__builtin_amdgcn_mfma_f32_32x32x16_bf16(PAF(2),VFR(2),o[0],0,0,0), C1,0); \
    KRD(GL,3); GAPB(o[1]=__builtin_amdgcn_mfma_f32_32x32x16_bf16(PAF(2),VFR(6),o[1],0,0,0), C1,4); \
    GAPB(o[0]=__builtin_amdgcn_mfma_f32_32x32x16_bf16(PAF(3),VFR(3),o[0],0,0,0), C1,8); \
    GAPB(o[1]=__builtin_amdgcn_mfma_f32_32x32x16_bf16(PAF(3),VFR(7),o[1],0,0,0), C1,12); \
    if(GL){ CKLD(P0,P1,(t)+1); CKSUB(P0,P1); } \
    }while(0)
  int t=1;
  #undef CMASK
  #define CMASK(P0,P1,t) do{}while(0)
  for(;t+5<NT;t+=2){
    STEP(pB0,pB1,pA0,pA1,t,true,true,true);     WAIT_BAR(2); RESC(); ROT();
    STEP(pA0,pA1,pB0,pB1,t+1,true,true,true);   WAIT_BAR(2); RESC(); ROT();
  }
  #undef CMASK
  #define CMASK(P0,P1,t) do{int jb_=(t)-(NT-4); if(jb_>=0)cmask(P0,P1,jb_,qrel,hi);}while(0)
  #define ENDW(tt) do{ if((tt)+3<NT){WAIT_BAR(2);} else if((tt)+2<NT){WAIT_BAR(1);} else {WAIT_BAR(0);} }while(0)
  for(;t+1<NT;t+=2){
    STEP(pB0,pB1,pA0,pA1,t,(t+3<NT),(t+1<NT),(t+1<NT));       ENDW(t);   RESC(); ROT();
    STEP(pA0,pA1,pB0,pB1,t+1,(t+4<NT),(t+2<NT),(t+2<NT));     ENDW(t+1); RESC(); ROT();
  }
  STEP(pB0,pB1,pA0,pA1,NT-1,false,false,false); RESC();
  { float sacc=pB0[0]+pB0[1]; _Pragma("unroll") for(int r=2;r<16;++r)sacc+=pB0[r]; _Pragma("unroll") for(int r=0;r<16;++r)sacc+=pB1[r]; l_reg+=sacc;
    pw0=(u32x4){PKW(pB0,0),PKW(pB0,2),PKW(pB0,4),PKW(pB0,6)};pw1=(u32x4){PKW(pB0,8),PKW(pB0,10),PKW(pB0,12),PKW(pB0,14)};pw2=(u32x4){PKW(pB1,0),PKW(pB1,2),PKW(pB1,4),PKW(pB1,6)};pw3=(u32x4){PKW(pB1,8),PKW(pB1,10),PKW(pB1,12),PKW(pB1,14)};
    SBAR(); pv(o,vb0+sl_cur,PAF(0),PAF(1),PAF(2),PAF(3)); }
  #undef PKW
  #undef PAF
  #undef VFR
  #undef PIN
  #undef MX3
  #undef GAPA
  #undef GAPB
  #undef EX
  #undef VRD
  #undef KRD
  #undef STEP
  #undef ENDW
  {auto rr=__builtin_amdgcn_permlane32_swap(__float_as_uint(l_reg),__float_as_uint(l_reg),false,false);l_reg=__uint_as_float(rr[0])+__uint_as_float(rr[1]);}
  if(hi==0)wsf[32+r32]=l_reg;asm volatile("s_waitcnt lgkmcnt(0)":::"memory");
  float rli[16];
  #pragma unroll
  for(int r=0;r<16;++r)rli[r]=__builtin_amdgcn_rcpf(wsf[32+crow(r,hi)]);
  bf16*Ow=O+(rowbase+q0+wid*QBLK)*DM+h*D;
  { bf16*stg=(bf16*)(shm+LDS_OST)+wid*2048;
    #pragma unroll
    for(int r=0;r<16;++r){const int orow=crow(r,hi);
      #pragma unroll
      for(int d0=0;d0<2;++d0)stg[orow*64+d0*32+r32]=__float2bfloat16(o[d0][r]*rli[r]);}
    asm volatile("s_waitcnt lgkmcnt(0)":::"memory");
    #pragma unroll
    for(int i=0;i<4;++i){const int row=i*8+(lane>>3),ch=lane&7; const u32x4 v=*(const u32x4*)(stg+row*64+ch*8); ATTN_STORE16(Ow+(long)row*DM+ch*8,v);} }
  asm volatile("s_waitcnt lgkmcnt(0)\n\ts_barrier":::"memory");
  #undef DMA_K
  #undef DMA_V
  #undef CMASK
  #undef START
  #undef RESC
  #undef ROT
  #undef CKLD
  #undef CKSUB
}
constexpr int ATTN_LDS_BYTES=LDS_BYTES;
struct AttnTensors { const bf16* Q; const bf16* K; const bf16* V; bf16* O; const float* C2T; float M2; };
struct AttnUnit { int bh; int qb; };
struct StaticOrder {
  int vcu, G;
  __device__ __forceinline__ explicit StaticOrder(int grid,int v):vcu(v),G(grid){}
  __device__ __forceinline__ bool next(int i,AttnUnit&u)const{ const int L=i*G+vcu; if(L>=BATCH*NHEAD*NQB)return false; const int r=L>>8, idx=L&255, k=idx&7; u.bh=idx>>3; u.qb=(r==0)?(NQB-1-k):k; return true; }
  __device__ __forceinline__ void a_ready(const AttnUnit&)const{}
  __device__ __forceinline__ void done(const AttnUnit&)const{}
};
template<class Sched,int THRL=8> __device__ __forceinline__ void attn_phase(char*lds,const AttnTensors&T,const Sched&S){
  AttnUnit u;
  for(int i=0;S.next(i,u);++i){ S.a_ready(u); attn_unit<THRL>(u.bh/NHEAD,u.bh%NHEAD,u.qb,T.Q,T.K,T.V,T.O,T.C2T+(size_t)u.bh*SEQ,T.M2,lds); S.done(u); }
}
#undef SBAR
#undef WAIT_BAR
}

constexpr int NWAVES = 8, NTHR = 512;
constexpr int DM = 1024, NB = 4, SEQ = 4096, DB = 128, DSEQ = 8, PAST = 2048, PAGE = 128, NPAGES = 16;
constexpr int MP = NB * SEQ, MS = DB * DSEQ, M = MP + MS;
constexpr int DP = 512, DA = 512, NH = 8, HD = 64, DIN = 4104, NPROJ = 4096;
constexpr int NKEYS = 128, NEXP = 16384, PH = 8, TOPK = 16, DKH = 128, DQ = 2048;
constexpr float EPS = 1e-6f;
constexpr float LOG2E = 1.4426950408889634f;
constexpr float C2 = 0.125f * LOG2E;
constexpr size_t O_YP = 0, O_YS = O_YP + (size_t)MP * DM, O_KP = O_YS + (size_t)MS * DM, O_VP = O_KP + (size_t)MP * DA, O_LFP = O_VP + (size_t)MP * DA,
                 O_PP = O_LFP + (size_t)MP * NH, O_KS = O_PP + (size_t)NB * 15 * DP, O_VS = O_KS + (size_t)MS * DA, O_LFS = O_VS + (size_t)MS * DA,
                 O_PS = O_LFS + (size_t)MS * NH, O_END = O_PS + (size_t)DB * 15 * DP;
constexpr size_t MiB = 1u << 20;
constexpr size_t WS_CTL = 0, CTL_ZERO_BYTES = 1 * MiB;
constexpr size_t WS_WIN = 2 * MiB, WS_WBP = 10 * MiB, WS_WBA = 11 * MiB, WS_WOUT = 12 * MiB, WS_WQ = 14 * MiB, WS_SUBK = 18 * MiB, WS_CP2 = 19 * MiB, WS_RSS = 20 * MiB, WS_US = 22 * MiB, WS_VS = 23 * MiB;
constexpr size_t WS_PU = 32 * MiB, WS_PV = 64 * MiB, WS_XN = 96 * MiB  , WS_U = 132 * MiB, WS_Q = 150 * MiB, WS_K = 168 * MiB, WS_V = 186 * MiB,
                 WS_GA = 204 * MiB, WS_GB = 240 * MiB, WS_PO = 276 * MiB, WS_AO = 294 * MiB, WS_T = 312 * MiB, WS_MIX = 348 * MiB, WS_PQ = 384 * MiB,
                 WS_SI = 456 * MiB, WS_SG = 466 * MiB, WS_H = 476 * MiB, WS_END = 548 * MiB;
constexpr int CW_BAR = 4096;
constexpr int LDS_BYTES = 163840;
constexpr int SCR_BYTES = 159 * 1024;
constexpr int MISC_OFF = SCR_BYTES;

typedef unsigned short bf16;
typedef unsigned v4u __attribute__((ext_vector_type(4)));
typedef unsigned v2u __attribute__((ext_vector_type(2)));
typedef float f32x4 __attribute__((ext_vector_type(4)));
typedef float f32x2 __attribute__((ext_vector_type(2)));

__device__ __forceinline__ float bf2f(unsigned short b) { return __uint_as_float((unsigned)b << 16); }
__device__ __forceinline__ float bflo(unsigned w) { return __uint_as_float(w << 16); }
__device__ __forceinline__ float bfhi(unsigned w) { return __uint_as_float(w & 0xffff0000u); }
typedef __bf16 bf16x2_t __attribute__((ext_vector_type(2)));
__device__ __forceinline__ unsigned pkbf(float lo, float hi) { f32x2 v = {lo, hi}; bf16x2_t b = __builtin_convertvector(v, bf16x2_t); return __builtin_bit_cast(unsigned, b); }
__device__ __forceinline__ float wave_sum(float v) {
#pragma unroll
    for (int o = 1; o < 64; o <<= 1) v += __shfl_xor(v, o);
    return v;
}
__device__ __forceinline__ float wave_max(float v) {
#pragma unroll
    for (int o = 1; o < 64; o <<= 1) v = fmaxf(v, __shfl_xor(v, o));
    return v;
}

struct Args {
    const float* x_p; const float* x_s; const float* cache_k; const float* cache_v; const float* cache_lf; const float* state_pool; const int* page_table;
    const float* norm_mix_g; const float* w_in; const float* b_forget; const float* q_norm_g; const float* k_norm_g; const float* pool_mix_w; const float* pool_scale;
    const float* w_bp; const float* w_ba; const float* w_out; const float* norm_ffn_g; const float* w_query; const float* sub_keys; const float* peer_u; const float* peer_v;
    float* out; unsigned char* ws; int ph_lo, ph_hi, li, pad;
};

using pg8::Unit;
struct EpiInProj {
    static constexpr bool PERM = true, AFTER_DRAIN = false;
    bf16 *U, *Q, *K, *V, *GA, *GB; float* out; const float *gq, *gk;
    __device__ __forceinline__ void operator()(const f32x4 (&acc)[2][2][4][2], const Unit& u, int wr, int wc, int fr, int fq) const {
        const int pn = u.pn; const int row0 = u.pm * 256 + wr * 64 + fr; const bool prompt = u.pm < (MP / 256);
        if (pn < 2) {
#pragma unroll
            for (int ai = 0; ai < 2; ++ai)
#pragma unroll
                for (int m = 0; m < 4; ++m) { const int row = row0 + ai * 128 + m * 16;
                    float* tail = nullptr;
                    if (prompt) { const int s = row & (SEQ - 1), b = row >> 12; if (s >= SEQ - 15) tail = out + O_PP + (size_t)(b * 15 + (s - (SEQ - 15))) * DP; }
                    else { const int rs = row - MP; tail = out + O_PS + (size_t)((rs >> 3) * 15 + 7 + (rs & 7)) * DP; }
#pragma unroll
                    for (int bj = 0; bj < 2; ++bj) { const int col = pn * 256 + bj * 128 + wc * 32 + 8 * fq; const f32x4 v0 = acc[ai][bj][m][0], v1 = acc[ai][bj][m][1];
                        v4u w; w.x = pkbf(v0[0], v0[1]); w.y = pkbf(v0[2], v0[3]); w.z = pkbf(v1[0], v1[1]); w.w = pkbf(v1[2], v1[3]);
                        *(v4u*)(U + (size_t)row * DP + col) = w;
                        if (tail) { *(f32x4*)(tail + col) = v0; *(f32x4*)(tail + col + 4) = v1; } } }
        } else if (pn < 6) {
            const bool isq = pn < 4; const int head = 4 * (pn & 1) + wc; const float* g = isq ? gq : gk;
            f32x4 gv[2][2];
#pragma unroll
            for (int bj = 0; bj < 2; ++bj)
#pragma unroll
                for (int n = 0; n < 2; ++n) gv[bj][n] = *(const f32x4*)(g + 32 * bj + 8 * fq + 4 * n);
            bf16* dst = isq ? Q : K;
#pragma unroll
            for (int ai = 0; ai < 2; ++ai)
#pragma unroll
                for (int m = 0; m < 4; ++m) { const int row = row0 + ai * 128 + m * 16; float ss = 0.f;
#pragma unroll
                    for (int bj = 0; bj < 2; ++bj)
#pragma unroll
                        for (int n = 0; n < 2; ++n) { const f32x4 x = acc[ai][bj][m][n]; ss += (x[0] * x[0] + x[1] * x[1]) + (x[2] * x[2] + x[3] * x[3]); }
                    ss += __shfl_xor(ss, 16); ss += __shfl_xor(ss, 32);
                    float r = 1.0f / sqrtf(ss * (1.0f / 64.0f) + EPS);
                    float* kout = isq ? nullptr : (prompt ? out + O_KP + (size_t)row * DA : out + O_KS + (size_t)(row - MP) * DA);
                    const float rq = isq ? r * C2 : r;
#pragma unroll
                    for (int bj = 0; bj < 2; ++bj) { const int col = head * 64 + 32 * bj + 8 * fq; const f32x4 v0 = acc[ai][bj][m][0] * gv[bj][0] * rq, v1 = acc[ai][bj][m][1] * gv[bj][1] * rq;
                        v4u w; w.x = pkbf(v0[0], v0[1]); w.y = pkbf(v0[2], v0[3]); w.z = pkbf(v1[0], v1[1]); w.w = pkbf(v1[2], v1[3]);
                        *(v4u*)(dst + (size_t)row * DA + col) = w;
                        if (!isq) { *(f32x4*)(kout + col) = v0; *(f32x4*)(kout + col + 4) = v1; } } }
        } else if (pn < 8) {
#pragma unroll
            for (int ai = 0; ai < 2; ++ai)
#pragma unroll
                for (int m = 0; m < 4; ++m) { const int row = row0 + ai * 128 + m * 16;
                    float* vout = prompt ? out + O_VP + (size_t)row * DA : out + O_VS + (size_t)(row - MP) * DA;
#pragma unroll
                    for (int bj = 0; bj < 2; ++bj) { const int col = (pn - 6) * 256 + bj * 128 + wc * 32 + 8 * fq; const f32x4 v0 = acc[ai][bj][m][0], v1 = acc[ai][bj][m][1];
                        v4u w; w.x = pkbf(v0[0], v0[1]); w.y = pkbf(v0[2], v0[3]); w.z = pkbf(v1[0], v1[1]); w.w = pkbf(v1[2], v1[3]);
                        *(v4u*)(V + (size_t)row * DA + col) = w; *(f32x4*)(vout + col) = v0; *(f32x4*)(vout + col + 4) = v1; } }
        } else {
            bf16* dst = pn < 12 ? GA : GB; const int ct = (pn < 12 ? pn - 8 : pn - 12) * 256;
#pragma unroll
            for (int ai = 0; ai < 2; ++ai)
#pragma unroll
                for (int m = 0; m < 4; ++m) { const int row = row0 + ai * 128 + m * 16;
#pragma unroll
                    for (int bj = 0; bj < 2; ++bj) { const int col = ct + bj * 128 + wc * 32 + 8 * fq; float s[8];
#pragma unroll
                        for (int n = 0; n < 2; ++n)
#pragma unroll
                            for (int i = 0; i < 4; ++i) s[4 * n + i] = __builtin_amdgcn_rcpf(1.0f + __builtin_amdgcn_exp2f(-LOG2E * acc[ai][bj][m][n][i]));
                        v4u w; w.x = pkbf(s[0], s[1]); w.y = pkbf(s[2], s[3]); w.z = pkbf(s[4], s[5]); w.w = pkbf(s[6], s[7]);
                        *(v4u*)(dst + (size_t)row * DM + col) = w; } }
        }
    }
};
template <int MODE> struct EpiGate {
    static constexpr bool PERM = true, AFTER_DRAIN = false;
    const bf16* G; const bf16* Tin; bf16* O;
    __device__ __forceinline__ void operator()(const f32x4 (&acc)[2][2][4][2], const Unit& u, int wr, int wc, int fr, int fq) const {
        const int row0 = u.pm * 256 + wr * 64 + fr;
#pragma unroll
        for (int ai = 0; ai < 2; ++ai)
#pragma unroll
            for (int m = 0; m < 4; ++m) { const int row = row0 + ai * 128 + m * 16;
#pragma unroll
                for (int bj = 0; bj < 2; ++bj) { const size_t off = (size_t)row * DM + u.pn * 256 + bj * 128 + wc * 32 + 8 * fq;
                    const v4u g = *(const v4u*)(G + off); const f32x4 v0 = acc[ai][bj][m][0], v1 = acc[ai][bj][m][1];
                    float r[8] = {v0[0] * bflo(g.x), v0[1] * bfhi(g.x), v0[2] * bflo(g.y), v0[3] * bfhi(g.y), v1[0] * bflo(g.z), v1[1] * bfhi(g.z), v1[2] * bflo(g.w), v1[3] * bfhi(g.w)};
                    if (MODE == 1) { const v4u t = *(const v4u*)(Tin + off);
                        r[0] += bflo(t.x); r[1] += bfhi(t.x); r[2] += bflo(t.y); r[3] += bfhi(t.y); r[4] += bflo(t.z); r[5] += bfhi(t.z); r[6] += bflo(t.w); r[7] += bfhi(t.w); }
                    v4u w; w.x = pkbf(r[0], r[1]); w.y = pkbf(r[2], r[3]); w.z = pkbf(r[4], r[5]); w.w = pkbf(r[6], r[7]);
                    *(v4u*)(O + off) = w; } }
    }
};
struct EpiOut {
    static constexpr bool PERM = true, AFTER_DRAIN = false;
    const float* xp; const float* xs; float* H; bf16* HG; const float* gf; float* RSS;
    __device__ __forceinline__ void operator()(const f32x4 (&acc)[2][2][4][2], const Unit& u, int wr, int wc, int fr, int fq) const {
        const int row0 = u.pm * 256 + wr * 64 + fr; const bool prompt = u.pm < (MP / 256);
        f32x4 gv[2][2];
#pragma unroll
        for (int bj = 0; bj < 2; ++bj)
#pragma unroll
            for (int n = 0; n < 2; ++n) gv[bj][n] = *(const f32x4*)(gf + u.pn * 256 + bj * 128 + wc * 32 + 8 * fq + 4 * n);
#pragma unroll
        for (int ai = 0; ai < 2; ++ai)
#pragma unroll
            for (int m = 0; m < 4; ++m) { const int row = row0 + ai * 128 + m * 16; float ss = 0.f;
                const float* xr = prompt ? xp + (size_t)row * DM : xs + (size_t)(row - MP) * DM;
#pragma unroll
                for (int bj = 0; bj < 2; ++bj) { const int col = u.pn * 256 + bj * 128 + wc * 32 + 8 * fq;
                    const f32x4 h0 = acc[ai][bj][m][0] + *(const f32x4*)(xr + col), h1 = acc[ai][bj][m][1] + *(const f32x4*)(xr + col + 4);
                    ss += (h0[0] * h0[0] + h0[1] * h0[1]) + (h0[2] * h0[2] + h0[3] * h0[3]) + (h1[0] * h1[0] + h1[1] * h1[1]) + (h1[2] * h1[2] + h1[3] * h1[3]);
                    *(f32x4*)(H + (size_t)row * DM + col) = h0; *(f32x4*)(H + (size_t)row * DM + col + 4) = h1;
                    const f32x4 a0 = h0 * gv[bj][0], a1 = h1 * gv[bj][1];
                    v4u w; w.x = pkbf(a0[0], a0[1]); w.y = pkbf(a0[2], a0[3]); w.z = pkbf(a1[0], a1[1]); w.w = pkbf(a1[2], a1[3]);
                    *(v4u*)(HG + (size_t)row * DM + col) = w; }
                ss += __shfl_xor(ss, 16); ss += __shfl_xor(ss, 32);
                if (fq == 0) RSS[(size_t)row * 16 + u.pn * 4 + wc] = ss; }
    }
};

struct Frame {
    LAS unsigned char* lds; volatile LAS unsigned* MISC; gu32* ctl;
    int tid, lane, wave, vcu, G;
};

__device__ __forceinline__ void transpose_item(const float* W, int ldw, int K, bf16* WT, int src_col0, int dst_row0, int k0, LAS float* scr, int lane) {
#pragma unroll 8
    for (int i = 0; i < 32; ++i) { const int kk = 2 * i + (lane >> 5); scr[kk * 33 + (lane & 31)] = W[(size_t)(k0 + kk) * ldw + src_col0 + (lane & 31)]; }
    LDS_WAIT(); asm volatile("" ::: "memory");
    const int c = lane & 7;
#pragma unroll
    for (int j = 0; j < 4; ++j) { const int n = (lane >> 3) + 8 * j; const LAS float* s = scr + (8 * c) * 33 + n;
        v4u o; o.x = pkbf(s[0 * 33], s[1 * 33]); o.y = pkbf(s[2 * 33], s[3 * 33]); o.z = pkbf(s[4 * 33], s[5 * 33]); o.w = pkbf(s[6 * 33], s[7 * 33]);
        *(v4u*)(WT + (size_t)(dst_row0 + n) * K + k0 + 8 * c) = o; }
    LDS_WAIT(); asm volatile("" ::: "memory");
}
__device__ __forceinline__ int win_src_col(int db) {
    if (db < 16) return 32 * db;
    if (db < 48) { const int base = db < 32 ? 512 : 1024; const int local = (db - 16) & 15, tile = local >> 3, blk = local & 7, bj = blk >> 2, w = blk & 3; return base + tile * 256 + 64 * w + 32 * bj; }
    if (db < 64) return 1536 + 32 * (db - 48);
    if (db < 96) return 2056 + 32 * (db - 64);
    return 3080 + 32 * (db - 96);
}
__device__ __forceinline__ void cvt_rows_bf16(const float* src, bf16* dst, size_t n8, size_t gtid, size_t gn) {
    for (size_t i = gtid; i < n8; i += gn) { const f32x4 a = *(const f32x4*)(src + 8 * i), b = *(const f32x4*)(src + 8 * i + 4);
        v4u w; w.x = pkbf(a[0], a[1]); w.y = pkbf(a[2], a[3]); w.z = pkbf(b[0], b[1]); w.w = pkbf(b[2], b[3]); *(v4u*)(dst + 8 * i) = w; }
}
__device__ __forceinline__ void cvt_rows_fp8(const float* src, unsigned char* dst, float* scl, int gw, int NGW, int lane) {
    for (int e0 = gw; e0 < NEXP; e0 += 2 * NGW) {
        f32x4 q[2][4]; float mx[2];
#pragma unroll
        for (int u = 0; u < 2; ++u) { const int e = (e0 + u * NGW < NEXP) ? e0 + u * NGW : e0; const float* r = src + (size_t)e * DM + 16 * lane;
            q[u][0] = *(const f32x4*)r; q[u][1] = *(const f32x4*)(r + 4); q[u][2] = *(const f32x4*)(r + 8); q[u][3] = *(const f32x4*)(r + 12); }
#pragma unroll
        for (int u = 0; u < 2; ++u) { float m = 0.f;
#pragma unroll
            for (int j = 0; j < 4; ++j) m = fmaxf(m, fmaxf(fmaxf(fabsf(q[u][j][0]), fabsf(q[u][j][1])), fmaxf(fabsf(q[u][j][2]), fabsf(q[u][j][3]))));
            mx[u] = m; }
#pragma unroll
        for (int o = 1; o < 64; o <<= 1) { mx[0] = fmaxf(mx[0], __shfl_xor(mx[0], o)); mx[1] = fmaxf(mx[1], __shfl_xor(mx[1], o)); }
#pragma unroll
        for (int u = 0; u < 2; ++u) { const int e = e0 + u * NGW; if (e < NEXP) {
            int k = 0; if (mx[u] > 1e-30f) k = 7 - ((int)((__builtin_bit_cast(unsigned, mx[u]) >> 23) & 0xffu) - 127);
            k = k < -100 ? -100 : (k > 100 ? 100 : k);
            const float sc = __builtin_bit_cast(float, (unsigned)(k + 127) << 23), isc = __builtin_bit_cast(float, (unsigned)(127 - k) << 23);
            int w[4];
#pragma unroll
            for (int j = 0; j < 4; ++j) { w[j] = 0; w[j] = __builtin_amdgcn_cvt_pk_fp8_f32(q[u][j][0] * sc, q[u][j][1] * sc, w[j], false); w[j] = __builtin_amdgcn_cvt_pk_fp8_f32(q[u][j][2] * sc, q[u][j][3] * sc, w[j], true); }
            *(v4u*)(dst + (size_t)(lane >> 3) * ((size_t)NEXP * 128) + (size_t)e * 128 + 16 * (lane & 7)) = (v4u){(unsigned)w[0], (unsigned)w[1], (unsigned)w[2], (unsigned)w[3]};
            if (lane == 0) scl[e] = isc; } }
    }
}
__device__ __forceinline__ void p0_prologue(Frame& F, const Args& a) {
    unsigned char* ws = a.ws;
    LAS float* scr = (LAS float*)(F.lds + F.wave * 16384);
    const int gw = F.vcu * NWAVES + F.wave, NGW = F.G * NWAVES;
    for (int it = gw; it < 4096; it += NGW) {
        int r = it;
        if (r < 2048) { const int kb = r >> 7, db = r & 127; transpose_item(a.w_in, DIN, DM, (bf16*)(ws + WS_WIN), win_src_col(db), 32 * db, 64 * kb, scr, F.lane); continue; } r -= 2048;
        if (r < 256) { continue; } r -= 256;
        if (r < 256) { const int kb = r >> 5, nb = r & 31; transpose_item(a.w_ba, DM, DA, (bf16*)(ws + WS_WBA), 32 * nb, 32 * nb, 64 * kb, scr, F.lane); continue; } r -= 256;
        if (r < 512) { const int kb = r >> 5, nb = r & 31; transpose_item(a.w_out, DM, DM, (bf16*)(ws + WS_WOUT), 32 * nb, 32 * nb, 64 * kb, scr, F.lane); continue; } r -= 512;
        { const int kb = r >> 6, nb = r & 63; transpose_item(a.w_query, DQ, DM, (bf16*)(ws + WS_WQ), 32 * nb, 32 * nb, 64 * kb, scr, F.lane); }
    }
    for (int it = gw; it < 16 * 4 * 16; it += NGW) { const int nb = it & 15, g = (it >> 4) & 3, cb = it >> 6; const int nn = 64 * nb + F.lane; float acc8[8];
#pragma unroll
        for (int i = 0; i < 8; ++i) acc8[i] = 0.f;
        const float* pm = a.pool_mix_w + (size_t)g * 16384 + (size_t)(8 * cb) * 128;
#pragma unroll 16
        for (int d = 0; d < 128; ++d) { const float wv = a.w_bp[(size_t)(g * 128 + d) * DM + nn] * a.pool_scale[g * 128 + d];
#pragma unroll
            for (int i = 0; i < 8; ++i) acc8[i] += pm[i * 128 + d] * wv; }
        v4u o; o.x = pkbf(acc8[0], acc8[1]); o.y = pkbf(acc8[2], acc8[3]); o.z = pkbf(acc8[4], acc8[5]); o.w = pkbf(acc8[6], acc8[7]);
        *(v4u*)((bf16*)(ws + WS_WBP) + (size_t)nn * DP + g * 128 + 8 * cb) = o; }
    { const size_t gtid = (size_t)F.vcu * NTHR + F.tid, gn = (size_t)F.G * NTHR;
      cvt_rows_fp8(a.peer_u, ws + WS_PU, (float*)(ws + WS_US), gw, NGW, F.lane);
      cvt_rows_fp8(a.peer_v, ws + WS_PV, (float*)(ws + WS_VS), gw, NGW, F.lane);
      cvt_rows_bf16(a.sub_keys, (bf16*)(ws + WS_SUBK), (size_t)PH * 2 * NKEYS * DKH / 8, gtid, gn);
      for (size_t i = gtid; i < (size_t)DB * 7 * DP; i += gn) { const int b = (int)(i / (7 * DP)), j = (int)((i / DP) % 7), c = (int)(i % DP);
          a.out[O_PS + (size_t)(b * 15 + j) * DP + c] = a.state_pool[(size_t)(b * 15 + 8 + j) * DP + c]; } }
    __syncthreads();
    LAS float* wfT = (LAS float*)F.lds;
    for (int i = F.tid; i < 8 * DM; i += NTHR) { const int col = i >> 3, h = i & 7; wfT[h * DM + col] = a.w_in[(size_t)col * DIN + 2048 + h]; }
    __syncthreads();
    bf16* XN = (bf16*)(ws + WS_XN);
    for (int row0 = gw; row0 < M; row0 += 2 * NGW) {
        f32x4 v[2][4]; float rr[2], f[2][8]; bool ok[2];
#pragma unroll
        for (int u = 0; u < 2; ++u) { const int row = row0 + u * NGW; ok[u] = row < M; const int rc = ok[u] ? row : row0;
            const float* xr = rc < MP ? a.x_p + (size_t)rc * DM : a.x_s + (size_t)(rc - MP) * DM;
#pragma unroll
            for (int j = 0; j < 4; ++j) v[u][j] = *(const f32x4*)(xr + 256 * j + 4 * F.lane); }
#pragma unroll
        for (int u = 0; u < 2; ++u) { float ss = 0.f;
#pragma unroll
            for (int j = 0; j < 4; ++j) ss += (v[u][j][0] * v[u][j][0] + v[u][j][1] * v[u][j][1]) + (v[u][j][2] * v[u][j][2] + v[u][j][3] * v[u][j][3]);
            rr[u] = ss; }
#pragma unroll
        for (int o = 1; o < 64; o <<= 1) { rr[0] += __shfl_xor(rr[0], o); rr[1] += __shfl_xor(rr[1], o); }
#pragma unroll
        for (int u = 0; u < 2; ++u) { const int row = ok[u] ? row0 + u * NGW : row0; const float r = 1.0f / sqrtf(rr[u] * (1.0f / DM) + EPS);
#pragma unroll
            for (int h = 0; h < 8; ++h) f[u][h] = 0.f;
#pragma unroll
            for (int j = 0; j < 4; ++j) { const f32x4 g = *(const f32x4*)(a.norm_mix_g + 256 * j + 4 * F.lane); v[u][j] = v[u][j] * r * g;
                v2u w; w.x = pkbf(v[u][j][0], v[u][j][1]); w.y = pkbf(v[u][j][2], v[u][j][3]); if (ok[u]) *(v2u*)(XN + (size_t)row * DM + 256 * j + 4 * F.lane) = w;
#pragma unroll
                for (int h = 0; h < 8; ++h) { const f32x4 wv = *(const LAS f32x4*)(wfT + h * DM + 256 * j + 4 * F.lane); f[u][h] += (v[u][j][0] * wv[0] + v[u][j][1] * wv[1]) + (v[u][j][2] * wv[2] + v[u][j][3] * wv[3]); } } }
#pragma unroll
        for (int u = 0; u < 2; ++u) { const int row = row0 + u * NGW;
            const bool b4 = (F.lane & 4) != 0, b2 = (F.lane & 2) != 0, b1 = (F.lane & 1) != 0; float t4[4], t2[2];
#pragma unroll
            for (int k = 0; k < 4; ++k) { const float keep = b4 ? f[u][4 + k] : f[u][k], send = b4 ? f[u][k] : f[u][4 + k]; t4[k] = keep + __shfl_xor(send, 4); }
#pragma unroll
            for (int k = 0; k < 2; ++k) { const float keep = b2 ? t4[2 + k] : t4[k], send = b2 ? t4[k] : t4[2 + k]; t2[k] = keep + __shfl_xor(send, 2); }
            float t1 = (b1 ? t2[1] : t2[0]) + __shfl_xor(b1 ? t2[0] : t2[1], 1);
            t1 += __shfl_xor(t1, 8); t1 += __shfl_xor(t1, 16); t1 += __shfl_xor(t1, 32);
            if (F.lane < 8 && ok[u]) { const float z = t1 + a.b_forget[F.lane]; const float lf = fminf(z, 0.f) - log1pf(expf(-fabsf(z)));
                if (row < MP) a.out[O_LFP + (size_t)row * NH + F.lane] = lf; else a.out[O_LFS + (size_t)(row - MP) * NH + F.lane] = lf; } }
    }
}

__device__ __forceinline__ void p2_cumsum_pool(Frame& F, const Args& a) {
    unsigned char* ws = a.ws;
    { const int gw = F.vcu * NWAVES + F.wave; float* CP2 = (float*)(ws + WS_CP2);
      if (gw < NB * NH) { const int b = gw >> 3, h = gw & 7; float carry = 0.f;
          for (int c = 0; c < SEQ / 64; ++c) { float v = a.out[O_LFP + (size_t)(b * SEQ + c * 64 + F.lane) * NH + h];
#pragma unroll
              for (int o = 1; o < 64; o <<= 1) { const float t = __shfl_up(v, o); if (F.lane >= o) v += t; }
              v += carry; CP2[(size_t)gw * SEQ + c * 64 + F.lane] = v * LOG2E; carry = __shfl(v, 63); } } }
    const bf16* U = (const bf16*)(ws + WS_U); bf16* PO = (bf16*)(ws + WS_PO);
    for (int item = F.vcu * NTHR + F.tid; item < M * 64; item += F.G * NTHR) {
        const int row = item >> 6, ch = (item & 63) * 8, g = ch >> 7, w = 2 << g;
        float sum[8], self[8];
#pragma unroll
        for (int i = 0; i < 8; ++i) sum[i] = 0.f;
        float cnt;
        if (row < MP) { const int s = row & (SEQ - 1); cnt = (float)(s + 1 < w ? s + 1 : w); const int nw = s + 1 < w ? s + 1 : w;
            for (int i = 0; i < nw; ++i) { const v4u q = *(const v4u*)(U + (size_t)(row - i) * DP + ch);
                const float e[8] = {bflo(q.x), bfhi(q.x), bflo(q.y), bfhi(q.y), bflo(q.z), bfhi(q.z), bflo(q.w), bfhi(q.w)};
#pragma unroll
                for (int k = 0; k < 8; ++k) { sum[k] += e[k]; if (i == 0) self[k] = e[k]; } }
        } else { const int rs = row - MP, b = rs >> 3, t = rs & 7; cnt = (float)w;
            for (int i = 0; i < w; ++i) { const int tt = t - i; float e[8];
                if (tt >= 0) { const v4u q = *(const v4u*)(U + (size_t)(MP + b * 8 + tt) * DP + ch);
                    e[0] = bflo(q.x); e[1] = bfhi(q.x); e[2] = bflo(q.y); e[3] = bfhi(q.y); e[4] = bflo(q.z); e[5] = bfhi(q.z); e[6] = bflo(q.w); e[7] = bfhi(q.w); }
                else { const f32x4 p0 = *(const f32x4*)(a.state_pool + (size_t)(b * 15 + 15 + tt) * DP + ch), p1 = *(const f32x4*)(a.state_pool + (size_t)(b * 15 + 15 + tt) * DP + ch + 4);
                    e[0] = p0[0]; e[1] = p0[1]; e[2] = p0[2]; e[3] = p0[3]; e[4] = p1[0]; e[5] = p1[1]; e[6] = p1[2]; e[7] = p1[3]; }
#pragma unroll
                for (int k = 0; k < 8; ++k) { sum[k] += e[k]; if (i == 0) self[k] = e[k]; } } }
        const float inv = 1.0f / cnt; float mm[8];
#pragma unroll
        for (int k = 0; k < 8; ++k) mm[k] = sum[k] * inv - self[k];
        v4u o; o.x = pkbf(mm[0], mm[1]); o.y = pkbf(mm[2], mm[3]); o.z = pkbf(mm[4], mm[5]); o.w = pkbf(mm[6], mm[7]);
        *(v4u*)(PO + (size_t)row * DP + ch) = o;
    }
}

__device__ __forceinline__ float attn_bound2(const Args& a, int lane) {
    asm volatile("" : "+v"(lane));
    const float gq = wave_max(fabsf(a.q_norm_g[lane])), gk = wave_max(fabsf(a.k_norm_g[lane]));
    return 64.0f * C2 * gq * gk * 1.03f;
}

typedef float f32x16 __attribute__((ext_vector_type(16)));
typedef short bf16x8v __attribute__((ext_vector_type(8)));
__device__ __forceinline__ int f2key(float s) { int b = __builtin_bit_cast(int, s); return b ^ ((b >> 31) & 0x7fffffff); }
__device__ __forceinline__ float key2f(int k) { return __builtin_bit_cast(float, k ^ ((k >> 31) & 0x7fffffff)); }
#define CE_DESC(x, y) do { const int mx_ = (x) > (y) ? (x) : (y), mn_ = (x) > (y) ? (y) : (x); (x) = mx_; (y) = mn_; } while (0)
template <int OFF, int N, typename T> __device__ __forceinline__ void bsort_desc(T& v) {
#pragma unroll
    for (int k = 2; k <= N; k <<= 1)
#pragma unroll
        for (int j = k >> 1; j > 0; j >>= 1)
#pragma unroll
            for (int i = 0; i < N; ++i) { const int l = i ^ j; if (l > i) { if ((i & k) == 0) CE_DESC(v[OFF + i], v[OFF + l]); else CE_DESC(v[OFF + l], v[OFF + i]); } }
}
template <int OFF, typename T> __device__ __forceinline__ void bmerge16_desc(T& v) {
#pragma unroll
    for (int j = 8; j > 0; j >>= 1)
#pragma unroll
        for (int i = 0; i < 16; ++i) { const int l = i ^ j; if (l > i) CE_DESC(v[OFF + i], v[OFF + l]); }
}
template <int OA, int OB, typename T> __device__ __forceinline__ void top16_merge(T& v) {
#pragma unroll
    for (int i = 0; i < 16; ++i) v[OA + i] = v[OA + i] > v[OB + 15 - i] ? v[OA + i] : v[OB + 15 - i];
    bmerge16_desc<OA>(v);
}
template <typename T> __device__ __forceinline__ void top16_of_64(T& v) {
    bsort_desc<0, 16>(v); bsort_desc<16, 16>(v); bsort_desc<32, 16>(v); bsort_desc<48, 16>(v);
    top16_merge<0, 16>(v); top16_merge<32, 48>(v); top16_merge<0, 32>(v);
}
__device__ __forceinline__ void p7_topk(Frame& F, const Args& a) {
    unsigned char* ws = a.ws;
    const bf16* PQ = (const bf16*)(ws + WS_PQ); const bf16* SK = (const bf16*)(ws + WS_SUBK); const float* RSS = (const float*)(ws + WS_RSS);
    int* SI = (int*)(ws + WS_SI); float* SG = (float*)(ws + WS_SG);
    const int lane = F.lane, j = lane & 31, hi = lane >> 5;
    constexpr int KROW = 272, KMAT = 128 * KROW;
    LAS unsigned char* kl = F.lds; LAS unsigned* ib = (LAS unsigned*)(F.lds + 2 * KMAT + F.wave * 1024);
    const int h = F.vcu & 7, wi = F.vcu >> 3, nwh = (F.G - h + 7) >> 3;
    __syncthreads();
    for (int i = F.tid; i < 2 * 128 * 16; i += NTHR) { const int p = i >> 11, n = (i >> 4) & 127, c = i & 15; *(LAS v4u*)(kl + p * KMAT + n * KROW + 16 * c) = *(const v4u*)(SK + ((size_t)(h * 2 + p) * NKEYS + n) * DKH + 8 * c); }
    __syncthreads();
    for (int tile = wi * NWAVES + F.wave; tile < M / 32; tile += nwh * NWAVES) {
        const int row0 = tile * 32;
        int jl = j, hl = hi; asm volatile("" : "+v"(jl), "+v"(hl));
        int top[2][16];
#pragma unroll
        for (int p = 0; p < 2; ++p) {
            bf16x8v qf[8];
#pragma unroll
            for (int ks = 0; ks < 8; ++ks) qf[ks] = *(const bf16x8v*)(PQ + (size_t)(row0 + jl) * DQ + h * 256 + p * 128 + 16 * ks + 8 * hl);
            f32x16 acc[4];
#pragma unroll
            for (int mt = 0; mt < 4; ++mt) acc[mt] = f32x16{};
            const LAS unsigned char* kb = kl + p * KMAT + jl * KROW + 16 * hl;
#pragma unroll
            for (int ks = 0; ks < 8; ++ks)
#pragma unroll
                for (int mt = 0; mt < 4; ++mt) { const bf16x8v af = *(const LAS bf16x8v*)(kb + mt * 32 * KROW + ks * 32); acc[mt] = __builtin_amdgcn_mfma_f32_32x32x16_bf16(af, qf[ks], acc[mt], 0, 0, 0); }
            int v[64];
#pragma unroll
            for (int mt = 0; mt < 4; ++mt)
#pragma unroll
                for (int r = 0; r < 16; ++r) { const int n = 32 * mt + (r & 3) + 8 * (r >> 2) + 4 * hi; v[16 * mt + r] = (f2key(acc[mt][r]) & ~127) | (127 - n); }
            top16_of_64(v);
#pragma unroll
            for (int i = 0; i < 16; ++i) top[p][i] = v[i];
        }
        int S[32];
#pragma unroll
        for (int i = 0; i < 16; ++i) { auto rr = __builtin_amdgcn_permlane32_swap((unsigned)top[0][i], (unsigned)top[1][i], false, false); S[i] = (int)rr[0]; S[16 + i] = (int)rr[1]; }
        top16_merge<0, 16>(S);
        { unsigned w0 = 0, w1 = 0, w2 = 0, w3 = 0;
#pragma unroll
          for (int i = 0; i < 4; ++i) { w0 |= (unsigned)(127 - (S[i] & 127)) << (8 * i); w1 |= (unsigned)(127 - (S[4 + i] & 127)) << (8 * i); w2 |= (unsigned)(127 - (S[8 + i] & 127)) << (8 * i); w3 |= (unsigned)(127 - (S[12 + i] & 127)) << (8 * i); }
          *(LAS v4u*)(ib + (hi * 32 + j) * 4) = (v4u){w0, w1, w2, w3}; }
        float s1[16], s2[16];
#pragma unroll
        for (int i = 0; i < 16; ++i) { auto rr = __builtin_amdgcn_permlane32_swap((unsigned)S[i], (unsigned)S[i], false, false); s1[i] = key2f((int)rr[0] & ~127); s2[i] = key2f((int)rr[1] & ~127); }
        int c[64]; { int n = 0;
#pragma unroll
          for (int ca = 0; ca < 16; ++ca)
#pragma unroll
              for (int cb = 0; cb < 16; ++cb) if ((ca + 1) * (cb + 1) <= 16) { c[n] = (f2key(s1[ca] + s2[cb]) & ~255) | (255 - (ca * 16 + cb)); ++n; }
#pragma unroll
          for (int q = 50; q < 64; ++q) c[q] = (int)0x80000000; }
        top16_of_64(c);
        float ssq = 0.f;
#pragma unroll
        for (int q = 0; q < 4; ++q) { const f32x4 t4 = *(const f32x4*)(RSS + (size_t)(row0 + j) * 16 + 4 * q); ssq += (t4[0] + t4[1]) + (t4[2] + t4[3]); }
        const float rstd = 1.0f / sqrtf(ssq * (1.0f / DM) + EPS);
        const float z0 = key2f(c[0] & ~255) * rstd; float e[16], esum = 0.f;
#pragma unroll
        for (int k = 0; k < 16; ++k) { e[k] = __expf(key2f(c[k] & ~255) * rstd - z0); esum += e[k]; }
        const float inv = 1.0f / esum;
        LDS_WAIT(); asm volatile("" ::: "memory");
        const LAS unsigned char* ib8 = (const LAS unsigned char*)ib;
        int oi[8]; float og[8];
#pragma unroll
        for (int k = 0; k < 8; ++k) { const int ck = hi ? c[8 + k] : c[k]; const float ek = hi ? e[8 + k] : e[k]; const int fl = 255 - (ck & 255);
            const int i1 = ib8[(0 * 32 + j) * 16 + (fl >> 4)], i2 = ib8[(1 * 32 + j) * 16 + (fl & 15)]; oi[k] = i1 * NKEYS + i2; og[k] = ek * inv; }
        { int* sp = SI + (size_t)(row0 + j) * 128 + h * 16 + hi * 8; float* gp = SG + (size_t)(row0 + j) * 128 + h * 16 + hi * 8;
          *(v4u*)sp = (v4u){(unsigned)oi[0], (unsigned)oi[1], (unsigned)oi[2], (unsigned)oi[3]}; *(v4u*)(sp + 4) = (v4u){(unsigned)oi[4], (unsigned)oi[5], (unsigned)oi[6], (unsigned)oi[7]};
          *(f32x4*)gp = (f32x4){og[0], og[1], og[2], og[3]}; *(f32x4*)(gp + 4) = (f32x4){og[4], og[5], og[6], og[7]}; }
        LDS_WAIT(); asm volatile("" ::: "memory");
    }
}


constexpr int P8_TOK = 34, P8_Q = 5, P8_NS = 8, P8_SW = 128;
static_assert(M % P8_TOK == 0 && P8_TOK <= 8 * P8_Q, "P8 chunking");
#define FP8X2(wd, hi_) __builtin_amdgcn_cvt_pk_f32_fp8((int)(wd), (hi_))
typedef __bf16 bf16x2v __attribute__((ext_vector_type(2)));
template <bool HI> __device__ __forceinline__ float p8_dot(unsigned wd, unsigned hpair, float accv) { const f32x2 f = FP8X2(wd, HI); return __builtin_amdgcn_fdot2_f32_bf16(__builtin_bit_cast(bf16x2v, pkbf(f[0], f[1])), __builtin_bit_cast(bf16x2v, hpair), accv, false); }
__device__ __forceinline__ void p8_gather(Frame& F, const Args& a) {
    unsigned char* ws = a.ws;
    const bf16* HG = (const bf16*)(ws + WS_XN); const unsigned char* PU = ws + WS_PU; const unsigned char* PV = ws + WS_PV; const float* US = (const float*)(ws + WS_US); const float* VS = (const float*)(ws + WS_VS);
    const float* RSS = (const float*)(ws + WS_RSS); const int* SI = (const int*)(ws + WS_SI); const float* SG = (const float*)(ws + WS_SG); const float* Hh = (const float*)(ws + WS_H);
    float* Y = a.out + O_YP;
    LAS unsigned short* ix = (LAS unsigned short*)F.lds;
    LAS float* wt = (LAS float*)(F.lds + P8_TOK * 128 * 2);
    LAS float* rs = (LAS float*)(F.lds + P8_TOK * 128 * 2 + P8_TOK * 128 * 4);
    int lane = F.lane; asm volatile("" : "+v"(lane));
    const int g = lane >> 3, c8 = lane & 7;
    for (int chunk = F.vcu; chunk < M / P8_TOK; chunk += F.G) {
        const int tb = chunk * P8_TOK;
        __syncthreads();
        for (int i = F.tid; i < P8_TOK * 128; i += NTHR) { ix[i] = (unsigned short)SI[(size_t)tb * 128 + i]; wt[i] = SG[(size_t)tb * 128 + i]; }
        if (F.tid < P8_TOK) { float s = 0.f; for (int k = 0; k < 16; ++k) s += RSS[(size_t)(tb + F.tid) * 16 + k]; rs[F.tid] = 1.0f / sqrtf(s * (1.0f / DM) + EPS); }
        __syncthreads();
        float acc[P8_Q][16];
#pragma unroll
        for (int q = 0; q < P8_Q; ++q)
#pragma unroll
            for (int i = 0; i < 16; ++i) acc[q][i] = 0.f;
        for (int s = 0; s < P8_NS; ++s) {
            __syncthreads();
            int cl = c8; asm volatile("" : "+v"(cl));
            const unsigned char* pus = PU + (size_t)s * ((size_t)NEXP * P8_SW) + 16 * cl;
#pragma unroll
            for (int q = 0; q < P8_Q; ++q) { const int lt = F.wave + 8 * q; if (lt < P8_TOK) {
                const v4u h0 = *(const v4u*)(HG + (size_t)(tb + lt) * DM + P8_SW * s + 16 * cl), h1 = *(const v4u*)(HG + (size_t)(tb + lt) * DM + P8_SW * s + 16 * cl + 8);
                const unsigned hp8[8] = {h0.x, h0.y, h0.z, h0.w, h1.x, h1.y, h1.z, h1.w};
                f32x2 hf2[8];
#pragma unroll
                for (int k = 0; k < 8; ++k) hf2[k] = (f32x2){bflo(hp8[k]), bfhi(hp8[k])};
                const v4u ea = *(const LAS v4u*)(ix + lt * 128 + g * 16), eb = *(const LAS v4u*)(ix + lt * 128 + g * 16 + 8);
                const unsigned ew[8] = {ea.x, ea.y, ea.z, ea.w, eb.x, eb.y, eb.z, eb.w};
                v4u r[16];
#pragma unroll
                for (int i = 0; i < 16; ++i) { const unsigned e = (i & 1) ? (ew[i >> 1] >> 16) : (ew[i >> 1] & 0xffffu); r[i] = *(const v4u*)(pus + (size_t)e * P8_SW); }
#pragma unroll
                for (int i = 0; i < 16; ++i) { const unsigned wd[4] = {r[i].x, r[i].y, r[i].z, r[i].w}; f32x2 d2 = (f32x2){acc[q][i], 0.f};
#pragma unroll
                    for (int jj = 0; jj < 4; ++jj) { d2 = FP8X2(wd[jj], false) * hf2[2 * jj] + d2; d2 = FP8X2(wd[jj], true) * hf2[2 * jj + 1] + d2; }
                    acc[q][i] = d2[0] + d2[1]; } } }
        }
#pragma unroll
        for (int q = 0; q < P8_Q; ++q) { const int lt = F.wave + 8 * q; if (lt < P8_TOK) {
            float v8[8], v4[4], v2[2]; const bool b4 = (c8 & 4) != 0, b2 = (c8 & 2) != 0, b1 = (c8 & 1) != 0;
#pragma unroll
            for (int j2 = 0; j2 < 8; ++j2) { const float keep = b4 ? acc[q][8 + j2] : acc[q][j2], send = b4 ? acc[q][j2] : acc[q][8 + j2]; v8[j2] = keep + __shfl_xor(send, 4); }
#pragma unroll
            for (int j2 = 0; j2 < 4; ++j2) { const float keep = b2 ? v8[4 + j2] : v8[j2], send = b2 ? v8[j2] : v8[4 + j2]; v4[j2] = keep + __shfl_xor(send, 2); }
#pragma unroll
            for (int j2 = 0; j2 < 2; ++j2) { const float keep = b1 ? v4[2 + j2] : v4[j2], send = b1 ? v4[j2] : v4[2 + j2]; v2[j2] = keep + __shfl_xor(send, 1); }
            const float r = rs[lt]; const int kk = lt * 128 + g * 16 + 2 * c8; LAS float* wp = wt + kk; const f32x2 gt = *(const LAS f32x2*)wp;
            const int e0 = ix[kk], e1 = ix[kk + 1];
            const float z0 = v2[0] * r * US[e0], z1 = v2[1] * r * US[e1];
            const float a0 = 0.5f * z0 * (1.0f + erff(z0 * 0.70710678118654752f)), a1 = 0.5f * z1 * (1.0f + erff(z1 * 0.70710678118654752f));
            *(LAS f32x2*)wp = (f32x2){gt[0] * a0 * VS[e0], gt[1] * a1 * VS[e1]}; } }
        LDS_WAIT(); asm volatile("" ::: "memory");
        for (int s = 0; s < P8_NS; ++s) {
            __syncthreads();
            int cl = c8; asm volatile("" : "+v"(cl));
            const unsigned char* pvs = PV + (size_t)s * ((size_t)NEXP * P8_SW) + 16 * cl;
#pragma unroll 1
            for (int q = 0; q < P8_Q; ++q) { const int lt = F.wave + 8 * q; if (lt < P8_TOK) {
                f32x2 o2[8];
#pragma unroll
                for (int k = 0; k < 8; ++k) o2[k] = (f32x2){0.f, 0.f};
                const v4u ea = *(const LAS v4u*)(ix + lt * 128 + g * 16), eb = *(const LAS v4u*)(ix + lt * 128 + g * 16 + 8);
                const unsigned ew[8] = {ea.x, ea.y, ea.z, ea.w, eb.x, eb.y, eb.z, eb.w};
                v4u r[16];
#pragma unroll
                for (int i = 0; i < 16; ++i) { const unsigned e = (i & 1) ? (ew[i >> 1] >> 16) : (ew[i >> 1] & 0xffffu); r[i] = *(const v4u*)(pvs + (size_t)e * P8_SW); }
                float wv[16];
#pragma unroll
                for (int i4 = 0; i4 < 4; ++i4) { const f32x4 w4 = *(const LAS f32x4*)(wt + lt * 128 + g * 16 + 4 * i4); wv[4 * i4] = w4[0]; wv[4 * i4 + 1] = w4[1]; wv[4 * i4 + 2] = w4[2]; wv[4 * i4 + 3] = w4[3]; }
#pragma unroll
                for (int i = 0; i < 16; ++i) { const f32x2 w2 = (f32x2){wv[i], wv[i]}; const unsigned wd[4] = {r[i].x, r[i].y, r[i].z, r[i].w};
#pragma unroll
                    for (int jj = 0; jj < 4; ++jj) { o2[2 * jj] = FP8X2(wd[jj], false) * w2 + o2[2 * jj]; o2[2 * jj + 1] = FP8X2(wd[jj], true) * w2 + o2[2 * jj + 1]; } }
                float o[16];
#pragma unroll
                for (int k = 0; k < 8; ++k) { o[2 * k] = o2[k][0]; o[2 * k + 1] = o2[k][1]; }
                const bool b5 = (lane & 32) != 0, b4 = (lane & 16) != 0, b3 = (lane & 8) != 0; float p8[8], p4[4], p2[2];
#pragma unroll
                for (int j2 = 0; j2 < 8; ++j2) { const float keep = b5 ? o[8 + j2] : o[j2], send = b5 ? o[j2] : o[8 + j2]; p8[j2] = keep + __shfl_xor(send, 32); }
#pragma unroll
                for (int j2 = 0; j2 < 4; ++j2) { const float keep = b4 ? p8[4 + j2] : p8[j2], send = b4 ? p8[j2] : p8[4 + j2]; p4[j2] = keep + __shfl_xor(send, 16); }
#pragma unroll
                for (int j2 = 0; j2 < 2; ++j2) { const float keep = b3 ? p4[2 + j2] : p4[j2], send = b3 ? p4[j2] : p4[2 + j2]; p2[j2] = keep + __shfl_xor(send, 8); }
                const size_t off = (size_t)(tb + lt) * DM + P8_SW * s + 16 * cl + (b5 ? 8 : 0) + (b4 ? 4 : 0) + (b3 ? 2 : 0);
                const f32x2 hv = *(const f32x2*)(Hh + off);
                *(f32x2*)(Y + off) = (f32x2){hv[0] + p2[0], hv[1] + p2[1]}; } }
        }
    }
}

__device__ __forceinline__ void p3_sample_attn2(Frame& F, const Args& a, const float M2) {
    unsigned char* ws = a.ws;
    const bf16* Q = (const bf16*)(ws + WS_Q); bf16* AO = (bf16*)(ws + WS_AO);
    LAS float* D2 = (LAS float*)F.lds;
    LAS float* E2 = (LAS float*)(F.lds + 32768);
    LAS float* Pt = (LAS float*)(F.lds + 32768 + 128);
    LAS float* Op = (LAS float*)(F.lds + 32768 + 128 + 8192);
    LAS float* lp = (LAS float*)(F.lds + 32768 + 128 + 8192 + 16384);
    int lane = F.lane; asm volatile("" : "+v"(lane));
    const int w = F.wave, hh = w >> 1, kh = w & 1, n = lane & 31, hi = lane >> 5;
    LAS float* Pw = Pt + w * 256;
    for (int unit = F.vcu; unit < DB * 2; unit += F.G) {
        const int b = unit >> 1, h = 4 * (unit & 1) + hh;
        __syncthreads();
        for (int i = F.tid; i < 4 * PAST; i += NTHR) { const int hq = i >> 11, jk = i & (PAST - 1); const int pg = a.page_table[b * NPAGES + (jk >> 7)];
            D2[i] = a.cache_lf[((size_t)pg * PAGE + (jk & 127)) * NH + 4 * (unit & 1) + hq]; }
        __syncthreads();
        if (kh == 0) {
            LAS float* d = D2 + hh * PAST; float loc[32]; float tot = 0.f;
#pragma unroll
            for (int k = 31; k >= 0; --k) { loc[k] = tot; tot += d[lane * 32 + k]; }
            float inc = tot;
#pragma unroll
            for (int o = 1; o < 64; o <<= 1) { const float t = __shfl_down(inc, o); if (lane + o < 64) inc += t; }
            const float excl = inc - tot;
#pragma unroll
            for (int k = 0; k < 32; ++k) d[lane * 32 + k] = (loc[k] + excl) * LOG2E;
            if (lane < 8) { float e = 0.f; for (int t = 0; t <= lane; ++t) e += a.out[O_LFS + (size_t)(b * 8 + t) * NH + h]; E2[hh * 8 + lane] = e * LOG2E; }
        }
        __syncthreads();
        bf16x8v qa[4];
#pragma unroll
        for (int ks = 0; ks < 4; ++ks) { qa[ks] = bf16x8v{}; if (n < 8) qa[ks] = *(const bf16x8v*)(Q + (size_t)(MP + b * 8 + n) * DA + h * 64 + 16 * ks + 8 * hi); }
        float e2[4];
#pragma unroll
        for (int t = 0; t < 4; ++t) e2[t] = E2[hh * 8 + 4 * hi + t] - M2;
        float o[8], lsum[4];
#pragma unroll
        for (int t = 0; t < 8; ++t) o[t] = 0.f;
#pragma unroll
        for (int t = 0; t < 4; ++t) lsum[t] = 0.f;
        const LAS float* dh = D2 + hh * PAST;
        int nskip; { const float dl = dh[32 * lane + 31]; nskip = __builtin_popcountll(__ballot(dl < -(40.f + 2.f * M2))); }
        nskip = __builtin_amdgcn_readfirstlane(nskip);
        const int nblk = PAST / 32 - nskip, nb0 = nblk >> 1;
        const int blk_lo = nskip + (kh ? nb0 : 0), nit = kh ? (nblk - nb0) : nb0;
        f32x4 kq[8]; float vv[32];
#define S3_COMPUTE(it_, NEWK) do { f32x16 sacc = f32x16{}; \
            _Pragma("unroll") for (int ks = 0; ks < 4; ++ks) { const f32x4 x0_ = kq[2 * ks], x1_ = kq[2 * ks + 1]; v4u kb_; kb_.x = pkbf(x0_[0], x0_[1]); kb_.y = pkbf(x0_[2], x0_[3]); kb_.z = pkbf(x1_[0], x1_[1]); kb_.w = pkbf(x1_[2], x1_[3]); \
                sacc = __builtin_amdgcn_mfma_f32_32x32x16_bf16(qa[ks], __builtin_bit_cast(bf16x8v, kb_), sacc, 0, 0, 0); } \
            float p_[4]; \
            if (!(NEWK)) { const float dj_ = dh[(blk_lo + (it_)) * 32 + n]; _Pragma("unroll") for (int t = 0; t < 4; ++t) p_[t] = __builtin_amdgcn_exp2f(sacc[t] + e2[t] + dj_); } \
            else { const float ek_ = E2[hh * 8 + (n & 7)]; _Pragma("unroll") for (int t = 0; t < 4; ++t) p_[t] = (n <= 4 * hi + t) ? __builtin_amdgcn_exp2f(sacc[t] + e2[t] - ek_) : 0.f; } \
            _Pragma("unroll") for (int t = 0; t < 4; ++t) lsum[t] += p_[t]; \
            *(LAS f32x4*)(Pw + n * 8 + 4 * hi) = (f32x4){p_[0], p_[1], p_[2], p_[3]}; \
            LDS_WAIT(); asm volatile("" ::: "memory"); \
            _Pragma("unroll") for (int k_ = 0; k_ < ((NEWK) ? 8 : 32); ++k_) { const f32x4 pa_ = *(const LAS f32x4*)(Pw + k_ * 8), pb_ = *(const LAS f32x4*)(Pw + k_ * 8 + 4); const float v_ = vv[k_]; \
                o[0] += pa_[0] * v_; o[1] += pa_[1] * v_; o[2] += pa_[2] * v_; o[3] += pa_[3] * v_; o[4] += pb_[0] * v_; o[5] += pb_[1] * v_; o[6] += pb_[2] * v_; o[7] += pb_[3] * v_; } \
            LDS_WAIT(); asm volatile("" ::: "memory"); } while (0)
        for (int it = 0; it < nit; ++it) {
            const int j0 = (blk_lo + it) * 32; const int pg = a.page_table[b * NPAGES + (j0 >> 7)];
            const size_t rowoff = (((size_t)pg * PAGE + (j0 & 127)) * NH + h) * HD;
            const float* kr = a.cache_k + rowoff + (size_t)n * (NH * HD) + 8 * hi; const float* vb = a.cache_v + rowoff;
#pragma unroll
            for (int ks = 0; ks < 4; ++ks) { kq[2 * ks] = __builtin_nontemporal_load((const f32x4*)(kr + 16 * ks)); kq[2 * ks + 1] = __builtin_nontemporal_load((const f32x4*)(kr + 16 * ks + 4)); }
#pragma unroll
            for (int k = 0; k < 32; ++k) vv[k] = __builtin_nontemporal_load(vb + (size_t)k * (NH * HD) + lane);
            S3_COMPUTE(it, false);
        }
        if (kh == 1) {
            const float* kr = a.out + O_KS + (size_t)(b * 8 + (n & 7)) * DA + h * HD + 8 * hi; const float* vr = a.out + O_VS + (size_t)(b * 8) * DA + h * HD + lane;
#pragma unroll
            for (int ks = 0; ks < 4; ++ks) { kq[2 * ks] = *(const f32x4*)(kr + 16 * ks); kq[2 * ks + 1] = *(const f32x4*)(kr + 16 * ks + 4); }
#pragma unroll
            for (int k = 0; k < 8; ++k) vv[k] = vr[(size_t)k * DA];
            S3_COMPUTE(0, true);
        }
#undef S3_COMPUTE
#pragma unroll
        for (int t = 0; t < 4; ++t) { float s = lsum[t]; s += __shfl_xor(s, 1); s += __shfl_xor(s, 2); s += __shfl_xor(s, 4); s += __shfl_xor(s, 8); s += __shfl_xor(s, 16); if (n == 0) lp[w * 8 + 4 * hi + t] = s; }
#pragma unroll
        for (int t = 0; t < 8; ++t) Op[(w * 8 + t) * 64 + lane] = o[t];
        __syncthreads();
        for (int i = F.tid; i < 4 * 8 * 64; i += NTHR) { const int hq = i >> 9, t = (i >> 6) & 7, d = i & 63;
            const float O = Op[((2 * hq) * 8 + t) * 64 + d] + Op[((2 * hq + 1) * 8 + t) * 64 + d], L = lp[(2 * hq) * 8 + t] + lp[(2 * hq + 1) * 8 + t];
            AO[(size_t)(MP + b * 8 + t) * DA + (4 * (unit & 1) + hq) * 64 + d] = (bf16)(pkbf(O / L, 0.f) & 0xffffu); }
    }
}


template <class Epi> __device__ __forceinline__ void sg_phase(Frame& F, const bf16* A  , const bf16* Bt  , int K, int N, const Epi& E) {
    int lane = F.lane; asm volatile("" : "+v"(lane));
    const int fr = lane & 15, fq = lane >> 4, ntc = N >> 6, ntile = (MS / 128) * ntc, pitch = 2 * K + 16, kc = K >> 3;
    for (int t = F.vcu; t < ntile; t += F.G) {
        const int tr = t % (MS / 128), tc = t / (MS / 128);
        __syncthreads();
        for (int i = F.tid; i < 64 * kc; i += NTHR) { const int r = i / kc, c = i - r * kc; *(LAS v4u*)(F.lds + r * pitch + 16 * c) = *(const v4u*)(Bt + (size_t)(64 * tc + r) * K + 8 * c); }
        __syncthreads();
        const bf16* ap = A + (size_t)(128 * tr + 16 * F.wave + fr) * K + 8 * fq;
        const LAS unsigned char* bp = F.lds + fr * pitch + 16 * fq;
        f32x4 acc[4];
#pragma unroll
        for (int c = 0; c < 4; ++c) acc[c] = (f32x4){0.f, 0.f, 0.f, 0.f};
#pragma unroll 8
        for (int ks = 0; ks < K; ks += 32) {
            const bf16x8v av = *(const bf16x8v*)(ap + ks);
#pragma unroll
            for (int c = 0; c < 4; ++c) { const bf16x8v bv = *(const LAS bf16x8v*)(bp + 16 * c * pitch + 2 * ks); acc[c] = __builtin_amdgcn_mfma_f32_16x16x32_bf16(bv, av, acc[c], 0, 0, 0); }
        }
        E(acc, 128 * tr + 16 * F.wave + fr, tc, fq);
    }
}
template <int MODE> struct SgGate { const bf16* G; const bf16* Tin; bf16* O;
    __device__ __forceinline__ void operator()(const f32x4 (&acc)[4], int rs, int tc, int fq) const {
#pragma unroll
        for (int c = 0; c < 4; ++c) { const size_t off = (size_t)(MP + rs) * DM + 64 * tc + 16 * c + 4 * fq; const v2u g = *(const v2u*)(G + off);
            float r[4] = {acc[c][0] * bflo(g.x), acc[c][1] * bfhi(g.x), acc[c][2] * bflo(g.y), acc[c][3] * bfhi(g.y)};
            if (MODE == 1) { const v2u t = *(const v2u*)(Tin + off); r[0] += bflo(t.x); r[1] += bfhi(t.x); r[2] += bflo(t.y); r[3] += bfhi(t.y); }
            v2u w; w.x = pkbf(r[0], r[1]); w.y = pkbf(r[2], r[3]); *(v2u*)(O + off) = w; } } };
struct SgOut { const float* xs; float* H; bf16* HG; const float* gf; float* RSS;
    __device__ __forceinline__ void operator()(const f32x4 (&acc)[4], int rs, int tc, int fq) const { float ss = 0.f;
#pragma unroll
        for (int c = 0; c < 4; ++c) { const int col = 64 * tc + 16 * c + 4 * fq; const f32x4 h = acc[c] + *(const f32x4*)(xs + (size_t)rs * DM + col);
            ss += (h[0] * h[0] + h[1] * h[1]) + (h[2] * h[2] + h[3] * h[3]);
            *(f32x4*)(H + (size_t)(MP + rs) * DM + col) = h; const f32x4 gv = *(const f32x4*)(gf + col);
            v2u w; w.x = pkbf(h[0] * gv[0], h[1] * gv[1]); w.y = pkbf(h[2] * gv[2], h[3] * gv[3]); *(v2u*)(HG + (size_t)(MP + rs) * DM + col) = w; }
        ss += __shfl_xor(ss, 16); ss += __shfl_xor(ss, 32);
        if (fq == 0) RSS[(size_t)(MP + rs) * 16 + tc] = ss; } };
struct SgPQ { bf16* PQ;
    __device__ __forceinline__ void operator()(const f32x4 (&acc)[4], int rs, int tc, int fq) const {
#pragma unroll
        for (int c = 0; c < 4; ++c) { v2u w; w.x = pkbf(acc[c][0], acc[c][1]); w.y = pkbf(acc[c][2], acc[c][3]); *(v2u*)(PQ + (size_t)(MP + rs) * DQ + 64 * tc + 16 * c + 4 * fq) = w; } } };

constexpr int N_PHASES = 9;
#ifndef MK_PER_PHASE
#define MK_PER_PHASE 0
#endif
__global__ void __launch_bounds__(NTHR, 2) fwd_kernel(Args args) {
    extern __shared__ __attribute__((aligned(16))) unsigned char lds[];
    Frame F;
    F.lds = (LAS unsigned char*)lds; F.MISC = (volatile LAS unsigned*)(F.lds + MISC_OFF);
    F.tid = threadIdx.x; F.lane = F.tid & 63; F.wave = __builtin_amdgcn_readfirstlane(F.tid >> 6);
    F.G = gridDim.x; { const int bx = blockIdx.x; F.vcu = (F.G % 8 == 0) ? (bx % 8) * (F.G / 8) + bx / 8 : bx; }
    F.ctl = (gu32*)(args.ws + WS_CTL);
    for (int u = F.tid; u < (LDS_BYTES - MISC_OFF) / 4; u += NTHR) ((LAS unsigned*)(F.lds + MISC_OFF))[u] = 0u;
    __syncthreads();
#if MK_PER_PHASE
#define GRID_BAR() do { } while (0)
#else
    XcdBarrier bar = xcd_barrier_post((unsigned*)(F.ctl + CW_BAR), F.MISC + 8);
#define GRID_BAR() xcd_barrier(bar)
#endif
    unsigned char* ws = args.ws;
    const int lo = args.ph_lo, hi = args.ph_hi;
#ifndef DBG_REP_PHASE
#define DBG_REP_PHASE -1
#endif
#ifndef DBG_REP_N
#define DBG_REP_N 1
#endif
#define REPS(k) for (int rep_ = 0; rep_ < ((k) == DBG_REP_PHASE ? 1 + DBG_REP_N : 1); ++rep_)
#define IN(k) (lo <= (k) && (k) < hi)
#define BOTH(k) (IN(k) && IN((k) + 1))
#define ENDPH(k) do { if (BOTH(k) || (k) == DBG_REP_PHASE) GRID_BAR(); } while (0)
    if (IN(0)) REPS(0) { p0_prologue(F, args); ENDPH(0); }
    if (IN(1)) REPS(1) {
        pg8::Gemm g{(const bf16*)(ws + WS_XN), (const bf16*)(ws + WS_WIN), M, NPROJ, DM}; pg8::StaticOrder S; S.init(M, NPROJ, F.G, (int)blockIdx.x);
        EpiInProj E{(bf16*)(ws + WS_U), (bf16*)(ws + WS_Q), (bf16*)(ws + WS_K), (bf16*)(ws + WS_V), (bf16*)(ws + WS_GA), (bf16*)(ws + WS_GB), args.out, args.q_norm_g, args.k_norm_g};
        pg8::gemm_phase<EpiInProj, pg8::StaticOrder, true, true>(F.lds, g, S, E);
        ENDPH(1);
    }
    if (IN(2)) REPS(2) { p2_cumsum_pool(F, args); ENDPH(2); }
    if (IN(3)) {
        const float M2 = __builtin_bit_cast(float, __builtin_amdgcn_readfirstlane(__builtin_bit_cast(int, attn_bound2(args, F.lane))));
#if !defined(DBG_SKIP_PATTN)
        { const attn_body::AttnTensors AT{(const attn_body::bf16*)(ws + WS_Q), (const attn_body::bf16*)(ws + WS_K), (const attn_body::bf16*)(ws + WS_V), (attn_body::bf16*)(ws + WS_AO), (const float*)(ws + WS_CP2), M2};
          const attn_body::StaticOrder S((int)F.G, F.vcu);
          attn_body::attn_phase<attn_body::StaticOrder>((char*)lds, AT, S);
#ifdef DBG_ATTN2
          __syncthreads(); attn_body::attn_phase<attn_body::StaticOrder>((char*)lds, AT, S);
#endif
        }
#endif
        REPS(3) { p3_sample_attn2(F, args, M2); }
        ENDPH(3); }
    if (IN(4)) REPS(4) {
        { pg8::Gemm g{(const bf16*)(ws + WS_PO), (const bf16*)(ws + WS_WBP), MP, DM, DP}; pg8::StaticOrder S; S.init(MP, DM, F.G, (int)blockIdx.x);
          EpiGate<0> E{(const bf16*)(ws + WS_GA), nullptr, (bf16*)(ws + WS_T)};
          pg8::gemm_phase<EpiGate<0>, pg8::StaticOrder, true, true>(F.lds, g, S, E); }
        __syncthreads();
        { pg8::Gemm g{(const bf16*)(ws + WS_AO), (const bf16*)(ws + WS_WBA), MP, DM, DA}; pg8::StaticOrder S; S.init(MP, DM, F.G, (int)blockIdx.x);
          EpiGate<1> E{(const bf16*)(ws + WS_GB), (const bf16*)(ws + WS_T), (bf16*)(ws + WS_MIX)};
          pg8::gemm_phase<EpiGate<1>, pg8::StaticOrder, true, true>(F.lds, g, S, E); }
        { SgGate<0> E{(const bf16*)(ws + WS_GA), nullptr, (bf16*)(ws + WS_T)}; sg_phase(F, (const bf16*)(ws + WS_PO) + (size_t)MP * DP, (const bf16*)(ws + WS_WBP), DP, DM, E); }
        asm volatile("s_waitcnt vmcnt(0)" ::: "memory"); __syncthreads();
        { SgGate<1> E{(const bf16*)(ws + WS_GB), (const bf16*)(ws + WS_T), (bf16*)(ws + WS_MIX)}; sg_phase(F, (const bf16*)(ws + WS_AO) + (size_t)MP * DA, (const bf16*)(ws + WS_WBA), DA, DM, E); }
        ENDPH(4);
    }
    if (IN(5)) REPS(5) {
        pg8::Gemm g{(const bf16*)(ws + WS_MIX), (const bf16*)(ws + WS_WOUT), MP, DM, DM}; pg8::StaticOrder S; S.init(MP, DM, F.G, (int)blockIdx.x);
        EpiOut E{args.x_p, args.x_s, (float*)(ws + WS_H), (bf16*)(ws + WS_XN), args.norm_ffn_g, (float*)(ws + WS_RSS)};
        pg8::gemm_phase<EpiOut, pg8::StaticOrder, true, true>(F.lds, g, S, E);
        { SgOut E2{args.x_s, (float*)(ws + WS_H), (bf16*)(ws + WS_XN), args.norm_ffn_g, (float*)(ws + WS_RSS)}; sg_phase(F, (const bf16*)(ws + WS_MIX) + (size_t)MP * DM, (const bf16*)(ws + WS_WOUT), DM, DM, E2); }
        ENDPH(5);
    }
    if (IN(6)) REPS(6) {
        pg8::Gemm g{(const bf16*)(ws + WS_XN), (const bf16*)(ws + WS_WQ), MP, DQ, DM}; pg8::StaticOrder S; S.init(MP, DQ, F.G, (int)blockIdx.x);
        pg8::EpiBf16<0> E{(bf16*)(ws + WS_PQ), DQ, nullptr, 0, 0, 1.f};
        pg8::gemm_phase<pg8::EpiBf16<0>, pg8::StaticOrder, true, true>(F.lds, g, S, E);
        { SgPQ E2{(bf16*)(ws + WS_PQ)}; sg_phase(F, (const bf16*)(ws + WS_XN) + (size_t)MP * DM, (const bf16*)(ws + WS_WQ), DM, DQ, E2); }
        ENDPH(6);
    }
    if (IN(7)) REPS(7) { p7_topk(F, args); ENDPH(7); }
    if (IN(8)) REPS(8) { p8_gather(F, args); ENDPH(8); }
#ifdef DBG_DUMP
    if (IN(9)) { const bf16* AO = (const bf16*)(ws + WS_AO); const bf16* PO = (const bf16*)(ws + WS_PO); const bf16* MX = (const bf16*)(ws + (DBG_DUMP == 3 ? WS_T : DBG_DUMP == 4 ? WS_GA : WS_MIX));
        for (size_t i = (size_t)blockIdx.x * NTHR + F.tid; i < (size_t)M * DM; i += (size_t)F.G * NTHR) { const int row = (int)(i >> 10), c = (int)(i & 1023);
            float v; if (DBG_DUMP == 1) v = c < 512 ? bf2f(AO[(size_t)row * DA + c]) : bf2f(PO[(size_t)row * DP + c - 512]); else v = bf2f(MX[i]);
            args.out[O_YP + i] = v; } }
#endif
#undef IN
#undef BOTH
}

extern "C" void kernel_launch(void* const* d_in, const int* in_sizes, int n_in, void* d_out, int out_size, void* d_ws, size_t ws_size, hipStream_t stream) {
    static int grid = 0;
    if (grid == 0) {
        if (n_in != 22 || (size_t)out_size != O_END || ws_size < WS_END) { fprintf(stderr, "kernel_launch: unexpected shapes (n_in %d out %d ws %zu)\n", n_in, out_size, ws_size); grid = -1; return; }
        int dev = 0, cus = 0, per_cu = 0;
        if (hipGetDevice(&dev) != hipSuccess || hipDeviceGetAttribute(&cus, hipDeviceAttributeMultiprocessorCount, dev) != hipSuccess) { grid = -1; return; }
        if (hipFuncSetAttribute((const void*)fwd_kernel, hipFuncAttributeMaxDynamicSharedMemorySize, LDS_BYTES) != hipSuccess) { fprintf(stderr, "kernel_launch: hipFuncSetAttribute failed\n"); grid = -1; return; }
        if (hipOccupancyMaxActiveBlocksPerMultiprocessor(&per_cu, (const void*)fwd_kernel, NTHR, LDS_BYTES) != hipSuccess || per_cu < 1) fprintf(stderr, "kernel_launch: occupancy query reports %d\n", per_cu);
        (void)hipGetLastError();
        grid = cus;
    }
    if (grid < 0) return;
    if (hipMemsetAsync((char*)d_ws + WS_CTL, 0, CTL_ZERO_BYTES, stream) != hipSuccess) return;
    Args a{};
    a.x_p = (const float*)d_in[0]; a.x_s = (const float*)d_in[1]; a.cache_k = (const float*)d_in[2]; a.cache_v = (const float*)d_in[3]; a.cache_lf = (const float*)d_in[4];
    a.state_pool = (const float*)d_in[5]; a.page_table = (const int*)d_in[6]; a.norm_mix_g = (const float*)d_in[7]; a.w_in = (const float*)d_in[8]; a.b_forget = (const float*)d_in[9];
    a.q_norm_g = (const float*)d_in[10]; a.k_norm_g = (const float*)d_in[11]; a.pool_mix_w = (const float*)d_in[12]; a.pool_scale = (const float*)d_in[13]; a.w_bp = (const float*)d_in[14];
    a.w_ba = (const float*)d_in[15]; a.w_out = (const float*)d_in[16]; a.norm_ffn_g = (const float*)d_in[17]; a.w_query = (const float*)d_in[18]; a.sub_keys = (const float*)d_in[19];
    a.peer_u = (const float*)d_in[20]; a.peer_v = (const float*)d_in[21];
    a.out = (float*)d_out; a.ws = (unsigned char*)d_ws; a.pad = 0;
#if MK_PER_PHASE
#ifndef DBG_NPH
#define DBG_NPH N_PHASES
#endif
    for (int ph = 0; ph < DBG_NPH; ++ph) { a.ph_lo = ph; a.ph_hi = ph + 1; a.li = ph; hipLaunchKernelGGL(fwd_kernel, dim3(grid), dim3(NTHR), LDS_BYTES, stream, a); }
#ifdef DBG_DUMP
    a.ph_lo = 9; a.ph_hi = 10; a.li = 9; hipLaunchKernelGGL(fwd_kernel, dim3(grid), dim3(NTHR), LDS_BYTES, stream, a);
#endif
#else
    a.ph_lo = 0; a.ph_hi = N_PHASES; a.li = 0; hipLaunchKernelGGL(fwd_kernel, dim3(grid), dim3(NTHR), LDS_BYTES, stream, a);
#endif
}
```

```cpp
#include <hip/hip_runtime.h>
#include <cstdio>
#include <cstdint>
#include <cmath>
namespace pg8 {
#define PG8_LAS __attribute__((address_space(3)))
typedef unsigned short bf16_t;
typedef short bf16x8 __attribute__((ext_vector_type(8)));
typedef float f32x4 __attribute__((ext_vector_type(4)));
typedef unsigned u32x4 __attribute__((ext_vector_type(4)));
constexpr int BM = 256, BK = 64, HALF = 128, HTB = HALF * BK * 2  , STAGE_BYTES = 8 * HTB, NXCD = 8, WGM = 8;

__host__ __device__ __forceinline__ int lds_byte(int r, int c) { const int st = (r >> 4) * 2 + (c >> 5), rr = r & 15, cc = c & 31, ob = rr * 64 + cc * 2; return st * 1024 + (ob ^ (((ob >> 9) & 1) << 5)); }
__host__ __device__ __forceinline__ void stage_rc(int b, int& R, int& C) { const int st = b / 1024, sb = b % 1024, swz = sb ^ (((sb >> 9) & 1) << 5); R = (st >> 1) * 16 + swz / 64; C = (st & 1) * 32 + (swz % 64) / 2; }
__host__ __device__ __forceinline__ int perm32(int rho) { const int n = rho >> 4, i = rho & 15; return 8 * (i >> 2) + 4 * n + (i & 3); }

struct Unit { int pm, pn; };
struct Gemm { const bf16_t* A; const bf16_t* Bt; int M, N, K; };

struct StaticOrder {
    int nM, nN, nwg, G, c;
    __host__ __device__ void init(int M, int N, int G_, int c_) { nM = M / BM; nN = N / BM; nwg = nM * nN; G = G_; c = c_; }
    __host__ __device__ bool next(int i, Unit& u) const {
        const long L = (long)i * G + c; if (L >= nwg) return false;
        int wgid = (int)L; { const int q = nwg / NXCD, r = nwg % NXCD, xcd = wgid % NXCD, off = wgid / NXCD; wgid = (xcd < r ? xcd * (q + 1) : r * (q + 1) + (xcd - r) * q) + off; }
        const int nig = WGM * nN, gid = wgid / nig, fm = gid * WGM, gsz = (nM - fm) < WGM ? (nM - fm) : WGM;
        u.pm = fm + ((wgid % nig) % gsz); u.pn = (wgid % nig) / gsz; return true;
    }
    __device__ __forceinline__ void a_ready(const Unit&) const {}
    __device__ __forceinline__ void done(const Unit&) const {}
};

typedef float f32x2c __attribute__((ext_vector_type(2))); typedef __bf16 bf16x2c __attribute__((ext_vector_type(2)));
__device__ __forceinline__ unsigned cvt_pk_bf16(float lo, float hi) { f32x2c v = {lo, hi}; bf16x2c b = __builtin_convertvector(v, bf16x2c); return __builtin_bit_cast(unsigned, b); }
typedef float f32x2 __attribute__((ext_vector_type(2)));
__device__ __forceinline__ f32x2 gelu_pk(f32x2 v) {
    const f32x2 av = __builtin_elementwise_abs(v), d = av * 0.2316418882f + 1.0f;
    f32x2 t; t.x = __builtin_amdgcn_rcpf(d.x); t.y = __builtin_amdgcn_rcpf(d.y);
    f32x2 q = t * 0.5307027145f + (-0.7265760135f); q = q * t + 0.7107068705f; q = q * t + (-0.142248368f); q = q * t + 0.127414796f; q = q * t;
    const f32x2 s = (v * v) * (-0.72134752044f);
    f32x2 e; e.x = __builtin_amdgcn_exp2f(s.x); e.y = __builtin_amdgcn_exp2f(s.y);
    const f32x2 m = v * (q * e), r = v - m;
    f32x2 o; o.x = v.x < 0.f ? m.x : r.x; o.y = v.y < 0.f ? m.y : r.y; return o;
}

template <int ACT  > struct EpiBf16 {
    static constexpr bool PERM = true, AFTER_DRAIN = false; static_assert(ACT == 0 || ACT == 1, "EpiBf16: ACT is 0 (none) or 1 (gelu_pk)");
    bf16_t* O; int ldc; const float* bias; int split_cols; size_t split_stride; float scale0;
    __device__ __forceinline__ void operator()(const f32x4 (&acc)[2][2][4][2], const Unit& u, int wr, int wc, int fr, int fq) const {
        const int row0 = u.pm * BM + wr * 64 + fr; int colt = u.pn * BM; bf16_t* base = O;
        float sc = 1.f; if (split_cols) { const int t = colt / split_cols; base += (size_t)t * split_stride; colt -= t * split_cols; if (t == 0) sc = scale0; }
        const int col0 = colt + wc * 32 + 8 * fq, bcol0 = u.pn * BM + wc * 32 + 8 * fq;
        f32x4 bv[2][2];
#pragma unroll
        for (int bj = 0; bj < 2; ++bj)
#pragma unroll
            for (int n = 0; n < 2; ++n) bv[bj][n] = bias ? *(const f32x4*)(bias + bcol0 + bj * HALF + 4 * n) : (f32x4){0.f, 0.f, 0.f, 0.f};
#pragma unroll
        for (int ai = 0; ai < 2; ++ai)
#pragma unroll
            for (int m = 0; m < 4; ++m) { bf16_t* rowp = base + (size_t)(row0 + ai * HALF + m * 16) * ldc + col0;
#pragma unroll
                for (int bj = 0; bj < 2; ++bj) { f32x4 v0 = acc[ai][bj][m][0] + bv[bj][0], v1 = acc[ai][bj][m][1] + bv[bj][1];
                    if (ACT == 1) { f32x2 a = gelu_pk((f32x2){v0[0], v0[1]}), b = gelu_pk((f32x2){v0[2], v0[3]}), c = gelu_pk((f32x2){v1[0], v1[1]}), d = gelu_pk((f32x2){v1[2], v1[3]});
                        v0 = (f32x4){a.x, a.y, b.x, b.y}; v1 = (f32x4){c.x, c.y, d.x, d.y}; }
                    v0 = v0 * sc; v1 = v1 * sc; u32x4 w; w.x = cvt_pk_bf16(v0[0], v0[1]); w.y = cvt_pk_bf16(v0[2], v0[3]); w.z = cvt_pk_bf16(v1[0], v1[1]); w.w = cvt_pk_bf16(v1[2], v1[3]);
                    *(u32x4*)(rowp + bj * HALF) = w; } }
    }
};
template <class Epi, class Sched, bool ALIGN_EPI = false, bool SP2 = false>
__device__ __forceinline__ void gemm_phase(PG8_LAS unsigned char* lds, const Gemm g, const Sched& S, const Epi& E) {
    int tid = threadIdx.x; asm volatile("" : "+v"(tid));
    const int wid = __builtin_amdgcn_readfirstlane(tid >> 6), lane = tid & 63, wr = wid >> 2, wc = wid & 3, fr = lane & 15, fq = lane >> 4;
    const int K = g.K, nt = K / BK;
    unsigned voffA[2], voffB[2];
#pragma unroll
    for (int i = 0; i < 2; ++i) { int R, C; stage_rc(tid * 16 + i * 8192, R, C); const int Rb = Epi::PERM ? ((R & ~31) + perm32(R & 31)) : R;
        voffA[i] = (unsigned)(R * K + C) * 2u; voffB[i] = (unsigned)(Rb * K + C) * 2u; }
    const size_t kstep = (size_t)(BK * 2);
    const size_t hstep = (size_t)HALF * K * 2;
    const size_t tstep = 2 * hstep;
    const unsigned ldsw = (unsigned)wid * 1024u;
    const int aoff = lds_byte(wr * 64 + fr, fq * 8), boff = lds_byte(wc * 32 + fr, fq * 8);
#define PG8_SA(b, h) (((b) * 2 + (h)) * HTB)
#define PG8_SB(b, h) ((4 + (b) * 2 + (h)) * HTB)
#define PG8_STAGE(bufoff, gbase, voff) do { _Pragma("unroll") for (int _i = 0; _i < 2; ++_i) \
        __builtin_amdgcn_global_load_lds((const unsigned*)((const char*)(gbase) + (voff)[_i]), (PG8_LAS unsigned*)(lds + (bufoff) + ldsw + _i * 8192), 16, 0, 0); } while (0)
#define PG8_LDA(dst, b, h) do { _Pragma("unroll") for (int m = 0; m < 4; ++m) _Pragma("unroll") for (int k = 0; k < 2; ++k) dst[m][k] = *(const PG8_LAS bf16x8*)(lds + PG8_SA(b, h) + aoff + m * 2048 + k * 1024); } while (0)
#define PG8_LDB(dst, b, h) do { _Pragma("unroll") for (int n = 0; n < 2; ++n) _Pragma("unroll") for (int k = 0; k < 2; ++k) dst[n][k] = *(const PG8_LAS bf16x8*)(lds + PG8_SB(b, h) + boff + n * 2048 + k * 1024); } while (0)
#define PG8_MMA(ai, bj, At, Bt) do { __builtin_amdgcn_s_setprio(1); _Pragma("unroll") for (int m = 0; m < 4; ++m) _Pragma("unroll") for (int n = 0; n < 2; ++n) _Pragma("unroll") for (int k = 0; k < 2; ++k) \
        acc[ai][bj][m][n] = __builtin_amdgcn_mfma_f32_16x16x32_bf16(Bt[n][k], At[m][k], acc[ai][bj][m][n], 0, 0, 0); __builtin_amdgcn_s_setprio(0); } while (0)
#define PG8_WAIT_V(n) asm volatile("s_waitcnt vmcnt(" #n ")" ::: "memory")
#define PG8_WAIT_L(n) asm volatile("s_waitcnt lgkmcnt(" #n ")" ::: "memory")
#define PG8_BAR __builtin_amdgcn_s_barrier()
#define PG8_SCHED __builtin_amdgcn_sched_barrier(0)
    Unit cur, nxt; int ui = 0;
    if (!S.next(0, cur)) return;
    f32x4 acc[2][2][4][2];
#pragma unroll
    for (int a = 0; a < 2; ++a)
#pragma unroll
        for (int b = 0; b < 2; ++b)
#pragma unroll
            for (int m = 0; m < 4; ++m)
#pragma unroll
                for (int n = 0; n < 2; ++n) acc[a][b][m][n] = (f32x4){0.f, 0.f, 0.f, 0.f};
    bf16x8 At[4][2], B0[2][2], B1[2][2];
    const char* cA = (const char*)g.A + (size_t)cur.pm * tstep; const char* cB = (const char*)g.Bt + (size_t)cur.pn * tstep;
    S.a_ready(cur);
    if constexpr (SP2) {
        PG8_STAGE(PG8_SB(0, 0), cB, voffB); PG8_STAGE(PG8_SB(0, 1), cB + hstep, voffB); PG8_STAGE(PG8_SA(0, 0), cA, voffA); PG8_STAGE(PG8_SA(0, 1), cA + hstep, voffA);
        if (wr == 1) PG8_BAR;
        PG8_WAIT_V(2); PG8_BAR;
        PG8_STAGE(PG8_SB(1, 0), cB + kstep, voffB); PG8_STAGE(PG8_SA(1, 0), cA + kstep, voffA); PG8_STAGE(PG8_SB(1, 1), cB + hstep + kstep, voffB);
        PG8_WAIT_V(6); PG8_BAR;
    } else {
        PG8_STAGE(PG8_SB(0, 0), cB, voffB); PG8_STAGE(PG8_SA(0, 0), cA, voffA); PG8_STAGE(PG8_SB(0, 1), cB + hstep, voffB); PG8_STAGE(PG8_SA(0, 1), cA + hstep, voffA);
        if (wr == 1) PG8_BAR;
        PG8_WAIT_V(4); PG8_BAR;
        PG8_STAGE(PG8_SB(1, 0), cB + kstep, voffB); PG8_STAGE(PG8_SA(1, 0), cA + kstep, voffA); PG8_STAGE(PG8_SB(1, 1), cB + hstep + kstep, voffB);
        PG8_WAIT_V(6); PG8_BAR;
    }
    for (;;) {
        const bool has_next = S.next(ui + 1, nxt);
        const char* nA = has_next ? (const char*)g.A + (size_t)nxt.pm * tstep : cA; const char* nB = has_next ? (const char*)g.Bt + (size_t)nxt.pn * tstep : cB;
        for (int t = 0; t < nt; t += 2) {
            const bool last = (t == nt - 2);
            const char* a1 = cA + (size_t)(t + 1) * kstep;
            const char* a2 = last ? nA : cA + (size_t)(t + 2) * kstep; const char* b2 = last ? nB : cB + (size_t)(t + 2) * kstep;
            const char* a3 = a2 + kstep; const char* b3 = b2 + kstep;
            if (last && has_next) S.a_ready(nxt);
            if constexpr (SP2) {
            PG8_LDB(B0, 0, 0); PG8_LDB(B1, 0, 1); PG8_SCHED; PG8_LDA(At, 0, 0); PG8_STAGE(PG8_SA(1, 1), a1 + hstep, voffA);
            PG8_WAIT_V(8); PG8_WAIT_L(0); PG8_BAR; PG8_MMA(0, 0, At, B0); PG8_MMA(0, 1, At, B1); PG8_BAR; PG8_SCHED;
            PG8_LDA(At, 0, 1); PG8_STAGE(PG8_SB(0, 0), b2, voffB); PG8_STAGE(PG8_SB(0, 1), b2 + hstep, voffB); PG8_STAGE(PG8_SA(0, 0), a2, voffA);
            PG8_WAIT_V(8); PG8_WAIT_L(0); PG8_BAR; PG8_MMA(1, 0, At, B0); PG8_MMA(1, 1, At, B1); PG8_BAR; PG8_SCHED;
            PG8_LDB(B0, 1, 0); PG8_LDB(B1, 1, 1); PG8_SCHED; PG8_LDA(At, 1, 0); PG8_STAGE(PG8_SA(0, 1), a2 + hstep, voffA);
            PG8_WAIT_V(8); PG8_WAIT_L(0); PG8_BAR; PG8_MMA(0, 0, At, B0); PG8_MMA(0, 1, At, B1); PG8_BAR; PG8_SCHED;
            PG8_LDA(At, 1, 1); PG8_STAGE(PG8_SB(1, 0), b3, voffB); PG8_STAGE(PG8_SB(1, 1), b3 + hstep, voffB); PG8_STAGE(PG8_SA(1, 0), a3, voffA);
            PG8_WAIT_V(8); PG8_WAIT_L(0); PG8_BAR; PG8_MMA(1, 0, At, B0); PG8_MMA(1, 1, At, B1); PG8_BAR; PG8_SCHED;
            } else {
            PG8_LDB(B0, 0, 0); PG8_SCHED; PG8_LDA(At, 0, 0); PG8_STAGE(PG8_SA(1, 1), a1 + hstep, voffA);
            PG8_WAIT_L(8); PG8_BAR; PG8_WAIT_L(0); PG8_MMA(0, 0, At, B0); PG8_BAR; PG8_SCHED;
            PG8_LDB(B1, 0, 1); PG8_STAGE(PG8_SB(0, 0), b2, voffB);
            PG8_BAR; PG8_WAIT_L(0); PG8_MMA(0, 1, At, B1); PG8_BAR;
            PG8_LDA(At, 0, 1); PG8_STAGE(PG8_SA(0, 0), a2, voffA);
            PG8_BAR; PG8_WAIT_L(0); PG8_MMA(1, 0, At, B0); PG8_BAR; PG8_SCHED;
            PG8_STAGE(PG8_SB(0, 1), b2 + hstep, voffB);
            PG8_WAIT_V(6); PG8_BAR; PG8_MMA(1, 1, At, B1); PG8_BAR;
            PG8_LDB(B0, 1, 0); PG8_SCHED; PG8_LDA(At, 1, 0); PG8_STAGE(PG8_SA(0, 1), a2 + hstep, voffA);
            PG8_WAIT_L(8); PG8_BAR; PG8_WAIT_L(0); PG8_MMA(0, 0, At, B0); PG8_BAR; PG8_SCHED;
            PG8_LDB(B1, 1, 1); PG8_STAGE(PG8_SB(1, 0), b3, voffB);
            PG8_BAR; PG8_WAIT_L(0); PG8_MMA(0, 1, At, B1); PG8_BAR;
            PG8_LDA(At, 1, 1); PG8_STAGE(PG8_SA(1, 0), a3, voffA);
            PG8_BAR; PG8_WAIT_L(0); PG8_MMA(1, 0, At, B0); PG8_BAR; PG8_SCHED;
            PG8_STAGE(PG8_SB(1, 1), b3 + hstep, voffB);
            PG8_WAIT_V(6); PG8_BAR; PG8_MMA(1, 1, At, B1); PG8_BAR;
            }
        }
        if constexpr (ALIGN_EPI) { if (wr == 0) PG8_BAR; }
        if constexpr (!Epi::AFTER_DRAIN) { E(acc, cur, wr, wc, fr, fq); S.done(cur); }
        if (!has_next) break;
#pragma unroll
        for (int a = 0; a < 2; ++a)
#pragma unroll
            for (int b = 0; b < 2; ++b)
#pragma unroll
                for (int m = 0; m < 4; ++m)
#pragma unroll
                    for (int n = 0; n < 2; ++n) acc[a][b][m][n] = (f32x4){0.f, 0.f, 0.f, 0.f};
        cur = nxt; cA = nA; cB = nB; ++ui;
        if constexpr (ALIGN_EPI) { if (wr == 1) PG8_BAR; }
    }
    PG8_WAIT_V(0);
    if constexpr (!ALIGN_EPI) { if (wr == 0) PG8_BAR; }
    PG8_BAR;
    if constexpr (Epi::AFTER_DRAIN) { E.fused(acc, cur, wr, wc, fr, fq, lds, wid, lane); S.done(cur); }
#undef PG8_SA
#undef PG8_SB
#undef PG8_STAGE
#undef PG8_LDA
#undef PG8_LDB
#undef PG8_MMA
#undef PG8_WAIT_V
#undef PG8_WAIT_L
#undef PG8_BAR
#undef PG8_SCHED
}
}
#define GAS __attribute__((address_space(1)))
#define LAS __attribute__((address_space(3)))
typedef unsigned short bf16;
typedef unsigned v4u __attribute__((ext_vector_type(4)));
typedef float f32x4 __attribute__((ext_vector_type(4)));
typedef short bf16x8 __attribute__((ext_vector_type(8)));
typedef GAS unsigned gu32;
typedef GAS unsigned long long gu64;
#define RLX_AGENT __ATOMIC_RELAXED, __HIP_MEMORY_SCOPE_AGENT
#define LDS_WAIT() asm volatile("s_waitcnt lgkmcnt(0)" ::: "memory")
#define VM_WAIT() asm volatile("s_waitcnt vmcnt(0)" ::: "memory")
__device__ __forceinline__ unsigned long long rt() { return __builtin_amdgcn_s_memrealtime(); }
__device__ __forceinline__ unsigned f2bf(float f) { unsigned u = __builtin_bit_cast(unsigned, f); return (u + 0x7fffu + ((u >> 16) & 1u)) >> 16; }
__device__ __forceinline__ unsigned pk2(float lo, float hi) { return f2bf(lo) | (f2bf(hi) << 16); }

#define XB_TMO      128
#define XB_XCNT(j)  (256  + 64 * (j))
#define XB_XSUB(j)  (1280 + 64 * (j))
#define XB_XGEN(j)  (2304 + 64 * (j))
#define XB_TOP      3328
#define XB_TOPGEN   3392
#define XCD_BAR_WORDS 3456
#define XB_SPIN_CAP (1u << 18)

__device__ __forceinline__ unsigned xb_ld(unsigned* p)              { return __hip_atomic_load(p, __ATOMIC_RELAXED, __HIP_MEMORY_SCOPE_AGENT); }
__device__ __forceinline__ unsigned xb_add(unsigned* p, unsigned v) { return __hip_atomic_fetch_add(p, v, __ATOMIC_RELAXED, __HIP_MEMORY_SCOPE_AGENT); }
__device__ __forceinline__ unsigned xb_xcc_id() { return (unsigned)__builtin_amdgcn_s_getreg((3 << 11) | 20) & 0xFu; }
#define XB_SPIN(cond, bar) do { unsigned _sp = 0; while (cond) { __builtin_amdgcn_s_sleep(1); \
    if ((++_sp & 255u) == 0u) { if (xb_ld(&(bar)[XB_TMO])) break; if (_sp > XB_SPIN_CAP) { atomicAdd(&(bar)[XB_TMO], 1u); break; } } } } while (0)

struct XcdBarrier {
    unsigned* bar; unsigned x;
    volatile LAS unsigned* st;
};

__device__ __forceinline__ XcdBarrier xcd_barrier_post(unsigned* bar, volatile LAS unsigned* st) {
    XcdBarrier b; b.bar = bar; b.x = xb_xcc_id(); b.st = st;
    if (threadIdx.x == 0) (void)xb_add(&bar[XB_XCNT(b.x)], 1u);
    return b;
}
__device__ __forceinline__ void xcd_barrier_complete(unsigned* bar, unsigned x, unsigned& nloc, unsigned& nx) {
    const unsigned G = gridDim.x * gridDim.y * gridDim.z;
    unsigned sum, cnt, mine, sp = 0u;
    for (;;) {
        sum = 0u; cnt = 0u; mine = 0u;
#pragma unroll
        for (unsigned j = 0; j < 16; ++j) { const unsigned c = xb_ld(&bar[XB_XCNT(j)]); sum += c; cnt += (c > 0u) ? 1u : 0u; mine = (j == x) ? c : mine; }
        if (sum == G) break;
        __builtin_amdgcn_s_sleep(1);
        if ((++sp & 255u) == 0u) { if (xb_ld(&bar[XB_TMO])) break; if (sp > XB_SPIN_CAP) { atomicAdd(&bar[XB_TMO], 1u); break; } }
    }
    nloc = mine > 0u ? mine : 1u; nx = cnt > 0u ? cnt : 1u;
}

__device__ __forceinline__ void xcd_barrier(const XcdBarrier& b) {
    asm volatile("s_waitcnt vmcnt(0)" ::: "memory");
    __syncthreads();
    if (threadIdx.x == 0) {
        unsigned* bar = b.bar;
        __builtin_amdgcn_s_waitcnt(0);
        unsigned nloc = b.st[0], nx = b.st[1];
        if (nloc == 0u) { xcd_barrier_complete(bar, b.x, nloc, nx); b.st[0] = nloc; b.st[1] = nx; }
        const unsigned old = xb_add(&bar[XB_XSUB(b.x)], 1u);
        const unsigned gen = old / nloc;
        if (old + 1u == (gen + 1u) * nloc) {
            __builtin_amdgcn_fence(__ATOMIC_RELEASE, "agent");
            asm volatile("s_waitcnt vmcnt(0)" ::: "memory");
            const unsigned og = xb_add(&bar[XB_TOP], 1u);
            const unsigned tg = og / nx;
            if (og + 1u == (tg + 1u) * nx) xb_add(&bar[XB_TOPGEN], 1u);
            else XB_SPIN(xb_ld(&bar[XB_TOPGEN]) == tg, bar);
            __builtin_amdgcn_fence(__ATOMIC_ACQUIRE, "agent");
            xb_add(&bar[XB_XGEN(b.x)], 1u);
            asm volatile("s_waitcnt vmcnt(0)" ::: "memory");
        } else {
            XB_SPIN(xb_ld(&bar[XB_XGEN(b.x)]) == gen, bar);
            __builtin_amdgcn_fence(__ATOMIC_ACQUIRE, "agent");
            asm volatile("s_waitcnt vmcnt(0)" ::: "memory");
        }
    }
    __syncthreads();
}
#include <hip/hip_bf16.h>
#include <cmath>
namespace attn_body {
using bf16=__hip_bfloat16;
using bf16x8=__attribute__((ext_vector_type(8)))short;
using s16x4=__attribute__((ext_vector_type(4)))short;
using f32x16=__attribute__((ext_vector_type(16)))float;
using u32x4=__attribute__((ext_vector_type(4)))unsigned;
constexpr int BATCH=4,NHEAD=8,SEQ=4096,D=64,DM=NHEAD*D;
constexpr int NW=8,QBLK=32,QB=QBLK*NW,KVBLK=64,NQB=SEQ/QB;
constexpr int ATTN_PITCH=DM, ATTN_UNIT_ROWS=QB;
__device__ __forceinline__ int crow(int r,int hi){return (r&3)+8*(r>>2)+4*hi;}
#define SBAR() __builtin_amdgcn_sched_barrier(0)
__device__ __forceinline__ void cmask(f32x16&p0,f32x16&p1,int jb,int qrel,int hi){
  const float NEG=-INFINITY; int kb=64*jb+4*hi;
  #pragma unroll
  for(int r=0;r<16;++r){int kv=kb+(r&3)+8*(r>>2); if(kv>qrel)p0[r]=NEG; if(kv+32>qrel)p1[r]=NEG;}
}

constexpr int NSLOT=3, SLOTB=8192;
constexpr int LDS_K=0, LDS_V=NSLOT*SLOTB, LDS_WS=2*NSLOT*SLOTB, LDS_OST=LDS_WS+NW*64*4, LDS_CK=LDS_OST+NW*4096, LDS_BYTES=LDS_CK+SEQ*4;
constexpr float C2=0.125f*1.4426950408889634f;
__device__ __forceinline__ void glds16(const void*gsrc,unsigned lds_dst){unsigned keep;
  asm volatile("s_mov_b32 %0, m0\n\ts_mov_b32 m0, %2\n\ts_nop 0\n\tglobal_load_lds_dwordx4 %1, off\n\ts_mov_b32 m0, %0":"=&s"(keep):"v"(gsrc),"s"(lds_dst):"memory");}
__device__ __forceinline__ float max3f(float a,float b,float c){float r;asm("v_max3_f32 %0, %1, %2, %3":"=v"(r):"v"(a),"v"(b),"v"(c));return r;}
__device__ __forceinline__ float max2f(float a,float b){float r;asm("v_max_f32_e32 %0, %1, %2":"=v"(r):"v"(a),"v"(b));return r;}
__device__ __forceinline__ float fadd_s(float a,float b){float r;asm("v_add_f32_e32 %0, %1, %2":"=v"(r):"v"(a),"v"(b));return r;}
__device__ __forceinline__ float fsub_s(float a,float b){float r;asm("v_sub_f32_e32 %0, %1, %2":"=v"(r):"v"(a),"v"(b));return r;}
typedef float f32x2_t __attribute__((ext_vector_type(2))); typedef __bf16 bf16x2_t __attribute__((ext_vector_type(2)));
__device__ __forceinline__ unsigned cvtpk_s(float lo,float hi){f32x2_t v={lo,hi};bf16x2_t b=__builtin_convertvector(v,bf16x2_t);return __builtin_bit_cast(unsigned,b);}
#define WAIT_BAR(N) asm volatile("s_waitcnt vmcnt(" #N ") lgkmcnt(0)\n\ts_barrier":::"memory")

__device__ __forceinline__ void qkt(f32x16&p0,f32x16&p1,const char*Kslot,const bf16x8*qr,int r32,int hi){
  const char*kb=Kslot+hi*1024+r32*16;
  #pragma unroll
  for(int d0=0;d0<4;++d0){
    const bf16x8 b0=*reinterpret_cast<const bf16x8*>(kb+d0*2048);
    const bf16x8 b1=*reinterpret_cast<const bf16x8*>(kb+d0*2048+512);
    p0=__builtin_amdgcn_mfma_f32_32x32x16_bf16(b0,qr[d0],p0,0,0,0);p1=__builtin_amdgcn_mfma_f32_32x32x16_bf16(b1,qr[d0],p1,0,0,0);}
}
typedef __attribute__((address_space(3))) const char* lds_cptr;
typedef short v4i16_t __attribute__((ext_vector_type(4)));
__device__ __forceinline__ void kload8(bf16x8*kf,lds_cptr kp){
  kf[0]=*(const __attribute__((address_space(3))) bf16x8*)(kp);      kf[1]=*(const __attribute__((address_space(3))) bf16x8*)(kp+512);
  kf[2]=*(const __attribute__((address_space(3))) bf16x8*)(kp+2048); kf[3]=*(const __attribute__((address_space(3))) bf16x8*)(kp+2560);
  kf[4]=*(const __attribute__((address_space(3))) bf16x8*)(kp+4096); kf[5]=*(const __attribute__((address_space(3))) bf16x8*)(kp+4608);
  kf[6]=*(const __attribute__((address_space(3))) bf16x8*)(kp+6144); kf[7]=*(const __attribute__((address_space(3))) bf16x8*)(kp+6656);
}
__device__ __forceinline__ void kload2(bf16x8*kf,lds_cptr kp,int j){ kf[2*j]=*(const __attribute__((address_space(3))) bf16x8*)(kp+j*2048); kf[2*j+1]=*(const __attribute__((address_space(3))) bf16x8*)(kp+j*2048+512); }
__device__ __forceinline__ s16x4 vtr(lds_cptr p){ return __builtin_bit_cast(s16x4,__builtin_amdgcn_ds_read_tr16_b64_v4i16((__attribute__((address_space(3))) v4i16_t*)p)); }
__device__ __forceinline__ float rowmax(const f32x16&p0,const f32x16&p1){
  float a=max3f(p0[0],p0[1],p1[0]),b=max3f(p0[2],p0[3],p1[1]);a=max3f(a,p1[2],p1[3]);
  #pragma unroll
  for(int r=4;r<16;r+=4){a=max3f(a,p0[r],p0[r+1]);b=max3f(b,p0[r+2],p0[r+3]);a=max3f(a,p1[r],p1[r+1]);b=max3f(b,p1[r+2],p1[r+3]);}
  const float m=max2f(a,b);
  auto rr=__builtin_amdgcn_permlane32_swap(__float_as_uint(m),__float_as_uint(m),false,false);
  return max2f(__uint_as_float(rr[0]),__uint_as_float(rr[1]));
}
__device__ __forceinline__ void pv(f32x16*o,int vb,bf16x8 pa0,bf16x8 pa1,bf16x8 pa2,bf16x8 pa3){
  #pragma unroll
  for(int d0=0;d0<2;++d0){s16x4 lo[4],hi[4];
    #pragma unroll
    for(int ks=0;ks<4;++ks){
      asm volatile("ds_read_b64_tr_b16 %0,%1 offset:%c2":"=&v"(lo[ks]):"v"(vb),"i"(d0*4096+ks*1024):"memory");
      asm volatile("ds_read_b64_tr_b16 %0,%1 offset:%c2":"=&v"(hi[ks]):"v"(vb),"i"(d0*4096+ks*1024+512):"memory");}
    asm volatile("s_waitcnt lgkmcnt(0)":::"memory");SBAR();
    #define PK(k) (bf16x8){lo[k][0],lo[k][1],lo[k][2],lo[k][3],hi[k][0],hi[k][1],hi[k][2],hi[k][3]}
    o[d0]=__builtin_amdgcn_mfma_f32_32x32x16_bf16(pa0,PK(0),o[d0],0,0,0);
    o[d0]=__builtin_amdgcn_mfma_f32_32x32x16_bf16(pa1,PK(1),o[d0],0,0,0);
    o[d0]=__builtin_amdgcn_mfma_f32_32x32x16_bf16(pa2,PK(2),o[d0],0,0,0);
    o[d0]=__builtin_amdgcn_mfma_f32_32x32x16_bf16(pa3,PK(3),o[d0],0,0,0);
    #undef PK
  }
}

#ifndef ATTN_STORE16
#define ATTN_STORE16(p,v) (*(u32x4*)(p)=(v))
#endif
template<int THRL> __device__ __forceinline__ void attn_unit(int b,int h,int qb,const bf16*Q,const bf16*__restrict__ K,const bf16*__restrict__ V,bf16*O,const float*__restrict__ c2,float M2,char*shm){
  int tid=threadIdx.x; asm volatile("":"+v"(tid)); const int lane=tid&63,r32=lane&31,hi=lane>>5; const int wid=__builtin_amdgcn_readfirstlane(tid>>6);
  const long rowbase=(long)b*SEQ; const int q0=qb*QB;
  const bf16*Qw=Q+(rowbase+q0+wid*QBLK)*DM+h*D;
  const bf16*Kh0=K+rowbase*DM+h*D,*Vh0=V+rowbase*DM+h*D;
  const unsigned lds0=(unsigned)(uintptr_t)shm;
  float*wsf=(float*)(shm+LDS_WS)+wid*64;
  const unsigned kdst=lds0+LDS_K+wid*1024, vdst=lds0+LDS_V+wid*1024;
  #define DMA_K(t,slot) glds16(ksrc+(long)(t)*KVBLK*DM,(unsigned)__builtin_amdgcn_readfirstlane(kdst+(slot)))
  #define DMA_V(t,slot) glds16(vsrc+(long)(t)*KVBLK*DM,(unsigned)__builtin_amdgcn_readfirstlane(vdst+(slot)))
  const int vb0=(int)(lds0+LDS_V)+((lane>>4)&1)*32+(lane&3)*8+(4*hi+((lane&15)>>2))*64;
  const char*Kbase=shm+LDS_K; bf16x8 kf[8];
  const lds_cptr shm3=(lds_cptr)shm; const lds_cptr kp0=shm3+LDS_K+hi*1024+r32*16; const lds_cptr vp0=shm3+LDS_V+((lane>>4)&1)*32+(lane&3)*8+(4*hi+((lane&15)>>2))*64;
  const int NT0=(q0+QB)/KVBLK;
  int ts; { const int tl=lane; const float cqa=c2[q0]; const float ckb=(tl<NT0-4)?c2[64*tl+63]:cqa; const unsigned long long bm=__ballot((tl<NT0-4)&&(cqa-ckb< -(30.f+2.f*M2))); ts=__builtin_popcountll(bm)&~1; }
  ts=__builtin_amdgcn_readfirstlane(ts);
  const int NT=NT0-ts;
  const bf16*Kh=Kh0+(long)ts*KVBLK*DM,*Vh=Vh0+(long)ts*KVBLK*DM;
  const bf16*ksrc=Kh+(long)lane*DM+wid*8;
  const bf16*vsrc=Vh+(long)(16*(wid&3)+(lane>>2))*DM+(wid>>2)*32+(lane&3)*8;
  typedef float f32x4_t __attribute__((ext_vector_type(4)));
  int tidl=tid; asm volatile("":"+v"(tidl));
  const int nck4=(q0+QB)/4; f32x4_t ckv0=f32x4_t{},ckv1=f32x4_t{}; if(tidl<nck4)ckv0=((const f32x4_t*)c2)[tidl]; if(tidl+512<nck4)ckv1=((const f32x4_t*)c2)[tidl+512];
  const float cq=c2[q0+wid*QBLK+r32]-M2;
  DMA_K(0,0);DMA_V(0,0);DMA_K(1,SLOTB);
  bf16x8 qr[4];
  #pragma unroll
  for(int d0=0;d0<4;++d0)qr[d0]=*reinterpret_cast<const bf16x8*>(&Qw[(long)r32*DM+d0*16+hi*8]);
  float l_reg=0.f;f32x16 o[2];o[0]=f32x16{};o[1]=f32x16{};
  { __attribute__((address_space(3))) f32x4_t*ckl=(__attribute__((address_space(3))) f32x4_t*)((lds_cptr)shm+LDS_CK); if(tidl<nck4)ckl[tidl]=ckv0; if(tidl+512<nck4)ckl[tidl+512]=ckv1; }
  const __attribute__((address_space(3))) f32x4_t*ckp=(const __attribute__((address_space(3))) f32x4_t*)((lds_cptr)shm+LDS_CK)+hi+ts*16;
  #define CKLD(P0,P1,t) do{ _Pragma("unroll") for(int g_=0;g_<4;++g_){ const f32x4_t a_=ckp[(t)*16+2*g_], b_=ckp[(t)*16+8+2*g_]; P0[4*g_]=a_[0];P0[4*g_+1]=a_[1];P0[4*g_+2]=a_[2];P0[4*g_+3]=a_[3]; P1[4*g_]=b_[0];P1[4*g_+1]=b_[1];P1[4*g_+2]=b_[2];P1[4*g_+3]=b_[3]; } }while(0)
  #define CKSUB(P0,P1) do{ _Pragma("unroll") for(int r=0;r<16;++r){P0[r]=cq-P0[r];P1[r]=cq-P1[r];} }while(0)
  const int qrel=wid*QBLK+r32;
  #define CMASK(P0,P1,t) do{int jb_=(t)-(NT-4); if(jb_>=0)cmask(P0,P1,jb_,qrel,hi);}while(0)
  #define START(P0,P1) do{ _Pragma("unroll") for(int r=0;r<16;++r)P0[r]=__builtin_amdgcn_exp2f(P0[r]); }while(0)
  #define RESC() do{}while(0)
  f32x16 pA0,pA1,pB0,pB1;
  int sl_prev=0,sl_cur=0,sl_next=SLOTB;
  #define ROT() do{sl_prev=sl_cur;sl_cur=sl_next;sl_next=(sl_next==(NSLOT-1)*SLOTB)?0:sl_next+SLOTB;}while(0)
  DMA_K(2,2*SLOTB);
  WAIT_BAR(3);
  CKLD(pA0,pA1,0);CKSUB(pA0,pA1);
  qkt(pA0,pA1,Kbase,qr,r32,hi);asm volatile("s_nop 15\n\ts_nop 7":"+v"(pA0),"+v"(pA1));CMASK(pA0,pA1,0);
  CKLD(pB0,pB1,1);CKSUB(pB0,pB1);
  START(pA0,pA1);
  _Pragma("unroll") for(int r=0;r<16;++r)pA1[r]=__builtin_amdgcn_exp2f(pA1[r]);
  WAIT_BAR(0);
  DMA_K(3,0);DMA_V(1,SLOTB);
  ROT();
  kload8(kf,kp0+sl_cur);
  WAIT_BAR(2);
  s16x4 vlo[8],vhi[8]; u32x4 pw0,pw1,pw2,pw3;
  #define PKW(P,B) cvtpk_s(P[B],P[B+1])
  #define PAF(k) __builtin_bit_cast(bf16x8,pw##k)
  #define VFR(i) (bf16x8){vlo[i][0],vlo[i][1],vlo[i][2],vlo[i][3],vhi[i][0],vhi[i][1],vhi[i][2],vhi[i][3]}
  #define PIN(x) asm volatile("":"+v"(x))
  #define MX3(a,b,c) __builtin_fmaxf(__builtin_fmaxf((a),(b)),(c))
  #define GAPA(MF,A0,A1,A2,A3,W0,W1,PW) do{ MF; sacc+=A0; sacc+=A1; sacc+=A2; sacc+=A3; PIN(sacc); W0; W1; PIN(PW); SBAR(); }while(0)
  #define EX(v) __builtin_amdgcn_exp2f(v)
  #define GAPB(MF,X,B) do{ MF; X[B]=EX(X[B]); X[B+1]=EX(X[B+1]); X[B+2]=EX(X[B+2]); X[B+3]=EX(X[B+3]); PIN(X); SBAR(); }while(0)
  #define VRD(i) do{ vlo[i]=vtr(vp_+(((i)>>2)*4096+((i)&3)*1024)); vhi[i]=vtr(vp_+(((i)>>2)*4096+((i)&3)*1024+512)); }while(0)
  #define KRD(G,j) do{ if(G){ kload2(kf,kp0+sl_next,j); SBAR(); } }while(0)
  #define STEP(C0,C1,P0,P1,t,GK,GV,GL) do{ SBAR(); \
    const lds_cptr vp_=vp0+sl_prev; \
    VRD(0); SBAR(); float sacc=(P0[0]+P0[1]); \
    GAPA(C0=__builtin_amdgcn_mfma_f32_32x32x16_bf16(kf[0],qr[0],C0,0,0,0), P0[2],P0[3],P0[4],P0[5],     pw0[0]=PKW(P0,0), pw0[1]=PKW(P0,2), pw0); \
    VRD(4); SBAR(); GAPA(C1=__builtin_amdgcn_mfma_f32_32x32x16_bf16(kf[1],qr[0],C1,0,0,0), P0[6],P0[7],P0[8],P0[9],     pw0[2]=PKW(P0,4), pw0[3]=PKW(P0,6), pw0); \
    VRD(1); SBAR(); GAPA(C0=__builtin_amdgcn_mfma_f32_32x32x16_bf16(kf[2],qr[1],C0,0,0,0),   P0[10],P0[11],P0[12],P0[13], pw1[0]=PKW(P0,8), pw1[1]=PKW(P0,10), pw1); \
    VRD(5); SBAR(); GAPA(C1=__builtin_amdgcn_mfma_f32_32x32x16_bf16(kf[3],qr[1],C1,0,0,0),   P0[14],P0[15],P1[0],P1[1],   pw1[2]=PKW(P0,12),pw1[3]=PKW(P0,14), pw1); \
    VRD(2); SBAR(); GAPA(C0=__builtin_amdgcn_mfma_f32_32x32x16_bf16(kf[4],qr[2],C0,0,0,0),   P1[2],P1[3],P1[4],P1[5],     pw2[0]=PKW(P1,0), pw2[1]=PKW(P1,2), pw2); \
    VRD(6); SBAR(); GAPA(C1=__builtin_amdgcn_mfma_f32_32x32x16_bf16(kf[5],qr[2],C1,0,0,0),   P1[6],P1[7],P1[8],P1[9],     pw2[2]=PKW(P1,4), pw2[3]=PKW(P1,6), pw2); \
    VRD(3); SBAR(); GAPA(C0=__builtin_amdgcn_mfma_f32_32x32x16_bf16(kf[6],qr[3],C0,0,0,0),   P1[10],P1[11],P1[12],P1[13], pw3[0]=PKW(P1,8), pw3[1]=PKW(P1,10), pw3); \
    VRD(7); SBAR(); GAPA(C1=__builtin_amdgcn_mfma_f32_32x32x16_bf16(kf[7],qr[3],C1,0,0,0),   P1[14],P1[15],0.f,0.f,       pw3[2]=PKW(P1,12),pw3[3]=PKW(P1,14), pw3); \
    l_reg+=sacc; \
    if(GK){DMA_K((t)+3,sl_cur);} if(GV){DMA_V((t)+1,sl_next);} \
    CMASK(C0,C1,t); \
    SBAR(); \
    GAPB(o[0]=__builtin_amdgcn_mfma_f32_32x32x16_bf16(PAF(0),VFR(0),o[0],0,0,0), C0,0); \
    GAPB(o[1]=__builtin_amdgcn_mfma_f32_32x32x16_bf16(PAF(0),VFR(4),o[1],0,0,0), C0,4); \
    KRD(GL,0); GAPB(o[0]=__builtin_amdgcn_mfma_f32_32x32x16_bf16(PAF(1),VFR(1),o[0],0,0,0), C0,8); \
    KRD(GL,1); GAPB(o[1]=__builtin_amdgcn_mfma_f32_32x32x16_bf16(PAF(1),VFR(5),o[1],0,0,0), C0,12); \
    KRD(GL,2); GAPB(o[0]=__builtin_amdgcn_mfma_f32_32x32x16_bf16(PAF(2),VFR(2),o[0],0,0,0), C1,0); \
    KRD(GL,3); GAPB(o[1]=__builtin_amdgcn_mfma_f32_32x32x16_bf16(PAF(2),VFR(6),o[1],0,0,0), C1,4); \
    GAPB(o[0]=__builtin_amdgcn_mfma_f32_32x32x16_bf16(PAF(3),VFR(3),o[0],0,0,0), C1,8); \
    GAPB(o[1]=__builtin_amdgcn_mfma_f32_32x32x16_bf16(PAF(3),VFR(7),o[1],0,0,0), C1,12); \
    if(GL){ CKLD(P0,P1,(t)+1); CKSUB(P0,P1); } \
    }while(0)
  int t=1;
  #undef CMASK
  #define CMASK(P0,P1,t) do{}while(0)
  for(;t+5<NT;t+=2){
    STEP(pB0,pB1,pA0,pA1,t,true,true,true);     WAIT_BAR(2); RESC(); ROT();
    STEP(pA0,pA1,pB0,pB1,t+1,true,true,true);   WAIT_BAR(2); RESC(); ROT();
  }
  #undef CMASK
  #define CMASK(P0,P1,t) do{int jb_=(t)-(NT-4); if(jb_>=0)cmask(P0,P1,jb_,qrel,hi);}while(0)
  #define ENDW(tt) do{ if((tt)+3<NT){WAIT_BAR(2);} else if((tt)+2<NT){WAIT_BAR(1);} else {WAIT_BAR(0);} }while(0)
  for(;t+1<NT;t+=2){
    STEP(pB0,pB1,pA0,pA1,t,(t+3<NT),(t+1<NT),(t+1<NT));       ENDW(t);   RESC(); ROT();
    STEP(pA0,pA1,pB0,pB1,t+1,(t+4<NT),(t+2<NT),(t+2<NT));     ENDW(t+1); RESC(); ROT();
  }
  STEP(pB0,pB1,pA0,pA1,NT-1,false,false,false); RESC();
  { float sacc=pB0[0]+pB0[1]; _Pragma("unroll") for(int r=2;r<16;++r)sacc+=pB0[r]; _Pragma("unroll") for(int r=0;r<16;++r)sacc+=pB1[r]; l_reg+=sacc;
    pw0=(u32x4){PKW(pB0,0),PKW(pB0,2),PKW(pB0,4),PKW(pB0,6)};pw1=(u32x4){PKW(pB0,8),PKW(pB0,10),PKW(pB0,12),PKW(pB0,14)};pw2=(u32x4){PKW(pB1,0),PKW(pB1,2),PKW(pB1,4),PKW(pB1,6)};pw3=(u32x4){PKW(pB1,8),PKW(pB1,10),PKW(pB1,12),PKW(pB1,14)};
    SBAR(); pv(o,vb0+sl_cur,PAF(0),PAF(1),PAF(2),PAF(3)); }
  #undef PKW
  #undef PAF
  #undef VFR
  #undef PIN
  #undef MX3
  #undef GAPA
  #undef GAPB
  #undef EX
  #undef VRD
  #undef KRD
  #undef STEP
  #undef ENDW
  {auto rr=__builtin_amdgcn_permlane32_swap(__float_as_uint(l_reg),__float_as_uint(l_reg),false,false);l_reg=__uint_as_float(rr[0])+__uint_as_float(rr[1]);}
  if(hi==0)wsf[32+r32]=l_reg;asm volatile("s_waitcnt lgkmcnt(0)":::"memory");
  float rli[16];
  #pragma unroll
  for(int r=0;r<16;++r)rli[r]=__builtin_amdgcn_rcpf(wsf[32+crow(r,hi)]);
  bf16*Ow=O+(rowbase+q0+wid*QBLK)*DM+h*D;
  { bf16*stg=(bf16*)(shm+LDS_OST)+wid*2048;
    #pragma unroll
    for(int r=0;r<16;++r){const int orow=crow(r,hi);
      #pragma unroll
      for(int d0=0;d0<2;++d0)stg[orow*64+d0*32+r32]=__float2bfloat16(o[d0][r]*rli[r]);}
    asm volatile("s_waitcnt lgkmcnt(0)":::"memory");
    #pragma unroll
    for(int i=0;i<4;++i){const int row=i*8+(lane>>3),ch=lane&7; const u32x4 v=*(const u32x4*)(stg+row*64+ch*8); ATTN_STORE16(Ow+(long)row*DM+ch*8,v);} }
  asm volatile("s_waitcnt lgkmcnt(0)\n\ts_barrier":::"memory");
  #undef DMA_K
  #undef DMA_V
  #undef CMASK
  #undef START
  #undef RESC
  #undef ROT
  #undef CKLD
  #undef CKSUB
}
constexpr int ATTN_LDS_BYTES=LDS_BYTES;
struct AttnTensors { const bf16* Q; const bf16* K; const bf16* V; bf16* O; const float* C2T; float M2; };
struct AttnUnit { int bh; int qb; };
struct StaticOrder {
  int vcu, G;
  __device__ __forceinline__ explicit StaticOrder(int grid,int v):vcu(v),G(grid){}
  __device__ __forceinline__ bool next(int i,AttnUnit&u)const{ const int L=i*G+vcu; if(L>=BATCH*NHEAD*NQB)return false; const int r=L>>8, idx=L&255, k=idx&7; u.bh=idx>>3; u.qb=(r==0)?(NQB-1-k):k; return true; }
  __device__ __forceinline__ void a_ready(const AttnUnit&)const{}
  __device__ __forceinline__ void done(const AttnUnit&)const{}
};
template<class Sched,int THRL=8> __device__ __forceinline__ void attn_phase(char*lds,const AttnTensors&T,const Sched&S){
  AttnUnit u;
  for(int i=0;S.next(i,u);++i){ S.a_ready(u); attn_unit<THRL>(u.bh/NHEAD,u.bh%NHEAD,u.qb,T.Q,T.K,T.V,T.O,T.C2T+(size_t)u.bh*SEQ,T.M2,lds); S.done(u); }
}
#undef SBAR
#undef WAIT_BAR
}

constexpr int NWAVES = 8, NTHR = 512;
constexpr int DM = 1024, NB = 4, SEQ = 4096, DB = 128, DSEQ = 8, PAST = 2048, PAGE = 128, NPAGES = 16;
constexpr int MP = NB * SEQ, MS = DB * DSEQ, M = MP + MS;
constexpr int DP = 512, DA = 512, NH = 8, HD = 64, DIN = 4104, NPROJ = 4096;
constexpr int NKEYS = 128, NEXP = 16384, PH = 8, TOPK = 16, DKH = 128, DQ = 2048;
constexpr float EPS = 1e-6f;
constexpr float LOG2E = 1.4426950408889634f;
constexpr float C2 = 0.125f * LOG2E;
constexpr size_t O_YP = 0, O_YS = O_YP + (size_t)MP * DM, O_KP = O_YS + (size_t)MS * DM, O_VP = O_KP + (size_t)MP * DA, O_LFP = O_VP + (size_t)MP * DA,
                 O_PP = O_LFP + (size_t)MP * NH, O_KS = O_PP + (size_t)NB * 15 * DP, O_VS = O_KS + (size_t)MS * DA, O_LFS = O_VS + (size_t)MS * DA,
                 O_PS = O_LFS + (size_t)MS * NH, O_END = O_PS + (size_t)DB * 15 * DP;
constexpr size_t MiB = 1u << 20;
constexpr size_t WS_CTL = 0, CTL_ZERO_BYTES = 1 * MiB;
constexpr size_t WS_WIN = 2 * MiB, WS_WBP = 10 * MiB, WS_WBA = 11 * MiB, WS_WOUT = 12 * MiB, WS_WQ = 14 * MiB, WS_SUBK = 18 * MiB, WS_CP2 = 19 * MiB, WS_RSS = 20 * MiB, WS_US = 22 * MiB, WS_VS = 23 * MiB;
constexpr size_t WS_PU = 32 * MiB, WS_PV = 64 * MiB, WS_XN = 96 * MiB  , WS_U = 132 * MiB, WS_Q = 150 * MiB, WS_K = 168 * MiB, WS_V = 186 * MiB,
                 WS_GA = 204 * MiB, WS_GB = 240 * MiB, WS_PO = 276 * MiB, WS_AO = 294 * MiB, WS_T = 312 * MiB, WS_MIX = 348 * MiB, WS_PQ = 384 * MiB,
                 WS_SI = 456 * MiB, WS_SG = 466 * MiB, WS_H = 476 * MiB, WS_END = 548 * MiB;
constexpr int CW_BAR = 4096;
constexpr int LDS_BYTES = 163840;
constexpr int SCR_BYTES = 159 * 1024;
constexpr int MISC_OFF = SCR_BYTES;

typedef unsigned short bf16;
typedef unsigned v4u __attribute__((ext_vector_type(4)));
typedef unsigned v2u __attribute__((ext_vector_type(2)));
typedef float f32x4 __attribute__((ext_vector_type(4)));
typedef float f32x2 __attribute__((ext_vector_type(2)));

__device__ __forceinline__ float bf2f(unsigned short b) { return __uint_as_float((unsigned)b << 16); }
__device__ __forceinline__ float bflo(unsigned w) { return __uint_as_float(w << 16); }
__device__ __forceinline__ float bfhi(unsigned w) { return __uint_as_float(w & 0xffff0000u); }
typedef __bf16 bf16x2_t __attribute__((ext_vector_type(2)));
__device__ __forceinline__ unsigned pkbf(float lo, float hi) { f32x2 v = {lo, hi}; bf16x2_t b = __builtin_convertvector(v, bf16x2_t); return __builtin_bit_cast(unsigned, b); }
__device__ __forceinline__ float wave_sum(float v) {
#pragma unroll
    for (int o = 1; o < 64; o <<= 1) v += __shfl_xor(v, o);
    return v;
}
__device__ __forceinline__ float wave_max(float v) {
#pragma unroll
    for (int o = 1; o < 64; o <<= 1) v = fmaxf(v, __shfl_xor(v, o));
    return v;
}

struct Args {
    const float* x_p; const float* x_s; const float* cache_k; const float* cache_v; const float* cache_lf; const float* state_pool; const int* page_table;
    const float* norm_mix_g; const float* w_in; const float* b_forget; const float* q_norm_g; const float* k_norm_g; const float* pool_mix_w; const float* pool_scale;
    const float* w_bp; const float* w_ba; const float* w_out; const float* norm_ffn_g; const float* w_query; const float* sub_keys; const float* peer_u; const float* peer_v;
    float* out; unsigned char* ws; int ph_lo, ph_hi, li, pad;
};

using pg8::Unit;
struct EpiInProj {
    static constexpr bool PERM = true, AFTER_DRAIN = false;
    bf16 *U, *Q, *K, *V, *GA, *GB; float* out; const float *gq, *gk; int pn_off;
    __device__ __forceinline__ void operator()(const f32x4 (&acc)[2][2][4][2], const Unit& u, int wr, int wc, int fr, int fq) const {
        const int pn = u.pn + pn_off; const int row0 = u.pm * 256 + wr * 64 + fr; const bool prompt = u.pm < (MP / 256);
        if (pn < 2) {
#pragma unroll
            for (int ai = 0; ai < 2; ++ai)
#pragma unroll
                for (int m = 0; m < 4; ++m) { const int row = row0 + ai * 128 + m * 16;
                    float* tail = nullptr;
                    if (prompt) { const int s = row & (SEQ - 1), b = row >> 12; if (s >= SEQ - 15) tail = out + O_PP + (size_t)(b * 15 + (s - (SEQ - 15))) * DP; }
                    else { const int rs = row - MP; tail = out + O_PS + (size_t)((rs >> 3) * 15 + 7 + (rs & 7)) * DP; }
#pragma unroll
                    for (int bj = 0; bj < 2; ++bj) { const int col = pn * 256 + bj * 128 + wc * 32 + 8 * fq; const f32x4 v0 = acc[ai][bj][m][0], v1 = acc[ai][bj][m][1];
                        v4u w; w.x = pkbf(v0[0], v0[1]); w.y = pkbf(v0[2], v0[3]); w.z = pkbf(v1[0], v1[1]); w.w = pkbf(v1[2], v1[3]);
                        *(v4u*)(U + (size_t)row * DP + col) = w;
                        if (tail) { *(f32x4*)(tail + col) = v0; *(f32x4*)(tail + col + 4) = v1; } } }
        } else if (pn < 6) {
            const bool isq = pn < 4; const int head = 4 * (pn & 1) + wc; const float* g = isq ? gq : gk;
            f32x4 gv[2][2];
#pragma unroll
            for (int bj = 0; bj < 2; ++bj)
#pragma unroll
                for (int n = 0; n < 2; ++n) gv[bj][n] = *(const f32x4*)(g + 32 * bj + 8 * fq + 4 * n);
            bf16* dst = isq ? Q : K;
#pragma unroll
            for (int ai = 0; ai < 2; ++ai)
#pragma unroll
                for (int m = 0; m < 4; ++m) { const int row = row0 + ai * 128 + m * 16; float ss = 0.f;
#pragma unroll
                    for (int bj = 0; bj < 2; ++bj)
#pragma unroll
                        for (int n = 0; n < 2; ++n) { const f32x4 x = acc[ai][bj][m][n]; ss += (x[0] * x[0] + x[1] * x[1]) + (x[2] * x[2] + x[3] * x[3]); }
                    ss += __shfl_xor(ss, 16); ss += __shfl_xor(ss, 32);
                    float r = 1.0f / sqrtf(ss * (1.0f / 64.0f) + EPS);
                    float* kout = isq ? nullptr : (prompt ? out + O_KP + (size_t)row * DA : out + O_KS + (size_t)(row - MP) * DA);
                    const float rq = isq ? r * C2 : r;
#pragma unroll
                    for (int bj = 0; bj < 2; ++bj) { const int col = head * 64 + 32 * bj + 8 * fq; const f32x4 v0 = acc[ai][bj][m][0] * gv[bj][0] * rq, v1 = acc[ai][bj][m][1] * gv[bj][1] * rq;
                        v4u w; w.x = pkbf(v0[0], v0[1]); w.y = pkbf(v0[2], v0[3]); w.z = pkbf(v1[0], v1[1]); w.w = pkbf(v1[2], v1[3]);
                        *(v4u*)(dst + (size_t)row * DA + col) = w;
                        if (!isq) { *(f32x4*)(kout + col) = v0; *(f32x4*)(kout + col + 4) = v1; } } }
        } else if (pn < 8) {
#pragma unroll
            for (int ai = 0; ai < 2; ++ai)
#pragma unroll
                for (int m = 0; m < 4; ++m) { const int row = row0 + ai * 128 + m * 16;
                    float* vout = prompt ? out + O_VP + (size_t)row * DA : out + O_VS + (size_t)(row - MP) * DA;
#pragma unroll
                    for (int bj = 0; bj < 2; ++bj) { const int col = (pn - 6) * 256 + bj * 128 + wc * 32 + 8 * fq; const f32x4 v0 = acc[ai][bj][m][0], v1 = acc[ai][bj][m][1];
                        v4u w; w.x = pkbf(v0[0], v0[1]); w.y = pkbf(v0[2], v0[3]); w.z = pkbf(v1[0], v1[1]); w.w = pkbf(v1[2], v1[3]);
                        *(v4u*)(V + (size_t)row * DA + col) = w; *(f32x4*)(vout + col) = v0; *(f32x4*)(vout + col + 4) = v1; } }
        } else {
            bf16* dst = pn < 12 ? GA : GB; const int ct = (pn < 12 ? pn - 8 : pn - 12) * 256;
#pragma unroll
            for (int ai = 0; ai < 2; ++ai)
#pragma unroll
                for (int m = 0; m < 4; ++m) { const int row = row0 + ai * 128 + m * 16;
#pragma unroll
                    for (int bj = 0; bj < 2; ++bj) { const int col = ct + bj * 128 + wc * 32 + 8 * fq; float s[8];
#pragma unroll
                        for (int n = 0; n < 2; ++n)
#pragma unroll
                            for (int i = 0; i < 4; ++i) s[4 * n + i] = __builtin_amdgcn_rcpf(1.0f + __builtin_amdgcn_exp2f(-LOG2E * acc[ai][bj][m][n][i]));
                        v4u w; w.x = pkbf(s[0], s[1]); w.y = pkbf(s[2], s[3]); w.z = pkbf(s[4], s[5]); w.w = pkbf(s[6], s[7]);
                        *(v4u*)(dst + (size_t)row * DM + col) = w; } }
        }
    }
};
template <int MODE> struct EpiGate {
    static constexpr bool PERM = true, AFTER_DRAIN = false;
    const bf16* G; const bf16* Tin; bf16* O;
    __device__ __forceinline__ void operator()(const f32x4 (&acc)[2][2][4][2], const Unit& u, int wr, int wc, int fr, int fq) const {
        const int row0 = u.pm * 256 + wr * 64 + fr;
#pragma unroll
        for (int ai = 0; ai < 2; ++ai)
#pragma unroll
            for (int m = 0; m < 4; ++m) { const int row = row0 + ai * 128 + m * 16;
#pragma unroll
                for (int bj = 0; bj < 2; ++bj) { const size_t off = (size_t)row * DM + u.pn * 256 + bj * 128 + wc * 32 + 8 * fq;
                    const v4u g = *(const v4u*)(G + off); const f32x4 v0 = acc[ai][bj][m][0], v1 = acc[ai][bj][m][1];
                    float r[8] = {v0[0] * bflo(g.x), v0[1] * bfhi(g.x), v0[2] * bflo(g.y), v0[3] * bfhi(g.y), v1[0] * bflo(g.z), v1[1] * bfhi(g.z), v1[2] * bflo(g.w), v1[3] * bfhi(g.w)};
                    if (MODE == 1) { const v4u t = *(const v4u*)(Tin + off);
                        r[0] += bflo(t.x); r[1] += bfhi(t.x); r[2] += bflo(t.y); r[3] += bfhi(t.y); r[4] += bflo(t.z); r[5] += bfhi(t.z); r[6] += bflo(t.w); r[7] += bfhi(t.w); }
                    v4u w; w.x = pkbf(r[0], r[1]); w.y = pkbf(r[2], r[3]); w.z = pkbf(r[4], r[5]); w.w = pkbf(r[6], r[7]);
                    *(v4u*)(O + off) = w; } }
    }
};
struct EpiOut {
    static constexpr bool PERM = true, AFTER_DRAIN = false;
    const float* xp; const float* xs; float* H; bf16* HG; const float* gf; float* RSS;
    __device__ __forceinline__ void operator()(const f32x4 (&acc)[2][2][4][2], const Unit& u, int wr, int wc, int fr, int fq) const {
        const int row0 = u.pm * 256 + wr * 64 + fr; const bool prompt = u.pm < (MP / 256);
        f32x4 gv[2][2];
#pragma unroll
        for (int bj = 0; bj < 2; ++bj)
#pragma unroll
            for (int n = 0; n < 2; ++n) gv[bj][n] = *(const f32x4*)(gf + u.pn * 256 + bj * 128 + wc * 32 + 8 * fq + 4 * n);
#pragma unroll
        for (int ai = 0; ai < 2; ++ai)
#pragma unroll
            for (int m = 0; m < 4; ++m) { const int row = row0 + ai * 128 + m * 16; float ss = 0.f;
                const float* xr = prompt ? xp + (size_t)row * DM : xs + (size_t)(row - MP) * DM;
#pragma unroll
                for (int bj = 0; bj < 2; ++bj) { const int col = u.pn * 256 + bj * 128 + wc * 32 + 8 * fq;
                    const f32x4 h0 = acc[ai][bj][m][0] + *(const f32x4*)(xr + col), h1 = acc[ai][bj][m][1] + *(const f32x4*)(xr + col + 4);
                    ss += (h0[0] * h0[0] + h0[1] * h0[1]) + (h0[2] * h0[2] + h0[3] * h0[3]) + (h1[0] * h1[0] + h1[1] * h1[1]) + (h1[2] * h1[2] + h1[3] * h1[3]);
                    *(f32x4*)(H + (size_t)row * DM + col) = h0; *(f32x4*)(H + (size_t)row * DM + col + 4) = h1;
                    const f32x4 a0 = h0 * gv[bj][0], a1 = h1 * gv[bj][1];
                    v4u w; w.x = pkbf(a0[0], a0[1]); w.y = pkbf(a0[2], a0[3]); w.z = pkbf(a1[0], a1[1]); w.w = pkbf(a1[2], a1[3]);
                    *(v4u*)(HG + (size_t)row * DM + col) = w; }
                ss += __shfl_xor(ss, 16); ss += __shfl_xor(ss, 32);
                if (fq == 0) RSS[(size_t)row * 16 + u.pn * 4 + wc] = ss; }
    }
};

struct Frame {
    LAS unsigned char* lds; volatile LAS unsigned* MISC; gu32* ctl;
    int tid, lane, wave, vcu, G;
};

__device__ __forceinline__ void transpose_item(const float* W, int ldw, int K, bf16* WT, int src_col0, int dst_row0, int k0, LAS float* scr, int lane) {
#pragma unroll 8
    for (int i = 0; i < 32; ++i) { const int kk = 2 * i + (lane >> 5); scr[kk * 33 + (lane & 31)] = W[(size_t)(k0 + kk) * ldw + src_col0 + (lane & 31)]; }
    LDS_WAIT(); asm volatile("" ::: "memory");
    const int c = lane & 7;
#pragma unroll
    for (int j = 0; j < 4; ++j) { const int n = (lane >> 3) + 8 * j; const LAS float* s = scr + (8 * c) * 33 + n;
        v4u o; o.x = pkbf(s[0 * 33], s[1 * 33]); o.y = pkbf(s[2 * 33], s[3 * 33]); o.z = pkbf(s[4 * 33], s[5 * 33]); o.w = pkbf(s[6 * 33], s[7 * 33]);
        *(v4u*)(WT + (size_t)(dst_row0 + n) * K + k0 + 8 * c) = o; }
    LDS_WAIT(); asm volatile("" ::: "memory");
}
__device__ __forceinline__ int win_src_col(int db) {
    if (db < 16) return 32 * db;
    if (db < 48) { const int base = db < 32 ? 512 : 1024; const int local = (db - 16) & 15, tile = local >> 3, blk = local & 7, bj = blk >> 2, w = blk & 3; return base + tile * 256 + 64 * w + 32 * bj; }
    if (db < 64) return 1536 + 32 * (db - 48);
    if (db < 96) return 2056 + 32 * (db - 64);
    return 3080 + 32 * (db - 96);
}
__device__ __forceinline__ void cvt_rows_bf16(const float* src, bf16* dst, size_t n8, size_t gtid, size_t gn) {
    for (size_t i = gtid; i < n8; i += gn) { const f32x4 a = *(const f32x4*)(src + 8 * i), b = *(const f32x4*)(src + 8 * i + 4);
        v4u w; w.x = pkbf(a[0], a[1]); w.y = pkbf(a[2], a[3]); w.z = pkbf(b[0], b[1]); w.w = pkbf(b[2], b[3]); *(v4u*)(dst + 8 * i) = w; }
}
__device__ __forceinline__ void cvt_rows_fp8(const float* src, unsigned char* dst, float* scl, int gw, int NGW, int lane) {
    for (int e0 = gw; e0 < NEXP; e0 += 2 * NGW) {
        f32x4 q[2][4]; float mx[2];
#pragma unroll
        for (int u = 0; u < 2; ++u) { const int e = (e0 + u * NGW < NEXP) ? e0 + u * NGW : e0; const float* r = src + (size_t)e * DM + 16 * lane;
            q[u][0] = *(const f32x4*)r; q[u][1] = *(const f32x4*)(r + 4); q[u][2] = *(const f32x4*)(r + 8); q[u][3] = *(const f32x4*)(r + 12); }
#pragma unroll
        for (int u = 0; u < 2; ++u) { float m = 0.f;
#pragma unroll
            for (int j = 0; j < 4; ++j) m = fmaxf(m, fmaxf(fmaxf(fabsf(q[u][j][0]), fabsf(q[u][j][1])), fmaxf(fabsf(q[u][j][2]), fabsf(q[u][j][3]))));
            mx[u] = m; }
#pragma unroll
        for (int o = 1; o < 64; o <<= 1) { mx[0] = fmaxf(mx[0], __shfl_xor(mx[0], o)); mx[1] = fmaxf(mx[1], __shfl_xor(mx[1], o)); }
#pragma unroll
        for (int u = 0; u < 2; ++u) { const int e = e0 + u * NGW; if (e < NEXP) {
            int k = 0; if (mx[u] > 1e-30f) k = 7 - ((int)((__builtin_bit_cast(unsigned, mx[u]) >> 23) & 0xffu) - 127);
            k = k < -100 ? -100 : (k > 100 ? 100 : k);
            const float sc = __builtin_bit_cast(float, (unsigned)(k + 127) << 23), isc = __builtin_bit_cast(float, (unsigned)(127 - k) << 23);
            int w[4];
#pragma unroll
            for (int j = 0; j < 4; ++j) { w[j] = 0; w[j] = __builtin_amdgcn_cvt_pk_fp8_f32(q[u][j][0] * sc, q[u][j][1] * sc, w[j], false); w[j] = __builtin_amdgcn_cvt_pk_fp8_f32(q[u][j][2] * sc, q[u][j][3] * sc, w[j], true); }
            *(v4u*)(dst + (size_t)(lane >> 3) * ((size_t)NEXP * 128) + (size_t)e * 128 + 16 * (lane & 7)) = (v4u){(unsigned)w[0], (unsigned)w[1], (unsigned)w[2], (unsigned)w[3]};
            if (lane == 0) scl[e] = isc; } }
    }
}
__device__ __forceinline__ void p0_prologue(Frame& F, const Args& a) {
    unsigned char* ws = a.ws;
    LAS float* scr = (LAS float*)(F.lds + F.wave * 16384);
    const int gw = F.vcu * NWAVES + F.wave, NGW = F.G * NWAVES;
    for (int it = gw; it < 4096; it += NGW) {
        int r = it;
        if (r < 2048) { const int kb = r >> 7, db = r & 127; transpose_item(a.w_in, DIN, DM, (bf16*)(ws + WS_WIN), win_src_col(db), 32 * db, 64 * kb, scr, F.lane); continue; } r -= 2048;
        if (r < 256) { continue; } r -= 256;
        if (r < 256) { const int kb = r >> 5, nb = r & 31; transpose_item(a.w_ba, DM, DA, (bf16*)(ws + WS_WBA), 32 * nb, 32 * nb, 64 * kb, scr, F.lane); continue; } r -= 256;
        if (r < 512) { const int kb = r >> 5, nb = r & 31; transpose_item(a.w_out, DM, DM, (bf16*)(ws + WS_WOUT), 32 * nb, 32 * nb, 64 * kb, scr, F.lane); continue; } r -= 512;
        { const int kb = r >> 6, nb = r & 63; transpose_item(a.w_query, DQ, DM, (bf16*)(ws + WS_WQ), 32 * nb, 32 * nb, 64 * kb, scr, F.lane); }
    }
    for (int it = gw; it < 16 * 4 * 16; it += NGW) { const int nb = it & 15, g = (it >> 4) & 3, cb = it >> 6; const int nn = 64 * nb + F.lane; float acc8[8];
#pragma unroll
        for (int i = 0; i < 8; ++i) acc8[i] = 0.f;
        const float* pm = a.pool_mix_w + (size_t)g * 16384 + (size_t)(8 * cb) * 128;
#pragma unroll 16
        for (int d = 0; d < 128; ++d) { const float wv = a.w_bp[(size_t)(g * 128 + d) * DM + nn] * a.pool_scale[g * 128 + d];
#pragma unroll
            for (int i = 0; i < 8; ++i) acc8[i] += pm[i * 128 + d] * wv; }
        v4u o; o.x = pkbf(acc8[0], acc8[1]); o.y = pkbf(acc8[2], acc8[3]); o.z = pkbf(acc8[4], acc8[5]); o.w = pkbf(acc8[6], acc8[7]);
        *(v4u*)((bf16*)(ws + WS_WBP) + (size_t)nn * DP + g * 128 + 8 * cb) = o; }
    { const size_t gtid = (size_t)F.vcu * NTHR + F.tid, gn = (size_t)F.G * NTHR;
      cvt_rows_fp8(a.peer_u, ws + WS_PU, (float*)(ws + WS_US), gw, NGW, F.lane);
      cvt_rows_fp8(a.peer_v, ws + WS_PV, (float*)(ws + WS_VS), gw, NGW, F.lane);
      cvt_rows_bf16(a.sub_keys, (bf16*)(ws + WS_SUBK), (size_t)PH * 2 * NKEYS * DKH / 8, gtid, gn);
      for (size_t i = gtid; i < (size_t)DB * 7 * DP; i += gn) { const int b = (int)(i / (7 * DP)), j = (int)((i / DP) % 7), c = (int)(i % DP);
          a.out[O_PS + (size_t)(b * 15 + j) * DP + c] = a.state_pool[(size_t)(b * 15 + 8 + j) * DP + c]; } }
    __syncthreads();
    LAS float* wfT = (LAS float*)F.lds;
    for (int i = F.tid; i < 8 * DM; i += NTHR) { const int col = i >> 3, h = i & 7; wfT[h * DM + col] = a.w_in[(size_t)col * DIN + 2048 + h]; }
    __syncthreads();
    bf16* XN = (bf16*)(ws + WS_XN);
    for (int row0 = gw; row0 < M; row0 += 2 * NGW) {
        f32x4 v[2][4]; float rr[2], f[2][8]; bool ok[2];
#pragma unroll
        for (int u = 0; u < 2; ++u) { const int row = row0 + u * NGW; ok[u] = row < M; const int rc = ok[u] ? row : row0;
            const float* xr = rc < MP ? a.x_p + (size_t)rc * DM : a.x_s + (size_t)(rc - MP) * DM;
#pragma unroll
            for (int j = 0; j < 4; ++j) v[u][j] = *(const f32x4*)(xr + 256 * j + 4 * F.lane); }
#pragma unroll
        for (int u = 0; u < 2; ++u) { float ss = 0.f;
#pragma unroll
            for (int j = 0; j < 4; ++j) ss += (v[u][j][0] * v[u][j][0] + v[u][j][1] * v[u][j][1]) + (v[u][j][2] * v[u][j][2] + v[u][j][3] * v[u][j][3]);
            rr[u] = ss; }
#pragma unroll
        for (int o = 1; o < 64; o <<= 1) { rr[0] += __shfl_xor(rr[0], o); rr[1] += __shfl_xor(rr[1], o); }
#pragma unroll
        for (int u = 0; u < 2; ++u) { const int row = ok[u] ? row0 + u * NGW : row0; const float r = 1.0f / sqrtf(rr[u] * (1.0f / DM) + EPS);
#pragma unroll
            for (int h = 0; h < 8; ++h) f[u][h] = 0.f;
#pragma unroll
            for (int j = 0; j < 4; ++j) { const f32x4 g = *(const f32x4*)(a.norm_mix_g + 256 * j + 4 * F.lane); v[u][j] = v[u][j] * r * g;
                v2u w; w.x = pkbf(v[u][j][0], v[u][j][1]); w.y = pkbf(v[u][j][2], v[u][j][3]); if (ok[u]) *(v2u*)(XN + (size_t)row * DM + 256 * j + 4 * F.lane) = w;
#pragma unroll
                for (int h = 0; h < 8; ++h) { const f32x4 wv = *(const LAS f32x4*)(wfT + h * DM + 256 * j + 4 * F.lane); f[u][h] += (v[u][j][0] * wv[0] + v[u][j][1] * wv[1]) + (v[u][j][2] * wv[2] + v[u][j][3] * wv[3]); } } }
#pragma unroll
        for (int u = 0; u < 2; ++u) { const int row = row0 + u * NGW;
            const bool b4 = (F.lane & 4) != 0, b2 = (F.lane & 2) != 0, b1 = (F.lane & 1) != 0; float t4[4], t2[2];
#pragma unroll
            for (int k = 0; k < 4; ++k) { const float keep = b4 ? f[u][4 + k] : f[u][k], send = b4 ? f[u][k] : f[u][4 + k]; t4[k] = keep + __shfl_xor(send, 4); }
#pragma unroll
            for (int k = 0; k < 2; ++k) { const float keep = b2 ? t4[2 + k] : t4[k], send = b2 ? t4[k] : t4[2 + k]; t2[k] = keep + __shfl_xor(send, 2); }
            float t1 = (b1 ? t2[1] : t2[0]) + __shfl_xor(b1 ? t2[0] : t2[1], 1);
            t1 += __shfl_xor(t1, 8); t1 += __shfl_xor(t1, 16); t1 += __shfl_xor(t1, 32);
            if (F.lane < 8 && ok[u]) { const float z = t1 + a.b_forget[F.lane]; const float lf = fminf(z, 0.f) - log1pf(expf(-fabsf(z)));
                if (row < MP) a.out[O_LFP + (size_t)row * NH + F.lane] = lf; else a.out[O_LFS + (size_t)(row - MP) * NH + F.lane] = lf; } }
    }
}

template <int W> __device__ __forceinline__ void p2_item(const Args& a, unsigned char* ws, int row, int ch) {
    const bf16* U = (const bf16*)(ws + WS_U); bf16* PO = (bf16*)(ws + WS_PO);
    float e[W][8]; float cnt;
    if (row < MP) { const int s = row & (SEQ - 1); cnt = (float)(s + 1 < W ? s + 1 : W);
#pragma unroll
        for (int i = 0; i < W; ++i) { v4u q = (v4u){0u, 0u, 0u, 0u}; if (s - i >= 0) q = *(const v4u*)(U + (size_t)(row - i) * DP + ch);
            e[i][0] = bflo(q.x); e[i][1] = bfhi(q.x); e[i][2] = bflo(q.y); e[i][3] = bfhi(q.y); e[i][4] = bflo(q.z); e[i][5] = bfhi(q.z); e[i][6] = bflo(q.w); e[i][7] = bfhi(q.w); }
    } else { const int rs = row - MP, b = rs >> 3, t = rs & 7; cnt = (float)W;
#pragma unroll
        for (int i = 0; i < W; ++i) { const int tt = t - i;
            if (tt >= 0) { const v4u q = *(const v4u*)(U + (size_t)(MP + b * 8 + tt) * DP + ch);
                e[i][0] = bflo(q.x); e[i][1] = bfhi(q.x); e[i][2] = bflo(q.y); e[i][3] = bfhi(q.y); e[i][4] = bflo(q.z); e[i][5] = bfhi(q.z); e[i][6] = bflo(q.w); e[i][7] = bfhi(q.w); }
            else { const f32x4 p0 = *(const f32x4*)(a.state_pool + (size_t)(b * 15 + 15 + tt) * DP + ch), p1 = *(const f32x4*)(a.state_pool + (size_t)(b * 15 + 15 + tt) * DP + ch + 4);
                e[i][0] = p0[0]; e[i][1] = p0[1]; e[i][2] = p0[2]; e[i][3] = p0[3]; e[i][4] = p1[0]; e[i][5] = p1[1]; e[i][6] = p1[2]; e[i][7] = p1[3]; } } }
    const float inv = 1.0f / cnt; float mm[8];
#pragma unroll
    for (int k = 0; k < 8; ++k) { float sum = 0.f;
#pragma unroll
        for (int i = 0; i < W; ++i) sum += e[i][k];
        mm[k] = sum * inv - e[0][k]; }
    v4u o; o.x = pkbf(mm[0], mm[1]); o.y = pkbf(mm[2], mm[3]); o.z = pkbf(mm[4], mm[5]); o.w = pkbf(mm[6], mm[7]);
    *(v4u*)(PO + (size_t)row * DP + ch) = o;
}
__device__ __forceinline__ void p2_cumsum_pool(Frame& F, const Args& a) {
    unsigned char* ws = a.ws;
    { const int gw = F.vcu * NWAVES + F.wave; float* CP2 = (float*)(ws + WS_CP2);
      if (gw < NB * NH) { const int b = gw >> 3, h = gw & 7; float carry = 0.f;
          for (int c = 0; c < SEQ / 64; ++c) { float v = a.out[O_LFP + (size_t)(b * SEQ + c * 64 + F.lane) * NH + h];
#pragma unroll
              for (int o = 1; o < 64; o <<= 1) { const float t = __shfl_up(v, o); if (F.lane >= o) v += t; }
              v += carry; CP2[(size_t)gw * SEQ + c * 64 + F.lane] = v * LOG2E; carry = __shfl(v, 63); } } }
    const int nfree = F.G > 2 * (M / 256) ? F.G - M / 256 : F.G, myslot = F.G > 2 * (M / 256) ? (int)blockIdx.x - M / 256 : (int)blockIdx.x;
    if (myslot >= 0)
    for (int item = myslot * NTHR + F.tid; item < M * 64; item += nfree * NTHR) {
        const int row = item >> 6, ch = (item & 63) * 8, g = ch >> 7;
        if (g == 0) p2_item<2>(a, ws, row, ch); else if (g == 1) p2_item<4>(a, ws, row, ch); else if (g == 2) p2_item<8>(a, ws, row, ch); else p2_item<16>(a, ws, row, ch);
    }
}

__device__ __forceinline__ float attn_bound2(const Args& a, int lane) {
    asm volatile("" : "+v"(lane));
    const float gq = wave_max(fabsf(a.q_norm_g[lane])), gk = wave_max(fabsf(a.k_norm_g[lane]));
    return 64.0f * C2 * gq * gk * 1.03f;
}

typedef float f32x16 __attribute__((ext_vector_type(16)));
typedef short bf16x8v __attribute__((ext_vector_type(8)));
__device__ __forceinline__ int f2key(float s) { int b = __builtin_bit_cast(int, s); return b ^ ((b >> 31) & 0x7fffffff); }
__device__ __forceinline__ float key2f(int k) { return __builtin_bit_cast(float, k ^ ((k >> 31) & 0x7fffffff)); }
#define CE_DESC(x, y) do { const int mx_ = (x) > (y) ? (x) : (y), mn_ = (x) > (y) ? (y) : (x); (x) = mx_; (y) = mn_; } while (0)
template <int OFF, int N, typename T> __device__ __forceinline__ void bsort_desc(T& v) {
#pragma unroll
    for (int k = 2; k <= N; k <<= 1)
#pragma unroll
        for (int j = k >> 1; j > 0; j >>= 1)
#pragma unroll
            for (int i = 0; i < N; ++i) { const int l = i ^ j; if (l > i) { if ((i & k) == 0) CE_DESC(v[OFF + i], v[OFF + l]); else CE_DESC(v[OFF + l], v[OFF + i]); } }
}
template <int OFF, typename T> __device__ __forceinline__ void bmerge16_desc(T& v) {
#pragma unroll
    for (int j = 8; j > 0; j >>= 1)
#pragma unroll
        for (int i = 0; i < 16; ++i) { const int l = i ^ j; if (l > i) CE_DESC(v[OFF + i], v[OFF + l]); }
}
template <int OA, int OB, typename T> __device__ __forceinline__ void top16_merge(T& v) {
#pragma unroll
    for (int i = 0; i < 16; ++i) v[OA + i] = v[OA + i] > v[OB + 15 - i] ? v[OA + i] : v[OB + 15 - i];
    bmerge16_desc<OA>(v);
}
template <typename T> __device__ __forceinline__ void top16_of_64(T& v) {
    bsort_desc<0, 16>(v); bsort_desc<16, 16>(v); bsort_desc<32, 16>(v); bsort_desc<48, 16>(v);
    top16_merge<0, 16>(v); top16_merge<32, 48>(v); top16_merge<0, 32>(v);
}
__device__ __forceinline__ void p7_topk(Frame& F, const Args& a) {
    unsigned char* ws = a.ws;
    const bf16* PQ = (const bf16*)(ws + WS_PQ); const bf16* SK = (const bf16*)(ws + WS_SUBK); const float* RSS = (const float*)(ws + WS_RSS);
    int* SI = (int*)(ws + WS_SI); float* SG = (float*)(ws + WS_SG);
    const int lane = F.lane, j = lane & 31, hi = lane >> 5;
    constexpr int KROW = 272, KMAT = 128 * KROW;
    LAS unsigned char* kl = F.lds; LAS unsigned* ib = (LAS unsigned*)(F.lds + 2 * KMAT + F.wave * 1024);
    const int h = F.vcu & 7, wi = F.vcu >> 3, nwh = (F.G - h + 7) >> 3;
    __syncthreads();
    for (int i = F.tid; i < 2 * 128 * 16; i += NTHR) { const int p = i >> 11, n = (i >> 4) & 127, c = i & 15; *(LAS v4u*)(kl + p * KMAT + n * KROW + 16 * c) = *(const v4u*)(SK + ((size_t)(h * 2 + p) * NKEYS + n) * DKH + 8 * c); }
    __syncthreads();
    for (int tile = wi * NWAVES + F.wave; tile < M / 32; tile += nwh * NWAVES) {
        const int row0 = tile * 32;
        int jl = j, hl = hi; asm volatile("" : "+v"(jl), "+v"(hl));
        int top[2][16];
#pragma unroll
        for (int p = 0; p < 2; ++p) {
            bf16x8v qf[8];
#pragma unroll
            for (int ks = 0; ks < 8; ++ks) qf[ks] = *(const bf16x8v*)(PQ + (size_t)(row0 + jl) * DQ + h * 256 + p * 128 + 16 * ks + 8 * hl);
            f32x16 acc[4];
#pragma unroll
            for (int mt = 0; mt < 4; ++mt) acc[mt] = f32x16{};
            const LAS unsigned char* kb = kl + p * KMAT + jl * KROW + 16 * hl;
#pragma unroll
            for (int ks = 0; ks < 8; ++ks)
#pragma unroll
                for (int mt = 0; mt < 4; ++mt) { const bf16x8v af = *(const LAS bf16x8v*)(kb + mt * 32 * KROW + ks * 32); acc[mt] = __builtin_amdgcn_mfma_f32_32x32x16_bf16(af, qf[ks], acc[mt], 0, 0, 0); }
            int v[64];
#pragma unroll
            for (int mt = 0; mt < 4; ++mt)
#pragma unroll
                for (int r = 0; r < 16; ++r) { const int n = 32 * mt + (r & 3) + 8 * (r >> 2) + 4 * hi; v[16 * mt + r] = (f2key(acc[mt][r]) & ~127) | (127 - n); }
            top16_of_64(v);
#pragma unroll
            for (int i = 0; i < 16; ++i) top[p][i] = v[i];
        }
        int S[32];
#pragma unroll
        for (int i = 0; i < 16; ++i) { auto rr = __builtin_amdgcn_permlane32_swap((unsigned)top[0][i], (unsigned)top[1][i], false, false); S[i] = (int)rr[0]; S[16 + i] = (int)rr[1]; }
        top16_merge<0, 16>(S);
        { unsigned w0 = 0, w1 = 0, w2 = 0, w3 = 0;
#pragma unroll
          for (int i = 0; i < 4; ++i) { w0 |= (unsigned)(127 - (S[i] & 127)) << (8 * i); w1 |= (unsigned)(127 - (S[4 + i] & 127)) << (8 * i); w2 |= (unsigned)(127 - (S[8 + i] & 127)) << (8 * i); w3 |= (unsigned)(127 - (S[12 + i] & 127)) << (8 * i); }
          *(LAS v4u*)(ib + (hi * 32 + j) * 4) = (v4u){w0, w1, w2, w3}; }
        float s1[16], s2[16];
#pragma unroll
        for (int i = 0; i < 16; ++i) { auto rr = __builtin_amdgcn_permlane32_swap((unsigned)S[i], (unsigned)S[i], false, false); s1[i] = key2f((int)rr[0] & ~127); s2[i] = key2f((int)rr[1] & ~127); }
        int c[64]; { int n = 0;
#pragma unroll
          for (int ca = 0; ca < 16; ++ca)
#pragma unroll
              for (int cb = 0; cb < 16; ++cb) if ((ca + 1) * (cb + 1) <= 16) { c[n] = (f2key(s1[ca] + s2[cb]) & ~255) | (255 - (ca * 16 + cb)); ++n; }
#pragma unroll
          for (int q = 50; q < 64; ++q) c[q] = (int)0x80000000; }
        top16_of_64(c);
        float ssq = 0.f;
#pragma unroll
        for (int q = 0; q < 4; ++q) { const f32x4 t4 = *(const f32x4*)(RSS + (size_t)(row0 + j) * 16 + 4 * q); ssq += (t4[0] + t4[1]) + (t4[2] + t4[3]); }
        const float rstd = 1.0f / sqrtf(ssq * (1.0f / DM) + EPS);
        const float z0 = key2f(c[0] & ~255) * rstd; float e[16], esum = 0.f;
#pragma unroll
        for (int k = 0; k < 16; ++k) { e[k] = __expf(key2f(c[k] & ~255) * rstd - z0); esum += e[k]; }
        const float inv = 1.0f / esum;
        LDS_WAIT(); asm volatile("" ::: "memory");
        const LAS unsigned char* ib8 = (const LAS unsigned char*)ib;
        int oi[8]; float og[8];
#pragma unroll
        for (int k = 0; k < 8; ++k) { const int ck = hi ? c[8 + k] : c[k]; const float ek = hi ? e[8 + k] : e[k]; const int fl = 255 - (ck & 255);
            const int i1 = ib8[(0 * 32 + j) * 16 + (fl >> 4)], i2 = ib8[(1 * 32 + j) * 16 + (fl & 15)]; oi[k] = i1 * NKEYS + i2; og[k] = ek * inv; }
        { int* sp = SI + (size_t)(row0 + j) * 128 + h * 16 + hi * 8; float* gp = SG + (size_t)(row0 + j) * 128 + h * 16 + hi * 8;
          *(v4u*)sp = (v4u){(unsigned)oi[0], (unsigned)oi[1], (unsigned)oi[2], (unsigned)oi[3]}; *(v4u*)(sp + 4) = (v4u){(unsigned)oi[4], (unsigned)oi[5], (unsigned)oi[6], (unsigned)oi[7]};
          *(f32x4*)gp = (f32x4){og[0], og[1], og[2], og[3]}; *(f32x4*)(gp + 4) = (f32x4){og[4], og[5], og[6], og[7]}; }
        LDS_WAIT(); asm volatile("" ::: "memory");
    }
}


constexpr int P8_TOK = 34, P8_Q = 5, P8_NS = 8, P8_SW = 128;
static_assert(M % P8_TOK == 0 && P8_TOK <= 8 * P8_Q, "P8 chunking");
#define FP8X2(wd, hi_) __builtin_amdgcn_cvt_pk_f32_fp8((int)(wd), (hi_))
typedef __bf16 bf16x2v __attribute__((ext_vector_type(2)));
template <bool HI> __device__ __forceinline__ float p8_dot(unsigned wd, unsigned hpair, float accv) { const f32x2 f = FP8X2(wd, HI); return __builtin_amdgcn_fdot2_f32_bf16(__builtin_bit_cast(bf16x2v, pkbf(f[0], f[1])), __builtin_bit_cast(bf16x2v, hpair), accv, false); }
__device__ __forceinline__ void p8_gather(Frame& F, const Args& a) {
    unsigned char* ws = a.ws;
    const bf16* HG = (const bf16*)(ws + WS_XN); const unsigned char* PU = ws + WS_PU; const unsigned char* PV = ws + WS_PV; const float* US = (const float*)(ws + WS_US); const float* VS = (const float*)(ws + WS_VS);
    const float* RSS = (const float*)(ws + WS_RSS); const int* SI = (const int*)(ws + WS_SI); const float* SG = (const float*)(ws + WS_SG); const float* Hh = (const float*)(ws + WS_H);
    float* Y = a.out + O_YP;
    LAS unsigned short* ix = (LAS unsigned short*)F.lds;
    LAS float* wt = (LAS float*)(F.lds + P8_TOK * 128 * 2);
    LAS float* rs = (LAS float*)(F.lds + P8_TOK * 128 * 2 + P8_TOK * 128 * 4);
    int lane = F.lane; asm volatile("" : "+v"(lane));
    const int g = lane >> 3, c8 = lane & 7;
    for (int chunk = F.vcu; chunk < M / P8_TOK; chunk += F.G) {
        const int tb = chunk * P8_TOK;
        __syncthreads();
        for (int i = F.tid; i < P8_TOK * 128; i += NTHR) { ix[i] = (unsigned short)SI[(size_t)tb * 128 + i]; wt[i] = SG[(size_t)tb * 128 + i]; }
        if (F.tid < P8_TOK) { float s = 0.f; for (int k = 0; k < 16; ++k) s += RSS[(size_t)(tb + F.tid) * 16 + k]; rs[F.tid] = 1.0f / sqrtf(s * (1.0f / DM) + EPS); }
        __syncthreads();
        float acc[P8_Q][16];
#pragma unroll
        for (int q = 0; q < P8_Q; ++q)
#pragma unroll
            for (int i = 0; i < 16; ++i) acc[q][i] = 0.f;
        for (int s = 0; s < P8_NS; ++s) {
            __syncthreads();
            int cl = c8; asm volatile("" : "+v"(cl));
            const unsigned char* pus = PU + (size_t)s * ((size_t)NEXP * P8_SW) + 16 * cl;
#pragma unroll
            for (int q = 0; q < P8_Q; ++q) { const int lt = F.wave + 8 * q; if (lt < P8_TOK) {
                const v4u h0 = *(const v4u*)(HG + (size_t)(tb + lt) * DM + P8_SW * s + 16 * cl), h1 = *(const v4u*)(HG + (size_t)(tb + lt) * DM + P8_SW * s + 16 * cl + 8);
                const unsigned hp8[8] = {h0.x, h0.y, h0.z, h0.w, h1.x, h1.y, h1.z, h1.w};
                f32x2 hf2[8];
#pragma unroll
                for (int k = 0; k < 8; ++k) hf2[k] = (f32x2){bflo(hp8[k]), bfhi(hp8[k])};
                const v4u ea = *(const LAS v4u*)(ix + lt * 128 + g * 16), eb = *(const LAS v4u*)(ix + lt * 128 + g * 16 + 8);
                const unsigned ew[8] = {ea.x, ea.y, ea.z, ea.w, eb.x, eb.y, eb.z, eb.w};
                v4u r[16];
#pragma unroll
                for (int i = 0; i < 16; ++i) { const unsigned e = (i & 1) ? (ew[i >> 1] >> 16) : (ew[i >> 1] & 0xffffu); r[i] = *(const v4u*)(pus + (size_t)e * P8_SW); }
#pragma unroll
                for (int i = 0; i < 16; ++i) { const unsigned wd[4] = {r[i].x, r[i].y, r[i].z, r[i].w}; f32x2 d2 = (f32x2){acc[q][i], 0.f};
#pragma unroll
                    for (int jj = 0; jj < 4; ++jj) { d2 = FP8X2(wd[jj], false) * hf2[2 * jj] + d2; d2 = FP8X2(wd[jj], true) * hf2[2 * jj + 1] + d2; }
                    acc[q][i] = d2[0] + d2[1]; } } }
        }
#pragma unroll
        for (int q = 0; q < P8_Q; ++q) { const int lt = F.wave + 8 * q; if (lt < P8_TOK) {
            float v8[8], v4[4], v2[2]; const bool b4 = (c8 & 4) != 0, b2 = (c8 & 2) != 0, b1 = (c8 & 1) != 0;
#pragma unroll
            for (int j2 = 0; j2 < 8; ++j2) { const float keep = b4 ? acc[q][8 + j2] : acc[q][j2], send = b4 ? acc[q][j2] : acc[q][8 + j2]; v8[j2] = keep + __shfl_xor(send, 4); }
#pragma unroll
            for (int j2 = 0; j2 < 4; ++j2) { const float keep = b2 ? v8[4 + j2] : v8[j2], send = b2 ? v8[j2] : v8[4 + j2]; v4[j2] = keep + __shfl_xor(send, 2); }
#pragma unroll
            for (int j2 = 0; j2 < 2; ++j2) { const float keep = b1 ? v4[2 + j2] : v4[j2], send = b1 ? v4[j2] : v4[2 + j2]; v2[j2] = keep + __shfl_xor(send, 1); }
            const float r = rs[lt]; const int kk = lt * 128 + g * 16 + 2 * c8; LAS float* wp = wt + kk; const f32x2 gt = *(const LAS f32x2*)wp;
            const int e0 = ix[kk], e1 = ix[kk + 1];
            const float z0 = v2[0] * r * US[e0], z1 = v2[1] * r * US[e1];
            const float a0 = 0.5f * z0 * (1.0f + erff(z0 * 0.70710678118654752f)), a1 = 0.5f * z1 * (1.0f + erff(z1 * 0.70710678118654752f));
            *(LAS f32x2*)wp = (f32x2){gt[0] * a0 * VS[e0], gt[1] * a1 * VS[e1]}; } }
        LDS_WAIT(); asm volatile("" ::: "memory");
        for (int s = 0; s < P8_NS; ++s) {
            __syncthreads();
            int cl = c8; asm volatile("" : "+v"(cl));
            const unsigned char* pvs = PV + (size_t)s * ((size_t)NEXP * P8_SW) + 16 * cl;
#pragma unroll 1
            for (int q = 0; q < P8_Q; ++q) { const int lt = F.wave + 8 * q; if (lt < P8_TOK) {
                f32x2 o2[8];
#pragma unroll
                for (int k = 0; k < 8; ++k) o2[k] = (f32x2){0.f, 0.f};
                const v4u ea = *(const LAS v4u*)(ix + lt * 128 + g * 16), eb = *(const LAS v4u*)(ix + lt * 128 + g * 16 + 8);
                const unsigned ew[8] = {ea.x, ea.y, ea.z, ea.w, eb.x, eb.y, eb.z, eb.w};
                v4u r[16];
#pragma unroll
                for (int i = 0; i < 16; ++i) { const unsigned e = (i & 1) ? (ew[i >> 1] >> 16) : (ew[i >> 1] & 0xffffu); r[i] = *(const v4u*)(pvs + (size_t)e * P8_SW); }
                float wv[16];
#pragma unroll
                for (int i4 = 0; i4 < 4; ++i4) { const f32x4 w4 = *(const LAS f32x4*)(wt + lt * 128 + g * 16 + 4 * i4); wv[4 * i4] = w4[0]; wv[4 * i4 + 1] = w4[1]; wv[4 * i4 + 2] = w4[2]; wv[4 * i4 + 3] = w4[3]; }
#pragma unroll
                for (int i = 0; i < 16; ++i) { const f32x2 w2 = (f32x2){wv[i], wv[i]}; const unsigned wd[4] = {r[i].x, r[i].y, r[i].z, r[i].w};
#pragma unroll
                    for (int jj = 0; jj < 4; ++jj) { o2[2 * jj] = FP8X2(wd[jj], false) * w2 + o2[2 * jj]; o2[2 * jj + 1] = FP8X2(wd[jj], true) * w2 + o2[2 * jj + 1]; } }
                float o[16];
#pragma unroll
                for (int k = 0; k < 8; ++k) { o[2 * k] = o2[k][0]; o[2 * k + 1] = o2[k][1]; }
                const bool b5 = (lane & 32) != 0, b4 = (lane & 16) != 0, b3 = (lane & 8) != 0; float p8[8], p4[4], p2[2];
#pragma unroll
                for (int j2 = 0; j2 < 8; ++j2) { const float keep = b5 ? o[8 + j2] : o[j2], send = b5 ? o[j2] : o[8 + j2]; p8[j2] = keep + __shfl_xor(send, 32); }
#pragma unroll
                for (int j2 = 0; j2 < 4; ++j2) { const float keep = b4 ? p8[4 + j2] : p8[j2], send = b4 ? p8[j2] : p8[4 + j2]; p4[j2] = keep + __shfl_xor(send, 16); }
#pragma unroll
                for (int j2 = 0; j2 < 2; ++j2) { const float keep = b3 ? p4[2 + j2] : p4[j2], send = b3 ? p4[j2] : p4[2 + j2]; p2[j2] = keep + __shfl_xor(send, 8); }
                const size_t off = (size_t)(tb + lt) * DM + P8_SW * s + 16 * cl + (b5 ? 8 : 0) + (b4 ? 4 : 0) + (b3 ? 2 : 0);
                const f32x2 hv = *(const f32x2*)(Hh + off);
                *(f32x2*)(Y + off) = (f32x2){hv[0] + p2[0], hv[1] + p2[1]}; } }
        }
    }
}

__device__ __forceinline__ void p3_sample_attn2(Frame& F, const Args& a, const float M2) {
    unsigned char* ws = a.ws;
    const bf16* Q = (const bf16*)(ws + WS_Q); bf16* AO = (bf16*)(ws + WS_AO);
    LAS float* D2 = (LAS float*)F.lds;
    LAS float* E2 = (LAS float*)(F.lds + 32768);
    LAS float* Pt = (LAS float*)(F.lds + 32768 + 128);
    LAS float* Op = (LAS float*)(F.lds + 32768 + 128 + 8192);
    LAS float* lp = (LAS float*)(F.lds + 32768 + 128 + 8192 + 16384);
    int lane = F.lane; asm volatile("" : "+v"(lane));
    const int w = F.wave, hh = w >> 1, kh = w & 1, n = lane & 31, hi = lane >> 5;
    LAS float* Pw = Pt + w * 256;
    for (int unit = F.vcu; unit < DB * 2; unit += F.G) {
        const int b = unit >> 1, h = 4 * (unit & 1) + hh;
        __syncthreads();
        for (int i = F.tid; i < 4 * PAST; i += NTHR) { const int hq = i >> 11, jk = i & (PAST - 1); const int pg = a.page_table[b * NPAGES + (jk >> 7)];
            D2[i] = a.cache_lf[((size_t)pg * PAGE + (jk & 127)) * NH + 4 * (unit & 1) + hq]; }
        __syncthreads();
        if (kh == 0) {
            LAS float* d = D2 + hh * PAST; float loc[32]; float tot = 0.f;
#pragma unroll
            for (int k = 31; k >= 0; --k) { loc[k] = tot; tot += d[lane * 32 + k]; }
            float inc = tot;
#pragma unroll
            for (int o = 1; o < 64; o <<= 1) { const float t = __shfl_down(inc, o); if (lane + o < 64) inc += t; }
            const float excl = inc - tot;
#pragma unroll
            for (int k = 0; k < 32; ++k) d[lane * 32 + k] = (loc[k] + excl) * LOG2E;
            if (lane < 8) { float e = 0.f; for (int t = 0; t <= lane; ++t) e += a.out[O_LFS + (size_t)(b * 8 + t) * NH + h]; E2[hh * 8 + lane] = e * LOG2E; }
        }
        __syncthreads();
        bf16x8v qa[4];
#pragma unroll
        for (int ks = 0; ks < 4; ++ks) { qa[ks] = bf16x8v{}; if (n < 8) qa[ks] = *(const bf16x8v*)(Q + (size_t)(MP + b * 8 + n) * DA + h * 64 + 16 * ks + 8 * hi); }
        float e2[4];
#pragma unroll
        for (int t = 0; t < 4; ++t) e2[t] = E2[hh * 8 + 4 * hi + t] - M2;
        float o[8], lsum[4];
#pragma unroll
        for (int t = 0; t < 8; ++t) o[t] = 0.f;
#pragma unroll
        for (int t = 0; t < 4; ++t) lsum[t] = 0.f;
        const LAS float* dh = D2 + hh * PAST;
        int nskip; { const float dl = dh[32 * lane + 31]; nskip = __builtin_popcountll(__ballot(dl < -(30.f + 2.f * M2))); }
        nskip = __builtin_amdgcn_readfirstlane(nskip);
        const int nblk = PAST / 32 - nskip, nb0 = nblk >> 1;
        const int blk_lo = nskip + (kh ? nb0 : 0), nit = kh ? (nblk - nb0) : nb0;
        f32x4 kq[8]; float vv[32];
#define S3_COMPUTE(it_, NEWK) do { f32x16 sacc = f32x16{}; \
            _Pragma("unroll") for (int ks = 0; ks < 4; ++ks) { const f32x4 x0_ = kq[2 * ks], x1_ = kq[2 * ks + 1]; v4u kb_; kb_.x = pkbf(x0_[0], x0_[1]); kb_.y = pkbf(x0_[2], x0_[3]); kb_.z = pkbf(x1_[0], x1_[1]); kb_.w = pkbf(x1_[2], x1_[3]); \
                sacc = __builtin_amdgcn_mfma_f32_32x32x16_bf16(qa[ks], __builtin_bit_cast(bf16x8v, kb_), sacc, 0, 0, 0); } \
            float p_[4]; \
            if (!(NEWK)) { const float dj_ = dh[(blk_lo + (it_)) * 32 + n]; _Pragma("unroll") for (int t = 0; t < 4; ++t) p_[t] = __builtin_amdgcn_exp2f(sacc[t] + e2[t] + dj_); } \
            else { const float ek_ = E2[hh * 8 + (n & 7)]; _Pragma("unroll") for (int t = 0; t < 4; ++t) p_[t] = (n <= 4 * hi + t) ? __builtin_amdgcn_exp2f(sacc[t] + e2[t] - ek_) : 0.f; } \
            _Pragma("unroll") for (int t = 0; t < 4; ++t) lsum[t] += p_[t]; \
            *(LAS f32x4*)(Pw + n * 8 + 4 * hi) = (f32x4){p_[0], p_[1], p_[2], p_[3]}; \
            LDS_WAIT(); asm volatile("" ::: "memory"); \
            _Pragma("unroll") for (int k_ = 0; k_ < ((NEWK) ? 8 : 32); ++k_) { const f32x4 pa_ = *(const LAS f32x4*)(Pw + k_ * 8), pb_ = *(const LAS f32x4*)(Pw + k_ * 8 + 4); const float v_ = vv[k_]; \
                o[0] += pa_[0] * v_; o[1] += pa_[1] * v_; o[2] += pa_[2] * v_; o[3] += pa_[3] * v_; o[4] += pb_[0] * v_; o[5] += pb_[1] * v_; o[6] += pb_[2] * v_; o[7] += pb_[3] * v_; } \
            LDS_WAIT(); asm volatile("" ::: "memory"); } while (0)
        for (int it = 0; it < nit; ++it) {
            const int j0 = (blk_lo + it) * 32; const int pg = a.page_table[b * NPAGES + (j0 >> 7)];
            const size_t rowoff = (((size_t)pg * PAGE + (j0 & 127)) * NH + h) * HD;
            const float* kr = a.cache_k + rowoff + (size_t)n * (NH * HD) + 8 * hi; const float* vb = a.cache_v + rowoff;
#pragma unroll
            for (int ks = 0; ks < 4; ++ks) { kq[2 * ks] = __builtin_nontemporal_load((const f32x4*)(kr + 16 * ks)); kq[2 * ks + 1] = __builtin_nontemporal_load((const f32x4*)(kr + 16 * ks + 4)); }
#pragma unroll
            for (int k = 0; k < 32; ++k) vv[k] = __builtin_nontemporal_load(vb + (size_t)k * (NH * HD) + lane);
            S3_COMPUTE(it, false);
        }
        if (kh == 1) {
            const float* kr = a.out + O_KS + (size_t)(b * 8 + (n & 7)) * DA + h * HD + 8 * hi; const float* vr = a.out + O_VS + (size_t)(b * 8) * DA + h * HD + lane;
#pragma unroll
            for (int ks = 0; ks < 4; ++ks) { kq[2 * ks] = *(const f32x4*)(kr + 16 * ks); kq[2 * ks + 1] = *(const f32x4*)(kr + 16 * ks + 4); }
#pragma unroll
            for (int k = 0; k < 8; ++k) vv[k] = vr[(size_t)k * DA];
            S3_COMPUTE(0, true);
        }
#undef S3_COMPUTE
#pragma unroll
        for (int t = 0; t < 4; ++t) { float s = lsum[t]; s += __shfl_xor(s, 1); s += __shfl_xor(s, 2); s += __shfl_xor(s, 4); s += __shfl_xor(s, 8); s += __shfl_xor(s, 16); if (n == 0) lp[w * 8 + 4 * hi + t] = s; }
#pragma unroll
        for (int t = 0; t < 8; ++t) Op[(w * 8 + t) * 64 + lane] = o[t];
        __syncthreads();
        for (int i = F.tid; i < 4 * 8 * 64; i += NTHR) { const int hq = i >> 9, t = (i >> 6) & 7, d = i & 63;
            const float O = Op[((2 * hq) * 8 + t) * 64 + d] + Op[((2 * hq + 1) * 8 + t) * 64 + d], L = lp[(2 * hq) * 8 + t] + lp[(2 * hq + 1) * 8 + t];
            AO[(size_t)(MP + b * 8 + t) * DA + (4 * (unit & 1) + hq) * 64 + d] = (bf16)(pkbf(O / L, 0.f) & 0xffffu); }
    }
}


template <class Epi> __device__ __forceinline__ void sg_phase(Frame& F, const bf16* A  , const bf16* Bt  , int K, int N, const Epi& E) {
    int lane = F.lane; asm volatile("" : "+v"(lane));
    const int fr = lane & 15, fq = lane >> 4, ntc = N >> 6, ntile = (MS / 128) * ntc, pitch = 2 * K + 16, kc = K >> 3;
    for (int t = F.vcu; t < ntile; t += F.G) {
        const int tr = t % (MS / 128), tc = t / (MS / 128);
        __syncthreads();
        for (int i = F.tid; i < 64 * kc; i += NTHR) { const int r = i / kc, c = i - r * kc; *(LAS v4u*)(F.lds + r * pitch + 16 * c) = *(const v4u*)(Bt + (size_t)(64 * tc + r) * K + 8 * c); }
        __syncthreads();
        const bf16* ap = A + (size_t)(128 * tr + 16 * F.wave + fr) * K + 8 * fq;
        const LAS unsigned char* bp = F.lds + fr * pitch + 16 * fq;
        f32x4 acc[4];
#pragma unroll
        for (int c = 0; c < 4; ++c) acc[c] = (f32x4){0.f, 0.f, 0.f, 0.f};
#pragma unroll 8
        for (int ks = 0; ks < K; ks += 32) {
            const bf16x8v av = *(const bf16x8v*)(ap + ks);
#pragma unroll
            for (int c = 0; c < 4; ++c) { const bf16x8v bv = *(const LAS bf16x8v*)(bp + 16 * c * pitch + 2 * ks); acc[c] = __builtin_amdgcn_mfma_f32_16x16x32_bf16(bv, av, acc[c], 0, 0, 0); }
        }
        E(acc, 128 * tr + 16 * F.wave + fr, tc, fq);
    }
}
template <int MODE> struct SgGate { const bf16* G; const bf16* Tin; bf16* O;
    __device__ __forceinline__ void operator()(const f32x4 (&acc)[4], int rs, int tc, int fq) const {
#pragma unroll
        for (int c = 0; c < 4; ++c) { const size_t off = (size_t)(MP + rs) * DM + 64 * tc + 16 * c + 4 * fq; const v2u g = *(const v2u*)(G + off);
            float r[4] = {acc[c][0] * bflo(g.x), acc[c][1] * bfhi(g.x), acc[c][2] * bflo(g.y), acc[c][3] * bfhi(g.y)};
            if (MODE == 1) { const v2u t = *(const v2u*)(Tin + off); r[0] += bflo(t.x); r[1] += bfhi(t.x); r[2] += bflo(t.y); r[3] += bfhi(t.y); }
            v2u w; w.x = pkbf(r[0], r[1]); w.y = pkbf(r[2], r[3]); *(v2u*)(O + off) = w; } } };
struct SgOut { const float* xs; float* H; bf16* HG; const float* gf; float* RSS;
    __device__ __forceinline__ void operator()(const f32x4 (&acc)[4], int rs, int tc, int fq) const { float ss = 0.f;
#pragma unroll
        for (int c = 0; c < 4; ++c) { const int col = 64 * tc + 16 * c + 4 * fq; const f32x4 h = acc[c] + *(const f32x4*)(xs + (size_t)rs * DM + col);
            ss += (h[0] * h[0] + h[1] * h[1]) + (h[2] * h[2] + h[3] * h[3]);
            *(f32x4*)(H + (size_t)(MP + rs) * DM + col) = h; const f32x4 gv = *(const f32x4*)(gf + col);
            v2u w; w.x = pkbf(h[0] * gv[0], h[1] * gv[1]); w.y = pkbf(h[2] * gv[2], h[3] * gv[3]); *(v2u*)(HG + (size_t)(MP + rs) * DM + col) = w; }
        ss += __shfl_xor(ss, 16); ss += __shfl_xor(ss, 32);
        if (fq == 0) RSS[(size_t)(MP + rs) * 16 + tc] = ss; } };
struct SgPQ { bf16* PQ;
    __device__ __forceinline__ void operator()(const f32x4 (&acc)[4], int rs, int tc, int fq) const {
#pragma unroll
        for (int c = 0; c < 4; ++c) { v2u w; w.x = pkbf(acc[c][0], acc[c][1]); w.y = pkbf(acc[c][2], acc[c][3]); *(v2u*)(PQ + (size_t)(MP + rs) * DQ + 64 * tc + 16 * c + 4 * fq) = w; } } };

constexpr int N_PHASES = 9;
#ifndef MK_PER_PHASE
#define MK_PER_PHASE 0
#endif
__global__ void __launch_bounds__(NTHR, 2) fwd_kernel(Args args) {
    extern __shared__ __attribute__((aligned(16))) unsigned char lds[];
    Frame F;
    F.lds = (LAS unsigned char*)lds; F.MISC = (volatile LAS unsigned*)(F.lds + MISC_OFF);
    F.tid = threadIdx.x; F.lane = F.tid & 63; F.wave = __builtin_amdgcn_readfirstlane(F.tid >> 6);
    F.G = gridDim.x; { const int bx = blockIdx.x; F.vcu = (F.G % 8 == 0) ? (bx % 8) * (F.G / 8) + bx / 8 : bx; }
    F.ctl = (gu32*)(args.ws + WS_CTL);
    for (int u = F.tid; u < (LDS_BYTES - MISC_OFF) / 4; u += NTHR) ((LAS unsigned*)(F.lds + MISC_OFF))[u] = 0u;
    __syncthreads();
#if MK_PER_PHASE
#define GRID_BAR() do { } while (0)
#else
    XcdBarrier bar = xcd_barrier_post((unsigned*)(F.ctl + CW_BAR), F.MISC + 8);
#define GRID_BAR() xcd_barrier(bar)
#endif
    unsigned char* ws = args.ws;
    const int lo = args.ph_lo, hi = args.ph_hi;
#ifndef DBG_REP_PHASE
#define DBG_REP_PHASE -1
#endif
#ifndef DBG_REP_N
#define DBG_REP_N 1
#endif
#define REPS(k) for (int rep_ = 0; rep_ < ((k) == DBG_REP_PHASE ? 1 + DBG_REP_N : 1); ++rep_)
#define IN(k) (lo <= (k) && (k) < hi)
#define BOTH(k) (IN(k) && IN((k) + 1))
#define ENDPH(k) do { if (BOTH(k) || (k) == DBG_REP_PHASE) GRID_BAR(); } while (0)
    if (IN(0)) REPS(0) { p0_prologue(F, args); ENDPH(0); }
    if (IN(1)) REPS(1) {
        pg8::Gemm g{(const bf16*)(ws + WS_XN), (const bf16*)(ws + WS_WIN), M, NPROJ - 256, DM}; pg8::StaticOrder S; S.init(M, NPROJ - 256, F.G, (int)blockIdx.x);
        EpiInProj E{(bf16*)(ws + WS_U), (bf16*)(ws + WS_Q), (bf16*)(ws + WS_K), (bf16*)(ws + WS_V), (bf16*)(ws + WS_GA), (bf16*)(ws + WS_GB), args.out, args.q_norm_g, args.k_norm_g, 0};
        pg8::gemm_phase<EpiInProj, pg8::StaticOrder, true, true>(F.lds, g, S, E);
        ENDPH(1);
    }
    if (IN(2)) REPS(2) {
        { pg8::Gemm g{(const bf16*)(ws + WS_XN), (const bf16*)(ws + WS_WIN) + (size_t)(NPROJ - 256) * DM, M, 256, DM}; pg8::StaticOrder S; S.init(M, 256, F.G, (int)blockIdx.x);
          EpiInProj E{(bf16*)(ws + WS_U), (bf16*)(ws + WS_Q), (bf16*)(ws + WS_K), (bf16*)(ws + WS_V), (bf16*)(ws + WS_GA), (bf16*)(ws + WS_GB), args.out, args.q_norm_g, args.k_norm_g, 15};
          pg8::gemm_phase<EpiInProj, pg8::StaticOrder, true, true>(F.lds, g, S, E); }
        __syncthreads();
        p2_cumsum_pool(F, args); ENDPH(2); }
    if (IN(3)) {
        const float M2 = __builtin_bit_cast(float, __builtin_amdgcn_readfirstlane(__builtin_bit_cast(int, attn_bound2(args, F.lane))));
#if !defined(DBG_SKIP_PATTN)
        { const attn_body::AttnTensors AT{(const attn_body::bf16*)(ws + WS_Q), (const attn_body::bf16*)(ws + WS_K), (const attn_body::bf16*)(ws + WS_V), (attn_body::bf16*)(ws + WS_AO), (const float*)(ws + WS_CP2), M2};
          const attn_body::StaticOrder S((int)F.G, F.vcu);
          attn_body::attn_phase<attn_body::StaticOrder>((char*)lds, AT, S);
#ifdef DBG_ATTN2
          __syncthreads(); attn_body::attn_phase<attn_body::StaticOrder>((char*)lds, AT, S);
#endif
        }
#endif
        REPS(3) { p3_sample_attn2(F, args, M2); }
        ENDPH(3); }
    if (IN(4)) REPS(4) {
        { pg8::Gemm g{(const bf16*)(ws + WS_PO), (const bf16*)(ws + WS_WBP), MP, DM, DP}; pg8::StaticOrder S; S.init(MP, DM, F.G, (int)blockIdx.x);
          EpiGate<0> E{(const bf16*)(ws + WS_GA), nullptr, (bf16*)(ws + WS_T)};
          pg8::gemm_phase<EpiGate<0>, pg8::StaticOrder, true, true>(F.lds, g, S, E); }
        __syncthreads();
        { pg8::Gemm g{(const bf16*)(ws + WS_AO), (const bf16*)(ws + WS_WBA), MP, DM, DA}; pg8::StaticOrder S; S.init(MP, DM, F.G, (int)blockIdx.x);
          EpiGate<1> E{(const bf16*)(ws + WS_GB), (const bf16*)(ws + WS_T), (bf16*)(ws + WS_MIX)};
          pg8::gemm_phase<EpiGate<1>, pg8::StaticOrder, true, true>(F.lds, g, S, E); }
        { SgGate<0> E{(const bf16*)(ws + WS_GA), nullptr, (bf16*)(ws + WS_T)}; sg_phase(F, (const bf16*)(ws + WS_PO) + (size_t)MP * DP, (const bf16*)(ws + WS_WBP), DP, DM, E); }
        asm volatile("s_waitcnt vmcnt(0)" ::: "memory"); __syncthreads();
        { SgGate<1> E{(const bf16*)(ws + WS_GB), (const bf16*)(ws + WS_T), (bf16*)(ws + WS_MIX)}; sg_phase(F, (const bf16*)(ws + WS_AO) + (size_t)MP * DA, (const bf16*)(ws + WS_WBA), DA, DM, E); }
        ENDPH(4);
    }
    if (IN(5)) REPS(5) {
        pg8::Gemm g{(const bf16*)(ws + WS_MIX), (const bf16*)(ws + WS_WOUT), MP, DM, DM}; pg8::StaticOrder S; S.init(MP, DM, F.G, (int)blockIdx.x);
        EpiOut E{args.x_p, args.x_s, (float*)(ws + WS_H), (bf16*)(ws + WS_XN), args.norm_ffn_g, (float*)(ws + WS_RSS)};
        pg8::gemm_phase<EpiOut, pg8::StaticOrder, true, true>(F.lds, g, S, E);
        { SgOut E2{args.x_s, (float*)(ws + WS_H), (bf16*)(ws + WS_XN), args.norm_ffn_g, (float*)(ws + WS_RSS)}; sg_phase(F, (const bf16*)(ws + WS_MIX) + (size_t)MP * DM, (const bf16*)(ws + WS_WOUT), DM, DM, E2); }
        ENDPH(5);
    }
    if (IN(6)) REPS(6) {
        pg8::Gemm g{(const bf16*)(ws + WS_XN), (const bf16*)(ws + WS_WQ), MP, DQ, DM}; pg8::StaticOrder S; S.init(MP, DQ, F.G, (int)blockIdx.x);
        pg8::EpiBf16<0> E{(bf16*)(ws + WS_PQ), DQ, nullptr, 0, 0, 1.f};
        pg8::gemm_phase<pg8::EpiBf16<0>, pg8::StaticOrder, true, true>(F.lds, g, S, E);
        { SgPQ E2{(bf16*)(ws + WS_PQ)}; sg_phase(F, (const bf16*)(ws + WS_XN) + (size_t)MP * DM, (const bf16*)(ws + WS_WQ), DM, DQ, E2); }
        ENDPH(6);
    }
    if (IN(7)) REPS(7) { p7_topk(F, args); ENDPH(7); }
    if (IN(8)) REPS(8) { p8_gather(F, args); ENDPH(8); }
#ifdef DBG_DUMP
    if (IN(9)) { const bf16* AO = (const bf16*)(ws + WS_AO); const bf16* PO = (const bf16*)(ws + WS_PO); const bf16* MX = (const bf16*)(ws + (DBG_DUMP == 3 ? WS_T : DBG_DUMP == 4 ? WS_GA : WS_MIX));
        for (size_t i = (size_t)blockIdx.x * NTHR + F.tid; i < (size_t)M * DM; i += (size_t)F.G * NTHR) { const int row = (int)(i >> 10), c = (int)(i & 1023);
            float v; if (DBG_DUMP == 1) v = c < 512 ? bf2f(AO[(size_t)row * DA + c]) : bf2f(PO[(size_t)row * DP + c - 512]); else v = bf2f(MX[i]);
            args.out[O_YP + i] = v; } }
#endif
#undef IN
#undef BOTH
}

extern "C" void kernel_launch(void* const* d_in, const int* in_sizes, int n_in, void* d_out, int out_size, void* d_ws, size_t ws_size, hipStream_t stream) {
    static int grid = 0;
    if (grid == 0) {
        if (n_in != 22 || (size_t)out_size != O_END || ws_size < WS_END) { fprintf(stderr, "kernel_launch: unexpected shapes (n_in %d out %d ws %zu)\n", n_in, out_size, ws_size); grid = -1; return; }
        int dev = 0, cus = 0, per_cu = 0;
        if (hipGetDevice(&dev) != hipSuccess || hipDeviceGetAttribute(&cus, hipDeviceAttributeMultiprocessorCount, dev) != hipSuccess) { grid = -1; return; }
        if (hipFuncSetAttribute((const void*)fwd_kernel, hipFuncAttributeMaxDynamicSharedMemorySize, LDS_BYTES) != hipSuccess) { fprintf(stderr, "kernel_launch: hipFuncSetAttribute failed\n"); grid = -1; return; }
        if (hipOccupancyMaxActiveBlocksPerMultiprocessor(&per_cu, (const void*)fwd_kernel, NTHR, LDS_BYTES) != hipSuccess || per_cu < 1) fprintf(stderr, "kernel_launch: occupancy query reports %d\n", per_cu);
        (void)hipGetLastError();
        grid = cus;
    }
    if (grid < 0) return;
    if (hipMemsetAsync((char*)d_ws + WS_CTL, 0, CTL_ZERO_BYTES, stream) != hipSuccess) return;
    Args a{};
    a.x_p = (const float*)d_in[0]; a.x_s = (const float*)d_in[1]; a.cache_k = (const float*)d_in[2]; a.cache_v = (const float*)d_in[3]; a.cache_lf = (const float*)d_in[4];
    a.state_pool = (const float*)d_in[5]; a.page_table = (const int*)d_in[6]; a.norm_mix_g = (const float*)d_in[7]; a.w_in = (const float*)d_in[8]; a.b_forget = (const float*)d_in[9];
    a.q_norm_g = (const float*)d_in[10]; a.k_norm_g = (const float*)d_in[11]; a.pool_mix_w = (const float*)d_in[12]; a.pool_scale = (const float*)d_in[13]; a.w_bp = (const float*)d_in[14];
    a.w_ba = (const float*)d_in[15]; a.w_out = (const float*)d_in[16]; a.norm_ffn_g = (const float*)d_in[17]; a.w_query = (const float*)d_in[18]; a.sub_keys = (const float*)d_in[19];
    a.peer_u = (const float*)d_in[20]; a.peer_v = (const float*)d_in[21];
    a.out = (float*)d_out; a.ws = (unsigned char*)d_ws; a.pad = 0;
#if MK_PER_PHASE
#ifndef DBG_NPH
#define DBG_NPH N_PHASES
#endif
    for (int ph = 0; ph < DBG_NPH; ++ph) { a.ph_lo = ph; a.ph_hi = ph + 1; a.li = ph; hipLaunchKernelGGL(fwd_kernel, dim3(grid), dim3(NTHR), LDS_BYTES, stream, a); }
#ifdef DBG_DUMP
    a.ph_lo = 9; a.ph_hi = 10; a.li = 9; hipLaunchKernelGGL(fwd_kernel, dim3(grid), dim3(NTHR), LDS_BYTES, stream, a);
#endif
#else
    a.ph_lo = 0; a.ph_hi = N_PHASES; a.li = 0; hipLaunchKernelGGL(fwd_kernel, dim3(grid), dim3(NTHR), LDS_BYTES, stream, a);
#endif
}
```

```cpp
#include <hip/hip_runtime.h>
#include <cstdio>
#include <cstdint>
#include <cmath>
namespace pg8 {
#define PG8_LAS __attribute__((address_space(3)))
typedef unsigned short bf16_t;
typedef short bf16x8 __attribute__((ext_vector_type(8)));
typedef float f32x4 __attribute__((ext_vector_type(4)));
typedef unsigned u32x4 __attribute__((ext_vector_type(4)));
constexpr int BM = 256, BK = 64, HALF = 128, HTB = HALF * BK * 2  , STAGE_BYTES = 8 * HTB, NXCD = 8, WGM = 8;

__host__ __device__ __forceinline__ int lds_byte(int r, int c) { const int st = (r >> 4) * 2 + (c >> 5), rr = r & 15, cc = c & 31, ob = rr * 64 + cc * 2; return st * 1024 + (ob ^ (((ob >> 9) & 1) << 5)); }
__host__ __device__ __forceinline__ void stage_rc(int b, int& R, int& C) { const int st = b / 1024, sb = b % 1024, swz = sb ^ (((sb >> 9) & 1) << 5); R = (st >> 1) * 16 + swz / 64; C = (st & 1) * 32 + (swz % 64) / 2; }
__host__ __device__ __forceinline__ int perm32(int rho) { const int n = rho >> 4, i = rho & 15; return 8 * (i >> 2) + 4 * n + (i & 3); }

struct Unit { int pm, pn; };
struct Gemm { const bf16_t* A; const bf16_t* Bt; int M, N, K; };

struct StaticOrder {
    int nM, nN, nwg, G, c;
    __host__ __device__ void init(int M, int N, int G_, int c_) { nM = M / BM; nN = N / BM; nwg = nM * nN; G = G_; c = c_; }
    __host__ __device__ bool next(int i, Unit& u) const {
        const long L = (long)i * G + c; if (L >= nwg) return false;
        int wgid = (int)L; { const int q = nwg / NXCD, r = nwg % NXCD, xcd = wgid % NXCD, off = wgid / NXCD; wgid = (xcd < r ? xcd * (q + 1) : r * (q + 1) + (xcd - r) * q) + off; }
        const int nig = WGM * nN, gid = wgid / nig, fm = gid * WGM, gsz = (nM - fm) < WGM ? (nM - fm) : WGM;
        u.pm = fm + ((wgid % nig) % gsz); u.pn = (wgid % nig) / gsz; return true;
    }
    __device__ __forceinline__ void a_ready(const Unit&) const {}
    __device__ __forceinline__ void done(const Unit&) const {}
};

typedef float f32x2c __attribute__((ext_vector_type(2))); typedef __bf16 bf16x2c __attribute__((ext_vector_type(2)));
__device__ __forceinline__ unsigned cvt_pk_bf16(float lo, float hi) { f32x2c v = {lo, hi}; bf16x2c b = __builtin_convertvector(v, bf16x2c); return __builtin_bit_cast(unsigned, b); }
typedef float f32x2 __attribute__((ext_vector_type(2)));
__device__ __forceinline__ f32x2 gelu_pk(f32x2 v) {
    const f32x2 av = __builtin_elementwise_abs(v), d = av * 0.2316418882f + 1.0f;
    f32x2 t; t.x = __builtin_amdgcn_rcpf(d.x); t.y = __builtin_amdgcn_rcpf(d.y);
    f32x2 q = t * 0.5307027145f + (-0.7265760135f); q = q * t + 0.7107068705f; q = q * t + (-0.142248368f); q = q * t + 0.127414796f; q = q * t;
    const f32x2 s = (v * v) * (-0.72134752044f);
    f32x2 e; e.x = __builtin_amdgcn_exp2f(s.x); e.y = __builtin_amdgcn_exp2f(s.y);
    const f32x2 m = v * (q * e), r = v - m;
    f32x2 o; o.x = v.x < 0.f ? m.x : r.x; o.y = v.y < 0.f ? m.y : r.y; return o;
}

template <int ACT  > struct EpiBf16 {
    static constexpr bool PERM = true, AFTER_DRAIN = false; static_assert(ACT == 0 || ACT == 1, "EpiBf16: ACT is 0 (none) or 1 (gelu_pk)");
    bf16_t* O; int ldc; const float* bias; int split_cols; size_t split_stride; float scale0;
    __device__ __forceinline__ void operator()(const f32x4 (&acc)[2][2][4][2], const Unit& u, int wr, int wc, int fr, int fq) const {
        const int row0 = u.pm * BM + wr * 64 + fr; int colt = u.pn * BM; bf16_t* base = O;
        float sc = 1.f; if (split_cols) { const int t = colt / split_cols; base += (size_t)t * split_stride; colt -= t * split_cols; if (t == 0) sc = scale0; }
        const int col0 = colt + wc * 32 + 8 * fq, bcol0 = u.pn * BM + wc * 32 + 8 * fq;
        f32x4 bv[2][2];
#pragma unroll
        for (int bj = 0; bj < 2; ++bj)
#pragma unroll
            for (int n = 0; n < 2; ++n) bv[bj][n] = bias ? *(const f32x4*)(bias + bcol0 + bj * HALF + 4 * n) : (f32x4){0.f, 0.f, 0.f, 0.f};
#pragma unroll
        for (int ai = 0; ai < 2; ++ai)
#pragma unroll
            for (int m = 0; m < 4; ++m) { bf16_t* rowp = base + (size_t)(row0 + ai * HALF + m * 16) * ldc + col0;
#pragma unroll
                for (int bj = 0; bj < 2; ++bj) { f32x4 v0 = acc[ai][bj][m][0] + bv[bj][0], v1 = acc[ai][bj][m][1] + bv[bj][1];
                    if (ACT == 1) { f32x2 a = gelu_pk((f32x2){v0[0], v0[1]}), b = gelu_pk((f32x2){v0[2], v0[3]}), c = gelu_pk((f32x2){v1[0], v1[1]}), d = gelu_pk((f32x2){v1[2], v1[3]});
                        v0 = (f32x4){a.x, a.y, b.x, b.y}; v1 = (f32x4){c.x, c.y, d.x, d.y}; }
                    v0 = v0 * sc; v1 = v1 * sc; u32x4 w; w.x = cvt_pk_bf16(v0[0], v0[1]); w.y = cvt_pk_bf16(v0[2], v0[3]); w.z = cvt_pk_bf16(v1[0], v1[1]); w.w = cvt_pk_bf16(v1[2], v1[3]);
                    *(u32x4*)(rowp + bj * HALF) = w; } }
    }
};
template <class Epi, class Sched, bool ALIGN_EPI = false, bool SP2 = false>
__device__ __forceinline__ void gemm_phase(PG8_LAS unsigned char* lds, const Gemm g, const Sched& S, const Epi& E) {
    int tid = threadIdx.x; asm volatile("" : "+v"(tid));
    const int wid = __builtin_amdgcn_readfirstlane(tid >> 6), lane = tid & 63, wr = wid >> 2, wc = wid & 3, fr = lane & 15, fq = lane >> 4;
    const int K = g.K, nt = K / BK;
    unsigned voffA[2], voffB[2];
#pragma unroll
    for (int i = 0; i < 2; ++i) { int R, C; stage_rc(tid * 16 + i * 8192, R, C); const int Rb = Epi::PERM ? ((R & ~31) + perm32(R & 31)) : R;
        voffA[i] = (unsigned)(R * K + C) * 2u; voffB[i] = (unsigned)(Rb * K + C) * 2u; }
    const size_t kstep = (size_t)(BK * 2);
    const size_t hstep = (size_t)HALF * K * 2;
    const size_t tstep = 2 * hstep;
    const unsigned ldsw = (unsigned)wid * 1024u;
    const int aoff = lds_byte(wr * 64 + fr, fq * 8), boff = lds_byte(wc * 32 + fr, fq * 8);
#define PG8_SA(b, h) (((b) * 2 + (h)) * HTB)
#define PG8_SB(b, h) ((4 + (b) * 2 + (h)) * HTB)
#define PG8_STAGE(bufoff, gbase, voff) do { _Pragma("unroll") for (int _i = 0; _i < 2; ++_i) \
        __builtin_amdgcn_global_load_lds((const unsigned*)((const char*)(gbase) + (voff)[_i]), (PG8_LAS unsigned*)(lds + (bufoff) + ldsw + _i * 8192), 16, 0, 0); } while (0)
#define PG8_LDA(dst, b, h) do { _Pragma("unroll") for (int m = 0; m < 4; ++m) _Pragma("unroll") for (int k = 0; k < 2; ++k) dst[m][k] = *(const PG8_LAS bf16x8*)(lds + PG8_SA(b, h) + aoff + m * 2048 + k * 1024); } while (0)
#define PG8_LDB(dst, b, h) do { _Pragma("unroll") for (int n = 0; n < 2; ++n) _Pragma("unroll") for (int k = 0; k < 2; ++k) dst[n][k] = *(const PG8_LAS bf16x8*)(lds + PG8_SB(b, h) + boff + n * 2048 + k * 1024); } while (0)
#define PG8_MMA(ai, bj, At, Bt) do { __builtin_amdgcn_s_setprio(1); _Pragma("unroll") for (int m = 0; m < 4; ++m) _Pragma("unroll") for (int n = 0; n < 2; ++n) _Pragma("unroll") for (int k = 0; k < 2; ++k) \
        acc[ai][bj][m][n] = __builtin_amdgcn_mfma_f32_16x16x32_bf16(Bt[n][k], At[m][k], acc[ai][bj][m][n], 0, 0, 0); __builtin_amdgcn_s_setprio(0); } while (0)
#define PG8_WAIT_V(n) asm volatile("s_waitcnt vmcnt(" #n ")" ::: "memory")
#define PG8_WAIT_L(n) asm volatile("s_waitcnt lgkmcnt(" #n ")" ::: "memory")
#define PG8_BAR __builtin_amdgcn_s_barrier()
#define PG8_SCHED __builtin_amdgcn_sched_barrier(0)
    Unit cur, nxt; int ui = 0;
    if (!S.next(0, cur)) return;
    f32x4 acc[2][2][4][2];
#pragma unroll
    for (int a = 0; a < 2; ++a)
#pragma unroll
        for (int b = 0; b < 2; ++b)
#pragma unroll
            for (int m = 0; m < 4; ++m)
#pragma unroll
                for (int n = 0; n < 2; ++n) acc[a][b][m][n] = (f32x4){0.f, 0.f, 0.f, 0.f};
    bf16x8 At[4][2], B0[2][2], B1[2][2];
    const char* cA = (const char*)g.A + (size_t)cur.pm * tstep; const char* cB = (const char*)g.Bt + (size_t)cur.pn * tstep;
    S.a_ready(cur);
    if constexpr (SP2) {
        PG8_STAGE(PG8_SB(0, 0), cB, voffB); PG8_STAGE(PG8_SB(0, 1), cB + hstep, voffB); PG8_STAGE(PG8_SA(0, 0), cA, voffA); PG8_STAGE(PG8_SA(0, 1), cA + hstep, voffA);
        if (wr == 1) PG8_BAR;
        PG8_WAIT_V(2); PG8_BAR;
        PG8_STAGE(PG8_SB(1, 0), cB + kstep, voffB); PG8_STAGE(PG8_SA(1, 0), cA + kstep, voffA); PG8_STAGE(PG8_SB(1, 1), cB + hstep + kstep, voffB);
        PG8_WAIT_V(6); PG8_BAR;
    } else {
        PG8_STAGE(PG8_SB(0, 0), cB, voffB); PG8_STAGE(PG8_SA(0, 0), cA, voffA); PG8_STAGE(PG8_SB(0, 1), cB + hstep, voffB); PG8_STAGE(PG8_SA(0, 1), cA + hstep, voffA);
        if (wr == 1) PG8_BAR;
        PG8_WAIT_V(4); PG8_BAR;
        PG8_STAGE(PG8_SB(1, 0), cB + kstep, voffB); PG8_STAGE(PG8_SA(1, 0), cA + kstep, voffA); PG8_STAGE(PG8_SB(1, 1), cB + hstep + kstep, voffB);
        PG8_WAIT_V(6); PG8_BAR;
    }
    for (;;) {
        const bool has_next = S.next(ui + 1, nxt);
        const char* nA = has_next ? (const char*)g.A + (size_t)nxt.pm * tstep : cA; const char* nB = has_next ? (const char*)g.Bt + (size_t)nxt.pn * tstep : cB;
        for (int t = 0; t < nt; t += 2) {
            const bool last = (t == nt - 2);
            const char* a1 = cA + (size_t)(t + 1) * kstep;
            const char* a2 = last ? nA : cA + (size_t)(t + 2) * kstep; const char* b2 = last ? nB : cB + (size_t)(t + 2) * kstep;
            const char* a3 = a2 + kstep; const char* b3 = b2 + kstep;
            if (last && has_next) S.a_ready(nxt);
            if constexpr (SP2) {
            PG8_LDB(B0, 0, 0); PG8_LDB(B1, 0, 1); PG8_SCHED; PG8_LDA(At, 0, 0); PG8_STAGE(PG8_SA(1, 1), a1 + hstep, voffA);
            PG8_WAIT_V(8); PG8_WAIT_L(0); PG8_BAR; PG8_MMA(0, 0, At, B0); PG8_MMA(0, 1, At, B1); PG8_BAR; PG8_SCHED;
            PG8_LDA(At, 0, 1); PG8_STAGE(PG8_SB(0, 0), b2, voffB); PG8_STAGE(PG8_SB(0, 1), b2 + hstep, voffB); PG8_STAGE(PG8_SA(0, 0), a2, voffA);
            PG8_WAIT_V(8); PG8_WAIT_L(0); PG8_BAR; PG8_MMA(1, 0, At, B0); PG8_MMA(1, 1, At, B1); PG8_BAR; PG8_SCHED;
            PG8_LDB(B0, 1, 0); PG8_LDB(B1, 1, 1); PG8_SCHED; PG8_LDA(At, 1, 0); PG8_STAGE(PG8_SA(0, 1), a2 + hstep, voffA);
            PG8_WAIT_V(8); PG8_WAIT_L(0); PG8_BAR; PG8_MMA(0, 0, At, B0); PG8_MMA(0, 1, At, B1); PG8_BAR; PG8_SCHED;
            PG8_LDA(At, 1, 1); PG8_STAGE(PG8_SB(1, 0), b3, voffB); PG8_STAGE(PG8_SB(1, 1), b3 + hstep, voffB); PG8_STAGE(PG8_SA(1, 0), a3, voffA);
            PG8_WAIT_V(8); PG8_WAIT_L(0); PG8_BAR; PG8_MMA(1, 0, At, B0); PG8_MMA(1, 1, At, B1); PG8_BAR; PG8_SCHED;
            } else {
            PG8_LDB(B0, 0, 0); PG8_SCHED; PG8_LDA(At, 0, 0); PG8_STAGE(PG8_SA(1, 1), a1 + hstep, voffA);
            PG8_WAIT_L(8); PG8_BAR; PG8_WAIT_L(0); PG8_MMA(0, 0, At, B0); PG8_BAR; PG8_SCHED;
            PG8_LDB(B1, 0, 1); PG8_STAGE(PG8_SB(0, 0), b2, voffB);
            PG8_BAR; PG8_WAIT_L(0); PG8_MMA(0, 1, At, B1); PG8_BAR;
            PG8_LDA(At, 0, 1); PG8_STAGE(PG8_SA(0, 0), a2, voffA);
            PG8_BAR; PG8_WAIT_L(0); PG8_MMA(1, 0, At, B0); PG8_BAR; PG8_SCHED;
            PG8_STAGE(PG8_SB(0, 1), b2 + hstep, voffB);
            PG8_WAIT_V(6); PG8_BAR; PG8_MMA(1, 1, At, B1); PG8_BAR;
            PG8_LDB(B0, 1, 0); PG8_SCHED; PG8_LDA(At, 1, 0); PG8_STAGE(PG8_SA(0, 1), a2 + hstep, voffA);
            PG8_WAIT_L(8); PG8_BAR; PG8_WAIT_L(0); PG8_MMA(0, 0, At, B0); PG8_BAR; PG8_SCHED;
            PG8_LDB(B1, 1, 1); PG8_STAGE(PG8_SB(1, 0), b3, voffB);
            PG8_BAR; PG8_WAIT_L(0); PG8_MMA(0, 1, At, B1); PG8_BAR;
            PG8_LDA(At, 1, 1); PG8_STAGE(PG8_SA(1, 0), a3, voffA);
            PG8_BAR; PG8_WAIT_L(0); PG8_MMA(1, 0, At, B0); PG8_BAR; PG8_SCHED;
            PG8_STAGE(PG8_SB(1, 1), b3 + hstep, voffB);
            PG8_WAIT_V(6); PG8_BAR; PG8_MMA(1, 1, At, B1); PG8_BAR;
            }
        }
        if constexpr (ALIGN_EPI) { if (wr == 0) PG8_BAR; }
        if constexpr (!Epi::AFTER_DRAIN) { E(acc, cur, wr, wc, fr, fq); S.done(cur); }
        if (!has_next) break;
#pragma unroll
        for (int a = 0; a < 2; ++a)
#pragma unroll
            for (int b = 0; b < 2; ++b)
#pragma unroll
                for (int m = 0; m < 4; ++m)
#pragma unroll
                    for (int n = 0; n < 2; ++n) acc[a][b][m][n] = (f32x4){0.f, 0.f, 0.f, 0.f};
        cur = nxt; cA = nA; cB = nB; ++ui;
        if constexpr (ALIGN_EPI) { if (wr == 1) PG8_BAR; }
    }
    PG8_WAIT_V(0);
    if constexpr (!ALIGN_EPI) { if (wr == 0) PG8_BAR; }
    PG8_BAR;
    if constexpr (Epi::AFTER_DRAIN) { E.fused(acc, cur, wr, wc, fr, fq, lds, wid, lane); S.done(cur); }
#undef PG8_SA
#undef PG8_SB
#undef PG8_STAGE
#undef PG8_LDA
#undef PG8_LDB
#undef PG8_MMA
#undef PG8_WAIT_V
#undef PG8_WAIT_L
#undef PG8_BAR
#undef PG8_SCHED
}
}
#define GAS __attribute__((address_space(1)))
#define LAS __attribute__((address_space(3)))
typedef unsigned short bf16;
typedef unsigned v4u __attribute__((ext_vector_type(4)));
typedef float f32x4 __attribute__((ext_vector_type(4)));
typedef short bf16x8 __attribute__((ext_vector_type(8)));
typedef GAS unsigned gu32;
typedef GAS unsigned long long gu64;
#define RLX_AGENT __ATOMIC_RELAXED, __HIP_MEMORY_SCOPE_AGENT
#define LDS_WAIT() asm volatile("s_waitcnt lgkmcnt(0)" ::: "memory")
#define VM_WAIT() asm volatile("s_waitcnt vmcnt(0)" ::: "memory")
__device__ __forceinline__ unsigned long long rt() { return __builtin_amdgcn_s_memrealtime(); }
__device__ __forceinline__ unsigned f2bf(float f) { unsigned u = __builtin_bit_cast(unsigned, f); return (u + 0x7fffu + ((u >> 16) & 1u)) >> 16; }
__device__ __forceinline__ unsigned pk2(float lo, float hi) { return f2bf(lo) | (f2bf(hi) << 16); }

#define XB_TMO      128
#define XB_XCNT(j)  (256  + 64 * (j))
#define XB_XSUB(j)  (1280 + 64 * (j))
#define XB_XGEN(j)  (2304 + 64 * (j))
#define XB_TOP      3328
#define XB_TOPGEN   3392
#define XCD_BAR_WORDS 3456
#define XB_SPIN_CAP (1u << 18)

__device__ __forceinline__ unsigned xb_ld(unsigned* p)              { return __hip_atomic_load(p, __ATOMIC_RELAXED, __HIP_MEMORY_SCOPE_AGENT); }
__device__ __forceinline__ unsigned xb_add(unsigned* p, unsigned v) { return __hip_atomic_fetch_add(p, v, __ATOMIC_RELAXED, __HIP_MEMORY_SCOPE_AGENT); }
__device__ __forceinline__ unsigned xb_xcc_id() { return (unsigned)__builtin_amdgcn_s_getreg((3 << 11) | 20) & 0xFu; }
#define XB_SPIN(cond, bar) do { unsigned _sp = 0; while (cond) { __builtin_amdgcn_s_sleep(1); \
    if ((++_sp & 255u) == 0u) { if (xb_ld(&(bar)[XB_TMO])) break; if (_sp > XB_SPIN_CAP) { atomicAdd(&(bar)[XB_TMO], 1u); break; } } } } while (0)

struct XcdBarrier {
    unsigned* bar; unsigned x;
    volatile LAS unsigned* st;
};

__device__ __forceinline__ XcdBarrier xcd_barrier_post(unsigned* bar, volatile LAS unsigned* st) {
    XcdBarrier b; b.bar = bar; b.x = xb_xcc_id(); b.st = st;
    if (threadIdx.x == 0) (void)xb_add(&bar[XB_XCNT(b.x)], 1u);
    return b;
}
__device__ __forceinline__ void xcd_barrier_complete(unsigned* bar, unsigned x, unsigned& nloc, unsigned& nx) {
    const unsigned G = gridDim.x * gridDim.y * gridDim.z;
    unsigned sum, cnt, mine, sp = 0u;
    for (;;) {
        sum = 0u; cnt = 0u; mine = 0u;
#pragma unroll
        for (unsigned j = 0; j < 16; ++j) { const unsigned c = xb_ld(&bar[XB_XCNT(j)]); sum += c; cnt += (c > 0u) ? 1u : 0u; mine = (j == x) ? c : mine; }
        if (sum == G) break;
        __builtin_amdgcn_s_sleep(1);
        if ((++sp & 255u) == 0u) { if (xb_ld(&bar[XB_TMO])) break; if (sp > XB_SPIN_CAP) { atomicAdd(&bar[XB_TMO], 1u); break; } }
    }
    nloc = mine > 0u ? mine : 1u; nx = cnt > 0u ? cnt : 1u;
}

__device__ __forceinline__ void xcd_barrier(const XcdBarrier& b) {
    asm volatile("s_waitcnt vmcnt(0)" ::: "memory");
    __syncthreads();
    if (threadIdx.x == 0) {
        unsigned* bar = b.bar;
        __builtin_amdgcn_s_waitcnt(0);
        unsigned nloc = b.st[0], nx = b.st[1];
        if (nloc == 0u) { xcd_barrier_complete(bar, b.x, nloc, nx); b.st[0] = nloc; b.st[1] = nx; }
        const unsigned old = xb_add(&bar[XB_XSUB(b.x)], 1u);
        const unsigned gen = old / nloc;
        if (old + 1u == (gen + 1u) * nloc) {
            __builtin_amdgcn_fence(__ATOMIC_RELEASE, "agent");
            asm volatile("s_waitcnt vmcnt(0)" ::: "memory");
            const unsigned og = xb_add(&bar[XB_TOP], 1u);
            const unsigned tg = og / nx;
            if (og + 1u == (tg + 1u) * nx) xb_add(&bar[XB_TOPGEN], 1u);
            else XB_SPIN(xb_ld(&bar[XB_TOPGEN]) == tg, bar);
            __builtin_amdgcn_fence(__ATOMIC_ACQUIRE, "agent");
            xb_add(&bar[XB_XGEN(b.x)], 1u);
            asm volatile("s_waitcnt vmcnt(0)" ::: "memory");
        } else {
            XB_SPIN(xb_ld(&bar[XB_XGEN(b.x)]) == gen, bar);
            __builtin_amdgcn_fence(__ATOMIC_ACQUIRE, "agent");
            asm volatile("s_waitcnt vmcnt(0)" ::: "memory");
        }
    }
    __syncthreads();
}
#include <hip/hip_bf16.h>
#include <cmath>
namespace attn_body {
using bf16=__hip_bfloat16;
using bf16x8=__attribute__((ext_vector_type(8)))short;
using s16x4=__attribute__((ext_vector_type(4)))short;
using f32x16=__attribute__((ext_vector_type(16)))float;
using u32x4=__attribute__((ext_vector_type(4)))unsigned;
constexpr int BATCH=4,NHEAD=8,SEQ=4096,D=64,DM=NHEAD*D;
constexpr int NW=8,QBLK=32,QB=QBLK*NW,KVBLK=64,NQB=SEQ/QB;
constexpr int ATTN_PITCH=DM, ATTN_UNIT_ROWS=QB;
__device__ __forceinline__ int crow(int r,int hi){return (r&3)+8*(r>>2)+4*hi;}
#define SBAR() __builtin_amdgcn_sched_barrier(0)
__device__ __forceinline__ void cmask(f32x16&p0,f32x16&p1,int jb,int qrel,int hi){
  const float NEG=-INFINITY; int kb=64*jb+4*hi;
  #pragma unroll
  for(int r=0;r<16;++r){int kv=kb+(r&3)+8*(r>>2); if(kv>qrel)p0[r]=NEG; if(kv+32>qrel)p1[r]=NEG;}
}

constexpr int NSLOT=3, SLOTB=8192;
constexpr int LDS_K=0, LDS_V=NSLOT*SLOTB, LDS_WS=2*NSLOT*SLOTB, LDS_OST=LDS_WS+NW*64*4, LDS_CK=LDS_OST+NW*4096, LDS_BYTES=LDS_CK+SEQ*4;
constexpr float C2=0.125f*1.4426950408889634f;
__device__ __forceinline__ void glds16(const void*gsrc,unsigned lds_dst){unsigned keep;
  asm volatile("s_mov_b32 %0, m0\n\ts_mov_b32 m0, %2\n\ts_nop 0\n\tglobal_load_lds_dwordx4 %1, off\n\ts_mov_b32 m0, %0":"=&s"(keep):"v"(gsrc),"s"(lds_dst):"memory");}
__device__ __forceinline__ float max3f(float a,float b,float c){float r;asm("v_max3_f32 %0, %1, %2, %3":"=v"(r):"v"(a),"v"(b),"v"(c));return r;}
__device__ __forceinline__ float max2f(float a,float b){float r;asm("v_max_f32_e32 %0, %1, %2":"=v"(r):"v"(a),"v"(b));return r;}
__device__ __forceinline__ float fadd_s(float a,float b){float r;asm("v_add_f32_e32 %0, %1, %2":"=v"(r):"v"(a),"v"(b));return r;}
__device__ __forceinline__ float fsub_s(float a,float b){float r;asm("v_sub_f32_e32 %0, %1, %2":"=v"(r):"v"(a),"v"(b));return r;}
typedef float f32x2_t __attribute__((ext_vector_type(2))); typedef __bf16 bf16x2_t __attribute__((ext_vector_type(2)));
__device__ __forceinline__ unsigned cvtpk_s(float lo,float hi){f32x2_t v={lo,hi};bf16x2_t b=__builtin_convertvector(v,bf16x2_t);return __builtin_bit_cast(unsigned,b);}
#define WAIT_BAR(N) asm volatile("s_waitcnt vmcnt(" #N ") lgkmcnt(0)\n\ts_barrier":::"memory")

__device__ __forceinline__ void qkt(f32x16&p0,f32x16&p1,const char*Kslot,const bf16x8*qr,int r32,int hi){
  const char*kb=Kslot+hi*1024+r32*16;
  #pragma unroll
  for(int d0=0;d0<4;++d0){
    const bf16x8 b0=*reinterpret_cast<const bf16x8*>(kb+d0*2048);
    const bf16x8 b1=*reinterpret_cast<const bf16x8*>(kb+d0*2048+512);
    p0=__builtin_amdgcn_mfma_f32_32x32x16_bf16(b0,qr[d0],p0,0,0,0);p1=__builtin_amdgcn_mfma_f32_32x32x16_bf16(b1,qr[d0],p1,0,0,0);}
}
typedef __attribute__((address_space(3))) const char* lds_cptr;
typedef short v4i16_t __attribute__((ext_vector_type(4)));
__device__ __forceinline__ void kload8(bf16x8*kf,lds_cptr kp){
  kf[0]=*(const __attribute__((address_space(3))) bf16x8*)(kp);      kf[1]=*(const __attribute__((address_space(3))) bf16x8*)(kp+512);
  kf[2]=*(const __attribute__((address_space(3))) bf16x8*)(kp+2048); kf[3]=*(const __attribute__((address_space(3))) bf16x8*)(kp+2560);
  kf[4]=*(const __attribute__((address_space(3))) bf16x8*)(kp+4096); kf[5]=*(const __attribute__((address_space(3))) bf16x8*)(kp+4608);
  kf[6]=*(const __attribute__((address_space(3))) bf16x8*)(kp+6144); kf[7]=*(const __attribute__((address_space(3))) bf16x8*)(kp+6656);
}
__device__ __forceinline__ void kload2(bf16x8*kf,lds_cptr kp,int j){ kf[2*j]=*(const __attribute__((address_space(3))) bf16x8*)(kp+j*2048); kf[2*j+1]=*(const __attribute__((address_space(3))) bf16x8*)(kp+j*2048+512); }
__device__ __forceinline__ s16x4 vtr(lds_cptr p){ return __builtin_bit_cast(s16x4,__builtin_amdgcn_ds_read_tr16_b64_v4i16((__attribute__((address_space(3))) v4i16_t*)p)); }
__device__ __forceinline__ float rowmax(const f32x16&p0,const f32x16&p1){
  float a=max3f(p0[0],p0[1],p1[0]),b=max3f(p0[2],p0[3],p1[1]);a=max3f(a,p1[2],p1[3]);
  #pragma unroll
  for(int r=4;r<16;r+=4){a=max3f(a,p0[r],p0[r+1]);b=max3f(b,p0[r+2],p0[r+3]);a=max3f(a,p1[r],p1[r+1]);b=max3f(b,p1[r+2],p1[r+3]);}
  const float m=max2f(a,b);
  auto rr=__builtin_amdgcn_permlane32_swap(__float_as_uint(m),__float_as_uint(m),false,false);
  return max2f(__uint_as_float(rr[0]),__uint_as_float(rr[1]));
}
__device__ __forceinline__ void pv(f32x16*o,int vb,bf16x8 pa0,bf16x8 pa1,bf16x8 pa2,bf16x8 pa3){
  #pragma unroll
  for(int d0=0;d0<2;++d0){s16x4 lo[4],hi[4];
    #pragma unroll
    for(int ks=0;ks<4;++ks){
      asm volatile("ds_read_b64_tr_b16 %0,%1 offset:%c2":"=&v"(lo[ks]):"v"(vb),"i"(d0*4096+ks*1024):"memory");
      asm volatile("ds_read_b64_tr_b16 %0,%1 offset:%c2":"=&v"(hi[ks]):"v"(vb),"i"(d0*4096+ks*1024+512):"memory");}
    asm volatile("s_waitcnt lgkmcnt(0)":::"memory");SBAR();
    #define PK(k) (bf16x8){lo[k][0],lo[k][1],lo[k][2],lo[k][3],hi[k][0],hi[k][1],hi[k][2],hi[k][3]}
    o[d0]=__builtin_amdgcn_mfma_f32_32x32x16_bf16(pa0,PK(0),o[d0],0,0,0);
    o[d0]=__builtin_amdgcn_mfma_f32_32x32x16_bf16(pa1,PK(1),o[d0],0,0,0);
    o[d0]=__builtin_amdgcn_mfma_f32_32x32x16_bf16(pa2,PK(2),o[d0],0,0,0);
    o[d0]=__builtin_amdgcn_mfma_f32_32x32x16_bf16(pa3,PK(3),o[d0],0,0,0);
    #undef PK
  }
}

#ifndef ATTN_STORE16
#define ATTN_STORE16(p,v) (*(u32x4*)(p)=(v))
#endif
template<int THRL> __device__ __forceinline__ void attn_unit(int b,int h,int qb,const bf16*Q,const bf16*__restrict__ K,const bf16*__restrict__ V,bf16*O,const float*__restrict__ c2,float M2,char*shm){
  int tid=threadIdx.x; asm volatile("":"+v"(tid)); const int lane=tid&63,r32=lane&31,hi=lane>>5; const int wid=__builtin_amdgcn_readfirstlane(tid>>6);
  const long rowbase=(long)b*SEQ; const int q0=qb*QB;
  const bf16*Qw=Q+(rowbase+q0+wid*QBLK)*DM+h*D;
  const bf16*Kh0=K+rowbase*DM+h*D,*Vh0=V+rowbase*DM+h*D;
  const unsigned lds0=(unsigned)(uintptr_t)shm;
  float*wsf=(float*)(shm+LDS_WS)+wid*64;
  const unsigned kdst=lds0+LDS_K+wid*1024, vdst=lds0+LDS_V+wid*1024;
  #define DMA_K(t,slot) glds16(ksrc+(long)(t)*KVBLK*DM,(unsigned)__builtin_amdgcn_readfirstlane(kdst+(slot)))
  #define DMA_V(t,slot) glds16(vsrc+(long)(t)*KVBLK*DM,(unsigned)__builtin_amdgcn_readfirstlane(vdst+(slot)))
  const int vb0=(int)(lds0+LDS_V)+((lane>>4)&1)*32+(lane&3)*8+(4*hi+((lane&15)>>2))*64;
  const char*Kbase=shm+LDS_K; bf16x8 kf[8];
  const lds_cptr shm3=(lds_cptr)shm; const lds_cptr kp0=shm3+LDS_K+hi*1024+r32*16; const lds_cptr vp0=shm3+LDS_V+((lane>>4)&1)*32+(lane&3)*8+(4*hi+((lane&15)>>2))*64;
  const int NT0=(q0+QB)/KVBLK;
  int ts; { const int tl=lane; const float cqa=c2[q0]; const float ckb=(tl<NT0-4)?c2[64*tl+63]:cqa; const unsigned long long bm=__ballot((tl<NT0-4)&&(cqa-ckb< -(30.f+2.f*M2))); ts=__builtin_popcountll(bm)&~1; }
  ts=__builtin_amdgcn_readfirstlane(ts);
  const int NT=NT0-ts;
  const bf16*Kh=Kh0+(long)ts*KVBLK*DM,*Vh=Vh0+(long)ts*KVBLK*DM;
  const bf16*ksrc=Kh+(long)lane*DM+wid*8;
  const bf16*vsrc=Vh+(long)(16*(wid&3)+(lane>>2))*DM+(wid>>2)*32+(lane&3)*8;
  typedef float f32x4_t __attribute__((ext_vector_type(4)));
  int tidl=tid; asm volatile("":"+v"(tidl));
  const int nck4=(q0+QB)/4; f32x4_t ckv0=f32x4_t{},ckv1=f32x4_t{}; if(tidl<nck4)ckv0=((const f32x4_t*)c2)[tidl]; if(tidl+512<nck4)ckv1=((const f32x4_t*)c2)[tidl+512];
  const float cq=c2[q0+wid*QBLK+r32]-M2;
  DMA_K(0,0);DMA_V(0,0);DMA_K(1,SLOTB);
  bf16x8 qr[4];
  #pragma unroll
  for(int d0=0;d0<4;++d0)qr[d0]=*reinterpret_cast<const bf16x8*>(&Qw[(long)r32*DM+d0*16+hi*8]);
  float l_reg=0.f;f32x16 o[2];o[0]=f32x16{};o[1]=f32x16{};
  { __attribute__((address_space(3))) f32x4_t*ckl=(__attribute__((address_space(3))) f32x4_t*)((lds_cptr)shm+LDS_CK); if(tidl<nck4)ckl[tidl]=ckv0; if(tidl+512<nck4)ckl[tidl+512]=ckv1; }
  const __attribute__((address_space(3))) f32x4_t*ckp=(const __attribute__((address_space(3))) f32x4_t*)((lds_cptr)shm+LDS_CK)+hi+ts*16;
  #define CKLD(P0,P1,t) do{ _Pragma("unroll") for(int g_=0;g_<4;++g_){ const f32x4_t a_=ckp[(t)*16+2*g_], b_=ckp[(t)*16+8+2*g_]; P0[4*g_]=a_[0];P0[4*g_+1]=a_[1];P0[4*g_+2]=a_[2];P0[4*g_+3]=a_[3]; P1[4*g_]=b_[0];P1[4*g_+1]=b_[1];P1[4*g_+2]=b_[2];P1[4*g_+3]=b_[3]; } }while(0)
  #define CKSUB(P0,P1) do{ _Pragma("unroll") for(int r=0;r<16;++r){P0[r]=cq-P0[r];P1[r]=cq-P1[r];} }while(0)
  const int qrel=wid*QBLK+r32;
  #define CMASK(P0,P1,t) do{int jb_=(t)-(NT-4); if(jb_>=0)cmask(P0,P1,jb_,qrel,hi);}while(0)
  #define START(P0,P1) do{ _Pragma("unroll") for(int r=0;r<16;++r)P0[r]=__builtin_amdgcn_exp2f(P0[r]); }while(0)
  #define RESC() do{}while(0)
  f32x16 pA0,pA1,pB0,pB1;
  int sl_prev=0,sl_cur=0,sl_next=SLOTB;
  #define ROT() do{sl_prev=sl_cur;sl_cur=sl_next;sl_next=(sl_next==(NSLOT-1)*SLOTB)?0:sl_next+SLOTB;}while(0)
  DMA_K(2,2*SLOTB);
  WAIT_BAR(3);
  CKLD(pA0,pA1,0);CKSUB(pA0,pA1);
  qkt(pA0,pA1,Kbase,qr,r32,hi);asm volatile("s_nop 15\n\ts_nop 7":"+v"(pA0),"+v"(pA1));CMASK(pA0,pA1,0);
  CKLD(pB0,pB1,1);CKSUB(pB0,pB1);
  START(pA0,pA1);
  _Pragma("unroll") for(int r=0;r<16;++r)pA1[r]=__builtin_amdgcn_exp2f(pA1[r]);
  WAIT_BAR(0);
  DMA_K(3,0);DMA_V(1,SLOTB);
  ROT();
  kload8(kf,kp0+sl_cur);
  WAIT_BAR(2);
  s16x4 vlo[8],vhi[8]; u32x4 pw0,pw1,pw2,pw3;
  #define PKW(P,B) cvtpk_s(P[B],P[B+1])
  #define PAF(k) __builtin_bit_cast(bf16x8,pw##k)
  #define VFR(i) (bf16x8){vlo[i][0],vlo[i][1],vlo[i][2],vlo[i][3],vhi[i][0],vhi[i][1],vhi[i][2],vhi[i][3]}
  #define PIN(x) asm volatile("":"+v"(x))
  #define MX3(a,b,c) __builtin_fmaxf(__builtin_fmaxf((a),(b)),(c))
  #define GAPA(MF,A0,A1,A2,A3,W0,W1,PW) do{ MF; sacc+=A0; sacc+=A1; sacc+=A2; sacc+=A3; PIN(sacc); W0; W1; PIN(PW); SBAR(); }while(0)
  #define EX(v) __builtin_amdgcn_exp2f(v)
  #define GAPB(MF,X,B) do{ MF; X[B]=EX(X[B]); X[B+1]=EX(X[B+1]); X[B+2]=EX(X[B+2]); X[B+3]=EX(X[B+3]); PIN(X); SBAR(); }while(0)
  #define VRD(i) do{ vlo[i]=vtr(vp_+(((i)>>2)*4096+((i)&3)*1024)); vhi[i]=vtr(vp_+(((i)>>2)*4096+((i)&3)*1024+512)); }while(0)
  #define KRD(G,j) do{ if(G){ kload2(kf,kp0+sl_next,j); SBAR(); } }while(0)
  #define STEP(C0,C1,P0,P1,t,GK,GV,GL) do{ SBAR(); \
    const lds_cptr vp_=vp0+sl_prev; \
    VRD(0); SBAR(); float sacc=(P0[0]+P0[1]); \
    GAPA(C0=__builtin_amdgcn_mfma_f32_32x32x16_bf16(kf[0],qr[0],C0,0,0,0), P0[2],P0[3],P0[4],P0[5],     pw0[0]=PKW(P0,0), pw0[1]=PKW(P0,2), pw0); \
    VRD(4); SBAR(); GAPA(C1=__builtin_amdgcn_mfma_f32_32x32x16_bf16(kf[1],qr[0],C1,0,0,0), P0[6],P0[7],P0[8],P0[9],     pw0[2]=PKW(P0,4), pw0[3]=PKW(P0,6), pw0); \
    VRD(1); SBAR(); GAPA(C0=__builtin_amdgcn_mfma_f32_32x32x16_bf16(kf[2],qr[1],C0,0,0,0),   P0[10],P0[11],P0[12],P0[13], pw1[0]=PKW(P0,8), pw1[1]=PKW(P0,10), pw1); \
    VRD(5); SBAR(); GAPA(C1=__builtin_amdgcn_mfma_f32_32x32x16_bf16(kf[3],qr[1],C1,0,0,0),   P0[14],P0[15],P1[0],P1[1],   pw1[2]=PKW(P0,12),pw1[3]=PKW(P0,14), pw1); \
    VRD(2); SBAR(); GAPA(C0=__builtin_amdgcn_mfma_f32_32x32x16_bf16(kf[4],qr[2],C0,0,0,0),   P1[2],P1[3],P1[4],P1[5],     pw2[0]=PKW(P1,0), pw2[1]=PKW(P1,2), pw2); \
    VRD(6); SBAR(); GAPA(C1=__builtin_amdgcn_mfma_f32_32x32x16_bf16(kf[5],qr[2],C1,0,0,0),   P1[6],P1[7],P1[8],P1[9],     pw2[2]=PKW(P1,4), pw2[3]=PKW(P1,6), pw2); \
    VRD(3); SBAR(); GAPA(C0=__builtin_amdgcn_mfma_f32_32x32x16_bf16(kf[6],qr[3],C0,0,0,0),   P1[10],P1[11],P1[12],P1[13], pw3[0]=PKW(P1,8), pw3[1]=PKW(P1,10), pw3); \
    VRD(7); SBAR(); GAPA(C1=__builtin_amdgcn_mfma_f32_32x32x16_bf16(kf[7],qr[3],C1,0,0,0),   P1[14],P1[15],0.f,0.f,       pw3[2]=PKW(P1,12),pw3[3]=PKW(P1,14), pw3); \
    l_reg+=sacc; \
    if(GK){DMA_K((t)+3,sl_cur);} if(GV){DMA_V((t)+1,sl_next);} \
    CMASK(C0,C1,t); \
    SBAR(); \
    GAPB(o[0]=__builtin_amdgcn_mfma_f32_32x32x16_bf16(PAF(0),VFR(0),o[0],0,0,0), C0,0); \
    GAPB(o[1]=__builtin_amdgcn_mfma_f32_32x32x16_bf16(PAF(0),VFR(4),o[1],0,0,0), C0,4); \
    KRD(GL,0); GAPB(o[0]=__builtin_amdgcn_mfma_f32_32x32x16_bf16(PAF(1),VFR(1),o[0],0,0,0), C0,8); \
    KRD(GL,1); GAPB(o[1]=__builtin_amdgcn_mfma_f32_32x32x16_bf16(PAF(1),VFR(5),o[1],0,0,0), C0,12); \
    KRD(GL,2); GAPB(o[0]=__builtin_amdgcn_mfma_f32_32x32x16_bf16(PAF(2),VFR(2),o[0],0,0,0), C1,0); \
    KRD(GL,3); GAPB(o[1]=__builtin_amdgcn_mfma_f32_32x32x16_bf16(PAF(2),VFR(6),o[1],0,0,0), C1,4); \
    GAPB(o[0]=__builtin_amdgcn_mfma_f32_32x32x16_bf16(PAF(3),VFR(3),o[0],0,0,0), C1,8); \
    GAPB(o[1]=__builtin_amdgcn_mfma_f32_32x32x16_bf16(PAF(3),VFR(7),o[1],0,0,0), C1,12); \
    if(GL){ CKLD(P0,P1,(t)+1); CKSUB(P0,P1); } \
    }while(0)
  int t=1;
  #undef CMASK
  #define CMASK(P0,P1,t) do{}while(0)
  for(;t+5<NT;t+=2){
    STEP(pB0,pB1,pA0,pA1,t,true,true,true);     WAIT_BAR(2); RESC(); ROT();
    STEP(pA0,pA1,pB0,pB1,t+1,true,true,true);   WAIT_BAR(2); RESC(); ROT();
  }
  #undef CMASK
  #define CMASK(P0,P1,t) do{int jb_=(t)-(NT-4); if(jb_>=0)cmask(P0,P1,jb_,qrel,hi);}while(0)
  #define ENDW(tt) do{ if((tt)+3<NT){WAIT_BAR(2);} else if((tt)+2<NT){WAIT_BAR(1);} else {WAIT_BAR(0);} }while(0)
  for(;t+1<NT;t+=2){
    STEP(pB0,pB1,pA0,pA1,t,(t+3<NT),(t+1<NT),(t+1<NT));       ENDW(t);   RESC(); ROT();
    STEP(pA0,pA1,pB0,pB1,t+1,(t+4<NT),(t+2<NT),(t+2<NT));     ENDW(t+1); RESC(); ROT();
  }
  STEP(pB0,pB1,pA0,pA1,NT-1,false,false,false); RESC();
  { float sacc=pB0[0]+pB0[1]; _Pragma("unroll") for(int r=2;r<16;++r)sacc+=pB0[r]; _Pragma("unroll") for(int r=0;r<16;++r)sacc+=pB1[r]; l_reg+=sacc;
    pw0=(u32x4){PKW(pB0,0),PKW(pB0,2),PKW(pB0,4),PKW(pB0,6)};pw1=(u32x4){PKW(pB0,8),PKW(pB0,10),PKW(pB0,12),PKW(pB0,14)};pw2=(u32x4){PKW(pB1,0),PKW(pB1,2),PKW(pB1,4),PKW(pB1,6)};pw3=(u32x4){PKW(pB1,8),PKW(pB1,10),PKW(pB1,12),PKW(pB1,14)};
    SBAR(); pv(o,vb0+sl_cur,PAF(0),PAF(1),PAF(2),PAF(3)); }
  #undef PKW
  #undef PAF
  #undef VFR
  #undef PIN
  #undef MX3
  #undef GAPA
  #undef GAPB
  #undef EX
  #undef VRD
  #undef KRD
  #undef STEP
  #undef ENDW
  {auto rr=__builtin_amdgcn_permlane32_swap(__float_as_uint(l_reg),__float_as_uint(l_reg),false,false);l_reg=__uint_as_float(rr[0])+__uint_as_float(rr[1]);}
  if(hi==0)wsf[32+r32]=l_reg;asm volatile("s_waitcnt lgkmcnt(0)":::"memory");
  float rli[16];
  #pragma unroll
  for(int r=0;r<16;++r)rli[r]=__builtin_amdgcn_rcpf(wsf[32+crow(r,hi)]);
  bf16*Ow=O+(rowbase+q0+wid*QBLK)*DM+h*D;
  { bf16*stg=(bf16*)(shm+LDS_OST)+wid*2048;
    #pragma unroll
    for(int r=0;r<16;++r){const int orow=crow(r,hi);
      #pragma unroll
      for(int d0=0;d0<2;++d0)stg[orow*64+d0*32+r32]=__float2bfloat16(o[d0][r]*rli[r]);}
    asm volatile("s_waitcnt lgkmcnt(0)":::"memory");
    #pragma unroll
    for(int i=0;i<4;++i){const int row=i*8+(lane>>3),ch=lane&7; const u32x4 v=*(const u32x4*)(stg+row*64+ch*8); ATTN_STORE16(Ow+(long)row*DM+ch*8,v);} }
  asm volatile("s_waitcnt lgkmcnt(0)\n\ts_barrier":::"memory");
  #undef DMA_K
  #undef DMA_V
  #undef CMASK
  #undef START
  #undef RESC
  #undef ROT
  #undef CKLD
  #undef CKSUB
}
constexpr int ATTN_LDS_BYTES=LDS_BYTES;
struct AttnTensors { const bf16* Q; const bf16* K; const bf16* V; bf16* O; const float* C2T; float M2; };
struct AttnUnit { int bh; int qb; };
struct StaticOrder {
  int vcu, G;
  __device__ __forceinline__ explicit StaticOrder(int grid,int v):vcu(v),G(grid){}
  __device__ __forceinline__ bool next(int i,AttnUnit&u)const{ const int L=i*G+vcu; if(L>=BATCH*NHEAD*NQB)return false; const int r=L>>8, idx=L&255, k=idx&7; u.bh=idx>>3; u.qb=(r==0)?(NQB-1-k):k; return true; }
  __device__ __forceinline__ void a_ready(const AttnUnit&)const{}
  __device__ __forceinline__ void done(const AttnUnit&)const{}
};
template<class Sched,int THRL=8> __device__ __forceinline__ void attn_phase(char*lds,const AttnTensors&T,const Sched&S){
  AttnUnit u;
  for(int i=0;S.next(i,u);++i){ S.a_ready(u); attn_unit<THRL>(u.bh/NHEAD,u.bh%NHEAD,u.qb,T.Q,T.K,T.V,T.O,T.C2T+(size_t)u.bh*SEQ,T.M2,lds); S.done(u); }
}
#undef SBAR
#undef WAIT_BAR
}

constexpr int NWAVES = 8, NTHR = 512;
constexpr int DM = 1024, NB = 4, SEQ = 4096, DB = 128, DSEQ = 8, PAST = 2048, PAGE = 128, NPAGES = 16;
constexpr int MP = NB * SEQ, MS = DB * DSEQ, M = MP + MS;
constexpr int DP = 512, DA = 512, NH = 8, HD = 64, DIN = 4104, NPROJ = 4096;
constexpr int NKEYS = 128, NEXP = 16384, PH = 8, TOPK = 16, DKH = 128, DQ = 2048;
constexpr float EPS = 1e-6f;
constexpr float LOG2E = 1.4426950408889634f;
constexpr float C2 = 0.125f * LOG2E;
constexpr size_t O_YP = 0, O_YS = O_YP + (size_t)MP * DM, O_KP = O_YS + (size_t)MS * DM, O_VP = O_KP + (size_t)MP * DA, O_LFP = O_VP + (size_t)MP * DA,
                 O_PP = O_LFP + (size_t)MP * NH, O_KS = O_PP + (size_t)NB * 15 * DP, O_VS = O_KS + (size_t)MS * DA, O_LFS = O_VS + (size_t)MS * DA,
                 O_PS = O_LFS + (size_t)MS * NH, O_END = O_PS + (size_t)DB * 15 * DP;
constexpr size_t MiB = 1u << 20;
constexpr size_t WS_CTL = 0, CTL_ZERO_BYTES = 1 * MiB;
constexpr size_t WS_WIN = 2 * MiB, WS_WBP = 10 * MiB, WS_WBA = 11 * MiB, WS_WOUT = 12 * MiB, WS_WQ = 14 * MiB, WS_SUBK = 18 * MiB, WS_CP2 = 19 * MiB, WS_RSS = 20 * MiB, WS_US = 22 * MiB, WS_VS = 23 * MiB;
constexpr size_t WS_PU = 32 * MiB, WS_PV = 64 * MiB, WS_XN = 96 * MiB  , WS_U = 132 * MiB, WS_Q = 150 * MiB, WS_K = 168 * MiB, WS_V = 186 * MiB,
                 WS_GA = 204 * MiB, WS_GB = 240 * MiB, WS_PO = 276 * MiB, WS_AO = 294 * MiB, WS_T = 312 * MiB, WS_MIX = 348 * MiB, WS_PQ = 384 * MiB,
                 WS_SI = 456 * MiB, WS_SG = 466 * MiB, WS_H = 476 * MiB, WS_END = 548 * MiB;
constexpr int CW_BAR = 4096;
constexpr int LDS_BYTES = 163840;
constexpr int SCR_BYTES = 159 * 1024;
constexpr int MISC_OFF = SCR_BYTES;

typedef unsigned short bf16;
typedef unsigned v4u __attribute__((ext_vector_type(4)));
typedef unsigned v2u __attribute__((ext_vector_type(2)));
typedef float f32x4 __attribute__((ext_vector_type(4)));
typedef float f32x2 __attribute__((ext_vector_type(2)));

__device__ __forceinline__ float bf2f(unsigned short b) { return __uint_as_float((unsigned)b << 16); }
__device__ __forceinline__ float bflo(unsigned w) { return __uint_as_float(w << 16); }
__device__ __forceinline__ float bfhi(unsigned w) { return __uint_as_float(w & 0xffff0000u); }
typedef __bf16 bf16x2_t __attribute__((ext_vector_type(2)));
__device__ __forceinline__ unsigned pkbf(float lo, float hi) { f32x2 v = {lo, hi}; bf16x2_t b = __builtin_convertvector(v, bf16x2_t); return __builtin_bit_cast(unsigned, b); }
__device__ __forceinline__ float wave_sum(float v) {
#pragma unroll
    for (int o = 1; o < 64; o <<= 1) v += __shfl_xor(v, o);
    return v;
}
__device__ __forceinline__ float wave_max(float v) {
#pragma unroll
    for (int o = 1; o < 64; o <<= 1) v = fmaxf(v, __shfl_xor(v, o));
    return v;
}

struct Args {
    const float* x_p; const float* x_s; const float* cache_k; const float* cache_v; const float* cache_lf; const float* state_pool; const int* page_table;
    const float* norm_mix_g; const float* w_in; const float* b_forget; const float* q_norm_g; const float* k_norm_g; const float* pool_mix_w; const float* pool_scale;
    const float* w_bp; const float* w_ba; const float* w_out; const float* norm_ffn_g; const float* w_query; const float* sub_keys; const float* peer_u; const float* peer_v;
    float* out; unsigned char* ws; int ph_lo, ph_hi, li, pad;
};

using pg8::Unit;
struct EpiInProj {
    static constexpr bool PERM = true, AFTER_DRAIN = false;
    bf16 *U, *Q, *K, *V, *GA, *GB; float* out; const float *gq, *gk; int pn_off;
    __device__ __forceinline__ void operator()(const f32x4 (&acc)[2][2][4][2], const Unit& u, int wr, int wc, int fr, int fq) const {
        const int pn = u.pn + pn_off; const int row0 = u.pm * 256 + wr * 64 + fr; const bool prompt = u.pm < (MP / 256);
        if (pn < 2) {
#pragma unroll
            for (int ai = 0; ai < 2; ++ai)
#pragma unroll
                for (int m = 0; m < 4; ++m) { const int row = row0 + ai * 128 + m * 16;
                    float* tail = nullptr;
                    if (prompt) { const int s = row & (SEQ - 1), b = row >> 12; if (s >= SEQ - 15) tail = out + O_PP + (size_t)(b * 15 + (s - (SEQ - 15))) * DP; }
                    else { const int rs = row - MP; tail = out + O_PS + (size_t)((rs >> 3) * 15 + 7 + (rs & 7)) * DP; }
#pragma unroll
                    for (int bj = 0; bj < 2; ++bj) { const int col = pn * 256 + bj * 128 + wc * 32 + 8 * fq; const f32x4 v0 = acc[ai][bj][m][0], v1 = acc[ai][bj][m][1];
                        v4u w; w.x = pkbf(v0[0], v0[1]); w.y = pkbf(v0[2], v0[3]); w.z = pkbf(v1[0], v1[1]); w.w = pkbf(v1[2], v1[3]);
                        *(v4u*)(U + (size_t)row * DP + col) = w;
                        if (tail) { *(f32x4*)(tail + col) = v0; *(f32x4*)(tail + col + 4) = v1; } } }
        } else if (pn < 6) {
            const bool isq = pn < 4; const int head = 4 * (pn & 1) + wc; const float* g = isq ? gq : gk;
            f32x4 gv[2][2];
#pragma unroll
            for (int bj = 0; bj < 2; ++bj)
#pragma unroll
                for (int n = 0; n < 2; ++n) gv[bj][n] = *(const f32x4*)(g + 32 * bj + 8 * fq + 4 * n);
            bf16* dst = isq ? Q : K;
#pragma unroll
            for (int ai = 0; ai < 2; ++ai)
#pragma unroll
                for (int m = 0; m < 4; ++m) { const int row = row0 + ai * 128 + m * 16; float ss = 0.f;
#pragma unroll
                    for (int bj = 0; bj < 2; ++bj)
#pragma unroll
                        for (int n = 0; n < 2; ++n) { const f32x4 x = acc[ai][bj][m][n]; ss += (x[0] * x[0] + x[1] * x[1]) + (x[2] * x[2] + x[3] * x[3]); }
                    ss += __shfl_xor(ss, 16); ss += __shfl_xor(ss, 32);
                    float r = 1.0f / sqrtf(ss * (1.0f / 64.0f) + EPS);
                    float* kout = isq ? nullptr : (prompt ? out + O_KP + (size_t)row * DA : out + O_KS + (size_t)(row - MP) * DA);
                    const float rq = isq ? r * C2 : r;
#pragma unroll
                    for (int bj = 0; bj < 2; ++bj) { const int col = head * 64 + 32 * bj + 8 * fq; const f32x4 v0 = acc[ai][bj][m][0] * gv[bj][0] * rq, v1 = acc[ai][bj][m][1] * gv[bj][1] * rq;
                        v4u w; w.x = pkbf(v0[0], v0[1]); w.y = pkbf(v0[2], v0[3]); w.z = pkbf(v1[0], v1[1]); w.w = pkbf(v1[2], v1[3]);
                        *(v4u*)(dst + (size_t)row * DA + col) = w;
                        if (!isq) { *(f32x4*)(kout + col) = v0; *(f32x4*)(kout + col + 4) = v1; } } }
        } else if (pn < 8) {
#pragma unroll
            for (int ai = 0; ai < 2; ++ai)
#pragma unroll
                for (int m = 0; m < 4; ++m) { const int row = row0 + ai * 128 + m * 16;
                    float* vout = prompt ? out + O_VP + (size_t)row * DA : out + O_VS + (size_t)(row - MP) * DA;
#pragma unroll
                    for (int bj = 0; bj < 2; ++bj) { const int col = (pn - 6) * 256 + bj * 128 + wc * 32 + 8 * fq; const f32x4 v0 = acc[ai][bj][m][0], v1 = acc[ai][bj][m][1];
                        v4u w; w.x = pkbf(v0[0], v0[1]); w.y = pkbf(v0[2], v0[3]); w.z = pkbf(v1[0], v1[1]); w.w = pkbf(v1[2], v1[3]);
                        *(v4u*)(V + (size_t)row * DA + col) = w; *(f32x4*)(vout + col) = v0; *(f32x4*)(vout + col + 4) = v1; } }
        } else {
            bf16* dst = pn < 12 ? GA : GB; const int ct = (pn < 12 ? pn - 8 : pn - 12) * 256;
#pragma unroll
            for (int ai = 0; ai < 2; ++ai)
#pragma unroll
                for (int m = 0; m < 4; ++m) { const int row = row0 + ai * 128 + m * 16;
#pragma unroll
                    for (int bj = 0; bj < 2; ++bj) { const int col = ct + bj * 128 + wc * 32 + 8 * fq; float s[8];
#pragma unroll
                        for (int n = 0; n < 2; ++n)
#pragma unroll
                            for (int i = 0; i < 4; ++i) s[4 * n + i] = __builtin_amdgcn_rcpf(1.0f + __builtin_amdgcn_exp2f(-LOG2E * acc[ai][bj][m][n][i]));
                        v4u w; w.x = pkbf(s[0], s[1]); w.y = pkbf(s[2], s[3]); w.z = pkbf(s[4], s[5]); w.w = pkbf(s[6], s[7]);
                        *(v4u*)(dst + (size_t)row * DM + col) = w; } }
        }
    }
};
template <int MODE> struct EpiGate {
    static constexpr bool PERM = true, AFTER_DRAIN = false;
    const bf16* G; const bf16* Tin; bf16* O;
    __device__ __forceinline__ void operator()(const f32x4 (&acc)[2][2][4][2], const Unit& u, int wr, int wc, int fr, int fq) const {
        const int row0 = u.pm * 256 + wr * 64 + fr;
#pragma unroll
        for (int ai = 0; ai < 2; ++ai)
#pragma unroll
            for (int m = 0; m < 4; ++m) { const int row = row0 + ai * 128 + m * 16;
#pragma unroll
                for (int bj = 0; bj < 2; ++bj) { const size_t off = (size_t)row * DM + u.pn * 256 + bj * 128 + wc * 32 + 8 * fq;
                    const v4u g = *(const v4u*)(G + off); const f32x4 v0 = acc[ai][bj][m][0], v1 = acc[ai][bj][m][1];
                    float r[8] = {v0[0] * bflo(g.x), v0[1] * bfhi(g.x), v0[2] * bflo(g.y), v0[3] * bfhi(g.y), v1[0] * bflo(g.z), v1[1] * bfhi(g.z), v1[2] * bflo(g.w), v1[3] * bfhi(g.w)};
                    if (MODE == 1) { const v4u t = *(const v4u*)(Tin + off);
                        r[0] += bflo(t.x); r[1] += bfhi(t.x); r[2] += bflo(t.y); r[3] += bfhi(t.y); r[4] += bflo(t.z); r[5] += bfhi(t.z); r[6] += bflo(t.w); r[7] += bfhi(t.w); }
                    v4u w; w.x = pkbf(r[0], r[1]); w.y = pkbf(r[2], r[3]); w.z = pkbf(r[4], r[5]); w.w = pkbf(r[6], r[7]);
                    *(v4u*)(O + off) = w; } }
    }
};
struct EpiOut {
    static constexpr bool PERM = true, AFTER_DRAIN = false;
    const float* xp; const float* xs; float* H; bf16* HG; const float* gf; float* RSS;
    __device__ __forceinline__ void operator()(const f32x4 (&acc)[2][2][4][2], const Unit& u, int wr, int wc, int fr, int fq) const {
        const int row0 = u.pm * 256 + wr * 64 + fr; const bool prompt = u.pm < (MP / 256);
        f32x4 gv[2][2];
#pragma unroll
        for (int bj = 0; bj < 2; ++bj)
#pragma unroll
            for (int n = 0; n < 2; ++n) gv[bj][n] = *(const f32x4*)(gf + u.pn * 256 + bj * 128 + wc * 32 + 8 * fq + 4 * n);
#pragma unroll
        for (int ai = 0; ai < 2; ++ai)
#pragma unroll
            for (int m = 0; m < 4; ++m) { const int row = row0 + ai * 128 + m * 16; float ss = 0.f;
                const float* xr = prompt ? xp + (size_t)row * DM : xs + (size_t)(row - MP) * DM;
#pragma unroll
                for (int bj = 0; bj < 2; ++bj) { const int col = u.pn * 256 + bj * 128 + wc * 32 + 8 * fq;
                    const f32x4 h0 = acc[ai][bj][m][0] + *(const f32x4*)(xr + col), h1 = acc[ai][bj][m][1] + *(const f32x4*)(xr + col + 4);
                    ss += (h0[0] * h0[0] + h0[1] * h0[1]) + (h0[2] * h0[2] + h0[3] * h0[3]) + (h1[0] * h1[0] + h1[1] * h1[1]) + (h1[2] * h1[2] + h1[3] * h1[3]);
                    *(f32x4*)(H + (size_t)row * DM + col) = h0; *(f32x4*)(H + (size_t)row * DM + col + 4) = h1;
                    const f32x4 a0 = h0 * gv[bj][0], a1 = h1 * gv[bj][1];
                    v4u w; w.x = pkbf(a0[0], a0[1]); w.y = pkbf(a0[2], a0[3]); w.z = pkbf(a1[0], a1[1]); w.w = pkbf(a1[2], a1[3]);
                    *(v4u*)(HG + (size_t)row * DM + col) = w; }
                ss += __shfl_xor(ss, 16); ss += __shfl_xor(ss, 32);
                if (fq == 0) RSS[(size_t)row * 16 + u.pn * 4 + wc] = ss; }
    }
};

struct Frame {
    LAS unsigned char* lds; volatile LAS unsigned* MISC; gu32* ctl;
    int tid, lane, wave, vcu, G;
};

__device__ __forceinline__ void transpose_item(const float* W, int ldw, int K, bf16* WT, int src_col0, int dst_row0, int k0, LAS float* scr, int lane) {
#pragma unroll 8
    for (int i = 0; i < 32; ++i) { const int kk = 2 * i + (lane >> 5); scr[kk * 33 + (lane & 31)] = W[(size_t)(k0 + kk) * ldw + src_col0 + (lane & 31)]; }
    LDS_WAIT(); asm volatile("" ::: "memory");
    const int c = lane & 7;
#pragma unroll
    for (int j = 0; j < 4; ++j) { const int n = (lane >> 3) + 8 * j; const LAS float* s = scr + (8 * c) * 33 + n;
        v4u o; o.x = pkbf(s[0 * 33], s[1 * 33]); o.y = pkbf(s[2 * 33], s[3 * 33]); o.z = pkbf(s[4 * 33], s[5 * 33]); o.w = pkbf(s[6 * 33], s[7 * 33]);
        *(v4u*)(WT + (size_t)(dst_row0 + n) * K + k0 + 8 * c) = o; }
    LDS_WAIT(); asm volatile("" ::: "memory");
}
__device__ __forceinline__ int win_src_col(int db) {
    if (db < 16) return 32 * db;
    if (db < 48) { const int base = db < 32 ? 512 : 1024; const int local = (db - 16) & 15, tile = local >> 3, blk = local & 7, bj = blk >> 2, w = blk & 3; return base + tile * 256 + 64 * w + 32 * bj; }
    if (db < 64) return 1536 + 32 * (db - 48);
    if (db < 96) return 2056 + 32 * (db - 64);
    return 3080 + 32 * (db - 96);
}
__device__ __forceinline__ void cvt_rows_bf16(const float* src, bf16* dst, size_t n8, size_t gtid, size_t gn) {
    for (size_t i = gtid; i < n8; i += gn) { const f32x4 a = *(const f32x4*)(src + 8 * i), b = *(const f32x4*)(src + 8 * i + 4);
        v4u w; w.x = pkbf(a[0], a[1]); w.y = pkbf(a[2], a[3]); w.z = pkbf(b[0], b[1]); w.w = pkbf(b[2], b[3]); *(v4u*)(dst + 8 * i) = w; }
}
__device__ __forceinline__ void cvt_rows_fp8(const float* src, unsigned char* dst, float* scl, int gw, int NGW, int lane) {
    for (int e0 = gw; e0 < NEXP; e0 += 2 * NGW) {
        f32x4 q[2][4]; float mx[2];
#pragma unroll
        for (int u = 0; u < 2; ++u) { const int e = (e0 + u * NGW < NEXP) ? e0 + u * NGW : e0; const float* r = src + (size_t)e * DM + 16 * lane;
            q[u][0] = *(const f32x4*)r; q[u][1] = *(const f32x4*)(r + 4); q[u][2] = *(const f32x4*)(r + 8); q[u][3] = *(const f32x4*)(r + 12); }
#pragma unroll
        for (int u = 0; u < 2; ++u) { float m = 0.f;
#pragma unroll
            for (int j = 0; j < 4; ++j) m = fmaxf(m, fmaxf(fmaxf(fabsf(q[u][j][0]), fabsf(q[u][j][1])), fmaxf(fabsf(q[u][j][2]), fabsf(q[u][j][3]))));
            mx[u] = m; }
#pragma unroll
        for (int o = 1; o < 64; o <<= 1) { mx[0] = fmaxf(mx[0], __shfl_xor(mx[0], o)); mx[1] = fmaxf(mx[1], __shfl_xor(mx[1], o)); }
#pragma unroll
        for (int u = 0; u < 2; ++u) { const int e = e0 + u * NGW; if (e < NEXP) {
            int k = 0; if (mx[u] > 1e-30f) k = 7 - ((int)((__builtin_bit_cast(unsigned, mx[u]) >> 23) & 0xffu) - 127);
            k = k < -100 ? -100 : (k > 100 ? 100 : k);
            const float sc = __builtin_bit_cast(float, (unsigned)(k + 127) << 23), isc = __builtin_bit_cast(float, (unsigned)(127 - k) << 23);
            int w[4];
#pragma unroll
            for (int j = 0; j < 4; ++j) { w[j] = 0; w[j] = __builtin_amdgcn_cvt_pk_fp8_f32(q[u][j][0] * sc, q[u][j][1] * sc, w[j], false); w[j] = __builtin_amdgcn_cvt_pk_fp8_f32(q[u][j][2] * sc, q[u][j][3] * sc, w[j], true); }
            *(v4u*)(dst + (size_t)(lane >> 3) * ((size_t)NEXP * 128) + (size_t)e * 128 + 16 * (lane & 7)) = (v4u){(unsigned)w[0], (unsigned)w[1], (unsigned)w[2], (unsigned)w[3]};
            if (lane == 0) scl[e] = isc; } }
    }
}
__device__ __forceinline__ void p0_prologue(Frame& F, const Args& a) {
    unsigned char* ws = a.ws;
    LAS float* scr = (LAS float*)(F.lds + F.wave * 16384);
    const int gw = F.vcu * NWAVES + F.wave, NGW = F.G * NWAVES;
    for (int it = gw; it < 4096; it += NGW) {
        int r = it;
        if (r < 2048) { const int kb = r >> 7, db = r & 127; transpose_item(a.w_in, DIN, DM, (bf16*)(ws + WS_WIN), win_src_col(db), 32 * db, 64 * kb, scr, F.lane); continue; } r -= 2048;
        if (r < 256) { continue; } r -= 256;
        if (r < 256) { const int kb = r >> 5, nb = r & 31; transpose_item(a.w_ba, DM, DA, (bf16*)(ws + WS_WBA), 32 * nb, 32 * nb, 64 * kb, scr, F.lane); continue; } r -= 256;
        if (r < 512) { const int kb = r >> 5, nb = r & 31; transpose_item(a.w_out, DM, DM, (bf16*)(ws + WS_WOUT), 32 * nb, 32 * nb, 64 * kb, scr, F.lane); continue; } r -= 512;
        { const int kb = r >> 6, nb = r & 63; transpose_item(a.w_query, DQ, DM, (bf16*)(ws + WS_WQ), 32 * nb, 32 * nb, 64 * kb, scr, F.lane); }
    }
    for (int it = gw; it < 16 * 4 * 16; it += NGW) { const int nb = it & 15, g = (it >> 4) & 3, cb = it >> 6; const int nn = 64 * nb + F.lane; float acc8[8];
#pragma unroll
        for (int i = 0; i < 8; ++i) acc8[i] = 0.f;
        const float* pm = a.pool_mix_w + (size_t)g * 16384 + (size_t)(8 * cb) * 128;
#pragma unroll 16
        for (int d = 0; d < 128; ++d) { const float wv = a.w_bp[(size_t)(g * 128 + d) * DM + nn] * a.pool_scale[g * 128 + d];
#pragma unroll
            for (int i = 0; i < 8; ++i) acc8[i] += pm[i * 128 + d] * wv; }
        v4u o; o.x = pkbf(acc8[0], acc8[1]); o.y = pkbf(acc8[2], acc8[3]); o.z = pkbf(acc8[4], acc8[5]); o.w = pkbf(acc8[6], acc8[7]);
        *(v4u*)((bf16*)(ws + WS_WBP) + (size_t)nn * DP + g * 128 + 8 * cb) = o; }
    { const size_t gtid = (size_t)F.vcu * NTHR + F.tid, gn = (size_t)F.G * NTHR;
      cvt_rows_fp8(a.peer_u, ws + WS_PU, (float*)(ws + WS_US), gw, NGW, F.lane);
      cvt_rows_fp8(a.peer_v, ws + WS_PV, (float*)(ws + WS_VS), gw, NGW, F.lane);
      cvt_rows_bf16(a.sub_keys, (bf16*)(ws + WS_SUBK), (size_t)PH * 2 * NKEYS * DKH / 8, gtid, gn);
      for (size_t i = gtid; i < (size_t)DB * 7 * DP; i += gn) { const int b = (int)(i / (7 * DP)), j = (int)((i / DP) % 7), c = (int)(i % DP);
          a.out[O_PS + (size_t)(b * 15 + j) * DP + c] = a.state_pool[(size_t)(b * 15 + 8 + j) * DP + c]; } }
    __syncthreads();
    LAS float* wfT = (LAS float*)F.lds;
    for (int i = F.tid; i < 8 * DM; i += NTHR) { const int col = i >> 3, h = i & 7; wfT[h * DM + col] = a.w_in[(size_t)col * DIN + 2048 + h]; }
    __syncthreads();
    bf16* XN = (bf16*)(ws + WS_XN);
    for (int row0 = gw; row0 < M; row0 += 2 * NGW) {
        f32x4 v[2][4]; float rr[2], f[2][8]; bool ok[2];
#pragma unroll
        for (int u = 0; u < 2; ++u) { const int row = row0 + u * NGW; ok[u] = row < M; const int rc = ok[u] ? row : row0;
            const float* xr = rc < MP ? a.x_p + (size_t)rc * DM : a.x_s + (size_t)(rc - MP) * DM;
#pragma unroll
            for (int j = 0; j < 4; ++j) v[u][j] = *(const f32x4*)(xr + 256 * j + 4 * F.lane); }
#pragma unroll
        for (int u = 0; u < 2; ++u) { float ss = 0.f;
#pragma unroll
            for (int j = 0; j < 4; ++j) ss += (v[u][j][0] * v[u][j][0] + v[u][j][1] * v[u][j][1]) + (v[u][j][2] * v[u][j][2] + v[u][j][3] * v[u][j][3]);
            rr[u] = ss; }
#pragma unroll
        for (int o = 1; o < 64; o <<= 1) { rr[0] += __shfl_xor(rr[0], o); rr[1] += __shfl_xor(rr[1], o); }
#pragma unroll
        for (int u = 0; u < 2; ++u) { const int row = ok[u] ? row0 + u * NGW : row0; const float r = 1.0f / sqrtf(rr[u] * (1.0f / DM) + EPS);
#pragma unroll
            for (int h = 0; h < 8; ++h) f[u][h] = 0.f;
#pragma unroll
            for (int j = 0; j < 4; ++j) { const f32x4 g = *(const f32x4*)(a.norm_mix_g + 256 * j + 4 * F.lane); v[u][j] = v[u][j] * r * g;
                v2u w; w.x = pkbf(v[u][j][0], v[u][j][1]); w.y = pkbf(v[u][j][2], v[u][j][3]); if (ok[u]) *(v2u*)(XN + (size_t)row * DM + 256 * j + 4 * F.lane) = w;
#pragma unroll
                for (int h = 0; h < 8; ++h) { const f32x4 wv = *(const LAS f32x4*)(wfT + h * DM + 256 * j + 4 * F.lane); f[u][h] += (v[u][j][0] * wv[0] + v[u][j][1] * wv[1]) + (v[u][j][2] * wv[2] + v[u][j][3] * wv[3]); } } }
#pragma unroll
        for (int u = 0; u < 2; ++u) { const int row = row0 + u * NGW;
            const bool b4 = (F.lane & 4) != 0, b2 = (F.lane & 2) != 0, b1 = (F.lane & 1) != 0; float t4[4], t2[2];
#pragma unroll
            for (int k = 0; k < 4; ++k) { const float keep = b4 ? f[u][4 + k] : f[u][k], send = b4 ? f[u][k] : f[u][4 + k]; t4[k] = keep + __shfl_xor(send, 4); }
#pragma unroll
            for (int k = 0; k < 2; ++k) { const float keep = b2 ? t4[2 + k] : t4[k], send = b2 ? t4[k] : t4[2 + k]; t2[k] = keep + __shfl_xor(send, 2); }
            float t1 = (b1 ? t2[1] : t2[0]) + __shfl_xor(b1 ? t2[0] : t2[1], 1);
            t1 += __shfl_xor(t1, 8); t1 += __shfl_xor(t1, 16); t1 += __shfl_xor(t1, 32);
            if (F.lane < 8 && ok[u]) { const float z = t1 + a.b_forget[F.lane]; const float lf = fminf(z, 0.f) - log1pf(expf(-fabsf(z)));
                if (row < MP) a.out[O_LFP + (size_t)row * NH + F.lane] = lf; else a.out[O_LFS + (size_t)(row - MP) * NH + F.lane] = lf; } }
    }
}

template <int W> __device__ __forceinline__ void p2_item(const Args& a, unsigned char* ws, int row, int ch) {
    const bf16* U = (const bf16*)(ws + WS_U); bf16* PO = (bf16*)(ws + WS_PO);
    float e[W][8]; float cnt;
    if (row < MP) { const int s = row & (SEQ - 1); cnt = (float)(s + 1 < W ? s + 1 : W);
#pragma unroll
        for (int i = 0; i < W; ++i) { v4u q = (v4u){0u, 0u, 0u, 0u}; if (s - i >= 0) q = *(const v4u*)(U + (size_t)(row - i) * DP + ch);
            e[i][0] = bflo(q.x); e[i][1] = bfhi(q.x); e[i][2] = bflo(q.y); e[i][3] = bfhi(q.y); e[i][4] = bflo(q.z); e[i][5] = bfhi(q.z); e[i][6] = bflo(q.w); e[i][7] = bfhi(q.w); }
    } else { const int rs = row - MP, b = rs >> 3, t = rs & 7; cnt = (float)W;
#pragma unroll
        for (int i = 0; i < W; ++i) { const int tt = t - i;
            if (tt >= 0) { const v4u q = *(const v4u*)(U + (size_t)(MP + b * 8 + tt) * DP + ch);
                e[i][0] = bflo(q.x); e[i][1] = bfhi(q.x); e[i][2] = bflo(q.y); e[i][3] = bfhi(q.y); e[i][4] = bflo(q.z); e[i][5] = bfhi(q.z); e[i][6] = bflo(q.w); e[i][7] = bfhi(q.w); }
            else { const f32x4 p0 = *(const f32x4*)(a.state_pool + (size_t)(b * 15 + 15 + tt) * DP + ch), p1 = *(const f32x4*)(a.state_pool + (size_t)(b * 15 + 15 + tt) * DP + ch + 4);
                e[i][0] = p0[0]; e[i][1] = p0[1]; e[i][2] = p0[2]; e[i][3] = p0[3]; e[i][4] = p1[0]; e[i][5] = p1[1]; e[i][6] = p1[2]; e[i][7] = p1[3]; } } }
    const float inv = 1.0f / cnt; float mm[8];
#pragma unroll
    for (int k = 0; k < 8; ++k) { float sum = 0.f;
#pragma unroll
        for (int i = 0; i < W; ++i) sum += e[i][k];
        mm[k] = sum * inv - e[0][k]; }
    v4u o; o.x = pkbf(mm[0], mm[1]); o.y = pkbf(mm[2], mm[3]); o.z = pkbf(mm[4], mm[5]); o.w = pkbf(mm[6], mm[7]);
    *(v4u*)(PO + (size_t)row * DP + ch) = o;
}
__device__ __forceinline__ void p1_cumsum(Frame& F, const Args& a) {
    unsigned char* ws = a.ws;
    { const int gw = F.vcu * NWAVES + F.wave; float* CP2 = (float*)(ws + WS_CP2);
      if (gw < NB * NH) { const int b = gw >> 3, h = gw & 7; float carry = 0.f;
          for (int c = 0; c < SEQ / 64; ++c) { float v = a.out[O_LFP + (size_t)(b * SEQ + c * 64 + F.lane) * NH + h];
#pragma unroll
              for (int o = 1; o < 64; o <<= 1) { const float t = __shfl_up(v, o); if (F.lane >= o) v += t; }
              v += carry; CP2[(size_t)gw * SEQ + c * 64 + F.lane] = v * LOG2E; carry = __shfl(v, 63); } } }
}
__device__ __forceinline__ void p2_cumsum_pool(Frame& F, const Args& a) {
    unsigned char* ws = a.ws;
    const int nfree = F.G > 2 * (M / 256) ? F.G - M / 256 : F.G, myslot = F.G > 2 * (M / 256) ? (int)blockIdx.x - M / 256 : (int)blockIdx.x;
    if (myslot >= 0)
    for (int item = myslot * NTHR + F.tid; item < M * 64; item += nfree * NTHR) {
        const int row = item >> 6, ch = (item & 63) * 8, g = ch >> 7;
        if (g == 0) p2_item<2>(a, ws, row, ch); else if (g == 1) p2_item<4>(a, ws, row, ch); else if (g == 2) p2_item<8>(a, ws, row, ch); else p2_item<16>(a, ws, row, ch);
    }
}

__device__ __forceinline__ float attn_bound2(const Args& a, int lane) {
    asm volatile("" : "+v"(lane));
    const float gq = wave_max(fabsf(a.q_norm_g[lane])), gk = wave_max(fabsf(a.k_norm_g[lane]));
    return 64.0f * C2 * gq * gk * 1.03f;
}

typedef float f32x16 __attribute__((ext_vector_type(16)));
typedef short bf16x8v __attribute__((ext_vector_type(8)));
__device__ __forceinline__ int f2key(float s) { int b = __builtin_bit_cast(int, s); return b ^ ((b >> 31) & 0x7fffffff); }
__device__ __forceinline__ float key2f(int k) { return __builtin_bit_cast(float, k ^ ((k >> 31) & 0x7fffffff)); }
#define CE_DESC(x, y) do { const int mx_ = (x) > (y) ? (x) : (y), mn_ = (x) > (y) ? (y) : (x); (x) = mx_; (y) = mn_; } while (0)
template <int OFF, int N, typename T> __device__ __forceinline__ void bsort_desc(T& v) {
#pragma unroll
    for (int k = 2; k <= N; k <<= 1)
#pragma unroll
        for (int j = k >> 1; j > 0; j >>= 1)
#pragma unroll
            for (int i = 0; i < N; ++i) { const int l = i ^ j; if (l > i) { if ((i & k) == 0) CE_DESC(v[OFF + i], v[OFF + l]); else CE_DESC(v[OFF + l], v[OFF + i]); } }
}
template <int OFF, typename T> __device__ __forceinline__ void bmerge16_desc(T& v) {
#pragma unroll
    for (int j = 8; j > 0; j >>= 1)
#pragma unroll
        for (int i = 0; i < 16; ++i) { const int l = i ^ j; if (l > i) CE_DESC(v[OFF + i], v[OFF + l]); }
}
template <int OA, int OB, typename T> __device__ __forceinline__ void top16_merge(T& v) {
#pragma unroll
    for (int i = 0; i < 16; ++i) v[OA + i] = v[OA + i] > v[OB + 15 - i] ? v[OA + i] : v[OB + 15 - i];
    bmerge16_desc<OA>(v);
}
template <typename T> __device__ __forceinline__ void top16_of_64(T& v) {
    bsort_desc<0, 16>(v); bsort_desc<16, 16>(v); bsort_desc<32, 16>(v); bsort_desc<48, 16>(v);
    top16_merge<0, 16>(v); top16_merge<32, 48>(v); top16_merge<0, 32>(v);
}
__device__ __forceinline__ void p7_topk(Frame& F, const Args& a) {
    unsigned char* ws = a.ws;
    const bf16* PQ = (const bf16*)(ws + WS_PQ); const bf16* SK = (const bf16*)(ws + WS_SUBK); const float* RSS = (const float*)(ws + WS_RSS);
    int* SI = (int*)(ws + WS_SI); float* SG = (float*)(ws + WS_SG);
    const int lane = F.lane, j = lane & 31, hi = lane >> 5;
    constexpr int KROW = 272, KMAT = 128 * KROW;
    LAS unsigned char* kl = F.lds; LAS unsigned* ib = (LAS unsigned*)(F.lds + 2 * KMAT + F.wave * 1024);
    const int h = F.vcu & 7, wi = F.vcu >> 3, nwh = (F.G - h + 7) >> 3;
    __syncthreads();
    for (int i = F.tid; i < 2 * 128 * 16; i += NTHR) { const int p = i >> 11, n = (i >> 4) & 127, c = i & 15; *(LAS v4u*)(kl + p * KMAT + n * KROW + 16 * c) = *(const v4u*)(SK + ((size_t)(h * 2 + p) * NKEYS + n) * DKH + 8 * c); }
    __syncthreads();
    for (int tile = wi * NWAVES + F.wave; tile < M / 32; tile += nwh * NWAVES) {
        const int row0 = tile * 32;
        int jl = j, hl = hi; asm volatile("" : "+v"(jl), "+v"(hl));
        int top[2][16];
#pragma unroll
        for (int p = 0; p < 2; ++p) {
            bf16x8v qf[8];
#pragma unroll
            for (int ks = 0; ks < 8; ++ks) qf[ks] = *(const bf16x8v*)(PQ + (size_t)(row0 + jl) * DQ + h * 256 + p * 128 + 16 * ks + 8 * hl);
            f32x16 acc[4];
#pragma unroll
            for (int mt = 0; mt < 4; ++mt) acc[mt] = f32x16{};
            const LAS unsigned char* kb = kl + p * KMAT + jl * KROW + 16 * hl;
#pragma unroll
            for (int ks = 0; ks < 8; ++ks)
#pragma unroll
                for (int mt = 0; mt < 4; ++mt) { const bf16x8v af = *(const LAS bf16x8v*)(kb + mt * 32 * KROW + ks * 32); acc[mt] = __builtin_amdgcn_mfma_f32_32x32x16_bf16(af, qf[ks], acc[mt], 0, 0, 0); }
            int v[64];
#pragma unroll
            for (int mt = 0; mt < 4; ++mt)
#pragma unroll
                for (int r = 0; r < 16; ++r) { const int n = 32 * mt + (r & 3) + 8 * (r >> 2) + 4 * hi; v[16 * mt + r] = (f2key(acc[mt][r]) & ~127) | (127 - n); }
            top16_of_64(v);
#pragma unroll
            for (int i = 0; i < 16; ++i) top[p][i] = v[i];
        }
        int S[32];
#pragma unroll
        for (int i = 0; i < 16; ++i) { auto rr = __builtin_amdgcn_permlane32_swap((unsigned)top[0][i], (unsigned)top[1][i], false, false); S[i] = (int)rr[0]; S[16 + i] = (int)rr[1]; }
        top16_merge<0, 16>(S);
        { unsigned w0 = 0, w1 = 0, w2 = 0, w3 = 0;
#pragma unroll
          for (int i = 0; i < 4; ++i) { w0 |= (unsigned)(127 - (S[i] & 127)) << (8 * i); w1 |= (unsigned)(127 - (S[4 + i] & 127)) << (8 * i); w2 |= (unsigned)(127 - (S[8 + i] & 127)) << (8 * i); w3 |= (unsigned)(127 - (S[12 + i] & 127)) << (8 * i); }
          *(LAS v4u*)(ib + (hi * 32 + j) * 4) = (v4u){w0, w1, w2, w3}; }
        float s1[16], s2[16];
#pragma unroll
        for (int i = 0; i < 16; ++i) { auto rr = __builtin_amdgcn_permlane32_swap((unsigned)S[i], (unsigned)S[i], false, false); s1[i] = key2f((int)rr[0] & ~127); s2[i] = key2f((int)rr[1] & ~127); }
        int c[64]; { int n = 0;
#pragma unroll
          for (int ca = 0; ca < 16; ++ca)
#pragma unroll
              for (int cb = 0; cb < 16; ++cb) if ((ca + 1) * (cb + 1) <= 16) { c[n] = (f2key(s1[ca] + s2[cb]) & ~255) | (255 - (ca * 16 + cb)); ++n; }
#pragma unroll
          for (int q = 50; q < 64; ++q) c[q] = (int)0x80000000; }
        top16_of_64(c);
        float ssq = 0.f;
#pragma unroll
        for (int q = 0; q < 4; ++q) { const f32x4 t4 = *(const f32x4*)(RSS + (size_t)(row0 + j) * 16 + 4 * q); ssq += (t4[0] + t4[1]) + (t4[2] + t4[3]); }
        const float rstd = 1.0f / sqrtf(ssq * (1.0f / DM) + EPS);
        const float z0 = key2f(c[0] & ~255) * rstd; float e[16], esum = 0.f;
#pragma unroll
        for (int k = 0; k < 16; ++k) { e[k] = __expf(key2f(c[k] & ~255) * rstd - z0); esum += e[k]; }
        const float inv = 1.0f / esum;
        LDS_WAIT(); asm volatile("" ::: "memory");
        const LAS unsigned char* ib8 = (const LAS unsigned char*)ib;
        int oi[8]; float og[8];
#pragma unroll
        for (int k = 0; k < 8; ++k) { const int ck = hi ? c[8 + k] : c[k]; const float ek = hi ? e[8 + k] : e[k]; const int fl = 255 - (ck & 255);
            const int i1 = ib8[(0 * 32 + j) * 16 + (fl >> 4)], i2 = ib8[(1 * 32 + j) * 16 + (fl & 15)]; oi[k] = i1 * NKEYS + i2; og[k] = ek * inv; }
        { int* sp = SI + (size_t)(row0 + j) * 128 + h * 16 + hi * 8; float* gp = SG + (size_t)(row0 + j) * 128 + h * 16 + hi * 8;
          *(v4u*)sp = (v4u){(unsigned)oi[0], (unsigned)oi[1], (unsigned)oi[2], (unsigned)oi[3]}; *(v4u*)(sp + 4) = (v4u){(unsigned)oi[4], (unsigned)oi[5], (unsigned)oi[6], (unsigned)oi[7]};
          *(f32x4*)gp = (f32x4){og[0], og[1], og[2], og[3]}; *(f32x4*)(gp + 4) = (f32x4){og[4], og[5], og[6], og[7]}; }
        LDS_WAIT(); asm volatile("" ::: "memory");
    }
}


constexpr int P8_TOK = 34, P8_Q = 5, P8_NS = 8, P8_SW = 128;
static_assert(M % P8_TOK == 0 && P8_TOK <= 8 * P8_Q, "P8 chunking");
#define FP8X2(wd, hi_) __builtin_amdgcn_cvt_pk_f32_fp8((int)(wd), (hi_))
typedef __bf16 bf16x2v __attribute__((ext_vector_type(2)));
template <bool HI> __device__ __forceinline__ float p8_dot(unsigned wd, unsigned hpair, float accv) { const f32x2 f = FP8X2(wd, HI); return __builtin_amdgcn_fdot2_f32_bf16(__builtin_bit_cast(bf16x2v, pkbf(f[0], f[1])), __builtin_bit_cast(bf16x2v, hpair), accv, false); }
__device__ __forceinline__ void p8_gather(Frame& F, const Args& a) {
    unsigned char* ws = a.ws;
    const bf16* HG = (const bf16*)(ws + WS_XN); const unsigned char* PU = ws + WS_PU; const unsigned char* PV = ws + WS_PV; const float* US = (const float*)(ws + WS_US); const float* VS = (const float*)(ws + WS_VS);
    const float* RSS = (const float*)(ws + WS_RSS); const int* SI = (const int*)(ws + WS_SI); const float* SG = (const float*)(ws + WS_SG); const float* Hh = (const float*)(ws + WS_H);
    float* Y = a.out + O_YP;
    LAS unsigned short* ix = (LAS unsigned short*)F.lds;
    LAS float* wt = (LAS float*)(F.lds + P8_TOK * 128 * 2);
    LAS float* rs = (LAS float*)(F.lds + P8_TOK * 128 * 2 + P8_TOK * 128 * 4);
    int lane = F.lane; asm volatile("" : "+v"(lane));
    const int g = lane >> 3, c8 = lane & 7;
    for (int chunk = F.vcu; chunk < M / P8_TOK; chunk += F.G) {
        const int tb = chunk * P8_TOK;
        __syncthreads();
        for (int i = F.tid; i < P8_TOK * 128; i += NTHR) { ix[i] = (unsigned short)SI[(size_t)tb * 128 + i]; wt[i] = SG[(size_t)tb * 128 + i]; }
        if (F.tid < P8_TOK) { float s = 0.f; for (int k = 0; k < 16; ++k) s += RSS[(size_t)(tb + F.tid) * 16 + k]; rs[F.tid] = 1.0f / sqrtf(s * (1.0f / DM) + EPS); }
        __syncthreads();
        float acc[P8_Q][16];
#pragma unroll
        for (int q = 0; q < P8_Q; ++q)
#pragma unroll
            for (int i = 0; i < 16; ++i) acc[q][i] = 0.f;
        for (int s = 0; s < P8_NS; ++s) {
            __syncthreads();
            int cl = c8; asm volatile("" : "+v"(cl));
            const unsigned char* pus = PU + (size_t)s * ((size_t)NEXP * P8_SW) + 16 * cl;
#pragma unroll
            for (int q = 0; q < P8_Q; ++q) { const int lt = F.wave + 8 * q; if (lt < P8_TOK) {
                const v4u h0 = *(const v4u*)(HG + (size_t)(tb + lt) * DM + P8_SW * s + 16 * cl), h1 = *(const v4u*)(HG + (size_t)(tb + lt) * DM + P8_SW * s + 16 * cl + 8);
                const unsigned hp8[8] = {h0.x, h0.y, h0.z, h0.w, h1.x, h1.y, h1.z, h1.w};
                f32x2 hf2[8];
#pragma unroll
                for (int k = 0; k < 8; ++k) hf2[k] = (f32x2){bflo(hp8[k]), bfhi(hp8[k])};
                const v4u ea = *(const LAS v4u*)(ix + lt * 128 + g * 16), eb = *(const LAS v4u*)(ix + lt * 128 + g * 16 + 8);
                const unsigned ew[8] = {ea.x, ea.y, ea.z, ea.w, eb.x, eb.y, eb.z, eb.w};
                v4u r[16];
#pragma unroll
                for (int i = 0; i < 16; ++i) { const unsigned e = (i & 1) ? (ew[i >> 1] >> 16) : (ew[i >> 1] & 0xffffu); r[i] = *(const v4u*)(pus + (size_t)e * P8_SW); }
#pragma unroll
                for (int i = 0; i < 16; ++i) { const unsigned wd[4] = {r[i].x, r[i].y, r[i].z, r[i].w}; f32x2 d2 = (f32x2){acc[q][i], 0.f};
#pragma unroll
                    for (int jj = 0; jj < 4; ++jj) { d2 = FP8X2(wd[jj], false) * hf2[2 * jj] + d2; d2 = FP8X2(wd[jj], true) * hf2[2 * jj + 1] + d2; }
                    acc[q][i] = d2[0] + d2[1]; } } }
        }
#pragma unroll
        for (int q = 0; q < P8_Q; ++q) { const int lt = F.wave + 8 * q; if (lt < P8_TOK) {
            float v8[8], v4[4], v2[2]; const bool b4 = (c8 & 4) != 0, b2 = (c8 & 2) != 0, b1 = (c8 & 1) != 0;
#pragma unroll
            for (int j2 = 0; j2 < 8; ++j2) { const float keep = b4 ? acc[q][8 + j2] : acc[q][j2], send = b4 ? acc[q][j2] : acc[q][8 + j2]; v8[j2] = keep + __shfl_xor(send, 4); }
#pragma unroll
            for (int j2 = 0; j2 < 4; ++j2) { const float keep = b2 ? v8[4 + j2] : v8[j2], send = b2 ? v8[j2] : v8[4 + j2]; v4[j2] = keep + __shfl_xor(send, 2); }
#pragma unroll
            for (int j2 = 0; j2 < 2; ++j2) { const float keep = b1 ? v4[2 + j2] : v4[j2], send = b1 ? v4[j2] : v4[2 + j2]; v2[j2] = keep + __shfl_xor(send, 1); }
            const float r = rs[lt]; const int kk = lt * 128 + g * 16 + 2 * c8; LAS float* wp = wt + kk; const f32x2 gt = *(const LAS f32x2*)wp;
            const int e0 = ix[kk], e1 = ix[kk + 1];
            const float z0 = v2[0] * r * US[e0], z1 = v2[1] * r * US[e1];
            const float a0 = 0.5f * z0 * (1.0f + erff(z0 * 0.70710678118654752f)), a1 = 0.5f * z1 * (1.0f + erff(z1 * 0.70710678118654752f));
            *(LAS f32x2*)wp = (f32x2){gt[0] * a0 * VS[e0], gt[1] * a1 * VS[e1]}; } }
        LDS_WAIT(); asm volatile("" ::: "memory");
        for (int s = 0; s < P8_NS; ++s) {
            __syncthreads();
            int cl = c8; asm volatile("" : "+v"(cl));
            const unsigned char* pvs = PV + (size_t)s * ((size_t)NEXP * P8_SW) + 16 * cl;
#pragma unroll 1
            for (int q = 0; q < P8_Q; ++q) { const int lt = F.wave + 8 * q; if (lt < P8_TOK) {
                f32x2 o2[8];
#pragma unroll
                for (int k = 0; k < 8; ++k) o2[k] = (f32x2){0.f, 0.f};
                const v4u ea = *(const LAS v4u*)(ix + lt * 128 + g * 16), eb = *(const LAS v4u*)(ix + lt * 128 + g * 16 + 8);
                const unsigned ew[8] = {ea.x, ea.y, ea.z, ea.w, eb.x, eb.y, eb.z, eb.w};
                v4u r[16];
#pragma unroll
                for (int i = 0; i < 16; ++i) { const unsigned e = (i & 1) ? (ew[i >> 1] >> 16) : (ew[i >> 1] & 0xffffu); r[i] = *(const v4u*)(pvs + (size_t)e * P8_SW); }
                float wv[16];
#pragma unroll
                for (int i4 = 0; i4 < 4; ++i4) { const f32x4 w4 = *(const LAS f32x4*)(wt + lt * 128 + g * 16 + 4 * i4); wv[4 * i4] = w4[0]; wv[4 * i4 + 1] = w4[1]; wv[4 * i4 + 2] = w4[2]; wv[4 * i4 + 3] = w4[3]; }
#pragma unroll
                for (int i = 0; i < 16; ++i) { const f32x2 w2 = (f32x2){wv[i], wv[i]}; const unsigned wd[4] = {r[i].x, r[i].y, r[i].z, r[i].w};
#pragma unroll
                    for (int jj = 0; jj < 4; ++jj) { o2[2 * jj] = FP8X2(wd[jj], false) * w2 + o2[2 * jj]; o2[2 * jj + 1] = FP8X2(wd[jj], true) * w2 + o2[2 * jj + 1]; } }
                float o[16];
#pragma unroll
                for (int k = 0; k < 8; ++k) { o[2 * k] = o2[k][0]; o[2 * k + 1] = o2[k][1]; }
                const bool b5 = (lane & 32) != 0, b4 = (lane & 16) != 0, b3 = (lane & 8) != 0; float p8[8], p4[4], p2[2];
#pragma unroll
                for (int j2 = 0; j2 < 8; ++j2) { const float keep = b5 ? o[8 + j2] : o[j2], send = b5 ? o[j2] : o[8 + j2]; p8[j2] = keep + __shfl_xor(send, 32); }
#pragma unroll
                for (int j2 = 0; j2 < 4; ++j2) { const float keep = b4 ? p8[4 + j2] : p8[j2], send = b4 ? p8[j2] : p8[4 + j2]; p4[j2] = keep + __shfl_xor(send, 16); }
#pragma unroll
                for (int j2 = 0; j2 < 2; ++j2) { const float keep = b3 ? p4[2 + j2] : p4[j2], send = b3 ? p4[j2] : p4[2 + j2]; p2[j2] = keep + __shfl_xor(send, 8); }
                const size_t off = (size_t)(tb + lt) * DM + P8_SW * s + 16 * cl + (b5 ? 8 : 0) + (b4 ? 4 : 0) + (b3 ? 2 : 0);
                const f32x2 hv = *(const f32x2*)(Hh + off);
                *(f32x2*)(Y + off) = (f32x2){hv[0] + p2[0], hv[1] + p2[1]}; } }
        }
    }
}

__device__ __forceinline__ void p3_sample_attn2(Frame& F, const Args& a, const float M2) {
    unsigned char* ws = a.ws;
    const bf16* Q = (const bf16*)(ws + WS_Q); bf16* AO = (bf16*)(ws + WS_AO);
    LAS float* D2 = (LAS float*)F.lds;
    LAS float* E2 = (LAS float*)(F.lds + 32768);
    LAS float* Pt = (LAS float*)(F.lds + 32768 + 128);
    LAS float* Op = (LAS float*)(F.lds + 32768 + 128 + 8192);
    LAS float* lp = (LAS float*)(F.lds + 32768 + 128 + 8192 + 16384);
    int lane = F.lane; asm volatile("" : "+v"(lane));
    const int w = F.wave, hh = w >> 1, kh = w & 1, n = lane & 31, hi = lane >> 5;
    LAS float* Pw = Pt + w * 256;
    for (int unit = F.vcu; unit < DB * 2; unit += F.G) {
        const int b = unit >> 1, h = 4 * (unit & 1) + hh;
        __syncthreads();
        for (int i = F.tid; i < 4 * PAST; i += NTHR) { const int hq = i >> 11, jk = i & (PAST - 1); const int pg = a.page_table[b * NPAGES + (jk >> 7)];
            D2[i] = a.cache_lf[((size_t)pg * PAGE + (jk & 127)) * NH + 4 * (unit & 1) + hq]; }
        __syncthreads();
        if (kh == 0) {
            LAS float* d = D2 + hh * PAST; float loc[32]; float tot = 0.f;
#pragma unroll
            for (int k = 31; k >= 0; --k) { loc[k] = tot; tot += d[lane * 32 + k]; }
            float inc = tot;
#pragma unroll
            for (int o = 1; o < 64; o <<= 1) { const float t = __shfl_down(inc, o); if (lane + o < 64) inc += t; }
            const float excl = inc - tot;
#pragma unroll
            for (int k = 0; k < 32; ++k) d[lane * 32 + k] = (loc[k] + excl) * LOG2E;
            if (lane < 8) { float e = 0.f; for (int t = 0; t <= lane; ++t) e += a.out[O_LFS + (size_t)(b * 8 + t) * NH + h]; E2[hh * 8 + lane] = e * LOG2E; }
        }
        __syncthreads();
        bf16x8v qa[4];
#pragma unroll
        for (int ks = 0; ks < 4; ++ks) { qa[ks] = bf16x8v{}; if (n < 8) qa[ks] = *(const bf16x8v*)(Q + (size_t)(MP + b * 8 + n) * DA + h * 64 + 16 * ks + 8 * hi); }
        float e2[4];
#pragma unroll
        for (int t = 0; t < 4; ++t) e2[t] = E2[hh * 8 + 4 * hi + t] - M2;
        float o[8], lsum[4];
#pragma unroll
        for (int t = 0; t < 8; ++t) o[t] = 0.f;
#pragma unroll
        for (int t = 0; t < 4; ++t) lsum[t] = 0.f;
        const LAS float* dh = D2 + hh * PAST;
        int nskip; { const float dl = dh[32 * lane + 31]; nskip = __builtin_popcountll(__ballot(dl < -(30.f + 2.f * M2))); }
        nskip = __builtin_amdgcn_readfirstlane(nskip);
        const int nblk = PAST / 32 - nskip, nb0 = nblk >> 1;
        const int blk_lo = nskip + (kh ? nb0 : 0), nit = kh ? (nblk - nb0) : nb0;
        f32x4 kq[8]; float vv[32];
#define S3_COMPUTE(it_, NEWK) do { f32x16 sacc = f32x16{}; \
            _Pragma("unroll") for (int ks = 0; ks < 4; ++ks) { const f32x4 x0_ = kq[2 * ks], x1_ = kq[2 * ks + 1]; v4u kb_; kb_.x = pkbf(x0_[0], x0_[1]); kb_.y = pkbf(x0_[2], x0_[3]); kb_.z = pkbf(x1_[0], x1_[1]); kb_.w = pkbf(x1_[2], x1_[3]); \
                sacc = __builtin_amdgcn_mfma_f32_32x32x16_bf16(qa[ks], __builtin_bit_cast(bf16x8v, kb_), sacc, 0, 0, 0); } \
            float p_[4]; \
            if (!(NEWK)) { const float dj_ = dh[(blk_lo + (it_)) * 32 + n]; _Pragma("unroll") for (int t = 0; t < 4; ++t) p_[t] = __builtin_amdgcn_exp2f(sacc[t] + e2[t] + dj_); } \
            else { const float ek_ = E2[hh * 8 + (n & 7)]; _Pragma("unroll") for (int t = 0; t < 4; ++t) p_[t] = (n <= 4 * hi + t) ? __builtin_amdgcn_exp2f(sacc[t] + e2[t] - ek_) : 0.f; } \
            _Pragma("unroll") for (int t = 0; t < 4; ++t) lsum[t] += p_[t]; \
            *(LAS f32x4*)(Pw + n * 8 + 4 * hi) = (f32x4){p_[0], p_[1], p_[2], p_[3]}; \
            LDS_WAIT(); asm volatile("" ::: "memory"); \
            _Pragma("unroll") for (int k_ = 0; k_ < ((NEWK) ? 8 : 32); ++k_) { const f32x4 pa_ = *(const LAS f32x4*)(Pw + k_ * 8), pb_ = *(const LAS f32x4*)(Pw + k_ * 8 + 4); const float v_ = vv[k_]; \
                o[0] += pa_[0] * v_; o[1] += pa_[1] * v_; o[2] += pa_[2] * v_; o[3] += pa_[3] * v_; o[4] += pb_[0] * v_; o[5] += pb_[1] * v_; o[6] += pb_[2] * v_; o[7] += pb_[3] * v_; } \
            LDS_WAIT(); asm volatile("" ::: "memory"); } while (0)
        for (int it = 0; it < nit; ++it) {
            const int j0 = (blk_lo + it) * 32; const int pg = a.page_table[b * NPAGES + (j0 >> 7)];
            const size_t rowoff = (((size_t)pg * PAGE + (j0 & 127)) * NH + h) * HD;
            const float* kr = a.cache_k + rowoff + (size_t)n * (NH * HD) + 8 * hi; const float* vb = a.cache_v + rowoff;
#pragma unroll
            for (int ks = 0; ks < 4; ++ks) { kq[2 * ks] = __builtin_nontemporal_load((const f32x4*)(kr + 16 * ks)); kq[2 * ks + 1] = __builtin_nontemporal_load((const f32x4*)(kr + 16 * ks + 4)); }
#pragma unroll
            for (int k = 0; k < 32; ++k) vv[k] = __builtin_nontemporal_load(vb + (size_t)k * (NH * HD) + lane);
            S3_COMPUTE(it, false);
        }
        if (kh == 1) {
            const float* kr = a.out + O_KS + (size_t)(b * 8 + (n & 7)) * DA + h * HD + 8 * hi; const float* vr = a.out + O_VS + (size_t)(b * 8) * DA + h * HD + lane;
#pragma unroll
            for (int ks = 0; ks < 4; ++ks) { kq[2 * ks] = *(const f32x4*)(kr + 16 * ks); kq[2 * ks + 1] = *(const f32x4*)(kr + 16 * ks + 4); }
#pragma unroll
            for (int k = 0; k < 8; ++k) vv[k] = vr[(size_t)k * DA];
            S3_COMPUTE(0, true);
        }
#undef S3_COMPUTE
#pragma unroll
        for (int t = 0; t < 4; ++t) { float s = lsum[t]; s += __shfl_xor(s, 1); s += __shfl_xor(s, 2); s += __shfl_xor(s, 4); s += __shfl_xor(s, 8); s += __shfl_xor(s, 16); if (n == 0) lp[w * 8 + 4 * hi + t] = s; }
#pragma unroll
        for (int t = 0; t < 8; ++t) Op[(w * 8 + t) * 64 + lane] = o[t];
        __syncthreads();
        for (int i = F.tid; i < 4 * 8 * 64; i += NTHR) { const int hq = i >> 9, t = (i >> 6) & 7, d = i & 63;
            const float O = Op[((2 * hq) * 8 + t) * 64 + d] + Op[((2 * hq + 1) * 8 + t) * 64 + d], L = lp[(2 * hq) * 8 + t] + lp[(2 * hq + 1) * 8 + t];
            AO[(size_t)(MP + b * 8 + t) * DA + (4 * (unit & 1) + hq) * 64 + d] = (bf16)(pkbf(O / L, 0.f) & 0xffffu); }
    }
}


template <class Epi> __device__ __forceinline__ void sg_phase(Frame& F, const bf16* A  , const bf16* Bt  , int K, int N, const Epi& E) {
    int lane = F.lane; asm volatile("" : "+v"(lane));
    const int fr = lane & 15, fq = lane >> 4, ntc = N >> 6, ntile = (MS / 128) * ntc, pitch = 2 * K + 16, kc = K >> 3;
    for (int t = F.vcu; t < ntile; t += F.G) {
        const int tr = t % (MS / 128), tc = t / (MS / 128);
        __syncthreads();
        for (int i = F.tid; i < 64 * kc; i += NTHR) { const int r = i / kc, c = i - r * kc; *(LAS v4u*)(F.lds + r * pitch + 16 * c) = *(const v4u*)(Bt + (size_t)(64 * tc + r) * K + 8 * c); }
        __syncthreads();
        const bf16* ap = A + (size_t)(128 * tr + 16 * F.wave + fr) * K + 8 * fq;
        const LAS unsigned char* bp = F.lds + fr * pitch + 16 * fq;
        f32x4 acc[4];
#pragma unroll
        for (int c = 0; c < 4; ++c) acc[c] = (f32x4){0.f, 0.f, 0.f, 0.f};
#pragma unroll 8
        for (int ks = 0; ks < K; ks += 32) {
            const bf16x8v av = *(const bf16x8v*)(ap + ks);
#pragma unroll
            for (int c = 0; c < 4; ++c) { const bf16x8v bv = *(const LAS bf16x8v*)(bp + 16 * c * pitch + 2 * ks); acc[c] = __builtin_amdgcn_mfma_f32_16x16x32_bf16(bv, av, acc[c], 0, 0, 0); }
        }
        E(acc, 128 * tr + 16 * F.wave + fr, tc, fq);
    }
}
template <int MODE> struct SgGate { const bf16* G; const bf16* Tin; bf16* O;
    __device__ __forceinline__ void operator()(const f32x4 (&acc)[4], int rs, int tc, int fq) const {
#pragma unroll
        for (int c = 0; c < 4; ++c) { const size_t off = (size_t)(MP + rs) * DM + 64 * tc + 16 * c + 4 * fq; const v2u g = *(const v2u*)(G + off);
            float r[4] = {acc[c][0] * bflo(g.x), acc[c][1] * bfhi(g.x), acc[c][2] * bflo(g.y), acc[c][3] * bfhi(g.y)};
            if (MODE == 1) { const v2u t = *(const v2u*)(Tin + off); r[0] += bflo(t.x); r[1] += bfhi(t.x); r[2] += bflo(t.y); r[3] += bfhi(t.y); }
            v2u w; w.x = pkbf(r[0], r[1]); w.y = pkbf(r[2], r[3]); *(v2u*)(O + off) = w; } } };
struct SgOut { const float* xs; float* H; bf16* HG; const float* gf; float* RSS;
    __device__ __forceinline__ void operator()(const f32x4 (&acc)[4], int rs, int tc, int fq) const { float ss = 0.f;
#pragma unroll
        for (int c = 0; c < 4; ++c) { const int col = 64 * tc + 16 * c + 4 * fq; const f32x4 h = acc[c] + *(const f32x4*)(xs + (size_t)rs * DM + col);
            ss += (h[0] * h[0] + h[1] * h[1]) + (h[2] * h[2] + h[3] * h[3]);
            *(f32x4*)(H + (size_t)(MP + rs) * DM + col) = h; const f32x4 gv = *(const f32x4*)(gf + col);
            v2u w; w.x = pkbf(h[0] * gv[0], h[1] * gv[1]); w.y = pkbf(h[2] * gv[2], h[3] * gv[3]); *(v2u*)(HG + (size_t)(MP + rs) * DM + col) = w; }
        ss += __shfl_xor(ss, 16); ss += __shfl_xor(ss, 32);
        if (fq == 0) RSS[(size_t)(MP + rs) * 16 + tc] = ss; } };
struct SgPQ { bf16* PQ;
    __device__ __forceinline__ void operator()(const f32x4 (&acc)[4], int rs, int tc, int fq) const {
#pragma unroll
        for (int c = 0; c < 4; ++c) { v2u w; w.x = pkbf(acc[c][0], acc[c][1]); w.y = pkbf(acc[c][2], acc[c][3]); *(v2u*)(PQ + (size_t)(MP + rs) * DQ + 64 * tc + 16 * c + 4 * fq) = w; } } };

constexpr int N_PHASES = 9;
#ifndef MK_PER_PHASE
#define MK_PER_PHASE 0
#endif
__global__ void __launch_bounds__(NTHR, 2) fwd_kernel(Args args) {
    extern __shared__ __attribute__((aligned(16))) unsigned char lds[];
    Frame F;
    F.lds = (LAS unsigned char*)lds; F.MISC = (volatile LAS unsigned*)(F.lds + MISC_OFF);
    F.tid = threadIdx.x; F.lane = F.tid & 63; F.wave = __builtin_amdgcn_readfirstlane(F.tid >> 6);
    F.G = gridDim.x; { const int bx = blockIdx.x; F.vcu = (F.G % 8 == 0) ? (bx % 8) * (F.G / 8) + bx / 8 : bx; }
    F.ctl = (gu32*)(args.ws + WS_CTL);
    for (int u = F.tid; u < (LDS_BYTES - MISC_OFF) / 4; u += NTHR) ((LAS unsigned*)(F.lds + MISC_OFF))[u] = 0u;
    __syncthreads();
#if MK_PER_PHASE
#define GRID_BAR() do { } while (0)
#else
    XcdBarrier bar = xcd_barrier_post((unsigned*)(F.ctl + CW_BAR), F.MISC + 8);
#define GRID_BAR() xcd_barrier(bar)
#endif
    unsigned char* ws = args.ws;
    const int lo = args.ph_lo, hi = args.ph_hi;
#ifndef DBG_REP_PHASE
#define DBG_REP_PHASE -1
#endif
#ifndef DBG_REP_N
#define DBG_REP_N 1
#endif
#define REPS(k) for (int rep_ = 0; rep_ < ((k) == DBG_REP_PHASE ? 1 + DBG_REP_N : 1); ++rep_)
#define IN(k) (lo <= (k) && (k) < hi)
#define BOTH(k) (IN(k) && IN((k) + 1))
#define ENDPH(k) do { if (BOTH(k) || (k) == DBG_REP_PHASE) GRID_BAR(); } while (0)
    if (IN(0)) REPS(0) { p0_prologue(F, args); ENDPH(0); }
    if (IN(1)) REPS(1) {
        p1_cumsum(F, args);
        pg8::Gemm g{(const bf16*)(ws + WS_XN), (const bf16*)(ws + WS_WIN), M, NPROJ - 256, DM}; pg8::StaticOrder S; S.init(M, NPROJ - 256, F.G, (int)blockIdx.x);
        EpiInProj E{(bf16*)(ws + WS_U), (bf16*)(ws + WS_Q), (bf16*)(ws + WS_K), (bf16*)(ws + WS_V), (bf16*)(ws + WS_GA), (bf16*)(ws + WS_GB), args.out, args.q_norm_g, args.k_norm_g, 0};
        pg8::gemm_phase<EpiInProj, pg8::StaticOrder, true, true>(F.lds, g, S, E);
        ENDPH(1);
    }
    if (IN(2)) REPS(2) {
        { pg8::Gemm g{(const bf16*)(ws + WS_XN), (const bf16*)(ws + WS_WIN) + (size_t)(NPROJ - 256) * DM, M, 256, DM}; pg8::StaticOrder S; S.init(M, 256, F.G, (int)blockIdx.x);
          EpiInProj E{(bf16*)(ws + WS_U), (bf16*)(ws + WS_Q), (bf16*)(ws + WS_K), (bf16*)(ws + WS_V), (bf16*)(ws + WS_GA), (bf16*)(ws + WS_GB), args.out, args.q_norm_g, args.k_norm_g, 15};
          pg8::gemm_phase<EpiInProj, pg8::StaticOrder, true, true>(F.lds, g, S, E); }
        __syncthreads();
        p2_cumsum_pool(F, args);
        if (2 == DBG_REP_PHASE || !IN(3)) GRID_BAR();
        __syncthreads(); }
    if (IN(3)) {
        const float M2 = __builtin_bit_cast(float, __builtin_amdgcn_readfirstlane(__builtin_bit_cast(int, attn_bound2(args, F.lane))));
#if !defined(DBG_SKIP_PATTN)
        { const attn_body::AttnTensors AT{(const attn_body::bf16*)(ws + WS_Q), (const attn_body::bf16*)(ws + WS_K), (const attn_body::bf16*)(ws + WS_V), (attn_body::bf16*)(ws + WS_AO), (const float*)(ws + WS_CP2), M2};
          const attn_body::StaticOrder S((int)F.G, F.vcu);
          attn_body::attn_phase<attn_body::StaticOrder>((char*)lds, AT, S);
#ifdef DBG_ATTN2
          __syncthreads(); attn_body::attn_phase<attn_body::StaticOrder>((char*)lds, AT, S);
#endif
        }
#endif
        REPS(3) { p3_sample_attn2(F, args, M2); }
        ENDPH(3); }
    if (IN(4)) REPS(4) {
        { pg8::Gemm g{(const bf16*)(ws + WS_PO), (const bf16*)(ws + WS_WBP), MP, DM, DP}; pg8::StaticOrder S; S.init(MP, DM, F.G, (int)blockIdx.x);
          EpiGate<0> E{(const bf16*)(ws + WS_GA), nullptr, (bf16*)(ws + WS_T)};
          pg8::gemm_phase<EpiGate<0>, pg8::StaticOrder, true, true>(F.lds, g, S, E); }
        __syncthreads();
        { pg8::Gemm g{(const bf16*)(ws + WS_AO), (const bf16*)(ws + WS_WBA), MP, DM, DA}; pg8::StaticOrder S; S.init(MP, DM, F.G, (int)blockIdx.x);
          EpiGate<1> E{(const bf16*)(ws + WS_GB), (const bf16*)(ws + WS_T), (bf16*)(ws + WS_MIX)};
          pg8::gemm_phase<EpiGate<1>, pg8::StaticOrder, true, true>(F.lds, g, S, E); }
        { SgGate<0> E{(const bf16*)(ws + WS_GA), nullptr, (bf16*)(ws + WS_T)}; sg_phase(F, (const bf16*)(ws + WS_PO) + (size_t)MP * DP, (const bf16*)(ws + WS_WBP), DP, DM, E); }
        asm volatile("s_waitcnt vmcnt(0)" ::: "memory"); __syncthreads();
        { SgGate<1> E{(const bf16*)(ws + WS_GB), (const bf16*)(ws + WS_T), (bf16*)(ws + WS_MIX)}; sg_phase(F, (const bf16*)(ws + WS_AO) + (size_t)MP * DA, (const bf16*)(ws + WS_WBA), DA, DM, E); }
        ENDPH(4);
    }
    if (IN(5)) REPS(5) {
        pg8::Gemm g{(const bf16*)(ws + WS_MIX), (const bf16*)(ws + WS_WOUT), MP, DM, DM}; pg8::StaticOrder S; S.init(MP, DM, F.G, (int)blockIdx.x);
        EpiOut E{args.x_p, args.x_s, (float*)(ws + WS_H), (bf16*)(ws + WS_XN), args.norm_ffn_g, (float*)(ws + WS_RSS)};
        pg8::gemm_phase<EpiOut, pg8::StaticOrder, true, true>(F.lds, g, S, E);
        { SgOut E2{args.x_s, (float*)(ws + WS_H), (bf16*)(ws + WS_XN), args.norm_ffn_g, (float*)(ws + WS_RSS)}; sg_phase(F, (const bf16*)(ws + WS_MIX) + (size_t)MP * DM, (const bf16*)(ws + WS_WOUT), DM, DM, E2); }
        ENDPH(5);
    }
    if (IN(6)) REPS(6) {
        pg8::Gemm g{(const bf16*)(ws + WS_XN), (const bf16*)(ws + WS_WQ), MP, DQ, DM}; pg8::StaticOrder S; S.init(MP, DQ, F.G, (int)blockIdx.x);
        pg8::EpiBf16<0> E{(bf16*)(ws + WS_PQ), DQ, nullptr, 0, 0, 1.f};
        pg8::gemm_phase<pg8::EpiBf16<0>, pg8::StaticOrder, true, true>(F.lds, g, S, E);
        { SgPQ E2{(bf16*)(ws + WS_PQ)}; sg_phase(F, (const bf16*)(ws + WS_XN) + (size_t)MP * DM, (const bf16*)(ws + WS_WQ), DM, DQ, E2); }
        ENDPH(6);
    }
    if (IN(7)) REPS(7) { p7_topk(F, args); ENDPH(7); }
    if (IN(8)) REPS(8) { p8_gather(F, args); ENDPH(8); }
#ifdef DBG_DUMP
    if (IN(9)) { const bf16* AO = (const bf16*)(ws + WS_AO); const bf16* PO = (const bf16*)(ws + WS_PO); const bf16* MX = (const bf16*)(ws + (DBG_DUMP == 3 ? WS_T : DBG_DUMP == 4 ? WS_GA : WS_MIX));
        for (size_t i = (size_t)blockIdx.x * NTHR + F.tid; i < (size_t)M * DM; i += (size_t)F.G * NTHR) { const int row = (int)(i >> 10), c = (int)(i & 1023);
            float v; if (DBG_DUMP == 1) v = c < 512 ? bf2f(AO[(size_t)row * DA + c]) : bf2f(PO[(size_t)row * DP + c - 512]); else v = bf2f(MX[i]);
            args.out[O_YP + i] = v; } }
#endif
#undef IN
#undef BOTH
}

extern "C" void kernel_launch(void* const* d_in, const int* in_sizes, int n_in, void* d_out, int out_size, void* d_ws, size_t ws_size, hipStream_t stream) {
    static int grid = 0;
    if (grid == 0) {
        if (n_in != 22 || (size_t)out_size != O_END || ws_size < WS_END) { fprintf(stderr, "kernel_launch: unexpected shapes (n_in %d out %d ws %zu)\n", n_in, out_size, ws_size); grid = -1; return; }
        int dev = 0, cus = 0, per_cu = 0;
        if (hipGetDevice(&dev) != hipSuccess || hipDeviceGetAttribute(&cus, hipDeviceAttributeMultiprocessorCount, dev) != hipSuccess) { grid = -1; return; }
        if (hipFuncSetAttribute((const void*)fwd_kernel, hipFuncAttributeMaxDynamicSharedMemorySize, LDS_BYTES) != hipSuccess) { fprintf(stderr, "kernel_launch: hipFuncSetAttribute failed\n"); grid = -1; return; }
        if (hipOccupancyMaxActiveBlocksPerMultiprocessor(&per_cu, (const void*)fwd_kernel, NTHR, LDS_BYTES) != hipSuccess || per_cu < 1) fprintf(stderr, "kernel_launch: occupancy query reports %d\n", per_cu);
        (void)hipGetLastError();
        grid = cus;
    }
    if (grid < 0) return;
    if (hipMemsetAsync((char*)d_ws + WS_CTL, 0, CTL_ZERO_BYTES, stream) != hipSuccess) return;
    Args a{};
    a.x_p = (const float*)d_in[0]; a.x_s = (const float*)d_in[1]; a.cache_k = (const float*)d_in[2]; a.cache_v = (const float*)d_in[3]; a.cache_lf = (const float*)d_in[4];
    a.state_pool = (const float*)d_in[5]; a.page_table = (const int*)d_in[6]; a.norm_mix_g = (const float*)d_in[7]; a.w_in = (const float*)d_in[8]; a.b_forget = (const float*)d_in[9];
    a.q_norm_g = (const float*)d_in[10]; a.k_norm_g = (const float*)d_in[11]; a.pool_mix_w = (const float*)d_in[12]; a.pool_scale = (const float*)d_in[13]; a.w_bp = (const float*)d_in[14];
    a.w_ba = (const float*)d_in[15]; a.w_out = (const float*)d_in[16]; a.norm_ffn_g = (const float*)d_in[17]; a.w_query = (const float*)d_in[18]; a.sub_keys = (const float*)d_in[19];
    a.peer_u = (const float*)d_in[20]; a.peer_v = (const float*)d_in[21];
    a.out = (float*)d_out; a.ws = (unsigned char*)d_ws; a.pad = 0;
#if MK_PER_PHASE
#ifndef DBG_NPH
#define DBG_NPH N_PHASES
#endif
    for (int ph = 0; ph < DBG_NPH; ++ph) { a.ph_lo = ph; a.ph_hi = ph + 1; a.li = ph; hipLaunchKernelGGL(fwd_kernel, dim3(grid), dim3(NTHR), LDS_BYTES, stream, a); }
#ifdef DBG_DUMP
    a.ph_lo = 9; a.ph_hi = 10; a.li = 9; hipLaunchKernelGGL(fwd_kernel, dim3(grid), dim3(NTHR), LDS_BYTES, stream, a);
#endif
#else
    a.ph_lo = 0; a.ph_hi = N_PHASES; a.li = 0; hipLaunchKernelGGL(fwd_kernel, dim3(grid), dim3(NTHR), LDS_BYTES, stream, a);
#endif
}
```

```cpp
#include <hip/hip_runtime.h>
#include <cstdio>
#include <cstdint>
#include <cmath>
namespace pg8 {
#define PG8_LAS __attribute__((address_space(3)))
typedef unsigned short bf16_t;
typedef short bf16x8 __attribute__((ext_vector_type(8)));
typedef float f32x4 __attribute__((ext_vector_type(4)));
typedef unsigned u32x4 __attribute__((ext_vector_type(4)));
constexpr int BM = 256, BK = 64, HALF = 128, HTB = HALF * BK * 2  , STAGE_BYTES = 8 * HTB, NXCD = 8, WGM = 8;

__host__ __device__ __forceinline__ int lds_byte(int r, int c) { const int st = (r >> 4) * 2 + (c >> 5), rr = r & 15, cc = c & 31, ob = rr * 64 + cc * 2; return st * 1024 + (ob ^ (((ob >> 9) & 1) << 5)); }
__host__ __device__ __forceinline__ void stage_rc(int b, int& R, int& C) { const int st = b / 1024, sb = b % 1024, swz = sb ^ (((sb >> 9) & 1) << 5); R = (st >> 1) * 16 + swz / 64; C = (st & 1) * 32 + (swz % 64) / 2; }
__host__ __device__ __forceinline__ int perm32(int rho) { const int n = rho >> 4, i = rho & 15; return 8 * (i >> 2) + 4 * n + (i & 3); }

struct Unit { int pm, pn; };
struct Gemm { const bf16_t* A; const bf16_t* Bt; int M, N, K; };

struct StaticOrder {
    int nM, nN, nwg, G, c;
    __host__ __device__ void init(int M, int N, int G_, int c_) { nM = M / BM; nN = N / BM; nwg = nM * nN; G = G_; c = c_; }
    __host__ __device__ bool next(int i, Unit& u) const {
        const long L = (long)i * G + c; if (L >= nwg) return false;
        int wgid = (int)L; { const int q = nwg / NXCD, r = nwg % NXCD, xcd = wgid % NXCD, off = wgid / NXCD; wgid = (xcd < r ? xcd * (q + 1) : r * (q + 1) + (xcd - r) * q) + off; }
        const int nig = WGM * nN, gid = wgid / nig, fm = gid * WGM, gsz = (nM - fm) < WGM ? (nM - fm) : WGM;
        u.pm = fm + ((wgid % nig) % gsz); u.pn = (wgid % nig) / gsz; return true;
    }
    __device__ __forceinline__ void a_ready(const Unit&) const {}
    __device__ __forceinline__ void done(const Unit&) const {}
};

typedef float f32x2c __attribute__((ext_vector_type(2))); typedef __bf16 bf16x2c __attribute__((ext_vector_type(2)));
__device__ __forceinline__ unsigned cvt_pk_bf16(float lo, float hi) { f32x2c v = {lo, hi}; bf16x2c b = __builtin_convertvector(v, bf16x2c); return __builtin_bit_cast(unsigned, b); }
typedef float f32x2 __attribute__((ext_vector_type(2)));
__device__ __forceinline__ f32x2 gelu_pk(f32x2 v) {
    const f32x2 av = __builtin_elementwise_abs(v), d = av * 0.2316418882f + 1.0f;
    f32x2 t; t.x = __builtin_amdgcn_rcpf(d.x); t.y = __builtin_amdgcn_rcpf(d.y);
    f32x2 q = t * 0.5307027145f + (-0.7265760135f); q = q * t + 0.7107068705f; q = q * t + (-0.142248368f); q = q * t + 0.127414796f; q = q * t;
    const f32x2 s = (v * v) * (-0.72134752044f);
    f32x2 e; e.x = __builtin_amdgcn_exp2f(s.x); e.y = __builtin_amdgcn_exp2f(s.y);
    const f32x2 m = v * (q * e), r = v - m;
    f32x2 o; o.x = v.x < 0.f ? m.x : r.x; o.y = v.y < 0.f ? m.y : r.y; return o;
}

template <int ACT  > struct EpiBf16 {
    static constexpr bool PERM = true, AFTER_DRAIN = false; static_assert(ACT == 0 || ACT == 1, "EpiBf16: ACT is 0 (none) or 1 (gelu_pk)");
    bf16_t* O; int ldc; const float* bias; int split_cols; size_t split_stride; float scale0;
    __device__ __forceinline__ void operator()(const f32x4 (&acc)[2][2][4][2], const Unit& u, int wr, int wc, int fr, int fq) const {
        const int row0 = u.pm * BM + wr * 64 + fr; int colt = u.pn * BM; bf16_t* base = O;
        float sc = 1.f; if (split_cols) { const int t = colt / split_cols; base += (size_t)t * split_stride; colt -= t * split_cols; if (t == 0) sc = scale0; }
        const int col0 = colt + wc * 32 + 8 * fq, bcol0 = u.pn * BM + wc * 32 + 8 * fq;
        f32x4 bv[2][2];
#pragma unroll
        for (int bj = 0; bj < 2; ++bj)
#pragma unroll
            for (int n = 0; n < 2; ++n) bv[bj][n] = bias ? *(const f32x4*)(bias + bcol0 + bj * HALF + 4 * n) : (f32x4){0.f, 0.f, 0.f, 0.f};
#pragma unroll
        for (int ai = 0; ai < 2; ++ai)
#pragma unroll
            for (int m = 0; m < 4; ++m) { bf16_t* rowp = base + (size_t)(row0 + ai * HALF + m * 16) * ldc + col0;
#pragma unroll
                for (int bj = 0; bj < 2; ++bj) { f32x4 v0 = acc[ai][bj][m][0] + bv[bj][0], v1 = acc[ai][bj][m][1] + bv[bj][1];
                    if (ACT == 1) { f32x2 a = gelu_pk((f32x2){v0[0], v0[1]}), b = gelu_pk((f32x2){v0[2], v0[3]}), c = gelu_pk((f32x2){v1[0], v1[1]}), d = gelu_pk((f32x2){v1[2], v1[3]});
                        v0 = (f32x4){a.x, a.y, b.x, b.y}; v1 = (f32x4){c.x, c.y, d.x, d.y}; }
                    v0 = v0 * sc; v1 = v1 * sc; u32x4 w; w.x = cvt_pk_bf16(v0[0], v0[1]); w.y = cvt_pk_bf16(v0[2], v0[3]); w.z = cvt_pk_bf16(v1[0], v1[1]); w.w = cvt_pk_bf16(v1[2], v1[3]);
                    *(u32x4*)(rowp + bj * HALF) = w; } }
    }
};
template <class Epi, class Sched, bool ALIGN_EPI = false, bool SP2 = false>
__device__ __forceinline__ void gemm_phase(PG8_LAS unsigned char* lds, const Gemm g, const Sched& S, const Epi& E) {
    int tid = threadIdx.x; asm volatile("" : "+v"(tid));
    const int wid = __builtin_amdgcn_readfirstlane(tid >> 6), lane = tid & 63, wr = wid >> 2, wc = wid & 3, fr = lane & 15, fq = lane >> 4;
    const int K = g.K, nt = K / BK;
    unsigned voffA[2], voffB[2];
#pragma unroll
    for (int i = 0; i < 2; ++i) { int R, C; stage_rc(tid * 16 + i * 8192, R, C); const int Rb = Epi::PERM ? ((R & ~31) + perm32(R & 31)) : R;
        voffA[i] = (unsigned)(R * K + C) * 2u; voffB[i] = (unsigned)(Rb * K + C) * 2u; }
    const size_t kstep = (size_t)(BK * 2);
    const size_t hstep = (size_t)HALF * K * 2;
    const size_t tstep = 2 * hstep;
    const unsigned ldsw = (unsigned)wid * 1024u;
    const int aoff = lds_byte(wr * 64 + fr, fq * 8), boff = lds_byte(wc * 32 + fr, fq * 8);
#define PG8_SA(b, h) (((b) * 2 + (h)) * HTB)
#define PG8_SB(b, h) ((4 + (b) * 2 + (h)) * HTB)
#define PG8_STAGE(bufoff, gbase, voff) do { _Pragma("unroll") for (int _i = 0; _i < 2; ++_i) \
        __builtin_amdgcn_global_load_lds((const unsigned*)((const char*)(gbase) + (voff)[_i]), (PG8_LAS unsigned*)(lds + (bufoff) + ldsw + _i * 8192), 16, 0, 0); } while (0)
#define PG8_LDA(dst, b, h) do { _Pragma("unroll") for (int m = 0; m < 4; ++m) _Pragma("unroll") for (int k = 0; k < 2; ++k) dst[m][k] = *(const PG8_LAS bf16x8*)(lds + PG8_SA(b, h) + aoff + m * 2048 + k * 1024); } while (0)
#define PG8_LDB(dst, b, h) do { _Pragma("unroll") for (int n = 0; n < 2; ++n) _Pragma("unroll") for (int k = 0; k < 2; ++k) dst[n][k] = *(const PG8_LAS bf16x8*)(lds + PG8_SB(b, h) + boff + n * 2048 + k * 1024); } while (0)
#define PG8_MMA(ai, bj, At, Bt) do { __builtin_amdgcn_s_setprio(1); _Pragma("unroll") for (int m = 0; m < 4; ++m) _Pragma("unroll") for (int n = 0; n < 2; ++n) _Pragma("unroll") for (int k = 0; k < 2; ++k) \
        acc[ai][bj][m][n] = __builtin_amdgcn_mfma_f32_16x16x32_bf16(Bt[n][k], At[m][k], acc[ai][bj][m][n], 0, 0, 0); __builtin_amdgcn_s_setprio(0); } while (0)
#define PG8_WAIT_V(n) asm volatile("s_waitcnt vmcnt(" #n ")" ::: "memory")
#define PG8_WAIT_L(n) asm volatile("s_waitcnt lgkmcnt(" #n ")" ::: "memory")
#define PG8_BAR __builtin_amdgcn_s_barrier()
#define PG8_SCHED __builtin_amdgcn_sched_barrier(0)
    Unit cur, nxt; int ui = 0;
    if (!S.next(0, cur)) return;
    f32x4 acc[2][2][4][2];
#pragma unroll
    for (int a = 0; a < 2; ++a)
#pragma unroll
        for (int b = 0; b < 2; ++b)
#pragma unroll
            for (int m = 0; m < 4; ++m)
#pragma unroll
                for (int n = 0; n < 2; ++n) acc[a][b][m][n] = (f32x4){0.f, 0.f, 0.f, 0.f};
    bf16x8 At[4][2], B0[2][2], B1[2][2];
    const char* cA = (const char*)g.A + (size_t)cur.pm * tstep; const char* cB = (const char*)g.Bt + (size_t)cur.pn * tstep;
    S.a_ready(cur);
    if constexpr (SP2) {
        PG8_STAGE(PG8_SB(0, 0), cB, voffB); PG8_STAGE(PG8_SB(0, 1), cB + hstep, voffB); PG8_STAGE(PG8_SA(0, 0), cA, voffA); PG8_STAGE(PG8_SA(0, 1), cA + hstep, voffA);
        if (wr == 1) PG8_BAR;
        PG8_WAIT_V(2); PG8_BAR;
        PG8_STAGE(PG8_SB(1, 0), cB + kstep, voffB); PG8_STAGE(PG8_SA(1, 0), cA + kstep, voffA); PG8_STAGE(PG8_SB(1, 1), cB + hstep + kstep, voffB);
        PG8_WAIT_V(6); PG8_BAR;
    } else {
        PG8_STAGE(PG8_SB(0, 0), cB, voffB); PG8_STAGE(PG8_SA(0, 0), cA, voffA); PG8_STAGE(PG8_SB(0, 1), cB + hstep, voffB); PG8_STAGE(PG8_SA(0, 1), cA + hstep, voffA);
        if (wr == 1) PG8_BAR;
        PG8_WAIT_V(4); PG8_BAR;
        PG8_STAGE(PG8_SB(1, 0), cB + kstep, voffB); PG8_STAGE(PG8_SA(1, 0), cA + kstep, voffA); PG8_STAGE(PG8_SB(1, 1), cB + hstep + kstep, voffB);
        PG8_WAIT_V(6); PG8_BAR;
    }
    for (;;) {
        const bool has_next = S.next(ui + 1, nxt);
        const char* nA = has_next ? (const char*)g.A + (size_t)nxt.pm * tstep : cA; const char* nB = has_next ? (const char*)g.Bt + (size_t)nxt.pn * tstep : cB;
        for (int t = 0; t < nt; t += 2) {
            const bool last = (t == nt - 2);
            const char* a1 = cA + (size_t)(t + 1) * kstep;
            const char* a2 = last ? nA : cA + (size_t)(t + 2) * kstep; const char* b2 = last ? nB : cB + (size_t)(t + 2) * kstep;
            const char* a3 = a2 + kstep; const char* b3 = b2 + kstep;
            if (last && has_next) S.a_ready(nxt);
            if constexpr (SP2) {
            PG8_LDB(B0, 0, 0); PG8_LDB(B1, 0, 1); PG8_SCHED; PG8_LDA(At, 0, 0); PG8_STAGE(PG8_SA(1, 1), a1 + hstep, voffA);
            PG8_WAIT_V(8); PG8_WAIT_L(0); PG8_BAR; PG8_MMA(0, 0, At, B0); PG8_MMA(0, 1, At, B1); PG8_BAR; PG8_SCHED;
            PG8_LDA(At, 0, 1); PG8_STAGE(PG8_SB(0, 0), b2, voffB); PG8_STAGE(PG8_SB(0, 1), b2 + hstep, voffB); PG8_STAGE(PG8_SA(0, 0), a2, voffA);
            PG8_WAIT_V(8); PG8_WAIT_L(0); PG8_BAR; PG8_MMA(1, 0, At, B0); PG8_MMA(1, 1, At, B1); PG8_BAR; PG8_SCHED;
            PG8_LDB(B0, 1, 0); PG8_LDB(B1, 1, 1); PG8_SCHED; PG8_LDA(At, 1, 0); PG8_STAGE(PG8_SA(0, 1), a2 + hstep, voffA);
            PG8_WAIT_V(8); PG8_WAIT_L(0); PG8_BAR; PG8_MMA(0, 0, At, B0); PG8_MMA(0, 1, At, B1); PG8_BAR; PG8_SCHED;
            PG8_LDA(At, 1, 1); PG8_STAGE(PG8_SB(1, 0), b3, voffB); PG8_STAGE(PG8_SB(1, 1), b3 + hstep, voffB); PG8_STAGE(PG8_SA(1, 0), a3, voffA);
            PG8_WAIT_V(8); PG8_WAIT_L(0); PG8_BAR; PG8_MMA(1, 0, At, B0); PG8_MMA(1, 1, At, B1); PG8_BAR; PG8_SCHED;
            } else {
            PG8_LDB(B0, 0, 0); PG8_SCHED; PG8_LDA(At, 0, 0); PG8_STAGE(PG8_SA(1, 1), a1 + hstep, voffA);
            PG8_WAIT_L(8); PG8_BAR; PG8_WAIT_L(0); PG8_MMA(0, 0, At, B0); PG8_BAR; PG8_SCHED;
            PG8_LDB(B1, 0, 1); PG8_STAGE(PG8_SB(0, 0), b2, voffB);
            PG8_BAR; PG8_WAIT_L(0); PG8_MMA(0, 1, At, B1); PG8_BAR;
            PG8_LDA(At, 0, 1); PG8_STAGE(PG8_SA(0, 0), a2, voffA);
            PG8_BAR; PG8_WAIT_L(0); PG8_MMA(1, 0, At, B0); PG8_BAR; PG8_SCHED;
            PG8_STAGE(PG8_SB(0, 1), b2 + hstep, voffB);
            PG8_WAIT_V(6); PG8_BAR; PG8_MMA(1, 1, At, B1); PG8_BAR;
            PG8_LDB(B0, 1, 0); PG8_SCHED; PG8_LDA(At, 1, 0); PG8_STAGE(PG8_SA(0, 1), a2 + hstep, voffA);
            PG8_WAIT_L(8); PG8_BAR; PG8_WAIT_L(0); PG8_MMA(0, 0, At, B0); PG8_BAR; PG8_SCHED;
            PG8_LDB(B1, 1, 1); PG8_STAGE(PG8_SB(1, 0), b3, voffB);
            PG8_BAR; PG8_WAIT_L(0); PG8_MMA(0, 1, At, B1); PG8_BAR;
            PG8_LDA(At, 1, 1); PG8_STAGE(PG8_SA(1, 0), a3, voffA);
            PG8_BAR; PG8_WAIT_L(0); PG8_MMA(1, 0, At, B0); PG8_BAR; PG8_SCHED;
            PG8_STAGE(PG8_SB(1, 1), b3 + hstep, voffB);
            PG8_WAIT_V(6); PG8_BAR; PG8_MMA(1, 1, At, B1); PG8_BAR;
            }
        }
        if constexpr (ALIGN_EPI) { if (wr == 0) PG8_BAR; }
        if constexpr (!Epi::AFTER_DRAIN) { E(acc, cur, wr, wc, fr, fq); S.done(cur); }
        if (!has_next) break;
#pragma unroll
        for (int a = 0; a < 2; ++a)
#pragma unroll
            for (int b = 0; b < 2; ++b)
#pragma unroll
                for (int m = 0; m < 4; ++m)
#pragma unroll
                    for (int n = 0; n < 2; ++n) acc[a][b][m][n] = (f32x4){0.f, 0.f, 0.f, 0.f};
        cur = nxt; cA = nA; cB = nB; ++ui;
        if constexpr (ALIGN_EPI) { if (wr == 1) PG8_BAR; }
    }
    PG8_WAIT_V(0);
    if constexpr (!ALIGN_EPI) { if (wr == 0) PG8_BAR; }
    PG8_BAR;
    if constexpr (Epi::AFTER_DRAIN) { E.fused(acc, cur, wr, wc, fr, fq, lds, wid, lane); S.done(cur); }
#undef PG8_SA
#undef PG8_SB
#undef PG8_STAGE
#undef PG8_LDA
#undef PG8_LDB
#undef PG8_MMA
#undef PG8_WAIT_V
#undef PG8_WAIT_L
#undef PG8_BAR
#undef PG8_SCHED
}
}
#define GAS __attribute__((address_space(1)))
#define LAS __attribute__((address_space(3)))
typedef unsigned short bf16;
typedef unsigned v4u __attribute__((ext_vector_type(4)));
typedef float f32x4 __attribute__((ext_vector_type(4)));
typedef short bf16x8 __attribute__((ext_vector_type(8)));
typedef GAS unsigned gu32;
typedef GAS unsigned long long gu64;
#define RLX_AGENT __ATOMIC_RELAXED, __HIP_MEMORY_SCOPE_AGENT
#define LDS_WAIT() asm volatile("s_waitcnt lgkmcnt(0)" ::: "memory")
#define VM_WAIT() asm volatile("s_waitcnt vmcnt(0)" ::: "memory")
__device__ __forceinline__ unsigned long long rt() { return __builtin_amdgcn_s_memrealtime(); }
__device__ __forceinline__ unsigned f2bf(float f) { unsigned u = __builtin_bit_cast(unsigned, f); return (u + 0x7fffu + ((u >> 16) & 1u)) >> 16; }
__device__ __forceinline__ unsigned pk2(float lo, float hi) { return f2bf(lo) | (f2bf(hi) << 16); }

#define XB_TMO      128
#define XB_XCNT(j)  (256  + 64 * (j))
#define XB_XSUB(j)  (1280 + 64 * (j))
#define XB_XGEN(j)  (2304 + 64 * (j))
#define XB_TOP      3328
#define XB_TOPGEN   3392
#define XCD_BAR_WORDS 3456
#define XB_SPIN_CAP (1u << 18)

__device__ __forceinline__ unsigned xb_ld(unsigned* p)              { return __hip_atomic_load(p, __ATOMIC_RELAXED, __HIP_MEMORY_SCOPE_AGENT); }
__device__ __forceinline__ unsigned xb_add(unsigned* p, unsigned v) { return __hip_atomic_fetch_add(p, v, __ATOMIC_RELAXED, __HIP_MEMORY_SCOPE_AGENT); }
__device__ __forceinline__ unsigned xb_xcc_id() { return (unsigned)__builtin_amdgcn_s_getreg((3 << 11) | 20) & 0xFu; }
#define XB_SPIN(cond, bar) do { unsigned _sp = 0; while (cond) { __builtin_amdgcn_s_sleep(1); \
    if ((++_sp & 255u) == 0u) { if (xb_ld(&(bar)[XB_TMO])) break; if (_sp > XB_SPIN_CAP) { atomicAdd(&(bar)[XB_TMO], 1u); break; } } } } while (0)

struct XcdBarrier {
    unsigned* bar; unsigned x;
    volatile LAS unsigned* st;
};

__device__ __forceinline__ XcdBarrier xcd_barrier_post(unsigned* bar, volatile LAS unsigned* st) {
    XcdBarrier b; b.bar = bar; b.x = xb_xcc_id(); b.st = st;
    if (threadIdx.x == 0) (void)xb_add(&bar[XB_XCNT(b.x)], 1u);
    return b;
}
__device__ __forceinline__ void xcd_barrier_complete(unsigned* bar, unsigned x, unsigned& nloc, unsigned& nx) {
    const unsigned G = gridDim.x * gridDim.y * gridDim.z;
    unsigned sum, cnt, mine, sp = 0u;
    for (;;) {
        sum = 0u; cnt = 0u; mine = 0u;
#pragma unroll
        for (unsigned j = 0; j < 16; ++j) { const unsigned c = xb_ld(&bar[XB_XCNT(j)]); sum += c; cnt += (c > 0u) ? 1u : 0u; mine = (j == x) ? c : mine; }
        if (sum == G) break;
        __builtin_amdgcn_s_sleep(1);
        if ((++sp & 255u) == 0u) { if (xb_ld(&bar[XB_TMO])) break; if (sp > XB_SPIN_CAP) { atomicAdd(&bar[XB_TMO], 1u); break; } }
    }
    nloc = mine > 0u ? mine : 1u; nx = cnt > 0u ? cnt : 1u;
}

__device__ __forceinline__ void xcd_barrier(const XcdBarrier& b) {
    asm volatile("s_waitcnt vmcnt(0)" ::: "memory");
    __syncthreads();
    if (threadIdx.x == 0) {
        unsigned* bar = b.bar;
        __builtin_amdgcn_s_waitcnt(0);
        unsigned nloc = b.st[0], nx = b.st[1];
        if (nloc == 0u) { xcd_barrier_complete(bar, b.x, nloc, nx); b.st[0] = nloc; b.st[1] = nx; }
        const unsigned old = xb_add(&bar[XB_XSUB(b.x)], 1u);
        const unsigned gen = old / nloc;
        if (old + 1u == (gen + 1u) * nloc) {
            __builtin_amdgcn_fence(__ATOMIC_RELEASE, "agent");
            asm volatile("s_waitcnt vmcnt(0)" ::: "memory");
            const unsigned og = xb_add(&bar[XB_TOP], 1u);
            const unsigned tg = og / nx;
            if (og + 1u == (tg + 1u) * nx) xb_add(&bar[XB_TOPGEN], 1u);
            else XB_SPIN(xb_ld(&bar[XB_TOPGEN]) == tg, bar);
            __builtin_amdgcn_fence(__ATOMIC_ACQUIRE, "agent");
            xb_add(&bar[XB_XGEN(b.x)], 1u);
            asm volatile("s_waitcnt vmcnt(0)" ::: "memory");
        } else {
            XB_SPIN(xb_ld(&bar[XB_XGEN(b.x)]) == gen, bar);
            __builtin_amdgcn_fence(__ATOMIC_ACQUIRE, "agent");
            asm volatile("s_waitcnt vmcnt(0)" ::: "memory");
        }
    }
    __syncthreads();
}
#include <hip/hip_bf16.h>
#include <cmath>
namespace attn_body {
using bf16=__hip_bfloat16;
using bf16x8=__attribute__((ext_vector_type(8)))short;
using s16x4=__attribute__((ext_vector_type(4)))short;
using f32x16=__attribute__((ext_vector_type(16)))float;
using u32x4=__attribute__((ext_vector_type(4)))unsigned;
constexpr int BATCH=4,NHEAD=8,SEQ=4096,D=64,DM=NHEAD*D;
constexpr int NW=8,QBLK=32,QB=QBLK*NW,KVBLK=64,NQB=SEQ/QB;
constexpr int ATTN_PITCH=DM, ATTN_UNIT_ROWS=QB;
__device__ __forceinline__ int crow(int r,int hi){return (r&3)+8*(r>>2)+4*hi;}
#define SBAR() __builtin_amdgcn_sched_barrier(0)
__device__ __forceinline__ void cmask(f32x16&p0,f32x16&p1,int jb,int qrel,int hi){
  const float NEG=-INFINITY; int kb=64*jb+4*hi;
  #pragma unroll
  for(int r=0;r<16;++r){int kv=kb+(r&3)+8*(r>>2); if(kv>qrel)p0[r]=NEG; if(kv+32>qrel)p1[r]=NEG;}
}

constexpr int NSLOT=3, SLOTB=8192;
constexpr int LDS_K=0, LDS_V=NSLOT*SLOTB, LDS_WS=2*NSLOT*SLOTB, LDS_OST=LDS_WS+NW*64*4, LDS_CK=LDS_OST+NW*4096, LDS_BYTES=LDS_CK+SEQ*4;
constexpr float C2=0.125f*1.4426950408889634f;
__device__ __forceinline__ void glds16(const void*gsrc,unsigned lds_dst){unsigned keep;
  asm volatile("s_mov_b32 %0, m0\n\ts_mov_b32 m0, %2\n\ts_nop 0\n\tglobal_load_lds_dwordx4 %1, off\n\ts_mov_b32 m0, %0":"=&s"(keep):"v"(gsrc),"s"(lds_dst):"memory");}
__device__ __forceinline__ float max3f(float a,float b,float c){float r;asm("v_max3_f32 %0, %1, %2, %3":"=v"(r):"v"(a),"v"(b),"v"(c));return r;}
__device__ __forceinline__ float max2f(float a,float b){float r;asm("v_max_f32_e32 %0, %1, %2":"=v"(r):"v"(a),"v"(b));return r;}
__device__ __forceinline__ float fadd_s(float a,float b){float r;asm("v_add_f32_e32 %0, %1, %2":"=v"(r):"v"(a),"v"(b));return r;}
__device__ __forceinline__ float fsub_s(float a,float b){float r;asm("v_sub_f32_e32 %0, %1, %2":"=v"(r):"v"(a),"v"(b));return r;}
typedef float f32x2_t __attribute__((ext_vector_type(2))); typedef __bf16 bf16x2_t __attribute__((ext_vector_type(2)));
__device__ __forceinline__ unsigned cvtpk_s(float lo,float hi){f32x2_t v={lo,hi};bf16x2_t b=__builtin_convertvector(v,bf16x2_t);return __builtin_bit_cast(unsigned,b);}
#define WAIT_BAR(N) asm volatile("s_waitcnt vmcnt(" #N ") lgkmcnt(0)\n\ts_barrier":::"memory")

__device__ __forceinline__ void qkt(f32x16&p0,f32x16&p1,const char*Kslot,const bf16x8*qr,int r32,int hi){
  const char*kb=Kslot+hi*1024+r32*16;
  #pragma unroll
  for(int d0=0;d0<4;++d0){
    const bf16x8 b0=*reinterpret_cast<const bf16x8*>(kb+d0*2048);
    const bf16x8 b1=*reinterpret_cast<const bf16x8*>(kb+d0*2048+512);
    p0=__builtin_amdgcn_mfma_f32_32x32x16_bf16(b0,qr[d0],p0,0,0,0);p1=__builtin_amdgcn_mfma_f32_32x32x16_bf16(b1,qr[d0],p1,0,0,0);}
}
typedef __attribute__((address_space(3))) const char* lds_cptr;
typedef short v4i16_t __attribute__((ext_vector_type(4)));
__device__ __forceinline__ void kload8(bf16x8*kf,lds_cptr kp){
  kf[0]=*(const __attribute__((address_space(3))) bf16x8*)(kp);      kf[1]=*(const __attribute__((address_space(3))) bf16x8*)(kp+512);
  kf[2]=*(const __attribute__((address_space(3))) bf16x8*)(kp+2048); kf[3]=*(const __attribute__((address_space(3))) bf16x8*)(kp+2560);
  kf[4]=*(const __attribute__((address_space(3))) bf16x8*)(kp+4096); kf[5]=*(const __attribute__((address_space(3))) bf16x8*)(kp+4608);
  kf[6]=*(const __attribute__((address_space(3))) bf16x8*)(kp+6144); kf[7]=*(const __attribute__((address_space(3))) bf16x8*)(kp+6656);
}
__device__ __forceinline__ void kload2(bf16x8*kf,lds_cptr kp,int j){ kf[2*j]=*(const __attribute__((address_space(3))) bf16x8*)(kp+j*2048); kf[2*j+1]=*(const __attribute__((address_space(3))) bf16x8*)(kp+j*2048+512); }
__device__ __forceinline__ s16x4 vtr(lds_cptr p){ return __builtin_bit_cast(s16x4,__builtin_amdgcn_ds_read_tr16_b64_v4i16((__attribute__((address_space(3))) v4i16_t*)p)); }
__device__ __forceinline__ float rowmax(const f32x16&p0,const f32x16&p1){
  float a=max3f(p0[0],p0[1],p1[0]),b=max3f(p0[2],p0[3],p1[1]);a=max3f(a,p1[2],p1[3]);
  #pragma unroll
  for(int r=4;r<16;r+=4){a=max3f(a,p0[r],p0[r+1]);b=max3f(b,p0[r+2],p0[r+3]);a=max3f(a,p1[r],p1[r+1]);b=max3f(b,p1[r+2],p1[r+3]);}
  const float m=max2f(a,b);
  auto rr=__builtin_amdgcn_permlane32_swap(__float_as_uint(m),__float_as_uint(m),false,false);
  return max2f(__uint_as_float(rr[0]),__uint_as_float(rr[1]));
}
__device__ __forceinline__ void pv(f32x16*o,int vb,bf16x8 pa0,bf16x8 pa1,bf16x8 pa2,bf16x8 pa3){
  #pragma unroll
  for(int d0=0;d0<2;++d0){s16x4 lo[4],hi[4];
    #pragma unroll
    for(int ks=0;ks<4;++ks){
      asm volatile("ds_read_b64_tr_b16 %0,%1 offset:%c2":"=&v"(lo[ks]):"v"(vb),"i"(d0*4096+ks*1024):"memory");
      asm volatile("ds_read_b64_tr_b16 %0,%1 offset:%c2":"=&v"(hi[ks]):"v"(vb),"i"(d0*4096+ks*1024+512):"memory");}
    asm volatile("s_waitcnt lgkmcnt(0)":::"memory");SBAR();
    #define PK(k) (bf16x8){lo[k][0],lo[k][1],lo[k][2],lo[k][3],hi[k][0],hi[k][1],hi[k][2],hi[k][3]}
    o[d0]=__builtin_amdgcn_mfma_f32_32x32x16_bf16(pa0,PK(0),o[d0],0,0,0);
    o[d0]=__builtin_amdgcn_mfma_f32_32x32x16_bf16(pa1,PK(1),o[d0],0,0,0);
    o[d0]=__builtin_amdgcn_mfma_f32_32x32x16_bf16(pa2,PK(2),o[d0],0,0,0);
    o[d0]=__builtin_amdgcn_mfma_f32_32x32x16_bf16(pa3,PK(3),o[d0],0,0,0);
    #undef PK
  }
}

#ifndef ATTN_STORE16
#define ATTN_STORE16(p,v) (*(u32x4*)(p)=(v))
#endif
template<int THRL> __device__ __forceinline__ void attn_unit(int b,int h,int qb,const bf16*Q,const bf16*__restrict__ K,const bf16*__restrict__ V,bf16*O,const float*__restrict__ c2,float M2,char*shm){
  int tid=threadIdx.x; asm volatile("":"+v"(tid)); const int lane=tid&63,r32=lane&31,hi=lane>>5; const int wid=__builtin_amdgcn_readfirstlane(tid>>6);
  const long rowbase=(long)b*SEQ; const int q0=qb*QB;
  const bf16*Qw=Q+(rowbase+q0+wid*QBLK)*DM+h*D;
  const bf16*Kh0=K+rowbase*DM+h*D,*Vh0=V+rowbase*DM+h*D;
  const unsigned lds0=(unsigned)(uintptr_t)shm;
  float*wsf=(float*)(shm+LDS_WS)+wid*64;
  const unsigned kdst=lds0+LDS_K+wid*1024, vdst=lds0+LDS_V+wid*1024;
  #define DMA_K(t,slot) glds16(ksrc+(long)(t)*KVBLK*DM,(unsigned)__builtin_amdgcn_readfirstlane(kdst+(slot)))
  #define DMA_V(t,slot) glds16(vsrc+(long)(t)*KVBLK*DM,(unsigned)__builtin_amdgcn_readfirstlane(vdst+(slot)))
  const int vb0=(int)(lds0+LDS_V)+((lane>>4)&1)*32+(lane&3)*8+(4*hi+((lane&15)>>2))*64;
  const char*Kbase=shm+LDS_K; bf16x8 kf[8];
  const lds_cptr shm3=(lds_cptr)shm; const lds_cptr kp0=shm3+LDS_K+hi*1024+r32*16; const lds_cptr vp0=shm3+LDS_V+((lane>>4)&1)*32+(lane&3)*8+(4*hi+((lane&15)>>2))*64;
  const int NT0=(q0+QB)/KVBLK;
  int ts; { const int tl=lane; const float cqa=c2[q0]; const float ckb=(tl<NT0-4)?c2[64*tl+63]:cqa; const unsigned long long bm=__ballot((tl<NT0-4)&&(cqa-ckb< -(30.f+2.f*M2))); ts=__builtin_popcountll(bm)&~1; }
  ts=__builtin_amdgcn_readfirstlane(ts);
  const int NT=NT0-ts;
  const bf16*Kh=Kh0+(long)ts*KVBLK*DM,*Vh=Vh0+(long)ts*KVBLK*DM;
  const bf16*ksrc=Kh+(long)lane*DM+wid*8;
  const bf16*vsrc=Vh+(long)(16*(wid&3)+(lane>>2))*DM+(wid>>2)*32+(lane&3)*8;
  typedef float f32x4_t __attribute__((ext_vector_type(4)));
  int tidl=tid; asm volatile("":"+v"(tidl));
  const int nck4=(q0+QB)/4; f32x4_t ckv0=f32x4_t{},ckv1=f32x4_t{}; if(tidl<nck4)ckv0=((const f32x4_t*)c2)[tidl]; if(tidl+512<nck4)ckv1=((const f32x4_t*)c2)[tidl+512];
  const float cq=c2[q0+wid*QBLK+r32]-M2;
  DMA_K(0,0);DMA_V(0,0);DMA_K(1,SLOTB);
  bf16x8 qr[4];
  #pragma unroll
  for(int d0=0;d0<4;++d0)qr[d0]=*reinterpret_cast<const bf16x8*>(&Qw[(long)r32*DM+d0*16+hi*8]);
  float l_reg=0.f;f32x16 o[2];o[0]=f32x16{};o[1]=f32x16{};
  { __attribute__((address_space(3))) f32x4_t*ckl=(__attribute__((address_space(3))) f32x4_t*)((lds_cptr)shm+LDS_CK); if(tidl<nck4)ckl[tidl]=ckv0; if(tidl+512<nck4)ckl[tidl+512]=ckv1; }
  const __attribute__((address_space(3))) f32x4_t*ckp=(const __attribute__((address_space(3))) f32x4_t*)((lds_cptr)shm+LDS_CK)+hi+ts*16;
  #define CKLD(P0,P1,t) do{ _Pragma("unroll") for(int g_=0;g_<4;++g_){ const f32x4_t a_=ckp[(t)*16+2*g_], b_=ckp[(t)*16+8+2*g_]; P0[4*g_]=a_[0];P0[4*g_+1]=a_[1];P0[4*g_+2]=a_[2];P0[4*g_+3]=a_[3]; P1[4*g_]=b_[0];P1[4*g_+1]=b_[1];P1[4*g_+2]=b_[2];P1[4*g_+3]=b_[3]; } }while(0)
  #define CKSUB(P0,P1) do{ _Pragma("unroll") for(int r=0;r<16;++r){P0[r]=cq-P0[r];P1[r]=cq-P1[r];} }while(0)
  const int qrel=wid*QBLK+r32;
  #define CMASK(P0,P1,t) do{int jb_=(t)-(NT-4); if(jb_>=0)cmask(P0,P1,jb_,qrel,hi);}while(0)
  #define START(P0,P1) do{ _Pragma("unroll") for(int r=0;r<16;++r)P0[r]=__builtin_amdgcn_exp2f(P0[r]); }while(0)
  #define RESC() do{}while(0)
  f32x16 pA0,pA1,pB0,pB1;
  int sl_prev=0,sl_cur=0,sl_next=SLOTB;
  #define ROT() do{sl_prev=sl_cur;sl_cur=sl_next;sl_next=(sl_next==(NSLOT-1)*SLOTB)?0:sl_next+SLOTB;}while(0)
  DMA_K(2,2*SLOTB);
  WAIT_BAR(3);
  CKLD(pA0,pA1,0);CKSUB(pA0,pA1);
  qkt(pA0,pA1,Kbase,qr,r32,hi);asm volatile("s_nop 15\n\ts_nop 7":"+v"(pA0),"+v"(pA1));CMASK(pA0,pA1,0);
  CKLD(pB0,pB1,1);CKSUB(pB0,pB1);
  START(pA0,pA1);
  _Pragma("unroll") for(int r=0;r<16;++r)pA1[r]=__builtin_amdgcn_exp2f(pA1[r]);
  WAIT_BAR(0);
  DMA_K(3,0);DMA_V(1,SLOTB);
  ROT();
  kload8(kf,kp0+sl_cur);
  WAIT_BAR(2);
  s16x4 vlo[8],vhi[8]; u32x4 pw0,pw1,pw2,pw3;
  #define PKW(P,B) cvtpk_s(P[B],P[B+1])
  #define PAF(k) __builtin_bit_cast(bf16x8,pw##k)
  #define VFR(i) (bf16x8){vlo[i][0],vlo[i][1],vlo[i][2],vlo[i][3],vhi[i][0],vhi[i][1],vhi[i][2],vhi[i][3]}
  #define PIN(x) asm volatile("":"+v"(x))
  #define MX3(a,b,c) __builtin_fmaxf(__builtin_fmaxf((a),(b)),(c))
  #define GAPA(MF,A0,A1,A2,A3,W0,W1,PW) do{ MF; sacc+=A0; sacc+=A1; sacc+=A2; sacc+=A3; PIN(sacc); W0; W1; PIN(PW); SBAR(); }while(0)
  #define EX(v) __builtin_amdgcn_exp2f(v)
  #define GAPB(MF,X,B) do{ MF; X[B]=EX(X[B]); X[B+1]=EX(X[B+1]); X[B+2]=EX(X[B+2]); X[B+3]=EX(X[B+3]); PIN(X); SBAR(); }while(0)
  #define VRD(i) do{ vlo[i]=vtr(vp_+(((i)>>2)*4096+((i)&3)*1024)); vhi[i]=vtr(vp_+(((i)>>2)*4096+((i)&3)*1024+512)); }while(0)
  #define KRD(G,j) do{ if(G){ kload2(kf,kp0+sl_next,j); SBAR(); } }while(0)
  #define STEP(C0,C1,P0,P1,t,GK,GV,GL) do{ SBAR(); \
    const lds_cptr vp_=vp0+sl_prev; \
    VRD(0); SBAR(); float sacc=(P0[0]+P0[1]); \
    GAPA(C0=__builtin_amdgcn_mfma_f32_32x32x16_bf16(kf[0],qr[0],C0,0,0,0), P0[2],P0[3],P0[4],P0[5],     pw0[0]=PKW(P0,0), pw0[1]=PKW(P0,2), pw0); \
    VRD(4); SBAR(); GAPA(C1=__builtin_amdgcn_mfma_f32_32x32x16_bf16(kf[1],qr[0],C1,0,0,0), P0[6],P0[7],P0[8],P0[9],     pw0[2]=PKW(P0,4), pw0[3]=PKW(P0,6), pw0); \
    VRD(1); SBAR(); GAPA(C0=__builtin_amdgcn_mfma_f32_32x32x16_bf16(kf[2],qr[1],C0,0,0,0),   P0[10],P0[11],P0[12],P0[13], pw1[0]=PKW(P0,8), pw1[1]=PKW(P0,10), pw1); \
    VRD(5); SBAR(); GAPA(C1=__builtin_amdgcn_mfma_f32_32x32x16_bf16(kf[3],qr[1],C1,0,0,0),   P0[14],P0[15],P1[0],P1[1],   pw1[2]=PKW(P0,12),pw1[3]=PKW(P0,14), pw1); \
    VRD(2); SBAR(); GAPA(C0=__builtin_amdgcn_mfma_f32_32x32x16_bf16(kf[4],qr[2],C0,0,0,0),   P1[2],P1[3],P1[4],P1[5],     pw2[0]=PKW(P1,0), pw2[1]=PKW(P1,2), pw2); \
    VRD(6); SBAR(); GAPA(C1=__builtin_amdgcn_mfma_f32_32x32x16_bf16(kf[5],qr[2],C1,0,0,0),   P1[6],P1[7],P1[8],P1[9],     pw2[2]=PKW(P1,4), pw2[3]=PKW(P1,6), pw2); \
    VRD(3); SBAR(); GAPA(C0=__builtin_amdgcn_mfma_f32_32x32x16_bf16(kf[6],qr[3],C0,0,0,0),   P1[10],P1[11],P1[12],P1[13], pw3[0]=PKW(P1,8), pw3[1]=PKW(P1,10), pw3); \
    VRD(7); SBAR(); GAPA(C1=__builtin_amdgcn_mfma_f32_32x32x16_bf16(kf[7],qr[3],C1,0,0,0),   P1[14],P1[15],0.f,0.f,       pw3[2]=PKW(P1,12),pw3[3]=PKW(P1,14), pw3); \
    l_reg+=sacc; \
    if(GK){DMA_K((t)+3,sl_cur);} if(GV){DMA_V((t)+1,sl_next);} \
    CMASK(C0,C1,t); \
    SBAR(); \
    GAPB(o[0]=__builtin_amdgcn_mfma_f32_32x32x16_bf16(PAF(0),VFR(0),o[0],0,0,0), C0,0); \
    GAPB(o[1]=__builtin_amdgcn_mfma_f32_32x32x16_bf16(PAF(0),VFR(4),o[1],0,0,0), C0,4); \
    KRD(GL,0); GAPB(o[0]=__builtin_amdgcn_mfma_f32_32x32x16_bf16(PAF(1),VFR(1),o[0],0,0,0), C0,8); \
    KRD(GL,1); GAPB(o[1]=__builtin_amdgcn_mfma_f32_32x32x16_bf16(PAF(1),VFR(5),o[1],0,0,0), C0,12); \
    KRD(GL,2); GAPB(o[0]=__builtin_amdgcn_mfma_f32_32x32x16_bf16(PAF(2),VFR(2),o[0],0,0,0), C1,0); \
    KRD(GL,3); GAPB(o[1]=__builtin_amdgcn_mfma_f32_32x32x16_bf16(PAF(2),VFR(6),o[1],0,0,0), C1,4); \
    GAPB(o[0]=__builtin_amdgcn_mfma_f32_32x32x16_bf16(PAF(3),VFR(3),o[0],0,0,0), C1,8); \
    GAPB(o[1]=__builtin_amdgcn_mfma_f32_32x32x16_bf16(PAF(3),VFR(7),o[1],0,0,0), C1,12); \
    if(GL){ CKLD(P0,P1,(t)+1); CKSUB(P0,P1); } \
    }while(0)
  int t=1;
  #undef CMASK
  #define CMASK(P0,P1,t) do{}while(0)
  for(;t+5<NT;t+=2){
    STEP(pB0,pB1,pA0,pA1,t,true,true,true);     WAIT_BAR(2); RESC(); ROT();
    STEP(pA0,pA1,pB0,pB1,t+1,true,true,true);   WAIT_BAR(2); RESC(); ROT();
  }
  #undef CMASK
  #define CMASK(P0,P1,t) do{int jb_=(t)-(NT-4); if(jb_>=0)cmask(P0,P1,jb_,qrel,hi);}while(0)
  #define ENDW(tt) do{ if((tt)+3<NT){WAIT_BAR(2);} else if((tt)+2<NT){WAIT_BAR(1);} else {WAIT_BAR(0);} }while(0)
  for(;t+1<NT;t+=2){
    STEP(pB0,pB1,pA0,pA1,t,(t+3<NT),(t+1<NT),(t+1<NT));       ENDW(t);   RESC(); ROT();
    STEP(pA0,pA1,pB0,pB1,t+1,(t+4<NT),(t+2<NT),(t+2<NT));     ENDW(t+1); RESC(); ROT();
  }
  STEP(pB0,pB1,pA0,pA1,NT-1,false,false,false); RESC();
  { float sacc=pB0[0]+pB0[1]; _Pragma("unroll") for(int r=2;r<16;++r)sacc+=pB0[r]; _Pragma("unroll") for(int r=0;r<16;++r)sacc+=pB1[r]; l_reg+=sacc;
    pw0=(u32x4){PKW(pB0,0),PKW(pB0,2),PKW(pB0,4),PKW(pB0,6)};pw1=(u32x4){PKW(pB0,8),PKW(pB0,10),PKW(pB0,12),PKW(pB0,14)};pw2=(u32x4){PKW(pB1,0),PKW(pB1,2),PKW(pB1,4),PKW(pB1,6)};pw3=(u32x4){PKW(pB1,8),PKW(pB1,10),PKW(pB1,12),PKW(pB1,14)};
    SBAR(); pv(o,vb0+sl_cur,PAF(0),PAF(1),PAF(2),PAF(3)); }
  #undef PKW
  #undef PAF
  #undef VFR
  #undef PIN
  #undef MX3
  #undef GAPA
  #undef GAPB
  #undef EX
  #undef VRD
  #undef KRD
  #undef STEP
  #undef ENDW
  {auto rr=__builtin_amdgcn_permlane32_swap(__float_as_uint(l_reg),__float_as_uint(l_reg),false,false);l_reg=__uint_as_float(rr[0])+__uint_as_float(rr[1]);}
  if(hi==0)wsf[32+r32]=l_reg;asm volatile("s_waitcnt lgkmcnt(0)":::"memory");
  float rli[16];
  #pragma unroll
  for(int r=0;r<16;++r)rli[r]=__builtin_amdgcn_rcpf(wsf[32+crow(r,hi)]);
  bf16*Ow=O+(rowbase+q0+wid*QBLK)*DM+h*D;
  { bf16*stg=(bf16*)(shm+LDS_OST)+wid*2048;
    #pragma unroll
    for(int r=0;r<16;++r){const int orow=crow(r,hi);
      #pragma unroll
      for(int d0=0;d0<2;++d0)stg[orow*64+d0*32+r32]=__float2bfloat16(o[d0][r]*rli[r]);}
    asm volatile("s_waitcnt lgkmcnt(0)":::"memory");
    #pragma unroll
    for(int i=0;i<4;++i){const int row=i*8+(lane>>3),ch=lane&7; const u32x4 v=*(const u32x4*)(stg+row*64+ch*8); ATTN_STORE16(Ow+(long)row*DM+ch*8,v);} }
  asm volatile("s_waitcnt lgkmcnt(0)\n\ts_barrier":::"memory");
  #undef DMA_K
  #undef DMA_V
  #undef CMASK
  #undef START
  #undef RESC
  #undef ROT
  #undef CKLD
  #undef CKSUB
}
constexpr int ATTN_LDS_BYTES=LDS_BYTES;
struct AttnTensors { const bf16* Q; const bf16* K; const bf16* V; bf16* O; const float* C2T; float M2; };
struct AttnUnit { int bh; int qb; };
struct StaticOrder {
  int vcu, G;
  __device__ __forceinline__ explicit StaticOrder(int grid,int v):vcu(v),G(grid){}
  __device__ __forceinline__ bool next(int i,AttnUnit&u)const{ const int L=i*G+vcu; if(L>=BATCH*NHEAD*NQB)return false; const int r=L>>8, idx=L&255, k=idx&7; u.bh=idx>>3; u.qb=(r==0)?(NQB-1-k):k; return true; }
  __device__ __forceinline__ void a_ready(const AttnUnit&)const{}
  __device__ __forceinline__ void done(const AttnUnit&)const{}
};
template<class Sched,int THRL=8> __device__ __forceinline__ void attn_phase(char*lds,const AttnTensors&T,const Sched&S){
  AttnUnit u;
  for(int i=0;S.next(i,u);++i){ S.a_ready(u); attn_unit<THRL>(u.bh/NHEAD,u.bh%NHEAD,u.qb,T.Q,T.K,T.V,T.O,T.C2T+(size_t)u.bh*SEQ,T.M2,lds); S.done(u); }
}
#undef SBAR
#undef WAIT_BAR
}

constexpr int NWAVES = 8, NTHR = 512;
constexpr int DM = 1024, NB = 4, SEQ = 4096, DB = 128, DSEQ = 8, PAST = 2048, PAGE = 128, NPAGES = 16;
constexpr int MP = NB * SEQ, MS = DB * DSEQ, M = MP + MS;
constexpr int DP = 512, DA = 512, NH = 8, HD = 64, DIN = 4104, NPROJ = 4096;
constexpr int NKEYS = 128, NEXP = 16384, PH = 8, TOPK = 16, DKH = 128, DQ = 2048;
constexpr float EPS = 1e-6f;
constexpr float LOG2E = 1.4426950408889634f;
constexpr float C2 = 0.125f * LOG2E;
constexpr size_t O_YP = 0, O_YS = O_YP + (size_t)MP * DM, O_KP = O_YS + (size_t)MS * DM, O_VP = O_KP + (size_t)MP * DA, O_LFP = O_VP + (size_t)MP * DA,
                 O_PP = O_LFP + (size_t)MP * NH, O_KS = O_PP + (size_t)NB * 15 * DP, O_VS = O_KS + (size_t)MS * DA, O_LFS = O_VS + (size_t)MS * DA,
                 O_PS = O_LFS + (size_t)MS * NH, O_END = O_PS + (size_t)DB * 15 * DP;
constexpr size_t MiB = 1u << 20;
constexpr size_t WS_CTL = 0, CTL_ZERO_BYTES = 1 * MiB;
constexpr size_t WS_WIN = 2 * MiB, WS_WBP = 10 * MiB, WS_WBA = 11 * MiB, WS_WOUT = 12 * MiB, WS_WQ = 14 * MiB, WS_SUBK = 18 * MiB, WS_CP2 = 19 * MiB, WS_RSS = 20 * MiB, WS_US = 22 * MiB, WS_VS = 23 * MiB;
constexpr size_t WS_PU = 32 * MiB, WS_PV = 64 * MiB, WS_XN = 96 * MiB  , WS_U = 132 * MiB, WS_Q = 150 * MiB, WS_K = 168 * MiB, WS_V = 186 * MiB,
                 WS_GA = 204 * MiB, WS_GB = 240 * MiB, WS_PO = 276 * MiB, WS_AO = 294 * MiB, WS_T = 312 * MiB, WS_MIX = 348 * MiB, WS_PQ = 384 * MiB,
                 WS_SI = 456 * MiB, WS_SG = 466 * MiB, WS_H = 476 * MiB, WS_END = 548 * MiB;
constexpr int CW_BAR = 4096;
constexpr int LDS_BYTES = 163840;
constexpr int SCR_BYTES = 159 * 1024;
constexpr int MISC_OFF = SCR_BYTES;

typedef unsigned short bf16;
typedef unsigned v4u __attribute__((ext_vector_type(4)));
typedef unsigned v2u __attribute__((ext_vector_type(2)));
typedef float f32x4 __attribute__((ext_vector_type(4)));
typedef float f32x2 __attribute__((ext_vector_type(2)));

__device__ __forceinline__ float bf2f(unsigned short b) { return __uint_as_float((unsigned)b << 16); }
__device__ __forceinline__ float bflo(unsigned w) { return __uint_as_float(w << 16); }
__device__ __forceinline__ float bfhi(unsigned w) { return __uint_as_float(w & 0xffff0000u); }
typedef __bf16 bf16x2_t __attribute__((ext_vector_type(2)));
__device__ __forceinline__ unsigned pkbf(float lo, float hi) { f32x2 v = {lo, hi}; bf16x2_t b = __builtin_convertvector(v, bf16x2_t); return __builtin_bit_cast(unsigned, b); }
__device__ __forceinline__ float wave_sum(float v) {
#pragma unroll
    for (int o = 1; o < 64; o <<= 1) v += __shfl_xor(v, o);
    return v;
}
__device__ __forceinline__ float wave_max(float v) {
#pragma unroll
    for (int o = 1; o < 64; o <<= 1) v = fmaxf(v, __shfl_xor(v, o));
    return v;
}

struct Args {
    const float* x_p; const float* x_s; const float* cache_k; const float* cache_v; const float* cache_lf; const float* state_pool; const int* page_table;
    const float* norm_mix_g; const float* w_in; const float* b_forget; const float* q_norm_g; const float* k_norm_g; const float* pool_mix_w; const float* pool_scale;
    const float* w_bp; const float* w_ba; const float* w_out; const float* norm_ffn_g; const float* w_query; const float* sub_keys; const float* peer_u; const float* peer_v;
    float* out; unsigned char* ws; int ph_lo, ph_hi, li, pad;
};

using pg8::Unit;
struct EpiInProj {
    static constexpr bool PERM = true, AFTER_DRAIN = false;
    bf16 *U, *Q, *K, *V, *GA, *GB; float* out; const float *gq, *gk; int pn_off;
    __device__ __forceinline__ void operator()(const f32x4 (&acc)[2][2][4][2], const Unit& u, int wr, int wc, int fr, int fq) const {
        const int pn = u.pn + pn_off; const int row0 = u.pm * 256 + wr * 64 + fr; const bool prompt = u.pm < (MP / 256);
        if (pn < 2) {
#pragma unroll
            for (int ai = 0; ai < 2; ++ai)
#pragma unroll
                for (int m = 0; m < 4; ++m) { const int row = row0 + ai * 128 + m * 16;
                    float* tail = nullptr;
                    if (prompt) { const int s = row & (SEQ - 1), b = row >> 12; if (s >= SEQ - 15) tail = out + O_PP + (size_t)(b * 15 + (s - (SEQ - 15))) * DP; }
                    else { const int rs = row - MP; tail = out + O_PS + (size_t)((rs >> 3) * 15 + 7 + (rs & 7)) * DP; }
#pragma unroll
                    for (int bj = 0; bj < 2; ++bj) { const int col = pn * 256 + bj * 128 + wc * 32 + 8 * fq; const f32x4 v0 = acc[ai][bj][m][0], v1 = acc[ai][bj][m][1];
                        v4u w; w.x = pkbf(v0[0], v0[1]); w.y = pkbf(v0[2], v0[3]); w.z = pkbf(v1[0], v1[1]); w.w = pkbf(v1[2], v1[3]);
                        *(v4u*)(U + (size_t)row * DP + col) = w;
                        if (tail) { *(f32x4*)(tail + col) = v0; *(f32x4*)(tail + col + 4) = v1; } } }
        } else if (pn < 6) {
            const bool isq = pn < 4; const int head = 4 * (pn & 1) + wc; const float* g = isq ? gq : gk;
            f32x4 gv[2][2];
#pragma unroll
            for (int bj = 0; bj < 2; ++bj)
#pragma unroll
                for (int n = 0; n < 2; ++n) gv[bj][n] = *(const f32x4*)(g + 32 * bj + 8 * fq + 4 * n);
            bf16* dst = isq ? Q : K;
#pragma unroll
            for (int ai = 0; ai < 2; ++ai)
#pragma unroll
                for (int m = 0; m < 4; ++m) { const int row = row0 + ai * 128 + m * 16; float ss = 0.f;
#pragma unroll
                    for (int bj = 0; bj < 2; ++bj)
#pragma unroll
                        for (int n = 0; n < 2; ++n) { const f32x4 x = acc[ai][bj][m][n]; ss += (x[0] * x[0] + x[1] * x[1]) + (x[2] * x[2] + x[3] * x[3]); }
                    ss += __shfl_xor(ss, 16); ss += __shfl_xor(ss, 32);
                    float r = 1.0f / sqrtf(ss * (1.0f / 64.0f) + EPS);
                    float* kout = isq ? nullptr : (prompt ? out + O_KP + (size_t)row * DA : out + O_KS + (size_t)(row - MP) * DA);
                    const float rq = isq ? r * C2 : r;
#pragma unroll
                    for (int bj = 0; bj < 2; ++bj) { const int col = head * 64 + 32 * bj + 8 * fq; const f32x4 v0 = acc[ai][bj][m][0] * gv[bj][0] * rq, v1 = acc[ai][bj][m][1] * gv[bj][1] * rq;
                        v4u w; w.x = pkbf(v0[0], v0[1]); w.y = pkbf(v0[2], v0[3]); w.z = pkbf(v1[0], v1[1]); w.w = pkbf(v1[2], v1[3]);
                        *(v4u*)(dst + (size_t)row * DA + col) = w;
                        if (!isq) { *(f32x4*)(kout + col) = v0; *(f32x4*)(kout + col + 4) = v1; } } }
        } else if (pn < 8) {
#pragma unroll
            for (int ai = 0; ai < 2; ++ai)
#pragma unroll
                for (int m = 0; m < 4; ++m) { const int row = row0 + ai * 128 + m * 16;
                    float* vout = prompt ? out + O_VP + (size_t)row * DA : out + O_VS + (size_t)(row - MP) * DA;
#pragma unroll
                    for (int bj = 0; bj < 2; ++bj) { const int col = (pn - 6) * 256 + bj * 128 + wc * 32 + 8 * fq; const f32x4 v0 = acc[ai][bj][m][0], v1 = acc[ai][bj][m][1];
                        v4u w; w.x = pkbf(v0[0], v0[1]); w.y = pkbf(v0[2], v0[3]); w.z = pkbf(v1[0], v1[1]); w.w = pkbf(v1[2], v1[3]);
                        *(v4u*)(V + (size_t)row * DA + col) = w; *(f32x4*)(vout + col) = v0; *(f32x4*)(vout + col + 4) = v1; } }
        } else {
            bf16* dst = pn < 12 ? GA : GB; const int ct = (pn < 12 ? pn - 8 : pn - 12) * 256;
#pragma unroll
            for (int ai = 0; ai < 2; ++ai)
#pragma unroll
                for (int m = 0; m < 4; ++m) { const int row = row0 + ai * 128 + m * 16;
#pragma unroll
                    for (int bj = 0; bj < 2; ++bj) { const int col = ct + bj * 128 + wc * 32 + 8 * fq; float s[8];
#pragma unroll
                        for (int n = 0; n < 2; ++n)
#pragma unroll
                            for (int i = 0; i < 4; ++i) s[4 * n + i] = __builtin_amdgcn_rcpf(1.0f + __builtin_amdgcn_exp2f(-LOG2E * acc[ai][bj][m][n][i]));
                        v4u w; w.x = pkbf(s[0], s[1]); w.y = pkbf(s[2], s[3]); w.z = pkbf(s[4], s[5]); w.w = pkbf(s[6], s[7]);
                        *(v4u*)(dst + (size_t)row * DM + col) = w; } }
        }
    }
};
template <int MODE> struct EpiGate {
    static constexpr bool PERM = true, AFTER_DRAIN = false;
    const bf16* G; const bf16* Tin; bf16* O;
    __device__ __forceinline__ void operator()(const f32x4 (&acc)[2][2][4][2], const Unit& u, int wr, int wc, int fr, int fq) const {
        const int row0 = u.pm * 256 + wr * 64 + fr;
#pragma unroll
        for (int ai = 0; ai < 2; ++ai)
#pragma unroll
            for (int m = 0; m < 4; ++m) { const int row = row0 + ai * 128 + m * 16;
#pragma unroll
                for (int bj = 0; bj < 2; ++bj) { const size_t off = (size_t)row * DM + u.pn * 256 + bj * 128 + wc * 32 + 8 * fq;
                    const v4u g = *(const v4u*)(G + off); const f32x4 v0 = acc[ai][bj][m][0], v1 = acc[ai][bj][m][1];
                    float r[8] = {v0[0] * bflo(g.x), v0[1] * bfhi(g.x), v0[2] * bflo(g.y), v0[3] * bfhi(g.y), v1[0] * bflo(g.z), v1[1] * bfhi(g.z), v1[2] * bflo(g.w), v1[3] * bfhi(g.w)};
                    if (MODE == 1) { const v4u t = *(const v4u*)(Tin + off);
                        r[0] += bflo(t.x); r[1] += bfhi(t.x); r[2] += bflo(t.y); r[3] += bfhi(t.y); r[4] += bflo(t.z); r[5] += bfhi(t.z); r[6] += bflo(t.w); r[7] += bfhi(t.w); }
                    v4u w; w.x = pkbf(r[0], r[1]); w.y = pkbf(r[2], r[3]); w.z = pkbf(r[4], r[5]); w.w = pkbf(r[6], r[7]);
                    *(v4u*)(O + off) = w; } }
    }
};
struct EpiOut {
    static constexpr bool PERM = true, AFTER_DRAIN = false;
    const float* xp; const float* xs; float* H; bf16* HG; const float* gf; float* RSS;
    __device__ __forceinline__ void operator()(const f32x4 (&acc)[2][2][4][2], const Unit& u, int wr, int wc, int fr, int fq) const {
        const int row0 = u.pm * 256 + wr * 64 + fr; const bool prompt = u.pm < (MP / 256);
        f32x4 gv[2][2];
#pragma unroll
        for (int bj = 0; bj < 2; ++bj)
#pragma unroll
            for (int n = 0; n < 2; ++n) gv[bj][n] = *(const f32x4*)(gf + u.pn * 256 + bj * 128 + wc * 32 + 8 * fq + 4 * n);
#pragma unroll
        for (int ai = 0; ai < 2; ++ai)
#pragma unroll
            for (int m = 0; m < 4; ++m) { const int row = row0 + ai * 128 + m * 16; float ss = 0.f;
                const float* xr = prompt ? xp + (size_t)row * DM : xs + (size_t)(row - MP) * DM;
#pragma unroll
                for (int bj = 0; bj < 2; ++bj) { const int col = u.pn * 256 + bj * 128 + wc * 32 + 8 * fq;
                    const f32x4 h0 = acc[ai][bj][m][0] + *(const f32x4*)(xr + col), h1 = acc[ai][bj][m][1] + *(const f32x4*)(xr + col + 4);
                    ss += (h0[0] * h0[0] + h0[1] * h0[1]) + (h0[2] * h0[2] + h0[3] * h0[3]) + (h1[0] * h1[0] + h1[1] * h1[1]) + (h1[2] * h1[2] + h1[3] * h1[3]);
                    *(f32x4*)(H + (size_t)row * DM + col) = h0; *(f32x4*)(H + (size_t)row * DM + col + 4) = h1;
                    const f32x4 a0 = h0 * gv[bj][0], a1 = h1 * gv[bj][1];
                    v4u w; w.x = pkbf(a0[0], a0[1]); w.y = pkbf(a0[2], a0[3]); w.z = pkbf(a1[0], a1[1]); w.w = pkbf(a1[2], a1[3]);
                    *(v4u*)(HG + (size_t)row * DM + col) = w; }
                ss += __shfl_xor(ss, 16); ss += __shfl_xor(ss, 32);
                if (fq == 0) RSS[(size_t)row * 16 + u.pn * 4 + wc] = ss; }
    }
};

struct Frame {
    LAS unsigned char* lds; volatile LAS unsigned* MISC; gu32* ctl;
    int tid, lane, wave, vcu, G;
};

__device__ __forceinline__ void transpose_item(const float* W, int ldw, int K, bf16* WT, int src_col0, int dst_row0, int k0, LAS float* scr, int lane) {
#pragma unroll 8
    for (int i = 0; i < 32; ++i) { const int kk = 2 * i + (lane >> 5); scr[kk * 33 + (lane & 31)] = W[(size_t)(k0 + kk) * ldw + src_col0 + (lane & 31)]; }
    LDS_WAIT(); asm volatile("" ::: "memory");
    const int c = lane & 7;
#pragma unroll
    for (int j = 0; j < 4; ++j) { const int n = (lane >> 3) + 8 * j; const LAS float* s = scr + (8 * c) * 33 + n;
        v4u o; o.x = pkbf(s[0 * 33], s[1 * 33]); o.y = pkbf(s[2 * 33], s[3 * 33]); o.z = pkbf(s[4 * 33], s[5 * 33]); o.w = pkbf(s[6 * 33], s[7 * 33]);
        *(v4u*)(WT + (size_t)(dst_row0 + n) * K + k0 + 8 * c) = o; }
    LDS_WAIT(); asm volatile("" ::: "memory");
}
__device__ __forceinline__ int win_src_col(int db) {
    if (db < 16) return 32 * db;
    if (db < 48) { const int base = db < 32 ? 512 : 1024; const int local = (db - 16) & 15, tile = local >> 3, blk = local & 7, bj = blk >> 2, w = blk & 3; return base + tile * 256 + 64 * w + 32 * bj; }
    if (db < 64) return 1536 + 32 * (db - 48);
    if (db < 96) return 2056 + 32 * (db - 64);
    return 3080 + 32 * (db - 96);
}
__device__ __forceinline__ void cvt_rows_bf16(const float* src, bf16* dst, size_t n8, size_t gtid, size_t gn) {
    for (size_t i = gtid; i < n8; i += gn) { const f32x4 a = *(const f32x4*)(src + 8 * i), b = *(const f32x4*)(src + 8 * i + 4);
        v4u w; w.x = pkbf(a[0], a[1]); w.y = pkbf(a[2], a[3]); w.z = pkbf(b[0], b[1]); w.w = pkbf(b[2], b[3]); *(v4u*)(dst + 8 * i) = w; }
}
__device__ __forceinline__ void cvt_rows_fp8(const float* src, unsigned char* dst, float* scl, int gw, int NGW, int lane) {
    for (int e0 = gw; e0 < NEXP; e0 += 2 * NGW) {
        f32x4 q[2][4]; float mx[2];
#pragma unroll
        for (int u = 0; u < 2; ++u) { const int e = (e0 + u * NGW < NEXP) ? e0 + u * NGW : e0; const float* r = src + (size_t)e * DM + 16 * lane;
            q[u][0] = *(const f32x4*)r; q[u][1] = *(const f32x4*)(r + 4); q[u][2] = *(const f32x4*)(r + 8); q[u][3] = *(const f32x4*)(r + 12); }
#pragma unroll
        for (int u = 0; u < 2; ++u) { float m = 0.f;
#pragma unroll
            for (int j = 0; j < 4; ++j) m = fmaxf(m, fmaxf(fmaxf(fabsf(q[u][j][0]), fabsf(q[u][j][1])), fmaxf(fabsf(q[u][j][2]), fabsf(q[u][j][3]))));
            mx[u] = m; }
#pragma unroll
        for (int o = 1; o < 64; o <<= 1) { mx[0] = fmaxf(mx[0], __shfl_xor(mx[0], o)); mx[1] = fmaxf(mx[1], __shfl_xor(mx[1], o)); }
#pragma unroll
        for (int u = 0; u < 2; ++u) { const int e = e0 + u * NGW; if (e < NEXP) {
            int k = 0; if (mx[u] > 1e-30f) k = 7 - ((int)((__builtin_bit_cast(unsigned, mx[u]) >> 23) & 0xffu) - 127);
            k = k < -100 ? -100 : (k > 100 ? 100 : k);
            const float sc = __builtin_bit_cast(float, (unsigned)(k + 127) << 23), isc = __builtin_bit_cast(float, (unsigned)(127 - k) << 23);
            int w[4];
#pragma unroll
            for (int j = 0; j < 4; ++j) { w[j] = 0; w[j] = __builtin_amdgcn_cvt_pk_fp8_f32(q[u][j][0] * sc, q[u][j][1] * sc, w[j], false); w[j] = __builtin_amdgcn_cvt_pk_fp8_f32(q[u][j][2] * sc, q[u][j][3] * sc, w[j], true); }
            *(v4u*)(dst + (size_t)(lane >> 3) * ((size_t)NEXP * 128) + (size_t)e * 128 + 16 * (lane & 7)) = (v4u){(unsigned)w[0], (unsigned)w[1], (unsigned)w[2], (unsigned)w[3]};
            if (lane == 0) scl[e] = isc; } }
    }
}
__device__ __forceinline__ void p0_prologue(Frame& F, const Args& a) {
    unsigned char* ws = a.ws;
    LAS float* scr = (LAS float*)(F.lds + F.wave * 16384);
    const int gw = F.vcu * NWAVES + F.wave, NGW = F.G * NWAVES;
    for (int it = gw; it < 4096; it += NGW) {
        int r = it;
        if (r < 2048) { const int kb = r >> 7, db = r & 127; transpose_item(a.w_in, DIN, DM, (bf16*)(ws + WS_WIN), win_src_col(db), 32 * db, 64 * kb, scr, F.lane); continue; } r -= 2048;
        if (r < 256) { continue; } r -= 256;
        if (r < 256) { const int kb = r >> 5, nb = r & 31; transpose_item(a.w_ba, DM, DA, (bf16*)(ws + WS_WBA), 32 * nb, 32 * nb, 64 * kb, scr, F.lane); continue; } r -= 256;
        if (r < 512) { const int kb = r >> 5, nb = r & 31; transpose_item(a.w_out, DM, DM, (bf16*)(ws + WS_WOUT), 32 * nb, 32 * nb, 64 * kb, scr, F.lane); continue; } r -= 512;
        { const int kb = r >> 6, nb = r & 63; transpose_item(a.w_query, DQ, DM, (bf16*)(ws + WS_WQ), 32 * nb, 32 * nb, 64 * kb, scr, F.lane); }
    }
    for (int it = gw; it < 16 * 4 * 16; it += NGW) { const int nb = it & 15, g = (it >> 4) & 3, cb = it >> 6; const int nn = 64 * nb + F.lane; float acc8[8];
#pragma unroll
        for (int i = 0; i < 8; ++i) acc8[i] = 0.f;
        const float* pm = a.pool_mix_w + (size_t)g * 16384 + (size_t)(8 * cb) * 128;
#pragma unroll 16
        for (int d = 0; d < 128; ++d) { const float wv = a.w_bp[(size_t)(g * 128 + d) * DM + nn] * a.pool_scale[g * 128 + d];
#pragma unroll
            for (int i = 0; i < 8; ++i) acc8[i] += pm[i * 128 + d] * wv; }
        v4u o; o.x = pkbf(acc8[0], acc8[1]); o.y = pkbf(acc8[2], acc8[3]); o.z = pkbf(acc8[4], acc8[5]); o.w = pkbf(acc8[6], acc8[7]);
        *(v4u*)((bf16*)(ws + WS_WBP) + (size_t)nn * DP + g * 128 + 8 * cb) = o; }
    { const size_t gtid = (size_t)F.vcu * NTHR + F.tid, gn = (size_t)F.G * NTHR;
      cvt_rows_fp8(a.peer_u, ws + WS_PU, (float*)(ws + WS_US), gw, NGW, F.lane);
      cvt_rows_fp8(a.peer_v, ws + WS_PV, (float*)(ws + WS_VS), gw, NGW, F.lane);
      cvt_rows_bf16(a.sub_keys, (bf16*)(ws + WS_SUBK), (size_t)PH * 2 * NKEYS * DKH / 8, gtid, gn);
      for (size_t i = gtid; i < (size_t)DB * 7 * DP; i += gn) { const int b = (int)(i / (7 * DP)), j = (int)((i / DP) % 7), c = (int)(i % DP);
          a.out[O_PS + (size_t)(b * 15 + j) * DP + c] = a.state_pool[(size_t)(b * 15 + 8 + j) * DP + c]; } }
    __syncthreads();
    LAS float* wfT = (LAS float*)F.lds;
    for (int i = F.tid; i < 8 * DM; i += NTHR) { const int col = i >> 3, h = i & 7; wfT[h * DM + col] = a.w_in[(size_t)col * DIN + 2048 + h]; }
    __syncthreads();
    bf16* XN = (bf16*)(ws + WS_XN);
    for (int row0 = gw; row0 < M; row0 += 2 * NGW) {
        f32x4 v[2][4]; float rr[2], f[2][8]; bool ok[2];
#pragma unroll
        for (int u = 0; u < 2; ++u) { const int row = row0 + u * NGW; ok[u] = row < M; const int rc = ok[u] ? row : row0;
            const float* xr = rc < MP ? a.x_p + (size_t)rc * DM : a.x_s + (size_t)(rc - MP) * DM;
#pragma unroll
            for (int j = 0; j < 4; ++j) v[u][j] = *(const f32x4*)(xr + 256 * j + 4 * F.lane); }
#pragma unroll
        for (int u = 0; u < 2; ++u) { float ss = 0.f;
#pragma unroll
            for (int j = 0; j < 4; ++j) ss += (v[u][j][0] * v[u][j][0] + v[u][j][1] * v[u][j][1]) + (v[u][j][2] * v[u][j][2] + v[u][j][3] * v[u][j][3]);
            rr[u] = ss; }
#pragma unroll
        for (int o = 1; o < 64; o <<= 1) { rr[0] += __shfl_xor(rr[0], o); rr[1] += __shfl_xor(rr[1], o); }
#pragma unroll
        for (int u = 0; u < 2; ++u) { const int row = ok[u] ? row0 + u * NGW : row0; const float r = 1.0f / sqrtf(rr[u] * (1.0f / DM) + EPS);
#pragma unroll
            for (int h = 0; h < 8; ++h) f[u][h] = 0.f;
#pragma unroll
            for (int j = 0; j < 4; ++j) { const f32x4 g = *(const f32x4*)(a.norm_mix_g + 256 * j + 4 * F.lane); v[u][j] = v[u][j] * r * g;
                v2u w; w.x = pkbf(v[u][j][0], v[u][j][1]); w.y = pkbf(v[u][j][2], v[u][j][3]); if (ok[u]) *(v2u*)(XN + (size_t)row * DM + 256 * j + 4 * F.lane) = w;
#pragma unroll
                for (int h = 0; h < 8; ++h) { const f32x4 wv = *(const LAS f32x4*)(wfT + h * DM + 256 * j + 4 * F.lane); f[u][h] += (v[u][j][0] * wv[0] + v[u][j][1] * wv[1]) + (v[u][j][2] * wv[2] + v[u][j][3] * wv[3]); } } }
#pragma unroll
        for (int u = 0; u < 2; ++u) { const int row = row0 + u * NGW;
            const bool b4 = (F.lane & 4) != 0, b2 = (F.lane & 2) != 0, b1 = (F.lane & 1) != 0; float t4[4], t2[2];
#pragma unroll
            for (int k = 0; k < 4; ++k) { const float keep = b4 ? f[u][4 + k] : f[u][k], send = b4 ? f[u][k] : f[u][4 + k]; t4[k] = keep + __shfl_xor(send, 4); }
#pragma unroll
            for (int k = 0; k < 2; ++k) { const float keep = b2 ? t4[2 + k] : t4[k], send = b2 ? t4[k] : t4[2 + k]; t2[k] = keep + __shfl_xor(send, 2); }
            float t1 = (b1 ? t2[1] : t2[0]) + __shfl_xor(b1 ? t2[0] : t2[1], 1);
            t1 += __shfl_xor(t1, 8); t1 += __shfl_xor(t1, 16); t1 += __shfl_xor(t1, 32);
            if (F.lane < 8 && ok[u]) { const float z = t1 + a.b_forget[F.lane]; const float lf = fminf(z, 0.f) - log1pf(expf(-fabsf(z)));
                if (row < MP) a.out[O_LFP + (size_t)row * NH + F.lane] = lf; else a.out[O_LFS + (size_t)(row - MP) * NH + F.lane] = lf; } }
    }
}

template <int W> __device__ __forceinline__ void p2_item(const Args& a, unsigned char* ws, int row, int ch) {
    const bf16* U = (const bf16*)(ws + WS_U); bf16* PO = (bf16*)(ws + WS_PO);
    float e[W][8]; float cnt;
    if (row < MP) { const int s = row & (SEQ - 1); cnt = (float)(s + 1 < W ? s + 1 : W);
#pragma unroll
        for (int i = 0; i < W; ++i) { v4u q = (v4u){0u, 0u, 0u, 0u}; if (s - i >= 0) q = *(const v4u*)(U + (size_t)(row - i) * DP + ch);
            e[i][0] = bflo(q.x); e[i][1] = bfhi(q.x); e[i][2] = bflo(q.y); e[i][3] = bfhi(q.y); e[i][4] = bflo(q.z); e[i][5] = bfhi(q.z); e[i][6] = bflo(q.w); e[i][7] = bfhi(q.w); }
    } else { const int rs = row - MP, b = rs >> 3, t = rs & 7; cnt = (float)W;
#pragma unroll
        for (int i = 0; i < W; ++i) { const int tt = t - i;
            if (tt >= 0) { const v4u q = *(const v4u*)(U + (size_t)(MP + b * 8 + tt) * DP + ch);
                e[i][0] = bflo(q.x); e[i][1] = bfhi(q.x); e[i][2] = bflo(q.y); e[i][3] = bfhi(q.y); e[i][4] = bflo(q.z); e[i][5] = bfhi(q.z); e[i][6] = bflo(q.w); e[i][7] = bfhi(q.w); }
            else { const f32x4 p0 = *(const f32x4*)(a.state_pool + (size_t)(b * 15 + 15 + tt) * DP + ch), p1 = *(const f32x4*)(a.state_pool + (size_t)(b * 15 + 15 + tt) * DP + ch + 4);
                e[i][0] = p0[0]; e[i][1] = p0[1]; e[i][2] = p0[2]; e[i][3] = p0[3]; e[i][4] = p1[0]; e[i][5] = p1[1]; e[i][6] = p1[2]; e[i][7] = p1[3]; } } }
    const float inv = 1.0f / cnt; float mm[8];
#pragma unroll
    for (int k = 0; k < 8; ++k) { float sum = 0.f;
#pragma unroll
        for (int i = 0; i < W; ++i) sum += e[i][k];
        mm[k] = sum * inv - e[0][k]; }
    v4u o; o.x = pkbf(mm[0], mm[1]); o.y = pkbf(mm[2], mm[3]); o.z = pkbf(mm[4], mm[5]); o.w = pkbf(mm[6], mm[7]);
    *(v4u*)(PO + (size_t)row * DP + ch) = o;
}
__device__ __forceinline__ void p1_cumsum(Frame& F, const Args& a) {
    unsigned char* ws = a.ws;
    { const int gw = F.vcu * NWAVES + F.wave; float* CP2 = (float*)(ws + WS_CP2);
      if (gw < NB * NH) { const int b = gw >> 3, h = gw & 7; float carry = 0.f;
          for (int c = 0; c < SEQ / 64; ++c) { float v = a.out[O_LFP + (size_t)(b * SEQ + c * 64 + F.lane) * NH + h];
#pragma unroll
              for (int o = 1; o < 64; o <<= 1) { const float t = __shfl_up(v, o); if (F.lane >= o) v += t; }
              v += carry; CP2[(size_t)gw * SEQ + c * 64 + F.lane] = v * LOG2E; carry = __shfl(v, 63); } } }
}
__device__ __forceinline__ void p2_cumsum_pool(Frame& F, const Args& a) {
    unsigned char* ws = a.ws;
    const int nfree = F.G > 2 * (M / 256) ? F.G - M / 256 : F.G, myslot = F.G > 2 * (M / 256) ? (int)blockIdx.x - M / 256 : (int)blockIdx.x;
    if (myslot >= 0)
    for (int item = myslot * NTHR + F.tid; item < M * 64; item += nfree * NTHR) {
        const int row = item >> 6, ch = (item & 63) * 8, g = ch >> 7;
        if (g == 0) p2_item<2>(a, ws, row, ch); else if (g == 1) p2_item<4>(a, ws, row, ch); else if (g == 2) p2_item<8>(a, ws, row, ch); else p2_item<16>(a, ws, row, ch);
    }
}

__device__ __forceinline__ float attn_bound2(const Args& a, int lane) {
    asm volatile("" : "+v"(lane));
    const float gq = wave_max(fabsf(a.q_norm_g[lane])), gk = wave_max(fabsf(a.k_norm_g[lane]));
    return 64.0f * C2 * gq * gk * 1.03f;
}

typedef float f32x16 __attribute__((ext_vector_type(16)));
typedef short bf16x8v __attribute__((ext_vector_type(8)));
__device__ __forceinline__ int f2key(float s) { int b = __builtin_bit_cast(int, s); return b ^ ((b >> 31) & 0x7fffffff); }
__device__ __forceinline__ float key2f(int k) { return __builtin_bit_cast(float, k ^ ((k >> 31) & 0x7fffffff)); }
#define CE_DESC(x, y) do { const int mx_ = (x) > (y) ? (x) : (y), mn_ = (x) > (y) ? (y) : (x); (x) = mx_; (y) = mn_; } while (0)
template <int OFF, int N, typename T> __device__ __forceinline__ void bsort_desc(T& v) {
#pragma unroll
    for (int k = 2; k <= N; k <<= 1)
#pragma unroll
        for (int j = k >> 1; j > 0; j >>= 1)
#pragma unroll
            for (int i = 0; i < N; ++i) { const int l = i ^ j; if (l > i) { if ((i & k) == 0) CE_DESC(v[OFF + i], v[OFF + l]); else CE_DESC(v[OFF + l], v[OFF + i]); } }
}
template <int OFF, typename T> __device__ __forceinline__ void bmerge16_desc(T& v) {
#pragma unroll
    for (int j = 8; j > 0; j >>= 1)
#pragma unroll
        for (int i = 0; i < 16; ++i) { const int l = i ^ j; if (l > i) CE_DESC(v[OFF + i], v[OFF + l]); }
}
template <int OA, int OB, typename T> __device__ __forceinline__ void top16_merge(T& v) {
#pragma unroll
    for (int i = 0; i < 16; ++i) v[OA + i] = v[OA + i] > v[OB + 15 - i] ? v[OA + i] : v[OB + 15 - i];
    bmerge16_desc<OA>(v);
}
template <typename T> __device__ __forceinline__ void top16_of_64(T& v) {
    bsort_desc<0, 16>(v); bsort_desc<16, 16>(v); bsort_desc<32, 16>(v); bsort_desc<48, 16>(v);
    top16_merge<0, 16>(v); top16_merge<32, 48>(v); top16_merge<0, 32>(v);
}
__device__ __forceinline__ void p7_topk(Frame& F, const Args& a) {
    unsigned char* ws = a.ws;
    const bf16* PQ = (const bf16*)(ws + WS_PQ); const bf16* SK = (const bf16*)(ws + WS_SUBK); const float* RSS = (const float*)(ws + WS_RSS);
    int* SI = (int*)(ws + WS_SI); float* SG = (float*)(ws + WS_SG);
    const int lane = F.lane, j = lane & 31, hi = lane >> 5;
    constexpr int KROW = 272, KMAT = 128 * KROW;
    LAS unsigned char* kl = F.lds; LAS unsigned* ib = (LAS unsigned*)(F.lds + 2 * KMAT + F.wave * 1024);
    const int h = F.vcu & 7, wi = F.vcu >> 3, nwh = (F.G - h + 7) >> 3;
    __syncthreads();
    for (int i = F.tid; i < 2 * 128 * 16; i += NTHR) { const int p = i >> 11, n = (i >> 4) & 127, c = i & 15; *(LAS v4u*)(kl + p * KMAT + n * KROW + 16 * c) = *(const v4u*)(SK + ((size_t)(h * 2 + p) * NKEYS + n) * DKH + 8 * c); }
    __syncthreads();
    for (int tile = wi * NWAVES + F.wave; tile < M / 32; tile += nwh * NWAVES) {
        const int row0 = tile * 32;
        int jl = j, hl = hi; asm volatile("" : "+v"(jl), "+v"(hl));
        int top[2][16];
#pragma unroll
        for (int p = 0; p < 2; ++p) {
            bf16x8v qf[8];
#pragma unroll
            for (int ks = 0; ks < 8; ++ks) qf[ks] = *(const bf16x8v*)(PQ + (size_t)(row0 + jl) * DQ + h * 256 + p * 128 + 16 * ks + 8 * hl);
            f32x16 acc[4];
#pragma unroll
            for (int mt = 0; mt < 4; ++mt) acc[mt] = f32x16{};
            const LAS unsigned char* kb = kl + p * KMAT + jl * KROW + 16 * hl;
#pragma unroll
            for (int ks = 0; ks < 8; ++ks)
#pragma unroll
                for (int mt = 0; mt < 4; ++mt) { const bf16x8v af = *(const LAS bf16x8v*)(kb + mt * 32 * KROW + ks * 32); acc[mt] = __builtin_amdgcn_mfma_f32_32x32x16_bf16(af, qf[ks], acc[mt], 0, 0, 0); }
            int v[64];
#pragma unroll
            for (int mt = 0; mt < 4; ++mt)
#pragma unroll
                for (int r = 0; r < 16; ++r) { const int n = 32 * mt + (r & 3) + 8 * (r >> 2) + 4 * hi; v[16 * mt + r] = (f2key(acc[mt][r]) & ~127) | (127 - n); }
            top16_of_64(v);
#pragma unroll
            for (int i = 0; i < 16; ++i) top[p][i] = v[i];
        }
        int S[32];
#pragma unroll
        for (int i = 0; i < 16; ++i) { auto rr = __builtin_amdgcn_permlane32_swap((unsigned)top[0][i], (unsigned)top[1][i], false, false); S[i] = (int)rr[0]; S[16 + i] = (int)rr[1]; }
        top16_merge<0, 16>(S);
        { unsigned w0 = 0, w1 = 0, w2 = 0, w3 = 0;
#pragma unroll
          for (int i = 0; i < 4; ++i) { w0 |= (unsigned)(127 - (S[i] & 127)) << (8 * i); w1 |= (unsigned)(127 - (S[4 + i] & 127)) << (8 * i); w2 |= (unsigned)(127 - (S[8 + i] & 127)) << (8 * i); w3 |= (unsigned)(127 - (S[12 + i] & 127)) << (8 * i); }
          *(LAS v4u*)(ib + (hi * 32 + j) * 4) = (v4u){w0, w1, w2, w3}; }
        float s1[16], s2[16];
#pragma unroll
        for (int i = 0; i < 16; ++i) { auto rr = __builtin_amdgcn_permlane32_swap((unsigned)S[i], (unsigned)S[i], false, false); s1[i] = key2f((int)rr[0] & ~127); s2[i] = key2f((int)rr[1] & ~127); }
        int c[64]; { int n = 0;
#pragma unroll
          for (int ca = 0; ca < 16; ++ca)
#pragma unroll
              for (int cb = 0; cb < 16; ++cb) if ((ca + 1) * (cb + 1) <= 16) { c[n] = (f2key(s1[ca] + s2[cb]) & ~255) | (255 - (ca * 16 + cb)); ++n; }
#pragma unroll
          for (int q = 50; q < 64; ++q) c[q] = (int)0x80000000; }
        top16_of_64(c);
        float ssq = 0.f;
#pragma unroll
        for (int q = 0; q < 4; ++q) { const f32x4 t4 = *(const f32x4*)(RSS + (size_t)(row0 + j) * 16 + 4 * q); ssq += (t4[0] + t4[1]) + (t4[2] + t4[3]); }
        const float rstd = 1.0f / sqrtf(ssq * (1.0f / DM) + EPS);
        const float z0 = key2f(c[0] & ~255) * rstd; float e[16], esum = 0.f;
#pragma unroll
        for (int k = 0; k < 16; ++k) { e[k] = __expf(key2f(c[k] & ~255) * rstd - z0); esum += e[k]; }
        const float inv = 1.0f / esum;
        LDS_WAIT(); asm volatile("" ::: "memory");
        const LAS unsigned char* ib8 = (const LAS unsigned char*)ib;
        int oi[8]; float og[8];
#pragma unroll
        for (int k = 0; k < 8; ++k) { const int ck = hi ? c[8 + k] : c[k]; const float ek = hi ? e[8 + k] : e[k]; const int fl = 255 - (ck & 255);
            const int i1 = ib8[(0 * 32 + j) * 16 + (fl >> 4)], i2 = ib8[(1 * 32 + j) * 16 + (fl & 15)]; oi[k] = i1 * NKEYS + i2; og[k] = ek * inv; }
        { int* sp = SI + (size_t)(row0 + j) * 128 + h * 16 + hi * 8; float* gp = SG + (size_t)(row0 + j) * 128 + h * 16 + hi * 8;
          *(v4u*)sp = (v4u){(unsigned)oi[0], (unsigned)oi[1], (unsigned)oi[2], (unsigned)oi[3]}; *(v4u*)(sp + 4) = (v4u){(unsigned)oi[4], (unsigned)oi[5], (unsigned)oi[6], (unsigned)oi[7]};
          *(f32x4*)gp = (f32x4){og[0], og[1], og[2], og[3]}; *(f32x4*)(gp + 4) = (f32x4){og[4], og[5], og[6], og[7]}; }
        LDS_WAIT(); asm volatile("" ::: "memory");
    }
}


constexpr int P8_SUP = 68, P8_TA = 32, P8_TOK = 36, P8_Q = 5, P8_NS = 8, P8_SW = 128;
static_assert(M % P8_SUP == 0 && P8_TOK <= 8 * P8_Q && P8_TA + P8_TOK == P8_SUP, "P8 chunking");
#define FP8X2(wd, hi_) __builtin_amdgcn_cvt_pk_f32_fp8((int)(wd), (hi_))
typedef __bf16 bf16x2v __attribute__((ext_vector_type(2)));
template <bool HI> __device__ __forceinline__ float p8_dot(unsigned wd, unsigned hpair, float accv) { const f32x2 f = FP8X2(wd, HI); return __builtin_amdgcn_fdot2_f32_bf16(__builtin_bit_cast(bf16x2v, pkbf(f[0], f[1])), __builtin_bit_cast(bf16x2v, hpair), accv, false); }
__device__ __forceinline__ void p8_gather(Frame& F, const Args& a) {
    unsigned char* ws = a.ws;
    const bf16* HG = (const bf16*)(ws + WS_XN); const unsigned char* PU = ws + WS_PU; const unsigned char* PV = ws + WS_PV; const float* US = (const float*)(ws + WS_US); const float* VS = (const float*)(ws + WS_VS);
    const float* RSS = (const float*)(ws + WS_RSS); const int* SI = (const int*)(ws + WS_SI); const float* SG = (const float*)(ws + WS_SG); const float* Hh = (const float*)(ws + WS_H);
    float* Y = a.out + O_YP;
    LAS unsigned short* ix = (LAS unsigned short*)F.lds;
    LAS float* wt = (LAS float*)(F.lds + P8_TOK * 128 * 2);
    LAS float* rs = (LAS float*)(F.lds + P8_TOK * 128 * 2 + P8_TOK * 128 * 4);
    int lane = F.lane; asm volatile("" : "+v"(lane));
    const int g = lane >> 3, c8 = lane & 7;
    for (int chunk = 2 * F.vcu; chunk < 2 * (M / P8_SUP); chunk += (chunk & 1) ? 2 * F.G - 1 : 1) {
        const int tb = (chunk >> 1) * P8_SUP + ((chunk & 1) ? P8_TA : 0), ntok = (chunk & 1) ? P8_TOK : P8_TA;
        __syncthreads();
        for (int i = F.tid; i < ntok * 128; i += NTHR) { ix[i] = (unsigned short)SI[(size_t)tb * 128 + i]; wt[i] = SG[(size_t)tb * 128 + i]; }
        if (F.tid < ntok) { float s = 0.f; for (int k = 0; k < 16; ++k) s += RSS[(size_t)(tb + F.tid) * 16 + k]; rs[F.tid] = 1.0f / sqrtf(s * (1.0f / DM) + EPS); }
        __syncthreads();
        float acc[P8_Q][16];
#pragma unroll
        for (int q = 0; q < P8_Q; ++q)
#pragma unroll
            for (int i = 0; i < 16; ++i) acc[q][i] = 0.f;
        for (int s = 0; s < P8_NS; ++s) {
            __syncthreads();
            int cl = c8; asm volatile("" : "+v"(cl));
            const unsigned char* pus = PU + (size_t)s * ((size_t)NEXP * P8_SW) + 16 * cl;
#pragma unroll
            for (int q = 0; q < P8_Q; ++q) { const int lt = F.wave + 8 * q; if (lt < ntok) {
                const v4u h0 = *(const v4u*)(HG + (size_t)(tb + lt) * DM + P8_SW * s + 16 * cl), h1 = *(const v4u*)(HG + (size_t)(tb + lt) * DM + P8_SW * s + 16 * cl + 8);
                const unsigned hp8[8] = {h0.x, h0.y, h0.z, h0.w, h1.x, h1.y, h1.z, h1.w};
                f32x2 hf2[8];
#pragma unroll
                for (int k = 0; k < 8; ++k) hf2[k] = (f32x2){bflo(hp8[k]), bfhi(hp8[k])};
                const v4u ea = *(const LAS v4u*)(ix + lt * 128 + g * 16), eb = *(const LAS v4u*)(ix + lt * 128 + g * 16 + 8);
                const unsigned ew[8] = {ea.x, ea.y, ea.z, ea.w, eb.x, eb.y, eb.z, eb.w};
                v4u r[16];
#pragma unroll
                for (int i = 0; i < 16; ++i) { const unsigned e = (i & 1) ? (ew[i >> 1] >> 16) : (ew[i >> 1] & 0xffffu); r[i] = *(const v4u*)(pus + (size_t)e * P8_SW); }
#pragma unroll
                for (int i = 0; i < 16; ++i) { const unsigned wd[4] = {r[i].x, r[i].y, r[i].z, r[i].w}; f32x2 d2 = (f32x2){acc[q][i], 0.f};
#pragma unroll
                    for (int jj = 0; jj < 4; ++jj) { d2 = FP8X2(wd[jj], false) * hf2[2 * jj] + d2; d2 = FP8X2(wd[jj], true) * hf2[2 * jj + 1] + d2; }
                    acc[q][i] = d2[0] + d2[1]; } } }
        }
#pragma unroll
        for (int q = 0; q < P8_Q; ++q) { const int lt = F.wave + 8 * q; if (lt < ntok) {
            float v8[8], v4[4], v2[2]; const bool b4 = (c8 & 4) != 0, b2 = (c8 & 2) != 0, b1 = (c8 & 1) != 0;
#pragma unroll
            for (int j2 = 0; j2 < 8; ++j2) { const float keep = b4 ? acc[q][8 + j2] : acc[q][j2], send = b4 ? acc[q][j2] : acc[q][8 + j2]; v8[j2] = keep + __shfl_xor(send, 4); }
#pragma unroll
            for (int j2 = 0; j2 < 4; ++j2) { const float keep = b2 ? v8[4 + j2] : v8[j2], send = b2 ? v8[j2] : v8[4 + j2]; v4[j2] = keep + __shfl_xor(send, 2); }
#pragma unroll
            for (int j2 = 0; j2 < 2; ++j2) { const float keep = b1 ? v4[2 + j2] : v4[j2], send = b1 ? v4[j2] : v4[2 + j2]; v2[j2] = keep + __shfl_xor(send, 1); }
            const float r = rs[lt]; const int kk = lt * 128 + g * 16 + 2 * c8; LAS float* wp = wt + kk; const f32x2 gt = *(const LAS f32x2*)wp;
            const int e0 = ix[kk], e1 = ix[kk + 1];
            const float z0 = v2[0] * r * US[e0], z1 = v2[1] * r * US[e1];
            const float a0 = 0.5f * z0 * (1.0f + erff(z0 * 0.70710678118654752f)), a1 = 0.5f * z1 * (1.0f + erff(z1 * 0.70710678118654752f));
            *(LAS f32x2*)wp = (f32x2){gt[0] * a0 * VS[e0], gt[1] * a1 * VS[e1]}; } }
        LDS_WAIT(); asm volatile("" ::: "memory");
        for (int s = 0; s < P8_NS; ++s) {
            __syncthreads();
            int cl = c8; asm volatile("" : "+v"(cl));
            const unsigned char* pvs = PV + (size_t)s * ((size_t)NEXP * P8_SW) + 16 * cl;
#pragma unroll 1
            for (int q = 0; q < P8_Q; ++q) { const int lt = F.wave + 8 * q; if (lt < ntok) {
                f32x2 o2[8];
#pragma unroll
                for (int k = 0; k < 8; ++k) o2[k] = (f32x2){0.f, 0.f};
                const v4u ea = *(const LAS v4u*)(ix + lt * 128 + g * 16), eb = *(const LAS v4u*)(ix + lt * 128 + g * 16 + 8);
                const unsigned ew[8] = {ea.x, ea.y, ea.z, ea.w, eb.x, eb.y, eb.z, eb.w};
                v4u r[16];
#pragma unroll
                for (int i = 0; i < 16; ++i) { const unsigned e = (i & 1) ? (ew[i >> 1] >> 16) : (ew[i >> 1] & 0xffffu); r[i] = *(const v4u*)(pvs + (size_t)e * P8_SW); }
                float wv[16];
#pragma unroll
                for (int i4 = 0; i4 < 4; ++i4) { const f32x4 w4 = *(const LAS f32x4*)(wt + lt * 128 + g * 16 + 4 * i4); wv[4 * i4] = w4[0]; wv[4 * i4 + 1] = w4[1]; wv[4 * i4 + 2] = w4[2]; wv[4 * i4 + 3] = w4[3]; }
#pragma unroll
                for (int i = 0; i < 16; ++i) { const f32x2 w2 = (f32x2){wv[i], wv[i]}; const unsigned wd[4] = {r[i].x, r[i].y, r[i].z, r[i].w};
#pragma unroll
                    for (int jj = 0; jj < 4; ++jj) { o2[2 * jj] = FP8X2(wd[jj], false) * w2 + o2[2 * jj]; o2[2 * jj + 1] = FP8X2(wd[jj], true) * w2 + o2[2 * jj + 1]; } }
                float o[16];
#pragma unroll
                for (int k = 0; k < 8; ++k) { o[2 * k] = o2[k][0]; o[2 * k + 1] = o2[k][1]; }
                const bool b5 = (lane & 32) != 0, b4 = (lane & 16) != 0, b3 = (lane & 8) != 0; float p8[8], p4[4], p2[2];
#pragma unroll
                for (int j2 = 0; j2 < 8; ++j2) { const float keep = b5 ? o[8 + j2] : o[j2], send = b5 ? o[j2] : o[8 + j2]; p8[j2] = keep + __shfl_xor(send, 32); }
#pragma unroll
                for (int j2 = 0; j2 < 4; ++j2) { const float keep = b4 ? p8[4 + j2] : p8[j2], send = b4 ? p8[j2] : p8[4 + j2]; p4[j2] = keep + __shfl_xor(send, 16); }
#pragma unroll
                for (int j2 = 0; j2 < 2; ++j2) { const float keep = b3 ? p4[2 + j2] : p4[j2], send = b3 ? p4[j2] : p4[2 + j2]; p2[j2] = keep + __shfl_xor(send, 8); }
                const size_t off = (size_t)(tb + lt) * DM + P8_SW * s + 16 * cl + (b5 ? 8 : 0) + (b4 ? 4 : 0) + (b3 ? 2 : 0);
                const f32x2 hv = *(const f32x2*)(Hh + off);
                *(f32x2*)(Y + off) = (f32x2){hv[0] + p2[0], hv[1] + p2[1]}; } }
        }
    }
}

__device__ __forceinline__ void p3_sample_attn2(Frame& F, const Args& a, const float M2) {
    unsigned char* ws = a.ws;
    const bf16* Q = (const bf16*)(ws + WS_Q); bf16* AO = (bf16*)(ws + WS_AO);
    LAS float* D2 = (LAS float*)F.lds;
    LAS float* E2 = (LAS float*)(F.lds + 32768);
    LAS float* Pt = (LAS float*)(F.lds + 32768 + 128);
    LAS float* Op = (LAS float*)(F.lds + 32768 + 128 + 8192);
    LAS float* lp = (LAS float*)(F.lds + 32768 + 128 + 8192 + 16384);
    int lane = F.lane; asm volatile("" : "+v"(lane));
    const int w = F.wave, hh = w >> 1, kh = w & 1, n = lane & 31, hi = lane >> 5;
    LAS float* Pw = Pt + w * 256;
    for (int unit = F.vcu; unit < DB * 2; unit += F.G) {
        const int b = unit >> 1, h = 4 * (unit & 1) + hh;
        __syncthreads();
        for (int i = F.tid; i < 4 * PAST; i += NTHR) { const int hq = i >> 11, jk = i & (PAST - 1); const int pg = a.page_table[b * NPAGES + (jk >> 7)];
            D2[i] = a.cache_lf[((size_t)pg * PAGE + (jk & 127)) * NH + 4 * (unit & 1) + hq]; }
        __syncthreads();
        if (kh == 0) {
            LAS float* d = D2 + hh * PAST; float loc[32]; float tot = 0.f;
#pragma unroll
            for (int k = 31; k >= 0; --k) { loc[k] = tot; tot += d[lane * 32 + k]; }
            float inc = tot;
#pragma unroll
            for (int o = 1; o < 64; o <<= 1) { const float t = __shfl_down(inc, o); if (lane + o < 64) inc += t; }
            const float excl = inc - tot;
#pragma unroll
            for (int k = 0; k < 32; ++k) d[lane * 32 + k] = (loc[k] + excl) * LOG2E;
            if (lane < 8) { float e = 0.f; for (int t = 0; t <= lane; ++t) e += a.out[O_LFS + (size_t)(b * 8 + t) * NH + h]; E2[hh * 8 + lane] = e * LOG2E; }
        }
        __syncthreads();
        bf16x8v qa[4];
#pragma unroll
        for (int ks = 0; ks < 4; ++ks) { qa[ks] = bf16x8v{}; if (n < 8) qa[ks] = *(const bf16x8v*)(Q + (size_t)(MP + b * 8 + n) * DA + h * 64 + 16 * ks + 8 * hi); }
        float e2[4];
#pragma unroll
        for (int t = 0; t < 4; ++t) e2[t] = E2[hh * 8 + 4 * hi + t] - M2;
        float o[8], lsum[4];
#pragma unroll
        for (int t = 0; t < 8; ++t) o[t] = 0.f;
#pragma unroll
        for (int t = 0; t < 4; ++t) lsum[t] = 0.f;
        const LAS float* dh = D2 + hh * PAST;
        int nskip; { const float dl = dh[32 * lane + 31]; nskip = __builtin_popcountll(__ballot(dl < -(30.f + 2.f * M2))); }
        nskip = __builtin_amdgcn_readfirstlane(nskip);
        const int nblk = PAST / 32 - nskip, nb0 = nblk >> 1;
        const int blk_lo = nskip + (kh ? nb0 : 0), nit = kh ? (nblk - nb0) : nb0;
        f32x4 kq[8]; float vv[32];
#define S3_COMPUTE(it_, NEWK) do { f32x16 sacc = f32x16{}; \
            _Pragma("unroll") for (int ks = 0; ks < 4; ++ks) { const f32x4 x0_ = kq[2 * ks], x1_ = kq[2 * ks + 1]; v4u kb_; kb_.x = pkbf(x0_[0], x0_[1]); kb_.y = pkbf(x0_[2], x0_[3]); kb_.z = pkbf(x1_[0], x1_[1]); kb_.w = pkbf(x1_[2], x1_[3]); \
                sacc = __builtin_amdgcn_mfma_f32_32x32x16_bf16(qa[ks], __builtin_bit_cast(bf16x8v, kb_), sacc, 0, 0, 0); } \
            float p_[4]; \
            if (!(NEWK)) { const float dj_ = dh[(blk_lo + (it_)) * 32 + n]; _Pragma("unroll") for (int t = 0; t < 4; ++t) p_[t] = __builtin_amdgcn_exp2f(sacc[t] + e2[t] + dj_); } \
            else { const float ek_ = E2[hh * 8 + (n & 7)]; _Pragma("unroll") for (int t = 0; t < 4; ++t) p_[t] = (n <= 4 * hi + t) ? __builtin_amdgcn_exp2f(sacc[t] + e2[t] - ek_) : 0.f; } \
            _Pragma("unroll") for (int t = 0; t < 4; ++t) lsum[t] += p_[t]; \
            *(LAS f32x4*)(Pw + n * 8 + 4 * hi) = (f32x4){p_[0], p_[1], p_[2], p_[3]}; \
            LDS_WAIT(); asm volatile("" ::: "memory"); \
            _Pragma("unroll") for (int k_ = 0; k_ < ((NEWK) ? 8 : 32); ++k_) { const f32x4 pa_ = *(const LAS f32x4*)(Pw + k_ * 8), pb_ = *(const LAS f32x4*)(Pw + k_ * 8 + 4); const float v_ = vv[k_]; \
                o[0] += pa_[0] * v_; o[1] += pa_[1] * v_; o[2] += pa_[2] * v_; o[3] += pa_[3] * v_; o[4] += pb_[0] * v_; o[5] += pb_[1] * v_; o[6] += pb_[2] * v_; o[7] += pb_[3] * v_; } \
            LDS_WAIT(); asm volatile("" ::: "memory"); } while (0)
        for (int it = 0; it < nit; ++it) {
            const int j0 = (blk_lo + it) * 32; const int pg = a.page_table[b * NPAGES + (j0 >> 7)];
            const size_t rowoff = (((size_t)pg * PAGE + (j0 & 127)) * NH + h) * HD;
            const float* kr = a.cache_k + rowoff + (size_t)n * (NH * HD) + 8 * hi; const float* vb = a.cache_v + rowoff;
#pragma unroll
            for (int ks = 0; ks < 4; ++ks) { kq[2 * ks] = __builtin_nontemporal_load((const f32x4*)(kr + 16 * ks)); kq[2 * ks + 1] = __builtin_nontemporal_load((const f32x4*)(kr + 16 * ks + 4)); }
#pragma unroll
            for (int k = 0; k < 32; ++k) vv[k] = __builtin_nontemporal_load(vb + (size_t)k * (NH * HD) + lane);
            S3_COMPUTE(it, false);
        }
        if (kh == 1) {
            const float* kr = a.out + O_KS + (size_t)(b * 8 + (n & 7)) * DA + h * HD + 8 * hi; const float* vr = a.out + O_VS + (size_t)(b * 8) * DA + h * HD + lane;
#pragma unroll
            for (int ks = 0; ks < 4; ++ks) { kq[2 * ks] = *(const f32x4*)(kr + 16 * ks); kq[2 * ks + 1] = *(const f32x4*)(kr + 16 * ks + 4); }
#pragma unroll
            for (int k = 0; k < 8; ++k) vv[k] = vr[(size_t)k * DA];
            S3_COMPUTE(0, true);
        }
#undef S3_COMPUTE
#pragma unroll
        for (int t = 0; t < 4; ++t) { float s = lsum[t]; s += __shfl_xor(s, 1); s += __shfl_xor(s, 2); s += __shfl_xor(s, 4); s += __shfl_xor(s, 8); s += __shfl_xor(s, 16); if (n == 0) lp[w * 8 + 4 * hi + t] = s; }
#pragma unroll
        for (int t = 0; t < 8; ++t) Op[(w * 8 + t) * 64 + lane] = o[t];
        __syncthreads();
        for (int i = F.tid; i < 4 * 8 * 64; i += NTHR) { const int hq = i >> 9, t = (i >> 6) & 7, d = i & 63;
            const float O = Op[((2 * hq) * 8 + t) * 64 + d] + Op[((2 * hq + 1) * 8 + t) * 64 + d], L = lp[(2 * hq) * 8 + t] + lp[(2 * hq + 1) * 8 + t];
            AO[(size_t)(MP + b * 8 + t) * DA + (4 * (unit & 1) + hq) * 64 + d] = (bf16)(pkbf(O / L, 0.f) & 0xffffu); }
    }
}


template <class Epi> __device__ __forceinline__ void sg_phase(Frame& F, const bf16* A  , const bf16* Bt  , int K, int N, const Epi& E) {
    int lane = F.lane; asm volatile("" : "+v"(lane));
    const int fr = lane & 15, fq = lane >> 4, ntc = N >> 6, ntile = (MS / 128) * ntc, pitch = 2 * K + 16, kc = K >> 3;
    for (int t = F.vcu; t < ntile; t += F.G) {
        const int tr = t % (MS / 128), tc = t / (MS / 128);
        __syncthreads();
        for (int i = F.tid; i < 64 * kc; i += NTHR) { const int r = i / kc, c = i - r * kc; *(LAS v4u*)(F.lds + r * pitch + 16 * c) = *(const v4u*)(Bt + (size_t)(64 * tc + r) * K + 8 * c); }
        __syncthreads();
        const bf16* ap = A + (size_t)(128 * tr + 16 * F.wave + fr) * K + 8 * fq;
        const LAS unsigned char* bp = F.lds + fr * pitch + 16 * fq;
        f32x4 acc[4];
#pragma unroll
        for (int c = 0; c < 4; ++c) acc[c] = (f32x4){0.f, 0.f, 0.f, 0.f};
#pragma unroll 8
        for (int ks = 0; ks < K; ks += 32) {
            const bf16x8v av = *(const bf16x8v*)(ap + ks);
#pragma unroll
            for (int c = 0; c < 4; ++c) { const bf16x8v bv = *(const LAS bf16x8v*)(bp + 16 * c * pitch + 2 * ks); acc[c] = __builtin_amdgcn_mfma_f32_16x16x32_bf16(bv, av, acc[c], 0, 0, 0); }
        }
        E(acc, 128 * tr + 16 * F.wave + fr, tc, fq);
    }
}
template <int MODE> struct SgGate { const bf16* G; const bf16* Tin; bf16* O;
    __device__ __forceinline__ void operator()(const f32x4 (&acc)[4], int rs, int tc, int fq) const {
#pragma unroll
        for (int c = 0; c < 4; ++c) { const size_t off = (size_t)(MP + rs) * DM + 64 * tc + 16 * c + 4 * fq; const v2u g = *(const v2u*)(G + off);
            float r[4] = {acc[c][0] * bflo(g.x), acc[c][1] * bfhi(g.x), acc[c][2] * bflo(g.y), acc[c][3] * bfhi(g.y)};
            if (MODE == 1) { const v2u t = *(const v2u*)(Tin + off); r[0] += bflo(t.x); r[1] += bfhi(t.x); r[2] += bflo(t.y); r[3] += bfhi(t.y); }
            v2u w; w.x = pkbf(r[0], r[1]); w.y = pkbf(r[2], r[3]); *(v2u*)(O + off) = w; } } };
struct SgOut { const float* xs; float* H; bf16* HG; const float* gf; float* RSS;
    __device__ __forceinline__ void operator()(const f32x4 (&acc)[4], int rs, int tc, int fq) const { float ss = 0.f;
#pragma unroll
        for (int c = 0; c < 4; ++c) { const int col = 64 * tc + 16 * c + 4 * fq; const f32x4 h = acc[c] + *(const f32x4*)(xs + (size_t)rs * DM + col);
            ss += (h[0] * h[0] + h[1] * h[1]) + (h[2] * h[2] + h[3] * h[3]);
            *(f32x4*)(H + (size_t)(MP + rs) * DM + col) = h; const f32x4 gv = *(const f32x4*)(gf + col);
            v2u w; w.x = pkbf(h[0] * gv[0], h[1] * gv[1]); w.y = pkbf(h[2] * gv[2], h[3] * gv[3]); *(v2u*)(HG + (size_t)(MP + rs) * DM + col) = w; }
        ss += __shfl_xor(ss, 16); ss += __shfl_xor(ss, 32);
        if (fq == 0) RSS[(size_t)(MP + rs) * 16 + tc] = ss; } };
struct SgPQ { bf16* PQ;
    __device__ __forceinline__ void operator()(const f32x4 (&acc)[4], int rs, int tc, int fq) const {
#pragma unroll
        for (int c = 0; c < 4; ++c) { v2u w; w.x = pkbf(acc[c][0], acc[c][1]); w.y = pkbf(acc[c][2], acc[c][3]); *(v2u*)(PQ + (size_t)(MP + rs) * DQ + 64 * tc + 16 * c + 4 * fq) = w; } } };

constexpr int N_PHASES = 9;
#ifndef MK_PER_PHASE
#define MK_PER_PHASE 0
#endif
__global__ void __launch_bounds__(NTHR, 2) fwd_kernel(Args args) {
    extern __shared__ __attribute__((aligned(16))) unsigned char lds[];
    Frame F;
    F.lds = (LAS unsigned char*)lds; F.MISC = (volatile LAS unsigned*)(F.lds + MISC_OFF);
    F.tid = threadIdx.x; F.lane = F.tid & 63; F.wave = __builtin_amdgcn_readfirstlane(F.tid >> 6);
    F.G = gridDim.x; { const int bx = blockIdx.x; F.vcu = (F.G % 8 == 0) ? (bx % 8) * (F.G / 8) + bx / 8 : bx; }
    F.ctl = (gu32*)(args.ws + WS_CTL);
    for (int u = F.tid; u < (LDS_BYTES - MISC_OFF) / 4; u += NTHR) ((LAS unsigned*)(F.lds + MISC_OFF))[u] = 0u;
    __syncthreads();
#if MK_PER_PHASE
#define GRID_BAR() do { } while (0)
#else
    XcdBarrier bar = xcd_barrier_post((unsigned*)(F.ctl + CW_BAR), F.MISC + 8);
#define GRID_BAR() xcd_barrier(bar)
#endif
    unsigned char* ws = args.ws;
    const int lo = args.ph_lo, hi = args.ph_hi;
#ifndef DBG_REP_PHASE
#define DBG_REP_PHASE -1
#endif
#ifndef DBG_REP_N
#define DBG_REP_N 1
#endif
#define REPS(k) for (int rep_ = 0; rep_ < ((k) == DBG_REP_PHASE ? 1 + DBG_REP_N : 1); ++rep_)
#define IN(k) (lo <= (k) && (k) < hi)
#define BOTH(k) (IN(k) && IN((k) + 1))
#define ENDPH(k) do { if (BOTH(k) || (k) == DBG_REP_PHASE) GRID_BAR(); } while (0)
    if (IN(0)) REPS(0) { p0_prologue(F, args); ENDPH(0); }
    if (IN(1)) REPS(1) {
        p1_cumsum(F, args);
        pg8::Gemm g{(const bf16*)(ws + WS_XN), (const bf16*)(ws + WS_WIN), M, NPROJ - 256, DM}; pg8::StaticOrder S; S.init(M, NPROJ - 256, F.G, (int)blockIdx.x);
        EpiInProj E{(bf16*)(ws + WS_U), (bf16*)(ws + WS_Q), (bf16*)(ws + WS_K), (bf16*)(ws + WS_V), (bf16*)(ws + WS_GA), (bf16*)(ws + WS_GB), args.out, args.q_norm_g, args.k_norm_g, 0};
        pg8::gemm_phase<EpiInProj, pg8::StaticOrder, true, true>(F.lds, g, S, E);
        ENDPH(1);
    }
    if (IN(2)) REPS(2) {
        { pg8::Gemm g{(const bf16*)(ws + WS_XN), (const bf16*)(ws + WS_WIN) + (size_t)(NPROJ - 256) * DM, M, 256, DM}; pg8::StaticOrder S; S.init(M, 256, F.G, (int)blockIdx.x);
          EpiInProj E{(bf16*)(ws + WS_U), (bf16*)(ws + WS_Q), (bf16*)(ws + WS_K), (bf16*)(ws + WS_V), (bf16*)(ws + WS_GA), (bf16*)(ws + WS_GB), args.out, args.q_norm_g, args.k_norm_g, 15};
          pg8::gemm_phase<EpiInProj, pg8::StaticOrder, true, true>(F.lds, g, S, E); }
        __syncthreads();
        p2_cumsum_pool(F, args);
        if (2 == DBG_REP_PHASE || !IN(3)) GRID_BAR();
        __syncthreads(); }
    if (IN(3)) {
        const float M2 = __builtin_bit_cast(float, __builtin_amdgcn_readfirstlane(__builtin_bit_cast(int, attn_bound2(args, F.lane))));
#if !defined(DBG_SKIP_PATTN)
        { const attn_body::AttnTensors AT{(const attn_body::bf16*)(ws + WS_Q), (const attn_body::bf16*)(ws + WS_K), (const attn_body::bf16*)(ws + WS_V), (attn_body::bf16*)(ws + WS_AO), (const float*)(ws + WS_CP2), M2};
          const attn_body::StaticOrder S((int)F.G, F.vcu);
          attn_body::attn_phase<attn_body::StaticOrder>((char*)lds, AT, S);
#ifdef DBG_ATTN2
          __syncthreads(); attn_body::attn_phase<attn_body::StaticOrder>((char*)lds, AT, S);
#endif
        }
#endif
        REPS(3) { p3_sample_attn2(F, args, M2); }
        ENDPH(3); }
    if (IN(4)) REPS(4) {
        { pg8::Gemm g{(const bf16*)(ws + WS_PO), (const bf16*)(ws + WS_WBP), MP, DM, DP}; pg8::StaticOrder S; S.init(MP, DM, F.G, (int)blockIdx.x);
          EpiGate<0> E{(const bf16*)(ws + WS_GA), nullptr, (bf16*)(ws + WS_T)};
          pg8::gemm_phase<EpiGate<0>, pg8::StaticOrder, true, true>(F.lds, g, S, E); }
        __syncthreads();
        { pg8::Gemm g{(const bf16*)(ws + WS_AO), (const bf16*)(ws + WS_WBA), MP, DM, DA}; pg8::StaticOrder S; S.init(MP, DM, F.G, (int)blockIdx.x);
          EpiGate<1> E{(const bf16*)(ws + WS_GB), (const bf16*)(ws + WS_T), (bf16*)(ws + WS_MIX)};
          pg8::gemm_phase<EpiGate<1>, pg8::StaticOrder, true, true>(F.lds, g, S, E); }
        { SgGate<0> E{(const bf16*)(ws + WS_GA), nullptr, (bf16*)(ws + WS_T)}; sg_phase(F, (const bf16*)(ws + WS_PO) + (size_t)MP * DP, (const bf16*)(ws + WS_WBP), DP, DM, E); }
        asm volatile("s_waitcnt vmcnt(0)" ::: "memory"); __syncthreads();
        { SgGate<1> E{(const bf16*)(ws + WS_GB), (const bf16*)(ws + WS_T), (bf16*)(ws + WS_MIX)}; sg_phase(F, (const bf16*)(ws + WS_AO) + (size_t)MP * DA, (const bf16*)(ws + WS_WBA), DA, DM, E); }
        ENDPH(4);
    }
    if (IN(5)) REPS(5) {
        pg8::Gemm g{(const bf16*)(ws + WS_MIX), (const bf16*)(ws + WS_WOUT), MP, DM, DM}; pg8::StaticOrder S; S.init(MP, DM, F.G, (int)blockIdx.x);
        EpiOut E{args.x_p, args.x_s, (float*)(ws + WS_H), (bf16*)(ws + WS_XN), args.norm_ffn_g, (float*)(ws + WS_RSS)};
        pg8::gemm_phase<EpiOut, pg8::StaticOrder, true, true>(F.lds, g, S, E);
        { SgOut E2{args.x_s, (float*)(ws + WS_H), (bf16*)(ws + WS_XN), args.norm_ffn_g, (float*)(ws + WS_RSS)}; sg_phase(F, (const bf16*)(ws + WS_MIX) + (size_t)MP * DM, (const bf16*)(ws + WS_WOUT), DM, DM, E2); }
        ENDPH(5);
    }
    if (IN(6)) REPS(6) {
        pg8::Gemm g{(const bf16*)(ws + WS_XN), (const bf16*)(ws + WS_WQ), MP, DQ, DM}; pg8::StaticOrder S; S.init(MP, DQ, F.G, (int)blockIdx.x);
        pg8::EpiBf16<0> E{(bf16*)(ws + WS_PQ), DQ, nullptr, 0, 0, 1.f};
        pg8::gemm_phase<pg8::EpiBf16<0>, pg8::StaticOrder, true, true>(F.lds, g, S, E);
        { SgPQ E2{(bf16*)(ws + WS_PQ)}; sg_phase(F, (const bf16*)(ws + WS_XN) + (size_t)MP * DM, (const bf16*)(ws + WS_WQ), DM, DQ, E2); }
        ENDPH(6);
    }
    if (IN(7)) REPS(7) { p7_topk(F, args); ENDPH(7); }
    if (IN(8)) REPS(8) { p8_gather(F, args); ENDPH(8); }
#ifdef DBG_DUMP
    if (IN(9)) { const bf16* AO = (const bf16*)(ws + WS_AO); const bf16* PO = (const bf16*)(ws + WS_PO); const bf16* MX = (const bf16*)(ws + (DBG_DUMP == 3 ? WS_T : DBG_DUMP == 4 ? WS_GA : WS_MIX));
        for (size_t i = (size_t)blockIdx.x * NTHR + F.tid; i < (size_t)M * DM; i += (size_t)F.G * NTHR) { const int row = (int)(i >> 10), c = (int)(i & 1023);
            float v; if (DBG_DUMP == 1) v = c < 512 ? bf2f(AO[(size_t)row * DA + c]) : bf2f(PO[(size_t)row * DP + c - 512]); else v = bf2f(MX[i]);
            args.out[O_YP + i] = v; } }
#endif
#undef IN
#undef BOTH
}

extern "C" void kernel_launch(void* const* d_in, const int* in_sizes, int n_in, void* d_out, int out_size, void* d_ws, size_t ws_size, hipStream_t stream) {
    static int grid = 0;
    if (grid == 0) {
        if (n_in != 22 || (size_t)out_size != O_END || ws_size < WS_END) { fprintf(stderr, "kernel_launch: unexpected shapes (n_in %d out %d ws %zu)\n", n_in, out_size, ws_size); grid = -1; return; }
        int dev = 0, cus = 0, per_cu = 0;
        if (hipGetDevice(&dev) != hipSuccess || hipDeviceGetAttribute(&cus, hipDeviceAttributeMultiprocessorCount, dev) != hipSuccess) { grid = -1; return; }
        if (hipFuncSetAttribute((const void*)fwd_kernel, hipFuncAttributeMaxDynamicSharedMemorySize, LDS_BYTES) != hipSuccess) { fprintf(stderr, "kernel_launch: hipFuncSetAttribute failed\n"); grid = -1; return; }
        if (hipOccupancyMaxActiveBlocksPerMultiprocessor(&per_cu, (const void*)fwd_kernel, NTHR, LDS_BYTES) != hipSuccess || per_cu < 1) fprintf(stderr, "kernel_launch: occupancy query reports %d\n", per_cu);
        (void)hipGetLastError();
        grid = cus;
    }
    if (grid < 0) return;
    if (hipMemsetAsync((char*)d_ws + WS_CTL, 0, CTL_ZERO_BYTES, stream) != hipSuccess) return;
    Args a{};
    a.x_p = (const float*)d_in[0]; a.x_s = (const float*)d_in[1]; a.cache_k = (const float*)d_in[2]; a.cache_v = (const float*)d_in[3]; a.cache_lf = (const float*)d_in[4];
    a.state_pool = (const float*)d_in[5]; a.page_table = (const int*)d_in[6]; a.norm_mix_g = (const float*)d_in[7]; a.w_in = (const float*)d_in[8]; a.b_forget = (const float*)d_in[9];
    a.q_norm_g = (const float*)d_in[10]; a.k_norm_g = (const float*)d_in[11]; a.pool_mix_w = (const float*)d_in[12]; a.pool_scale = (const float*)d_in[13]; a.w_bp = (const float*)d_in[14];
    a.w_ba = (const float*)d_in[15]; a.w_out = (const float*)d_in[16]; a.norm_ffn_g = (const float*)d_in[17]; a.w_query = (const float*)d_in[18]; a.sub_keys = (const float*)d_in[19];
    a.peer_u = (const float*)d_in[20]; a.peer_v = (const float*)d_in[21];
    a.out = (float*)d_out; a.ws = (unsigned char*)d_ws; a.pad = 0;
#if MK_PER_PHASE
#ifndef DBG_NPH
#define DBG_NPH N_PHASES
#endif
    for (int ph = 0; ph < DBG_NPH; ++ph) { a.ph_lo = ph; a.ph_hi = ph + 1; a.li = ph; hipLaunchKernelGGL(fwd_kernel, dim3(grid), dim3(NTHR), LDS_BYTES, stream, a); }
#ifdef DBG_DUMP
    a.ph_lo = 9; a.ph_hi = 10; a.li = 9; hipLaunchKernelGGL(fwd_kernel, dim3(grid), dim3(NTHR), LDS_BYTES, stream, a);
#endif
#else
    a.ph_lo = 0; a.ph_hi = N_PHASES; a.li = 0; hipLaunchKernelGGL(fwd_kernel, dim3(grid), dim3(NTHR), LDS_BYTES, stream, a);
#endif
}
```

```cpp
#include <hip/hip_runtime.h>
#include <cstdio>
#include <cstdint>
#include <cmath>
namespace pg8 {
#define PG8_LAS __attribute__((address_space(3)))
typedef unsigned short bf16_t;
typedef short bf16x8 __attribute__((ext_vector_type(8)));
typedef float f32x4 __attribute__((ext_vector_type(4)));
typedef unsigned u32x4 __attribute__((ext_vector_type(4)));
constexpr int BM = 256, BK = 64, HALF = 128, HTB = HALF * BK * 2  , STAGE_BYTES = 8 * HTB, NXCD = 8, WGM = 8;

__host__ __device__ __forceinline__ int lds_byte(int r, int c) { const int st = (r >> 4) * 2 + (c >> 5), rr = r & 15, cc = c & 31, ob = rr * 64 + cc * 2; return st * 1024 + (ob ^ (((ob >> 9) & 1) << 5)); }
__host__ __device__ __forceinline__ void stage_rc(int b, int& R, int& C) { const int st = b / 1024, sb = b % 1024, swz = sb ^ (((sb >> 9) & 1) << 5); R = (st >> 1) * 16 + swz / 64; C = (st & 1) * 32 + (swz % 64) / 2; }
__host__ __device__ __forceinline__ int perm32(int rho) { const int n = rho >> 4, i = rho & 15; return 8 * (i >> 2) + 4 * n + (i & 3); }

struct Unit { int pm, pn, sel; };
struct Gemm { const bf16_t* A; const bf16_t* Bt; int M, N, K; const bf16_t* A2; const bf16_t* Bt2; };

struct StaticOrder {
    int nM, nN, nwg, G, c;
    __host__ __device__ void init(int M, int N, int G_, int c_) { nM = M / BM; nN = N / BM; nwg = nM * nN; G = G_; c = c_; }
    __host__ __device__ bool next(int i, Unit& u) const {
        const long L = (long)i * G + c; if (L >= nwg) return false;
        int wgid = (int)L; { const int q = nwg / NXCD, r = nwg % NXCD, xcd = wgid % NXCD, off = wgid / NXCD; wgid = (xcd < r ? xcd * (q + 1) : r * (q + 1) + (xcd - r) * q) + off; }
        const int nig = WGM * nN, gid = wgid / nig, fm = gid * WGM, gsz = (nM - fm) < WGM ? (nM - fm) : WGM;
        u.pm = fm + ((wgid % nig) % gsz); u.pn = (wgid % nig) / gsz; return true;
    }
    __device__ __forceinline__ void a_ready(const Unit&) const {}
    __device__ __forceinline__ void done(const Unit&) const {}
};

typedef float f32x2c __attribute__((ext_vector_type(2))); typedef __bf16 bf16x2c __attribute__((ext_vector_type(2)));
__device__ __forceinline__ unsigned cvt_pk_bf16(float lo, float hi) { f32x2c v = {lo, hi}; bf16x2c b = __builtin_convertvector(v, bf16x2c); return __builtin_bit_cast(unsigned, b); }
typedef float f32x2 __attribute__((ext_vector_type(2)));
__device__ __forceinline__ f32x2 gelu_pk(f32x2 v) {
    const f32x2 av = __builtin_elementwise_abs(v), d = av * 0.2316418882f + 1.0f;
    f32x2 t; t.x = __builtin_amdgcn_rcpf(d.x); t.y = __builtin_amdgcn_rcpf(d.y);
    f32x2 q = t * 0.5307027145f + (-0.7265760135f); q = q * t + 0.7107068705f; q = q * t + (-0.142248368f); q = q * t + 0.127414796f; q = q * t;
    const f32x2 s = (v * v) * (-0.72134752044f);
    f32x2 e; e.x = __builtin_amdgcn_exp2f(s.x); e.y = __builtin_amdgcn_exp2f(s.y);
    const f32x2 m = v * (q * e), r = v - m;
    f32x2 o; o.x = v.x < 0.f ? m.x : r.x; o.y = v.y < 0.f ? m.y : r.y; return o;
}

template <int ACT  > struct EpiBf16 {
    static constexpr bool PERM = true, AFTER_DRAIN = false, CHAIN = false; static_assert(ACT == 0 || ACT == 1, "EpiBf16: ACT is 0 (none) or 1 (gelu_pk)");
    bf16_t* O; int ldc; const float* bias; int split_cols; size_t split_stride; float scale0;
    __device__ __forceinline__ void operator()(const f32x4 (&acc)[2][2][4][2], const Unit& u, int wr, int wc, int fr, int fq) const {
        const int row0 = u.pm * BM + wr * 64 + fr; int colt = u.pn * BM; bf16_t* base = O;
        float sc = 1.f; if (split_cols) { const int t = colt / split_cols; base += (size_t)t * split_stride; colt -= t * split_cols; if (t == 0) sc = scale0; }
        const int col0 = colt + wc * 32 + 8 * fq, bcol0 = u.pn * BM + wc * 32 + 8 * fq;
        f32x4 bv[2][2];
#pragma unroll
        for (int bj = 0; bj < 2; ++bj)
#pragma unroll
            for (int n = 0; n < 2; ++n) bv[bj][n] = bias ? *(const f32x4*)(bias + bcol0 + bj * HALF + 4 * n) : (f32x4){0.f, 0.f, 0.f, 0.f};
#pragma unroll
        for (int ai = 0; ai < 2; ++ai)
#pragma unroll
            for (int m = 0; m < 4; ++m) { bf16_t* rowp = base + (size_t)(row0 + ai * HALF + m * 16) * ldc + col0;
#pragma unroll
                for (int bj = 0; bj < 2; ++bj) { f32x4 v0 = acc[ai][bj][m][0] + bv[bj][0], v1 = acc[ai][bj][m][1] + bv[bj][1];
                    if (ACT == 1) { f32x2 a = gelu_pk((f32x2){v0[0], v0[1]}), b = gelu_pk((f32x2){v0[2], v0[3]}), c = gelu_pk((f32x2){v1[0], v1[1]}), d = gelu_pk((f32x2){v1[2], v1[3]});
                        v0 = (f32x4){a.x, a.y, b.x, b.y}; v1 = (f32x4){c.x, c.y, d.x, d.y}; }
                    v0 = v0 * sc; v1 = v1 * sc; u32x4 w; w.x = cvt_pk_bf16(v0[0], v0[1]); w.y = cvt_pk_bf16(v0[2], v0[3]); w.z = cvt_pk_bf16(v1[0], v1[1]); w.w = cvt_pk_bf16(v1[2], v1[3]);
                    *(u32x4*)(rowp + bj * HALF) = w; } }
    }
};
template <class Epi, class Sched, bool ALIGN_EPI = false, bool SP2 = false>
__device__ __forceinline__ void gemm_phase(PG8_LAS unsigned char* lds, const Gemm g, const Sched& S, const Epi& E) {
    int tid = threadIdx.x; asm volatile("" : "+v"(tid));
    const int wid = __builtin_amdgcn_readfirstlane(tid >> 6), lane = tid & 63, wr = wid >> 2, wc = wid & 3, fr = lane & 15, fq = lane >> 4;
    const int K = g.K, nt = K / BK;
    unsigned voffA[2], voffB[2];
#pragma unroll
    for (int i = 0; i < 2; ++i) { int R, C; stage_rc(tid * 16 + i * 8192, R, C); const int Rb = Epi::PERM ? ((R & ~31) + perm32(R & 31)) : R;
        voffA[i] = (unsigned)(R * K + C) * 2u; voffB[i] = (unsigned)(Rb * K + C) * 2u; }
    const size_t kstep = (size_t)(BK * 2);
    const size_t hstep = (size_t)HALF * K * 2;
    const size_t tstep = 2 * hstep;
    const unsigned ldsw = (unsigned)wid * 1024u;
    const int aoff = lds_byte(wr * 64 + fr, fq * 8), boff = lds_byte(wc * 32 + fr, fq * 8);
#define PG8_SA(b, h) (((b) * 2 + (h)) * HTB)
#define PG8_SB(b, h) ((4 + (b) * 2 + (h)) * HTB)
#define PG8_STAGE(bufoff, gbase, voff) do { _Pragma("unroll") for (int _i = 0; _i < 2; ++_i) \
        __builtin_amdgcn_global_load_lds((const unsigned*)((const char*)(gbase) + (voff)[_i]), (PG8_LAS unsigned*)(lds + (bufoff) + ldsw + _i * 8192), 16, 0, 0); } while (0)
#define PG8_LDA(dst, b, h) do { _Pragma("unroll") for (int m = 0; m < 4; ++m) _Pragma("unroll") for (int k = 0; k < 2; ++k) dst[m][k] = *(const PG8_LAS bf16x8*)(lds + PG8_SA(b, h) + aoff + m * 2048 + k * 1024); } while (0)
#define PG8_LDB(dst, b, h) do { _Pragma("unroll") for (int n = 0; n < 2; ++n) _Pragma("unroll") for (int k = 0; k < 2; ++k) dst[n][k] = *(const PG8_LAS bf16x8*)(lds + PG8_SB(b, h) + boff + n * 2048 + k * 1024); } while (0)
#define PG8_MMA(ai, bj, At, Bt) do { __builtin_amdgcn_s_setprio(1); _Pragma("unroll") for (int m = 0; m < 4; ++m) _Pragma("unroll") for (int n = 0; n < 2; ++n) _Pragma("unroll") for (int k = 0; k < 2; ++k) \
        acc[ai][bj][m][n] = __builtin_amdgcn_mfma_f32_16x16x32_bf16(Bt[n][k], At[m][k], acc[ai][bj][m][n], 0, 0, 0); __builtin_amdgcn_s_setprio(0); } while (0)
#define PG8_WAIT_V(n) asm volatile("s_waitcnt vmcnt(" #n ")" ::: "memory")
#define PG8_WAIT_L(n) asm volatile("s_waitcnt lgkmcnt(" #n ")" ::: "memory")
#define PG8_BAR __builtin_amdgcn_s_barrier()
#define PG8_SCHED __builtin_amdgcn_sched_barrier(0)
    Unit cur, nxt; int ui = 0;
    if (!S.next(0, cur)) return;
    f32x4 acc[2][2][4][2];
#pragma unroll
    for (int a = 0; a < 2; ++a)
#pragma unroll
        for (int b = 0; b < 2; ++b)
#pragma unroll
            for (int m = 0; m < 4; ++m)
#pragma unroll
                for (int n = 0; n < 2; ++n) acc[a][b][m][n] = (f32x4){0.f, 0.f, 0.f, 0.f};
    bf16x8 At[4][2], B0[2][2], B1[2][2];
    const char* cA = (const char*)g.A + (size_t)cur.pm * tstep; const char* cB = (const char*)g.Bt + (size_t)cur.pn * tstep;
    if constexpr (Epi::CHAIN) { if (cur.sel) { cA = (const char*)g.A2 + (size_t)cur.pm * tstep; cB = (const char*)g.Bt2 + (size_t)cur.pn * tstep; } }
    S.a_ready(cur);
    if constexpr (SP2) {
        PG8_STAGE(PG8_SB(0, 0), cB, voffB); PG8_STAGE(PG8_SB(0, 1), cB + hstep, voffB); PG8_STAGE(PG8_SA(0, 0), cA, voffA); PG8_STAGE(PG8_SA(0, 1), cA + hstep, voffA);
        if (wr == 1) PG8_BAR;
        PG8_WAIT_V(2); PG8_BAR;
        PG8_STAGE(PG8_SB(1, 0), cB + kstep, voffB); PG8_STAGE(PG8_SA(1, 0), cA + kstep, voffA); PG8_STAGE(PG8_SB(1, 1), cB + hstep + kstep, voffB);
        PG8_WAIT_V(6); PG8_BAR;
    } else {
        PG8_STAGE(PG8_SB(0, 0), cB, voffB); PG8_STAGE(PG8_SA(0, 0), cA, voffA); PG8_STAGE(PG8_SB(0, 1), cB + hstep, voffB); PG8_STAGE(PG8_SA(0, 1), cA + hstep, voffA);
        if (wr == 1) PG8_BAR;
        PG8_WAIT_V(4); PG8_BAR;
        PG8_STAGE(PG8_SB(1, 0), cB + kstep, voffB); PG8_STAGE(PG8_SA(1, 0), cA + kstep, voffA); PG8_STAGE(PG8_SB(1, 1), cB + hstep + kstep, voffB);
        PG8_WAIT_V(6); PG8_BAR;
    }
    for (;;) {
        const bool has_next = S.next(ui + 1, nxt);
        const char* nA = has_next ? (const char*)g.A + (size_t)nxt.pm * tstep : cA; const char* nB = has_next ? (const char*)g.Bt + (size_t)nxt.pn * tstep : cB;
        if constexpr (Epi::CHAIN) { if (has_next && nxt.sel) { nA = (const char*)g.A2 + (size_t)nxt.pm * tstep; nB = (const char*)g.Bt2 + (size_t)nxt.pn * tstep; } }
        for (int t = 0; t < nt; t += 2) {
            const bool last = (t == nt - 2);
            const char* a1 = cA + (size_t)(t + 1) * kstep;
            const char* a2 = last ? nA : cA + (size_t)(t + 2) * kstep; const char* b2 = last ? nB : cB + (size_t)(t + 2) * kstep;
            const char* a3 = a2 + kstep; const char* b3 = b2 + kstep;
            if (last && has_next) S.a_ready(nxt);
            if constexpr (SP2) {
            PG8_LDB(B0, 0, 0); PG8_LDB(B1, 0, 1); PG8_SCHED; PG8_LDA(At, 0, 0); PG8_STAGE(PG8_SA(1, 1), a1 + hstep, voffA);
            PG8_WAIT_V(8); PG8_WAIT_L(0); PG8_BAR; PG8_MMA(0, 0, At, B0); PG8_MMA(0, 1, At, B1); PG8_BAR; PG8_SCHED;
            PG8_LDA(At, 0, 1); PG8_STAGE(PG8_SB(0, 0), b2, voffB); PG8_STAGE(PG8_SB(0, 1), b2 + hstep, voffB); PG8_STAGE(PG8_SA(0, 0), a2, voffA);
            PG8_WAIT_V(8); PG8_WAIT_L(0); PG8_BAR; PG8_MMA(1, 0, At, B0); PG8_MMA(1, 1, At, B1); PG8_BAR; PG8_SCHED;
            PG8_LDB(B0, 1, 0); PG8_LDB(B1, 1, 1); PG8_SCHED; PG8_LDA(At, 1, 0); PG8_STAGE(PG8_SA(0, 1), a2 + hstep, voffA);
            PG8_WAIT_V(8); PG8_WAIT_L(0); PG8_BAR; PG8_MMA(0, 0, At, B0); PG8_MMA(0, 1, At, B1); PG8_BAR; PG8_SCHED;
            PG8_LDA(At, 1, 1); PG8_STAGE(PG8_SB(1, 0), b3, voffB); PG8_STAGE(PG8_SB(1, 1), b3 + hstep, voffB); PG8_STAGE(PG8_SA(1, 0), a3, voffA);
            PG8_WAIT_V(8); PG8_WAIT_L(0); PG8_BAR; PG8_MMA(1, 0, At, B0); PG8_MMA(1, 1, At, B1); PG8_BAR; PG8_SCHED;
            } else {
            PG8_LDB(B0, 0, 0); PG8_SCHED; PG8_LDA(At, 0, 0); PG8_STAGE(PG8_SA(1, 1), a1 + hstep, voffA);
            PG8_WAIT_L(8); PG8_BAR; PG8_WAIT_L(0); PG8_MMA(0, 0, At, B0); PG8_BAR; PG8_SCHED;
            PG8_LDB(B1, 0, 1); PG8_STAGE(PG8_SB(0, 0), b2, voffB);
            PG8_BAR; PG8_WAIT_L(0); PG8_MMA(0, 1, At, B1); PG8_BAR;
            PG8_LDA(At, 0, 1); PG8_STAGE(PG8_SA(0, 0), a2, voffA);
            PG8_BAR; PG8_WAIT_L(0); PG8_MMA(1, 0, At, B0); PG8_BAR; PG8_SCHED;
            PG8_STAGE(PG8_SB(0, 1), b2 + hstep, voffB);
            PG8_WAIT_V(6); PG8_BAR; PG8_MMA(1, 1, At, B1); PG8_BAR;
            PG8_LDB(B0, 1, 0); PG8_SCHED; PG8_LDA(At, 1, 0); PG8_STAGE(PG8_SA(0, 1), a2 + hstep, voffA);
            PG8_WAIT_L(8); PG8_BAR; PG8_WAIT_L(0); PG8_MMA(0, 0, At, B0); PG8_BAR; PG8_SCHED;
            PG8_LDB(B1, 1, 1); PG8_STAGE(PG8_SB(1, 0), b3, voffB);
            PG8_BAR; PG8_WAIT_L(0); PG8_MMA(0, 1, At, B1); PG8_BAR;
            PG8_LDA(At, 1, 1); PG8_STAGE(PG8_SA(1, 0), a3, voffA);
            PG8_BAR; PG8_WAIT_L(0); PG8_MMA(1, 0, At, B0); PG8_BAR; PG8_SCHED;
            PG8_STAGE(PG8_SB(1, 1), b3 + hstep, voffB);
            PG8_WAIT_V(6); PG8_BAR; PG8_MMA(1, 1, At, B1); PG8_BAR;
            }
        }
        if constexpr (ALIGN_EPI) { if (wr == 0) PG8_BAR; }
        bool keep_acc = false;
        if constexpr (Epi::CHAIN) { if (cur.sel == 0) { E.mid(acc, cur, wr, wc, fr, fq); keep_acc = true; } else { E(acc, cur, wr, wc, fr, fq); S.done(cur); } }
        else if constexpr (!Epi::AFTER_DRAIN) { E(acc, cur, wr, wc, fr, fq); S.done(cur); }
        if (!has_next) break;
        if (!keep_acc) {
#pragma unroll
        for (int a = 0; a < 2; ++a)
#pragma unroll
            for (int b = 0; b < 2; ++b)
#pragma unroll
                for (int m = 0; m < 4; ++m)
#pragma unroll
                    for (int n = 0; n < 2; ++n) acc[a][b][m][n] = (f32x4){0.f, 0.f, 0.f, 0.f};
        }
        cur = nxt; cA = nA; cB = nB; ++ui;
        if constexpr (ALIGN_EPI) { if (wr == 1) PG8_BAR; }
    }
    PG8_WAIT_V(0);
    if constexpr (!ALIGN_EPI) { if (wr == 0) PG8_BAR; }
    PG8_BAR;
    if constexpr (Epi::AFTER_DRAIN) { E.fused(acc, cur, wr, wc, fr, fq, lds, wid, lane); S.done(cur); }
#undef PG8_SA
#undef PG8_SB
#undef PG8_STAGE
#undef PG8_LDA
#undef PG8_LDB
#undef PG8_MMA
#undef PG8_WAIT_V
#undef PG8_WAIT_L
#undef PG8_BAR
#undef PG8_SCHED
}
}
#define GAS __attribute__((address_space(1)))
#define LAS __attribute__((address_space(3)))
typedef unsigned short bf16;
typedef unsigned v4u __attribute__((ext_vector_type(4)));
typedef float f32x4 __attribute__((ext_vector_type(4)));
typedef short bf16x8 __attribute__((ext_vector_type(8)));
typedef GAS unsigned gu32;
typedef GAS unsigned long long gu64;
#define RLX_AGENT __ATOMIC_RELAXED, __HIP_MEMORY_SCOPE_AGENT
#define LDS_WAIT() asm volatile("s_waitcnt lgkmcnt(0)" ::: "memory")
#define VM_WAIT() asm volatile("s_waitcnt vmcnt(0)" ::: "memory")
__device__ __forceinline__ unsigned long long rt() { return __builtin_amdgcn_s_memrealtime(); }
__device__ __forceinline__ unsigned f2bf(float f) { unsigned u = __builtin_bit_cast(unsigned, f); return (u + 0x7fffu + ((u >> 16) & 1u)) >> 16; }
__device__ __forceinline__ unsigned pk2(float lo, float hi) { return f2bf(lo) | (f2bf(hi) << 16); }

#define XB_TMO      128
#define XB_XCNT(j)  (256  + 64 * (j))
#define XB_XSUB(j)  (1280 + 64 * (j))
#define XB_XGEN(j)  (2304 + 64 * (j))
#define XB_TOP      3328
#define XB_TOPGEN   3392
#define XCD_BAR_WORDS 3456
#define XB_SPIN_CAP (1u << 18)

__device__ __forceinline__ unsigned xb_ld(unsigned* p)              { return __hip_atomic_load(p, __ATOMIC_RELAXED, __HIP_MEMORY_SCOPE_AGENT); }
__device__ __forceinline__ unsigned xb_add(unsigned* p, unsigned v) { return __hip_atomic_fetch_add(p, v, __ATOMIC_RELAXED, __HIP_MEMORY_SCOPE_AGENT); }
__device__ __forceinline__ unsigned xb_xcc_id() { return (unsigned)__builtin_amdgcn_s_getreg((3 << 11) | 20) & 0xFu; }
#define XB_SPIN(cond, bar) do { unsigned _sp = 0; while (cond) { __builtin_amdgcn_s_sleep(1); \
    if ((++_sp & 255u) == 0u) { if (xb_ld(&(bar)[XB_TMO])) break; if (_sp > XB_SPIN_CAP) { atomicAdd(&(bar)[XB_TMO], 1u); break; } } } } while (0)

struct XcdBarrier {
    unsigned* bar; unsigned x;
    volatile LAS unsigned* st;
};

__device__ __forceinline__ XcdBarrier xcd_barrier_post(unsigned* bar, volatile LAS unsigned* st) {
    XcdBarrier b; b.bar = bar; b.x = xb_xcc_id(); b.st = st;
    if (threadIdx.x == 0) (void)xb_add(&bar[XB_XCNT(b.x)], 1u);
    return b;
}
__device__ __forceinline__ void xcd_barrier_complete(unsigned* bar, unsigned x, unsigned& nloc, unsigned& nx) {
    const unsigned G = gridDim.x * gridDim.y * gridDim.z;
    unsigned sum, cnt, mine, sp = 0u;
    for (;;) {
        sum = 0u; cnt = 0u; mine = 0u;
#pragma unroll
        for (unsigned j = 0; j < 16; ++j) { const unsigned c = xb_ld(&bar[XB_XCNT(j)]); sum += c; cnt += (c > 0u) ? 1u : 0u; mine = (j == x) ? c : mine; }
        if (sum == G) break;
        __builtin_amdgcn_s_sleep(1);
        if ((++sp & 255u) == 0u) { if (xb_ld(&bar[XB_TMO])) break; if (sp > XB_SPIN_CAP) { atomicAdd(&bar[XB_TMO], 1u); break; } }
    }
    nloc = mine > 0u ? mine : 1u; nx = cnt > 0u ? cnt : 1u;
}

__device__ __forceinline__ void xcd_barrier(const XcdBarrier& b) {
    asm volatile("s_waitcnt vmcnt(0)" ::: "memory");
    __syncthreads();
    if (threadIdx.x == 0) {
        unsigned* bar = b.bar;
        __builtin_amdgcn_s_waitcnt(0);
        unsigned nloc = b.st[0], nx = b.st[1];
        if (nloc == 0u) { xcd_barrier_complete(bar, b.x, nloc, nx); b.st[0] = nloc; b.st[1] = nx; }
        const unsigned old = xb_add(&bar[XB_XSUB(b.x)], 1u);
        const unsigned gen = old / nloc;
        if (old + 1u == (gen + 1u) * nloc) {
            __builtin_amdgcn_fence(__ATOMIC_RELEASE, "agent");
            asm volatile("s_waitcnt vmcnt(0)" ::: "memory");
            const unsigned og = xb_add(&bar[XB_TOP], 1u);
            const unsigned tg = og / nx;
            if (og + 1u == (tg + 1u) * nx) xb_add(&bar[XB_TOPGEN], 1u);
            else XB_SPIN(xb_ld(&bar[XB_TOPGEN]) == tg, bar);
            __builtin_amdgcn_fence(__ATOMIC_ACQUIRE, "agent");
            xb_add(&bar[XB_XGEN(b.x)], 1u);
            asm volatile("s_waitcnt vmcnt(0)" ::: "memory");
        } else {
            XB_SPIN(xb_ld(&bar[XB_XGEN(b.x)]) == gen, bar);
            __builtin_amdgcn_fence(__ATOMIC_ACQUIRE, "agent");
            asm volatile("s_waitcnt vmcnt(0)" ::: "memory");
        }
    }
    __syncthreads();
}
#include <hip/hip_bf16.h>
#include <cmath>
namespace attn_body {
using bf16=__hip_bfloat16;
using bf16x8=__attribute__((ext_vector_type(8)))short;
using s16x4=__attribute__((ext_vector_type(4)))short;
using f32x16=__attribute__((ext_vector_type(16)))float;
using u32x4=__attribute__((ext_vector_type(4)))unsigned;
constexpr int BATCH=4,NHEAD=8,SEQ=4096,D=64,DM=NHEAD*D;
constexpr int NW=8,QBLK=32,QB=QBLK*NW,KVBLK=64,NQB=SEQ/QB;
constexpr int ATTN_PITCH=DM, ATTN_UNIT_ROWS=QB;
__device__ __forceinline__ int crow(int r,int hi){return (r&3)+8*(r>>2)+4*hi;}
#define SBAR() __builtin_amdgcn_sched_barrier(0)
__device__ __forceinline__ void cmask(f32x16&p0,f32x16&p1,int jb,int qrel,int hi){
  const float NEG=-INFINITY; int kb=64*jb+4*hi;
  #pragma unroll
  for(int r=0;r<16;++r){int kv=kb+(r&3)+8*(r>>2); if(kv>qrel)p0[r]=NEG; if(kv+32>qrel)p1[r]=NEG;}
}

constexpr int NSLOT=3, SLOTB=8192;
constexpr int LDS_K=0, LDS_V=NSLOT*SLOTB, LDS_WS=2*NSLOT*SLOTB, LDS_OST=LDS_WS+NW*64*4, LDS_CK=LDS_OST+NW*4096, LDS_BYTES=LDS_CK+SEQ*4;
constexpr float C2=0.125f*1.4426950408889634f;
__device__ __forceinline__ void glds16(const void*gsrc,unsigned lds_dst){unsigned keep;
  asm volatile("s_mov_b32 %0, m0\n\ts_mov_b32 m0, %2\n\ts_nop 0\n\tglobal_load_lds_dwordx4 %1, off\n\ts_mov_b32 m0, %0":"=&s"(keep):"v"(gsrc),"s"(lds_dst):"memory");}
__device__ __forceinline__ float max3f(float a,float b,float c){float r;asm("v_max3_f32 %0, %1, %2, %3":"=v"(r):"v"(a),"v"(b),"v"(c));return r;}
__device__ __forceinline__ float max2f(float a,float b){float r;asm("v_max_f32_e32 %0, %1, %2":"=v"(r):"v"(a),"v"(b));return r;}
__device__ __forceinline__ float fadd_s(float a,float b){float r;asm("v_add_f32_e32 %0, %1, %2":"=v"(r):"v"(a),"v"(b));return r;}
__device__ __forceinline__ float fsub_s(float a,float b){float r;asm("v_sub_f32_e32 %0, %1, %2":"=v"(r):"v"(a),"v"(b));return r;}
typedef float f32x2_t __attribute__((ext_vector_type(2))); typedef __bf16 bf16x2_t __attribute__((ext_vector_type(2)));
__device__ __forceinline__ unsigned cvtpk_s(float lo,float hi){f32x2_t v={lo,hi};bf16x2_t b=__builtin_convertvector(v,bf16x2_t);return __builtin_bit_cast(unsigned,b);}
#define WAIT_BAR(N) asm volatile("s_waitcnt vmcnt(" #N ") lgkmcnt(0)\n\ts_barrier":::"memory")

__device__ __forceinline__ void qkt(f32x16&p0,f32x16&p1,const char*Kslot,const bf16x8*qr,int r32,int hi){
  const char*kb=Kslot+hi*1024+r32*16;
  #pragma unroll
  for(int d0=0;d0<4;++d0){
    const bf16x8 b0=*reinterpret_cast<const bf16x8*>(kb+d0*2048);
    const bf16x8 b1=*reinterpret_cast<const bf16x8*>(kb+d0*2048+512);
    p0=__builtin_amdgcn_mfma_f32_32x32x16_bf16(b0,qr[d0],p0,0,0,0);p1=__builtin_amdgcn_mfma_f32_32x32x16_bf16(b1,qr[d0],p1,0,0,0);}
}
typedef __attribute__((address_space(3))) const char* lds_cptr;
typedef short v4i16_t __attribute__((ext_vector_type(4)));
__device__ __forceinline__ void kload8(bf16x8*kf,lds_cptr kp){
  kf[0]=*(const __attribute__((address_space(3))) bf16x8*)(kp);      kf[1]=*(const __attribute__((address_space(3))) bf16x8*)(kp+512);
  kf[2]=*(const __attribute__((address_space(3))) bf16x8*)(kp+2048); kf[3]=*(const __attribute__((address_space(3))) bf16x8*)(kp+2560);
  kf[4]=*(const __attribute__((address_space(3))) bf16x8*)(kp+4096); kf[5]=*(const __attribute__((address_space(3))) bf16x8*)(kp+4608);
  kf[6]=*(const __attribute__((address_space(3))) bf16x8*)(kp+6144); kf[7]=*(const __attribute__((address_space(3))) bf16x8*)(kp+6656);
}
__device__ __forceinline__ void kload2(bf16x8*kf,lds_cptr kp,int j){ kf[2*j]=*(const __attribute__((address_space(3))) bf16x8*)(kp+j*2048); kf[2*j+1]=*(const __attribute__((address_space(3))) bf16x8*)(kp+j*2048+512); }
__device__ __forceinline__ s16x4 vtr(lds_cptr p){ return __builtin_bit_cast(s16x4,__builtin_amdgcn_ds_read_tr16_b64_v4i16((__attribute__((address_space(3))) v4i16_t*)p)); }
__device__ __forceinline__ float rowmax(const f32x16&p0,const f32x16&p1){
  float a=max3f(p0[0],p0[1],p1[0]),b=max3f(p0[2],p0[3],p1[1]);a=max3f(a,p1[2],p1[3]);
  #pragma unroll
  for(int r=4;r<16;r+=4){a=max3f(a,p0[r],p0[r+1]);b=max3f(b,p0[r+2],p0[r+3]);a=max3f(a,p1[r],p1[r+1]);b=max3f(b,p1[r+2],p1[r+3]);}
  const float m=max2f(a,b);
  auto rr=__builtin_amdgcn_permlane32_swap(__float_as_uint(m),__float_as_uint(m),false,false);
  return max2f(__uint_as_float(rr[0]),__uint_as_float(rr[1]));
}
__device__ __forceinline__ void pv(f32x16*o,int vb,bf16x8 pa0,bf16x8 pa1,bf16x8 pa2,bf16x8 pa3){
  #pragma unroll
  for(int d0=0;d0<2;++d0){s16x4 lo[4],hi[4];
    #pragma unroll
    for(int ks=0;ks<4;++ks){
      asm volatile("ds_read_b64_tr_b16 %0,%1 offset:%c2":"=&v"(lo[ks]):"v"(vb),"i"(d0*4096+ks*1024):"memory");
      asm volatile("ds_read_b64_tr_b16 %0,%1 offset:%c2":"=&v"(hi[ks]):"v"(vb),"i"(d0*4096+ks*1024+512):"memory");}
    asm volatile("s_waitcnt lgkmcnt(0)":::"memory");SBAR();
    #define PK(k) (bf16x8){lo[k][0],lo[k][1],lo[k][2],lo[k][3],hi[k][0],hi[k][1],hi[k][2],hi[k][3]}
    o[d0]=__builtin_amdgcn_mfma_f32_32x32x16_bf16(pa0,PK(0),o[d0],0,0,0);
    o[d0]=__builtin_amdgcn_mfma_f32_32x32x16_bf16(pa1,PK(1),o[d0],0,0,0);
    o[d0]=__builtin_amdgcn_mfma_f32_32x32x16_bf16(pa2,PK(2),o[d0],0,0,0);
    o[d0]=__builtin_amdgcn_mfma_f32_32x32x16_bf16(pa3,PK(3),o[d0],0,0,0);
    #undef PK
  }
}

#ifndef ATTN_STORE16
#define ATTN_STORE16(p,v) (*(u32x4*)(p)=(v))
#endif
template<int THRL> __device__ __forceinline__ void attn_unit(int b,int h,int qb,const bf16*Q,const bf16*__restrict__ K,const bf16*__restrict__ V,bf16*O,const float*__restrict__ c2,float M2,char*shm){
  int tid=threadIdx.x; asm volatile("":"+v"(tid)); const int lane=tid&63,r32=lane&31,hi=lane>>5; const int wid=__builtin_amdgcn_readfirstlane(tid>>6);
  const long rowbase=(long)b*SEQ; const int q0=qb*QB;
  const bf16*Qw=Q+(rowbase+q0+wid*QBLK)*DM+h*D;
  const bf16*Kh0=K+rowbase*DM+h*D,*Vh0=V+rowbase*DM+h*D;
  const unsigned lds0=(unsigned)(uintptr_t)shm;
  float*wsf=(float*)(shm+LDS_WS)+wid*64;
  const unsigned kdst=lds0+LDS_K+wid*1024, vdst=lds0+LDS_V+wid*1024;
  #define DMA_K(t,slot) glds16(ksrc+(long)(t)*KVBLK*DM,(unsigned)__builtin_amdgcn_readfirstlane(kdst+(slot)))
  #define DMA_V(t,slot) glds16(vsrc+(long)(t)*KVBLK*DM,(unsigned)__builtin_amdgcn_readfirstlane(vdst+(slot)))
  const int vb0=(int)(lds0+LDS_V)+((lane>>4)&1)*32+(lane&3)*8+(4*hi+((lane&15)>>2))*64;
  const char*Kbase=shm+LDS_K; bf16x8 kf[8];
  const lds_cptr shm3=(lds_cptr)shm; const lds_cptr kp0=shm3+LDS_K+hi*1024+r32*16; const lds_cptr vp0=shm3+LDS_V+((lane>>4)&1)*32+(lane&3)*8+(4*hi+((lane&15)>>2))*64;
  const int NT0=(q0+QB)/KVBLK;
  int ts; { const int tl=lane; const float cqa=c2[q0]; const float ckb=(tl<NT0-4)?c2[64*tl+63]:cqa; const unsigned long long bm=__ballot((tl<NT0-4)&&(cqa-ckb< -(24.f+2.f*M2))); ts=__builtin_popcountll(bm)&~1; }
  ts=__builtin_amdgcn_readfirstlane(ts);
  const int NT=NT0-ts;
  const bf16*Kh=Kh0+(long)ts*KVBLK*DM,*Vh=Vh0+(long)ts*KVBLK*DM;
  const bf16*ksrc=Kh+(long)lane*DM+wid*8;
  const bf16*vsrc=Vh+(long)(16*(wid&3)+(lane>>2))*DM+(wid>>2)*32+(lane&3)*8;
  typedef float f32x4_t __attribute__((ext_vector_type(4)));
  int tidl=tid; asm volatile("":"+v"(tidl));
  const int nck4=(q0+QB)/4; f32x4_t ckv0=f32x4_t{},ckv1=f32x4_t{}; if(tidl<nck4)ckv0=((const f32x4_t*)c2)[tidl]; if(tidl+512<nck4)ckv1=((const f32x4_t*)c2)[tidl+512];
  const float cq=c2[q0+wid*QBLK+r32]-M2;
  DMA_K(0,0);DMA_V(0,0);DMA_K(1,SLOTB);
  bf16x8 qr[4];
  #pragma unroll
  for(int d0=0;d0<4;++d0)qr[d0]=*reinterpret_cast<const bf16x8*>(&Qw[(long)r32*DM+d0*16+hi*8]);
  float l_reg=0.f;f32x16 o[2];o[0]=f32x16{};o[1]=f32x16{};
  { __attribute__((address_space(3))) f32x4_t*ckl=(__attribute__((address_space(3))) f32x4_t*)((lds_cptr)shm+LDS_CK); if(tidl<nck4)ckl[tidl]=ckv0; if(tidl+512<nck4)ckl[tidl+512]=ckv1; }
  const __attribute__((address_space(3))) f32x4_t*ckp=(const __attribute__((address_space(3))) f32x4_t*)((lds_cptr)shm+LDS_CK)+hi+ts*16;
  #define CKLD(P0,P1,t) do{ _Pragma("unroll") for(int g_=0;g_<4;++g_){ const f32x4_t a_=ckp[(t)*16+2*g_], b_=ckp[(t)*16+8+2*g_]; P0[4*g_]=a_[0];P0[4*g_+1]=a_[1];P0[4*g_+2]=a_[2];P0[4*g_+3]=a_[3]; P1[4*g_]=b_[0];P1[4*g_+1]=b_[1];P1[4*g_+2]=b_[2];P1[4*g_+3]=b_[3]; } }while(0)
  #define CKSUB(P0,P1) do{ _Pragma("unroll") for(int r=0;r<16;++r){P0[r]=cq-P0[r];P1[r]=cq-P1[r];} }while(0)
  const int qrel=wid*QBLK+r32;
  #define CMASK(P0,P1,t) do{int jb_=(t)-(NT-4); if(jb_>=0)cmask(P0,P1,jb_,qrel,hi);}while(0)
  #define START(P0,P1) do{ _Pragma("unroll") for(int r=0;r<16;++r)P0[r]=__builtin_amdgcn_exp2f(P0[r]); }while(0)
  #define RESC() do{}while(0)
  f32x16 pA0,pA1,pB0,pB1;
  int sl_prev=0,sl_cur=0,sl_next=SLOTB;
  #define ROT() do{sl_prev=sl_cur;sl_cur=sl_next;sl_next=(sl_next==(NSLOT-1)*SLOTB)?0:sl_next+SLOTB;}while(0)
  DMA_K(2,2*SLOTB);
  WAIT_BAR(3);
  CKLD(pA0,pA1,0);CKSUB(pA0,pA1);
  qkt(pA0,pA1,Kbase,qr,r32,hi);asm volatile("s_nop 15\n\ts_nop 7":"+v"(pA0),"+v"(pA1));CMASK(pA0,pA1,0);
  CKLD(pB0,pB1,1);CKSUB(pB0,pB1);
  START(pA0,pA1);
  _Pragma("unroll") for(int r=0;r<16;++r)pA1[r]=__builtin_amdgcn_exp2f(pA1[r]);
  WAIT_BAR(0);
  DMA_K(3,0);DMA_V(1,SLOTB);
  ROT();
  kload8(kf,kp0+sl_cur);
  WAIT_BAR(2);
  s16x4 vlo[8],vhi[8]; u32x4 pw0,pw1,pw2,pw3;
  #define PKW(P,B) cvtpk_s(P[B],P[B+1])
  #define PAF(k) __builtin_bit_cast(bf16x8,pw##k)
  #define VFR(i) (bf16x8){vlo[i][0],vlo[i][1],vlo[i][2],vlo[i][3],vhi[i][0],vhi[i][1],vhi[i][2],vhi[i][3]}
  #define PIN(x) asm volatile("":"+v"(x))
  #define MX3(a,b,c) __builtin_fmaxf(__builtin_fmaxf((a),(b)),(c))
  #define GAPA(MF,A0,A1,A2,A3,W0,W1,PW) do{ MF; sacc+=A0; sacc+=A1; sacc+=A2; sacc+=A3; PIN(sacc); W0; W1; PIN(PW); SBAR(); }while(0)
  #define EX(v) __builtin_amdgcn_exp2f(v)
  #define GAPB(MF,X,B) do{ MF; X[B]=EX(X[B]); X[B+1]=EX(X[B+1]); X[B+2]=EX(X[B+2]); X[B+3]=EX(X[B+3]); PIN(X); SBAR(); }while(0)
  #define VRD(i) do{ vlo[i]=vtr(vp_+(((i)>>2)*4096+((i)&3)*1024)); vhi[i]=vtr(vp_+(((i)>>2)*4096+((i)&3)*1024+512)); }while(0)
  #define KRD(G,j) do{ if(G){ kload2(kf,kp0+sl_next,j); SBAR(); } }while(0)
  #define STEP(C0,C1,P0,P1,t,GK,GV,GL) do{ SBAR(); \
    const lds_cptr vp_=vp0+sl_prev; \
    VRD(0); SBAR(); float sacc=(P0[0]+P0[1]); \
    GAPA(C0=__builtin_amdgcn_mfma_f32_32x32x16_bf16(kf[0],qr[0],C0,0,0,0), P0[2],P0[3],P0[4],P0[5],     pw0[0]=PKW(P0,0), pw0[1]=PKW(P0,2), pw0); \
    VRD(4); SBAR(); GAPA(C1=__builtin_amdgcn_mfma_f32_32x32x16_bf16(kf[1],qr[0],C1,0,0,0), P0[6],P0[7],P0[8],P0[9],     pw0[2]=PKW(P0,4), pw0[3]=PKW(P0,6), pw0); \
    VRD(1); SBAR(); GAPA(C0=__builtin_amdgcn_mfma_f32_32x32x16_bf16(kf[2],qr[1],C0,0,0,0),   P0[10],P0[11],P0[12],P0[13], pw1[0]=PKW(P0,8), pw1[1]=PKW(P0,10), pw1); \
    VRD(5); SBAR(); GAPA(C1=__builtin_amdgcn_mfma_f32_32x32x16_bf16(kf[3],qr[1],C1,0,0,0),   P0[14],P0[15],P1[0],P1[1],   pw1[2]=PKW(P0,12),pw1[3]=PKW(P0,14), pw1); \
    VRD(2); SBAR(); GAPA(C0=__builtin_amdgcn_mfma_f32_32x32x16_bf16(kf[4],qr[2],C0,0,0,0),   P1[2],P1[3],P1[4],P1[5],     pw2[0]=PKW(P1,0), pw2[1]=PKW(P1,2), pw2); \
    VRD(6); SBAR(); GAPA(C1=__builtin_amdgcn_mfma_f32_32x32x16_bf16(kf[5],qr[2],C1,0,0,0),   P1[6],P1[7],P1[8],P1[9],     pw2[2]=PKW(P1,4), pw2[3]=PKW(P1,6), pw2); \
    VRD(3); SBAR(); GAPA(C0=__builtin_amdgcn_mfma_f32_32x32x16_bf16(kf[6],qr[3],C0,0,0,0),   P1[10],P1[11],P1[12],P1[13], pw3[0]=PKW(P1,8), pw3[1]=PKW(P1,10), pw3); \
    VRD(7); SBAR(); GAPA(C1=__builtin_amdgcn_mfma_f32_32x32x16_bf16(kf[7],qr[3],C1,0,0,0),   P1[14],P1[15],0.f,0.f,       pw3[2]=PKW(P1,12),pw3[3]=PKW(P1,14), pw3); \
    l_reg+=sacc; \
    if(GK){DMA_K((t)+3,sl_cur);} if(GV){DMA_V((t)+1,sl_next);} \
    CMASK(C0,C1,t); \
    SBAR(); \
    GAPB(o[0]=__builtin_amdgcn_mfma_f32_32x32x16_bf16(PAF(0),VFR(0),o[0],0,0,0), C0,0); \
    GAPB(o[1]=__builtin_amdgcn_mfma_f32_32x32x16_bf16(PAF(0),VFR(4),o[1],0,0,0), C0,4); \
    KRD(GL,0); GAPB(o[0]=__builtin_amdgcn_mfma_f32_32x32x16_bf16(PAF(1),VFR(1),o[0],0,0,0), C0,8); \
    KRD(GL,1); GAPB(o[1]=__builtin_amdgcn_mfma_f32_32x32x16_bf16(PAF(1),VFR(5),o[1],0,0,0), C0,12); \
    KRD(GL,2); GAPB(o[0]=__builtin_amdgcn_mfma_f32_32x32x16_bf16(PAF(2),VFR(2),o[0],0,0,0), C1,0); \
    KRD(GL,3); GAPB(o[1]=__builtin_amdgcn_mfma_f32_32x32x16_bf16(PAF(2),VFR(6),o[1],0,0,0), C1,4); \
    GAPB(o[0]=__builtin_amdgcn_mfma_f32_32x32x16_bf16(PAF(3),VFR(3),o[0],0,0,0), C1,8); \
    GAPB(o[1]=__builtin_amdgcn_mfma_f32_32x32x16_bf16(PAF(3),VFR(7),o[1],0,0,0), C1,12); \
    if(GL){ CKLD(P0,P1,(t)+1); CKSUB(P0,P1); } \
    }while(0)
  int t=1;
  #undef CMASK
  #define CMASK(P0,P1,t) do{}while(0)
  for(;t+5<NT;t+=2){
    STEP(pB0,pB1,pA0,pA1,t,true,true,true);     WAIT_BAR(2); RESC(); ROT();
    STEP(pA0,pA1,pB0,pB1,t+1,true,true,true);   WAIT_BAR(2); RESC(); ROT();
  }
  #undef CMASK
  #define CMASK(P0,P1,t) do{int jb_=(t)-(NT-4); if(jb_>=0)cmask(P0,P1,jb_,qrel,hi);}while(0)
  #define ENDW(tt) do{ if((tt)+3<NT){WAIT_BAR(2);} else if((tt)+2<NT){WAIT_BAR(1);} else {WAIT_BAR(0);} }while(0)
  for(;t+1<NT;t+=2){
    STEP(pB0,pB1,pA0,pA1,t,(t+3<NT),(t+1<NT),(t+1<NT));       ENDW(t);   RESC(); ROT();
    STEP(pA0,pA1,pB0,pB1,t+1,(t+4<NT),(t+2<NT),(t+2<NT));     ENDW(t+1); RESC(); ROT();
  }
  STEP(pB0,pB1,pA0,pA1,NT-1,false,false,false); RESC();
  { float sacc=pB0[0]+pB0[1]; _Pragma("unroll") for(int r=2;r<16;++r)sacc+=pB0[r]; _Pragma("unroll") for(int r=0;r<16;++r)sacc+=pB1[r]; l_reg+=sacc;
    pw0=(u32x4){PKW(pB0,0),PKW(pB0,2),PKW(pB0,4),PKW(pB0,6)};pw1=(u32x4){PKW(pB0,8),PKW(pB0,10),PKW(pB0,12),PKW(pB0,14)};pw2=(u32x4){PKW(pB1,0),PKW(pB1,2),PKW(pB1,4),PKW(pB1,6)};pw3=(u32x4){PKW(pB1,8),PKW(pB1,10),PKW(pB1,12),PKW(pB1,14)};
    SBAR(); pv(o,vb0+sl_cur,PAF(0),PAF(1),PAF(2),PAF(3)); }
  #undef PKW
  #undef PAF
  #undef VFR
  #undef PIN
  #undef MX3
  #undef GAPA
  #undef GAPB
  #undef EX
  #undef VRD
  #undef KRD
  #undef STEP
  #undef ENDW
  {auto rr=__builtin_amdgcn_permlane32_swap(__float_as_uint(l_reg),__float_as_uint(l_reg),false,false);l_reg=__uint_as_float(rr[0])+__uint_as_float(rr[1]);}
  if(hi==0)wsf[32+r32]=l_reg;asm volatile("s_waitcnt lgkmcnt(0)":::"memory");
  float rli[16];
  #pragma unroll
  for(int r=0;r<16;++r)rli[r]=__builtin_amdgcn_rcpf(wsf[32+crow(r,hi)]);
  bf16*Ow=O+(rowbase+q0+wid*QBLK)*DM+h*D;
  { bf16*stg=(bf16*)(shm+LDS_OST)+wid*2048;
    #pragma unroll
    for(int r=0;r<16;++r){const int orow=crow(r,hi);
      #pragma unroll
      for(int d0=0;d0<2;++d0)stg[orow*64+d0*32+r32]=__float2bfloat16(o[d0][r]*rli[r]);}
    asm volatile("s_waitcnt lgkmcnt(0)":::"memory");
    #pragma unroll
    for(int i=0;i<4;++i){const int row=i*8+(lane>>3),ch=lane&7; const u32x4 v=*(const u32x4*)(stg+row*64+ch*8); ATTN_STORE16(Ow+(long)row*DM+ch*8,v);} }
  asm volatile("s_waitcnt lgkmcnt(0)\n\ts_barrier":::"memory");
  #undef DMA_K
  #undef DMA_V
  #undef CMASK
  #undef START
  #undef RESC
  #undef ROT
  #undef CKLD
  #undef CKSUB
}
constexpr int ATTN_LDS_BYTES=LDS_BYTES;
struct AttnTensors { const bf16* Q; const bf16* K; const bf16* V; bf16* O; const float* C2T; float M2; };
struct AttnUnit { int bh; int qb; };
struct StaticOrder {
  int vcu, G;
  __device__ __forceinline__ explicit StaticOrder(int grid,int v):vcu(v),G(grid){}
  __device__ __forceinline__ bool next(int i,AttnUnit&u)const{ const int L=i*G+vcu; if(L>=BATCH*NHEAD*NQB)return false; const int r=L>>8, idx=L&255, k=idx&7; u.bh=idx>>3; u.qb=(r==0)?(NQB-1-k):k; return true; }
  __device__ __forceinline__ void a_ready(const AttnUnit&)const{}
  __device__ __forceinline__ void done(const AttnUnit&)const{}
};
struct QueueOrder {
  unsigned* cnt; volatile __attribute__((address_space(3))) unsigned* slot;
  __device__ __forceinline__ bool next(int,AttnUnit&u)const{
    if(threadIdx.x==0){ *slot=__hip_atomic_fetch_add(cnt,1u,__ATOMIC_RELAXED,__HIP_MEMORY_SCOPE_AGENT); }
    __syncthreads(); const unsigned L=*slot; __syncthreads();
    if(L>=(unsigned)(BATCH*NHEAD*NQB))return false;
    u.qb=NQB-1-(int)(L>>5); u.bh=(int)(L&31); return true; }
  __device__ __forceinline__ void a_ready(const AttnUnit&)const{}
  __device__ __forceinline__ void done(const AttnUnit&)const{}
};
template<class Sched,int THRL=8> __device__ __forceinline__ void attn_phase(char*lds,const AttnTensors&T,const Sched&S){
  AttnUnit u;
  for(int i=0;S.next(i,u);++i){ S.a_ready(u); attn_unit<THRL>(u.bh/NHEAD,u.bh%NHEAD,u.qb,T.Q,T.K,T.V,T.O,T.C2T+(size_t)u.bh*SEQ,T.M2,lds); S.done(u); }
}
#undef SBAR
#undef WAIT_BAR
}

constexpr int NWAVES = 8, NTHR = 512;
constexpr int DM = 1024, NB = 4, SEQ = 4096, DB = 128, DSEQ = 8, PAST = 2048, PAGE = 128, NPAGES = 16;
constexpr int MP = NB * SEQ, MS = DB * DSEQ, M = MP + MS;
constexpr int DP = 512, DA = 512, NH = 8, HD = 64, DIN = 4104, NPROJ = 4096;
constexpr int NKEYS = 128, NEXP = 16384, PH = 8, TOPK = 16, DKH = 128, DQ = 2048;
constexpr float EPS = 1e-6f;
constexpr float LOG2E = 1.4426950408889634f;
constexpr float C2 = 0.125f * LOG2E;
constexpr size_t O_YP = 0, O_YS = O_YP + (size_t)MP * DM, O_KP = O_YS + (size_t)MS * DM, O_VP = O_KP + (size_t)MP * DA, O_LFP = O_VP + (size_t)MP * DA,
                 O_PP = O_LFP + (size_t)MP * NH, O_KS = O_PP + (size_t)NB * 15 * DP, O_VS = O_KS + (size_t)MS * DA, O_LFS = O_VS + (size_t)MS * DA,
                 O_PS = O_LFS + (size_t)MS * NH, O_END = O_PS + (size_t)DB * 15 * DP;
constexpr size_t MiB = 1u << 20;
constexpr size_t WS_CTL = 0, CTL_ZERO_BYTES = 64 * 1024;
constexpr size_t WS_WIN = 2 * MiB, WS_WBP = 10 * MiB, WS_WBA = 11 * MiB, WS_WOUT = 12 * MiB, WS_WQ = 14 * MiB, WS_SUBK = 18 * MiB, WS_CP2 = 19 * MiB, WS_RSS = 20 * MiB, WS_US = 22 * MiB, WS_VS = 23 * MiB;
constexpr size_t WS_PU = 32 * MiB, WS_PV = 64 * MiB, WS_XN = 96 * MiB  , WS_U = 132 * MiB, WS_Q = 150 * MiB, WS_K = 168 * MiB, WS_V = 186 * MiB,
                 WS_GA = 204 * MiB, WS_GB = 240 * MiB, WS_PO = 276 * MiB, WS_AO = 294 * MiB, WS_T = 312 * MiB, WS_MIX = 348 * MiB, WS_PQ = 384 * MiB,
                 WS_SI = 456 * MiB, WS_SG = 466 * MiB, WS_H = 476 * MiB, WS_END = 548 * MiB;
constexpr int CW_BAR = 4096;
constexpr int LDS_BYTES = 163840;
constexpr int SCR_BYTES = 159 * 1024;
constexpr int MISC_OFF = SCR_BYTES;

typedef unsigned short bf16;
typedef unsigned v4u __attribute__((ext_vector_type(4)));
typedef unsigned v2u __attribute__((ext_vector_type(2)));
typedef float f32x4 __attribute__((ext_vector_type(4)));
typedef float f32x2 __attribute__((ext_vector_type(2)));

__device__ __forceinline__ float bf2f(unsigned short b) { return __uint_as_float((unsigned)b << 16); }
__device__ __forceinline__ float bflo(unsigned w) { return __uint_as_float(w << 16); }
__device__ __forceinline__ float bfhi(unsigned w) { return __uint_as_float(w & 0xffff0000u); }
typedef __bf16 bf16x2_t __attribute__((ext_vector_type(2)));
__device__ __forceinline__ unsigned pkbf(float lo, float hi) { f32x2 v = {lo, hi}; bf16x2_t b = __builtin_convertvector(v, bf16x2_t); return __builtin_bit_cast(unsigned, b); }
__device__ __forceinline__ float wave_sum(float v) {
#pragma unroll
    for (int o = 1; o < 64; o <<= 1) v += __shfl_xor(v, o);
    return v;
}
__device__ __forceinline__ float wave_max(float v) {
#pragma unroll
    for (int o = 1; o < 64; o <<= 1) v = fmaxf(v, __shfl_xor(v, o));
    return v;
}

struct Args {
    const float* x_p; const float* x_s; const float* cache_k; const float* cache_v; const float* cache_lf; const float* state_pool; const int* page_table;
    const float* norm_mix_g; const float* w_in; const float* b_forget; const float* q_norm_g; const float* k_norm_g; const float* pool_mix_w; const float* pool_scale;
    const float* w_bp; const float* w_ba; const float* w_out; const float* norm_ffn_g; const float* w_query; const float* sub_keys; const float* peer_u; const float* peer_v;
    float* out; unsigned char* ws; int ph_lo, ph_hi, li, pad;
};

using pg8::Unit;
struct EpiInProj {
    static constexpr bool PERM = true, AFTER_DRAIN = false, CHAIN = false;
    bf16 *U, *Q, *K, *V, *GA, *GB; float* out; const float *gq, *gk; int pn_off;
    __device__ __forceinline__ void operator()(const f32x4 (&acc)[2][2][4][2], const Unit& u, int wr, int wc, int fr, int fq) const {
        const int pn = u.pn + pn_off; const int row0 = u.pm * 256 + wr * 64 + fr; const bool prompt = u.pm < (MP / 256);
        if (pn < 2) {
#pragma unroll
            for (int ai = 0; ai < 2; ++ai)
#pragma unroll
                for (int m = 0; m < 4; ++m) { const int row = row0 + ai * 128 + m * 16;
                    float* tail = nullptr;
                    if (prompt) { const int s = row & (SEQ - 1), b = row >> 12; if (s >= SEQ - 15) tail = out + O_PP + (size_t)(b * 15 + (s - (SEQ - 15))) * DP; }
                    else { const int rs = row - MP; tail = out + O_PS + (size_t)((rs >> 3) * 15 + 7 + (rs & 7)) * DP; }
#pragma unroll
                    for (int bj = 0; bj < 2; ++bj) { const int col = pn * 256 + bj * 128 + wc * 32 + 8 * fq; const f32x4 v0 = acc[ai][bj][m][0], v1 = acc[ai][bj][m][1];
                        v4u w; w.x = pkbf(v0[0], v0[1]); w.y = pkbf(v0[2], v0[3]); w.z = pkbf(v1[0], v1[1]); w.w = pkbf(v1[2], v1[3]);
                        *(v4u*)(U + (size_t)row * DP + col) = w;
                        if (tail) { *(f32x4*)(tail + col) = v0; *(f32x4*)(tail + col + 4) = v1; } } }
        } else if (pn < 6) {
            const bool isq = pn < 4; const int head = 4 * (pn & 1) + wc; const float* g = isq ? gq : gk;
            f32x4 gv[2][2];
#pragma unroll
            for (int bj = 0; bj < 2; ++bj)
#pragma unroll
                for (int n = 0; n < 2; ++n) gv[bj][n] = *(const f32x4*)(g + 32 * bj + 8 * fq + 4 * n);
            bf16* dst = isq ? Q : K;
#pragma unroll
            for (int ai = 0; ai < 2; ++ai)
#pragma unroll
                for (int m = 0; m < 4; ++m) { const int row = row0 + ai * 128 + m * 16; float ss = 0.f;
#pragma unroll
                    for (int bj = 0; bj < 2; ++bj)
#pragma unroll
                        for (int n = 0; n < 2; ++n) { const f32x4 x = acc[ai][bj][m][n]; ss += (x[0] * x[0] + x[1] * x[1]) + (x[2] * x[2] + x[3] * x[3]); }
                    ss += __shfl_xor(ss, 16); ss += __shfl_xor(ss, 32);
                    float r = 1.0f / sqrtf(ss * (1.0f / 64.0f) + EPS);
                    float* kout = isq ? nullptr : (prompt ? out + O_KP + (size_t)row * DA : out + O_KS + (size_t)(row - MP) * DA);
                    const float rq = isq ? r * C2 : r;
#pragma unroll
                    for (int bj = 0; bj < 2; ++bj) { const int col = head * 64 + 32 * bj + 8 * fq; const f32x4 v0 = acc[ai][bj][m][0] * gv[bj][0] * rq, v1 = acc[ai][bj][m][1] * gv[bj][1] * rq;
                        v4u w; w.x = pkbf(v0[0], v0[1]); w.y = pkbf(v0[2], v0[3]); w.z = pkbf(v1[0], v1[1]); w.w = pkbf(v1[2], v1[3]);
                        *(v4u*)(dst + (size_t)row * DA + col) = w;
                        if (!isq) { __builtin_nontemporal_store(v0, (f32x4*)(kout + col)); __builtin_nontemporal_store(v1, (f32x4*)(kout + col + 4)); } } }
        } else if (pn < 8) {
#pragma unroll
            for (int ai = 0; ai < 2; ++ai)
#pragma unroll
                for (int m = 0; m < 4; ++m) { const int row = row0 + ai * 128 + m * 16;
                    float* vout = prompt ? out + O_VP + (size_t)row * DA : out + O_VS + (size_t)(row - MP) * DA;
#pragma unroll
                    for (int bj = 0; bj < 2; ++bj) { const int col = (pn - 6) * 256 + bj * 128 + wc * 32 + 8 * fq; const f32x4 v0 = acc[ai][bj][m][0], v1 = acc[ai][bj][m][1];
                        v4u w; w.x = pkbf(v0[0], v0[1]); w.y = pkbf(v0[2], v0[3]); w.z = pkbf(v1[0], v1[1]); w.w = pkbf(v1[2], v1[3]);
                        *(v4u*)(V + (size_t)row * DA + col) = w; __builtin_nontemporal_store(v0, (f32x4*)(vout + col)); __builtin_nontemporal_store(v1, (f32x4*)(vout + col + 4)); } }
        } else {
            bf16* dst = pn < 12 ? GA : GB; const int ct = (pn < 12 ? pn - 8 : pn - 12) * 256;
#pragma unroll
            for (int ai = 0; ai < 2; ++ai)
#pragma unroll
                for (int m = 0; m < 4; ++m) { const int row = row0 + ai * 128 + m * 16;
#pragma unroll
                    for (int bj = 0; bj < 2; ++bj) { const int col = ct + bj * 128 + wc * 32 + 8 * fq; float s[8];
#pragma unroll
                        for (int n = 0; n < 2; ++n)
#pragma unroll
                            for (int i = 0; i < 4; ++i) s[4 * n + i] = __builtin_amdgcn_rcpf(1.0f + __builtin_amdgcn_exp2f(-LOG2E * acc[ai][bj][m][n][i]));
                        v4u w; w.x = pkbf(s[0], s[1]); w.y = pkbf(s[2], s[3]); w.z = pkbf(s[4], s[5]); w.w = pkbf(s[6], s[7]);
                        *(v4u*)(dst + (size_t)row * DM + col) = w; } }
        }
    }
};
template <int MODE> struct EpiGate {
    static constexpr bool PERM = true, AFTER_DRAIN = false, CHAIN = false;
    const bf16* G; const bf16* Tin; bf16* O;
    __device__ __forceinline__ void operator()(const f32x4 (&acc)[2][2][4][2], const Unit& u, int wr, int wc, int fr, int fq) const {
        const int row0 = u.pm * 256 + wr * 64 + fr;
#pragma unroll
        for (int ai = 0; ai < 2; ++ai)
#pragma unroll
            for (int m = 0; m < 4; ++m) { const int row = row0 + ai * 128 + m * 16;
#pragma unroll
                for (int bj = 0; bj < 2; ++bj) { const size_t off = (size_t)row * DM + u.pn * 256 + bj * 128 + wc * 32 + 8 * fq;
                    const v4u g = *(const v4u*)(G + off); const f32x4 v0 = acc[ai][bj][m][0], v1 = acc[ai][bj][m][1];
                    float r[8] = {v0[0] * bflo(g.x), v0[1] * bfhi(g.x), v0[2] * bflo(g.y), v0[3] * bfhi(g.y), v1[0] * bflo(g.z), v1[1] * bfhi(g.z), v1[2] * bflo(g.w), v1[3] * bfhi(g.w)};
                    if (MODE == 1) { const v4u t = *(const v4u*)(Tin + off);
                        r[0] += bflo(t.x); r[1] += bfhi(t.x); r[2] += bflo(t.y); r[3] += bfhi(t.y); r[4] += bflo(t.z); r[5] += bfhi(t.z); r[6] += bflo(t.w); r[7] += bfhi(t.w); }
                    v4u w; w.x = pkbf(r[0], r[1]); w.y = pkbf(r[2], r[3]); w.z = pkbf(r[4], r[5]); w.w = pkbf(r[6], r[7]);
                    *(v4u*)(O + off) = w; } }
    }
};
struct EpiMerge {
    static constexpr bool PERM = true, AFTER_DRAIN = false, CHAIN = true;
    const bf16* GA; const bf16* GB; bf16* O;
    __device__ __forceinline__ void mid(f32x4 (&acc)[2][2][4][2], const Unit& u, int wr, int wc, int fr, int fq) const {
        const int row0 = u.pm * 256 + wr * 64 + fr;
#pragma unroll
        for (int ai = 0; ai < 2; ++ai)
#pragma unroll
            for (int m = 0; m < 4; ++m) { const int row = row0 + ai * 128 + m * 16;
#pragma unroll
                for (int bj = 0; bj < 2; ++bj) { const size_t off = (size_t)row * DM + u.pn * 256 + bj * 128 + wc * 32 + 8 * fq;
                    const v4u ga = *(const v4u*)(GA + off), gb = *(const v4u*)(GB + off);
                    const unsigned gaw[4] = {ga.x, ga.y, ga.z, ga.w}, gbw[4] = {gb.x, gb.y, gb.z, gb.w};
#pragma unroll
                    for (int k = 0; k < 4; ++k) { const float r0 = bflo(gaw[k]) * __builtin_amdgcn_rcpf(fmaxf(bflo(gbw[k]), 0x1p-60f)), r1 = bfhi(gaw[k]) * __builtin_amdgcn_rcpf(fmaxf(bfhi(gbw[k]), 0x1p-60f));
                        acc[ai][bj][m][k >> 1][2 * (k & 1)] *= r0; acc[ai][bj][m][k >> 1][2 * (k & 1) + 1] *= r1; } } }
    }
    __device__ __forceinline__ void operator()(const f32x4 (&acc)[2][2][4][2], const Unit& u, int wr, int wc, int fr, int fq) const {
        const int row0 = u.pm * 256 + wr * 64 + fr;
#pragma unroll
        for (int ai = 0; ai < 2; ++ai)
#pragma unroll
            for (int m = 0; m < 4; ++m) { const int row = row0 + ai * 128 + m * 16;
#pragma unroll
                for (int bj = 0; bj < 2; ++bj) { const size_t off = (size_t)row * DM + u.pn * 256 + bj * 128 + wc * 32 + 8 * fq;
                    const v4u gb = *(const v4u*)(GB + off); const unsigned gbw[4] = {gb.x, gb.y, gb.z, gb.w}; unsigned ow[4];
#pragma unroll
                    for (int k = 0; k < 4; ++k) ow[k] = pkbf(acc[ai][bj][m][k >> 1][2 * (k & 1)] * fmaxf(bflo(gbw[k]), 0x1p-60f), acc[ai][bj][m][k >> 1][2 * (k & 1) + 1] * fmaxf(bfhi(gbw[k]), 0x1p-60f));
                    *(v4u*)(O + off) = (v4u){ow[0], ow[1], ow[2], ow[3]}; } }
    }
};
struct EpiOut {
    static constexpr bool PERM = true, AFTER_DRAIN = false, CHAIN = false;
    const float* xp; const float* xs; float* H; bf16* HG; const float* gf; float* RSS;
    __device__ __forceinline__ void operator()(const f32x4 (&acc)[2][2][4][2], const Unit& u, int wr, int wc, int fr, int fq) const {
        const int row0 = u.pm * 256 + wr * 64 + fr; const bool prompt = u.pm < (MP / 256);
#pragma unroll
        for (int ai = 0; ai < 2; ++ai)
#pragma unroll
            for (int m = 0; m < 4; ++m) { const int row = row0 + ai * 128 + m * 16; float ss = 0.f;
                const float* xr = prompt ? xp + (size_t)row * DM : xs + (size_t)(row - MP) * DM;
#pragma unroll
                for (int bj = 0; bj < 2; ++bj) { const int col = u.pn * 256 + bj * 128 + wc * 32 + 8 * fq;
                    const f32x4 h0 = acc[ai][bj][m][0] + *(const f32x4*)(xr + col), h1 = acc[ai][bj][m][1] + *(const f32x4*)(xr + col + 4);
                    ss += (h0[0] * h0[0] + h0[1] * h0[1]) + (h0[2] * h0[2] + h0[3] * h0[3]) + (h1[0] * h1[0] + h1[1] * h1[1]) + (h1[2] * h1[2] + h1[3] * h1[3]);
                    v4u w; w.x = pkbf(h0[0], h0[1]); w.y = pkbf(h0[2], h0[3]); w.z = pkbf(h1[0], h1[1]); w.w = pkbf(h1[2], h1[3]);
                    *(v4u*)(HG + (size_t)row * DM + col) = w; }
                ss += __shfl_xor(ss, 16); ss += __shfl_xor(ss, 32);
                if (fq == 0) RSS[(size_t)row * 16 + u.pn * 4 + wc] = ss; }
    }
};

struct Frame {
    LAS unsigned char* lds; volatile LAS unsigned* MISC; gu32* ctl;
    int tid, lane, wave, vcu, G;
};

__device__ __forceinline__ void transpose_item(const float* W, int ldw, int K, bf16* WT, int src_col0, int dst_row0, int k0, LAS float* scr, int lane, const float* kscale = nullptr) {
#pragma unroll 8
    for (int i = 0; i < 32; ++i) { const int kk = 2 * i + (lane >> 5); const float wv = W[(size_t)(k0 + kk) * ldw + src_col0 + (lane & 31)]; scr[kk * 33 + (lane & 31)] = kscale ? wv * kscale[k0 + kk] : wv; }
    LDS_WAIT(); asm volatile("" ::: "memory");
    const int c = lane & 7;
#pragma unroll
    for (int j = 0; j < 4; ++j) { const int n = (lane >> 3) + 8 * j; const LAS float* s = scr + (8 * c) * 33 + n;
        v4u o; o.x = pkbf(s[0 * 33], s[1 * 33]); o.y = pkbf(s[2 * 33], s[3 * 33]); o.z = pkbf(s[4 * 33], s[5 * 33]); o.w = pkbf(s[6 * 33], s[7 * 33]);
        *(v4u*)(WT + (size_t)(dst_row0 + n) * K + k0 + 8 * c) = o; }
    LDS_WAIT(); asm volatile("" ::: "memory");
}
__device__ __forceinline__ int win_src_col(int db) {
    if (db < 16) return 32 * db;
    if (db < 48) { const int base = db < 32 ? 512 : 1024; const int local = (db - 16) & 15, tile = local >> 3, blk = local & 7, bj = blk >> 2, w = blk & 3; return base + tile * 256 + 64 * w + 32 * bj; }
    if (db < 64) return 1536 + 32 * (db - 48);
    if (db < 96) return 2056 + 32 * (db - 64);
    return 3080 + 32 * (db - 96);
}
__device__ __forceinline__ void cvt_rows_bf16(const float* src, bf16* dst, size_t n8, size_t gtid, size_t gn) {
    for (size_t i = gtid; i < n8; i += gn) { const f32x4 a = *(const f32x4*)(src + 8 * i), b = *(const f32x4*)(src + 8 * i + 4);
        v4u w; w.x = pkbf(a[0], a[1]); w.y = pkbf(a[2], a[3]); w.z = pkbf(b[0], b[1]); w.w = pkbf(b[2], b[3]); *(v4u*)(dst + 8 * i) = w; }
}
template <bool I8> __device__ __forceinline__ void cvt_rows_fp8(const float* src, unsigned char* dst, float* scl, int gw, int NGW, int lane, const float* colscale = nullptr) {
    for (int e0 = gw; e0 < NEXP; e0 += 2 * NGW) {
        f32x4 q[2][4]; float mx[2];
#pragma unroll
        for (int u = 0; u < 2; ++u) { const int e = (e0 + u * NGW < NEXP) ? e0 + u * NGW : e0; const float* r = src + (size_t)e * DM + 16 * lane;
            q[u][0] = *(const f32x4*)r; q[u][1] = *(const f32x4*)(r + 4); q[u][2] = *(const f32x4*)(r + 8); q[u][3] = *(const f32x4*)(r + 12);
            if (colscale) {
#pragma unroll
                for (int j = 0; j < 4; ++j) q[u][j] = q[u][j] * *(const f32x4*)(colscale + 16 * lane + 4 * j); } }
#pragma unroll
        for (int u = 0; u < 2; ++u) { float m = 0.f;
#pragma unroll
            for (int j = 0; j < 4; ++j) m = fmaxf(m, fmaxf(fmaxf(fabsf(q[u][j][0]), fabsf(q[u][j][1])), fmaxf(fabsf(q[u][j][2]), fabsf(q[u][j][3]))));
            mx[u] = m; }
#pragma unroll
        for (int o = 1; o < 64; o <<= 1) { mx[0] = fmaxf(mx[0], __shfl_xor(mx[0], o)); mx[1] = fmaxf(mx[1], __shfl_xor(mx[1], o)); }
#pragma unroll
        for (int u = 0; u < 2; ++u) { const int e = e0 + u * NGW; if (e < NEXP) {
            if constexpr (I8) {
                float best = 1.0f, berr = 3.0e38f;
#pragma unroll
                for (int ci = 0; ci < 5; ++ci) { const float rho = 1.0f - 0.1f * ci, cs = mx[u] > 1e-30f ? 7.0f / (rho * mx[u]) : 0.f, ics = rho * mx[u] * (1.0f / 7.0f); float er = 0.f;
#pragma unroll
                    for (int j = 0; j < 4; ++j)
#pragma unroll
                        for (int i = 0; i < 4; ++i) { const float x = q[u][j][i], d = x - ics * __builtin_amdgcn_fmed3f(rintf(x * cs), -7.0f, 7.0f); er += d * d; }
#pragma unroll
                    for (int o = 1; o < 64; o <<= 1) er += __shfl_xor(er, o);
                    if (er < berr) { berr = er; best = rho; } }
                const float cm = best * mx[u], sc = cm > 1e-30f ? 7.0f / cm : 0.f, isc = cm * (1.0f / 112.0f);
                unsigned w[2] = {0u, 0u};
#pragma unroll
                for (int j = 0; j < 4; ++j)
#pragma unroll
                    for (int i = 0; i < 4; i += 2) { const int qe = (int)__builtin_amdgcn_fmed3f(rintf(q[u][j][i] * sc), -7.0f, 7.0f), qo = (int)__builtin_amdgcn_fmed3f(rintf(q[u][j][i + 1] * sc), -7.0f, 7.0f);
                        const unsigned byte = (((unsigned)qo & 15u) << 4) | ((unsigned)(qe + 8) & 15u); const int t = 2 * j + (i >> 1); w[t >> 2] |= byte << (8 * (t & 3)); }
                *(v2u*)(dst + (size_t)(lane >> 4) * ((size_t)NEXP * 128) + (size_t)e * 128 + 8 * (lane & 15)) = (v2u){w[0], w[1]};
                if (lane == 0) scl[e] = isc;
                continue; }
            } }
    }
}
__device__ __forceinline__ void p0_prologue(Frame& F, const Args& a) {
    unsigned char* ws = a.ws;
    LAS float* scr = (LAS float*)(F.lds + F.wave * 16384);
    const int gw = F.vcu * NWAVES + F.wave, NGW = F.G * NWAVES;
    for (int it = gw; it < 4096; it += NGW) {
        int r = it;
        if (r < 2048) { const int kb = r >> 7, db = r & 127; transpose_item(a.w_in, DIN, DM, (bf16*)(ws + WS_WIN), win_src_col(db), 32 * db, 64 * kb, scr, F.lane); continue; } r -= 2048;
        if (r < 256) { continue; } r -= 256;
        if (r < 256) { const int kb = r >> 5, nb = r & 31; transpose_item(a.w_ba, DM, DA, (bf16*)(ws + WS_WBA), 32 * nb, 32 * nb, 64 * kb, scr, F.lane); continue; } r -= 256;
        if (r < 512) { const int kb = r >> 5, nb = r & 31; transpose_item(a.w_out, DM, DM, (bf16*)(ws + WS_WOUT), 32 * nb, 32 * nb, 64 * kb, scr, F.lane); continue; } r -= 512;
        { const int kb = r >> 6, nb = r & 63; transpose_item(a.w_query, DQ, DM, (bf16*)(ws + WS_WQ), 32 * nb, 32 * nb, 64 * kb, scr, F.lane, a.norm_ffn_g); }
    }
    for (int it = gw; it < 16 * 4 * 16; it += NGW) { const int nb = it & 15, g = (it >> 4) & 3, cb = it >> 6; const int nn = 64 * nb + F.lane; float acc8[8];
#pragma unroll
        for (int i = 0; i < 8; ++i) acc8[i] = 0.f;
        const float* pm = a.pool_mix_w + (size_t)g * 16384 + (size_t)(8 * cb) * 128;
#pragma unroll 16
        for (int d = 0; d < 128; ++d) { const float wv = a.w_bp[(size_t)(g * 128 + d) * DM + nn] * a.pool_scale[g * 128 + d];
#pragma unroll
            for (int i = 0; i < 8; ++i) acc8[i] += pm[i * 128 + d] * wv; }
        v4u o; o.x = pkbf(acc8[0], acc8[1]); o.y = pkbf(acc8[2], acc8[3]); o.z = pkbf(acc8[4], acc8[5]); o.w = pkbf(acc8[6], acc8[7]);
        *(v4u*)((bf16*)(ws + WS_WBP) + (size_t)nn * DP + g * 128 + 8 * cb) = o; }
    { const size_t gtid = (size_t)F.vcu * NTHR + F.tid, gn = (size_t)F.G * NTHR;
      cvt_rows_fp8<true>(a.peer_u, ws + WS_PU, (float*)(ws + WS_US), gw, NGW, F.lane, a.norm_ffn_g);
      cvt_rows_fp8<true>(a.peer_v, ws + WS_PV, (float*)(ws + WS_VS), gw, NGW, F.lane);
      cvt_rows_bf16(a.sub_keys, (bf16*)(ws + WS_SUBK), (size_t)PH * 2 * NKEYS * DKH / 8, gtid, gn);
      for (size_t i = gtid; i < (size_t)DB * 7 * DP; i += gn) { const int b = (int)(i / (7 * DP)), j = (int)((i / DP) % 7), c = (int)(i % DP);
          a.out[O_PS + (size_t)(b * 15 + j) * DP + c] = a.state_pool[(size_t)(b * 15 + 8 + j) * DP + c]; } }
    __syncthreads();
    LAS float* wfT = (LAS float*)F.lds;
    for (int i = F.tid; i < 8 * DM; i += NTHR) { const int col = i >> 3, h = i & 7; wfT[h * DM + col] = a.w_in[(size_t)col * DIN + 2048 + h]; }
    __syncthreads();
    bf16* XN = (bf16*)(ws + WS_XN);
    for (int row0 = gw; row0 < M; row0 += 2 * NGW) {
        f32x4 v[2][4]; float rr[2], f[2][8]; bool ok[2];
#pragma unroll
        for (int u = 0; u < 2; ++u) { const int row = row0 + u * NGW; ok[u] = row < M; const int rc = ok[u] ? row : row0;
            const float* xr = rc < MP ? a.x_p + (size_t)rc * DM : a.x_s + (size_t)(rc - MP) * DM;
#pragma unroll
            for (int j = 0; j < 4; ++j) v[u][j] = *(const f32x4*)(xr + 256 * j + 4 * F.lane); }
#pragma unroll
        for (int u = 0; u < 2; ++u) { float ss = 0.f;
#pragma unroll
            for (int j = 0; j < 4; ++j) ss += (v[u][j][0] * v[u][j][0] + v[u][j][1] * v[u][j][1]) + (v[u][j][2] * v[u][j][2] + v[u][j][3] * v[u][j][3]);
            rr[u] = ss; }
#pragma unroll
        for (int o = 1; o < 64; o <<= 1) { rr[0] += __shfl_xor(rr[0], o); rr[1] += __shfl_xor(rr[1], o); }
#pragma unroll
        for (int u = 0; u < 2; ++u) { const int row = ok[u] ? row0 + u * NGW : row0; const float r = 1.0f / sqrtf(rr[u] * (1.0f / DM) + EPS);
#pragma unroll
            for (int h = 0; h < 8; ++h) f[u][h] = 0.f;
#pragma unroll
            for (int j = 0; j < 4; ++j) { const f32x4 g = *(const f32x4*)(a.norm_mix_g + 256 * j + 4 * F.lane); v[u][j] = v[u][j] * r * g;
                v2u w; w.x = pkbf(v[u][j][0], v[u][j][1]); w.y = pkbf(v[u][j][2], v[u][j][3]); if (ok[u]) *(v2u*)(XN + (size_t)row * DM + 256 * j + 4 * F.lane) = w;
#pragma unroll
                for (int h = 0; h < 8; ++h) { const f32x4 wv = *(const LAS f32x4*)(wfT + h * DM + 256 * j + 4 * F.lane); f[u][h] += (v[u][j][0] * wv[0] + v[u][j][1] * wv[1]) + (v[u][j][2] * wv[2] + v[u][j][3] * wv[3]); } } }
#pragma unroll
        for (int u = 0; u < 2; ++u) { const int row = row0 + u * NGW;
            const bool b4 = (F.lane & 4) != 0, b2 = (F.lane & 2) != 0, b1 = (F.lane & 1) != 0; float t4[4], t2[2];
#pragma unroll
            for (int k = 0; k < 4; ++k) { const float keep = b4 ? f[u][4 + k] : f[u][k], send = b4 ? f[u][k] : f[u][4 + k]; t4[k] = keep + __shfl_xor(send, 4); }
#pragma unroll
            for (int k = 0; k < 2; ++k) { const float keep = b2 ? t4[2 + k] : t4[k], send = b2 ? t4[k] : t4[2 + k]; t2[k] = keep + __shfl_xor(send, 2); }
            float t1 = (b1 ? t2[1] : t2[0]) + __shfl_xor(b1 ? t2[0] : t2[1], 1);
            t1 += __shfl_xor(t1, 8); t1 += __shfl_xor(t1, 16); t1 += __shfl_xor(t1, 32);
            if (F.lane < 8 && ok[u]) { const float z = t1 + a.b_forget[F.lane]; const float lf = fminf(z, 0.f) - log1pf(expf(-fabsf(z)));
                if (row < MP) a.out[O_LFP + (size_t)row * NH + F.lane] = lf; else a.out[O_LFS + (size_t)(row - MP) * NH + F.lane] = lf; } }
    }
}

template <int W> __device__ __forceinline__ void p2_item(const Args& a, unsigned char* ws, int row, int ch) {
    const bf16* U = (const bf16*)(ws + WS_U); bf16* PO = (bf16*)(ws + WS_PO);
    float e[W][8]; float cnt;
    if (row < MP) { const int s = row & (SEQ - 1); cnt = (float)(s + 1 < W ? s + 1 : W);
#pragma unroll
        for (int i = 0; i < W; ++i) { v4u q = (v4u){0u, 0u, 0u, 0u}; if (s - i >= 0) q = *(const v4u*)(U + (size_t)(row - i) * DP + ch);
            e[i][0] = bflo(q.x); e[i][1] = bfhi(q.x); e[i][2] = bflo(q.y); e[i][3] = bfhi(q.y); e[i][4] = bflo(q.z); e[i][5] = bfhi(q.z); e[i][6] = bflo(q.w); e[i][7] = bfhi(q.w); }
    } else { const int rs = row - MP, b = rs >> 3, t = rs & 7; cnt = (float)W;
#pragma unroll
        for (int i = 0; i < W; ++i) { const int tt = t - i;
            if (tt >= 0) { const v4u q = *(const v4u*)(U + (size_t)(MP + b * 8 + tt) * DP + ch);
                e[i][0] = bflo(q.x); e[i][1] = bfhi(q.x); e[i][2] = bflo(q.y); e[i][3] = bfhi(q.y); e[i][4] = bflo(q.z); e[i][5] = bfhi(q.z); e[i][6] = bflo(q.w); e[i][7] = bfhi(q.w); }
            else { const f32x4 p0 = *(const f32x4*)(a.state_pool + (size_t)(b * 15 + 15 + tt) * DP + ch), p1 = *(const f32x4*)(a.state_pool + (size_t)(b * 15 + 15 + tt) * DP + ch + 4);
                e[i][0] = p0[0]; e[i][1] = p0[1]; e[i][2] = p0[2]; e[i][3] = p0[3]; e[i][4] = p1[0]; e[i][5] = p1[1]; e[i][6] = p1[2]; e[i][7] = p1[3]; } } }
    const float inv = 1.0f / cnt; float mm[8];
#pragma unroll
    for (int k = 0; k < 8; ++k) { float sum = 0.f;
#pragma unroll
        for (int i = 0; i < W; ++i) sum += e[i][k];
        mm[k] = sum * inv - e[0][k]; }
    v4u o; o.x = pkbf(mm[0], mm[1]); o.y = pkbf(mm[2], mm[3]); o.z = pkbf(mm[4], mm[5]); o.w = pkbf(mm[6], mm[7]);
    *(v4u*)(PO + (size_t)row * DP + ch) = o;
}
__device__ __forceinline__ void p1_cumsum(Frame& F, const Args& a) {
    unsigned char* ws = a.ws;
    { const int gw = ((int)blockIdx.x - ((int)F.G - (NB * NH) / NWAVES)) * NWAVES + F.wave; float* CP2 = (float*)(ws + WS_CP2);
      if (gw >= 0 && gw < NB * NH) { const int b = gw >> 3, h = gw & 7; float carry = 0.f;
          for (int c = 0; c < SEQ / 64; ++c) { float v = a.out[O_LFP + (size_t)(b * SEQ + c * 64 + F.lane) * NH + h];
#pragma unroll
              for (int o = 1; o < 64; o <<= 1) { const float t = __shfl_up(v, o); if (F.lane >= o) v += t; }
              v += carry; CP2[(size_t)gw * SEQ + c * 64 + F.lane] = v * LOG2E; carry = __shfl(v, 63); } } }
}
__device__ __forceinline__ void p2_cumsum_pool(Frame& F, const Args& a) {
    unsigned char* ws = a.ws;
    const int nfree = F.G > 2 * (M / 256) ? F.G - M / 256 : F.G, myslot = F.G > 2 * (M / 256) ? (int)blockIdx.x - M / 256 : (int)blockIdx.x;
    if (myslot >= 0)
    for (int item = myslot * NTHR + F.tid; item < M * 64; item += nfree * NTHR) {
        const int row = item >> 6, ch = (item & 63) * 8, g = ch >> 7;
        if (g == 0) p2_item<2>(a, ws, row, ch); else if (g == 1) p2_item<4>(a, ws, row, ch); else if (g == 2) p2_item<8>(a, ws, row, ch); else p2_item<16>(a, ws, row, ch);
    }
}

__device__ __forceinline__ float attn_bound2(const Args& a, int lane) {
    asm volatile("" : "+v"(lane));
    const float gq = wave_max(fabsf(a.q_norm_g[lane])), gk = wave_max(fabsf(a.k_norm_g[lane]));
    return 64.0f * C2 * gq * gk * 1.03f;
}

typedef float f32x16 __attribute__((ext_vector_type(16)));
typedef short bf16x8v __attribute__((ext_vector_type(8)));
__device__ __forceinline__ int f2key(float s) { int b = __builtin_bit_cast(int, s); return b ^ ((b >> 31) & 0x7fffffff); }
__device__ __forceinline__ float key2f(int k) { return __builtin_bit_cast(float, k ^ ((k >> 31) & 0x7fffffff)); }
#define CE_DESC(x, y) do { const int mx_ = (x) > (y) ? (x) : (y), mn_ = (x) > (y) ? (y) : (x); (x) = mx_; (y) = mn_; } while (0)
template <int OFF, int N, typename T> __device__ __forceinline__ void bsort_desc(T& v) {
#pragma unroll
    for (int k = 2; k <= N; k <<= 1)
#pragma unroll
        for (int j = k >> 1; j > 0; j >>= 1)
#pragma unroll
            for (int i = 0; i < N; ++i) { const int l = i ^ j; if (l > i) { if ((i & k) == 0) CE_DESC(v[OFF + i], v[OFF + l]); else CE_DESC(v[OFF + l], v[OFF + i]); } }
}
template <int OFF, typename T> __device__ __forceinline__ void bmerge16_desc(T& v) {
#pragma unroll
    for (int j = 8; j > 0; j >>= 1)
#pragma unroll
        for (int i = 0; i < 16; ++i) { const int l = i ^ j; if (l > i) CE_DESC(v[OFF + i], v[OFF + l]); }
}
template <int OA, int OB, typename T> __device__ __forceinline__ void top16_merge(T& v) {
#pragma unroll
    for (int i = 0; i < 16; ++i) v[OA + i] = v[OA + i] > v[OB + 15 - i] ? v[OA + i] : v[OB + 15 - i];
    bmerge16_desc<OA>(v);
}
template <typename T> __device__ __forceinline__ void top16_of_64(T& v) {
    bsort_desc<0, 16>(v); bsort_desc<16, 16>(v); bsort_desc<32, 16>(v); bsort_desc<48, 16>(v);
    top16_merge<0, 16>(v); top16_merge<32, 48>(v); top16_merge<0, 32>(v);
}
__device__ __forceinline__ void p7_topk(Frame& F, const Args& a) {
    unsigned char* ws = a.ws;
    const bf16* PQ = (const bf16*)(ws + WS_PQ); const bf16* SK = (const bf16*)(ws + WS_SUBK); const float* RSS = (const float*)(ws + WS_RSS);
    int* SI = (int*)(ws + WS_SI); float* SG = (float*)(ws + WS_SG);
    const int lane = F.lane, j = lane & 31, hi = lane >> 5;
    constexpr int KROW = 272, KMAT = 128 * KROW;
    LAS unsigned char* kl = F.lds; LAS unsigned* ib = (LAS unsigned*)(F.lds + 2 * KMAT + F.wave * 1024);
    const int h = F.vcu & 7, wi = F.vcu >> 3, nwh = (F.G - h + 7) >> 3;
    __syncthreads();
    for (int i = F.tid; i < 2 * 128 * 16; i += NTHR) { const int p = i >> 11, n = (i >> 4) & 127, c = i & 15; *(LAS v4u*)(kl + p * KMAT + n * KROW + 16 * c) = *(const v4u*)(SK + ((size_t)(h * 2 + p) * NKEYS + n) * DKH + 8 * c); }
    __syncthreads();
    const bool grp = (F.G == 256);
    const int gx = F.vcu >> 5, wl = (F.vcu >> 3) & 3;
    for (int lt = (grp ? wl : wi) * NWAVES + F.wave; lt < (grp ? 68 : M / 32); lt += (grp ? 4 : nwh) * NWAVES) {
        const int tile = grp ? (lt < 64 ? 64 * gx + lt : 512 + 4 * gx + (lt - 64)) : lt;
        const int row0 = tile * 32;
        int jl = j, hl = hi; asm volatile("" : "+v"(jl), "+v"(hl));
        int top[2][16];
#pragma unroll
        for (int p = 0; p < 2; ++p) {
            bf16x8v qf[8];
#pragma unroll
            for (int ks = 0; ks < 8; ++ks) qf[ks] = *(const bf16x8v*)(PQ + (size_t)(row0 + jl) * DQ + h * 256 + p * 128 + 16 * ks + 8 * hl);
            f32x16 acc[4];
#pragma unroll
            for (int mt = 0; mt < 4; ++mt) acc[mt] = f32x16{};
            const LAS unsigned char* kb = kl + p * KMAT + jl * KROW + 16 * hl;
#pragma unroll
            for (int ks = 0; ks < 8; ++ks)
#pragma unroll
                for (int mt = 0; mt < 4; ++mt) { const bf16x8v af = *(const LAS bf16x8v*)(kb + mt * 32 * KROW + ks * 32); acc[mt] = __builtin_amdgcn_mfma_f32_32x32x16_bf16(af, qf[ks], acc[mt], 0, 0, 0); }
            int v[64];
#pragma unroll
            for (int mt = 0; mt < 4; ++mt)
#pragma unroll
                for (int r = 0; r < 16; ++r) { const int n = 32 * mt + (r & 3) + 8 * (r >> 2) + 4 * hi; v[16 * mt + r] = (f2key(acc[mt][r]) & ~127) | (127 - n); }
            top16_of_64(v);
#pragma unroll
            for (int i = 0; i < 16; ++i) top[p][i] = v[i];
        }
        int S[32];
#pragma unroll
        for (int i = 0; i < 16; ++i) { auto rr = __builtin_amdgcn_permlane32_swap((unsigned)top[0][i], (unsigned)top[1][i], false, false); S[i] = (int)rr[0]; S[16 + i] = (int)rr[1]; }
        top16_merge<0, 16>(S);
        { unsigned w0 = 0, w1 = 0, w2 = 0, w3 = 0;
#pragma unroll
          for (int i = 0; i < 4; ++i) { w0 |= (unsigned)(127 - (S[i] & 127)) << (8 * i); w1 |= (unsigned)(127 - (S[4 + i] & 127)) << (8 * i); w2 |= (unsigned)(127 - (S[8 + i] & 127)) << (8 * i); w3 |= (unsigned)(127 - (S[12 + i] & 127)) << (8 * i); }
          *(LAS v4u*)(ib + (hi * 32 + j) * 4) = (v4u){w0, w1, w2, w3}; }
        float s1[16], s2[16];
#pragma unroll
        for (int i = 0; i < 16; ++i) { auto rr = __builtin_amdgcn_permlane32_swap((unsigned)S[i], (unsigned)S[i], false, false); s1[i] = key2f((int)rr[0] & ~127); s2[i] = key2f((int)rr[1] & ~127); }
        int c[64]; { int n = 0;
#pragma unroll
          for (int ca = 0; ca < 16; ++ca)
#pragma unroll
              for (int cb = 0; cb < 16; ++cb) if ((ca + 1) * (cb + 1) <= 16) { c[n] = (f2key(s1[ca] + s2[cb]) & ~255) | (255 - (ca * 16 + cb)); ++n; }
#pragma unroll
          for (int q = 50; q < 64; ++q) c[q] = (int)0x80000000; }
        top16_of_64(c);
        float ssq = 0.f;
#pragma unroll
        for (int q = 0; q < 4; ++q) { const f32x4 t4 = *(const f32x4*)(RSS + (size_t)(row0 + j) * 16 + 4 * q); ssq += (t4[0] + t4[1]) + (t4[2] + t4[3]); }
        const float rstd = 1.0f / sqrtf(ssq * (1.0f / DM) + EPS);
        const float z0 = key2f(c[0] & ~255) * rstd; float e[16], esum = 0.f;
#pragma unroll
        for (int k = 0; k < 16; ++k) { e[k] = __expf(key2f(c[k] & ~255) * rstd - z0); esum += e[k]; }
        const float inv = 1.0f / esum;
        LDS_WAIT(); asm volatile("" ::: "memory");
        const LAS unsigned char* ib8 = (const LAS unsigned char*)ib;
        int oi[8]; float og[8];
#pragma unroll
        for (int k = 0; k < 8; ++k) { const int ck = hi ? c[8 + k] : c[k]; const float ek = hi ? e[8 + k] : e[k]; const int fl = 255 - (ck & 255);
            const int i1 = ib8[(0 * 32 + j) * 16 + (fl >> 4)], i2 = ib8[(1 * 32 + j) * 16 + (fl & 15)]; oi[k] = i1 * NKEYS + i2; og[k] = ek * inv; }
        { int* sp = SI + (size_t)(row0 + j) * 128 + h * 16 + hi * 8; float* gp = SG + (size_t)(row0 + j) * 128 + h * 16 + hi * 8;
          *(v4u*)sp = (v4u){(unsigned)oi[0], (unsigned)oi[1], (unsigned)oi[2], (unsigned)oi[3]}; *(v4u*)(sp + 4) = (v4u){(unsigned)oi[4], (unsigned)oi[5], (unsigned)oi[6], (unsigned)oi[7]};
          *(f32x4*)gp = (f32x4){og[0], og[1], og[2], og[3]}; *(f32x4*)(gp + 4) = (f32x4){og[4], og[5], og[6], og[7]}; }
        LDS_WAIT(); asm volatile("" ::: "memory");
    }
}


constexpr int P8_SW = 128;
#define FP8X2(wd, hi_) __builtin_amdgcn_cvt_pk_f32_fp8((int)(wd), (hi_))
constexpr int P8_T = 68;
static_assert(M % P8_T == 0, "P8 chunking");
__device__ __forceinline__ void p8_gather(Frame& F, const Args& a) {
    unsigned char* ws = a.ws;
    const bf16* HG = (const bf16*)(ws + WS_XN); const unsigned char* PU = ws + WS_PU; const unsigned char* PV = ws + WS_PV; const float* US = (const float*)(ws + WS_US); const float* VS = (const float*)(ws + WS_VS);
    const float* RSS = (const float*)(ws + WS_RSS); const int* SI = (const int*)(ws + WS_SI); const float* SG = (const float*)(ws + WS_SG);
    float* Y = a.out + O_YP; unsigned char* HQ = ws + WS_Q;
    LAS unsigned short* ix = (LAS unsigned short*)F.lds;
    LAS float* wt = (LAS float*)(F.lds + P8_T * 128 * 2);
    LAS float* zp = (LAS float*)(F.lds + P8_T * 128 * 6);
    LAS float* rs = (LAS float*)(F.lds + P8_T * 128 * 10);
    LAS float* hs = (LAS float*)(F.lds + P8_T * 128 * 10 + 512);
    LAS float* wsc = (LAS float*)(F.lds + P8_T * 128 * 10 + 1024);
    LAS unsigned char* wq = F.lds + P8_T * 128 * 10 + 2048;
    int lane = F.lane; asm volatile("" : "+v"(lane));
    const int g = lane >> 3, c8 = lane & 7;
    const bool grp = (F.G == 256);
    for (int sup = F.vcu; sup < M / P8_T; sup += F.G) {
        const int tb = grp ? 2048 * (F.vcu >> 5) + 64 * (F.vcu & 31) : sup * P8_T, tb2 = grp ? MP + 128 * (F.vcu >> 5) + 4 * (F.vcu & 31) - 64 : tb;
#define P8_ROW(lt_) (((lt_) < 64 ? tb : tb2) + (lt_))
        __syncthreads();
        for (int i = F.tid; i < P8_T * 128; i += NTHR) { const size_t src = (size_t)P8_ROW(i >> 7) * 128 + (i & 127); ix[i] = (unsigned short)SI[src]; wt[i] = SG[src]; zp[i] = 0.f; }
        if (F.tid < P8_T) { float s = 0.f; for (int k = 0; k < 16; ++k) s += RSS[(size_t)P8_ROW(F.tid) * 16 + k]; rs[F.tid] = 1.0f / sqrtf(s * (1.0f / DM) + EPS); }
        for (int lt = F.wave; lt < P8_T; lt += NWAVES) { const bf16* hr = HG + (size_t)P8_ROW(lt) * DM + 16 * lane; const v4u ha = *(const v4u*)hr, hb2 = *(const v4u*)(hr + 8);
            const unsigned hp[8] = {ha.x, ha.y, ha.z, ha.w, hb2.x, hb2.y, hb2.z, hb2.w}; float hv[16], m = 0.f;
#pragma unroll
            for (int k = 0; k < 8; ++k) { hv[2 * k] = bflo(hp[k]); hv[2 * k + 1] = bfhi(hp[k]); m = fmaxf(m, fmaxf(fabsf(hv[2 * k]), fabsf(hv[2 * k + 1]))); }
#pragma unroll
            for (int o = 1; o < 64; o <<= 1) m = fmaxf(m, __shfl_xor(m, o));
            const float sc = m > 1e-30f ? 127.0f / m : 0.f; unsigned qw[4];
            unsigned qe[2] = {0u, 0u}, qo[2] = {0u, 0u};
#pragma unroll
            for (int t = 0; t < 8; ++t) { const int ie = (int)rintf(hv[2 * t] * sc), io = (int)rintf(hv[2 * t + 1] * sc); qe[t >> 2] |= ((unsigned)ie & 255u) << (8 * (t & 3)); qo[t >> 2] |= ((unsigned)io & 255u) << (8 * (t & 3)); }
            unsigned char* hq = HQ + (size_t)P8_ROW(lt) * DM + (lane >> 4) * 256 + 8 * (lane & 15);
            *(v2u*)hq = (v2u){qe[0], qe[1]}; *(v2u*)(hq + 128) = (v2u){qo[0], qo[1]};
            if (lane == 0) hs[lt] = m * (1.0f / 127.0f); }
        asm volatile("s_waitcnt vmcnt(0)" ::: "memory");
        __syncthreads();
        if (F.tid == 0) { __builtin_amdgcn_fence(__ATOMIC_ACQUIRE, "agent"); asm volatile("s_waitcnt vmcnt(0)" ::: "memory"); }
        __syncthreads();
        for (int s = 0; s < 4; ++s) {
            __syncthreads();
            int cl = c8; asm volatile("" : "+v"(cl));
            const unsigned char* pus = PU + (size_t)s * ((size_t)NEXP * P8_SW) + 16 * cl;
#pragma unroll 1
            for (int lt = F.wave; lt < P8_T; lt += NWAVES) {
                const unsigned char* hq = HQ + (size_t)P8_ROW(lt) * DM + 256 * s + 16 * cl;
                const v4u h0 = *(const v4u*)hq, h1 = *(const v4u*)(hq + 128);
                const int he[4] = {(int)h0.x, (int)h0.y, (int)h0.z, (int)h0.w}, ho[4] = {(int)h1.x, (int)h1.y, (int)h1.z, (int)h1.w};
                int hsum = 0;
#pragma unroll
                for (int jj = 0; jj < 4; ++jj) hsum = __builtin_amdgcn_sdot4(he[jj], 0x01010101, hsum, false);
                const int dl0 = -8 * hsum;
                const v4u ea = *(const LAS v4u*)(ix + lt * 128 + g * 16), eb = *(const LAS v4u*)(ix + lt * 128 + g * 16 + 8);
                const unsigned ew[8] = {ea.x, ea.y, ea.z, ea.w, eb.x, eb.y, eb.z, eb.w};
                v4u r[16];
#pragma unroll
                for (int i = 0; i < 16; ++i) { const unsigned e = (i & 1) ? (ew[i >> 1] >> 16) : (ew[i >> 1] & 0xffffu); r[i] = *(const v4u*)(pus + (size_t)e * P8_SW); }
                int acc[16];
#pragma unroll
                for (int i = 0; i < 16; ++i) { const unsigned wd[4] = {r[i].x, r[i].y, r[i].z, r[i].w}; int dh = 0, dl = dl0;
#pragma unroll
                    for (int jj = 0; jj < 4; ++jj) { dh = __builtin_amdgcn_sdot4((int)(wd[jj] & 0xf0f0f0f0u), ho[jj], dh, false); dl = __builtin_amdgcn_sdot4((int)(wd[jj] & 0x0f0f0f0fu), he[jj], dl, false); }
                    acc[i] = dh + (dl << 4); }
                int v8[8], v4[4], v2[2]; const bool b4 = (c8 & 4) != 0, b2 = (c8 & 2) != 0, b1 = (c8 & 1) != 0;
#pragma unroll
                for (int j2 = 0; j2 < 8; ++j2) { const int keep = b4 ? acc[8 + j2] : acc[j2], send = b4 ? acc[j2] : acc[8 + j2]; v8[j2] = keep + __shfl_xor(send, 4); }
#pragma unroll
                for (int j2 = 0; j2 < 4; ++j2) { const int keep = b2 ? v8[4 + j2] : v8[j2], send = b2 ? v8[j2] : v8[4 + j2]; v4[j2] = keep + __shfl_xor(send, 2); }
#pragma unroll
                for (int j2 = 0; j2 < 2; ++j2) { const int keep = b1 ? v4[2 + j2] : v4[j2], send = b1 ? v4[j2] : v4[2 + j2]; v2[j2] = keep + __shfl_xor(send, 1); }
                LAS f32x2* zq = (LAS f32x2*)(zp + lt * 128 + g * 16 + 2 * c8); const f32x2 z0 = *zq; *zq = (f32x2){z0[0] + (float)v2[0], z0[1] + (float)v2[1]};
            }
        }
        for (int lt = F.wave; lt < P8_T; lt += NWAVES) {
            const float r = rs[lt]; const int kk = lt * 128 + g * 16 + 2 * c8; LAS float* wp = wt + kk; const f32x2 gt = *(const LAS f32x2*)wp; const f32x2 zz = *(const LAS f32x2*)(zp + kk);
            const int e0 = ix[kk], e1 = ix[kk + 1];
            const float rh = r * hs[lt]; const float z0 = zz[0] * rh * US[e0], z1 = zz[1] * rh * US[e1];
            const float a0 = 0.5f * z0 * (1.0f + erff(z0 * 0.70710678118654752f)), a1 = 0.5f * z1 * (1.0f + erff(z1 * 0.70710678118654752f));
            const float w0 = gt[0] * a0 * VS[e0], w1 = gt[1] * a1 * VS[e1]; float mw = fmaxf(fabsf(w0), fabsf(w1));
#pragma unroll
            for (int o = 1; o < 64; o <<= 1) mw = fmaxf(mw, __shfl_xor(mw, o));
            const float wsq = mw > 1e-30f ? 127.0f / mw : 0.f; const int q0 = (int)rintf(w0 * wsq), q1 = (int)rintf(w1 * wsq);
            *(LAS unsigned short*)(wq + kk) = (unsigned short)(((unsigned)q0 & 255u) | (((unsigned)q1 & 255u) << 8));
            if (lane == 0) wsc[lt] = mw * (1.0f / 127.0f); }
        LDS_WAIT(); asm volatile("" ::: "memory");
        for (int s = 0; s < 4; ++s) {
            __syncthreads();
            int cl = c8; asm volatile("" : "+v"(cl));
            const unsigned char* pvs = PV + (size_t)s * ((size_t)NEXP * P8_SW) + 16 * cl;
#pragma unroll 1
            for (int lt = F.wave; lt < P8_T; lt += NWAVES) {
                const v4u ea = *(const LAS v4u*)(ix + lt * 128 + g * 16), eb = *(const LAS v4u*)(ix + lt * 128 + g * 16 + 8);
                const unsigned ew[8] = {ea.x, ea.y, ea.z, ea.w, eb.x, eb.y, eb.z, eb.w};
                v4u r[16];
#pragma unroll
                for (int i = 0; i < 16; ++i) { const unsigned e = (i & 1) ? (ew[i >> 1] >> 16) : (ew[i >> 1] & 0xffffu); r[i] = *(const v4u*)(pvs + (size_t)e * P8_SW); }
                const v4u wq4 = *(const LAS v4u*)(wq + lt * 128 + g * 16); const int Wg[4] = {(int)wq4.x, (int)wq4.y, (int)wq4.z, (int)wq4.w};
                int sw = 0;
#pragma unroll
                for (int G = 0; G < 4; ++G) sw = __builtin_amdgcn_sdot4(Wg[G], 0x01010101, sw, false);
                int acc[32];
#pragma unroll
                for (int c = 0; c < 32; ++c) acc[c] = -8 * sw;
#pragma unroll
                for (int G = 0; G < 4; ++G)
#pragma unroll
                    for (int jj = 0; jj < 4; ++jj) {
                        const unsigned A = r[4 * G][jj], B = r[4 * G + 1][jj], C = r[4 * G + 2][jj], D = r[4 * G + 3][jj];
                        const unsigned t0 = __builtin_amdgcn_perm(B, A, 0x05010400u), t1 = __builtin_amdgcn_perm(B, A, 0x07030602u), t2 = __builtin_amdgcn_perm(D, C, 0x05010400u), t3 = __builtin_amdgcn_perm(D, C, 0x07030602u);
                        const unsigned T[4] = {__builtin_amdgcn_perm(t2, t0, 0x05040100u), __builtin_amdgcn_perm(t2, t0, 0x07060302u), __builtin_amdgcn_perm(t3, t1, 0x05040100u), __builtin_amdgcn_perm(t3, t1, 0x07060302u)};
#pragma unroll
                        for (int bb = 0; bb < 4; ++bb) { const int t = 4 * jj + bb;
                            acc[2 * t]     = __builtin_amdgcn_sdot4((int)(T[bb] & 0x0f0f0f0fu), Wg[G], acc[2 * t], false);
                            acc[2 * t + 1] = __builtin_amdgcn_sdot4((int)T[bb], Wg[G], acc[2 * t + 1], false); } }
#pragma unroll
                for (int t = 0; t < 16; ++t) { acc[2 * t + 1] -= acc[2 * t]; acc[2 * t] <<= 4; }
                const bool b5 = (lane & 32) != 0, b4 = (lane & 16) != 0, b3 = (lane & 8) != 0; int p16[16], p8[8], p4[4];
#pragma unroll
                for (int j2 = 0; j2 < 16; ++j2) { const int keep = b5 ? acc[16 + j2] : acc[j2], send = b5 ? acc[j2] : acc[16 + j2]; p16[j2] = keep + __shfl_xor(send, 32); }
#pragma unroll
                for (int j2 = 0; j2 < 8; ++j2) { const int keep = b4 ? p16[8 + j2] : p16[j2], send = b4 ? p16[j2] : p16[8 + j2]; p8[j2] = keep + __shfl_xor(send, 16); }
#pragma unroll
                for (int j2 = 0; j2 < 4; ++j2) { const int keep = b3 ? p8[4 + j2] : p8[j2], send = b3 ? p8[j2] : p8[4 + j2]; p4[j2] = keep + __shfl_xor(send, 8); }
                const size_t off = (size_t)P8_ROW(lt) * DM + 256 * s + 32 * cl + (b5 ? 16 : 0) + (b4 ? 8 : 0) + (b3 ? 4 : 0);
                const v2u hw2 = *(const v2u*)(HG + off); const float ws_t = wsc[lt];
                __builtin_nontemporal_store((f32x4){bflo(hw2.x) + ws_t * (float)p4[0], bfhi(hw2.x) + ws_t * (float)p4[1], bflo(hw2.y) + ws_t * (float)p4[2], bfhi(hw2.y) + ws_t * (float)p4[3]}, (f32x4*)(Y + off)); }
        }
    }
}
#undef P8_ROW

__device__ __forceinline__ void p3_sample_attn2(Frame& F, const Args& a, const float M2) {
    unsigned char* ws = a.ws;
    const bf16* Q = (const bf16*)(ws + WS_Q); bf16* AO = (bf16*)(ws + WS_AO);
    LAS float* D2 = (LAS float*)F.lds;
    LAS float* E2 = (LAS float*)(F.lds + 32768);
    LAS float* Op = (LAS float*)(F.lds + 32768 + 128 + 8192);
    LAS float* lp = (LAS float*)(F.lds + 32768 + 128 + 8192 + 16384);
    int lane = F.lane; asm volatile("" : "+v"(lane));
    const int w = F.wave, hh = w >> 1, kh = w & 1, c = lane & 15, g = lane >> 4;
    for (;;) {
        __syncthreads();
        if (F.tid == 0) F.MISC[17] = __hip_atomic_fetch_add((unsigned*)(F.ctl + 8320), 1u, __ATOMIC_RELAXED, __HIP_MEMORY_SCOPE_AGENT);
        __syncthreads();
        const int unit = (int)F.MISC[17];
        if (unit >= DB * 2) break;
        const int b = unit >> 1, h = 4 * (unit & 1) + hh;
        __syncthreads();
        for (int jk = F.tid; jk < PAST; jk += NTHR) { const int pg = a.page_table[b * NPAGES + (jk >> 7)];
            const f32x4 l4 = *(const f32x4*)(a.cache_lf + ((size_t)pg * PAGE + (jk & 127)) * NH + 4 * (unit & 1));
            D2[jk] = l4[0]; D2[PAST + jk] = l4[1]; D2[2 * PAST + jk] = l4[2]; D2[3 * PAST + jk] = l4[3]; }
        __syncthreads();
        if (kh == 0) {
            LAS float* d = D2 + hh * PAST; float loc[32]; float tot = 0.f;
#pragma unroll
            for (int k = 31; k >= 0; --k) { loc[k] = tot; tot += d[lane * 32 + k]; }
            float inc = tot;
#pragma unroll
            for (int o = 1; o < 64; o <<= 1) { const float t = __shfl_down(inc, o); if (lane + o < 64) inc += t; }
            const float excl = inc - tot;
#pragma unroll
            for (int k = 0; k < 32; ++k) d[lane * 32 + k] = (loc[k] + excl) * LOG2E;
            if (lane < 8) { float e = 0.f; for (int t = 0; t <= lane; ++t) e += a.out[O_LFS + (size_t)(b * 8 + t) * NH + h]; E2[hh * 8 + lane] = e * LOG2E; }
        }
        __syncthreads();
        bf16x8v qb[2];
#pragma unroll
        for (int ks = 0; ks < 2; ++ks) { qb[ks] = bf16x8v{}; if (c < 8) qb[ks] = *(const bf16x8v*)(Q + (size_t)(MP + b * 8 + c) * DA + h * 64 + 32 * ks + 8 * g); }
        const float e2q = E2[hh * 8 + (c & 7)] - M2;
        f32x4 oacc[4]; float lsum = 0.f;
#pragma unroll
        for (int m = 0; m < 4; ++m) oacc[m] = (f32x4){0.f, 0.f, 0.f, 0.f};
        const LAS float* dh = D2 + hh * PAST;
        int nskip; { const float dl = dh[32 * lane + 31]; nskip = __builtin_popcountll(__ballot(dl < -(24.f + 2.f * M2))); }
        nskip = __builtin_amdgcn_readfirstlane(nskip);
        const int nblk = PAST / 32 - nskip, nb0 = nblk >> 1;
        const int blk_lo = nskip + (kh ? nb0 : 0), nit = kh ? (nblk - nb0) : nb0;
#define S3_PACK8(x0_, x1_) __builtin_bit_cast(bf16x8v, (v4u){pkbf((x0_)[0], (x0_)[1]), pkbf((x0_)[2], (x0_)[3]), pkbf((x1_)[0], (x1_)[1]), pkbf((x1_)[2], (x1_)[3])})
#define S3_PV(p0_, p1_, vq_) do { const bf16x8v pb_ = S3_PACK8(p0_, p1_); \
            _Pragma("unroll") for (int m = 0; m < 4; ++m) { const bf16x8v va_ = __builtin_bit_cast(bf16x8v, (v4u){pkbf((vq_)[0][m], (vq_)[1][m]), pkbf((vq_)[2][m], (vq_)[3][m]), pkbf((vq_)[4][m], (vq_)[5][m]), pkbf((vq_)[6][m], (vq_)[7][m])}); \
                oacc[m] = __builtin_amdgcn_mfma_f32_16x16x32_bf16(va_, pb_, oacc[m], 0, 0, 0); } } while (0)
        for (int it = 0; it < nit; ++it) {
            const int j0 = (blk_lo + it) * 32; const int pg = a.page_table[b * NPAGES + (j0 >> 7)];
            const size_t rowoff = (((size_t)pg * PAGE + (j0 & 127)) * NH + h) * HD;
            const float* kr = a.cache_k + rowoff + (size_t)c * (NH * HD) + 8 * g; const float* vr = a.cache_v + rowoff + 4 * c;
            f32x4 kq[2][2][2], vq[8];
#pragma unroll
            for (int tl = 0; tl < 2; ++tl)
#pragma unroll
                for (int ks = 0; ks < 2; ++ks) { const float* kp = kr + (size_t)(16 * tl) * (NH * HD) + 32 * ks; kq[tl][ks][0] = __builtin_nontemporal_load((const f32x4*)kp); kq[tl][ks][1] = __builtin_nontemporal_load((const f32x4*)(kp + 4)); }
#pragma unroll
            for (int jj = 0; jj < 8; ++jj) vq[jj] = __builtin_nontemporal_load((const f32x4*)(vr + (size_t)((jj < 4 ? 0 : 12) + 4 * g + jj) * (NH * HD)));
            const f32x4 d0 = *(const LAS f32x4*)(dh + j0 + 4 * g), d1 = *(const LAS f32x4*)(dh + j0 + 16 + 4 * g);
            f32x4 s0 = d0 + e2q, s1 = d1 + e2q;
#pragma unroll
            for (int ks = 0; ks < 2; ++ks) { s0 = __builtin_amdgcn_mfma_f32_16x16x32_bf16(S3_PACK8(kq[0][ks][0], kq[0][ks][1]), qb[ks], s0, 0, 0, 0);
                                             s1 = __builtin_amdgcn_mfma_f32_16x16x32_bf16(S3_PACK8(kq[1][ks][0], kq[1][ks][1]), qb[ks], s1, 0, 0, 0); }
            f32x4 p0, p1;
#pragma unroll
            for (int r = 0; r < 4; ++r) { p0[r] = __builtin_amdgcn_exp2f(s0[r]); p1[r] = __builtin_amdgcn_exp2f(s1[r]); }
            lsum += (p0[0] + p0[1]) + (p0[2] + p0[3]) + (p1[0] + p1[1]) + (p1[2] + p1[3]);
            S3_PV(p0, p1, vq);
        }
        if (kh == 1) {
            const float* kr = a.out + O_KS + (size_t)(b * 8 + (c & 7)) * DA + h * HD + 8 * g;
            f32x4 s0 = (f32x4){0.f, 0.f, 0.f, 0.f};
#pragma unroll
            for (int ks = 0; ks < 2; ++ks) { const f32x4 x0 = *(const f32x4*)(kr + 32 * ks), x1 = *(const f32x4*)(kr + 32 * ks + 4); s0 = __builtin_amdgcn_mfma_f32_16x16x32_bf16(S3_PACK8(x0, x1), qb[ks], s0, 0, 0, 0); }
            f32x4 p0, p1 = (f32x4){0.f, 0.f, 0.f, 0.f}, vq[8];
#pragma unroll
            for (int r = 0; r < 4; ++r) { const int key = 4 * g + r; const float ek = E2[hh * 8 + (key & 7)]; p0[r] = (key < 8 && key <= c) ? __builtin_amdgcn_exp2f(s0[r] + e2q - ek) : 0.f; }
#pragma unroll
            for (int jj = 0; jj < 8; ++jj) { vq[jj] = (f32x4){0.f, 0.f, 0.f, 0.f}; if (jj < 4 && g < 2) vq[jj] = *(const f32x4*)(a.out + O_VS + (size_t)(b * 8 + 4 * g + jj) * DA + h * HD + 4 * c); }
            lsum += (p0[0] + p0[1]) + (p0[2] + p0[3]);
            S3_PV(p0, p1, vq);
        }
#undef S3_PV
#undef S3_PACK8
        lsum += __shfl_xor(lsum, 16); lsum += __shfl_xor(lsum, 32);
        if (lane < 8) lp[w * 8 + lane] = lsum;
        if (c < 8) {
#pragma unroll
            for (int r = 0; r < 4; ++r) *(LAS f32x4*)(Op + (w * 8 + c) * 64 + 16 * g + 4 * r) = (f32x4){oacc[0][r], oacc[1][r], oacc[2][r], oacc[3][r]}; }
        __syncthreads();
        for (int i = F.tid; i < 4 * 8 * 64; i += NTHR) { const int hq = i >> 9, t = (i >> 6) & 7, d = i & 63;
            const float O = Op[((2 * hq) * 8 + t) * 64 + d] + Op[((2 * hq + 1) * 8 + t) * 64 + d], L = lp[(2 * hq) * 8 + t] + lp[(2 * hq + 1) * 8 + t];
            AO[(size_t)(MP + b * 8 + t) * DA + (4 * (unit & 1) + hq) * 64 + d] = (bf16)(pkbf(O / L, 0.f) & 0xffffu); }
    }
}


template <class Epi> __device__ __forceinline__ void sg_phase(Frame& F, const bf16* A  , const bf16* Bt  , int K, int N, const Epi& E) {
    int lane = F.lane; asm volatile("" : "+v"(lane));
    const int fr = lane & 15, fq = lane >> 4, ntc = N >> 6, ntile = (MS / 128) * ntc, pitch = 2 * K + 16, kc = K >> 3;
    const bool grp = (F.G == 256);
    for (int t = grp ? (F.vcu & 31) : F.vcu; t < (grp ? ntc : ntile); t += grp ? 32 : F.G) {
        const int tr = grp ? (F.vcu >> 5) : t % (MS / 128), tc = grp ? t : t / (MS / 128);
        __syncthreads();
        for (int i = F.tid; i < 64 * kc; i += NTHR) { const int r = i / kc, c = i - r * kc; *(LAS v4u*)(F.lds + r * pitch + 16 * c) = *(const v4u*)(Bt + (size_t)(64 * tc + r) * K + 8 * c); }
        __syncthreads();
        const bf16* ap = A + (size_t)(128 * tr + 16 * F.wave + fr) * K + 8 * fq;
        const LAS unsigned char* bp = F.lds + fr * pitch + 16 * fq;
        f32x4 acc[4];
#pragma unroll
        for (int c = 0; c < 4; ++c) acc[c] = (f32x4){0.f, 0.f, 0.f, 0.f};
#pragma unroll 8
        for (int ks = 0; ks < K; ks += 32) {
            const bf16x8v av = *(const bf16x8v*)(ap + ks);
#pragma unroll
            for (int c = 0; c < 4; ++c) { const bf16x8v bv = *(const LAS bf16x8v*)(bp + 16 * c * pitch + 2 * ks); acc[c] = __builtin_amdgcn_mfma_f32_16x16x32_bf16(bv, av, acc[c], 0, 0, 0); }
        }
        E(acc, 128 * tr + 16 * F.wave + fr, tc, fq);
    }
}
template <int MODE> struct SgGate { const bf16* G; const bf16* Tin; bf16* O;
    __device__ __forceinline__ void operator()(const f32x4 (&acc)[4], int rs, int tc, int fq) const {
#pragma unroll
        for (int c = 0; c < 4; ++c) { const size_t off = (size_t)(MP + rs) * DM + 64 * tc + 16 * c + 4 * fq; const v2u g = *(const v2u*)(G + off);
            float r[4] = {acc[c][0] * bflo(g.x), acc[c][1] * bfhi(g.x), acc[c][2] * bflo(g.y), acc[c][3] * bfhi(g.y)};
            if (MODE == 1) { const v2u t = *(const v2u*)(Tin + off); r[0] += bflo(t.x); r[1] += bfhi(t.x); r[2] += bflo(t.y); r[3] += bfhi(t.y); }
            v2u w; w.x = pkbf(r[0], r[1]); w.y = pkbf(r[2], r[3]); *(v2u*)(O + off) = w; } } };
struct SgOut { const float* xs; float* H; bf16* HG; const float* gf; float* RSS;
    __device__ __forceinline__ void operator()(const f32x4 (&acc)[4], int rs, int tc, int fq) const { float ss = 0.f;
#pragma unroll
        for (int c = 0; c < 4; ++c) { const int col = 64 * tc + 16 * c + 4 * fq; const f32x4 h = acc[c] + *(const f32x4*)(xs + (size_t)rs * DM + col);
            ss += (h[0] * h[0] + h[1] * h[1]) + (h[2] * h[2] + h[3] * h[3]);
            v2u w; w.x = pkbf(h[0], h[1]); w.y = pkbf(h[2], h[3]); *(v2u*)(HG + (size_t)(MP + rs) * DM + col) = w; }
        ss += __shfl_xor(ss, 16); ss += __shfl_xor(ss, 32);
        if (fq == 0) RSS[(size_t)(MP + rs) * 16 + tc] = ss; } };
struct SgPQ { bf16* PQ;
    __device__ __forceinline__ void operator()(const f32x4 (&acc)[4], int rs, int tc, int fq) const {
#pragma unroll
        for (int c = 0; c < 4; ++c) { v2u w; w.x = pkbf(acc[c][0], acc[c][1]); w.y = pkbf(acc[c][2], acc[c][3]); *(v2u*)(PQ + (size_t)(MP + rs) * DQ + 64 * tc + 16 * c + 4 * fq) = w; } } };

constexpr int CW_GRP = 8448, CW_XID = 12288;
__device__ __forceinline__ void group_barrier(const Frame& F, const XcdBarrier& b, int seam) {
    asm volatile("s_waitcnt vmcnt(0)" ::: "memory");
    __syncthreads();
    if (threadIdx.x == 0) {
        const unsigned x = blockIdx.x & 7u, n = (gridDim.x - x + 7u) >> 3;
        unsigned same = F.MISC[20];
        if (same == 0u) { unsigned acc = 1u; for (unsigned m = x; m < gridDim.x; m += 8u) acc &= (xb_ld((unsigned*)(F.ctl + CW_XID + (int)m)) == b.x + 1u) ? 1u : 0u; same = 1u + acc; F.MISC[20] = same; }
        unsigned* c = (unsigned*)(F.ctl + CW_GRP + 64 * (seam * 8 + (int)x));
        if (same != 2u) { __builtin_amdgcn_fence(__ATOMIC_RELEASE, "agent"); asm volatile("s_waitcnt vmcnt(0)" ::: "memory"); }
        (void)xb_add(c, 1u);
        XB_SPIN(xb_ld(c) < n, b.bar);
        __builtin_amdgcn_fence(__ATOMIC_ACQUIRE, "agent");
        asm volatile("s_waitcnt vmcnt(0)" ::: "memory");
    }
    __syncthreads();
}

struct ChainOrder : pg8::StaticOrder {
    __device__ bool next(int i, pg8::Unit& u) const { const bool ok = pg8::StaticOrder::next(i >> 1, u); u.sel = i & 1; return ok; }
};

constexpr int N_PHASES = 9;
#ifndef MK_PER_PHASE
#define MK_PER_PHASE 0
#endif
__global__ void __launch_bounds__(NTHR, 2) fwd_kernel(Args args) {
    extern __shared__ __attribute__((aligned(16))) unsigned char lds[];
    Frame F;
    F.lds = (LAS unsigned char*)lds; F.MISC = (volatile LAS unsigned*)(F.lds + MISC_OFF);
    F.tid = threadIdx.x; F.lane = F.tid & 63; F.wave = __builtin_amdgcn_readfirstlane(F.tid >> 6);
    F.G = gridDim.x; { const int bx = blockIdx.x; F.vcu = (F.G % 8 == 0) ? (bx % 8) * (F.G / 8) + bx / 8 : bx; }
    F.ctl = (gu32*)(args.ws + WS_CTL);
    for (int u = F.tid; u < (LDS_BYTES - MISC_OFF) / 4; u += NTHR) ((LAS unsigned*)(F.lds + MISC_OFF))[u] = 0u;
    __syncthreads();
#if MK_PER_PHASE
#define GRID_BAR() do { } while (0)
#else
    XcdBarrier bar = xcd_barrier_post((unsigned*)(F.ctl + CW_BAR), F.MISC + 8);
    if (F.tid == 0) __hip_atomic_store((unsigned*)(F.ctl + CW_XID + (int)blockIdx.x), bar.x + 1u, __ATOMIC_RELAXED, __HIP_MEMORY_SCOPE_AGENT);
#define GRID_BAR() xcd_barrier(bar)
#endif
    unsigned char* ws = args.ws;
    const int lo = args.ph_lo, hi = args.ph_hi;
    const bool grp = (F.G == 256);
#ifndef DBG_REP_PHASE
#define DBG_REP_PHASE -1
#endif
#ifndef DBG_REP_N
#define DBG_REP_N 1
#endif
#define REPS(k) for (int rep_ = 0; rep_ < ((k) == DBG_REP_PHASE ? 1 + DBG_REP_N : 1); ++rep_)
#define IN(k) (lo <= (k) && (k) < hi)
#define BOTH(k) (IN(k) && IN((k) + 1))
#define ENDPH(k) do { if (BOTH(k) || (k) == DBG_REP_PHASE) GRID_BAR(); } while (0)
#if MK_PER_PHASE
#define ENDPH_G(k, seam) ENDPH(k)
#else
#define ENDPH_G(k, seam) do { if (BOTH(k) || (k) == DBG_REP_PHASE) { if (grp && (k) != DBG_REP_PHASE) group_barrier(F, bar, seam); else GRID_BAR(); } } while (0)
#endif
    if (IN(0)) REPS(0) { p0_prologue(F, args); ENDPH(0); }
    if (IN(1)) REPS(1) {
        p1_cumsum(F, args);
        pg8::Gemm g{(const bf16*)(ws + WS_XN), (const bf16*)(ws + WS_WIN), M, NPROJ - 256, DM}; pg8::StaticOrder S; S.init(M, NPROJ - 256, F.G, (int)blockIdx.x);
        EpiInProj E{(bf16*)(ws + WS_U), (bf16*)(ws + WS_Q), (bf16*)(ws + WS_K), (bf16*)(ws + WS_V), (bf16*)(ws + WS_GA), (bf16*)(ws + WS_GB), args.out, args.q_norm_g, args.k_norm_g, 0};
        pg8::gemm_phase<EpiInProj, pg8::StaticOrder, true, true>(F.lds, g, S, E);
        ENDPH(1);
    }
    if (IN(2)) REPS(2) {
        { pg8::Gemm g{(const bf16*)(ws + WS_XN), (const bf16*)(ws + WS_WIN) + (size_t)(NPROJ - 256) * DM, M, 256, DM}; pg8::StaticOrder S; S.init(M, 256, F.G, (int)blockIdx.x);
          EpiInProj E{(bf16*)(ws + WS_U), (bf16*)(ws + WS_Q), (bf16*)(ws + WS_K), (bf16*)(ws + WS_V), (bf16*)(ws + WS_GA), (bf16*)(ws + WS_GB), args.out, args.q_norm_g, args.k_norm_g, 15};
          pg8::gemm_phase<EpiInProj, pg8::StaticOrder, true, true>(F.lds, g, S, E); }
        __syncthreads();
        p2_cumsum_pool(F, args);
        if (2 == DBG_REP_PHASE || !IN(3)) GRID_BAR();
        __syncthreads(); }
    if (IN(3)) {
        const float M2 = __builtin_bit_cast(float, __builtin_amdgcn_readfirstlane(__builtin_bit_cast(int, attn_bound2(args, F.lane))));
#if !defined(DBG_SKIP_PATTN)
        { const attn_body::AttnTensors AT{(const attn_body::bf16*)(ws + WS_Q), (const attn_body::bf16*)(ws + WS_K), (const attn_body::bf16*)(ws + WS_V), (attn_body::bf16*)(ws + WS_AO), (const float*)(ws + WS_CP2), M2};
          const attn_body::QueueOrder S{(unsigned*)(F.ctl + 8192), F.MISC + 16};
          attn_body::attn_phase<attn_body::QueueOrder>((char*)lds, AT, S);
#ifdef DBG_ATTN2
          __syncthreads(); attn_body::attn_phase<attn_body::StaticOrder>((char*)lds, AT, S);
#endif
        }
#endif
        REPS(3) { p3_sample_attn2(F, args, M2); }
        ENDPH(3); }
    if (IN(4)) REPS(4) {
        { pg8::Gemm g{(const bf16*)(ws + WS_PO), (const bf16*)(ws + WS_WBP), MP, DM, DP, (const bf16*)(ws + WS_AO), (const bf16*)(ws + WS_WBA)}; ChainOrder S; S.init(MP, DM, F.G, (int)blockIdx.x);
          EpiMerge E{(const bf16*)(ws + WS_GA), (const bf16*)(ws + WS_GB), (bf16*)(ws + WS_MIX)};
          pg8::gemm_phase<EpiMerge, ChainOrder, true, true>(F.lds, g, S, E); }
        { SgGate<0> E{(const bf16*)(ws + WS_GA), nullptr, (bf16*)(ws + WS_T)}; sg_phase(F, (const bf16*)(ws + WS_PO) + (size_t)MP * DP, (const bf16*)(ws + WS_WBP), DP, DM, E); }
        asm volatile("s_waitcnt vmcnt(0)" ::: "memory"); __syncthreads();
        { SgGate<1> E{(const bf16*)(ws + WS_GB), (const bf16*)(ws + WS_T), (bf16*)(ws + WS_MIX)}; sg_phase(F, (const bf16*)(ws + WS_AO) + (size_t)MP * DA, (const bf16*)(ws + WS_WBA), DA, DM, E); }
        ENDPH_G(4, 0);
    }
    if (IN(5)) REPS(5) {
        pg8::Gemm g{(const bf16*)(ws + WS_MIX), (const bf16*)(ws + WS_WOUT), MP, DM, DM}; pg8::StaticOrder S; S.init(MP, DM, F.G, (int)blockIdx.x);
        EpiOut E{args.x_p, args.x_s, (float*)(ws + WS_H), (bf16*)(ws + WS_XN), args.norm_ffn_g, (float*)(ws + WS_RSS)};
        pg8::gemm_phase<EpiOut, pg8::StaticOrder, true, true>(F.lds, g, S, E);
        { SgOut E2{args.x_s, (float*)(ws + WS_H), (bf16*)(ws + WS_XN), args.norm_ffn_g, (float*)(ws + WS_RSS)}; sg_phase(F, (const bf16*)(ws + WS_MIX) + (size_t)MP * DM, (const bf16*)(ws + WS_WOUT), DM, DM, E2); }
        ENDPH_G(5, 1);
    }
    if (IN(6)) REPS(6) {
        pg8::Gemm g{(const bf16*)(ws + WS_XN), (const bf16*)(ws + WS_WQ), MP, DQ, DM}; pg8::StaticOrder S; S.init(MP, DQ, F.G, (int)blockIdx.x);
        pg8::EpiBf16<0> E{(bf16*)(ws + WS_PQ), DQ, nullptr, 0, 0, 1.f};
        pg8::gemm_phase<pg8::EpiBf16<0>, pg8::StaticOrder, true, true>(F.lds, g, S, E);
        { SgPQ E2{(bf16*)(ws + WS_PQ)}; sg_phase(F, (const bf16*)(ws + WS_XN) + (size_t)MP * DM, (const bf16*)(ws + WS_WQ), DM, DQ, E2); }
        ENDPH_G(6, 2);
    }
    if (IN(7)) REPS(7) { p7_topk(F, args); ENDPH_G(7, 3); }
    if (IN(8)) REPS(8) { p8_gather(F, args); ENDPH(8); }
#ifdef DBG_DUMP
    if (IN(9)) { const bf16* AO = (const bf16*)(ws + WS_AO); const bf16* PO = (const bf16*)(ws + WS_PO); const bf16* MX = (const bf16*)(ws + (DBG_DUMP == 3 ? WS_T : DBG_DUMP == 4 ? WS_GA : WS_MIX));
        for (size_t i = (size_t)blockIdx.x * NTHR + F.tid; i < (size_t)M * DM; i += (size_t)F.G * NTHR) { const int row = (int)(i >> 10), c = (int)(i & 1023);
            float v; if (DBG_DUMP == 1) v = c < 512 ? bf2f(AO[(size_t)row * DA + c]) : bf2f(PO[(size_t)row * DP + c - 512]); else v = bf2f(MX[i]);
            args.out[O_YP + i] = v; } }
#endif
#undef IN
#undef BOTH
}

extern "C" void kernel_launch(void* const* d_in, const int* in_sizes, int n_in, void* d_out, int out_size, void* d_ws, size_t ws_size, hipStream_t stream) {
    static int grid = 0;
    if (grid == 0) {
        if (n_in != 22 || (size_t)out_size != O_END || ws_size < WS_END) { fprintf(stderr, "kernel_launch: unexpected shapes (n_in %d out %d ws %zu)\n", n_in, out_size, ws_size); grid = -1; return; }
        int dev = 0, cus = 0, per_cu = 0;
        if (hipGetDevice(&dev) != hipSuccess || hipDeviceGetAttribute(&cus, hipDeviceAttributeMultiprocessorCount, dev) != hipSuccess) { grid = -1; return; }
        if (hipFuncSetAttribute((const void*)fwd_kernel, hipFuncAttributeMaxDynamicSharedMemorySize, LDS_BYTES) != hipSuccess) { fprintf(stderr, "kernel_launch: hipFuncSetAttribute failed\n"); grid = -1; return; }
        if (hipOccupancyMaxActiveBlocksPerMultiprocessor(&per_cu, (const void*)fwd_kernel, NTHR, LDS_BYTES) != hipSuccess || per_cu < 1) fprintf(stderr, "kernel_launch: occupancy query reports %d\n", per_cu);
        (void)hipGetLastError();
        grid = cus;
    }
    if (grid < 0) return;
    if (hipMemsetAsync((char*)d_ws + WS_CTL, 0, CTL_ZERO_BYTES, stream) != hipSuccess) return;
    Args a{};
    a.x_p = (const float*)d_in[0]; a.x_s = (const float*)d_in[1]; a.cache_k = (const float*)d_in[2]; a.cache_v = (const float*)d_in[3]; a.cache_lf = (const float*)d_in[4];
    a.state_pool = (const float*)d_in[5]; a.page_table = (const int*)d_in[6]; a.norm_mix_g = (const float*)d_in[7]; a.w_in = (const float*)d_in[8]; a.b_forget = (const float*)d_in[9];
    a.q_norm_g = (const float*)d_in[10]; a.k_norm_g = (const float*)d_in[11]; a.pool_mix_w = (const float*)d_in[12]; a.pool_scale = (const float*)d_in[13]; a.w_bp = (const float*)d_in[14];
    a.w_ba = (const float*)d_in[15]; a.w_out = (const float*)d_in[16]; a.norm_ffn_g = (const float*)d_in[17]; a.w_query = (const float*)d_in[18]; a.sub_keys = (const float*)d_in[19];
    a.peer_u = (const float*)d_in[20]; a.peer_v = (const float*)d_in[21];
    a.out = (float*)d_out; a.ws = (unsigned char*)d_ws; a.pad = 0;
#if MK_PER_PHASE
#ifndef DBG_NPH
#define DBG_NPH N_PHASES
#endif
    for (int ph = 0; ph < DBG_NPH; ++ph) { a.ph_lo = ph; a.ph_hi = ph + 1; a.li = ph; hipLaunchKernelGGL(fwd_kernel, dim3(grid), dim3(NTHR), LDS_BYTES, stream, a); }
#ifdef DBG_DUMP
    a.ph_lo = 9; a.ph_hi = 10; a.li = 9; hipLaunchKernelGGL(fwd_kernel, dim3(grid), dim3(NTHR), LDS_BYTES, stream, a);
#endif
#else
    a.ph_lo = 0; a.ph_hi = N_PHASES; a.li = 0; hipLaunchKernelGGL(fwd_kernel, dim3(grid), dim3(NTHR), LDS_BYTES, stream, a);
#endif
}
```

```cpp
#include <hip/hip_runtime.h>
#include <cstdio>
#include <cstdint>
#include <cmath>
namespace pg8 {
#define PG8_LAS __attribute__((address_space(3)))
typedef unsigned short bf16_t;
typedef short bf16x8 __attribute__((ext_vector_type(8)));
typedef float f32x4 __attribute__((ext_vector_type(4)));
typedef unsigned u32x4 __attribute__((ext_vector_type(4)));
constexpr int BM = 256, BK = 64, HALF = 128, HTB = HALF * BK * 2  , STAGE_BYTES = 8 * HTB, NXCD = 8, WGM = 8;

__host__ __device__ __forceinline__ int lds_byte(int r, int c) { const int st = (r >> 4) * 2 + (c >> 5), rr = r & 15, cc = c & 31, ob = rr * 64 + cc * 2; return st * 1024 + (ob ^ (((ob >> 9) & 1) << 5)); }
__host__ __device__ __forceinline__ void stage_rc(int b, int& R, int& C) { const int st = b / 1024, sb = b % 1024, swz = sb ^ (((sb >> 9) & 1) << 5); R = (st >> 1) * 16 + swz / 64; C = (st & 1) * 32 + (swz % 64) / 2; }
__host__ __device__ __forceinline__ int perm32(int rho) { const int n = rho >> 4, i = rho & 15; return 8 * (i >> 2) + 4 * n + (i & 3); }

struct Unit { int pm, pn, sel; };
struct Gemm { const bf16_t* A; const bf16_t* Bt; int M, N, K; const bf16_t* A2; const bf16_t* Bt2; };

struct StaticOrder {
    int nM, nN, nwg, G, c;
    __host__ __device__ void init(int M, int N, int G_, int c_) { nM = M / BM; nN = N / BM; nwg = nM * nN; G = G_; c = c_; }
    __host__ __device__ bool next(int i, Unit& u) const {
        const long L = (long)i * G + c; if (L >= nwg) return false;
        int wgid = (int)L; { const int q = nwg / NXCD, r = nwg % NXCD, xcd = wgid % NXCD, off = wgid / NXCD; wgid = (xcd < r ? xcd * (q + 1) : r * (q + 1) + (xcd - r) * q) + off; }
        const int nig = WGM * nN, gid = wgid / nig, fm = gid * WGM, gsz = (nM - fm) < WGM ? (nM - fm) : WGM;
        u.pm = fm + ((wgid % nig) % gsz); u.pn = (wgid % nig) / gsz; return true;
    }
    __device__ __forceinline__ void a_ready(const Unit&) const {}
    __device__ __forceinline__ void done(const Unit&) const {}
};

typedef float f32x2c __attribute__((ext_vector_type(2))); typedef __bf16 bf16x2c __attribute__((ext_vector_type(2)));
__device__ __forceinline__ unsigned cvt_pk_bf16(float lo, float hi) { f32x2c v = {lo, hi}; bf16x2c b = __builtin_convertvector(v, bf16x2c); return __builtin_bit_cast(unsigned, b); }
typedef float f32x2 __attribute__((ext_vector_type(2)));
__device__ __forceinline__ f32x2 gelu_pk(f32x2 v) {
    const f32x2 av = __builtin_elementwise_abs(v), d = av * 0.2316418882f + 1.0f;
    f32x2 t; t.x = __builtin_amdgcn_rcpf(d.x); t.y = __builtin_amdgcn_rcpf(d.y);
    f32x2 q = t * 0.5307027145f + (-0.7265760135f); q = q * t + 0.7107068705f; q = q * t + (-0.142248368f); q = q * t + 0.127414796f; q = q * t;
    const f32x2 s = (v * v) * (-0.72134752044f);
    f32x2 e; e.x = __builtin_amdgcn_exp2f(s.x); e.y = __builtin_amdgcn_exp2f(s.y);
    const f32x2 m = v * (q * e), r = v - m;
    f32x2 o; o.x = v.x < 0.f ? m.x : r.x; o.y = v.y < 0.f ? m.y : r.y; return o;
}

template <int ACT  > struct EpiBf16 {
    static constexpr bool PERM = true, AFTER_DRAIN = false, CHAIN = false; static_assert(ACT == 0 || ACT == 1, "EpiBf16: ACT is 0 (none) or 1 (gelu_pk)");
    bf16_t* O; int ldc; const float* bias; int split_cols; size_t split_stride; float scale0;
    __device__ __forceinline__ void operator()(const f32x4 (&acc)[2][2][4][2], const Unit& u, int wr, int wc, int fr, int fq) const {
        const int row0 = u.pm * BM + wr * 64 + fr; int colt = u.pn * BM; bf16_t* base = O;
        float sc = 1.f; if (split_cols) { const int t = colt / split_cols; base += (size_t)t * split_stride; colt -= t * split_cols; if (t == 0) sc = scale0; }
        const int col0 = colt + wc * 32 + 8 * fq, bcol0 = u.pn * BM + wc * 32 + 8 * fq;
        f32x4 bv[2][2];
#pragma unroll
        for (int bj = 0; bj < 2; ++bj)
#pragma unroll
            for (int n = 0; n < 2; ++n) bv[bj][n] = bias ? *(const f32x4*)(bias + bcol0 + bj * HALF + 4 * n) : (f32x4){0.f, 0.f, 0.f, 0.f};
#pragma unroll
        for (int ai = 0; ai < 2; ++ai)
#pragma unroll
            for (int m = 0; m < 4; ++m) { bf16_t* rowp = base + (size_t)(row0 + ai * HALF + m * 16) * ldc + col0;
#pragma unroll
                for (int bj = 0; bj < 2; ++bj) { f32x4 v0 = acc[ai][bj][m][0] + bv[bj][0], v1 = acc[ai][bj][m][1] + bv[bj][1];
                    if (ACT == 1) { f32x2 a = gelu_pk((f32x2){v0[0], v0[1]}), b = gelu_pk((f32x2){v0[2], v0[3]}), c = gelu_pk((f32x2){v1[0], v1[1]}), d = gelu_pk((f32x2){v1[2], v1[3]});
                        v0 = (f32x4){a.x, a.y, b.x, b.y}; v1 = (f32x4){c.x, c.y, d.x, d.y}; }
                    v0 = v0 * sc; v1 = v1 * sc; u32x4 w; w.x = cvt_pk_bf16(v0[0], v0[1]); w.y = cvt_pk_bf16(v0[2], v0[3]); w.z = cvt_pk_bf16(v1[0], v1[1]); w.w = cvt_pk_bf16(v1[2], v1[3]);
                    *(u32x4*)(rowp + bj * HALF) = w; } }
    }
};
template <class Epi, class Sched, bool ALIGN_EPI = false, bool SP2 = false>
__device__ __forceinline__ void gemm_phase(PG8_LAS unsigned char* lds, const Gemm g, const Sched& S, const Epi& E) {
    int tid = threadIdx.x; asm volatile("" : "+v"(tid));
    const int wid = __builtin_amdgcn_readfirstlane(tid >> 6), lane = tid & 63, wr = wid >> 2, wc = wid & 3, fr = lane & 15, fq = lane >> 4;
    const int K = g.K, nt = K / BK;
    unsigned voffA[2], voffB[2];
#pragma unroll
    for (int i = 0; i < 2; ++i) { int R, C; stage_rc(tid * 16 + i * 8192, R, C); const int Rb = Epi::PERM ? ((R & ~31) + perm32(R & 31)) : R;
        voffA[i] = (unsigned)(R * K + C) * 2u; voffB[i] = (unsigned)(Rb * K + C) * 2u; }
    const size_t kstep = (size_t)(BK * 2);
    const size_t hstep = (size_t)HALF * K * 2;
    const size_t tstep = 2 * hstep;
    const unsigned ldsw = (unsigned)wid * 1024u;
    const int aoff = lds_byte(wr * 64 + fr, fq * 8), boff = lds_byte(wc * 32 + fr, fq * 8);
#define PG8_SA(b, h) (((b) * 2 + (h)) * HTB)
#define PG8_SB(b, h) ((4 + (b) * 2 + (h)) * HTB)
#define PG8_STAGE(bufoff, gbase, voff) do { _Pragma("unroll") for (int _i = 0; _i < 2; ++_i) \
        __builtin_amdgcn_global_load_lds((const unsigned*)((const char*)(gbase) + (voff)[_i]), (PG8_LAS unsigned*)(lds + (bufoff) + ldsw + _i * 8192), 16, 0, 0); } while (0)
#define PG8_LDA(dst, b, h) do { _Pragma("unroll") for (int m = 0; m < 4; ++m) _Pragma("unroll") for (int k = 0; k < 2; ++k) dst[m][k] = *(const PG8_LAS bf16x8*)(lds + PG8_SA(b, h) + aoff + m * 2048 + k * 1024); } while (0)
#define PG8_LDB(dst, b, h) do { _Pragma("unroll") for (int n = 0; n < 2; ++n) _Pragma("unroll") for (int k = 0; k < 2; ++k) dst[n][k] = *(const PG8_LAS bf16x8*)(lds + PG8_SB(b, h) + boff + n * 2048 + k * 1024); } while (0)
#define PG8_MMA(ai, bj, At, Bt) do { __builtin_amdgcn_s_setprio(1); _Pragma("unroll") for (int m = 0; m < 4; ++m) _Pragma("unroll") for (int n = 0; n < 2; ++n) _Pragma("unroll") for (int k = 0; k < 2; ++k) \
        acc[ai][bj][m][n] = __builtin_amdgcn_mfma_f32_16x16x32_bf16(Bt[n][k], At[m][k], acc[ai][bj][m][n], 0, 0, 0); __builtin_amdgcn_s_setprio(0); } while (0)
#define PG8_WAIT_V(n) asm volatile("s_waitcnt vmcnt(" #n ")" ::: "memory")
#define PG8_WAIT_L(n) asm volatile("s_waitcnt lgkmcnt(" #n ")" ::: "memory")
#define PG8_BAR __builtin_amdgcn_s_barrier()
#define PG8_SCHED __builtin_amdgcn_sched_barrier(0)
    Unit cur, nxt; int ui = 0;
    if (!S.next(0, cur)) return;
    f32x4 acc[2][2][4][2];
#pragma unroll
    for (int a = 0; a < 2; ++a)
#pragma unroll
        for (int b = 0; b < 2; ++b)
#pragma unroll
            for (int m = 0; m < 4; ++m)
#pragma unroll
                for (int n = 0; n < 2; ++n) acc[a][b][m][n] = (f32x4){0.f, 0.f, 0.f, 0.f};
    bf16x8 At[4][2], B0[2][2], B1[2][2];
    const char* cA = (const char*)g.A + (size_t)cur.pm * tstep; const char* cB = (const char*)g.Bt + (size_t)cur.pn * tstep;
    if constexpr (Epi::CHAIN) { if (cur.sel) { cA = (const char*)g.A2 + (size_t)cur.pm * tstep; cB = (const char*)g.Bt2 + (size_t)cur.pn * tstep; } }
    S.a_ready(cur);
    if constexpr (SP2) {
        PG8_STAGE(PG8_SB(0, 0), cB, voffB); PG8_STAGE(PG8_SB(0, 1), cB + hstep, voffB); PG8_STAGE(PG8_SA(0, 0), cA, voffA); PG8_STAGE(PG8_SA(0, 1), cA + hstep, voffA);
        if (wr == 1) PG8_BAR;
        PG8_WAIT_V(2); PG8_BAR;
        PG8_STAGE(PG8_SB(1, 0), cB + kstep, voffB); PG8_STAGE(PG8_SA(1, 0), cA + kstep, voffA); PG8_STAGE(PG8_SB(1, 1), cB + hstep + kstep, voffB);
        PG8_WAIT_V(6); PG8_BAR;
    } else {
        PG8_STAGE(PG8_SB(0, 0), cB, voffB); PG8_STAGE(PG8_SA(0, 0), cA, voffA); PG8_STAGE(PG8_SB(0, 1), cB + hstep, voffB); PG8_STAGE(PG8_SA(0, 1), cA + hstep, voffA);
        if (wr == 1) PG8_BAR;
        PG8_WAIT_V(4); PG8_BAR;
        PG8_STAGE(PG8_SB(1, 0), cB + kstep, voffB); PG8_STAGE(PG8_SA(1, 0), cA + kstep, voffA); PG8_STAGE(PG8_SB(1, 1), cB + hstep + kstep, voffB);
        PG8_WAIT_V(6); PG8_BAR;
    }
    for (;;) {
        const bool has_next = S.next(ui + 1, nxt);
        const char* nA = has_next ? (const char*)g.A + (size_t)nxt.pm * tstep : cA; const char* nB = has_next ? (const char*)g.Bt + (size_t)nxt.pn * tstep : cB;
        if constexpr (Epi::CHAIN) { if (has_next && nxt.sel) { nA = (const char*)g.A2 + (size_t)nxt.pm * tstep; nB = (const char*)g.Bt2 + (size_t)nxt.pn * tstep; } }
        for (int t = 0; t < nt; t += 2) {
            const bool last = (t == nt - 2);
            const char* a1 = cA + (size_t)(t + 1) * kstep;
            const char* a2 = last ? nA : cA + (size_t)(t + 2) * kstep; const char* b2 = last ? nB : cB + (size_t)(t + 2) * kstep;
            const char* a3 = a2 + kstep; const char* b3 = b2 + kstep;
            if (last && has_next) S.a_ready(nxt);
            if constexpr (SP2) {
            PG8_LDB(B0, 0, 0); PG8_LDB(B1, 0, 1); PG8_SCHED; PG8_LDA(At, 0, 0); PG8_STAGE(PG8_SA(1, 1), a1 + hstep, voffA);
            PG8_WAIT_V(8); PG8_WAIT_L(0); PG8_BAR; PG8_MMA(0, 0, At, B0); PG8_MMA(0, 1, At, B1); PG8_BAR; PG8_SCHED;
            PG8_LDA(At, 0, 1); PG8_STAGE(PG8_SB(0, 0), b2, voffB); PG8_STAGE(PG8_SB(0, 1), b2 + hstep, voffB); PG8_STAGE(PG8_SA(0, 0), a2, voffA);
            PG8_WAIT_V(8); PG8_WAIT_L(0); PG8_BAR; PG8_MMA(1, 0, At, B0); PG8_MMA(1, 1, At, B1); PG8_BAR; PG8_SCHED;
            PG8_LDB(B0, 1, 0); PG8_LDB(B1, 1, 1); PG8_SCHED; PG8_LDA(At, 1, 0); PG8_STAGE(PG8_SA(0, 1), a2 + hstep, voffA);
            PG8_WAIT_V(8); PG8_WAIT_L(0); PG8_BAR; PG8_MMA(0, 0, At, B0); PG8_MMA(0, 1, At, B1); PG8_BAR; PG8_SCHED;
            PG8_LDA(At, 1, 1); PG8_STAGE(PG8_SB(1, 0), b3, voffB); PG8_STAGE(PG8_SB(1, 1), b3 + hstep, voffB); PG8_STAGE(PG8_SA(1, 0), a3, voffA);
            PG8_WAIT_V(8); PG8_WAIT_L(0); PG8_BAR; PG8_MMA(1, 0, At, B0); PG8_MMA(1, 1, At, B1); PG8_BAR; PG8_SCHED;
            } else {
            PG8_LDB(B0, 0, 0); PG8_SCHED; PG8_LDA(At, 0, 0); PG8_STAGE(PG8_SA(1, 1), a1 + hstep, voffA);
            PG8_WAIT_L(8); PG8_BAR; PG8_WAIT_L(0); PG8_MMA(0, 0, At, B0); PG8_BAR; PG8_SCHED;
            PG8_LDB(B1, 0, 1); PG8_STAGE(PG8_SB(0, 0), b2, voffB);
            PG8_BAR; PG8_WAIT_L(0); PG8_MMA(0, 1, At, B1); PG8_BAR;
            PG8_LDA(At, 0, 1); PG8_STAGE(PG8_SA(0, 0), a2, voffA);
            PG8_BAR; PG8_WAIT_L(0); PG8_MMA(1, 0, At, B0); PG8_BAR; PG8_SCHED;
            PG8_STAGE(PG8_SB(0, 1), b2 + hstep, voffB);
            PG8_WAIT_V(6); PG8_BAR; PG8_MMA(1, 1, At, B1); PG8_BAR;
            PG8_LDB(B0, 1, 0); PG8_SCHED; PG8_LDA(At, 1, 0); PG8_STAGE(PG8_SA(0, 1), a2 + hstep, voffA);
            PG8_WAIT_L(8); PG8_BAR; PG8_WAIT_L(0); PG8_MMA(0, 0, At, B0); PG8_BAR; PG8_SCHED;
            PG8_LDB(B1, 1, 1); PG8_STAGE(PG8_SB(1, 0), b3, voffB);
            PG8_BAR; PG8_WAIT_L(0); PG8_MMA(0, 1, At, B1); PG8_BAR;
            PG8_LDA(At, 1, 1); PG8_STAGE(PG8_SA(1, 0), a3, voffA);
            PG8_BAR; PG8_WAIT_L(0); PG8_MMA(1, 0, At, B0); PG8_BAR; PG8_SCHED;
            PG8_STAGE(PG8_SB(1, 1), b3 + hstep, voffB);
            PG8_WAIT_V(6); PG8_BAR; PG8_MMA(1, 1, At, B1); PG8_BAR;
            }
        }
        if constexpr (ALIGN_EPI) { if (wr == 0) PG8_BAR; }
        bool keep_acc = false;
        if constexpr (Epi::CHAIN) { if (cur.sel == 0) { E.mid(acc, cur, wr, wc, fr, fq); keep_acc = true; } else { E(acc, cur, wr, wc, fr, fq); S.done(cur); } }
        else if constexpr (!Epi::AFTER_DRAIN) { E(acc, cur, wr, wc, fr, fq); S.done(cur); }
        if (!has_next) break;
        if (!keep_acc) {
#pragma unroll
        for (int a = 0; a < 2; ++a)
#pragma unroll
            for (int b = 0; b < 2; ++b)
#pragma unroll
                for (int m = 0; m < 4; ++m)
#pragma unroll
                    for (int n = 0; n < 2; ++n) acc[a][b][m][n] = (f32x4){0.f, 0.f, 0.f, 0.f};
        }
        cur = nxt; cA = nA; cB = nB; ++ui;
        if constexpr (ALIGN_EPI) { if (wr == 1) PG8_BAR; }
    }
    PG8_WAIT_V(0);
    if constexpr (!ALIGN_EPI) { if (wr == 0) PG8_BAR; }
    PG8_BAR;
    if constexpr (Epi::AFTER_DRAIN) { E.fused(acc, cur, wr, wc, fr, fq, lds, wid, lane); S.done(cur); }
#undef PG8_SA
#undef PG8_SB
#undef PG8_STAGE
#undef PG8_LDA
#undef PG8_LDB
#undef PG8_MMA
#undef PG8_WAIT_V
#undef PG8_WAIT_L
#undef PG8_BAR
#undef PG8_SCHED
}
}
#define GAS __attribute__((address_space(1)))
#define LAS __attribute__((address_space(3)))
typedef unsigned short bf16;
typedef unsigned v4u __attribute__((ext_vector_type(4)));
typedef float f32x4 __attribute__((ext_vector_type(4)));
typedef short bf16x8 __attribute__((ext_vector_type(8)));
typedef GAS unsigned gu32;
typedef GAS unsigned long long gu64;
#define RLX_AGENT __ATOMIC_RELAXED, __HIP_MEMORY_SCOPE_AGENT
#define LDS_WAIT() asm volatile("s_waitcnt lgkmcnt(0)" ::: "memory")
#define VM_WAIT() asm volatile("s_waitcnt vmcnt(0)" ::: "memory")
__device__ __forceinline__ unsigned long long rt() { return __builtin_amdgcn_s_memrealtime(); }
__device__ __forceinline__ unsigned f2bf(float f) { unsigned u = __builtin_bit_cast(unsigned, f); return (u + 0x7fffu + ((u >> 16) & 1u)) >> 16; }
__device__ __forceinline__ unsigned pk2(float lo, float hi) { return f2bf(lo) | (f2bf(hi) << 16); }

#define XB_TMO      128
#define XB_XCNT(j)  (256  + 64 * (j))
#define XB_XSUB(j)  (1280 + 64 * (j))
#define XB_XGEN(j)  (2304 + 64 * (j))
#define XB_TOP      3328
#define XB_TOPGEN   3392
#define XCD_BAR_WORDS 3456
#define XB_SPIN_CAP (1u << 18)

__device__ __forceinline__ unsigned xb_ld(unsigned* p)              { return __hip_atomic_load(p, __ATOMIC_RELAXED, __HIP_MEMORY_SCOPE_AGENT); }
__device__ __forceinline__ unsigned xb_add(unsigned* p, unsigned v) { return __hip_atomic_fetch_add(p, v, __ATOMIC_RELAXED, __HIP_MEMORY_SCOPE_AGENT); }
__device__ __forceinline__ unsigned xb_xcc_id() { return (unsigned)__builtin_amdgcn_s_getreg((3 << 11) | 20) & 0xFu; }
#define XB_SPIN(cond, bar) do { unsigned _sp = 0; while (cond) { __builtin_amdgcn_s_sleep(1); \
    if ((++_sp & 255u) == 0u) { if (xb_ld(&(bar)[XB_TMO])) break; if (_sp > XB_SPIN_CAP) { atomicAdd(&(bar)[XB_TMO], 1u); break; } } } } while (0)

struct XcdBarrier {
    unsigned* bar; unsigned x;
    volatile LAS unsigned* st;
};

__device__ __forceinline__ XcdBarrier xcd_barrier_post(unsigned* bar, volatile LAS unsigned* st) {
    XcdBarrier b; b.bar = bar; b.x = xb_xcc_id(); b.st = st;
    if (threadIdx.x == 0) (void)xb_add(&bar[XB_XCNT(b.x)], 1u);
    return b;
}
__device__ __forceinline__ void xcd_barrier_complete(unsigned* bar, unsigned x, unsigned& nloc, unsigned& nx) {
    const unsigned G = gridDim.x * gridDim.y * gridDim.z;
    unsigned sum, cnt, mine, sp = 0u;
    for (;;) {
        sum = 0u; cnt = 0u; mine = 0u;
#pragma unroll
        for (unsigned j = 0; j < 16; ++j) { const unsigned c = xb_ld(&bar[XB_XCNT(j)]); sum += c; cnt += (c > 0u) ? 1u : 0u; mine = (j == x) ? c : mine; }
        if (sum == G) break;
        __builtin_amdgcn_s_sleep(1);
        if ((++sp & 255u) == 0u) { if (xb_ld(&bar[XB_TMO])) break; if (sp > XB_SPIN_CAP) { atomicAdd(&bar[XB_TMO], 1u); break; } }
    }
    nloc = mine > 0u ? mine : 1u; nx = cnt > 0u ? cnt : 1u;
}

__device__ __forceinline__ void xcd_barrier(const XcdBarrier& b) {
    asm volatile("s_waitcnt vmcnt(0)" ::: "memory");
    __syncthreads();
    if (threadIdx.x == 0) {
        unsigned* bar = b.bar;
        __builtin_amdgcn_s_waitcnt(0);
        unsigned nloc = b.st[0], nx = b.st[1];
        if (nloc == 0u) { xcd_barrier_complete(bar, b.x, nloc, nx); b.st[0] = nloc; b.st[1] = nx; }
        const unsigned old = xb_add(&bar[XB_XSUB(b.x)], 1u);
        const unsigned gen = old / nloc;
        if (old + 1u == (gen + 1u) * nloc) {
            __builtin_amdgcn_fence(__ATOMIC_RELEASE, "agent");
            asm volatile("s_waitcnt vmcnt(0)" ::: "memory");
            const unsigned og = xb_add(&bar[XB_TOP], 1u);
            const unsigned tg = og / nx;
            if (og + 1u == (tg + 1u) * nx) xb_add(&bar[XB_TOPGEN], 1u);
            else XB_SPIN(xb_ld(&bar[XB_TOPGEN]) == tg, bar);
            __builtin_amdgcn_fence(__ATOMIC_ACQUIRE, "agent");
            xb_add(&bar[XB_XGEN(b.x)], 1u);
            asm volatile("s_waitcnt vmcnt(0)" ::: "memory");
        } else {
            XB_SPIN(xb_ld(&bar[XB_XGEN(b.x)]) == gen, bar);
            __builtin_amdgcn_fence(__ATOMIC_ACQUIRE, "agent");
            asm volatile("s_waitcnt vmcnt(0)" ::: "memory");
        }
    }
    __syncthreads();
}
#include <hip/hip_bf16.h>
#include <cmath>
namespace attn_body {
using bf16=__hip_bfloat16;
using bf16x8=__attribute__((ext_vector_type(8)))short;
using s16x4=__attribute__((ext_vector_type(4)))short;
using f32x16=__attribute__((ext_vector_type(16)))float;
using u32x4=__attribute__((ext_vector_type(4)))unsigned;
constexpr int BATCH=4,NHEAD=8,SEQ=4096,D=64,DM=NHEAD*D;
constexpr int NW=8,QBLK=32,QB=QBLK*NW,KVBLK=64,NQB=SEQ/QB;
constexpr int ATTN_PITCH=DM, ATTN_UNIT_ROWS=QB;
__device__ __forceinline__ int crow(int r,int hi){return (r&3)+8*(r>>2)+4*hi;}
#define SBAR() __builtin_amdgcn_sched_barrier(0)
__device__ __forceinline__ void cmask(f32x16&p0,f32x16&p1,int jb,int qrel,int hi){
  const float NEG=-INFINITY; int kb=64*jb+4*hi;
  #pragma unroll
  for(int r=0;r<16;++r){int kv=kb+(r&3)+8*(r>>2); if(kv>qrel)p0[r]=NEG; if(kv+32>qrel)p1[r]=NEG;}
}

constexpr int NSLOT=3, SLOTB=8192;
constexpr int LDS_K=0, LDS_V=NSLOT*SLOTB, LDS_WS=2*NSLOT*SLOTB, LDS_OST=LDS_WS+NW*64*4, LDS_CK=LDS_OST+NW*4096, LDS_BYTES=LDS_CK+SEQ*4;
constexpr float C2=0.125f*1.4426950408889634f;
__device__ __forceinline__ void glds16(const void*gsrc,unsigned lds_dst){unsigned keep;
  asm volatile("s_mov_b32 %0, m0\n\ts_mov_b32 m0, %2\n\ts_nop 0\n\tglobal_load_lds_dwordx4 %1, off\n\ts_mov_b32 m0, %0":"=&s"(keep):"v"(gsrc),"s"(lds_dst):"memory");}
__device__ __forceinline__ float max3f(float a,float b,float c){float r;asm("v_max3_f32 %0, %1, %2, %3":"=v"(r):"v"(a),"v"(b),"v"(c));return r;}
__device__ __forceinline__ float max2f(float a,float b){float r;asm("v_max_f32_e32 %0, %1, %2":"=v"(r):"v"(a),"v"(b));return r;}
__device__ __forceinline__ float fadd_s(float a,float b){float r;asm("v_add_f32_e32 %0, %1, %2":"=v"(r):"v"(a),"v"(b));return r;}
__device__ __forceinline__ float fsub_s(float a,float b){float r;asm("v_sub_f32_e32 %0, %1, %2":"=v"(r):"v"(a),"v"(b));return r;}
typedef float f32x2_t __attribute__((ext_vector_type(2))); typedef __bf16 bf16x2_t __attribute__((ext_vector_type(2)));
__device__ __forceinline__ unsigned cvtpk_s(float lo,float hi){f32x2_t v={lo,hi};bf16x2_t b=__builtin_convertvector(v,bf16x2_t);return __builtin_bit_cast(unsigned,b);}
#define WAIT_BAR(N) asm volatile("s_waitcnt vmcnt(" #N ") lgkmcnt(0)\n\ts_barrier":::"memory")

__device__ __forceinline__ void qkt(f32x16&p0,f32x16&p1,const char*Kslot,const bf16x8*qr,int r32,int hi){
  const char*kb=Kslot+hi*1024+r32*16;
  #pragma unroll
  for(int d0=0;d0<4;++d0){
    const bf16x8 b0=*reinterpret_cast<const bf16x8*>(kb+d0*2048);
    const bf16x8 b1=*reinterpret_cast<const bf16x8*>(kb+d0*2048+512);
    p0=__builtin_amdgcn_mfma_f32_32x32x16_bf16(b0,qr[d0],p0,0,0,0);p1=__builtin_amdgcn_mfma_f32_32x32x16_bf16(b1,qr[d0],p1,0,0,0);}
}
typedef __attribute__((address_space(3))) const char* lds_cptr;
typedef short v4i16_t __attribute__((ext_vector_type(4)));
__device__ __forceinline__ void kload8(bf16x8*kf,lds_cptr kp){
  kf[0]=*(const __attribute__((address_space(3))) bf16x8*)(kp);      kf[1]=*(const __attribute__((address_space(3))) bf16x8*)(kp+512);
  kf[2]=*(const __attribute__((address_space(3))) bf16x8*)(kp+2048); kf[3]=*(const __attribute__((address_space(3))) bf16x8*)(kp+2560);
  kf[4]=*(const __attribute__((address_space(3))) bf16x8*)(kp+4096); kf[5]=*(const __attribute__((address_space(3))) bf16x8*)(kp+4608);
  kf[6]=*(const __attribute__((address_space(3))) bf16x8*)(kp+6144); kf[7]=*(const __attribute__((address_space(3))) bf16x8*)(kp+6656);
}
__device__ __forceinline__ void kload2(bf16x8*kf,lds_cptr kp,int j){ kf[2*j]=*(const __attribute__((address_space(3))) bf16x8*)(kp+j*2048); kf[2*j+1]=*(const __attribute__((address_space(3))) bf16x8*)(kp+j*2048+512); }
__device__ __forceinline__ s16x4 vtr(lds_cptr p){ return __builtin_bit_cast(s16x4,__builtin_amdgcn_ds_read_tr16_b64_v4i16((__attribute__((address_space(3))) v4i16_t*)p)); }
__device__ __forceinline__ float rowmax(const f32x16&p0,const f32x16&p1){
  float a=max3f(p0[0],p0[1],p1[0]),b=max3f(p0[2],p0[3],p1[1]);a=max3f(a,p1[2],p1[3]);
  #pragma unroll
  for(int r=4;r<16;r+=4){a=max3f(a,p0[r],p0[r+1]);b=max3f(b,p0[r+2],p0[r+3]);a=max3f(a,p1[r],p1[r+1]);b=max3f(b,p1[r+2],p1[r+3]);}
  const float m=max2f(a,b);
  auto rr=__builtin_amdgcn_permlane32_swap(__float_as_uint(m),__float_as_uint(m),false,false);
  return max2f(__uint_as_float(rr[0]),__uint_as_float(rr[1]));
}
__device__ __forceinline__ void pv(f32x16*o,int vb,bf16x8 pa0,bf16x8 pa1,bf16x8 pa2,bf16x8 pa3){
  #pragma unroll
  for(int d0=0;d0<2;++d0){s16x4 lo[4],hi[4];
    #pragma unroll
    for(int ks=0;ks<4;++ks){
      asm volatile("ds_read_b64_tr_b16 %0,%1 offset:%c2":"=&v"(lo[ks]):"v"(vb),"i"(d0*4096+ks*1024):"memory");
      asm volatile("ds_read_b64_tr_b16 %0,%1 offset:%c2":"=&v"(hi[ks]):"v"(vb),"i"(d0*4096+ks*1024+512):"memory");}
    asm volatile("s_waitcnt lgkmcnt(0)":::"memory");SBAR();
    #define PK(k) (bf16x8){lo[k][0],lo[k][1],lo[k][2],lo[k][3],hi[k][0],hi[k][1],hi[k][2],hi[k][3]}
    o[d0]=__builtin_amdgcn_mfma_f32_32x32x16_bf16(pa0,PK(0),o[d0],0,0,0);
    o[d0]=__builtin_amdgcn_mfma_f32_32x32x16_bf16(pa1,PK(1),o[d0],0,0,0);
    o[d0]=__builtin_amdgcn_mfma_f32_32x32x16_bf16(pa2,PK(2),o[d0],0,0,0);
    o[d0]=__builtin_amdgcn_mfma_f32_32x32x16_bf16(pa3,PK(3),o[d0],0,0,0);
    #undef PK
  }
}

#ifndef ATTN_STORE16
#define ATTN_STORE16(p,v) (*(u32x4*)(p)=(v))
#endif
template<int THRL> __device__ __forceinline__ void attn_unit(int b,int h,int qb,const bf16*Q,const bf16*__restrict__ K,const bf16*__restrict__ V,bf16*O,const float*__restrict__ c2,float M2,char*shm){
  int tid=threadIdx.x; asm volatile("":"+v"(tid)); const int lane=tid&63,r32=lane&31,hi=lane>>5; const int wid=__builtin_amdgcn_readfirstlane(tid>>6);
  const long rowbase=(long)b*SEQ; const int q0=qb*QB;
  const bf16*Qw=Q+(rowbase+q0+wid*QBLK)*DM+h*D;
  const bf16*Kh0=K+rowbase*DM+h*D,*Vh0=V+rowbase*DM+h*D;
  const unsigned lds0=(unsigned)(uintptr_t)shm;
  float*wsf=(float*)(shm+LDS_WS)+wid*64;
  const unsigned kdst=lds0+LDS_K+wid*1024, vdst=lds0+LDS_V+wid*1024;
  #define DMA_K(t,slot) glds16(ksrc+(long)(t)*KVBLK*DM,(unsigned)__builtin_amdgcn_readfirstlane(kdst+(slot)))
  #define DMA_V(t,slot) glds16(vsrc+(long)(t)*KVBLK*DM,(unsigned)__builtin_amdgcn_readfirstlane(vdst+(slot)))
  const int vb0=(int)(lds0+LDS_V)+((lane>>4)&1)*32+(lane&3)*8+(4*hi+((lane&15)>>2))*64;
  const char*Kbase=shm+LDS_K; bf16x8 kf[8];
  const lds_cptr shm3=(lds_cptr)shm; const lds_cptr kp0=shm3+LDS_K+hi*1024+r32*16; const lds_cptr vp0=shm3+LDS_V+((lane>>4)&1)*32+(lane&3)*8+(4*hi+((lane&15)>>2))*64;
  const int NT0=(q0+QB)/KVBLK;
  int ts; { const int tl=lane; const float cqa=c2[q0]; const float ckb=(tl<NT0-4)?c2[64*tl+63]:cqa; const unsigned long long bm=__ballot((tl<NT0-4)&&(cqa-ckb< -(24.f+2.f*M2))); ts=__builtin_popcountll(bm)&~1; }
  ts=__builtin_amdgcn_readfirstlane(ts);
  const int NT=NT0-ts;
  const bf16*Kh=Kh0+(long)ts*KVBLK*DM,*Vh=Vh0+(long)ts*KVBLK*DM;
  const bf16*ksrc=Kh+(long)lane*DM+wid*8;
  const bf16*vsrc=Vh+(long)(16*(wid&3)+(lane>>2))*DM+(wid>>2)*32+(lane&3)*8;
  typedef float f32x4_t __attribute__((ext_vector_type(4)));
  int tidl=tid; asm volatile("":"+v"(tidl));
  const int nck4=(q0+QB)/4; f32x4_t ckv0=f32x4_t{},ckv1=f32x4_t{}; if(tidl<nck4)ckv0=((const f32x4_t*)c2)[tidl]; if(tidl+512<nck4)ckv1=((const f32x4_t*)c2)[tidl+512];
  const float cq=c2[q0+wid*QBLK+r32]-M2;
  DMA_K(0,0);DMA_V(0,0);DMA_K(1,SLOTB);
  bf16x8 qr[4];
  #pragma unroll
  for(int d0=0;d0<4;++d0)qr[d0]=*reinterpret_cast<const bf16x8*>(&Qw[(long)r32*DM+d0*16+hi*8]);
  float l_reg=0.f;f32x16 o[2];o[0]=f32x16{};o[1]=f32x16{};
  { __attribute__((address_space(3))) f32x4_t*ckl=(__attribute__((address_space(3))) f32x4_t*)((lds_cptr)shm+LDS_CK); if(tidl<nck4)ckl[tidl]=ckv0; if(tidl+512<nck4)ckl[tidl+512]=ckv1; }
  const __attribute__((address_space(3))) f32x4_t*ckp=(const __attribute__((address_space(3))) f32x4_t*)((lds_cptr)shm+LDS_CK)+hi+ts*16;
  #define CKLD(P0,P1,t) do{ _Pragma("unroll") for(int g_=0;g_<4;++g_){ const f32x4_t a_=ckp[(t)*16+2*g_], b_=ckp[(t)*16+8+2*g_]; P0[4*g_]=a_[0];P0[4*g_+1]=a_[1];P0[4*g_+2]=a_[2];P0[4*g_+3]=a_[3]; P1[4*g_]=b_[0];P1[4*g_+1]=b_[1];P1[4*g_+2]=b_[2];P1[4*g_+3]=b_[3]; } }while(0)
  #define CKSUB(P0,P1) do{ _Pragma("unroll") for(int r=0;r<16;++r){P0[r]=cq-P0[r];P1[r]=cq-P1[r];} }while(0)
  const int qrel=wid*QBLK+r32;
  #define CMASK(P0,P1,t) do{int jb_=(t)-(NT-4); if(jb_>=0)cmask(P0,P1,jb_,qrel,hi);}while(0)
  #define START(P0,P1) do{ _Pragma("unroll") for(int r=0;r<16;++r)P0[r]=__builtin_amdgcn_exp2f(P0[r]); }while(0)
  #define RESC() do{}while(0)
  f32x16 pA0,pA1,pB0,pB1;
  int sl_prev=0,sl_cur=0,sl_next=SLOTB;
  #define ROT() do{sl_prev=sl_cur;sl_cur=sl_next;sl_next=(sl_next==(NSLOT-1)*SLOTB)?0:sl_next+SLOTB;}while(0)
  DMA_K(2,2*SLOTB);
  WAIT_BAR(3);
  CKLD(pA0,pA1,0);CKSUB(pA0,pA1);
  qkt(pA0,pA1,Kbase,qr,r32,hi);asm volatile("s_nop 15\n\ts_nop 7":"+v"(pA0),"+v"(pA1));CMASK(pA0,pA1,0);
  CKLD(pB0,pB1,1);CKSUB(pB0,pB1);
  START(pA0,pA1);
  _Pragma("unroll") for(int r=0;r<16;++r)pA1[r]=__builtin_amdgcn_exp2f(pA1[r]);
  WAIT_BAR(0);
  DMA_K(3,0);DMA_V(1,SLOTB);
  ROT();
  kload8(kf,kp0+sl_cur);
  WAIT_BAR(2);
  s16x4 vlo[8],vhi[8]; u32x4 pw0,pw1,pw2,pw3;
  #define PKW(P,B) cvtpk_s(P[B],P[B+1])
  #define PAF(k) __builtin_bit_cast(bf16x8,pw##k)
  #define VFR(i) (bf16x8){vlo[i][0],vlo[i][1],vlo[i][2],vlo[i][3],vhi[i][0],vhi[i][1],vhi[i][2],vhi[i][3]}
  #define PIN(x) asm volatile("":"+v"(x))
  #define MX3(a,b,c) __builtin_fmaxf(__builtin_fmaxf((a),(b)),(c))
  #define GAPA(MF,A0,A1,A2,A3,W0,W1,PW) do{ MF; sacc+=A0; sacc+=A1; sacc+=A2; sacc+=A3; PIN(sacc); W0; W1; PIN(PW); SBAR(); }while(0)
  #define EX(v) __builtin_amdgcn_exp2f(v)
  #define GAPB(MF,X,B) do{ MF; X[B]=EX(X[B]); X[B+1]=EX(X[B+1]); X[B+2]=EX(X[B+2]); X[B+3]=EX(X[B+3]); PIN(X); SBAR(); }while(0)
  #define VRD(i) do{ vlo[i]=vtr(vp_+(((i)>>2)*4096+((i)&3)*1024)); vhi[i]=vtr(vp_+(((i)>>2)*4096+((i)&3)*1024+512)); }while(0)
  #define KRD(G,j) do{ if(G){ kload2(kf,kp0+sl_next,j); SBAR(); } }while(0)
  #define STEP(C0,C1,P0,P1,t,GK,GV,GL) do{ SBAR(); \
    const lds_cptr vp_=vp0+sl_prev; \
    VRD(0); SBAR(); float sacc=(P0[0]+P0[1]); \
    GAPA(C0=__builtin_amdgcn_mfma_f32_32x32x16_bf16(kf[0],qr[0],C0,0,0,0), P0[2],P0[3],P0[4],P0[5],     pw0[0]=PKW(P0,0), pw0[1]=PKW(P0,2), pw0); \
    VRD(4); SBAR(); GAPA(C1=__builtin_amdgcn_mfma_f32_32x32x16_bf16(kf[1],qr[0],C1,0,0,0), P0[6],P0[7],P0[8],P0[9],     pw0[2]=PKW(P0,4), pw0[3]=PKW(P0,6), pw0); \
    VRD(1); SBAR(); GAPA(C0=__builtin_amdgcn_mfma_f32_32x32x16_bf16(kf[2],qr[1],C0,0,0,0),   P0[10],P0[11],P0[12],P0[13], pw1[0]=PKW(P0,8), pw1[1]=PKW(P0,10), pw1); \
    VRD(5); SBAR(); GAPA(C1=__builtin_amdgcn_mfma_f32_32x32x16_bf16(kf[3],qr[1],C1,0,0,0),   P0[14],P0[15],P1[0],P1[1],   pw1[2]=PKW(P0,12),pw1[3]=PKW(P0,14), pw1); \
    VRD(2); SBAR(); GAPA(C0=__builtin_amdgcn_mfma_f32_32x32x16_bf16(kf[4],qr[2],C0,0,0,0),   P1[2],P1[3],P1[4],P1[5],     pw2[0]=PKW(P1,0), pw2[1]=PKW(P1,2), pw2); \
    VRD(6); SBAR(); GAPA(C1=__builtin_amdgcn_mfma_f32_32x32x16_bf16(kf[5],qr[2],C1,0,0,0),   P1[6],P1[7],P1[8],P1[9],     pw2[2]=PKW(P1,4), pw2[3]=PKW(P1,6), pw2); \
    VRD(3); SBAR(); GAPA(C0=__builtin_amdgcn_mfma_f32_32x32x16_bf16(kf[6],qr[3],C0,0,0,0),   P1[10],P1[11],P1[12],P1[13], pw3[0]=PKW(P1,8), pw3[1]=PKW(P1,10), pw3); \
    VRD(7); SBAR(); GAPA(C1=__builtin_amdgcn_mfma_f32_32x32x16_bf16(kf[7],qr[3],C1,0,0,0),   P1[14],P1[15],0.f,0.f,       pw3[2]=PKW(P1,12),pw3[3]=PKW(P1,14), pw3); \
    l_reg+=sacc; \
    if(GK){DMA_K((t)+3,sl_cur);} if(GV){DMA_V((t)+1,sl_next);} \
    CMASK(C0,C1,t); \
    SBAR(); \
    GAPB(o[0]=__builtin_amdgcn_mfma_f32_32x32x16_bf16(PAF(0),VFR(0),o[0],0,0,0), C0,0); \
    GAPB(o[1]=__builtin_amdgcn_mfma_f32_32x32x16_bf16(PAF(0),VFR(4),o[1],0,0,0), C0,4); \
    KRD(GL,0); GAPB(o[0]=__builtin_amdgcn_mfma_f32_32x32x16_bf16(PAF(1),VFR(1),o[0],0,0,0), C0,8); \
    KRD(GL,1); GAPB(o[1]=__builtin_amdgcn_mfma_f32_32x32x16_bf16(PAF(1),VFR(5),o[1],0,0,0), C0,12); \
    KRD(GL,2); GAPB(o[0]=__builtin_amdgcn_mfma_f32_32x32x16_bf16(PAF(2),VFR(2),o[0],0,0,0), C1,0); \
    KRD(GL,3); GAPB(o[1]=__builtin_amdgcn_mfma_f32_32x32x16_bf16(PAF(2),VFR(6),o[1],0,0,0), C1,4); \
    GAPB(o[0]=__builtin_amdgcn_mfma_f32_32x32x16_bf16(PAF(3),VFR(3),o[0],0,0,0), C1,8); \
    GAPB(o[1]=__builtin_amdgcn_mfma_f32_32x32x16_bf16(PAF(3),VFR(7),o[1],0,0,0), C1,12); \
    if(GL){ CKLD(P0,P1,(t)+1); CKSUB(P0,P1); } \
    }while(0)
  int t=1;
  #undef CMASK
  #define CMASK(P0,P1,t) do{}while(0)
  for(;t+5<NT;t+=2){
    STEP(pB0,pB1,pA0,pA1,t,true,true,true);     WAIT_BAR(2); RESC(); ROT();
    STEP(pA0,pA1,pB0,pB1,t+1,true,true,true);   WAIT_BAR(2); RESC(); ROT();
  }
  #undef CMASK
  #define CMASK(P0,P1,t) do{int jb_=(t)-(NT-4); if(jb_>=0)cmask(P0,P1,jb_,qrel,hi);}while(0)
  #define ENDW(tt) do{ if((tt)+3<NT){WAIT_BAR(2);} else if((tt)+2<NT){WAIT_BAR(1);} else {WAIT_BAR(0);} }while(0)
  for(;t+1<NT;t+=2){
    STEP(pB0,pB1,pA0,pA1,t,(t+3<NT),(t+1<NT),(t+1<NT));       ENDW(t);   RESC(); ROT();
    STEP(pA0,pA1,pB0,pB1,t+1,(t+4<NT),(t+2<NT),(t+2<NT));     ENDW(t+1); RESC(); ROT();
  }
  STEP(pB0,pB1,pA0,pA1,NT-1,false,false,false); RESC();
  { float sacc=pB0[0]+pB0[1]; _Pragma("unroll") for(int r=2;r<16;++r)sacc+=pB0[r]; _Pragma("unroll") for(int r=0;r<16;++r)sacc+=pB1[r]; l_reg+=sacc;
    pw0=(u32x4){PKW(pB0,0),PKW(pB0,2),PKW(pB0,4),PKW(pB0,6)};pw1=(u32x4){PKW(pB0,8),PKW(pB0,10),PKW(pB0,12),PKW(pB0,14)};pw2=(u32x4){PKW(pB1,0),PKW(pB1,2),PKW(pB1,4),PKW(pB1,6)};pw3=(u32x4){PKW(pB1,8),PKW(pB1,10),PKW(pB1,12),PKW(pB1,14)};
    SBAR(); pv(o,vb0+sl_cur,PAF(0),PAF(1),PAF(2),PAF(3)); }
  #undef PKW
  #undef PAF
  #undef VFR
  #undef PIN
  #undef MX3
  #undef GAPA
  #undef GAPB
  #undef EX
  #undef VRD
  #undef KRD
  #undef STEP
  #undef ENDW
  {auto rr=__builtin_amdgcn_permlane32_swap(__float_as_uint(l_reg),__float_as_uint(l_reg),false,false);l_reg=__uint_as_float(rr[0])+__uint_as_float(rr[1]);}
  if(hi==0)wsf[32+r32]=l_reg;asm volatile("s_waitcnt lgkmcnt(0)":::"memory");
  float rli[16];
  #pragma unroll
  for(int r=0;r<16;++r)rli[r]=__builtin_amdgcn_rcpf(wsf[32+crow(r,hi)]);
  bf16*Ow=O+(rowbase+q0+wid*QBLK)*DM+h*D;
  { bf16*stg=(bf16*)(shm+LDS_OST)+wid*2048;
    #pragma unroll
    for(int r=0;r<16;++r){const int orow=crow(r,hi);
      #pragma unroll
      for(int d0=0;d0<2;++d0)stg[orow*64+d0*32+r32]=__float2bfloat16(o[d0][r]*rli[r]);}
    asm volatile("s_waitcnt lgkmcnt(0)":::"memory");
    #pragma unroll
    for(int i=0;i<4;++i){const int row=i*8+(lane>>3),ch=lane&7; const u32x4 v=*(const u32x4*)(stg+row*64+ch*8); ATTN_STORE16(Ow+(long)row*DM+ch*8,v);} }
  asm volatile("s_waitcnt lgkmcnt(0)\n\ts_barrier":::"memory");
  #undef DMA_K
  #undef DMA_V
  #undef CMASK
  #undef START
  #undef RESC
  #undef ROT
  #undef CKLD
  #undef CKSUB
}
constexpr int ATTN_LDS_BYTES=LDS_BYTES;
struct AttnTensors { const bf16* Q; const bf16* K; const bf16* V; bf16* O; const float* C2T; float M2; };
struct AttnUnit { int bh; int qb; };
struct StaticOrder {
  int vcu, G;
  __device__ __forceinline__ explicit StaticOrder(int grid,int v):vcu(v),G(grid){}
  __device__ __forceinline__ bool next(int i,AttnUnit&u)const{ const int L=i*G+vcu; if(L>=BATCH*NHEAD*NQB)return false; const int r=L>>8, idx=L&255, k=idx&7; u.bh=idx>>3; u.qb=(r==0)?(NQB-1-k):k; return true; }
  __device__ __forceinline__ void a_ready(const AttnUnit&)const{}
  __device__ __forceinline__ void done(const AttnUnit&)const{}
};
struct QueueOrder {
  unsigned* cnt; volatile __attribute__((address_space(3))) unsigned* slot;
  __device__ __forceinline__ bool next(int,AttnUnit&u)const{
    if(threadIdx.x==0){ *slot=__hip_atomic_fetch_add(cnt,1u,__ATOMIC_RELAXED,__HIP_MEMORY_SCOPE_AGENT); }
    __syncthreads(); const unsigned L=*slot; __syncthreads();
    if(L>=(unsigned)(BATCH*NHEAD*NQB))return false;
    u.qb=NQB-1-(int)(L>>5); u.bh=(int)(L&31); return true; }
  __device__ __forceinline__ void a_ready(const AttnUnit&)const{}
  __device__ __forceinline__ void done(const AttnUnit&)const{}
};
template<class Sched,int THRL=8> __device__ __forceinline__ void attn_phase(char*lds,const AttnTensors&T,const Sched&S){
  AttnUnit u;
  for(int i=0;S.next(i,u);++i){ S.a_ready(u); attn_unit<THRL>(u.bh/NHEAD,u.bh%NHEAD,u.qb,T.Q,T.K,T.V,T.O,T.C2T+(size_t)u.bh*SEQ,T.M2,lds); S.done(u); }
}
#undef SBAR
#undef WAIT_BAR
}

constexpr int NWAVES = 8, NTHR = 512;
constexpr int DM = 1024, NB = 4, SEQ = 4096, DB = 128, DSEQ = 8, PAST = 2048, PAGE = 128, NPAGES = 16;
constexpr int MP = NB * SEQ, MS = DB * DSEQ, M = MP + MS;
constexpr int DP = 512, DA = 512, NH = 8, HD = 64, DIN = 4104, NPROJ = 4096;
constexpr int NKEYS = 128, NEXP = 16384, PH = 8, TOPK = 16, DKH = 128, DQ = 2048;
constexpr float EPS = 1e-6f;
constexpr float LOG2E = 1.4426950408889634f;
constexpr float C2 = 0.125f * LOG2E;
constexpr size_t O_YP = 0, O_YS = O_YP + (size_t)MP * DM, O_KP = O_YS + (size_t)MS * DM, O_VP = O_KP + (size_t)MP * DA, O_LFP = O_VP + (size_t)MP * DA,
                 O_PP = O_LFP + (size_t)MP * NH, O_KS = O_PP + (size_t)NB * 15 * DP, O_VS = O_KS + (size_t)MS * DA, O_LFS = O_VS + (size_t)MS * DA,
                 O_PS = O_LFS + (size_t)MS * NH, O_END = O_PS + (size_t)DB * 15 * DP;
constexpr size_t MiB = 1u << 20;
constexpr size_t WS_CTL = 0, CTL_ZERO_BYTES = 64 * 1024;
constexpr size_t WS_WIN = 2 * MiB, WS_WBP = 10 * MiB, WS_WBA = 11 * MiB, WS_WOUT = 12 * MiB, WS_WQ = 14 * MiB, WS_SUBK = 18 * MiB, WS_CP2 = 19 * MiB, WS_RSS = 20 * MiB, WS_US = 22 * MiB, WS_VS = 23 * MiB;
constexpr size_t WS_PU = 32 * MiB, WS_PV = 64 * MiB, WS_XN = 96 * MiB  , WS_U = 132 * MiB, WS_Q = 150 * MiB, WS_K = 168 * MiB, WS_V = 186 * MiB,
                 WS_GA = 204 * MiB, WS_GB = 240 * MiB, WS_PO = 276 * MiB, WS_AO = 294 * MiB, WS_T = 312 * MiB, WS_MIX = 348 * MiB, WS_PQ = 384 * MiB,
                 WS_SI = 456 * MiB, WS_SG = 466 * MiB, WS_H = 476 * MiB, WS_END = 548 * MiB;
constexpr int CW_BAR = 4096;
constexpr int LDS_BYTES = 163840;
constexpr int SCR_BYTES = 159 * 1024;
constexpr int MISC_OFF = SCR_BYTES;

typedef unsigned short bf16;
typedef unsigned v4u __attribute__((ext_vector_type(4)));
typedef unsigned v2u __attribute__((ext_vector_type(2)));
typedef float f32x4 __attribute__((ext_vector_type(4)));
typedef float f32x2 __attribute__((ext_vector_type(2)));

__device__ __forceinline__ float bf2f(unsigned short b) { return __uint_as_float((unsigned)b << 16); }
__device__ __forceinline__ float bflo(unsigned w) { return __uint_as_float(w << 16); }
__device__ __forceinline__ float bfhi(unsigned w) { return __uint_as_float(w & 0xffff0000u); }
typedef __bf16 bf16x2_t __attribute__((ext_vector_type(2)));
__device__ __forceinline__ unsigned pkbf(float lo, float hi) { f32x2 v = {lo, hi}; bf16x2_t b = __builtin_convertvector(v, bf16x2_t); return __builtin_bit_cast(unsigned, b); }
__device__ __forceinline__ float wave_sum(float v) {
#pragma unroll
    for (int o = 1; o < 64; o <<= 1) v += __shfl_xor(v, o);
    return v;
}
__device__ __forceinline__ float wave_max(float v) {
#pragma unroll
    for (int o = 1; o < 64; o <<= 1) v = fmaxf(v, __shfl_xor(v, o));
    return v;
}

struct Args {
    const float* x_p; const float* x_s; const float* cache_k; const float* cache_v; const float* cache_lf; const float* state_pool; const int* page_table;
    const float* norm_mix_g; const float* w_in; const float* b_forget; const float* q_norm_g; const float* k_norm_g; const float* pool_mix_w; const float* pool_scale;
    const float* w_bp; const float* w_ba; const float* w_out; const float* norm_ffn_g; const float* w_query; const float* sub_keys; const float* peer_u; const float* peer_v;
    float* out; unsigned char* ws; int ph_lo, ph_hi, li, pad;
};

using pg8::Unit;
struct EpiInProj {
    static constexpr bool PERM = true, AFTER_DRAIN = false, CHAIN = false;
    bf16 *U, *Q, *K, *V, *GA, *GB; float* out; const float *gq, *gk; int pn_off;
    __device__ __forceinline__ void operator()(const f32x4 (&acc)[2][2][4][2], const Unit& u, int wr, int wc, int fr, int fq) const {
        const int pn = u.pn + pn_off; const int row0 = u.pm * 256 + wr * 64 + fr; const bool prompt = u.pm < (MP / 256);
        if (pn < 2) {
#pragma unroll
            for (int ai = 0; ai < 2; ++ai)
#pragma unroll
                for (int m = 0; m < 4; ++m) { const int row = row0 + ai * 128 + m * 16;
                    float* tail = nullptr;
                    if (prompt) { const int s = row & (SEQ - 1), b = row >> 12; if (s >= SEQ - 15) tail = out + O_PP + (size_t)(b * 15 + (s - (SEQ - 15))) * DP; }
                    else { const int rs = row - MP; tail = out + O_PS + (size_t)((rs >> 3) * 15 + 7 + (rs & 7)) * DP; }
#pragma unroll
                    for (int bj = 0; bj < 2; ++bj) { const int col = pn * 256 + bj * 128 + wc * 32 + 8 * fq; const f32x4 v0 = acc[ai][bj][m][0], v1 = acc[ai][bj][m][1];
                        v4u w; w.x = pkbf(v0[0], v0[1]); w.y = pkbf(v0[2], v0[3]); w.z = pkbf(v1[0], v1[1]); w.w = pkbf(v1[2], v1[3]);
                        *(v4u*)(U + (size_t)row * DP + col) = w;
                        if (tail) { *(f32x4*)(tail + col) = v0; *(f32x4*)(tail + col + 4) = v1; } } }
        } else if (pn < 6) {
            const bool isq = pn < 4; const int head = 4 * (pn & 1) + wc; const float* g = isq ? gq : gk;
            f32x4 gv[2][2];
#pragma unroll
            for (int bj = 0; bj < 2; ++bj)
#pragma unroll
                for (int n = 0; n < 2; ++n) gv[bj][n] = *(const f32x4*)(g + 32 * bj + 8 * fq + 4 * n);
            bf16* dst = isq ? Q : K;
#pragma unroll
            for (int ai = 0; ai < 2; ++ai)
#pragma unroll
                for (int m = 0; m < 4; ++m) { const int row = row0 + ai * 128 + m * 16; float ss = 0.f;
#pragma unroll
                    for (int bj = 0; bj < 2; ++bj)
#pragma unroll
                        for (int n = 0; n < 2; ++n) { const f32x4 x = acc[ai][bj][m][n]; ss += (x[0] * x[0] + x[1] * x[1]) + (x[2] * x[2] + x[3] * x[3]); }
                    ss += __shfl_xor(ss, 16); ss += __shfl_xor(ss, 32);
                    float r = 1.0f / sqrtf(ss * (1.0f / 64.0f) + EPS);
                    float* kout = isq ? nullptr : (prompt ? out + O_KP + (size_t)row * DA : out + O_KS + (size_t)(row - MP) * DA);
                    const float rq = isq ? r * C2 : r;
#pragma unroll
                    for (int bj = 0; bj < 2; ++bj) { const int col = head * 64 + 32 * bj + 8 * fq; const f32x4 v0 = acc[ai][bj][m][0] * gv[bj][0] * rq, v1 = acc[ai][bj][m][1] * gv[bj][1] * rq;
                        v4u w; w.x = pkbf(v0[0], v0[1]); w.y = pkbf(v0[2], v0[3]); w.z = pkbf(v1[0], v1[1]); w.w = pkbf(v1[2], v1[3]);
                        *(v4u*)(dst + (size_t)row * DA + col) = w;
                        if (!isq) { __builtin_nontemporal_store(v0, (f32x4*)(kout + col)); __builtin_nontemporal_store(v1, (f32x4*)(kout + col + 4)); } } }
        } else if (pn < 8) {
#pragma unroll
            for (int ai = 0; ai < 2; ++ai)
#pragma unroll
                for (int m = 0; m < 4; ++m) { const int row = row0 + ai * 128 + m * 16;
                    float* vout = prompt ? out + O_VP + (size_t)row * DA : out + O_VS + (size_t)(row - MP) * DA;
#pragma unroll
                    for (int bj = 0; bj < 2; ++bj) { const int col = (pn - 6) * 256 + bj * 128 + wc * 32 + 8 * fq; const f32x4 v0 = acc[ai][bj][m][0], v1 = acc[ai][bj][m][1];
                        v4u w; w.x = pkbf(v0[0], v0[1]); w.y = pkbf(v0[2], v0[3]); w.z = pkbf(v1[0], v1[1]); w.w = pkbf(v1[2], v1[3]);
                        *(v4u*)(V + (size_t)row * DA + col) = w; __builtin_nontemporal_store(v0, (f32x4*)(vout + col)); __builtin_nontemporal_store(v1, (f32x4*)(vout + col + 4)); } }
        } else {
            bf16* dst = pn < 12 ? GA : GB; const int ct = (pn < 12 ? pn - 8 : pn - 12) * 256;
#pragma unroll
            for (int ai = 0; ai < 2; ++ai)
#pragma unroll
                for (int m = 0; m < 4; ++m) { const int row = row0 + ai * 128 + m * 16;
#pragma unroll
                    for (int bj = 0; bj < 2; ++bj) { const int col = ct + bj * 128 + wc * 32 + 8 * fq; float s[8];
#pragma unroll
                        for (int n = 0; n < 2; ++n)
#pragma unroll
                            for (int i = 0; i < 4; ++i) s[4 * n + i] = __builtin_amdgcn_rcpf(1.0f + __builtin_amdgcn_exp2f(-LOG2E * acc[ai][bj][m][n][i]));
                        v4u w; w.x = pkbf(s[0], s[1]); w.y = pkbf(s[2], s[3]); w.z = pkbf(s[4], s[5]); w.w = pkbf(s[6], s[7]);
                        *(v4u*)(dst + (size_t)row * DM + col) = w; } }
        }
    }
};
template <int MODE> struct EpiGate {
    static constexpr bool PERM = true, AFTER_DRAIN = false, CHAIN = false;
    const bf16* G; const bf16* Tin; bf16* O;
    __device__ __forceinline__ void operator()(const f32x4 (&acc)[2][2][4][2], const Unit& u, int wr, int wc, int fr, int fq) const {
        const int row0 = u.pm * 256 + wr * 64 + fr;
#pragma unroll
        for (int ai = 0; ai < 2; ++ai)
#pragma unroll
            for (int m = 0; m < 4; ++m) { const int row = row0 + ai * 128 + m * 16;
#pragma unroll
                for (int bj = 0; bj < 2; ++bj) { const size_t off = (size_t)row * DM + u.pn * 256 + bj * 128 + wc * 32 + 8 * fq;
                    const v4u g = *(const v4u*)(G + off); const f32x4 v0 = acc[ai][bj][m][0], v1 = acc[ai][bj][m][1];
                    float r[8] = {v0[0] * bflo(g.x), v0[1] * bfhi(g.x), v0[2] * bflo(g.y), v0[3] * bfhi(g.y), v1[0] * bflo(g.z), v1[1] * bfhi(g.z), v1[2] * bflo(g.w), v1[3] * bfhi(g.w)};
                    if (MODE == 1) { const v4u t = *(const v4u*)(Tin + off);
                        r[0] += bflo(t.x); r[1] += bfhi(t.x); r[2] += bflo(t.y); r[3] += bfhi(t.y); r[4] += bflo(t.z); r[5] += bfhi(t.z); r[6] += bflo(t.w); r[7] += bfhi(t.w); }
                    v4u w; w.x = pkbf(r[0], r[1]); w.y = pkbf(r[2], r[3]); w.z = pkbf(r[4], r[5]); w.w = pkbf(r[6], r[7]);
                    *(v4u*)(O + off) = w; } }
    }
};
struct EpiMerge {
    static constexpr bool PERM = true, AFTER_DRAIN = false, CHAIN = true;
    const bf16* GA; const bf16* GB; bf16* O;
    __device__ __forceinline__ void mid(f32x4 (&acc)[2][2][4][2], const Unit& u, int wr, int wc, int fr, int fq) const {
        const int row0 = u.pm * 256 + wr * 64 + fr;
#pragma unroll
        for (int ai = 0; ai < 2; ++ai)
#pragma unroll
            for (int m = 0; m < 4; ++m) { const int row = row0 + ai * 128 + m * 16;
#pragma unroll
                for (int bj = 0; bj < 2; ++bj) { const size_t off = (size_t)row * DM + u.pn * 256 + bj * 128 + wc * 32 + 8 * fq;
                    const v4u ga = *(const v4u*)(GA + off), gb = *(const v4u*)(GB + off);
                    const unsigned gaw[4] = {ga.x, ga.y, ga.z, ga.w}, gbw[4] = {gb.x, gb.y, gb.z, gb.w};
#pragma unroll
                    for (int k = 0; k < 4; ++k) { const float r0 = bflo(gaw[k]) * __builtin_amdgcn_rcpf(fmaxf(bflo(gbw[k]), 0x1p-60f)), r1 = bfhi(gaw[k]) * __builtin_amdgcn_rcpf(fmaxf(bfhi(gbw[k]), 0x1p-60f));
                        acc[ai][bj][m][k >> 1][2 * (k & 1)] *= r0; acc[ai][bj][m][k >> 1][2 * (k & 1) + 1] *= r1; } } }
    }
    __device__ __forceinline__ void operator()(const f32x4 (&acc)[2][2][4][2], const Unit& u, int wr, int wc, int fr, int fq) const {
        const int row0 = u.pm * 256 + wr * 64 + fr;
#pragma unroll
        for (int ai = 0; ai < 2; ++ai)
#pragma unroll
            for (int m = 0; m < 4; ++m) { const int row = row0 + ai * 128 + m * 16;
#pragma unroll
                for (int bj = 0; bj < 2; ++bj) { const size_t off = (size_t)row * DM + u.pn * 256 + bj * 128 + wc * 32 + 8 * fq;
                    const v4u gb = *(const v4u*)(GB + off); const unsigned gbw[4] = {gb.x, gb.y, gb.z, gb.w}; unsigned ow[4];
#pragma unroll
                    for (int k = 0; k < 4; ++k) ow[k] = pkbf(acc[ai][bj][m][k >> 1][2 * (k & 1)] * fmaxf(bflo(gbw[k]), 0x1p-60f), acc[ai][bj][m][k >> 1][2 * (k & 1) + 1] * fmaxf(bfhi(gbw[k]), 0x1p-60f));
                    *(v4u*)(O + off) = (v4u){ow[0], ow[1], ow[2], ow[3]}; } }
    }
};
struct EpiOut {
    static constexpr bool PERM = true, AFTER_DRAIN = false, CHAIN = false;
    const float* xp; const float* xs; float* H; bf16* HG; const float* gf; float* RSS;
    __device__ __forceinline__ void operator()(const f32x4 (&acc)[2][2][4][2], const Unit& u, int wr, int wc, int fr, int fq) const {
        const int row0 = u.pm * 256 + wr * 64 + fr; const bool prompt = u.pm < (MP / 256);
#pragma unroll
        for (int ai = 0; ai < 2; ++ai)
#pragma unroll
            for (int m = 0; m < 4; ++m) { const int row = row0 + ai * 128 + m * 16; float ss = 0.f;
                const float* xr = prompt ? xp + (size_t)row * DM : xs + (size_t)(row - MP) * DM;
#pragma unroll
                for (int bj = 0; bj < 2; ++bj) { const int col = u.pn * 256 + bj * 128 + wc * 32 + 8 * fq;
                    const f32x4 h0 = acc[ai][bj][m][0] + *(const f32x4*)(xr + col), h1 = acc[ai][bj][m][1] + *(const f32x4*)(xr + col + 4);
                    ss += (h0[0] * h0[0] + h0[1] * h0[1]) + (h0[2] * h0[2] + h0[3] * h0[3]) + (h1[0] * h1[0] + h1[1] * h1[1]) + (h1[2] * h1[2] + h1[3] * h1[3]);
                    v4u w; w.x = pkbf(h0[0], h0[1]); w.y = pkbf(h0[2], h0[3]); w.z = pkbf(h1[0], h1[1]); w.w = pkbf(h1[2], h1[3]);
                    *(v4u*)(HG + (size_t)row * DM + col) = w; }
                ss += __shfl_xor(ss, 16); ss += __shfl_xor(ss, 32);
                if (fq == 0) RSS[(size_t)row * 16 + u.pn * 4 + wc] = ss; }
    }
};

struct Frame {
    LAS unsigned char* lds; volatile LAS unsigned* MISC; gu32* ctl;
    int tid, lane, wave, vcu, G;
};

__device__ __forceinline__ void transpose_item(const float* W, int ldw, int K, bf16* WT, int src_col0, int dst_row0, int k0, LAS float* scr, int lane, const float* kscale = nullptr) {
#pragma unroll 8
    for (int i = 0; i < 32; ++i) { const int kk = 2 * i + (lane >> 5); const float wv = W[(size_t)(k0 + kk) * ldw + src_col0 + (lane & 31)]; scr[kk * 33 + (lane & 31)] = kscale ? wv * kscale[k0 + kk] : wv; }
    LDS_WAIT(); asm volatile("" ::: "memory");
    const int c = lane & 7;
#pragma unroll
    for (int j = 0; j < 4; ++j) { const int n = (lane >> 3) + 8 * j; const LAS float* s = scr + (8 * c) * 33 + n;
        v4u o; o.x = pkbf(s[0 * 33], s[1 * 33]); o.y = pkbf(s[2 * 33], s[3 * 33]); o.z = pkbf(s[4 * 33], s[5 * 33]); o.w = pkbf(s[6 * 33], s[7 * 33]);
        *(v4u*)(WT + (size_t)(dst_row0 + n) * K + k0 + 8 * c) = o; }
    LDS_WAIT(); asm volatile("" ::: "memory");
}
__device__ __forceinline__ int win_src_col(int db) {
    if (db < 16) return 32 * db;
    if (db < 48) { const int base = db < 32 ? 512 : 1024; const int local = (db - 16) & 15, tile = local >> 3, blk = local & 7, bj = blk >> 2, w = blk & 3; return base + tile * 256 + 64 * w + 32 * bj; }
    if (db < 64) return 1536 + 32 * (db - 48);
    if (db < 96) return 2056 + 32 * (db - 64);
    return 3080 + 32 * (db - 96);
}
__device__ __forceinline__ void cvt_rows_bf16(const float* src, bf16* dst, size_t n8, size_t gtid, size_t gn) {
    for (size_t i = gtid; i < n8; i += gn) { const f32x4 a = *(const f32x4*)(src + 8 * i), b = *(const f32x4*)(src + 8 * i + 4);
        v4u w; w.x = pkbf(a[0], a[1]); w.y = pkbf(a[2], a[3]); w.z = pkbf(b[0], b[1]); w.w = pkbf(b[2], b[3]); *(v4u*)(dst + 8 * i) = w; }
}
template <bool I8> __device__ __forceinline__ void cvt_rows_fp8(const float* src, unsigned char* dst, float* scl, int gw, int NGW, int lane, const float* colscale = nullptr) {
    for (int e0 = gw; e0 < NEXP; e0 += 2 * NGW) {
        f32x4 q[2][4]; float mx[2];
#pragma unroll
        for (int u = 0; u < 2; ++u) { const int e = (e0 + u * NGW < NEXP) ? e0 + u * NGW : e0; const float* r = src + (size_t)e * DM + 16 * lane;
            q[u][0] = *(const f32x4*)r; q[u][1] = *(const f32x4*)(r + 4); q[u][2] = *(const f32x4*)(r + 8); q[u][3] = *(const f32x4*)(r + 12);
            if (colscale) {
#pragma unroll
                for (int j = 0; j < 4; ++j) q[u][j] = q[u][j] * *(const f32x4*)(colscale + 16 * lane + 4 * j); } }
#pragma unroll
        for (int u = 0; u < 2; ++u) { float m = 0.f;
#pragma unroll
            for (int j = 0; j < 4; ++j) m = fmaxf(m, fmaxf(fmaxf(fabsf(q[u][j][0]), fabsf(q[u][j][1])), fmaxf(fabsf(q[u][j][2]), fabsf(q[u][j][3]))));
            mx[u] = m; }
#pragma unroll
        for (int o = 1; o < 64; o <<= 1) { mx[0] = fmaxf(mx[0], __shfl_xor(mx[0], o)); mx[1] = fmaxf(mx[1], __shfl_xor(mx[1], o)); }
#pragma unroll
        for (int u = 0; u < 2; ++u) { const int e = e0 + u * NGW; if (e < NEXP) {
            if constexpr (I8) {
                float best = 1.0f, berr = 3.0e38f;
#pragma unroll
                for (int ci = 0; ci < 5; ++ci) { const float rho = 1.0f - 0.1f * ci, cs = mx[u] > 1e-30f ? 7.0f / (rho * mx[u]) : 0.f, ics = rho * mx[u] * (1.0f / 7.0f); float er = 0.f;
#pragma unroll
                    for (int j = 0; j < 4; ++j)
#pragma unroll
                        for (int i = 0; i < 4; ++i) { const float x = q[u][j][i], d = x - ics * __builtin_amdgcn_fmed3f(rintf(x * cs), -7.0f, 7.0f); er += d * d; }
#pragma unroll
                    for (int o = 1; o < 64; o <<= 1) er += __shfl_xor(er, o);
                    if (er < berr) { berr = er; best = rho; } }
                const float cm = best * mx[u], sc = cm > 1e-30f ? 7.0f / cm : 0.f, isc = cm * (1.0f / 112.0f);
                unsigned w[2] = {0u, 0u};
#pragma unroll
                for (int j = 0; j < 4; ++j)
#pragma unroll
                    for (int i = 0; i < 4; i += 2) { const int qe = (int)__builtin_amdgcn_fmed3f(rintf(q[u][j][i] * sc), -7.0f, 7.0f), qo = (int)__builtin_amdgcn_fmed3f(rintf(q[u][j][i + 1] * sc), -7.0f, 7.0f);
                        const unsigned byte = (((unsigned)qo & 15u) << 4) | ((unsigned)(qe + 8) & 15u); const int t = 2 * j + (i >> 1); w[t >> 2] |= byte << (8 * (t & 3)); }
                *(v2u*)(dst + (size_t)(lane >> 4) * ((size_t)NEXP * 128) + (size_t)e * 128 + 8 * (lane & 15)) = (v2u){w[0], w[1]};
                if (lane == 0) scl[e] = isc;
                continue; }
            } }
    }
}
__device__ __forceinline__ void p0_prologue(Frame& F, const Args& a) {
    unsigned char* ws = a.ws;
    LAS float* scr = (LAS float*)(F.lds + F.wave * 16384);
    const int gw = F.vcu * NWAVES + F.wave, NGW = F.G * NWAVES;
    for (int it = gw; it < 4096; it += NGW) {
        int r = it;
        if (r < 2048) { const int kb = r >> 7, db = r & 127; transpose_item(a.w_in, DIN, DM, (bf16*)(ws + WS_WIN), win_src_col(db), 32 * db, 64 * kb, scr, F.lane); continue; } r -= 2048;
        if (r < 256) { continue; } r -= 256;
        if (r < 256) { const int kb = r >> 5, nb = r & 31; transpose_item(a.w_ba, DM, DA, (bf16*)(ws + WS_WBA), 32 * nb, 32 * nb, 64 * kb, scr, F.lane); continue; } r -= 256;
        if (r < 512) { const int kb = r >> 5, nb = r & 31; transpose_item(a.w_out, DM, DM, (bf16*)(ws + WS_WOUT), 32 * nb, 32 * nb, 64 * kb, scr, F.lane); continue; } r -= 512;
        { const int kb = r >> 6, nb = r & 63; transpose_item(a.w_query, DQ, DM, (bf16*)(ws + WS_WQ), 32 * nb, 32 * nb, 64 * kb, scr, F.lane, a.norm_ffn_g); }
    }
    for (int it = gw; it < 16 * 4 * 16; it += NGW) { const int nb = it & 15, g = (it >> 4) & 3, cb = it >> 6; const int nn = 64 * nb + F.lane; float acc8[8];
#pragma unroll
        for (int i = 0; i < 8; ++i) acc8[i] = 0.f;
        const float* pm = a.pool_mix_w + (size_t)g * 16384 + (size_t)(8 * cb) * 128;
#pragma unroll 16
        for (int d = 0; d < 128; ++d) { const float wv = a.w_bp[(size_t)(g * 128 + d) * DM + nn] * a.pool_scale[g * 128 + d];
#pragma unroll
            for (int i = 0; i < 8; ++i) acc8[i] += pm[i * 128 + d] * wv; }
        v4u o; o.x = pkbf(acc8[0], acc8[1]); o.y = pkbf(acc8[2], acc8[3]); o.z = pkbf(acc8[4], acc8[5]); o.w = pkbf(acc8[6], acc8[7]);
        *(v4u*)((bf16*)(ws + WS_WBP) + (size_t)nn * DP + g * 128 + 8 * cb) = o; }
    { const size_t gtid = (size_t)F.vcu * NTHR + F.tid, gn = (size_t)F.G * NTHR;
      cvt_rows_fp8<true>(a.peer_u, ws + WS_PU, (float*)(ws + WS_US), gw, NGW, F.lane, a.norm_ffn_g);
      cvt_rows_fp8<true>(a.peer_v, ws + WS_PV, (float*)(ws + WS_VS), gw, NGW, F.lane);
      cvt_rows_bf16(a.sub_keys, (bf16*)(ws + WS_SUBK), (size_t)PH * 2 * NKEYS * DKH / 8, gtid, gn);
      for (size_t i = gtid; i < (size_t)DB * 7 * DP; i += gn) { const int b = (int)(i / (7 * DP)), j = (int)((i / DP) % 7), c = (int)(i % DP);
          a.out[O_PS + (size_t)(b * 15 + j) * DP + c] = a.state_pool[(size_t)(b * 15 + 8 + j) * DP + c]; } }
    __syncthreads();
    LAS float* wfT = (LAS float*)F.lds;
    for (int i = F.tid; i < 8 * DM; i += NTHR) { const int col = i >> 3, h = i & 7; wfT[h * DM + col] = a.w_in[(size_t)col * DIN + 2048 + h]; }
    __syncthreads();
    bf16* XN = (bf16*)(ws + WS_XN);
    for (int row0 = gw; row0 < M; row0 += 2 * NGW) {
        f32x4 v[2][4]; float rr[2], f[2][8]; bool ok[2];
#pragma unroll
        for (int u = 0; u < 2; ++u) { const int row = row0 + u * NGW; ok[u] = row < M; const int rc = ok[u] ? row : row0;
            const float* xr = rc < MP ? a.x_p + (size_t)rc * DM : a.x_s + (size_t)(rc - MP) * DM;
#pragma unroll
            for (int j = 0; j < 4; ++j) v[u][j] = *(const f32x4*)(xr + 256 * j + 4 * F.lane); }
#pragma unroll
        for (int u = 0; u < 2; ++u) { float ss = 0.f;
#pragma unroll
            for (int j = 0; j < 4; ++j) ss += (v[u][j][0] * v[u][j][0] + v[u][j][1] * v[u][j][1]) + (v[u][j][2] * v[u][j][2] + v[u][j][3] * v[u][j][3]);
            rr[u] = ss; }
#pragma unroll
        for (int o = 1; o < 64; o <<= 1) { rr[0] += __shfl_xor(rr[0], o); rr[1] += __shfl_xor(rr[1], o); }
#pragma unroll
        for (int u = 0; u < 2; ++u) { const int row = ok[u] ? row0 + u * NGW : row0; const float r = 1.0f / sqrtf(rr[u] * (1.0f / DM) + EPS);
#pragma unroll
            for (int h = 0; h < 8; ++h) f[u][h] = 0.f;
#pragma unroll
            for (int j = 0; j < 4; ++j) { const f32x4 g = *(const f32x4*)(a.norm_mix_g + 256 * j + 4 * F.lane); v[u][j] = v[u][j] * r * g;
                v2u w; w.x = pkbf(v[u][j][0], v[u][j][1]); w.y = pkbf(v[u][j][2], v[u][j][3]); if (ok[u]) *(v2u*)(XN + (size_t)row * DM + 256 * j + 4 * F.lane) = w;
#pragma unroll
                for (int h = 0; h < 8; ++h) { const f32x4 wv = *(const LAS f32x4*)(wfT + h * DM + 256 * j + 4 * F.lane); f[u][h] += (v[u][j][0] * wv[0] + v[u][j][1] * wv[1]) + (v[u][j][2] * wv[2] + v[u][j][3] * wv[3]); } } }
#pragma unroll
        for (int u = 0; u < 2; ++u) { const int row = row0 + u * NGW;
            const bool b4 = (F.lane & 4) != 0, b2 = (F.lane & 2) != 0, b1 = (F.lane & 1) != 0; float t4[4], t2[2];
#pragma unroll
            for (int k = 0; k < 4; ++k) { const float keep = b4 ? f[u][4 + k] : f[u][k], send = b4 ? f[u][k] : f[u][4 + k]; t4[k] = keep + __shfl_xor(send, 4); }
#pragma unroll
            for (int k = 0; k < 2; ++k) { const float keep = b2 ? t4[2 + k] : t4[k], send = b2 ? t4[k] : t4[2 + k]; t2[k] = keep + __shfl_xor(send, 2); }
            float t1 = (b1 ? t2[1] : t2[0]) + __shfl_xor(b1 ? t2[0] : t2[1], 1);
            t1 += __shfl_xor(t1, 8); t1 += __shfl_xor(t1, 16); t1 += __shfl_xor(t1, 32);
            if (F.lane < 8 && ok[u]) { const float z = t1 + a.b_forget[F.lane]; const float lf = fminf(z, 0.f) - log1pf(expf(-fabsf(z)));
                if (row < MP) a.out[O_LFP + (size_t)row * NH + F.lane] = lf; else a.out[O_LFS + (size_t)(row - MP) * NH + F.lane] = lf; } }
    }
}

template <int W> __device__ __forceinline__ void p2_item(const Args& a, unsigned char* ws, int row, int ch) {
    const bf16* U = (const bf16*)(ws + WS_U); bf16* PO = (bf16*)(ws + WS_PO);
    float e[W][8]; float cnt;
    if (row < MP) { const int s = row & (SEQ - 1); cnt = (float)(s + 1 < W ? s + 1 : W);
#pragma unroll
        for (int i = 0; i < W; ++i) { v4u q = (v4u){0u, 0u, 0u, 0u}; if (s - i >= 0) q = *(const v4u*)(U + (size_t)(row - i) * DP + ch);
            e[i][0] = bflo(q.x); e[i][1] = bfhi(q.x); e[i][2] = bflo(q.y); e[i][3] = bfhi(q.y); e[i][4] = bflo(q.z); e[i][5] = bfhi(q.z); e[i][6] = bflo(q.w); e[i][7] = bfhi(q.w); }
    } else { const int rs = row - MP, b = rs >> 3, t = rs & 7; cnt = (float)W;
#pragma unroll
        for (int i = 0; i < W; ++i) { const int tt = t - i;
            if (tt >= 0) { const v4u q = *(const v4u*)(U + (size_t)(MP + b * 8 + tt) * DP + ch);
                e[i][0] = bflo(q.x); e[i][1] = bfhi(q.x); e[i][2] = bflo(q.y); e[i][3] = bfhi(q.y); e[i][4] = bflo(q.z); e[i][5] = bfhi(q.z); e[i][6] = bflo(q.w); e[i][7] = bfhi(q.w); }
            else { const f32x4 p0 = *(const f32x4*)(a.state_pool + (size_t)(b * 15 + 15 + tt) * DP + ch), p1 = *(const f32x4*)(a.state_pool + (size_t)(b * 15 + 15 + tt) * DP + ch + 4);
                e[i][0] = p0[0]; e[i][1] = p0[1]; e[i][2] = p0[2]; e[i][3] = p0[3]; e[i][4] = p1[0]; e[i][5] = p1[1]; e[i][6] = p1[2]; e[i][7] = p1[3]; } } }
    const float inv = 1.0f / cnt; float mm[8];
#pragma unroll
    for (int k = 0; k < 8; ++k) { float sum = 0.f;
#pragma unroll
        for (int i = 0; i < W; ++i) sum += e[i][k];
        mm[k] = sum * inv - e[0][k]; }
    v4u o; o.x = pkbf(mm[0], mm[1]); o.y = pkbf(mm[2], mm[3]); o.z = pkbf(mm[4], mm[5]); o.w = pkbf(mm[6], mm[7]);
    *(v4u*)(PO + (size_t)row * DP + ch) = o;
}
__device__ __forceinline__ void p1_cumsum(Frame& F, const Args& a) {
    unsigned char* ws = a.ws;
    { const int gw = ((int)blockIdx.x - ((int)F.G - (NB * NH) / NWAVES)) * NWAVES + F.wave; float* CP2 = (float*)(ws + WS_CP2);
      if (gw >= 0 && gw < NB * NH) { const int b = gw >> 3, h = gw & 7; float carry = 0.f;
          for (int c = 0; c < SEQ / 64; ++c) { float v = a.out[O_LFP + (size_t)(b * SEQ + c * 64 + F.lane) * NH + h];
#pragma unroll
              for (int o = 1; o < 64; o <<= 1) { const float t = __shfl_up(v, o); if (F.lane >= o) v += t; }
              v += carry; CP2[(size_t)gw * SEQ + c * 64 + F.lane] = v * LOG2E; carry = __shfl(v, 63); } } }
}
__device__ __forceinline__ void p2_cumsum_pool(Frame& F, const Args& a) {
    unsigned char* ws = a.ws;
    const int nfree = F.G > 2 * (M / 256) ? F.G - M / 256 : F.G, myslot = F.G > 2 * (M / 256) ? (int)blockIdx.x - M / 256 : (int)blockIdx.x;
    if (myslot >= 0)
    for (int item = myslot * NTHR + F.tid; item < M * 64; item += nfree * NTHR) {
        const int wv = item >> 6, g = wv & 3, row = 4 * (wv >> 2) + ((item >> 4) & 3), ch = g * 128 + (item & 15) * 8;
        if (g == 0) p2_item<2>(a, ws, row, ch); else if (g == 1) p2_item<4>(a, ws, row, ch); else if (g == 2) p2_item<8>(a, ws, row, ch); else p2_item<16>(a, ws, row, ch);
    }
}

__device__ __forceinline__ float attn_bound2(const Args& a, int lane) {
    asm volatile("" : "+v"(lane));
    const float gq = wave_max(fabsf(a.q_norm_g[lane])), gk = wave_max(fabsf(a.k_norm_g[lane]));
    return 64.0f * C2 * gq * gk * 1.03f;
}

typedef float f32x16 __attribute__((ext_vector_type(16)));
typedef short bf16x8v __attribute__((ext_vector_type(8)));
__device__ __forceinline__ int f2key(float s) { int b = __builtin_bit_cast(int, s); return b ^ ((b >> 31) & 0x7fffffff); }
__device__ __forceinline__ float key2f(int k) { return __builtin_bit_cast(float, k ^ ((k >> 31) & 0x7fffffff)); }
#define CE_DESC(x, y) do { const int mx_ = (x) > (y) ? (x) : (y), mn_ = (x) > (y) ? (y) : (x); (x) = mx_; (y) = mn_; } while (0)
template <int OFF, int N, typename T> __device__ __forceinline__ void bsort_desc(T& v) {
#pragma unroll
    for (int k = 2; k <= N; k <<= 1)
#pragma unroll
        for (int j = k >> 1; j > 0; j >>= 1)
#pragma unroll
            for (int i = 0; i < N; ++i) { const int l = i ^ j; if (l > i) { if ((i & k) == 0) CE_DESC(v[OFF + i], v[OFF + l]); else CE_DESC(v[OFF + l], v[OFF + i]); } }
}
template <int OFF, typename T> __device__ __forceinline__ void bmerge16_desc(T& v) {
#pragma unroll
    for (int j = 8; j > 0; j >>= 1)
#pragma unroll
        for (int i = 0; i < 16; ++i) { const int l = i ^ j; if (l > i) CE_DESC(v[OFF + i], v[OFF + l]); }
}
template <int OA, int OB, typename T> __device__ __forceinline__ void top16_merge(T& v) {
#pragma unroll
    for (int i = 0; i < 16; ++i) v[OA + i] = v[OA + i] > v[OB + 15 - i] ? v[OA + i] : v[OB + 15 - i];
    bmerge16_desc<OA>(v);
}
template <typename T> __device__ __forceinline__ void top16_of_64(T& v) {
    bsort_desc<0, 16>(v); bsort_desc<16, 16>(v); bsort_desc<32, 16>(v); bsort_desc<48, 16>(v);
    top16_merge<0, 16>(v); top16_merge<32, 48>(v); top16_merge<0, 32>(v);
}
__device__ __forceinline__ void p7_topk(Frame& F, const Args& a) {
    unsigned char* ws = a.ws;
    const bf16* PQ = (const bf16*)(ws + WS_PQ); const bf16* SK = (const bf16*)(ws + WS_SUBK); const float* RSS = (const float*)(ws + WS_RSS);
    int* SI = (int*)(ws + WS_SI); float* SG = (float*)(ws + WS_SG);
    const int lane = F.lane, j = lane & 31, hi = lane >> 5;
    constexpr int KROW = 272, KMAT = 128 * KROW;
    LAS unsigned char* kl = F.lds; LAS unsigned* ib = (LAS unsigned*)(F.lds + 2 * KMAT + F.wave * 1024);
    const int h = F.vcu & 7, wi = F.vcu >> 3, nwh = (F.G - h + 7) >> 3;
    __syncthreads();
    for (int i = F.tid; i < 2 * 128 * 16; i += NTHR) { const int p = i >> 11, n = (i >> 4) & 127, c = i & 15; *(LAS v4u*)(kl + p * KMAT + n * KROW + 16 * c) = *(const v4u*)(SK + ((size_t)(h * 2 + p) * NKEYS + n) * DKH + 8 * c); }
    __syncthreads();
    const bool grp = (F.G == 256);
    const int gx = F.vcu >> 5, wl = (F.vcu >> 3) & 3;
    for (int lt = (grp ? wl : wi) * NWAVES + F.wave; lt < (grp ? 68 : M / 32); lt += (grp ? 4 : nwh) * NWAVES) {
        const int tile = grp ? (lt < 64 ? 64 * gx + lt : 512 + 4 * gx + (lt - 64)) : lt;
        const int row0 = tile * 32;
        int jl = j, hl = hi; asm volatile("" : "+v"(jl), "+v"(hl));
        int top[2][16];
#pragma unroll
        for (int p = 0; p < 2; ++p) {
            bf16x8v qf[8];
#pragma unroll
            for (int ks = 0; ks < 8; ++ks) qf[ks] = *(const bf16x8v*)(PQ + (size_t)(row0 + jl) * DQ + h * 256 + p * 128 + 16 * ks + 8 * hl);
            f32x16 acc[4];
#pragma unroll
            for (int mt = 0; mt < 4; ++mt) acc[mt] = f32x16{};
            const LAS unsigned char* kb = kl + p * KMAT + jl * KROW + 16 * hl;
#pragma unroll
            for (int ks = 0; ks < 8; ++ks)
#pragma unroll
                for (int mt = 0; mt < 4; ++mt) { const bf16x8v af = *(const LAS bf16x8v*)(kb + mt * 32 * KROW + ks * 32); acc[mt] = __builtin_amdgcn_mfma_f32_32x32x16_bf16(af, qf[ks], acc[mt], 0, 0, 0); }
            int v[64];
#pragma unroll
            for (int mt = 0; mt < 4; ++mt)
#pragma unroll
                for (int r = 0; r < 16; ++r) { const int n = 32 * mt + (r & 3) + 8 * (r >> 2) + 4 * hi; v[16 * mt + r] = (f2key(acc[mt][r]) & ~127) | (127 - n); }
            top16_of_64(v);
#pragma unroll
            for (int i = 0; i < 16; ++i) top[p][i] = v[i];
        }
        int S[32];
#pragma unroll
        for (int i = 0; i < 16; ++i) { auto rr = __builtin_amdgcn_permlane32_swap((unsigned)top[0][i], (unsigned)top[1][i], false, false); S[i] = (int)rr[0]; S[16 + i] = (int)rr[1]; }
        top16_merge<0, 16>(S);
        { unsigned w0 = 0, w1 = 0, w2 = 0, w3 = 0;
#pragma unroll
          for (int i = 0; i < 4; ++i) { w0 |= (unsigned)(127 - (S[i] & 127)) << (8 * i); w1 |= (unsigned)(127 - (S[4 + i] & 127)) << (8 * i); w2 |= (unsigned)(127 - (S[8 + i] & 127)) << (8 * i); w3 |= (unsigned)(127 - (S[12 + i] & 127)) << (8 * i); }
          *(LAS v4u*)(ib + (hi * 32 + j) * 4) = (v4u){w0, w1, w2, w3}; }
        float s1[16], s2[16];
#pragma unroll
        for (int i = 0; i < 16; ++i) { auto rr = __builtin_amdgcn_permlane32_swap((unsigned)S[i], (unsigned)S[i], false, false); s1[i] = key2f((int)rr[0] & ~127); s2[i] = key2f((int)rr[1] & ~127); }
        int c[64]; { int n = 0;
#pragma unroll
          for (int ca = 0; ca < 16; ++ca)
#pragma unroll
              for (int cb = 0; cb < 16; ++cb) if ((ca + 1) * (cb + 1) <= 16) { c[n] = (f2key(s1[ca] + s2[cb]) & ~255) | (255 - (ca * 16 + cb)); ++n; }
#pragma unroll
          for (int q = 50; q < 64; ++q) c[q] = (int)0x80000000; }
        top16_of_64(c);
        float ssq = 0.f;
#pragma unroll
        for (int q = 0; q < 4; ++q) { const f32x4 t4 = *(const f32x4*)(RSS + (size_t)(row0 + j) * 16 + 4 * q); ssq += (t4[0] + t4[1]) + (t4[2] + t4[3]); }
        const float rstd = 1.0f / sqrtf(ssq * (1.0f / DM) + EPS);
        const float z0 = key2f(c[0] & ~255) * rstd; float e[16], esum = 0.f;
#pragma unroll
        for (int k = 0; k < 16; ++k) { e[k] = __expf(key2f(c[k] & ~255) * rstd - z0); esum += e[k]; }
        const float inv = 1.0f / esum;
        LDS_WAIT(); asm volatile("" ::: "memory");
        const LAS unsigned char* ib8 = (const LAS unsigned char*)ib;
        int oi[8]; float og[8];
#pragma unroll
        for (int k = 0; k < 8; ++k) { const int ck = hi ? c[8 + k] : c[k]; const float ek = hi ? e[8 + k] : e[k]; const int fl = 255 - (ck & 255);
            const int i1 = ib8[(0 * 32 + j) * 16 + (fl >> 4)], i2 = ib8[(1 * 32 + j) * 16 + (fl & 15)]; oi[k] = i1 * NKEYS + i2; og[k] = ek * inv; }
        { int* sp = SI + (size_t)(row0 + j) * 128 + h * 16 + hi * 8; float* gp = SG + (size_t)(row0 + j) * 128 + h * 16 + hi * 8;
          *(v4u*)sp = (v4u){(unsigned)oi[0], (unsigned)oi[1], (unsigned)oi[2], (unsigned)oi[3]}; *(v4u*)(sp + 4) = (v4u){(unsigned)oi[4], (unsigned)oi[5], (unsigned)oi[6], (unsigned)oi[7]};
          *(f32x4*)gp = (f32x4){og[0], og[1], og[2], og[3]}; *(f32x4*)(gp + 4) = (f32x4){og[4], og[5], og[6], og[7]}; }
        LDS_WAIT(); asm volatile("" ::: "memory");
    }
}


constexpr int P8_SW = 128;
#define FP8X2(wd, hi_) __builtin_amdgcn_cvt_pk_f32_fp8((int)(wd), (hi_))
constexpr int P8_T = 68;
static_assert(M % P8_T == 0, "P8 chunking");
__device__ __forceinline__ void p8_gather(Frame& F, const Args& a) {
    unsigned char* ws = a.ws;
    const bf16* HG = (const bf16*)(ws + WS_XN); const unsigned char* PU = ws + WS_PU; const unsigned char* PV = ws + WS_PV; const float* US = (const float*)(ws + WS_US); const float* VS = (const float*)(ws + WS_VS);
    const float* RSS = (const float*)(ws + WS_RSS); const int* SI = (const int*)(ws + WS_SI); const float* SG = (const float*)(ws + WS_SG);
    float* Y = a.out + O_YP; unsigned char* HQ = ws + WS_Q;
    LAS unsigned short* ix = (LAS unsigned short*)F.lds;
    LAS float* wt = (LAS float*)(F.lds + P8_T * 128 * 2);
    LAS float* zp = (LAS float*)(F.lds + P8_T * 128 * 6);
    LAS float* rs = (LAS float*)(F.lds + P8_T * 128 * 10);
    LAS float* hs = (LAS float*)(F.lds + P8_T * 128 * 10 + 512);
    LAS float* wsc = (LAS float*)(F.lds + P8_T * 128 * 10 + 1024);
    LAS unsigned char* wq = F.lds + P8_T * 128 * 10 + 2048;
    int lane = F.lane; asm volatile("" : "+v"(lane));
    const int g = lane >> 3, c8 = lane & 7;
    const bool grp = (F.G == 256);
    for (int sup = F.vcu; sup < M / P8_T; sup += F.G) {
        const int tb = grp ? 2048 * (F.vcu >> 5) + 64 * (F.vcu & 31) : sup * P8_T, tb2 = grp ? MP + 128 * (F.vcu >> 5) + 4 * (F.vcu & 31) - 64 : tb;
#define P8_ROW(lt_) (((lt_) < 64 ? tb : tb2) + (lt_))
        __syncthreads();
        for (int i = F.tid; i < P8_T * 128; i += NTHR) { const size_t src = (size_t)P8_ROW(i >> 7) * 128 + (i & 127); ix[i] = (unsigned short)SI[src]; wt[i] = SG[src]; zp[i] = 0.f; }
        if (F.tid < P8_T) { float s = 0.f; for (int k = 0; k < 16; ++k) s += RSS[(size_t)P8_ROW(F.tid) * 16 + k]; rs[F.tid] = 1.0f / sqrtf(s * (1.0f / DM) + EPS); }
        for (int lt = F.wave; lt < P8_T; lt += NWAVES) { const bf16* hr = HG + (size_t)P8_ROW(lt) * DM + 16 * lane; const v4u ha = *(const v4u*)hr, hb2 = *(const v4u*)(hr + 8);
            const unsigned hp[8] = {ha.x, ha.y, ha.z, ha.w, hb2.x, hb2.y, hb2.z, hb2.w}; float hv[16], m = 0.f;
#pragma unroll
            for (int k = 0; k < 8; ++k) { hv[2 * k] = bflo(hp[k]); hv[2 * k + 1] = bfhi(hp[k]); m = fmaxf(m, fmaxf(fabsf(hv[2 * k]), fabsf(hv[2 * k + 1]))); }
#pragma unroll
            for (int o = 1; o < 64; o <<= 1) m = fmaxf(m, __shfl_xor(m, o));
            const float sc = m > 1e-30f ? 127.0f / m : 0.f; unsigned qw[4];
            unsigned qe[2] = {0u, 0u}, qo[2] = {0u, 0u};
#pragma unroll
            for (int t = 0; t < 8; ++t) { const int ie = (int)rintf(hv[2 * t] * sc), io = (int)rintf(hv[2 * t + 1] * sc); qe[t >> 2] |= ((unsigned)ie & 255u) << (8 * (t & 3)); qo[t >> 2] |= ((unsigned)io & 255u) << (8 * (t & 3)); }
            unsigned char* hq = HQ + (size_t)P8_ROW(lt) * DM + (lane >> 4) * 256 + 8 * (lane & 15);
            *(v2u*)hq = (v2u){qe[0], qe[1]}; *(v2u*)(hq + 128) = (v2u){qo[0], qo[1]};
            if (lane == 0) hs[lt] = m * (1.0f / 127.0f); }
        asm volatile("s_waitcnt vmcnt(0)" ::: "memory");
        __syncthreads();
        if (F.tid == 0) { __builtin_amdgcn_fence(__ATOMIC_ACQUIRE, "agent"); asm volatile("s_waitcnt vmcnt(0)" ::: "memory"); }
        __syncthreads();
        for (int s = 0; s < 4; ++s) {
            __syncthreads();
            int cl = c8; asm volatile("" : "+v"(cl));
            const unsigned char* pus = PU + (size_t)s * ((size_t)NEXP * P8_SW) + 16 * cl;
#pragma unroll 1
            for (int lt = F.wave; lt < P8_T; lt += NWAVES) {
                const unsigned char* hq = HQ + (size_t)P8_ROW(lt) * DM + 256 * s + 16 * cl;
                const v4u h0 = *(const v4u*)hq, h1 = *(const v4u*)(hq + 128);
                const int he[4] = {(int)h0.x, (int)h0.y, (int)h0.z, (int)h0.w}, ho[4] = {(int)h1.x, (int)h1.y, (int)h1.z, (int)h1.w};
                int hsum = 0;
#pragma unroll
                for (int jj = 0; jj < 4; ++jj) hsum = __builtin_amdgcn_sdot4(he[jj], 0x01010101, hsum, false);
                const int dl0 = -8 * hsum;
                const v4u ea = *(const LAS v4u*)(ix + lt * 128 + g * 16), eb = *(const LAS v4u*)(ix + lt * 128 + g * 16 + 8);
                const unsigned ew[8] = {ea.x, ea.y, ea.z, ea.w, eb.x, eb.y, eb.z, eb.w};
                v4u r[16];
#pragma unroll
                for (int i = 0; i < 16; ++i) { const unsigned e = (i & 1) ? (ew[i >> 1] >> 16) : (ew[i >> 1] & 0xffffu); r[i] = *(const v4u*)(pus + (size_t)e * P8_SW); }
                int acc[16];
#pragma unroll
                for (int i = 0; i < 16; ++i) { const unsigned wd[4] = {r[i].x, r[i].y, r[i].z, r[i].w}; int dh = 0, dl = dl0;
#pragma unroll
                    for (int jj = 0; jj < 4; ++jj) { dh = __builtin_amdgcn_sdot4((int)(wd[jj] & 0xf0f0f0f0u), ho[jj], dh, false); dl = __builtin_amdgcn_sdot4((int)(wd[jj] & 0x0f0f0f0fu), he[jj], dl, false); }
                    acc[i] = dh + (dl << 4); }
                int v8[8], v4[4], v2[2]; const bool b4 = (c8 & 4) != 0, b2 = (c8 & 2) != 0, b1 = (c8 & 1) != 0;
#pragma unroll
                for (int j2 = 0; j2 < 8; ++j2) { const int keep = b4 ? acc[8 + j2] : acc[j2], send = b4 ? acc[j2] : acc[8 + j2]; v8[j2] = keep + __shfl_xor(send, 4); }
#pragma unroll
                for (int j2 = 0; j2 < 4; ++j2) { const int keep = b2 ? v8[4 + j2] : v8[j2], send = b2 ? v8[j2] : v8[4 + j2]; v4[j2] = keep + __shfl_xor(send, 2); }
#pragma unroll
                for (int j2 = 0; j2 < 2; ++j2) { const int keep = b1 ? v4[2 + j2] : v4[j2], send = b1 ? v4[j2] : v4[2 + j2]; v2[j2] = keep + __shfl_xor(send, 1); }
                LAS f32x2* zq = (LAS f32x2*)(zp + lt * 128 + g * 16 + 2 * c8); const f32x2 z0 = *zq; *zq = (f32x2){z0[0] + (float)v2[0], z0[1] + (float)v2[1]};
            }
        }
        for (int lt = F.wave; lt < P8_T; lt += NWAVES) {
            const float r = rs[lt]; const int kk = lt * 128 + g * 16 + 2 * c8; LAS float* wp = wt + kk; const f32x2 gt = *(const LAS f32x2*)wp; const f32x2 zz = *(const LAS f32x2*)(zp + kk);
            const int e0 = ix[kk], e1 = ix[kk + 1];
            const float rh = r * hs[lt]; const float z0 = zz[0] * rh * US[e0], z1 = zz[1] * rh * US[e1];
            const float a0 = 0.5f * z0 * (1.0f + erff(z0 * 0.70710678118654752f)), a1 = 0.5f * z1 * (1.0f + erff(z1 * 0.70710678118654752f));
            const float w0 = gt[0] * a0 * VS[e0], w1 = gt[1] * a1 * VS[e1]; float mw = fmaxf(fabsf(w0), fabsf(w1));
#pragma unroll
            for (int o = 1; o < 64; o <<= 1) mw = fmaxf(mw, __shfl_xor(mw, o));
            const float wsq = mw > 1e-30f ? 127.0f / mw : 0.f; const int q0 = (int)rintf(w0 * wsq), q1 = (int)rintf(w1 * wsq);
            *(LAS unsigned short*)(wq + kk) = (unsigned short)(((unsigned)q0 & 255u) | (((unsigned)q1 & 255u) << 8));
            if (lane == 0) wsc[lt] = mw * (1.0f / 127.0f); }
        LDS_WAIT(); asm volatile("" ::: "memory");
        for (int s = 0; s < 4; ++s) {
            __syncthreads();
            int cl = c8; asm volatile("" : "+v"(cl));
            const unsigned char* pvs = PV + (size_t)s * ((size_t)NEXP * P8_SW) + 16 * cl;
#pragma unroll 1
            for (int lt = F.wave; lt < P8_T; lt += NWAVES) {
                const v4u ea = *(const LAS v4u*)(ix + lt * 128 + g * 16), eb = *(const LAS v4u*)(ix + lt * 128 + g * 16 + 8);
                const unsigned ew[8] = {ea.x, ea.y, ea.z, ea.w, eb.x, eb.y, eb.z, eb.w};
                v4u r[16];
#pragma unroll
                for (int i = 0; i < 16; ++i) { const unsigned e = (i & 1) ? (ew[i >> 1] >> 16) : (ew[i >> 1] & 0xffffu); r[i] = *(const v4u*)(pvs + (size_t)e * P8_SW); }
                const v4u wq4 = *(const LAS v4u*)(wq + lt * 128 + g * 16); const int Wg[4] = {(int)wq4.x, (int)wq4.y, (int)wq4.z, (int)wq4.w};
                int sw = 0;
#pragma unroll
                for (int G = 0; G < 4; ++G) sw = __builtin_amdgcn_sdot4(Wg[G], 0x01010101, sw, false);
                int acc[32];
#pragma unroll
                for (int c = 0; c < 32; ++c) acc[c] = -8 * sw;
#pragma unroll
                for (int G = 0; G < 4; ++G)
#pragma unroll
                    for (int jj = 0; jj < 4; ++jj) {
                        const unsigned A = r[4 * G][jj], B = r[4 * G + 1][jj], C = r[4 * G + 2][jj], D = r[4 * G + 3][jj];
                        const unsigned t0 = __builtin_amdgcn_perm(B, A, 0x05010400u), t1 = __builtin_amdgcn_perm(B, A, 0x07030602u), t2 = __builtin_amdgcn_perm(D, C, 0x05010400u), t3 = __builtin_amdgcn_perm(D, C, 0x07030602u);
                        const unsigned T[4] = {__builtin_amdgcn_perm(t2, t0, 0x05040100u), __builtin_amdgcn_perm(t2, t0, 0x07060302u), __builtin_amdgcn_perm(t3, t1, 0x05040100u), __builtin_amdgcn_perm(t3, t1, 0x07060302u)};
#pragma unroll
                        for (int bb = 0; bb < 4; ++bb) { const int t = 4 * jj + bb;
                            acc[2 * t]     = __builtin_amdgcn_sdot4((int)(T[bb] & 0x0f0f0f0fu), Wg[G], acc[2 * t], false);
                            acc[2 * t + 1] = __builtin_amdgcn_sdot4((int)T[bb], Wg[G], acc[2 * t + 1], false); } }
#pragma unroll
                for (int t = 0; t < 16; ++t) { acc[2 * t + 1] -= acc[2 * t]; acc[2 * t] <<= 4; }
                const bool b5 = (lane & 32) != 0, b4 = (lane & 16) != 0, b3 = (lane & 8) != 0; int p16[16], p8[8], p4[4];
#pragma unroll
                for (int j2 = 0; j2 < 16; ++j2) { const int keep = b5 ? acc[16 + j2] : acc[j2], send = b5 ? acc[j2] : acc[16 + j2]; p16[j2] = keep + __shfl_xor(send, 32); }
#pragma unroll
                for (int j2 = 0; j2 < 8; ++j2) { const int keep = b4 ? p16[8 + j2] : p16[j2], send = b4 ? p16[j2] : p16[8 + j2]; p8[j2] = keep + __shfl_xor(send, 16); }
#pragma unroll
                for (int j2 = 0; j2 < 4; ++j2) { const int keep = b3 ? p8[4 + j2] : p8[j2], send = b3 ? p8[j2] : p8[4 + j2]; p4[j2] = keep + __shfl_xor(send, 8); }
                const size_t off = (size_t)P8_ROW(lt) * DM + 256 * s + 32 * cl + (b5 ? 16 : 0) + (b4 ? 8 : 0) + (b3 ? 4 : 0);
                const v2u hw2 = *(const v2u*)(HG + off); const float ws_t = wsc[lt];
                __builtin_nontemporal_store((f32x4){bflo(hw2.x) + ws_t * (float)p4[0], bfhi(hw2.x) + ws_t * (float)p4[1], bflo(hw2.y) + ws_t * (float)p4[2], bfhi(hw2.y) + ws_t * (float)p4[3]}, (f32x4*)(Y + off)); }
        }
    }
}
#undef P8_ROW

__device__ __forceinline__ void p3_sample_attn2(Frame& F, const Args& a, const float M2) {
    unsigned char* ws = a.ws;
    const bf16* Q = (const bf16*)(ws + WS_Q); bf16* AO = (bf16*)(ws + WS_AO);
    LAS float* D2 = (LAS float*)F.lds;
    LAS float* E2 = (LAS float*)(F.lds + 32768);
    LAS float* Op = (LAS float*)(F.lds + 32768 + 128 + 8192);
    LAS float* lp = (LAS float*)(F.lds + 32768 + 128 + 8192 + 16384);
    int lane = F.lane; asm volatile("" : "+v"(lane));
    const int w = F.wave, hh = w >> 1, kh = w & 1, c = lane & 15, g = lane >> 4;
    for (;;) {
        __syncthreads();
        if (F.tid == 0) F.MISC[17] = __hip_atomic_fetch_add((unsigned*)(F.ctl + 8320), 1u, __ATOMIC_RELAXED, __HIP_MEMORY_SCOPE_AGENT);
        __syncthreads();
        const int unit = (int)F.MISC[17];
        if (unit >= DB * 2) break;
        const int b = unit >> 1, h = 4 * (unit & 1) + hh;
        __syncthreads();
        for (int jk = F.tid; jk < PAST; jk += NTHR) { const int pg = a.page_table[b * NPAGES + (jk >> 7)];
            const f32x4 l4 = *(const f32x4*)(a.cache_lf + ((size_t)pg * PAGE + (jk & 127)) * NH + 4 * (unit & 1));
            D2[jk] = l4[0]; D2[PAST + jk] = l4[1]; D2[2 * PAST + jk] = l4[2]; D2[3 * PAST + jk] = l4[3]; }
        __syncthreads();
        if (kh == 0) {
            LAS float* d = D2 + hh * PAST; float loc[32]; float tot = 0.f;
#pragma unroll
            for (int k = 31; k >= 0; --k) { loc[k] = tot; tot += d[lane * 32 + k]; }
            float inc = tot;
#pragma unroll
            for (int o = 1; o < 64; o <<= 1) { const float t = __shfl_down(inc, o); if (lane + o < 64) inc += t; }
            const float excl = inc - tot;
#pragma unroll
            for (int k = 0; k < 32; ++k) d[lane * 32 + k] = (loc[k] + excl) * LOG2E;
            if (lane < 8) { float e = 0.f; for (int t = 0; t <= lane; ++t) e += a.out[O_LFS + (size_t)(b * 8 + t) * NH + h]; E2[hh * 8 + lane] = e * LOG2E; }
        }
        __syncthreads();
        bf16x8v qb[2];
#pragma unroll
        for (int ks = 0; ks < 2; ++ks) { qb[ks] = bf16x8v{}; if (c < 8) qb[ks] = *(const bf16x8v*)(Q + (size_t)(MP + b * 8 + c) * DA + h * 64 + 32 * ks + 8 * g); }
        const float e2q = E2[hh * 8 + (c & 7)] - M2;
        f32x4 oacc[4]; float lsum = 0.f;
#pragma unroll
        for (int m = 0; m < 4; ++m) oacc[m] = (f32x4){0.f, 0.f, 0.f, 0.f};
        const LAS float* dh = D2 + hh * PAST;
        int nskip; { const float dl = dh[32 * lane + 31]; nskip = __builtin_popcountll(__ballot(dl < -(24.f + 2.f * M2))); }
        nskip = __builtin_amdgcn_readfirstlane(nskip);
        const int nblk = PAST / 32 - nskip, nb0 = nblk >> 1;
        const int blk_lo = nskip + (kh ? nb0 : 0), nit = kh ? (nblk - nb0) : nb0;
#define S3_PACK8(x0_, x1_) __builtin_bit_cast(bf16x8v, (v4u){pkbf((x0_)[0], (x0_)[1]), pkbf((x0_)[2], (x0_)[3]), pkbf((x1_)[0], (x1_)[1]), pkbf((x1_)[2], (x1_)[3])})
#define S3_PV(p0_, p1_, vq_) do { const bf16x8v pb_ = S3_PACK8(p0_, p1_); \
            _Pragma("unroll") for (int m = 0; m < 4; ++m) { const bf16x8v va_ = __builtin_bit_cast(bf16x8v, (v4u){pkbf((vq_)[0][m], (vq_)[1][m]), pkbf((vq_)[2][m], (vq_)[3][m]), pkbf((vq_)[4][m], (vq_)[5][m]), pkbf((vq_)[6][m], (vq_)[7][m])}); \
                oacc[m] = __builtin_amdgcn_mfma_f32_16x16x32_bf16(va_, pb_, oacc[m], 0, 0, 0); } } while (0)
        for (int it = 0; it < nit; ++it) {
            const int j0 = (blk_lo + it) * 32; const int pg = a.page_table[b * NPAGES + (j0 >> 7)];
            const size_t rowoff = (((size_t)pg * PAGE + (j0 & 127)) * NH + h) * HD;
            const float* kr = a.cache_k + rowoff + (size_t)c * (NH * HD) + 8 * g; const float* vr = a.cache_v + rowoff + 4 * c;
            f32x4 kq[2][2][2], vq[8];
#pragma unroll
            for (int tl = 0; tl < 2; ++tl)
#pragma unroll
                for (int ks = 0; ks < 2; ++ks) { const float* kp = kr + (size_t)(16 * tl) * (NH * HD) + 32 * ks; kq[tl][ks][0] = __builtin_nontemporal_load((const f32x4*)kp); kq[tl][ks][1] = __builtin_nontemporal_load((const f32x4*)(kp + 4)); }
#pragma unroll
            for (int jj = 0; jj < 8; ++jj) vq[jj] = __builtin_nontemporal_load((const f32x4*)(vr + (size_t)((jj < 4 ? 0 : 12) + 4 * g + jj) * (NH * HD)));
            const f32x4 d0 = *(const LAS f32x4*)(dh + j0 + 4 * g), d1 = *(const LAS f32x4*)(dh + j0 + 16 + 4 * g);
            f32x4 s0 = d0 + e2q, s1 = d1 + e2q;
#pragma unroll
            for (int ks = 0; ks < 2; ++ks) { s0 = __builtin_amdgcn_mfma_f32_16x16x32_bf16(S3_PACK8(kq[0][ks][0], kq[0][ks][1]), qb[ks], s0, 0, 0, 0);
                                             s1 = __builtin_amdgcn_mfma_f32_16x16x32_bf16(S3_PACK8(kq[1][ks][0], kq[1][ks][1]), qb[ks], s1, 0, 0, 0); }
            f32x4 p0, p1;
#pragma unroll
            for (int r = 0; r < 4; ++r) { p0[r] = __builtin_amdgcn_exp2f(s0[r]); p1[r] = __builtin_amdgcn_exp2f(s1[r]); }
            lsum += (p0[0] + p0[1]) + (p0[2] + p0[3]) + (p1[0] + p1[1]) + (p1[2] + p1[3]);
            S3_PV(p0, p1, vq);
        }
        if (kh == 1) {
            const float* kr = a.out + O_KS + (size_t)(b * 8 + (c & 7)) * DA + h * HD + 8 * g;
            f32x4 s0 = (f32x4){0.f, 0.f, 0.f, 0.f};
#pragma unroll
            for (int ks = 0; ks < 2; ++ks) { const f32x4 x0 = *(const f32x4*)(kr + 32 * ks), x1 = *(const f32x4*)(kr + 32 * ks + 4); s0 = __builtin_amdgcn_mfma_f32_16x16x32_bf16(S3_PACK8(x0, x1), qb[ks], s0, 0, 0, 0); }
            f32x4 p0, p1 = (f32x4){0.f, 0.f, 0.f, 0.f}, vq[8];
#pragma unroll
            for (int r = 0; r < 4; ++r) { const int key = 4 * g + r; const float ek = E2[hh * 8 + (key & 7)]; p0[r] = (key < 8 && key <= c) ? __builtin_amdgcn_exp2f(s0[r] + e2q - ek) : 0.f; }
#pragma unroll
            for (int jj = 0; jj < 8; ++jj) { vq[jj] = (f32x4){0.f, 0.f, 0.f, 0.f}; if (jj < 4 && g < 2) vq[jj] = *(const f32x4*)(a.out + O_VS + (size_t)(b * 8 + 4 * g + jj) * DA + h * HD + 4 * c); }
            lsum += (p0[0] + p0[1]) + (p0[2] + p0[3]);
            S3_PV(p0, p1, vq);
        }
#undef S3_PV
#undef S3_PACK8
        lsum += __shfl_xor(lsum, 16); lsum += __shfl_xor(lsum, 32);
        if (lane < 8) lp[w * 8 + lane] = lsum;
        if (c < 8) {
#pragma unroll
            for (int r = 0; r < 4; ++r) *(LAS f32x4*)(Op + (w * 8 + c) * 64 + 16 * g + 4 * r) = (f32x4){oacc[0][r], oacc[1][r], oacc[2][r], oacc[3][r]}; }
        __syncthreads();
        for (int i = F.tid; i < 4 * 8 * 64; i += NTHR) { const int hq = i >> 9, t = (i >> 6) & 7, d = i & 63;
            const float O = Op[((2 * hq) * 8 + t) * 64 + d] + Op[((2 * hq + 1) * 8 + t) * 64 + d], L = lp[(2 * hq) * 8 + t] + lp[(2 * hq + 1) * 8 + t];
            AO[(size_t)(MP + b * 8 + t) * DA + (4 * (unit & 1) + hq) * 64 + d] = (bf16)(pkbf(O / L, 0.f) & 0xffffu); }
    }
}


template <class Epi> __device__ __forceinline__ void sg_phase(Frame& F, const bf16* A  , const bf16* Bt  , int K, int N, const Epi& E) {
    int lane = F.lane; asm volatile("" : "+v"(lane));
    const int fr = lane & 15, fq = lane >> 4, ntc = N >> 6, ntile = (MS / 128) * ntc, pitch = 2 * K + 16, kc = K >> 3;
    const bool grp = (F.G == 256);
    for (int t = grp ? (F.vcu & 31) : F.vcu; t < (grp ? ntc : ntile); t += grp ? 32 : F.G) {
        const int tr = grp ? (F.vcu >> 5) : t % (MS / 128), tc = grp ? t : t / (MS / 128);
        __syncthreads();
        for (int i = F.tid; i < 64 * kc; i += NTHR) { const int r = i / kc, c = i - r * kc; *(LAS v4u*)(F.lds + r * pitch + 16 * c) = *(const v4u*)(Bt + (size_t)(64 * tc + r) * K + 8 * c); }
        __syncthreads();
        const bf16* ap = A + (size_t)(128 * tr + 16 * F.wave + fr) * K + 8 * fq;
        const LAS unsigned char* bp = F.lds + fr * pitch + 16 * fq;
        f32x4 acc[4];
#pragma unroll
        for (int c = 0; c < 4; ++c) acc[c] = (f32x4){0.f, 0.f, 0.f, 0.f};
#pragma unroll 8
        for (int ks = 0; ks < K; ks += 32) {
            const bf16x8v av = *(const bf16x8v*)(ap + ks);
#pragma unroll
            for (int c = 0; c < 4; ++c) { const bf16x8v bv = *(const LAS bf16x8v*)(bp + 16 * c * pitch + 2 * ks); acc[c] = __builtin_amdgcn_mfma_f32_16x16x32_bf16(bv, av, acc[c], 0, 0, 0); }
        }
        E(acc, 128 * tr + 16 * F.wave + fr, tc, fq);
    }
}
template <int MODE> struct SgGate { const bf16* G; const bf16* Tin; bf16* O;
    __device__ __forceinline__ void operator()(const f32x4 (&acc)[4], int rs, int tc, int fq) const {
#pragma unroll
        for (int c = 0; c < 4; ++c) { const size_t off = (size_t)(MP + rs) * DM + 64 * tc + 16 * c + 4 * fq; const v2u g = *(const v2u*)(G + off);
            float r[4] = {acc[c][0] * bflo(g.x), acc[c][1] * bfhi(g.x), acc[c][2] * bflo(g.y), acc[c][3] * bfhi(g.y)};
            if (MODE == 1) { const v2u t = *(const v2u*)(Tin + off); r[0] += bflo(t.x); r[1] += bfhi(t.x); r[2] += bflo(t.y); r[3] += bfhi(t.y); }
            v2u w; w.x = pkbf(r[0], r[1]); w.y = pkbf(r[2], r[3]); *(v2u*)(O + off) = w; } } };
struct SgOut { const float* xs; float* H; bf16* HG; const float* gf; float* RSS;
    __device__ __forceinline__ void operator()(const f32x4 (&acc)[4], int rs, int tc, int fq) const { float ss = 0.f;
#pragma unroll
        for (int c = 0; c < 4; ++c) { const int col = 64 * tc + 16 * c + 4 * fq; const f32x4 h = acc[c] + *(const f32x4*)(xs + (size_t)rs * DM + col);
            ss += (h[0] * h[0] + h[1] * h[1]) + (h[2] * h[2] + h[3] * h[3]);
            v2u w; w.x = pkbf(h[0], h[1]); w.y = pkbf(h[2], h[3]); *(v2u*)(HG + (size_t)(MP + rs) * DM + col) = w; }
        ss += __shfl_xor(ss, 16); ss += __shfl_xor(ss, 32);
        if (fq == 0) RSS[(size_t)(MP + rs) * 16 + tc] = ss; } };
struct SgPQ { bf16* PQ;
    __device__ __forceinline__ void operator()(const f32x4 (&acc)[4], int rs, int tc, int fq) const {
#pragma unroll
        for (int c = 0; c < 4; ++c) { v2u w; w.x = pkbf(acc[c][0], acc[c][1]); w.y = pkbf(acc[c][2], acc[c][3]); *(v2u*)(PQ + (size_t)(MP + rs) * DQ + 64 * tc + 16 * c + 4 * fq) = w; } } };

constexpr int CW_GRP = 8448, CW_XID = 12288;
__device__ __forceinline__ void group_barrier(const Frame& F, const XcdBarrier& b, int seam) {
    asm volatile("s_waitcnt vmcnt(0)" ::: "memory");
    __syncthreads();
    if (threadIdx.x == 0) {
        const unsigned x = blockIdx.x & 7u, n = (gridDim.x - x + 7u) >> 3;
        unsigned same = F.MISC[20];
        if (same == 0u) { unsigned acc = 1u; for (unsigned m = x; m < gridDim.x; m += 8u) acc &= (xb_ld((unsigned*)(F.ctl + CW_XID + (int)m)) == b.x + 1u) ? 1u : 0u; same = 1u + acc; F.MISC[20] = same; }
        unsigned* c = (unsigned*)(F.ctl + CW_GRP + 64 * (seam * 8 + (int)x));
        if (same != 2u) { __builtin_amdgcn_fence(__ATOMIC_RELEASE, "agent"); asm volatile("s_waitcnt vmcnt(0)" ::: "memory"); }
        (void)xb_add(c, 1u);
        XB_SPIN(xb_ld(c) < n, b.bar);
        __builtin_amdgcn_fence(__ATOMIC_ACQUIRE, "agent");
        asm volatile("s_waitcnt vmcnt(0)" ::: "memory");
    }
    __syncthreads();
}

struct ChainOrder : pg8::StaticOrder {
    __device__ bool next(int i, pg8::Unit& u) const { const bool ok = pg8::StaticOrder::next(i >> 1, u); u.sel = i & 1; return ok; }
};

constexpr int N_PHASES = 9;
#ifndef MK_PER_PHASE
#define MK_PER_PHASE 0
#endif
__global__ void __launch_bounds__(NTHR, 2) fwd_kernel(Args args) {
    extern __shared__ __attribute__((aligned(16))) unsigned char lds[];
    Frame F;
    F.lds = (LAS unsigned char*)lds; F.MISC = (volatile LAS unsigned*)(F.lds + MISC_OFF);
    F.tid = threadIdx.x; F.lane = F.tid & 63; F.wave = __builtin_amdgcn_readfirstlane(F.tid >> 6);
    F.G = gridDim.x; { const int bx = blockIdx.x; F.vcu = (F.G % 8 == 0) ? (bx % 8) * (F.G / 8) + bx / 8 : bx; }
    F.ctl = (gu32*)(args.ws + WS_CTL);
    for (int u = F.tid; u < (LDS_BYTES - MISC_OFF) / 4; u += NTHR) ((LAS unsigned*)(F.lds + MISC_OFF))[u] = 0u;
    __syncthreads();
#if MK_PER_PHASE
#define GRID_BAR() do { } while (0)
#else
    XcdBarrier bar = xcd_barrier_post((unsigned*)(F.ctl + CW_BAR), F.MISC + 8);
    if (F.tid == 0) __hip_atomic_store((unsigned*)(F.ctl + CW_XID + (int)blockIdx.x), bar.x + 1u, __ATOMIC_RELAXED, __HIP_MEMORY_SCOPE_AGENT);
#define GRID_BAR() xcd_barrier(bar)
#endif
    unsigned char* ws = args.ws;
    const int lo = args.ph_lo, hi = args.ph_hi;
    const bool grp = (F.G == 256);
#ifndef DBG_REP_PHASE
#define DBG_REP_PHASE -1
#endif
#ifndef DBG_REP_N
#define DBG_REP_N 1
#endif
#define REPS(k) for (int rep_ = 0; rep_ < ((k) == DBG_REP_PHASE ? 1 + DBG_REP_N : 1); ++rep_)
#define IN(k) (lo <= (k) && (k) < hi)
#define BOTH(k) (IN(k) && IN((k) + 1))
#define ENDPH(k) do { if (BOTH(k) || (k) == DBG_REP_PHASE) GRID_BAR(); } while (0)
#if MK_PER_PHASE
#define ENDPH_G(k, seam) ENDPH(k)
#else
#define ENDPH_G(k, seam) do { if (BOTH(k) || (k) == DBG_REP_PHASE) { if (grp && (k) != DBG_REP_PHASE) group_barrier(F, bar, seam); else GRID_BAR(); } } while (0)
#endif
    if (IN(0)) REPS(0) { p0_prologue(F, args); ENDPH(0); }
    if (IN(1)) REPS(1) {
        p1_cumsum(F, args);
        pg8::Gemm g{(const bf16*)(ws + WS_XN), (const bf16*)(ws + WS_WIN), M, NPROJ - 256, DM}; pg8::StaticOrder S; S.init(M, NPROJ - 256, F.G, (int)blockIdx.x);
        EpiInProj E{(bf16*)(ws + WS_U), (bf16*)(ws + WS_Q), (bf16*)(ws + WS_K), (bf16*)(ws + WS_V), (bf16*)(ws + WS_GA), (bf16*)(ws + WS_GB), args.out, args.q_norm_g, args.k_norm_g, 0};
        pg8::gemm_phase<EpiInProj, pg8::StaticOrder, true, true>(F.lds, g, S, E);
        ENDPH(1);
    }
    if (IN(2)) REPS(2) {
        { pg8::Gemm g{(const bf16*)(ws + WS_XN), (const bf16*)(ws + WS_WIN) + (size_t)(NPROJ - 256) * DM, M, 256, DM}; pg8::StaticOrder S; S.init(M, 256, F.G, (int)blockIdx.x);
          EpiInProj E{(bf16*)(ws + WS_U), (bf16*)(ws + WS_Q), (bf16*)(ws + WS_K), (bf16*)(ws + WS_V), (bf16*)(ws + WS_GA), (bf16*)(ws + WS_GB), args.out, args.q_norm_g, args.k_norm_g, 15};
          pg8::gemm_phase<EpiInProj, pg8::StaticOrder, true, true>(F.lds, g, S, E); }
        __syncthreads();
        p2_cumsum_pool(F, args);
        if (2 == DBG_REP_PHASE || !IN(3)) GRID_BAR();
        __syncthreads(); }
    if (IN(3)) {
        const float M2 = __builtin_bit_cast(float, __builtin_amdgcn_readfirstlane(__builtin_bit_cast(int, attn_bound2(args, F.lane))));
#if !defined(DBG_SKIP_PATTN)
        { const attn_body::AttnTensors AT{(const attn_body::bf16*)(ws + WS_Q), (const attn_body::bf16*)(ws + WS_K), (const attn_body::bf16*)(ws + WS_V), (attn_body::bf16*)(ws + WS_AO), (const float*)(ws + WS_CP2), M2};
          const attn_body::QueueOrder S{(unsigned*)(F.ctl + 8192), F.MISC + 16};
          attn_body::attn_phase<attn_body::QueueOrder>((char*)lds, AT, S);
#ifdef DBG_ATTN2
          __syncthreads(); attn_body::attn_phase<attn_body::StaticOrder>((char*)lds, AT, S);
#endif
        }
#endif
        REPS(3) { p3_sample_attn2(F, args, M2); }
        ENDPH(3); }
    if (IN(4)) REPS(4) {
        { pg8::Gemm g{(const bf16*)(ws + WS_PO), (const bf16*)(ws + WS_WBP), MP, DM, DP, (const bf16*)(ws + WS_AO), (const bf16*)(ws + WS_WBA)}; ChainOrder S; S.init(MP, DM, F.G, (int)blockIdx.x);
          EpiMerge E{(const bf16*)(ws + WS_GA), (const bf16*)(ws + WS_GB), (bf16*)(ws + WS_MIX)};
          pg8::gemm_phase<EpiMerge, ChainOrder, true, true>(F.lds, g, S, E); }
        { SgGate<0> E{(const bf16*)(ws + WS_GA), nullptr, (bf16*)(ws + WS_T)}; sg_phase(F, (const bf16*)(ws + WS_PO) + (size_t)MP * DP, (const bf16*)(ws + WS_WBP), DP, DM, E); }
        asm volatile("s_waitcnt vmcnt(0)" ::: "memory"); __syncthreads();
        { SgGate<1> E{(const bf16*)(ws + WS_GB), (const bf16*)(ws + WS_T), (bf16*)(ws + WS_MIX)}; sg_phase(F, (const bf16*)(ws + WS_AO) + (size_t)MP * DA, (const bf16*)(ws + WS_WBA), DA, DM, E); }
        ENDPH_G(4, 0);
    }
    if (IN(5)) REPS(5) {
        pg8::Gemm g{(const bf16*)(ws + WS_MIX), (const bf16*)(ws + WS_WOUT), MP, DM, DM}; pg8::StaticOrder S; S.init(MP, DM, F.G, (int)blockIdx.x);
        EpiOut E{args.x_p, args.x_s, (float*)(ws + WS_H), (bf16*)(ws + WS_XN), args.norm_ffn_g, (float*)(ws + WS_RSS)};
        pg8::gemm_phase<EpiOut, pg8::StaticOrder, true, true>(F.lds, g, S, E);
        { SgOut E2{args.x_s, (float*)(ws + WS_H), (bf16*)(ws + WS_XN), args.norm_ffn_g, (float*)(ws + WS_RSS)}; sg_phase(F, (const bf16*)(ws + WS_MIX) + (size_t)MP * DM, (const bf16*)(ws + WS_WOUT), DM, DM, E2); }
        ENDPH_G(5, 1);
    }
    if (IN(6)) REPS(6) {
        pg8::Gemm g{(const bf16*)(ws + WS_XN), (const bf16*)(ws + WS_WQ), MP, DQ, DM}; pg8::StaticOrder S; S.init(MP, DQ, F.G, (int)blockIdx.x);
        pg8::EpiBf16<0> E{(bf16*)(ws + WS_PQ), DQ, nullptr, 0, 0, 1.f};
        pg8::gemm_phase<pg8::EpiBf16<0>, pg8::StaticOrder, true, true>(F.lds, g, S, E);
        { SgPQ E2{(bf16*)(ws + WS_PQ)}; sg_phase(F, (const bf16*)(ws + WS_XN) + (size_t)MP * DM, (const bf16*)(ws + WS_WQ), DM, DQ, E2); }
        ENDPH_G(6, 2);
    }
    if (IN(7)) REPS(7) { p7_topk(F, args); ENDPH_G(7, 3); }
    if (IN(8)) REPS(8) { p8_gather(F, args); ENDPH(8); }
#ifdef DBG_DUMP
    if (IN(9)) { const bf16* AO = (const bf16*)(ws + WS_AO); const bf16* PO = (const bf16*)(ws + WS_PO); const bf16* MX = (const bf16*)(ws + (DBG_DUMP == 3 ? WS_T : DBG_DUMP == 4 ? WS_GA : WS_MIX));
        for (size_t i = (size_t)blockIdx.x * NTHR + F.tid; i < (size_t)M * DM; i += (size_t)F.G * NTHR) { const int row = (int)(i >> 10), c = (int)(i & 1023);
            float v; if (DBG_DUMP == 1) v = c < 512 ? bf2f(AO[(size_t)row * DA + c]) : bf2f(PO[(size_t)row * DP + c - 512]); else v = bf2f(MX[i]);
            args.out[O_YP + i] = v; } }
#endif
#undef IN
#undef BOTH
}

extern "C" void kernel_launch(void* const* d_in, const int* in_sizes, int n_in, void* d_out, int out_size, void* d_ws, size_t ws_size, hipStream_t stream) {
    static int grid = 0;
    if (grid == 0) {
        if (n_in != 22 || (size_t)out_size != O_END || ws_size < WS_END) { fprintf(stderr, "kernel_launch: unexpected shapes (n_in %d out %d ws %zu)\n", n_in, out_size, ws_size); grid = -1; return; }
        int dev = 0, cus = 0, per_cu = 0;
        if (hipGetDevice(&dev) != hipSuccess || hipDeviceGetAttribute(&cus, hipDeviceAttributeMultiprocessorCount, dev) != hipSuccess) { grid = -1; return; }
        if (hipFuncSetAttribute((const void*)fwd_kernel, hipFuncAttributeMaxDynamicSharedMemorySize, LDS_BYTES) != hipSuccess) { fprintf(stderr, "kernel_launch: hipFuncSetAttribute failed\n"); grid = -1; return; }
        if (hipOccupancyMaxActiveBlocksPerMultiprocessor(&per_cu, (const void*)fwd_kernel, NTHR, LDS_BYTES) != hipSuccess || per_cu < 1) fprintf(stderr, "kernel_launch: occupancy query reports %d\n", per_cu);
        (void)hipGetLastError();
        grid = cus;
    }
    if (grid < 0) return;
    if (hipMemsetAsync((char*)d_ws + WS_CTL, 0, CTL_ZERO_BYTES, stream) != hipSuccess) return;
    Args a{};
    a.x_p = (const float*)d_in[0]; a.x_s = (const float*)d_in[1]; a.cache_k = (const float*)d_in[2]; a.cache_v = (const float*)d_in[3]; a.cache_lf = (const float*)d_in[4];
    a.state_pool = (const float*)d_in[5]; a.page_table = (const int*)d_in[6]; a.norm_mix_g = (const float*)d_in[7]; a.w_in = (const float*)d_in[8]; a.b_forget = (const float*)d_in[9];
    a.q_norm_g = (const float*)d_in[10]; a.k_norm_g = (const float*)d_in[11]; a.pool_mix_w = (const float*)d_in[12]; a.pool_scale = (const float*)d_in[13]; a.w_bp = (const float*)d_in[14];
    a.w_ba = (const float*)d_in[15]; a.w_out = (const float*)d_in[16]; a.norm_ffn_g = (const float*)d_in[17]; a.w_query = (const float*)d_in[18]; a.sub_keys = (const float*)d_in[19];
    a.peer_u = (const float*)d_in[20]; a.peer_v = (const float*)d_in[21];
    a.out = (float*)d_out; a.ws = (unsigned char*)d_ws; a.pad = 0;
#if MK_PER_PHASE
#ifndef DBG_NPH
#define DBG_NPH N_PHASES
#endif
    for (int ph = 0; ph < DBG_NPH; ++ph) { a.ph_lo = ph; a.ph_hi = ph + 1; a.li = ph; hipLaunchKernelGGL(fwd_kernel, dim3(grid), dim3(NTHR), LDS_BYTES, stream, a); }
#ifdef DBG_DUMP
    a.ph_lo = 9; a.ph_hi = 10; a.li = 9; hipLaunchKernelGGL(fwd_kernel, dim3(grid), dim3(NTHR), LDS_BYTES, stream, a);
#endif
#else
    a.ph_lo = 0; a.ph_hi = N_PHASES; a.li = 0; hipLaunchKernelGGL(fwd_kernel, dim3(grid), dim3(NTHR), LDS_BYTES, stream, a);
#endif
}
```

```cpp
#include <hip/hip_runtime.h>
#include <cstdio>
#include <cstdint>
#include <cmath>
namespace pg8 {
#define PG8_LAS __attribute__((address_space(3)))
typedef unsigned short bf16_t;
typedef short bf16x8 __attribute__((ext_vector_type(8)));
typedef float f32x4 __attribute__((ext_vector_type(4)));
typedef unsigned u32x4 __attribute__((ext_vector_type(4)));
constexpr int BM = 256, BK = 64, HALF = 128, HTB = HALF * BK * 2  , STAGE_BYTES = 8 * HTB, NXCD = 8, WGM = 8;

__host__ __device__ __forceinline__ int lds_byte(int r, int c) { const int st = (r >> 4) * 2 + (c >> 5), rr = r & 15, cc = c & 31, ob = rr * 64 + cc * 2; return st * 1024 + (ob ^ (((ob >> 9) & 1) << 5)); }
__host__ __device__ __forceinline__ void stage_rc(int b, int& R, int& C) { const int st = b / 1024, sb = b % 1024, swz = sb ^ (((sb >> 9) & 1) << 5); R = (st >> 1) * 16 + swz / 64; C = (st & 1) * 32 + (swz % 64) / 2; }
__host__ __device__ __forceinline__ int perm32(int rho) { const int n = rho >> 4, i = rho & 15; return 8 * (i >> 2) + 4 * n + (i & 3); }

struct Unit { int pm, pn, sel; };
struct Gemm { const bf16_t* A; const bf16_t* Bt; int M, N, K; const bf16_t* A2; const bf16_t* Bt2; };

struct StaticOrder {
    int nM, nN, nwg, G, c;
    __host__ __device__ void init(int M, int N, int G_, int c_) { nM = M / BM; nN = N / BM; nwg = nM * nN; G = G_; c = c_; }
    __host__ __device__ bool next(int i, Unit& u) const {
        const long L = (long)i * G + c; if (L >= nwg) return false;
        int wgid = (int)L; { const int q = nwg / NXCD, r = nwg % NXCD, xcd = wgid % NXCD, off = wgid / NXCD; wgid = (xcd < r ? xcd * (q + 1) : r * (q + 1) + (xcd - r) * q) + off; }
        const int nig = WGM * nN, gid = wgid / nig, fm = gid * WGM, gsz = (nM - fm) < WGM ? (nM - fm) : WGM;
        u.pm = fm + ((wgid % nig) % gsz); u.pn = (wgid % nig) / gsz; return true;
    }
    __device__ __forceinline__ void a_ready(const Unit&) const {}
    __device__ __forceinline__ void done(const Unit&) const {}
};

typedef float f32x2c __attribute__((ext_vector_type(2))); typedef __bf16 bf16x2c __attribute__((ext_vector_type(2)));
__device__ __forceinline__ unsigned cvt_pk_bf16(float lo, float hi) { f32x2c v = {lo, hi}; bf16x2c b = __builtin_convertvector(v, bf16x2c); return __builtin_bit_cast(unsigned, b); }
typedef float f32x2 __attribute__((ext_vector_type(2)));
__device__ __forceinline__ f32x2 gelu_pk(f32x2 v) {
    const f32x2 av = __builtin_elementwise_abs(v), d = av * 0.2316418882f + 1.0f;
    f32x2 t; t.x = __builtin_amdgcn_rcpf(d.x); t.y = __builtin_amdgcn_rcpf(d.y);
    f32x2 q = t * 0.5307027145f + (-0.7265760135f); q = q * t + 0.7107068705f; q = q * t + (-0.142248368f); q = q * t + 0.127414796f; q = q * t;
    const f32x2 s = (v * v) * (-0.72134752044f);
    f32x2 e; e.x = __builtin_amdgcn_exp2f(s.x); e.y = __builtin_amdgcn_exp2f(s.y);
    const f32x2 m = v * (q * e), r = v - m;
    f32x2 o; o.x = v.x < 0.f ? m.x : r.x; o.y = v.y < 0.f ? m.y : r.y; return o;
}

template <int ACT  > struct EpiBf16 {
    static constexpr bool PERM = true, AFTER_DRAIN = false, CHAIN = false; static_assert(ACT == 0 || ACT == 1, "EpiBf16: ACT is 0 (none) or 1 (gelu_pk)");
    bf16_t* O; int ldc; const float* bias; int split_cols; size_t split_stride; float scale0;
    __device__ __forceinline__ void operator()(const f32x4 (&acc)[2][2][4][2], const Unit& u, int wr, int wc, int fr, int fq) const {
        const int row0 = u.pm * BM + wr * 64 + fr; int colt = u.pn * BM; bf16_t* base = O;
        float sc = 1.f; if (split_cols) { const int t = colt / split_cols; base += (size_t)t * split_stride; colt -= t * split_cols; if (t == 0) sc = scale0; }
        const int col0 = colt + wc * 32 + 8 * fq, bcol0 = u.pn * BM + wc * 32 + 8 * fq;
        f32x4 bv[2][2];
#pragma unroll
        for (int bj = 0; bj < 2; ++bj)
#pragma unroll
            for (int n = 0; n < 2; ++n) bv[bj][n] = bias ? *(const f32x4*)(bias + bcol0 + bj * HALF + 4 * n) : (f32x4){0.f, 0.f, 0.f, 0.f};
#pragma unroll
        for (int ai = 0; ai < 2; ++ai)
#pragma unroll
            for (int m = 0; m < 4; ++m) { bf16_t* rowp = base + (size_t)(row0 + ai * HALF + m * 16) * ldc + col0;
#pragma unroll
                for (int bj = 0; bj < 2; ++bj) { f32x4 v0 = acc[ai][bj][m][0] + bv[bj][0], v1 = acc[ai][bj][m][1] + bv[bj][1];
                    if (ACT == 1) { f32x2 a = gelu_pk((f32x2){v0[0], v0[1]}), b = gelu_pk((f32x2){v0[2], v0[3]}), c = gelu_pk((f32x2){v1[0], v1[1]}), d = gelu_pk((f32x2){v1[2], v1[3]});
                        v0 = (f32x4){a.x, a.y, b.x, b.y}; v1 = (f32x4){c.x, c.y, d.x, d.y}; }
                    v0 = v0 * sc; v1 = v1 * sc; u32x4 w; w.x = cvt_pk_bf16(v0[0], v0[1]); w.y = cvt_pk_bf16(v0[2], v0[3]); w.z = cvt_pk_bf16(v1[0], v1[1]); w.w = cvt_pk_bf16(v1[2], v1[3]);
                    *(u32x4*)(rowp + bj * HALF) = w; } }
    }
};
template <class Epi, class Sched, bool ALIGN_EPI = false, bool SP2 = false>
__device__ __forceinline__ void gemm_phase(PG8_LAS unsigned char* lds, const Gemm g, const Sched& S, const Epi& E) {
    int tid = threadIdx.x; asm volatile("" : "+v"(tid));
    const int wid = __builtin_amdgcn_readfirstlane(tid >> 6), lane = tid & 63, wr = wid >> 2, wc = wid & 3, fr = lane & 15, fq = lane >> 4;
    const int K = g.K, nt = K / BK;
    unsigned voffA[2], voffB[2];
#pragma unroll
    for (int i = 0; i < 2; ++i) { int R, C; stage_rc(tid * 16 + i * 8192, R, C); const int Rb = Epi::PERM ? ((R & ~31) + perm32(R & 31)) : R;
        voffA[i] = (unsigned)(R * K + C) * 2u; voffB[i] = (unsigned)(Rb * K + C) * 2u; }
    const size_t kstep = (size_t)(BK * 2);
    const size_t hstep = (size_t)HALF * K * 2;
    const size_t tstep = 2 * hstep;
    const unsigned ldsw = (unsigned)wid * 1024u;
    const int aoff = lds_byte(wr * 64 + fr, fq * 8), boff = lds_byte(wc * 32 + fr, fq * 8);
#define PG8_SA(b, h) (((b) * 2 + (h)) * HTB)
#define PG8_SB(b, h) ((4 + (b) * 2 + (h)) * HTB)
#define PG8_STAGE(bufoff, gbase, voff) do { _Pragma("unroll") for (int _i = 0; _i < 2; ++_i) \
        __builtin_amdgcn_global_load_lds((const unsigned*)((const char*)(gbase) + (voff)[_i]), (PG8_LAS unsigned*)(lds + (bufoff) + ldsw + _i * 8192), 16, 0, 0); } while (0)
#define PG8_LDA(dst, b, h) do { _Pragma("unroll") for (int m = 0; m < 4; ++m) _Pragma("unroll") for (int k = 0; k < 2; ++k) dst[m][k] = *(const PG8_LAS bf16x8*)(lds + PG8_SA(b, h) + aoff + m * 2048 + k * 1024); } while (0)
#define PG8_LDB(dst, b, h) do { _Pragma("unroll") for (int n = 0; n < 2; ++n) _Pragma("unroll") for (int k = 0; k < 2; ++k) dst[n][k] = *(const PG8_LAS bf16x8*)(lds + PG8_SB(b, h) + boff + n * 2048 + k * 1024); } while (0)
#define PG8_MMA(ai, bj, At, Bt) do { __builtin_amdgcn_s_setprio(1); _Pragma("unroll") for (int m = 0; m < 4; ++m) _Pragma("unroll") for (int n = 0; n < 2; ++n) _Pragma("unroll") for (int k = 0; k < 2; ++k) \
        acc[ai][bj][m][n] = __builtin_amdgcn_mfma_f32_16x16x32_bf16(Bt[n][k], At[m][k], acc[ai][bj][m][n], 0, 0, 0); __builtin_amdgcn_s_setprio(0); } while (0)
#define PG8_WAIT_V(n) asm volatile("s_waitcnt vmcnt(" #n ")" ::: "memory")
#define PG8_WAIT_L(n) asm volatile("s_waitcnt lgkmcnt(" #n ")" ::: "memory")
#define PG8_BAR __builtin_amdgcn_s_barrier()
#define PG8_SCHED __builtin_amdgcn_sched_barrier(0)
    Unit cur, nxt; int ui = 0;
    if (!S.next(0, cur)) return;
    f32x4 acc[2][2][4][2];
#pragma unroll
    for (int a = 0; a < 2; ++a)
#pragma unroll
        for (int b = 0; b < 2; ++b)
#pragma unroll
            for (int m = 0; m < 4; ++m)
#pragma unroll
                for (int n = 0; n < 2; ++n) acc[a][b][m][n] = (f32x4){0.f, 0.f, 0.f, 0.f};
    bf16x8 At[4][2], B0[2][2], B1[2][2];
    const char* cA = (const char*)g.A + (size_t)cur.pm * tstep; const char* cB = (const char*)g.Bt + (size_t)cur.pn * tstep;
    if constexpr (Epi::CHAIN) { if (cur.sel) { cA = (const char*)g.A2 + (size_t)cur.pm * tstep; cB = (const char*)g.Bt2 + (size_t)cur.pn * tstep; } }
    S.a_ready(cur);
    if constexpr (SP2) {
        PG8_STAGE(PG8_SB(0, 0), cB, voffB); PG8_STAGE(PG8_SB(0, 1), cB + hstep, voffB); PG8_STAGE(PG8_SA(0, 0), cA, voffA); PG8_STAGE(PG8_SA(0, 1), cA + hstep, voffA);
        if (wr == 1) PG8_BAR;
        PG8_WAIT_V(2); PG8_BAR;
        PG8_STAGE(PG8_SB(1, 0), cB + kstep, voffB); PG8_STAGE(PG8_SA(1, 0), cA + kstep, voffA); PG8_STAGE(PG8_SB(1, 1), cB + hstep + kstep, voffB);
        PG8_WAIT_V(6); PG8_BAR;
    } else {
        PG8_STAGE(PG8_SB(0, 0), cB, voffB); PG8_STAGE(PG8_SA(0, 0), cA, voffA); PG8_STAGE(PG8_SB(0, 1), cB + hstep, voffB); PG8_STAGE(PG8_SA(0, 1), cA + hstep, voffA);
        if (wr == 1) PG8_BAR;
        PG8_WAIT_V(4); PG8_BAR;
        PG8_STAGE(PG8_SB(1, 0), cB + kstep, voffB); PG8_STAGE(PG8_SA(1, 0), cA + kstep, voffA); PG8_STAGE(PG8_SB(1, 1), cB + hstep + kstep, voffB);
        PG8_WAIT_V(6); PG8_BAR;
    }
    for (;;) {
        const bool has_next = S.next(ui + 1, nxt);
        const char* nA = has_next ? (const char*)g.A + (size_t)nxt.pm * tstep : cA; const char* nB = has_next ? (const char*)g.Bt + (size_t)nxt.pn * tstep : cB;
        if constexpr (Epi::CHAIN) { if (has_next && nxt.sel) { nA = (const char*)g.A2 + (size_t)nxt.pm * tstep; nB = (const char*)g.Bt2 + (size_t)nxt.pn * tstep; } }
        for (int t = 0; t < nt; t += 2) {
            const bool last = (t == nt - 2);
            const char* a1 = cA + (size_t)(t + 1) * kstep;
            const char* a2 = last ? nA : cA + (size_t)(t + 2) * kstep; const char* b2 = last ? nB : cB + (size_t)(t + 2) * kstep;
            const char* a3 = a2 + kstep; const char* b3 = b2 + kstep;
            if (last && has_next) S.a_ready(nxt);
            if constexpr (SP2) {
            PG8_LDB(B0, 0, 0); PG8_LDB(B1, 0, 1); PG8_SCHED; PG8_LDA(At, 0, 0); PG8_STAGE(PG8_SA(1, 1), a1 + hstep, voffA);
            PG8_WAIT_V(8); PG8_WAIT_L(0); PG8_BAR; PG8_MMA(0, 0, At, B0); PG8_MMA(0, 1, At, B1); PG8_BAR; PG8_SCHED;
            PG8_LDA(At, 0, 1); PG8_STAGE(PG8_SB(0, 0), b2, voffB); PG8_STAGE(PG8_SB(0, 1), b2 + hstep, voffB); PG8_STAGE(PG8_SA(0, 0), a2, voffA);
            PG8_WAIT_V(8); PG8_WAIT_L(0); PG8_BAR; PG8_MMA(1, 0, At, B0); PG8_MMA(1, 1, At, B1); PG8_BAR; PG8_SCHED;
            PG8_LDB(B0, 1, 0); PG8_LDB(B1, 1, 1); PG8_SCHED; PG8_LDA(At, 1, 0); PG8_STAGE(PG8_SA(0, 1), a2 + hstep, voffA);
            PG8_WAIT_V(8); PG8_WAIT_L(0); PG8_BAR; PG8_MMA(0, 0, At, B0); PG8_MMA(0, 1, At, B1); PG8_BAR; PG8_SCHED;
            PG8_LDA(At, 1, 1); PG8_STAGE(PG8_SB(1, 0), b3, voffB); PG8_STAGE(PG8_SB(1, 1), b3 + hstep, voffB); PG8_STAGE(PG8_SA(1, 0), a3, voffA);
            PG8_WAIT_V(8); PG8_WAIT_L(0); PG8_BAR; PG8_MMA(1, 0, At, B0); PG8_MMA(1, 1, At, B1); PG8_BAR; PG8_SCHED;
            } else {
            PG8_LDB(B0, 0, 0); PG8_SCHED; PG8_LDA(At, 0, 0); PG8_STAGE(PG8_SA(1, 1), a1 + hstep, voffA);
            PG8_WAIT_L(8); PG8_BAR; PG8_WAIT_L(0); PG8_MMA(0, 0, At, B0); PG8_BAR; PG8_SCHED;
            PG8_LDB(B1, 0, 1); PG8_STAGE(PG8_SB(0, 0), b2, voffB);
            PG8_BAR; PG8_WAIT_L(0); PG8_MMA(0, 1, At, B1); PG8_BAR;
            PG8_LDA(At, 0, 1); PG8_STAGE(PG8_SA(0, 0), a2, voffA);
            PG8_BAR; PG8_WAIT_L(0); PG8_MMA(1, 0, At, B0); PG8_BAR; PG8_SCHED;
            PG8_STAGE(PG8_SB(0, 1), b2 + hstep, voffB);
            PG8_WAIT_V(6); PG8_BAR; PG8_MMA(1, 1, At, B1); PG8_BAR;
            PG8_LDB(B0, 1, 0); PG8_SCHED; PG8_LDA(At, 1, 0); PG8_STAGE(PG8_SA(0, 1), a2 + hstep, voffA);
            PG8_WAIT_L(8); PG8_BAR; PG8_WAIT_L(0); PG8_MMA(0, 0, At, B0); PG8_BAR; PG8_SCHED;
            PG8_LDB(B1, 1, 1); PG8_STAGE(PG8_SB(1, 0), b3, voffB);
            PG8_BAR; PG8_WAIT_L(0); PG8_MMA(0, 1, At, B1); PG8_BAR;
            PG8_LDA(At, 1, 1); PG8_STAGE(PG8_SA(1, 0), a3, voffA);
            PG8_BAR; PG8_WAIT_L(0); PG8_MMA(1, 0, At, B0); PG8_BAR; PG8_SCHED;
            PG8_STAGE(PG8_SB(1, 1), b3 + hstep, voffB);
            PG8_WAIT_V(6); PG8_BAR; PG8_MMA(1, 1, At, B1); PG8_BAR;
            }
        }
        if constexpr (ALIGN_EPI) { if (wr == 0) PG8_BAR; }
        bool keep_acc = false;
        if constexpr (Epi::CHAIN) { if (cur.sel == 0) { E.mid(acc, cur, wr, wc, fr, fq); keep_acc = true; } else { E(acc, cur, wr, wc, fr, fq); S.done(cur); } }
        else if constexpr (!Epi::AFTER_DRAIN) { E(acc, cur, wr, wc, fr, fq); S.done(cur); }
        if (!has_next) break;
        if (!keep_acc) {
#pragma unroll
        for (int a = 0; a < 2; ++a)
#pragma unroll
            for (int b = 0; b < 2; ++b)
#pragma unroll
                for (int m = 0; m < 4; ++m)
#pragma unroll
                    for (int n = 0; n < 2; ++n) acc[a][b][m][n] = (f32x4){0.f, 0.f, 0.f, 0.f};
        }
        cur = nxt; cA = nA; cB = nB; ++ui;
        if constexpr (ALIGN_EPI) { if (wr == 1) PG8_BAR; }
    }
    PG8_WAIT_V(0);
    if constexpr (!ALIGN_EPI) { if (wr == 0) PG8_BAR; }
    PG8_BAR;
    if constexpr (Epi::AFTER_DRAIN) { E.fused(acc, cur, wr, wc, fr, fq, lds, wid, lane); S.done(cur); }
#undef PG8_SA
#undef PG8_SB
#undef PG8_STAGE
#undef PG8_LDA
#undef PG8_LDB
#undef PG8_MMA
#undef PG8_WAIT_V
#undef PG8_WAIT_L
#undef PG8_BAR
#undef PG8_SCHED
}
}
#define GAS __attribute__((address_space(1)))
#define LAS __attribute__((address_space(3)))
typedef unsigned short bf16;
typedef unsigned v4u __attribute__((ext_vector_type(4)));
typedef float f32x4 __attribute__((ext_vector_type(4)));
typedef short bf16x8 __attribute__((ext_vector_type(8)));
typedef GAS unsigned gu32;
typedef GAS unsigned long long gu64;
#define RLX_AGENT __ATOMIC_RELAXED, __HIP_MEMORY_SCOPE_AGENT
#define LDS_WAIT() asm volatile("s_waitcnt lgkmcnt(0)" ::: "memory")
#define VM_WAIT() asm volatile("s_waitcnt vmcnt(0)" ::: "memory")
__device__ __forceinline__ unsigned long long rt() { return __builtin_amdgcn_s_memrealtime(); }
__device__ __forceinline__ unsigned f2bf(float f) { unsigned u = __builtin_bit_cast(unsigned, f); return (u + 0x7fffu + ((u >> 16) & 1u)) >> 16; }
__device__ __forceinline__ unsigned pk2(float lo, float hi) { return f2bf(lo) | (f2bf(hi) << 16); }

#define XB_TMO      128
#define XB_XCNT(j)  (256  + 64 * (j))
#define XB_XSUB(j)  (1280 + 64 * (j))
#define XB_XGEN(j)  (2304 + 64 * (j))
#define XB_TOP      3328
#define XB_TOPGEN   3392
#define XCD_BAR_WORDS 3456
#define XB_SPIN_CAP (1u << 18)

__device__ __forceinline__ unsigned xb_ld(unsigned* p)              { return __hip_atomic_load(p, __ATOMIC_RELAXED, __HIP_MEMORY_SCOPE_AGENT); }
__device__ __forceinline__ unsigned xb_add(unsigned* p, unsigned v) { return __hip_atomic_fetch_add(p, v, __ATOMIC_RELAXED, __HIP_MEMORY_SCOPE_AGENT); }
__device__ __forceinline__ unsigned xb_xcc_id() { return (unsigned)__builtin_amdgcn_s_getreg((3 << 11) | 20) & 0xFu; }
#define XB_SPIN(cond, bar) do { unsigned _sp = 0; while (cond) { __builtin_amdgcn_s_sleep(1); \
    if ((++_sp & 255u) == 0u) { if (xb_ld(&(bar)[XB_TMO])) break; if (_sp > XB_SPIN_CAP) { atomicAdd(&(bar)[XB_TMO], 1u); break; } } } } while (0)

struct XcdBarrier {
    unsigned* bar; unsigned x;
    volatile LAS unsigned* st;
};

__device__ __forceinline__ XcdBarrier xcd_barrier_post(unsigned* bar, volatile LAS unsigned* st) {
    XcdBarrier b; b.bar = bar; b.x = xb_xcc_id(); b.st = st;
    if (threadIdx.x == 0) (void)xb_add(&bar[XB_XCNT(b.x)], 1u);
    return b;
}
__device__ __forceinline__ void xcd_barrier_complete(unsigned* bar, unsigned x, unsigned& nloc, unsigned& nx) {
    const unsigned G = gridDim.x * gridDim.y * gridDim.z;
    unsigned sum, cnt, mine, sp = 0u;
    for (;;) {
        sum = 0u; cnt = 0u; mine = 0u;
#pragma unroll
        for (unsigned j = 0; j < 16; ++j) { const unsigned c = xb_ld(&bar[XB_XCNT(j)]); sum += c; cnt += (c > 0u) ? 1u : 0u; mine = (j == x) ? c : mine; }
        if (sum == G) break;
        __builtin_amdgcn_s_sleep(1);
        if ((++sp & 255u) == 0u) { if (xb_ld(&bar[XB_TMO])) break; if (sp > XB_SPIN_CAP) { atomicAdd(&bar[XB_TMO], 1u); break; } }
    }
    nloc = mine > 0u ? mine : 1u; nx = cnt > 0u ? cnt : 1u;
}

__device__ __forceinline__ void xcd_barrier(const XcdBarrier& b) {
    asm volatile("s_waitcnt vmcnt(0)" ::: "memory");
    __syncthreads();
    if (threadIdx.x == 0) {
        unsigned* bar = b.bar;
        __builtin_amdgcn_s_waitcnt(0);
        unsigned nloc = b.st[0], nx = b.st[1];
        if (nloc == 0u) { xcd_barrier_complete(bar, b.x, nloc, nx); b.st[0] = nloc; b.st[1] = nx; }
        const unsigned old = xb_add(&bar[XB_XSUB(b.x)], 1u);
        const unsigned gen = old / nloc;
        if (old + 1u == (gen + 1u) * nloc) {
            __builtin_amdgcn_fence(__ATOMIC_RELEASE, "agent");
            asm volatile("s_waitcnt vmcnt(0)" ::: "memory");
            const unsigned og = xb_add(&bar[XB_TOP], 1u);
            const unsigned tg = og / nx;
            if (og + 1u == (tg + 1u) * nx) xb_add(&bar[XB_TOPGEN], 1u);
            else XB_SPIN(xb_ld(&bar[XB_TOPGEN]) == tg, bar);
            __builtin_amdgcn_fence(__ATOMIC_ACQUIRE, "agent");
            xb_add(&bar[XB_XGEN(b.x)], 1u);
            asm volatile("s_waitcnt vmcnt(0)" ::: "memory");
        } else {
            XB_SPIN(xb_ld(&bar[XB_XGEN(b.x)]) == gen, bar);
            __builtin_amdgcn_fence(__ATOMIC_ACQUIRE, "agent");
            asm volatile("s_waitcnt vmcnt(0)" ::: "memory");
        }
    }
    __syncthreads();
}
#include <hip/hip_bf16.h>
#include <cmath>
namespace attn_body {
using bf16=__hip_bfloat16;
using bf16x8=__attribute__((ext_vector_type(8)))short;
using s16x4=__attribute__((ext_vector_type(4)))short;
using f32x16=__attribute__((ext_vector_type(16)))float;
using u32x4=__attribute__((ext_vector_type(4)))unsigned;
constexpr int BATCH=4,NHEAD=8,SEQ=4096,D=64,DM=NHEAD*D;
constexpr int NW=8,QBLK=32,QB=QBLK*NW,KVBLK=64,NQB=SEQ/QB;
constexpr int ATTN_PITCH=DM, ATTN_UNIT_ROWS=QB;
__device__ __forceinline__ int crow(int r,int hi){return (r&3)+8*(r>>2)+4*hi;}
#define SBAR() __builtin_amdgcn_sched_barrier(0)
__device__ __forceinline__ void cmask(f32x16&p0,f32x16&p1,int jb,int qrel,int hi){
  const float NEG=-INFINITY; int kb=64*jb+4*hi;
  #pragma unroll
  for(int r=0;r<16;++r){int kv=kb+(r&3)+8*(r>>2); if(kv>qrel)p0[r]=NEG; if(kv+32>qrel)p1[r]=NEG;}
}

constexpr int NSLOT=3, SLOTB=8192;
constexpr int LDS_K=0, LDS_V=NSLOT*SLOTB, LDS_WS=2*NSLOT*SLOTB, LDS_OST=LDS_WS+NW*64*4, LDS_CK=LDS_OST+NW*4096, LDS_BYTES=LDS_CK+SEQ*4;
constexpr float C2=0.125f*1.4426950408889634f;
__device__ __forceinline__ void glds16(const void*gsrc,unsigned lds_dst){unsigned keep;
  asm volatile("s_mov_b32 %0, m0\n\ts_mov_b32 m0, %2\n\ts_nop 0\n\tglobal_load_lds_dwordx4 %1, off\n\ts_mov_b32 m0, %0":"=&s"(keep):"v"(gsrc),"s"(lds_dst):"memory");}
__device__ __forceinline__ float max3f(float a,float b,float c){float r;asm("v_max3_f32 %0, %1, %2, %3":"=v"(r):"v"(a),"v"(b),"v"(c));return r;}
__device__ __forceinline__ float max2f(float a,float b){float r;asm("v_max_f32_e32 %0, %1, %2":"=v"(r):"v"(a),"v"(b));return r;}
__device__ __forceinline__ float fadd_s(float a,float b){float r;asm("v_add_f32_e32 %0, %1, %2":"=v"(r):"v"(a),"v"(b));return r;}
__device__ __forceinline__ float fsub_s(float a,float b){float r;asm("v_sub_f32_e32 %0, %1, %2":"=v"(r):"v"(a),"v"(b));return r;}
typedef float f32x2_t __attribute__((ext_vector_type(2))); typedef __bf16 bf16x2_t __attribute__((ext_vector_type(2)));
__device__ __forceinline__ unsigned cvtpk_s(float lo,float hi){f32x2_t v={lo,hi};bf16x2_t b=__builtin_convertvector(v,bf16x2_t);return __builtin_bit_cast(unsigned,b);}
#define WAIT_BAR(N) asm volatile("s_waitcnt vmcnt(" #N ") lgkmcnt(0)\n\ts_barrier":::"memory")

__device__ __forceinline__ void qkt(f32x16&p0,f32x16&p1,const char*Kslot,const bf16x8*qr,int r32,int hi){
  const char*kb=Kslot+hi*1024+r32*16;
  #pragma unroll
  for(int d0=0;d0<4;++d0){
    const bf16x8 b0=*reinterpret_cast<const bf16x8*>(kb+d0*2048);
    const bf16x8 b1=*reinterpret_cast<const bf16x8*>(kb+d0*2048+512);
    p0=__builtin_amdgcn_mfma_f32_32x32x16_bf16(b0,qr[d0],p0,0,0,0);p1=__builtin_amdgcn_mfma_f32_32x32x16_bf16(b1,qr[d0],p1,0,0,0);}
}
typedef __attribute__((address_space(3))) const char* lds_cptr;
typedef short v4i16_t __attribute__((ext_vector_type(4)));
__device__ __forceinline__ void kload8(bf16x8*kf,lds_cptr kp){
  kf[0]=*(const __attribute__((address_space(3))) bf16x8*)(kp);      kf[1]=*(const __attribute__((address_space(3))) bf16x8*)(kp+512);
  kf[2]=*(const __attribute__((address_space(3))) bf16x8*)(kp+2048); kf[3]=*(const __attribute__((address_space(3))) bf16x8*)(kp+2560);
  kf[4]=*(const __attribute__((address_space(3))) bf16x8*)(kp+4096); kf[5]=*(const __attribute__((address_space(3))) bf16x8*)(kp+4608);
  kf[6]=*(const __attribute__((address_space(3))) bf16x8*)(kp+6144); kf[7]=*(const __attribute__((address_space(3))) bf16x8*)(kp+6656);
}
__device__ __forceinline__ void kload2(bf16x8*kf,lds_cptr kp,int j){ kf[2*j]=*(const __attribute__((address_space(3))) bf16x8*)(kp+j*2048); kf[2*j+1]=*(const __attribute__((address_space(3))) bf16x8*)(kp+j*2048+512); }
__device__ __forceinline__ s16x4 vtr(lds_cptr p){ return __builtin_bit_cast(s16x4,__builtin_amdgcn_ds_read_tr16_b64_v4i16((__attribute__((address_space(3))) v4i16_t*)p)); }
__device__ __forceinline__ float rowmax(const f32x16&p0,const f32x16&p1){
  float a=max3f(p0[0],p0[1],p1[0]),b=max3f(p0[2],p0[3],p1[1]);a=max3f(a,p1[2],p1[3]);
  #pragma unroll
  for(int r=4;r<16;r+=4){a=max3f(a,p0[r],p0[r+1]);b=max3f(b,p0[r+2],p0[r+3]);a=max3f(a,p1[r],p1[r+1]);b=max3f(b,p1[r+2],p1[r+3]);}
  const float m=max2f(a,b);
  auto rr=__builtin_amdgcn_permlane32_swap(__float_as_uint(m),__float_as_uint(m),false,false);
  return max2f(__uint_as_float(rr[0]),__uint_as_float(rr[1]));
}
__device__ __forceinline__ void pv(f32x16*o,int vb,bf16x8 pa0,bf16x8 pa1,bf16x8 pa2,bf16x8 pa3){
  #pragma unroll
  for(int d0=0;d0<2;++d0){s16x4 lo[4],hi[4];
    #pragma unroll
    for(int ks=0;ks<4;++ks){
      asm volatile("ds_read_b64_tr_b16 %0,%1 offset:%c2":"=&v"(lo[ks]):"v"(vb),"i"(d0*4096+ks*1024):"memory");
      asm volatile("ds_read_b64_tr_b16 %0,%1 offset:%c2":"=&v"(hi[ks]):"v"(vb),"i"(d0*4096+ks*1024+512):"memory");}
    asm volatile("s_waitcnt lgkmcnt(0)":::"memory");SBAR();
    #define PK(k) (bf16x8){lo[k][0],lo[k][1],lo[k][2],lo[k][3],hi[k][0],hi[k][1],hi[k][2],hi[k][3]}
    o[d0]=__builtin_amdgcn_mfma_f32_32x32x16_bf16(pa0,PK(0),o[d0],0,0,0);
    o[d0]=__builtin_amdgcn_mfma_f32_32x32x16_bf16(pa1,PK(1),o[d0],0,0,0);
    o[d0]=__builtin_amdgcn_mfma_f32_32x32x16_bf16(pa2,PK(2),o[d0],0,0,0);
    o[d0]=__builtin_amdgcn_mfma_f32_32x32x16_bf16(pa3,PK(3),o[d0],0,0,0);
    #undef PK
  }
}

#ifndef ATTN_STORE16
#define ATTN_STORE16(p,v) (*(u32x4*)(p)=(v))
#endif
template<int THRL> __device__ __forceinline__ void attn_unit(int b,int h,int qb,const bf16*Q,const bf16*__restrict__ K,const bf16*__restrict__ V,bf16*O,const float*__restrict__ c2,float M2,char*shm){
  int tid=threadIdx.x; asm volatile("":"+v"(tid)); const int lane=tid&63,r32=lane&31,hi=lane>>5; const int wid=__builtin_amdgcn_readfirstlane(tid>>6);
  const long rowbase=(long)b*SEQ; const int q0=qb*QB;
  const bf16*Qw=Q+(rowbase+q0+wid*QBLK)*DM+h*D;
  const bf16*Kh0=K+rowbase*DM+h*D,*Vh0=V+rowbase*DM+h*D;
  const unsigned lds0=(unsigned)(uintptr_t)shm;
  float*wsf=(float*)(shm+LDS_WS)+wid*64;
  const unsigned kdst=lds0+LDS_K+wid*1024, vdst=lds0+LDS_V+wid*1024;
  #define DMA_K(t,slot) glds16(ksrc+(long)(t)*KVBLK*DM,(unsigned)__builtin_amdgcn_readfirstlane(kdst+(slot)))
  #define DMA_V(t,slot) glds16(vsrc+(long)(t)*KVBLK*DM,(unsigned)__builtin_amdgcn_readfirstlane(vdst+(slot)))
  const int vb0=(int)(lds0+LDS_V)+((lane>>4)&1)*32+(lane&3)*8+(4*hi+((lane&15)>>2))*64;
  const char*Kbase=shm+LDS_K; bf16x8 kf[8];
  const lds_cptr shm3=(lds_cptr)shm; const lds_cptr kp0=shm3+LDS_K+hi*1024+r32*16; const lds_cptr vp0=shm3+LDS_V+((lane>>4)&1)*32+(lane&3)*8+(4*hi+((lane&15)>>2))*64;
  const int NT0=(q0+QB)/KVBLK;
  int ts; { const int tl=lane; const float cqa=c2[q0]; const float ckb=(tl<NT0-4)?c2[64*tl+63]:cqa; const unsigned long long bm=__ballot((tl<NT0-4)&&(cqa-ckb< -(24.f+2.f*M2))); ts=__builtin_popcountll(bm)&~1; }
  ts=__builtin_amdgcn_readfirstlane(ts);
  const int NT=NT0-ts;
  const bf16*Kh=Kh0+(long)ts*KVBLK*DM,*Vh=Vh0+(long)ts*KVBLK*DM;
  const bf16*ksrc=Kh+(long)lane*DM+wid*8;
  const bf16*vsrc=Vh+(long)(16*(wid&3)+(lane>>2))*DM+(wid>>2)*32+(lane&3)*8;
  typedef float f32x4_t __attribute__((ext_vector_type(4)));
  int tidl=tid; asm volatile("":"+v"(tidl));
  const int nck4=(q0+QB)/4; f32x4_t ckv0=f32x4_t{},ckv1=f32x4_t{}; if(tidl<nck4)ckv0=((const f32x4_t*)c2)[tidl]; if(tidl+512<nck4)ckv1=((const f32x4_t*)c2)[tidl+512];
  const float cq=c2[q0+wid*QBLK+r32]-M2;
  DMA_K(0,0);DMA_V(0,0);DMA_K(1,SLOTB);
  bf16x8 qr[4];
  #pragma unroll
  for(int d0=0;d0<4;++d0)qr[d0]=*reinterpret_cast<const bf16x8*>(&Qw[(long)r32*DM+d0*16+hi*8]);
  float l_reg=0.f;f32x16 o[2];o[0]=f32x16{};o[1]=f32x16{};
  { __attribute__((address_space(3))) f32x4_t*ckl=(__attribute__((address_space(3))) f32x4_t*)((lds_cptr)shm+LDS_CK); if(tidl<nck4)ckl[tidl]=ckv0; if(tidl+512<nck4)ckl[tidl+512]=ckv1; }
  const __attribute__((address_space(3))) f32x4_t*ckp=(const __attribute__((address_space(3))) f32x4_t*)((lds_cptr)shm+LDS_CK)+hi+ts*16;
  #define CKLD(P0,P1,t) do{ _Pragma("unroll") for(int g_=0;g_<4;++g_){ const f32x4_t a_=ckp[(t)*16+2*g_], b_=ckp[(t)*16+8+2*g_]; P0[4*g_]=a_[0];P0[4*g_+1]=a_[1];P0[4*g_+2]=a_[2];P0[4*g_+3]=a_[3]; P1[4*g_]=b_[0];P1[4*g_+1]=b_[1];P1[4*g_+2]=b_[2];P1[4*g_+3]=b_[3]; } }while(0)
  #define CKSUB(P0,P1) do{ _Pragma("unroll") for(int r=0;r<16;++r){P0[r]=cq-P0[r];P1[r]=cq-P1[r];} }while(0)
  const int qrel=wid*QBLK+r32;
  #define CMASK(P0,P1,t) do{int jb_=(t)-(NT-4); if(jb_>=0)cmask(P0,P1,jb_,qrel,hi);}while(0)
  #define START(P0,P1) do{ _Pragma("unroll") for(int r=0;r<16;++r)P0[r]=__builtin_amdgcn_exp2f(P0[r]); }while(0)
  #define RESC() do{}while(0)
  f32x16 pA0,pA1,pB0,pB1;
  int sl_prev=0,sl_cur=0,sl_next=SLOTB;
  #define ROT() do{sl_prev=sl_cur;sl_cur=sl_next;sl_next=(sl_next==(NSLOT-1)*SLOTB)?0:sl_next+SLOTB;}while(0)
  DMA_K(2,2*SLOTB);
  WAIT_BAR(3);
  CKLD(pA0,pA1,0);CKSUB(pA0,pA1);
  qkt(pA0,pA1,Kbase,qr,r32,hi);asm volatile("s_nop 15\n\ts_nop 7":"+v"(pA0),"+v"(pA1));CMASK(pA0,pA1,0);
  CKLD(pB0,pB1,1);CKSUB(pB0,pB1);
  START(pA0,pA1);
  _Pragma("unroll") for(int r=0;r<16;++r)pA1[r]=__builtin_amdgcn_exp2f(pA1[r]);
  WAIT_BAR(0);
  DMA_K(3,0);DMA_V(1,SLOTB);
  ROT();
  kload8(kf,kp0+sl_cur);
  WAIT_BAR(2);
  s16x4 vlo[8],vhi[8]; u32x4 pw0,pw1,pw2,pw3;
  #define PKW(P,B) cvtpk_s(P[B],P[B+1])
  #define PAF(k) __builtin_bit_cast(bf16x8,pw##k)
  #define VFR(i) (bf16x8){vlo[i][0],vlo[i][1],vlo[i][2],vlo[i][3],vhi[i][0],vhi[i][1],vhi[i][2],vhi[i][3]}
  #define PIN(x) asm volatile("":"+v"(x))
  #define MX3(a,b,c) __builtin_fmaxf(__builtin_fmaxf((a),(b)),(c))
  #define GAPA(MF,A0,A1,A2,A3,W0,W1,PW) do{ MF; sacc+=A0; sacc+=A1; sacc+=A2; sacc+=A3; PIN(sacc); W0; W1; PIN(PW); SBAR(); }while(0)
  #define EX(v) __builtin_amdgcn_exp2f(v)
  #define GAPB(MF,X,B) do{ MF; X[B]=EX(X[B]); X[B+1]=EX(X[B+1]); X[B+2]=EX(X[B+2]); X[B+3]=EX(X[B+3]); PIN(X); SBAR(); }while(0)
  #define VRD(i) do{ vlo[i]=vtr(vp_+(((i)>>2)*4096+((i)&3)*1024)); vhi[i]=vtr(vp_+(((i)>>2)*4096+((i)&3)*1024+512)); }while(0)
  #define KRD(G,j) do{ if(G){ kload2(kf,kp0+sl_next,j); SBAR(); } }while(0)
  #define STEP(C0,C1,P0,P1,t,GK,GV,GL) do{ SBAR(); \
    const lds_cptr vp_=vp0+sl_prev; \
    VRD(0); SBAR(); float sacc=(P0[0]+P0[1]); \
    GAPA(C0=__builtin_amdgcn_mfma_f32_32x32x16_bf16(kf[0],qr[0],C0,0,0,0), P0[2],P0[3],P0[4],P0[5],     pw0[0]=PKW(P0,0), pw0[1]=PKW(P0,2), pw0); \
    VRD(4); SBAR(); GAPA(C1=__builtin_amdgcn_mfma_f32_32x32x16_bf16(kf[1],qr[0],C1,0,0,0), P0[6],P0[7],P0[8],P0[9],     pw0[2]=PKW(P0,4), pw0[3]=PKW(P0,6), pw0); \
    VRD(1); SBAR(); GAPA(C0=__builtin_amdgcn_mfma_f32_32x32x16_bf16(kf[2],qr[1],C0,0,0,0),   P0[10],P0[11],P0[12],P0[13], pw1[0]=PKW(P0,8), pw1[1]=PKW(P0,10), pw1); \
    VRD(5); SBAR(); GAPA(C1=__builtin_amdgcn_mfma_f32_32x32x16_bf16(kf[3],qr[1],C1,0,0,0),   P0[14],P0[15],P1[0],P1[1],   pw1[2]=PKW(P0,12),pw1[3]=PKW(P0,14), pw1); \
    VRD(2); SBAR(); GAPA(C0=__builtin_amdgcn_mfma_f32_32x32x16_bf16(kf[4],qr[2],C0,0,0,0),   P1[2],P1[3],P1[4],P1[5],     pw2[0]=PKW(P1,0), pw2[1]=PKW(P1,2), pw2); \
    VRD(6); SBAR(); GAPA(C1=__builtin_amdgcn_mfma_f32_32x32x16_bf16(kf[5],qr[2],C1,0,0,0),   P1[6],P1[7],P1[8],P1[9],     pw2[2]=PKW(P1,4), pw2[3]=PKW(P1,6), pw2); \
    VRD(3); SBAR(); GAPA(C0=__builtin_amdgcn_mfma_f32_32x32x16_bf16(kf[6],qr[3],C0,0,0,0),   P1[10],P1[11],P1[12],P1[13], pw3[0]=PKW(P1,8), pw3[1]=PKW(P1,10), pw3); \
    VRD(7); SBAR(); GAPA(C1=__builtin_amdgcn_mfma_f32_32x32x16_bf16(kf[7],qr[3],C1,0,0,0),   P1[14],P1[15],0.f,0.f,       pw3[2]=PKW(P1,12),pw3[3]=PKW(P1,14), pw3); \
    l_reg+=sacc; \
    if(GK){DMA_K((t)+3,sl_cur);} if(GV){DMA_V((t)+1,sl_next);} \
    CMASK(C0,C1,t); \
    SBAR(); \
    GAPB(o[0]=__builtin_amdgcn_mfma_f32_32x32x16_bf16(PAF(0),VFR(0),o[0],0,0,0), C0,0); \
    GAPB(o[1]=__builtin_amdgcn_mfma_f32_32x32x16_bf16(PAF(0),VFR(4),o[1],0,0,0), C0,4); \
    KRD(GL,0); GAPB(o[0]=__builtin_amdgcn_mfma_f32_32x32x16_bf16(PAF(1),VFR(1),o[0],0,0,0), C0,8); \
    KRD(GL,1); GAPB(o[1]=__builtin_amdgcn_mfma_f32_32x32x16_bf16(PAF(1),VFR(5),o[1],0,0,0), C0,12); \
    KRD(GL,2); GAPB(o[0]=__builtin_amdgcn_mfma_f32_32x32x16_bf16(PAF(2),VFR(2),o[0],0,0,0), C1,0); \
    KRD(GL,3); GAPB(o[1]=__builtin_amdgcn_mfma_f32_32x32x16_bf16(PAF(2),VFR(6),o[1],0,0,0), C1,4); \
    GAPB(o[0]=__builtin_amdgcn_mfma_f32_32x32x16_bf16(PAF(3),VFR(3),o[0],0,0,0), C1,8); \
    GAPB(o[1]=__builtin_amdgcn_mfma_f32_32x32x16_bf16(PAF(3),VFR(7),o[1],0,0,0), C1,12); \
    if(GL){ CKLD(P0,P1,(t)+1); CKSUB(P0,P1); } \
    }while(0)
  int t=1;
  #undef CMASK
  #define CMASK(P0,P1,t) do{}while(0)
  for(;t+5<NT;t+=2){
    STEP(pB0,pB1,pA0,pA1,t,true,true,true);     WAIT_BAR(2); RESC(); ROT();
    STEP(pA0,pA1,pB0,pB1,t+1,true,true,true);   WAIT_BAR(2); RESC(); ROT();
  }
  #undef CMASK
  #define CMASK(P0,P1,t) do{int jb_=(t)-(NT-4); if(jb_>=0)cmask(P0,P1,jb_,qrel,hi);}while(0)
  #define ENDW(tt) do{ if((tt)+3<NT){WAIT_BAR(2);} else if((tt)+2<NT){WAIT_BAR(1);} else {WAIT_BAR(0);} }while(0)
  for(;t+1<NT;t+=2){
    STEP(pB0,pB1,pA0,pA1,t,(t+3<NT),(t+1<NT),(t+1<NT));       ENDW(t);   RESC(); ROT();
    STEP(pA0,pA1,pB0,pB1,t+1,(t+4<NT),(t+2<NT),(t+2<NT));     ENDW(t+1); RESC(); ROT();
  }
  STEP(pB0,pB1,pA0,pA1,NT-1,false,false,false); RESC();
  { float sacc=pB0[0]+pB0[1]; _Pragma("unroll") for(int r=2;r<16;++r)sacc+=pB0[r]; _Pragma("unroll") for(int r=0;r<16;++r)sacc+=pB1[r]; l_reg+=sacc;
    pw0=(u32x4){PKW(pB0,0),PKW(pB0,2),PKW(pB0,4),PKW(pB0,6)};pw1=(u32x4){PKW(pB0,8),PKW(pB0,10),PKW(pB0,12),PKW(pB0,14)};pw2=(u32x4){PKW(pB1,0),PKW(pB1,2),PKW(pB1,4),PKW(pB1,6)};pw3=(u32x4){PKW(pB1,8),PKW(pB1,10),PKW(pB1,12),PKW(pB1,14)};
    SBAR(); pv(o,vb0+sl_cur,PAF(0),PAF(1),PAF(2),PAF(3)); }
  #undef PKW
  #undef PAF
  #undef VFR
  #undef PIN
  #undef MX3
  #undef GAPA
  #undef GAPB
  #undef EX
  #undef VRD
  #undef KRD
  #undef STEP
  #undef ENDW
  {auto rr=__builtin_amdgcn_permlane32_swap(__float_as_uint(l_reg),__float_as_uint(l_reg),false,false);l_reg=__uint_as_float(rr[0])+__uint_as_float(rr[1]);}
  if(hi==0)wsf[32+r32]=l_reg;asm volatile("s_waitcnt lgkmcnt(0)":::"memory");
  float rli[16];
  #pragma unroll
  for(int r=0;r<16;++r)rli[r]=__builtin_amdgcn_rcpf(wsf[32+crow(r,hi)]);
  bf16*Ow=O+(rowbase+q0+wid*QBLK)*DM+h*D;
  { bf16*stg=(bf16*)(shm+LDS_OST)+wid*2048;
    #pragma unroll
    for(int r=0;r<16;++r){const int orow=crow(r,hi);
      #pragma unroll
      for(int d0=0;d0<2;++d0)stg[orow*64+d0*32+r32]=__float2bfloat16(o[d0][r]*rli[r]);}
    asm volatile("s_waitcnt lgkmcnt(0)":::"memory");
    #pragma unroll
    for(int i=0;i<4;++i){const int row=i*8+(lane>>3),ch=lane&7; const u32x4 v=*(const u32x4*)(stg+row*64+ch*8); ATTN_STORE16(Ow+(long)row*DM+ch*8,v);} }
  asm volatile("s_waitcnt lgkmcnt(0)\n\ts_barrier":::"memory");
  #undef DMA_K
  #undef DMA_V
  #undef CMASK
  #undef START
  #undef RESC
  #undef ROT
  #undef CKLD
  #undef CKSUB
}
constexpr int ATTN_LDS_BYTES=LDS_BYTES;
struct AttnTensors { const bf16* Q; const bf16* K; const bf16* V; bf16* O; const float* C2T; float M2; };
struct AttnUnit { int bh; int qb; };
struct StaticOrder {
  int vcu, G;
  __device__ __forceinline__ explicit StaticOrder(int grid,int v):vcu(v),G(grid){}
  __device__ __forceinline__ bool next(int i,AttnUnit&u)const{ const int L=i*G+vcu; if(L>=BATCH*NHEAD*NQB)return false; const int r=L>>8, idx=L&255, k=idx&7; u.bh=idx>>3; u.qb=(r==0)?(NQB-1-k):k; return true; }
  __device__ __forceinline__ void a_ready(const AttnUnit&)const{}
  __device__ __forceinline__ void done(const AttnUnit&)const{}
};
struct QueueOrder {
  unsigned* cnt; volatile __attribute__((address_space(3))) unsigned* slot;
  __device__ __forceinline__ bool next(int,AttnUnit&u)const{
    if(threadIdx.x==0){ *slot=__hip_atomic_fetch_add(cnt,1u,__ATOMIC_RELAXED,__HIP_MEMORY_SCOPE_AGENT); }
    __syncthreads(); const unsigned L=*slot; __syncthreads();
    if(L>=(unsigned)(BATCH*NHEAD*NQB))return false;
    u.qb=NQB-1-(int)(L>>5); u.bh=(int)(L&31); return true; }
  __device__ __forceinline__ void a_ready(const AttnUnit&)const{}
  __device__ __forceinline__ void done(const AttnUnit&)const{}
};
template<class Sched,int THRL=8> __device__ __forceinline__ void attn_phase(char*lds,const AttnTensors&T,const Sched&S){
  AttnUnit u;
  for(int i=0;S.next(i,u);++i){ S.a_ready(u); attn_unit<THRL>(u.bh/NHEAD,u.bh%NHEAD,u.qb,T.Q,T.K,T.V,T.O,T.C2T+(size_t)u.bh*SEQ,T.M2,lds); S.done(u); }
}
#undef SBAR
#undef WAIT_BAR
}

constexpr int NWAVES = 8, NTHR = 512;
constexpr int DM = 1024, NB = 4, SEQ = 4096, DB = 128, DSEQ = 8, PAST = 2048, PAGE = 128, NPAGES = 16;
constexpr int MP = NB * SEQ, MS = DB * DSEQ, M = MP + MS;
constexpr int DP = 512, DA = 512, NH = 8, HD = 64, DIN = 4104, NPROJ = 4096;
constexpr int NKEYS = 128, NEXP = 16384, PH = 8, TOPK = 16, DKH = 128, DQ = 2048;
constexpr float EPS = 1e-6f;
constexpr float LOG2E = 1.4426950408889634f;
constexpr float C2 = 0.125f * LOG2E;
constexpr size_t O_YP = 0, O_YS = O_YP + (size_t)MP * DM, O_KP = O_YS + (size_t)MS * DM, O_VP = O_KP + (size_t)MP * DA, O_LFP = O_VP + (size_t)MP * DA,
                 O_PP = O_LFP + (size_t)MP * NH, O_KS = O_PP + (size_t)NB * 15 * DP, O_VS = O_KS + (size_t)MS * DA, O_LFS = O_VS + (size_t)MS * DA,
                 O_PS = O_LFS + (size_t)MS * NH, O_END = O_PS + (size_t)DB * 15 * DP;
constexpr size_t MiB = 1u << 20;
constexpr size_t WS_CTL = 0, CTL_ZERO_BYTES = 64 * 1024;
constexpr size_t WS_WIN = 2 * MiB, WS_WBP = 10 * MiB, WS_WBA = 11 * MiB, WS_WOUT = 12 * MiB, WS_WQ = 14 * MiB, WS_SUBK = 18 * MiB, WS_CP2 = 19 * MiB, WS_RSS = 20 * MiB, WS_US = 22 * MiB, WS_VS = 23 * MiB;
constexpr size_t WS_PU = 32 * MiB, WS_PV = 64 * MiB, WS_XN = 96 * MiB  , WS_U = 132 * MiB, WS_Q = 150 * MiB, WS_K = 168 * MiB, WS_V = 186 * MiB,
                 WS_GA = 204 * MiB, WS_GB = 240 * MiB, WS_PO = 276 * MiB, WS_AO = 294 * MiB, WS_T = 312 * MiB, WS_MIX = 348 * MiB, WS_PQ = 384 * MiB,
                 WS_SI = 456 * MiB, WS_SG = 466 * MiB, WS_H = 476 * MiB, WS_END = 548 * MiB;
constexpr int CW_BAR = 4096;
constexpr int LDS_BYTES = 163840;
constexpr int SCR_BYTES = 159 * 1024;
constexpr int MISC_OFF = SCR_BYTES;

typedef unsigned short bf16;
typedef unsigned v4u __attribute__((ext_vector_type(4)));
typedef unsigned v2u __attribute__((ext_vector_type(2)));
typedef float f32x4 __attribute__((ext_vector_type(4)));
typedef float f32x2 __attribute__((ext_vector_type(2)));

__device__ __forceinline__ float bf2f(unsigned short b) { return __uint_as_float((unsigned)b << 16); }
__device__ __forceinline__ float bflo(unsigned w) { return __uint_as_float(w << 16); }
__device__ __forceinline__ float bfhi(unsigned w) { return __uint_as_float(w & 0xffff0000u); }
typedef __bf16 bf16x2_t __attribute__((ext_vector_type(2)));
__device__ __forceinline__ unsigned pkbf(float lo, float hi) { f32x2 v = {lo, hi}; bf16x2_t b = __builtin_convertvector(v, bf16x2_t); return __builtin_bit_cast(unsigned, b); }
__device__ __forceinline__ float wave_sum(float v) {
#pragma unroll
    for (int o = 1; o < 64; o <<= 1) v += __shfl_xor(v, o);
    return v;
}
__device__ __forceinline__ float wave_max(float v) {
#pragma unroll
    for (int o = 1; o < 64; o <<= 1) v = fmaxf(v, __shfl_xor(v, o));
    return v;
}

struct Args {
    const float* x_p; const float* x_s; const float* cache_k; const float* cache_v; const float* cache_lf; const float* state_pool; const int* page_table;
    const float* norm_mix_g; const float* w_in; const float* b_forget; const float* q_norm_g; const float* k_norm_g; const float* pool_mix_w; const float* pool_scale;
    const float* w_bp; const float* w_ba; const float* w_out; const float* norm_ffn_g; const float* w_query; const float* sub_keys; const float* peer_u; const float* peer_v;
    float* out; unsigned char* ws; int ph_lo, ph_hi, li, pad;
};

using pg8::Unit;
struct EpiInProj {
    static constexpr bool PERM = true, AFTER_DRAIN = false, CHAIN = false;
    bf16 *U, *Q, *K, *V, *GA, *GB; float* out; const float *gq, *gk; int pn_off;
    __device__ __forceinline__ void operator()(const f32x4 (&acc)[2][2][4][2], const Unit& u, int wr, int wc, int fr, int fq) const {
        const int pn = u.pn + pn_off; const int row0 = u.pm * 256 + wr * 64 + fr; const bool prompt = u.pm < (MP / 256);
        if (pn < 2) {
#pragma unroll
            for (int ai = 0; ai < 2; ++ai)
#pragma unroll
                for (int m = 0; m < 4; ++m) { const int row = row0 + ai * 128 + m * 16;
                    float* tail = nullptr;
                    if (prompt) { const int s = row & (SEQ - 1), b = row >> 12; if (s >= SEQ - 15) tail = out + O_PP + (size_t)(b * 15 + (s - (SEQ - 15))) * DP; }
                    else { const int rs = row - MP; tail = out + O_PS + (size_t)((rs >> 3) * 15 + 7 + (rs & 7)) * DP; }
#pragma unroll
                    for (int bj = 0; bj < 2; ++bj) { const int col = pn * 256 + bj * 128 + wc * 32 + 8 * fq; const f32x4 v0 = acc[ai][bj][m][0], v1 = acc[ai][bj][m][1];
                        v4u w; w.x = pkbf(v0[0], v0[1]); w.y = pkbf(v0[2], v0[3]); w.z = pkbf(v1[0], v1[1]); w.w = pkbf(v1[2], v1[3]);
                        *(v4u*)(U + (size_t)row * DP + col) = w;
                        if (tail) { *(f32x4*)(tail + col) = v0; *(f32x4*)(tail + col + 4) = v1; } } }
        } else if (pn < 6) {
            const bool isq = pn < 4; const int head = 4 * (pn & 1) + wc; const float* g = isq ? gq : gk;
            f32x4 gv[2][2];
#pragma unroll
            for (int bj = 0; bj < 2; ++bj)
#pragma unroll
                for (int n = 0; n < 2; ++n) gv[bj][n] = *(const f32x4*)(g + 32 * bj + 8 * fq + 4 * n);
            bf16* dst = isq ? Q : K;
#pragma unroll
            for (int ai = 0; ai < 2; ++ai)
#pragma unroll
                for (int m = 0; m < 4; ++m) { const int row = row0 + ai * 128 + m * 16; float ss = 0.f;
#pragma unroll
                    for (int bj = 0; bj < 2; ++bj)
#pragma unroll
                        for (int n = 0; n < 2; ++n) { const f32x4 x = acc[ai][bj][m][n]; ss += (x[0] * x[0] + x[1] * x[1]) + (x[2] * x[2] + x[3] * x[3]); }
                    ss += __shfl_xor(ss, 16); ss += __shfl_xor(ss, 32);
                    float r = 1.0f / sqrtf(ss * (1.0f / 64.0f) + EPS);
                    float* kout = isq ? nullptr : (prompt ? out + O_KP + (size_t)row * DA : out + O_KS + (size_t)(row - MP) * DA);
                    const float rq = isq ? r * C2 : r;
#pragma unroll
                    for (int bj = 0; bj < 2; ++bj) { const int col = head * 64 + 32 * bj + 8 * fq; const f32x4 v0 = acc[ai][bj][m][0] * gv[bj][0] * rq, v1 = acc[ai][bj][m][1] * gv[bj][1] * rq;
                        v4u w; w.x = pkbf(v0[0], v0[1]); w.y = pkbf(v0[2], v0[3]); w.z = pkbf(v1[0], v1[1]); w.w = pkbf(v1[2], v1[3]);
                        *(v4u*)(dst + (size_t)row * DA + col) = w;
                        if (!isq) { __builtin_nontemporal_store(v0, (f32x4*)(kout + col)); __builtin_nontemporal_store(v1, (f32x4*)(kout + col + 4)); } } }
        } else if (pn < 8) {
#pragma unroll
            for (int ai = 0; ai < 2; ++ai)
#pragma unroll
                for (int m = 0; m < 4; ++m) { const int row = row0 + ai * 128 + m * 16;
                    float* vout = prompt ? out + O_VP + (size_t)row * DA : out + O_VS + (size_t)(row - MP) * DA;
#pragma unroll
                    for (int bj = 0; bj < 2; ++bj) { const int col = (pn - 6) * 256 + bj * 128 + wc * 32 + 8 * fq; const f32x4 v0 = acc[ai][bj][m][0], v1 = acc[ai][bj][m][1];
                        v4u w; w.x = pkbf(v0[0], v0[1]); w.y = pkbf(v0[2], v0[3]); w.z = pkbf(v1[0], v1[1]); w.w = pkbf(v1[2], v1[3]);
                        *(v4u*)(V + (size_t)row * DA + col) = w; __builtin_nontemporal_store(v0, (f32x4*)(vout + col)); __builtin_nontemporal_store(v1, (f32x4*)(vout + col + 4)); } }
        } else {
            bf16* dst = pn < 12 ? GA : GB; const int ct = (pn < 12 ? pn - 8 : pn - 12) * 256;
#pragma unroll
            for (int ai = 0; ai < 2; ++ai)
#pragma unroll
                for (int m = 0; m < 4; ++m) { const int row = row0 + ai * 128 + m * 16;
#pragma unroll
                    for (int bj = 0; bj < 2; ++bj) { const int col = ct + bj * 128 + wc * 32 + 8 * fq; float s[8];
#pragma unroll
                        for (int n = 0; n < 2; ++n)
#pragma unroll
                            for (int i = 0; i < 4; ++i) s[4 * n + i] = __builtin_amdgcn_rcpf(1.0f + __builtin_amdgcn_exp2f(-LOG2E * acc[ai][bj][m][n][i]));
                        v4u w; w.x = pkbf(s[0], s[1]); w.y = pkbf(s[2], s[3]); w.z = pkbf(s[4], s[5]); w.w = pkbf(s[6], s[7]);
                        *(v4u*)(dst + (size_t)row * DM + col) = w; } }
        }
    }
};
template <int MODE> struct EpiGate {
    static constexpr bool PERM = true, AFTER_DRAIN = false, CHAIN = false;
    const bf16* G; const bf16* Tin; bf16* O;
    __device__ __forceinline__ void operator()(const f32x4 (&acc)[2][2][4][2], const Unit& u, int wr, int wc, int fr, int fq) const {
        const int row0 = u.pm * 256 + wr * 64 + fr;
#pragma unroll
        for (int ai = 0; ai < 2; ++ai)
#pragma unroll
            for (int m = 0; m < 4; ++m) { const int row = row0 + ai * 128 + m * 16;
#pragma unroll
                for (int bj = 0; bj < 2; ++bj) { const size_t off = (size_t)row * DM + u.pn * 256 + bj * 128 + wc * 32 + 8 * fq;
                    const v4u g = *(const v4u*)(G + off); const f32x4 v0 = acc[ai][bj][m][0], v1 = acc[ai][bj][m][1];
                    float r[8] = {v0[0] * bflo(g.x), v0[1] * bfhi(g.x), v0[2] * bflo(g.y), v0[3] * bfhi(g.y), v1[0] * bflo(g.z), v1[1] * bfhi(g.z), v1[2] * bflo(g.w), v1[3] * bfhi(g.w)};
                    if (MODE == 1) { const v4u t = *(const v4u*)(Tin + off);
                        r[0] += bflo(t.x); r[1] += bfhi(t.x); r[2] += bflo(t.y); r[3] += bfhi(t.y); r[4] += bflo(t.z); r[5] += bfhi(t.z); r[6] += bflo(t.w); r[7] += bfhi(t.w); }
                    v4u w; w.x = pkbf(r[0], r[1]); w.y = pkbf(r[2], r[3]); w.z = pkbf(r[4], r[5]); w.w = pkbf(r[6], r[7]);
                    *(v4u*)(O + off) = w; } }
    }
};
struct EpiMerge {
    static constexpr bool PERM = true, AFTER_DRAIN = false, CHAIN = true;
    const bf16* GA; const bf16* GB; bf16* O;
    __device__ __forceinline__ void mid(f32x4 (&acc)[2][2][4][2], const Unit& u, int wr, int wc, int fr, int fq) const {
        const int row0 = u.pm * 256 + wr * 64 + fr;
#pragma unroll
        for (int ai = 0; ai < 2; ++ai)
#pragma unroll
            for (int m = 0; m < 4; ++m) { const int row = row0 + ai * 128 + m * 16;
#pragma unroll
                for (int bj = 0; bj < 2; ++bj) { const size_t off = (size_t)row * DM + u.pn * 256 + bj * 128 + wc * 32 + 8 * fq;
                    const v4u ga = *(const v4u*)(GA + off), gb = *(const v4u*)(GB + off);
                    const unsigned gaw[4] = {ga.x, ga.y, ga.z, ga.w}, gbw[4] = {gb.x, gb.y, gb.z, gb.w};
#pragma unroll
                    for (int k = 0; k < 4; ++k) { const float r0 = bflo(gaw[k]) * __builtin_amdgcn_rcpf(fmaxf(bflo(gbw[k]), 0x1p-60f)), r1 = bfhi(gaw[k]) * __builtin_amdgcn_rcpf(fmaxf(bfhi(gbw[k]), 0x1p-60f));
                        acc[ai][bj][m][k >> 1][2 * (k & 1)] *= r0; acc[ai][bj][m][k >> 1][2 * (k & 1) + 1] *= r1; } } }
    }
    __device__ __forceinline__ void operator()(const f32x4 (&acc)[2][2][4][2], const Unit& u, int wr, int wc, int fr, int fq) const {
        const int row0 = u.pm * 256 + wr * 64 + fr;
#pragma unroll
        for (int ai = 0; ai < 2; ++ai)
#pragma unroll
            for (int m = 0; m < 4; ++m) { const int row = row0 + ai * 128 + m * 16;
#pragma unroll
                for (int bj = 0; bj < 2; ++bj) { const size_t off = (size_t)row * DM + u.pn * 256 + bj * 128 + wc * 32 + 8 * fq;
                    const v4u gb = *(const v4u*)(GB + off); const unsigned gbw[4] = {gb.x, gb.y, gb.z, gb.w}; unsigned ow[4];
#pragma unroll
                    for (int k = 0; k < 4; ++k) ow[k] = pkbf(acc[ai][bj][m][k >> 1][2 * (k & 1)] * fmaxf(bflo(gbw[k]), 0x1p-60f), acc[ai][bj][m][k >> 1][2 * (k & 1) + 1] * fmaxf(bfhi(gbw[k]), 0x1p-60f));
                    *(v4u*)(O + off) = (v4u){ow[0], ow[1], ow[2], ow[3]}; } }
    }
};
struct EpiOut {
    static constexpr bool PERM = true, AFTER_DRAIN = false, CHAIN = false;
    const float* xp; const float* xs; float* H; bf16* HG; const float* gf; float* RSS;
    __device__ __forceinline__ void operator()(const f32x4 (&acc)[2][2][4][2], const Unit& u, int wr, int wc, int fr, int fq) const {
        const int row0 = u.pm * 256 + wr * 64 + fr; const bool prompt = u.pm < (MP / 256);
#pragma unroll
        for (int ai = 0; ai < 2; ++ai)
#pragma unroll
            for (int m = 0; m < 4; ++m) { const int row = row0 + ai * 128 + m * 16; float ss = 0.f;
                const float* xr = prompt ? xp + (size_t)row * DM : xs + (size_t)(row - MP) * DM;
#pragma unroll
                for (int bj = 0; bj < 2; ++bj) { const int col = u.pn * 256 + bj * 128 + wc * 32 + 8 * fq;
                    const f32x4 h0 = acc[ai][bj][m][0] + *(const f32x4*)(xr + col), h1 = acc[ai][bj][m][1] + *(const f32x4*)(xr + col + 4);
                    ss += (h0[0] * h0[0] + h0[1] * h0[1]) + (h0[2] * h0[2] + h0[3] * h0[3]) + (h1[0] * h1[0] + h1[1] * h1[1]) + (h1[2] * h1[2] + h1[3] * h1[3]);
                    v4u w; w.x = pkbf(h0[0], h0[1]); w.y = pkbf(h0[2], h0[3]); w.z = pkbf(h1[0], h1[1]); w.w = pkbf(h1[2], h1[3]);
                    *(v4u*)(HG + (size_t)row * DM + col) = w; }
                ss += __shfl_xor(ss, 16); ss += __shfl_xor(ss, 32);
                if (fq == 0) RSS[(size_t)row * 16 + u.pn * 4 + wc] = ss; }
    }
};

struct Frame {
    LAS unsigned char* lds; volatile LAS unsigned* MISC; gu32* ctl;
    int tid, lane, wave, vcu, G;
};

__device__ __forceinline__ void transpose_item(const float* W, int ldw, int K, bf16* WT, int src_col0, int dst_row0, int k0, LAS float* scr, int lane, const float* kscale = nullptr) {
#pragma unroll 8
    for (int i = 0; i < 32; ++i) { const int kk = 2 * i + (lane >> 5); const float wv = W[(size_t)(k0 + kk) * ldw + src_col0 + (lane & 31)]; scr[kk * 33 + (lane & 31)] = kscale ? wv * kscale[k0 + kk] : wv; }
    LDS_WAIT(); asm volatile("" ::: "memory");
    const int c = lane & 7;
#pragma unroll
    for (int j = 0; j < 4; ++j) { const int n = (lane >> 3) + 8 * j; const LAS float* s = scr + (8 * c) * 33 + n;
        v4u o; o.x = pkbf(s[0 * 33], s[1 * 33]); o.y = pkbf(s[2 * 33], s[3 * 33]); o.z = pkbf(s[4 * 33], s[5 * 33]); o.w = pkbf(s[6 * 33], s[7 * 33]);
        *(v4u*)(WT + (size_t)(dst_row0 + n) * K + k0 + 8 * c) = o; }
    LDS_WAIT(); asm volatile("" ::: "memory");
}
__device__ __forceinline__ int win_src_col(int db) {
    if (db < 16) return 32 * db;
    if (db < 48) { const int base = db < 32 ? 512 : 1024; const int local = (db - 16) & 15, tile = local >> 3, blk = local & 7, bj = blk >> 2, w = blk & 3; return base + tile * 256 + 64 * w + 32 * bj; }
    if (db < 64) return 1536 + 32 * (db - 48);
    if (db < 96) return 2056 + 32 * (db - 64);
    return 3080 + 32 * (db - 96);
}
__device__ __forceinline__ void cvt_rows_bf16(const float* src, bf16* dst, size_t n8, size_t gtid, size_t gn) {
    for (size_t i = gtid; i < n8; i += gn) { const f32x4 a = *(const f32x4*)(src + 8 * i), b = *(const f32x4*)(src + 8 * i + 4);
        v4u w; w.x = pkbf(a[0], a[1]); w.y = pkbf(a[2], a[3]); w.z = pkbf(b[0], b[1]); w.w = pkbf(b[2], b[3]); *(v4u*)(dst + 8 * i) = w; }
}
template <bool I8> __device__ __forceinline__ void cvt_rows_fp8(const float* src, unsigned char* dst, float* scl, int gw, int NGW, int lane, const float* colscale = nullptr) {
    for (int e0 = gw; e0 < NEXP; e0 += 2 * NGW) {
        f32x4 q[2][4]; float mx[2];
#pragma unroll
        for (int u = 0; u < 2; ++u) { const int e = (e0 + u * NGW < NEXP) ? e0 + u * NGW : e0; const float* r = src + (size_t)e * DM + 16 * lane;
            q[u][0] = *(const f32x4*)r; q[u][1] = *(const f32x4*)(r + 4); q[u][2] = *(const f32x4*)(r + 8); q[u][3] = *(const f32x4*)(r + 12);
            if (colscale) {
#pragma unroll
                for (int j = 0; j < 4; ++j) q[u][j] = q[u][j] * *(const f32x4*)(colscale + 16 * lane + 4 * j); } }
#pragma unroll
        for (int u = 0; u < 2; ++u) { float m = 0.f;
#pragma unroll
            for (int j = 0; j < 4; ++j) m = fmaxf(m, fmaxf(fmaxf(fabsf(q[u][j][0]), fabsf(q[u][j][1])), fmaxf(fabsf(q[u][j][2]), fabsf(q[u][j][3]))));
            mx[u] = m; }
#pragma unroll
        for (int o = 1; o < 64; o <<= 1) { mx[0] = fmaxf(mx[0], __shfl_xor(mx[0], o)); mx[1] = fmaxf(mx[1], __shfl_xor(mx[1], o)); }
#pragma unroll
        for (int u = 0; u < 2; ++u) { const int e = e0 + u * NGW; if (e < NEXP) {
            if constexpr (I8) {
                float best = 1.0f, berr = 3.0e38f;
#pragma unroll
                for (int ci = 0; ci < 5; ++ci) { const float rho = 1.0f - 0.1f * ci, cs = mx[u] > 1e-30f ? 7.0f / (rho * mx[u]) : 0.f, ics = rho * mx[u] * (1.0f / 7.0f); float er = 0.f;
#pragma unroll
                    for (int j = 0; j < 4; ++j)
#pragma unroll
                        for (int i = 0; i < 4; ++i) { const float x = q[u][j][i], d = x - ics * __builtin_amdgcn_fmed3f(rintf(x * cs), -7.0f, 7.0f); er += d * d; }
#pragma unroll
                    for (int o = 1; o < 64; o <<= 1) er += __shfl_xor(er, o);
                    if (er < berr) { berr = er; best = rho; } }
                const float cm = best * mx[u], sc = cm > 1e-30f ? 7.0f / cm : 0.f, isc = cm * (1.0f / 112.0f);
                unsigned w[2] = {0u, 0u};
#pragma unroll
                for (int j = 0; j < 4; ++j)
#pragma unroll
                    for (int i = 0; i < 4; i += 2) { const int qe = (int)__builtin_amdgcn_fmed3f(rintf(q[u][j][i] * sc), -7.0f, 7.0f), qo = (int)__builtin_amdgcn_fmed3f(rintf(q[u][j][i + 1] * sc), -7.0f, 7.0f);
                        const unsigned byte = (((unsigned)qo & 15u) << 4) | ((unsigned)(qe + 8) & 15u); const int t = 2 * j + (i >> 1); w[t >> 2] |= byte << (8 * (t & 3)); }
                *(v2u*)(dst + (size_t)(lane >> 4) * ((size_t)NEXP * 128) + (size_t)e * 128 + 8 * (lane & 15)) = (v2u){w[0], w[1]};
                if (lane == 0) scl[e] = isc;
                continue; }
            } }
    }
}
__device__ __forceinline__ void p0_prologue(Frame& F, const Args& a) {
    unsigned char* ws = a.ws;
    LAS float* scr = (LAS float*)(F.lds + F.wave * 16384);
    const int gw = F.vcu * NWAVES + F.wave, NGW = F.G * NWAVES;
    for (int it = gw; it < 4096; it += NGW) {
        int r = it;
        if (r < 2048) { const int kb = r >> 7, db = r & 127; transpose_item(a.w_in, DIN, DM, (bf16*)(ws + WS_WIN), win_src_col(db), 32 * db, 64 * kb, scr, F.lane); continue; } r -= 2048;
        if (r < 256) { continue; } r -= 256;
        if (r < 256) { const int kb = r >> 5, nb = r & 31; transpose_item(a.w_ba, DM, DA, (bf16*)(ws + WS_WBA), 32 * nb, 32 * nb, 64 * kb, scr, F.lane); continue; } r -= 256;
        if (r < 512) { const int kb = r >> 5, nb = r & 31; transpose_item(a.w_out, DM, DM, (bf16*)(ws + WS_WOUT), 32 * nb, 32 * nb, 64 * kb, scr, F.lane); continue; } r -= 512;
        { const int kb = r >> 6, nb = r & 63; transpose_item(a.w_query, DQ, DM, (bf16*)(ws + WS_WQ), 32 * nb, 32 * nb, 64 * kb, scr, F.lane, a.norm_ffn_g); }
    }
    for (int it = gw; it < 16 * 4 * 16; it += NGW) { const int nb = it & 15, g = (it >> 4) & 3, cb = it >> 6; const int nn = 64 * nb + F.lane; float acc8[8];
#pragma unroll
        for (int i = 0; i < 8; ++i) acc8[i] = 0.f;
        const float* pm = a.pool_mix_w + (size_t)g * 16384 + (size_t)(8 * cb) * 128;
#pragma unroll 16
        for (int d = 0; d < 128; ++d) { const float wv = a.w_bp[(size_t)(g * 128 + d) * DM + nn] * a.pool_scale[g * 128 + d];
#pragma unroll
            for (int i = 0; i < 8; ++i) acc8[i] += pm[i * 128 + d] * wv; }
        v4u o; o.x = pkbf(acc8[0], acc8[1]); o.y = pkbf(acc8[2], acc8[3]); o.z = pkbf(acc8[4], acc8[5]); o.w = pkbf(acc8[6], acc8[7]);
        *(v4u*)((bf16*)(ws + WS_WBP) + (size_t)nn * DP + g * 128 + 8 * cb) = o; }
    { const size_t gtid = (size_t)F.vcu * NTHR + F.tid, gn = (size_t)F.G * NTHR;
      cvt_rows_fp8<true>(a.peer_u, ws + WS_PU, (float*)(ws + WS_US), gw, NGW, F.lane, a.norm_ffn_g);
      cvt_rows_fp8<true>(a.peer_v, ws + WS_PV, (float*)(ws + WS_VS), gw, NGW, F.lane);
      cvt_rows_bf16(a.sub_keys, (bf16*)(ws + WS_SUBK), (size_t)PH * 2 * NKEYS * DKH / 8, gtid, gn);
      for (size_t i = gtid; i < (size_t)DB * 7 * DP; i += gn) { const int b = (int)(i / (7 * DP)), j = (int)((i / DP) % 7), c = (int)(i % DP);
          a.out[O_PS + (size_t)(b * 15 + j) * DP + c] = a.state_pool[(size_t)(b * 15 + 8 + j) * DP + c]; } }
    __syncthreads();
    LAS float* wfT = (LAS float*)F.lds;
    for (int i = F.tid; i < 8 * DM; i += NTHR) { const int col = i >> 3, h = i & 7; wfT[h * DM + col] = a.w_in[(size_t)col * DIN + 2048 + h]; }
    __syncthreads();
    bf16* XN = (bf16*)(ws + WS_XN);
    for (int row0 = gw; row0 < M; row0 += 2 * NGW) {
        f32x4 v[2][4]; float rr[2], f[2][8]; bool ok[2];
#pragma unroll
        for (int u = 0; u < 2; ++u) { const int row = row0 + u * NGW; ok[u] = row < M; const int rc = ok[u] ? row : row0;
            const float* xr = rc < MP ? a.x_p + (size_t)rc * DM : a.x_s + (size_t)(rc - MP) * DM;
#pragma unroll
            for (int j = 0; j < 4; ++j) v[u][j] = *(const f32x4*)(xr + 256 * j + 4 * F.lane); }
#pragma unroll
        for (int u = 0; u < 2; ++u) { float ss = 0.f;
#pragma unroll
            for (int j = 0; j < 4; ++j) ss += (v[u][j][0] * v[u][j][0] + v[u][j][1] * v[u][j][1]) + (v[u][j][2] * v[u][j][2] + v[u][j][3] * v[u][j][3]);
            rr[u] = ss; }
#pragma unroll
        for (int o = 1; o < 64; o <<= 1) { rr[0] += __shfl_xor(rr[0], o); rr[1] += __shfl_xor(rr[1], o); }
#pragma unroll
        for (int u = 0; u < 2; ++u) { const int row = ok[u] ? row0 + u * NGW : row0; const float r = 1.0f / sqrtf(rr[u] * (1.0f / DM) + EPS);
#pragma unroll
            for (int h = 0; h < 8; ++h) f[u][h] = 0.f;
#pragma unroll
            for (int j = 0; j < 4; ++j) { const f32x4 g = *(const f32x4*)(a.norm_mix_g + 256 * j + 4 * F.lane); v[u][j] = v[u][j] * r * g;
                v2u w; w.x = pkbf(v[u][j][0], v[u][j][1]); w.y = pkbf(v[u][j][2], v[u][j][3]); if (ok[u]) *(v2u*)(XN + (size_t)row * DM + 256 * j + 4 * F.lane) = w;
#pragma unroll
                for (int h = 0; h < 8; ++h) { const f32x4 wv = *(const LAS f32x4*)(wfT + h * DM + 256 * j + 4 * F.lane); f[u][h] += (v[u][j][0] * wv[0] + v[u][j][1] * wv[1]) + (v[u][j][2] * wv[2] + v[u][j][3] * wv[3]); } } }
#pragma unroll
        for (int u = 0; u < 2; ++u) { const int row = row0 + u * NGW;
            const bool b4 = (F.lane & 4) != 0, b2 = (F.lane & 2) != 0, b1 = (F.lane & 1) != 0; float t4[4], t2[2];
#pragma unroll
            for (int k = 0; k < 4; ++k) { const float keep = b4 ? f[u][4 + k] : f[u][k], send = b4 ? f[u][k] : f[u][4 + k]; t4[k] = keep + __shfl_xor(send, 4); }
#pragma unroll
            for (int k = 0; k < 2; ++k) { const float keep = b2 ? t4[2 + k] : t4[k], send = b2 ? t4[k] : t4[2 + k]; t2[k] = keep + __shfl_xor(send, 2); }
            float t1 = (b1 ? t2[1] : t2[0]) + __shfl_xor(b1 ? t2[0] : t2[1], 1);
            t1 += __shfl_xor(t1, 8); t1 += __shfl_xor(t1, 16); t1 += __shfl_xor(t1, 32);
            if (F.lane < 8 && ok[u]) { const float z = t1 + a.b_forget[F.lane]; const float lf = fminf(z, 0.f) - log1pf(expf(-fabsf(z)));
                if (row < MP) a.out[O_LFP + (size_t)row * NH + F.lane] = lf; else a.out[O_LFS + (size_t)(row - MP) * NH + F.lane] = lf; } }
    }
}

template <int W> __device__ __forceinline__ void p2_item(const Args& a, unsigned char* ws, int row, int ch) {
    const bf16* U = (const bf16*)(ws + WS_U); bf16* PO = (bf16*)(ws + WS_PO);
    float e[W][8]; float cnt;
    if (row < MP) { const int s = row & (SEQ - 1); cnt = (float)(s + 1 < W ? s + 1 : W);
#pragma unroll
        for (int i = 0; i < W; ++i) { v4u q = (v4u){0u, 0u, 0u, 0u}; if (s - i >= 0) q = *(const v4u*)(U + (size_t)(row - i) * DP + ch);
            e[i][0] = bflo(q.x); e[i][1] = bfhi(q.x); e[i][2] = bflo(q.y); e[i][3] = bfhi(q.y); e[i][4] = bflo(q.z); e[i][5] = bfhi(q.z); e[i][6] = bflo(q.w); e[i][7] = bfhi(q.w); }
    } else { const int rs = row - MP, b = rs >> 3, t = rs & 7; cnt = (float)W;
#pragma unroll
        for (int i = 0; i < W; ++i) { const int tt = t - i;
            if (tt >= 0) { const v4u q = *(const v4u*)(U + (size_t)(MP + b * 8 + tt) * DP + ch);
                e[i][0] = bflo(q.x); e[i][1] = bfhi(q.x); e[i][2] = bflo(q.y); e[i][3] = bfhi(q.y); e[i][4] = bflo(q.z); e[i][5] = bfhi(q.z); e[i][6] = bflo(q.w); e[i][7] = bfhi(q.w); }
            else { const f32x4 p0 = *(const f32x4*)(a.state_pool + (size_t)(b * 15 + 15 + tt) * DP + ch), p1 = *(const f32x4*)(a.state_pool + (size_t)(b * 15 + 15 + tt) * DP + ch + 4);
                e[i][0] = p0[0]; e[i][1] = p0[1]; e[i][2] = p0[2]; e[i][3] = p0[3]; e[i][4] = p1[0]; e[i][5] = p1[1]; e[i][6] = p1[2]; e[i][7] = p1[3]; } } }
    const float inv = 1.0f / cnt; float mm[8];
#pragma unroll
    for (int k = 0; k < 8; ++k) { float sum = 0.f;
#pragma unroll
        for (int i = 0; i < W; ++i) sum += e[i][k];
        mm[k] = sum * inv - e[0][k]; }
    v4u o; o.x = pkbf(mm[0], mm[1]); o.y = pkbf(mm[2], mm[3]); o.z = pkbf(mm[4], mm[5]); o.w = pkbf(mm[6], mm[7]);
    *(v4u*)(PO + (size_t)row * DP + ch) = o;
}
template <int W> __device__ __forceinline__ void p2_slide(unsigned char* ws, int row0, int ch) {
    const bf16* U = (const bf16*)(ws + WS_U); bf16* PO = (bf16*)(ws + WS_PO);
    const int s0 = row0 & (SEQ - 1);
    v4u x[W + 3];
#pragma unroll
    for (int k = 0; k < W + 3; ++k) { x[k] = (v4u){0u, 0u, 0u, 0u}; if (s0 + k - (W - 1) >= 0) x[k] = *(const v4u*)(U + (size_t)(row0 + k - (W - 1)) * DP + ch); }
    float S[8];
#pragma unroll
    for (int c = 0; c < 8; ++c) S[c] = 0.f;
#pragma unroll
    for (int k = 0; k < W; ++k) { const unsigned w4[4] = {x[k].x, x[k].y, x[k].z, x[k].w};
#pragma unroll
        for (int c = 0; c < 4; ++c) { S[2 * c] += bflo(w4[c]); S[2 * c + 1] += bfhi(w4[c]); } }
#pragma unroll
    for (int j = 0; j < 4; ++j) {
        const unsigned cur[4] = {x[W - 1 + j].x, x[W - 1 + j].y, x[W - 1 + j].z, x[W - 1 + j].w};
        if (j > 0) { const unsigned old4[4] = {x[j - 1].x, x[j - 1].y, x[j - 1].z, x[j - 1].w};
#pragma unroll
            for (int c = 0; c < 4; ++c) { S[2 * c] += bflo(cur[c]) - bflo(old4[c]); S[2 * c + 1] += bfhi(cur[c]) - bfhi(old4[c]); } }
        const int sj = s0 + j; const float inv = 1.0f / (float)(sj + 1 < W ? sj + 1 : W);
        v4u o; o.x = pkbf(S[0] * inv - bflo(cur[0]), S[1] * inv - bfhi(cur[0])); o.y = pkbf(S[2] * inv - bflo(cur[1]), S[3] * inv - bfhi(cur[1]));
        o.z = pkbf(S[4] * inv - bflo(cur[2]), S[5] * inv - bfhi(cur[2])); o.w = pkbf(S[6] * inv - bflo(cur[3]), S[7] * inv - bfhi(cur[3]));
        *(v4u*)(PO + (size_t)(row0 + j) * DP + ch) = o; }
}
__device__ __forceinline__ void p1_cumsum(Frame& F, const Args& a) {
    unsigned char* ws = a.ws;
    { const int gw = ((int)blockIdx.x - ((int)F.G - (NB * NH) / NWAVES)) * NWAVES + F.wave; float* CP2 = (float*)(ws + WS_CP2);
      if (gw >= 0 && gw < NB * NH) { const int b = gw >> 3, h = gw & 7; float carry = 0.f;
          for (int c = 0; c < SEQ / 64; ++c) { float v = a.out[O_LFP + (size_t)(b * SEQ + c * 64 + F.lane) * NH + h];
#pragma unroll
              for (int o = 1; o < 64; o <<= 1) { const float t = __shfl_up(v, o); if (F.lane >= o) v += t; }
              v += carry; CP2[(size_t)gw * SEQ + c * 64 + F.lane] = v * LOG2E; carry = __shfl(v, 63); } } }
}
__device__ __forceinline__ void p2_cumsum_pool(Frame& F, const Args& a) {
    unsigned char* ws = a.ws;
    const int nfree = F.G > 2 * (M / 256) ? F.G - M / 256 : F.G, myslot = F.G > 2 * (M / 256) ? (int)blockIdx.x - M / 256 : (int)blockIdx.x;
    if (myslot >= 0)
    for (int task = myslot * NWAVES + F.wave; task < (MP / 16) * 4; task += nfree * NWAVES) {
        const int g = task & 3, row0 = 16 * (task >> 2) + 4 * (F.lane >> 4), ch = g * 128 + (F.lane & 15) * 8;
        if (g == 0) p2_slide<2>(ws, row0, ch); else if (g == 1) p2_slide<4>(ws, row0, ch); else if (g == 2) p2_slide<8>(ws, row0, ch); else p2_slide<16>(ws, row0, ch);
    }
    if (myslot >= 0)
    for (int item = MP * 64 + myslot * NTHR + F.tid; item < M * 64; item += nfree * NTHR) {
        const int wv = item >> 6, g = wv & 3, row = 4 * (wv >> 2) + ((item >> 4) & 3), ch = g * 128 + (item & 15) * 8;
        if (g == 0) p2_item<2>(a, ws, row, ch); else if (g == 1) p2_item<4>(a, ws, row, ch); else if (g == 2) p2_item<8>(a, ws, row, ch); else p2_item<16>(a, ws, row, ch);
    }
}

__device__ __forceinline__ float attn_bound2(const Args& a, int lane) {
    asm volatile("" : "+v"(lane));
    const float gq = wave_max(fabsf(a.q_norm_g[lane])), gk = wave_max(fabsf(a.k_norm_g[lane]));
    return 64.0f * C2 * gq * gk * 1.03f;
}

typedef float f32x16 __attribute__((ext_vector_type(16)));
typedef short bf16x8v __attribute__((ext_vector_type(8)));
__device__ __forceinline__ int f2key(float s) { int b = __builtin_bit_cast(int, s); return b ^ ((b >> 31) & 0x7fffffff); }
__device__ __forceinline__ float key2f(int k) { return __builtin_bit_cast(float, k ^ ((k >> 31) & 0x7fffffff)); }
#define CE_DESC(x, y) do { const int mx_ = (x) > (y) ? (x) : (y), mn_ = (x) > (y) ? (y) : (x); (x) = mx_; (y) = mn_; } while (0)
template <int OFF, int N, typename T> __device__ __forceinline__ void bsort_desc(T& v) {
#pragma unroll
    for (int k = 2; k <= N; k <<= 1)
#pragma unroll
        for (int j = k >> 1; j > 0; j >>= 1)
#pragma unroll
            for (int i = 0; i < N; ++i) { const int l = i ^ j; if (l > i) { if ((i & k) == 0) CE_DESC(v[OFF + i], v[OFF + l]); else CE_DESC(v[OFF + l], v[OFF + i]); } }
}
template <int OFF, typename T> __device__ __forceinline__ void bmerge16_desc(T& v) {
#pragma unroll
    for (int j = 8; j > 0; j >>= 1)
#pragma unroll
        for (int i = 0; i < 16; ++i) { const int l = i ^ j; if (l > i) CE_DESC(v[OFF + i], v[OFF + l]); }
}
template <int OA, int OB, typename T> __device__ __forceinline__ void top16_merge(T& v) {
#pragma unroll
    for (int i = 0; i < 16; ++i) v[OA + i] = v[OA + i] > v[OB + 15 - i] ? v[OA + i] : v[OB + 15 - i];
    bmerge16_desc<OA>(v);
}
template <typename T> __device__ __forceinline__ void top16_of_64(T& v) {
    bsort_desc<0, 16>(v); bsort_desc<16, 16>(v); bsort_desc<32, 16>(v); bsort_desc<48, 16>(v);
    top16_merge<0, 16>(v); top16_merge<32, 48>(v); top16_merge<0, 32>(v);
}
__device__ __forceinline__ void p7_topk(Frame& F, const Args& a) {
    unsigned char* ws = a.ws;
    const bf16* PQ = (const bf16*)(ws + WS_PQ); const bf16* SK = (const bf16*)(ws + WS_SUBK); const float* RSS = (const float*)(ws + WS_RSS);
    int* SI = (int*)(ws + WS_SI); float* SG = (float*)(ws + WS_SG);
    const int lane = F.lane, j = lane & 31, hi = lane >> 5;
    constexpr int KROW = 272, KMAT = 128 * KROW;
    LAS unsigned char* kl = F.lds; LAS unsigned* ib = (LAS unsigned*)(F.lds + 2 * KMAT + F.wave * 1024);
    const int h = F.vcu & 7, wi = F.vcu >> 3, nwh = (F.G - h + 7) >> 3;
    __syncthreads();
    for (int i = F.tid; i < 2 * 128 * 16; i += NTHR) { const int p = i >> 11, n = (i >> 4) & 127, c = i & 15; *(LAS v4u*)(kl + p * KMAT + n * KROW + 16 * c) = *(const v4u*)(SK + ((size_t)(h * 2 + p) * NKEYS + n) * DKH + 8 * c); }
    __syncthreads();
    const bool grp = (F.G == 256);
    const int gx = F.vcu >> 5, wl = (F.vcu >> 3) & 3;
    for (int lt = (grp ? wl : wi) * NWAVES + F.wave; lt < (grp ? 68 : M / 32); lt += (grp ? 4 : nwh) * NWAVES) {
        const int tile = grp ? (lt < 64 ? 64 * gx + lt : 512 + 4 * gx + (lt - 64)) : lt;
        const int row0 = tile * 32;
        int jl = j, hl = hi; asm volatile("" : "+v"(jl), "+v"(hl));
        int top[2][16];
#pragma unroll
        for (int p = 0; p < 2; ++p) {
            bf16x8v qf[8];
#pragma unroll
            for (int ks = 0; ks < 8; ++ks) qf[ks] = *(const bf16x8v*)(PQ + (size_t)(row0 + jl) * DQ + h * 256 + p * 128 + 16 * ks + 8 * hl);
            f32x16 acc[4];
#pragma unroll
            for (int mt = 0; mt < 4; ++mt) acc[mt] = f32x16{};
            const LAS unsigned char* kb = kl + p * KMAT + jl * KROW + 16 * hl;
#pragma unroll
            for (int ks = 0; ks < 8; ++ks)
#pragma unroll
                for (int mt = 0; mt < 4; ++mt) { const bf16x8v af = *(const LAS bf16x8v*)(kb + mt * 32 * KROW + ks * 32); acc[mt] = __builtin_amdgcn_mfma_f32_32x32x16_bf16(af, qf[ks], acc[mt], 0, 0, 0); }
            int v[64];
#pragma unroll
            for (int mt = 0; mt < 4; ++mt)
#pragma unroll
                for (int r = 0; r < 16; ++r) { const int n = 32 * mt + (r & 3) + 8 * (r >> 2) + 4 * hi; v[16 * mt + r] = (f2key(acc[mt][r]) & ~127) | (127 - n); }
            top16_of_64(v);
#pragma unroll
            for (int i = 0; i < 16; ++i) top[p][i] = v[i];
        }
        int S[32];
#pragma unroll
        for (int i = 0; i < 16; ++i) { auto rr = __builtin_amdgcn_permlane32_swap((unsigned)top[0][i], (unsigned)top[1][i], false, false); S[i] = (int)rr[0]; S[16 + i] = (int)rr[1]; }
        top16_merge<0, 16>(S);
        { unsigned w0 = 0, w1 = 0, w2 = 0, w3 = 0;
#pragma unroll
          for (int i = 0; i < 4; ++i) { w0 |= (unsigned)(127 - (S[i] & 127)) << (8 * i); w1 |= (unsigned)(127 - (S[4 + i] & 127)) << (8 * i); w2 |= (unsigned)(127 - (S[8 + i] & 127)) << (8 * i); w3 |= (unsigned)(127 - (S[12 + i] & 127)) << (8 * i); }
          *(LAS v4u*)(ib + (hi * 32 + j) * 4) = (v4u){w0, w1, w2, w3}; }
        float s1[16], s2[16];
#pragma unroll
        for (int i = 0; i < 16; ++i) { auto rr = __builtin_amdgcn_permlane32_swap((unsigned)S[i], (unsigned)S[i], false, false); s1[i] = key2f((int)rr[0] & ~127); s2[i] = key2f((int)rr[1] & ~127); }
        int c[64]; { int n = 0;
#pragma unroll
          for (int ca = 0; ca < 16; ++ca)
#pragma unroll
              for (int cb = 0; cb < 16; ++cb) if ((ca + 1) * (cb + 1) <= 16) { c[n] = (f2key(s1[ca] + s2[cb]) & ~255) | (255 - (ca * 16 + cb)); ++n; }
#pragma unroll
          for (int q = 50; q < 64; ++q) c[q] = (int)0x80000000; }
        top16_of_64(c);
        float ssq = 0.f;
#pragma unroll
        for (int q = 0; q < 4; ++q) { const f32x4 t4 = *(const f32x4*)(RSS + (size_t)(row0 + j) * 16 + 4 * q); ssq += (t4[0] + t4[1]) + (t4[2] + t4[3]); }
        const float rstd = 1.0f / sqrtf(ssq * (1.0f / DM) + EPS);
        const float z0 = key2f(c[0] & ~255) * rstd; float e[16], esum = 0.f;
#pragma unroll
        for (int k = 0; k < 16; ++k) { e[k] = __expf(key2f(c[k] & ~255) * rstd - z0); esum += e[k]; }
        const float inv = 1.0f / esum;
        LDS_WAIT(); asm volatile("" ::: "memory");
        const LAS unsigned char* ib8 = (const LAS unsigned char*)ib;
        int oi[8]; float og[8];
#pragma unroll
        for (int k = 0; k < 8; ++k) { const int ck = hi ? c[8 + k] : c[k]; const float ek = hi ? e[8 + k] : e[k]; const int fl = 255 - (ck & 255);
            const int i1 = ib8[(0 * 32 + j) * 16 + (fl >> 4)], i2 = ib8[(1 * 32 + j) * 16 + (fl & 15)]; oi[k] = i1 * NKEYS + i2; og[k] = ek * inv; }
        { int* sp = SI + (size_t)(row0 + j) * 128 + h * 16 + hi * 8; float* gp = SG + (size_t)(row0 + j) * 128 + h * 16 + hi * 8;
          *(v4u*)sp = (v4u){(unsigned)oi[0], (unsigned)oi[1], (unsigned)oi[2], (unsigned)oi[3]}; *(v4u*)(sp + 4) = (v4u){(unsigned)oi[4], (unsigned)oi[5], (unsigned)oi[6], (unsigned)oi[7]};
          *(f32x4*)gp = (f32x4){og[0], og[1], og[2], og[3]}; *(f32x4*)(gp + 4) = (f32x4){og[4], og[5], og[6], og[7]}; }
        LDS_WAIT(); asm volatile("" ::: "memory");
    }
}


constexpr int P8_SW = 128;
#define FP8X2(wd, hi_) __builtin_amdgcn_cvt_pk_f32_fp8((int)(wd), (hi_))
constexpr int P8_T = 68;
static_assert(M % P8_T == 0, "P8 chunking");
__device__ __forceinline__ void p8_gather(Frame& F, const Args& a) {
    unsigned char* ws = a.ws;
    const bf16* HG = (const bf16*)(ws + WS_XN); const unsigned char* PU = ws + WS_PU; const unsigned char* PV = ws + WS_PV; const float* US = (const float*)(ws + WS_US); const float* VS = (const float*)(ws + WS_VS);
    const float* RSS = (const float*)(ws + WS_RSS); const int* SI = (const int*)(ws + WS_SI); const float* SG = (const float*)(ws + WS_SG);
    float* Y = a.out + O_YP; unsigned char* HQ = ws + WS_Q;
    LAS unsigned short* ix = (LAS unsigned short*)F.lds;
    LAS float* wt = (LAS float*)(F.lds + P8_T * 128 * 2);
    LAS float* zp = (LAS float*)(F.lds + P8_T * 128 * 6);
    LAS float* rs = (LAS float*)(F.lds + P8_T * 128 * 10);
    LAS float* hs = (LAS float*)(F.lds + P8_T * 128 * 10 + 512);
    LAS float* wsc = (LAS float*)(F.lds + P8_T * 128 * 10 + 1024);
    LAS unsigned char* wq = F.lds + P8_T * 128 * 10 + 2048;
    int lane = F.lane; asm volatile("" : "+v"(lane));
    const int g = lane >> 3, c8 = lane & 7;
    const bool grp = (F.G == 256);
    for (int sup = F.vcu; sup < M / P8_T; sup += F.G) {
        const int tb = grp ? 2048 * (F.vcu >> 5) + 64 * (F.vcu & 31) : sup * P8_T, tb2 = grp ? MP + 128 * (F.vcu >> 5) + 4 * (F.vcu & 31) - 64 : tb;
#define P8_ROW(lt_) (((lt_) < 64 ? tb : tb2) + (lt_))
        __syncthreads();
        for (int i = F.tid; i < P8_T * 128; i += NTHR) { const size_t src = (size_t)P8_ROW(i >> 7) * 128 + (i & 127); ix[i] = (unsigned short)SI[src]; wt[i] = SG[src]; zp[i] = 0.f; }
        if (F.tid < P8_T) { float s = 0.f; for (int k = 0; k < 16; ++k) s += RSS[(size_t)P8_ROW(F.tid) * 16 + k]; rs[F.tid] = 1.0f / sqrtf(s * (1.0f / DM) + EPS); }
        for (int lt = F.wave; lt < P8_T; lt += NWAVES) { const bf16* hr = HG + (size_t)P8_ROW(lt) * DM + 16 * lane; const v4u ha = *(const v4u*)hr, hb2 = *(const v4u*)(hr + 8);
            const unsigned hp[8] = {ha.x, ha.y, ha.z, ha.w, hb2.x, hb2.y, hb2.z, hb2.w}; float hv[16], m = 0.f;
#pragma unroll
            for (int k = 0; k < 8; ++k) { hv[2 * k] = bflo(hp[k]); hv[2 * k + 1] = bfhi(hp[k]); m = fmaxf(m, fmaxf(fabsf(hv[2 * k]), fabsf(hv[2 * k + 1]))); }
#pragma unroll
            for (int o = 1; o < 64; o <<= 1) m = fmaxf(m, __shfl_xor(m, o));
            const float sc = m > 1e-30f ? 127.0f / m : 0.f; unsigned qw[4];
            unsigned qe[2] = {0u, 0u}, qo[2] = {0u, 0u};
#pragma unroll
            for (int t = 0; t < 8; ++t) { const int ie = (int)rintf(hv[2 * t] * sc), io = (int)rintf(hv[2 * t + 1] * sc); qe[t >> 2] |= ((unsigned)ie & 255u) << (8 * (t & 3)); qo[t >> 2] |= ((unsigned)io & 255u) << (8 * (t & 3)); }
            unsigned char* hq = HQ + (size_t)P8_ROW(lt) * DM + (lane >> 4) * 256 + 8 * (lane & 15);
            *(v2u*)hq = (v2u){qe[0], qe[1]}; *(v2u*)(hq + 128) = (v2u){qo[0], qo[1]};
            if (lane == 0) hs[lt] = m * (1.0f / 127.0f); }
        asm volatile("s_waitcnt vmcnt(0)" ::: "memory");
        __syncthreads();
        if (F.tid == 0) { __builtin_amdgcn_fence(__ATOMIC_ACQUIRE, "agent"); asm volatile("s_waitcnt vmcnt(0)" ::: "memory"); }
        __syncthreads();
        for (int s = 0; s < 4; ++s) {
            __syncthreads();
            int cl = c8; asm volatile("" : "+v"(cl));
            const unsigned char* pus = PU + (size_t)s * ((size_t)NEXP * P8_SW) + 16 * cl;
#pragma unroll 1
            for (int lt = F.wave; lt < P8_T; lt += NWAVES) {
                const unsigned char* hq = HQ + (size_t)P8_ROW(lt) * DM + 256 * s + 16 * cl;
                const v4u h0 = *(const v4u*)hq, h1 = *(const v4u*)(hq + 128);
                const int he[4] = {(int)h0.x, (int)h0.y, (int)h0.z, (int)h0.w}, ho[4] = {(int)h1.x, (int)h1.y, (int)h1.z, (int)h1.w};
                int hsum = 0;
#pragma unroll
                for (int jj = 0; jj < 4; ++jj) hsum = __builtin_amdgcn_sdot4(he[jj], 0x01010101, hsum, false);
                const int dl0 = -8 * hsum;
                const v4u ea = *(const LAS v4u*)(ix + lt * 128 + g * 16), eb = *(const LAS v4u*)(ix + lt * 128 + g * 16 + 8);
                const unsigned ew[8] = {ea.x, ea.y, ea.z, ea.w, eb.x, eb.y, eb.z, eb.w};
                v4u r[16];
#pragma unroll
                for (int i = 0; i < 16; ++i) { const unsigned e = (i & 1) ? (ew[i >> 1] >> 16) : (ew[i >> 1] & 0xffffu); r[i] = *(const v4u*)(pus + (size_t)e * P8_SW); }
                int acc[16];
#pragma unroll
                for (int i = 0; i < 16; ++i) { const unsigned wd[4] = {r[i].x, r[i].y, r[i].z, r[i].w}; int dh = 0, dl = dl0;
#pragma unroll
                    for (int jj = 0; jj < 4; ++jj) { dh = __builtin_amdgcn_sdot4((int)(wd[jj] & 0xf0f0f0f0u), ho[jj], dh, false); dl = __builtin_amdgcn_sdot4((int)(wd[jj] & 0x0f0f0f0fu), he[jj], dl, false); }
                    acc[i] = dh + (dl << 4); }
                int v8[8], v4[4], v2[2]; const bool b4 = (c8 & 4) != 0, b2 = (c8 & 2) != 0, b1 = (c8 & 1) != 0;
#pragma unroll
                for (int j2 = 0; j2 < 8; ++j2) { const int keep = b4 ? acc[8 + j2] : acc[j2], send = b4 ? acc[j2] : acc[8 + j2]; v8[j2] = keep + __shfl_xor(send, 4); }
#pragma unroll
                for (int j2 = 0; j2 < 4; ++j2) { const int keep = b2 ? v8[4 + j2] : v8[j2], send = b2 ? v8[j2] : v8[4 + j2]; v4[j2] = keep + __shfl_xor(send, 2); }
#pragma unroll
                for (int j2 = 0; j2 < 2; ++j2) { const int keep = b1 ? v4[2 + j2] : v4[j2], send = b1 ? v4[j2] : v4[2 + j2]; v2[j2] = keep + __shfl_xor(send, 1); }
                LAS f32x2* zq = (LAS f32x2*)(zp + lt * 128 + g * 16 + 2 * c8); const f32x2 z0 = *zq; *zq = (f32x2){z0[0] + (float)v2[0], z0[1] + (float)v2[1]};
            }
        }
        for (int lt = F.wave; lt < P8_T; lt += NWAVES) {
            const float r = rs[lt]; const int kk = lt * 128 + g * 16 + 2 * c8; LAS float* wp = wt + kk; const f32x2 gt = *(const LAS f32x2*)wp; const f32x2 zz = *(const LAS f32x2*)(zp + kk);
            const int e0 = ix[kk], e1 = ix[kk + 1];
            const float rh = r * hs[lt]; const float z0 = zz[0] * rh * US[e0], z1 = zz[1] * rh * US[e1];
            const float a0 = 0.5f * z0 * (1.0f + erff(z0 * 0.70710678118654752f)), a1 = 0.5f * z1 * (1.0f + erff(z1 * 0.70710678118654752f));
            const float w0 = gt[0] * a0 * VS[e0], w1 = gt[1] * a1 * VS[e1]; float mw = fmaxf(fabsf(w0), fabsf(w1));
#pragma unroll
            for (int o = 1; o < 64; o <<= 1) mw = fmaxf(mw, __shfl_xor(mw, o));
            const float wsq = mw > 1e-30f ? 127.0f / mw : 0.f; const int q0 = (int)rintf(w0 * wsq), q1 = (int)rintf(w1 * wsq);
            *(LAS unsigned short*)(wq + kk) = (unsigned short)(((unsigned)q0 & 255u) | (((unsigned)q1 & 255u) << 8));
            if (lane == 0) wsc[lt] = mw * (1.0f / 127.0f); }
        LDS_WAIT(); asm volatile("" ::: "memory");
        for (int s = 0; s < 4; ++s) {
            __syncthreads();
            int cl = c8; asm volatile("" : "+v"(cl));
            const unsigned char* pvs = PV + (size_t)s * ((size_t)NEXP * P8_SW) + 16 * cl;
#pragma unroll 1
            for (int lt = F.wave; lt < P8_T; lt += NWAVES) {
                const v4u ea = *(const LAS v4u*)(ix + lt * 128 + g * 16), eb = *(const LAS v4u*)(ix + lt * 128 + g * 16 + 8);
                const unsigned ew[8] = {ea.x, ea.y, ea.z, ea.w, eb.x, eb.y, eb.z, eb.w};
                v4u r[16];
#pragma unroll
                for (int i = 0; i < 16; ++i) { const unsigned e = (i & 1) ? (ew[i >> 1] >> 16) : (ew[i >> 1] & 0xffffu); r[i] = *(const v4u*)(pvs + (size_t)e * P8_SW); }
                const v4u wq4 = *(const LAS v4u*)(wq + lt * 128 + g * 16); const int Wg[4] = {(int)wq4.x, (int)wq4.y, (int)wq4.z, (int)wq4.w};
                int sw = 0;
#pragma unroll
                for (int G = 0; G < 4; ++G) sw = __builtin_amdgcn_sdot4(Wg[G], 0x01010101, sw, false);
                int acc[32];
#pragma unroll
                for (int c = 0; c < 32; ++c) acc[c] = -8 * sw;
#pragma unroll
                for (int G = 0; G < 4; ++G)
#pragma unroll
                    for (int jj = 0; jj < 4; ++jj) {
                        const unsigned A = r[4 * G][jj], B = r[4 * G + 1][jj], C = r[4 * G + 2][jj], D = r[4 * G + 3][jj];
                        const unsigned t0 = __builtin_amdgcn_perm(B, A, 0x05010400u), t1 = __builtin_amdgcn_perm(B, A, 0x07030602u), t2 = __builtin_amdgcn_perm(D, C, 0x05010400u), t3 = __builtin_amdgcn_perm(D, C, 0x07030602u);
                        const unsigned T[4] = {__builtin_amdgcn_perm(t2, t0, 0x05040100u), __builtin_amdgcn_perm(t2, t0, 0x07060302u), __builtin_amdgcn_perm(t3, t1, 0x05040100u), __builtin_amdgcn_perm(t3, t1, 0x07060302u)};
#pragma unroll
                        for (int bb = 0; bb < 4; ++bb) { const int t = 4 * jj + bb;
                            acc[2 * t]     = __builtin_amdgcn_sdot4((int)(T[bb] & 0x0f0f0f0fu), Wg[G], acc[2 * t], false);
                            acc[2 * t + 1] = __builtin_amdgcn_sdot4((int)T[bb], Wg[G], acc[2 * t + 1], false); } }
#pragma unroll
                for (int t = 0; t < 16; ++t) { acc[2 * t + 1] -= acc[2 * t]; acc[2 * t] <<= 4; }
                const bool b5 = (lane & 32) != 0, b4 = (lane & 16) != 0, b3 = (lane & 8) != 0; int p16[16], p8[8], p4[4];
#pragma unroll
                for (int j2 = 0; j2 < 16; ++j2) { const int keep = b5 ? acc[16 + j2] : acc[j2], send = b5 ? acc[j2] : acc[16 + j2]; p16[j2] = keep + __shfl_xor(send, 32); }
#pragma unroll
                for (int j2 = 0; j2 < 8; ++j2) { const int keep = b4 ? p16[8 + j2] : p16[j2], send = b4 ? p16[j2] : p16[8 + j2]; p8[j2] = keep + __shfl_xor(send, 16); }
#pragma unroll
                for (int j2 = 0; j2 < 4; ++j2) { const int keep = b3 ? p8[4 + j2] : p8[j2], send = b3 ? p8[j2] : p8[4 + j2]; p4[j2] = keep + __shfl_xor(send, 8); }
                const size_t off = (size_t)P8_ROW(lt) * DM + 256 * s + 32 * cl + (b5 ? 16 : 0) + (b4 ? 8 : 0) + (b3 ? 4 : 0);
                const v2u hw2 = *(const v2u*)(HG + off); const float ws_t = wsc[lt];
                __builtin_nontemporal_store((f32x4){bflo(hw2.x) + ws_t * (float)p4[0], bfhi(hw2.x) + ws_t * (float)p4[1], bflo(hw2.y) + ws_t * (float)p4[2], bfhi(hw2.y) + ws_t * (float)p4[3]}, (f32x4*)(Y + off)); }
        }
    }
}
#undef P8_ROW

__device__ __forceinline__ void p3_sample_attn2(Frame& F, const Args& a, const float M2) {
    unsigned char* ws = a.ws;
    const bf16* Q = (const bf16*)(ws + WS_Q); bf16* AO = (bf16*)(ws + WS_AO);
    LAS float* D2 = (LAS float*)F.lds;
    LAS float* E2 = (LAS float*)(F.lds + 32768);
    LAS float* Op = (LAS float*)(F.lds + 32768 + 128 + 8192);
    LAS float* lp = (LAS float*)(F.lds + 32768 + 128 + 8192 + 16384);
    int lane = F.lane; asm volatile("" : "+v"(lane));
    const int w = F.wave, hh = w >> 1, kh = w & 1, c = lane & 15, g = lane >> 4;
    for (;;) {
        __syncthreads();
        if (F.tid == 0) F.MISC[17] = __hip_atomic_fetch_add((unsigned*)(F.ctl + 8320), 1u, __ATOMIC_RELAXED, __HIP_MEMORY_SCOPE_AGENT);
        __syncthreads();
        const int unit = (int)F.MISC[17];
        if (unit >= DB * 2) break;
        const int b = unit >> 1, h = 4 * (unit & 1) + hh;
        __syncthreads();
        for (int jk = F.tid; jk < PAST; jk += NTHR) { const int pg = a.page_table[b * NPAGES + (jk >> 7)];
            const f32x4 l4 = *(const f32x4*)(a.cache_lf + ((size_t)pg * PAGE + (jk & 127)) * NH + 4 * (unit & 1));
            D2[jk] = l4[0]; D2[PAST + jk] = l4[1]; D2[2 * PAST + jk] = l4[2]; D2[3 * PAST + jk] = l4[3]; }
        __syncthreads();
        if (kh == 0) {
            LAS float* d = D2 + hh * PAST; float loc[32]; float tot = 0.f;
#pragma unroll
            for (int k = 31; k >= 0; --k) { loc[k] = tot; tot += d[lane * 32 + k]; }
            float inc = tot;
#pragma unroll
            for (int o = 1; o < 64; o <<= 1) { const float t = __shfl_down(inc, o); if (lane + o < 64) inc += t; }
            const float excl = inc - tot;
#pragma unroll
            for (int k = 0; k < 32; ++k) d[lane * 32 + k] = (loc[k] + excl) * LOG2E;
            if (lane < 8) { float e = 0.f; for (int t = 0; t <= lane; ++t) e += a.out[O_LFS + (size_t)(b * 8 + t) * NH + h]; E2[hh * 8 + lane] = e * LOG2E; }
        }
        __syncthreads();
        bf16x8v qb[2];
#pragma unroll
        for (int ks = 0; ks < 2; ++ks) { qb[ks] = bf16x8v{}; if (c < 8) qb[ks] = *(const bf16x8v*)(Q + (size_t)(MP + b * 8 + c) * DA + h * 64 + 32 * ks + 8 * g); }
        const float e2q = E2[hh * 8 + (c & 7)] - M2;
        f32x4 oacc[4]; float lsum = 0.f;
#pragma unroll
        for (int m = 0; m < 4; ++m) oacc[m] = (f32x4){0.f, 0.f, 0.f, 0.f};
        const LAS float* dh = D2 + hh * PAST;
        int nskip; { const float dl = dh[32 * lane + 31]; nskip = __builtin_popcountll(__ballot(dl < -(24.f + 2.f * M2))); }
        nskip = __builtin_amdgcn_readfirstlane(nskip);
        const int nblk = PAST / 32 - nskip, nb0 = nblk >> 1;
        const int blk_lo = nskip + (kh ? nb0 : 0), nit = kh ? (nblk - nb0) : nb0;
#define S3_PACK8(x0_, x1_) __builtin_bit_cast(bf16x8v, (v4u){pkbf((x0_)[0], (x0_)[1]), pkbf((x0_)[2], (x0_)[3]), pkbf((x1_)[0], (x1_)[1]), pkbf((x1_)[2], (x1_)[3])})
#define S3_PV(p0_, p1_, vq_) do { const bf16x8v pb_ = S3_PACK8(p0_, p1_); \
            _Pragma("unroll") for (int m = 0; m < 4; ++m) { const bf16x8v va_ = __builtin_bit_cast(bf16x8v, (v4u){pkbf((vq_)[0][m], (vq_)[1][m]), pkbf((vq_)[2][m], (vq_)[3][m]), pkbf((vq_)[4][m], (vq_)[5][m]), pkbf((vq_)[6][m], (vq_)[7][m])}); \
                oacc[m] = __builtin_amdgcn_mfma_f32_16x16x32_bf16(va_, pb_, oacc[m], 0, 0, 0); } } while (0)
        for (int it = 0; it < nit; ++it) {
            const int j0 = (blk_lo + it) * 32; const int pg = a.page_table[b * NPAGES + (j0 >> 7)];
            const size_t rowoff = (((size_t)pg * PAGE + (j0 & 127)) * NH + h) * HD;
            const float* kr = a.cache_k + rowoff + (size_t)c * (NH * HD) + 8 * g; const float* vr = a.cache_v + rowoff + 4 * c;
            f32x4 kq[2][2][2], vq[8];
#pragma unroll
            for (int tl = 0; tl < 2; ++tl)
#pragma unroll
                for (int ks = 0; ks < 2; ++ks) { const float* kp = kr + (size_t)(16 * tl) * (NH * HD) + 32 * ks; kq[tl][ks][0] = __builtin_nontemporal_load((const f32x4*)kp); kq[tl][ks][1] = __builtin_nontemporal_load((const f32x4*)(kp + 4)); }
#pragma unroll
            for (int jj = 0; jj < 8; ++jj) vq[jj] = __builtin_nontemporal_load((const f32x4*)(vr + (size_t)((jj < 4 ? 0 : 12) + 4 * g + jj) * (NH * HD)));
            const f32x4 d0 = *(const LAS f32x4*)(dh + j0 + 4 * g), d1 = *(const LAS f32x4*)(dh + j0 + 16 + 4 * g);
            f32x4 s0 = d0 + e2q, s1 = d1 + e2q;
#pragma unroll
            for (int ks = 0; ks < 2; ++ks) { s0 = __builtin_amdgcn_mfma_f32_16x16x32_bf16(S3_PACK8(kq[0][ks][0], kq[0][ks][1]), qb[ks], s0, 0, 0, 0);
                                             s1 = __builtin_amdgcn_mfma_f32_16x16x32_bf16(S3_PACK8(kq[1][ks][0], kq[1][ks][1]), qb[ks], s1, 0, 0, 0); }
            f32x4 p0, p1;
#pragma unroll
            for (int r = 0; r < 4; ++r) { p0[r] = __builtin_amdgcn_exp2f(s0[r]); p1[r] = __builtin_amdgcn_exp2f(s1[r]); }
            lsum += (p0[0] + p0[1]) + (p0[2] + p0[3]) + (p1[0] + p1[1]) + (p1[2] + p1[3]);
            S3_PV(p0, p1, vq);
        }
        if (kh == 1) {
            const float* kr = a.out + O_KS + (size_t)(b * 8 + (c & 7)) * DA + h * HD + 8 * g;
            f32x4 s0 = (f32x4){0.f, 0.f, 0.f, 0.f};
#pragma unroll
            for (int ks = 0; ks < 2; ++ks) { const f32x4 x0 = *(const f32x4*)(kr + 32 * ks), x1 = *(const f32x4*)(kr + 32 * ks + 4); s0 = __builtin_amdgcn_mfma_f32_16x16x32_bf16(S3_PACK8(x0, x1), qb[ks], s0, 0, 0, 0); }
            f32x4 p0, p1 = (f32x4){0.f, 0.f, 0.f, 0.f}, vq[8];
#pragma unroll
            for (int r = 0; r < 4; ++r) { const int key = 4 * g + r; const float ek = E2[hh * 8 + (key & 7)]; p0[r] = (key < 8 && key <= c) ? __builtin_amdgcn_exp2f(s0[r] + e2q - ek) : 0.f; }
#pragma unroll
            for (int jj = 0; jj < 8; ++jj) { vq[jj] = (f32x4){0.f, 0.f, 0.f, 0.f}; if (jj < 4 && g < 2) vq[jj] = *(const f32x4*)(a.out + O_VS + (size_t)(b * 8 + 4 * g + jj) * DA + h * HD + 4 * c); }
            lsum += (p0[0] + p0[1]) + (p0[2] + p0[3]);
            S3_PV(p0, p1, vq);
        }
#undef S3_PV
#undef S3_PACK8
        lsum += __shfl_xor(lsum, 16); lsum += __shfl_xor(lsum, 32);
        if (lane < 8) lp[w * 8 + lane] = lsum;
        if (c < 8) {
#pragma unroll
            for (int r = 0; r < 4; ++r) *(LAS f32x4*)(Op + (w * 8 + c) * 64 + 16 * g + 4 * r) = (f32x4){oacc[0][r], oacc[1][r], oacc[2][r], oacc[3][r]}; }
        __syncthreads();
        for (int i = F.tid; i < 4 * 8 * 64; i += NTHR) { const int hq = i >> 9, t = (i >> 6) & 7, d = i & 63;
            const float O = Op[((2 * hq) * 8 + t) * 64 + d] + Op[((2 * hq + 1) * 8 + t) * 64 + d], L = lp[(2 * hq) * 8 + t] + lp[(2 * hq + 1) * 8 + t];
            AO[(size_t)(MP + b * 8 + t) * DA + (4 * (unit & 1) + hq) * 64 + d] = (bf16)(pkbf(O / L, 0.f) & 0xffffu); }
    }
}


template <class Epi> __device__ __forceinline__ void sg_phase(Frame& F, const bf16* A  , const bf16* Bt  , int K, int N, const Epi& E) {
    int lane = F.lane; asm volatile("" : "+v"(lane));
    const int fr = lane & 15, fq = lane >> 4, ntc = N >> 6, ntile = (MS / 128) * ntc, pitch = 2 * K + 16, kc = K >> 3;
    const bool grp = (F.G == 256);
    for (int t = grp ? (F.vcu & 31) : F.vcu; t < (grp ? ntc : ntile); t += grp ? 32 : F.G) {
        const int tr = grp ? (F.vcu >> 5) : t % (MS / 128), tc = grp ? t : t / (MS / 128);
        __syncthreads();
        for (int i = F.tid; i < 64 * kc; i += NTHR) { const int r = i / kc, c = i - r * kc; *(LAS v4u*)(F.lds + r * pitch + 16 * c) = *(const v4u*)(Bt + (size_t)(64 * tc + r) * K + 8 * c); }
        __syncthreads();
        const bf16* ap = A + (size_t)(128 * tr + 16 * F.wave + fr) * K + 8 * fq;
        const LAS unsigned char* bp = F.lds + fr * pitch + 16 * fq;
        f32x4 acc[4];
#pragma unroll
        for (int c = 0; c < 4; ++c) acc[c] = (f32x4){0.f, 0.f, 0.f, 0.f};
#pragma unroll 8
        for (int ks = 0; ks < K; ks += 32) {
            const bf16x8v av = *(const bf16x8v*)(ap + ks);
#pragma unroll
            for (int c = 0; c < 4; ++c) { const bf16x8v bv = *(const LAS bf16x8v*)(bp + 16 * c * pitch + 2 * ks); acc[c] = __builtin_amdgcn_mfma_f32_16x16x32_bf16(bv, av, acc[c], 0, 0, 0); }
        }
        E(acc, 128 * tr + 16 * F.wave + fr, tc, fq);
    }
}
template <int MODE> struct SgGate { const bf16* G; const bf16* Tin; bf16* O;
    __device__ __forceinline__ void operator()(const f32x4 (&acc)[4], int rs, int tc, int fq) const {
#pragma unroll
        for (int c = 0; c < 4; ++c) { const size_t off = (size_t)(MP + rs) * DM + 64 * tc + 16 * c + 4 * fq; const v2u g = *(const v2u*)(G + off);
            float r[4] = {acc[c][0] * bflo(g.x), acc[c][1] * bfhi(g.x), acc[c][2] * bflo(g.y), acc[c][3] * bfhi(g.y)};
            if (MODE == 1) { const v2u t = *(const v2u*)(Tin + off); r[0] += bflo(t.x); r[1] += bfhi(t.x); r[2] += bflo(t.y); r[3] += bfhi(t.y); }
            v2u w; w.x = pkbf(r[0], r[1]); w.y = pkbf(r[2], r[3]); *(v2u*)(O + off) = w; } } };
struct SgOut { const float* xs; float* H; bf16* HG; const float* gf; float* RSS;
    __device__ __forceinline__ void operator()(const f32x4 (&acc)[4], int rs, int tc, int fq) const { float ss = 0.f;
#pragma unroll
        for (int c = 0; c < 4; ++c) { const int col = 64 * tc + 16 * c + 4 * fq; const f32x4 h = acc[c] + *(const f32x4*)(xs + (size_t)rs * DM + col);
            ss += (h[0] * h[0] + h[1] * h[1]) + (h[2] * h[2] + h[3] * h[3]);
            v2u w; w.x = pkbf(h[0], h[1]); w.y = pkbf(h[2], h[3]); *(v2u*)(HG + (size_t)(MP + rs) * DM + col) = w; }
        ss += __shfl_xor(ss, 16); ss += __shfl_xor(ss, 32);
        if (fq == 0) RSS[(size_t)(MP + rs) * 16 + tc] = ss; } };
struct SgPQ { bf16* PQ;
    __device__ __forceinline__ void operator()(const f32x4 (&acc)[4], int rs, int tc, int fq) const {
#pragma unroll
        for (int c = 0; c < 4; ++c) { v2u w; w.x = pkbf(acc[c][0], acc[c][1]); w.y = pkbf(acc[c][2], acc[c][3]); *(v2u*)(PQ + (size_t)(MP + rs) * DQ + 64 * tc + 16 * c + 4 * fq) = w; } } };

constexpr int CW_GRP = 8448, CW_XID = 12288;
__device__ __forceinline__ void group_barrier(const Frame& F, const XcdBarrier& b, int seam) {
    asm volatile("s_waitcnt vmcnt(0)" ::: "memory");
    __syncthreads();
    if (threadIdx.x == 0) {
        const unsigned x = blockIdx.x & 7u, n = (gridDim.x - x + 7u) >> 3;
        unsigned same = F.MISC[20];
        if (same == 0u) { unsigned acc = 1u; for (unsigned m = x; m < gridDim.x; m += 8u) acc &= (xb_ld((unsigned*)(F.ctl + CW_XID + (int)m)) == b.x + 1u) ? 1u : 0u; same = 1u + acc; F.MISC[20] = same; }
        unsigned* c = (unsigned*)(F.ctl + CW_GRP + 64 * (seam * 8 + (int)x));
        if (same != 2u) { __builtin_amdgcn_fence(__ATOMIC_RELEASE, "agent"); asm volatile("s_waitcnt vmcnt(0)" ::: "memory"); }
        (void)xb_add(c, 1u);
        XB_SPIN(xb_ld(c) < n, b.bar);
        __builtin_amdgcn_fence(__ATOMIC_ACQUIRE, "agent");
        asm volatile("s_waitcnt vmcnt(0)" ::: "memory");
    }
    __syncthreads();
}

struct ChainOrder : pg8::StaticOrder {
    __device__ bool next(int i, pg8::Unit& u) const { const bool ok = pg8::StaticOrder::next(i >> 1, u); u.sel = i & 1; return ok; }
};

constexpr int N_PHASES = 9;
#ifndef MK_PER_PHASE
#define MK_PER_PHASE 0
#endif
__global__ void __launch_bounds__(NTHR, 2) fwd_kernel(Args args) {
    extern __shared__ __attribute__((aligned(16))) unsigned char lds[];
    Frame F;
    F.lds = (LAS unsigned char*)lds; F.MISC = (volatile LAS unsigned*)(F.lds + MISC_OFF);
    F.tid = threadIdx.x; F.lane = F.tid & 63; F.wave = __builtin_amdgcn_readfirstlane(F.tid >> 6);
    F.G = gridDim.x; { const int bx = blockIdx.x; F.vcu = (F.G % 8 == 0) ? (bx % 8) * (F.G / 8) + bx / 8 : bx; }
    F.ctl = (gu32*)(args.ws + WS_CTL);
    for (int u = F.tid; u < (LDS_BYTES - MISC_OFF) / 4; u += NTHR) ((LAS unsigned*)(F.lds + MISC_OFF))[u] = 0u;
    __syncthreads();
#if MK_PER_PHASE
#define GRID_BAR() do { } while (0)
#else
    XcdBarrier bar = xcd_barrier_post((unsigned*)(F.ctl + CW_BAR), F.MISC + 8);
    if (F.tid == 0) __hip_atomic_store((unsigned*)(F.ctl + CW_XID + (int)blockIdx.x), bar.x + 1u, __ATOMIC_RELAXED, __HIP_MEMORY_SCOPE_AGENT);
#define GRID_BAR() xcd_barrier(bar)
#endif
    unsigned char* ws = args.ws;
    const int lo = args.ph_lo, hi = args.ph_hi;
    const bool grp = (F.G == 256);
#ifndef DBG_REP_PHASE
#define DBG_REP_PHASE -1
#endif
#ifndef DBG_REP_N
#define DBG_REP_N 1
#endif
#define REPS(k) for (int rep_ = 0; rep_ < ((k) == DBG_REP_PHASE ? 1 + DBG_REP_N : 1); ++rep_)
#define IN(k) (lo <= (k) && (k) < hi)
#define BOTH(k) (IN(k) && IN((k) + 1))
#define ENDPH(k) do { if (BOTH(k) || (k) == DBG_REP_PHASE) GRID_BAR(); } while (0)
#if MK_PER_PHASE
#define ENDPH_G(k, seam) ENDPH(k)
#else
#define ENDPH_G(k, seam) do { if (BOTH(k) || (k) == DBG_REP_PHASE) { if (grp && (k) != DBG_REP_PHASE) group_barrier(F, bar, seam); else GRID_BAR(); } } while (0)
#endif
    if (IN(0)) REPS(0) { p0_prologue(F, args); ENDPH(0); }
    if (IN(1)) REPS(1) {
        p1_cumsum(F, args);
        pg8::Gemm g{(const bf16*)(ws + WS_XN), (const bf16*)(ws + WS_WIN), M, NPROJ - 256, DM}; pg8::StaticOrder S; S.init(M, NPROJ - 256, F.G, (int)blockIdx.x);
        EpiInProj E{(bf16*)(ws + WS_U), (bf16*)(ws + WS_Q), (bf16*)(ws + WS_K), (bf16*)(ws + WS_V), (bf16*)(ws + WS_GA), (bf16*)(ws + WS_GB), args.out, args.q_norm_g, args.k_norm_g, 0};
        pg8::gemm_phase<EpiInProj, pg8::StaticOrder, true, true>(F.lds, g, S, E);
        ENDPH(1);
    }
    if (IN(2)) REPS(2) {
        { pg8::Gemm g{(const bf16*)(ws + WS_XN), (const bf16*)(ws + WS_WIN) + (size_t)(NPROJ - 256) * DM, M, 256, DM}; pg8::StaticOrder S; S.init(M, 256, F.G, (int)blockIdx.x);
          EpiInProj E{(bf16*)(ws + WS_U), (bf16*)(ws + WS_Q), (bf16*)(ws + WS_K), (bf16*)(ws + WS_V), (bf16*)(ws + WS_GA), (bf16*)(ws + WS_GB), args.out, args.q_norm_g, args.k_norm_g, 15};
          pg8::gemm_phase<EpiInProj, pg8::StaticOrder, true, true>(F.lds, g, S, E); }
        __syncthreads();
        p2_cumsum_pool(F, args);
        if (2 == DBG_REP_PHASE || !IN(3)) GRID_BAR();
        __syncthreads(); }
    if (IN(3)) {
        const float M2 = __builtin_bit_cast(float, __builtin_amdgcn_readfirstlane(__builtin_bit_cast(int, attn_bound2(args, F.lane))));
#if !defined(DBG_SKIP_PATTN)
        { const attn_body::AttnTensors AT{(const attn_body::bf16*)(ws + WS_Q), (const attn_body::bf16*)(ws + WS_K), (const attn_body::bf16*)(ws + WS_V), (attn_body::bf16*)(ws + WS_AO), (const float*)(ws + WS_CP2), M2};
          const attn_body::QueueOrder S{(unsigned*)(F.ctl + 8192), F.MISC + 16};
          attn_body::attn_phase<attn_body::QueueOrder>((char*)lds, AT, S);
#ifdef DBG_ATTN2
          __syncthreads(); attn_body::attn_phase<attn_body::StaticOrder>((char*)lds, AT, S);
#endif
        }
#endif
        REPS(3) { p3_sample_attn2(F, args, M2); }
        ENDPH(3); }
    if (IN(4)) REPS(4) {
        { pg8::Gemm g{(const bf16*)(ws + WS_PO), (const bf16*)(ws + WS_WBP), MP, DM, DP, (const bf16*)(ws + WS_AO), (const bf16*)(ws + WS_WBA)}; ChainOrder S; S.init(MP, DM, F.G, (int)blockIdx.x);
          EpiMerge E{(const bf16*)(ws + WS_GA), (const bf16*)(ws + WS_GB), (bf16*)(ws + WS_MIX)};
          pg8::gemm_phase<EpiMerge, ChainOrder, true, true>(F.lds, g, S, E); }
        { SgGate<0> E{(const bf16*)(ws + WS_GA), nullptr, (bf16*)(ws + WS_T)}; sg_phase(F, (const bf16*)(ws + WS_PO) + (size_t)MP * DP, (const bf16*)(ws + WS_WBP), DP, DM, E); }
        asm volatile("s_waitcnt vmcnt(0)" ::: "memory"); __syncthreads();
        { SgGate<1> E{(const bf16*)(ws + WS_GB), (const bf16*)(ws + WS_T), (bf16*)(ws + WS_MIX)}; sg_phase(F, (const bf16*)(ws + WS_AO) + (size_t)MP * DA, (const bf16*)(ws + WS_WBA), DA, DM, E); }
        ENDPH_G(4, 0);
    }
    if (IN(5)) REPS(5) {
        pg8::Gemm g{(const bf16*)(ws + WS_MIX), (const bf16*)(ws + WS_WOUT), MP, DM, DM}; pg8::StaticOrder S; S.init(MP, DM, F.G, (int)blockIdx.x);
        EpiOut E{args.x_p, args.x_s, (float*)(ws + WS_H), (bf16*)(ws + WS_XN), args.norm_ffn_g, (float*)(ws + WS_RSS)};
        pg8::gemm_phase<EpiOut, pg8::StaticOrder, true, true>(F.lds, g, S, E);
        { SgOut E2{args.x_s, (float*)(ws + WS_H), (bf16*)(ws + WS_XN), args.norm_ffn_g, (float*)(ws + WS_RSS)}; sg_phase(F, (const bf16*)(ws + WS_MIX) + (size_t)MP * DM, (const bf16*)(ws + WS_WOUT), DM, DM, E2); }
        ENDPH_G(5, 1);
    }
    if (IN(6)) REPS(6) {
        pg8::Gemm g{(const bf16*)(ws + WS_XN), (const bf16*)(ws + WS_WQ), MP, DQ, DM}; pg8::StaticOrder S; S.init(MP, DQ, F.G, (int)blockIdx.x);
        pg8::EpiBf16<0> E{(bf16*)(ws + WS_PQ), DQ, nullptr, 0, 0, 1.f};
        pg8::gemm_phase<pg8::EpiBf16<0>, pg8::StaticOrder, true, true>(F.lds, g, S, E);
        { SgPQ E2{(bf16*)(ws + WS_PQ)}; sg_phase(F, (const bf16*)(ws + WS_XN) + (size_t)MP * DM, (const bf16*)(ws + WS_WQ), DM, DQ, E2); }
        ENDPH_G(6, 2);
    }
    if (IN(7)) REPS(7) { p7_topk(F, args); ENDPH_G(7, 3); }
    if (IN(8)) REPS(8) { p8_gather(F, args); ENDPH(8); }
#ifdef DBG_DUMP
    if (IN(9)) { const bf16* AO = (const bf16*)(ws + WS_AO); const bf16* PO = (const bf16*)(ws + WS_PO); const bf16* MX = (const bf16*)(ws + (DBG_DUMP == 3 ? WS_T : DBG_DUMP == 4 ? WS_GA : WS_MIX));
        for (size_t i = (size_t)blockIdx.x * NTHR + F.tid; i < (size_t)M * DM; i += (size_t)F.G * NTHR) { const int row = (int)(i >> 10), c = (int)(i & 1023);
            float v; if (DBG_DUMP == 1) v = c < 512 ? bf2f(AO[(size_t)row * DA + c]) : bf2f(PO[(size_t)row * DP + c - 512]); else v = bf2f(MX[i]);
            args.out[O_YP + i] = v; } }
#endif
#undef IN
#undef BOTH
}

extern "C" void kernel_launch(void* const* d_in, const int* in_sizes, int n_in, void* d_out, int out_size, void* d_ws, size_t ws_size, hipStream_t stream) {
    static int grid = 0;
    if (grid == 0) {
        if (n_in != 22 || (size_t)out_size != O_END || ws_size < WS_END) { fprintf(stderr, "kernel_launch: unexpected shapes (n_in %d out %d ws %zu)\n", n_in, out_size, ws_size); grid = -1; return; }
        int dev = 0, cus = 0, per_cu = 0;
        if (hipGetDevice(&dev) != hipSuccess || hipDeviceGetAttribute(&cus, hipDeviceAttributeMultiprocessorCount, dev) != hipSuccess) { grid = -1; return; }
        if (hipFuncSetAttribute((const void*)fwd_kernel, hipFuncAttributeMaxDynamicSharedMemorySize, LDS_BYTES) != hipSuccess) { fprintf(stderr, "kernel_launch: hipFuncSetAttribute failed\n"); grid = -1; return; }
        if (hipOccupancyMaxActiveBlocksPerMultiprocessor(&per_cu, (const void*)fwd_kernel, NTHR, LDS_BYTES) != hipSuccess || per_cu < 1) fprintf(stderr, "kernel_launch: occupancy query reports %d\n", per_cu);
        (void)hipGetLastError();
        grid = cus;
    }
    if (grid < 0) return;
    if (hipMemsetAsync((char*)d_ws + WS_CTL, 0, CTL_ZERO_BYTES, stream) != hipSuccess) return;
    Args a{};
    a.x_p = (const float*)d_in[0]; a.x_s = (const float*)d_in[1]; a.cache_k = (const float*)d_in[2]; a.cache_v = (const float*)d_in[3]; a.cache_lf = (const float*)d_in[4];
    a.state_pool = (const float*)d_in[5]; a.page_table = (const int*)d_in[6]; a.norm_mix_g = (const float*)d_in[7]; a.w_in = (const float*)d_in[8]; a.b_forget = (const float*)d_in[9];
    a.q_norm_g = (const float*)d_in[10]; a.k_norm_g = (const float*)d_in[11]; a.pool_mix_w = (const float*)d_in[12]; a.pool_scale = (const float*)d_in[13]; a.w_bp = (const float*)d_in[14];
    a.w_ba = (const float*)d_in[15]; a.w_out = (const float*)d_in[16]; a.norm_ffn_g = (const float*)d_in[17]; a.w_query = (const float*)d_in[18]; a.sub_keys = (const float*)d_in[19];
    a.peer_u = (const float*)d_in[20]; a.peer_v = (const float*)d_in[21];
    a.out = (float*)d_out; a.ws = (unsigned char*)d_ws; a.pad = 0;
#if MK_PER_PHASE
#ifndef DBG_NPH
#define DBG_NPH N_PHASES
#endif
    for (int ph = 0; ph < DBG_NPH; ++ph) { a.ph_lo = ph; a.ph_hi = ph + 1; a.li = ph; hipLaunchKernelGGL(fwd_kernel, dim3(grid), dim3(NTHR), LDS_BYTES, stream, a); }
#ifdef DBG_DUMP
    a.ph_lo = 9; a.ph_hi = 10; a.li = 9; hipLaunchKernelGGL(fwd_kernel, dim3(grid), dim3(NTHR), LDS_BYTES, stream, a);
#endif
#else
    a.ph_lo = 0; a.ph_hi = N_PHASES; a.li = 0; hipLaunchKernelGGL(fwd_kernel, dim3(grid), dim3(NTHR), LDS_BYTES, stream, a);
#endif
}
```

```cpp
#include <hip/hip_runtime.h>
#include <cstdio>
#include <cstdint>
#include <cmath>
namespace pg8 {
#define PG8_LAS __attribute__((address_space(3)))
typedef unsigned short bf16_t;
typedef short bf16x8 __attribute__((ext_vector_type(8)));
typedef float f32x4 __attribute__((ext_vector_type(4)));
typedef unsigned u32x4 __attribute__((ext_vector_type(4)));
constexpr int BM = 256, BK = 64, HALF = 128, HTB = HALF * BK * 2  , STAGE_BYTES = 8 * HTB, NXCD = 8, WGM = 8;

__host__ __device__ __forceinline__ int lds_byte(int r, int c) { const int st = (r >> 4) * 2 + (c >> 5), rr = r & 15, cc = c & 31, ob = rr * 64 + cc * 2; return st * 1024 + (ob ^ (((ob >> 9) & 1) << 5)); }
__host__ __device__ __forceinline__ void stage_rc(int b, int& R, int& C) { const int st = b / 1024, sb = b % 1024, swz = sb ^ (((sb >> 9) & 1) << 5); R = (st >> 1) * 16 + swz / 64; C = (st & 1) * 32 + (swz % 64) / 2; }
__host__ __device__ __forceinline__ int perm32(int rho) { const int n = rho >> 4, i = rho & 15; return 8 * (i >> 2) + 4 * n + (i & 3); }

struct Unit { int pm, pn, sel; };
struct Gemm { const bf16_t* A; const bf16_t* Bt; int M, N, K; const bf16_t* A2; const bf16_t* Bt2; };

struct StaticOrder {
    int nM, nN, nwg, G, c;
    __host__ __device__ void init(int M, int N, int G_, int c_) { nM = M / BM; nN = N / BM; nwg = nM * nN; G = G_; c = c_; }
    __host__ __device__ bool next(int i, Unit& u) const {
        const long L = (long)i * G + c; if (L >= nwg) return false;
        int wgid = (int)L; { const int q = nwg / NXCD, r = nwg % NXCD, xcd = wgid % NXCD, off = wgid / NXCD; wgid = (xcd < r ? xcd * (q + 1) : r * (q + 1) + (xcd - r) * q) + off; }
        const int nig = WGM * nN, gid = wgid / nig, fm = gid * WGM, gsz = (nM - fm) < WGM ? (nM - fm) : WGM;
        u.pm = fm + ((wgid % nig) % gsz); u.pn = (wgid % nig) / gsz; return true;
    }
    __device__ __forceinline__ void a_ready(const Unit&) const {}
    __device__ __forceinline__ void done(const Unit&) const {}
};

typedef float f32x2c __attribute__((ext_vector_type(2))); typedef __bf16 bf16x2c __attribute__((ext_vector_type(2)));
__device__ __forceinline__ unsigned cvt_pk_bf16(float lo, float hi) { f32x2c v = {lo, hi}; bf16x2c b = __builtin_convertvector(v, bf16x2c); return __builtin_bit_cast(unsigned, b); }
typedef float f32x2 __attribute__((ext_vector_type(2)));
__device__ __forceinline__ f32x2 gelu_pk(f32x2 v) {
    const f32x2 av = __builtin_elementwise_abs(v), d = av * 0.2316418882f + 1.0f;
    f32x2 t; t.x = __builtin_amdgcn_rcpf(d.x); t.y = __builtin_amdgcn_rcpf(d.y);
    f32x2 q = t * 0.5307027145f + (-0.7265760135f); q = q * t + 0.7107068705f; q = q * t + (-0.142248368f); q = q * t + 0.127414796f; q = q * t;
    const f32x2 s = (v * v) * (-0.72134752044f);
    f32x2 e; e.x = __builtin_amdgcn_exp2f(s.x); e.y = __builtin_amdgcn_exp2f(s.y);
    const f32x2 m = v * (q * e), r = v - m;
    f32x2 o; o.x = v.x < 0.f ? m.x : r.x; o.y = v.y < 0.f ? m.y : r.y; return o;
}

template <int ACT  > struct EpiBf16 {
    static constexpr bool PERM = true, AFTER_DRAIN = false, CHAIN = false; static_assert(ACT == 0 || ACT == 1, "EpiBf16: ACT is 0 (none) or 1 (gelu_pk)");
    bf16_t* O; int ldc; const float* bias; int split_cols; size_t split_stride; float scale0;
    __device__ __forceinline__ void operator()(const f32x4 (&acc)[2][2][4][2], const Unit& u, int wr, int wc, int fr, int fq) const {
        const int row0 = u.pm * BM + wr * 64 + fr; int colt = u.pn * BM; bf16_t* base = O;
        float sc = 1.f; if (split_cols) { const int t = colt / split_cols; base += (size_t)t * split_stride; colt -= t * split_cols; if (t == 0) sc = scale0; }
        const int col0 = colt + wc * 32 + 8 * fq, bcol0 = u.pn * BM + wc * 32 + 8 * fq;
        f32x4 bv[2][2];
#pragma unroll
        for (int bj = 0; bj < 2; ++bj)
#pragma unroll
            for (int n = 0; n < 2; ++n) bv[bj][n] = bias ? *(const f32x4*)(bias + bcol0 + bj * HALF + 4 * n) : (f32x4){0.f, 0.f, 0.f, 0.f};
#pragma unroll
        for (int ai = 0; ai < 2; ++ai)
#pragma unroll
            for (int m = 0; m < 4; ++m) { bf16_t* rowp = base + (size_t)(row0 + ai * HALF + m * 16) * ldc + col0;
#pragma unroll
                for (int bj = 0; bj < 2; ++bj) { f32x4 v0 = acc[ai][bj][m][0] + bv[bj][0], v1 = acc[ai][bj][m][1] + bv[bj][1];
                    if (ACT == 1) { f32x2 a = gelu_pk((f32x2){v0[0], v0[1]}), b = gelu_pk((f32x2){v0[2], v0[3]}), c = gelu_pk((f32x2){v1[0], v1[1]}), d = gelu_pk((f32x2){v1[2], v1[3]});
                        v0 = (f32x4){a.x, a.y, b.x, b.y}; v1 = (f32x4){c.x, c.y, d.x, d.y}; }
                    v0 = v0 * sc; v1 = v1 * sc; u32x4 w; w.x = cvt_pk_bf16(v0[0], v0[1]); w.y = cvt_pk_bf16(v0[2], v0[3]); w.z = cvt_pk_bf16(v1[0], v1[1]); w.w = cvt_pk_bf16(v1[2], v1[3]);
                    *(u32x4*)(rowp + bj * HALF) = w; } }
    }
};
template <class Epi, class Sched, bool ALIGN_EPI = false, bool SP2 = false>
__device__ __forceinline__ void gemm_phase(PG8_LAS unsigned char* lds, const Gemm g, const Sched& S, const Epi& E) {
    int tid = threadIdx.x; asm volatile("" : "+v"(tid));
    const int wid = __builtin_amdgcn_readfirstlane(tid >> 6), lane = tid & 63, wr = wid >> 2, wc = wid & 3, fr = lane & 15, fq = lane >> 4;
    const int K = g.K, nt = K / BK;
    unsigned voffA[2], voffB[2];
#pragma unroll
    for (int i = 0; i < 2; ++i) { int R, C; stage_rc(tid * 16 + i * 8192, R, C); const int Rb = Epi::PERM ? ((R & ~31) + perm32(R & 31)) : R;
        voffA[i] = (unsigned)(R * K + C) * 2u; voffB[i] = (unsigned)(Rb * K + C) * 2u; }
    const size_t kstep = (size_t)(BK * 2);
    const size_t hstep = (size_t)HALF * K * 2;
    const size_t tstep = 2 * hstep;
    const unsigned ldsw = (unsigned)wid * 1024u;
    const int aoff = lds_byte(wr * 64 + fr, fq * 8), boff = lds_byte(wc * 32 + fr, fq * 8);
#define PG8_SA(b, h) (((b) * 2 + (h)) * HTB)
#define PG8_SB(b, h) ((4 + (b) * 2 + (h)) * HTB)
#define PG8_STAGE(bufoff, gbase, voff) do { _Pragma("unroll") for (int _i = 0; _i < 2; ++_i) \
        __builtin_amdgcn_global_load_lds((const unsigned*)((const char*)(gbase) + (voff)[_i]), (PG8_LAS unsigned*)(lds + (bufoff) + ldsw + _i * 8192), 16, 0, 0); } while (0)
#define PG8_LDA(dst, b, h) do { _Pragma("unroll") for (int m = 0; m < 4; ++m) _Pragma("unroll") for (int k = 0; k < 2; ++k) dst[m][k] = *(const PG8_LAS bf16x8*)(lds + PG8_SA(b, h) + aoff + m * 2048 + k * 1024); } while (0)
#define PG8_LDB(dst, b, h) do { _Pragma("unroll") for (int n = 0; n < 2; ++n) _Pragma("unroll") for (int k = 0; k < 2; ++k) dst[n][k] = *(const PG8_LAS bf16x8*)(lds + PG8_SB(b, h) + boff + n * 2048 + k * 1024); } while (0)
#define PG8_MMA(ai, bj, At, Bt) do { __builtin_amdgcn_s_setprio(1); _Pragma("unroll") for (int m = 0; m < 4; ++m) _Pragma("unroll") for (int n = 0; n < 2; ++n) _Pragma("unroll") for (int k = 0; k < 2; ++k) \
        acc[ai][bj][m][n] = __builtin_amdgcn_mfma_f32_16x16x32_bf16(Bt[n][k], At[m][k], acc[ai][bj][m][n], 0, 0, 0); __builtin_amdgcn_s_setprio(0); } while (0)
#define PG8_WAIT_V(n) asm volatile("s_waitcnt vmcnt(" #n ")" ::: "memory")
#define PG8_WAIT_L(n) asm volatile("s_waitcnt lgkmcnt(" #n ")" ::: "memory")
#define PG8_BAR __builtin_amdgcn_s_barrier()
#define PG8_SCHED __builtin_amdgcn_sched_barrier(0)
    Unit cur, nxt; int ui = 0;
    if (!S.next(0, cur)) return;
    f32x4 acc[2][2][4][2];
#pragma unroll
    for (int a = 0; a < 2; ++a)
#pragma unroll
        for (int b = 0; b < 2; ++b)
#pragma unroll
            for (int m = 0; m < 4; ++m)
#pragma unroll
                for (int n = 0; n < 2; ++n) acc[a][b][m][n] = (f32x4){0.f, 0.f, 0.f, 0.f};
    bf16x8 At[4][2], B0[2][2], B1[2][2];
    const char* cA = (const char*)g.A + (size_t)cur.pm * tstep; const char* cB = (const char*)g.Bt + (size_t)cur.pn * tstep;
    if constexpr (Epi::CHAIN) { if (cur.sel) { cA = (const char*)g.A2 + (size_t)cur.pm * tstep; cB = (const char*)g.Bt2 + (size_t)cur.pn * tstep; } }
    S.a_ready(cur);
    if constexpr (SP2) {
        PG8_STAGE(PG8_SB(0, 0), cB, voffB); PG8_STAGE(PG8_SB(0, 1), cB + hstep, voffB); PG8_STAGE(PG8_SA(0, 0), cA, voffA); PG8_STAGE(PG8_SA(0, 1), cA + hstep, voffA);
        if (wr == 1) PG8_BAR;
        PG8_WAIT_V(2); PG8_BAR;
        PG8_STAGE(PG8_SB(1, 0), cB + kstep, voffB); PG8_STAGE(PG8_SA(1, 0), cA + kstep, voffA); PG8_STAGE(PG8_SB(1, 1), cB + hstep + kstep, voffB);
        PG8_WAIT_V(6); PG8_BAR;
    } else {
        PG8_STAGE(PG8_SB(0, 0), cB, voffB); PG8_STAGE(PG8_SA(0, 0), cA, voffA); PG8_STAGE(PG8_SB(0, 1), cB + hstep, voffB); PG8_STAGE(PG8_SA(0, 1), cA + hstep, voffA);
        if (wr == 1) PG8_BAR;
        PG8_WAIT_V(4); PG8_BAR;
        PG8_STAGE(PG8_SB(1, 0), cB + kstep, voffB); PG8_STAGE(PG8_SA(1, 0), cA + kstep, voffA); PG8_STAGE(PG8_SB(1, 1), cB + hstep + kstep, voffB);
        PG8_WAIT_V(6); PG8_BAR;
    }
    for (;;) {
        const bool has_next = S.next(ui + 1, nxt);
        const char* nA = has_next ? (const char*)g.A + (size_t)nxt.pm * tstep : cA; const char* nB = has_next ? (const char*)g.Bt + (size_t)nxt.pn * tstep : cB;
        if constexpr (Epi::CHAIN) { if (has_next && nxt.sel) { nA = (const char*)g.A2 + (size_t)nxt.pm * tstep; nB = (const char*)g.Bt2 + (size_t)nxt.pn * tstep; } }
        for (int t = 0; t < nt; t += 2) {
            const bool last = (t == nt - 2);
            const char* a1 = cA + (size_t)(t + 1) * kstep;
            const char* a2 = last ? nA : cA + (size_t)(t + 2) * kstep; const char* b2 = last ? nB : cB + (size_t)(t + 2) * kstep;
            const char* a3 = a2 + kstep; const char* b3 = b2 + kstep;
            if (last && has_next) S.a_ready(nxt);
            if constexpr (SP2) {
            PG8_LDB(B0, 0, 0); PG8_LDB(B1, 0, 1); PG8_SCHED; PG8_LDA(At, 0, 0); PG8_STAGE(PG8_SA(1, 1), a1 + hstep, voffA);
            PG8_WAIT_V(8); PG8_WAIT_L(0); PG8_BAR; PG8_MMA(0, 0, At, B0); PG8_MMA(0, 1, At, B1); PG8_BAR; PG8_SCHED;
            PG8_LDA(At, 0, 1); PG8_STAGE(PG8_SB(0, 0), b2, voffB); PG8_STAGE(PG8_SB(0, 1), b2 + hstep, voffB); PG8_STAGE(PG8_SA(0, 0), a2, voffA);
            PG8_WAIT_V(8); PG8_WAIT_L(0); PG8_BAR; PG8_MMA(1, 0, At, B0); PG8_MMA(1, 1, At, B1); PG8_BAR; PG8_SCHED;
            PG8_LDB(B0, 1, 0); PG8_LDB(B1, 1, 1); PG8_SCHED; PG8_LDA(At, 1, 0); PG8_STAGE(PG8_SA(0, 1), a2 + hstep, voffA);
            PG8_WAIT_V(8); PG8_WAIT_L(0); PG8_BAR; PG8_MMA(0, 0, At, B0); PG8_MMA(0, 1, At, B1); PG8_BAR; PG8_SCHED;
            PG8_LDA(At, 1, 1); PG8_STAGE(PG8_SB(1, 0), b3, voffB); PG8_STAGE(PG8_SB(1, 1), b3 + hstep, voffB); PG8_STAGE(PG8_SA(1, 0), a3, voffA);
            PG8_WAIT_V(8); PG8_WAIT_L(0); PG8_BAR; PG8_MMA(1, 0, At, B0); PG8_MMA(1, 1, At, B1); PG8_BAR; PG8_SCHED;
            } else {
            PG8_LDB(B0, 0, 0); PG8_SCHED; PG8_LDA(At, 0, 0); PG8_STAGE(PG8_SA(1, 1), a1 + hstep, voffA);
            PG8_WAIT_L(8); PG8_BAR; PG8_WAIT_L(0); PG8_MMA(0, 0, At, B0); PG8_BAR; PG8_SCHED;
            PG8_LDB(B1, 0, 1); PG8_STAGE(PG8_SB(0, 0), b2, voffB);
            PG8_BAR; PG8_WAIT_L(0); PG8_MMA(0, 1, At, B1); PG8_BAR;
            PG8_LDA(At, 0, 1); PG8_STAGE(PG8_SA(0, 0), a2, voffA);
            PG8_BAR; PG8_WAIT_L(0); PG8_MMA(1, 0, At, B0); PG8_BAR; PG8_SCHED;
            PG8_STAGE(PG8_SB(0, 1), b2 + hstep, voffB);
            PG8_WAIT_V(6); PG8_BAR; PG8_MMA(1, 1, At, B1); PG8_BAR;
            PG8_LDB(B0, 1, 0); PG8_SCHED; PG8_LDA(At, 1, 0); PG8_STAGE(PG8_SA(0, 1), a2 + hstep, voffA);
            PG8_WAIT_L(8); PG8_BAR; PG8_WAIT_L(0); PG8_MMA(0, 0, At, B0); PG8_BAR; PG8_SCHED;
            PG8_LDB(B1, 1, 1); PG8_STAGE(PG8_SB(1, 0), b3, voffB);
            PG8_BAR; PG8_WAIT_L(0); PG8_MMA(0, 1, At, B1); PG8_BAR;
            PG8_LDA(At, 1, 1); PG8_STAGE(PG8_SA(1, 0), a3, voffA);
            PG8_BAR; PG8_WAIT_L(0); PG8_MMA(1, 0, At, B0); PG8_BAR; PG8_SCHED;
            PG8_STAGE(PG8_SB(1, 1), b3 + hstep, voffB);
            PG8_WAIT_V(6); PG8_BAR; PG8_MMA(1, 1, At, B1); PG8_BAR;
            }
        }
        if constexpr (ALIGN_EPI) { if (wr == 0) PG8_BAR; }
        bool keep_acc = false;
        if constexpr (Epi::CHAIN) { if (cur.sel == 0) { E.mid(acc, cur, wr, wc, fr, fq); keep_acc = true; } else { E(acc, cur, wr, wc, fr, fq); S.done(cur); } }
        else if constexpr (!Epi::AFTER_DRAIN) { E(acc, cur, wr, wc, fr, fq); S.done(cur); }
        if (!has_next) break;
        if (!keep_acc) {
#pragma unroll
        for (int a = 0; a < 2; ++a)
#pragma unroll
            for (int b = 0; b < 2; ++b)
#pragma unroll
                for (int m = 0; m < 4; ++m)
#pragma unroll
                    for (int n = 0; n < 2; ++n) acc[a][b][m][n] = (f32x4){0.f, 0.f, 0.f, 0.f};
        }
        cur = nxt; cA = nA; cB = nB; ++ui;
        if constexpr (ALIGN_EPI) { if (wr == 1) PG8_BAR; }
    }
    PG8_WAIT_V(0);
    if constexpr (!ALIGN_EPI) { if (wr == 0) PG8_BAR; }
    PG8_BAR;
    if constexpr (Epi::AFTER_DRAIN) { E.fused(acc, cur, wr, wc, fr, fq, lds, wid, lane); S.done(cur); }
#undef PG8_SA
#undef PG8_SB
#undef PG8_STAGE
#undef PG8_LDA
#undef PG8_LDB
#undef PG8_MMA
#undef PG8_WAIT_V
#undef PG8_WAIT_L
#undef PG8_BAR
#undef PG8_SCHED
}
}
#define GAS __attribute__((address_space(1)))
#define LAS __attribute__((address_space(3)))
typedef unsigned short bf16;
typedef unsigned v4u __attribute__((ext_vector_type(4)));
typedef float f32x4 __attribute__((ext_vector_type(4)));
typedef short bf16x8 __attribute__((ext_vector_type(8)));
typedef GAS unsigned gu32;
typedef GAS unsigned long long gu64;
#define RLX_AGENT __ATOMIC_RELAXED, __HIP_MEMORY_SCOPE_AGENT
#define LDS_WAIT() asm volatile("s_waitcnt lgkmcnt(0)" ::: "memory")
#define VM_WAIT() asm volatile("s_waitcnt vmcnt(0)" ::: "memory")
__device__ __forceinline__ unsigned long long rt() { return __builtin_amdgcn_s_memrealtime(); }
__device__ __forceinline__ unsigned f2bf(float f) { unsigned u = __builtin_bit_cast(unsigned, f); return (u + 0x7fffu + ((u >> 16) & 1u)) >> 16; }
__device__ __forceinline__ unsigned pk2(float lo, float hi) { return f2bf(lo) | (f2bf(hi) << 16); }

#define XB_TMO      128
#define XB_XCNT(j)  (256  + 64 * (j))
#define XB_XSUB(j)  (1280 + 64 * (j))
#define XB_XGEN(j)  (2304 + 64 * (j))
#define XB_TOP      3328
#define XB_TOPGEN   3392
#define XCD_BAR_WORDS 3456
#define XB_SPIN_CAP (1u << 18)

__device__ __forceinline__ unsigned xb_ld(unsigned* p)              { return __hip_atomic_load(p, __ATOMIC_RELAXED, __HIP_MEMORY_SCOPE_AGENT); }
__device__ __forceinline__ unsigned xb_add(unsigned* p, unsigned v) { return __hip_atomic_fetch_add(p, v, __ATOMIC_RELAXED, __HIP_MEMORY_SCOPE_AGENT); }
__device__ __forceinline__ unsigned xb_xcc_id() { return (unsigned)__builtin_amdgcn_s_getreg((3 << 11) | 20) & 0xFu; }
#define XB_SPIN(cond, bar) do { unsigned _sp = 0; while (cond) { __builtin_amdgcn_s_sleep(1); \
    if ((++_sp & 255u) == 0u) { if (xb_ld(&(bar)[XB_TMO])) break; if (_sp > XB_SPIN_CAP) { atomicAdd(&(bar)[XB_TMO], 1u); break; } } } } while (0)

struct XcdBarrier {
    unsigned* bar; unsigned x;
    volatile LAS unsigned* st;
};

__device__ __forceinline__ XcdBarrier xcd_barrier_post(unsigned* bar, volatile LAS unsigned* st) {
    XcdBarrier b; b.bar = bar; b.x = xb_xcc_id(); b.st = st;
    if (threadIdx.x == 0) (void)xb_add(&bar[XB_XCNT(b.x)], 1u);
    return b;
}
__device__ __forceinline__ void xcd_barrier_complete(unsigned* bar, unsigned x, unsigned& nloc, unsigned& nx) {
    const unsigned G = gridDim.x * gridDim.y * gridDim.z;
    unsigned sum, cnt, mine, sp = 0u;
    for (;;) {
        sum = 0u; cnt = 0u; mine = 0u;
#pragma unroll
        for (unsigned j = 0; j < 16; ++j) { const unsigned c = xb_ld(&bar[XB_XCNT(j)]); sum += c; cnt += (c > 0u) ? 1u : 0u; mine = (j == x) ? c : mine; }
        if (sum == G) break;
        __builtin_amdgcn_s_sleep(1);
        if ((++sp & 255u) == 0u) { if (xb_ld(&bar[XB_TMO])) break; if (sp > XB_SPIN_CAP) { atomicAdd(&bar[XB_TMO], 1u); break; } }
    }
    nloc = mine > 0u ? mine : 1u; nx = cnt > 0u ? cnt : 1u;
}

__device__ __forceinline__ void xcd_barrier(const XcdBarrier& b) {
    asm volatile("s_waitcnt vmcnt(0)" ::: "memory");
    __syncthreads();
    if (threadIdx.x == 0) {
        unsigned* bar = b.bar;
        __builtin_amdgcn_s_waitcnt(0);
        unsigned nloc = b.st[0], nx = b.st[1];
        if (nloc == 0u) { xcd_barrier_complete(bar, b.x, nloc, nx); b.st[0] = nloc; b.st[1] = nx; }
        const unsigned old = xb_add(&bar[XB_XSUB(b.x)], 1u);
        const unsigned gen = old / nloc;
        if (old + 1u == (gen + 1u) * nloc) {
            __builtin_amdgcn_fence(__ATOMIC_RELEASE, "agent");
            asm volatile("s_waitcnt vmcnt(0)" ::: "memory");
            const unsigned og = xb_add(&bar[XB_TOP], 1u);
            const unsigned tg = og / nx;
            if (og + 1u == (tg + 1u) * nx) xb_add(&bar[XB_TOPGEN], 1u);
            else XB_SPIN(xb_ld(&bar[XB_TOPGEN]) == tg, bar);
            __builtin_amdgcn_fence(__ATOMIC_ACQUIRE, "agent");
            xb_add(&bar[XB_XGEN(b.x)], 1u);
            asm volatile("s_waitcnt vmcnt(0)" ::: "memory");
        } else {
            XB_SPIN(xb_ld(&bar[XB_XGEN(b.x)]) == gen, bar);
            __builtin_amdgcn_fence(__ATOMIC_ACQUIRE, "agent");
            asm volatile("s_waitcnt vmcnt(0)" ::: "memory");
        }
    }
    __syncthreads();
}
#include <hip/hip_bf16.h>
#include <cmath>
namespace attn_body {
using bf16=__hip_bfloat16;
using bf16x8=__attribute__((ext_vector_type(8)))short;
using s16x4=__attribute__((ext_vector_type(4)))short;
using f32x16=__attribute__((ext_vector_type(16)))float;
using u32x4=__attribute__((ext_vector_type(4)))unsigned;
constexpr int BATCH=4,NHEAD=8,SEQ=4096,D=64,DM=NHEAD*D;
constexpr int NW=8,QBLK=32,QB=QBLK*NW,KVBLK=64,NQB=SEQ/QB;
constexpr int ATTN_PITCH=DM, ATTN_UNIT_ROWS=QB;
__device__ __forceinline__ int crow(int r,int hi){return (r&3)+8*(r>>2)+4*hi;}
#define SBAR() __builtin_amdgcn_sched_barrier(0)
__device__ __forceinline__ void cmask(f32x16&p0,f32x16&p1,int jb,int qrel,int hi){
  const float NEG=-INFINITY; int kb=64*jb+4*hi;
  #pragma unroll
  for(int r=0;r<16;++r){int kv=kb+(r&3)+8*(r>>2); if(kv>qrel)p0[r]=NEG; if(kv+32>qrel)p1[r]=NEG;}
}

constexpr int NSLOT=3, SLOTB=8192;
constexpr int LDS_K=0, LDS_V=NSLOT*SLOTB, LDS_WS=2*NSLOT*SLOTB, LDS_OST=LDS_WS+NW*64*4, LDS_CK=LDS_OST+NW*4096, LDS_BYTES=LDS_CK+SEQ*4;
constexpr float C2=0.125f*1.4426950408889634f;
__device__ __forceinline__ void glds16(const void*gsrc,unsigned lds_dst){unsigned keep;
  asm volatile("s_mov_b32 %0, m0\n\ts_mov_b32 m0, %2\n\ts_nop 0\n\tglobal_load_lds_dwordx4 %1, off\n\ts_mov_b32 m0, %0":"=&s"(keep):"v"(gsrc),"s"(lds_dst):"memory");}
__device__ __forceinline__ float max3f(float a,float b,float c){float r;asm("v_max3_f32 %0, %1, %2, %3":"=v"(r):"v"(a),"v"(b),"v"(c));return r;}
__device__ __forceinline__ float max2f(float a,float b){float r;asm("v_max_f32_e32 %0, %1, %2":"=v"(r):"v"(a),"v"(b));return r;}
__device__ __forceinline__ float fadd_s(float a,float b){float r;asm("v_add_f32_e32 %0, %1, %2":"=v"(r):"v"(a),"v"(b));return r;}
__device__ __forceinline__ float fsub_s(float a,float b){float r;asm("v_sub_f32_e32 %0, %1, %2":"=v"(r):"v"(a),"v"(b));return r;}
typedef float f32x2_t __attribute__((ext_vector_type(2))); typedef __bf16 bf16x2_t __attribute__((ext_vector_type(2)));
__device__ __forceinline__ unsigned cvtpk_s(float lo,float hi){f32x2_t v={lo,hi};bf16x2_t b=__builtin_convertvector(v,bf16x2_t);return __builtin_bit_cast(unsigned,b);}
#define WAIT_BAR(N) asm volatile("s_waitcnt vmcnt(" #N ") lgkmcnt(0)\n\ts_barrier":::"memory")

__device__ __forceinline__ void qkt(f32x16&p0,f32x16&p1,const char*Kslot,const bf16x8*qr,int r32,int hi){
  const char*kb=Kslot+hi*1024+r32*16;
  #pragma unroll
  for(int d0=0;d0<4;++d0){
    const bf16x8 b0=*reinterpret_cast<const bf16x8*>(kb+d0*2048);
    const bf16x8 b1=*reinterpret_cast<const bf16x8*>(kb+d0*2048+512);
    p0=__builtin_amdgcn_mfma_f32_32x32x16_bf16(b0,qr[d0],p0,0,0,0);p1=__builtin_amdgcn_mfma_f32_32x32x16_bf16(b1,qr[d0],p1,0,0,0);}
}
typedef __attribute__((address_space(3))) const char* lds_cptr;
typedef short v4i16_t __attribute__((ext_vector_type(4)));
__device__ __forceinline__ void kload8(bf16x8*kf,lds_cptr kp){
  kf[0]=*(const __attribute__((address_space(3))) bf16x8*)(kp);      kf[1]=*(const __attribute__((address_space(3))) bf16x8*)(kp+512);
  kf[2]=*(const __attribute__((address_space(3))) bf16x8*)(kp+2048); kf[3]=*(const __attribute__((address_space(3))) bf16x8*)(kp+2560);
  kf[4]=*(const __attribute__((address_space(3))) bf16x8*)(kp+4096); kf[5]=*(const __attribute__((address_space(3))) bf16x8*)(kp+4608);
  kf[6]=*(const __attribute__((address_space(3))) bf16x8*)(kp+6144); kf[7]=*(const __attribute__((address_space(3))) bf16x8*)(kp+6656);
}
__device__ __forceinline__ void kload2(bf16x8*kf,lds_cptr kp,int j){ kf[2*j]=*(const __attribute__((address_space(3))) bf16x8*)(kp+j*2048); kf[2*j+1]=*(const __attribute__((address_space(3))) bf16x8*)(kp+j*2048+512); }
__device__ __forceinline__ s16x4 vtr(lds_cptr p){ return __builtin_bit_cast(s16x4,__builtin_amdgcn_ds_read_tr16_b64_v4i16((__attribute__((address_space(3))) v4i16_t*)p)); }
__device__ __forceinline__ float rowmax(const f32x16&p0,const f32x16&p1){
  float a=max3f(p0[0],p0[1],p1[0]),b=max3f(p0[2],p0[3],p1[1]);a=max3f(a,p1[2],p1[3]);
  #pragma unroll
  for(int r=4;r<16;r+=4){a=max3f(a,p0[r],p0[r+1]);b=max3f(b,p0[r+2],p0[r+3]);a=max3f(a,p1[r],p1[r+1]);b=max3f(b,p1[r+2],p1[r+3]);}
  const float m=max2f(a,b);
  auto rr=__builtin_amdgcn_permlane32_swap(__float_as_uint(m),__float_as_uint(m),false,false);
  return max2f(__uint_as_float(rr[0]),__uint_as_float(rr[1]));
}
__device__ __forceinline__ void pv(f32x16*o,int vb,bf16x8 pa0,bf16x8 pa1,bf16x8 pa2,bf16x8 pa3){
  #pragma unroll
  for(int d0=0;d0<2;++d0){s16x4 lo[4],hi[4];
    #pragma unroll
    for(int ks=0;ks<4;++ks){
      asm volatile("ds_read_b64_tr_b16 %0,%1 offset:%c2":"=&v"(lo[ks]):"v"(vb),"i"(d0*4096+ks*1024):"memory");
      asm volatile("ds_read_b64_tr_b16 %0,%1 offset:%c2":"=&v"(hi[ks]):"v"(vb),"i"(d0*4096+ks*1024+512):"memory");}
    asm volatile("s_waitcnt lgkmcnt(0)":::"memory");SBAR();
    #define PK(k) (bf16x8){lo[k][0],lo[k][1],lo[k][2],lo[k][3],hi[k][0],hi[k][1],hi[k][2],hi[k][3]}
    o[d0]=__builtin_amdgcn_mfma_f32_32x32x16_bf16(pa0,PK(0),o[d0],0,0,0);
    o[d0]=__builtin_amdgcn_mfma_f32_32x32x16_bf16(pa1,PK(1),o[d0],0,0,0);
    o[d0]=__builtin_amdgcn_mfma_f32_32x32x16_bf16(pa2,PK(2),o[d0],0,0,0);
    o[d0]=__builtin_amdgcn_mfma_f32_32x32x16_bf16(pa3,PK(3),o[d0],0,0,0);
    #undef PK
  }
}

#ifndef ATTN_STORE16
#define ATTN_STORE16(p,v) (*(u32x4*)(p)=(v))
#endif
template<int THRL> __device__ __forceinline__ void attn_unit(int b,int h,int qb,const bf16*Q,const bf16*__restrict__ K,const bf16*__restrict__ V,bf16*O,const float*__restrict__ c2,float M2,char*shm){
  int tid=threadIdx.x; asm volatile("":"+v"(tid)); const int lane=tid&63,r32=lane&31,hi=lane>>5; const int wid=__builtin_amdgcn_readfirstlane(tid>>6);
  const long rowbase=(long)b*SEQ; const int q0=qb*QB;
  const bf16*Qw=Q+(rowbase+q0+wid*QBLK)*DM+h*D;
  const bf16*Kh0=K+rowbase*DM+h*D,*Vh0=V+rowbase*DM+h*D;
  const unsigned lds0=(unsigned)(uintptr_t)shm;
  float*wsf=(float*)(shm+LDS_WS)+wid*64;
  const unsigned kdst=lds0+LDS_K+wid*1024, vdst=lds0+LDS_V+wid*1024;
  #define DMA_K(t,slot) glds16(ksrc+(long)(t)*KVBLK*DM,(unsigned)__builtin_amdgcn_readfirstlane(kdst+(slot)))
  #define DMA_V(t,slot) glds16(vsrc+(long)(t)*KVBLK*DM,(unsigned)__builtin_amdgcn_readfirstlane(vdst+(slot)))
  const int vb0=(int)(lds0+LDS_V)+((lane>>4)&1)*32+(lane&3)*8+(4*hi+((lane&15)>>2))*64;
  const char*Kbase=shm+LDS_K; bf16x8 kf[8];
  const lds_cptr shm3=(lds_cptr)shm; const lds_cptr kp0=shm3+LDS_K+hi*1024+r32*16; const lds_cptr vp0=shm3+LDS_V+((lane>>4)&1)*32+(lane&3)*8+(4*hi+((lane&15)>>2))*64;
  const int NT0=(q0+QB)/KVBLK;
  int ts; { const int tl=lane; const float cqa=c2[q0]; const float ckb=(tl<NT0-4)?c2[64*tl+63]:cqa; const unsigned long long bm=__ballot((tl<NT0-4)&&(cqa-ckb< -(24.f+2.f*M2))); ts=__builtin_popcountll(bm)&~1; }
  ts=__builtin_amdgcn_readfirstlane(ts);
  const int NT=NT0-ts;
  const bf16*Kh=Kh0+(long)ts*KVBLK*DM,*Vh=Vh0+(long)ts*KVBLK*DM;
  const bf16*ksrc=Kh+(long)lane*DM+wid*8;
  const bf16*vsrc=Vh+(long)(16*(wid&3)+(lane>>2))*DM+(wid>>2)*32+(lane&3)*8;
  typedef float f32x4_t __attribute__((ext_vector_type(4)));
  int tidl=tid; asm volatile("":"+v"(tidl));
  const int nck4=(q0+QB)/4; f32x4_t ckv0=f32x4_t{},ckv1=f32x4_t{}; if(tidl<nck4)ckv0=((const f32x4_t*)c2)[tidl]; if(tidl+512<nck4)ckv1=((const f32x4_t*)c2)[tidl+512];
  const float cq=c2[q0+wid*QBLK+r32]-M2;
  DMA_K(0,0);DMA_V(0,0);DMA_K(1,SLOTB);
  bf16x8 qr[4];
  #pragma unroll
  for(int d0=0;d0<4;++d0)qr[d0]=*reinterpret_cast<const bf16x8*>(&Qw[(long)r32*DM+d0*16+hi*8]);
  float l_reg=0.f;f32x16 o[2];o[0]=f32x16{};o[1]=f32x16{};
  { __attribute__((address_space(3))) f32x4_t*ckl=(__attribute__((address_space(3))) f32x4_t*)((lds_cptr)shm+LDS_CK); if(tidl<nck4)ckl[tidl]=ckv0; if(tidl+512<nck4)ckl[tidl+512]=ckv1; }
  const __attribute__((address_space(3))) f32x4_t*ckp=(const __attribute__((address_space(3))) f32x4_t*)((lds_cptr)shm+LDS_CK)+hi+ts*16;
  #define CKLD(P0,P1,t) do{ _Pragma("unroll") for(int g_=0;g_<4;++g_){ const f32x4_t a_=ckp[(t)*16+2*g_], b_=ckp[(t)*16+8+2*g_]; P0[4*g_]=a_[0];P0[4*g_+1]=a_[1];P0[4*g_+2]=a_[2];P0[4*g_+3]=a_[3]; P1[4*g_]=b_[0];P1[4*g_+1]=b_[1];P1[4*g_+2]=b_[2];P1[4*g_+3]=b_[3]; } }while(0)
  #define CKSUB(P0,P1) do{ _Pragma("unroll") for(int r=0;r<16;++r){P0[r]=cq-P0[r];P1[r]=cq-P1[r];} }while(0)
  const int qrel=wid*QBLK+r32;
  #define CMASK(P0,P1,t) do{int jb_=(t)-(NT-4); if(jb_>=0)cmask(P0,P1,jb_,qrel,hi);}while(0)
  #define START(P0,P1) do{ _Pragma("unroll") for(int r=0;r<16;++r)P0[r]=__builtin_amdgcn_exp2f(P0[r]); }while(0)
  #define RESC() do{}while(0)
  f32x16 pA0,pA1,pB0,pB1;
  int sl_prev=0,sl_cur=0,sl_next=SLOTB;
  #define ROT() do{sl_prev=sl_cur;sl_cur=sl_next;sl_next=(sl_next==(NSLOT-1)*SLOTB)?0:sl_next+SLOTB;}while(0)
  DMA_K(2,2*SLOTB);
  WAIT_BAR(3);
  CKLD(pA0,pA1,0);CKSUB(pA0,pA1);
  qkt(pA0,pA1,Kbase,qr,r32,hi);asm volatile("s_nop 15\n\ts_nop 7":"+v"(pA0),"+v"(pA1));CMASK(pA0,pA1,0);
  CKLD(pB0,pB1,1);CKSUB(pB0,pB1);
  START(pA0,pA1);
  _Pragma("unroll") for(int r=0;r<16;++r)pA1[r]=__builtin_amdgcn_exp2f(pA1[r]);
  WAIT_BAR(0);
  DMA_K(3,0);DMA_V(1,SLOTB);
  ROT();
  kload8(kf,kp0+sl_cur);
  WAIT_BAR(2);
  s16x4 vlo[8],vhi[8]; u32x4 pw0,pw1,pw2,pw3;
  #define PKW(P,B) cvtpk_s(P[B],P[B+1])
  #define PAF(k) __builtin_bit_cast(bf16x8,pw##k)
  #define VFR(i) (bf16x8){vlo[i][0],vlo[i][1],vlo[i][2],vlo[i][3],vhi[i][0],vhi[i][1],vhi[i][2],vhi[i][3]}
  #define PIN(x) asm volatile("":"+v"(x))
  #define MX3(a,b,c) __builtin_fmaxf(__builtin_fmaxf((a),(b)),(c))
  #define GAPA(MF,A0,A1,A2,A3,W0,W1,PW) do{ MF; sacc+=A0; sacc+=A1; sacc+=A2; sacc+=A3; PIN(sacc); W0; W1; PIN(PW); SBAR(); }while(0)
  #define EX(v) __builtin_amdgcn_exp2f(v)
  #define GAPB(MF,X,B) do{ MF; X[B]=EX(X[B]); X[B+1]=EX(X[B+1]); X[B+2]=EX(X[B+2]); X[B+3]=EX(X[B+3]); PIN(X); SBAR(); }while(0)
  #define VRD(i) do{ vlo[i]=vtr(vp_+(((i)>>2)*4096+((i)&3)*1024)); vhi[i]=vtr(vp_+(((i)>>2)*4096+((i)&3)*1024+512)); }while(0)
  #define KRD(G,j) do{ if(G){ kload2(kf,kp0+sl_next,j); SBAR(); } }while(0)
  #define STEP(C0,C1,P0,P1,t,GK,GV,GL) do{ SBAR(); \
    const lds_cptr vp_=vp0+sl_prev; \
    VRD(0); SBAR(); float sacc=(P0[0]+P0[1]); \
    GAPA(C0=__builtin_amdgcn_mfma_f32_32x32x16_bf16(kf[0],qr[0],C0,0,0,0), P0[2],P0[3],P0[4],P0[5],     pw0[0]=PKW(P0,0), pw0[1]=PKW(P0,2), pw0); \
    VRD(4); SBAR(); GAPA(C1=__builtin_amdgcn_mfma_f32_32x32x16_bf16(kf[1],qr[0],C1,0,0,0), P0[6],P0[7],P0[8],P0[9],     pw0[2]=PKW(P0,4), pw0[3]=PKW(P0,6), pw0); \
    VRD(1); SBAR(); GAPA(C0=__builtin_amdgcn_mfma_f32_32x32x16_bf16(kf[2],qr[1],C0,0,0,0),   P0[10],P0[11],P0[12],P0[13], pw1[0]=PKW(P0,8), pw1[1]=PKW(P0,10), pw1); \
    VRD(5); SBAR(); GAPA(C1=__builtin_amdgcn_mfma_f32_32x32x16_bf16(kf[3],qr[1],C1,0,0,0),   P0[14],P0[15],P1[0],P1[1],   pw1[2]=PKW(P0,12),pw1[3]=PKW(P0,14), pw1); \
    VRD(2); SBAR(); GAPA(C0=__builtin_amdgcn_mfma_f32_32x32x16_bf16(kf[4],qr[2],C0,0,0,0),   P1[2],P1[3],P1[4],P1[5],     pw2[0]=PKW(P1,0), pw2[1]=PKW(P1,2), pw2); \
    VRD(6); SBAR(); GAPA(C1=__builtin_amdgcn_mfma_f32_32x32x16_bf16(kf[5],qr[2],C1,0,0,0),   P1[6],P1[7],P1[8],P1[9],     pw2[2]=PKW(P1,4), pw2[3]=PKW(P1,6), pw2); \
    VRD(3); SBAR(); GAPA(C0=__builtin_amdgcn_mfma_f32_32x32x16_bf16(kf[6],qr[3],C0,0,0,0),   P1[10],P1[11],P1[12],P1[13], pw3[0]=PKW(P1,8), pw3[1]=PKW(P1,10), pw3); \
    VRD(7); SBAR(); GAPA(C1=__builtin_amdgcn_mfma_f32_32x32x16_bf16(kf[7],qr[3],C1,0,0,0),   P1[14],P1[15],0.f,0.f,       pw3[2]=PKW(P1,12),pw3[3]=PKW(P1,14), pw3); \
    l_reg+=sacc; \
    if(GK){DMA_K((t)+3,sl_cur);} if(GV){DMA_V((t)+1,sl_next);} \
    CMASK(C0,C1,t); \
    SBAR(); \
    GAPB(o[0]=__builtin_amdgcn_mfma_f32_32x32x16_bf16(PAF(0),VFR(0),o[0],0,0,0), C0,0); \
    GAPB(o[1]=__builtin_amdgcn_mfma_f32_32x32x16_bf16(PAF(0),VFR(4),o[1],0,0,0), C0,4); \
    KRD(GL,0); GAPB(o[0]=__builtin_amdgcn_mfma_f32_32x32x16_bf16(PAF(1),VFR(1),o[0],0,0,0), C0,8); \
    KRD(GL,1); GAPB(o[1]=__builtin_amdgcn_mfma_f32_32x32x16_bf16(PAF(1),VFR(5),o[1],0,0,0), C0,12); \
    KRD(GL,2); GAPB(o[0]=__builtin_amdgcn_mfma_f32_32x32x16_bf16(PAF(2),VFR(2),o[0],0,0,0), C1,0); \
    KRD(GL,3); GAPB(o[1]=__builtin_amdgcn_mfma_f32_32x32x16_bf16(PAF(2),VFR(6),o[1],0,0,0), C1,4); \
    GAPB(o[0]=__builtin_amdgcn_mfma_f32_32x32x16_bf16(PAF(3),VFR(3),o[0],0,0,0), C1,8); \
    GAPB(o[1]=__builtin_amdgcn_mfma_f32_32x32x16_bf16(PAF(3),VFR(7),o[1],0,0,0), C1,12); \
    if(GL){ CKLD(P0,P1,(t)+1); CKSUB(P0,P1); } \
    }while(0)
  int t=1;
  #undef CMASK
  #define CMASK(P0,P1,t) do{}while(0)
  for(;t+5<NT;t+=2){
    STEP(pB0,pB1,pA0,pA1,t,true,true,true);     WAIT_BAR(2); RESC(); ROT();
    STEP(pA0,pA1,pB0,pB1,t+1,true,true,true);   WAIT_BAR(2); RESC(); ROT();
  }
  #undef CMASK
  #define CMASK(P0,P1,t) do{int jb_=(t)-(NT-4); if(jb_>=0)cmask(P0,P1,jb_,qrel,hi);}while(0)
  #define ENDW(tt) do{ if((tt)+3<NT){WAIT_BAR(2);} else if((tt)+2<NT){WAIT_BAR(1);} else {WAIT_BAR(0);} }while(0)
  for(;t+1<NT;t+=2){
    STEP(pB0,pB1,pA0,pA1,t,(t+3<NT),(t+1<NT),(t+1<NT));       ENDW(t);   RESC(); ROT();
    STEP(pA0,pA1,pB0,pB1,t+1,(t+4<NT),(t+2<NT),(t+2<NT));     ENDW(t+1); RESC(); ROT();
  }
  STEP(pB0,pB1,pA0,pA1,NT-1,false,false,false); RESC();
  { float sacc=pB0[0]+pB0[1]; _Pragma("unroll") for(int r=2;r<16;++r)sacc+=pB0[r]; _Pragma("unroll") for(int r=0;r<16;++r)sacc+=pB1[r]; l_reg+=sacc;
    pw0=(u32x4){PKW(pB0,0),PKW(pB0,2),PKW(pB0,4),PKW(pB0,6)};pw1=(u32x4){PKW(pB0,8),PKW(pB0,10),PKW(pB0,12),PKW(pB0,14)};pw2=(u32x4){PKW(pB1,0),PKW(pB1,2),PKW(pB1,4),PKW(pB1,6)};pw3=(u32x4){PKW(pB1,8),PKW(pB1,10),PKW(pB1,12),PKW(pB1,14)};
    SBAR(); pv(o,vb0+sl_cur,PAF(0),PAF(1),PAF(2),PAF(3)); }
  #undef PKW
  #undef PAF
  #undef VFR
  #undef PIN
  #undef MX3
  #undef GAPA
  #undef GAPB
  #undef EX
  #undef VRD
  #undef KRD
  #undef STEP
  #undef ENDW
  {auto rr=__builtin_amdgcn_permlane32_swap(__float_as_uint(l_reg),__float_as_uint(l_reg),false,false);l_reg=__uint_as_float(rr[0])+__uint_as_float(rr[1]);}
  if(hi==0)wsf[32+r32]=l_reg;asm volatile("s_waitcnt lgkmcnt(0)":::"memory");
  float rli[16];
  #pragma unroll
  for(int r=0;r<16;++r)rli[r]=__builtin_amdgcn_rcpf(wsf[32+crow(r,hi)]);
  bf16*Ow=O+(rowbase+q0+wid*QBLK)*DM+h*D;
  { bf16*stg=(bf16*)(shm+LDS_OST)+wid*2048;
    #pragma unroll
    for(int r=0;r<16;++r){const int orow=crow(r,hi);
      #pragma unroll
      for(int d0=0;d0<2;++d0)stg[orow*64+d0*32+r32]=__float2bfloat16(o[d0][r]*rli[r]);}
    asm volatile("s_waitcnt lgkmcnt(0)":::"memory");
    #pragma unroll
    for(int i=0;i<4;++i){const int row=i*8+(lane>>3),ch=lane&7; const u32x4 v=*(const u32x4*)(stg+row*64+ch*8); ATTN_STORE16(Ow+(long)row*DM+ch*8,v);} }
  asm volatile("s_waitcnt lgkmcnt(0)\n\ts_barrier":::"memory");
  #undef DMA_K
  #undef DMA_V
  #undef CMASK
  #undef START
  #undef RESC
  #undef ROT
  #undef CKLD
  #undef CKSUB
}
constexpr int ATTN_LDS_BYTES=LDS_BYTES;
struct AttnTensors { const bf16* Q; const bf16* K; const bf16* V; bf16* O; const float* C2T; float M2; };
struct AttnUnit { int bh; int qb; };
struct StaticOrder {
  int vcu, G;
  __device__ __forceinline__ explicit StaticOrder(int grid,int v):vcu(v),G(grid){}
  __device__ __forceinline__ bool next(int i,AttnUnit&u)const{ const int L=i*G+vcu; if(L>=BATCH*NHEAD*NQB)return false; const int r=L>>8, idx=L&255, k=idx&7; u.bh=idx>>3; u.qb=(r==0)?(NQB-1-k):k; return true; }
  __device__ __forceinline__ void a_ready(const AttnUnit&)const{}
  __device__ __forceinline__ void done(const AttnUnit&)const{}
};
struct QueueOrder {
  unsigned* cnt; volatile __attribute__((address_space(3))) unsigned* slot;
  __device__ __forceinline__ bool next(int,AttnUnit&u)const{
    if(threadIdx.x==0){ *slot=__hip_atomic_fetch_add(cnt,1u,__ATOMIC_RELAXED,__HIP_MEMORY_SCOPE_AGENT); }
    __syncthreads(); const unsigned L=*slot; __syncthreads();
    if(L>=(unsigned)(BATCH*NHEAD*NQB))return false;
    u.qb=NQB-1-(int)(L>>5); u.bh=(int)(L&31); return true; }
  __device__ __forceinline__ void a_ready(const AttnUnit&)const{}
  __device__ __forceinline__ void done(const AttnUnit&)const{}
};
template<class Sched,int THRL=8> __device__ __forceinline__ void attn_phase(char*lds,const AttnTensors&T,const Sched&S){
  AttnUnit u;
  for(int i=0;S.next(i,u);++i){ S.a_ready(u); attn_unit<THRL>(u.bh/NHEAD,u.bh%NHEAD,u.qb,T.Q,T.K,T.V,T.O,T.C2T+(size_t)u.bh*SEQ,T.M2,lds); S.done(u); }
}
#undef SBAR
#undef WAIT_BAR
}

constexpr int NWAVES = 8, NTHR = 512;
constexpr int DM = 1024, NB = 4, SEQ = 4096, DB = 128, DSEQ = 8, PAST = 2048, PAGE = 128, NPAGES = 16;
constexpr int MP = NB * SEQ, MS = DB * DSEQ, M = MP + MS;
constexpr int DP = 512, DA = 512, NH = 8, HD = 64, DIN = 4104, NPROJ = 4096;
constexpr int NKEYS = 128, NEXP = 16384, PH = 8, TOPK = 16, DKH = 128, DQ = 2048;
constexpr float EPS = 1e-6f;
constexpr float LOG2E = 1.4426950408889634f;
constexpr float C2 = 0.125f * LOG2E;
constexpr size_t O_YP = 0, O_YS = O_YP + (size_t)MP * DM, O_KP = O_YS + (size_t)MS * DM, O_VP = O_KP + (size_t)MP * DA, O_LFP = O_VP + (size_t)MP * DA,
                 O_PP = O_LFP + (size_t)MP * NH, O_KS = O_PP + (size_t)NB * 15 * DP, O_VS = O_KS + (size_t)MS * DA, O_LFS = O_VS + (size_t)MS * DA,
                 O_PS = O_LFS + (size_t)MS * NH, O_END = O_PS + (size_t)DB * 15 * DP;
constexpr size_t MiB = 1u << 20;
constexpr size_t WS_CTL = 0, CTL_ZERO_BYTES = 64 * 1024;
constexpr size_t WS_WIN = 2 * MiB, WS_WBP = 10 * MiB, WS_WBA = 11 * MiB, WS_WOUT = 12 * MiB, WS_WQ = 14 * MiB, WS_SUBK = 18 * MiB, WS_CP2 = 19 * MiB, WS_RSS = 20 * MiB, WS_US = 22 * MiB, WS_VS = 23 * MiB;
constexpr size_t WS_PU = 32 * MiB, WS_PV = 64 * MiB, WS_XN = 96 * MiB  , WS_U = 132 * MiB, WS_Q = 150 * MiB, WS_K = 168 * MiB, WS_V = 186 * MiB,
                 WS_GA = 204 * MiB, WS_GB = 240 * MiB, WS_PO = 276 * MiB, WS_AO = 294 * MiB, WS_T = 312 * MiB, WS_MIX = 348 * MiB, WS_PQ = 384 * MiB,
                 WS_SI = 456 * MiB, WS_SG = 466 * MiB, WS_H = 476 * MiB, WS_END = 548 * MiB;
constexpr int CW_BAR = 4096;
constexpr int LDS_BYTES = 163840;
constexpr int SCR_BYTES = 159 * 1024;
constexpr int MISC_OFF = SCR_BYTES;

typedef unsigned short bf16;
typedef unsigned v4u __attribute__((ext_vector_type(4)));
typedef unsigned v2u __attribute__((ext_vector_type(2)));
typedef float f32x4 __attribute__((ext_vector_type(4)));
typedef float f32x2 __attribute__((ext_vector_type(2)));

__device__ __forceinline__ float bf2f(unsigned short b) { return __uint_as_float((unsigned)b << 16); }
__device__ __forceinline__ float bflo(unsigned w) { return __uint_as_float(w << 16); }
__device__ __forceinline__ float bfhi(unsigned w) { return __uint_as_float(w & 0xffff0000u); }
typedef __bf16 bf16x2_t __attribute__((ext_vector_type(2)));
__device__ __forceinline__ unsigned pkbf(float lo, float hi) { f32x2 v = {lo, hi}; bf16x2_t b = __builtin_convertvector(v, bf16x2_t); return __builtin_bit_cast(unsigned, b); }
__device__ __forceinline__ float wave_sum(float v) {
#pragma unroll
    for (int o = 1; o < 64; o <<= 1) v += __shfl_xor(v, o);
    return v;
}
__device__ __forceinline__ float wave_max(float v) {
#pragma unroll
    for (int o = 1; o < 64; o <<= 1) v = fmaxf(v, __shfl_xor(v, o));
    return v;
}

struct Args {
    const float* x_p; const float* x_s; const float* cache_k; const float* cache_v; const float* cache_lf; const float* state_pool; const int* page_table;
    const float* norm_mix_g; const float* w_in; const float* b_forget; const float* q_norm_g; const float* k_norm_g; const float* pool_mix_w; const float* pool_scale;
    const float* w_bp; const float* w_ba; const float* w_out; const float* norm_ffn_g; const float* w_query; const float* sub_keys; const float* peer_u; const float* peer_v;
    float* out; unsigned char* ws; int ph_lo, ph_hi, li, pad;
};

using pg8::Unit;
struct EpiInProj {
    static constexpr bool PERM = true, AFTER_DRAIN = false, CHAIN = false;
    bf16 *U, *Q, *K, *V, *GA, *GB; float* out; const float *gq, *gk; int pn_off;
    __device__ __forceinline__ void operator()(const f32x4 (&acc)[2][2][4][2], const Unit& u, int wr, int wc, int fr, int fq) const {
        const int pn = u.pn + pn_off; const int row0 = u.pm * 256 + wr * 64 + fr; const bool prompt = u.pm < (MP / 256);
        if (pn < 2) {
#pragma unroll
            for (int ai = 0; ai < 2; ++ai)
#pragma unroll
                for (int m = 0; m < 4; ++m) { const int row = row0 + ai * 128 + m * 16;
                    float* tail = nullptr;
                    if (prompt) { const int s = row & (SEQ - 1), b = row >> 12; if (s >= SEQ - 15) tail = out + O_PP + (size_t)(b * 15 + (s - (SEQ - 15))) * DP; }
                    else { const int rs = row - MP; tail = out + O_PS + (size_t)((rs >> 3) * 15 + 7 + (rs & 7)) * DP; }
#pragma unroll
                    for (int bj = 0; bj < 2; ++bj) { const int col = pn * 256 + bj * 128 + wc * 32 + 8 * fq; const f32x4 v0 = acc[ai][bj][m][0], v1 = acc[ai][bj][m][1];
                        v4u w; w.x = pkbf(v0[0], v0[1]); w.y = pkbf(v0[2], v0[3]); w.z = pkbf(v1[0], v1[1]); w.w = pkbf(v1[2], v1[3]);
                        *(v4u*)(U + (size_t)row * DP + col) = w;
                        if (tail) { *(f32x4*)(tail + col) = v0; *(f32x4*)(tail + col + 4) = v1; } } }
        } else if (pn < 6) {
            const bool isq = pn < 4; const int head = 4 * (pn & 1) + wc; const float* g = isq ? gq : gk;
            f32x4 gv[2][2];
#pragma unroll
            for (int bj = 0; bj < 2; ++bj)
#pragma unroll
                for (int n = 0; n < 2; ++n) gv[bj][n] = *(const f32x4*)(g + 32 * bj + 8 * fq + 4 * n);
            bf16* dst = isq ? Q : K;
#pragma unroll
            for (int ai = 0; ai < 2; ++ai)
#pragma unroll
                for (int m = 0; m < 4; ++m) { const int row = row0 + ai * 128 + m * 16; float ss = 0.f;
#pragma unroll
                    for (int bj = 0; bj < 2; ++bj)
#pragma unroll
                        for (int n = 0; n < 2; ++n) { const f32x4 x = acc[ai][bj][m][n]; ss += (x[0] * x[0] + x[1] * x[1]) + (x[2] * x[2] + x[3] * x[3]); }
                    ss += __shfl_xor(ss, 16); ss += __shfl_xor(ss, 32);
                    float r = 1.0f / sqrtf(ss * (1.0f / 64.0f) + EPS);
                    float* kout = isq ? nullptr : (prompt ? out + O_KP + (size_t)row * DA : out + O_KS + (size_t)(row - MP) * DA);
                    const float rq = isq ? r * C2 : r;
#pragma unroll
                    for (int bj = 0; bj < 2; ++bj) { const int col = head * 64 + 32 * bj + 8 * fq; const f32x4 v0 = acc[ai][bj][m][0] * gv[bj][0] * rq, v1 = acc[ai][bj][m][1] * gv[bj][1] * rq;
                        v4u w; w.x = pkbf(v0[0], v0[1]); w.y = pkbf(v0[2], v0[3]); w.z = pkbf(v1[0], v1[1]); w.w = pkbf(v1[2], v1[3]);
                        *(v4u*)(dst + (size_t)row * DA + col) = w;
                        if (!isq) { __builtin_nontemporal_store(v0, (f32x4*)(kout + col)); __builtin_nontemporal_store(v1, (f32x4*)(kout + col + 4)); } } }
        } else if (pn < 8) {
#pragma unroll
            for (int ai = 0; ai < 2; ++ai)
#pragma unroll
                for (int m = 0; m < 4; ++m) { const int row = row0 + ai * 128 + m * 16;
                    float* vout = prompt ? out + O_VP + (size_t)row * DA : out + O_VS + (size_t)(row - MP) * DA;
#pragma unroll
                    for (int bj = 0; bj < 2; ++bj) { const int col = (pn - 6) * 256 + bj * 128 + wc * 32 + 8 * fq; const f32x4 v0 = acc[ai][bj][m][0], v1 = acc[ai][bj][m][1];
                        v4u w; w.x = pkbf(v0[0], v0[1]); w.y = pkbf(v0[2], v0[3]); w.z = pkbf(v1[0], v1[1]); w.w = pkbf(v1[2], v1[3]);
                        *(v4u*)(V + (size_t)row * DA + col) = w; __builtin_nontemporal_store(v0, (f32x4*)(vout + col)); __builtin_nontemporal_store(v1, (f32x4*)(vout + col + 4)); } }
        } else {
            bf16* dst = pn < 12 ? GA : GB; const int ct = (pn < 12 ? pn - 8 : pn - 12) * 256;
#pragma unroll
            for (int ai = 0; ai < 2; ++ai)
#pragma unroll
                for (int m = 0; m < 4; ++m) { const int row = row0 + ai * 128 + m * 16;
#pragma unroll
                    for (int bj = 0; bj < 2; ++bj) { const int col = ct + bj * 128 + wc * 32 + 8 * fq; float s[8];
#pragma unroll
                        for (int n = 0; n < 2; ++n)
#pragma unroll
                            for (int i = 0; i < 4; ++i) s[4 * n + i] = __builtin_amdgcn_rcpf(1.0f + __builtin_amdgcn_exp2f(-LOG2E * acc[ai][bj][m][n][i]));
                        v4u w; w.x = pkbf(s[0], s[1]); w.y = pkbf(s[2], s[3]); w.z = pkbf(s[4], s[5]); w.w = pkbf(s[6], s[7]);
                        *(v4u*)(dst + (size_t)row * DM + col) = w; } }
        }
    }
};
template <int MODE> struct EpiGate {
    static constexpr bool PERM = true, AFTER_DRAIN = false, CHAIN = false;
    const bf16* G; const bf16* Tin; bf16* O;
    __device__ __forceinline__ void operator()(const f32x4 (&acc)[2][2][4][2], const Unit& u, int wr, int wc, int fr, int fq) const {
        const int row0 = u.pm * 256 + wr * 64 + fr;
#pragma unroll
        for (int ai = 0; ai < 2; ++ai)
#pragma unroll
            for (int m = 0; m < 4; ++m) { const int row = row0 + ai * 128 + m * 16;
#pragma unroll
                for (int bj = 0; bj < 2; ++bj) { const size_t off = (size_t)row * DM + u.pn * 256 + bj * 128 + wc * 32 + 8 * fq;
                    const v4u g = *(const v4u*)(G + off); const f32x4 v0 = acc[ai][bj][m][0], v1 = acc[ai][bj][m][1];
                    float r[8] = {v0[0] * bflo(g.x), v0[1] * bfhi(g.x), v0[2] * bflo(g.y), v0[3] * bfhi(g.y), v1[0] * bflo(g.z), v1[1] * bfhi(g.z), v1[2] * bflo(g.w), v1[3] * bfhi(g.w)};
                    if (MODE == 1) { const v4u t = *(const v4u*)(Tin + off);
                        r[0] += bflo(t.x); r[1] += bfhi(t.x); r[2] += bflo(t.y); r[3] += bfhi(t.y); r[4] += bflo(t.z); r[5] += bfhi(t.z); r[6] += bflo(t.w); r[7] += bfhi(t.w); }
                    v4u w; w.x = pkbf(r[0], r[1]); w.y = pkbf(r[2], r[3]); w.z = pkbf(r[4], r[5]); w.w = pkbf(r[6], r[7]);
                    *(v4u*)(O + off) = w; } }
    }
};
struct EpiMerge {
    static constexpr bool PERM = true, AFTER_DRAIN = false, CHAIN = true;
    const bf16* GA; const bf16* GB; bf16* O;
    __device__ __forceinline__ void mid(f32x4 (&acc)[2][2][4][2], const Unit& u, int wr, int wc, int fr, int fq) const {
        const int row0 = u.pm * 256 + wr * 64 + fr;
#pragma unroll
        for (int ai = 0; ai < 2; ++ai)
#pragma unroll
            for (int m = 0; m < 4; ++m) { const int row = row0 + ai * 128 + m * 16;
#pragma unroll
                for (int bj = 0; bj < 2; ++bj) { const size_t off = (size_t)row * DM + u.pn * 256 + bj * 128 + wc * 32 + 8 * fq;
                    const v4u ga = *(const v4u*)(GA + off), gb = *(const v4u*)(GB + off);
                    const unsigned gaw[4] = {ga.x, ga.y, ga.z, ga.w}, gbw[4] = {gb.x, gb.y, gb.z, gb.w};
#pragma unroll
                    for (int k = 0; k < 4; ++k) { const float r0 = bflo(gaw[k]) * __builtin_amdgcn_rcpf(fmaxf(bflo(gbw[k]), 0x1p-60f)), r1 = bfhi(gaw[k]) * __builtin_amdgcn_rcpf(fmaxf(bfhi(gbw[k]), 0x1p-60f));
                        acc[ai][bj][m][k >> 1][2 * (k & 1)] *= r0; acc[ai][bj][m][k >> 1][2 * (k & 1) + 1] *= r1; } } }
    }
    __device__ __forceinline__ void operator()(const f32x4 (&acc)[2][2][4][2], const Unit& u, int wr, int wc, int fr, int fq) const {
        const int row0 = u.pm * 256 + wr * 64 + fr;
#pragma unroll
        for (int ai = 0; ai < 2; ++ai)
#pragma unroll
            for (int m = 0; m < 4; ++m) { const int row = row0 + ai * 128 + m * 16;
#pragma unroll
                for (int bj = 0; bj < 2; ++bj) { const size_t off = (size_t)row * DM + u.pn * 256 + bj * 128 + wc * 32 + 8 * fq;
                    const v4u gb = *(const v4u*)(GB + off); const unsigned gbw[4] = {gb.x, gb.y, gb.z, gb.w}; unsigned ow[4];
#pragma unroll
                    for (int k = 0; k < 4; ++k) ow[k] = pkbf(acc[ai][bj][m][k >> 1][2 * (k & 1)] * fmaxf(bflo(gbw[k]), 0x1p-60f), acc[ai][bj][m][k >> 1][2 * (k & 1) + 1] * fmaxf(bfhi(gbw[k]), 0x1p-60f));
                    *(v4u*)(O + off) = (v4u){ow[0], ow[1], ow[2], ow[3]}; } }
    }
};
struct EpiOut {
    static constexpr bool PERM = true, AFTER_DRAIN = false, CHAIN = false;
    const float* xp; const float* xs; float* H; bf16* HG; const float* gf; float* RSS;
    __device__ __forceinline__ void operator()(const f32x4 (&acc)[2][2][4][2], const Unit& u, int wr, int wc, int fr, int fq) const {
        const int row0 = u.pm * 256 + wr * 64 + fr; const bool prompt = u.pm < (MP / 256);
#pragma unroll
        for (int ai = 0; ai < 2; ++ai)
#pragma unroll
            for (int m = 0; m < 4; ++m) { const int row = row0 + ai * 128 + m * 16; float ss = 0.f;
                const float* xr = prompt ? xp + (size_t)row * DM : xs + (size_t)(row - MP) * DM;
#pragma unroll
                for (int bj = 0; bj < 2; ++bj) { const int col = u.pn * 256 + bj * 128 + wc * 32 + 8 * fq;
                    const f32x4 h0 = acc[ai][bj][m][0] + *(const f32x4*)(xr + col), h1 = acc[ai][bj][m][1] + *(const f32x4*)(xr + col + 4);
                    ss += (h0[0] * h0[0] + h0[1] * h0[1]) + (h0[2] * h0[2] + h0[3] * h0[3]) + (h1[0] * h1[0] + h1[1] * h1[1]) + (h1[2] * h1[2] + h1[3] * h1[3]);
                    v4u w; w.x = pkbf(h0[0], h0[1]); w.y = pkbf(h0[2], h0[3]); w.z = pkbf(h1[0], h1[1]); w.w = pkbf(h1[2], h1[3]);
                    *(v4u*)(HG + (size_t)row * DM + col) = w; }
                ss += __shfl_xor(ss, 16); ss += __shfl_xor(ss, 32);
                if (fq == 0) RSS[(size_t)row * 16 + u.pn * 4 + wc] = ss; }
    }
};

struct Frame {
    LAS unsigned char* lds; volatile LAS unsigned* MISC; gu32* ctl;
    int tid, lane, wave, vcu, G;
};

__device__ __forceinline__ void transpose_item(const float* W, int ldw, int K, bf16* WT, int src_col0, int dst_row0, int k0, LAS float* scr, int lane, const float* kscale = nullptr) {
#pragma unroll 8
    for (int i = 0; i < 32; ++i) { const int kk = 2 * i + (lane >> 5); const float wv = W[(size_t)(k0 + kk) * ldw + src_col0 + (lane & 31)]; scr[kk * 33 + (lane & 31)] = kscale ? wv * kscale[k0 + kk] : wv; }
    LDS_WAIT(); asm volatile("" ::: "memory");
    const int c = lane & 7;
#pragma unroll
    for (int j = 0; j < 4; ++j) { const int n = (lane >> 3) + 8 * j; const LAS float* s = scr + (8 * c) * 33 + n;
        v4u o; o.x = pkbf(s[0 * 33], s[1 * 33]); o.y = pkbf(s[2 * 33], s[3 * 33]); o.z = pkbf(s[4 * 33], s[5 * 33]); o.w = pkbf(s[6 * 33], s[7 * 33]);
        *(v4u*)(WT + (size_t)(dst_row0 + n) * K + k0 + 8 * c) = o; }
    LDS_WAIT(); asm volatile("" ::: "memory");
}
__device__ __forceinline__ int win_src_col(int db) {
    if (db < 16) return 32 * db;
    if (db < 48) { const int base = db < 32 ? 512 : 1024; const int local = (db - 16) & 15, tile = local >> 3, blk = local & 7, bj = blk >> 2, w = blk & 3; return base + tile * 256 + 64 * w + 32 * bj; }
    if (db < 64) return 1536 + 32 * (db - 48);
    if (db < 96) return 2056 + 32 * (db - 64);
    return 3080 + 32 * (db - 96);
}
__device__ __forceinline__ void cvt_rows_bf16(const float* src, bf16* dst, size_t n8, size_t gtid, size_t gn) {
    for (size_t i = gtid; i < n8; i += gn) { const f32x4 a = *(const f32x4*)(src + 8 * i), b = *(const f32x4*)(src + 8 * i + 4);
        v4u w; w.x = pkbf(a[0], a[1]); w.y = pkbf(a[2], a[3]); w.z = pkbf(b[0], b[1]); w.w = pkbf(b[2], b[3]); *(v4u*)(dst + 8 * i) = w; }
}
template <bool I8> __device__ __forceinline__ void cvt_rows_fp8(const float* src, unsigned char* dst, float* scl, int gw, int NGW, int lane, const float* colscale = nullptr) {
    for (int e0 = gw; e0 < NEXP; e0 += 2 * NGW) {
        f32x4 q[2][4]; float mx[2];
#pragma unroll
        for (int u = 0; u < 2; ++u) { const int e = (e0 + u * NGW < NEXP) ? e0 + u * NGW : e0; const float* r = src + (size_t)e * DM + 16 * lane;
            q[u][0] = *(const f32x4*)r; q[u][1] = *(const f32x4*)(r + 4); q[u][2] = *(const f32x4*)(r + 8); q[u][3] = *(const f32x4*)(r + 12);
            if (colscale) {
#pragma unroll
                for (int j = 0; j < 4; ++j) q[u][j] = q[u][j] * *(const f32x4*)(colscale + 16 * lane + 4 * j); } }
#pragma unroll
        for (int u = 0; u < 2; ++u) { float m = 0.f;
#pragma unroll
            for (int j = 0; j < 4; ++j) m = fmaxf(m, fmaxf(fmaxf(fabsf(q[u][j][0]), fabsf(q[u][j][1])), fmaxf(fabsf(q[u][j][2]), fabsf(q[u][j][3]))));
            mx[u] = m; }
#pragma unroll
        for (int o = 1; o < 64; o <<= 1) { mx[0] = fmaxf(mx[0], __shfl_xor(mx[0], o)); mx[1] = fmaxf(mx[1], __shfl_xor(mx[1], o)); }
#pragma unroll
        for (int u = 0; u < 2; ++u) { const int e = e0 + u * NGW; if (e < NEXP) {
            if constexpr (I8) {
                float best = 1.0f, berr = 3.0e38f;
#pragma unroll
                for (int ci = 0; ci < 5; ++ci) { const float rho = 1.0f - 0.1f * ci, cs = mx[u] > 1e-30f ? 7.0f / (rho * mx[u]) : 0.f, ics = rho * mx[u] * (1.0f / 7.0f); float er = 0.f;
#pragma unroll
                    for (int j = 0; j < 4; ++j)
#pragma unroll
                        for (int i = 0; i < 4; ++i) { const float x = q[u][j][i], d = x - ics * __builtin_amdgcn_fmed3f(rintf(x * cs), -7.0f, 7.0f); er += d * d; }
#pragma unroll
                    for (int o = 1; o < 64; o <<= 1) er += __shfl_xor(er, o);
                    if (er < berr) { berr = er; best = rho; } }
                const float cm = best * mx[u], sc = cm > 1e-30f ? 7.0f / cm : 0.f, isc = cm * (1.0f / 112.0f);
                unsigned w[2] = {0u, 0u};
#pragma unroll
                for (int j = 0; j < 4; ++j)
#pragma unroll
                    for (int i = 0; i < 4; i += 2) { const int qe = (int)__builtin_amdgcn_fmed3f(rintf(q[u][j][i] * sc), -7.0f, 7.0f), qo = (int)__builtin_amdgcn_fmed3f(rintf(q[u][j][i + 1] * sc), -7.0f, 7.0f);
                        const unsigned byte = (((unsigned)qo & 15u) << 4) | ((unsigned)(qe + 8) & 15u); const int t = 2 * j + (i >> 1); w[t >> 2] |= byte << (8 * (t & 3)); }
                *(v2u*)(dst + (size_t)(lane >> 4) * ((size_t)NEXP * 128) + (size_t)e * 128 + 8 * (lane & 15)) = (v2u){w[0], w[1]};
                if (lane == 0) scl[e] = isc;
                continue; }
            } }
    }
}
__device__ __forceinline__ void p0_prologue(Frame& F, const Args& a) {
    unsigned char* ws = a.ws;
    LAS float* scr = (LAS float*)(F.lds + F.wave * 16384);
    const int gw = F.vcu * NWAVES + F.wave, NGW = F.G * NWAVES;
    for (int it = gw; it < 4096; it += NGW) {
        int r = it;
        if (r < 2048) { const int kb = r >> 7, db = r & 127; transpose_item(a.w_in, DIN, DM, (bf16*)(ws + WS_WIN), win_src_col(db), 32 * db, 64 * kb, scr, F.lane); continue; } r -= 2048;
        if (r < 256) { continue; } r -= 256;
        if (r < 256) { const int kb = r >> 5, nb = r & 31; transpose_item(a.w_ba, DM, DA, (bf16*)(ws + WS_WBA), 32 * nb, 32 * nb, 64 * kb, scr, F.lane); continue; } r -= 256;
        if (r < 512) { const int kb = r >> 5, nb = r & 31; transpose_item(a.w_out, DM, DM, (bf16*)(ws + WS_WOUT), 32 * nb, 32 * nb, 64 * kb, scr, F.lane); continue; } r -= 512;
        { const int kb = r >> 6, nb = r & 63; transpose_item(a.w_query, DQ, DM, (bf16*)(ws + WS_WQ), 32 * nb, 32 * nb, 64 * kb, scr, F.lane, a.norm_ffn_g); }
    }
    for (int it = gw; it < 16 * 4 * 16; it += NGW) { const int nb = it & 15, g = (it >> 4) & 3, cb = it >> 6; const int nn = 64 * nb + F.lane; float acc8[8];
#pragma unroll
        for (int i = 0; i < 8; ++i) acc8[i] = 0.f;
        const float* pm = a.pool_mix_w + (size_t)g * 16384 + (size_t)(8 * cb) * 128;
#pragma unroll 16
        for (int d = 0; d < 128; ++d) { const float wv = a.w_bp[(size_t)(g * 128 + d) * DM + nn] * a.pool_scale[g * 128 + d];
#pragma unroll
            for (int i = 0; i < 8; ++i) acc8[i] += pm[i * 128 + d] * wv; }
        v4u o; o.x = pkbf(acc8[0], acc8[1]); o.y = pkbf(acc8[2], acc8[3]); o.z = pkbf(acc8[4], acc8[5]); o.w = pkbf(acc8[6], acc8[7]);
        *(v4u*)((bf16*)(ws + WS_WBP) + (size_t)nn * DP + g * 128 + 8 * cb) = o; }
    { const size_t gtid = (size_t)F.vcu * NTHR + F.tid, gn = (size_t)F.G * NTHR;
      cvt_rows_fp8<true>(a.peer_u, ws + WS_PU, (float*)(ws + WS_US), gw, NGW, F.lane, a.norm_ffn_g);
      cvt_rows_fp8<true>(a.peer_v, ws + WS_PV, (float*)(ws + WS_VS), gw, NGW, F.lane);
      cvt_rows_bf16(a.sub_keys, (bf16*)(ws + WS_SUBK), (size_t)PH * 2 * NKEYS * DKH / 8, gtid, gn);
      for (size_t i = gtid; i < (size_t)DB * 7 * DP; i += gn) { const int b = (int)(i / (7 * DP)), j = (int)((i / DP) % 7), c = (int)(i % DP);
          a.out[O_PS + (size_t)(b * 15 + j) * DP + c] = a.state_pool[(size_t)(b * 15 + 8 + j) * DP + c]; } }
    __syncthreads();
    LAS float* wfT = (LAS float*)F.lds;
    for (int i = F.tid; i < 8 * DM; i += NTHR) { const int col = i >> 3, h = i & 7; wfT[h * DM + col] = a.w_in[(size_t)col * DIN + 2048 + h]; }
    __syncthreads();
    bf16* XN = (bf16*)(ws + WS_XN);
    for (int row0 = gw; row0 < M; row0 += 2 * NGW) {
        f32x4 v[2][4]; float rr[2], f[2][8]; bool ok[2];
#pragma unroll
        for (int u = 0; u < 2; ++u) { const int row = row0 + u * NGW; ok[u] = row < M; const int rc = ok[u] ? row : row0;
            const float* xr = rc < MP ? a.x_p + (size_t)rc * DM : a.x_s + (size_t)(rc - MP) * DM;
#pragma unroll
            for (int j = 0; j < 4; ++j) v[u][j] = *(const f32x4*)(xr + 256 * j + 4 * F.lane); }
#pragma unroll
        for (int u = 0; u < 2; ++u) { float ss = 0.f;
#pragma unroll
            for (int j = 0; j < 4; ++j) ss += (v[u][j][0] * v[u][j][0] + v[u][j][1] * v[u][j][1]) + (v[u][j][2] * v[u][j][2] + v[u][j][3] * v[u][j][3]);
            rr[u] = ss; }
#pragma unroll
        for (int o = 1; o < 64; o <<= 1) { rr[0] += __shfl_xor(rr[0], o); rr[1] += __shfl_xor(rr[1], o); }
#pragma unroll
        for (int u = 0; u < 2; ++u) { const int row = ok[u] ? row0 + u * NGW : row0; const float r = 1.0f / sqrtf(rr[u] * (1.0f / DM) + EPS);
#pragma unroll
            for (int h = 0; h < 8; ++h) f[u][h] = 0.f;
#pragma unroll
            for (int j = 0; j < 4; ++j) { const f32x4 g = *(const f32x4*)(a.norm_mix_g + 256 * j + 4 * F.lane); v[u][j] = v[u][j] * r * g;
                v2u w; w.x = pkbf(v[u][j][0], v[u][j][1]); w.y = pkbf(v[u][j][2], v[u][j][3]); if (ok[u]) *(v2u*)(XN + (size_t)row * DM + 256 * j + 4 * F.lane) = w;
#pragma unroll
                for (int h = 0; h < 8; ++h) { const f32x4 wv = *(const LAS f32x4*)(wfT + h * DM + 256 * j + 4 * F.lane); f[u][h] += (v[u][j][0] * wv[0] + v[u][j][1] * wv[1]) + (v[u][j][2] * wv[2] + v[u][j][3] * wv[3]); } } }
#pragma unroll
        for (int u = 0; u < 2; ++u) { const int row = row0 + u * NGW;
            const bool b4 = (F.lane & 4) != 0, b2 = (F.lane & 2) != 0, b1 = (F.lane & 1) != 0; float t4[4], t2[2];
#pragma unroll
            for (int k = 0; k < 4; ++k) { const float keep = b4 ? f[u][4 + k] : f[u][k], send = b4 ? f[u][k] : f[u][4 + k]; t4[k] = keep + __shfl_xor(send, 4); }
#pragma unroll
            for (int k = 0; k < 2; ++k) { const float keep = b2 ? t4[2 + k] : t4[k], send = b2 ? t4[k] : t4[2 + k]; t2[k] = keep + __shfl_xor(send, 2); }
            float t1 = (b1 ? t2[1] : t2[0]) + __shfl_xor(b1 ? t2[0] : t2[1], 1);
            t1 += __shfl_xor(t1, 8); t1 += __shfl_xor(t1, 16); t1 += __shfl_xor(t1, 32);
            if (F.lane < 8 && ok[u]) { const float z = t1 + a.b_forget[F.lane]; const float lf = fminf(z, 0.f) - log1pf(expf(-fabsf(z)));
                if (row < MP) a.out[O_LFP + (size_t)row * NH + F.lane] = lf; else a.out[O_LFS + (size_t)(row - MP) * NH + F.lane] = lf; } }
    }
}

template <int W> __device__ __forceinline__ void p2_item(const Args& a, unsigned char* ws, int row, int ch) {
    const bf16* U = (const bf16*)(ws + WS_U); bf16* PO = (bf16*)(ws + WS_PO);
    float e[W][8]; float cnt;
    if (row < MP) { const int s = row & (SEQ - 1); cnt = (float)(s + 1 < W ? s + 1 : W);
#pragma unroll
        for (int i = 0; i < W; ++i) { v4u q = (v4u){0u, 0u, 0u, 0u}; if (s - i >= 0) q = *(const v4u*)(U + (size_t)(row - i) * DP + ch);
            e[i][0] = bflo(q.x); e[i][1] = bfhi(q.x); e[i][2] = bflo(q.y); e[i][3] = bfhi(q.y); e[i][4] = bflo(q.z); e[i][5] = bfhi(q.z); e[i][6] = bflo(q.w); e[i][7] = bfhi(q.w); }
    } else { const int rs = row - MP, b = rs >> 3, t = rs & 7; cnt = (float)W;
#pragma unroll
        for (int i = 0; i < W; ++i) { const int tt = t - i;
            if (tt >= 0) { const v4u q = *(const v4u*)(U + (size_t)(MP + b * 8 + tt) * DP + ch);
                e[i][0] = bflo(q.x); e[i][1] = bfhi(q.x); e[i][2] = bflo(q.y); e[i][3] = bfhi(q.y); e[i][4] = bflo(q.z); e[i][5] = bfhi(q.z); e[i][6] = bflo(q.w); e[i][7] = bfhi(q.w); }
            else { const f32x4 p0 = *(const f32x4*)(a.state_pool + (size_t)(b * 15 + 15 + tt) * DP + ch), p1 = *(const f32x4*)(a.state_pool + (size_t)(b * 15 + 15 + tt) * DP + ch + 4);
                e[i][0] = p0[0]; e[i][1] = p0[1]; e[i][2] = p0[2]; e[i][3] = p0[3]; e[i][4] = p1[0]; e[i][5] = p1[1]; e[i][6] = p1[2]; e[i][7] = p1[3]; } } }
    const float inv = 1.0f / cnt; float mm[8];
#pragma unroll
    for (int k = 0; k < 8; ++k) { float sum = 0.f;
#pragma unroll
        for (int i = 0; i < W; ++i) sum += e[i][k];
        mm[k] = sum * inv - e[0][k]; }
    v4u o; o.x = pkbf(mm[0], mm[1]); o.y = pkbf(mm[2], mm[3]); o.z = pkbf(mm[4], mm[5]); o.w = pkbf(mm[6], mm[7]);
    *(v4u*)(PO + (size_t)row * DP + ch) = o;
}
template <int W> __device__ __forceinline__ void p2_slide(unsigned char* ws, int row0, int ch) {
    const bf16* U = (const bf16*)(ws + WS_U); bf16* PO = (bf16*)(ws + WS_PO);
    const int s0 = row0 & (SEQ - 1);
    v4u x[W + 3];
#pragma unroll
    for (int k = 0; k < W + 3; ++k) { x[k] = (v4u){0u, 0u, 0u, 0u}; if (s0 + k - (W - 1) >= 0) x[k] = *(const v4u*)(U + (size_t)(row0 + k - (W - 1)) * DP + ch); }
    float S[8];
#pragma unroll
    for (int c = 0; c < 8; ++c) S[c] = 0.f;
#pragma unroll
    for (int k = 0; k < W; ++k) { const unsigned w4[4] = {x[k].x, x[k].y, x[k].z, x[k].w};
#pragma unroll
        for (int c = 0; c < 4; ++c) { S[2 * c] += bflo(w4[c]); S[2 * c + 1] += bfhi(w4[c]); } }
#pragma unroll
    for (int j = 0; j < 4; ++j) {
        const unsigned cur[4] = {x[W - 1 + j].x, x[W - 1 + j].y, x[W - 1 + j].z, x[W - 1 + j].w};
        if (j > 0) { const unsigned old4[4] = {x[j - 1].x, x[j - 1].y, x[j - 1].z, x[j - 1].w};
#pragma unroll
            for (int c = 0; c < 4; ++c) { S[2 * c] += bflo(cur[c]) - bflo(old4[c]); S[2 * c + 1] += bfhi(cur[c]) - bfhi(old4[c]); } }
        const int sj = s0 + j; const float inv = 1.0f / (float)(sj + 1 < W ? sj + 1 : W);
        v4u o; o.x = pkbf(S[0] * inv - bflo(cur[0]), S[1] * inv - bfhi(cur[0])); o.y = pkbf(S[2] * inv - bflo(cur[1]), S[3] * inv - bfhi(cur[1]));
        o.z = pkbf(S[4] * inv - bflo(cur[2]), S[5] * inv - bfhi(cur[2])); o.w = pkbf(S[6] * inv - bflo(cur[3]), S[7] * inv - bfhi(cur[3]));
        *(v4u*)(PO + (size_t)(row0 + j) * DP + ch) = o; }
}
__device__ __forceinline__ void p1_cumsum(Frame& F, const Args& a) {
    unsigned char* ws = a.ws;
    { const int gw = ((int)blockIdx.x - ((int)F.G - (NB * NH) / NWAVES)) * NWAVES + F.wave; float* CP2 = (float*)(ws + WS_CP2);
      if (gw >= 0 && gw < NB * NH) { const int b = gw >> 3, h = gw & 7; float carry = 0.f;
          for (int c = 0; c < SEQ / 64; ++c) { float v = a.out[O_LFP + (size_t)(b * SEQ + c * 64 + F.lane) * NH + h];
#pragma unroll
              for (int o = 1; o < 64; o <<= 1) { const float t = __shfl_up(v, o); if (F.lane >= o) v += t; }
              v += carry; CP2[(size_t)gw * SEQ + c * 64 + F.lane] = v * LOG2E; carry = __shfl(v, 63); } } }
}
__device__ __forceinline__ void p2_cumsum_pool(Frame& F, const Args& a) {
    unsigned char* ws = a.ws;
    const int nfree = F.G > 2 * (M / 256) ? F.G - M / 256 : F.G, myslot = F.G > 2 * (M / 256) ? (int)blockIdx.x - M / 256 : (int)blockIdx.x;
    if (myslot >= 0)
    for (int task = myslot * NWAVES + F.wave; task < (MP / 16) * 4; task += nfree * NWAVES) {
        const int g = task & 3, row0 = 16 * (task >> 2) + 4 * (F.lane >> 4), ch = g * 128 + (F.lane & 15) * 8;
        if (g == 0) p2_slide<2>(ws, row0, ch); else if (g == 1) p2_slide<4>(ws, row0, ch); else if (g == 2) p2_slide<8>(ws, row0, ch); else p2_slide<16>(ws, row0, ch);
    }
    if (myslot >= 0)
    for (int item = MP * 64 + myslot * NTHR + F.tid; item < M * 64; item += nfree * NTHR) {
        const int wv = item >> 6, g = wv & 3, row = 4 * (wv >> 2) + ((item >> 4) & 3), ch = g * 128 + (item & 15) * 8;
        if (g == 0) p2_item<2>(a, ws, row, ch); else if (g == 1) p2_item<4>(a, ws, row, ch); else if (g == 2) p2_item<8>(a, ws, row, ch); else p2_item<16>(a, ws, row, ch);
    }
}

__device__ __forceinline__ float attn_bound2(const Args& a, int lane) {
    asm volatile("" : "+v"(lane));
    const float gq = wave_max(fabsf(a.q_norm_g[lane])), gk = wave_max(fabsf(a.k_norm_g[lane]));
    return 64.0f * C2 * gq * gk * 1.03f;
}

typedef float f32x16 __attribute__((ext_vector_type(16)));
typedef short bf16x8v __attribute__((ext_vector_type(8)));
__device__ __forceinline__ int f2key(float s) { int b = __builtin_bit_cast(int, s); return b ^ ((b >> 31) & 0x7fffffff); }
__device__ __forceinline__ float key2f(int k) { return __builtin_bit_cast(float, k ^ ((k >> 31) & 0x7fffffff)); }
#define CE_DESC(x, y) do { const int mx_ = (x) > (y) ? (x) : (y), mn_ = (x) > (y) ? (y) : (x); (x) = mx_; (y) = mn_; } while (0)
template <int OFF, int N, typename T> __device__ __forceinline__ void bsort_desc(T& v) {
#pragma unroll
    for (int k = 2; k <= N; k <<= 1)
#pragma unroll
        for (int j = k >> 1; j > 0; j >>= 1)
#pragma unroll
            for (int i = 0; i < N; ++i) { const int l = i ^ j; if (l > i) { if ((i & k) == 0) CE_DESC(v[OFF + i], v[OFF + l]); else CE_DESC(v[OFF + l], v[OFF + i]); } }
}
template <int OFF, typename T> __device__ __forceinline__ void bmerge16_desc(T& v) {
#pragma unroll
    for (int j = 8; j > 0; j >>= 1)
#pragma unroll
        for (int i = 0; i < 16; ++i) { const int l = i ^ j; if (l > i) CE_DESC(v[OFF + i], v[OFF + l]); }
}
template <int OA, int OB, typename T> __device__ __forceinline__ void top16_merge(T& v) {
#pragma unroll
    for (int i = 0; i < 16; ++i) v[OA + i] = v[OA + i] > v[OB + 15 - i] ? v[OA + i] : v[OB + 15 - i];
    bmerge16_desc<OA>(v);
}
template <typename T> __device__ __forceinline__ void top16_of_64(T& v) {
    bsort_desc<0, 16>(v); bsort_desc<16, 16>(v); bsort_desc<32, 16>(v); bsort_desc<48, 16>(v);
    top16_merge<0, 16>(v); top16_merge<32, 48>(v); top16_merge<0, 32>(v);
}
__device__ __forceinline__ void p7_topk(Frame& F, const Args& a) {
    unsigned char* ws = a.ws;
    const bf16* PQ = (const bf16*)(ws + WS_PQ); const bf16* SK = (const bf16*)(ws + WS_SUBK); const float* RSS = (const float*)(ws + WS_RSS);
    int* SI = (int*)(ws + WS_SI); float* SG = (float*)(ws + WS_SG);
    const int lane = F.lane, j = lane & 31, hi = lane >> 5;
    constexpr int KROW = 272, KMAT = 128 * KROW;
    LAS unsigned char* kl = F.lds; LAS unsigned* ib = (LAS unsigned*)(F.lds + 2 * KMAT + F.wave * 1024);
    const int h = F.vcu & 7, wi = F.vcu >> 3, nwh = (F.G - h + 7) >> 3;
    __syncthreads();
    for (int i = F.tid; i < 2 * 128 * 16; i += NTHR) { const int p = i >> 11, n = (i >> 4) & 127, c = i & 15; *(LAS v4u*)(kl + p * KMAT + n * KROW + 16 * c) = *(const v4u*)(SK + ((size_t)(h * 2 + p) * NKEYS + n) * DKH + 8 * c); }
    __syncthreads();
    const bool grp = (F.G == 256);
    const int gx = F.vcu >> 5, wl = (F.vcu >> 3) & 3;
    for (int lt = (grp ? wl : wi) * NWAVES + F.wave; lt < (grp ? 68 : M / 32); lt += (grp ? 4 : nwh) * NWAVES) {
        const int tile = grp ? (lt < 64 ? 64 * gx + lt : 512 + 4 * gx + (lt - 64)) : lt;
        const int row0 = tile * 32;
        int jl = j, hl = hi; asm volatile("" : "+v"(jl), "+v"(hl));
        int top[2][16];
#pragma unroll
        for (int p = 0; p < 2; ++p) {
            bf16x8v qf[8];
#pragma unroll
            for (int ks = 0; ks < 8; ++ks) qf[ks] = *(const bf16x8v*)(PQ + (size_t)(row0 + jl) * DQ + h * 256 + p * 128 + 16 * ks + 8 * hl);
            f32x16 acc[4];
#pragma unroll
            for (int mt = 0; mt < 4; ++mt) acc[mt] = f32x16{};
            const LAS unsigned char* kb = kl + p * KMAT + jl * KROW + 16 * hl;
#pragma unroll
            for (int ks = 0; ks < 8; ++ks)
#pragma unroll
                for (int mt = 0; mt < 4; ++mt) { const bf16x8v af = *(const LAS bf16x8v*)(kb + mt * 32 * KROW + ks * 32); acc[mt] = __builtin_amdgcn_mfma_f32_32x32x16_bf16(af, qf[ks], acc[mt], 0, 0, 0); }
            int v[64];
#pragma unroll
            for (int mt = 0; mt < 4; ++mt)
#pragma unroll
                for (int r = 0; r < 16; ++r) { const int n = 32 * mt + (r & 3) + 8 * (r >> 2) + 4 * hi; v[16 * mt + r] = (f2key(acc[mt][r]) & ~127) | (127 - n); }
            top16_of_64(v);
#pragma unroll
            for (int i = 0; i < 16; ++i) top[p][i] = v[i];
        }
        int S[32];
#pragma unroll
        for (int i = 0; i < 16; ++i) { auto rr = __builtin_amdgcn_permlane32_swap((unsigned)top[0][i], (unsigned)top[1][i], false, false); S[i] = (int)rr[0]; S[16 + i] = (int)rr[1]; }
        top16_merge<0, 16>(S);
        { unsigned w0 = 0, w1 = 0, w2 = 0, w3 = 0;
#pragma unroll
          for (int i = 0; i < 4; ++i) { w0 |= (unsigned)(127 - (S[i] & 127)) << (8 * i); w1 |= (unsigned)(127 - (S[4 + i] & 127)) << (8 * i); w2 |= (unsigned)(127 - (S[8 + i] & 127)) << (8 * i); w3 |= (unsigned)(127 - (S[12 + i] & 127)) << (8 * i); }
          *(LAS v4u*)(ib + (hi * 32 + j) * 4) = (v4u){w0, w1, w2, w3}; }
        float s1[16], s2[16];
#pragma unroll
        for (int i = 0; i < 16; ++i) { auto rr = __builtin_amdgcn_permlane32_swap((unsigned)S[i], (unsigned)S[i], false, false); s1[i] = key2f((int)rr[0] & ~127); s2[i] = key2f((int)rr[1] & ~127); }
        int c[64]; { int n = 0;
#pragma unroll
          for (int ca = 0; ca < 16; ++ca)
#pragma unroll
              for (int cb = 0; cb < 16; ++cb) if ((ca + 1) * (cb + 1) <= 16) { c[n] = (f2key(s1[ca] + s2[cb]) & ~255) | (255 - (ca * 16 + cb)); ++n; }
#pragma unroll
          for (int q = 50; q < 64; ++q) c[q] = (int)0x80000000; }
        top16_of_64(c);
        float ssq = 0.f;
#pragma unroll
        for (int q = 0; q < 4; ++q) { const f32x4 t4 = *(const f32x4*)(RSS + (size_t)(row0 + j) * 16 + 4 * q); ssq += (t4[0] + t4[1]) + (t4[2] + t4[3]); }
        const float rstd = 1.0f / sqrtf(ssq * (1.0f / DM) + EPS);
        const float z0 = key2f(c[0] & ~255) * rstd; float e[16], esum = 0.f;
#pragma unroll
        for (int k = 0; k < 16; ++k) { e[k] = __expf(key2f(c[k] & ~255) * rstd - z0); esum += e[k]; }
        const float inv = 1.0f / esum;
        LDS_WAIT(); asm volatile("" ::: "memory");
        const LAS unsigned char* ib8 = (const LAS unsigned char*)ib;
        int oi[8]; float og[8];
#pragma unroll
        for (int k = 0; k < 8; ++k) { const int ck = hi ? c[8 + k] : c[k]; const float ek = hi ? e[8 + k] : e[k]; const int fl = 255 - (ck & 255);
            const int i1 = ib8[(0 * 32 + j) * 16 + (fl >> 4)], i2 = ib8[(1 * 32 + j) * 16 + (fl & 15)]; oi[k] = i1 * NKEYS + i2; og[k] = ek * inv; }
        { int* sp = SI + (size_t)(row0 + j) * 128 + h * 16 + hi * 8; float* gp = SG + (size_t)(row0 + j) * 128 + h * 16 + hi * 8;
          *(v4u*)sp = (v4u){(unsigned)oi[0], (unsigned)oi[1], (unsigned)oi[2], (unsigned)oi[3]}; *(v4u*)(sp + 4) = (v4u){(unsigned)oi[4], (unsigned)oi[5], (unsigned)oi[6], (unsigned)oi[7]};
          *(f32x4*)gp = (f32x4){og[0], og[1], og[2], og[3]}; *(f32x4*)(gp + 4) = (f32x4){og[4], og[5], og[6], og[7]}; }
        LDS_WAIT(); asm volatile("" ::: "memory");
    }
}


constexpr int P8_SW = 128;
#define FP8X2(wd, hi_) __builtin_amdgcn_cvt_pk_f32_fp8((int)(wd), (hi_))
constexpr int P8_T = 68;
static_assert(M % P8_T == 0, "P8 chunking");
__device__ __forceinline__ void p8_gather(Frame& F, const Args& a) {
    unsigned char* ws = a.ws;
    const bf16* HG = (const bf16*)(ws + WS_XN); const unsigned char* PU = ws + WS_PU; const unsigned char* PV = ws + WS_PV; const float* US = (const float*)(ws + WS_US); const float* VS = (const float*)(ws + WS_VS);
    const float* RSS = (const float*)(ws + WS_RSS); const int* SI = (const int*)(ws + WS_SI); const float* SG = (const float*)(ws + WS_SG);
    float* Y = a.out + O_YP; unsigned char* HQ = ws + WS_Q;
    LAS unsigned short* ix = (LAS unsigned short*)F.lds;
    LAS float* wt = (LAS float*)(F.lds + P8_T * 128 * 2);
    LAS float* zp = (LAS float*)(F.lds + P8_T * 128 * 6);
    LAS float* rs = (LAS float*)(F.lds + P8_T * 128 * 10);
    LAS float* hs = (LAS float*)(F.lds + P8_T * 128 * 10 + 512);
    LAS float* wsc = (LAS float*)(F.lds + P8_T * 128 * 10 + 1024);
    LAS unsigned char* wq = F.lds + P8_T * 128 * 10 + 2048;
    int lane = F.lane; asm volatile("" : "+v"(lane));
    const int g = lane >> 3, c8 = lane & 7;
    const bool grp = (F.G == 256);
    for (int sup = F.vcu; sup < M / P8_T; sup += F.G) {
        const int tb = grp ? 2048 * (F.vcu >> 5) + 64 * (F.vcu & 31) : sup * P8_T, tb2 = grp ? MP + 128 * (F.vcu >> 5) + 4 * (F.vcu & 31) - 64 : tb;
#define P8_ROW(lt_) (((lt_) < 64 ? tb : tb2) + (lt_))
        __syncthreads();
        for (int i = F.tid; i < P8_T * 128; i += NTHR) { const size_t src = (size_t)P8_ROW(i >> 7) * 128 + (i & 127); ix[i] = (unsigned short)SI[src]; wt[i] = SG[src]; zp[i] = 0.f; }
        if (F.tid < P8_T) { float s = 0.f; for (int k = 0; k < 16; ++k) s += RSS[(size_t)P8_ROW(F.tid) * 16 + k]; rs[F.tid] = 1.0f / sqrtf(s * (1.0f / DM) + EPS); }
        for (int lt = F.wave; lt < P8_T; lt += NWAVES) { const bf16* hr = HG + (size_t)P8_ROW(lt) * DM + 16 * lane; const v4u ha = *(const v4u*)hr, hb2 = *(const v4u*)(hr + 8);
            const unsigned hp[8] = {ha.x, ha.y, ha.z, ha.w, hb2.x, hb2.y, hb2.z, hb2.w}; float hv[16], m = 0.f;
#pragma unroll
            for (int k = 0; k < 8; ++k) { hv[2 * k] = bflo(hp[k]); hv[2 * k + 1] = bfhi(hp[k]); m = fmaxf(m, fmaxf(fabsf(hv[2 * k]), fabsf(hv[2 * k + 1]))); }
#pragma unroll
            for (int o = 1; o < 64; o <<= 1) m = fmaxf(m, __shfl_xor(m, o));
            const float sc = m > 1e-30f ? 127.0f / m : 0.f; unsigned qw[4];
            unsigned qe[2] = {0u, 0u}, qo[2] = {0u, 0u};
#pragma unroll
            for (int t = 0; t < 8; ++t) { const int ie = (int)rintf(hv[2 * t] * sc), io = (int)rintf(hv[2 * t + 1] * sc); qe[t >> 2] |= ((unsigned)ie & 255u) << (8 * (t & 3)); qo[t >> 2] |= ((unsigned)io & 255u) << (8 * (t & 3)); }
            unsigned char* hq = HQ + (size_t)P8_ROW(lt) * DM + (lane >> 4) * 256 + 8 * (lane & 15);
            *(v2u*)hq = (v2u){qe[0], qe[1]}; *(v2u*)(hq + 128) = (v2u){qo[0], qo[1]};
            if (lane == 0) hs[lt] = m * (1.0f / 127.0f); }
        asm volatile("s_waitcnt vmcnt(0)" ::: "memory");
        __syncthreads();
        if (F.tid == 0) { __builtin_amdgcn_fence(__ATOMIC_ACQUIRE, "agent"); asm volatile("s_waitcnt vmcnt(0)" ::: "memory"); }
        __syncthreads();
        for (int s = 0; s < 4; ++s) {
            __syncthreads();
            int cl = c8; asm volatile("" : "+v"(cl));
            const unsigned char* pus = PU + (size_t)s * ((size_t)NEXP * P8_SW) + 16 * cl;
#pragma unroll 1
            for (int lt = F.wave; lt < P8_T; lt += NWAVES) {
                const unsigned char* hq = HQ + (size_t)P8_ROW(lt) * DM + 256 * s + 16 * cl;
                const v4u h0 = *(const v4u*)hq, h1 = *(const v4u*)(hq + 128);
                const int he[4] = {(int)h0.x, (int)h0.y, (int)h0.z, (int)h0.w}, ho[4] = {(int)h1.x, (int)h1.y, (int)h1.z, (int)h1.w};
                int hsum = 0;
#pragma unroll
                for (int jj = 0; jj < 4; ++jj) hsum = __builtin_amdgcn_sdot4(he[jj], 0x01010101, hsum, false);
                const int dl0 = -8 * hsum;
                const v4u ea = *(const LAS v4u*)(ix + lt * 128 + g * 16), eb = *(const LAS v4u*)(ix + lt * 128 + g * 16 + 8);
                const unsigned ew[8] = {ea.x, ea.y, ea.z, ea.w, eb.x, eb.y, eb.z, eb.w};
                v4u r[16];
#pragma unroll
                for (int i = 0; i < 16; ++i) { const unsigned e = (i & 1) ? (ew[i >> 1] >> 16) : (ew[i >> 1] & 0xffffu); r[i] = *(const v4u*)(pus + (size_t)e * P8_SW); }
                int acc[16];
#pragma unroll
                for (int i = 0; i < 16; ++i) { const unsigned wd[4] = {r[i].x, r[i].y, r[i].z, r[i].w}; int dh = 0, dl = dl0;
#pragma unroll
                    for (int jj = 0; jj < 4; ++jj) { dh = __builtin_amdgcn_sdot4((int)(wd[jj] & 0xf0f0f0f0u), ho[jj], dh, false); dl = __builtin_amdgcn_sdot4((int)(wd[jj] & 0x0f0f0f0fu), he[jj], dl, false); }
                    acc[i] = dh + (dl << 4); }
                int v8[8], v4[4], v2[2]; const bool b4 = (c8 & 4) != 0, b2 = (c8 & 2) != 0, b1 = (c8 & 1) != 0;
#pragma unroll
                for (int j2 = 0; j2 < 8; ++j2) { const int keep = b4 ? acc[8 + j2] : acc[j2], send = b4 ? acc[j2] : acc[8 + j2]; v8[j2] = keep + __shfl_xor(send, 4); }
#pragma unroll
                for (int j2 = 0; j2 < 4; ++j2) { const int keep = b2 ? v8[4 + j2] : v8[j2], send = b2 ? v8[j2] : v8[4 + j2]; v4[j2] = keep + __shfl_xor(send, 2); }
#pragma unroll
                for (int j2 = 0; j2 < 2; ++j2) { const int keep = b1 ? v4[2 + j2] : v4[j2], send = b1 ? v4[j2] : v4[2 + j2]; v2[j2] = keep + __shfl_xor(send, 1); }
                LAS f32x2* zq = (LAS f32x2*)(zp + lt * 128 + g * 16 + 2 * c8); const f32x2 z0 = *zq; *zq = (f32x2){z0[0] + (float)v2[0], z0[1] + (float)v2[1]};
            }
        }
        for (int lt = F.wave; lt < P8_T; lt += NWAVES) {
            const float r = rs[lt]; const int kk = lt * 128 + g * 16 + 2 * c8; LAS float* wp = wt + kk; const f32x2 gt = *(const LAS f32x2*)wp; const f32x2 zz = *(const LAS f32x2*)(zp + kk);
            const int e0 = ix[kk], e1 = ix[kk + 1];
            const float rh = r * hs[lt]; const float z0 = zz[0] * rh * US[e0], z1 = zz[1] * rh * US[e1];
            const float a0 = 0.5f * z0 * (1.0f + erff(z0 * 0.70710678118654752f)), a1 = 0.5f * z1 * (1.0f + erff(z1 * 0.70710678118654752f));
            const float w0 = gt[0] * a0 * VS[e0], w1 = gt[1] * a1 * VS[e1]; float mw = fmaxf(fabsf(w0), fabsf(w1));
#pragma unroll
            for (int o = 1; o < 64; o <<= 1) mw = fmaxf(mw, __shfl_xor(mw, o));
            const float wsq = mw > 1e-30f ? 127.0f / mw : 0.f; const int q0 = (int)rintf(w0 * wsq), q1 = (int)rintf(w1 * wsq);
            *(LAS unsigned short*)(wq + kk) = (unsigned short)(((unsigned)q0 & 255u) | (((unsigned)q1 & 255u) << 8));
            if (lane == 0) wsc[lt] = mw * (1.0f / 127.0f); }
        LDS_WAIT(); asm volatile("" ::: "memory");
        for (int s = 0; s < 4; ++s) {
            __syncthreads();
            int cl = c8; asm volatile("" : "+v"(cl));
            const unsigned char* pvs = PV + (size_t)s * ((size_t)NEXP * P8_SW) + 16 * cl;
#pragma unroll 1
            for (int lt = F.wave; lt < P8_T; lt += NWAVES) {
                const v4u ea = *(const LAS v4u*)(ix + lt * 128 + g * 16), eb = *(const LAS v4u*)(ix + lt * 128 + g * 16 + 8);
                const unsigned ew[8] = {ea.x, ea.y, ea.z, ea.w, eb.x, eb.y, eb.z, eb.w};
                v4u r[16];
#pragma unroll
                for (int i = 0; i < 16; ++i) { const unsigned e = (i & 1) ? (ew[i >> 1] >> 16) : (ew[i >> 1] & 0xffffu); r[i] = *(const v4u*)(pvs + (size_t)e * P8_SW); }
                const v4u wq4 = *(const LAS v4u*)(wq + lt * 128 + g * 16); const int Wg[4] = {(int)wq4.x, (int)wq4.y, (int)wq4.z, (int)wq4.w};
                int sw = 0;
#pragma unroll
                for (int G = 0; G < 4; ++G) sw = __builtin_amdgcn_sdot4(Wg[G], 0x01010101, sw, false);
                int acc[32];
#pragma unroll
                for (int c = 0; c < 32; ++c) acc[c] = -8 * sw;
#pragma unroll
                for (int G = 0; G < 4; ++G)
#pragma unroll
                    for (int jj = 0; jj < 4; ++jj) {
                        const unsigned A = r[4 * G][jj], B = r[4 * G + 1][jj], C = r[4 * G + 2][jj], D = r[4 * G + 3][jj];
                        const unsigned t0 = __builtin_amdgcn_perm(B, A, 0x05010400u), t1 = __builtin_amdgcn_perm(B, A, 0x07030602u), t2 = __builtin_amdgcn_perm(D, C, 0x05010400u), t3 = __builtin_amdgcn_perm(D, C, 0x07030602u);
                        const unsigned T[4] = {__builtin_amdgcn_perm(t2, t0, 0x05040100u), __builtin_amdgcn_perm(t2, t0, 0x07060302u), __builtin_amdgcn_perm(t3, t1, 0x05040100u), __builtin_amdgcn_perm(t3, t1, 0x07060302u)};
#pragma unroll
                        for (int bb = 0; bb < 4; ++bb) { const int t = 4 * jj + bb;
                            acc[2 * t]     = __builtin_amdgcn_sdot4((int)(T[bb] & 0x0f0f0f0fu), Wg[G], acc[2 * t], false);
                            acc[2 * t + 1] = __builtin_amdgcn_sdot4((int)T[bb], Wg[G], acc[2 * t + 1], false); } }
#pragma unroll
                for (int t = 0; t < 16; ++t) { acc[2 * t + 1] -= acc[2 * t]; acc[2 * t] <<= 4; }
                const bool b5 = (lane & 32) != 0, b4 = (lane & 16) != 0, b3 = (lane & 8) != 0; int p16[16], p8[8], p4[4];
#pragma unroll
                for (int j2 = 0; j2 < 16; ++j2) { const int keep = b5 ? acc[16 + j2] : acc[j2], send = b5 ? acc[j2] : acc[16 + j2]; p16[j2] = keep + __shfl_xor(send, 32); }
#pragma unroll
                for (int j2 = 0; j2 < 8; ++j2) { const int keep = b4 ? p16[8 + j2] : p16[j2], send = b4 ? p16[j2] : p16[8 + j2]; p8[j2] = keep + __shfl_xor(send, 16); }
#pragma unroll
                for (int j2 = 0; j2 < 4; ++j2) { const int keep = b3 ? p8[4 + j2] : p8[j2], send = b3 ? p8[j2] : p8[4 + j2]; p4[j2] = keep + __shfl_xor(send, 8); }
                const size_t off = (size_t)P8_ROW(lt) * DM + 256 * s + 32 * cl + (b5 ? 16 : 0) + (b4 ? 8 : 0) + (b3 ? 4 : 0);
                const v2u hw2 = *(const v2u*)(HG + off); const float ws_t = wsc[lt];
                __builtin_nontemporal_store((f32x4){bflo(hw2.x) + ws_t * (float)p4[0], bfhi(hw2.x) + ws_t * (float)p4[1], bflo(hw2.y) + ws_t * (float)p4[2], bfhi(hw2.y) + ws_t * (float)p4[3]}, (f32x4*)(Y + off)); }
        }
    }
}
#undef P8_ROW

__device__ __forceinline__ void p3_sample_attn2(Frame& F, const Args& a, const float M2) {
    unsigned char* ws = a.ws;
    const bf16* Q = (const bf16*)(ws + WS_Q); bf16* AO = (bf16*)(ws + WS_AO);
    LAS float* D2 = (LAS float*)F.lds;
    LAS float* E2 = (LAS float*)(F.lds + 32768);
    LAS float* Op = (LAS float*)(F.lds + 32768 + 128 + 8192);
    LAS float* lp = (LAS float*)(F.lds + 32768 + 128 + 8192 + 16384);
    int lane = F.lane; asm volatile("" : "+v"(lane));
    const int w = F.wave, hh = w >> 1, kh = w & 1, c = lane & 15, g = lane >> 4;
    for (;;) {
        __syncthreads();
        if (F.tid == 0) F.MISC[17] = __hip_atomic_fetch_add((unsigned*)(F.ctl + 8320), 1u, __ATOMIC_RELAXED, __HIP_MEMORY_SCOPE_AGENT);
        __syncthreads();
        const int unit = (int)F.MISC[17];
        if (unit >= DB * 2) break;
        const int b = unit >> 1, h = 4 * (unit & 1) + hh;
        const int pgv = a.page_table[b * NPAGES + (lane & (NPAGES - 1))];
        __syncthreads();
        for (int jk = F.tid; jk < PAST; jk += NTHR) { const int pg = a.page_table[b * NPAGES + (jk >> 7)];
            const f32x4 l4 = *(const f32x4*)(a.cache_lf + ((size_t)pg * PAGE + (jk & 127)) * NH + 4 * (unit & 1));
            D2[jk] = l4[0]; D2[PAST + jk] = l4[1]; D2[2 * PAST + jk] = l4[2]; D2[3 * PAST + jk] = l4[3]; }
        __syncthreads();
        if (kh == 0) {
            LAS float* d = D2 + hh * PAST; float loc[32]; float tot = 0.f;
#pragma unroll
            for (int k = 31; k >= 0; --k) { loc[k] = tot; tot += d[lane * 32 + k]; }
            float inc = tot;
#pragma unroll
            for (int o = 1; o < 64; o <<= 1) { const float t = __shfl_down(inc, o); if (lane + o < 64) inc += t; }
            const float excl = inc - tot;
#pragma unroll
            for (int k = 0; k < 32; ++k) d[lane * 32 + k] = (loc[k] + excl) * LOG2E;
            if (lane < 8) { float lv[8], e = 0.f;
#pragma unroll
                for (int t = 0; t < 8; ++t) lv[t] = a.out[O_LFS + (size_t)(b * 8 + t) * NH + h];
#pragma unroll
                for (int t = 0; t < 8; ++t) e += (t <= lane) ? lv[t] : 0.f;
                E2[hh * 8 + lane] = e * LOG2E; }
        }
        __syncthreads();
        bf16x8v qb[2];
#pragma unroll
        for (int ks = 0; ks < 2; ++ks) { qb[ks] = bf16x8v{}; if (c < 8) qb[ks] = *(const bf16x8v*)(Q + (size_t)(MP + b * 8 + c) * DA + h * 64 + 32 * ks + 8 * g); }
        const float e2q = E2[hh * 8 + (c & 7)] - M2;
        f32x4 oacc[4]; float lsum = 0.f;
#pragma unroll
        for (int m = 0; m < 4; ++m) oacc[m] = (f32x4){0.f, 0.f, 0.f, 0.f};
        const LAS float* dh = D2 + hh * PAST;
        int nskip; { const float dl = dh[32 * lane + 31]; nskip = __builtin_popcountll(__ballot(dl < -(24.f + 2.f * M2))); }
        nskip = __builtin_amdgcn_readfirstlane(nskip);
        const int nblk = PAST / 32 - nskip, nb0 = nblk >> 1;
        const int blk_lo = nskip + (kh ? nb0 : 0), nit = kh ? (nblk - nb0) : nb0;
#define S3_PACK8(x0_, x1_) __builtin_bit_cast(bf16x8v, (v4u){pkbf((x0_)[0], (x0_)[1]), pkbf((x0_)[2], (x0_)[3]), pkbf((x1_)[0], (x1_)[1]), pkbf((x1_)[2], (x1_)[3])})
#define S3_PV(p0_, p1_, vq_) do { const bf16x8v pb_ = S3_PACK8(p0_, p1_); \
            _Pragma("unroll") for (int m = 0; m < 4; ++m) { const bf16x8v va_ = __builtin_bit_cast(bf16x8v, (v4u){pkbf((vq_)[0][m], (vq_)[1][m]), pkbf((vq_)[2][m], (vq_)[3][m]), pkbf((vq_)[4][m], (vq_)[5][m]), pkbf((vq_)[6][m], (vq_)[7][m])}); \
                oacc[m] = __builtin_amdgcn_mfma_f32_16x16x32_bf16(va_, pb_, oacc[m], 0, 0, 0); } } while (0)
        for (int it = 0; it < nit; ++it) {
            const int j0 = (blk_lo + it) * 32; const int pg = __builtin_amdgcn_readlane(pgv, __builtin_amdgcn_readfirstlane(j0 >> 7));
            const size_t rowoff = (((size_t)pg * PAGE + (j0 & 127)) * NH + h) * HD;
            const float* kr = a.cache_k + rowoff + (size_t)c * (NH * HD) + 8 * g; const float* vr = a.cache_v + rowoff + 4 * c;
            f32x4 kq[2][2][2], vq[8];
#pragma unroll
            for (int tl = 0; tl < 2; ++tl)
#pragma unroll
                for (int ks = 0; ks < 2; ++ks) { const float* kp = kr + (size_t)(16 * tl) * (NH * HD) + 32 * ks; kq[tl][ks][0] = __builtin_nontemporal_load((const f32x4*)kp); kq[tl][ks][1] = __builtin_nontemporal_load((const f32x4*)(kp + 4)); }
#pragma unroll
            for (int jj = 0; jj < 8; ++jj) vq[jj] = __builtin_nontemporal_load((const f32x4*)(vr + (size_t)((jj < 4 ? 0 : 12) + 4 * g + jj) * (NH * HD)));
            const f32x4 d0 = *(const LAS f32x4*)(dh + j0 + 4 * g), d1 = *(const LAS f32x4*)(dh + j0 + 16 + 4 * g);
            f32x4 s0 = d0 + e2q, s1 = d1 + e2q;
#pragma unroll
            for (int ks = 0; ks < 2; ++ks) { s0 = __builtin_amdgcn_mfma_f32_16x16x32_bf16(S3_PACK8(kq[0][ks][0], kq[0][ks][1]), qb[ks], s0, 0, 0, 0);
                                             s1 = __builtin_amdgcn_mfma_f32_16x16x32_bf16(S3_PACK8(kq[1][ks][0], kq[1][ks][1]), qb[ks], s1, 0, 0, 0); }
            f32x4 p0, p1;
#pragma unroll
            for (int r = 0; r < 4; ++r) { p0[r] = __builtin_amdgcn_exp2f(s0[r]); p1[r] = __builtin_amdgcn_exp2f(s1[r]); }
            lsum += (p0[0] + p0[1]) + (p0[2] + p0[3]) + (p1[0] + p1[1]) + (p1[2] + p1[3]);
            S3_PV(p0, p1, vq);
        }
        if (kh == 1) {
            const float* kr = a.out + O_KS + (size_t)(b * 8 + (c & 7)) * DA + h * HD + 8 * g;
            f32x4 s0 = (f32x4){0.f, 0.f, 0.f, 0.f};
#pragma unroll
            for (int ks = 0; ks < 2; ++ks) { const f32x4 x0 = *(const f32x4*)(kr + 32 * ks), x1 = *(const f32x4*)(kr + 32 * ks + 4); s0 = __builtin_amdgcn_mfma_f32_16x16x32_bf16(S3_PACK8(x0, x1), qb[ks], s0, 0, 0, 0); }
            f32x4 p0, p1 = (f32x4){0.f, 0.f, 0.f, 0.f}, vq[8];
#pragma unroll
            for (int r = 0; r < 4; ++r) { const int key = 4 * g + r; const float ek = E2[hh * 8 + (key & 7)]; p0[r] = (key < 8 && key <= c) ? __builtin_amdgcn_exp2f(s0[r] + e2q - ek) : 0.f; }
#pragma unroll
            for (int jj = 0; jj < 8; ++jj) { vq[jj] = (f32x4){0.f, 0.f, 0.f, 0.f}; if (jj < 4 && g < 2) vq[jj] = *(const f32x4*)(a.out + O_VS + (size_t)(b * 8 + 4 * g + jj) * DA + h * HD + 4 * c); }
            lsum += (p0[0] + p0[1]) + (p0[2] + p0[3]);
            S3_PV(p0, p1, vq);
        }
#undef S3_PV
#undef S3_PACK8
        lsum += __shfl_xor(lsum, 16); lsum += __shfl_xor(lsum, 32);
        if (lane < 8) lp[w * 8 + lane] = lsum;
        if (c < 8) {
#pragma unroll
            for (int r = 0; r < 4; ++r) *(LAS f32x4*)(Op + (w * 8 + c) * 64 + 16 * g + 4 * r) = (f32x4){oacc[0][r], oacc[1][r], oacc[2][r], oacc[3][r]}; }
        __syncthreads();
        for (int i = F.tid; i < 4 * 8 * 64; i += NTHR) { const int hq = i >> 9, t = (i >> 6) & 7, d = i & 63;
            const float O = Op[((2 * hq) * 8 + t) * 64 + d] + Op[((2 * hq + 1) * 8 + t) * 64 + d], L = lp[(2 * hq) * 8 + t] + lp[(2 * hq + 1) * 8 + t];
            AO[(size_t)(MP + b * 8 + t) * DA + (4 * (unit & 1) + hq) * 64 + d] = (bf16)(pkbf(O / L, 0.f) & 0xffffu); }
    }
}


template <class Epi> __device__ __forceinline__ void sg_phase(Frame& F, const bf16* A  , const bf16* Bt  , int K, int N, const Epi& E) {
    int lane = F.lane; asm volatile("" : "+v"(lane));
    const int fr = lane & 15, fq = lane >> 4, ntc = N >> 6, ntile = (MS / 128) * ntc, pitch = 2 * K + 16, kc = K >> 3;
    const bool grp = (F.G == 256);
    for (int t = grp ? (F.vcu & 31) : F.vcu; t < (grp ? ntc : ntile); t += grp ? 32 : F.G) {
        const int tr = grp ? (F.vcu >> 5) : t % (MS / 128), tc = grp ? t : t / (MS / 128);
        __syncthreads();
        for (int i = F.tid; i < 64 * kc; i += NTHR) { const int r = i / kc, c = i - r * kc; *(LAS v4u*)(F.lds + r * pitch + 16 * c) = *(const v4u*)(Bt + (size_t)(64 * tc + r) * K + 8 * c); }
        __syncthreads();
        const bf16* ap = A + (size_t)(128 * tr + 16 * F.wave + fr) * K + 8 * fq;
        const LAS unsigned char* bp = F.lds + fr * pitch + 16 * fq;
        f32x4 acc[4];
#pragma unroll
        for (int c = 0; c < 4; ++c) acc[c] = (f32x4){0.f, 0.f, 0.f, 0.f};
#pragma unroll 8
        for (int ks = 0; ks < K; ks += 32) {
            const bf16x8v av = *(const bf16x8v*)(ap + ks);
#pragma unroll
            for (int c = 0; c < 4; ++c) { const bf16x8v bv = *(const LAS bf16x8v*)(bp + 16 * c * pitch + 2 * ks); acc[c] = __builtin_amdgcn_mfma_f32_16x16x32_bf16(bv, av, acc[c], 0, 0, 0); }
        }
        E(acc, 128 * tr + 16 * F.wave + fr, tc, fq);
    }
}
template <int MODE> struct SgGate { const bf16* G; const bf16* Tin; bf16* O;
    __device__ __forceinline__ void operator()(const f32x4 (&acc)[4], int rs, int tc, int fq) const {
#pragma unroll
        for (int c = 0; c < 4; ++c) { const size_t off = (size_t)(MP + rs) * DM + 64 * tc + 16 * c + 4 * fq; const v2u g = *(const v2u*)(G + off);
            float r[4] = {acc[c][0] * bflo(g.x), acc[c][1] * bfhi(g.x), acc[c][2] * bflo(g.y), acc[c][3] * bfhi(g.y)};
            if (MODE == 1) { const v2u t = *(const v2u*)(Tin + off); r[0] += bflo(t.x); r[1] += bfhi(t.x); r[2] += bflo(t.y); r[3] += bfhi(t.y); }
            v2u w; w.x = pkbf(r[0], r[1]); w.y = pkbf(r[2], r[3]); *(v2u*)(O + off) = w; } } };
struct SgOut { const float* xs; float* H; bf16* HG; const float* gf; float* RSS;
    __device__ __forceinline__ void operator()(const f32x4 (&acc)[4], int rs, int tc, int fq) const { float ss = 0.f;
#pragma unroll
        for (int c = 0; c < 4; ++c) { const int col = 64 * tc + 16 * c + 4 * fq; const f32x4 h = acc[c] + *(const f32x4*)(xs + (size_t)rs * DM + col);
            ss += (h[0] * h[0] + h[1] * h[1]) + (h[2] * h[2] + h[3] * h[3]);
            v2u w; w.x = pkbf(h[0], h[1]); w.y = pkbf(h[2], h[3]); *(v2u*)(HG + (size_t)(MP + rs) * DM + col) = w; }
        ss += __shfl_xor(ss, 16); ss += __shfl_xor(ss, 32);
        if (fq == 0) RSS[(size_t)(MP + rs) * 16 + tc] = ss; } };
struct SgPQ { bf16* PQ;
    __device__ __forceinline__ void operator()(const f32x4 (&acc)[4], int rs, int tc, int fq) const {
#pragma unroll
        for (int c = 0; c < 4; ++c) { v2u w; w.x = pkbf(acc[c][0], acc[c][1]); w.y = pkbf(acc[c][2], acc[c][3]); *(v2u*)(PQ + (size_t)(MP + rs) * DQ + 64 * tc + 16 * c + 4 * fq) = w; } } };

constexpr int CW_GRP = 8448, CW_XID = 12288;
__device__ __forceinline__ void group_barrier(const Frame& F, const XcdBarrier& b, int seam) {
    asm volatile("s_waitcnt vmcnt(0)" ::: "memory");
    __syncthreads();
    if (threadIdx.x == 0) {
        const unsigned x = blockIdx.x & 7u, n = (gridDim.x - x + 7u) >> 3;
        unsigned same = F.MISC[20];
        if (same == 0u) { unsigned acc = 1u; for (unsigned m = x; m < gridDim.x; m += 8u) acc &= (xb_ld((unsigned*)(F.ctl + CW_XID + (int)m)) == b.x + 1u) ? 1u : 0u; same = 1u + acc; F.MISC[20] = same; }
        unsigned* c = (unsigned*)(F.ctl + CW_GRP + 64 * (seam * 8 + (int)x));
        if (same != 2u) { __builtin_amdgcn_fence(__ATOMIC_RELEASE, "agent"); asm volatile("s_waitcnt vmcnt(0)" ::: "memory"); }
        (void)xb_add(c, 1u);
        XB_SPIN(xb_ld(c) < n, b.bar);
        __builtin_amdgcn_fence(__ATOMIC_ACQUIRE, "agent");
        asm volatile("s_waitcnt vmcnt(0)" ::: "memory");
    }
    __syncthreads();
}

struct ChainOrder : pg8::StaticOrder {
    __device__ bool next(int i, pg8::Unit& u) const { const bool ok = pg8::StaticOrder::next(i >> 1, u); u.sel = i & 1; return ok; }
};

constexpr int N_PHASES = 9;
#ifndef MK_PER_PHASE
#define MK_PER_PHASE 0
#endif
__global__ void __launch_bounds__(NTHR, 2) fwd_kernel(Args args) {
    extern __shared__ __attribute__((aligned(16))) unsigned char lds[];
    Frame F;
    F.lds = (LAS unsigned char*)lds; F.MISC = (volatile LAS unsigned*)(F.lds + MISC_OFF);
    F.tid = threadIdx.x; F.lane = F.tid & 63; F.wave = __builtin_amdgcn_readfirstlane(F.tid >> 6);
    F.G = gridDim.x; { const int bx = blockIdx.x; F.vcu = (F.G % 8 == 0) ? (bx % 8) * (F.G / 8) + bx / 8 : bx; }
    F.ctl = (gu32*)(args.ws + WS_CTL);
    for (int u = F.tid; u < (LDS_BYTES - MISC_OFF) / 4; u += NTHR) ((LAS unsigned*)(F.lds + MISC_OFF))[u] = 0u;
    __syncthreads();
#if MK_PER_PHASE
#define GRID_BAR() do { } while (0)
#else
    XcdBarrier bar = xcd_barrier_post((unsigned*)(F.ctl + CW_BAR), F.MISC + 8);
    if (F.tid == 0) __hip_atomic_store((unsigned*)(F.ctl + CW_XID + (int)blockIdx.x), bar.x + 1u, __ATOMIC_RELAXED, __HIP_MEMORY_SCOPE_AGENT);
#define GRID_BAR() xcd_barrier(bar)
#endif
    unsigned char* ws = args.ws;
    const int lo = args.ph_lo, hi = args.ph_hi;
    const bool grp = (F.G == 256);
#ifndef DBG_REP_PHASE
#define DBG_REP_PHASE -1
#endif
#ifndef DBG_REP_N
#define DBG_REP_N 1
#endif
#define REPS(k) for (int rep_ = 0; rep_ < ((k) == DBG_REP_PHASE ? 1 + DBG_REP_N : 1); ++rep_)
#define IN(k) (lo <= (k) && (k) < hi)
#define BOTH(k) (IN(k) && IN((k) + 1))
#define ENDPH(k) do { if (BOTH(k) || (k) == DBG_REP_PHASE) GRID_BAR(); } while (0)
#if MK_PER_PHASE
#define ENDPH_G(k, seam) ENDPH(k)
#else
#define ENDPH_G(k, seam) do { if (BOTH(k) || (k) == DBG_REP_PHASE) { if (grp && (k) != DBG_REP_PHASE) group_barrier(F, bar, seam); else GRID_BAR(); } } while (0)
#endif
    if (IN(0)) REPS(0) { p0_prologue(F, args); ENDPH(0); }
    if (IN(1)) REPS(1) {
        p1_cumsum(F, args);
        pg8::Gemm g{(const bf16*)(ws + WS_XN), (const bf16*)(ws + WS_WIN), M, NPROJ - 256, DM}; pg8::StaticOrder S; S.init(M, NPROJ - 256, F.G, (int)blockIdx.x);
        EpiInProj E{(bf16*)(ws + WS_U), (bf16*)(ws + WS_Q), (bf16*)(ws + WS_K), (bf16*)(ws + WS_V), (bf16*)(ws + WS_GA), (bf16*)(ws + WS_GB), args.out, args.q_norm_g, args.k_norm_g, 0};
        pg8::gemm_phase<EpiInProj, pg8::StaticOrder, true, true>(F.lds, g, S, E);
        ENDPH(1);
    }
    if (IN(2)) REPS(2) {
        { pg8::Gemm g{(const bf16*)(ws + WS_XN), (const bf16*)(ws + WS_WIN) + (size_t)(NPROJ - 256) * DM, M, 256, DM}; pg8::StaticOrder S; S.init(M, 256, F.G, (int)blockIdx.x);
          EpiInProj E{(bf16*)(ws + WS_U), (bf16*)(ws + WS_Q), (bf16*)(ws + WS_K), (bf16*)(ws + WS_V), (bf16*)(ws + WS_GA), (bf16*)(ws + WS_GB), args.out, args.q_norm_g, args.k_norm_g, 15};
          pg8::gemm_phase<EpiInProj, pg8::StaticOrder, true, true>(F.lds, g, S, E); }
        __syncthreads();
        p2_cumsum_pool(F, args);
        if (2 == DBG_REP_PHASE || !IN(3)) GRID_BAR();
        __syncthreads(); }
    if (IN(3)) {
        const float M2 = __builtin_bit_cast(float, __builtin_amdgcn_readfirstlane(__builtin_bit_cast(int, attn_bound2(args, F.lane))));
#if !defined(DBG_SKIP_PATTN)
        { const attn_body::AttnTensors AT{(const attn_body::bf16*)(ws + WS_Q), (const attn_body::bf16*)(ws + WS_K), (const attn_body::bf16*)(ws + WS_V), (attn_body::bf16*)(ws + WS_AO), (const float*)(ws + WS_CP2), M2};
          const attn_body::QueueOrder S{(unsigned*)(F.ctl + 8192), F.MISC + 16};
          attn_body::attn_phase<attn_body::QueueOrder>((char*)lds, AT, S);
#ifdef DBG_ATTN2
          __syncthreads(); attn_body::attn_phase<attn_body::StaticOrder>((char*)lds, AT, S);
#endif
        }
#endif
        REPS(3) { p3_sample_attn2(F, args, M2); }
        ENDPH(3); }
    if (IN(4)) REPS(4) {
        { pg8::Gemm g{(const bf16*)(ws + WS_PO), (const bf16*)(ws + WS_WBP), MP, DM, DP, (const bf16*)(ws + WS_AO), (const bf16*)(ws + WS_WBA)}; ChainOrder S; S.init(MP, DM, F.G, (int)blockIdx.x);
          EpiMerge E{(const bf16*)(ws + WS_GA), (const bf16*)(ws + WS_GB), (bf16*)(ws + WS_MIX)};
          pg8::gemm_phase<EpiMerge, ChainOrder, true, true>(F.lds, g, S, E); }
        { SgGate<0> E{(const bf16*)(ws + WS_GA), nullptr, (bf16*)(ws + WS_T)}; sg_phase(F, (const bf16*)(ws + WS_PO) + (size_t)MP * DP, (const bf16*)(ws + WS_WBP), DP, DM, E); }
        asm volatile("s_waitcnt vmcnt(0)" ::: "memory"); __syncthreads();
        { SgGate<1> E{(const bf16*)(ws + WS_GB), (const bf16*)(ws + WS_T), (bf16*)(ws + WS_MIX)}; sg_phase(F, (const bf16*)(ws + WS_AO) + (size_t)MP * DA, (const bf16*)(ws + WS_WBA), DA, DM, E); }
        ENDPH_G(4, 0);
    }
    if (IN(5)) REPS(5) {
        pg8::Gemm g{(const bf16*)(ws + WS_MIX), (const bf16*)(ws + WS_WOUT), MP, DM, DM}; pg8::StaticOrder S; S.init(MP, DM, F.G, (int)blockIdx.x);
        EpiOut E{args.x_p, args.x_s, (float*)(ws + WS_H), (bf16*)(ws + WS_XN), args.norm_ffn_g, (float*)(ws + WS_RSS)};
        pg8::gemm_phase<EpiOut, pg8::StaticOrder, true, true>(F.lds, g, S, E);
        { SgOut E2{args.x_s, (float*)(ws + WS_H), (bf16*)(ws + WS_XN), args.norm_ffn_g, (float*)(ws + WS_RSS)}; sg_phase(F, (const bf16*)(ws + WS_MIX) + (size_t)MP * DM, (const bf16*)(ws + WS_WOUT), DM, DM, E2); }
        ENDPH_G(5, 1);
    }
    if (IN(6)) REPS(6) {
        pg8::Gemm g{(const bf16*)(ws + WS_XN), (const bf16*)(ws + WS_WQ), MP, DQ, DM}; pg8::StaticOrder S; S.init(MP, DQ, F.G, (int)blockIdx.x);
        pg8::EpiBf16<0> E{(bf16*)(ws + WS_PQ), DQ, nullptr, 0, 0, 1.f};
        pg8::gemm_phase<pg8::EpiBf16<0>, pg8::StaticOrder, true, true>(F.lds, g, S, E);
        { SgPQ E2{(bf16*)(ws + WS_PQ)}; sg_phase(F, (const bf16*)(ws + WS_XN) + (size_t)MP * DM, (const bf16*)(ws + WS_WQ), DM, DQ, E2); }
        ENDPH_G(6, 2);
    }
    if (IN(7)) REPS(7) { p7_topk(F, args); ENDPH_G(7, 3); }
    if (IN(8)) REPS(8) { p8_gather(F, args); ENDPH(8); }
#ifdef DBG_DUMP
    if (IN(9)) { const bf16* AO = (const bf16*)(ws + WS_AO); const bf16* PO = (const bf16*)(ws + WS_PO); const bf16* MX = (const bf16*)(ws + (DBG_DUMP == 3 ? WS_T : DBG_DUMP == 4 ? WS_GA : WS_MIX));
        for (size_t i = (size_t)blockIdx.x * NTHR + F.tid; i < (size_t)M * DM; i += (size_t)F.G * NTHR) { const int row = (int)(i >> 10), c = (int)(i & 1023);
            float v; if (DBG_DUMP == 1) v = c < 512 ? bf2f(AO[(size_t)row * DA + c]) : bf2f(PO[(size_t)row * DP + c - 512]); else v = bf2f(MX[i]);
            args.out[O_YP + i] = v; } }
#endif
#undef IN
#undef BOTH
}

extern "C" void kernel_launch(void* const* d_in, const int* in_sizes, int n_in, void* d_out, int out_size, void* d_ws, size_t ws_size, hipStream_t stream) {
    static int grid = 0;
    if (grid == 0) {
        if (n_in != 22 || (size_t)out_size != O_END || ws_size < WS_END) { fprintf(stderr, "kernel_launch: unexpected shapes (n_in %d out %d ws %zu)\n", n_in, out_size, ws_size); grid = -1; return; }
        int dev = 0, cus = 0, per_cu = 0;
        if (hipGetDevice(&dev) != hipSuccess || hipDeviceGetAttribute(&cus, hipDeviceAttributeMultiprocessorCount, dev) != hipSuccess) { grid = -1; return; }
        if (hipFuncSetAttribute((const void*)fwd_kernel, hipFuncAttributeMaxDynamicSharedMemorySize, LDS_BYTES) != hipSuccess) { fprintf(stderr, "kernel_launch: hipFuncSetAttribute failed\n"); grid = -1; return; }
        if (hipOccupancyMaxActiveBlocksPerMultiprocessor(&per_cu, (const void*)fwd_kernel, NTHR, LDS_BYTES) != hipSuccess || per_cu < 1) fprintf(stderr, "kernel_launch: occupancy query reports %d\n", per_cu);
        (void)hipGetLastError();
        grid = cus;
    }
    if (grid < 0) return;
    if (hipMemsetAsync((char*)d_ws + WS_CTL, 0, CTL_ZERO_BYTES, stream) != hipSuccess) return;
    Args a{};
    a.x_p = (const float*)d_in[0]; a.x_s = (const float*)d_in[1]; a.cache_k = (const float*)d_in[2]; a.cache_v = (const float*)d_in[3]; a.cache_lf = (const float*)d_in[4];
    a.state_pool = (const float*)d_in[5]; a.page_table = (const int*)d_in[6]; a.norm_mix_g = (const float*)d_in[7]; a.w_in = (const float*)d_in[8]; a.b_forget = (const float*)d_in[9];
    a.q_norm_g = (const float*)d_in[10]; a.k_norm_g = (const float*)d_in[11]; a.pool_mix_w = (const float*)d_in[12]; a.pool_scale = (const float*)d_in[13]; a.w_bp = (const float*)d_in[14];
    a.w_ba = (const float*)d_in[15]; a.w_out = (const float*)d_in[16]; a.norm_ffn_g = (const float*)d_in[17]; a.w_query = (const float*)d_in[18]; a.sub_keys = (const float*)d_in[19];
    a.peer_u = (const float*)d_in[20]; a.peer_v = (const float*)d_in[21];
    a.out = (float*)d_out; a.ws = (unsigned char*)d_ws; a.pad = 0;
#if MK_PER_PHASE
#ifndef DBG_NPH
#define DBG_NPH N_PHASES
#endif
    for (int ph = 0; ph < DBG_NPH; ++ph) { a.ph_lo = ph; a.ph_hi = ph + 1; a.li = ph; hipLaunchKernelGGL(fwd_kernel, dim3(grid), dim3(NTHR), LDS_BYTES, stream, a); }
#ifdef DBG_DUMP
    a.ph_lo = 9; a.ph_hi = 10; a.li = 9; hipLaunchKernelGGL(fwd_kernel, dim3(grid), dim3(NTHR), LDS_BYTES, stream, a);
#endif
#else
    a.ph_lo = 0; a.ph_hi = N_PHASES; a.li = 0; hipLaunchKernelGGL(fwd_kernel, dim3(grid), dim3(NTHR), LDS_BYTES, stream, a);
#endif
}
```

```cpp
#include <hip/hip_runtime.h>
#include <cstdio>
#include <cstdint>
#include <cmath>
namespace pg8 {
#define PG8_LAS __attribute__((address_space(3)))
typedef unsigned short bf16_t;
typedef short bf16x8 __attribute__((ext_vector_type(8)));
typedef float f32x4 __attribute__((ext_vector_type(4)));
typedef unsigned u32x4 __attribute__((ext_vector_type(4)));
constexpr int BM = 256, BK = 64, HALF = 128, HTB = HALF * BK * 2  , STAGE_BYTES = 8 * HTB, NXCD = 8, WGM = 8;

__host__ __device__ __forceinline__ int lds_byte(int r, int c) { const int st = (r >> 4) * 2 + (c >> 5), rr = r & 15, cc = c & 31, ob = rr * 64 + cc * 2; return st * 1024 + (ob ^ (((ob >> 9) & 1) << 5)); }
__host__ __device__ __forceinline__ void stage_rc(int b, int& R, int& C) { const int st = b / 1024, sb = b % 1024, swz = sb ^ (((sb >> 9) & 1) << 5); R = (st >> 1) * 16 + swz / 64; C = (st & 1) * 32 + (swz % 64) / 2; }
__host__ __device__ __forceinline__ int perm32(int rho) { const int n = rho >> 4, i = rho & 15; return 8 * (i >> 2) + 4 * n + (i & 3); }

struct Unit { int pm, pn, sel; };
struct Gemm { const bf16_t* A; const bf16_t* Bt; int M, N, K; const bf16_t* A2; const bf16_t* Bt2; };

struct StaticOrder {
    int nM, nN, nwg, G, c;
    __host__ __device__ void init(int M, int N, int G_, int c_) { nM = M / BM; nN = N / BM; nwg = nM * nN; G = G_; c = c_; }
    __host__ __device__ bool next(int i, Unit& u) const {
        const long L = (long)i * G + c; if (L >= nwg) return false;
        int wgid = (int)L; { const int q = nwg / NXCD, r = nwg % NXCD, xcd = wgid % NXCD, off = wgid / NXCD; wgid = (xcd < r ? xcd * (q + 1) : r * (q + 1) + (xcd - r) * q) + off; }
        const int nig = WGM * nN, gid = wgid / nig, fm = gid * WGM, gsz = (nM - fm) < WGM ? (nM - fm) : WGM;
        u.pm = fm + ((wgid % nig) % gsz); u.pn = (wgid % nig) / gsz; return true;
    }
    __device__ __forceinline__ void a_ready(const Unit&) const {}
    __device__ __forceinline__ void done(const Unit&) const {}
};

typedef float f32x2c __attribute__((ext_vector_type(2))); typedef __bf16 bf16x2c __attribute__((ext_vector_type(2)));
__device__ __forceinline__ unsigned cvt_pk_bf16(float lo, float hi) { f32x2c v = {lo, hi}; bf16x2c b = __builtin_convertvector(v, bf16x2c); return __builtin_bit_cast(unsigned, b); }
typedef float f32x2 __attribute__((ext_vector_type(2)));
__device__ __forceinline__ f32x2 gelu_pk(f32x2 v) {
    const f32x2 av = __builtin_elementwise_abs(v), d = av * 0.2316418882f + 1.0f;
    f32x2 t; t.x = __builtin_amdgcn_rcpf(d.x); t.y = __builtin_amdgcn_rcpf(d.y);
    f32x2 q = t * 0.5307027145f + (-0.7265760135f); q = q * t + 0.7107068705f; q = q * t + (-0.142248368f); q = q * t + 0.127414796f; q = q * t;
    const f32x2 s = (v * v) * (-0.72134752044f);
    f32x2 e; e.x = __builtin_amdgcn_exp2f(s.x); e.y = __builtin_amdgcn_exp2f(s.y);
    const f32x2 m = v * (q * e), r = v - m;
    f32x2 o; o.x = v.x < 0.f ? m.x : r.x; o.y = v.y < 0.f ? m.y : r.y; return o;
}

template <int ACT  > struct EpiBf16 {
    static constexpr bool PERM = true, AFTER_DRAIN = false, CHAIN = false; static_assert(ACT == 0 || ACT == 1, "EpiBf16: ACT is 0 (none) or 1 (gelu_pk)");
    bf16_t* O; int ldc; const float* bias; int split_cols; size_t split_stride; float scale0;
    __device__ __forceinline__ void operator()(const f32x4 (&acc)[2][2][4][2], const Unit& u, int wr, int wc, int fr, int fq) const {
        const int row0 = u.pm * BM + wr * 64 + fr; int colt = u.pn * BM; bf16_t* base = O;
        float sc = 1.f; if (split_cols) { const int t = colt / split_cols; base += (size_t)t * split_stride; colt -= t * split_cols; if (t == 0) sc = scale0; }
        const int col0 = colt + wc * 32 + 8 * fq, bcol0 = u.pn * BM + wc * 32 + 8 * fq;
        f32x4 bv[2][2];
#pragma unroll
        for (int bj = 0; bj < 2; ++bj)
#pragma unroll
            for (int n = 0; n < 2; ++n) bv[bj][n] = bias ? *(const f32x4*)(bias + bcol0 + bj * HALF + 4 * n) : (f32x4){0.f, 0.f, 0.f, 0.f};
#pragma unroll
        for (int ai = 0; ai < 2; ++ai)
#pragma unroll
            for (int m = 0; m < 4; ++m) { bf16_t* rowp = base + (size_t)(row0 + ai * HALF + m * 16) * ldc + col0;
#pragma unroll
                for (int bj = 0; bj < 2; ++bj) { f32x4 v0 = acc[ai][bj][m][0] + bv[bj][0], v1 = acc[ai][bj][m][1] + bv[bj][1];
                    if (ACT == 1) { f32x2 a = gelu_pk((f32x2){v0[0], v0[1]}), b = gelu_pk((f32x2){v0[2], v0[3]}), c = gelu_pk((f32x2){v1[0], v1[1]}), d = gelu_pk((f32x2){v1[2], v1[3]});
                        v0 = (f32x4){a.x, a.y, b.x, b.y}; v1 = (f32x4){c.x, c.y, d.x, d.y}; }
                    v0 = v0 * sc; v1 = v1 * sc; u32x4 w; w.x = cvt_pk_bf16(v0[0], v0[1]); w.y = cvt_pk_bf16(v0[2], v0[3]); w.z = cvt_pk_bf16(v1[0], v1[1]); w.w = cvt_pk_bf16(v1[2], v1[3]);
                    *(u32x4*)(rowp + bj * HALF) = w; } }
    }
};
template <class Epi, class Sched, bool ALIGN_EPI = false, bool SP2 = false>
__device__ __forceinline__ void gemm_phase(PG8_LAS unsigned char* lds, const Gemm g, const Sched& S, const Epi& E) {
    int tid = threadIdx.x; asm volatile("" : "+v"(tid));
    const int wid = __builtin_amdgcn_readfirstlane(tid >> 6), lane = tid & 63, wr = wid >> 2, wc = wid & 3, fr = lane & 15, fq = lane >> 4;
    const int K = g.K, nt = K / BK;
    unsigned voffA[2], voffB[2];
#pragma unroll
    for (int i = 0; i < 2; ++i) { int R, C; stage_rc(tid * 16 + i * 8192, R, C); const int Rb = Epi::PERM ? ((R & ~31) + perm32(R & 31)) : R;
        voffA[i] = (unsigned)(R * K + C) * 2u; voffB[i] = (unsigned)(Rb * K + C) * 2u; }
    const size_t kstep = (size_t)(BK * 2);
    const size_t hstep = (size_t)HALF * K * 2;
    const size_t tstep = 2 * hstep;
    const unsigned ldsw = (unsigned)wid * 1024u;
    const int aoff = lds_byte(wr * 64 + fr, fq * 8), boff = lds_byte(wc * 32 + fr, fq * 8);
#define PG8_SA(b, h) (((b) * 2 + (h)) * HTB)
#define PG8_SB(b, h) ((4 + (b) * 2 + (h)) * HTB)
#define PG8_STAGE(bufoff, gbase, voff) do { _Pragma("unroll") for (int _i = 0; _i < 2; ++_i) \
        __builtin_amdgcn_global_load_lds((const unsigned*)((const char*)(gbase) + (voff)[_i]), (PG8_LAS unsigned*)(lds + (bufoff) + ldsw + _i * 8192), 16, 0, 0); } while (0)
#define PG8_LDA(dst, b, h) do { _Pragma("unroll") for (int m = 0; m < 4; ++m) _Pragma("unroll") for (int k = 0; k < 2; ++k) dst[m][k] = *(const PG8_LAS bf16x8*)(lds + PG8_SA(b, h) + aoff + m * 2048 + k * 1024); } while (0)
#define PG8_LDB(dst, b, h) do { _Pragma("unroll") for (int n = 0; n < 2; ++n) _Pragma("unroll") for (int k = 0; k < 2; ++k) dst[n][k] = *(const PG8_LAS bf16x8*)(lds + PG8_SB(b, h) + boff + n * 2048 + k * 1024); } while (0)
#define PG8_MMA(ai, bj, At, Bt) do { __builtin_amdgcn_s_setprio(1); _Pragma("unroll") for (int m = 0; m < 4; ++m) _Pragma("unroll") for (int n = 0; n < 2; ++n) _Pragma("unroll") for (int k = 0; k < 2; ++k) \
        acc[ai][bj][m][n] = __builtin_amdgcn_mfma_f32_16x16x32_bf16(Bt[n][k], At[m][k], acc[ai][bj][m][n], 0, 0, 0); __builtin_amdgcn_s_setprio(0); } while (0)
#define PG8_WAIT_V(n) asm volatile("s_waitcnt vmcnt(" #n ")" ::: "memory")
#define PG8_WAIT_L(n) asm volatile("s_waitcnt lgkmcnt(" #n ")" ::: "memory")
#define PG8_BAR __builtin_amdgcn_s_barrier()
#define PG8_SCHED __builtin_amdgcn_sched_barrier(0)
    Unit cur, nxt; int ui = 0;
    if (!S.next(0, cur)) return;
    f32x4 acc[2][2][4][2];
#pragma unroll
    for (int a = 0; a < 2; ++a)
#pragma unroll
        for (int b = 0; b < 2; ++b)
#pragma unroll
            for (int m = 0; m < 4; ++m)
#pragma unroll
                for (int n = 0; n < 2; ++n) acc[a][b][m][n] = (f32x4){0.f, 0.f, 0.f, 0.f};
    bf16x8 At[4][2], B0[2][2], B1[2][2];
    const char* cA = (const char*)g.A + (size_t)cur.pm * tstep; const char* cB = (const char*)g.Bt + (size_t)cur.pn * tstep;
    if constexpr (Epi::CHAIN) { if (cur.sel) { cA = (const char*)g.A2 + (size_t)cur.pm * tstep; cB = (const char*)g.Bt2 + (size_t)cur.pn * tstep; } }
    S.a_ready(cur);
    if constexpr (SP2) {
        PG8_STAGE(PG8_SB(0, 0), cB, voffB); PG8_STAGE(PG8_SB(0, 1), cB + hstep, voffB); PG8_STAGE(PG8_SA(0, 0), cA, voffA); PG8_STAGE(PG8_SA(0, 1), cA + hstep, voffA);
        if (wr == 1) PG8_BAR;
        PG8_WAIT_V(2); PG8_BAR;
        PG8_STAGE(PG8_SB(1, 0), cB + kstep, voffB); PG8_STAGE(PG8_SA(1, 0), cA + kstep, voffA); PG8_STAGE(PG8_SB(1, 1), cB + hstep + kstep, voffB);
        PG8_WAIT_V(6); PG8_BAR;
    } else {
        PG8_STAGE(PG8_SB(0, 0), cB, voffB); PG8_STAGE(PG8_SA(0, 0), cA, voffA); PG8_STAGE(PG8_SB(0, 1), cB + hstep, voffB); PG8_STAGE(PG8_SA(0, 1), cA + hstep, voffA);
        if (wr == 1) PG8_BAR;
        PG8_WAIT_V(4); PG8_BAR;
        PG8_STAGE(PG8_SB(1, 0), cB + kstep, voffB); PG8_STAGE(PG8_SA(1, 0), cA + kstep, voffA); PG8_STAGE(PG8_SB(1, 1), cB + hstep + kstep, voffB);
        PG8_WAIT_V(6); PG8_BAR;
    }
    for (;;) {
        const bool has_next = S.next(ui + 1, nxt);
        const char* nA = has_next ? (const char*)g.A + (size_t)nxt.pm * tstep : cA; const char* nB = has_next ? (const char*)g.Bt + (size_t)nxt.pn * tstep : cB;
        if constexpr (Epi::CHAIN) { if (has_next && nxt.sel) { nA = (const char*)g.A2 + (size_t)nxt.pm * tstep; nB = (const char*)g.Bt2 + (size_t)nxt.pn * tstep; } }
        for (int t = 0; t < nt; t += 2) {
            const bool last = (t == nt - 2);
            const char* a1 = cA + (size_t)(t + 1) * kstep;
            const char* a2 = last ? nA : cA + (size_t)(t + 2) * kstep; const char* b2 = last ? nB : cB + (size_t)(t + 2) * kstep;
            const char* a3 = a2 + kstep; const char* b3 = b2 + kstep;
            if (last && has_next) S.a_ready(nxt);
            if constexpr (SP2) {
            PG8_LDB(B0, 0, 0); PG8_LDB(B1, 0, 1); PG8_SCHED; PG8_LDA(At, 0, 0); PG8_STAGE(PG8_SA(1, 1), a1 + hstep, voffA);
            PG8_WAIT_V(8); PG8_WAIT_L(0); PG8_BAR; PG8_MMA(0, 0, At, B0); PG8_MMA(0, 1, At, B1); PG8_BAR; PG8_SCHED;
            PG8_LDA(At, 0, 1); PG8_STAGE(PG8_SB(0, 0), b2, voffB); PG8_STAGE(PG8_SB(0, 1), b2 + hstep, voffB); PG8_STAGE(PG8_SA(0, 0), a2, voffA);
            PG8_WAIT_V(8); PG8_WAIT_L(0); PG8_BAR; PG8_MMA(1, 0, At, B0); PG8_MMA(1, 1, At, B1); PG8_BAR; PG8_SCHED;
            PG8_LDB(B0, 1, 0); PG8_LDB(B1, 1, 1); PG8_SCHED; PG8_LDA(At, 1, 0); PG8_STAGE(PG8_SA(0, 1), a2 + hstep, voffA);
            PG8_WAIT_V(8); PG8_WAIT_L(0); PG8_BAR; PG8_MMA(0, 0, At, B0); PG8_MMA(0, 1, At, B1); PG8_BAR; PG8_SCHED;
            PG8_LDA(At, 1, 1); PG8_STAGE(PG8_SB(1, 0), b3, voffB); PG8_STAGE(PG8_SB(1, 1), b3 + hstep, voffB); PG8_STAGE(PG8_SA(1, 0), a3, voffA);
            PG8_WAIT_V(8); PG8_WAIT_L(0); PG8_BAR; PG8_MMA(1, 0, At, B0); PG8_MMA(1, 1, At, B1); PG8_BAR; PG8_SCHED;
            } else {
            PG8_LDB(B0, 0, 0); PG8_SCHED; PG8_LDA(At, 0, 0); PG8_STAGE(PG8_SA(1, 1), a1 + hstep, voffA);
            PG8_WAIT_L(8); PG8_BAR; PG8_WAIT_L(0); PG8_MMA(0, 0, At, B0); PG8_BAR; PG8_SCHED;
            PG8_LDB(B1, 0, 1); PG8_STAGE(PG8_SB(0, 0), b2, voffB);
            PG8_BAR; PG8_WAIT_L(0); PG8_MMA(0, 1, At, B1); PG8_BAR;
            PG8_LDA(At, 0, 1); PG8_STAGE(PG8_SA(0, 0), a2, voffA);
            PG8_BAR; PG8_WAIT_L(0); PG8_MMA(1, 0, At, B0); PG8_BAR; PG8_SCHED;
            PG8_STAGE(PG8_SB(0, 1), b2 + hstep, voffB);
            PG8_WAIT_V(6); PG8_BAR; PG8_MMA(1, 1, At, B1); PG8_BAR;
            PG8_LDB(B0, 1, 0); PG8_SCHED; PG8_LDA(At, 1, 0); PG8_STAGE(PG8_SA(0, 1), a2 + hstep, voffA);
            PG8_WAIT_L(8); PG8_BAR; PG8_WAIT_L(0); PG8_MMA(0, 0, At, B0); PG8_BAR; PG8_SCHED;
            PG8_LDB(B1, 1, 1); PG8_STAGE(PG8_SB(1, 0), b3, voffB);
            PG8_BAR; PG8_WAIT_L(0); PG8_MMA(0, 1, At, B1); PG8_BAR;
            PG8_LDA(At, 1, 1); PG8_STAGE(PG8_SA(1, 0), a3, voffA);
            PG8_BAR; PG8_WAIT_L(0); PG8_MMA(1, 0, At, B0); PG8_BAR; PG8_SCHED;
            PG8_STAGE(PG8_SB(1, 1), b3 + hstep, voffB);
            PG8_WAIT_V(6); PG8_BAR; PG8_MMA(1, 1, At, B1); PG8_BAR;
            }
        }
        if constexpr (ALIGN_EPI) { if (wr == 0) PG8_BAR; }
        bool keep_acc = false;
        if constexpr (Epi::CHAIN) { if (cur.sel == 0) { E.mid(acc, cur, wr, wc, fr, fq); keep_acc = true; } else { E(acc, cur, wr, wc, fr, fq); S.done(cur); } }
        else if constexpr (!Epi::AFTER_DRAIN) { E(acc, cur, wr, wc, fr, fq); S.done(cur); }
        if (!has_next) break;
        if (!keep_acc) {
#pragma unroll
        for (int a = 0; a < 2; ++a)
#pragma unroll
            for (int b = 0; b < 2; ++b)
#pragma unroll
                for (int m = 0; m < 4; ++m)
#pragma unroll
                    for (int n = 0; n < 2; ++n) acc[a][b][m][n] = (f32x4){0.f, 0.f, 0.f, 0.f};
        }
        cur = nxt; cA = nA; cB = nB; ++ui;
        if constexpr (ALIGN_EPI) { if (wr == 1) PG8_BAR; }
    }
    PG8_WAIT_V(0);
    if constexpr (!ALIGN_EPI) { if (wr == 0) PG8_BAR; }
    PG8_BAR;
    if constexpr (Epi::AFTER_DRAIN) { E.fused(acc, cur, wr, wc, fr, fq, lds, wid, lane); S.done(cur); }
#undef PG8_SA
#undef PG8_SB
#undef PG8_STAGE
#undef PG8_LDA
#undef PG8_LDB
#undef PG8_MMA
#undef PG8_WAIT_V
#undef PG8_WAIT_L
#undef PG8_BAR
#undef PG8_SCHED
}
}
#define GAS __attribute__((address_space(1)))
#define LAS __attribute__((address_space(3)))
typedef unsigned short bf16;
typedef unsigned v4u __attribute__((ext_vector_type(4)));
typedef float f32x4 __attribute__((ext_vector_type(4)));
typedef short bf16x8 __attribute__((ext_vector_type(8)));
typedef GAS unsigned gu32;
typedef GAS unsigned long long gu64;
#define RLX_AGENT __ATOMIC_RELAXED, __HIP_MEMORY_SCOPE_AGENT
#define LDS_WAIT() asm volatile("s_waitcnt lgkmcnt(0)" ::: "memory")
#define VM_WAIT() asm volatile("s_waitcnt vmcnt(0)" ::: "memory")
__device__ __forceinline__ unsigned long long rt() { return __builtin_amdgcn_s_memrealtime(); }
__device__ __forceinline__ unsigned f2bf(float f) { unsigned u = __builtin_bit_cast(unsigned, f); return (u + 0x7fffu + ((u >> 16) & 1u)) >> 16; }
__device__ __forceinline__ unsigned pk2(float lo, float hi) { return f2bf(lo) | (f2bf(hi) << 16); }

#define XB_TMO      128
#define XB_XCNT(j)  (256  + 64 * (j))
#define XB_XSUB(j)  (1280 + 64 * (j))
#define XB_XGEN(j)  (2304 + 64 * (j))
#define XB_TOP      3328
#define XB_TOPGEN   3392
#define XCD_BAR_WORDS 3456
#define XB_SPIN_CAP (1u << 18)

__device__ __forceinline__ unsigned xb_ld(unsigned* p)              { return __hip_atomic_load(p, __ATOMIC_RELAXED, __HIP_MEMORY_SCOPE_AGENT); }
__device__ __forceinline__ unsigned xb_add(unsigned* p, unsigned v) { return __hip_atomic_fetch_add(p, v, __ATOMIC_RELAXED, __HIP_MEMORY_SCOPE_AGENT); }
__device__ __forceinline__ unsigned xb_xcc_id() { return (unsigned)__builtin_amdgcn_s_getreg((3 << 11) | 20) & 0xFu; }
#define XB_SPIN(cond, bar) do { unsigned _sp = 0; while (cond) { __builtin_amdgcn_s_sleep(1); \
    if ((++_sp & 255u) == 0u) { if (xb_ld(&(bar)[XB_TMO])) break; if (_sp > XB_SPIN_CAP) { atomicAdd(&(bar)[XB_TMO], 1u); break; } } } } while (0)

struct XcdBarrier {
    unsigned* bar; unsigned x;
    volatile LAS unsigned* st;
};

__device__ __forceinline__ XcdBarrier xcd_barrier_post(unsigned* bar, volatile LAS unsigned* st) {
    XcdBarrier b; b.bar = bar; b.x = xb_xcc_id(); b.st = st;
    if (threadIdx.x == 0) (void)xb_add(&bar[XB_XCNT(b.x)], 1u);
    return b;
}
__device__ __forceinline__ void xcd_barrier_complete(unsigned* bar, unsigned x, unsigned& nloc, unsigned& nx) {
    const unsigned G = gridDim.x * gridDim.y * gridDim.z;
    unsigned sum, cnt, mine, sp = 0u;
    for (;;) {
        sum = 0u; cnt = 0u; mine = 0u;
#pragma unroll
        for (unsigned j = 0; j < 16; ++j) { const unsigned c = xb_ld(&bar[XB_XCNT(j)]); sum += c; cnt += (c > 0u) ? 1u : 0u; mine = (j == x) ? c : mine; }
        if (sum == G) break;
        __builtin_amdgcn_s_sleep(1);
        if ((++sp & 255u) == 0u) { if (xb_ld(&bar[XB_TMO])) break; if (sp > XB_SPIN_CAP) { atomicAdd(&bar[XB_TMO], 1u); break; } }
    }
    nloc = mine > 0u ? mine : 1u; nx = cnt > 0u ? cnt : 1u;
}

__device__ __forceinline__ void xcd_barrier(const XcdBarrier& b) {
    asm volatile("s_waitcnt vmcnt(0)" ::: "memory");
    __syncthreads();
    if (threadIdx.x == 0) {
        unsigned* bar = b.bar;
        __builtin_amdgcn_s_waitcnt(0);
        unsigned nloc = b.st[0], nx = b.st[1];
        if (nloc == 0u) { xcd_barrier_complete(bar, b.x, nloc, nx); b.st[0] = nloc; b.st[1] = nx; }
        const unsigned old = xb_add(&bar[XB_XSUB(b.x)], 1u);
        const unsigned gen = old / nloc;
        if (old + 1u == (gen + 1u) * nloc) {
            __builtin_amdgcn_fence(__ATOMIC_RELEASE, "agent");
            asm volatile("s_waitcnt vmcnt(0)" ::: "memory");
            const unsigned og = xb_add(&bar[XB_TOP], 1u);
            const unsigned tg = og / nx;
            if (og + 1u == (tg + 1u) * nx) xb_add(&bar[XB_TOPGEN], 1u);
            else XB_SPIN(xb_ld(&bar[XB_TOPGEN]) == tg, bar);
            __builtin_amdgcn_fence(__ATOMIC_ACQUIRE, "agent");
            xb_add(&bar[XB_XGEN(b.x)], 1u);
            asm volatile("s_waitcnt vmcnt(0)" ::: "memory");
        } else {
            XB_SPIN(xb_ld(&bar[XB_XGEN(b.x)]) == gen, bar);
            __builtin_amdgcn_fence(__ATOMIC_ACQUIRE, "agent");
            asm volatile("s_waitcnt vmcnt(0)" ::: "memory");
        }
    }
    __syncthreads();
}
#include <hip/hip_bf16.h>
#include <cmath>
namespace attn_body {
using bf16=__hip_bfloat16;
using bf16x8=__attribute__((ext_vector_type(8)))short;
using s16x4=__attribute__((ext_vector_type(4)))short;
using f32x16=__attribute__((ext_vector_type(16)))float;
using u32x4=__attribute__((ext_vector_type(4)))unsigned;
constexpr int BATCH=4,NHEAD=8,SEQ=4096,D=64,DM=NHEAD*D;
constexpr int NW=8,QBLK=32,QB=QBLK*NW,KVBLK=64,NQB=SEQ/QB;
constexpr int ATTN_PITCH=DM, ATTN_UNIT_ROWS=QB;
__device__ __forceinline__ int crow(int r,int hi){return (r&3)+8*(r>>2)+4*hi;}
#define SBAR() __builtin_amdgcn_sched_barrier(0)
__device__ __forceinline__ void cmask(f32x16&p0,f32x16&p1,int jb,int qrel,int hi){
  const float NEG=-INFINITY; int kb=64*jb+4*hi;
  #pragma unroll
  for(int r=0;r<16;++r){int kv=kb+(r&3)+8*(r>>2); if(kv>qrel)p0[r]=NEG; if(kv+32>qrel)p1[r]=NEG;}
}

constexpr int NSLOT=3, SLOTB=8192;
constexpr int LDS_K=0, LDS_V=NSLOT*SLOTB, LDS_WS=2*NSLOT*SLOTB, LDS_OST=LDS_WS+NW*64*4, LDS_CK=LDS_OST+NW*4096, LDS_BYTES=LDS_CK+SEQ*4;
constexpr float C2=0.125f*1.4426950408889634f;
__device__ __forceinline__ void glds16(const void*gsrc,unsigned lds_dst){unsigned keep;
  asm volatile("s_mov_b32 %0, m0\n\ts_mov_b32 m0, %2\n\ts_nop 0\n\tglobal_load_lds_dwordx4 %1, off\n\ts_mov_b32 m0, %0":"=&s"(keep):"v"(gsrc),"s"(lds_dst):"memory");}
__device__ __forceinline__ float max3f(float a,float b,float c){float r;asm("v_max3_f32 %0, %1, %2, %3":"=v"(r):"v"(a),"v"(b),"v"(c));return r;}
__device__ __forceinline__ float max2f(float a,float b){float r;asm("v_max_f32_e32 %0, %1, %2":"=v"(r):"v"(a),"v"(b));return r;}
__device__ __forceinline__ float fadd_s(float a,float b){float r;asm("v_add_f32_e32 %0, %1, %2":"=v"(r):"v"(a),"v"(b));return r;}
__device__ __forceinline__ float fsub_s(float a,float b){float r;asm("v_sub_f32_e32 %0, %1, %2":"=v"(r):"v"(a),"v"(b));return r;}
typedef float f32x2_t __attribute__((ext_vector_type(2))); typedef __bf16 bf16x2_t __attribute__((ext_vector_type(2)));
__device__ __forceinline__ unsigned cvtpk_s(float lo,float hi){f32x2_t v={lo,hi};bf16x2_t b=__builtin_convertvector(v,bf16x2_t);return __builtin_bit_cast(unsigned,b);}
#define WAIT_BAR(N) asm volatile("s_waitcnt vmcnt(" #N ") lgkmcnt(0)\n\ts_barrier":::"memory")

__device__ __forceinline__ void qkt(f32x16&p0,f32x16&p1,const char*Kslot,const bf16x8*qr,int r32,int hi){
  const char*kb=Kslot+hi*1024+r32*16;
  #pragma unroll
  for(int d0=0;d0<4;++d0){
    const bf16x8 b0=*reinterpret_cast<const bf16x8*>(kb+d0*2048);
    const bf16x8 b1=*reinterpret_cast<const bf16x8*>(kb+d0*2048+512);
    p0=__builtin_amdgcn_mfma_f32_32x32x16_bf16(b0,qr[d0],p0,0,0,0);p1=__builtin_amdgcn_mfma_f32_32x32x16_bf16(b1,qr[d0],p1,0,0,0);}
}
typedef __attribute__((address_space(3))) const char* lds_cptr;
typedef short v4i16_t __attribute__((ext_vector_type(4)));
__device__ __forceinline__ void kload8(bf16x8*kf,lds_cptr kp){
  kf[0]=*(const __attribute__((address_space(3))) bf16x8*)(kp);      kf[1]=*(const __attribute__((address_space(3))) bf16x8*)(kp+512);
  kf[2]=*(const __attribute__((address_space(3))) bf16x8*)(kp+2048); kf[3]=*(const __attribute__((address_space(3))) bf16x8*)(kp+2560);
  kf[4]=*(const __attribute__((address_space(3))) bf16x8*)(kp+4096); kf[5]=*(const __attribute__((address_space(3))) bf16x8*)(kp+4608);
  kf[6]=*(const __attribute__((address_space(3))) bf16x8*)(kp+6144); kf[7]=*(const __attribute__((address_space(3))) bf16x8*)(kp+6656);
}
__device__ __forceinline__ void kload2(bf16x8*kf,lds_cptr kp,int j){ kf[2*j]=*(const __attribute__((address_space(3))) bf16x8*)(kp+j*2048); kf[2*j+1]=*(const __attribute__((address_space(3))) bf16x8*)(kp+j*2048+512); }
__device__ __forceinline__ s16x4 vtr(lds_cptr p){ return __builtin_bit_cast(s16x4,__builtin_amdgcn_ds_read_tr16_b64_v4i16((__attribute__((address_space(3))) v4i16_t*)p)); }
__device__ __forceinline__ float rowmax(const f32x16&p0,const f32x16&p1){
  float a=max3f(p0[0],p0[1],p1[0]),b=max3f(p0[2],p0[3],p1[1]);a=max3f(a,p1[2],p1[3]);
  #pragma unroll
  for(int r=4;r<16;r+=4){a=max3f(a,p0[r],p0[r+1]);b=max3f(b,p0[r+2],p0[r+3]);a=max3f(a,p1[r],p1[r+1]);b=max3f(b,p1[r+2],p1[r+3]);}
  const float m=max2f(a,b);
  auto rr=__builtin_amdgcn_permlane32_swap(__float_as_uint(m),__float_as_uint(m),false,false);
  return max2f(__uint_as_float(rr[0]),__uint_as_float(rr[1]));
}
__device__ __forceinline__ void pv(f32x16*o,int vb,bf16x8 pa0,bf16x8 pa1,bf16x8 pa2,bf16x8 pa3){
  #pragma unroll
  for(int d0=0;d0<2;++d0){s16x4 lo[4],hi[4];
    #pragma unroll
    for(int ks=0;ks<4;++ks){
      asm volatile("ds_read_b64_tr_b16 %0,%1 offset:%c2":"=&v"(lo[ks]):"v"(vb),"i"(d0*4096+ks*1024):"memory");
      asm volatile("ds_read_b64_tr_b16 %0,%1 offset:%c2":"=&v"(hi[ks]):"v"(vb),"i"(d0*4096+ks*1024+512):"memory");}
    asm volatile("s_waitcnt lgkmcnt(0)":::"memory");SBAR();
    #define PK(k) (bf16x8){lo[k][0],lo[k][1],lo[k][2],lo[k][3],hi[k][0],hi[k][1],hi[k][2],hi[k][3]}
    o[d0]=__builtin_amdgcn_mfma_f32_32x32x16_bf16(pa0,PK(0),o[d0],0,0,0);
    o[d0]=__builtin_amdgcn_mfma_f32_32x32x16_bf16(pa1,PK(1),o[d0],0,0,0);
    o[d0]=__builtin_amdgcn_mfma_f32_32x32x16_bf16(pa2,PK(2),o[d0],0,0,0);
    o[d0]=__builtin_amdgcn_mfma_f32_32x32x16_bf16(pa3,PK(3),o[d0],0,0,0);
    #undef PK
  }
}

#ifndef ATTN_STORE16
#define ATTN_STORE16(p,v) (*(u32x4*)(p)=(v))
#endif
template<int THRL> __device__ __forceinline__ void attn_unit(int b,int h,int qb,const bf16*Q,const bf16*__restrict__ K,const bf16*__restrict__ V,bf16*O,const float*__restrict__ c2,float M2,char*shm){
  int tid=threadIdx.x; asm volatile("":"+v"(tid)); const int lane=tid&63,r32=lane&31,hi=lane>>5; const int wid=__builtin_amdgcn_readfirstlane(tid>>6);
  const long rowbase=(long)b*SEQ; const int q0=qb*QB;
  const bf16*Qw=Q+(rowbase+q0+wid*QBLK)*DM+h*D;
  const bf16*Kh0=K+rowbase*DM+h*D,*Vh0=V+rowbase*DM+h*D;
  const unsigned lds0=(unsigned)(uintptr_t)shm;
  float*wsf=(float*)(shm+LDS_WS)+wid*64;
  const unsigned kdst=lds0+LDS_K+wid*1024, vdst=lds0+LDS_V+wid*1024;
  #define DMA_K(t,slot) glds16(ksrc+(long)(t)*KVBLK*DM,(unsigned)__builtin_amdgcn_readfirstlane(kdst+(slot)))
  #define DMA_V(t,slot) glds16(vsrc+(long)(t)*KVBLK*DM,(unsigned)__builtin_amdgcn_readfirstlane(vdst+(slot)))
  const int vb0=(int)(lds0+LDS_V)+((lane>>4)&1)*32+(lane&3)*8+(4*hi+((lane&15)>>2))*64;
  const char*Kbase=shm+LDS_K; bf16x8 kf[8];
  const lds_cptr shm3=(lds_cptr)shm; const lds_cptr kp0=shm3+LDS_K+hi*1024+r32*16; const lds_cptr vp0=shm3+LDS_V+((lane>>4)&1)*32+(lane&3)*8+(4*hi+((lane&15)>>2))*64;
  const int NT0=(q0+QB)/KVBLK;
  int ts; { const int tl=lane; const float cqa=c2[q0]; const float ckb=(tl<NT0-4)?c2[64*tl+63]:cqa; const unsigned long long bm=__ballot((tl<NT0-4)&&(cqa-ckb< -(24.f+2.f*M2))); ts=__builtin_popcountll(bm)&~1; }
  ts=__builtin_amdgcn_readfirstlane(ts);
  const int NT=NT0-ts;
  const bf16*Kh=Kh0+(long)ts*KVBLK*DM,*Vh=Vh0+(long)ts*KVBLK*DM;
  const bf16*ksrc=Kh+(long)lane*DM+wid*8;
  const bf16*vsrc=Vh+(long)(16*(wid&3)+(lane>>2))*DM+(wid>>2)*32+(lane&3)*8;
  typedef float f32x4_t __attribute__((ext_vector_type(4)));
  int tidl=tid; asm volatile("":"+v"(tidl));
  const int nck4=(q0+QB)/4; f32x4_t ckv0=f32x4_t{},ckv1=f32x4_t{}; if(tidl<nck4)ckv0=((const f32x4_t*)c2)[tidl]; if(tidl+512<nck4)ckv1=((const f32x4_t*)c2)[tidl+512];
  const float cq=c2[q0+wid*QBLK+r32]-M2;
  DMA_K(0,0);DMA_V(0,0);DMA_K(1,SLOTB);
  bf16x8 qr[4];
  #pragma unroll
  for(int d0=0;d0<4;++d0)qr[d0]=*reinterpret_cast<const bf16x8*>(&Qw[(long)r32*DM+d0*16+hi*8]);
  float l_reg=0.f;f32x16 o[2];o[0]=f32x16{};o[1]=f32x16{};
  { __attribute__((address_space(3))) f32x4_t*ckl=(__attribute__((address_space(3))) f32x4_t*)((lds_cptr)shm+LDS_CK); if(tidl<nck4)ckl[tidl]=ckv0; if(tidl+512<nck4)ckl[tidl+512]=ckv1; }
  const __attribute__((address_space(3))) f32x4_t*ckp=(const __attribute__((address_space(3))) f32x4_t*)((lds_cptr)shm+LDS_CK)+hi+ts*16;
  #define CKLD(P0,P1,t) do{ _Pragma("unroll") for(int g_=0;g_<4;++g_){ const f32x4_t a_=ckp[(t)*16+2*g_], b_=ckp[(t)*16+8+2*g_]; P0[4*g_]=a_[0];P0[4*g_+1]=a_[1];P0[4*g_+2]=a_[2];P0[4*g_+3]=a_[3]; P1[4*g_]=b_[0];P1[4*g_+1]=b_[1];P1[4*g_+2]=b_[2];P1[4*g_+3]=b_[3]; } }while(0)
  #define CKSUB(P0,P1) do{ _Pragma("unroll") for(int r=0;r<16;++r){P0[r]=cq-P0[r];P1[r]=cq-P1[r];} }while(0)
  const int qrel=wid*QBLK+r32;
  #define CMASK(P0,P1,t) do{int jb_=(t)-(NT-4); if(jb_>=0)cmask(P0,P1,jb_,qrel,hi);}while(0)
  #define START(P0,P1) do{ _Pragma("unroll") for(int r=0;r<16;++r)P0[r]=__builtin_amdgcn_exp2f(P0[r]); }while(0)
  #define RESC() do{}while(0)
  f32x16 pA0,pA1,pB0,pB1;
  int sl_prev=0,sl_cur=0,sl_next=SLOTB;
  #define ROT() do{sl_prev=sl_cur;sl_cur=sl_next;sl_next=(sl_next==(NSLOT-1)*SLOTB)?0:sl_next+SLOTB;}while(0)
  DMA_K(2,2*SLOTB);
  WAIT_BAR(3);
  CKLD(pA0,pA1,0);CKSUB(pA0,pA1);
  qkt(pA0,pA1,Kbase,qr,r32,hi);asm volatile("s_nop 15\n\ts_nop 7":"+v"(pA0),"+v"(pA1));CMASK(pA0,pA1,0);
  CKLD(pB0,pB1,1);CKSUB(pB0,pB1);
  START(pA0,pA1);
  _Pragma("unroll") for(int r=0;r<16;++r)pA1[r]=__builtin_amdgcn_exp2f(pA1[r]);
  WAIT_BAR(0);
  DMA_K(3,0);DMA_V(1,SLOTB);
  ROT();
  kload8(kf,kp0+sl_cur);
  WAIT_BAR(2);
  s16x4 vlo[8],vhi[8]; u32x4 pw0,pw1,pw2,pw3;
  #define PKW(P,B) cvtpk_s(P[B],P[B+1])
  #define PAF(k) __builtin_bit_cast(bf16x8,pw##k)
  #define VFR(i) (bf16x8){vlo[i][0],vlo[i][1],vlo[i][2],vlo[i][3],vhi[i][0],vhi[i][1],vhi[i][2],vhi[i][3]}
  #define PIN(x) asm volatile("":"+v"(x))
  #define MX3(a,b,c) __builtin_fmaxf(__builtin_fmaxf((a),(b)),(c))
  #define GAPA(MF,A0,A1,A2,A3,W0,W1,PW) do{ MF; sacc+=A0; sacc+=A1; sacc+=A2; sacc+=A3; PIN(sacc); W0; W1; PIN(PW); SBAR(); }while(0)
  #define EX(v) __builtin_amdgcn_exp2f(v)
  #define GAPB(MF,X,B) do{ MF; X[B]=EX(X[B]); X[B+1]=EX(X[B+1]); X[B+2]=EX(X[B+2]); X[B+3]=EX(X[B+3]); PIN(X); SBAR(); }while(0)
  #define VRD(i) do{ vlo[i]=vtr(vp_+(((i)>>2)*4096+((i)&3)*1024)); vhi[i]=vtr(vp_+(((i)>>2)*4096+((i)&3)*1024+512)); }while(0)
  #define KRD(G,j) do{ if(G){ kload2(kf,kp0+sl_next,j); SBAR(); } }while(0)
  #define STEP(C0,C1,P0,P1,t,GK,GV,GL) do{ SBAR(); \
    const lds_cptr vp_=vp0+sl_prev; \
    VRD(0); SBAR(); float sacc=(P0[0]+P0[1]); \
    GAPA(C0=__builtin_amdgcn_mfma_f32_32x32x16_bf16(kf[0],qr[0],C0,0,0,0), P0[2],P0[3],P0[4],P0[5],     pw0[0]=PKW(P0,0), pw0[1]=PKW(P0,2), pw0); \
    VRD(4); SBAR(); GAPA(C1=__builtin_amdgcn_mfma_f32_32x32x16_bf16(kf[1],qr[0],C1,0,0,0), P0[6],P0[7],P0[8],P0[9],     pw0[2]=PKW(P0,4), pw0[3]=PKW(P0,6), pw0); \
    VRD(1); SBAR(); GAPA(C0=__builtin_amdgcn_mfma_f32_32x32x16_bf16(kf[2],qr[1],C0,0,0,0),   P0[10],P0[11],P0[12],P0[13], pw1[0]=PKW(P0,8), pw1[1]=PKW(P0,10), pw1); \
    VRD(5); SBAR(); GAPA(C1=__builtin_amdgcn_mfma_f32_32x32x16_bf16(kf[3],qr[1],C1,0,0,0),   P0[14],P0[15],P1[0],P1[1],   pw1[2]=PKW(P0,12),pw1[3]=PKW(P0,14), pw1); \
    VRD(2); SBAR(); GAPA(C0=__builtin_amdgcn_mfma_f32_32x32x16_bf16(kf[4],qr[2],C0,0,0,0),   P1[2],P1[3],P1[4],P1[5],     pw2[0]=PKW(P1,0), pw2[1]=PKW(P1,2), pw2); \
    VRD(6); SBAR(); GAPA(C1=__builtin_amdgcn_mfma_f32_32x32x16_bf16(kf[5],qr[2],C1,0,0,0),   P1[6],P1[7],P1[8],P1[9],     pw2[2]=PKW(P1,4), pw2[3]=PKW(P1,6), pw2); \
    VRD(3); SBAR(); GAPA(C0=__builtin_amdgcn_mfma_f32_32x32x16_bf16(kf[6],qr[3],C0,0,0,0),   P1[10],P1[11],P1[12],P1[13], pw3[0]=PKW(P1,8), pw3[1]=PKW(P1,10), pw3); \
    VRD(7); SBAR(); GAPA(C1=__builtin_amdgcn_mfma_f32_32x32x16_bf16(kf[7],qr[3],C1,0,0,0),   P1[14],P1[15],0.f,0.f,       pw3[2]=PKW(P1,12),pw3[3]=PKW(P1,14), pw3); \
    l_reg+=sacc; \
    if(GK){DMA_K((t)+3,sl_cur);} if(GV){DMA_V((t)+1,sl_next);} \
    CMASK(C0,C1,t); \
    SBAR(); \
    GAPB(o[0]=__builtin_amdgcn_mfma_f32_32x32x16_bf16(PAF(0),VFR(0),o[0],0,0,0), C0,0); \
    GAPB(o[1]=__builtin_amdgcn_mfma_f32_32x32x16_bf16(PAF(0),VFR(4),o[1],0,0,0), C0,4); \
    KRD(GL,0); GAPB(o[0]=__builtin_amdgcn_mfma_f32_32x32x16_bf16(PAF(1),VFR(1),o[0],0,0,0), C0,8); \
    KRD(GL,1); GAPB(o[1]=__builtin_amdgcn_mfma_f32_32x32x16_bf16(PAF(1),VFR(5),o[1],0,0,0), C0,12); \
    KRD(GL,2); GAPB(o[0]=__builtin_amdgcn_mfma_f32_32x32x16_bf16(PAF(2),VFR(2),o[0],0,0,0), C1,0); \
    KRD(GL,3); GAPB(o[1]=__builtin_amdgcn_mfma_f32_32x32x16_bf16(PAF(2),VFR(6),o[1],0,0,0), C1,4); \
    GAPB(o[0]=__builtin_amdgcn_mfma_f32_32x32x16_bf16(PAF(3),VFR(3),o[0],0,0,0), C1,8); \
    GAPB(o[1]=__builtin_amdgcn_mfma_f32_32x32x16_bf16(PAF(3),VFR(7),o[1],0,0,0), C1,12); \
    if(GL){ CKLD(P0,P1,(t)+1); CKSUB(P0,P1); } \
    }while(0)
  int t=1;
  #undef CMASK
  #define CMASK(P0,P1,t) do{}while(0)
  for(;t+5<NT;t+=2){
    STEP(pB0,pB1,pA0,pA1,t,true,true,true);     WAIT_BAR(2); RESC(); ROT();
    STEP(pA0,pA1,pB0,pB1,t+1,true,true,true);   WAIT_BAR(2); RESC(); ROT();
  }
  #undef CMASK
  #define CMASK(P0,P1,t) do{int jb_=(t)-(NT-4); if(jb_>=0)cmask(P0,P1,jb_,qrel,hi);}while(0)
  #define ENDW(tt) do{ if((tt)+3<NT){WAIT_BAR(2);} else if((tt)+2<NT){WAIT_BAR(1);} else {WAIT_BAR(0);} }while(0)
  for(;t+1<NT;t+=2){
    STEP(pB0,pB1,pA0,pA1,t,(t+3<NT),(t+1<NT),(t+1<NT));       ENDW(t);   RESC(); ROT();
    STEP(pA0,pA1,pB0,pB1,t+1,(t+4<NT),(t+2<NT),(t+2<NT));     ENDW(t+1); RESC(); ROT();
  }
  STEP(pB0,pB1,pA0,pA1,NT-1,false,false,false); RESC();
  { float sacc=pB0[0]+pB0[1]; _Pragma("unroll") for(int r=2;r<16;++r)sacc+=pB0[r]; _Pragma("unroll") for(int r=0;r<16;++r)sacc+=pB1[r]; l_reg+=sacc;
    pw0=(u32x4){PKW(pB0,0),PKW(pB0,2),PKW(pB0,4),PKW(pB0,6)};pw1=(u32x4){PKW(pB0,8),PKW(pB0,10),PKW(pB0,12),PKW(pB0,14)};pw2=(u32x4){PKW(pB1,0),PKW(pB1,2),PKW(pB1,4),PKW(pB1,6)};pw3=(u32x4){PKW(pB1,8),PKW(pB1,10),PKW(pB1,12),PKW(pB1,14)};
    SBAR(); pv(o,vb0+sl_cur,PAF(0),PAF(1),PAF(2),PAF(3)); }
  #undef PKW
  #undef PAF
  #undef VFR
  #undef PIN
  #undef MX3
  #undef GAPA
  #undef GAPB
  #undef EX
  #undef VRD
  #undef KRD
  #undef STEP
  #undef ENDW
  {auto rr=__builtin_amdgcn_permlane32_swap(__float_as_uint(l_reg),__float_as_uint(l_reg),false,false);l_reg=__uint_as_float(rr[0])+__uint_as_float(rr[1]);}
  if(hi==0)wsf[32+r32]=l_reg;asm volatile("s_waitcnt lgkmcnt(0)":::"memory");
  float rli[16];
  #pragma unroll
  for(int r=0;r<16;++r)rli[r]=__builtin_amdgcn_rcpf(wsf[32+crow(r,hi)]);
  bf16*Ow=O+(rowbase+q0+wid*QBLK)*DM+h*D;
  { bf16*stg=(bf16*)(shm+LDS_OST)+wid*2048;
    #pragma unroll
    for(int r=0;r<16;++r){const int orow=crow(r,hi);
      #pragma unroll
      for(int d0=0;d0<2;++d0)stg[orow*64+d0*32+r32]=__float2bfloat16(o[d0][r]*rli[r]);}
    asm volatile("s_waitcnt lgkmcnt(0)":::"memory");
    #pragma unroll
    for(int i=0;i<4;++i){const int row=i*8+(lane>>3),ch=lane&7; const u32x4 v=*(const u32x4*)(stg+row*64+ch*8); ATTN_STORE16(Ow+(long)row*DM+ch*8,v);} }
  asm volatile("s_waitcnt lgkmcnt(0)\n\ts_barrier":::"memory");
  #undef DMA_K
  #undef DMA_V
  #undef CMASK
  #undef START
  #undef RESC
  #undef ROT
  #undef CKLD
  #undef CKSUB
}
constexpr int ATTN_LDS_BYTES=LDS_BYTES;
struct AttnTensors { const bf16* Q; const bf16* K; const bf16* V; bf16* O; const float* C2T; float M2; };
struct AttnUnit { int bh; int qb; };
struct StaticOrder {
  int vcu, G;
  __device__ __forceinline__ explicit StaticOrder(int grid,int v):vcu(v),G(grid){}
  __device__ __forceinline__ bool next(int i,AttnUnit&u)const{ const int L=i*G+vcu; if(L>=BATCH*NHEAD*NQB)return false; const int r=L>>8, idx=L&255, k=idx&7; u.bh=idx>>3; u.qb=(r==0)?(NQB-1-k):k; return true; }
  __device__ __forceinline__ void a_ready(const AttnUnit&)const{}
  __device__ __forceinline__ void done(const AttnUnit&)const{}
};
struct QueueOrder {
  unsigned* cnt; volatile __attribute__((address_space(3))) unsigned* slot;
  __device__ __forceinline__ bool next(int,AttnUnit&u)const{
    if(threadIdx.x==0){ *slot=__hip_atomic_fetch_add(cnt,1u,__ATOMIC_RELAXED,__HIP_MEMORY_SCOPE_AGENT); }
    __syncthreads(); const unsigned L=*slot; __syncthreads();
    if(L>=(unsigned)(BATCH*NHEAD*NQB))return false;
    u.qb=NQB-1-(int)(L>>5); u.bh=(int)(L&31); return true; }
  __device__ __forceinline__ void a_ready(const AttnUnit&)const{}
  __device__ __forceinline__ void done(const AttnUnit&)const{}
};
template<class Sched,int THRL=8> __device__ __forceinline__ void attn_phase(char*lds,const AttnTensors&T,const Sched&S){
  AttnUnit u;
  for(int i=0;S.next(i,u);++i){ S.a_ready(u); attn_unit<THRL>(u.bh/NHEAD,u.bh%NHEAD,u.qb,T.Q,T.K,T.V,T.O,T.C2T+(size_t)u.bh*SEQ,T.M2,lds); S.done(u); }
}
#undef SBAR
#undef WAIT_BAR
}

constexpr int NWAVES = 8, NTHR = 512;
constexpr int DM = 1024, NB = 4, SEQ = 4096, DB = 128, DSEQ = 8, PAST = 2048, PAGE = 128, NPAGES = 16;
constexpr int MP = NB * SEQ, MS = DB * DSEQ, M = MP + MS;
constexpr int DP = 512, DA = 512, NH = 8, HD = 64, DIN = 4104, NPROJ = 4096;
constexpr int NKEYS = 128, NEXP = 16384, PH = 8, TOPK = 16, DKH = 128, DQ = 2048;
constexpr float EPS = 1e-6f;
constexpr float LOG2E = 1.4426950408889634f;
constexpr float C2 = 0.125f * LOG2E;
constexpr size_t O_YP = 0, O_YS = O_YP + (size_t)MP * DM, O_KP = O_YS + (size_t)MS * DM, O_VP = O_KP + (size_t)MP * DA, O_LFP = O_VP + (size_t)MP * DA,
                 O_PP = O_LFP + (size_t)MP * NH, O_KS = O_PP + (size_t)NB * 15 * DP, O_VS = O_KS + (size_t)MS * DA, O_LFS = O_VS + (size_t)MS * DA,
                 O_PS = O_LFS + (size_t)MS * NH, O_END = O_PS + (size_t)DB * 15 * DP;
constexpr size_t MiB = 1u << 20;
constexpr size_t WS_CTL = 0, CTL_ZERO_BYTES = 64 * 1024;
constexpr size_t WS_WIN = 2 * MiB, WS_WBP = 10 * MiB, WS_WBA = 11 * MiB, WS_WOUT = 12 * MiB, WS_WQ = 14 * MiB, WS_SUBK = 18 * MiB, WS_CP2 = 19 * MiB, WS_RSS = 20 * MiB, WS_US = 22 * MiB, WS_VS = 23 * MiB;
constexpr size_t WS_PU = 32 * MiB, WS_PV = 64 * MiB, WS_XN = 96 * MiB  , WS_U = 132 * MiB, WS_Q = 150 * MiB, WS_K = 168 * MiB, WS_V = 186 * MiB,
                 WS_GA = 204 * MiB, WS_GB = 240 * MiB, WS_PO = 276 * MiB, WS_AO = 294 * MiB, WS_T = 312 * MiB, WS_MIX = 348 * MiB, WS_PQ = 384 * MiB,
                 WS_SI = 456 * MiB, WS_SG = 466 * MiB, WS_H = 476 * MiB, WS_END = 548 * MiB;
constexpr int CW_BAR = 4096;
constexpr int LDS_BYTES = 163840;
constexpr int SCR_BYTES = 159 * 1024;
constexpr int MISC_OFF = SCR_BYTES;

typedef unsigned short bf16;
typedef unsigned v4u __attribute__((ext_vector_type(4)));
typedef unsigned v2u __attribute__((ext_vector_type(2)));
typedef float f32x4 __attribute__((ext_vector_type(4)));
typedef float f32x2 __attribute__((ext_vector_type(2)));

__device__ __forceinline__ float bf2f(unsigned short b) { return __uint_as_float((unsigned)b << 16); }
__device__ __forceinline__ float bflo(unsigned w) { return __uint_as_float(w << 16); }
__device__ __forceinline__ float bfhi(unsigned w) { return __uint_as_float(w & 0xffff0000u); }
typedef __bf16 bf16x2_t __attribute__((ext_vector_type(2)));
__device__ __forceinline__ unsigned pkbf(float lo, float hi) { f32x2 v = {lo, hi}; bf16x2_t b = __builtin_convertvector(v, bf16x2_t); return __builtin_bit_cast(unsigned, b); }
__device__ __forceinline__ float wave_sum(float v) {
#pragma unroll
    for (int o = 1; o < 64; o <<= 1) v += __shfl_xor(v, o);
    return v;
}
__device__ __forceinline__ float wave_max(float v) {
#pragma unroll
    for (int o = 1; o < 64; o <<= 1) v = fmaxf(v, __shfl_xor(v, o));
    return v;
}

struct Args {
    const float* x_p; const float* x_s; const float* cache_k; const float* cache_v; const float* cache_lf; const float* state_pool; const int* page_table;
    const float* norm_mix_g; const float* w_in; const float* b_forget; const float* q_norm_g; const float* k_norm_g; const float* pool_mix_w; const float* pool_scale;
    const float* w_bp; const float* w_ba; const float* w_out; const float* norm_ffn_g; const float* w_query; const float* sub_keys; const float* peer_u; const float* peer_v;
    float* out; unsigned char* ws; int ph_lo, ph_hi, li, pad;
};

using pg8::Unit;
struct EpiInProj {
    static constexpr bool PERM = true, AFTER_DRAIN = false, CHAIN = false;
    bf16 *U, *Q, *K, *V, *GA, *GB; float* out; const float *gq, *gk; int pn_off;
    __device__ __forceinline__ void operator()(const f32x4 (&acc)[2][2][4][2], const Unit& u, int wr, int wc, int fr, int fq) const {
        const int pn = u.pn + pn_off; const int row0 = u.pm * 256 + wr * 64 + fr; const bool prompt = u.pm < (MP / 256);
        if (pn < 2) {
#pragma unroll
            for (int ai = 0; ai < 2; ++ai)
#pragma unroll
                for (int m = 0; m < 4; ++m) { const int row = row0 + ai * 128 + m * 16;
                    float* tail = nullptr;
                    if (prompt) { const int s = row & (SEQ - 1), b = row >> 12; if (s >= SEQ - 15) tail = out + O_PP + (size_t)(b * 15 + (s - (SEQ - 15))) * DP; }
                    else { const int rs = row - MP; tail = out + O_PS + (size_t)((rs >> 3) * 15 + 7 + (rs & 7)) * DP; }
#pragma unroll
                    for (int bj = 0; bj < 2; ++bj) { const int col = pn * 256 + bj * 128 + wc * 32 + 8 * fq; const f32x4 v0 = acc[ai][bj][m][0], v1 = acc[ai][bj][m][1];
                        v4u w; w.x = pkbf(v0[0], v0[1]); w.y = pkbf(v0[2], v0[3]); w.z = pkbf(v1[0], v1[1]); w.w = pkbf(v1[2], v1[3]);
                        *(v4u*)(U + (size_t)row * DP + col) = w;
                        if (tail) { *(f32x4*)(tail + col) = v0; *(f32x4*)(tail + col + 4) = v1; } } }
        } else if (pn < 6) {
            const bool isq = pn < 4; const int head = 4 * (pn & 1) + wc; const float* g = isq ? gq : gk;
            f32x4 gv[2][2];
#pragma unroll
            for (int bj = 0; bj < 2; ++bj)
#pragma unroll
                for (int n = 0; n < 2; ++n) gv[bj][n] = *(const f32x4*)(g + 32 * bj + 8 * fq + 4 * n);
            bf16* dst = isq ? Q : K;
#pragma unroll
            for (int ai = 0; ai < 2; ++ai)
#pragma unroll
                for (int m = 0; m < 4; ++m) { const int row = row0 + ai * 128 + m * 16; float ss = 0.f;
#pragma unroll
                    for (int bj = 0; bj < 2; ++bj)
#pragma unroll
                        for (int n = 0; n < 2; ++n) { const f32x4 x = acc[ai][bj][m][n]; ss += (x[0] * x[0] + x[1] * x[1]) + (x[2] * x[2] + x[3] * x[3]); }
                    ss += __shfl_xor(ss, 16); ss += __shfl_xor(ss, 32);
                    float r = 1.0f / sqrtf(ss * (1.0f / 64.0f) + EPS);
                    float* kout = isq ? nullptr : (prompt ? out + O_KP + (size_t)row * DA : out + O_KS + (size_t)(row - MP) * DA);
                    const float rq = isq ? r * C2 : r;
#pragma unroll
                    for (int bj = 0; bj < 2; ++bj) { const int col = head * 64 + 32 * bj + 8 * fq; const f32x4 v0 = acc[ai][bj][m][0] * gv[bj][0] * rq, v1 = acc[ai][bj][m][1] * gv[bj][1] * rq;
                        v4u w; w.x = pkbf(v0[0], v0[1]); w.y = pkbf(v0[2], v0[3]); w.z = pkbf(v1[0], v1[1]); w.w = pkbf(v1[2], v1[3]);
                        *(v4u*)(dst + (size_t)row * DA + col) = w;
                        if (!isq) { __builtin_nontemporal_store(v0, (f32x4*)(kout + col)); __builtin_nontemporal_store(v1, (f32x4*)(kout + col + 4)); } } }
        } else if (pn < 8) {
#pragma unroll
            for (int ai = 0; ai < 2; ++ai)
#pragma unroll
                for (int m = 0; m < 4; ++m) { const int row = row0 + ai * 128 + m * 16;
                    float* vout = prompt ? out + O_VP + (size_t)row * DA : out + O_VS + (size_t)(row - MP) * DA;
#pragma unroll
                    for (int bj = 0; bj < 2; ++bj) { const int col = (pn - 6) * 256 + bj * 128 + wc * 32 + 8 * fq; const f32x4 v0 = acc[ai][bj][m][0], v1 = acc[ai][bj][m][1];
                        v4u w; w.x = pkbf(v0[0], v0[1]); w.y = pkbf(v0[2], v0[3]); w.z = pkbf(v1[0], v1[1]); w.w = pkbf(v1[2], v1[3]);
                        *(v4u*)(V + (size_t)row * DA + col) = w; __builtin_nontemporal_store(v0, (f32x4*)(vout + col)); __builtin_nontemporal_store(v1, (f32x4*)(vout + col + 4)); } }
        } else {
            bf16* dst = pn < 12 ? GA : GB; const int ct = (pn < 12 ? pn - 8 : pn - 12) * 256;
#pragma unroll
            for (int ai = 0; ai < 2; ++ai)
#pragma unroll
                for (int m = 0; m < 4; ++m) { const int row = row0 + ai * 128 + m * 16;
#pragma unroll
                    for (int bj = 0; bj < 2; ++bj) { const int col = ct + bj * 128 + wc * 32 + 8 * fq; float s[8];
#pragma unroll
                        for (int n = 0; n < 2; ++n)
#pragma unroll
                            for (int i = 0; i < 4; ++i) s[4 * n + i] = __builtin_amdgcn_rcpf(1.0f + __builtin_amdgcn_exp2f(-LOG2E * acc[ai][bj][m][n][i]));
                        v4u w; w.x = pkbf(s[0], s[1]); w.y = pkbf(s[2], s[3]); w.z = pkbf(s[4], s[5]); w.w = pkbf(s[6], s[7]);
                        *(v4u*)(dst + (size_t)row * DM + col) = w; } }
        }
    }
};
template <int MODE> struct EpiGate {
    static constexpr bool PERM = true, AFTER_DRAIN = false, CHAIN = false;
    const bf16* G; const bf16* Tin; bf16* O;
    __device__ __forceinline__ void operator()(const f32x4 (&acc)[2][2][4][2], const Unit& u, int wr, int wc, int fr, int fq) const {
        const int row0 = u.pm * 256 + wr * 64 + fr;
#pragma unroll
        for (int ai = 0; ai < 2; ++ai)
#pragma unroll
            for (int m = 0; m < 4; ++m) { const int row = row0 + ai * 128 + m * 16;
#pragma unroll
                for (int bj = 0; bj < 2; ++bj) { const size_t off = (size_t)row * DM + u.pn * 256 + bj * 128 + wc * 32 + 8 * fq;
                    const v4u g = *(const v4u*)(G + off); const f32x4 v0 = acc[ai][bj][m][0], v1 = acc[ai][bj][m][1];
                    float r[8] = {v0[0] * bflo(g.x), v0[1] * bfhi(g.x), v0[2] * bflo(g.y), v0[3] * bfhi(g.y), v1[0] * bflo(g.z), v1[1] * bfhi(g.z), v1[2] * bflo(g.w), v1[3] * bfhi(g.w)};
                    if (MODE == 1) { const v4u t = *(const v4u*)(Tin + off);
                        r[0] += bflo(t.x); r[1] += bfhi(t.x); r[2] += bflo(t.y); r[3] += bfhi(t.y); r[4] += bflo(t.z); r[5] += bfhi(t.z); r[6] += bflo(t.w); r[7] += bfhi(t.w); }
                    v4u w; w.x = pkbf(r[0], r[1]); w.y = pkbf(r[2], r[3]); w.z = pkbf(r[4], r[5]); w.w = pkbf(r[6], r[7]);
                    *(v4u*)(O + off) = w; } }
    }
};
struct EpiMerge {
    static constexpr bool PERM = true, AFTER_DRAIN = false, CHAIN = true;
    const bf16* GA; const bf16* GB; bf16* O;
    __device__ __forceinline__ void mid(f32x4 (&acc)[2][2][4][2], const Unit& u, int wr, int wc, int fr, int fq) const {
        const int row0 = u.pm * 256 + wr * 64 + fr;
#pragma unroll
        for (int ai = 0; ai < 2; ++ai)
#pragma unroll
            for (int m = 0; m < 4; ++m) { const int row = row0 + ai * 128 + m * 16;
#pragma unroll
                for (int bj = 0; bj < 2; ++bj) { const size_t off = (size_t)row * DM + u.pn * 256 + bj * 128 + wc * 32 + 8 * fq;
                    const v4u ga = *(const v4u*)(GA + off), gb = *(const v4u*)(GB + off);
                    const unsigned gaw[4] = {ga.x, ga.y, ga.z, ga.w}, gbw[4] = {gb.x, gb.y, gb.z, gb.w};
#pragma unroll
                    for (int k = 0; k < 4; ++k) { const float r0 = bflo(gaw[k]) * __builtin_amdgcn_rcpf(fmaxf(bflo(gbw[k]), 0x1p-60f)), r1 = bfhi(gaw[k]) * __builtin_amdgcn_rcpf(fmaxf(bfhi(gbw[k]), 0x1p-60f));
                        acc[ai][bj][m][k >> 1][2 * (k & 1)] *= r0; acc[ai][bj][m][k >> 1][2 * (k & 1) + 1] *= r1; } } }
    }
    __device__ __forceinline__ void operator()(const f32x4 (&acc)[2][2][4][2], const Unit& u, int wr, int wc, int fr, int fq) const {
        const int row0 = u.pm * 256 + wr * 64 + fr;
#pragma unroll
        for (int ai = 0; ai < 2; ++ai)
#pragma unroll
            for (int m = 0; m < 4; ++m) { const int row = row0 + ai * 128 + m * 16;
#pragma unroll
                for (int bj = 0; bj < 2; ++bj) { const size_t off = (size_t)row * DM + u.pn * 256 + bj * 128 + wc * 32 + 8 * fq;
                    const v4u gb = *(const v4u*)(GB + off); const unsigned gbw[4] = {gb.x, gb.y, gb.z, gb.w}; unsigned ow[4];
#pragma unroll
                    for (int k = 0; k < 4; ++k) ow[k] = pkbf(acc[ai][bj][m][k >> 1][2 * (k & 1)] * fmaxf(bflo(gbw[k]), 0x1p-60f), acc[ai][bj][m][k >> 1][2 * (k & 1) + 1] * fmaxf(bfhi(gbw[k]), 0x1p-60f));
                    *(v4u*)(O + off) = (v4u){ow[0], ow[1], ow[2], ow[3]}; } }
    }
};
struct EpiOut {
    static constexpr bool PERM = true, AFTER_DRAIN = false, CHAIN = false;
    const float* xp; const float* xs; float* H; bf16* HG; const float* gf; float* RSS;
    __device__ __forceinline__ void operator()(const f32x4 (&acc)[2][2][4][2], const Unit& u, int wr, int wc, int fr, int fq) const {
        const int row0 = u.pm * 256 + wr * 64 + fr; const bool prompt = u.pm < (MP / 256);
#pragma unroll
        for (int ai = 0; ai < 2; ++ai)
#pragma unroll
            for (int m = 0; m < 4; ++m) { const int row = row0 + ai * 128 + m * 16; float ss = 0.f;
                const float* xr = prompt ? xp + (size_t)row * DM : xs + (size_t)(row - MP) * DM;
#pragma unroll
                for (int bj = 0; bj < 2; ++bj) { const int col = u.pn * 256 + bj * 128 + wc * 32 + 8 * fq;
                    const f32x4 h0 = acc[ai][bj][m][0] + *(const f32x4*)(xr + col), h1 = acc[ai][bj][m][1] + *(const f32x4*)(xr + col + 4);
                    ss += (h0[0] * h0[0] + h0[1] * h0[1]) + (h0[2] * h0[2] + h0[3] * h0[3]) + (h1[0] * h1[0] + h1[1] * h1[1]) + (h1[2] * h1[2] + h1[3] * h1[3]);
                    v4u w; w.x = pkbf(h0[0], h0[1]); w.y = pkbf(h0[2], h0[3]); w.z = pkbf(h1[0], h1[1]); w.w = pkbf(h1[2], h1[3]);
                    *(v4u*)(HG + (size_t)row * DM + col) = w; }
                ss += __shfl_xor(ss, 16); ss += __shfl_xor(ss, 32);
                if (fq == 0) RSS[(size_t)row * 16 + u.pn * 4 + wc] = ss; }
    }
};

struct Frame {
    LAS unsigned char* lds; volatile LAS unsigned* MISC; gu32* ctl;
    int tid, lane, wave, vcu, G;
};

__device__ __forceinline__ void transpose_item(const float* W, int ldw, int K, bf16* WT, int src_col0, int dst_row0, int k0, LAS float* scr, int lane, const float* kscale = nullptr) {
#pragma unroll 8
    for (int i = 0; i < 32; ++i) { const int kk = 2 * i + (lane >> 5); const float wv = W[(size_t)(k0 + kk) * ldw + src_col0 + (lane & 31)]; scr[kk * 33 + (lane & 31)] = kscale ? wv * kscale[k0 + kk] : wv; }
    LDS_WAIT(); asm volatile("" ::: "memory");
    const int c = lane & 7;
#pragma unroll
    for (int j = 0; j < 4; ++j) { const int n = (lane >> 3) + 8 * j; const LAS float* s = scr + (8 * c) * 33 + n;
        v4u o; o.x = pkbf(s[0 * 33], s[1 * 33]); o.y = pkbf(s[2 * 33], s[3 * 33]); o.z = pkbf(s[4 * 33], s[5 * 33]); o.w = pkbf(s[6 * 33], s[7 * 33]);
        *(v4u*)(WT + (size_t)(dst_row0 + n) * K + k0 + 8 * c) = o; }
    LDS_WAIT(); asm volatile("" ::: "memory");
}
__device__ __forceinline__ int win_src_col(int db) {
    if (db < 16) return 32 * db;
    if (db < 48) { const int base = db < 32 ? 512 : 1024; const int local = (db - 16) & 15, tile = local >> 3, blk = local & 7, bj = blk >> 2, w = blk & 3; return base + tile * 256 + 64 * w + 32 * bj; }
    if (db < 64) return 1536 + 32 * (db - 48);
    if (db < 96) return 2056 + 32 * (db - 64);
    return 3080 + 32 * (db - 96);
}
__device__ __forceinline__ void cvt_rows_bf16(const float* src, bf16* dst, size_t n8, size_t gtid, size_t gn) {
    for (size_t i = gtid; i < n8; i += gn) { const f32x4 a = *(const f32x4*)(src + 8 * i), b = *(const f32x4*)(src + 8 * i + 4);
        v4u w; w.x = pkbf(a[0], a[1]); w.y = pkbf(a[2], a[3]); w.z = pkbf(b[0], b[1]); w.w = pkbf(b[2], b[3]); *(v4u*)(dst + 8 * i) = w; }
}
template <bool I8, int LOFF = 8> __device__ __forceinline__ void cvt_rows_fp8(const float* src, unsigned char* dst, float* scl, int gw, int NGW, int lane, const float* colscale = nullptr) {
    for (int e0 = gw; e0 < NEXP; e0 += 2 * NGW) {
        f32x4 q[2][4]; float mx[2];
#pragma unroll
        for (int u = 0; u < 2; ++u) { const int e = (e0 + u * NGW < NEXP) ? e0 + u * NGW : e0; const float* r = src + (size_t)e * DM + 16 * lane;
            q[u][0] = *(const f32x4*)r; q[u][1] = *(const f32x4*)(r + 4); q[u][2] = *(const f32x4*)(r + 8); q[u][3] = *(const f32x4*)(r + 12);
            if (colscale) {
#pragma unroll
                for (int j = 0; j < 4; ++j) q[u][j] = q[u][j] * *(const f32x4*)(colscale + 16 * lane + 4 * j); } }
#pragma unroll
        for (int u = 0; u < 2; ++u) { float m = 0.f;
#pragma unroll
            for (int j = 0; j < 4; ++j) m = fmaxf(m, fmaxf(fmaxf(fabsf(q[u][j][0]), fabsf(q[u][j][1])), fmaxf(fabsf(q[u][j][2]), fabsf(q[u][j][3]))));
            mx[u] = m; }
#pragma unroll
        for (int o = 1; o < 64; o <<= 1) { mx[0] = fmaxf(mx[0], __shfl_xor(mx[0], o)); mx[1] = fmaxf(mx[1], __shfl_xor(mx[1], o)); }
#pragma unroll
        for (int u = 0; u < 2; ++u) { const int e = e0 + u * NGW; if (e < NEXP) {
            if constexpr (I8) {
                float best = 1.0f, berr = 3.0e38f;
#pragma unroll
                for (int ci = 0; ci < 5; ++ci) { const float rho = 1.0f - 0.1f * ci, cs = mx[u] > 1e-30f ? 7.0f / (rho * mx[u]) : 0.f, ics = rho * mx[u] * (1.0f / 7.0f); float er = 0.f;
#pragma unroll
                    for (int j = 0; j < 4; ++j)
#pragma unroll
                        for (int i = 0; i < 4; ++i) { const float x = q[u][j][i], d = x - ics * __builtin_amdgcn_fmed3f(rintf(x * cs), -7.0f, 7.0f); er += d * d; }
#pragma unroll
                    for (int o = 1; o < 64; o <<= 1) er += __shfl_xor(er, o);
                    if (er < berr) { berr = er; best = rho; } }
                const float cm = best * mx[u], sc = cm > 1e-30f ? 7.0f / cm : 0.f, isc = cm * (LOFF ? 1.0f / 112.0f : 1.0f / 7.0f);
                unsigned w[2] = {0u, 0u};
#pragma unroll
                for (int j = 0; j < 4; ++j)
#pragma unroll
                    for (int i = 0; i < 4; i += 2) { const int qe = (int)__builtin_amdgcn_fmed3f(rintf(q[u][j][i] * sc), -7.0f, 7.0f), qo = (int)__builtin_amdgcn_fmed3f(rintf(q[u][j][i + 1] * sc), -7.0f, 7.0f);
                        const unsigned byte = (((unsigned)qo & 15u) << 4) | ((unsigned)(qe + LOFF) & 15u); const int t = 2 * j + (i >> 1); w[t >> 2] |= byte << (8 * (t & 3)); }
                *(v2u*)(dst + (size_t)(lane >> 4) * ((size_t)NEXP * 128) + (size_t)e * 128 + 8 * (lane & 15)) = (v2u){w[0], w[1]};
                if (lane == 0) scl[e] = isc;
                continue; }
            } }
    }
}
__device__ __forceinline__ void p0_prologue(Frame& F, const Args& a) {
    unsigned char* ws = a.ws;
    LAS float* scr = (LAS float*)(F.lds + F.wave * 16384);
    const int gw = F.vcu * NWAVES + F.wave, NGW = F.G * NWAVES;
    for (int it = gw; it < 4096; it += NGW) {
        int r = it;
        if (r < 2048) { const int kb = r >> 7, db = r & 127; transpose_item(a.w_in, DIN, DM, (bf16*)(ws + WS_WIN), win_src_col(db), 32 * db, 64 * kb, scr, F.lane); continue; } r -= 2048;
        if (r < 256) { continue; } r -= 256;
        if (r < 256) { const int kb = r >> 5, nb = r & 31; transpose_item(a.w_ba, DM, DA, (bf16*)(ws + WS_WBA), 32 * nb, 32 * nb, 64 * kb, scr, F.lane); continue; } r -= 256;
        if (r < 512) { const int kb = r >> 5, nb = r & 31; transpose_item(a.w_out, DM, DM, (bf16*)(ws + WS_WOUT), 32 * nb, 32 * nb, 64 * kb, scr, F.lane); continue; } r -= 512;
        { const int kb = r >> 6, nb = r & 63; transpose_item(a.w_query, DQ, DM, (bf16*)(ws + WS_WQ), 32 * nb, 32 * nb, 64 * kb, scr, F.lane, a.norm_ffn_g); }
    }
    for (int it = gw; it < 16 * 4 * 16; it += NGW) { const int nb = it & 15, g = (it >> 4) & 3, cb = it >> 6; const int nn = 64 * nb + F.lane; float acc8[8];
#pragma unroll
        for (int i = 0; i < 8; ++i) acc8[i] = 0.f;
        const float* pm = a.pool_mix_w + (size_t)g * 16384 + (size_t)(8 * cb) * 128;
#pragma unroll 16
        for (int d = 0; d < 128; ++d) { const float wv = a.w_bp[(size_t)(g * 128 + d) * DM + nn] * a.pool_scale[g * 128 + d];
#pragma unroll
            for (int i = 0; i < 8; ++i) acc8[i] += pm[i * 128 + d] * wv; }
        v4u o; o.x = pkbf(acc8[0], acc8[1]); o.y = pkbf(acc8[2], acc8[3]); o.z = pkbf(acc8[4], acc8[5]); o.w = pkbf(acc8[6], acc8[7]);
        *(v4u*)((bf16*)(ws + WS_WBP) + (size_t)nn * DP + g * 128 + 8 * cb) = o; }
    { const size_t gtid = (size_t)F.vcu * NTHR + F.tid, gn = (size_t)F.G * NTHR;
      cvt_rows_fp8<true, 0>(a.peer_u, ws + WS_PU, (float*)(ws + WS_US), gw, NGW, F.lane, a.norm_ffn_g);
      cvt_rows_fp8<true>(a.peer_v, ws + WS_PV, (float*)(ws + WS_VS), gw, NGW, F.lane);
      cvt_rows_bf16(a.sub_keys, (bf16*)(ws + WS_SUBK), (size_t)PH * 2 * NKEYS * DKH / 8, gtid, gn);
      for (size_t i = gtid; i < (size_t)DB * 7 * DP; i += gn) { const int b = (int)(i / (7 * DP)), j = (int)((i / DP) % 7), c = (int)(i % DP);
          a.out[O_PS + (size_t)(b * 15 + j) * DP + c] = a.state_pool[(size_t)(b * 15 + 8 + j) * DP + c]; } }
    __syncthreads();
    LAS float* wfT = (LAS float*)F.lds;
    for (int i = F.tid; i < 8 * DM; i += NTHR) { const int col = i >> 3, h = i & 7; wfT[h * DM + col] = a.w_in[(size_t)col * DIN + 2048 + h]; }
    __syncthreads();
    bf16* XN = (bf16*)(ws + WS_XN);
    for (int row0 = gw; row0 < M; row0 += 2 * NGW) {
        f32x4 v[2][4]; float rr[2], f[2][8]; bool ok[2];
#pragma unroll
        for (int u = 0; u < 2; ++u) { const int row = row0 + u * NGW; ok[u] = row < M; const int rc = ok[u] ? row : row0;
            const float* xr = rc < MP ? a.x_p + (size_t)rc * DM : a.x_s + (size_t)(rc - MP) * DM;
#pragma unroll
            for (int j = 0; j < 4; ++j) v[u][j] = *(const f32x4*)(xr + 256 * j + 4 * F.lane); }
#pragma unroll
        for (int u = 0; u < 2; ++u) { float ss = 0.f;
#pragma unroll
            for (int j = 0; j < 4; ++j) ss += (v[u][j][0] * v[u][j][0] + v[u][j][1] * v[u][j][1]) + (v[u][j][2] * v[u][j][2] + v[u][j][3] * v[u][j][3]);
            rr[u] = ss; }
#pragma unroll
        for (int o = 1; o < 64; o <<= 1) { rr[0] += __shfl_xor(rr[0], o); rr[1] += __shfl_xor(rr[1], o); }
#pragma unroll
        for (int u = 0; u < 2; ++u) { const int row = ok[u] ? row0 + u * NGW : row0; const float r = 1.0f / sqrtf(rr[u] * (1.0f / DM) + EPS);
#pragma unroll
            for (int h = 0; h < 8; ++h) f[u][h] = 0.f;
#pragma unroll
            for (int j = 0; j < 4; ++j) { const f32x4 g = *(const f32x4*)(a.norm_mix_g + 256 * j + 4 * F.lane); v[u][j] = v[u][j] * r * g;
                v2u w; w.x = pkbf(v[u][j][0], v[u][j][1]); w.y = pkbf(v[u][j][2], v[u][j][3]); if (ok[u]) *(v2u*)(XN + (size_t)row * DM + 256 * j + 4 * F.lane) = w;
#pragma unroll
                for (int h = 0; h < 8; ++h) { const f32x4 wv = *(const LAS f32x4*)(wfT + h * DM + 256 * j + 4 * F.lane); f[u][h] += (v[u][j][0] * wv[0] + v[u][j][1] * wv[1]) + (v[u][j][2] * wv[2] + v[u][j][3] * wv[3]); } } }
#pragma unroll
        for (int u = 0; u < 2; ++u) { const int row = row0 + u * NGW;
            const bool b4 = (F.lane & 4) != 0, b2 = (F.lane & 2) != 0, b1 = (F.lane & 1) != 0; float t4[4], t2[2];
#pragma unroll
            for (int k = 0; k < 4; ++k) { const float keep = b4 ? f[u][4 + k] : f[u][k], send = b4 ? f[u][k] : f[u][4 + k]; t4[k] = keep + __shfl_xor(send, 4); }
#pragma unroll
            for (int k = 0; k < 2; ++k) { const float keep = b2 ? t4[2 + k] : t4[k], send = b2 ? t4[k] : t4[2 + k]; t2[k] = keep + __shfl_xor(send, 2); }
            float t1 = (b1 ? t2[1] : t2[0]) + __shfl_xor(b1 ? t2[0] : t2[1], 1);
            t1 += __shfl_xor(t1, 8); t1 += __shfl_xor(t1, 16); t1 += __shfl_xor(t1, 32);
            if (F.lane < 8 && ok[u]) { const float z = t1 + a.b_forget[F.lane]; const float lf = fminf(z, 0.f) - log1pf(expf(-fabsf(z)));
                if (row < MP) a.out[O_LFP + (size_t)row * NH + F.lane] = lf; else a.out[O_LFS + (size_t)(row - MP) * NH + F.lane] = lf; } }
    }
}

template <int W> __device__ __forceinline__ void p2_item(const Args& a, unsigned char* ws, int row, int ch) {
    const bf16* U = (const bf16*)(ws + WS_U); bf16* PO = (bf16*)(ws + WS_PO);
    float e[W][8]; float cnt;
    if (row < MP) { const int s = row & (SEQ - 1); cnt = (float)(s + 1 < W ? s + 1 : W);
#pragma unroll
        for (int i = 0; i < W; ++i) { v4u q = (v4u){0u, 0u, 0u, 0u}; if (s - i >= 0) q = *(const v4u*)(U + (size_t)(row - i) * DP + ch);
            e[i][0] = bflo(q.x); e[i][1] = bfhi(q.x); e[i][2] = bflo(q.y); e[i][3] = bfhi(q.y); e[i][4] = bflo(q.z); e[i][5] = bfhi(q.z); e[i][6] = bflo(q.w); e[i][7] = bfhi(q.w); }
    } else { const int rs = row - MP, b = rs >> 3, t = rs & 7; cnt = (float)W;
#pragma unroll
        for (int i = 0; i < W; ++i) { const int tt = t - i;
            if (tt >= 0) { const v4u q = *(const v4u*)(U + (size_t)(MP + b * 8 + tt) * DP + ch);
                e[i][0] = bflo(q.x); e[i][1] = bfhi(q.x); e[i][2] = bflo(q.y); e[i][3] = bfhi(q.y); e[i][4] = bflo(q.z); e[i][5] = bfhi(q.z); e[i][6] = bflo(q.w); e[i][7] = bfhi(q.w); }
            else { const f32x4 p0 = *(const f32x4*)(a.state_pool + (size_t)(b * 15 + 15 + tt) * DP + ch), p1 = *(const f32x4*)(a.state_pool + (size_t)(b * 15 + 15 + tt) * DP + ch + 4);
                e[i][0] = p0[0]; e[i][1] = p0[1]; e[i][2] = p0[2]; e[i][3] = p0[3]; e[i][4] = p1[0]; e[i][5] = p1[1]; e[i][6] = p1[2]; e[i][7] = p1[3]; } } }
    const float inv = 1.0f / cnt; float mm[8];
#pragma unroll
    for (int k = 0; k < 8; ++k) { float sum = 0.f;
#pragma unroll
        for (int i = 0; i < W; ++i) sum += e[i][k];
        mm[k] = sum * inv - e[0][k]; }
    v4u o; o.x = pkbf(mm[0], mm[1]); o.y = pkbf(mm[2], mm[3]); o.z = pkbf(mm[4], mm[5]); o.w = pkbf(mm[6], mm[7]);
    *(v4u*)(PO + (size_t)row * DP + ch) = o;
}
template <int W> __device__ __forceinline__ void p2_slide(unsigned char* ws, int row0, int ch) {
    const bf16* U = (const bf16*)(ws + WS_U); bf16* PO = (bf16*)(ws + WS_PO);
    const int s0 = row0 & (SEQ - 1);
    v4u x[W + 3];
#pragma unroll
    for (int k = 0; k < W + 3; ++k) { x[k] = (v4u){0u, 0u, 0u, 0u}; if (s0 + k - (W - 1) >= 0) x[k] = *(const v4u*)(U + (size_t)(row0 + k - (W - 1)) * DP + ch); }
    float S[8];
#pragma unroll
    for (int c = 0; c < 8; ++c) S[c] = 0.f;
#pragma unroll
    for (int k = 0; k < W; ++k) { const unsigned w4[4] = {x[k].x, x[k].y, x[k].z, x[k].w};
#pragma unroll
        for (int c = 0; c < 4; ++c) { S[2 * c] += bflo(w4[c]); S[2 * c + 1] += bfhi(w4[c]); } }
#pragma unroll
    for (int j = 0; j < 4; ++j) {
        const unsigned cur[4] = {x[W - 1 + j].x, x[W - 1 + j].y, x[W - 1 + j].z, x[W - 1 + j].w};
        if (j > 0) { const unsigned old4[4] = {x[j - 1].x, x[j - 1].y, x[j - 1].z, x[j - 1].w};
#pragma unroll
            for (int c = 0; c < 4; ++c) { S[2 * c] += bflo(cur[c]) - bflo(old4[c]); S[2 * c + 1] += bfhi(cur[c]) - bfhi(old4[c]); } }
        const int sj = s0 + j; const float inv = 1.0f / (float)(sj + 1 < W ? sj + 1 : W);
        v4u o; o.x = pkbf(S[0] * inv - bflo(cur[0]), S[1] * inv - bfhi(cur[0])); o.y = pkbf(S[2] * inv - bflo(cur[1]), S[3] * inv - bfhi(cur[1]));
        o.z = pkbf(S[4] * inv - bflo(cur[2]), S[5] * inv - bfhi(cur[2])); o.w = pkbf(S[6] * inv - bflo(cur[3]), S[7] * inv - bfhi(cur[3]));
        *(v4u*)(PO + (size_t)(row0 + j) * DP + ch) = o; }
}
__device__ __forceinline__ void p1_cumsum(Frame& F, const Args& a) {
    unsigned char* ws = a.ws;
    { const int gw = ((int)blockIdx.x - ((int)F.G - (NB * NH) / NWAVES)) * NWAVES + F.wave; float* CP2 = (float*)(ws + WS_CP2);
      if (gw >= 0 && gw < NB * NH) { const int b = gw >> 3, h = gw & 7; float carry = 0.f;
          for (int c = 0; c < SEQ / 64; ++c) { float v = a.out[O_LFP + (size_t)(b * SEQ + c * 64 + F.lane) * NH + h];
#pragma unroll
              for (int o = 1; o < 64; o <<= 1) { const float t = __shfl_up(v, o); if (F.lane >= o) v += t; }
              v += carry; CP2[(size_t)gw * SEQ + c * 64 + F.lane] = v * LOG2E; carry = __shfl(v, 63); } } }
}
__device__ __forceinline__ void p2_cumsum_pool(Frame& F, const Args& a) {
    unsigned char* ws = a.ws;
    const int nfree = F.G > 2 * (M / 256) ? F.G - M / 256 : F.G, myslot = F.G > 2 * (M / 256) ? (int)blockIdx.x - M / 256 : (int)blockIdx.x;
    if (myslot >= 0)
    for (int task = myslot * NWAVES + F.wave; task < (MP / 16) * 4; task += nfree * NWAVES) {
        const int g = task & 3, row0 = 16 * (task >> 2) + 4 * (F.lane >> 4), ch = g * 128 + (F.lane & 15) * 8;
        if (g == 0) p2_slide<2>(ws, row0, ch); else if (g == 1) p2_slide<4>(ws, row0, ch); else if (g == 2) p2_slide<8>(ws, row0, ch); else p2_slide<16>(ws, row0, ch);
    }
    if (myslot >= 0)
    for (int item = MP * 64 + myslot * NTHR + F.tid; item < M * 64; item += nfree * NTHR) {
        const int wv = item >> 6, g = wv & 3, row = 4 * (wv >> 2) + ((item >> 4) & 3), ch = g * 128 + (item & 15) * 8;
        if (g == 0) p2_item<2>(a, ws, row, ch); else if (g == 1) p2_item<4>(a, ws, row, ch); else if (g == 2) p2_item<8>(a, ws, row, ch); else p2_item<16>(a, ws, row, ch);
    }
}

__device__ __forceinline__ float attn_bound2(const Args& a, int lane) {
    asm volatile("" : "+v"(lane));
    const float gq = wave_max(fabsf(a.q_norm_g[lane])), gk = wave_max(fabsf(a.k_norm_g[lane]));
    return 64.0f * C2 * gq * gk * 1.03f;
}

typedef float f32x16 __attribute__((ext_vector_type(16)));
typedef short bf16x8v __attribute__((ext_vector_type(8)));
__device__ __forceinline__ int f2key(float s) { int b = __builtin_bit_cast(int, s); return b ^ ((b >> 31) & 0x7fffffff); }
__device__ __forceinline__ float key2f(int k) { return __builtin_bit_cast(float, k ^ ((k >> 31) & 0x7fffffff)); }
#define CE_DESC(x, y) do { const int mx_ = (x) > (y) ? (x) : (y), mn_ = (x) > (y) ? (y) : (x); (x) = mx_; (y) = mn_; } while (0)
template <int OFF, int N, typename T> __device__ __forceinline__ void bsort_desc(T& v) {
#pragma unroll
    for (int k = 2; k <= N; k <<= 1)
#pragma unroll
        for (int j = k >> 1; j > 0; j >>= 1)
#pragma unroll
            for (int i = 0; i < N; ++i) { const int l = i ^ j; if (l > i) { if ((i & k) == 0) CE_DESC(v[OFF + i], v[OFF + l]); else CE_DESC(v[OFF + l], v[OFF + i]); } }
}
template <int OFF, typename T> __device__ __forceinline__ void bmerge16_desc(T& v) {
#pragma unroll
    for (int j = 8; j > 0; j >>= 1)
#pragma unroll
        for (int i = 0; i < 16; ++i) { const int l = i ^ j; if (l > i) CE_DESC(v[OFF + i], v[OFF + l]); }
}
template <int OA, int OB, typename T> __device__ __forceinline__ void top16_merge(T& v) {
#pragma unroll
    for (int i = 0; i < 16; ++i) v[OA + i] = v[OA + i] > v[OB + 15 - i] ? v[OA + i] : v[OB + 15 - i];
    bmerge16_desc<OA>(v);
}
template <typename T> __device__ __forceinline__ void top16_of_64(T& v) {
    bsort_desc<0, 16>(v); bsort_desc<16, 16>(v); bsort_desc<32, 16>(v); bsort_desc<48, 16>(v);
    top16_merge<0, 16>(v); top16_merge<32, 48>(v); top16_merge<0, 32>(v);
}
__device__ __forceinline__ void p7_topk(Frame& F, const Args& a) {
    unsigned char* ws = a.ws;
    const bf16* PQ = (const bf16*)(ws + WS_PQ); const bf16* SK = (const bf16*)(ws + WS_SUBK); const float* RSS = (const float*)(ws + WS_RSS);
    int* SI = (int*)(ws + WS_SI); float* SG = (float*)(ws + WS_SG);
    const int lane = F.lane, j = lane & 31, hi = lane >> 5;
    constexpr int KROW = 272, KMAT = 128 * KROW;
    LAS unsigned char* kl = F.lds; LAS unsigned* ib = (LAS unsigned*)(F.lds + 2 * KMAT + F.wave * 1024);
    const int h = F.vcu & 7, wi = F.vcu >> 3, nwh = (F.G - h + 7) >> 3;
    __syncthreads();
    for (int i = F.tid; i < 2 * 128 * 16; i += NTHR) { const int p = i >> 11, n = (i >> 4) & 127, c = i & 15; *(LAS v4u*)(kl + p * KMAT + n * KROW + 16 * c) = *(const v4u*)(SK + ((size_t)(h * 2 + p) * NKEYS + n) * DKH + 8 * c); }
    __syncthreads();
    const bool grp = (F.G == 256);
    const int gx = F.vcu >> 5, wl = (F.vcu >> 3) & 3;
    for (int lt = (grp ? wl : wi) * NWAVES + F.wave; lt < (grp ? 68 : M / 32); lt += (grp ? 4 : nwh) * NWAVES) {
        const int tile = grp ? (lt < 64 ? 64 * gx + lt : 512 + 4 * gx + (lt - 64)) : lt;
        const int row0 = tile * 32;
        int jl = j, hl = hi; asm volatile("" : "+v"(jl), "+v"(hl));
        int top[2][16];
#pragma unroll
        for (int p = 0; p < 2; ++p) {
            bf16x8v qf[8];
#pragma unroll
            for (int ks = 0; ks < 8; ++ks) qf[ks] = *(const bf16x8v*)(PQ + (size_t)(row0 + jl) * DQ + h * 256 + p * 128 + 16 * ks + 8 * hl);
            f32x16 acc[4];
#pragma unroll
            for (int mt = 0; mt < 4; ++mt) acc[mt] = f32x16{};
            const LAS unsigned char* kb = kl + p * KMAT + jl * KROW + 16 * hl;
#pragma unroll
            for (int ks = 0; ks < 8; ++ks)
#pragma unroll
                for (int mt = 0; mt < 4; ++mt) { const bf16x8v af = *(const LAS bf16x8v*)(kb + mt * 32 * KROW + ks * 32); acc[mt] = __builtin_amdgcn_mfma_f32_32x32x16_bf16(af, qf[ks], acc[mt], 0, 0, 0); }
            int v[64];
#pragma unroll
            for (int mt = 0; mt < 4; ++mt)
#pragma unroll
                for (int r = 0; r < 16; ++r) { const int n = 32 * mt + (r & 3) + 8 * (r >> 2) + 4 * hi; v[16 * mt + r] = (f2key(acc[mt][r]) & ~127) | (127 - n); }
            top16_of_64(v);
#pragma unroll
            for (int i = 0; i < 16; ++i) top[p][i] = v[i];
        }
        int S[32];
#pragma unroll
        for (int i = 0; i < 16; ++i) { auto rr = __builtin_amdgcn_permlane32_swap((unsigned)top[0][i], (unsigned)top[1][i], false, false); S[i] = (int)rr[0]; S[16 + i] = (int)rr[1]; }
        top16_merge<0, 16>(S);
        { unsigned w0 = 0, w1 = 0, w2 = 0, w3 = 0;
#pragma unroll
          for (int i = 0; i < 4; ++i) { w0 |= (unsigned)(127 - (S[i] & 127)) << (8 * i); w1 |= (unsigned)(127 - (S[4 + i] & 127)) << (8 * i); w2 |= (unsigned)(127 - (S[8 + i] & 127)) << (8 * i); w3 |= (unsigned)(127 - (S[12 + i] & 127)) << (8 * i); }
          *(LAS v4u*)(ib + (hi * 32 + j) * 4) = (v4u){w0, w1, w2, w3}; }
        float s1[16], s2[16];
#pragma unroll
        for (int i = 0; i < 16; ++i) { auto rr = __builtin_amdgcn_permlane32_swap((unsigned)S[i], (unsigned)S[i], false, false); s1[i] = key2f((int)rr[0] & ~127); s2[i] = key2f((int)rr[1] & ~127); }
        int c[64]; { int n = 0;
#pragma unroll
          for (int ca = 0; ca < 16; ++ca)
#pragma unroll
              for (int cb = 0; cb < 16; ++cb) if ((ca + 1) * (cb + 1) <= 16) { c[n < 24 ? n : n + 8] = (f2key(s1[ca] + s2[cb]) & ~255) | (255 - (ca * 16 + cb)); ++n; }
#pragma unroll
          for (int q = 24; q < 32; ++q) c[q] = (int)0x80000000;
#pragma unroll
          for (int q = 58; q < 64; ++q) c[q] = (int)0x80000000; }
        top16_merge<0, 16>(c); bsort_desc<32, 16>(c); top16_merge<0, 32>(c); bsort_desc<48, 16>(c); top16_merge<0, 48>(c);
        float ssq = 0.f;
#pragma unroll
        for (int q = 0; q < 4; ++q) { const f32x4 t4 = *(const f32x4*)(RSS + (size_t)(row0 + j) * 16 + 4 * q); ssq += (t4[0] + t4[1]) + (t4[2] + t4[3]); }
        const float rstd = 1.0f / sqrtf(ssq * (1.0f / DM) + EPS);
        const float z0 = key2f(c[0] & ~255) * rstd; float e[16], esum = 0.f;
#pragma unroll
        for (int k = 0; k < 16; ++k) { e[k] = __expf(key2f(c[k] & ~255) * rstd - z0); esum += e[k]; }
        const float inv = 1.0f / esum;
        LDS_WAIT(); asm volatile("" ::: "memory");
        const LAS unsigned char* ib8 = (const LAS unsigned char*)ib;
        int oi[8]; float og[8];
#pragma unroll
        for (int k = 0; k < 8; ++k) { const int ck = hi ? c[8 + k] : c[k]; const float ek = hi ? e[8 + k] : e[k]; const int fl = 255 - (ck & 255);
            const int i1 = ib8[(0 * 32 + j) * 16 + (fl >> 4)], i2 = ib8[(1 * 32 + j) * 16 + (fl & 15)]; oi[k] = i1 * NKEYS + i2; og[k] = ek * inv; }
        { int* sp = SI + (size_t)(row0 + j) * 128 + h * 16 + hi * 8; float* gp = SG + (size_t)(row0 + j) * 128 + h * 16 + hi * 8;
          *(v4u*)sp = (v4u){(unsigned)oi[0], (unsigned)oi[1], (unsigned)oi[2], (unsigned)oi[3]}; *(v4u*)(sp + 4) = (v4u){(unsigned)oi[4], (unsigned)oi[5], (unsigned)oi[6], (unsigned)oi[7]};
          *(f32x4*)gp = (f32x4){og[0], og[1], og[2], og[3]}; *(f32x4*)(gp + 4) = (f32x4){og[4], og[5], og[6], og[7]}; }
        LDS_WAIT(); asm volatile("" ::: "memory");
    }
}


constexpr int P8_SW = 128;
#define FP8X2(wd, hi_) __builtin_amdgcn_cvt_pk_f32_fp8((int)(wd), (hi_))
constexpr int P8_T = 68;
static_assert(M % P8_T == 0, "P8 chunking");
__device__ __forceinline__ void p8_gather(Frame& F, const Args& a) {
    unsigned char* ws = a.ws;
    const bf16* HG = (const bf16*)(ws + WS_XN); const unsigned char* PU = ws + WS_PU; const unsigned char* PV = ws + WS_PV; const float* US = (const float*)(ws + WS_US); const float* VS = (const float*)(ws + WS_VS);
    const float* RSS = (const float*)(ws + WS_RSS); const int* SI = (const int*)(ws + WS_SI); const float* SG = (const float*)(ws + WS_SG);
    float* Y = a.out + O_YP; unsigned char* HQ = ws + WS_Q;
    LAS unsigned short* ix = (LAS unsigned short*)F.lds;
    LAS float* wt = (LAS float*)(F.lds + P8_T * 128 * 2);
    LAS float* zp = (LAS float*)(F.lds + P8_T * 128 * 6);
    LAS float* rs = (LAS float*)(F.lds + P8_T * 128 * 10);
    LAS float* hs = (LAS float*)(F.lds + P8_T * 128 * 10 + 512);
    LAS float* wsc = (LAS float*)(F.lds + P8_T * 128 * 10 + 1024);
    LAS unsigned char* wq = F.lds + P8_T * 128 * 10 + 2048;
    LAS int* swl = (LAS int*)(F.lds + P8_T * 128 * 10 + 2048 + P8_T * 128);
    int lane = F.lane; asm volatile("" : "+v"(lane));
    const int g = lane >> 3, c8 = lane & 7;
    const bool grp = (F.G == 256);
    for (int sup = F.vcu; sup < M / P8_T; sup += F.G) {
        const int tb = grp ? 2048 * (F.vcu >> 5) + 64 * (F.vcu & 31) : sup * P8_T, tb2 = grp ? MP + 128 * (F.vcu >> 5) + 4 * (F.vcu & 31) - 64 : tb;
#define P8_ROW(lt_) (((lt_) < 64 ? tb : tb2) + (lt_))
        __syncthreads();
        for (int i = F.tid; i < P8_T * 128; i += NTHR) { const size_t src = (size_t)P8_ROW(i >> 7) * 128 + (i & 127); ix[i] = (unsigned short)SI[src]; wt[i] = SG[src]; zp[i] = 0.f; }
        if (F.tid < P8_T) { float s = 0.f; for (int k = 0; k < 16; ++k) s += RSS[(size_t)P8_ROW(F.tid) * 16 + k]; rs[F.tid] = 1.0f / sqrtf(s * (1.0f / DM) + EPS); }
        for (int lt = F.wave; lt < P8_T; lt += NWAVES) { const bf16* hr = HG + (size_t)P8_ROW(lt) * DM + 16 * lane; const v4u ha = *(const v4u*)hr, hb2 = *(const v4u*)(hr + 8);
            const unsigned hp[8] = {ha.x, ha.y, ha.z, ha.w, hb2.x, hb2.y, hb2.z, hb2.w}; float hv[16], m = 0.f;
#pragma unroll
            for (int k = 0; k < 8; ++k) { hv[2 * k] = bflo(hp[k]); hv[2 * k + 1] = bfhi(hp[k]); m = fmaxf(m, fmaxf(fabsf(hv[2 * k]), fabsf(hv[2 * k + 1]))); }
#pragma unroll
            for (int o = 1; o < 64; o <<= 1) m = fmaxf(m, __shfl_xor(m, o));
            const float sc = m > 1e-30f ? 119.0f / m : 0.f;
            unsigned qa[2] = {0u, 0u}, qb[2] = {0u, 0u};
#pragma unroll
            for (int c = 0; c < 16; ++c) { const int h8 = (int)rintf(hv[c] * sc), b = ((h8 + 8) & 15) - 8, a4 = (h8 - b) >> 4; qa[c >> 3] |= ((unsigned)a4 & 15u) << (4 * (c & 7)); qb[c >> 3] |= ((unsigned)b & 15u) << (4 * (c & 7)); }
            unsigned char* hq = HQ + (size_t)P8_ROW(lt) * DM + (lane >> 4) * 256 + 8 * (lane & 15);
            *(v2u*)hq = (v2u){qa[0], qa[1]}; *(v2u*)(hq + 128) = (v2u){qb[0], qb[1]};
            if (lane == 0) hs[lt] = m * (1.0f / 119.0f); }
        asm volatile("s_waitcnt vmcnt(0)" ::: "memory");
        __syncthreads();
        if (F.tid == 0) { __builtin_amdgcn_fence(__ATOMIC_ACQUIRE, "agent"); asm volatile("s_waitcnt vmcnt(0)" ::: "memory"); }
        __syncthreads();
        for (int s = 0; s < 4; ++s) {
            __syncthreads();
            int cl = c8; asm volatile("" : "+v"(cl));
            const unsigned char* pus = PU + (size_t)s * ((size_t)NEXP * P8_SW) + 16 * cl;
#pragma unroll 1
            for (int lt = F.wave; lt < P8_T; lt += NWAVES) {
                const unsigned char* hq = HQ + (size_t)P8_ROW(lt) * DM + 256 * s + 16 * cl;
                const v4u h0 = *(const v4u*)hq, h1 = *(const v4u*)(hq + 128);
                const int hA[4] = {(int)h0.x, (int)h0.y, (int)h0.z, (int)h0.w}, hB[4] = {(int)h1.x, (int)h1.y, (int)h1.z, (int)h1.w};
                const v4u ea = *(const LAS v4u*)(ix + lt * 128 + g * 16), eb = *(const LAS v4u*)(ix + lt * 128 + g * 16 + 8);
                const unsigned ew[8] = {ea.x, ea.y, ea.z, ea.w, eb.x, eb.y, eb.z, eb.w};
                v4u r[16];
#pragma unroll
                for (int i = 0; i < 16; ++i) { const unsigned e = (i & 1) ? (ew[i >> 1] >> 16) : (ew[i >> 1] & 0xffffu); r[i] = *(const v4u*)(pus + (size_t)e * P8_SW); }
                int acc[16];
#pragma unroll
                for (int i = 0; i < 16; ++i) { const unsigned wd[4] = {r[i].x, r[i].y, r[i].z, r[i].w}; int dA = 0, dB = 0;
#pragma unroll
                    for (int jj = 0; jj < 4; ++jj) { dA = __builtin_amdgcn_sdot8((int)wd[jj], hA[jj], dA, false); dB = __builtin_amdgcn_sdot8((int)wd[jj], hB[jj], dB, false); }
                    acc[i] = (dA << 4) + dB; }
                int v8[8], v4[4], v2[2]; const bool b4 = (c8 & 4) != 0, b2 = (c8 & 2) != 0, b1 = (c8 & 1) != 0;
#pragma unroll
                for (int j2 = 0; j2 < 8; ++j2) { const int keep = b4 ? acc[8 + j2] : acc[j2], send = b4 ? acc[j2] : acc[8 + j2]; v8[j2] = keep + __shfl_xor(send, 4); }
#pragma unroll
                for (int j2 = 0; j2 < 4; ++j2) { const int keep = b2 ? v8[4 + j2] : v8[j2], send = b2 ? v8[j2] : v8[4 + j2]; v4[j2] = keep + __shfl_xor(send, 2); }
#pragma unroll
                for (int j2 = 0; j2 < 2; ++j2) { const int keep = b1 ? v4[2 + j2] : v4[j2], send = b1 ? v4[j2] : v4[2 + j2]; v2[j2] = keep + __shfl_xor(send, 1); }
                LAS f32x2* zq = (LAS f32x2*)(zp + lt * 128 + g * 16 + 2 * c8); const f32x2 z0 = *zq; *zq = (f32x2){z0[0] + (float)v2[0], z0[1] + (float)v2[1]};
            }
        }
        for (int lt = F.wave; lt < P8_T; lt += NWAVES) {
            const float r = rs[lt]; const int kk = lt * 128 + g * 16 + 2 * c8; LAS float* wp = wt + kk; const f32x2 gt = *(const LAS f32x2*)wp; const f32x2 zz = *(const LAS f32x2*)(zp + kk);
            const int e0 = ix[kk], e1 = ix[kk + 1];
            const float rh = r * hs[lt]; const float z0 = zz[0] * rh * US[e0], z1 = zz[1] * rh * US[e1];
            const float a0 = 0.5f * z0 * (1.0f + erff(z0 * 0.70710678118654752f)), a1 = 0.5f * z1 * (1.0f + erff(z1 * 0.70710678118654752f));
            const float w0 = gt[0] * a0 * VS[e0], w1 = gt[1] * a1 * VS[e1]; float mw = fmaxf(fabsf(w0), fabsf(w1));
#pragma unroll
            for (int o = 1; o < 64; o <<= 1) mw = fmaxf(mw, __shfl_xor(mw, o));
            const float wsq = mw > 1e-30f ? 127.0f / mw : 0.f; const int q0 = (int)rintf(w0 * wsq), q1 = (int)rintf(w1 * wsq);
            *(LAS unsigned short*)(wq + kk) = (unsigned short)(((unsigned)q0 & 255u) | (((unsigned)q1 & 255u) << 8));
            { int sg = q0 + q1; sg += __shfl_xor(sg, 1); sg += __shfl_xor(sg, 2); sg += __shfl_xor(sg, 4); if (c8 == 0) swl[lt * 8 + g] = sg; }
            if (lane == 0) wsc[lt] = mw * (1.0f / 127.0f); }
        LDS_WAIT(); asm volatile("" ::: "memory");
        for (int s = 0; s < 4; ++s) {
            __syncthreads();
            int cl = c8; asm volatile("" : "+v"(cl));
            const unsigned char* pvs = PV + (size_t)s * ((size_t)NEXP * P8_SW) + 16 * cl;
#pragma unroll 1
            for (int lt = F.wave; lt < P8_T; lt += NWAVES) {
                const v4u ea = *(const LAS v4u*)(ix + lt * 128 + g * 16), eb = *(const LAS v4u*)(ix + lt * 128 + g * 16 + 8);
                const unsigned ew[8] = {ea.x, ea.y, ea.z, ea.w, eb.x, eb.y, eb.z, eb.w};
                v4u r[16];
#pragma unroll
                for (int i = 0; i < 16; ++i) { const unsigned e = (i & 1) ? (ew[i >> 1] >> 16) : (ew[i >> 1] & 0xffffu); r[i] = *(const v4u*)(pvs + (size_t)e * P8_SW); }
                const v4u wq4 = *(const LAS v4u*)(wq + lt * 128 + g * 16); const int Wg[4] = {(int)wq4.x, (int)wq4.y, (int)wq4.z, (int)wq4.w};
                const int sw = swl[lt * 8 + g];
                int acc[32];
#pragma unroll
                for (int c = 0; c < 32; ++c) acc[c] = -8 * sw;
#pragma unroll
                for (int G = 0; G < 4; ++G)
#pragma unroll
                    for (int jj = 0; jj < 4; ++jj) {
                        const unsigned A = r[4 * G][jj], B = r[4 * G + 1][jj], C = r[4 * G + 2][jj], D = r[4 * G + 3][jj];
                        const unsigned t0 = __builtin_amdgcn_perm(B, A, 0x05010400u), t1 = __builtin_amdgcn_perm(B, A, 0x07030602u), t2 = __builtin_amdgcn_perm(D, C, 0x05010400u), t3 = __builtin_amdgcn_perm(D, C, 0x07030602u);
                        const unsigned T[4] = {__builtin_amdgcn_perm(t2, t0, 0x05040100u), __builtin_amdgcn_perm(t2, t0, 0x07060302u), __builtin_amdgcn_perm(t3, t1, 0x05040100u), __builtin_amdgcn_perm(t3, t1, 0x07060302u)};
#pragma unroll
                        for (int bb = 0; bb < 4; ++bb) { const int t = 4 * jj + bb;
                            acc[2 * t]     = __builtin_amdgcn_sdot4((int)(T[bb] & 0x0f0f0f0fu), Wg[G], acc[2 * t], false);
                            acc[2 * t + 1] = __builtin_amdgcn_sdot4((int)T[bb], Wg[G], acc[2 * t + 1], false); } }
#pragma unroll
                for (int t = 0; t < 16; ++t) { acc[2 * t + 1] -= acc[2 * t]; acc[2 * t] <<= 4; }
                const bool b5 = (lane & 32) != 0, b4 = (lane & 16) != 0, b3 = (lane & 8) != 0; int p16[16], p8[8], p4[4];
#pragma unroll
                for (int j2 = 0; j2 < 16; ++j2) { const int keep = b5 ? acc[16 + j2] : acc[j2], send = b5 ? acc[j2] : acc[16 + j2]; p16[j2] = keep + __shfl_xor(send, 32); }
#pragma unroll
                for (int j2 = 0; j2 < 8; ++j2) { const int keep = b4 ? p16[8 + j2] : p16[j2], send = b4 ? p16[j2] : p16[8 + j2]; p8[j2] = keep + __shfl_xor(send, 16); }
#pragma unroll
                for (int j2 = 0; j2 < 4; ++j2) { const int keep = b3 ? p8[4 + j2] : p8[j2], send = b3 ? p8[j2] : p8[4 + j2]; p4[j2] = keep + __shfl_xor(send, 8); }
                const size_t off = (size_t)P8_ROW(lt) * DM + 256 * s + 32 * cl + (b5 ? 16 : 0) + (b4 ? 8 : 0) + (b3 ? 4 : 0);
                const v2u hw2 = *(const v2u*)(HG + off); const float ws_t = wsc[lt];
                __builtin_nontemporal_store((f32x4){bflo(hw2.x) + ws_t * (float)p4[0], bfhi(hw2.x) + ws_t * (float)p4[1], bflo(hw2.y) + ws_t * (float)p4[2], bfhi(hw2.y) + ws_t * (float)p4[3]}, (f32x4*)(Y + off)); }
        }
    }
}
#undef P8_ROW

__device__ __forceinline__ void p3_sample_attn2(Frame& F, const Args& a, const float M2) {
    unsigned char* ws = a.ws;
    const bf16* Q = (const bf16*)(ws + WS_Q); bf16* AO = (bf16*)(ws + WS_AO);
    LAS float* D2 = (LAS float*)F.lds;
    constexpr int DST = PAST + PAST / 8;
    LAS float* E2 = (LAS float*)(F.lds + 36864);
    LAS float* Op = (LAS float*)(F.lds + 32768 + 128 + 8192);
    LAS float* lp = (LAS float*)(F.lds + 32768 + 128 + 8192 + 16384);
    int lane = F.lane; asm volatile("" : "+v"(lane));
    const int w = F.wave, hh = w >> 1, kh = w & 1, c = lane & 15, g = lane >> 4;
    for (;;) {
        __syncthreads();
        if (F.tid == 0) F.MISC[17] = __hip_atomic_fetch_add((unsigned*)(F.ctl + 8320), 1u, __ATOMIC_RELAXED, __HIP_MEMORY_SCOPE_AGENT);
        __syncthreads();
        const int unit = (int)F.MISC[17];
        if (unit >= DB * 2) break;
        const int b = unit >> 1, h = 4 * (unit & 1) + hh;
        const int pgv = a.page_table[b * NPAGES + (lane & (NPAGES - 1))];
        __syncthreads();
        for (int jk = F.tid; jk < PAST; jk += NTHR) { const int pg = __builtin_amdgcn_readlane(pgv, __builtin_amdgcn_readfirstlane(jk >> 7));
            const f32x4 l4 = *(const f32x4*)(a.cache_lf + ((size_t)pg * PAGE + (jk & 127)) * NH + 4 * (unit & 1));
            const int ji = jk + (jk >> 5) * 4; D2[ji] = l4[0]; D2[DST + ji] = l4[1]; D2[2 * DST + ji] = l4[2]; D2[3 * DST + ji] = l4[3]; }
        __syncthreads();
        if (kh == 0) {
            LAS float* d = D2 + hh * DST; float loc[32]; float tot = 0.f;
#pragma unroll
            for (int k = 31; k >= 0; --k) { loc[k] = tot; tot += d[lane * 36 + k]; }
            float inc = tot;
#pragma unroll
            for (int o = 1; o < 64; o <<= 1) { const float t = __shfl_down(inc, o); if (lane + o < 64) inc += t; }
            const float excl = inc - tot;
#pragma unroll
            for (int k = 0; k < 32; ++k) d[lane * 36 + k] = (loc[k] + excl) * LOG2E;
            if (lane < 8) { float lv[8], e = 0.f;
#pragma unroll
                for (int t = 0; t < 8; ++t) lv[t] = a.out[O_LFS + (size_t)(b * 8 + t) * NH + h];
#pragma unroll
                for (int t = 0; t < 8; ++t) e += (t <= lane) ? lv[t] : 0.f;
                E2[hh * 8 + lane] = e * LOG2E; }
        }
        __syncthreads();
        bf16x8v qb[2];
#pragma unroll
        for (int ks = 0; ks < 2; ++ks) { qb[ks] = bf16x8v{}; if (c < 8) qb[ks] = *(const bf16x8v*)(Q + (size_t)(MP + b * 8 + c) * DA + h * 64 + 32 * ks + 8 * g); }
        const float e2q = E2[hh * 8 + (c & 7)] - M2;
        f32x4 oacc[4]; float lsum = 0.f;
#pragma unroll
        for (int m = 0; m < 4; ++m) oacc[m] = (f32x4){0.f, 0.f, 0.f, 0.f};
        const LAS float* dh = D2 + hh * DST;
        int nskip; { const float dl = dh[36 * lane + 31]; nskip = __builtin_popcountll(__ballot(dl < -(24.f + 2.f * M2))); }
        nskip = __builtin_amdgcn_readfirstlane(nskip);
        const int nblk = PAST / 32 - nskip, nb0 = nblk >> 1;
        const int blk_lo = nskip + (kh ? nb0 : 0), nit = kh ? (nblk - nb0) : nb0;
#define S3_PACK8(x0_, x1_) __builtin_bit_cast(bf16x8v, (v4u){pkbf((x0_)[0], (x0_)[1]), pkbf((x0_)[2], (x0_)[3]), pkbf((x1_)[0], (x1_)[1]), pkbf((x1_)[2], (x1_)[3])})
#define S3_PV(p0_, p1_, vq_) do { const bf16x8v pb_ = S3_PACK8(p0_, p1_); \
            _Pragma("unroll") for (int m = 0; m < 4; ++m) { const bf16x8v va_ = __builtin_bit_cast(bf16x8v, (v4u){pkbf((vq_)[0][m], (vq_)[1][m]), pkbf((vq_)[2][m], (vq_)[3][m]), pkbf((vq_)[4][m], (vq_)[5][m]), pkbf((vq_)[6][m], (vq_)[7][m])}); \
                oacc[m] = __builtin_amdgcn_mfma_f32_16x16x32_bf16(va_, pb_, oacc[m], 0, 0, 0); } } while (0)
        for (int it = 0; it < nit; ++it) {
            const int j0 = (blk_lo + it) * 32; const int pg = __builtin_amdgcn_readlane(pgv, __builtin_amdgcn_readfirstlane(j0 >> 7));
            const size_t rowoff = (((size_t)pg * PAGE + (j0 & 127)) * NH + h) * HD;
            const float* kr = a.cache_k + rowoff + (size_t)c * (NH * HD) + 8 * g; const float* vr = a.cache_v + rowoff + 4 * c;
            f32x4 kq[2][2][2], vq[8];
#pragma unroll
            for (int tl = 0; tl < 2; ++tl)
#pragma unroll
                for (int ks = 0; ks < 2; ++ks) { const float* kp = kr + (size_t)(16 * tl) * (NH * HD) + 32 * ks; kq[tl][ks][0] = __builtin_nontemporal_load((const f32x4*)kp); kq[tl][ks][1] = __builtin_nontemporal_load((const f32x4*)(kp + 4)); }
#pragma unroll
            for (int jj = 0; jj < 8; ++jj) vq[jj] = __builtin_nontemporal_load((const f32x4*)(vr + (size_t)((jj < 4 ? 0 : 12) + 4 * g + jj) * (NH * HD)));
            const f32x4 d0 = *(const LAS f32x4*)(dh + j0 + (j0 >> 3) + 4 * g), d1 = *(const LAS f32x4*)(dh + j0 + (j0 >> 3) + 16 + 4 * g);
            f32x4 s0 = d0 + e2q, s1 = d1 + e2q;
#pragma unroll
            for (int ks = 0; ks < 2; ++ks) { s0 = __builtin_amdgcn_mfma_f32_16x16x32_bf16(S3_PACK8(kq[0][ks][0], kq[0][ks][1]), qb[ks], s0, 0, 0, 0);
                                             s1 = __builtin_amdgcn_mfma_f32_16x16x32_bf16(S3_PACK8(kq[1][ks][0], kq[1][ks][1]), qb[ks], s1, 0, 0, 0); }
            f32x4 p0, p1;
#pragma unroll
            for (int r = 0; r < 4; ++r) { p0[r] = __builtin_amdgcn_exp2f(s0[r]); p1[r] = __builtin_amdgcn_exp2f(s1[r]); }
            lsum += (p0[0] + p0[1]) + (p0[2] + p0[3]) + (p1[0] + p1[1]) + (p1[2] + p1[3]);
            S3_PV(p0, p1, vq);
        }
        if (kh == 1) {
            const float* kr = a.out + O_KS + (size_t)(b * 8 + (c & 7)) * DA + h * HD + 8 * g;
            f32x4 s0 = (f32x4){0.f, 0.f, 0.f, 0.f};
#pragma unroll
            for (int ks = 0; ks < 2; ++ks) { const f32x4 x0 = *(const f32x4*)(kr + 32 * ks), x1 = *(const f32x4*)(kr + 32 * ks + 4); s0 = __builtin_amdgcn_mfma_f32_16x16x32_bf16(S3_PACK8(x0, x1), qb[ks], s0, 0, 0, 0); }
            f32x4 p0, p1 = (f32x4){0.f, 0.f, 0.f, 0.f}, vq[8];
#pragma unroll
            for (int r = 0; r < 4; ++r) { const int key = 4 * g + r; const float ek = E2[hh * 8 + (key & 7)]; p0[r] = (key < 8 && key <= c) ? __builtin_amdgcn_exp2f(s0[r] + e2q - ek) : 0.f; }
#pragma unroll
            for (int jj = 0; jj < 8; ++jj) { vq[jj] = (f32x4){0.f, 0.f, 0.f, 0.f}; if (jj < 4 && g < 2) vq[jj] = *(const f32x4*)(a.out + O_VS + (size_t)(b * 8 + 4 * g + jj) * DA + h * HD + 4 * c); }
            lsum += (p0[0] + p0[1]) + (p0[2] + p0[3]);
            S3_PV(p0, p1, vq);
        }
#undef S3_PV
#undef S3_PACK8
        lsum += __shfl_xor(lsum, 16); lsum += __shfl_xor(lsum, 32);
        if (lane < 8) lp[w * 8 + lane] = lsum;
        if (c < 8) {
#pragma unroll
            for (int r = 0; r < 4; ++r) *(LAS f32x4*)(Op + (w * 8 + c) * 64 + 16 * g + 4 * r) = (f32x4){oacc[0][r], oacc[1][r], oacc[2][r], oacc[3][r]}; }
        __syncthreads();
        for (int i = F.tid; i < 4 * 8 * 64; i += NTHR) { const int hq = i >> 9, t = (i >> 6) & 7, d = i & 63;
            const float O = Op[((2 * hq) * 8 + t) * 64 + d] + Op[((2 * hq + 1) * 8 + t) * 64 + d], L = lp[(2 * hq) * 8 + t] + lp[(2 * hq + 1) * 8 + t];
            AO[(size_t)(MP + b * 8 + t) * DA + (4 * (unit & 1) + hq) * 64 + d] = (bf16)(pkbf(O / L, 0.f) & 0xffffu); }
    }
}


template <class Epi> __device__ __forceinline__ void sg_phase(Frame& F, const bf16* A  , const bf16* Bt  , int K, int N, const Epi& E) {
    int lane = F.lane; asm volatile("" : "+v"(lane));
    const int fr = lane & 15, fq = lane >> 4, ntc = N >> 6, ntile = (MS / 128) * ntc, pitch = 2 * K + 16, kc = K >> 3;
    const bool grp = (F.G == 256);
    for (int t = grp ? (F.vcu & 31) : F.vcu; t < (grp ? ntc : ntile); t += grp ? 32 : F.G) {
        const int tr = grp ? (F.vcu >> 5) : t % (MS / 128), tc = grp ? t : t / (MS / 128);
        __syncthreads();
        for (int i = F.tid; i < 64 * kc; i += NTHR) { const int r = i / kc, c = i - r * kc; *(LAS v4u*)(F.lds + r * pitch + 16 * c) = *(const v4u*)(Bt + (size_t)(64 * tc + r) * K + 8 * c); }
        __syncthreads();
        const bf16* ap = A + (size_t)(128 * tr + 16 * F.wave + fr) * K + 8 * fq;
        const LAS unsigned char* bp = F.lds + fr * pitch + 16 * fq;
        f32x4 acc[4];
#pragma unroll
        for (int c = 0; c < 4; ++c) acc[c] = (f32x4){0.f, 0.f, 0.f, 0.f};
#pragma unroll 8
        for (int ks = 0; ks < K; ks += 32) {
            const bf16x8v av = *(const bf16x8v*)(ap + ks);
#pragma unroll
            for (int c = 0; c < 4; ++c) { const bf16x8v bv = *(const LAS bf16x8v*)(bp + 16 * c * pitch + 2 * ks); acc[c] = __builtin_amdgcn_mfma_f32_16x16x32_bf16(bv, av, acc[c], 0, 0, 0); }
        }
        E(acc, 128 * tr + 16 * F.wave + fr, tc, fq);
    }
}
template <int MODE> struct SgGate { const bf16* G; const bf16* Tin; bf16* O;
    __device__ __forceinline__ void operator()(const f32x4 (&acc)[4], int rs, int tc, int fq) const {
#pragma unroll
        for (int c = 0; c < 4; ++c) { const size_t off = (size_t)(MP + rs) * DM + 64 * tc + 16 * c + 4 * fq; const v2u g = *(const v2u*)(G + off);
            float r[4] = {acc[c][0] * bflo(g.x), acc[c][1] * bfhi(g.x), acc[c][2] * bflo(g.y), acc[c][3] * bfhi(g.y)};
            if (MODE == 1) { const v2u t = *(const v2u*)(Tin + off); r[0] += bflo(t.x); r[1] += bfhi(t.x); r[2] += bflo(t.y); r[3] += bfhi(t.y); }
            v2u w; w.x = pkbf(r[0], r[1]); w.y = pkbf(r[2], r[3]); *(v2u*)(O + off) = w; } } };
struct SgOut { const float* xs; float* H; bf16* HG; const float* gf; float* RSS;
    __device__ __forceinline__ void operator()(const f32x4 (&acc)[4], int rs, int tc, int fq) const { float ss = 0.f;
#pragma unroll
        for (int c = 0; c < 4; ++c) { const int col = 64 * tc + 16 * c + 4 * fq; const f32x4 h = acc[c] + *(const f32x4*)(xs + (size_t)rs * DM + col);
            ss += (h[0] * h[0] + h[1] * h[1]) + (h[2] * h[2] + h[3] * h[3]);
            v2u w; w.x = pkbf(h[0], h[1]); w.y = pkbf(h[2], h[3]); *(v2u*)(HG + (size_t)(MP + rs) * DM + col) = w; }
        ss += __shfl_xor(ss, 16); ss += __shfl_xor(ss, 32);
        if (fq == 0) RSS[(size_t)(MP + rs) * 16 + tc] = ss; } };
struct SgPQ { bf16* PQ;
    __device__ __forceinline__ void operator()(const f32x4 (&acc)[4], int rs, int tc, int fq) const {
#pragma unroll
        for (int c = 0; c < 4; ++c) { v2u w; w.x = pkbf(acc[c][0], acc[c][1]); w.y = pkbf(acc[c][2], acc[c][3]); *(v2u*)(PQ + (size_t)(MP + rs) * DQ + 64 * tc + 16 * c + 4 * fq) = w; } } };

constexpr int CW_GRP = 8448, CW_XID = 12288;
__device__ __forceinline__ void group_barrier(const Frame& F, const XcdBarrier& b, int seam) {
    asm volatile("s_waitcnt vmcnt(0)" ::: "memory");
    __syncthreads();
    if (threadIdx.x == 0) {
        const unsigned x = blockIdx.x & 7u, n = (gridDim.x - x + 7u) >> 3;
        unsigned same = F.MISC[20];
        if (same == 0u) { unsigned acc = 1u; for (unsigned m = x; m < gridDim.x; m += 8u) acc &= (xb_ld((unsigned*)(F.ctl + CW_XID + (int)m)) == b.x + 1u) ? 1u : 0u; same = 1u + acc; F.MISC[20] = same; }
        unsigned* c = (unsigned*)(F.ctl + CW_GRP + 64 * (seam * 8 + (int)x));
        if (same != 2u) { __builtin_amdgcn_fence(__ATOMIC_RELEASE, "agent"); asm volatile("s_waitcnt vmcnt(0)" ::: "memory"); }
        (void)xb_add(c, 1u);
        XB_SPIN(xb_ld(c) < n, b.bar);
        __builtin_amdgcn_fence(__ATOMIC_ACQUIRE, "agent");
        asm volatile("s_waitcnt vmcnt(0)" ::: "memory");
    }
    __syncthreads();
}

struct ChainOrder : pg8::StaticOrder {
    __device__ bool next(int i, pg8::Unit& u) const { const bool ok = pg8::StaticOrder::next(i >> 1, u); u.sel = i & 1; return ok; }
};

constexpr int N_PHASES = 9;
#ifndef MK_PER_PHASE
#define MK_PER_PHASE 0
#endif
__global__ void __launch_bounds__(NTHR, 2) fwd_kernel(Args args) {
    extern __shared__ __attribute__((aligned(16))) unsigned char lds[];
    Frame F;
    F.lds = (LAS unsigned char*)lds; F.MISC = (volatile LAS unsigned*)(F.lds + MISC_OFF);
    F.tid = threadIdx.x; F.lane = F.tid & 63; F.wave = __builtin_amdgcn_readfirstlane(F.tid >> 6);
    F.G = gridDim.x; { const int bx = blockIdx.x; F.vcu = (F.G % 8 == 0) ? (bx % 8) * (F.G / 8) + bx / 8 : bx; }
    F.ctl = (gu32*)(args.ws + WS_CTL);
    for (int u = F.tid; u < (LDS_BYTES - MISC_OFF) / 4; u += NTHR) ((LAS unsigned*)(F.lds + MISC_OFF))[u] = 0u;
    __syncthreads();
#if MK_PER_PHASE
#define GRID_BAR() do { } while (0)
#else
    XcdBarrier bar = xcd_barrier_post((unsigned*)(F.ctl + CW_BAR), F.MISC + 8);
    if (F.tid == 0) __hip_atomic_store((unsigned*)(F.ctl + CW_XID + (int)blockIdx.x), bar.x + 1u, __ATOMIC_RELAXED, __HIP_MEMORY_SCOPE_AGENT);
#define GRID_BAR() xcd_barrier(bar)
#endif
    unsigned char* ws = args.ws;
    const int lo = args.ph_lo, hi = args.ph_hi;
    const bool grp = (F.G == 256);
#ifndef DBG_REP_PHASE
#define DBG_REP_PHASE -1
#endif
#ifndef DBG_REP_N
#define DBG_REP_N 1
#endif
#define REPS(k) for (int rep_ = 0; rep_ < ((k) == DBG_REP_PHASE ? 1 + DBG_REP_N : 1); ++rep_)
#define IN(k) (lo <= (k) && (k) < hi)
#define BOTH(k) (IN(k) && IN((k) + 1))
#define ENDPH(k) do { if (BOTH(k) || (k) == DBG_REP_PHASE) GRID_BAR(); } while (0)
#if MK_PER_PHASE
#define ENDPH_G(k, seam) ENDPH(k)
#else
#define ENDPH_G(k, seam) do { if (BOTH(k) || (k) == DBG_REP_PHASE) { if (grp && (k) != DBG_REP_PHASE) group_barrier(F, bar, seam); else GRID_BAR(); } } while (0)
#endif
    if (IN(0)) REPS(0) { p0_prologue(F, args); ENDPH(0); }
    if (IN(1)) REPS(1) {
        p1_cumsum(F, args);
        pg8::Gemm g{(const bf16*)(ws + WS_XN), (const bf16*)(ws + WS_WIN), M, NPROJ - 256, DM}; pg8::StaticOrder S; S.init(M, NPROJ - 256, F.G, (int)blockIdx.x);
        EpiInProj E{(bf16*)(ws + WS_U), (bf16*)(ws + WS_Q), (bf16*)(ws + WS_K), (bf16*)(ws + WS_V), (bf16*)(ws + WS_GA), (bf16*)(ws + WS_GB), args.out, args.q_norm_g, args.k_norm_g, 0};
        pg8::gemm_phase<EpiInProj, pg8::StaticOrder, true, true>(F.lds, g, S, E);
        ENDPH(1);
    }
    if (IN(2)) REPS(2) {
        { pg8::Gemm g{(const bf16*)(ws + WS_XN), (const bf16*)(ws + WS_WIN) + (size_t)(NPROJ - 256) * DM, M, 256, DM}; pg8::StaticOrder S; S.init(M, 256, F.G, (int)blockIdx.x);
          EpiInProj E{(bf16*)(ws + WS_U), (bf16*)(ws + WS_Q), (bf16*)(ws + WS_K), (bf16*)(ws + WS_V), (bf16*)(ws + WS_GA), (bf16*)(ws + WS_GB), args.out, args.q_norm_g, args.k_norm_g, 15};
          pg8::gemm_phase<EpiInProj, pg8::StaticOrder, true, true>(F.lds, g, S, E); }
        __syncthreads();
        p2_cumsum_pool(F, args);
        if (2 == DBG_REP_PHASE || !IN(3)) GRID_BAR();
        __syncthreads(); }
    if (IN(3)) {
        const float M2 = __builtin_bit_cast(float, __builtin_amdgcn_readfirstlane(__builtin_bit_cast(int, attn_bound2(args, F.lane))));
#if !defined(DBG_SKIP_PATTN)
        { const attn_body::AttnTensors AT{(const attn_body::bf16*)(ws + WS_Q), (const attn_body::bf16*)(ws + WS_K), (const attn_body::bf16*)(ws + WS_V), (attn_body::bf16*)(ws + WS_AO), (const float*)(ws + WS_CP2), M2};
          const attn_body::QueueOrder S{(unsigned*)(F.ctl + 8192), F.MISC + 16};
          attn_body::attn_phase<attn_body::QueueOrder>((char*)lds, AT, S);
#ifdef DBG_ATTN2
          __syncthreads(); attn_body::attn_phase<attn_body::StaticOrder>((char*)lds, AT, S);
#endif
        }
#endif
        REPS(3) { p3_sample_attn2(F, args, M2); }
        ENDPH(3); }
    if (IN(4)) REPS(4) {
        { pg8::Gemm g{(const bf16*)(ws + WS_PO), (const bf16*)(ws + WS_WBP), MP, DM, DP, (const bf16*)(ws + WS_AO), (const bf16*)(ws + WS_WBA)}; ChainOrder S; S.init(MP, DM, F.G, (int)blockIdx.x);
          EpiMerge E{(const bf16*)(ws + WS_GA), (const bf16*)(ws + WS_GB), (bf16*)(ws + WS_MIX)};
          pg8::gemm_phase<EpiMerge, ChainOrder, true, true>(F.lds, g, S, E); }
        { SgGate<0> E{(const bf16*)(ws + WS_GA), nullptr, (bf16*)(ws + WS_T)}; sg_phase(F, (const bf16*)(ws + WS_PO) + (size_t)MP * DP, (const bf16*)(ws + WS_WBP), DP, DM, E); }
        asm volatile("s_waitcnt vmcnt(0)" ::: "memory"); __syncthreads();
        { SgGate<1> E{(const bf16*)(ws + WS_GB), (const bf16*)(ws + WS_T), (bf16*)(ws + WS_MIX)}; sg_phase(F, (const bf16*)(ws + WS_AO) + (size_t)MP * DA, (const bf16*)(ws + WS_WBA), DA, DM, E); }
        ENDPH_G(4, 0);
    }
    if (IN(5)) REPS(5) {
        pg8::Gemm g{(const bf16*)(ws + WS_MIX), (const bf16*)(ws + WS_WOUT), MP, DM, DM}; pg8::StaticOrder S; S.init(MP, DM, F.G, (int)blockIdx.x);
        EpiOut E{args.x_p, args.x_s, (float*)(ws + WS_H), (bf16*)(ws + WS_XN), args.norm_ffn_g, (float*)(ws + WS_RSS)};
        pg8::gemm_phase<EpiOut, pg8::StaticOrder, true, true>(F.lds, g, S, E);
        { SgOut E2{args.x_s, (float*)(ws + WS_H), (bf16*)(ws + WS_XN), args.norm_ffn_g, (float*)(ws + WS_RSS)}; sg_phase(F, (const bf16*)(ws + WS_MIX) + (size_t)MP * DM, (const bf16*)(ws + WS_WOUT), DM, DM, E2); }
        ENDPH_G(5, 1);
    }
    if (IN(6)) REPS(6) {
        pg8::Gemm g{(const bf16*)(ws + WS_XN), (const bf16*)(ws + WS_WQ), MP, DQ, DM}; pg8::StaticOrder S; S.init(MP, DQ, F.G, (int)blockIdx.x);
        pg8::EpiBf16<0> E{(bf16*)(ws + WS_PQ), DQ, nullptr, 0, 0, 1.f};
        pg8::gemm_phase<pg8::EpiBf16<0>, pg8::StaticOrder, true, true>(F.lds, g, S, E);
        { SgPQ E2{(bf16*)(ws + WS_PQ)}; sg_phase(F, (const bf16*)(ws + WS_XN) + (size_t)MP * DM, (const bf16*)(ws + WS_WQ), DM, DQ, E2); }
        ENDPH_G(6, 2);
    }
    if (IN(7)) REPS(7) { p7_topk(F, args); ENDPH_G(7, 3); }
    if (IN(8)) REPS(8) { p8_gather(F, args); ENDPH(8); }
#ifdef DBG_DUMP
    if (IN(9)) { const bf16* AO = (const bf16*)(ws + WS_AO); const bf16* PO = (const bf16*)(ws + WS_PO); const bf16* MX = (const bf16*)(ws + (DBG_DUMP == 3 ? WS_T : DBG_DUMP == 4 ? WS_GA : WS_MIX));
        for (size_t i = (size_t)blockIdx.x * NTHR + F.tid; i < (size_t)M * DM; i += (size_t)F.G * NTHR) { const int row = (int)(i >> 10), c = (int)(i & 1023);
            float v; if (DBG_DUMP == 1) v = c < 512 ? bf2f(AO[(size_t)row * DA + c]) : bf2f(PO[(size_t)row * DP + c - 512]); else v = bf2f(MX[i]);
            args.out[O_YP + i] = v; } }
#endif
#undef IN
#undef BOTH
}

extern "C" void kernel_launch(void* const* d_in, const int* in_sizes, int n_in, void* d_out, int out_size, void* d_ws, size_t ws_size, hipStream_t stream) {
    static int grid = 0;
    if (grid == 0) {
        if (n_in != 22 || (size_t)out_size != O_END || ws_size < WS_END) { fprintf(stderr, "kernel_launch: unexpected shapes (n_in %d out %d ws %zu)\n", n_in, out_size, ws_size); grid = -1; return; }
        int dev = 0, cus = 0, per_cu = 0;
        if (hipGetDevice(&dev) != hipSuccess || hipDeviceGetAttribute(&cus, hipDeviceAttributeMultiprocessorCount, dev) != hipSuccess) { grid = -1; return; }
        if (hipFuncSetAttribute((const void*)fwd_kernel, hipFuncAttributeMaxDynamicSharedMemorySize, LDS_BYTES) != hipSuccess) { fprintf(stderr, "kernel_launch: hipFuncSetAttribute failed\n"); grid = -1; return; }
        if (hipOccupancyMaxActiveBlocksPerMultiprocessor(&per_cu, (const void*)fwd_kernel, NTHR, LDS_BYTES) != hipSuccess || per_cu < 1) fprintf(stderr, "kernel_launch: occupancy query reports %d\n", per_cu);
        (void)hipGetLastError();
        grid = cus;
    }
    if (grid < 0) return;
    if (hipMemsetAsync((char*)d_ws + WS_CTL, 0, CTL_ZERO_BYTES, stream) != hipSuccess) return;
    Args a{};
    a.x_p = (const float*)d_in[0]; a.x_s = (const float*)d_in[1]; a.cache_k = (const float*)d_in[2]; a.cache_v = (const float*)d_in[3]; a.cache_lf = (const float*)d_in[4];
    a.state_pool = (const float*)d_in[5]; a.page_table = (const int*)d_in[6]; a.norm_mix_g = (const float*)d_in[7]; a.w_in = (const float*)d_in[8]; a.b_forget = (const float*)d_in[9];
    a.q_norm_g = (const float*)d_in[10]; a.k_norm_g = (const float*)d_in[11]; a.pool_mix_w = (const float*)d_in[12]; a.pool_scale = (const float*)d_in[13]; a.w_bp = (const float*)d_in[14];
    a.w_ba = (const float*)d_in[15]; a.w_out = (const float*)d_in[16]; a.norm_ffn_g = (const float*)d_in[17]; a.w_query = (const float*)d_in[18]; a.sub_keys = (const float*)d_in[19];
    a.peer_u = (const float*)d_in[20]; a.peer_v = (const float*)d_in[21];
    a.out = (float*)d_out; a.ws = (unsigned char*)d_ws; a.pad = 0;
#if MK_PER_PHASE
#ifndef DBG_NPH
#define DBG_NPH N_PHASES
#endif
    for (int ph = 0; ph < DBG_NPH; ++ph) { a.ph_lo = ph; a.ph_hi = ph + 1; a.li = ph; hipLaunchKernelGGL(fwd_kernel, dim3(grid), dim3(NTHR), LDS_BYTES, stream, a); }
#ifdef DBG_DUMP
    a.ph_lo = 9; a.ph_hi = 10; a.li = 9; hipLaunchKernelGGL(fwd_kernel, dim3(grid), dim3(NTHR), LDS_BYTES, stream, a);
#endif
#else
    a.ph_lo = 0; a.ph_hi = N_PHASES; a.li = 0; hipLaunchKernelGGL(fwd_kernel, dim3(grid), dim3(NTHR), LDS_BYTES, stream, a);
#endif
}
```
